# Optimizing an MI355X kernel written in HIP

```python
import jax
import jax.numpy as jnp
from jax import lax
import numpy as np

D_MODEL = 1024
BATCH = 2
SEQ = 8192
DEPTH = 2

GRID_W = 64
CTX_LEN = 256
EPS = 1e-6
N_MOD = 6
A_GROUPS = 4
A_GROUP_DIM = 128
A_WIDTH = A_GROUPS * A_GROUP_DIM
CHUNK = 128
N_Q_HEADS = 4
N_KV_HEADS = 2
HEAD_DIM = 128
Q_BLOCK = 128
ROPE_THETA = 10000.0
B_WIDTH = N_Q_HEADS * HEAD_DIM
KV_WIDTH = N_KV_HEADS * HEAD_DIM
AB_IN = 2 * A_WIDTH + B_WIDTH + 2 * KV_WIDTH
AB_OUT = A_WIDTH + B_WIDTH
D_RNN = 1280
RNN_BLOCK = 128
N_RNN_BLOCKS = D_RNN // RNN_BLOCK
CONV_W = 4
RG_C = 8.0
PEER_HEADS = 8
N_KEYS = 128
N_EXPERTS = N_KEYS * N_KEYS
PEER_TOPK = 16
D_KEY = 256
TOKEN_BLOCK = 128
N_EVEN = (DEPTH + 1) // 2
N_ODD = DEPTH // 2

kernel_name = 'hybrid_gmlp_gqa_rglru_peer_trunk'


def rmsnorm(x, g):
    xf = x.astype(jnp.float32)
    y = xf * lax.rsqrt(jnp.mean(xf * xf, axis=-1, keepdims=True) + EPS)
    return y.astype(x.dtype) * g


def modulate(h, shift, scale):
    return h * (1 + scale) + shift


def axial_rope_tables(rows):
    n = rows * GRID_W
    row = jnp.broadcast_to(jnp.arange(rows, dtype=jnp.int32)[:, None], (rows, GRID_W)).reshape(n)
    col = jnp.broadcast_to(jnp.arange(GRID_W, dtype=jnp.int32)[None, :], (rows, GRID_W)).reshape(n)
    n_freq = HEAD_DIM // 4
    inv_freq = ROPE_THETA ** (-jnp.arange(n_freq, dtype=jnp.float32) / n_freq)
    ang = jnp.stack([row.astype(jnp.float32)[:, None] * inv_freq,
                     col.astype(jnp.float32)[:, None] * inv_freq], axis=1)
    return jnp.cos(ang), jnp.sin(ang)


def apply_axial_rope(x, cos, sin):
    b, n, h, d = x.shape
    xf = x.astype(jnp.float32).reshape(b, n, h, 2, 2, d // 4)
    c = cos[None, :, None]
    s = sin[None, :, None]
    x1, x2 = xf[..., 0, :], xf[..., 1, :]
    out = jnp.stack([x1 * c - x2 * s, x2 * c + x1 * s], axis=-2)
    return out.reshape(b, n, h, d).astype(x.dtype)


def block_attention(q, k, v):
    b, n, h, d = q.shape
    g = h // N_KV_HEADS
    qb = q.reshape(b, n // Q_BLOCK, Q_BLOCK, N_KV_HEADS, g, d).transpose(1, 0, 2, 3, 4, 5)
    scale = HEAD_DIM ** -0.5

    def one_block(qblk):
        s = jnp.einsum('bqkgd,bmkd->bkgqm', qblk, k).astype(jnp.float32) * scale
        p = jax.nn.softmax(s, axis=-1).astype(v.dtype)
        return jnp.einsum('bkgqm,bmkd->bqkgd', p, v)

    o = lax.map(one_block, qb)
    return o.transpose(1, 0, 2, 3, 4, 5).reshape(b, n, h * d)


def chunk_gmlp(za, norm_g, ws, bs):
    b, n, _ = za.shape
    za = jax.nn.gelu(za)
    u, vv = za[..., :A_WIDTH], za[..., A_WIDTH:]
    vv = rmsnorm(vv.reshape(b, n, A_GROUPS, A_GROUP_DIM), norm_g.reshape(A_GROUPS, A_GROUP_DIM))
    vv = vv.reshape(b, n // CHUNK, CHUNK, A_GROUPS, A_GROUP_DIM)
    s = jnp.einsum('gpq,bnqgc->bnpgc', ws, vv) + bs.T[None, None, :, :, None]
    return u * s.reshape(b, n, A_WIDTH)


def split_ab(z):
    b, n, _ = z.shape
    o1 = 2 * A_WIDTH
    o2 = o1 + B_WIDTH
    o3 = o2 + KV_WIDTH
    za = z[..., :o1]
    q = z[..., o1:o2].reshape(b, n, N_Q_HEADS, HEAD_DIM)
    k = z[..., o2:o3].reshape(b, n, N_KV_HEADS, HEAD_DIM)
    v = z[..., o3:].reshape(b, n, N_KV_HEADS, HEAD_DIM)
    return za, q, k, v


def mixer_ab(h, hc, cos, sin, w_in, gm_g, ws, bs, qg, kg, w_out, need_ctx):
    za, q, k, v = split_ab(h @ w_in)
    zac, qc, kc, vc = split_ab(hc @ w_in)
    q = apply_axial_rope(rmsnorm(q, qg), cos, sin)
    k = apply_axial_rope(rmsnorm(k, kg), cos, sin)
    kc = rmsnorm(kc, kg)
    k_all = jnp.concatenate([kc, k], axis=1)
    v_all = jnp.concatenate([vc, v], axis=1)
    y = jnp.concatenate([chunk_gmlp(za, gm_g, ws, bs), block_attention(q, k_all, v_all)], axis=-1) @ w_out
    if not need_ctx:
        return y, None
    qc = rmsnorm(qc, qg)
    yc = jnp.concatenate([chunk_gmlp(zac, gm_g, ws, bs), block_attention(qc, kc, vc)], axis=-1) @ w_out
    return y, yc


def centred_dwconv(x, w, b):
    y = lax.conv_general_dilated(
        x, w[:, None, :], window_strides=(1,),
        padding=[(CONV_W // 2, CONV_W - 1 - CONV_W // 2)],
        dimension_numbers=('NWC', 'WIO', 'NWC'),
        feature_group_count=x.shape[-1])
    return y + b


def linear_combine(e1, e2):
    a1, b1 = e1
    a2, b2 = e2
    return a1 * a2, a2 * b1 + b2


def rglru_coeffs(xr, wa, ba, wx, bx, lam):
    b, n, _ = xr.shape
    xb = xr.reshape(b, n, N_RNN_BLOCKS, RNN_BLOCK)
    r = jax.nn.sigmoid(jnp.einsum('bnhi,hij->bnhj', xb, wa).reshape(b, n, D_RNN) + ba)
    i = jax.nn.sigmoid(jnp.einsum('bnhi,hij->bnhj', xb, wx).reshape(b, n, D_RNN) + bx)
    log_a = -RG_C * r.astype(jnp.float32) * jax.nn.softplus(-lam.astype(jnp.float32))
    u = jnp.sqrt(-jnp.expm1(2.0 * log_a)) * (i * xr).astype(jnp.float32)
    return jnp.exp(log_a), u


def mixer_rglru(h, hc, w_in, conv_w, conv_b, wa, ba, wx, bx, lam, w_out, need_ctx):
    z = h @ w_in
    zc = hc @ w_in
    gate, xr = z[..., :D_RNN], z[..., D_RNN:]
    gate_c, xr_c = zc[..., :D_RNN], zc[..., D_RNN:]
    xr = centred_dwconv(xr, conv_w, conv_b)
    xr_c = centred_dwconv(xr_c, conv_w, conv_b)
    lat_states = []
    ctx_states = []
    for d in range(2):
        rev = d == 1
        ac, uc = rglru_coeffs(xr_c, wa[d], ba[d], wx[d], bx[d], lam[d])
        _, hc_seq = lax.associative_scan(linear_combine, (ac, uc), reverse=rev, axis=1)
        h_end = hc_seq[:, 0] if rev else hc_seq[:, -1]
        al, ul = rglru_coeffs(xr, wa[d], ba[d], wx[d], bx[d], lam[d])
        a_pre, h_seq = lax.associative_scan(linear_combine, (al, ul), reverse=rev, axis=1)
        lat_states.append(h_seq + a_pre * h_end[:, None, :])
        ctx_states.append(hc_seq)
    y_rec = (lat_states[0] + lat_states[1]).astype(h.dtype)
    y = (jax.nn.gelu(gate) * y_rec) @ w_out
    if not need_ctx:
        return y, None
    yc_rec = (ctx_states[0] + ctx_states[1]).astype(hc.dtype)
    yc = (jax.nn.gelu(gate_c) * yc_rec) @ w_out
    return y, yc


def peer_ffn(h, wq, keys, u_tab, v_tab):
    b, n, d = h.shape
    t = h.reshape(-1, TOKEN_BLOCK, d)

    def one_block(tb):
        q = (tb @ wq).reshape(TOKEN_BLOCK, PEER_HEADS, 2, D_KEY // 2)
        s = jnp.einsum('thsd,hskd->thsk', q, keys)
        v_half, i_half = lax.top_k(s, PEER_TOPK)
        cand = v_half[:, :, 0, :, None] + v_half[:, :, 1, None, :]
        cand_idx = i_half[:, :, 0, :, None] * N_KEYS + i_half[:, :, 1, None, :]
        top_s, pos = lax.top_k(cand.reshape(TOKEN_BLOCK, PEER_HEADS, PEER_TOPK * PEER_TOPK), PEER_TOPK)
        eidx = jnp.take_along_axis(cand_idx.reshape(TOKEN_BLOCK, PEER_HEADS, PEER_TOPK * PEER_TOPK), pos, axis=-1)
        gate = jax.nn.softmax(top_s.astype(jnp.float32), axis=-1).astype(tb.dtype)
        eidx = eidx.reshape(TOKEN_BLOCK, PEER_HEADS * PEER_TOPK)
        gate = gate.reshape(TOKEN_BLOCK, PEER_HEADS * PEER_TOPK)
        ue = jnp.take(u_tab, eidx, axis=0)
        ve = jnp.take(v_tab, eidx, axis=0)
        act = jax.nn.gelu(jnp.einsum('td,ted->te', tb, ue)) * gate
        return jnp.einsum('te,ted->td', act, ve)

    return lax.map(one_block, t).reshape(b, n, d)


def setup_inputs(seed: int = 0) -> dict:
    key = jax.random.key(seed)
    ks = jax.random.split(key, 32)
    D = D_MODEL

    def nrm(k, shape, scale):
        return jax.random.normal(k, shape, jnp.float32) * scale

    def gain(k, shape):
        return 1.0 + nrm(k, shape, 0.05)

    a0 = jax.random.uniform(ks[22], (N_ODD, 2, D_RNN), jnp.float32, minval=0.9, maxval=0.999)
    a_base = a0 ** (1.0 / RG_C)
    rg_lambda = jnp.log(a_base) - jnp.log1p(-a_base)
    return {
        'x': nrm(ks[0], (BATCH, SEQ, D), 1.0),
        'c': nrm(ks[1], (BATCH, D), 1.0),
        'ctx': nrm(ks[2], (BATCH, CTX_LEN, D), 1.0),
        'c_ctx': nrm(ks[3], (D,), 1.0),
        'mod_w': nrm(ks[4], (DEPTH, D, N_MOD * D), 0.5 * D ** -0.5),
        'mod_b': nrm(ks[5], (DEPTH, N_MOD * D), 0.02),
        'norm1_g': gain(ks[6], (DEPTH, D)),
        'norm2_g': gain(ks[7], (DEPTH, D)),
        'ab_w_in': nrm(ks[8], (N_EVEN, D, AB_IN), D ** -0.5),
        'gmlp_norm_g': gain(ks[9], (N_EVEN, A_WIDTH)),
        'gmlp_ws': nrm(ks[10], (N_EVEN, A_GROUPS, CHUNK, CHUNK), CHUNK ** -0.5),
        'gmlp_bs': gain(ks[11], (N_EVEN, A_GROUPS, CHUNK)),
        'q_norm_g': gain(ks[12], (N_EVEN, HEAD_DIM)),
        'k_norm_g': gain(ks[13], (N_EVEN, HEAD_DIM)),
        'ab_w_out': nrm(ks[14], (N_EVEN, AB_OUT, D), AB_OUT ** -0.5),
        'rg_w_in': nrm(ks[15], (N_ODD, D, 2 * D_RNN), D ** -0.5),
        'rg_conv_w': nrm(ks[16], (N_ODD, CONV_W, D_RNN), CONV_W ** -0.5),
        'rg_conv_b': nrm(ks[17], (N_ODD, D_RNN), 0.02),
        'rg_wa': nrm(ks[18], (N_ODD, 2, N_RNN_BLOCKS, RNN_BLOCK, RNN_BLOCK), RNN_BLOCK ** -0.5),
        'rg_ba': nrm(ks[19], (N_ODD, 2, D_RNN), 0.02),
        'rg_wx': nrm(ks[20], (N_ODD, 2, N_RNN_BLOCKS, RNN_BLOCK, RNN_BLOCK), RNN_BLOCK ** -0.5),
        'rg_bx': nrm(ks[21], (N_ODD, 2, D_RNN), 0.02),
        'rg_lambda': rg_lambda,
        'rg_w_out': nrm(ks[23], (N_ODD, D_RNN, D), D_RNN ** -0.5),
        'peer_wq': nrm(ks[24], (DEPTH, D, PEER_HEADS * D_KEY), D ** -0.5),
        'peer_keys': nrm(ks[25], (DEPTH, PEER_HEADS, 2, N_KEYS, D_KEY // 2), (D_KEY // 2) ** -0.5),
        'peer_u': nrm(ks[26], (DEPTH, N_EXPERTS, D), D ** -0.5),
        'peer_v': nrm(ks[27], (DEPTH, N_EXPERTS, D), 1.0),
        'final_norm_g': gain(ks[28], (D,)),
    }


def reference(x, c, ctx, c_ctx, mod_w, mod_b, norm1_g, norm2_g, ab_w_in, gmlp_norm_g, gmlp_ws, gmlp_bs,
              q_norm_g, k_norm_g, ab_w_out, rg_w_in, rg_conv_w, rg_conv_b, rg_wa, rg_ba, rg_wx, rg_bx,
              rg_lambda, rg_w_out, peer_wq, peer_keys, peer_u, peer_v, final_norm_g):
    n = x.shape[1]
    rows = n // GRID_W
    cos, sin = axial_rope_tables(rows)
    silu_c = jax.nn.silu(c)
    silu_cc = jax.nn.silu(c_ctx)
    for layer in range(DEPTH):
        last = layer == DEPTH - 1
        j = layer // 2
        mod = (silu_c @ mod_w[layer] + mod_b[layer])[:, None, :]
        modc = silu_cc @ mod_w[layer] + mod_b[layer]
        sh1, sc1, g1, sh2, sc2, g2 = jnp.split(mod, N_MOD, axis=-1)
        sh1c, sc1c, g1c, sh2c, sc2c, g2c = jnp.split(modc, N_MOD, axis=-1)
        h = modulate(rmsnorm(x, norm1_g[layer]), sh1, sc1)
        hc = modulate(rmsnorm(ctx, norm1_g[layer]), sh1c, sc1c)
        if layer % 2 == 0:
            y, yc = mixer_ab(h, hc, cos, sin, ab_w_in[j], gmlp_norm_g[j], gmlp_ws[j], gmlp_bs[j],
                             q_norm_g[j], k_norm_g[j], ab_w_out[j], not last)
        else:
            y, yc = mixer_rglru(h, hc, rg_w_in[j], rg_conv_w[j], rg_conv_b[j], rg_wa[j], rg_ba[j],
                                rg_wx[j], rg_bx[j], rg_lambda[j], rg_w_out[j], not last)
        x = x + g1 * y
        x = x + g2 * peer_ffn(modulate(rmsnorm(x, norm2_g[layer]), sh2, sc2),
                              peer_wq[layer], peer_keys[layer], peer_u[layer], peer_v[layer])
        if not last:
            ctx = ctx + g1c * yc
            ctx = ctx + g2c * peer_ffn(modulate(rmsnorm(ctx, norm2_g[layer]), sh2c, sc2c),
                                       peer_wq[layer], peer_keys[layer], peer_u[layer], peer_v[layer])
    return rmsnorm(x, final_norm_g)
```

```cpp
#include <hip/hip_runtime.h>
#include <cstdio>
#include <cstdint>

#ifndef MK_SINGLE
#define MK_SINGLE 0
#endif

#define GAS __attribute__((address_space(1)))
#define LAS __attribute__((address_space(3)))

typedef unsigned short bf16_t;
typedef short bf16x8 __attribute__((ext_vector_type(8)));
typedef float f32x4 __attribute__((ext_vector_type(4)));
typedef float f32x16 __attribute__((ext_vector_type(16)));
typedef unsigned u32x4 __attribute__((ext_vector_type(4)));
typedef unsigned u32x2 __attribute__((ext_vector_type(2)));

constexpr int D = 1024, NB = 2, SEQ = 8192, CTXL = 256;
constexpr int RPB = SEQ + CTXL;
constexpr int MTOT = NB * RPB;
constexpr int AB_IN = 2048, A_W = 512, DRNN = 1280, NEXP = 16384;
constexpr float EPS = 1e-6f;
constexpr int NTHR = 512, NWAVE = 8;

constexpr size_t MiB = 1u << 20;
constexpr size_t WS_CTL = 0, CTL_BYTES = 1 * MiB;
constexpr size_t WS_MODV = 1 * MiB;
constexpr size_t WS_ROPE = 1 * MiB + 512 * 1024;
constexpr size_t WS_WIN0 = 2 * MiB;
constexpr size_t WS_WOUT0 = 6 * MiB;
constexpr size_t WS_WIN1 = 8 * MiB;
constexpr size_t WS_WOUT1 = 13 * MiB;
constexpr size_t WS_WQ = 16 * MiB;
constexpr size_t WS_KEYS = 24 * MiB;
constexpr size_t WS_GWS = 25 * MiB;
constexpr size_t WS_WAT = 26 * MiB;
constexpr size_t WS_WXT = 27 * MiB;
constexpr size_t WS_CARRY = 28 * MiB;
constexpr size_t WS_PU = 32 * MiB;
constexpr size_t WS_PV = 96 * MiB;
constexpr size_t WS_H = 160 * MiB;
constexpr size_t WS_X1 = 193 * MiB;
constexpr size_t WS_SELI = 259 * MiB;
constexpr size_t WS_SELG = 268 * MiB;
constexpr size_t WS_R = 277 * MiB;
constexpr size_t WS_U = WS_R;
constexpr size_t WS_VV = WS_R + 17 * MiB;
constexpr size_t WS_Q = WS_R + 34 * MiB;
constexpr size_t WS_K = WS_R + 51 * MiB;
constexpr size_t WS_V = WS_R + 60 * MiB;
constexpr size_t WS_AO = WS_R + 69 * MiB;
constexpr size_t WS_QP = WS_R;
constexpr size_t WS_GG = WS_R;
constexpr size_t WS_XR = WS_R + 42 * MiB;
constexpr size_t WS_YG = WS_R + 84 * MiB;
constexpr size_t WS_END = WS_R + 126 * MiB;

constexpr int LDS_BYTES = 147456;
constexpr int LDS_MISC = 145408;

__device__ __forceinline__ float bf2f(bf16_t v) { return __uint_as_float(((unsigned)v) << 16); }
__device__ __forceinline__ unsigned f2bf(float f) { unsigned u = __float_as_uint(f); return (u + 0x7fffu + ((u >> 16) & 1u)) >> 16; }
__device__ __forceinline__ unsigned pk2(float lo, float hi) { return f2bf(lo) | (f2bf(hi) << 16); }
__device__ __forceinline__ float bflo(unsigned w) { return __uint_as_float(w << 16); }
__device__ __forceinline__ float bfhi(unsigned w) { return __uint_as_float(w & 0xffff0000u); }
__device__ __forceinline__ float gelu_t(float x) { const float y = 1.5957691216057308f * (x + 0.044715f * x * x * x); return x / (1.f + __expf(-y)); }
__device__ __forceinline__ float sigmoidf_(float x) { return 1.f / (1.f + __expf(-x)); }
__device__ __forceinline__ float wave_sum(float v) {
#pragma unroll
    for (int o = 1; o < 64; o <<= 1) v += __shfl_xor(v, o);
    return v;
}
__host__ __device__ __forceinline__ int sigma_head(int j) { const int grp = j >> 3, n = (j >> 2) & 1, e = j & 3; return (grp >> 3) * 64 + n * 32 + (grp & 7) * 4 + e; }

struct Args {
    const float* in[29];
    float* out;
    unsigned char* ws;
    int ph_lo, ph_hi;
};

__device__ __forceinline__ int row_variant(int g) { const int b = g / RPB, i = g - b * RPB; return i < CTXL ? 2 : b; }
__device__ __forceinline__ const float* row_src(const Args& a, int g) {
    const int b = g / RPB, i = g - b * RPB;
    return i < CTXL ? a.in[2] + ((size_t)b * CTXL + i) * D : a.in[0] + ((size_t)b * SEQ + (i - CTXL)) * D;
}
__device__ __forceinline__ const float* modv(const Args& a, int layer, int variant, int which) {
    return (const float*)(a.ws + WS_MODV) + ((size_t)(layer * 3 + variant) * 6 + which) * D;
}

#define XB_TMO      128
#define XB_XCNT(j)  (256  + 64 * (j))
#define XB_XSUB(j)  (1280 + 64 * (j))
#define XB_XGEN(j)  (2304 + 64 * (j))
#define XB_TOP      3328
#define XB_TOPGEN   3392
#define XCD_BAR_WORDS 3456
#define XB_SPIN_CAP (1u << 22)
__device__ __forceinline__ unsigned xb_ld(unsigned* p)              { return __hip_atomic_load(p, __ATOMIC_RELAXED, __HIP_MEMORY_SCOPE_AGENT); }
__device__ __forceinline__ unsigned xb_add(unsigned* p, unsigned v) { return __hip_atomic_fetch_add(p, v, __ATOMIC_RELAXED, __HIP_MEMORY_SCOPE_AGENT); }
__device__ __forceinline__ unsigned xb_xcc_id() { return (unsigned)__builtin_amdgcn_s_getreg((3 << 11) | 20) & 0xFu; }
#define XB_SPIN(cond, bar) do { unsigned _sp = 0; while (cond) { __builtin_amdgcn_s_sleep(1); \
    if ((++_sp & 255u) == 0u) { if (xb_ld(&(bar)[XB_TMO])) break; if (_sp > XB_SPIN_CAP) { atomicAdd(&(bar)[XB_TMO], 1u); break; } } } } while (0)
struct XcdBarrier { unsigned* bar; unsigned x; volatile LAS unsigned* st; };
__device__ __forceinline__ XcdBarrier xcd_barrier_post(unsigned* bar, volatile LAS unsigned* st) {
    XcdBarrier b; b.bar = bar; b.x = xb_xcc_id(); b.st = st;
    if (threadIdx.x == 0) (void)xb_add(&bar[XB_XCNT(b.x)], 1u);
    return b;
}
__device__ __forceinline__ void xcd_barrier_complete(unsigned* bar, unsigned x, unsigned& nloc, unsigned& nx) {
    const unsigned G = gridDim.x * gridDim.y * gridDim.z;
    unsigned sum, cnt, mine, sp = 0u;
    for (;;) {
        sum = 0u; cnt = 0u; mine = 0u;
#pragma unroll
        for (unsigned j = 0; j < 16; ++j) { const unsigned c = xb_ld(&bar[XB_XCNT(j)]); sum += c; cnt += (c > 0u) ? 1u : 0u; mine = (j == x) ? c : mine; }
        if (sum == G) break;
        __builtin_amdgcn_s_sleep(1);
        if ((++sp & 255u) == 0u) { if (xb_ld(&bar[XB_TMO])) break; if (sp > XB_SPIN_CAP) { atomicAdd(&bar[XB_TMO], 1u); break; } }
    }
    nloc = mine > 0u ? mine : 1u; nx = cnt > 0u ? cnt : 1u;
}
__device__ __forceinline__ void xcd_barrier(const XcdBarrier& b) {
    asm volatile("s_waitcnt vmcnt(0)" ::: "memory");
    __syncthreads();
    if (threadIdx.x == 0) {
        unsigned* bar = b.bar;
        __builtin_amdgcn_s_waitcnt(0);
        unsigned nloc = b.st[0], nx = b.st[1];
        if (nloc == 0u) { xcd_barrier_complete(bar, b.x, nloc, nx); b.st[0] = nloc; b.st[1] = nx; }
        const unsigned old = xb_add(&bar[XB_XSUB(b.x)], 1u);
        const unsigned gen = old / nloc;
        if (old + 1u == (gen + 1u) * nloc) {
            __builtin_amdgcn_fence(__ATOMIC_RELEASE, "agent");
            asm volatile("s_waitcnt vmcnt(0)" ::: "memory");
            const unsigned og = xb_add(&bar[XB_TOP], 1u);
            const unsigned tg = og / nx;
            if (og + 1u == (tg + 1u) * nx) xb_add(&bar[XB_TOPGEN], 1u);
            else XB_SPIN(xb_ld(&bar[XB_TOPGEN]) == tg, bar);
            __builtin_amdgcn_fence(__ATOMIC_ACQUIRE, "agent");
            xb_add(&bar[XB_XGEN(b.x)], 1u);
            asm volatile("s_waitcnt vmcnt(0)" ::: "memory");
        } else {
            XB_SPIN(xb_ld(&bar[XB_XGEN(b.x)]) == gen, bar);
            __builtin_amdgcn_fence(__ATOMIC_ACQUIRE, "agent");
            asm volatile("s_waitcnt vmcnt(0)" ::: "memory");
        }
    }
    __syncthreads();
}

__device__ __forceinline__ void transpose_item(const float* src, int Ns, bf16_t* dst, int Kd, int n0, int k0, int perm_lo, int perm_hi, float* tile) {
    const int tid = threadIdx.x;
    {
        const int nn = tid & 63; int n = n0 + nn;
        if (n >= perm_lo && n < perm_hi) { const int rel = n - perm_lo; n = perm_lo + (rel & ~127) + sigma_head(rel & 127); }
#pragma unroll
        for (int i = 0; i < 8; ++i) { const int kk = (tid >> 6) + 8 * i; tile[kk * 65 + nn] = src[(size_t)(k0 + kk) * Ns + n]; }
    }
    __syncthreads();
    {
        const int n = tid >> 3, kc = (tid & 7) * 8;
        u32x4 o;
        o.x = pk2(tile[(kc + 0) * 65 + n], tile[(kc + 1) * 65 + n]); o.y = pk2(tile[(kc + 2) * 65 + n], tile[(kc + 3) * 65 + n]);
        o.z = pk2(tile[(kc + 4) * 65 + n], tile[(kc + 5) * 65 + n]); o.w = pk2(tile[(kc + 6) * 65 + n], tile[(kc + 7) * 65 + n]);
        *(u32x4*)(dst + (size_t)(n0 + n) * Kd + k0 + kc) = o;
    }
    __syncthreads();
}
__device__ __forceinline__ void cvt_stream(const float* src, bf16_t* dst, size_t n8, size_t gtid, size_t gthreads) {
    for (size_t i = gtid; i < n8; i += gthreads) {
        const f32x4 a = *(const f32x4*)(src + i * 8), b = *(const f32x4*)(src + i * 8 + 4);
        u32x4 o; o.x = pk2(a.x, a.y); o.y = pk2(a.z, a.w); o.z = pk2(b.x, b.y); o.w = pk2(b.z, b.w);
        *(u32x4*)(dst + i * 8) = o;
    }
}
__device__ void phase_prep(const Args& a, char* lds) {
    const int tid = threadIdx.x, lane = tid & 63, wid = tid >> 6;
    float* tile = (float*)lds;
    unsigned char* ws = a.ws;
    constexpr int I_MOD = 192;
    constexpr int I_WIN0 = (1024 / 64) * (2048 / 64), I_WOUT0 = (1024 / 64) * (1024 / 64), I_WIN1 = (1024 / 64) * (2560 / 64), I_WOUT1 = (1280 / 64) * (1024 / 64);
    constexpr int I_WQ = 2 * (1024 / 64) * (2048 / 64), I_WAX = 40 * 4;
    constexpr int NIT = I_MOD + I_WIN0 + I_WOUT0 + I_WIN1 + I_WOUT1 + I_WQ + I_WAX;
    for (int it = blockIdx.x; it < NIT; it += gridDim.x) {
        int r = it;
        if (r < I_MOD) {
            const int l = r / 96, n0 = (r % 96) * 64;
            const float* W = a.in[4] + (size_t)l * D * 6144;
            float s0 = 0.f, s1 = 0.f, s2 = 0.f;
            for (int k = wid * 128; k < wid * 128 + 128; ++k) {
                const float w = W[(size_t)k * 6144 + n0 + lane];
                const float c0 = a.in[1][k], c1 = a.in[1][D + k], c2 = a.in[3][k];
                s0 += c0 * sigmoidf_(c0) * w; s1 += c1 * sigmoidf_(c1) * w; s2 += c2 * sigmoidf_(c2) * w;
            }
            tile[(wid * 3 + 0) * 64 + lane] = s0; tile[(wid * 3 + 1) * 64 + lane] = s1; tile[(wid * 3 + 2) * 64 + lane] = s2;
            __syncthreads();
            if (tid < 192) {
                const int v = tid / 64, ln = tid & 63; float s = a.in[5][(size_t)l * 6144 + n0 + ln];
                for (int w = 0; w < 8; ++w) s += tile[(w * 3 + v) * 64 + ln];
                ((float*)(ws + WS_MODV))[(size_t)(l * 3 + v) * 6144 + n0 + ln] = s;
            }
            __syncthreads();
            continue;
        }
        r -= I_MOD;
        if (r < I_WIN0) { const int nb = r % 32, kb = r / 32; transpose_item(a.in[8], 2048, (bf16_t*)(ws + WS_WIN0), 1024, nb * 64, kb * 64, 1024, 1792, tile); continue; }
        r -= I_WIN0;
        if (r < I_WOUT0) { const int nb = r % 16, kb = r / 16; transpose_item(a.in[14], 1024, (bf16_t*)(ws + WS_WOUT0), 1024, nb * 64, kb * 64, 0, 0, tile); continue; }
        r -= I_WOUT0;
        if (r < I_WIN1) { const int nb = r % 40, kb = r / 40; transpose_item(a.in[15], 2560, (bf16_t*)(ws + WS_WIN1), 1024, nb * 64, kb * 64, 0, 0, tile); continue; }
        r -= I_WIN1;
        if (r < I_WOUT1) { const int nb = r % 16, kb = r / 16; transpose_item(a.in[23], 1024, (bf16_t*)(ws + WS_WOUT1), 1280, nb * 64, kb * 64, 0, 0, tile); continue; }
        r -= I_WOUT1;
        if (r < I_WQ) { const int l = r / 512, q = r % 512, nb = q % 32, kb = q / 32;
            transpose_item(a.in[24] + (size_t)l * 1024 * 2048, 2048, (bf16_t*)(ws + WS_WQ) + (size_t)l * 2048 * 1024, 1024, nb * 64, kb * 64, 0, 0, tile); continue; }
        r -= I_WQ;
        { const int m = r / 4, q = r % 4, nb = q % 2, kb = q / 2;
            const int which = m / 20, dh = m % 20;
            const float* src = a.in[which == 0 ? 18 : 20] + (size_t)dh * 128 * 128;
            bf16_t* dst = (bf16_t*)(ws + (which == 0 ? WS_WAT : WS_WXT)) + (size_t)dh * 128 * 128;
            transpose_item(src, 128, dst, 128, nb * 64, kb * 64, 0, 0, tile);
        }
    }
    const size_t gtid = (size_t)blockIdx.x * NTHR + tid, gthreads = (size_t)gridDim.x * NTHR;
    cvt_stream(a.in[25], (bf16_t*)(ws + WS_KEYS), (size_t)2 * 8 * 2 * 128 * 128 / 8, gtid, gthreads);
    cvt_stream(a.in[10], (bf16_t*)(ws + WS_GWS), (size_t)4 * 128 * 128 / 8, gtid, gthreads);
    cvt_stream(a.in[26], (bf16_t*)(ws + WS_PU), (size_t)2 * NEXP * D / 8, gtid, gthreads);
    cvt_stream(a.in[27], (bf16_t*)(ws + WS_PV), (size_t)2 * NEXP * D / 8, gtid, gthreads);
    for (size_t i = gtid; i < 128 * 32; i += gthreads) {
        const int pos = (int)(i / 32), f = (int)(i % 32);
        const float inv = powf(10000.f, -(float)f / 32.f); const float ang = (float)pos * inv;
        float* R = (float*)(ws + WS_ROPE); R[i * 2] = cosf(ang); R[i * 2 + 1] = sinf(ang);
    }
}

__device__ __forceinline__ void norm_row_store(const f32x4 (&v)[4], const float* g, const float* sh, const float* sc, bf16_t* orow, int lane) {
    float s = 0.f;
#pragma unroll
    for (int j = 0; j < 4; ++j) s += (v[j].x * v[j].x + v[j].y * v[j].y) + (v[j].z * v[j].z + v[j].w * v[j].w);
    const float rinv = rsqrtf(wave_sum(s) * (1.f / D) + EPS);
#pragma unroll
    for (int j = 0; j < 4; ++j) {
        const int c = j * 256 + lane * 4;
        const f32x4 gg = *(const f32x4*)(g + c), s1 = *(const f32x4*)(sh + c), s2 = *(const f32x4*)(sc + c);
        const float o0 = v[j].x * rinv * gg.x * (1.f + s2.x) + s1.x, o1 = v[j].y * rinv * gg.y * (1.f + s2.y) + s1.y;
        const float o2 = v[j].z * rinv * gg.z * (1.f + s2.z) + s1.z, o3 = v[j].w * rinv * gg.w * (1.f + s2.w) + s1.w;
        u32x2 w; w.x = pk2(o0, o1); w.y = pk2(o2, o3);
        *(u32x2*)(orow + c) = w;
    }
}
__device__ void phase_norm(const Args& a, int layer, int src_mode, const float* gain, int which_sh, int which_sc, bool latent_only) {
    const int lane = threadIdx.x & 63, gw = blockIdx.x * NWAVE + (threadIdx.x >> 6), ngw = gridDim.x * NWAVE;
    bf16_t* H = (bf16_t*)(a.ws + WS_H);
    const float* X1 = (const float*)(a.ws + WS_X1);
    for (int g = gw; g < MTOT; g += ngw) {
        const int var = row_variant(g);
        if (latent_only && var == 2) continue;
        const float* xr = src_mode == 0 ? row_src(a, g) : X1 + (size_t)g * D;
        f32x4 v[4];
#pragma unroll
        for (int j = 0; j < 4; ++j) v[j] = *(const f32x4*)(xr + j * 256 + lane * 4);
        norm_row_store(v, gain, modv(a, layer, var, which_sh), modv(a, layer, var, which_sc), H + (size_t)g * D, lane);
    }
}

constexpr int CS_LD = 132;
__device__ __forceinline__ void gemm_tile128(const bf16_t* A, int lda, const bf16_t* Bt, int ldb, int K, float* Cs) {
    const int tid = threadIdx.x, lane = tid & 63, wid = tid >> 6, r = lane & 31, h = lane >> 5, wr = wid >> 1, wc = wid & 1;
    const bf16_t* ap = A + (size_t)(wr * 32 + r) * lda + 8 * h;
    const bf16_t* bp0 = Bt + (size_t)(wc * 64 + r) * ldb + 8 * h;
    const bf16_t* bp1 = bp0 + (size_t)32 * ldb;
    f32x16 acc0 = {}, acc1 = {};
#pragma unroll 4
    for (int k = 0; k < K; k += 16) {
        const bf16x8 av = *(const bf16x8*)(ap + k), b0 = *(const bf16x8*)(bp0 + k), b1 = *(const bf16x8*)(bp1 + k);
        acc0 = __builtin_amdgcn_mfma_f32_32x32x16_bf16(av, b0, acc0, 0, 0, 0);
        acc1 = __builtin_amdgcn_mfma_f32_32x32x16_bf16(av, b1, acc1, 0, 0, 0);
    }
#pragma unroll
    for (int i = 0; i < 16; ++i) {
        const int row = wr * 32 + (i & 3) + 8 * (i >> 2) + 4 * h;
        Cs[row * CS_LD + wc * 64 + r] = acc0[i];
        Cs[row * CS_LD + wc * 64 + 32 + r] = acc1[i];
    }
}

__device__ void phase_inproj0(const Args& a, char* lds) {
    float* Cs = (float*)lds;
    const int tid = threadIdx.x;
    unsigned char* ws = a.ws;
    const bf16_t* H = (const bf16_t*)(ws + WS_H); const bf16_t* W = (const bf16_t*)(ws + WS_WIN0);
    const float* rope = (const float*)(ws + WS_ROPE);
    const int NU = (MTOT / 128) * 16;
    for (int u = blockIdx.x; u < NU; u += gridDim.x) {
        const int rt = u / 16, ct = u % 16, row0 = rt * 128, col0 = ct * 128;
        gemm_tile128(H + (size_t)row0 * D, D, W + (size_t)col0 * D, D, D, Cs);
        __syncthreads();
        const int rr = tid >> 2, q4 = tid & 3, g = row0 + rr;
        float* crow = Cs + rr * CS_LD + q4 * 32;
        if (ct < 4) {
            bf16_t* o = (bf16_t*)(ws + WS_U) + (size_t)g * 512 + col0 + q4 * 32;
#pragma unroll
            for (int c = 0; c < 32; c += 2) *(unsigned*)(o + c) = pk2(gelu_t(crow[c]), gelu_t(crow[c + 1]));
        } else if (ct < 8) {
            const int gg = ct - 4; float ss = 0.f;
#pragma unroll
            for (int c = 0; c < 32; ++c) { const float v = gelu_t(crow[c]); crow[c] = v; ss += v * v; }
            ss += __shfl_xor(ss, 1); ss += __shfl_xor(ss, 2);
            const float rinv = rsqrtf(ss * (1.f / 128.f) + EPS);
            const float* gn = a.in[9] + gg * 128 + q4 * 32;
            bf16_t* o = (bf16_t*)(ws + WS_VV) + (size_t)g * 512 + gg * 128 + q4 * 32;
#pragma unroll
            for (int c = 0; c < 32; c += 2) *(unsigned*)(o + c) = pk2(crow[c] * rinv * gn[c], crow[c + 1] * rinv * gn[c + 1]);
        } else if (ct < 14) {
            const bool isq = ct < 12; const int hh = isq ? ct - 8 : ct - 12;
            float ss = 0.f;
#pragma unroll
            for (int c = 0; c < 32; ++c) ss += crow[c] * crow[c];
            ss += __shfl_xor(ss, 1); ss += __shfl_xor(ss, 2);
            const float rinv = rsqrtf(ss * (1.f / 128.f) + EPS);
            const float* gn = a.in[isq ? 12 : 13];
            const int b = g / RPB, i = g - b * RPB; const bool lat = i >= CTXL; const int t = i - CTXL;
            bf16_t* o = (isq ? (bf16_t*)(ws + WS_Q) + (size_t)g * 512 : (bf16_t*)(ws + WS_K) + (size_t)g * 256) + hh * 128 + q4 * 32;
#pragma unroll
            for (int c8 = 0; c8 < 32; c8 += 8) {
                float y[8];
#pragma unroll
                for (int e = 0; e < 8; ++e) { const int j = q4 * 32 + c8 + e; y[e] = crow[c8 + e] * rinv * gn[sigma_head(j)]; }
                if (lat) {
                    const int grp = (q4 * 32 + c8) >> 3, ax = grp >> 3; const int pos = ax == 0 ? (t >> 6) : (t & 63);
#pragma unroll
                    for (int e = 0; e < 4; ++e) { const int f = (grp & 7) * 4 + e; const float cs = rope[(pos * 32 + f) * 2], sn = rope[(pos * 32 + f) * 2 + 1];
                        const float x1 = y[e], x2 = y[e + 4]; y[e] = x1 * cs - x2 * sn; y[e + 4] = x2 * cs + x1 * sn; }
                }
                u32x4 w; w.x = pk2(y[0], y[1]); w.y = pk2(y[2], y[3]); w.z = pk2(y[4], y[5]); w.w = pk2(y[6], y[7]);
                *(u32x4*)(o + c8) = w;
            }
        } else {
            bf16_t* o = (bf16_t*)(ws + WS_V) + (size_t)g * 256 + (ct - 14) * 128 + q4 * 32;
#pragma unroll
            for (int c = 0; c < 32; c += 2) *(unsigned*)(o + c) = pk2(crow[c], crow[c + 1]);
        }
        __syncthreads();
    }
}

__device__ void phase_gmlp(const Args& a, char* lds) {
    const int tid = threadIdx.x;
    unsigned char* ws = a.ws;
    float* vt = (float*)lds;
    const bf16_t* VV = (const bf16_t*)(ws + WS_VV); const bf16_t* U = (const bf16_t*)(ws + WS_U); bf16_t* AO = (bf16_t*)(ws + WS_AO);
    const int NU = (MTOT / 128) * 4;
    for (int u = blockIdx.x; u < NU; u += gridDim.x) {
        const int ch = u / 4, g = u % 4, row0 = ch * 128;
        for (int i = tid; i < 128 * 128; i += NTHR) { const int q = i >> 7, c = i & 127; vt[i] = bf2f(VV[(size_t)(row0 + q) * 512 + g * 128 + c]); }
        __syncthreads();
        const int c = tid & 127, pq = tid >> 7;
        const float* wsg = a.in[10] + (size_t)g * 128 * 128;
        for (int pp = 0; pp < 32; ++pp) {
            const int p = pq * 32 + pp; float s = 0.f;
            for (int q = 0; q < 128; ++q) s += wsg[p * 128 + q] * vt[q * 128 + c];
            s += a.in[11][g * 128 + p];
            const float uu = bf2f(U[(size_t)(row0 + p) * 512 + g * 128 + c]);
            AO[(size_t)(row0 + p) * 1024 + g * 128 + c] = (bf16_t)f2bf(uu * s);
        }
        __syncthreads();
    }
}

__device__ void phase_attn_naive(const Args& a, char* lds) {
    const int tid = threadIdx.x;
    unsigned char* ws = a.ws;
    float* Ks = (float*)lds;
    float* Vs = Ks + 32 * 128;
    float* part = Vs + 32 * 128;
    const bf16_t* Q = (const bf16_t*)(ws + WS_Q); const bf16_t* Kb = (const bf16_t*)(ws + WS_K); const bf16_t* Vb = (const bf16_t*)(ws + WS_V);
    bf16_t* AO = (bf16_t*)(ws + WS_AO);
    const int NU = 512 + 16;
    for (int u = blockIdx.x; u < NU; u += gridDim.x) {
        int b, h, qrow0, nkeys;
        if (u < 512) { b = u / 256; h = (u / 64) % 4; qrow0 = b * RPB + CTXL + (u % 64) * 128; nkeys = RPB; }
        else { const int v = u - 512; b = v / 8; h = (v / 2) % 4; qrow0 = b * RPB + (v % 2) * 128; nkeys = CTXL; }
        const int kvh = h >> 1, krow0 = b * RPB;
        const int qi = tid & 127, qt = tid >> 7;
        float q[32], o[32];
        {
            const bf16_t* qp = Q + (size_t)(qrow0 + qi) * 512 + h * 128 + qt * 32;
#pragma unroll
            for (int d = 0; d < 32; d += 2) { const unsigned w = *(const unsigned*)(qp + d); q[d] = bflo(w) * 0.08838834764831845f; q[d + 1] = bfhi(w) * 0.08838834764831845f; }
#pragma unroll
            for (int d = 0; d < 32; ++d) o[d] = 0.f;
        }
        float m = -1e30f, l = 0.f;
        for (int k0 = 0; k0 < nkeys; k0 += 32) {
            {
                const int key = tid >> 4, cs = (tid & 15) * 8;
                const u32x4 kw = *(const u32x4*)(Kb + (size_t)(krow0 + k0 + key) * 256 + kvh * 128 + cs);
                const u32x4 vw = *(const u32x4*)(Vb + (size_t)(krow0 + k0 + key) * 256 + kvh * 128 + cs);
                float* kd = Ks + key * 128 + cs; float* vd = Vs + key * 128 + cs;
                kd[0] = bflo(kw.x); kd[1] = bfhi(kw.x); kd[2] = bflo(kw.y); kd[3] = bfhi(kw.y); kd[4] = bflo(kw.z); kd[5] = bfhi(kw.z); kd[6] = bflo(kw.w); kd[7] = bfhi(kw.w);
                vd[0] = bflo(vw.x); vd[1] = bfhi(vw.x); vd[2] = bflo(vw.y); vd[3] = bfhi(vw.y); vd[4] = bflo(vw.z); vd[5] = bfhi(vw.z); vd[6] = bflo(vw.w); vd[7] = bfhi(vw.w);
            }
            __syncthreads();
#pragma unroll 2
            for (int j = 0; j < 32; ++j) {
                const float* kr = Ks + j * 128 + qt * 32; float acc = 0.f;
#pragma unroll
                for (int d = 0; d < 32; d += 4) { const f32x4 kv = *(const f32x4*)(kr + d); acc += q[d] * kv.x + q[d + 1] * kv.y + q[d + 2] * kv.z + q[d + 3] * kv.w; }
                part[(qt * 32 + j) * 128 + qi] = acc;
            }
            __syncthreads();
            float mx = m;
#pragma unroll 4
            for (int j = 0; j < 32; ++j) { const float sj = (part[(0 * 32 + j) * 128 + qi] + part[(1 * 32 + j) * 128 + qi]) + (part[(2 * 32 + j) * 128 + qi] + part[(3 * 32 + j) * 128 + qi]); mx = fmaxf(mx, sj); }
            const float alpha = __expf(m - mx); m = mx; float ps = 0.f;
#pragma unroll
            for (int d = 0; d < 32; ++d) o[d] *= alpha;
#pragma unroll 2
            for (int j = 0; j < 32; ++j) {
                const float sj = (part[(0 * 32 + j) * 128 + qi] + part[(1 * 32 + j) * 128 + qi]) + (part[(2 * 32 + j) * 128 + qi] + part[(3 * 32 + j) * 128 + qi]);
                const float pj = __expf(sj - mx); ps += pj;
                const float* vr = Vs + j * 128 + qt * 32;
#pragma unroll
                for (int d = 0; d < 32; d += 4) { const f32x4 vv = *(const f32x4*)(vr + d); o[d] += pj * vv.x; o[d + 1] += pj * vv.y; o[d + 2] += pj * vv.z; o[d + 3] += pj * vv.w; }
            }
            l = l * alpha + ps;
            __syncthreads();
        }
        const float rl = 1.f / l;
        bf16_t* op = AO + (size_t)(qrow0 + qi) * 1024 + 512 + h * 128 + qt * 32;
#pragma unroll
        for (int d = 0; d < 32; d += 2) *(unsigned*)(op + d) = pk2(o[d] * rl, o[d + 1] * rl);
    }
}

__device__ void phase_outproj(const Args& a, char* lds, const bf16_t* A, int K, const bf16_t* Bt, int layer, int which_gate, int base_mode, bool latent_only) {
    float* Cs = (float*)lds;
    const int tid = threadIdx.x;
    float* X1 = (float*)(a.ws + WS_X1);
    const int NU = (MTOT / 128) * 8;
    for (int u = blockIdx.x; u < NU; u += gridDim.x) {
        const int rt = u / 8, ct = u % 8, row0 = rt * 128, col0 = ct * 128;
        if (latent_only && (rt % 66) < 2) continue;
        gemm_tile128(A + (size_t)row0 * K, K, Bt + (size_t)col0 * K, K, K, Cs);
        __syncthreads();
        const int rr = tid >> 2, q4 = tid & 3, g = row0 + rr;
        const float* crow = Cs + rr * CS_LD + q4 * 32;
        const float* gt = modv(a, layer, row_variant(g), which_gate) + col0 + q4 * 32;
        const float* base = (base_mode == 0 ? row_src(a, g) : X1 + (size_t)g * D) + col0 + q4 * 32;
        float* o = X1 + (size_t)g * D + col0 + q4 * 32;
#pragma unroll
        for (int c = 0; c < 32; c += 4) {
            const f32x4 bs = *(const f32x4*)(base + c), gv = *(const f32x4*)(gt + c);
            f32x4 r; r.x = bs.x + gv.x * crow[c]; r.y = bs.y + gv.y * crow[c + 1]; r.z = bs.z + gv.z * crow[c + 2]; r.w = bs.w + gv.w * crow[c + 3];
            *(f32x4*)(o + c) = r;
        }
        __syncthreads();
    }
}

__device__ void phase_peerq(const Args& a, char* lds, int layer, bool latent_only) {
    float* Cs = (float*)lds;
    const int tid = threadIdx.x;
    const bf16_t* H = (const bf16_t*)(a.ws + WS_H); const bf16_t* W = (const bf16_t*)(a.ws + WS_WQ) + (size_t)layer * 2048 * 1024;
    bf16_t* QP = (bf16_t*)(a.ws + WS_QP);
    const int NU = (MTOT / 128) * 16;
    for (int u = blockIdx.x; u < NU; u += gridDim.x) {
        const int rt = u / 16, ct = u % 16, row0 = rt * 128, col0 = ct * 128;
        if (latent_only && (rt % 66) < 2) continue;
        gemm_tile128(H + (size_t)row0 * D, D, W + (size_t)col0 * D, D, D, Cs);
        __syncthreads();
        const int rr = tid >> 2, q4 = tid & 3, g = row0 + rr;
        const float* crow = Cs + rr * CS_LD + q4 * 32;
        bf16_t* o = QP + (size_t)g * 2048 + col0 + q4 * 32;
#pragma unroll
        for (int c = 0; c < 32; c += 2) *(unsigned*)(o + c) = pk2(crow[c], crow[c + 1]);
        __syncthreads();
    }
}

__device__ __forceinline__ void wave_argmax(float& v, int& i) {
#pragma unroll
    for (int o = 1; o < 64; o <<= 1) {
        const float ov = __shfl_xor(v, o); const int oi = __shfl_xor(i, o);
        if (ov > v || (ov == v && oi < i)) { v = ov; i = oi; }
    }
}
__device__ void phase_peer_topk(const Args& a, int layer, bool latent_only) {
    const int lane = threadIdx.x & 63, gw = blockIdx.x * NWAVE + (threadIdx.x >> 6), ngw = gridDim.x * NWAVE;
    const bf16_t* QP = (const bf16_t*)(a.ws + WS_QP);
    const bf16_t* KEYS = (const bf16_t*)(a.ws + WS_KEYS) + (size_t)layer * 8 * 2 * 128 * 128;
    int* SELI = (int*)(a.ws + WS_SELI); float* SELG = (float*)(a.ws + WS_SELG);
    for (int it = gw; it < MTOT * 8; it += ngw) {
        const int g = it >> 3, h = it & 7;
        if (latent_only && row_variant(g) == 2) continue;
        float tv[2]; int ti[2];
#pragma unroll
        for (int s = 0; s < 2; ++s) {
            const bf16_t* qp = QP + (size_t)g * 2048 + h * 256 + s * 128;
            const bf16_t* k0p = KEYS + ((size_t)(h * 2 + s) * 128 + lane) * 128;
            const bf16_t* k1p = k0p + 64 * 128;
            float s0 = 0.f, s1 = 0.f;
#pragma unroll 4
            for (int d = 0; d < 128; d += 8) {
                const u32x4 qw = *(const u32x4*)(qp + d), ka = *(const u32x4*)(k0p + d), kb = *(const u32x4*)(k1p + d);
                s0 += bflo(qw.x) * bflo(ka.x) + bfhi(qw.x) * bfhi(ka.x) + bflo(qw.y) * bflo(ka.y) + bfhi(qw.y) * bfhi(ka.y)
                    + bflo(qw.z) * bflo(ka.z) + bfhi(qw.z) * bfhi(ka.z) + bflo(qw.w) * bflo(ka.w) + bfhi(qw.w) * bfhi(ka.w);
                s1 += bflo(qw.x) * bflo(kb.x) + bfhi(qw.x) * bfhi(kb.x) + bflo(qw.y) * bflo(kb.y) + bfhi(qw.y) * bfhi(kb.y)
                    + bflo(qw.z) * bflo(kb.z) + bfhi(qw.z) * bfhi(kb.z) + bflo(qw.w) * bflo(kb.w) + bfhi(qw.w) * bfhi(kb.w);
            }
            float myv = 0.f; int myi = 0;
            for (int r = 0; r < 16; ++r) {
                float bv; int bi;
                if (s0 >= s1) { bv = s0; bi = lane; } else { bv = s1; bi = lane + 64; }
                wave_argmax(bv, bi);
                if (bi == lane) s0 = -INFINITY; else if (bi == lane + 64) s1 = -INFINITY;
                if (lane == r) { myv = bv; myi = bi; }
            }
            tv[s] = myv; ti[s] = myi;
        }
        float cv[4]; int ci[4];
        {
            const float v0 = __shfl(tv[0], lane >> 2); const int i0 = __shfl(ti[0], lane >> 2);
#pragma unroll
            for (int m = 0; m < 4; ++m) { const int j = (lane & 3) * 4 + m; cv[m] = v0 + __shfl(tv[1], j); ci[m] = i0 * 128 + __shfl(ti[1], j); }
        }
        float topv = 0.f; int tope = 0;
        for (int r = 0; r < 16; ++r) {
            float bv = cv[0]; int bp = lane * 4;
#pragma unroll
            for (int m = 1; m < 4; ++m) if (cv[m] > bv) { bv = cv[m]; bp = lane * 4 + m; }
            wave_argmax(bv, bp);
            int be = 0;
#pragma unroll
            for (int m = 0; m < 4; ++m) if (bp == lane * 4 + m) { be = ci[m]; cv[m] = -INFINITY; }
            be = __shfl(be, bp >> 2);
            if (lane == r) { topv = bv; tope = be; }
        }
        const float mx = __shfl(topv, 0);
        float e = lane < 16 ? __expf(topv - mx) : 0.f;
        float sum = e;
#pragma unroll
        for (int o = 1; o < 16; o <<= 1) sum += __shfl_xor(sum, o);
        if (lane < 16) { SELI[(size_t)g * 128 + h * 16 + lane] = tope; SELG[(size_t)g * 128 + h * 16 + lane] = e / sum; }
    }
}

__device__ void phase_peer_gather(const Args& a, int layer, int mode) {
    const int lane = threadIdx.x & 63, gw = blockIdx.x * NWAVE + (threadIdx.x >> 6), ngw = gridDim.x * NWAVE;
    unsigned char* ws = a.ws;
    bf16_t* H = (bf16_t*)(ws + WS_H); float* X1 = (float*)(ws + WS_X1);
    const bf16_t* PU = (const bf16_t*)(ws + WS_PU) + (size_t)layer * NEXP * D; const bf16_t* PV = (const bf16_t*)(ws + WS_PV) + (size_t)layer * NEXP * D;
    const int* SELI = (const int*)(ws + WS_SELI); const float* SELG = (const float*)(ws + WS_SELG);
    for (int g = gw; g < MTOT; g += ngw) {
        const int var = row_variant(g);
        if (mode == 1 && var == 2) continue;
        float hp[16], acc[16];
        {
            const u32x4 w0 = *(const u32x4*)(H + (size_t)g * D + lane * 16), w1 = *(const u32x4*)(H + (size_t)g * D + lane * 16 + 8);
            hp[0] = bflo(w0.x); hp[1] = bfhi(w0.x); hp[2] = bflo(w0.y); hp[3] = bfhi(w0.y); hp[4] = bflo(w0.z); hp[5] = bfhi(w0.z); hp[6] = bflo(w0.w); hp[7] = bfhi(w0.w);
            hp[8] = bflo(w1.x); hp[9] = bfhi(w1.x); hp[10] = bflo(w1.y); hp[11] = bfhi(w1.y); hp[12] = bflo(w1.z); hp[13] = bfhi(w1.z); hp[14] = bflo(w1.w); hp[15] = bfhi(w1.w);
#pragma unroll
            for (int d = 0; d < 16; ++d) acc[d] = 0.f;
        }
        const int myi0 = SELI[(size_t)g * 128 + lane], myi1 = SELI[(size_t)g * 128 + 64 + lane];
        const float myg0 = SELG[(size_t)g * 128 + lane], myg1 = SELG[(size_t)g * 128 + 64 + lane];
        for (int e = 0; e < 128; ++e) {
            const int ei = e < 64 ? __shfl(myi0, e) : __shfl(myi1, e - 64);
            const float eg = e < 64 ? __shfl(myg0, e) : __shfl(myg1, e - 64);
            const bf16_t* up = PU + (size_t)ei * D + lane * 16; const bf16_t* vp = PV + (size_t)ei * D + lane * 16;
            const u32x4 u0 = *(const u32x4*)up, u1 = *(const u32x4*)(up + 8), v0 = *(const u32x4*)vp, v1 = *(const u32x4*)(vp + 8);
            float dt = hp[0] * bflo(u0.x) + hp[1] * bfhi(u0.x) + hp[2] * bflo(u0.y) + hp[3] * bfhi(u0.y) + hp[4] * bflo(u0.z) + hp[5] * bfhi(u0.z) + hp[6] * bflo(u0.w) + hp[7] * bfhi(u0.w)
                     + hp[8] * bflo(u1.x) + hp[9] * bfhi(u1.x) + hp[10] * bflo(u1.y) + hp[11] * bfhi(u1.y) + hp[12] * bflo(u1.z) + hp[13] * bfhi(u1.z) + hp[14] * bflo(u1.w) + hp[15] * bfhi(u1.w);
            dt = wave_sum(dt);
            const float act = gelu_t(dt) * eg;
            acc[0] += act * bflo(v0.x); acc[1] += act * bfhi(v0.x); acc[2] += act * bflo(v0.y); acc[3] += act * bfhi(v0.y);
            acc[4] += act * bflo(v0.z); acc[5] += act * bfhi(v0.z); acc[6] += act * bflo(v0.w); acc[7] += act * bfhi(v0.w);
            acc[8] += act * bflo(v1.x); acc[9] += act * bfhi(v1.x); acc[10] += act * bflo(v1.y); acc[11] += act * bfhi(v1.y);
            acc[12] += act * bflo(v1.z); acc[13] += act * bfhi(v1.z); acc[14] += act * bflo(v1.w); acc[15] += act * bfhi(v1.w);
        }
        float* xr = X1 + (size_t)g * D + lane * 16;
        const float* g2 = modv(a, layer, var, 5) + lane * 16;
        float xn[16]; float ss = 0.f;
#pragma unroll
        for (int d = 0; d < 16; d += 4) {
            const f32x4 xv = *(const f32x4*)(xr + d), gv = *(const f32x4*)(g2 + d);
            xn[d] = xv.x + gv.x * acc[d]; xn[d + 1] = xv.y + gv.y * acc[d + 1]; xn[d + 2] = xv.z + gv.z * acc[d + 2]; xn[d + 3] = xv.w + gv.w * acc[d + 3];
            ss += xn[d] * xn[d] + xn[d + 1] * xn[d + 1] + xn[d + 2] * xn[d + 2] + xn[d + 3] * xn[d + 3];
        }
        const float rinv = rsqrtf(wave_sum(ss) * (1.f / D) + EPS);
        if (mode == 0) {
#pragma unroll
            for (int d = 0; d < 16; d += 4) { f32x4 o; o.x = xn[d]; o.y = xn[d + 1]; o.z = xn[d + 2]; o.w = xn[d + 3]; *(f32x4*)(xr + d) = o; }
            const float* gn = a.in[6] + D + lane * 16; const float* sh = modv(a, 1, var, 0) + lane * 16; const float* sc = modv(a, 1, var, 1) + lane * 16;
            unsigned w[8];
#pragma unroll
            for (int d = 0; d < 16; d += 2) w[d >> 1] = pk2(xn[d] * rinv * gn[d] * (1.f + sc[d]) + sh[d], xn[d + 1] * rinv * gn[d + 1] * (1.f + sc[d + 1]) + sh[d + 1]);
            u32x4 o0, o1; o0.x = w[0]; o0.y = w[1]; o0.z = w[2]; o0.w = w[3]; o1.x = w[4]; o1.y = w[5]; o1.z = w[6]; o1.w = w[7];
            *(u32x4*)(H + (size_t)g * D + lane * 16) = o0; *(u32x4*)(H + (size_t)g * D + lane * 16 + 8) = o1;
        } else {
            const int b = g / RPB, t = g - b * RPB - CTXL;
            float* op = a.out + ((size_t)b * SEQ + t) * D + lane * 16; const float* gn = a.in[28] + lane * 16;
#pragma unroll
            for (int d = 0; d < 16; d += 4) { f32x4 o; o.x = xn[d] * rinv * gn[d]; o.y = xn[d + 1] * rinv * gn[d + 1]; o.z = xn[d + 2] * rinv * gn[d + 2]; o.w = xn[d + 3] * rinv * gn[d + 3]; *(f32x4*)(op + d) = o; }
        }
    }
}

__device__ void phase_inproj1(const Args& a, char* lds) {
    float* Cs = (float*)lds;
    const int tid = threadIdx.x;
    const bf16_t* H = (const bf16_t*)(a.ws + WS_H); const bf16_t* W = (const bf16_t*)(a.ws + WS_WIN1);
    const int NU = (MTOT / 128) * 20;
    for (int u = blockIdx.x; u < NU; u += gridDim.x) {
        const int rt = u / 20, ct = u % 20, row0 = rt * 128, col0 = ct * 128;
        if (ct < 10 && (rt % 66) < 2) continue;
        gemm_tile128(H + (size_t)row0 * D, D, W + (size_t)col0 * D, D, D, Cs);
        __syncthreads();
        const int rr = tid >> 2, q4 = tid & 3, g = row0 + rr;
        const float* crow = Cs + rr * CS_LD + q4 * 32;
        if (ct < 10) {
            bf16_t* o = (bf16_t*)(a.ws + WS_GG) + (size_t)g * DRNN + col0 + q4 * 32;
#pragma unroll
            for (int c = 0; c < 32; c += 2) *(unsigned*)(o + c) = pk2(gelu_t(crow[c]), gelu_t(crow[c + 1]));
        } else {
            bf16_t* o = (bf16_t*)(a.ws + WS_XR) + (size_t)g * DRNN + (col0 - DRNN) + q4 * 32;
#pragma unroll
            for (int c = 0; c < 32; c += 2) *(unsigned*)(o + c) = pk2(crow[c], crow[c + 1]);
        }
        __syncthreads();
    }
}

__device__ void phase_rglru(const Args& a, char* lds, int pass) {
    const int tid = threadIdx.x;
    unsigned char* ws = a.ws;
    float* xc = (float*)lds;
    float* seg = xc + 128 * 128;
    const bf16_t* XR = (const bf16_t*)(ws + WS_XR); const bf16_t* GG = (const bf16_t*)(ws + WS_GG); bf16_t* YG = (bf16_t*)(ws + WS_YG);
    float* CARRY = (float*)(ws + WS_CARRY);
    const int j = tid & 127, tq = tid >> 7;
    const int NU = (MTOT / 128) * 10;
    for (int u = blockIdx.x; u < NU; u += gridDim.x) {
        const int T = u / 10, hb = u % 10, b = T / 66, tl = T % 66, row0 = T * 128, ch = hb * 128 + j;
        if (pass == 1 && tl < 2) continue;
        const int seq_lo = tl < 2 ? b * RPB : b * RPB + CTXL, seq_hi = tl < 2 ? b * RPB + CTXL : (b + 1) * RPB;
        {
            const float w0 = a.in[16][0 * DRNN + ch], w1 = a.in[16][1 * DRNN + ch], w2 = a.in[16][2 * DRNN + ch], w3 = a.in[16][3 * DRNN + ch], cb = a.in[17][ch];
            for (int tt = 0; tt < 32; ++tt) {
                const int g = row0 + tq * 32 + tt;
                const float xm2 = (g - 2 >= seq_lo) ? bf2f(XR[(size_t)(g - 2) * DRNN + ch]) : 0.f;
                const float xm1 = (g - 1 >= seq_lo) ? bf2f(XR[(size_t)(g - 1) * DRNN + ch]) : 0.f;
                const float x0 = bf2f(XR[(size_t)g * DRNN + ch]);
                const float xp1 = (g + 1 < seq_hi) ? bf2f(XR[(size_t)(g + 1) * DRNN + ch]) : 0.f;
                xc[(tq * 32 + tt) * 128 + j] = w0 * xm2 + w1 * xm1 + w2 * x0 + w3 * xp1 + cb;
            }
        }
        __syncthreads();
        float acc[4][32];
#pragma unroll
        for (int m = 0; m < 4; ++m)
#pragma unroll
            for (int tt = 0; tt < 32; ++tt) acc[m][tt] = 0.f;
        {
            const float* wa0 = a.in[18] + ((size_t)(0 * 10 + hb) * 128) * 128 + j; const float* wx0 = a.in[20] + ((size_t)(0 * 10 + hb) * 128) * 128 + j;
            const float* wa1 = a.in[18] + ((size_t)(1 * 10 + hb) * 128) * 128 + j; const float* wx1 = a.in[20] + ((size_t)(1 * 10 + hb) * 128) * 128 + j;
            for (int i = 0; i < 128; ++i) {
                const float w0 = wa0[i * 128], w1 = wx0[i * 128], w2 = wa1[i * 128], w3 = wx1[i * 128];
#pragma unroll
                for (int tt = 0; tt < 32; ++tt) { const float x = xc[(tq * 32 + tt) * 128 + i]; acc[0][tt] += x * w0; acc[1][tt] += x * w1; acc[2][tt] += x * w2; acc[3][tt] += x * w3; }
            }
        }
#pragma unroll
        for (int d = 0; d < 2; ++d) {
            const float ba = a.in[19][d * DRNN + ch], bx = a.in[21][d * DRNN + ch], lam = a.in[22][d * DRNN + ch];
            const float sp = log1pf(__expf(-lam));
#pragma unroll
            for (int tt = 0; tt < 32; ++tt) {
                const float r = sigmoidf_(acc[2 * d][tt] + ba), ig = sigmoidf_(acc[2 * d + 1][tt] + bx);
                const float la = -8.f * r * sp; const float av = __expf(la);
                const float uv = sqrtf(fmaxf(-expm1f(2.f * la), 0.f)) * ig * xc[(tq * 32 + tt) * 128 + j];
                acc[2 * d][tt] = av; acc[2 * d + 1][tt] = uv;
            }
        }
        {
            float Af = 1.f, Hf = 0.f, Ab = 1.f, Hb = 0.f;
#pragma unroll
            for (int tt = 0; tt < 32; ++tt) { Hf = acc[0][tt] * Hf + acc[1][tt]; Af *= acc[0][tt]; }
#pragma unroll
            for (int tt = 31; tt >= 0; --tt) { Hb = acc[2][tt] * Hb + acc[3][tt]; Ab *= acc[2][tt]; }
            seg[((0 * 4 + tq) * 128 + j) * 2] = Af; seg[((0 * 4 + tq) * 128 + j) * 2 + 1] = Hf;
            seg[((1 * 4 + tq) * 128 + j) * 2] = Ab; seg[((1 * 4 + tq) * 128 + j) * 2 + 1] = Hb;
        }
        __syncthreads();
        if (pass == 0) {
            if (tq == 0) {
                float A = 1.f, Hh = 0.f;
                for (int s = 0; s < 4; ++s) { const float sa = seg[((0 * 4 + s) * 128 + j) * 2], sh = seg[((0 * 4 + s) * 128 + j) * 2 + 1]; Hh = sa * Hh + sh; A *= sa; }
                float* c0 = CARRY + (((size_t)(b * 2 + 0) * 66 + tl) * DRNN + ch) * 2; c0[0] = A; c0[1] = Hh;
                A = 1.f; Hh = 0.f;
                for (int s = 3; s >= 0; --s) { const float sa = seg[((1 * 4 + s) * 128 + j) * 2], sh = seg[((1 * 4 + s) * 128 + j) * 2 + 1]; Hh = sa * Hh + sh; A *= sa; }
                float* c1 = CARRY + (((size_t)(b * 2 + 1) * 66 + tl) * DRNN + ch) * 2; c1[0] = A; c1[1] = Hh;
            }
        } else {
            float hf = 0.f, hbk = 0.f;
            for (int t2 = 0; t2 < tl; ++t2) { const float* c = CARRY + (((size_t)(b * 2 + 0) * 66 + t2) * DRNN + ch) * 2; hf = c[0] * hf + c[1]; }
            { const float* c = CARRY + (((size_t)(b * 2 + 1) * 66 + 1) * DRNN + ch) * 2; hbk = c[0] * hbk + c[1]; }
            { const float* c = CARRY + (((size_t)(b * 2 + 1) * 66 + 0) * DRNN + ch) * 2; hbk = c[0] * hbk + c[1]; }
            for (int t2 = 65; t2 > tl; --t2) { const float* c = CARRY + (((size_t)(b * 2 + 1) * 66 + t2) * DRNN + ch) * 2; hbk = c[0] * hbk + c[1]; }
            for (int s = 0; s < tq; ++s) { const float sa = seg[((0 * 4 + s) * 128 + j) * 2], sh = seg[((0 * 4 + s) * 128 + j) * 2 + 1]; hf = sa * hf + sh; }
            for (int s = 3; s > tq; --s) { const float sa = seg[((1 * 4 + s) * 128 + j) * 2], sh = seg[((1 * 4 + s) * 128 + j) * 2 + 1]; hbk = sa * hbk + sh; }
#pragma unroll
            for (int tt = 0; tt < 32; ++tt) { hf = acc[0][tt] * hf + acc[1][tt]; acc[0][tt] = hf; }
#pragma unroll
            for (int tt = 31; tt >= 0; --tt) { hbk = acc[2][tt] * hbk + acc[3][tt]; acc[0][tt] += hbk; }
#pragma unroll
            for (int tt = 0; tt < 32; ++tt) {
                const int g = row0 + tq * 32 + tt;
                YG[(size_t)g * DRNN + ch] = (bf16_t)f2bf(acc[0][tt] * bf2f(GG[(size_t)g * DRNN + ch]));
            }
        }
        __syncthreads();
    }
}

constexpr int NPHASE = 17;
__global__ void __launch_bounds__(NTHR, 2) mega(Args a) {
    extern __shared__ __attribute__((aligned(16))) char lds[];
    volatile LAS unsigned* MISC = (volatile LAS unsigned*)((LAS char*)lds + LDS_MISC);
    if (threadIdx.x < 64) MISC[threadIdx.x] = 0u;
    __syncthreads();
    XcdBarrier bar; bar.bar = (unsigned*)(a.ws + WS_CTL) + 4096; bar.x = 0; bar.st = nullptr;
    const bool multi = (a.ph_hi - a.ph_lo) > 1;
    if (multi) bar = xcd_barrier_post((unsigned*)(a.ws + WS_CTL) + 4096, MISC + 8);
    const int lo = a.ph_lo, hi = a.ph_hi;
    unsigned char* ws = a.ws;
#define IN(k) (lo <= (k) && (k) < hi)
#define SEAM(k) do { if (IN(k) && IN((k) + 1)) xcd_barrier(bar); } while (0)
    if (IN(0)) { phase_prep(a, lds); } SEAM(0);
    if (IN(1)) { phase_norm(a, 0, 0, a.in[6], 0, 1, false); } SEAM(1);
    if (IN(2)) { phase_inproj0(a, lds); } SEAM(2);
    if (IN(3)) { phase_gmlp(a, lds); phase_attn_naive(a, lds); } SEAM(3);
    if (IN(4)) { phase_outproj(a, lds, (const bf16_t*)(ws + WS_AO), 1024, (const bf16_t*)(ws + WS_WOUT0), 0, 2, 0, false); } SEAM(4);
    if (IN(5)) { phase_norm(a, 0, 1, a.in[7], 3, 4, false); } SEAM(5);
    if (IN(6)) { phase_peerq(a, lds, 0, false); } SEAM(6);
    if (IN(7)) { phase_peer_topk(a, 0, false); } SEAM(7);
    if (IN(8)) { phase_peer_gather(a, 0, 0); } SEAM(8);
    if (IN(9)) { phase_inproj1(a, lds); } SEAM(9);
    if (IN(10)) { phase_rglru(a, lds, 0); } SEAM(10);
    if (IN(11)) { phase_rglru(a, lds, 1); } SEAM(11);
    if (IN(12)) { phase_outproj(a, lds, (const bf16_t*)(ws + WS_YG), 1280, (const bf16_t*)(ws + WS_WOUT1), 1, 2, 1, true); } SEAM(12);
    if (IN(13)) { phase_norm(a, 1, 1, a.in[7] + D, 3, 4, true); } SEAM(13);
    if (IN(14)) { phase_peerq(a, lds, 1, true); } SEAM(14);
    if (IN(15)) { phase_peer_topk(a, 1, true); } SEAM(15);
    if (IN(16)) { phase_peer_gather(a, 1, 1); }
#undef IN
#undef SEAM
}

extern "C" void kernel_launch(void* const* d_in, const int* in_sizes, int n_in, void* d_out, int out_size, void* d_ws, size_t ws_size, hipStream_t stream) {
    static int grid = 0;
    if (grid == 0) {
        if (n_in != 29 || out_size != NB * SEQ * D || ws_size < WS_END) {
            fprintf(stderr, "kernel_launch: unexpected shapes: n_in %d out %d ws %zu (need %zu)\n", n_in, out_size, ws_size, (size_t)WS_END); grid = -1; return; }
        int dev = 0, cus = 0, per_cu = 0;
        if (hipGetDevice(&dev) != hipSuccess || hipDeviceGetAttribute(&cus, hipDeviceAttributeMultiprocessorCount, dev) != hipSuccess) { grid = -1; return; }
        if (hipFuncSetAttribute((const void*)mega, hipFuncAttributeMaxDynamicSharedMemorySize, LDS_BYTES) != hipSuccess) { fprintf(stderr, "kernel_launch: hipFuncSetAttribute failed\n"); grid = -1; return; }
        if (hipOccupancyMaxActiveBlocksPerMultiprocessor(&per_cu, (const void*)mega, NTHR, LDS_BYTES) != hipSuccess || per_cu < 1)
            fprintf(stderr, "kernel_launch: occupancy query reports %d blocks per CU\n", per_cu);
        (void)hipGetLastError();
        grid = cus;
    }
    if (grid < 0) return;
    (void)hipMemsetAsync((char*)d_ws + WS_CTL, 0, CTL_BYTES, stream);
    Args a{};
    for (int i = 0; i < 29; ++i) a.in[i] = (const float*)d_in[i];
    a.out = (float*)d_out; a.ws = (unsigned char*)d_ws;
#if MK_SINGLE
    a.ph_lo = 0; a.ph_hi = NPHASE;
    hipLaunchKernelGGL(mega, dim3(grid), dim3(NTHR), LDS_BYTES, stream, a);
#else
    for (int p = 0; p < NPHASE; ++p) { a.ph_lo = p; a.ph_hi = p + 1; hipLaunchKernelGGL(mega, dim3(grid), dim3(NTHR), LDS_BYTES, stream, a); }
#endif
    const hipError_t le = hipPeekAtLastError();
    if (le != hipSuccess) fprintf(stderr, "kernel_launch: launch failed: %s\n", hipGetErrorName(le));
}
```

```cpp
#include <hip/hip_runtime.h>
#include <cstdio>
#include <cstdint>

#ifndef MK_SINGLE
#define MK_SINGLE 1
#endif

#define GAS __attribute__((address_space(1)))
#define LAS __attribute__((address_space(3)))

typedef unsigned short bf16_t;
typedef short bf16x8 __attribute__((ext_vector_type(8)));
typedef float f32x4 __attribute__((ext_vector_type(4)));
typedef float f32x16 __attribute__((ext_vector_type(16)));
typedef unsigned u32x4 __attribute__((ext_vector_type(4)));
typedef unsigned u32x2 __attribute__((ext_vector_type(2)));

constexpr int D = 1024, NB = 2, SEQ = 8192, CTXL = 256;
constexpr int RPB = SEQ + CTXL;
constexpr int MTOT = NB * RPB;
constexpr int AB_IN = 2048, A_W = 512, DRNN = 1280, NEXP = 16384;
constexpr float EPS = 1e-6f;
constexpr int NTHR = 512, NWAVE = 8;

constexpr size_t MiB = 1u << 20;
constexpr size_t WS_CTL = 0, CTL_BYTES = 1 * MiB;
constexpr size_t WS_MODV = 1 * MiB;
constexpr size_t WS_ROPE = 1 * MiB + 512 * 1024;
constexpr size_t WS_WIN0 = 2 * MiB;
constexpr size_t WS_WOUT0 = 6 * MiB;
constexpr size_t WS_WIN1 = 8 * MiB;
constexpr size_t WS_WOUT1 = 13 * MiB;
constexpr size_t WS_WQ = 16 * MiB;
constexpr size_t WS_KEYS = 24 * MiB;
constexpr size_t WS_GWS = 25 * MiB;
constexpr size_t WS_WAT = 26 * MiB;
constexpr size_t WS_WXT = 27 * MiB;
constexpr size_t WS_CARRY = 28 * MiB;
constexpr size_t WS_PU = 32 * MiB;
constexpr size_t WS_PV = 96 * MiB;
constexpr size_t WS_H = 160 * MiB;
constexpr size_t WS_X1 = 193 * MiB;
constexpr size_t WS_SELI = 259 * MiB;
constexpr size_t WS_SELG = 268 * MiB;
constexpr size_t WS_R = 277 * MiB;
constexpr size_t WS_U = WS_R;
constexpr size_t WS_VV = WS_R + 17 * MiB;
constexpr size_t WS_Q = WS_R + 34 * MiB;
constexpr size_t WS_K = WS_R + 51 * MiB;
constexpr size_t WS_V = WS_R + 60 * MiB;
constexpr size_t WS_AO = WS_R + 69 * MiB;
constexpr size_t WS_QP = WS_R;
constexpr size_t WS_GG = WS_R;
constexpr size_t WS_XR = WS_R + 42 * MiB;
constexpr size_t WS_YG = WS_R + 84 * MiB;
constexpr size_t WS_END = WS_R + 126 * MiB;

constexpr int LDS_BYTES = 147456;
constexpr int LDS_MISC = 145408;

__device__ __forceinline__ float bf2f(bf16_t v) { return __uint_as_float(((unsigned)v) << 16); }
__device__ __forceinline__ unsigned f2bf(float f) { unsigned u = __float_as_uint(f); return (u + 0x7fffu + ((u >> 16) & 1u)) >> 16; }
__device__ __forceinline__ unsigned pk2(float lo, float hi) { return f2bf(lo) | (f2bf(hi) << 16); }
__device__ __forceinline__ float bflo(unsigned w) { return __uint_as_float(w << 16); }
__device__ __forceinline__ float bfhi(unsigned w) { return __uint_as_float(w & 0xffff0000u); }
__device__ __forceinline__ float gelu_t(float x) { const float y = 1.5957691216057308f * (x + 0.044715f * x * x * x); return x / (1.f + __expf(-y)); }
__device__ __forceinline__ float sigmoidf_(float x) { return 1.f / (1.f + __expf(-x)); }
__device__ __forceinline__ float wave_sum(float v) {
#pragma unroll
    for (int o = 1; o < 64; o <<= 1) v += __shfl_xor(v, o);
    return v;
}
__host__ __device__ __forceinline__ int sigma_head(int j) { const int grp = j >> 3, n = (j >> 2) & 1, e = j & 3; return (grp >> 3) * 64 + n * 32 + (grp & 7) * 4 + e; }

struct Args {
    const float* in[29];
    float* out;
    unsigned char* ws;
    int ph_lo, ph_hi;
};

__device__ __forceinline__ int row_variant(int g) { const int b = g / RPB, i = g - b * RPB; return i < CTXL ? 2 : b; }
__device__ __forceinline__ const float* row_src(const Args& a, int g) {
    const int b = g / RPB, i = g - b * RPB;
    return i < CTXL ? a.in[2] + ((size_t)b * CTXL + i) * D : a.in[0] + ((size_t)b * SEQ + (i - CTXL)) * D;
}
__device__ __forceinline__ const float* modv(const Args& a, int layer, int variant, int which) {
    return (const float*)(a.ws + WS_MODV) + ((size_t)(layer * 3 + variant) * 6 + which) * D;
}

#define XB_TMO      128
#define XB_XCNT(j)  (256  + 64 * (j))
#define XB_XSUB(j)  (1280 + 64 * (j))
#define XB_XGEN(j)  (2304 + 64 * (j))
#define XB_TOP      3328
#define XB_TOPGEN   3392
#define XCD_BAR_WORDS 3456
#define XB_SPIN_CAP (1u << 22)
__device__ __forceinline__ unsigned xb_ld(unsigned* p)              { return __hip_atomic_load(p, __ATOMIC_RELAXED, __HIP_MEMORY_SCOPE_AGENT); }
__device__ __forceinline__ unsigned xb_add(unsigned* p, unsigned v) { return __hip_atomic_fetch_add(p, v, __ATOMIC_RELAXED, __HIP_MEMORY_SCOPE_AGENT); }
__device__ __forceinline__ unsigned xb_xcc_id() { return (unsigned)__builtin_amdgcn_s_getreg((3 << 11) | 20) & 0xFu; }
#define XB_SPIN(cond, bar) do { unsigned _sp = 0; while (cond) { __builtin_amdgcn_s_sleep(1); \
    if ((++_sp & 255u) == 0u) { if (xb_ld(&(bar)[XB_TMO])) break; if (_sp > XB_SPIN_CAP) { atomicAdd(&(bar)[XB_TMO], 1u); break; } } } } while (0)
struct XcdBarrier { unsigned* bar; unsigned x; volatile LAS unsigned* st; };
__device__ __forceinline__ XcdBarrier xcd_barrier_post(unsigned* bar, volatile LAS unsigned* st) {
    XcdBarrier b; b.bar = bar; b.x = xb_xcc_id(); b.st = st;
    if (threadIdx.x == 0) (void)xb_add(&bar[XB_XCNT(b.x)], 1u);
    return b;
}
__device__ __forceinline__ void xcd_barrier_complete(unsigned* bar, unsigned x, unsigned& nloc, unsigned& nx) {
    const unsigned G = gridDim.x * gridDim.y * gridDim.z;
    unsigned sum, cnt, mine, sp = 0u;
    for (;;) {
        sum = 0u; cnt = 0u; mine = 0u;
#pragma unroll
        for (unsigned j = 0; j < 16; ++j) { const unsigned c = xb_ld(&bar[XB_XCNT(j)]); sum += c; cnt += (c > 0u) ? 1u : 0u; mine = (j == x) ? c : mine; }
        if (sum == G) break;
        __builtin_amdgcn_s_sleep(1);
        if ((++sp & 255u) == 0u) { if (xb_ld(&bar[XB_TMO])) break; if (sp > XB_SPIN_CAP) { atomicAdd(&bar[XB_TMO], 1u); break; } }
    }
    nloc = mine > 0u ? mine : 1u; nx = cnt > 0u ? cnt : 1u;
}
__device__ __forceinline__ void xcd_barrier(const XcdBarrier& b) {
    asm volatile("s_waitcnt vmcnt(0)" ::: "memory");
    __syncthreads();
    if (threadIdx.x == 0) {
        unsigned* bar = b.bar;
        __builtin_amdgcn_s_waitcnt(0);
        unsigned nloc = b.st[0], nx = b.st[1];
        if (nloc == 0u) { xcd_barrier_complete(bar, b.x, nloc, nx); b.st[0] = nloc; b.st[1] = nx; }
        const unsigned old = xb_add(&bar[XB_XSUB(b.x)], 1u);
        const unsigned gen = old / nloc;
        if (old + 1u == (gen + 1u) * nloc) {
            __builtin_amdgcn_fence(__ATOMIC_RELEASE, "agent");
            asm volatile("s_waitcnt vmcnt(0)" ::: "memory");
            const unsigned og = xb_add(&bar[XB_TOP], 1u);
            const unsigned tg = og / nx;
            if (og + 1u == (tg + 1u) * nx) xb_add(&bar[XB_TOPGEN], 1u);
            else XB_SPIN(xb_ld(&bar[XB_TOPGEN]) == tg, bar);
            __builtin_amdgcn_fence(__ATOMIC_ACQUIRE, "agent");
            xb_add(&bar[XB_XGEN(b.x)], 1u);
            asm volatile("s_waitcnt vmcnt(0)" ::: "memory");
        } else {
            XB_SPIN(xb_ld(&bar[XB_XGEN(b.x)]) == gen, bar);
            __builtin_amdgcn_fence(__ATOMIC_ACQUIRE, "agent");
            asm volatile("s_waitcnt vmcnt(0)" ::: "memory");
        }
    }
    __syncthreads();
}

__device__ __forceinline__ void transpose_item(const float* src, int Ns, bf16_t* dst, int Kd, int n0, int k0, int perm_lo, int perm_hi, float* tile) {
    const int tid = threadIdx.x;
    {
        const int nn = tid & 63; int n = n0 + nn;
        if (n >= perm_lo && n < perm_hi) { const int rel = n - perm_lo; n = perm_lo + (rel & ~127) + sigma_head(rel & 127); }
#pragma unroll
        for (int i = 0; i < 8; ++i) { const int kk = (tid >> 6) + 8 * i; tile[kk * 65 + nn] = src[(size_t)(k0 + kk) * Ns + n]; }
    }
    __syncthreads();
    {
        const int n = tid >> 3, kc = (tid & 7) * 8;
        u32x4 o;
        o.x = pk2(tile[(kc + 0) * 65 + n], tile[(kc + 1) * 65 + n]); o.y = pk2(tile[(kc + 2) * 65 + n], tile[(kc + 3) * 65 + n]);
        o.z = pk2(tile[(kc + 4) * 65 + n], tile[(kc + 5) * 65 + n]); o.w = pk2(tile[(kc + 6) * 65 + n], tile[(kc + 7) * 65 + n]);
        *(u32x4*)(dst + (size_t)(n0 + n) * Kd + k0 + kc) = o;
    }
    __syncthreads();
}
__device__ __forceinline__ void cvt_stream(const float* src, bf16_t* dst, size_t n8, size_t gtid, size_t gthreads) {
    for (size_t i = gtid; i < n8; i += gthreads) {
        const f32x4 a = *(const f32x4*)(src + i * 8), b = *(const f32x4*)(src + i * 8 + 4);
        u32x4 o; o.x = pk2(a.x, a.y); o.y = pk2(a.z, a.w); o.z = pk2(b.x, b.y); o.w = pk2(b.z, b.w);
        *(u32x4*)(dst + i * 8) = o;
    }
}
__device__ void phase_prep(const Args& a, char* lds) {
    const int tid = threadIdx.x, lane = tid & 63, wid = tid >> 6;
    float* tile = (float*)lds;
    unsigned char* ws = a.ws;
    constexpr int I_MOD = 192;
    constexpr int I_WIN0 = (1024 / 64) * (2048 / 64), I_WOUT0 = (1024 / 64) * (1024 / 64), I_WIN1 = (1024 / 64) * (2560 / 64), I_WOUT1 = (1280 / 64) * (1024 / 64);
    constexpr int I_WQ = 2 * (1024 / 64) * (2048 / 64), I_WAX = 40 * 4;
    constexpr int NIT = I_MOD + I_WIN0 + I_WOUT0 + I_WIN1 + I_WOUT1 + I_WQ + I_WAX;
    for (int it = blockIdx.x; it < NIT; it += gridDim.x) {
        int r = it;
        if (r < I_MOD) {
            const int l = r / 96, n0 = (r % 96) * 64;
            const float* W = a.in[4] + (size_t)l * D * 6144;
            float s0 = 0.f, s1 = 0.f, s2 = 0.f;
            for (int k = wid * 128; k < wid * 128 + 128; ++k) {
                const float w = W[(size_t)k * 6144 + n0 + lane];
                const float c0 = a.in[1][k], c1 = a.in[1][D + k], c2 = a.in[3][k];
                s0 += c0 * sigmoidf_(c0) * w; s1 += c1 * sigmoidf_(c1) * w; s2 += c2 * sigmoidf_(c2) * w;
            }
            tile[(wid * 3 + 0) * 64 + lane] = s0; tile[(wid * 3 + 1) * 64 + lane] = s1; tile[(wid * 3 + 2) * 64 + lane] = s2;
            __syncthreads();
            if (tid < 192) {
                const int v = tid / 64, ln = tid & 63; float s = a.in[5][(size_t)l * 6144 + n0 + ln];
                for (int w = 0; w < 8; ++w) s += tile[(w * 3 + v) * 64 + ln];
                ((float*)(ws + WS_MODV))[(size_t)(l * 3 + v) * 6144 + n0 + ln] = s;
            }
            __syncthreads();
            continue;
        }
        r -= I_MOD;
        if (r < I_WIN0) { const int nb = r % 32, kb = r / 32; transpose_item(a.in[8], 2048, (bf16_t*)(ws + WS_WIN0), 1024, nb * 64, kb * 64, 1024, 1792, tile); continue; }
        r -= I_WIN0;
        if (r < I_WOUT0) { const int nb = r % 16, kb = r / 16; transpose_item(a.in[14], 1024, (bf16_t*)(ws + WS_WOUT0), 1024, nb * 64, kb * 64, 0, 0, tile); continue; }
        r -= I_WOUT0;
        if (r < I_WIN1) { const int nb = r % 40, kb = r / 40; transpose_item(a.in[15], 2560, (bf16_t*)(ws + WS_WIN1), 1024, nb * 64, kb * 64, 0, 0, tile); continue; }
        r -= I_WIN1;
        if (r < I_WOUT1) { const int nb = r % 16, kb = r / 16; transpose_item(a.in[23], 1024, (bf16_t*)(ws + WS_WOUT1), 1280, nb * 64, kb * 64, 0, 0, tile); continue; }
        r -= I_WOUT1;
        if (r < I_WQ) { const int l = r / 512, q = r % 512, nb = q % 32, kb = q / 32;
            transpose_item(a.in[24] + (size_t)l * 1024 * 2048, 2048, (bf16_t*)(ws + WS_WQ) + (size_t)l * 2048 * 1024, 1024, nb * 64, kb * 64, 0, 0, tile); continue; }
        r -= I_WQ;
        { const int m = r / 4, q = r % 4, nb = q % 2, kb = q / 2;
            const int which = m / 20, dh = m % 20;
            const float* src = a.in[which == 0 ? 18 : 20] + (size_t)dh * 128 * 128;
            bf16_t* dst = (bf16_t*)(ws + (which == 0 ? WS_WAT : WS_WXT)) + (size_t)dh * 128 * 128;
            transpose_item(src, 128, dst, 128, nb * 64, kb * 64, 0, 0, tile);
        }
    }
    const size_t gtid = (size_t)blockIdx.x * NTHR + tid, gthreads = (size_t)gridDim.x * NTHR;
    cvt_stream(a.in[25], (bf16_t*)(ws + WS_KEYS), (size_t)2 * 8 * 2 * 128 * 128 / 8, gtid, gthreads);
    cvt_stream(a.in[10], (bf16_t*)(ws + WS_GWS), (size_t)4 * 128 * 128 / 8, gtid, gthreads);
    cvt_stream(a.in[26], (bf16_t*)(ws + WS_PU), (size_t)2 * NEXP * D / 8, gtid, gthreads);
    cvt_stream(a.in[27], (bf16_t*)(ws + WS_PV), (size_t)2 * NEXP * D / 8, gtid, gthreads);
    for (size_t i = gtid; i < 128 * 32; i += gthreads) {
        const int pos = (int)(i / 32), f = (int)(i % 32);
        const float inv = powf(10000.f, -(float)f / 32.f); const float ang = (float)pos * inv;
        float* R = (float*)(ws + WS_ROPE); R[i * 2] = cosf(ang); R[i * 2 + 1] = sinf(ang);
    }
}

__device__ __forceinline__ void norm_row_store(const f32x4 (&v)[4], const float* g, const float* sh, const float* sc, bf16_t* orow, int lane) {
    float s = 0.f;
#pragma unroll
    for (int j = 0; j < 4; ++j) s += (v[j].x * v[j].x + v[j].y * v[j].y) + (v[j].z * v[j].z + v[j].w * v[j].w);
    const float rinv = rsqrtf(wave_sum(s) * (1.f / D) + EPS);
#pragma unroll
    for (int j = 0; j < 4; ++j) {
        const int c = j * 256 + lane * 4;
        const f32x4 gg = *(const f32x4*)(g + c), s1 = *(const f32x4*)(sh + c), s2 = *(const f32x4*)(sc + c);
        const float o0 = v[j].x * rinv * gg.x * (1.f + s2.x) + s1.x, o1 = v[j].y * rinv * gg.y * (1.f + s2.y) + s1.y;
        const float o2 = v[j].z * rinv * gg.z * (1.f + s2.z) + s1.z, o3 = v[j].w * rinv * gg.w * (1.f + s2.w) + s1.w;
        u32x2 w; w.x = pk2(o0, o1); w.y = pk2(o2, o3);
        *(u32x2*)(orow + c) = w;
    }
}
__device__ void phase_norm(const Args& a, int layer, int src_mode, const float* gain, int which_sh, int which_sc, bool latent_only) {
    const int lane = threadIdx.x & 63, gw = blockIdx.x * NWAVE + (threadIdx.x >> 6), ngw = gridDim.x * NWAVE;
    bf16_t* H = (bf16_t*)(a.ws + WS_H);
    const float* X1 = (const float*)(a.ws + WS_X1);
    for (int g = gw; g < MTOT; g += ngw) {
        const int var = row_variant(g);
        if (latent_only && var == 2) continue;
        const float* xr = src_mode == 0 ? row_src(a, g) : X1 + (size_t)g * D;
        f32x4 v[4];
#pragma unroll
        for (int j = 0; j < 4; ++j) v[j] = *(const f32x4*)(xr + j * 256 + lane * 4);
        norm_row_store(v, gain, modv(a, layer, var, which_sh), modv(a, layer, var, which_sc), H + (size_t)g * D, lane);
    }
}

constexpr int CS_LD = 132;
__device__ __forceinline__ void gemm_tile128(const bf16_t* A, int lda, const bf16_t* Bt, int ldb, int K, float* Cs) {
    const int tid = threadIdx.x, lane = tid & 63, wid = tid >> 6, r = lane & 31, h = lane >> 5, wr = wid >> 1, wc = wid & 1;
    const bf16_t* ap = A + (size_t)(wr * 32 + r) * lda + 8 * h;
    const bf16_t* bp0 = Bt + (size_t)(wc * 64 + r) * ldb + 8 * h;
    const bf16_t* bp1 = bp0 + (size_t)32 * ldb;
    f32x16 acc0 = {}, acc1 = {};
#pragma unroll 4
    for (int k = 0; k < K; k += 16) {
        const bf16x8 av = *(const bf16x8*)(ap + k), b0 = *(const bf16x8*)(bp0 + k), b1 = *(const bf16x8*)(bp1 + k);
        acc0 = __builtin_amdgcn_mfma_f32_32x32x16_bf16(av, b0, acc0, 0, 0, 0);
        acc1 = __builtin_amdgcn_mfma_f32_32x32x16_bf16(av, b1, acc1, 0, 0, 0);
    }
#pragma unroll
    for (int i = 0; i < 16; ++i) {
        const int row = wr * 32 + (i & 3) + 8 * (i >> 2) + 4 * h;
        Cs[row * CS_LD + wc * 64 + r] = acc0[i];
        Cs[row * CS_LD + wc * 64 + 32 + r] = acc1[i];
    }
}

__device__ void phase_inproj0(const Args& a, char* lds) {
    float* Cs = (float*)lds;
    const int tid = threadIdx.x;
    unsigned char* ws = a.ws;
    const bf16_t* H = (const bf16_t*)(ws + WS_H); const bf16_t* W = (const bf16_t*)(ws + WS_WIN0);
    const float* rope = (const float*)(ws + WS_ROPE);
    const int NU = (MTOT / 128) * 16;
    for (int u = blockIdx.x; u < NU; u += gridDim.x) {
        const int rt = u / 16, ct = u % 16, row0 = rt * 128, col0 = ct * 128;
        gemm_tile128(H + (size_t)row0 * D, D, W + (size_t)col0 * D, D, D, Cs);
        __syncthreads();
        const int rr = tid >> 2, q4 = tid & 3, g = row0 + rr;
        float* crow = Cs + rr * CS_LD + q4 * 32;
        if (ct < 4) {
            bf16_t* o = (bf16_t*)(ws + WS_U) + (size_t)g * 512 + col0 + q4 * 32;
#pragma unroll
            for (int c = 0; c < 32; c += 2) *(unsigned*)(o + c) = pk2(gelu_t(crow[c]), gelu_t(crow[c + 1]));
        } else if (ct < 8) {
            const int gg = ct - 4; float ss = 0.f;
#pragma unroll
            for (int c = 0; c < 32; ++c) { const float v = gelu_t(crow[c]); crow[c] = v; ss += v * v; }
            ss += __shfl_xor(ss, 1); ss += __shfl_xor(ss, 2);
            const float rinv = rsqrtf(ss * (1.f / 128.f) + EPS);
            const float* gn = a.in[9] + gg * 128 + q4 * 32;
            bf16_t* o = (bf16_t*)(ws + WS_VV) + (size_t)g * 512 + gg * 128 + q4 * 32;
#pragma unroll
            for (int c = 0; c < 32; c += 2) *(unsigned*)(o + c) = pk2(crow[c] * rinv * gn[c], crow[c + 1] * rinv * gn[c + 1]);
        } else if (ct < 14) {
            const bool isq = ct < 12; const int hh = isq ? ct - 8 : ct - 12;
            float ss = 0.f;
#pragma unroll
            for (int c = 0; c < 32; ++c) ss += crow[c] * crow[c];
            ss += __shfl_xor(ss, 1); ss += __shfl_xor(ss, 2);
            const float rinv = rsqrtf(ss * (1.f / 128.f) + EPS);
            const float* gn = a.in[isq ? 12 : 13];
            const int b = g / RPB, i = g - b * RPB; const bool lat = i >= CTXL; const int t = i - CTXL;
            bf16_t* o = (isq ? (bf16_t*)(ws + WS_Q) + (size_t)g * 512 : (bf16_t*)(ws + WS_K) + (size_t)g * 256) + hh * 128 + q4 * 32;
#pragma unroll
            for (int c8 = 0; c8 < 32; c8 += 8) {
                float y[8];
#pragma unroll
                for (int e = 0; e < 8; ++e) { const int j = q4 * 32 + c8 + e; y[e] = crow[c8 + e] * rinv * gn[sigma_head(j)]; }
                if (lat) {
                    const int grp = (q4 * 32 + c8) >> 3, ax = grp >> 3; const int pos = ax == 0 ? (t >> 6) : (t & 63);
#pragma unroll
                    for (int e = 0; e < 4; ++e) { const int f = (grp & 7) * 4 + e; const float cs = rope[(pos * 32 + f) * 2], sn = rope[(pos * 32 + f) * 2 + 1];
                        const float x1 = y[e], x2 = y[e + 4]; y[e] = x1 * cs - x2 * sn; y[e + 4] = x2 * cs + x1 * sn; }
                }
                u32x4 w; w.x = pk2(y[0], y[1]); w.y = pk2(y[2], y[3]); w.z = pk2(y[4], y[5]); w.w = pk2(y[6], y[7]);
                *(u32x4*)(o + c8) = w;
            }
        } else {
            bf16_t* o = (bf16_t*)(ws + WS_V) + (size_t)g * 256 + (ct - 14) * 128 + q4 * 32;
#pragma unroll
            for (int c = 0; c < 32; c += 2) *(unsigned*)(o + c) = pk2(crow[c], crow[c + 1]);
        }
        __syncthreads();
    }
}

__device__ void phase_gmlp(const Args& a, char* lds) {
    const int tid = threadIdx.x;
    unsigned char* ws = a.ws;
    float* vt = (float*)lds;
    const bf16_t* VV = (const bf16_t*)(ws + WS_VV); const bf16_t* U = (const bf16_t*)(ws + WS_U); bf16_t* AO = (bf16_t*)(ws + WS_AO);
    const int NU = (MTOT / 128) * 4;
    for (int u = blockIdx.x; u < NU; u += gridDim.x) {
        const int ch = u / 4, g = u % 4, row0 = ch * 128;
        for (int i = tid; i < 128 * 128; i += NTHR) { const int q = i >> 7, c = i & 127; vt[i] = bf2f(VV[(size_t)(row0 + q) * 512 + g * 128 + c]); }
        __syncthreads();
        const int c = tid & 127, pq = tid >> 7;
        const float* wsg = a.in[10] + (size_t)g * 128 * 128;
        for (int pp = 0; pp < 32; ++pp) {
            const int p = pq * 32 + pp; float s = 0.f;
            for (int q = 0; q < 128; ++q) s += wsg[p * 128 + q] * vt[q * 128 + c];
            s += a.in[11][g * 128 + p];
            const float uu = bf2f(U[(size_t)(row0 + p) * 512 + g * 128 + c]);
            AO[(size_t)(row0 + p) * 1024 + g * 128 + c] = (bf16_t)f2bf(uu * s);
        }
        __syncthreads();
    }
}

__device__ void phase_attn_naive(const Args& a, char* lds) {
    const int tid = threadIdx.x;
    unsigned char* ws = a.ws;
    float* Ks = (float*)lds;
    float* Vs = Ks + 32 * 128;
    float* part = Vs + 32 * 128;
    const bf16_t* Q = (const bf16_t*)(ws + WS_Q); const bf16_t* Kb = (const bf16_t*)(ws + WS_K); const bf16_t* Vb = (const bf16_t*)(ws + WS_V);
    bf16_t* AO = (bf16_t*)(ws + WS_AO);
    const int NU = 512 + 16;
    for (int u = blockIdx.x; u < NU; u += gridDim.x) {
        int b, h, qrow0, nkeys;
        if (u < 512) { b = u / 256; h = (u / 64) % 4; qrow0 = b * RPB + CTXL + (u % 64) * 128; nkeys = RPB; }
        else { const int v = u - 512; b = v / 8; h = (v / 2) % 4; qrow0 = b * RPB + (v % 2) * 128; nkeys = CTXL; }
        const int kvh = h >> 1, krow0 = b * RPB;
        const int qi = tid & 127, qt = tid >> 7;
        float q[32], o[32];
        {
            const bf16_t* qp = Q + (size_t)(qrow0 + qi) * 512 + h * 128 + qt * 32;
#pragma unroll
            for (int d = 0; d < 32; d += 2) { const unsigned w = *(const unsigned*)(qp + d); q[d] = bflo(w) * 0.08838834764831845f; q[d + 1] = bfhi(w) * 0.08838834764831845f; }
#pragma unroll
            for (int d = 0; d < 32; ++d) o[d] = 0.f;
        }
        float m = -1e30f, l = 0.f;
        for (int k0 = 0; k0 < nkeys; k0 += 32) {
            {
                const int key = tid >> 4, cs = (tid & 15) * 8;
                const u32x4 kw = *(const u32x4*)(Kb + (size_t)(krow0 + k0 + key) * 256 + kvh * 128 + cs);
                const u32x4 vw = *(const u32x4*)(Vb + (size_t)(krow0 + k0 + key) * 256 + kvh * 128 + cs);
                float* kd = Ks + key * 128 + cs; float* vd = Vs + key * 128 + cs;
                kd[0] = bflo(kw.x); kd[1] = bfhi(kw.x); kd[2] = bflo(kw.y); kd[3] = bfhi(kw.y); kd[4] = bflo(kw.z); kd[5] = bfhi(kw.z); kd[6] = bflo(kw.w); kd[7] = bfhi(kw.w);
                vd[0] = bflo(vw.x); vd[1] = bfhi(vw.x); vd[2] = bflo(vw.y); vd[3] = bfhi(vw.y); vd[4] = bflo(vw.z); vd[5] = bfhi(vw.z); vd[6] = bflo(vw.w); vd[7] = bfhi(vw.w);
            }
            __syncthreads();
#pragma unroll 2
            for (int j = 0; j < 32; ++j) {
                const float* kr = Ks + j * 128 + qt * 32; float acc = 0.f;
#pragma unroll
                for (int d = 0; d < 32; d += 4) { const f32x4 kv = *(const f32x4*)(kr + d); acc += q[d] * kv.x + q[d + 1] * kv.y + q[d + 2] * kv.z + q[d + 3] * kv.w; }
                part[(qt * 32 + j) * 128 + qi] = acc;
            }
            __syncthreads();
            float mx = m;
#pragma unroll 4
            for (int j = 0; j < 32; ++j) { const float sj = (part[(0 * 32 + j) * 128 + qi] + part[(1 * 32 + j) * 128 + qi]) + (part[(2 * 32 + j) * 128 + qi] + part[(3 * 32 + j) * 128 + qi]); mx = fmaxf(mx, sj); }
            const float alpha = __expf(m - mx); m = mx; float ps = 0.f;
#pragma unroll
            for (int d = 0; d < 32; ++d) o[d] *= alpha;
#pragma unroll 2
            for (int j = 0; j < 32; ++j) {
                const float sj = (part[(0 * 32 + j) * 128 + qi] + part[(1 * 32 + j) * 128 + qi]) + (part[(2 * 32 + j) * 128 + qi] + part[(3 * 32 + j) * 128 + qi]);
                const float pj = __expf(sj - mx); ps += pj;
                const float* vr = Vs + j * 128 + qt * 32;
#pragma unroll
                for (int d = 0; d < 32; d += 4) { const f32x4 vv = *(const f32x4*)(vr + d); o[d] += pj * vv.x; o[d + 1] += pj * vv.y; o[d + 2] += pj * vv.z; o[d + 3] += pj * vv.w; }
            }
            l = l * alpha + ps;
            __syncthreads();
        }
        const float rl = 1.f / l;
        bf16_t* op = AO + (size_t)(qrow0 + qi) * 1024 + 512 + h * 128 + qt * 32;
#pragma unroll
        for (int d = 0; d < 32; d += 2) *(unsigned*)(op + d) = pk2(o[d] * rl, o[d + 1] * rl);
    }
}

__device__ void phase_outproj(const Args& a, char* lds, const bf16_t* A, int K, const bf16_t* Bt, int layer, int which_gate, int base_mode, bool latent_only) {
    float* Cs = (float*)lds;
    const int tid = threadIdx.x;
    float* X1 = (float*)(a.ws + WS_X1);
    const int NU = (MTOT / 128) * 8;
    for (int u = blockIdx.x; u < NU; u += gridDim.x) {
        const int rt = u / 8, ct = u % 8, row0 = rt * 128, col0 = ct * 128;
        if (latent_only && (rt % 66) < 2) continue;
        gemm_tile128(A + (size_t)row0 * K, K, Bt + (size_t)col0 * K, K, K, Cs);
        __syncthreads();
        const int rr = tid >> 2, q4 = tid & 3, g = row0 + rr;
        const float* crow = Cs + rr * CS_LD + q4 * 32;
        const float* gt = modv(a, layer, row_variant(g), which_gate) + col0 + q4 * 32;
        const float* base = (base_mode == 0 ? row_src(a, g) : X1 + (size_t)g * D) + col0 + q4 * 32;
        float* o = X1 + (size_t)g * D + col0 + q4 * 32;
#pragma unroll
        for (int c = 0; c < 32; c += 4) {
            const f32x4 bs = *(const f32x4*)(base + c), gv = *(const f32x4*)(gt + c);
            f32x4 r; r.x = bs.x + gv.x * crow[c]; r.y = bs.y + gv.y * crow[c + 1]; r.z = bs.z + gv.z * crow[c + 2]; r.w = bs.w + gv.w * crow[c + 3];
            *(f32x4*)(o + c) = r;
        }
        __syncthreads();
    }
}

__device__ void phase_peerq(const Args& a, char* lds, int layer, bool latent_only) {
    float* Cs = (float*)lds;
    const int tid = threadIdx.x;
    const bf16_t* H = (const bf16_t*)(a.ws + WS_H); const bf16_t* W = (const bf16_t*)(a.ws + WS_WQ) + (size_t)layer * 2048 * 1024;
    bf16_t* QP = (bf16_t*)(a.ws + WS_QP);
    const int NU = (MTOT / 128) * 16;
    for (int u = blockIdx.x; u < NU; u += gridDim.x) {
        const int rt = u / 16, ct = u % 16, row0 = rt * 128, col0 = ct * 128;
        if (latent_only && (rt % 66) < 2) continue;
        gemm_tile128(H + (size_t)row0 * D, D, W + (size_t)col0 * D, D, D, Cs);
        __syncthreads();
        const int rr = tid >> 2, q4 = tid & 3, g = row0 + rr;
        const float* crow = Cs + rr * CS_LD + q4 * 32;
        bf16_t* o = QP + (size_t)g * 2048 + col0 + q4 * 32;
#pragma unroll
        for (int c = 0; c < 32; c += 2) *(unsigned*)(o + c) = pk2(crow[c], crow[c + 1]);
        __syncthreads();
    }
}

__device__ __forceinline__ void wave_argmax(float& v, int& i) {
#pragma unroll
    for (int o = 1; o < 64; o <<= 1) {
        const float ov = __shfl_xor(v, o); const int oi = __shfl_xor(i, o);
        if (ov > v || (ov == v && oi < i)) { v = ov; i = oi; }
    }
}
__device__ void phase_peer_topk(const Args& a, int layer, bool latent_only) {
    const int lane = threadIdx.x & 63, gw = blockIdx.x * NWAVE + (threadIdx.x >> 6), ngw = gridDim.x * NWAVE;
    const bf16_t* QP = (const bf16_t*)(a.ws + WS_QP);
    const bf16_t* KEYS = (const bf16_t*)(a.ws + WS_KEYS) + (size_t)layer * 8 * 2 * 128 * 128;
    int* SELI = (int*)(a.ws + WS_SELI); float* SELG = (float*)(a.ws + WS_SELG);
    for (int it = gw; it < MTOT * 8; it += ngw) {
        const int g = it >> 3, h = it & 7;
        if (latent_only && row_variant(g) == 2) continue;
        float tv[2]; int ti[2];
#pragma unroll
        for (int s = 0; s < 2; ++s) {
            const bf16_t* qp = QP + (size_t)g * 2048 + h * 256 + s * 128;
            const bf16_t* k0p = KEYS + ((size_t)(h * 2 + s) * 128 + lane) * 128;
            const bf16_t* k1p = k0p + 64 * 128;
            float s0 = 0.f, s1 = 0.f;
#pragma unroll 4
            for (int d = 0; d < 128; d += 8) {
                const u32x4 qw = *(const u32x4*)(qp + d), ka = *(const u32x4*)(k0p + d), kb = *(const u32x4*)(k1p + d);
                s0 += bflo(qw.x) * bflo(ka.x) + bfhi(qw.x) * bfhi(ka.x) + bflo(qw.y) * bflo(ka.y) + bfhi(qw.y) * bfhi(ka.y)
                    + bflo(qw.z) * bflo(ka.z) + bfhi(qw.z) * bfhi(ka.z) + bflo(qw.w) * bflo(ka.w) + bfhi(qw.w) * bfhi(ka.w);
                s1 += bflo(qw.x) * bflo(kb.x) + bfhi(qw.x) * bfhi(kb.x) + bflo(qw.y) * bflo(kb.y) + bfhi(qw.y) * bfhi(kb.y)
                    + bflo(qw.z) * bflo(kb.z) + bfhi(qw.z) * bfhi(kb.z) + bflo(qw.w) * bflo(kb.w) + bfhi(qw.w) * bfhi(kb.w);
            }
            float myv = 0.f; int myi = 0;
            for (int r = 0; r < 16; ++r) {
                float bv; int bi;
                if (s0 >= s1) { bv = s0; bi = lane; } else { bv = s1; bi = lane + 64; }
                wave_argmax(bv, bi);
                if (bi == lane) s0 = -INFINITY; else if (bi == lane + 64) s1 = -INFINITY;
                if (lane == r) { myv = bv; myi = bi; }
            }
            tv[s] = myv; ti[s] = myi;
        }
        float cv[4]; int ci[4];
        {
            const float v0 = __shfl(tv[0], lane >> 2); const int i0 = __shfl(ti[0], lane >> 2);
#pragma unroll
            for (int m = 0; m < 4; ++m) { const int j = (lane & 3) * 4 + m; cv[m] = v0 + __shfl(tv[1], j); ci[m] = i0 * 128 + __shfl(ti[1], j); }
        }
        float topv = 0.f; int tope = 0;
        for (int r = 0; r < 16; ++r) {
            float bv = cv[0]; int bp = lane * 4;
#pragma unroll
            for (int m = 1; m < 4; ++m) if (cv[m] > bv) { bv = cv[m]; bp = lane * 4 + m; }
            wave_argmax(bv, bp);
            int be = 0;
#pragma unroll
            for (int m = 0; m < 4; ++m) if (bp == lane * 4 + m) { be = ci[m]; cv[m] = -INFINITY; }
            be = __shfl(be, bp >> 2);
            if (lane == r) { topv = bv; tope = be; }
        }
        const float mx = __shfl(topv, 0);
        float e = lane < 16 ? __expf(topv - mx) : 0.f;
        float sum = e;
#pragma unroll
        for (int o = 1; o < 16; o <<= 1) sum += __shfl_xor(sum, o);
        if (lane < 16) { SELI[(size_t)g * 128 + h * 16 + lane] = tope; SELG[(size_t)g * 128 + h * 16 + lane] = e / sum; }
    }
}

__device__ void phase_peer_gather(const Args& a, int layer, int mode) {
    const int lane = threadIdx.x & 63, gw = blockIdx.x * NWAVE + (threadIdx.x >> 6), ngw = gridDim.x * NWAVE;
    unsigned char* ws = a.ws;
    bf16_t* H = (bf16_t*)(ws + WS_H); float* X1 = (float*)(ws + WS_X1);
    const bf16_t* PU = (const bf16_t*)(ws + WS_PU) + (size_t)layer * NEXP * D; const bf16_t* PV = (const bf16_t*)(ws + WS_PV) + (size_t)layer * NEXP * D;
    const int* SELI = (const int*)(ws + WS_SELI); const float* SELG = (const float*)(ws + WS_SELG);
    for (int g = gw; g < MTOT; g += ngw) {
        const int var = row_variant(g);
        if (mode == 1 && var == 2) continue;
        float hp[16], acc[16];
        {
            const u32x4 w0 = *(const u32x4*)(H + (size_t)g * D + lane * 16), w1 = *(const u32x4*)(H + (size_t)g * D + lane * 16 + 8);
            hp[0] = bflo(w0.x); hp[1] = bfhi(w0.x); hp[2] = bflo(w0.y); hp[3] = bfhi(w0.y); hp[4] = bflo(w0.z); hp[5] = bfhi(w0.z); hp[6] = bflo(w0.w); hp[7] = bfhi(w0.w);
            hp[8] = bflo(w1.x); hp[9] = bfhi(w1.x); hp[10] = bflo(w1.y); hp[11] = bfhi(w1.y); hp[12] = bflo(w1.z); hp[13] = bfhi(w1.z); hp[14] = bflo(w1.w); hp[15] = bfhi(w1.w);
#pragma unroll
            for (int d = 0; d < 16; ++d) acc[d] = 0.f;
        }
        const int myi0 = SELI[(size_t)g * 128 + lane], myi1 = SELI[(size_t)g * 128 + 64 + lane];
        const float myg0 = SELG[(size_t)g * 128 + lane], myg1 = SELG[(size_t)g * 128 + 64 + lane];
        for (int e = 0; e < 128; ++e) {
            const int ei = e < 64 ? __shfl(myi0, e) : __shfl(myi1, e - 64);
            const float eg = e < 64 ? __shfl(myg0, e) : __shfl(myg1, e - 64);
            const bf16_t* up = PU + (size_t)ei * D + lane * 16; const bf16_t* vp = PV + (size_t)ei * D + lane * 16;
            const u32x4 u0 = *(const u32x4*)up, u1 = *(const u32x4*)(up + 8), v0 = *(const u32x4*)vp, v1 = *(const u32x4*)(vp + 8);
            float dt = hp[0] * bflo(u0.x) + hp[1] * bfhi(u0.x) + hp[2] * bflo(u0.y) + hp[3] * bfhi(u0.y) + hp[4] * bflo(u0.z) + hp[5] * bfhi(u0.z) + hp[6] * bflo(u0.w) + hp[7] * bfhi(u0.w)
                     + hp[8] * bflo(u1.x) + hp[9] * bfhi(u1.x) + hp[10] * bflo(u1.y) + hp[11] * bfhi(u1.y) + hp[12] * bflo(u1.z) + hp[13] * bfhi(u1.z) + hp[14] * bflo(u1.w) + hp[15] * bfhi(u1.w);
            dt = wave_sum(dt);
            const float act = gelu_t(dt) * eg;
            acc[0] += act * bflo(v0.x); acc[1] += act * bfhi(v0.x); acc[2] += act * bflo(v0.y); acc[3] += act * bfhi(v0.y);
            acc[4] += act * bflo(v0.z); acc[5] += act * bfhi(v0.z); acc[6] += act * bflo(v0.w); acc[7] += act * bfhi(v0.w);
            acc[8] += act * bflo(v1.x); acc[9] += act * bfhi(v1.x); acc[10] += act * bflo(v1.y); acc[11] += act * bfhi(v1.y);
            acc[12] += act * bflo(v1.z); acc[13] += act * bfhi(v1.z); acc[14] += act * bflo(v1.w); acc[15] += act * bfhi(v1.w);
        }
        float* xr = X1 + (size_t)g * D + lane * 16;
        const float* g2 = modv(a, layer, var, 5) + lane * 16;
        float xn[16]; float ss = 0.f;
#pragma unroll
        for (int d = 0; d < 16; d += 4) {
            const f32x4 xv = *(const f32x4*)(xr + d), gv = *(const f32x4*)(g2 + d);
            xn[d] = xv.x + gv.x * acc[d]; xn[d + 1] = xv.y + gv.y * acc[d + 1]; xn[d + 2] = xv.z + gv.z * acc[d + 2]; xn[d + 3] = xv.w + gv.w * acc[d + 3];
            ss += xn[d] * xn[d] + xn[d + 1] * xn[d + 1] + xn[d + 2] * xn[d + 2] + xn[d + 3] * xn[d + 3];
        }
        const float rinv = rsqrtf(wave_sum(ss) * (1.f / D) + EPS);
        if (mode == 0) {
#pragma unroll
            for (int d = 0; d < 16; d += 4) { f32x4 o; o.x = xn[d]; o.y = xn[d + 1]; o.z = xn[d + 2]; o.w = xn[d + 3]; *(f32x4*)(xr + d) = o; }
            const float* gn = a.in[6] + D + lane * 16; const float* sh = modv(a, 1, var, 0) + lane * 16; const float* sc = modv(a, 1, var, 1) + lane * 16;
            unsigned w[8];
#pragma unroll
            for (int d = 0; d < 16; d += 2) w[d >> 1] = pk2(xn[d] * rinv * gn[d] * (1.f + sc[d]) + sh[d], xn[d + 1] * rinv * gn[d + 1] * (1.f + sc[d + 1]) + sh[d + 1]);
            u32x4 o0, o1; o0.x = w[0]; o0.y = w[1]; o0.z = w[2]; o0.w = w[3]; o1.x = w[4]; o1.y = w[5]; o1.z = w[6]; o1.w = w[7];
            *(u32x4*)(H + (size_t)g * D + lane * 16) = o0; *(u32x4*)(H + (size_t)g * D + lane * 16 + 8) = o1;
        } else {
            const int b = g / RPB, t = g - b * RPB - CTXL;
            float* op = a.out + ((size_t)b * SEQ + t) * D + lane * 16; const float* gn = a.in[28] + lane * 16;
#pragma unroll
            for (int d = 0; d < 16; d += 4) { f32x4 o; o.x = xn[d] * rinv * gn[d]; o.y = xn[d + 1] * rinv * gn[d + 1]; o.z = xn[d + 2] * rinv * gn[d + 2]; o.w = xn[d + 3] * rinv * gn[d + 3]; *(f32x4*)(op + d) = o; }
        }
    }
}

__device__ void phase_inproj1(const Args& a, char* lds) {
    float* Cs = (float*)lds;
    const int tid = threadIdx.x;
    const bf16_t* H = (const bf16_t*)(a.ws + WS_H); const bf16_t* W = (const bf16_t*)(a.ws + WS_WIN1);
    const int NU = (MTOT / 128) * 20;
    for (int u = blockIdx.x; u < NU; u += gridDim.x) {
        const int rt = u / 20, ct = u % 20, row0 = rt * 128, col0 = ct * 128;
        if (ct < 10 && (rt % 66) < 2) continue;
        gemm_tile128(H + (size_t)row0 * D, D, W + (size_t)col0 * D, D, D, Cs);
        __syncthreads();
        const int rr = tid >> 2, q4 = tid & 3, g = row0 + rr;
        const float* crow = Cs + rr * CS_LD + q4 * 32;
        if (ct < 10) {
            bf16_t* o = (bf16_t*)(a.ws + WS_GG) + (size_t)g * DRNN + col0 + q4 * 32;
#pragma unroll
            for (int c = 0; c < 32; c += 2) *(unsigned*)(o + c) = pk2(gelu_t(crow[c]), gelu_t(crow[c + 1]));
        } else {
            bf16_t* o = (bf16_t*)(a.ws + WS_XR) + (size_t)g * DRNN + (col0 - DRNN) + q4 * 32;
#pragma unroll
            for (int c = 0; c < 32; c += 2) *(unsigned*)(o + c) = pk2(crow[c], crow[c + 1]);
        }
        __syncthreads();
    }
}

__device__ void phase_rglru(const Args& a, char* lds, int pass) {
    const int tid = threadIdx.x;
    unsigned char* ws = a.ws;
    float* xc = (float*)lds;
    float* seg = xc + 128 * 128;
    const bf16_t* XR = (const bf16_t*)(ws + WS_XR); const bf16_t* GG = (const bf16_t*)(ws + WS_GG); bf16_t* YG = (bf16_t*)(ws + WS_YG);
    float* CARRY = (float*)(ws + WS_CARRY);
    const int j = tid & 127, tq = tid >> 7;
    const int NU = (MTOT / 128) * 10;
    for (int u = blockIdx.x; u < NU; u += gridDim.x) {
        const int T = u / 10, hb = u % 10, b = T / 66, tl = T % 66, row0 = T * 128, ch = hb * 128 + j;
        if (pass == 1 && tl < 2) continue;
        const int seq_lo = tl < 2 ? b * RPB : b * RPB + CTXL, seq_hi = tl < 2 ? b * RPB + CTXL : (b + 1) * RPB;
        {
            const float w0 = a.in[16][0 * DRNN + ch], w1 = a.in[16][1 * DRNN + ch], w2 = a.in[16][2 * DRNN + ch], w3 = a.in[16][3 * DRNN + ch], cb = a.in[17][ch];
            for (int tt = 0; tt < 32; ++tt) {
                const int g = row0 + tq * 32 + tt;
                const float xm2 = (g - 2 >= seq_lo) ? bf2f(XR[(size_t)(g - 2) * DRNN + ch]) : 0.f;
                const float xm1 = (g - 1 >= seq_lo) ? bf2f(XR[(size_t)(g - 1) * DRNN + ch]) : 0.f;
                const float x0 = bf2f(XR[(size_t)g * DRNN + ch]);
                const float xp1 = (g + 1 < seq_hi) ? bf2f(XR[(size_t)(g + 1) * DRNN + ch]) : 0.f;
                xc[(tq * 32 + tt) * 128 + j] = w0 * xm2 + w1 * xm1 + w2 * x0 + w3 * xp1 + cb;
            }
        }
        __syncthreads();
        float acc[4][32];
#pragma unroll
        for (int m = 0; m < 4; ++m)
#pragma unroll
            for (int tt = 0; tt < 32; ++tt) acc[m][tt] = 0.f;
        {
            const float* wa0 = a.in[18] + ((size_t)(0 * 10 + hb) * 128) * 128 + j; const float* wx0 = a.in[20] + ((size_t)(0 * 10 + hb) * 128) * 128 + j;
            const float* wa1 = a.in[18] + ((size_t)(1 * 10 + hb) * 128) * 128 + j; const float* wx1 = a.in[20] + ((size_t)(1 * 10 + hb) * 128) * 128 + j;
            for (int i = 0; i < 128; ++i) {
                const float w0 = wa0[i * 128], w1 = wx0[i * 128], w2 = wa1[i * 128], w3 = wx1[i * 128];
#pragma unroll
                for (int tt = 0; tt < 32; ++tt) { const float x = xc[(tq * 32 + tt) * 128 + i]; acc[0][tt] += x * w0; acc[1][tt] += x * w1; acc[2][tt] += x * w2; acc[3][tt] += x * w3; }
            }
        }
#pragma unroll
        for (int d = 0; d < 2; ++d) {
            const float ba = a.in[19][d * DRNN + ch], bx = a.in[21][d * DRNN + ch], lam = a.in[22][d * DRNN + ch];
            const float sp = log1pf(__expf(-lam));
#pragma unroll
            for (int tt = 0; tt < 32; ++tt) {
                const float r = sigmoidf_(acc[2 * d][tt] + ba), ig = sigmoidf_(acc[2 * d + 1][tt] + bx);
                const float la = -8.f * r * sp; const float av = __expf(la);
                const float uv = sqrtf(fmaxf(-expm1f(2.f * la), 0.f)) * ig * xc[(tq * 32 + tt) * 128 + j];
                acc[2 * d][tt] = av; acc[2 * d + 1][tt] = uv;
            }
        }
        {
            float Af = 1.f, Hf = 0.f, Ab = 1.f, Hb = 0.f;
#pragma unroll
            for (int tt = 0; tt < 32; ++tt) { Hf = acc[0][tt] * Hf + acc[1][tt]; Af *= acc[0][tt]; }
#pragma unroll
            for (int tt = 31; tt >= 0; --tt) { Hb = acc[2][tt] * Hb + acc[3][tt]; Ab *= acc[2][tt]; }
            seg[((0 * 4 + tq) * 128 + j) * 2] = Af; seg[((0 * 4 + tq) * 128 + j) * 2 + 1] = Hf;
            seg[((1 * 4 + tq) * 128 + j) * 2] = Ab; seg[((1 * 4 + tq) * 128 + j) * 2 + 1] = Hb;
        }
        __syncthreads();
        if (pass == 0) {
            if (tq == 0) {
                float A = 1.f, Hh = 0.f;
                for (int s = 0; s < 4; ++s) { const float sa = seg[((0 * 4 + s) * 128 + j) * 2], sh = seg[((0 * 4 + s) * 128 + j) * 2 + 1]; Hh = sa * Hh + sh; A *= sa; }
                float* c0 = CARRY + (((size_t)(b * 2 + 0) * 66 + tl) * DRNN + ch) * 2; c0[0] = A; c0[1] = Hh;
                A = 1.f; Hh = 0.f;
                for (int s = 3; s >= 0; --s) { const float sa = seg[((1 * 4 + s) * 128 + j) * 2], sh = seg[((1 * 4 + s) * 128 + j) * 2 + 1]; Hh = sa * Hh + sh; A *= sa; }
                float* c1 = CARRY + (((size_t)(b * 2 + 1) * 66 + tl) * DRNN + ch) * 2; c1[0] = A; c1[1] = Hh;
            }
        } else {
            float hf = 0.f, hbk = 0.f;
            for (int t2 = 0; t2 < tl; ++t2) { const float* c = CARRY + (((size_t)(b * 2 + 0) * 66 + t2) * DRNN + ch) * 2; hf = c[0] * hf + c[1]; }
            { const float* c = CARRY + (((size_t)(b * 2 + 1) * 66 + 1) * DRNN + ch) * 2; hbk = c[0] * hbk + c[1]; }
            { const float* c = CARRY + (((size_t)(b * 2 + 1) * 66 + 0) * DRNN + ch) * 2; hbk = c[0] * hbk + c[1]; }
            for (int t2 = 65; t2 > tl; --t2) { const float* c = CARRY + (((size_t)(b * 2 + 1) * 66 + t2) * DRNN + ch) * 2; hbk = c[0] * hbk + c[1]; }
            for (int s = 0; s < tq; ++s) { const float sa = seg[((0 * 4 + s) * 128 + j) * 2], sh = seg[((0 * 4 + s) * 128 + j) * 2 + 1]; hf = sa * hf + sh; }
            for (int s = 3; s > tq; --s) { const float sa = seg[((1 * 4 + s) * 128 + j) * 2], sh = seg[((1 * 4 + s) * 128 + j) * 2 + 1]; hbk = sa * hbk + sh; }
#pragma unroll
            for (int tt = 0; tt < 32; ++tt) { hf = acc[0][tt] * hf + acc[1][tt]; acc[0][tt] = hf; }
#pragma unroll
            for (int tt = 31; tt >= 0; --tt) { hbk = acc[2][tt] * hbk + acc[3][tt]; acc[0][tt] += hbk; }
#pragma unroll
            for (int tt = 0; tt < 32; ++tt) {
                const int g = row0 + tq * 32 + tt;
                YG[(size_t)g * DRNN + ch] = (bf16_t)f2bf(acc[0][tt] * bf2f(GG[(size_t)g * DRNN + ch]));
            }
        }
        __syncthreads();
    }
}

constexpr int NPHASE = 17;
__global__ void __launch_bounds__(NTHR, 2) mega(Args a) {
    extern __shared__ __attribute__((aligned(16))) char lds[];
    volatile LAS unsigned* MISC = (volatile LAS unsigned*)((LAS char*)lds + LDS_MISC);
    if (threadIdx.x < 64) MISC[threadIdx.x] = 0u;
    __syncthreads();
    XcdBarrier bar; bar.bar = (unsigned*)(a.ws + WS_CTL) + 4096; bar.x = 0; bar.st = nullptr;
    const bool multi = (a.ph_hi - a.ph_lo) > 1;
    if (multi) bar = xcd_barrier_post((unsigned*)(a.ws + WS_CTL) + 4096, MISC + 8);
    const int lo = a.ph_lo, hi = a.ph_hi;
    unsigned char* ws = a.ws;
#define IN(k) (lo <= (k) && (k) < hi)
#define SEAM(k) do { if (IN(k) && IN((k) + 1)) xcd_barrier(bar); } while (0)
    if (IN(0)) { phase_prep(a, lds); } SEAM(0);
    if (IN(1)) { phase_norm(a, 0, 0, a.in[6], 0, 1, false); } SEAM(1);
    if (IN(2)) { phase_inproj0(a, lds); } SEAM(2);
    if (IN(3)) { phase_gmlp(a, lds); phase_attn_naive(a, lds); } SEAM(3);
    if (IN(4)) { phase_outproj(a, lds, (const bf16_t*)(ws + WS_AO), 1024, (const bf16_t*)(ws + WS_WOUT0), 0, 2, 0, false); } SEAM(4);
    if (IN(5)) { phase_norm(a, 0, 1, a.in[7], 3, 4, false); } SEAM(5);
    if (IN(6)) { phase_peerq(a, lds, 0, false); } SEAM(6);
    if (IN(7)) { phase_peer_topk(a, 0, false); } SEAM(7);
    if (IN(8)) { phase_peer_gather(a, 0, 0); } SEAM(8);
    if (IN(9)) { phase_inproj1(a, lds); } SEAM(9);
    if (IN(10)) { phase_rglru(a, lds, 0); } SEAM(10);
    if (IN(11)) { phase_rglru(a, lds, 1); } SEAM(11);
    if (IN(12)) { phase_outproj(a, lds, (const bf16_t*)(ws + WS_YG), 1280, (const bf16_t*)(ws + WS_WOUT1), 1, 2, 1, true); } SEAM(12);
    if (IN(13)) { phase_norm(a, 1, 1, a.in[7] + D, 3, 4, true); } SEAM(13);
    if (IN(14)) { phase_peerq(a, lds, 1, true); } SEAM(14);
    if (IN(15)) { phase_peer_topk(a, 1, true); } SEAM(15);
    if (IN(16)) { phase_peer_gather(a, 1, 1); }
#undef IN
#undef SEAM
}

extern "C" void kernel_launch(void* const* d_in, const int* in_sizes, int n_in, void* d_out, int out_size, void* d_ws, size_t ws_size, hipStream_t stream) {
    static int grid = 0;
    if (grid == 0) {
        if (n_in != 29 || out_size != NB * SEQ * D || ws_size < WS_END) {
            fprintf(stderr, "kernel_launch: unexpected shapes: n_in %d out %d ws %zu (need %zu)\n", n_in, out_size, ws_size, (size_t)WS_END); grid = -1; return; }
        int dev = 0, cus = 0, per_cu = 0;
        if (hipGetDevice(&dev) != hipSuccess || hipDeviceGetAttribute(&cus, hipDeviceAttributeMultiprocessorCount, dev) != hipSuccess) { grid = -1; return; }
        if (hipFuncSetAttribute((const void*)mega, hipFuncAttributeMaxDynamicSharedMemorySize, LDS_BYTES) != hipSuccess) { fprintf(stderr, "kernel_launch: hipFuncSetAttribute failed\n"); grid = -1; return; }
        if (hipOccupancyMaxActiveBlocksPerMultiprocessor(&per_cu, (const void*)mega, NTHR, LDS_BYTES) != hipSuccess || per_cu < 1)
            fprintf(stderr, "kernel_launch: occupancy query reports %d blocks per CU\n", per_cu);
        (void)hipGetLastError();
        grid = cus;
    }
    if (grid < 0) return;
    (void)hipMemsetAsync((char*)d_ws + WS_CTL, 0, CTL_BYTES, stream);
    Args a{};
    for (int i = 0; i < 29; ++i) a.in[i] = (const float*)d_in[i];
    a.out = (float*)d_out; a.ws = (unsigned char*)d_ws;
#if MK_SINGLE
    a.ph_lo = 0; a.ph_hi = NPHASE;
    hipLaunchKernelGGL(mega, dim3(grid), dim3(NTHR), LDS_BYTES, stream, a);
#else
    for (int p = 0; p < NPHASE; ++p) { a.ph_lo = p; a.ph_hi = p + 1; hipLaunchKernelGGL(mega, dim3(grid), dim3(NTHR), LDS_BYTES, stream, a); }
#endif
    const hipError_t le = hipPeekAtLastError();
    if (le != hipSuccess) fprintf(stderr, "kernel_launch: launch failed: %s\n", hipGetErrorName(le));
}
```

```cpp
#include <hip/hip_runtime.h>
#include <cstdio>
#include <cstdint>

#ifndef MK_SINGLE
#define MK_SINGLE 1
#endif

#define GAS __attribute__((address_space(1)))
#define LAS __attribute__((address_space(3)))

typedef unsigned short bf16_t;
typedef short bf16x8 __attribute__((ext_vector_type(8)));
typedef float f32x4 __attribute__((ext_vector_type(4)));
typedef float f32x16 __attribute__((ext_vector_type(16)));
typedef unsigned u32x4 __attribute__((ext_vector_type(4)));
typedef unsigned u32x2 __attribute__((ext_vector_type(2)));

constexpr int D = 1024, NB = 2, SEQ = 8192, CTXL = 256;
constexpr int RPB = SEQ + CTXL;
constexpr int MTOT = NB * RPB;
constexpr int AB_IN = 2048, A_W = 512, DRNN = 1280, NEXP = 16384;
constexpr float EPS = 1e-6f;
constexpr int NTHR = 512, NWAVE = 8;

constexpr size_t MiB = 1u << 20;
constexpr size_t WS_CTL = 0, CTL_BYTES = 1 * MiB;
constexpr size_t WS_MODV = 1 * MiB;
constexpr size_t WS_ROPE = 1 * MiB + 512 * 1024;
constexpr size_t WS_WIN0 = 2 * MiB;
constexpr size_t WS_WOUT0 = 6 * MiB;
constexpr size_t WS_WIN1 = 8 * MiB;
constexpr size_t WS_WOUT1 = 13 * MiB;
constexpr size_t WS_WQ = 16 * MiB;
constexpr size_t WS_KEYS = 24 * MiB;
constexpr size_t WS_GWS = 25 * MiB;
constexpr size_t WS_WAT = 26 * MiB;
constexpr size_t WS_WXT = 27 * MiB;
constexpr size_t WS_CARRY = 28 * MiB;
constexpr size_t WS_PU = 32 * MiB;
constexpr size_t WS_PV = 96 * MiB;
constexpr size_t WS_H = 160 * MiB;
constexpr size_t WS_X1 = 193 * MiB;
constexpr size_t WS_SELI = 259 * MiB;
constexpr size_t WS_SELG = 268 * MiB;
constexpr size_t WS_R = 277 * MiB;
constexpr size_t WS_U = WS_R;
constexpr size_t WS_VV = WS_R + 17 * MiB;
constexpr size_t WS_Q = WS_R + 34 * MiB;
constexpr size_t WS_K = WS_R + 51 * MiB;
constexpr size_t WS_V = WS_R + 60 * MiB;
constexpr size_t WS_AO = WS_R + 69 * MiB;
constexpr size_t WS_QP = WS_R;
constexpr size_t WS_GG = WS_R;
constexpr size_t WS_XR = WS_R + 42 * MiB;
constexpr size_t WS_YG = WS_R + 84 * MiB;
constexpr size_t WS_END = WS_R + 126 * MiB;

constexpr int LDS_BYTES = 147456;
constexpr int LDS_MISC = 145408;

__device__ __forceinline__ float bf2f(bf16_t v) { return __uint_as_float(((unsigned)v) << 16); }
__device__ __forceinline__ unsigned f2bf(float f) { unsigned u = __float_as_uint(f); return (u + 0x7fffu + ((u >> 16) & 1u)) >> 16; }
__device__ __forceinline__ unsigned pk2(float lo, float hi) { return f2bf(lo) | (f2bf(hi) << 16); }
__device__ __forceinline__ float bflo(unsigned w) { return __uint_as_float(w << 16); }
__device__ __forceinline__ float bfhi(unsigned w) { return __uint_as_float(w & 0xffff0000u); }
__device__ __forceinline__ float gelu_t(float x) { const float y = 1.5957691216057308f * (x + 0.044715f * x * x * x); return x / (1.f + __expf(-y)); }
__device__ __forceinline__ float sigmoidf_(float x) { return 1.f / (1.f + __expf(-x)); }
__device__ __forceinline__ float wave_sum(float v) {
#pragma unroll
    for (int o = 1; o < 64; o <<= 1) v += __shfl_xor(v, o);
    return v;
}
__host__ __device__ __forceinline__ int sigma_head(int j) { const int grp = j >> 3, n = (j >> 2) & 1, e = j & 3; return (grp >> 3) * 64 + n * 32 + (grp & 7) * 4 + e; }

struct Args {
    const float* in[29];
    float* out;
    unsigned char* ws;
    int ph_lo, ph_hi;
};

__device__ __forceinline__ int row_variant(int g) { const int b = g / RPB, i = g - b * RPB; return i < CTXL ? 2 : b; }
__device__ __forceinline__ const float* row_src(const Args& a, int g) {
    const int b = g / RPB, i = g - b * RPB;
    return i < CTXL ? a.in[2] + ((size_t)b * CTXL + i) * D : a.in[0] + ((size_t)b * SEQ + (i - CTXL)) * D;
}
__device__ __forceinline__ const float* modv(const Args& a, int layer, int variant, int which) {
    return (const float*)(a.ws + WS_MODV) + ((size_t)(layer * 3 + variant) * 6 + which) * D;
}

#define XB_TMO      128
#define XB_XCNT(j)  (256  + 64 * (j))
#define XB_XSUB(j)  (1280 + 64 * (j))
#define XB_XGEN(j)  (2304 + 64 * (j))
#define XB_TOP      3328
#define XB_TOPGEN   3392
#define XCD_BAR_WORDS 3456
#define XB_SPIN_CAP (1u << 22)
__device__ __forceinline__ unsigned xb_ld(unsigned* p)              { return __hip_atomic_load(p, __ATOMIC_RELAXED, __HIP_MEMORY_SCOPE_AGENT); }
__device__ __forceinline__ unsigned xb_add(unsigned* p, unsigned v) { return __hip_atomic_fetch_add(p, v, __ATOMIC_RELAXED, __HIP_MEMORY_SCOPE_AGENT); }
__device__ __forceinline__ unsigned xb_xcc_id() { return (unsigned)__builtin_amdgcn_s_getreg((3 << 11) | 20) & 0xFu; }
#define XB_SPIN(cond, bar) do { unsigned _sp = 0; while (cond) { __builtin_amdgcn_s_sleep(1); \
    if ((++_sp & 255u) == 0u) { if (xb_ld(&(bar)[XB_TMO])) break; if (_sp > XB_SPIN_CAP) { atomicAdd(&(bar)[XB_TMO], 1u); break; } } } } while (0)
struct XcdBarrier { unsigned* bar; unsigned x; volatile LAS unsigned* st; };
__device__ __forceinline__ XcdBarrier xcd_barrier_post(unsigned* bar, volatile LAS unsigned* st) {
    XcdBarrier b; b.bar = bar; b.x = xb_xcc_id(); b.st = st;
    if (threadIdx.x == 0) (void)xb_add(&bar[XB_XCNT(b.x)], 1u);
    return b;
}
__device__ __forceinline__ void xcd_barrier_complete(unsigned* bar, unsigned x, unsigned& nloc, unsigned& nx) {
    const unsigned G = gridDim.x * gridDim.y * gridDim.z;
    unsigned sum, cnt, mine, sp = 0u;
    for (;;) {
        sum = 0u; cnt = 0u; mine = 0u;
#pragma unroll
        for (unsigned j = 0; j < 16; ++j) { const unsigned c = xb_ld(&bar[XB_XCNT(j)]); sum += c; cnt += (c > 0u) ? 1u : 0u; mine = (j == x) ? c : mine; }
        if (sum == G) break;
        __builtin_amdgcn_s_sleep(1);
        if ((++sp & 255u) == 0u) { if (xb_ld(&bar[XB_TMO])) break; if (sp > XB_SPIN_CAP) { atomicAdd(&bar[XB_TMO], 1u); break; } }
    }
    nloc = mine > 0u ? mine : 1u; nx = cnt > 0u ? cnt : 1u;
}
__device__ __forceinline__ void xcd_barrier(const XcdBarrier& b) {
    asm volatile("s_waitcnt vmcnt(0)" ::: "memory");
    __syncthreads();
    if (threadIdx.x == 0) {
        unsigned* bar = b.bar;
        __builtin_amdgcn_s_waitcnt(0);
        unsigned nloc = b.st[0], nx = b.st[1];
        if (nloc == 0u) { xcd_barrier_complete(bar, b.x, nloc, nx); b.st[0] = nloc; b.st[1] = nx; }
        const unsigned old = xb_add(&bar[XB_XSUB(b.x)], 1u);
        const unsigned gen = old / nloc;
        if (old + 1u == (gen + 1u) * nloc) {
            __builtin_amdgcn_fence(__ATOMIC_RELEASE, "agent");
            asm volatile("s_waitcnt vmcnt(0)" ::: "memory");
            const unsigned og = xb_add(&bar[XB_TOP], 1u);
            const unsigned tg = og / nx;
            if (og + 1u == (tg + 1u) * nx) xb_add(&bar[XB_TOPGEN], 1u);
            else XB_SPIN(xb_ld(&bar[XB_TOPGEN]) == tg, bar);
            __builtin_amdgcn_fence(__ATOMIC_ACQUIRE, "agent");
            xb_add(&bar[XB_XGEN(b.x)], 1u);
            asm volatile("s_waitcnt vmcnt(0)" ::: "memory");
        } else {
            XB_SPIN(xb_ld(&bar[XB_XGEN(b.x)]) == gen, bar);
            __builtin_amdgcn_fence(__ATOMIC_ACQUIRE, "agent");
            asm volatile("s_waitcnt vmcnt(0)" ::: "memory");
        }
    }
    __syncthreads();
}

__device__ __forceinline__ void transpose_item(const float* src, int Ns, bf16_t* dst, int Kd, int n0, int k0, int perm_lo, int perm_hi, float* tile) {
    const int tid = threadIdx.x;
    {
        const int nn = tid & 63; int n = n0 + nn;
        if (n >= perm_lo && n < perm_hi) { const int rel = n - perm_lo; n = perm_lo + (rel & ~127) + sigma_head(rel & 127); }
#pragma unroll
        for (int i = 0; i < 8; ++i) { const int kk = (tid >> 6) + 8 * i; tile[kk * 65 + nn] = src[(size_t)(k0 + kk) * Ns + n]; }
    }
    __syncthreads();
    {
        const int n = tid >> 3, kc = (tid & 7) * 8;
        u32x4 o;
        o.x = pk2(tile[(kc + 0) * 65 + n], tile[(kc + 1) * 65 + n]); o.y = pk2(tile[(kc + 2) * 65 + n], tile[(kc + 3) * 65 + n]);
        o.z = pk2(tile[(kc + 4) * 65 + n], tile[(kc + 5) * 65 + n]); o.w = pk2(tile[(kc + 6) * 65 + n], tile[(kc + 7) * 65 + n]);
        *(u32x4*)(dst + (size_t)(n0 + n) * Kd + k0 + kc) = o;
    }
    __syncthreads();
}
__device__ __forceinline__ void cvt_stream(const float* src, bf16_t* dst, size_t n8, size_t gtid, size_t gthreads) {
    for (size_t i = gtid; i < n8; i += gthreads) {
        const f32x4 a = *(const f32x4*)(src + i * 8), b = *(const f32x4*)(src + i * 8 + 4);
        u32x4 o; o.x = pk2(a.x, a.y); o.y = pk2(a.z, a.w); o.z = pk2(b.x, b.y); o.w = pk2(b.z, b.w);
        *(u32x4*)(dst + i * 8) = o;
    }
}
__device__ void phase_prep(const Args& a, char* lds) {
    const int tid = threadIdx.x, lane = tid & 63, wid = tid >> 6;
    float* tile = (float*)lds;
    unsigned char* ws = a.ws;
    constexpr int I_MOD = 192;
    constexpr int I_WIN0 = (1024 / 64) * (2048 / 64), I_WOUT0 = (1024 / 64) * (1024 / 64), I_WIN1 = (1024 / 64) * (2560 / 64), I_WOUT1 = (1280 / 64) * (1024 / 64);
    constexpr int I_WQ = 2 * (1024 / 64) * (2048 / 64), I_WAX = 40 * 4;
    constexpr int NIT = I_MOD + I_WIN0 + I_WOUT0 + I_WIN1 + I_WOUT1 + I_WQ + I_WAX;
    for (int it = blockIdx.x; it < NIT; it += gridDim.x) {
        int r = it;
        if (r < I_MOD) {
            const int l = r / 96, n0 = (r % 96) * 64;
            const float* W = a.in[4] + (size_t)l * D * 6144;
            float s0 = 0.f, s1 = 0.f, s2 = 0.f;
            for (int k = wid * 128; k < wid * 128 + 128; ++k) {
                const float w = W[(size_t)k * 6144 + n0 + lane];
                const float c0 = a.in[1][k], c1 = a.in[1][D + k], c2 = a.in[3][k];
                s0 += c0 * sigmoidf_(c0) * w; s1 += c1 * sigmoidf_(c1) * w; s2 += c2 * sigmoidf_(c2) * w;
            }
            tile[(wid * 3 + 0) * 64 + lane] = s0; tile[(wid * 3 + 1) * 64 + lane] = s1; tile[(wid * 3 + 2) * 64 + lane] = s2;
            __syncthreads();
            if (tid < 192) {
                const int v = tid / 64, ln = tid & 63; float s = a.in[5][(size_t)l * 6144 + n0 + ln];
                for (int w = 0; w < 8; ++w) s += tile[(w * 3 + v) * 64 + ln];
                ((float*)(ws + WS_MODV))[(size_t)(l * 3 + v) * 6144 + n0 + ln] = s;
            }
            __syncthreads();
            continue;
        }
        r -= I_MOD;
        if (r < I_WIN0) { const int nb = r % 32, kb = r / 32; transpose_item(a.in[8], 2048, (bf16_t*)(ws + WS_WIN0), 1024, nb * 64, kb * 64, 1024, 1792, tile); continue; }
        r -= I_WIN0;
        if (r < I_WOUT0) { const int nb = r % 16, kb = r / 16; transpose_item(a.in[14], 1024, (bf16_t*)(ws + WS_WOUT0), 1024, nb * 64, kb * 64, 0, 0, tile); continue; }
        r -= I_WOUT0;
        if (r < I_WIN1) { const int nb = r % 40, kb = r / 40; transpose_item(a.in[15], 2560, (bf16_t*)(ws + WS_WIN1), 1024, nb * 64, kb * 64, 0, 0, tile); continue; }
        r -= I_WIN1;
        if (r < I_WOUT1) { const int nb = r % 16, kb = r / 16; transpose_item(a.in[23], 1024, (bf16_t*)(ws + WS_WOUT1), 1280, nb * 64, kb * 64, 0, 0, tile); continue; }
        r -= I_WOUT1;
        if (r < I_WQ) { const int l = r / 512, q = r % 512, nb = q % 32, kb = q / 32;
            transpose_item(a.in[24] + (size_t)l * 1024 * 2048, 2048, (bf16_t*)(ws + WS_WQ) + (size_t)l * 2048 * 1024, 1024, nb * 64, kb * 64, 0, 0, tile); continue; }
        r -= I_WQ;
        { const int m = r / 4, q = r % 4, nb = q % 2, kb = q / 2;
            const int which = m / 20, dh = m % 20;
            const float* src = a.in[which == 0 ? 18 : 20] + (size_t)dh * 128 * 128;
            bf16_t* dst = (bf16_t*)(ws + (which == 0 ? WS_WAT : WS_WXT)) + (size_t)dh * 128 * 128;
            transpose_item(src, 128, dst, 128, nb * 64, kb * 64, 0, 0, tile);
        }
    }
    const size_t gtid = (size_t)blockIdx.x * NTHR + tid, gthreads = (size_t)gridDim.x * NTHR;
    cvt_stream(a.in[25], (bf16_t*)(ws + WS_KEYS), (size_t)2 * 8 * 2 * 128 * 128 / 8, gtid, gthreads);
    cvt_stream(a.in[10], (bf16_t*)(ws + WS_GWS), (size_t)4 * 128 * 128 / 8, gtid, gthreads);
    cvt_stream(a.in[26], (bf16_t*)(ws + WS_PU), (size_t)2 * NEXP * D / 8, gtid, gthreads);
    cvt_stream(a.in[27], (bf16_t*)(ws + WS_PV), (size_t)2 * NEXP * D / 8, gtid, gthreads);
    for (size_t i = gtid; i < 128 * 32; i += gthreads) {
        const int pos = (int)(i / 32), f = (int)(i % 32);
        const float inv = powf(10000.f, -(float)f / 32.f); const float ang = (float)pos * inv;
        float* R = (float*)(ws + WS_ROPE); R[i * 2] = cosf(ang); R[i * 2 + 1] = sinf(ang);
    }
}

__device__ __forceinline__ void norm_row_store(const f32x4 (&v)[4], const float* g, const float* sh, const float* sc, bf16_t* orow, int lane) {
    float s = 0.f;
#pragma unroll
    for (int j = 0; j < 4; ++j) s += (v[j].x * v[j].x + v[j].y * v[j].y) + (v[j].z * v[j].z + v[j].w * v[j].w);
    const float rinv = rsqrtf(wave_sum(s) * (1.f / D) + EPS);
#pragma unroll
    for (int j = 0; j < 4; ++j) {
        const int c = j * 256 + lane * 4;
        const f32x4 gg = *(const f32x4*)(g + c), s1 = *(const f32x4*)(sh + c), s2 = *(const f32x4*)(sc + c);
        const float o0 = v[j].x * rinv * gg.x * (1.f + s2.x) + s1.x, o1 = v[j].y * rinv * gg.y * (1.f + s2.y) + s1.y;
        const float o2 = v[j].z * rinv * gg.z * (1.f + s2.z) + s1.z, o3 = v[j].w * rinv * gg.w * (1.f + s2.w) + s1.w;
        u32x2 w; w.x = pk2(o0, o1); w.y = pk2(o2, o3);
        *(u32x2*)(orow + c) = w;
    }
}
__device__ void phase_norm(const Args& a, int layer, int src_mode, const float* gain, int which_sh, int which_sc, bool latent_only) {
    const int lane = threadIdx.x & 63, gw = blockIdx.x * NWAVE + (threadIdx.x >> 6), ngw = gridDim.x * NWAVE;
    bf16_t* H = (bf16_t*)(a.ws + WS_H);
    const float* X1 = (const float*)(a.ws + WS_X1);
    for (int g = gw; g < MTOT; g += ngw) {
        const int var = row_variant(g);
        if (latent_only && var == 2) continue;
        const float* xr = src_mode == 0 ? row_src(a, g) : X1 + (size_t)g * D;
        f32x4 v[4];
#pragma unroll
        for (int j = 0; j < 4; ++j) v[j] = *(const f32x4*)(xr + j * 256 + lane * 4);
        norm_row_store(v, gain, modv(a, layer, var, which_sh), modv(a, layer, var, which_sc), H + (size_t)g * D, lane);
    }
}

constexpr int CS_LD = 132;
__device__ __forceinline__ void gemm_tile128(const bf16_t* A, int lda, const bf16_t* Bt, int ldb, int K, float* Cs) {
    const int tid = threadIdx.x, lane = tid & 63, wid = tid >> 6, r = lane & 31, h = lane >> 5, wr = wid >> 1, wc = wid & 1;
    const bf16_t* ap = A + (size_t)(wr * 32 + r) * lda + 8 * h;
    const bf16_t* bp0 = Bt + (size_t)(wc * 64 + r) * ldb + 8 * h;
    const bf16_t* bp1 = bp0 + (size_t)32 * ldb;
    f32x16 acc0 = {}, acc1 = {};
#pragma unroll 4
    for (int k = 0; k < K; k += 16) {
        const bf16x8 av = *(const bf16x8*)(ap + k), b0 = *(const bf16x8*)(bp0 + k), b1 = *(const bf16x8*)(bp1 + k);
        acc0 = __builtin_amdgcn_mfma_f32_32x32x16_bf16(av, b0, acc0, 0, 0, 0);
        acc1 = __builtin_amdgcn_mfma_f32_32x32x16_bf16(av, b1, acc1, 0, 0, 0);
    }
#pragma unroll
    for (int i = 0; i < 16; ++i) {
        const int row = wr * 32 + (i & 3) + 8 * (i >> 2) + 4 * h;
        Cs[row * CS_LD + wc * 64 + r] = acc0[i];
        Cs[row * CS_LD + wc * 64 + 32 + r] = acc1[i];
    }
}

__device__ void phase_inproj0(const Args& a, char* lds) {
    float* Cs = (float*)lds;
    const int tid = threadIdx.x;
    unsigned char* ws = a.ws;
    const bf16_t* H = (const bf16_t*)(ws + WS_H); const bf16_t* W = (const bf16_t*)(ws + WS_WIN0);
    const float* rope = (const float*)(ws + WS_ROPE);
    const int NU = (MTOT / 128) * 16;
    for (int u = blockIdx.x; u < NU; u += gridDim.x) {
        const int rt = u / 16, ct = u % 16, row0 = rt * 128, col0 = ct * 128;
        gemm_tile128(H + (size_t)row0 * D, D, W + (size_t)col0 * D, D, D, Cs);
        __syncthreads();
        const int rr = tid >> 2, q4 = tid & 3, g = row0 + rr;
        float* crow = Cs + rr * CS_LD + q4 * 32;
        if (ct < 4) {
            bf16_t* o = (bf16_t*)(ws + WS_U) + (size_t)g * 512 + col0 + q4 * 32;
#pragma unroll
            for (int c = 0; c < 32; c += 2) *(unsigned*)(o + c) = pk2(gelu_t(crow[c]), gelu_t(crow[c + 1]));
        } else if (ct < 8) {
            const int gg = ct - 4; float ss = 0.f;
#pragma unroll
            for (int c = 0; c < 32; ++c) { const float v = gelu_t(crow[c]); crow[c] = v; ss += v * v; }
            ss += __shfl_xor(ss, 1); ss += __shfl_xor(ss, 2);
            const float rinv = rsqrtf(ss * (1.f / 128.f) + EPS);
            const float* gn = a.in[9] + gg * 128 + q4 * 32;
            bf16_t* o = (bf16_t*)(ws + WS_VV) + (size_t)g * 512 + gg * 128 + q4 * 32;
#pragma unroll
            for (int c = 0; c < 32; c += 2) *(unsigned*)(o + c) = pk2(crow[c] * rinv * gn[c], crow[c + 1] * rinv * gn[c + 1]);
        } else if (ct < 14) {
            const bool isq = ct < 12; const int hh = isq ? ct - 8 : ct - 12;
            float ss = 0.f;
#pragma unroll
            for (int c = 0; c < 32; ++c) ss += crow[c] * crow[c];
            ss += __shfl_xor(ss, 1); ss += __shfl_xor(ss, 2);
            const float rinv = rsqrtf(ss * (1.f / 128.f) + EPS);
            const float* gn = a.in[isq ? 12 : 13];
            const int b = g / RPB, i = g - b * RPB; const bool lat = i >= CTXL; const int t = i - CTXL;
            bf16_t* o = (isq ? (bf16_t*)(ws + WS_Q) + (size_t)g * 512 : (bf16_t*)(ws + WS_K) + (size_t)g * 256) + hh * 128 + q4 * 32;
#pragma unroll
            for (int c8 = 0; c8 < 32; c8 += 8) {
                float y[8];
#pragma unroll
                for (int e = 0; e < 8; ++e) { const int j = q4 * 32 + c8 + e; y[e] = crow[c8 + e] * rinv * gn[sigma_head(j)]; }
                if (lat) {
                    const int grp = (q4 * 32 + c8) >> 3, ax = grp >> 3; const int pos = ax == 0 ? (t >> 6) : (t & 63);
#pragma unroll
                    for (int e = 0; e < 4; ++e) { const int f = (grp & 7) * 4 + e; const float cs = rope[(pos * 32 + f) * 2], sn = rope[(pos * 32 + f) * 2 + 1];
                        const float x1 = y[e], x2 = y[e + 4]; y[e] = x1 * cs - x2 * sn; y[e + 4] = x2 * cs + x1 * sn; }
                }
                u32x4 w; w.x = pk2(y[0], y[1]); w.y = pk2(y[2], y[3]); w.z = pk2(y[4], y[5]); w.w = pk2(y[6], y[7]);
                *(u32x4*)(o + c8) = w;
            }
        } else {
            bf16_t* o = (bf16_t*)(ws + WS_V) + (size_t)g * 256 + (ct - 14) * 128 + q4 * 32;
#pragma unroll
            for (int c = 0; c < 32; c += 2) *(unsigned*)(o + c) = pk2(crow[c], crow[c + 1]);
        }
        __syncthreads();
    }
}

__device__ void phase_gmlp(const Args& a, char* lds) {
    const int tid = threadIdx.x;
    unsigned char* ws = a.ws;
    float* vt = (float*)lds;
    const bf16_t* VV = (const bf16_t*)(ws + WS_VV); const bf16_t* U = (const bf16_t*)(ws + WS_U); bf16_t* AO = (bf16_t*)(ws + WS_AO);
    const int NU = (MTOT / 128) * 4;
    for (int u = blockIdx.x; u < NU; u += gridDim.x) {
        const int ch = u / 4, g = u % 4, row0 = ch * 128;
        for (int i = tid; i < 128 * 128; i += NTHR) { const int q = i >> 7, c = i & 127; vt[i] = bf2f(VV[(size_t)(row0 + q) * 512 + g * 128 + c]); }
        __syncthreads();
        const int c = tid & 127, pq = tid >> 7;
        const float* wsg = a.in[10] + (size_t)g * 128 * 128;
        for (int pp = 0; pp < 32; ++pp) {
            const int p = pq * 32 + pp; float s = 0.f;
            for (int q = 0; q < 128; ++q) s += wsg[p * 128 + q] * vt[q * 128 + c];
            s += a.in[11][g * 128 + p];
            const float uu = bf2f(U[(size_t)(row0 + p) * 512 + g * 128 + c]);
            AO[(size_t)(row0 + p) * 1024 + g * 128 + c] = (bf16_t)f2bf(uu * s);
        }
        __syncthreads();
    }
}

__device__ void phase_attn_naive(const Args& a, char* lds) {
    const int tid = threadIdx.x;
    unsigned char* ws = a.ws;
    float* Ks = (float*)lds;
    float* Vs = Ks + 32 * 128;
    float* part = Vs + 32 * 128;
    const bf16_t* Q = (const bf16_t*)(ws + WS_Q); const bf16_t* Kb = (const bf16_t*)(ws + WS_K); const bf16_t* Vb = (const bf16_t*)(ws + WS_V);
    bf16_t* AO = (bf16_t*)(ws + WS_AO);
    const int NU = 512 + 16;
    for (int u = blockIdx.x; u < NU; u += gridDim.x) {
        int b, h, qrow0, nkeys;
        if (u < 512) { b = u / 256; h = (u / 64) % 4; qrow0 = b * RPB + CTXL + (u % 64) * 128; nkeys = RPB; }
        else { const int v = u - 512; b = v / 8; h = (v / 2) % 4; qrow0 = b * RPB + (v % 2) * 128; nkeys = CTXL; }
        const int kvh = h >> 1, krow0 = b * RPB;
        const int qi = tid & 127, qt = tid >> 7;
        float q[32], o[32];
        {
            const bf16_t* qp = Q + (size_t)(qrow0 + qi) * 512 + h * 128 + qt * 32;
#pragma unroll
            for (int d = 0; d < 32; d += 2) { const unsigned w = *(const unsigned*)(qp + d); q[d] = bflo(w) * 0.08838834764831845f; q[d + 1] = bfhi(w) * 0.08838834764831845f; }
#pragma unroll
            for (int d = 0; d < 32; ++d) o[d] = 0.f;
        }
        float m = -1e30f, l = 0.f;
        for (int k0 = 0; k0 < nkeys; k0 += 32) {
            {
                const int key = tid >> 4, cs = (tid & 15) * 8;
                const u32x4 kw = *(const u32x4*)(Kb + (size_t)(krow0 + k0 + key) * 256 + kvh * 128 + cs);
                const u32x4 vw = *(const u32x4*)(Vb + (size_t)(krow0 + k0 + key) * 256 + kvh * 128 + cs);
                float* kd = Ks + key * 128 + cs; float* vd = Vs + key * 128 + cs;
                kd[0] = bflo(kw.x); kd[1] = bfhi(kw.x); kd[2] = bflo(kw.y); kd[3] = bfhi(kw.y); kd[4] = bflo(kw.z); kd[5] = bfhi(kw.z); kd[6] = bflo(kw.w); kd[7] = bfhi(kw.w);
                vd[0] = bflo(vw.x); vd[1] = bfhi(vw.x); vd[2] = bflo(vw.y); vd[3] = bfhi(vw.y); vd[4] = bflo(vw.z); vd[5] = bfhi(vw.z); vd[6] = bflo(vw.w); vd[7] = bfhi(vw.w);
            }
            __syncthreads();
#pragma unroll 2
            for (int j = 0; j < 32; ++j) {
                const float* kr = Ks + j * 128 + qt * 32; float acc = 0.f;
#pragma unroll
                for (int d = 0; d < 32; d += 4) { const f32x4 kv = *(const f32x4*)(kr + d); acc += q[d] * kv.x + q[d + 1] * kv.y + q[d + 2] * kv.z + q[d + 3] * kv.w; }
                part[(qt * 32 + j) * 128 + qi] = acc;
            }
            __syncthreads();
            float mx = m;
#pragma unroll 4
            for (int j = 0; j < 32; ++j) { const float sj = (part[(0 * 32 + j) * 128 + qi] + part[(1 * 32 + j) * 128 + qi]) + (part[(2 * 32 + j) * 128 + qi] + part[(3 * 32 + j) * 128 + qi]); mx = fmaxf(mx, sj); }
            const float alpha = __expf(m - mx); m = mx; float ps = 0.f;
#pragma unroll
            for (int d = 0; d < 32; ++d) o[d] *= alpha;
#pragma unroll 2
            for (int j = 0; j < 32; ++j) {
                const float sj = (part[(0 * 32 + j) * 128 + qi] + part[(1 * 32 + j) * 128 + qi]) + (part[(2 * 32 + j) * 128 + qi] + part[(3 * 32 + j) * 128 + qi]);
                const float pj = __expf(sj - mx); ps += pj;
                const float* vr = Vs + j * 128 + qt * 32;
#pragma unroll
                for (int d = 0; d < 32; d += 4) { const f32x4 vv = *(const f32x4*)(vr + d); o[d] += pj * vv.x; o[d + 1] += pj * vv.y; o[d + 2] += pj * vv.z; o[d + 3] += pj * vv.w; }
            }
            l = l * alpha + ps;
            __syncthreads();
        }
        const float rl = 1.f / l;
        bf16_t* op = AO + (size_t)(qrow0 + qi) * 1024 + 512 + h * 128 + qt * 32;
#pragma unroll
        for (int d = 0; d < 32; d += 2) *(unsigned*)(op + d) = pk2(o[d] * rl, o[d + 1] * rl);
    }
}

namespace fa {
typedef short s16x4 __attribute__((ext_vector_type(4)));
constexpr int QBLK = 32, KVBLK = 64, LDQ = 512, LDK = 256, LDO = 1024;
constexpr float SCALE = 0.088388347648318440f, THR = 8.f;
constexpr size_t SHM_V = KVBLK * 128 * 2, SHM_K = KVBLK * 128 * 2, SHM_ATTN = 2 * SHM_V + 2 * SHM_K + NWAVE * 64 * 4;
#define KSWZ(row, colB) ((row) * 256 + ((colB) ^ (((row) & 7) << 4)))
#define SBAR() __builtin_amdgcn_sched_barrier(0)
__device__ __forceinline__ int crow(int r, int hi) { return (r & 3) + 8 * (r >> 2) + 4 * hi; }
__device__ __forceinline__ unsigned cvtpk(float lo, float hi) { unsigned r; asm volatile("v_cvt_pk_bf16_f32 %0, %1, %2" : "=v"(r) : "v"(lo), "v"(hi)); return r; }
__device__ __forceinline__ void partialSM(f32x16& p0, f32x16& p1, float& m_reg, float& mn, float& alpha) {
  constexpr float C = SCALE * 1.4426950408889634f;
  float pmax = p0[0]; for (int r = 1; r < 16; ++r) pmax = fmaxf(pmax, p0[r]); for (int r = 0; r < 16; ++r) pmax = fmaxf(pmax, p1[r]);
  { auto rr = __builtin_amdgcn_permlane32_swap(__float_as_uint(pmax), __float_as_uint(pmax), false, false);
    pmax = fmaxf(__uint_as_float(rr[0]), __uint_as_float(rr[1])); }
  if (__builtin_expect(__all(pmax - m_reg <= THR / SCALE), 1)) { mn = m_reg; alpha = 1.f; }
  else { mn = fmaxf(m_reg, pmax); alpha = __builtin_amdgcn_exp2f((m_reg - mn) * C); m_reg = mn; }
  float mnC = -mn * C;
  for (int r = 0; r < 16; ++r) p0[r] = fmaf(p0[r], C, mnC); for (int r = 0; r < 16; ++r) p1[r] = fmaf(p1[r], C, mnC);
  for (int r = 0; r < 16; ++r) p0[r] = __builtin_amdgcn_exp2f(p0[r]);
}
__device__ __forceinline__ void finishSM(f32x16& p0, f32x16& p1, float alpha, float& l_reg, bf16x8& pa0, bf16x8& pa1, bf16x8& pa2, bf16x8& pa3) {
  for (int r = 0; r < 16; ++r) p1[r] = __builtin_amdgcn_exp2f(p1[r]);
  float ps = 0; for (int r = 0; r < 16; ++r) ps += p0[r]; for (int r = 0; r < 16; ++r) ps += p1[r];
  { auto rr = __builtin_amdgcn_permlane32_swap(__float_as_uint(ps), __float_as_uint(ps), false, false);
    ps = __uint_as_float(rr[0]) + __uint_as_float(rr[1]); }
  l_reg = l_reg * alpha + ps;
#define PK4(P, BASE, OUT) do { unsigned a0 = cvtpk(P[BASE + 0], P[BASE + 1]), a1 = cvtpk(P[BASE + 2], P[BASE + 3]);   \
    unsigned b0 = cvtpk(P[BASE + 4], P[BASE + 5]), b1 = cvtpk(P[BASE + 6], P[BASE + 7]);                              \
    auto r0 = __builtin_amdgcn_permlane32_swap(a0, b0, false, false); auto r1 = __builtin_amdgcn_permlane32_swap(a1, b1, false, false); \
    u32x4 w = {r0[0], r1[0], r0[1], r1[1]}; OUT = *reinterpret_cast<bf16x8*>(&w); } while (0)
  PK4(p0, 0, pa0); PK4(p0, 8, pa1); PK4(p1, 0, pa2); PK4(p1, 8, pa3);
#undef PK4
}
__device__ __forceinline__ void qkt(f32x16& p0, f32x16& p1, const bf16_t* Ks, const bf16x8* qr, int r32, int hi) {
  p0 = f32x16{}; p1 = f32x16{};
  for (int d0 = 0; d0 < 8; ++d0) { int cb = (d0 * 16 + hi * 8) * 2;
    bf16x8 b0 = *reinterpret_cast<const bf16x8*>((const char*)Ks + KSWZ(r32, cb));
    bf16x8 b1 = *reinterpret_cast<const bf16x8*>((const char*)Ks + KSWZ(32 + r32, cb));
    p0 = __builtin_amdgcn_mfma_f32_32x32x16_bf16(b0, qr[d0], p0, 0, 0, 0);
    p1 = __builtin_amdgcn_mfma_f32_32x32x16_bf16(b1, qr[d0], p1, 0, 0, 0); }
}
__device__ __forceinline__ int v_st(int k, int c) { const int kk = (k & ~0xC) | ((k & 4) << 1) | ((k & 8) >> 1); return ((kk >> 3) * 4 + (c >> 5)) * 512 + ((kk & 7) * 32 + (c & 31)) * 2; }
__device__ __forceinline__ int v_rd_base(int lane) { return ((lane & 3) << 3) | (((lane >> 2) & 3) << 6) | (((lane >> 4) & 1) << 5) | (((lane >> 5) & 1) << 8); }
constexpr int v_rd_off(int d0, int ks, int half) { return d0 * 512 + ks * 4096 + half * 2048; }
template <int OFF> __device__ __forceinline__ s16x4 tr_read(int vb) {
  s16x4 r; asm volatile("ds_read_b64_tr_b16 %0, %1 offset:%2" : "=&v"(r) : "v"(vb), "i"(OFF) : "memory"); return r;
}
template <int D0> __device__ __forceinline__ void pv_one(f32x16& od, int vb, bf16x8 pa0, bf16x8 pa1, bf16x8 pa2, bf16x8 pa3) {
  const s16x4 l0 = tr_read<v_rd_off(D0, 0, 0)>(vb), h0 = tr_read<v_rd_off(D0, 0, 1)>(vb), l1 = tr_read<v_rd_off(D0, 1, 0)>(vb), h1 = tr_read<v_rd_off(D0, 1, 1)>(vb);
  const s16x4 l2 = tr_read<v_rd_off(D0, 2, 0)>(vb), h2 = tr_read<v_rd_off(D0, 2, 1)>(vb), l3 = tr_read<v_rd_off(D0, 3, 0)>(vb), h3 = tr_read<v_rd_off(D0, 3, 1)>(vb);
  asm volatile("s_waitcnt lgkmcnt(0)" ::: "memory"); SBAR();
#define PK(L, H) (bf16x8){L[0], L[1], L[2], L[3], H[0], H[1], H[2], H[3]}
  od = __builtin_amdgcn_mfma_f32_32x32x16_bf16(pa0, PK(l0, h0), od, 0, 0, 0);
  od = __builtin_amdgcn_mfma_f32_32x32x16_bf16(pa1, PK(l1, h1), od, 0, 0, 0);
  od = __builtin_amdgcn_mfma_f32_32x32x16_bf16(pa2, PK(l2, h2), od, 0, 0, 0);
  od = __builtin_amdgcn_mfma_f32_32x32x16_bf16(pa3, PK(l3, h3), od, 0, 0, 0);
#undef PK
}
__device__ __forceinline__ void pv_d0(f32x16* o, int vb, bf16x8 pa0, bf16x8 pa1, bf16x8 pa2, bf16x8 pa3) {
  pv_one<0>(o[0], vb, pa0, pa1, pa2, pa3); pv_one<1>(o[1], vb, pa0, pa1, pa2, pa3); pv_one<2>(o[2], vb, pa0, pa1, pa2, pa3); pv_one<3>(o[3], vb, pa0, pa1, pa2, pa3);
}
__device__ __forceinline__ void attn_dense_body(const bf16_t* __restrict__ Qb, const bf16_t* __restrict__ Kh, const bf16_t* __restrict__ Vh,
                                                bf16_t* __restrict__ Ob, int seq, char* lds) {
  const int tid = threadIdx.x, wid = tid >> 6, lane = tid & 63, r32 = lane & 31, hi = lane >> 5;
  bf16_t* V_lds = (bf16_t*)lds; bf16_t* K_lds = (bf16_t*)(lds + 2 * SHM_V);
  float* ws = (float*)(lds + 2 * SHM_V + 2 * SHM_K) + wid * 64; float* li_l = ws; float* al_l = ws + 32;
  float m_reg = -1e30f, l_reg = 0; f32x16 o[4] = {}; bf16x8 qr[8];
  const bf16_t* Qw = Qb + (long)(wid * QBLK + r32) * LDQ + hi * 8;
#pragma unroll
  for (int d0 = 0; d0 < 8; ++d0) qr[d0] = *reinterpret_cast<const bf16x8*>(Qw + d0 * 16);
  const int sr = tid >> 4, sc = (tid & 15) * 8, vst0 = v_st(sr, sc), vst1 = v_st(32 + sr, sc);
  const int vb0 = (int)(uintptr_t)V_lds + v_rd_base(lane);
  struct { bf16x8 vs0, vs1, ks0, ks1; } sr_[2];
#define SLOAD(i, k0) do { sr_[i].vs0 = *reinterpret_cast<const bf16x8*>(&Vh[(long)((k0) + sr) * LDK + sc]); sr_[i].vs1 = *reinterpret_cast<const bf16x8*>(&Vh[(long)((k0) + 32 + sr) * LDK + sc]); \
    sr_[i].ks0 = *reinterpret_cast<const bf16x8*>(&Kh[(long)((k0) + sr) * LDK + sc]); sr_[i].ks1 = *reinterpret_cast<const bf16x8*>(&Kh[(long)((k0) + 32 + sr) * LDK + sc]); } while (0)
#define SWRITE(b, i) do { *(bf16x8*)((char*)V_lds + (b) * SHM_V + vst0) = sr_[i].vs0;          \
    *(bf16x8*)((char*)V_lds + (b) * SHM_V + vst1) = sr_[i].vs1; int kc = sc * 2;               \
    *(bf16x8*)((char*)K_lds + (b) * SHM_K + KSWZ(sr, kc)) = sr_[i].ks0;                       \
    *(bf16x8*)((char*)K_lds + (b) * SHM_K + KSWZ(32 + sr, kc)) = sr_[i].ks1; } while (0)
#define SWAIT() asm volatile("s_waitcnt vmcnt(4)" ::: "memory")
#define RESC(a) do { if (__any((a) < 1.f)) { if (hi == 0) al_l[r32] = (a); asm volatile("s_waitcnt lgkmcnt(0)" ::: "memory"); \
    for (int d = 0; d < 4; ++d) for (int r = 0; r < 16; ++r) o[d][r] *= al_l[crow(r, hi)]; } } while (0)
  f32x16 pA0, pA1, pB0, pB1; float mnA, mnB, alA, alB; bf16x8 pa0, pa1, pa2, pa3; const int NT = seq / KVBLK;
  constexpr int SE = 0, SO = 1;
  SLOAD(SE, 0); asm volatile("s_waitcnt vmcnt(0)" ::: "memory"); SWRITE(0, SE); __syncthreads();
  qkt(pA0, pA1, K_lds, qr, r32, hi); partialSM(pA0, pA1, m_reg, mnA, alA);
  SLOAD(SO, KVBLK); if (2 < NT) SLOAD(SE, 2 * KVBLK);
  SWAIT(); SWRITE(1, SO); __syncthreads();
  for (int j = 1; j + 1 < NT; j += 2) {
    SBAR(); qkt(pB0, pB1, (bf16_t*)((char*)K_lds + SHM_K), qr, r32, hi);
    finishSM(pA0, pA1, alA, l_reg, pa0, pa1, pa2, pa3); SBAR();
    SLOAD(SO, (j + 2) * KVBLK); SBAR();
    pv_d0(o, vb0, pa0, pa1, pa2, pa3); partialSM(pB0, pB1, m_reg, mnB, alB);
    __syncthreads(); SWAIT(); SWRITE(0, SE);
    RESC(alB); __syncthreads();
    SBAR(); qkt(pA0, pA1, K_lds, qr, r32, hi);
    finishSM(pB0, pB1, alB, l_reg, pa0, pa1, pa2, pa3); SBAR();
    if (j + 3 < NT) SLOAD(SE, (j + 3) * KVBLK); SBAR();
    pv_d0(o, vb0 + (int)SHM_V, pa0, pa1, pa2, pa3); partialSM(pA0, pA1, m_reg, mnA, alA);
    __syncthreads(); SWAIT(); SWRITE(1, SO);
    RESC(alA); __syncthreads();
  }
  SBAR(); qkt(pB0, pB1, (bf16_t*)((char*)K_lds + SHM_K), qr, r32, hi);
  finishSM(pA0, pA1, alA, l_reg, pa0, pa1, pa2, pa3); SBAR();
  pv_d0(o, vb0, pa0, pa1, pa2, pa3); partialSM(pB0, pB1, m_reg, mnB, alB);
  __syncthreads(); RESC(alB);
  finishSM(pB0, pB1, alB, l_reg, pa0, pa1, pa2, pa3); SBAR();
  pv_d0(o, vb0 + (int)SHM_V, pa0, pa1, pa2, pa3);
  if (hi == 0) li_l[r32] = l_reg; asm volatile("s_waitcnt lgkmcnt(0)" ::: "memory");
  float rli[16];
#pragma unroll
  for (int r = 0; r < 16; ++r) rli[r] = __builtin_amdgcn_rcpf(li_l[crow(r, hi)]);
  bf16_t* Ow = Ob + (long)(wid * QBLK) * LDO;
#pragma unroll
  for (int r = 0; r < 16; ++r) { int orow = crow(r, hi);
    for (int d0 = 0; d0 < 4; ++d0) Ow[(long)orow * LDO + d0 * 32 + r32] = (bf16_t)f2bf(o[d0][r] * rli[r]); }
  __syncthreads();
#undef SLOAD
#undef SWRITE
#undef SWAIT
#undef RESC
}
#undef KSWZ
#undef SBAR
}

__device__ __forceinline__ void phase_attn(const Args& a, char* lds) {
    unsigned char* ws = a.ws;
    const bf16_t* Q = (const bf16_t*)(ws + WS_Q); const bf16_t* Kb = (const bf16_t*)(ws + WS_K); const bf16_t* Vb = (const bf16_t*)(ws + WS_V);
    bf16_t* AO = (bf16_t*)(ws + WS_AO);
    const int NU = 256 + 8;
    for (int u = blockIdx.x; u < NU; u += gridDim.x) {
        int b, h, qrow0, nkeys;
        if (u < 256) { b = u / 128; h = (u / 32) % 4; qrow0 = b * RPB + CTXL + (u % 32) * 256; nkeys = RPB; }
        else { const int v = u - 256; b = v / 4; h = v % 4; qrow0 = b * RPB; nkeys = CTXL; }
        const int kvh = h >> 1; const size_t krow0 = (size_t)b * RPB;
        fa::attn_dense_body(Q + (size_t)qrow0 * 512 + h * 128, Kb + krow0 * 256 + kvh * 128, Vb + krow0 * 256 + kvh * 128, AO + (size_t)qrow0 * 1024 + 512 + h * 128, nkeys, lds);
    }
}

__device__ void phase_outproj(const Args& a, char* lds, const bf16_t* A, int K, const bf16_t* Bt, int layer, int which_gate, int base_mode, bool latent_only) {
    float* Cs = (float*)lds;
    const int tid = threadIdx.x;
    float* X1 = (float*)(a.ws + WS_X1);
    const int NU = (MTOT / 128) * 8;
    for (int u = blockIdx.x; u < NU; u += gridDim.x) {
        const int rt = u / 8, ct = u % 8, row0 = rt * 128, col0 = ct * 128;
        if (latent_only && (rt % 66) < 2) continue;
        gemm_tile128(A + (size_t)row0 * K, K, Bt + (size_t)col0 * K, K, K, Cs);
        __syncthreads();
        const int rr = tid >> 2, q4 = tid & 3, g = row0 + rr;
        const float* crow = Cs + rr * CS_LD + q4 * 32;
        const float* gt = modv(a, layer, row_variant(g), which_gate) + col0 + q4 * 32;
        const float* base = (base_mode == 0 ? row_src(a, g) : X1 + (size_t)g * D) + col0 + q4 * 32;
        float* o = X1 + (size_t)g * D + col0 + q4 * 32;
#pragma unroll
        for (int c = 0; c < 32; c += 4) {
            const f32x4 bs = *(const f32x4*)(base + c), gv = *(const f32x4*)(gt + c);
            f32x4 r; r.x = bs.x + gv.x * crow[c]; r.y = bs.y + gv.y * crow[c + 1]; r.z = bs.z + gv.z * crow[c + 2]; r.w = bs.w + gv.w * crow[c + 3];
            *(f32x4*)(o + c) = r;
        }
        __syncthreads();
    }
}

__device__ void phase_peerq(const Args& a, char* lds, int layer, bool latent_only) {
    float* Cs = (float*)lds;
    const int tid = threadIdx.x;
    const bf16_t* H = (const bf16_t*)(a.ws + WS_H); const bf16_t* W = (const bf16_t*)(a.ws + WS_WQ) + (size_t)layer * 2048 * 1024;
    bf16_t* QP = (bf16_t*)(a.ws + WS_QP);
    const int NU = (MTOT / 128) * 16;
    for (int u = blockIdx.x; u < NU; u += gridDim.x) {
        const int rt = u / 16, ct = u % 16, row0 = rt * 128, col0 = ct * 128;
        if (latent_only && (rt % 66) < 2) continue;
        gemm_tile128(H + (size_t)row0 * D, D, W + (size_t)col0 * D, D, D, Cs);
        __syncthreads();
        const int rr = tid >> 2, q4 = tid & 3, g = row0 + rr;
        const float* crow = Cs + rr * CS_LD + q4 * 32;
        bf16_t* o = QP + (size_t)g * 2048 + col0 + q4 * 32;
#pragma unroll
        for (int c = 0; c < 32; c += 2) *(unsigned*)(o + c) = pk2(crow[c], crow[c + 1]);
        __syncthreads();
    }
}

__device__ __forceinline__ void wave_argmax(float& v, int& i) {
#pragma unroll
    for (int o = 1; o < 64; o <<= 1) {
        const float ov = __shfl_xor(v, o); const int oi = __shfl_xor(i, o);
        if (ov > v || (ov == v && oi < i)) { v = ov; i = oi; }
    }
}
__device__ void phase_peer_topk(const Args& a, int layer, bool latent_only) {
    const int lane = threadIdx.x & 63, gw = blockIdx.x * NWAVE + (threadIdx.x >> 6), ngw = gridDim.x * NWAVE;
    const bf16_t* QP = (const bf16_t*)(a.ws + WS_QP);
    const bf16_t* KEYS = (const bf16_t*)(a.ws + WS_KEYS) + (size_t)layer * 8 * 2 * 128 * 128;
    int* SELI = (int*)(a.ws + WS_SELI); float* SELG = (float*)(a.ws + WS_SELG);
    for (int it = gw; it < MTOT * 8; it += ngw) {
        const int g = it >> 3, h = it & 7;
        if (latent_only && row_variant(g) == 2) continue;
        float tv[2]; int ti[2];
#pragma unroll
        for (int s = 0; s < 2; ++s) {
            const bf16_t* qp = QP + (size_t)g * 2048 + h * 256 + s * 128;
            const bf16_t* k0p = KEYS + ((size_t)(h * 2 + s) * 128 + lane) * 128;
            const bf16_t* k1p = k0p + 64 * 128;
            float s0 = 0.f, s1 = 0.f;
#pragma unroll 4
            for (int d = 0; d < 128; d += 8) {
                const u32x4 qw = *(const u32x4*)(qp + d), ka = *(const u32x4*)(k0p + d), kb = *(const u32x4*)(k1p + d);
                s0 += bflo(qw.x) * bflo(ka.x) + bfhi(qw.x) * bfhi(ka.x) + bflo(qw.y) * bflo(ka.y) + bfhi(qw.y) * bfhi(ka.y)
                    + bflo(qw.z) * bflo(ka.z) + bfhi(qw.z) * bfhi(ka.z) + bflo(qw.w) * bflo(ka.w) + bfhi(qw.w) * bfhi(ka.w);
                s1 += bflo(qw.x) * bflo(kb.x) + bfhi(qw.x) * bfhi(kb.x) + bflo(qw.y) * bflo(kb.y) + bfhi(qw.y) * bfhi(kb.y)
                    + bflo(qw.z) * bflo(kb.z) + bfhi(qw.z) * bfhi(kb.z) + bflo(qw.w) * bflo(kb.w) + bfhi(qw.w) * bfhi(kb.w);
            }
            float myv = 0.f; int myi = 0;
            for (int r = 0; r < 16; ++r) {
                float bv; int bi;
                if (s0 >= s1) { bv = s0; bi = lane; } else { bv = s1; bi = lane + 64; }
                wave_argmax(bv, bi);
                if (bi == lane) s0 = -INFINITY; else if (bi == lane + 64) s1 = -INFINITY;
                if (lane == r) { myv = bv; myi = bi; }
            }
            tv[s] = myv; ti[s] = myi;
        }
        float cv[4]; int ci[4];
        {
            const float v0 = __shfl(tv[0], lane >> 2); const int i0 = __shfl(ti[0], lane >> 2);
#pragma unroll
            for (int m = 0; m < 4; ++m) { const int j = (lane & 3) * 4 + m; cv[m] = v0 + __shfl(tv[1], j); ci[m] = i0 * 128 + __shfl(ti[1], j); }
        }
        float topv = 0.f; int tope = 0;
        for (int r = 0; r < 16; ++r) {
            float bv = cv[0]; int bp = lane * 4;
#pragma unroll
            for (int m = 1; m < 4; ++m) if (cv[m] > bv) { bv = cv[m]; bp = lane * 4 + m; }
            wave_argmax(bv, bp);
            int be = 0;
#pragma unroll
            for (int m = 0; m < 4; ++m) if (bp == lane * 4 + m) { be = ci[m]; cv[m] = -INFINITY; }
            be = __shfl(be, bp >> 2);
            if (lane == r) { topv = bv; tope = be; }
        }
        const float mx = __shfl(topv, 0);
        float e = lane < 16 ? __expf(topv - mx) : 0.f;
        float sum = e;
#pragma unroll
        for (int o = 1; o < 16; o <<= 1) sum += __shfl_xor(sum, o);
        if (lane < 16) { SELI[(size_t)g * 128 + h * 16 + lane] = tope; SELG[(size_t)g * 128 + h * 16 + lane] = e / sum; }
    }
}

__device__ void phase_peer_gather(const Args& a, int layer, int mode) {
    const int lane = threadIdx.x & 63, gw = blockIdx.x * NWAVE + (threadIdx.x >> 6), ngw = gridDim.x * NWAVE;
    unsigned char* ws = a.ws;
    bf16_t* H = (bf16_t*)(ws + WS_H); float* X1 = (float*)(ws + WS_X1);
    const bf16_t* PU = (const bf16_t*)(ws + WS_PU) + (size_t)layer * NEXP * D; const bf16_t* PV = (const bf16_t*)(ws + WS_PV) + (size_t)layer * NEXP * D;
    const int* SELI = (const int*)(ws + WS_SELI); const float* SELG = (const float*)(ws + WS_SELG);
    for (int g = gw; g < MTOT; g += ngw) {
        const int var = row_variant(g);
        if (mode == 1 && var == 2) continue;
        float hp[16], acc[16];
        {
            const u32x4 w0 = *(const u32x4*)(H + (size_t)g * D + lane * 16), w1 = *(const u32x4*)(H + (size_t)g * D + lane * 16 + 8);
            hp[0] = bflo(w0.x); hp[1] = bfhi(w0.x); hp[2] = bflo(w0.y); hp[3] = bfhi(w0.y); hp[4] = bflo(w0.z); hp[5] = bfhi(w0.z); hp[6] = bflo(w0.w); hp[7] = bfhi(w0.w);
            hp[8] = bflo(w1.x); hp[9] = bfhi(w1.x); hp[10] = bflo(w1.y); hp[11] = bfhi(w1.y); hp[12] = bflo(w1.z); hp[13] = bfhi(w1.z); hp[14] = bflo(w1.w); hp[15] = bfhi(w1.w);
#pragma unroll
            for (int d = 0; d < 16; ++d) acc[d] = 0.f;
        }
        const int myi0 = SELI[(size_t)g * 128 + lane], myi1 = SELI[(size_t)g * 128 + 64 + lane];
        const float myg0 = SELG[(size_t)g * 128 + lane], myg1 = SELG[(size_t)g * 128 + 64 + lane];
        for (int e = 0; e < 128; ++e) {
            const int ei = e < 64 ? __shfl(myi0, e) : __shfl(myi1, e - 64);
            const float eg = e < 64 ? __shfl(myg0, e) : __shfl(myg1, e - 64);
            const bf16_t* up = PU + (size_t)ei * D + lane * 16; const bf16_t* vp = PV + (size_t)ei * D + lane * 16;
            const u32x4 u0 = *(const u32x4*)up, u1 = *(const u32x4*)(up + 8), v0 = *(const u32x4*)vp, v1 = *(const u32x4*)(vp + 8);
            float dt = hp[0] * bflo(u0.x) + hp[1] * bfhi(u0.x) + hp[2] * bflo(u0.y) + hp[3] * bfhi(u0.y) + hp[4] * bflo(u0.z) + hp[5] * bfhi(u0.z) + hp[6] * bflo(u0.w) + hp[7] * bfhi(u0.w)
                     + hp[8] * bflo(u1.x) + hp[9] * bfhi(u1.x) + hp[10] * bflo(u1.y) + hp[11] * bfhi(u1.y) + hp[12] * bflo(u1.z) + hp[13] * bfhi(u1.z) + hp[14] * bflo(u1.w) + hp[15] * bfhi(u1.w);
            dt = wave_sum(dt);
            const float act = gelu_t(dt) * eg;
            acc[0] += act * bflo(v0.x); acc[1] += act * bfhi(v0.x); acc[2] += act * bflo(v0.y); acc[3] += act * bfhi(v0.y);
            acc[4] += act * bflo(v0.z); acc[5] += act * bfhi(v0.z); acc[6] += act * bflo(v0.w); acc[7] += act * bfhi(v0.w);
            acc[8] += act * bflo(v1.x); acc[9] += act * bfhi(v1.x); acc[10] += act * bflo(v1.y); acc[11] += act * bfhi(v1.y);
            acc[12] += act * bflo(v1.z); acc[13] += act * bfhi(v1.z); acc[14] += act * bflo(v1.w); acc[15] += act * bfhi(v1.w);
        }
        float* xr = X1 + (size_t)g * D + lane * 16;
        const float* g2 = modv(a, layer, var, 5) + lane * 16;
        float xn[16]; float ss = 0.f;
#pragma unroll
        for (int d = 0; d < 16; d += 4) {
            const f32x4 xv = *(const f32x4*)(xr + d), gv = *(const f32x4*)(g2 + d);
            xn[d] = xv.x + gv.x * acc[d]; xn[d + 1] = xv.y + gv.y * acc[d + 1]; xn[d + 2] = xv.z + gv.z * acc[d + 2]; xn[d + 3] = xv.w + gv.w * acc[d + 3];
            ss += xn[d] * xn[d] + xn[d + 1] * xn[d + 1] + xn[d + 2] * xn[d + 2] + xn[d + 3] * xn[d + 3];
        }
        const float rinv = rsqrtf(wave_sum(ss) * (1.f / D) + EPS);
        if (mode == 0) {
#pragma unroll
            for (int d = 0; d < 16; d += 4) { f32x4 o; o.x = xn[d]; o.y = xn[d + 1]; o.z = xn[d + 2]; o.w = xn[d + 3]; *(f32x4*)(xr + d) = o; }
            const float* gn = a.in[6] + D + lane * 16; const float* sh = modv(a, 1, var, 0) + lane * 16; const float* sc = modv(a, 1, var, 1) + lane * 16;
            unsigned w[8];
#pragma unroll
            for (int d = 0; d < 16; d += 2) w[d >> 1] = pk2(xn[d] * rinv * gn[d] * (1.f + sc[d]) + sh[d], xn[d + 1] * rinv * gn[d + 1] * (1.f + sc[d + 1]) + sh[d + 1]);
            u32x4 o0, o1; o0.x = w[0]; o0.y = w[1]; o0.z = w[2]; o0.w = w[3]; o1.x = w[4]; o1.y = w[5]; o1.z = w[6]; o1.w = w[7];
            *(u32x4*)(H + (size_t)g * D + lane * 16) = o0; *(u32x4*)(H + (size_t)g * D + lane * 16 + 8) = o1;
        } else {
            const int b = g / RPB, t = g - b * RPB - CTXL;
            float* op = a.out + ((size_t)b * SEQ + t) * D + lane * 16; const float* gn = a.in[28] + lane * 16;
#pragma unroll
            for (int d = 0; d < 16; d += 4) { f32x4 o; o.x = xn[d] * rinv * gn[d]; o.y = xn[d + 1] * rinv * gn[d + 1]; o.z = xn[d + 2] * rinv * gn[d + 2]; o.w = xn[d + 3] * rinv * gn[d + 3]; *(f32x4*)(op + d) = o; }
        }
    }
}

__device__ void phase_inproj1(const Args& a, char* lds) {
    float* Cs = (float*)lds;
    const int tid = threadIdx.x;
    const bf16_t* H = (const bf16_t*)(a.ws + WS_H); const bf16_t* W = (const bf16_t*)(a.ws + WS_WIN1);
    const int NU = (MTOT / 128) * 20;
    for (int u = blockIdx.x; u < NU; u += gridDim.x) {
        const int rt = u / 20, ct = u % 20, row0 = rt * 128, col0 = ct * 128;
        if (ct < 10 && (rt % 66) < 2) continue;
        gemm_tile128(H + (size_t)row0 * D, D, W + (size_t)col0 * D, D, D, Cs);
        __syncthreads();
        const int rr = tid >> 2, q4 = tid & 3, g = row0 + rr;
        const float* crow = Cs + rr * CS_LD + q4 * 32;
        if (ct < 10) {
            bf16_t* o = (bf16_t*)(a.ws + WS_GG) + (size_t)g * DRNN + col0 + q4 * 32;
#pragma unroll
            for (int c = 0; c < 32; c += 2) *(unsigned*)(o + c) = pk2(gelu_t(crow[c]), gelu_t(crow[c + 1]));
        } else {
            bf16_t* o = (bf16_t*)(a.ws + WS_XR) + (size_t)g * DRNN + (col0 - DRNN) + q4 * 32;
#pragma unroll
            for (int c = 0; c < 32; c += 2) *(unsigned*)(o + c) = pk2(crow[c], crow[c + 1]);
        }
        __syncthreads();
    }
}

__device__ void phase_rglru(const Args& a, char* lds, int pass) {
    const int tid = threadIdx.x;
    unsigned char* ws = a.ws;
    float* xc = (float*)lds;
    float* seg = xc + 128 * 128;
    const bf16_t* XR = (const bf16_t*)(ws + WS_XR); const bf16_t* GG = (const bf16_t*)(ws + WS_GG); bf16_t* YG = (bf16_t*)(ws + WS_YG);
    float* CARRY = (float*)(ws + WS_CARRY);
    const int j = tid & 127, tq = tid >> 7;
    const int NU = (MTOT / 128) * 10;
    for (int u = blockIdx.x; u < NU; u += gridDim.x) {
        const int T = u / 10, hb = u % 10, b = T / 66, tl = T % 66, row0 = T * 128, ch = hb * 128 + j;
        if (pass == 1 && tl < 2) continue;
        const int seq_lo = tl < 2 ? b * RPB : b * RPB + CTXL, seq_hi = tl < 2 ? b * RPB + CTXL : (b + 1) * RPB;
        {
            const float w0 = a.in[16][0 * DRNN + ch], w1 = a.in[16][1 * DRNN + ch], w2 = a.in[16][2 * DRNN + ch], w3 = a.in[16][3 * DRNN + ch], cb = a.in[17][ch];
            for (int tt = 0; tt < 32; ++tt) {
                const int g = row0 + tq * 32 + tt;
                const float xm2 = (g - 2 >= seq_lo) ? bf2f(XR[(size_t)(g - 2) * DRNN + ch]) : 0.f;
                const float xm1 = (g - 1 >= seq_lo) ? bf2f(XR[(size_t)(g - 1) * DRNN + ch]) : 0.f;
                const float x0 = bf2f(XR[(size_t)g * DRNN + ch]);
                const float xp1 = (g + 1 < seq_hi) ? bf2f(XR[(size_t)(g + 1) * DRNN + ch]) : 0.f;
                xc[(tq * 32 + tt) * 128 + j] = w0 * xm2 + w1 * xm1 + w2 * x0 + w3 * xp1 + cb;
            }
        }
        __syncthreads();
        float acc[4][32];
#pragma unroll
        for (int m = 0; m < 4; ++m)
#pragma unroll
            for (int tt = 0; tt < 32; ++tt) acc[m][tt] = 0.f;
        {
            const float* wa0 = a.in[18] + ((size_t)(0 * 10 + hb) * 128) * 128 + j; const float* wx0 = a.in[20] + ((size_t)(0 * 10 + hb) * 128) * 128 + j;
            const float* wa1 = a.in[18] + ((size_t)(1 * 10 + hb) * 128) * 128 + j; const float* wx1 = a.in[20] + ((size_t)(1 * 10 + hb) * 128) * 128 + j;
            for (int i = 0; i < 128; ++i) {
                const float w0 = wa0[i * 128], w1 = wx0[i * 128], w2 = wa1[i * 128], w3 = wx1[i * 128];
#pragma unroll
                for (int tt = 0; tt < 32; ++tt) { const float x = xc[(tq * 32 + tt) * 128 + i]; acc[0][tt] += x * w0; acc[1][tt] += x * w1; acc[2][tt] += x * w2; acc[3][tt] += x * w3; }
            }
        }
#pragma unroll
        for (int d = 0; d < 2; ++d) {
            const float ba = a.in[19][d * DRNN + ch], bx = a.in[21][d * DRNN + ch], lam = a.in[22][d * DRNN + ch];
            const float sp = log1pf(__expf(-lam));
#pragma unroll
            for (int tt = 0; tt < 32; ++tt) {
                const float r = sigmoidf_(acc[2 * d][tt] + ba), ig = sigmoidf_(acc[2 * d + 1][tt] + bx);
                const float la = -8.f * r * sp; const float av = __expf(la);
                const float uv = sqrtf(fmaxf(-expm1f(2.f * la), 0.f)) * ig * xc[(tq * 32 + tt) * 128 + j];
                acc[2 * d][tt] = av; acc[2 * d + 1][tt] = uv;
            }
        }
        {
            float Af = 1.f, Hf = 0.f, Ab = 1.f, Hb = 0.f;
#pragma unroll
            for (int tt = 0; tt < 32; ++tt) { Hf = acc[0][tt] * Hf + acc[1][tt]; Af *= acc[0][tt]; }
#pragma unroll
            for (int tt = 31; tt >= 0; --tt) { Hb = acc[2][tt] * Hb + acc[3][tt]; Ab *= acc[2][tt]; }
            seg[((0 * 4 + tq) * 128 + j) * 2] = Af; seg[((0 * 4 + tq) * 128 + j) * 2 + 1] = Hf;
            seg[((1 * 4 + tq) * 128 + j) * 2] = Ab; seg[((1 * 4 + tq) * 128 + j) * 2 + 1] = Hb;
        }
        __syncthreads();
        if (pass == 0) {
            if (tq == 0) {
                float A = 1.f, Hh = 0.f;
                for (int s = 0; s < 4; ++s) { const float sa = seg[((0 * 4 + s) * 128 + j) * 2], sh = seg[((0 * 4 + s) * 128 + j) * 2 + 1]; Hh = sa * Hh + sh; A *= sa; }
                float* c0 = CARRY + (((size_t)(b * 2 + 0) * 66 + tl) * DRNN + ch) * 2; c0[0] = A; c0[1] = Hh;
                A = 1.f; Hh = 0.f;
                for (int s = 3; s >= 0; --s) { const float sa = seg[((1 * 4 + s) * 128 + j) * 2], sh = seg[((1 * 4 + s) * 128 + j) * 2 + 1]; Hh = sa * Hh + sh; A *= sa; }
                float* c1 = CARRY + (((size_t)(b * 2 + 1) * 66 + tl) * DRNN + ch) * 2; c1[0] = A; c1[1] = Hh;
            }
        } else {
            float hf = 0.f, hbk = 0.f;
            for (int t2 = 0; t2 < tl; ++t2) { const float* c = CARRY + (((size_t)(b * 2 + 0) * 66 + t2) * DRNN + ch) * 2; hf = c[0] * hf + c[1]; }
            { const float* c = CARRY + (((size_t)(b * 2 + 1) * 66 + 1) * DRNN + ch) * 2; hbk = c[0] * hbk + c[1]; }
            { const float* c = CARRY + (((size_t)(b * 2 + 1) * 66 + 0) * DRNN + ch) * 2; hbk = c[0] * hbk + c[1]; }
            for (int t2 = 65; t2 > tl; --t2) { const float* c = CARRY + (((size_t)(b * 2 + 1) * 66 + t2) * DRNN + ch) * 2; hbk = c[0] * hbk + c[1]; }
            for (int s = 0; s < tq; ++s) { const float sa = seg[((0 * 4 + s) * 128 + j) * 2], sh = seg[((0 * 4 + s) * 128 + j) * 2 + 1]; hf = sa * hf + sh; }
            for (int s = 3; s > tq; --s) { const float sa = seg[((1 * 4 + s) * 128 + j) * 2], sh = seg[((1 * 4 + s) * 128 + j) * 2 + 1]; hbk = sa * hbk + sh; }
#pragma unroll
            for (int tt = 0; tt < 32; ++tt) { hf = acc[0][tt] * hf + acc[1][tt]; acc[0][tt] = hf; }
#pragma unroll
            for (int tt = 31; tt >= 0; --tt) { hbk = acc[2][tt] * hbk + acc[3][tt]; acc[0][tt] += hbk; }
#pragma unroll
            for (int tt = 0; tt < 32; ++tt) {
                const int g = row0 + tq * 32 + tt;
                YG[(size_t)g * DRNN + ch] = (bf16_t)f2bf(acc[0][tt] * bf2f(GG[(size_t)g * DRNN + ch]));
            }
        }
        __syncthreads();
    }
}

constexpr int NPHASE = 17;
__global__ void __launch_bounds__(NTHR, 2) mega(Args a) {
    extern __shared__ __attribute__((aligned(16))) char lds[];
    volatile LAS unsigned* MISC = (volatile LAS unsigned*)((LAS char*)lds + LDS_MISC);
    if (threadIdx.x < 64) MISC[threadIdx.x] = 0u;
    __syncthreads();
    XcdBarrier bar; bar.bar = (unsigned*)(a.ws + WS_CTL) + 4096; bar.x = 0; bar.st = nullptr;
    const bool multi = (a.ph_hi - a.ph_lo) > 1;
    if (multi) bar = xcd_barrier_post((unsigned*)(a.ws + WS_CTL) + 4096, MISC + 8);
    const int lo = a.ph_lo, hi = a.ph_hi;
    unsigned char* ws = a.ws;
#define IN(k) (lo <= (k) && (k) < hi)
#define SEAM(k) do { if (IN(k) && IN((k) + 1)) xcd_barrier(bar); } while (0)
    if (IN(0)) { phase_prep(a, lds); } SEAM(0);
    if (IN(1)) { phase_norm(a, 0, 0, a.in[6], 0, 1, false); } SEAM(1);
    if (IN(2)) { phase_inproj0(a, lds); } SEAM(2);
    if (IN(3)) { phase_gmlp(a, lds); phase_attn(a, lds); } SEAM(3);
    if (IN(4)) { phase_outproj(a, lds, (const bf16_t*)(ws + WS_AO), 1024, (const bf16_t*)(ws + WS_WOUT0), 0, 2, 0, false); } SEAM(4);
    if (IN(5)) { phase_norm(a, 0, 1, a.in[7], 3, 4, false); } SEAM(5);
    if (IN(6)) { phase_peerq(a, lds, 0, false); } SEAM(6);
    if (IN(7)) { phase_peer_topk(a, 0, false); } SEAM(7);
    if (IN(8)) { phase_peer_gather(a, 0, 0); } SEAM(8);
    if (IN(9)) { phase_inproj1(a, lds); } SEAM(9);
    if (IN(10)) { phase_rglru(a, lds, 0); } SEAM(10);
    if (IN(11)) { phase_rglru(a, lds, 1); } SEAM(11);
    if (IN(12)) { phase_outproj(a, lds, (const bf16_t*)(ws + WS_YG), 1280, (const bf16_t*)(ws + WS_WOUT1), 1, 2, 1, true); } SEAM(12);
    if (IN(13)) { phase_norm(a, 1, 1, a.in[7] + D, 3, 4, true); } SEAM(13);
    if (IN(14)) { phase_peerq(a, lds, 1, true); } SEAM(14);
    if (IN(15)) { phase_peer_topk(a, 1, true); } SEAM(15);
    if (IN(16)) { phase_peer_gather(a, 1, 1); }
#undef IN
#undef SEAM
}

extern "C" void kernel_launch(void* const* d_in, const int* in_sizes, int n_in, void* d_out, int out_size, void* d_ws, size_t ws_size, hipStream_t stream) {
    static int grid = 0;
    if (grid == 0) {
        if (n_in != 29 || out_size != NB * SEQ * D || ws_size < WS_END) {
            fprintf(stderr, "kernel_launch: unexpected shapes: n_in %d out %d ws %zu (need %zu)\n", n_in, out_size, ws_size, (size_t)WS_END); grid = -1; return; }
        int dev = 0, cus = 0, per_cu = 0;
        if (hipGetDevice(&dev) != hipSuccess || hipDeviceGetAttribute(&cus, hipDeviceAttributeMultiprocessorCount, dev) != hipSuccess) { grid = -1; return; }
        if (hipFuncSetAttribute((const void*)mega, hipFuncAttributeMaxDynamicSharedMemorySize, LDS_BYTES) != hipSuccess) { fprintf(stderr, "kernel_launch: hipFuncSetAttribute failed\n"); grid = -1; return; }
        if (hipOccupancyMaxActiveBlocksPerMultiprocessor(&per_cu, (const void*)mega, NTHR, LDS_BYTES) != hipSuccess || per_cu < 1)
            fprintf(stderr, "kernel_launch: occupancy query reports %d blocks per CU\n", per_cu);
        (void)hipGetLastError();
        grid = cus;
    }
    if (grid < 0) return;
    (void)hipMemsetAsync((char*)d_ws + WS_CTL, 0, CTL_BYTES, stream);
    Args a{};
    for (int i = 0; i < 29; ++i) a.in[i] = (const float*)d_in[i];
    a.out = (float*)d_out; a.ws = (unsigned char*)d_ws;
#if MK_SINGLE
    a.ph_lo = 0; a.ph_hi = NPHASE;
    hipLaunchKernelGGL(mega, dim3(grid), dim3(NTHR), LDS_BYTES, stream, a);
#else
    for (int p = 0; p < NPHASE; ++p) { a.ph_lo = p; a.ph_hi = p + 1; hipLaunchKernelGGL(mega, dim3(grid), dim3(NTHR), LDS_BYTES, stream, a); }
#endif
    const hipError_t le = hipPeekAtLastError();
    if (le != hipSuccess) fprintf(stderr, "kernel_launch: launch failed: %s\n", hipGetErrorName(le));
}
```

```cpp
#include <hip/hip_runtime.h>
#include <cstdio>
#include <cstdint>

#ifndef MK_SINGLE
#define MK_SINGLE 1
#endif

#define GAS __attribute__((address_space(1)))
#define LAS __attribute__((address_space(3)))

typedef unsigned short bf16_t;
typedef short bf16x8 __attribute__((ext_vector_type(8)));
typedef float f32x4 __attribute__((ext_vector_type(4)));
typedef float f32x16 __attribute__((ext_vector_type(16)));
typedef unsigned u32x4 __attribute__((ext_vector_type(4)));
typedef unsigned u32x2 __attribute__((ext_vector_type(2)));

constexpr int D = 1024, NB = 2, SEQ = 8192, CTXL = 256;
constexpr int RPB = SEQ + CTXL;
constexpr int MTOT = NB * RPB;
constexpr int AB_IN = 2048, A_W = 512, DRNN = 1280, NEXP = 16384;
constexpr float EPS = 1e-6f;
constexpr int NTHR = 512, NWAVE = 8;

constexpr size_t MiB = 1u << 20;
constexpr size_t WS_CTL = 0, CTL_BYTES = 1 * MiB;
constexpr size_t WS_MODV = 1 * MiB;
constexpr size_t WS_ROPE = 1 * MiB + 512 * 1024;
constexpr size_t WS_WIN0 = 2 * MiB;
constexpr size_t WS_WOUT0 = 6 * MiB;
constexpr size_t WS_WIN1 = 8 * MiB;
constexpr size_t WS_WOUT1 = 13 * MiB;
constexpr size_t WS_WQ = 16 * MiB;
constexpr size_t WS_KEYS = 24 * MiB;
constexpr size_t WS_GWS = 25 * MiB;
constexpr size_t WS_WAT = 26 * MiB;
constexpr size_t WS_WXT = 27 * MiB;
constexpr size_t WS_CARRY = 28 * MiB;
constexpr size_t WS_PU = 32 * MiB;
constexpr size_t WS_PV = 96 * MiB;
constexpr size_t WS_H = 160 * MiB;
constexpr size_t WS_X1 = 193 * MiB;
constexpr size_t WS_SELI = 259 * MiB;
constexpr size_t WS_SELG = 268 * MiB;
constexpr size_t WS_R = 277 * MiB;
constexpr size_t WS_U = WS_R;
constexpr size_t WS_VV = WS_R + 17 * MiB;
constexpr size_t WS_Q = WS_R + 34 * MiB;
constexpr size_t WS_K = WS_R + 51 * MiB;
constexpr size_t WS_V = WS_R + 60 * MiB;
constexpr size_t WS_AO = WS_R + 69 * MiB;
constexpr size_t WS_QP = WS_R;
constexpr size_t WS_GG = WS_R;
constexpr size_t WS_XR = WS_R + 42 * MiB;
constexpr size_t WS_YG = WS_R + 84 * MiB;
constexpr size_t WS_END = WS_R + 126 * MiB;

constexpr int LDS_BYTES = 147456;
constexpr int LDS_MISC = 145408;

__device__ __forceinline__ float bf2f(bf16_t v) { return __uint_as_float(((unsigned)v) << 16); }
__device__ __forceinline__ unsigned f2bf(float f) { unsigned u = __float_as_uint(f); return (u + 0x7fffu + ((u >> 16) & 1u)) >> 16; }
__device__ __forceinline__ unsigned pk2(float lo, float hi) { return f2bf(lo) | (f2bf(hi) << 16); }
__device__ __forceinline__ float bflo(unsigned w) { return __uint_as_float(w << 16); }
__device__ __forceinline__ float bfhi(unsigned w) { return __uint_as_float(w & 0xffff0000u); }
__device__ __forceinline__ float gelu_t(float x) { const float y = -2.302208198144325f * (x + 0.044715f * x * x * x); return x * __builtin_amdgcn_rcpf(1.f + __builtin_amdgcn_exp2f(y)); }
__device__ __forceinline__ float sigmoidf_(float x) { return 1.f / (1.f + __expf(-x)); }
__device__ __forceinline__ float wave_sum(float v) {
#pragma unroll
    for (int o = 1; o < 64; o <<= 1) v += __shfl_xor(v, o);
    return v;
}
__host__ __device__ __forceinline__ int sigma_head(int j) { const int grp = j >> 3, n = (j >> 2) & 1, e = j & 3; return (grp >> 3) * 64 + n * 32 + (grp & 7) * 4 + e; }

struct Args {
    const float* in[29];
    float* out;
    unsigned char* ws;
    int ph_lo, ph_hi;
};

__device__ __forceinline__ int row_variant(int g) { const int b = g / RPB, i = g - b * RPB; return i < CTXL ? 2 : b; }
__device__ __forceinline__ const float* row_src(const Args& a, int g) {
    const int b = g / RPB, i = g - b * RPB;
    return i < CTXL ? a.in[2] + ((size_t)b * CTXL + i) * D : a.in[0] + ((size_t)b * SEQ + (i - CTXL)) * D;
}
__device__ __forceinline__ const float* modv(const Args& a, int layer, int variant, int which) {
    return (const float*)(a.ws + WS_MODV) + ((size_t)(layer * 3 + variant) * 6 + which) * D;
}

#define XB_TMO      128
#define XB_XCNT(j)  (256  + 64 * (j))
#define XB_XSUB(j)  (1280 + 64 * (j))
#define XB_XGEN(j)  (2304 + 64 * (j))
#define XB_TOP      3328
#define XB_TOPGEN   3392
#define XCD_BAR_WORDS 3456
#define XB_SPIN_CAP (1u << 22)
__device__ __forceinline__ unsigned xb_ld(unsigned* p)              { return __hip_atomic_load(p, __ATOMIC_RELAXED, __HIP_MEMORY_SCOPE_AGENT); }
__device__ __forceinline__ unsigned xb_add(unsigned* p, unsigned v) { return __hip_atomic_fetch_add(p, v, __ATOMIC_RELAXED, __HIP_MEMORY_SCOPE_AGENT); }
__device__ __forceinline__ unsigned xb_xcc_id() { return (unsigned)__builtin_amdgcn_s_getreg((3 << 11) | 20) & 0xFu; }
#define XB_SPIN(cond, bar) do { unsigned _sp = 0; while (cond) { __builtin_amdgcn_s_sleep(1); \
    if ((++_sp & 255u) == 0u) { if (xb_ld(&(bar)[XB_TMO])) break; if (_sp > XB_SPIN_CAP) { atomicAdd(&(bar)[XB_TMO], 1u); break; } } } } while (0)
struct XcdBarrier { unsigned* bar; unsigned x; volatile LAS unsigned* st; };
__device__ __forceinline__ XcdBarrier xcd_barrier_post(unsigned* bar, volatile LAS unsigned* st) {
    XcdBarrier b; b.bar = bar; b.x = xb_xcc_id(); b.st = st;
    if (threadIdx.x == 0) (void)xb_add(&bar[XB_XCNT(b.x)], 1u);
    return b;
}
__device__ __forceinline__ void xcd_barrier_complete(unsigned* bar, unsigned x, unsigned& nloc, unsigned& nx) {
    const unsigned G = gridDim.x * gridDim.y * gridDim.z;
    unsigned sum, cnt, mine, sp = 0u;
    for (;;) {
        sum = 0u; cnt = 0u; mine = 0u;
#pragma unroll
        for (unsigned j = 0; j < 16; ++j) { const unsigned c = xb_ld(&bar[XB_XCNT(j)]); sum += c; cnt += (c > 0u) ? 1u : 0u; mine = (j == x) ? c : mine; }
        if (sum == G) break;
        __builtin_amdgcn_s_sleep(1);
        if ((++sp & 255u) == 0u) { if (xb_ld(&bar[XB_TMO])) break; if (sp > XB_SPIN_CAP) { atomicAdd(&bar[XB_TMO], 1u); break; } }
    }
    nloc = mine > 0u ? mine : 1u; nx = cnt > 0u ? cnt : 1u;
}
__device__ __forceinline__ void xcd_barrier(const XcdBarrier& b) {
    asm volatile("s_waitcnt vmcnt(0)" ::: "memory");
    __syncthreads();
    if (threadIdx.x == 0) {
        unsigned* bar = b.bar;
        __builtin_amdgcn_s_waitcnt(0);
        unsigned nloc = b.st[0], nx = b.st[1];
        if (nloc == 0u) { xcd_barrier_complete(bar, b.x, nloc, nx); b.st[0] = nloc; b.st[1] = nx; }
        const unsigned old = xb_add(&bar[XB_XSUB(b.x)], 1u);
        const unsigned gen = old / nloc;
        if (old + 1u == (gen + 1u) * nloc) {
            __builtin_amdgcn_fence(__ATOMIC_RELEASE, "agent");
            asm volatile("s_waitcnt vmcnt(0)" ::: "memory");
            const unsigned og = xb_add(&bar[XB_TOP], 1u);
            const unsigned tg = og / nx;
            if (og + 1u == (tg + 1u) * nx) xb_add(&bar[XB_TOPGEN], 1u);
            else XB_SPIN(xb_ld(&bar[XB_TOPGEN]) == tg, bar);
            __builtin_amdgcn_fence(__ATOMIC_ACQUIRE, "agent");
            xb_add(&bar[XB_XGEN(b.x)], 1u);
            asm volatile("s_waitcnt vmcnt(0)" ::: "memory");
        } else {
            XB_SPIN(xb_ld(&bar[XB_XGEN(b.x)]) == gen, bar);
            __builtin_amdgcn_fence(__ATOMIC_ACQUIRE, "agent");
            asm volatile("s_waitcnt vmcnt(0)" ::: "memory");
        }
    }
    __syncthreads();
}

__device__ __forceinline__ void transpose_item(const float* src, int Ns, bf16_t* dst, int Kd, int n0, int k0, int perm_lo, int perm_hi, float* tile) {
    const int tid = threadIdx.x;
    {
        const int nn = tid & 63; int n = n0 + nn;
        if (n >= perm_lo && n < perm_hi) { const int rel = n - perm_lo; n = perm_lo + (rel & ~127) + sigma_head(rel & 127); }
#pragma unroll
        for (int i = 0; i < 8; ++i) { const int kk = (tid >> 6) + 8 * i; tile[kk * 65 + nn] = src[(size_t)(k0 + kk) * Ns + n]; }
    }
    __syncthreads();
    {
        const int n = tid >> 3, kc = (tid & 7) * 8;
        u32x4 o;
        o.x = pk2(tile[(kc + 0) * 65 + n], tile[(kc + 1) * 65 + n]); o.y = pk2(tile[(kc + 2) * 65 + n], tile[(kc + 3) * 65 + n]);
        o.z = pk2(tile[(kc + 4) * 65 + n], tile[(kc + 5) * 65 + n]); o.w = pk2(tile[(kc + 6) * 65 + n], tile[(kc + 7) * 65 + n]);
        *(u32x4*)(dst + (size_t)(n0 + n) * Kd + k0 + kc) = o;
    }
    __syncthreads();
}
__device__ __forceinline__ void cvt_stream(const float* src, bf16_t* dst, size_t n8, size_t gtid, size_t gthreads) {
    for (size_t i = gtid; i < n8; i += gthreads) {
        const f32x4 a = *(const f32x4*)(src + i * 8), b = *(const f32x4*)(src + i * 8 + 4);
        u32x4 o; o.x = pk2(a.x, a.y); o.y = pk2(a.z, a.w); o.z = pk2(b.x, b.y); o.w = pk2(b.z, b.w);
        *(u32x4*)(dst + i * 8) = o;
    }
}
__device__ __forceinline__ void phase_prep(const Args& a, char* lds) {
    const int tid = threadIdx.x, lane = tid & 63, wid = tid >> 6;
    float* tile = (float*)lds;
    unsigned char* ws = a.ws;
    constexpr int I_MOD = 192;
    constexpr int I_WIN0 = (1024 / 64) * (2048 / 64), I_WOUT0 = (1024 / 64) * (1024 / 64), I_WIN1 = (1024 / 64) * (2560 / 64), I_WOUT1 = (1280 / 64) * (1024 / 64);
    constexpr int I_WQ = 2 * (1024 / 64) * (2048 / 64), I_WAX = 40 * 4;
    constexpr int NIT = I_MOD + I_WIN0 + I_WOUT0 + I_WIN1 + I_WOUT1 + I_WQ + I_WAX;
    for (int it = blockIdx.x; it < NIT; it += gridDim.x) {
        int r = it;
        if (r < I_MOD) {
            const int l = r / 96, n0 = (r % 96) * 64;
            const float* W = a.in[4] + (size_t)l * D * 6144;
            float s0 = 0.f, s1 = 0.f, s2 = 0.f;
            for (int k = wid * 128; k < wid * 128 + 128; ++k) {
                const float w = W[(size_t)k * 6144 + n0 + lane];
                const float c0 = a.in[1][k], c1 = a.in[1][D + k], c2 = a.in[3][k];
                s0 += c0 * sigmoidf_(c0) * w; s1 += c1 * sigmoidf_(c1) * w; s2 += c2 * sigmoidf_(c2) * w;
            }
            tile[(wid * 3 + 0) * 64 + lane] = s0; tile[(wid * 3 + 1) * 64 + lane] = s1; tile[(wid * 3 + 2) * 64 + lane] = s2;
            __syncthreads();
            if (tid < 192) {
                const int v = tid / 64, ln = tid & 63; float s = a.in[5][(size_t)l * 6144 + n0 + ln];
                for (int w = 0; w < 8; ++w) s += tile[(w * 3 + v) * 64 + ln];
                ((float*)(ws + WS_MODV))[(size_t)(l * 3 + v) * 6144 + n0 + ln] = s;
            }
            __syncthreads();
            continue;
        }
        r -= I_MOD;
        if (r < I_WIN0) { const int nb = r % 32, kb = r / 32; transpose_item(a.in[8], 2048, (bf16_t*)(ws + WS_WIN0), 1024, nb * 64, kb * 64, 1024, 1792, tile); continue; }
        r -= I_WIN0;
        if (r < I_WOUT0) { const int nb = r % 16, kb = r / 16; transpose_item(a.in[14], 1024, (bf16_t*)(ws + WS_WOUT0), 1024, nb * 64, kb * 64, 0, 0, tile); continue; }
        r -= I_WOUT0;
        if (r < I_WIN1) { const int nb = r % 40, kb = r / 40; transpose_item(a.in[15], 2560, (bf16_t*)(ws + WS_WIN1), 1024, nb * 64, kb * 64, 0, 0, tile); continue; }
        r -= I_WIN1;
        if (r < I_WOUT1) { const int nb = r % 16, kb = r / 16; transpose_item(a.in[23], 1024, (bf16_t*)(ws + WS_WOUT1), 1280, nb * 64, kb * 64, 0, 0, tile); continue; }
        r -= I_WOUT1;
        if (r < I_WQ) { const int l = r / 512, q = r % 512, nb = q % 32, kb = q / 32;
            transpose_item(a.in[24] + (size_t)l * 1024 * 2048, 2048, (bf16_t*)(ws + WS_WQ) + (size_t)l * 2048 * 1024, 1024, nb * 64, kb * 64, 0, 0, tile); continue; }
        r -= I_WQ;
        { const int m = r / 4, q = r % 4, nb = q % 2, kb = q / 2;
            const int which = m / 20, dh = m % 20;
            const float* src = a.in[which == 0 ? 18 : 20] + (size_t)dh * 128 * 128;
            bf16_t* dst = (bf16_t*)(ws + (which == 0 ? WS_WAT : WS_WXT)) + (size_t)dh * 128 * 128;
            transpose_item(src, 128, dst, 128, nb * 64, kb * 64, 0, 0, tile);
        }
    }
    const size_t gtid = (size_t)blockIdx.x * NTHR + tid, gthreads = (size_t)gridDim.x * NTHR;
    cvt_stream(a.in[25], (bf16_t*)(ws + WS_KEYS), (size_t)2 * 8 * 2 * 128 * 128 / 8, gtid, gthreads);
    cvt_stream(a.in[10], (bf16_t*)(ws + WS_GWS), (size_t)4 * 128 * 128 / 8, gtid, gthreads);
    cvt_stream(a.in[26], (bf16_t*)(ws + WS_PU), (size_t)2 * NEXP * D / 8, gtid, gthreads);
    cvt_stream(a.in[27], (bf16_t*)(ws + WS_PV), (size_t)2 * NEXP * D / 8, gtid, gthreads);
    for (size_t i = gtid; i < 128 * 32; i += gthreads) {
        const int pos = (int)(i / 32), f = (int)(i % 32);
        const float inv = powf(10000.f, -(float)f / 32.f); const float ang = (float)pos * inv;
        float* R = (float*)(ws + WS_ROPE); R[i * 2] = cosf(ang); R[i * 2 + 1] = sinf(ang);
    }
}

__device__ __forceinline__ void norm_row_store(const f32x4 (&v)[4], const float* g, const float* sh, const float* sc, bf16_t* orow, int lane) {
    float s = 0.f;
#pragma unroll
    for (int j = 0; j < 4; ++j) s += (v[j].x * v[j].x + v[j].y * v[j].y) + (v[j].z * v[j].z + v[j].w * v[j].w);
    const float rinv = rsqrtf(wave_sum(s) * (1.f / D) + EPS);
#pragma unroll
    for (int j = 0; j < 4; ++j) {
        const int c = j * 256 + lane * 4;
        const f32x4 gg = *(const f32x4*)(g + c), s1 = *(const f32x4*)(sh + c), s2 = *(const f32x4*)(sc + c);
        const float o0 = v[j].x * rinv * gg.x * (1.f + s2.x) + s1.x, o1 = v[j].y * rinv * gg.y * (1.f + s2.y) + s1.y;
        const float o2 = v[j].z * rinv * gg.z * (1.f + s2.z) + s1.z, o3 = v[j].w * rinv * gg.w * (1.f + s2.w) + s1.w;
        u32x2 w; w.x = pk2(o0, o1); w.y = pk2(o2, o3);
        *(u32x2*)(orow + c) = w;
    }
}
__device__ __forceinline__ void phase_norm(const Args& a, int layer, int src_mode, const float* gain, int which_sh, int which_sc, bool latent_only) {
    const int lane = threadIdx.x & 63, gw = blockIdx.x * NWAVE + (threadIdx.x >> 6), ngw = gridDim.x * NWAVE;
    bf16_t* H = (bf16_t*)(a.ws + WS_H);
    const float* X1 = (const float*)(a.ws + WS_X1);
    for (int g = gw; g < MTOT; g += ngw) {
        const int var = row_variant(g);
        if (latent_only && var == 2) continue;
        const float* xr = src_mode == 0 ? row_src(a, g) : X1 + (size_t)g * D;
        f32x4 v[4];
#pragma unroll
        for (int j = 0; j < 4; ++j) v[j] = *(const f32x4*)(xr + j * 256 + lane * 4);
        norm_row_store(v, gain, modv(a, layer, var, which_sh), modv(a, layer, var, which_sc), H + (size_t)g * D, lane);
    }
}

constexpr int CS_LD = 132;
__device__ __forceinline__ void gemm_tile128(const bf16_t* A, int lda, const bf16_t* Bt, int ldb, int K, float* Cs) {
    const int tid = threadIdx.x, lane = tid & 63, wid = tid >> 6, r = lane & 31, h = lane >> 5, wr = wid >> 1, wc = wid & 1;
    const bf16_t* ap = A + (size_t)(wr * 32 + r) * lda + 8 * h;
    const bf16_t* bp0 = Bt + (size_t)(wc * 64 + r) * ldb + 8 * h;
    const bf16_t* bp1 = bp0 + (size_t)32 * ldb;
    f32x16 acc0 = {}, acc1 = {};
#pragma unroll 4
    for (int k = 0; k < K; k += 16) {
        const bf16x8 av = *(const bf16x8*)(ap + k), b0 = *(const bf16x8*)(bp0 + k), b1 = *(const bf16x8*)(bp1 + k);
        acc0 = __builtin_amdgcn_mfma_f32_32x32x16_bf16(av, b0, acc0, 0, 0, 0);
        acc1 = __builtin_amdgcn_mfma_f32_32x32x16_bf16(av, b1, acc1, 0, 0, 0);
    }
#pragma unroll
    for (int i = 0; i < 16; ++i) {
        const int row = wr * 32 + (i & 3) + 8 * (i >> 2) + 4 * h;
        Cs[row * CS_LD + wc * 64 + r] = acc0[i];
        Cs[row * CS_LD + wc * 64 + 32 + r] = acc1[i];
    }
}

__device__ __forceinline__ void phase_inproj0(const Args& a, char* lds) {
    float* Cs = (float*)lds;
    const int tid = threadIdx.x;
    unsigned char* ws = a.ws;
    const bf16_t* H = (const bf16_t*)(ws + WS_H); const bf16_t* W = (const bf16_t*)(ws + WS_WIN0);
    const float* rope = (const float*)(ws + WS_ROPE);
    const int NU = (MTOT / 128) * 16;
    for (int u = blockIdx.x; u < NU; u += gridDim.x) {
        const int rt = u / 16, ct = u % 16, row0 = rt * 128, col0 = ct * 128;
        gemm_tile128(H + (size_t)row0 * D, D, W + (size_t)col0 * D, D, D, Cs);
        __syncthreads();
        const int rr = tid >> 2, q4 = tid & 3, g = row0 + rr;
        float* crow = Cs + rr * CS_LD + q4 * 32;
        if (ct < 4) {
            bf16_t* o = (bf16_t*)(ws + WS_U) + (size_t)g * 512 + col0 + q4 * 32;
#pragma unroll
            for (int c = 0; c < 32; c += 2) *(unsigned*)(o + c) = pk2(gelu_t(crow[c]), gelu_t(crow[c + 1]));
        } else if (ct < 8) {
            const int gg = ct - 4; float ss = 0.f;
#pragma unroll
            for (int c = 0; c < 32; ++c) { const float v = gelu_t(crow[c]); crow[c] = v; ss += v * v; }
            ss += __shfl_xor(ss, 1); ss += __shfl_xor(ss, 2);
            const float rinv = rsqrtf(ss * (1.f / 128.f) + EPS);
            const float* gn = a.in[9] + gg * 128 + q4 * 32;
            bf16_t* o = (bf16_t*)(ws + WS_VV) + (size_t)g * 512 + gg * 128 + q4 * 32;
#pragma unroll
            for (int c = 0; c < 32; c += 2) *(unsigned*)(o + c) = pk2(crow[c] * rinv * gn[c], crow[c + 1] * rinv * gn[c + 1]);
        } else if (ct < 14) {
            const bool isq = ct < 12; const int hh = isq ? ct - 8 : ct - 12;
            float ss = 0.f;
#pragma unroll
            for (int c = 0; c < 32; ++c) ss += crow[c] * crow[c];
            ss += __shfl_xor(ss, 1); ss += __shfl_xor(ss, 2);
            const float rinv = rsqrtf(ss * (1.f / 128.f) + EPS);
            const float* gn = a.in[isq ? 12 : 13];
            const int b = g / RPB, i = g - b * RPB; const bool lat = i >= CTXL; const int t = i - CTXL;
            bf16_t* o = (isq ? (bf16_t*)(ws + WS_Q) + (size_t)g * 512 : (bf16_t*)(ws + WS_K) + (size_t)g * 256) + hh * 128 + q4 * 32;
#pragma unroll
            for (int c8 = 0; c8 < 32; c8 += 8) {
                float y[8];
#pragma unroll
                for (int e = 0; e < 8; ++e) { const int j = q4 * 32 + c8 + e; y[e] = crow[c8 + e] * rinv * gn[sigma_head(j)]; }
                if (lat) {
                    const int grp = (q4 * 32 + c8) >> 3, ax = grp >> 3; const int pos = ax == 0 ? (t >> 6) : (t & 63);
#pragma unroll
                    for (int e = 0; e < 4; ++e) { const int f = (grp & 7) * 4 + e; const float cs = rope[(pos * 32 + f) * 2], sn = rope[(pos * 32 + f) * 2 + 1];
                        const float x1 = y[e], x2 = y[e + 4]; y[e] = x1 * cs - x2 * sn; y[e + 4] = x2 * cs + x1 * sn; }
                }
                u32x4 w; w.x = pk2(y[0], y[1]); w.y = pk2(y[2], y[3]); w.z = pk2(y[4], y[5]); w.w = pk2(y[6], y[7]);
                *(u32x4*)(o + c8) = w;
            }
        } else {
            bf16_t* o = (bf16_t*)(ws + WS_V) + (size_t)g * 256 + (ct - 14) * 128 + q4 * 32;
#pragma unroll
            for (int c = 0; c < 32; c += 2) *(unsigned*)(o + c) = pk2(crow[c], crow[c + 1]);
        }
        __syncthreads();
    }
}

__device__ __forceinline__ void phase_gmlp(const Args& a, char* lds) {
    const int tid = threadIdx.x;
    unsigned char* ws = a.ws;
    float* vt = (float*)lds;
    const bf16_t* VV = (const bf16_t*)(ws + WS_VV); const bf16_t* U = (const bf16_t*)(ws + WS_U); bf16_t* AO = (bf16_t*)(ws + WS_AO);
    const int NU = (MTOT / 128) * 4;
    for (int u = blockIdx.x; u < NU; u += gridDim.x) {
        const int ch = u / 4, g = u % 4, row0 = ch * 128;
        for (int i = tid; i < 128 * 128; i += NTHR) { const int q = i >> 7, c = i & 127; vt[i] = bf2f(VV[(size_t)(row0 + q) * 512 + g * 128 + c]); }
        __syncthreads();
        const int c = tid & 127, pq = tid >> 7;
        const float* wsg = a.in[10] + (size_t)g * 128 * 128;
        for (int pp = 0; pp < 32; ++pp) {
            const int p = pq * 32 + pp; float s = 0.f;
            for (int q = 0; q < 128; ++q) s += wsg[p * 128 + q] * vt[q * 128 + c];
            s += a.in[11][g * 128 + p];
            const float uu = bf2f(U[(size_t)(row0 + p) * 512 + g * 128 + c]);
            AO[(size_t)(row0 + p) * 1024 + g * 128 + c] = (bf16_t)f2bf(uu * s);
        }
        __syncthreads();
    }
}

__device__ __forceinline__ void phase_attn_naive(const Args& a, char* lds) {
    const int tid = threadIdx.x;
    unsigned char* ws = a.ws;
    float* Ks = (float*)lds;
    float* Vs = Ks + 32 * 128;
    float* part = Vs + 32 * 128;
    const bf16_t* Q = (const bf16_t*)(ws + WS_Q); const bf16_t* Kb = (const bf16_t*)(ws + WS_K); const bf16_t* Vb = (const bf16_t*)(ws + WS_V);
    bf16_t* AO = (bf16_t*)(ws + WS_AO);
    const int NU = 512 + 16;
    for (int u = blockIdx.x; u < NU; u += gridDim.x) {
        int b, h, qrow0, nkeys;
        if (u < 512) { b = u / 256; h = (u / 64) % 4; qrow0 = b * RPB + CTXL + (u % 64) * 128; nkeys = RPB; }
        else { const int v = u - 512; b = v / 8; h = (v / 2) % 4; qrow0 = b * RPB + (v % 2) * 128; nkeys = CTXL; }
        const int kvh = h >> 1, krow0 = b * RPB;
        const int qi = tid & 127, qt = tid >> 7;
        float q[32], o[32];
        {
            const bf16_t* qp = Q + (size_t)(qrow0 + qi) * 512 + h * 128 + qt * 32;
#pragma unroll
            for (int d = 0; d < 32; d += 2) { const unsigned w = *(const unsigned*)(qp + d); q[d] = bflo(w) * 0.08838834764831845f; q[d + 1] = bfhi(w) * 0.08838834764831845f; }
#pragma unroll
            for (int d = 0; d < 32; ++d) o[d] = 0.f;
        }
        float m = -1e30f, l = 0.f;
        for (int k0 = 0; k0 < nkeys; k0 += 32) {
            {
                const int key = tid >> 4, cs = (tid & 15) * 8;
                const u32x4 kw = *(const u32x4*)(Kb + (size_t)(krow0 + k0 + key) * 256 + kvh * 128 + cs);
                const u32x4 vw = *(const u32x4*)(Vb + (size_t)(krow0 + k0 + key) * 256 + kvh * 128 + cs);
                float* kd = Ks + key * 128 + cs; float* vd = Vs + key * 128 + cs;
                kd[0] = bflo(kw.x); kd[1] = bfhi(kw.x); kd[2] = bflo(kw.y); kd[3] = bfhi(kw.y); kd[4] = bflo(kw.z); kd[5] = bfhi(kw.z); kd[6] = bflo(kw.w); kd[7] = bfhi(kw.w);
                vd[0] = bflo(vw.x); vd[1] = bfhi(vw.x); vd[2] = bflo(vw.y); vd[3] = bfhi(vw.y); vd[4] = bflo(vw.z); vd[5] = bfhi(vw.z); vd[6] = bflo(vw.w); vd[7] = bfhi(vw.w);
            }
            __syncthreads();
#pragma unroll 2
            for (int j = 0; j < 32; ++j) {
                const float* kr = Ks + j * 128 + qt * 32; float acc = 0.f;
#pragma unroll
                for (int d = 0; d < 32; d += 4) { const f32x4 kv = *(const f32x4*)(kr + d); acc += q[d] * kv.x + q[d + 1] * kv.y + q[d + 2] * kv.z + q[d + 3] * kv.w; }
                part[(qt * 32 + j) * 128 + qi] = acc;
            }
            __syncthreads();
            float mx = m;
#pragma unroll 4
            for (int j = 0; j < 32; ++j) { const float sj = (part[(0 * 32 + j) * 128 + qi] + part[(1 * 32 + j) * 128 + qi]) + (part[(2 * 32 + j) * 128 + qi] + part[(3 * 32 + j) * 128 + qi]); mx = fmaxf(mx, sj); }
            const float alpha = __expf(m - mx); m = mx; float ps = 0.f;
#pragma unroll
            for (int d = 0; d < 32; ++d) o[d] *= alpha;
#pragma unroll 2
            for (int j = 0; j < 32; ++j) {
                const float sj = (part[(0 * 32 + j) * 128 + qi] + part[(1 * 32 + j) * 128 + qi]) + (part[(2 * 32 + j) * 128 + qi] + part[(3 * 32 + j) * 128 + qi]);
                const float pj = __expf(sj - mx); ps += pj;
                const float* vr = Vs + j * 128 + qt * 32;
#pragma unroll
                for (int d = 0; d < 32; d += 4) { const f32x4 vv = *(const f32x4*)(vr + d); o[d] += pj * vv.x; o[d + 1] += pj * vv.y; o[d + 2] += pj * vv.z; o[d + 3] += pj * vv.w; }
            }
            l = l * alpha + ps;
            __syncthreads();
        }
        const float rl = 1.f / l;
        bf16_t* op = AO + (size_t)(qrow0 + qi) * 1024 + 512 + h * 128 + qt * 32;
#pragma unroll
        for (int d = 0; d < 32; d += 2) *(unsigned*)(op + d) = pk2(o[d] * rl, o[d + 1] * rl);
    }
}

namespace fa {
typedef short s16x4 __attribute__((ext_vector_type(4)));
constexpr int QBLK = 32, KVBLK = 64, LDQ = 512, LDK = 256, LDO = 1024;
constexpr float SCALE = 0.088388347648318440f, THR = 8.f;
constexpr size_t SHM_V = KVBLK * 128 * 2, SHM_K = KVBLK * 128 * 2, SHM_ATTN = 2 * SHM_V + 2 * SHM_K + NWAVE * 64 * 4;
#define KSWZ(row, colB) ((row) * 256 + ((colB) ^ (((row) & 7) << 4)))
#define SBAR() __builtin_amdgcn_sched_barrier(0)
__device__ __forceinline__ int crow(int r, int hi) { return (r & 3) + 8 * (r >> 2) + 4 * hi; }
__device__ __forceinline__ unsigned cvtpk(float lo, float hi) { unsigned r; asm volatile("v_cvt_pk_bf16_f32 %0, %1, %2" : "=v"(r) : "v"(lo), "v"(hi)); return r; }
__device__ __forceinline__ void partialSM(f32x16& p0, f32x16& p1, float& m_reg, float& mn, float& alpha) {
  constexpr float C = SCALE * 1.4426950408889634f;
  float pmax = p0[0]; for (int r = 1; r < 16; ++r) pmax = fmaxf(pmax, p0[r]); for (int r = 0; r < 16; ++r) pmax = fmaxf(pmax, p1[r]);
  { auto rr = __builtin_amdgcn_permlane32_swap(__float_as_uint(pmax), __float_as_uint(pmax), false, false);
    pmax = fmaxf(__uint_as_float(rr[0]), __uint_as_float(rr[1])); }
  if (__builtin_expect(__all(pmax - m_reg <= THR / SCALE), 1)) { mn = m_reg; alpha = 1.f; }
  else { mn = fmaxf(m_reg, pmax); alpha = __builtin_amdgcn_exp2f((m_reg - mn) * C); m_reg = mn; }
  float mnC = -mn * C;
  for (int r = 0; r < 16; ++r) p0[r] = fmaf(p0[r], C, mnC); for (int r = 0; r < 16; ++r) p1[r] = fmaf(p1[r], C, mnC);
  for (int r = 0; r < 16; ++r) p0[r] = __builtin_amdgcn_exp2f(p0[r]);
}
__device__ __forceinline__ void finishSM(f32x16& p0, f32x16& p1, float alpha, float& l_reg, bf16x8& pa0, bf16x8& pa1, bf16x8& pa2, bf16x8& pa3) {
  for (int r = 0; r < 16; ++r) p1[r] = __builtin_amdgcn_exp2f(p1[r]);
  float ps = 0; for (int r = 0; r < 16; ++r) ps += p0[r]; for (int r = 0; r < 16; ++r) ps += p1[r];
  { auto rr = __builtin_amdgcn_permlane32_swap(__float_as_uint(ps), __float_as_uint(ps), false, false);
    ps = __uint_as_float(rr[0]) + __uint_as_float(rr[1]); }
  l_reg = l_reg * alpha + ps;
#define PK4(P, BASE, OUT) do { unsigned a0 = cvtpk(P[BASE + 0], P[BASE + 1]), a1 = cvtpk(P[BASE + 2], P[BASE + 3]);   \
    unsigned b0 = cvtpk(P[BASE + 4], P[BASE + 5]), b1 = cvtpk(P[BASE + 6], P[BASE + 7]);                              \
    auto r0 = __builtin_amdgcn_permlane32_swap(a0, b0, false, false); auto r1 = __builtin_amdgcn_permlane32_swap(a1, b1, false, false); \
    u32x4 w = {r0[0], r1[0], r0[1], r1[1]}; OUT = *reinterpret_cast<bf16x8*>(&w); } while (0)
  PK4(p0, 0, pa0); PK4(p0, 8, pa1); PK4(p1, 0, pa2); PK4(p1, 8, pa3);
#undef PK4
}
__device__ __forceinline__ void qkt(f32x16& p0, f32x16& p1, const bf16_t* Ks, const bf16x8* qr, int r32, int hi) {
  p0 = f32x16{}; p1 = f32x16{};
  for (int d0 = 0; d0 < 8; ++d0) { int cb = (d0 * 16 + hi * 8) * 2;
    bf16x8 b0 = *reinterpret_cast<const bf16x8*>((const char*)Ks + KSWZ(r32, cb));
    bf16x8 b1 = *reinterpret_cast<const bf16x8*>((const char*)Ks + KSWZ(32 + r32, cb));
    p0 = __builtin_amdgcn_mfma_f32_32x32x16_bf16(b0, qr[d0], p0, 0, 0, 0);
    p1 = __builtin_amdgcn_mfma_f32_32x32x16_bf16(b1, qr[d0], p1, 0, 0, 0); }
}
__device__ __forceinline__ int v_st(int k, int c) { const int kk = (k & ~0xC) | ((k & 4) << 1) | ((k & 8) >> 1); return ((kk >> 3) * 4 + (c >> 5)) * 512 + ((kk & 7) * 32 + (c & 31)) * 2; }
__device__ __forceinline__ int v_rd_base(int lane) { return ((lane & 3) << 3) | (((lane >> 2) & 3) << 6) | (((lane >> 4) & 1) << 5) | (((lane >> 5) & 1) << 8); }
constexpr int v_rd_off(int d0, int ks, int half) { return d0 * 512 + ks * 4096 + half * 2048; }
template <int OFF> __device__ __forceinline__ s16x4 tr_read(int vb) {
  s16x4 r; asm volatile("ds_read_b64_tr_b16 %0, %1 offset:%2" : "=&v"(r) : "v"(vb), "i"(OFF) : "memory"); return r;
}
template <int D0> __device__ __forceinline__ void pv_one(f32x16& od, int vb, bf16x8 pa0, bf16x8 pa1, bf16x8 pa2, bf16x8 pa3) {
  const s16x4 l0 = tr_read<v_rd_off(D0, 0, 0)>(vb), h0 = tr_read<v_rd_off(D0, 0, 1)>(vb), l1 = tr_read<v_rd_off(D0, 1, 0)>(vb), h1 = tr_read<v_rd_off(D0, 1, 1)>(vb);
  const s16x4 l2 = tr_read<v_rd_off(D0, 2, 0)>(vb), h2 = tr_read<v_rd_off(D0, 2, 1)>(vb), l3 = tr_read<v_rd_off(D0, 3, 0)>(vb), h3 = tr_read<v_rd_off(D0, 3, 1)>(vb);
  asm volatile("s_waitcnt lgkmcnt(0)" ::: "memory"); SBAR();
#define PK(L, H) (bf16x8){L[0], L[1], L[2], L[3], H[0], H[1], H[2], H[3]}
  od = __builtin_amdgcn_mfma_f32_32x32x16_bf16(pa0, PK(l0, h0), od, 0, 0, 0);
  od = __builtin_amdgcn_mfma_f32_32x32x16_bf16(pa1, PK(l1, h1), od, 0, 0, 0);
  od = __builtin_amdgcn_mfma_f32_32x32x16_bf16(pa2, PK(l2, h2), od, 0, 0, 0);
  od = __builtin_amdgcn_mfma_f32_32x32x16_bf16(pa3, PK(l3, h3), od, 0, 0, 0);
#undef PK
}
__device__ __forceinline__ void pv_d0(f32x16* o, int vb, bf16x8 pa0, bf16x8 pa1, bf16x8 pa2, bf16x8 pa3) {
  pv_one<0>(o[0], vb, pa0, pa1, pa2, pa3); pv_one<1>(o[1], vb, pa0, pa1, pa2, pa3); pv_one<2>(o[2], vb, pa0, pa1, pa2, pa3); pv_one<3>(o[3], vb, pa0, pa1, pa2, pa3);
}
__device__ __forceinline__ void attn_dense_body(const bf16_t* __restrict__ Qb, const bf16_t* __restrict__ Kh, const bf16_t* __restrict__ Vh,
                                                bf16_t* __restrict__ Ob, int seq, char* lds) {
  const int tid = threadIdx.x, wid = tid >> 6, lane = tid & 63, r32 = lane & 31, hi = lane >> 5;
  bf16_t* V_lds = (bf16_t*)lds; bf16_t* K_lds = (bf16_t*)(lds + 2 * SHM_V);
  float* ws = (float*)(lds + 2 * SHM_V + 2 * SHM_K) + wid * 64; float* li_l = ws; float* al_l = ws + 32;
  float m_reg = -1e30f, l_reg = 0; f32x16 o[4] = {}; bf16x8 qr[8];
  const bf16_t* Qw = Qb + (long)(wid * QBLK + r32) * LDQ + hi * 8;
#pragma unroll
  for (int d0 = 0; d0 < 8; ++d0) qr[d0] = *reinterpret_cast<const bf16x8*>(Qw + d0 * 16);
  const int sr = tid >> 4, sc = (tid & 15) * 8, vst0 = v_st(sr, sc), vst1 = v_st(32 + sr, sc);
  const int vb0 = (int)(uintptr_t)V_lds + v_rd_base(lane);
  struct { bf16x8 vs0, vs1, ks0, ks1; } sr_[2];
#define SLOAD(i, k0) do { sr_[i].vs0 = *reinterpret_cast<const bf16x8*>(&Vh[(long)((k0) + sr) * LDK + sc]); sr_[i].vs1 = *reinterpret_cast<const bf16x8*>(&Vh[(long)((k0) + 32 + sr) * LDK + sc]); \
    sr_[i].ks0 = *reinterpret_cast<const bf16x8*>(&Kh[(long)((k0) + sr) * LDK + sc]); sr_[i].ks1 = *reinterpret_cast<const bf16x8*>(&Kh[(long)((k0) + 32 + sr) * LDK + sc]); } while (0)
#define SWRITE(b, i) do { *(bf16x8*)((char*)V_lds + (b) * SHM_V + vst0) = sr_[i].vs0;          \
    *(bf16x8*)((char*)V_lds + (b) * SHM_V + vst1) = sr_[i].vs1; int kc = sc * 2;               \
    *(bf16x8*)((char*)K_lds + (b) * SHM_K + KSWZ(sr, kc)) = sr_[i].ks0;                       \
    *(bf16x8*)((char*)K_lds + (b) * SHM_K + KSWZ(32 + sr, kc)) = sr_[i].ks1; } while (0)
#define SWAIT() asm volatile("s_waitcnt vmcnt(4)" ::: "memory")
#define RESC(a) do { if (__any((a) < 1.f)) { if (hi == 0) al_l[r32] = (a); asm volatile("s_waitcnt lgkmcnt(0)" ::: "memory"); \
    for (int d = 0; d < 4; ++d) for (int r = 0; r < 16; ++r) o[d][r] *= al_l[crow(r, hi)]; } } while (0)
  f32x16 pA0, pA1, pB0, pB1; float mnA, mnB, alA, alB; bf16x8 pa0, pa1, pa2, pa3; const int NT = seq / KVBLK;
  constexpr int SE = 0, SO = 1;
  SLOAD(SE, 0); asm volatile("s_waitcnt vmcnt(0)" ::: "memory"); SWRITE(0, SE); __syncthreads();
  qkt(pA0, pA1, K_lds, qr, r32, hi); partialSM(pA0, pA1, m_reg, mnA, alA);
  SLOAD(SO, KVBLK); if (2 < NT) SLOAD(SE, 2 * KVBLK);
  SWAIT(); SWRITE(1, SO); __syncthreads();
  for (int j = 1; j + 1 < NT; j += 2) {
    SBAR(); qkt(pB0, pB1, (bf16_t*)((char*)K_lds + SHM_K), qr, r32, hi);
    finishSM(pA0, pA1, alA, l_reg, pa0, pa1, pa2, pa3); SBAR();
    SLOAD(SO, (j + 2) * KVBLK); SBAR();
    pv_d0(o, vb0, pa0, pa1, pa2, pa3); partialSM(pB0, pB1, m_reg, mnB, alB);
    __syncthreads(); SWAIT(); SWRITE(0, SE);
    RESC(alB); __syncthreads();
    SBAR(); qkt(pA0, pA1, K_lds, qr, r32, hi);
    finishSM(pB0, pB1, alB, l_reg, pa0, pa1, pa2, pa3); SBAR();
    if (j + 3 < NT) SLOAD(SE, (j + 3) * KVBLK); SBAR();
    pv_d0(o, vb0 + (int)SHM_V, pa0, pa1, pa2, pa3); partialSM(pA0, pA1, m_reg, mnA, alA);
    __syncthreads(); SWAIT(); SWRITE(1, SO);
    RESC(alA); __syncthreads();
  }
  SBAR(); qkt(pB0, pB1, (bf16_t*)((char*)K_lds + SHM_K), qr, r32, hi);
  finishSM(pA0, pA1, alA, l_reg, pa0, pa1, pa2, pa3); SBAR();
  pv_d0(o, vb0, pa0, pa1, pa2, pa3); partialSM(pB0, pB1, m_reg, mnB, alB);
  __syncthreads(); RESC(alB);
  finishSM(pB0, pB1, alB, l_reg, pa0, pa1, pa2, pa3); SBAR();
  pv_d0(o, vb0 + (int)SHM_V, pa0, pa1, pa2, pa3);
  if (hi == 0) li_l[r32] = l_reg; asm volatile("s_waitcnt lgkmcnt(0)" ::: "memory");
  float rli[16];
#pragma unroll
  for (int r = 0; r < 16; ++r) rli[r] = __builtin_amdgcn_rcpf(li_l[crow(r, hi)]);
  bf16_t* Ow = Ob + (long)(wid * QBLK) * LDO;
#pragma unroll
  for (int r = 0; r < 16; ++r) { int orow = crow(r, hi);
    for (int d0 = 0; d0 < 4; ++d0) Ow[(long)orow * LDO + d0 * 32 + r32] = (bf16_t)f2bf(o[d0][r] * rli[r]); }
  __syncthreads();
#undef SLOAD
#undef SWRITE
#undef SWAIT
#undef RESC
}
#undef KSWZ
#undef SBAR
}

__device__ __forceinline__ void phase_attn(const Args& a, char* lds) {
    unsigned char* ws = a.ws;
    const bf16_t* Q = (const bf16_t*)(ws + WS_Q); const bf16_t* Kb = (const bf16_t*)(ws + WS_K); const bf16_t* Vb = (const bf16_t*)(ws + WS_V);
    bf16_t* AO = (bf16_t*)(ws + WS_AO);
    const int NU = 256 + 8;
    for (int u = blockIdx.x; u < NU; u += gridDim.x) {
        int b, h, qrow0, nkeys;
        if (u < 256) { b = u / 128; h = (u / 32) % 4; qrow0 = b * RPB + CTXL + (u % 32) * 256; nkeys = RPB; }
        else { const int v = u - 256; b = v / 4; h = v % 4; qrow0 = b * RPB; nkeys = CTXL; }
        const int kvh = h >> 1; const size_t krow0 = (size_t)b * RPB;
        fa::attn_dense_body(Q + (size_t)qrow0 * 512 + h * 128, Kb + krow0 * 256 + kvh * 128, Vb + krow0 * 256 + kvh * 128, AO + (size_t)qrow0 * 1024 + 512 + h * 128, nkeys, lds);
    }
}

__device__ __forceinline__ void phase_outproj(const Args& a, char* lds, const bf16_t* A, int K, const bf16_t* Bt, int layer, int which_gate, int base_mode, bool latent_only) {
    float* Cs = (float*)lds;
    const int tid = threadIdx.x;
    float* X1 = (float*)(a.ws + WS_X1);
    const int NU = (MTOT / 128) * 8;
    for (int u = blockIdx.x; u < NU; u += gridDim.x) {
        const int rt = u / 8, ct = u % 8, row0 = rt * 128, col0 = ct * 128;
        if (latent_only && (rt % 66) < 2) continue;
        gemm_tile128(A + (size_t)row0 * K, K, Bt + (size_t)col0 * K, K, K, Cs);
        __syncthreads();
        const int rr = tid >> 2, q4 = tid & 3, g = row0 + rr;
        const float* crow = Cs + rr * CS_LD + q4 * 32;
        const float* gt = modv(a, layer, row_variant(g), which_gate) + col0 + q4 * 32;
        const float* base = (base_mode == 0 ? row_src(a, g) : X1 + (size_t)g * D) + col0 + q4 * 32;
        float* o = X1 + (size_t)g * D + col0 + q4 * 32;
#pragma unroll
        for (int c = 0; c < 32; c += 4) {
            const f32x4 bs = *(const f32x4*)(base + c), gv = *(const f32x4*)(gt + c);
            f32x4 r; r.x = bs.x + gv.x * crow[c]; r.y = bs.y + gv.y * crow[c + 1]; r.z = bs.z + gv.z * crow[c + 2]; r.w = bs.w + gv.w * crow[c + 3];
            *(f32x4*)(o + c) = r;
        }
        __syncthreads();
    }
}

__device__ __forceinline__ void phase_peerq(const Args& a, char* lds, int layer, bool latent_only) {
    float* Cs = (float*)lds;
    const int tid = threadIdx.x;
    const bf16_t* H = (const bf16_t*)(a.ws + WS_H); const bf16_t* W = (const bf16_t*)(a.ws + WS_WQ) + (size_t)layer * 2048 * 1024;
    bf16_t* QP = (bf16_t*)(a.ws + WS_QP);
    const int NU = (MTOT / 128) * 16;
    for (int u = blockIdx.x; u < NU; u += gridDim.x) {
        const int rt = u / 16, ct = u % 16, row0 = rt * 128, col0 = ct * 128;
        if (latent_only && (rt % 66) < 2) continue;
        gemm_tile128(H + (size_t)row0 * D, D, W + (size_t)col0 * D, D, D, Cs);
        __syncthreads();
        const int rr = tid >> 2, q4 = tid & 3, g = row0 + rr;
        const float* crow = Cs + rr * CS_LD + q4 * 32;
        bf16_t* o = QP + (size_t)g * 2048 + col0 + q4 * 32;
#pragma unroll
        for (int c = 0; c < 32; c += 2) *(unsigned*)(o + c) = pk2(crow[c], crow[c + 1]);
        __syncthreads();
    }
}

__device__ __forceinline__ void wave_argmax(float& v, int& i) {
#pragma unroll
    for (int o = 1; o < 64; o <<= 1) {
        const float ov = __shfl_xor(v, o); const int oi = __shfl_xor(i, o);
        if (ov > v || (ov == v && oi < i)) { v = ov; i = oi; }
    }
}
__device__ __forceinline__ void phase_peer_topk(const Args& a, int layer, bool latent_only) {
    const int lane = threadIdx.x & 63, gw = blockIdx.x * NWAVE + (threadIdx.x >> 6), ngw = gridDim.x * NWAVE;
    const bf16_t* QP = (const bf16_t*)(a.ws + WS_QP);
    const bf16_t* KEYS = (const bf16_t*)(a.ws + WS_KEYS) + (size_t)layer * 8 * 2 * 128 * 128;
    int* SELI = (int*)(a.ws + WS_SELI); float* SELG = (float*)(a.ws + WS_SELG);
    for (int it = gw; it < MTOT * 8; it += ngw) {
        const int g = it >> 3, h = it & 7;
        if (latent_only && row_variant(g) == 2) continue;
        float tv[2]; int ti[2];
#pragma unroll
        for (int s = 0; s < 2; ++s) {
            const bf16_t* qp = QP + (size_t)g * 2048 + h * 256 + s * 128;
            const bf16_t* k0p = KEYS + ((size_t)(h * 2 + s) * 128 + lane) * 128;
            const bf16_t* k1p = k0p + 64 * 128;
            float s0 = 0.f, s1 = 0.f;
#pragma unroll 4
            for (int d = 0; d < 128; d += 8) {
                const u32x4 qw = *(const u32x4*)(qp + d), ka = *(const u32x4*)(k0p + d), kb = *(const u32x4*)(k1p + d);
                s0 += bflo(qw.x) * bflo(ka.x) + bfhi(qw.x) * bfhi(ka.x) + bflo(qw.y) * bflo(ka.y) + bfhi(qw.y) * bfhi(ka.y)
                    + bflo(qw.z) * bflo(ka.z) + bfhi(qw.z) * bfhi(ka.z) + bflo(qw.w) * bflo(ka.w) + bfhi(qw.w) * bfhi(ka.w);
                s1 += bflo(qw.x) * bflo(kb.x) + bfhi(qw.x) * bfhi(kb.x) + bflo(qw.y) * bflo(kb.y) + bfhi(qw.y) * bfhi(kb.y)
                    + bflo(qw.z) * bflo(kb.z) + bfhi(qw.z) * bfhi(kb.z) + bflo(qw.w) * bflo(kb.w) + bfhi(qw.w) * bfhi(kb.w);
            }
            float myv = 0.f; int myi = 0;
            for (int r = 0; r < 16; ++r) {
                float bv; int bi;
                if (s0 >= s1) { bv = s0; bi = lane; } else { bv = s1; bi = lane + 64; }
                wave_argmax(bv, bi);
                if (bi == lane) s0 = -INFINITY; else if (bi == lane + 64) s1 = -INFINITY;
                if (lane == r) { myv = bv; myi = bi; }
            }
            tv[s] = myv; ti[s] = myi;
        }
        float cv[4]; int ci[4];
        {
            const float v0 = __shfl(tv[0], lane >> 2); const int i0 = __shfl(ti[0], lane >> 2);
#pragma unroll
            for (int m = 0; m < 4; ++m) { const int j = (lane & 3) * 4 + m; cv[m] = v0 + __shfl(tv[1], j); ci[m] = i0 * 128 + __shfl(ti[1], j); }
        }
        float topv = 0.f; int tope = 0;
        for (int r = 0; r < 16; ++r) {
            float bv = cv[0]; int bp = lane * 4;
#pragma unroll
            for (int m = 1; m < 4; ++m) if (cv[m] > bv) { bv = cv[m]; bp = lane * 4 + m; }
            wave_argmax(bv, bp);
            int be = 0;
#pragma unroll
            for (int m = 0; m < 4; ++m) if (bp == lane * 4 + m) { be = ci[m]; cv[m] = -INFINITY; }
            be = __shfl(be, bp >> 2);
            if (lane == r) { topv = bv; tope = be; }
        }
        const float mx = __shfl(topv, 0);
        float e = lane < 16 ? __expf(topv - mx) : 0.f;
        float sum = e;
#pragma unroll
        for (int o = 1; o < 16; o <<= 1) sum += __shfl_xor(sum, o);
        if (lane < 16) { SELI[(size_t)g * 128 + h * 16 + lane] = tope; SELG[(size_t)g * 128 + h * 16 + lane] = e / sum; }
    }
}

namespace tk {
__device__ __forceinline__ void ce(float& a, float& b) { const float mx = __builtin_fmaxf(a, b), mn = __builtin_fminf(a, b); a = mx; b = mn; }
__device__ __forceinline__ void sort16_desc(float (&v)[16]) {
#pragma unroll
    for (int ks = 1; ks <= 4; ++ks)
#pragma unroll
        for (int js = ks - 1; js >= 0; --js)
#pragma unroll
            for (int i = 0; i < 16; ++i) { const int k = 1 << ks, j = 1 << js, l = i ^ j; if (l > i) { if ((i & k) == 0) ce(v[i], v[l]); else ce(v[l], v[i]); } }
}
__device__ __forceinline__ void merge16_desc(float (&v)[16]) {
#pragma unroll
    for (int js = 3; js >= 0; --js)
#pragma unroll
        for (int i = 0; i < 16; ++i) { const int j = 1 << js, l = i ^ j; if (l > i) ce(v[i], v[l]); }
}
__device__ __forceinline__ void merge_prune(float (&x)[16], const float (&y)[16]) {
#pragma unroll
    for (int i = 0; i < 16; ++i) x[i] = __builtin_fmaxf(x[i], y[15 - i]);
    merge16_desc(x);
}
__host__ __device__ constexpr bool pair_ok(int i, int j) { return (i + 1) * (j + 1) <= 16; }
__host__ __device__ constexpr int pair_index(int i, int j) { int n = 0; for (int a = 0; a < 16; ++a) for (int b = 0; b < 16; ++b) { if (a == i && b == j) return n; if (pair_ok(a, b)) ++n; } return n; }
static_assert(pair_index(15, 15) == 49 + 0 || true, "");
}
__device__ __forceinline__ void phase_peer_topk2(const Args& a, int layer, bool latent_only) {
    const int lane = threadIdx.x & 63, r32 = lane & 31, hh = lane >> 5, gw = blockIdx.x * NWAVE + __builtin_amdgcn_readfirstlane(threadIdx.x >> 6), ngw = gridDim.x * NWAVE;
    const bf16_t* QP = (const bf16_t*)(a.ws + WS_QP);
    const bf16_t* KEYS = (const bf16_t*)(a.ws + WS_KEYS) + (size_t)layer * 8 * 2 * 128 * 128;
    int* SELI = (int*)(a.ws + WS_SELI); float* SELG = (float*)(a.ws + WS_SELG);
    const int NIT = (MTOT / 32) * 8;
    for (int it = gw; it < NIT; it += ngw) {
        const int tg = it >> 3, h = it & 7, g0 = tg * 32;
        if (latent_only && row_variant(g0) == 2) continue;
        float top[2][16];
#pragma unroll
        for (int s = 0; s < 2; ++s) {
            bf16x8 qf[8];
            unsigned qoff = (unsigned)(r32 * 2048 + 8 * hh), koff = (unsigned)(r32 * 128 + 8 * hh); asm volatile("" : "+v"(qoff), "+v"(koff));
            const bf16_t* qb = QP + (size_t)g0 * 2048 + h * 256 + s * 128;
#pragma unroll
            for (int k = 0; k < 8; ++k) qf[k] = *(const bf16x8*)(qb + qoff + k * 16);
            float grp[4][16];
#pragma unroll
            for (int kb = 0; kb < 4; ++kb) {
                const bf16_t* kbp = KEYS + (size_t)(h * 2 + s) * 128 * 128 + kb * 32 * 128;
                f32x16 acc = {};
#pragma unroll
                for (int k = 0; k < 8; ++k) { const bf16x8 kf = *(const bf16x8*)(kbp + koff + k * 16); acc = __builtin_amdgcn_mfma_f32_32x32x16_bf16(kf, qf[k], acc, 0, 0, 0); }
#pragma unroll
                for (int r = 0; r < 16; ++r) { const int key = kb * 32 + (r & 3) + 8 * (r >> 2) + 4 * hh; grp[kb][r] = __uint_as_float((__float_as_uint(acc[r]) & ~127u) | (unsigned)key); }
                tk::sort16_desc(grp[kb]); __builtin_amdgcn_sched_barrier(0);
            }
            tk::merge_prune(grp[0], grp[1]); __builtin_amdgcn_sched_barrier(0); tk::merge_prune(grp[2], grp[3]); __builtin_amdgcn_sched_barrier(0); tk::merge_prune(grp[0], grp[2]); __builtin_amdgcn_sched_barrier(0);
            float oth[16];
#pragma unroll
            for (int r = 0; r < 16; ++r) { const auto rr = __builtin_amdgcn_permlane32_swap(__float_as_uint(grp[0][r]), __float_as_uint(grp[0][r]), false, false); oth[r] = __uint_as_float(hh == 0 ? rr[1] : rr[0]); }
            tk::merge_prune(grp[0], oth);
#pragma unroll
            for (int r = 0; r < 16; ++r) top[s][r] = grp[0][r];
            __builtin_amdgcn_sched_barrier(0);
        }
        float cg[4][16];
#pragma unroll
        for (int q = 0; q < 4; ++q)
#pragma unroll
            for (int r = 0; r < 16; ++r) cg[q][r] = -INFINITY;
        cg[0][0] = __uint_as_float((__float_as_uint(top[0][0] + top[1][0]) & ~255u) | 0u);
        cg[0][1] = __uint_as_float((__float_as_uint(top[0][0] + top[1][1]) & ~255u) | 1u);
        cg[0][2] = __uint_as_float((__float_as_uint(top[0][0] + top[1][2]) & ~255u) | 2u);
        cg[0][3] = __uint_as_float((__float_as_uint(top[0][0] + top[1][3]) & ~255u) | 3u);
        cg[0][4] = __uint_as_float((__float_as_uint(top[0][0] + top[1][4]) & ~255u) | 4u);
        cg[0][5] = __uint_as_float((__float_as_uint(top[0][0] + top[1][5]) & ~255u) | 5u);
        cg[0][6] = __uint_as_float((__float_as_uint(top[0][0] + top[1][6]) & ~255u) | 6u);
        cg[0][7] = __uint_as_float((__float_as_uint(top[0][0] + top[1][7]) & ~255u) | 7u);
        cg[0][8] = __uint_as_float((__float_as_uint(top[0][0] + top[1][8]) & ~255u) | 8u);
        cg[0][9] = __uint_as_float((__float_as_uint(top[0][0] + top[1][9]) & ~255u) | 9u);
        cg[0][10] = __uint_as_float((__float_as_uint(top[0][0] + top[1][10]) & ~255u) | 10u);
        cg[0][11] = __uint_as_float((__float_as_uint(top[0][0] + top[1][11]) & ~255u) | 11u);
        cg[0][12] = __uint_as_float((__float_as_uint(top[0][0] + top[1][12]) & ~255u) | 12u);
        cg[0][13] = __uint_as_float((__float_as_uint(top[0][0] + top[1][13]) & ~255u) | 13u);
        cg[0][14] = __uint_as_float((__float_as_uint(top[0][0] + top[1][14]) & ~255u) | 14u);
        cg[0][15] = __uint_as_float((__float_as_uint(top[0][0] + top[1][15]) & ~255u) | 15u);
        cg[1][0] = __uint_as_float((__float_as_uint(top[0][1] + top[1][0]) & ~255u) | 16u);
        cg[1][1] = __uint_as_float((__float_as_uint(top[0][1] + top[1][1]) & ~255u) | 17u);
        cg[1][2] = __uint_as_float((__float_as_uint(top[0][1] + top[1][2]) & ~255u) | 18u);
        cg[1][3] = __uint_as_float((__float_as_uint(top[0][1] + top[1][3]) & ~255u) | 19u);
        cg[1][4] = __uint_as_float((__float_as_uint(top[0][1] + top[1][4]) & ~255u) | 20u);
        cg[1][5] = __uint_as_float((__float_as_uint(top[0][1] + top[1][5]) & ~255u) | 21u);
        cg[1][6] = __uint_as_float((__float_as_uint(top[0][1] + top[1][6]) & ~255u) | 22u);
        cg[1][7] = __uint_as_float((__float_as_uint(top[0][1] + top[1][7]) & ~255u) | 23u);
        cg[1][8] = __uint_as_float((__float_as_uint(top[0][2] + top[1][0]) & ~255u) | 32u);
        cg[1][9] = __uint_as_float((__float_as_uint(top[0][2] + top[1][1]) & ~255u) | 33u);
        cg[1][10] = __uint_as_float((__float_as_uint(top[0][2] + top[1][2]) & ~255u) | 34u);
        cg[1][11] = __uint_as_float((__float_as_uint(top[0][2] + top[1][3]) & ~255u) | 35u);
        cg[1][12] = __uint_as_float((__float_as_uint(top[0][2] + top[1][4]) & ~255u) | 36u);
        cg[1][13] = __uint_as_float((__float_as_uint(top[0][3] + top[1][0]) & ~255u) | 48u);
        cg[1][14] = __uint_as_float((__float_as_uint(top[0][3] + top[1][1]) & ~255u) | 49u);
        cg[1][15] = __uint_as_float((__float_as_uint(top[0][3] + top[1][2]) & ~255u) | 50u);
        cg[2][0] = __uint_as_float((__float_as_uint(top[0][3] + top[1][3]) & ~255u) | 51u);
        cg[2][1] = __uint_as_float((__float_as_uint(top[0][4] + top[1][0]) & ~255u) | 64u);
        cg[2][2] = __uint_as_float((__float_as_uint(top[0][4] + top[1][1]) & ~255u) | 65u);
        cg[2][3] = __uint_as_float((__float_as_uint(top[0][4] + top[1][2]) & ~255u) | 66u);
        cg[2][4] = __uint_as_float((__float_as_uint(top[0][5] + top[1][0]) & ~255u) | 80u);
        cg[2][5] = __uint_as_float((__float_as_uint(top[0][5] + top[1][1]) & ~255u) | 81u);
        cg[2][6] = __uint_as_float((__float_as_uint(top[0][6] + top[1][0]) & ~255u) | 96u);
        cg[2][7] = __uint_as_float((__float_as_uint(top[0][6] + top[1][1]) & ~255u) | 97u);
        cg[2][8] = __uint_as_float((__float_as_uint(top[0][7] + top[1][0]) & ~255u) | 112u);
        cg[2][9] = __uint_as_float((__float_as_uint(top[0][7] + top[1][1]) & ~255u) | 113u);
        cg[2][10] = __uint_as_float((__float_as_uint(top[0][8] + top[1][0]) & ~255u) | 128u);
        cg[2][11] = __uint_as_float((__float_as_uint(top[0][9] + top[1][0]) & ~255u) | 144u);
        cg[2][12] = __uint_as_float((__float_as_uint(top[0][10] + top[1][0]) & ~255u) | 160u);
        cg[2][13] = __uint_as_float((__float_as_uint(top[0][11] + top[1][0]) & ~255u) | 176u);
        cg[2][14] = __uint_as_float((__float_as_uint(top[0][12] + top[1][0]) & ~255u) | 192u);
        cg[2][15] = __uint_as_float((__float_as_uint(top[0][13] + top[1][0]) & ~255u) | 208u);
        cg[3][0] = __uint_as_float((__float_as_uint(top[0][14] + top[1][0]) & ~255u) | 224u);
        cg[3][1] = __uint_as_float((__float_as_uint(top[0][15] + top[1][0]) & ~255u) | 240u);
#pragma unroll
        for (int q = 0; q < 4; ++q) { tk::sort16_desc(cg[q]); __builtin_amdgcn_sched_barrier(0); }
        tk::merge_prune(cg[0], cg[1]); __builtin_amdgcn_sched_barrier(0); tk::merge_prune(cg[2], cg[3]); __builtin_amdgcn_sched_barrier(0); tk::merge_prune(cg[0], cg[2]); __builtin_amdgcn_sched_barrier(0);
        int eidx[16]; float ev[16]; float sum = 0.f;
#pragma unroll
        for (int r = 0; r < 16; ++r) {
            const unsigned bits = __float_as_uint(cg[0][r]); const int ci = (bits >> 4) & 15, cj = bits & 15;
            int ia = 0, ib = 0;
#pragma unroll
            for (int i = 0; i < 16; ++i) { ia = (ci == i) ? (int)(__float_as_uint(top[0][i]) & 127u) : ia; ib = (cj == i) ? (int)(__float_as_uint(top[1][i]) & 127u) : ib; }
            eidx[r] = ia * 128 + ib;
            ev[r] = __expf(cg[0][r] - cg[0][0]); sum += ev[r];
        }
        const float rs = 1.f / sum;
        int* oi = SELI + (size_t)(g0 + r32) * 128 + h * 16 + hh * 8; float* og = SELG + (size_t)(g0 + r32) * 128 + h * 16 + hh * 8;
        if (hh == 0) {
#pragma unroll
            for (int r = 0; r < 8; ++r) { oi[r] = eidx[r]; og[r] = ev[r] * rs; }
        } else {
#pragma unroll
            for (int r = 0; r < 8; ++r) { oi[r] = eidx[8 + r]; og[r] = ev[8 + r] * rs; }
        }
    }
}

__device__ __forceinline__ void phase_peer_gather(const Args& a, int layer, int mode) {
    const int lane = threadIdx.x & 63, gw = blockIdx.x * NWAVE + (threadIdx.x >> 6), ngw = gridDim.x * NWAVE;
    unsigned char* ws = a.ws;
    bf16_t* H = (bf16_t*)(ws + WS_H); float* X1 = (float*)(ws + WS_X1);
    const bf16_t* PU = (const bf16_t*)(ws + WS_PU) + (size_t)layer * NEXP * D; const bf16_t* PV = (const bf16_t*)(ws + WS_PV) + (size_t)layer * NEXP * D;
    const int* SELI = (const int*)(ws + WS_SELI); const float* SELG = (const float*)(ws + WS_SELG);
    for (int g = gw; g < MTOT; g += ngw) {
        const int var = row_variant(g);
        if (mode == 1 && var == 2) continue;
        float hp[16], acc[16];
        {
            const u32x4 w0 = *(const u32x4*)(H + (size_t)g * D + lane * 16), w1 = *(const u32x4*)(H + (size_t)g * D + lane * 16 + 8);
            hp[0] = bflo(w0.x); hp[1] = bfhi(w0.x); hp[2] = bflo(w0.y); hp[3] = bfhi(w0.y); hp[4] = bflo(w0.z); hp[5] = bfhi(w0.z); hp[6] = bflo(w0.w); hp[7] = bfhi(w0.w);
            hp[8] = bflo(w1.x); hp[9] = bfhi(w1.x); hp[10] = bflo(w1.y); hp[11] = bfhi(w1.y); hp[12] = bflo(w1.z); hp[13] = bfhi(w1.z); hp[14] = bflo(w1.w); hp[15] = bfhi(w1.w);
#pragma unroll
            for (int d = 0; d < 16; ++d) acc[d] = 0.f;
        }
        const int myi0 = SELI[(size_t)g * 128 + lane], myi1 = SELI[(size_t)g * 128 + 64 + lane];
        const float myg0 = SELG[(size_t)g * 128 + lane], myg1 = SELG[(size_t)g * 128 + 64 + lane];
        for (int e = 0; e < 128; ++e) {
            const int ei = e < 64 ? __shfl(myi0, e) : __shfl(myi1, e - 64);
            const float eg = e < 64 ? __shfl(myg0, e) : __shfl(myg1, e - 64);
            const bf16_t* up = PU + (size_t)ei * D + lane * 16; const bf16_t* vp = PV + (size_t)ei * D + lane * 16;
            const u32x4 u0 = *(const u32x4*)up, u1 = *(const u32x4*)(up + 8), v0 = *(const u32x4*)vp, v1 = *(const u32x4*)(vp + 8);
            float dt = hp[0] * bflo(u0.x) + hp[1] * bfhi(u0.x) + hp[2] * bflo(u0.y) + hp[3] * bfhi(u0.y) + hp[4] * bflo(u0.z) + hp[5] * bfhi(u0.z) + hp[6] * bflo(u0.w) + hp[7] * bfhi(u0.w)
                     + hp[8] * bflo(u1.x) + hp[9] * bfhi(u1.x) + hp[10] * bflo(u1.y) + hp[11] * bfhi(u1.y) + hp[12] * bflo(u1.z) + hp[13] * bfhi(u1.z) + hp[14] * bflo(u1.w) + hp[15] * bfhi(u1.w);
            dt = wave_sum(dt);
            const float act = gelu_t(dt) * eg;
            acc[0] += act * bflo(v0.x); acc[1] += act * bfhi(v0.x); acc[2] += act * bflo(v0.y); acc[3] += act * bfhi(v0.y);
            acc[4] += act * bflo(v0.z); acc[5] += act * bfhi(v0.z); acc[6] += act * bflo(v0.w); acc[7] += act * bfhi(v0.w);
            acc[8] += act * bflo(v1.x); acc[9] += act * bfhi(v1.x); acc[10] += act * bflo(v1.y); acc[11] += act * bfhi(v1.y);
            acc[12] += act * bflo(v1.z); acc[13] += act * bfhi(v1.z); acc[14] += act * bflo(v1.w); acc[15] += act * bfhi(v1.w);
        }
        float* xr = X1 + (size_t)g * D + lane * 16;
        const float* g2 = modv(a, layer, var, 5) + lane * 16;
        float xn[16]; float ss = 0.f;
#pragma unroll
        for (int d = 0; d < 16; d += 4) {
            const f32x4 xv = *(const f32x4*)(xr + d), gv = *(const f32x4*)(g2 + d);
            xn[d] = xv.x + gv.x * acc[d]; xn[d + 1] = xv.y + gv.y * acc[d + 1]; xn[d + 2] = xv.z + gv.z * acc[d + 2]; xn[d + 3] = xv.w + gv.w * acc[d + 3];
            ss += xn[d] * xn[d] + xn[d + 1] * xn[d + 1] + xn[d + 2] * xn[d + 2] + xn[d + 3] * xn[d + 3];
        }
        const float rinv = rsqrtf(wave_sum(ss) * (1.f / D) + EPS);
        if (mode == 0) {
#pragma unroll
            for (int d = 0; d < 16; d += 4) { f32x4 o; o.x = xn[d]; o.y = xn[d + 1]; o.z = xn[d + 2]; o.w = xn[d + 3]; *(f32x4*)(xr + d) = o; }
            const float* gn = a.in[6] + D + lane * 16; const float* sh = modv(a, 1, var, 0) + lane * 16; const float* sc = modv(a, 1, var, 1) + lane * 16;
            unsigned w[8];
#pragma unroll
            for (int d = 0; d < 16; d += 2) w[d >> 1] = pk2(xn[d] * rinv * gn[d] * (1.f + sc[d]) + sh[d], xn[d + 1] * rinv * gn[d + 1] * (1.f + sc[d + 1]) + sh[d + 1]);
            u32x4 o0, o1; o0.x = w[0]; o0.y = w[1]; o0.z = w[2]; o0.w = w[3]; o1.x = w[4]; o1.y = w[5]; o1.z = w[6]; o1.w = w[7];
            *(u32x4*)(H + (size_t)g * D + lane * 16) = o0; *(u32x4*)(H + (size_t)g * D + lane * 16 + 8) = o1;
        } else {
            const int b = g / RPB, t = g - b * RPB - CTXL;
            float* op = a.out + ((size_t)b * SEQ + t) * D + lane * 16; const float* gn = a.in[28] + lane * 16;
#pragma unroll
            for (int d = 0; d < 16; d += 4) { f32x4 o; o.x = xn[d] * rinv * gn[d]; o.y = xn[d + 1] * rinv * gn[d + 1]; o.z = xn[d + 2] * rinv * gn[d + 2]; o.w = xn[d + 3] * rinv * gn[d + 3]; *(f32x4*)(op + d) = o; }
        }
    }
}

typedef __bf16 bf16x2_t __attribute__((ext_vector_type(2)));
__device__ __forceinline__ float dot2bf(unsigned w, unsigned x, float acc) { return __builtin_amdgcn_fdot2_f32_bf16(__builtin_bit_cast(bf16x2_t, w), __builtin_bit_cast(bf16x2_t, x), acc, false); }
struct Row8 { u32x4 c[8]; };
__device__ __forceinline__ void load_row8(Row8& r, const bf16_t* p) {
#pragma unroll
    for (int c = 0; c < 8; ++c) r.c[c] = *(const u32x4*)(p + c * 128);
}
__device__ __forceinline__ float dot_row8(const Row8& r, const u32x4 (&hp)[8]) {
    float a0 = 0.f, a1 = 0.f, a2 = 0.f, a3 = 0.f;
#pragma unroll
    for (int c = 0; c < 8; ++c) { a0 = dot2bf(r.c[c].x, hp[c].x, a0); a1 = dot2bf(r.c[c].y, hp[c].y, a1); a2 = dot2bf(r.c[c].z, hp[c].z, a2); a3 = dot2bf(r.c[c].w, hp[c].w, a3); }
    float s = (a0 + a1) + (a2 + a3);
    s += __shfl_xor(s, 1); s += __shfl_xor(s, 2); s += __shfl_xor(s, 4); s += __shfl_xor(s, 8);
    return s;
}
__device__ __forceinline__ void fma_row(float (&acc)[16], const u32x4& v0, const u32x4& v1, float a) {
    acc[0] += a * bflo(v0.x); acc[1] += a * bfhi(v0.x); acc[2] += a * bflo(v0.y); acc[3] += a * bfhi(v0.y);
    acc[4] += a * bflo(v0.z); acc[5] += a * bfhi(v0.z); acc[6] += a * bflo(v0.w); acc[7] += a * bfhi(v0.w);
    acc[8] += a * bflo(v1.x); acc[9] += a * bfhi(v1.x); acc[10] += a * bflo(v1.y); acc[11] += a * bfhi(v1.y);
    acc[12] += a * bflo(v1.z); acc[13] += a * bfhi(v1.z); acc[14] += a * bflo(v1.w); acc[15] += a * bfhi(v1.w);
}
__device__ __forceinline__ void phase_peer_gather2(const Args& a, char* lds, int layer, int mode) {
    const int lane = threadIdx.x & 63, wid = threadIdx.x >> 6, gw = blockIdx.x * NWAVE + wid, ngw = gridDim.x * NWAVE;
    const int grp = lane >> 4, sub = lane & 15;
    unsigned char* ws = a.ws;
    bf16_t* H = (bf16_t*)(ws + WS_H); float* X1 = (float*)(ws + WS_X1);
    const bf16_t* PU = (const bf16_t*)(ws + WS_PU) + (size_t)layer * NEXP * D; const bf16_t* PV = (const bf16_t*)(ws + WS_PV) + (size_t)layer * NEXP * D;
    const int* SELI = (const int*)(ws + WS_SELI); const float* SELG = (const float*)(ws + WS_SELG);
    LAS int* lidx = (LAS int*)((LAS char*)lds + wid * 2048);
    LAS float* lgate = (LAS float*)(lidx + 128);
    LAS float* lact = lgate + 128;
    for (int g = gw; g < MTOT; g += ngw) {
        const int var = row_variant(g);
        if (mode == 1 && var == 2) continue;
        lidx[lane] = SELI[(size_t)g * 128 + lane]; lidx[64 + lane] = SELI[(size_t)g * 128 + 64 + lane];
        lgate[lane] = SELG[(size_t)g * 128 + lane]; lgate[64 + lane] = SELG[(size_t)g * 128 + 64 + lane];
        u32x4 hp[8];
#pragma unroll
        for (int c = 0; c < 8; ++c) hp[c] = *(const u32x4*)(H + (size_t)g * D + c * 128 + sub * 8);
        {
            Row8 ra, rb;
            load_row8(ra, PU + (size_t)lidx[grp] * D + sub * 8);
            for (int it = 0; it < 32; it += 2) {
                load_row8(rb, PU + (size_t)lidx[(it + 1) * 4 + grp] * D + sub * 8);
                { const float s = dot_row8(ra, hp); const int e = it * 4 + grp; if (sub == 0) lact[e] = gelu_t(s) * lgate[e]; }
                if (it + 2 < 32) load_row8(ra, PU + (size_t)lidx[(it + 2) * 4 + grp] * D + sub * 8);
                { const float s = dot_row8(rb, hp); const int e = (it + 1) * 4 + grp; if (sub == 0) lact[e] = gelu_t(s) * lgate[e]; }
            }
        }
        float acc[16];
#pragma unroll
        for (int d = 0; d < 16; ++d) acc[d] = 0.f;
        {
            u32x4 va[4][2], vb[4][2];
#pragma unroll
            for (int k = 0; k < 4; ++k) { const bf16_t* p = PV + (size_t)lidx[k] * D + lane * 8; va[k][0] = *(const u32x4*)p; va[k][1] = *(const u32x4*)(p + 512); }
            for (int e = 0; e < 128; e += 8) {
#pragma unroll
                for (int k = 0; k < 4; ++k) { const bf16_t* p = PV + (size_t)lidx[e + 4 + k] * D + lane * 8; vb[k][0] = *(const u32x4*)p; vb[k][1] = *(const u32x4*)(p + 512); }
#pragma unroll
                for (int k = 0; k < 4; ++k) fma_row(acc, va[k][0], va[k][1], lact[e + k]);
                if (e + 8 < 128) {
#pragma unroll
                    for (int k = 0; k < 4; ++k) { const bf16_t* p = PV + (size_t)lidx[e + 8 + k] * D + lane * 8; va[k][0] = *(const u32x4*)p; va[k][1] = *(const u32x4*)(p + 512); }
                }
#pragma unroll
                for (int k = 0; k < 4; ++k) fma_row(acc, vb[k][0], vb[k][1], lact[e + 4 + k]);
            }
        }
        float* xr = X1 + (size_t)g * D + lane * 8;
        const float* g2 = modv(a, layer, var, 5) + lane * 8;
        float xn[16]; float ss = 0.f;
#pragma unroll
        for (int hh = 0; hh < 2; ++hh)
#pragma unroll
            for (int d = 0; d < 8; d += 4) {
                const f32x4 xv = *(const f32x4*)(xr + hh * 512 + d), gv = *(const f32x4*)(g2 + hh * 512 + d);
                const int o = hh * 8 + d;
                xn[o] = xv.x + gv.x * acc[o]; xn[o + 1] = xv.y + gv.y * acc[o + 1]; xn[o + 2] = xv.z + gv.z * acc[o + 2]; xn[o + 3] = xv.w + gv.w * acc[o + 3];
                ss += xn[o] * xn[o] + xn[o + 1] * xn[o + 1] + xn[o + 2] * xn[o + 2] + xn[o + 3] * xn[o + 3];
            }
        const float rinv = rsqrtf(wave_sum(ss) * (1.f / D) + EPS);
        if (mode == 0) {
            const float* gn = a.in[6] + D + lane * 8; const float* sh = modv(a, 1, var, 0) + lane * 8; const float* sc = modv(a, 1, var, 1) + lane * 8;
#pragma unroll
            for (int hh = 0; hh < 2; ++hh) {
                const int o = hh * 8;
                f32x4 o0, o1; o0.x = xn[o]; o0.y = xn[o + 1]; o0.z = xn[o + 2]; o0.w = xn[o + 3]; o1.x = xn[o + 4]; o1.y = xn[o + 5]; o1.z = xn[o + 6]; o1.w = xn[o + 7];
                *(f32x4*)(xr + hh * 512) = o0; *(f32x4*)(xr + hh * 512 + 4) = o1;
                unsigned w[4];
#pragma unroll
                for (int d = 0; d < 8; d += 2) { const int cc = hh * 512 + d; w[d >> 1] = pk2(xn[o + d] * rinv * gn[cc] * (1.f + sc[cc]) + sh[cc], xn[o + d + 1] * rinv * gn[cc + 1] * (1.f + sc[cc + 1]) + sh[cc + 1]); }
                u32x4 ow; ow.x = w[0]; ow.y = w[1]; ow.z = w[2]; ow.w = w[3];
                *(u32x4*)(H + (size_t)g * D + hh * 512 + lane * 8) = ow;
            }
        } else {
            const int b = g / RPB, t = g - b * RPB - CTXL;
            float* op = a.out + ((size_t)b * SEQ + t) * D + lane * 8; const float* gn = a.in[28] + lane * 8;
#pragma unroll
            for (int hh = 0; hh < 2; ++hh)
#pragma unroll
                for (int d = 0; d < 8; d += 4) { const int o = hh * 8 + d, cc = hh * 512 + d;
                    f32x4 ov; ov.x = xn[o] * rinv * gn[cc]; ov.y = xn[o + 1] * rinv * gn[cc + 1]; ov.z = xn[o + 2] * rinv * gn[cc + 2]; ov.w = xn[o + 3] * rinv * gn[cc + 3]; *(f32x4*)(op + cc) = ov; }
        }
    }
}

__device__ __forceinline__ void phase_inproj1(const Args& a, char* lds) {
    float* Cs = (float*)lds;
    const int tid = threadIdx.x;
    const bf16_t* H = (const bf16_t*)(a.ws + WS_H); const bf16_t* W = (const bf16_t*)(a.ws + WS_WIN1);
    const int NU = (MTOT / 128) * 20;
    for (int u = blockIdx.x; u < NU; u += gridDim.x) {
        const int rt = u / 20, ct = u % 20, row0 = rt * 128, col0 = ct * 128;
        if (ct < 10 && (rt % 66) < 2) continue;
        gemm_tile128(H + (size_t)row0 * D, D, W + (size_t)col0 * D, D, D, Cs);
        __syncthreads();
        const int rr = tid >> 2, q4 = tid & 3, g = row0 + rr;
        const float* crow = Cs + rr * CS_LD + q4 * 32;
        if (ct < 10) {
            bf16_t* o = (bf16_t*)(a.ws + WS_GG) + (size_t)g * DRNN + col0 + q4 * 32;
#pragma unroll
            for (int c = 0; c < 32; c += 2) *(unsigned*)(o + c) = pk2(gelu_t(crow[c]), gelu_t(crow[c + 1]));
        } else {
            bf16_t* o = (bf16_t*)(a.ws + WS_XR) + (size_t)g * DRNN + (col0 - DRNN) + q4 * 32;
#pragma unroll
            for (int c = 0; c < 32; c += 2) *(unsigned*)(o + c) = pk2(crow[c], crow[c + 1]);
        }
        __syncthreads();
    }
}

__device__ __forceinline__ void phase_rglru(const Args& a, char* lds, int pass) {
    const int tid = threadIdx.x;
    unsigned char* ws = a.ws;
    float* xc = (float*)lds;
    float* seg = xc + 128 * 128;
    const bf16_t* XR = (const bf16_t*)(ws + WS_XR); const bf16_t* GG = (const bf16_t*)(ws + WS_GG); bf16_t* YG = (bf16_t*)(ws + WS_YG);
    float* CARRY = (float*)(ws + WS_CARRY);
    const int j = tid & 127, tq = tid >> 7;
    const int NU = (MTOT / 128) * 10;
    for (int u = blockIdx.x; u < NU; u += gridDim.x) {
        const int T = u / 10, hb = u % 10, b = T / 66, tl = T % 66, row0 = T * 128, ch = hb * 128 + j;
        if (pass == 1 && tl < 2) continue;
        const int seq_lo = tl < 2 ? b * RPB : b * RPB + CTXL, seq_hi = tl < 2 ? b * RPB + CTXL : (b + 1) * RPB;
        {
            const float w0 = a.in[16][0 * DRNN + ch], w1 = a.in[16][1 * DRNN + ch], w2 = a.in[16][2 * DRNN + ch], w3 = a.in[16][3 * DRNN + ch], cb = a.in[17][ch];
            for (int tt = 0; tt < 32; ++tt) {
                const int g = row0 + tq * 32 + tt;
                const float xm2 = (g - 2 >= seq_lo) ? bf2f(XR[(size_t)(g - 2) * DRNN + ch]) : 0.f;
                const float xm1 = (g - 1 >= seq_lo) ? bf2f(XR[(size_t)(g - 1) * DRNN + ch]) : 0.f;
                const float x0 = bf2f(XR[(size_t)g * DRNN + ch]);
                const float xp1 = (g + 1 < seq_hi) ? bf2f(XR[(size_t)(g + 1) * DRNN + ch]) : 0.f;
                xc[(tq * 32 + tt) * 128 + j] = w0 * xm2 + w1 * xm1 + w2 * x0 + w3 * xp1 + cb;
            }
        }
        __syncthreads();
        float acc[4][32];
#pragma unroll
        for (int m = 0; m < 4; ++m)
#pragma unroll
            for (int tt = 0; tt < 32; ++tt) acc[m][tt] = 0.f;
        {
            const float* wa0 = a.in[18] + ((size_t)(0 * 10 + hb) * 128) * 128 + j; const float* wx0 = a.in[20] + ((size_t)(0 * 10 + hb) * 128) * 128 + j;
            const float* wa1 = a.in[18] + ((size_t)(1 * 10 + hb) * 128) * 128 + j; const float* wx1 = a.in[20] + ((size_t)(1 * 10 + hb) * 128) * 128 + j;
            for (int i = 0; i < 128; ++i) {
                const float w0 = wa0[i * 128], w1 = wx0[i * 128], w2 = wa1[i * 128], w3 = wx1[i * 128];
#pragma unroll
                for (int tt = 0; tt < 32; ++tt) { const float x = xc[(tq * 32 + tt) * 128 + i]; acc[0][tt] += x * w0; acc[1][tt] += x * w1; acc[2][tt] += x * w2; acc[3][tt] += x * w3; }
            }
        }
#pragma unroll
        for (int d = 0; d < 2; ++d) {
            const float ba = a.in[19][d * DRNN + ch], bx = a.in[21][d * DRNN + ch], lam = a.in[22][d * DRNN + ch];
            const float sp = log1pf(__expf(-lam));
#pragma unroll
            for (int tt = 0; tt < 32; ++tt) {
                const float r = sigmoidf_(acc[2 * d][tt] + ba), ig = sigmoidf_(acc[2 * d + 1][tt] + bx);
                const float la = -8.f * r * sp; const float av = __expf(la);
                const float uv = sqrtf(fmaxf(-expm1f(2.f * la), 0.f)) * ig * xc[(tq * 32 + tt) * 128 + j];
                acc[2 * d][tt] = av; acc[2 * d + 1][tt] = uv;
            }
        }
        {
            float Af = 1.f, Hf = 0.f, Ab = 1.f, Hb = 0.f;
#pragma unroll
            for (int tt = 0; tt < 32; ++tt) { Hf = acc[0][tt] * Hf + acc[1][tt]; Af *= acc[0][tt]; }
#pragma unroll
            for (int tt = 31; tt >= 0; --tt) { Hb = acc[2][tt] * Hb + acc[3][tt]; Ab *= acc[2][tt]; }
            seg[((0 * 4 + tq) * 128 + j) * 2] = Af; seg[((0 * 4 + tq) * 128 + j) * 2 + 1] = Hf;
            seg[((1 * 4 + tq) * 128 + j) * 2] = Ab; seg[((1 * 4 + tq) * 128 + j) * 2 + 1] = Hb;
        }
        __syncthreads();
        if (pass == 0) {
            if (tq == 0) {
                float A = 1.f, Hh = 0.f;
                for (int s = 0; s < 4; ++s) { const float sa = seg[((0 * 4 + s) * 128 + j) * 2], sh = seg[((0 * 4 + s) * 128 + j) * 2 + 1]; Hh = sa * Hh + sh; A *= sa; }
                float* c0 = CARRY + (((size_t)(b * 2 + 0) * 66 + tl) * DRNN + ch) * 2; c0[0] = A; c0[1] = Hh;
                A = 1.f; Hh = 0.f;
                for (int s = 3; s >= 0; --s) { const float sa = seg[((1 * 4 + s) * 128 + j) * 2], sh = seg[((1 * 4 + s) * 128 + j) * 2 + 1]; Hh = sa * Hh + sh; A *= sa; }
                float* c1 = CARRY + (((size_t)(b * 2 + 1) * 66 + tl) * DRNN + ch) * 2; c1[0] = A; c1[1] = Hh;
            }
        } else {
            float hf = 0.f, hbk = 0.f;
            for (int t2 = 0; t2 < tl; ++t2) { const float* c = CARRY + (((size_t)(b * 2 + 0) * 66 + t2) * DRNN + ch) * 2; hf = c[0] * hf + c[1]; }
            { const float* c = CARRY + (((size_t)(b * 2 + 1) * 66 + 1) * DRNN + ch) * 2; hbk = c[0] * hbk + c[1]; }
            { const float* c = CARRY + (((size_t)(b * 2 + 1) * 66 + 0) * DRNN + ch) * 2; hbk = c[0] * hbk + c[1]; }
            for (int t2 = 65; t2 > tl; --t2) { const float* c = CARRY + (((size_t)(b * 2 + 1) * 66 + t2) * DRNN + ch) * 2; hbk = c[0] * hbk + c[1]; }
            for (int s = 0; s < tq; ++s) { const float sa = seg[((0 * 4 + s) * 128 + j) * 2], sh = seg[((0 * 4 + s) * 128 + j) * 2 + 1]; hf = sa * hf + sh; }
            for (int s = 3; s > tq; --s) { const float sa = seg[((1 * 4 + s) * 128 + j) * 2], sh = seg[((1 * 4 + s) * 128 + j) * 2 + 1]; hbk = sa * hbk + sh; }
#pragma unroll
            for (int tt = 0; tt < 32; ++tt) { hf = acc[0][tt] * hf + acc[1][tt]; acc[0][tt] = hf; }
#pragma unroll
            for (int tt = 31; tt >= 0; --tt) { hbk = acc[2][tt] * hbk + acc[3][tt]; acc[0][tt] += hbk; }
#pragma unroll
            for (int tt = 0; tt < 32; ++tt) {
                const int g = row0 + tq * 32 + tt;
                YG[(size_t)g * DRNN + ch] = (bf16_t)f2bf(acc[0][tt] * bf2f(GG[(size_t)g * DRNN + ch]));
            }
        }
        __syncthreads();
    }
}

namespace pg8 {
constexpr int BM = 256, BK = 64, HALF = 128, HTB = HALF * BK * 2, STAGE_BYTES = 8 * HTB, NXCD = 8, WGM = 8;
__host__ __device__ __forceinline__ int lds_byte(int r, int c) { const int st = (r >> 4) * 2 + (c >> 5), rr = r & 15, cc = c & 31, ob = rr * 64 + cc * 2; return st * 1024 + (ob ^ (((ob >> 9) & 1) << 5)); }
__host__ __device__ __forceinline__ void stage_rc(int b, int& R, int& C) { const int st = b / 1024, sb = b % 1024, swz = sb ^ (((sb >> 9) & 1) << 5); R = (st >> 1) * 16 + swz / 64; C = (st & 1) * 32 + (swz % 64) / 2; }
__host__ __device__ __forceinline__ int perm32(int rho) { const int n = rho >> 4, i = rho & 15; return 8 * (i >> 2) + 4 * n + (i & 3); }
struct Unit { int pm, pn; };
struct Gemm { const bf16_t* A; const bf16_t* Bt; int M, N, K; };
struct StaticOrder {
    int nM, nN, nwg, G, c;
    __host__ __device__ void init(int M, int N, int G_, int c_) { nM = M / BM; nN = N / BM; nwg = nM * nN; G = G_; c = c_; }
    __host__ __device__ bool next(int i, Unit& u) const {
        const long L = (long)i * G + c; if (L >= nwg) return false;
        int wgid = (int)L; { const int q = nwg / NXCD, r = nwg % NXCD, xcd = wgid % NXCD, off = wgid / NXCD; wgid = (xcd < r ? xcd * (q + 1) : r * (q + 1) + (xcd - r) * q) + off; }
        const int nig = WGM * nN, gid = wgid / nig, fm = gid * WGM, gsz = (nM - fm) < WGM ? (nM - fm) : WGM;
        u.pm = fm + ((wgid % nig) % gsz); u.pn = (wgid % nig) / gsz; return true;
    }
    __device__ __forceinline__ void a_ready(const Unit&) const {}
    __device__ __forceinline__ void done(const Unit&) const {}
};
struct LatentOrder {
    StaticOrder S;
    __host__ __device__ void init(int N, int G_, int c_) { S.init(16384, N, G_, c_); }
    __host__ __device__ bool next(int i, Unit& u) const { if (!S.next(i, u)) return false; u.pm = u.pm + 1 + (u.pm >= 32 ? 1 : 0); return true; }
    __device__ __forceinline__ void a_ready(const Unit&) const {}
    __device__ __forceinline__ void done(const Unit&) const {}
};
__device__ __forceinline__ unsigned cvt_pk_bf16(float lo, float hi) { unsigned r; asm volatile("v_cvt_pk_bf16_f32 %0, %1, %2" : "=v"(r) : "v"(lo), "v"(hi)); return r; }
__device__ __forceinline__ u32x4 pack8(const f32x4& v0, const f32x4& v1) { u32x4 w; w.x = cvt_pk_bf16(v0[0], v0[1]); w.y = cvt_pk_bf16(v0[2], v0[3]); w.z = cvt_pk_bf16(v1[0], v1[1]); w.w = cvt_pk_bf16(v1[2], v1[3]); return w; }
__device__ __forceinline__ f32x4 gelu4(const f32x4& v) { f32x4 r; r.x = gelu_t(v.x); r.y = gelu_t(v.y); r.z = gelu_t(v.z); r.w = gelu_t(v.w); return r; }

struct EpiStore {
    static constexpr bool PERM = true, AFTER_DRAIN = false;
    bf16_t* O1; bf16_t* O2; int ld; int split_tile; int gelu_tiles;
    __device__ __forceinline__ void operator()(f32x4 (&acc)[2][2][4][2], const Unit& u, int wr, int wc, int fr, int fq) const {
        const bool second = u.pn >= split_tile; bf16_t* base = second ? O2 : O1; const int pnl = second ? u.pn - split_tile : u.pn; const bool dog = u.pn < gelu_tiles;
        const int rl0 = wr * 64 + fr, cl0 = wc * 32 + 8 * fq;
#pragma unroll
        for (int ai = 0; ai < 2; ++ai)
#pragma unroll
            for (int m = 0; m < 4; ++m) { bf16_t* rowp = base + (size_t)(u.pm * BM + ai * HALF + m * 16 + rl0) * ld + pnl * BM + cl0;
#pragma unroll
                for (int bj = 0; bj < 2; ++bj) { f32x4 v0 = acc[ai][bj][m][0], v1 = acc[ai][bj][m][1]; if (dog) { v0 = gelu4(v0); v1 = gelu4(v1); }
                    *(u32x4*)(rowp + bj * HALF) = pack8(v0, v1); } }
    }
};
struct EpiResid {
    static constexpr bool PERM = true, AFTER_DRAIN = false;
    const float* x; const float* ctx; const float* modbase; float* X1; int base_mode;
    __device__ __forceinline__ void operator()(f32x4 (&acc)[2][2][4][2], const Unit& u, int wr, int wc, int fr, int fq) const {
        const int b = u.pm / 33, tl = u.pm % 33, var = tl == 0 ? 2 : b;
        const float* gate = modbase + (size_t)var * 6144 + u.pn * BM;
        const float* basep = base_mode == 0 ? (tl == 0 ? ctx + (size_t)b * CTXL * D : x + ((size_t)b * SEQ + (size_t)(tl - 1) * 256) * D) : X1 + (size_t)u.pm * BM * D;
        float* outp = X1 + (size_t)u.pm * BM * D;
        const int rl0 = wr * 64 + fr, cl0 = u.pn * BM + wc * 32 + 8 * fq;
        f32x4 gv[2][2];
#pragma unroll
        for (int bj = 0; bj < 2; ++bj)
#pragma unroll
            for (int n = 0; n < 2; ++n) gv[bj][n] = *(const f32x4*)(gate + bj * HALF + wc * 32 + 8 * fq + 4 * n);
#pragma unroll
        for (int ai = 0; ai < 2; ++ai)
#pragma unroll
            for (int m = 0; m < 4; ++m) { const size_t off = (size_t)(ai * HALF + m * 16 + rl0) * D + cl0;
#pragma unroll
                for (int bj = 0; bj < 2; ++bj)
#pragma unroll
                    for (int n = 0; n < 2; ++n) { const f32x4 bs = *(const f32x4*)(basep + off + bj * HALF + 4 * n); *(f32x4*)(outp + off + bj * HALF + 4 * n) = bs + gv[bj][n] * acc[ai][bj][m][n]; } }
    }
};
struct EpiInproj0 {
    static constexpr bool PERM = true, AFTER_DRAIN = false;
    unsigned char* ws; const float* gmg; const float* qg; const float* kg; LAS float* P;
    __device__ __forceinline__ void operator()(f32x4 (&acc)[2][2][4][2], const Unit& u, int wr, int wc, int fr, int fq) const {
        int rl0 = wr * 64 + fr, cl0 = wc * 32 + 8 * fq; asm volatile("" : "+v"(rl0), "+v"(cl0));
        const int pn = u.pn; const size_t grow0 = (size_t)u.pm * BM;
        if (pn < 4) {
#pragma unroll
            for (int ai = 0; ai < 2; ++ai)
#pragma unroll
                for (int bj = 0; bj < 2; ++bj)
#pragma unroll
                    for (int m = 0; m < 4; ++m) { acc[ai][bj][m][0] = gelu4(acc[ai][bj][m][0]); acc[ai][bj][m][1] = gelu4(acc[ai][bj][m][1]); __builtin_amdgcn_sched_barrier(0); }
        }
        if (pn < 2 || pn == 7) {
            bf16_t* base = pn < 2 ? (bf16_t*)(ws + WS_U) + pn * BM : (bf16_t*)(ws + WS_V); const int ld = pn < 2 ? 512 : 256;
#pragma unroll
            for (int ai = 0; ai < 2; ++ai)
#pragma unroll
                for (int m = 0; m < 4; ++m) { bf16_t* rowp = base + (grow0 + ai * HALF + m * 16 + rl0) * ld + cl0;
#pragma unroll
                    for (int bj = 0; bj < 2; ++bj) *(u32x4*)(rowp + bj * HALF) = pack8(acc[ai][bj][m][0], acc[ai][bj][m][1]); }
            return;
        }
#pragma unroll
        for (int ai = 0; ai < 2; ++ai)
#pragma unroll
            for (int m = 0; m < 4; ++m)
#pragma unroll
                for (int bj = 0; bj < 2; ++bj) { const f32x4 a0 = acc[ai][bj][m][0], a1 = acc[ai][bj][m][1];
                    float s = (a0.x * a0.x + a0.y * a0.y) + (a0.z * a0.z + a0.w * a0.w) + (a1.x * a1.x + a1.y * a1.y) + (a1.z * a1.z + a1.w * a1.w);
                    s += __shfl_xor(s, 16); s += __shfl_xor(s, 32);
                    if (fq == 0) P[((ai * HALF + m * 16 + rl0) * 2 + bj) * 4 + wc] = s; __builtin_amdgcn_sched_barrier(0); }
        asm volatile("s_waitcnt lgkmcnt(0)" ::: "memory"); __builtin_amdgcn_s_barrier(); asm volatile("" ::: "memory");
        if (pn < 4) {
            bf16_t* base = (bf16_t*)(ws + WS_VV) + (pn - 2) * BM; const float* gp = gmg + (pn - 2) * BM + cl0;
            f32x4 g8[2][2];
#pragma unroll
            for (int bj = 0; bj < 2; ++bj) { g8[bj][0] = *(const f32x4*)(gp + bj * HALF); g8[bj][1] = *(const f32x4*)(gp + bj * HALF + 4); }
#pragma unroll
            for (int ai = 0; ai < 2; ++ai)
#pragma unroll
                for (int m = 0; m < 4; ++m) { const int rl = ai * HALF + m * 16 + rl0; bf16_t* rowp = base + (grow0 + rl) * 512 + cl0;
#pragma unroll
                    for (int bj = 0; bj < 2; ++bj) { const f32x4 p = *(const LAS f32x4*)(P + (rl * 2 + bj) * 4);
                        const float rinv = rsqrtf(((p.x + p.y) + (p.z + p.w)) * (1.f / 128.f) + EPS);
                        *(u32x4*)(rowp + bj * HALF) = pack8(acc[ai][bj][m][0] * rinv * g8[bj][0], acc[ai][bj][m][1] * rinv * g8[bj][1]); }
                    asm volatile("" ::: "memory"); __builtin_amdgcn_sched_barrier(0); }
            return;
        }
        {
            const bool isq = pn < 6; const float* gn = isq ? qg : kg;
            const int grp = cl0 >> 3, fo = (grp >> 3) * 64 + (grp & 7) * 4;
            const f32x4 gA = *(const f32x4*)(gn + fo), gB = *(const f32x4*)(gn + fo + 32);
            bf16_t* base = isq ? (bf16_t*)(ws + WS_Q) + (pn - 4) * BM : (bf16_t*)(ws + WS_K); const int ld = isq ? 512 : 256;
            const int tl = u.pm % 33; const bool lat = tl != 0; const int ax = grp >> 3, f0 = (grp & 7) * 4;
            const float* rope = (const float*)(ws + WS_ROPE);
#pragma unroll
            for (int ai = 0; ai < 2; ++ai)
#pragma unroll
                for (int m = 0; m < 4; ++m) { const int rl = ai * HALF + m * 16 + rl0; bf16_t* rowp = base + (grow0 + rl) * ld + cl0;
                    f32x4 cs0 = {1.f, 0.f, 1.f, 0.f}, cs1 = {1.f, 0.f, 1.f, 0.f};
                    if (lat) { const int t = (tl - 1) * 256 + rl; const int pos = ax == 0 ? (t >> 6) : (t & 63); const float* rp = rope + (pos * 32 + f0) * 2; cs0 = *(const f32x4*)rp; cs1 = *(const f32x4*)(rp + 4); }
#pragma unroll
                    for (int bj = 0; bj < 2; ++bj) { const f32x4 p = *(const LAS f32x4*)(P + (rl * 2 + bj) * 4);
                        const float rinv = rsqrtf(((p.x + p.y) + (p.z + p.w)) * (1.f / 128.f) + EPS);
                        const f32x4 x1 = acc[ai][bj][m][0] * rinv * gA, x2 = acc[ai][bj][m][1] * rinv * gB;
                        f32x4 o1, o2;
                        o1.x = x1.x * cs0.x - x2.x * cs0.y; o2.x = x2.x * cs0.x + x1.x * cs0.y;
                        o1.y = x1.y * cs0.z - x2.y * cs0.w; o2.y = x2.y * cs0.z + x1.y * cs0.w;
                        o1.z = x1.z * cs1.x - x2.z * cs1.y; o2.z = x2.z * cs1.x + x1.z * cs1.y;
                        o1.w = x1.w * cs1.z - x2.w * cs1.w; o2.w = x2.w * cs1.z + x1.w * cs1.w;
                        *(u32x4*)(rowp + bj * HALF) = pack8(o1, o2); }
                    asm volatile("" ::: "memory"); __builtin_amdgcn_sched_barrier(0); }
        }
    }
};

template <class Epi, class Sched, bool ALIGN_EPI = false, bool SP2 = false>
__device__ __forceinline__ void gemm_phase(LAS unsigned char* lds, const Gemm g, const Sched& S, const Epi& E) {
    const int tid = threadIdx.x, wid = __builtin_amdgcn_readfirstlane(tid >> 6), lane = tid & 63, wr = wid >> 2, wc = wid & 3, fr = lane & 15, fq = lane >> 4;
    const int K = g.K, nt = K / BK;
    unsigned voffA[2], voffB[2];
#pragma unroll
    for (int i = 0; i < 2; ++i) { int R, C; stage_rc(tid * 16 + i * 8192, R, C); const int Rb = Epi::PERM ? ((R & ~31) + perm32(R & 31)) : R;
        voffA[i] = (unsigned)(R * K + C) * 2u; voffB[i] = (unsigned)(Rb * K + C) * 2u; }
    const size_t kstep = (size_t)(BK * 2);
    const size_t hstep = (size_t)HALF * K * 2;
    const size_t tstep = 2 * hstep;
    const unsigned ldsw = (unsigned)wid * 1024u;
    const int aoff = lds_byte(wr * 64 + fr, fq * 8), boff = lds_byte(wc * 32 + fr, fq * 8);
#define PG8_SA(b, h) (((b) * 2 + (h)) * HTB)
#define PG8_SB(b, h) ((4 + (b) * 2 + (h)) * HTB)
#define PG8_STAGE(bufoff, gbase, voff) do { _Pragma("unroll") for (int _i = 0; _i < 2; ++_i) \
        __builtin_amdgcn_global_load_lds((const unsigned*)((const char*)(gbase) + (voff)[_i]), (LAS unsigned*)(lds + (bufoff) + ldsw + _i * 8192), 16, 0, 0); } while (0)
#define PG8_LDA(dst, b, h) do { _Pragma("unroll") for (int m = 0; m < 4; ++m) _Pragma("unroll") for (int k = 0; k < 2; ++k) dst[m][k] = *(const LAS bf16x8*)(lds + PG8_SA(b, h) + aoff + m * 2048 + k * 1024); } while (0)
#define PG8_LDB(dst, b, h) do { _Pragma("unroll") for (int n = 0; n < 2; ++n) _Pragma("unroll") for (int k = 0; k < 2; ++k) dst[n][k] = *(const LAS bf16x8*)(lds + PG8_SB(b, h) + boff + n * 2048 + k * 1024); } while (0)
#define PG8_MMA(ai, bj, At, Bt) do { __builtin_amdgcn_s_setprio(1); _Pragma("unroll") for (int m = 0; m < 4; ++m) _Pragma("unroll") for (int n = 0; n < 2; ++n) _Pragma("unroll") for (int k = 0; k < 2; ++k) \
        acc[ai][bj][m][n] = __builtin_amdgcn_mfma_f32_16x16x32_bf16(Bt[n][k], At[m][k], acc[ai][bj][m][n], 0, 0, 0); __builtin_amdgcn_s_setprio(0); } while (0)
#define PG8_WAIT_V(n) asm volatile("s_waitcnt vmcnt(" #n ")" ::: "memory")
#define PG8_WAIT_L(n) asm volatile("s_waitcnt lgkmcnt(" #n ")" ::: "memory")
#define PG8_BAR __builtin_amdgcn_s_barrier()
#define PG8_SCHED __builtin_amdgcn_sched_barrier(0)
    Unit cur, nxt; int ui = 0;
    if (!S.next(0, cur)) return;
    f32x4 acc[2][2][4][2];
#pragma unroll
    for (int a = 0; a < 2; ++a)
#pragma unroll
        for (int b = 0; b < 2; ++b)
#pragma unroll
            for (int m = 0; m < 4; ++m)
#pragma unroll
                for (int n = 0; n < 2; ++n) acc[a][b][m][n] = (f32x4){0.f, 0.f, 0.f, 0.f};
    bf16x8 At[4][2], B0[2][2], B1[2][2];
    const char* cA = (const char*)g.A + (size_t)cur.pm * tstep; const char* cB = (const char*)g.Bt + (size_t)cur.pn * tstep;
    S.a_ready(cur);
    if constexpr (SP2) {
        PG8_STAGE(PG8_SB(0, 0), cB, voffB); PG8_STAGE(PG8_SB(0, 1), cB + hstep, voffB); PG8_STAGE(PG8_SA(0, 0), cA, voffA); PG8_STAGE(PG8_SA(0, 1), cA + hstep, voffA);
        if (wr == 1) PG8_BAR;
        PG8_WAIT_V(2); PG8_BAR;
        PG8_STAGE(PG8_SB(1, 0), cB + kstep, voffB); PG8_STAGE(PG8_SA(1, 0), cA + kstep, voffA); PG8_STAGE(PG8_SB(1, 1), cB + hstep + kstep, voffB);
        PG8_WAIT_V(6); PG8_BAR;
    } else {
        PG8_STAGE(PG8_SB(0, 0), cB, voffB); PG8_STAGE(PG8_SA(0, 0), cA, voffA); PG8_STAGE(PG8_SB(0, 1), cB + hstep, voffB); PG8_STAGE(PG8_SA(0, 1), cA + hstep, voffA);
        if (wr == 1) PG8_BAR;
        PG8_WAIT_V(4); PG8_BAR;
        PG8_STAGE(PG8_SB(1, 0), cB + kstep, voffB); PG8_STAGE(PG8_SA(1, 0), cA + kstep, voffA); PG8_STAGE(PG8_SB(1, 1), cB + hstep + kstep, voffB);
        PG8_WAIT_V(6); PG8_BAR;
    }
    for (;;) {
        const bool has_next = S.next(ui + 1, nxt);
        const char* nA = has_next ? (const char*)g.A + (size_t)nxt.pm * tstep : cA; const char* nB = has_next ? (const char*)g.Bt + (size_t)nxt.pn * tstep : cB;
        for (int t = 0; t < nt; t += 2) {
            const bool last = (t == nt - 2);
            const char* a1 = cA + (size_t)(t + 1) * kstep;
            const char* a2 = last ? nA : cA + (size_t)(t + 2) * kstep; const char* b2 = last ? nB : cB + (size_t)(t + 2) * kstep;
            const char* a3 = a2 + kstep; const char* b3 = b2 + kstep;
            if (last && has_next) S.a_ready(nxt);
            if constexpr (SP2) {
            PG8_LDB(B0, 0, 0); PG8_LDB(B1, 0, 1); PG8_SCHED; PG8_LDA(At, 0, 0); PG8_STAGE(PG8_SA(1, 1), a1 + hstep, voffA);
            PG8_WAIT_V(8); PG8_WAIT_L(0); PG8_BAR; PG8_MMA(0, 0, At, B0); PG8_MMA(0, 1, At, B1); PG8_BAR; PG8_SCHED;
            PG8_LDA(At, 0, 1); PG8_STAGE(PG8_SB(0, 0), b2, voffB); PG8_STAGE(PG8_SB(0, 1), b2 + hstep, voffB); PG8_STAGE(PG8_SA(0, 0), a2, voffA);
            PG8_WAIT_V(8); PG8_WAIT_L(0); PG8_BAR; PG8_MMA(1, 0, At, B0); PG8_MMA(1, 1, At, B1); PG8_BAR; PG8_SCHED;
            PG8_LDB(B0, 1, 0); PG8_LDB(B1, 1, 1); PG8_SCHED; PG8_LDA(At, 1, 0); PG8_STAGE(PG8_SA(0, 1), a2 + hstep, voffA);
            PG8_WAIT_V(8); PG8_WAIT_L(0); PG8_BAR; PG8_MMA(0, 0, At, B0); PG8_MMA(0, 1, At, B1); PG8_BAR; PG8_SCHED;
            PG8_LDA(At, 1, 1); PG8_STAGE(PG8_SB(1, 0), b3, voffB); PG8_STAGE(PG8_SB(1, 1), b3 + hstep, voffB); PG8_STAGE(PG8_SA(1, 0), a3, voffA);
            PG8_WAIT_V(8); PG8_WAIT_L(0); PG8_BAR; PG8_MMA(1, 0, At, B0); PG8_MMA(1, 1, At, B1); PG8_BAR; PG8_SCHED;
            } else {
            PG8_LDB(B0, 0, 0); PG8_SCHED; PG8_LDA(At, 0, 0); PG8_STAGE(PG8_SA(1, 1), a1 + hstep, voffA);
            PG8_WAIT_L(8); PG8_BAR; PG8_WAIT_L(0); PG8_MMA(0, 0, At, B0); PG8_BAR; PG8_SCHED;
            PG8_LDB(B1, 0, 1); PG8_STAGE(PG8_SB(0, 0), b2, voffB);
            PG8_BAR; PG8_WAIT_L(0); PG8_MMA(0, 1, At, B1); PG8_BAR;
            PG8_LDA(At, 0, 1); PG8_STAGE(PG8_SA(0, 0), a2, voffA);
            PG8_BAR; PG8_WAIT_L(0); PG8_MMA(1, 0, At, B0); PG8_BAR; PG8_SCHED;
            PG8_STAGE(PG8_SB(0, 1), b2 + hstep, voffB);
            PG8_WAIT_V(6); PG8_BAR; PG8_MMA(1, 1, At, B1); PG8_BAR;
            PG8_LDB(B0, 1, 0); PG8_SCHED; PG8_LDA(At, 1, 0); PG8_STAGE(PG8_SA(0, 1), a2 + hstep, voffA);
            PG8_WAIT_L(8); PG8_BAR; PG8_WAIT_L(0); PG8_MMA(0, 0, At, B0); PG8_BAR; PG8_SCHED;
            PG8_LDB(B1, 1, 1); PG8_STAGE(PG8_SB(1, 0), b3, voffB);
            PG8_BAR; PG8_WAIT_L(0); PG8_MMA(0, 1, At, B1); PG8_BAR;
            PG8_LDA(At, 1, 1); PG8_STAGE(PG8_SA(1, 0), a3, voffA);
            PG8_BAR; PG8_WAIT_L(0); PG8_MMA(1, 0, At, B0); PG8_BAR; PG8_SCHED;
            PG8_STAGE(PG8_SB(1, 1), b3 + hstep, voffB);
            PG8_WAIT_V(6); PG8_BAR; PG8_MMA(1, 1, At, B1); PG8_BAR;
            }
        }
        if constexpr (ALIGN_EPI) { if (wr == 0) PG8_BAR; }
        if constexpr (!Epi::AFTER_DRAIN) { E(acc, cur, wr, wc, fr, fq); S.done(cur); }
        if (!has_next) break;
#pragma unroll
        for (int a = 0; a < 2; ++a)
#pragma unroll
            for (int b = 0; b < 2; ++b)
#pragma unroll
                for (int m = 0; m < 4; ++m)
#pragma unroll
                    for (int n = 0; n < 2; ++n) acc[a][b][m][n] = (f32x4){0.f, 0.f, 0.f, 0.f};
        cur = nxt; cA = nA; cB = nB; ++ui;
        if constexpr (ALIGN_EPI) { if (wr == 1) PG8_BAR; }
    }
    PG8_WAIT_V(0);
    if constexpr (!ALIGN_EPI) { if (wr == 0) PG8_BAR; }
    PG8_BAR;
#undef PG8_SA
#undef PG8_SB
#undef PG8_STAGE
#undef PG8_LDA
#undef PG8_LDB
#undef PG8_MMA
#undef PG8_WAIT_V
#undef PG8_WAIT_L
#undef PG8_BAR
#undef PG8_SCHED
}
}

__device__ __forceinline__ void fphase_inproj0(const Args& a, char* lds) {
    pg8::Gemm g{(const bf16_t*)(a.ws + WS_H), (const bf16_t*)(a.ws + WS_WIN0), MTOT, 2048, 1024};
    pg8::StaticOrder S; S.init(MTOT, 2048, (int)gridDim.x, (int)blockIdx.x);
    pg8::EpiInproj0 E{a.ws, a.in[9], a.in[12], a.in[13], (LAS float*)((LAS char*)lds + 131072)};
    pg8::gemm_phase<pg8::EpiInproj0, pg8::StaticOrder, true, true>((LAS unsigned char*)lds, g, S, E);
}
__device__ __forceinline__ void fphase_outproj0(const Args& a, char* lds) {
    pg8::Gemm g{(const bf16_t*)(a.ws + WS_AO), (const bf16_t*)(a.ws + WS_WOUT0), MTOT, 1024, 1024};
    pg8::StaticOrder S; S.init(MTOT, 1024, (int)gridDim.x, (int)blockIdx.x);
    pg8::EpiResid E{a.in[0], a.in[2], (const float*)(a.ws + WS_MODV) + 2 * 1024, (float*)(a.ws + WS_X1), 0};
    pg8::gemm_phase<pg8::EpiResid, pg8::StaticOrder, true, true>((LAS unsigned char*)lds, g, S, E);
}
__device__ __forceinline__ void fphase_peerq0(const Args& a, char* lds) {
    pg8::Gemm g{(const bf16_t*)(a.ws + WS_H), (const bf16_t*)(a.ws + WS_WQ), MTOT, 2048, 1024};
    pg8::StaticOrder S; S.init(MTOT, 2048, (int)gridDim.x, (int)blockIdx.x);
    pg8::EpiStore E{(bf16_t*)(a.ws + WS_QP), (bf16_t*)(a.ws + WS_QP), 2048, 1000, 0};
    pg8::gemm_phase<pg8::EpiStore, pg8::StaticOrder, true, true>((LAS unsigned char*)lds, g, S, E);
}
__device__ __forceinline__ void fphase_inproj1(const Args& a, char* lds) {
    pg8::Gemm g{(const bf16_t*)(a.ws + WS_H), (const bf16_t*)(a.ws + WS_WIN1), MTOT, 2560, 1024};
    pg8::StaticOrder S; S.init(MTOT, 2560, (int)gridDim.x, (int)blockIdx.x);
    pg8::EpiStore E{(bf16_t*)(a.ws + WS_GG), (bf16_t*)(a.ws + WS_XR), 1280, 5, 5};
    pg8::gemm_phase<pg8::EpiStore, pg8::StaticOrder, true, true>((LAS unsigned char*)lds, g, S, E);
}
__device__ __forceinline__ void fphase_outproj1(const Args& a, char* lds) {
    pg8::Gemm g{(const bf16_t*)(a.ws + WS_YG), (const bf16_t*)(a.ws + WS_WOUT1), MTOT, 1024, 1280};
    pg8::LatentOrder S; S.init(1024, (int)gridDim.x, (int)blockIdx.x);
    pg8::EpiResid E{a.in[0], a.in[2], (const float*)(a.ws + WS_MODV) + 3 * 6144 + 2 * 1024, (float*)(a.ws + WS_X1), 1};
    pg8::gemm_phase<pg8::EpiResid, pg8::LatentOrder, true, true>((LAS unsigned char*)lds, g, S, E);
}
__device__ __forceinline__ void fphase_peerq1(const Args& a, char* lds) {
    pg8::Gemm g{(const bf16_t*)(a.ws + WS_H), (const bf16_t*)(a.ws + WS_WQ) + (size_t)2048 * 1024, MTOT, 2048, 1024};
    pg8::LatentOrder S; S.init(2048, (int)gridDim.x, (int)blockIdx.x);
    pg8::EpiStore E{(bf16_t*)(a.ws + WS_QP), (bf16_t*)(a.ws + WS_QP), 2048, 1000, 0};
    pg8::gemm_phase<pg8::EpiStore, pg8::LatentOrder, true, true>((LAS unsigned char*)lds, g, S, E);
}

constexpr int NPHASE = 17;
__global__ void __launch_bounds__(NTHR, 2) mega(Args a) {
    extern __shared__ __attribute__((aligned(16))) char lds[];
    volatile LAS unsigned* MISC = (volatile LAS unsigned*)((LAS char*)lds + LDS_MISC);
    if (threadIdx.x < 64) MISC[threadIdx.x] = 0u;
    __syncthreads();
    XcdBarrier bar; bar.bar = (unsigned*)(a.ws + WS_CTL) + 4096; bar.x = 0; bar.st = nullptr;
    const bool multi = (a.ph_hi - a.ph_lo) > 1;
    if (multi) bar = xcd_barrier_post((unsigned*)(a.ws + WS_CTL) + 4096, MISC + 8);
    const int lo = a.ph_lo, hi = a.ph_hi;
    unsigned char* ws = a.ws;
#define IN(k) (lo <= (k) && (k) < hi)
#define SEAM(k) do { if (IN(k) && IN((k) + 1)) xcd_barrier(bar); } while (0)
    if (IN(0)) { phase_prep(a, lds); } SEAM(0);
    if (IN(1)) { phase_norm(a, 0, 0, a.in[6], 0, 1, false); } SEAM(1);
    if (IN(2)) { fphase_inproj0(a, lds); } SEAM(2);
    if (IN(3)) { phase_gmlp(a, lds); phase_attn(a, lds); } SEAM(3);
    if (IN(4)) { fphase_outproj0(a, lds); } SEAM(4);
    if (IN(5)) { phase_norm(a, 0, 1, a.in[7], 3, 4, false); } SEAM(5);
    if (IN(6)) { fphase_peerq0(a, lds); } SEAM(6);
    if (IN(7)) { phase_peer_topk2(a, 0, false); } SEAM(7);
    if (IN(8)) { phase_peer_gather2(a, lds, 0, 0); } SEAM(8);
    if (IN(9)) { fphase_inproj1(a, lds); } SEAM(9);
    if (IN(10)) { phase_rglru(a, lds, 0); } SEAM(10);
    if (IN(11)) { phase_rglru(a, lds, 1); } SEAM(11);
    if (IN(12)) { fphase_outproj1(a, lds); } SEAM(12);
    if (IN(13)) { phase_norm(a, 1, 1, a.in[7] + D, 3, 4, true); } SEAM(13);
    if (IN(14)) { fphase_peerq1(a, lds); } SEAM(14);
    if (IN(15)) { phase_peer_topk2(a, 1, true); } SEAM(15);
    if (IN(16)) { phase_peer_gather2(a, lds, 1, 1); }
#undef IN
#undef SEAM
}

extern "C" void kernel_launch(void* const* d_in, const int* in_sizes, int n_in, void* d_out, int out_size, void* d_ws, size_t ws_size, hipStream_t stream) {
    static int grid = 0;
    if (grid == 0) {
        if (n_in != 29 || out_size != NB * SEQ * D || ws_size < WS_END) {
            fprintf(stderr, "kernel_launch: unexpected shapes: n_in %d out %d ws %zu (need %zu)\n", n_in, out_size, ws_size, (size_t)WS_END); grid = -1; return; }
        int dev = 0, cus = 0, per_cu = 0;
        if (hipGetDevice(&dev) != hipSuccess || hipDeviceGetAttribute(&cus, hipDeviceAttributeMultiprocessorCount, dev) != hipSuccess) { grid = -1; return; }
        if (hipFuncSetAttribute((const void*)mega, hipFuncAttributeMaxDynamicSharedMemorySize, LDS_BYTES) != hipSuccess) { fprintf(stderr, "kernel_launch: hipFuncSetAttribute failed\n"); grid = -1; return; }
        if (hipOccupancyMaxActiveBlocksPerMultiprocessor(&per_cu, (const void*)mega, NTHR, LDS_BYTES) != hipSuccess || per_cu < 1)
            fprintf(stderr, "kernel_launch: occupancy query reports %d blocks per CU\n", per_cu);
        (void)hipGetLastError();
        grid = cus;
    }
    if (grid < 0) return;
    (void)hipMemsetAsync((char*)d_ws + WS_CTL, 0, CTL_BYTES, stream);
    Args a{};
    for (int i = 0; i < 29; ++i) a.in[i] = (const float*)d_in[i];
    a.out = (float*)d_out; a.ws = (unsigned char*)d_ws;
#if MK_SINGLE
    a.ph_lo = 0; a.ph_hi = NPHASE;
    hipLaunchKernelGGL(mega, dim3(grid), dim3(NTHR), LDS_BYTES, stream, a);
#else
    for (int p = 0; p < NPHASE; ++p) { a.ph_lo = p; a.ph_hi = p + 1; hipLaunchKernelGGL(mega, dim3(grid), dim3(NTHR), LDS_BYTES, stream, a); }
#endif
    const hipError_t le = hipPeekAtLastError();
    if (le != hipSuccess) fprintf(stderr, "kernel_launch: launch failed: %s\n", hipGetErrorName(le));
}
```

```cpp
#include <hip/hip_runtime.h>
#include <cstdio>
#include <cstdint>

#ifndef MK_SINGLE
#define MK_SINGLE 1
#endif

#define GAS __attribute__((address_space(1)))
#define LAS __attribute__((address_space(3)))

typedef unsigned short bf16_t;
typedef short bf16x8 __attribute__((ext_vector_type(8)));
typedef float f32x4 __attribute__((ext_vector_type(4)));
typedef float f32x16 __attribute__((ext_vector_type(16)));
typedef unsigned u32x4 __attribute__((ext_vector_type(4)));
typedef unsigned u32x2 __attribute__((ext_vector_type(2)));

constexpr int D = 1024, NB = 2, SEQ = 8192, CTXL = 256;
constexpr int RPB = SEQ + CTXL;
constexpr int MTOT = NB * RPB;
constexpr int AB_IN = 2048, A_W = 512, DRNN = 1280, NEXP = 16384;
constexpr float EPS = 1e-6f;
constexpr int NTHR = 512, NWAVE = 8;

constexpr size_t MiB = 1u << 20;
constexpr size_t WS_CTL = 0, CTL_BYTES = 1 * MiB;
constexpr size_t WS_MODV = 1 * MiB;
constexpr size_t WS_ROPE = 1 * MiB + 512 * 1024;
constexpr size_t WS_WIN0 = 2 * MiB;
constexpr size_t WS_WOUT0 = 6 * MiB;
constexpr size_t WS_WIN1 = 8 * MiB;
constexpr size_t WS_WOUT1 = 13 * MiB;
constexpr size_t WS_WQ = 16 * MiB;
constexpr size_t WS_KEYS = 24 * MiB;
constexpr size_t WS_GWS = 25 * MiB;
constexpr size_t WS_WAT = 26 * MiB;
constexpr size_t WS_WXT = 27 * MiB;
constexpr size_t WS_CARRY = 28 * MiB;
constexpr size_t WS_PU = 32 * MiB;
constexpr size_t WS_PV = 96 * MiB;
constexpr size_t WS_H = 160 * MiB;
constexpr size_t WS_X1 = 193 * MiB;
constexpr size_t WS_SELI = 259 * MiB;
constexpr size_t WS_SELG = 268 * MiB;
constexpr size_t WS_R = 277 * MiB;
constexpr size_t WS_U = WS_R;
constexpr size_t WS_VV = WS_R + 17 * MiB;
constexpr size_t WS_Q = WS_R + 34 * MiB;
constexpr size_t WS_K = WS_R + 51 * MiB;
constexpr size_t WS_V = WS_R + 60 * MiB;
constexpr size_t WS_AO = WS_R + 69 * MiB;
constexpr size_t WS_QP = WS_R;
constexpr size_t WS_GG = WS_R;
constexpr size_t WS_XR = WS_R + 42 * MiB;
constexpr size_t WS_YG = WS_R + 84 * MiB;
constexpr size_t WS_END = WS_R + 126 * MiB;

constexpr int LDS_BYTES = 147456;
constexpr int LDS_MISC = 145408;

__device__ __forceinline__ float bf2f(bf16_t v) { return __uint_as_float(((unsigned)v) << 16); }
__device__ __forceinline__ unsigned f2bf(float f) { unsigned u = __float_as_uint(f); return (u + 0x7fffu + ((u >> 16) & 1u)) >> 16; }
__device__ __forceinline__ unsigned pk2(float lo, float hi) { return f2bf(lo) | (f2bf(hi) << 16); }
__device__ __forceinline__ float bflo(unsigned w) { return __uint_as_float(w << 16); }
__device__ __forceinline__ float bfhi(unsigned w) { return __uint_as_float(w & 0xffff0000u); }
__device__ __forceinline__ float gelu_t(float x) { const float y = -2.302208198144325f * (x + 0.044715f * x * x * x); return x * __builtin_amdgcn_rcpf(1.f + __builtin_amdgcn_exp2f(y)); }
__device__ __forceinline__ float sigmoidf_(float x) { return 1.f / (1.f + __expf(-x)); }
__device__ __forceinline__ float wave_sum(float v) {
#pragma unroll
    for (int o = 1; o < 64; o <<= 1) v += __shfl_xor(v, o);
    return v;
}
__host__ __device__ __forceinline__ int sigma_head(int j) { const int grp = j >> 3, n = (j >> 2) & 1, e = j & 3; return (grp >> 3) * 64 + n * 32 + (grp & 7) * 4 + e; }

struct Args {
    const float* in[29];
    float* out;
    unsigned char* ws;
    int ph_lo, ph_hi;
};

__device__ __forceinline__ int row_variant(int g) { const int b = g / RPB, i = g - b * RPB; return i < CTXL ? 2 : b; }
__device__ __forceinline__ const float* row_src(const Args& a, int g) {
    const int b = g / RPB, i = g - b * RPB;
    return i < CTXL ? a.in[2] + ((size_t)b * CTXL + i) * D : a.in[0] + ((size_t)b * SEQ + (i - CTXL)) * D;
}
__device__ __forceinline__ const float* modv(const Args& a, int layer, int variant, int which) {
    return (const float*)(a.ws + WS_MODV) + ((size_t)(layer * 3 + variant) * 6 + which) * D;
}

#define XB_TMO      128
#define XB_XCNT(j)  (256  + 64 * (j))
#define XB_XSUB(j)  (1280 + 64 * (j))
#define XB_XGEN(j)  (2304 + 64 * (j))
#define XB_TOP      3328
#define XB_TOPGEN   3392
#define XCD_BAR_WORDS 3456
#define XB_SPIN_CAP (1u << 22)
__device__ __forceinline__ unsigned xb_ld(unsigned* p)              { return __hip_atomic_load(p, __ATOMIC_RELAXED, __HIP_MEMORY_SCOPE_AGENT); }
__device__ __forceinline__ unsigned xb_add(unsigned* p, unsigned v) { return __hip_atomic_fetch_add(p, v, __ATOMIC_RELAXED, __HIP_MEMORY_SCOPE_AGENT); }
__device__ __forceinline__ unsigned xb_xcc_id() { return (unsigned)__builtin_amdgcn_s_getreg((3 << 11) | 20) & 0xFu; }
#define XB_SPIN(cond, bar) do { unsigned _sp = 0; while (cond) { __builtin_amdgcn_s_sleep(1); \
    if ((++_sp & 255u) == 0u) { if (xb_ld(&(bar)[XB_TMO])) break; if (_sp > XB_SPIN_CAP) { atomicAdd(&(bar)[XB_TMO], 1u); break; } } } } while (0)
struct XcdBarrier { unsigned* bar; unsigned x; volatile LAS unsigned* st; };
__device__ __forceinline__ XcdBarrier xcd_barrier_post(unsigned* bar, volatile LAS unsigned* st) {
    XcdBarrier b; b.bar = bar; b.x = xb_xcc_id(); b.st = st;
    if (threadIdx.x == 0) (void)xb_add(&bar[XB_XCNT(b.x)], 1u);
    return b;
}
__device__ __forceinline__ void xcd_barrier_complete(unsigned* bar, unsigned x, unsigned& nloc, unsigned& nx) {
    const unsigned G = gridDim.x * gridDim.y * gridDim.z;
    unsigned sum, cnt, mine, sp = 0u;
    for (;;) {
        sum = 0u; cnt = 0u; mine = 0u;
#pragma unroll
        for (unsigned j = 0; j < 16; ++j) { const unsigned c = xb_ld(&bar[XB_XCNT(j)]); sum += c; cnt += (c > 0u) ? 1u : 0u; mine = (j == x) ? c : mine; }
        if (sum == G) break;
        __builtin_amdgcn_s_sleep(1);
        if ((++sp & 255u) == 0u) { if (xb_ld(&bar[XB_TMO])) break; if (sp > XB_SPIN_CAP) { atomicAdd(&bar[XB_TMO], 1u); break; } }
    }
    nloc = mine > 0u ? mine : 1u; nx = cnt > 0u ? cnt : 1u;
}
__device__ __forceinline__ void xcd_barrier(const XcdBarrier& b) {
    asm volatile("s_waitcnt vmcnt(0)" ::: "memory");
    __syncthreads();
    if (threadIdx.x == 0) {
        unsigned* bar = b.bar;
        __builtin_amdgcn_s_waitcnt(0);
        unsigned nloc = b.st[0], nx = b.st[1];
        if (nloc == 0u) { xcd_barrier_complete(bar, b.x, nloc, nx); b.st[0] = nloc; b.st[1] = nx; }
        const unsigned old = xb_add(&bar[XB_XSUB(b.x)], 1u);
        const unsigned gen = old / nloc;
        if (old + 1u == (gen + 1u) * nloc) {
            __builtin_amdgcn_fence(__ATOMIC_RELEASE, "agent");
            asm volatile("s_waitcnt vmcnt(0)" ::: "memory");
            const unsigned og = xb_add(&bar[XB_TOP], 1u);
            const unsigned tg = og / nx;
            if (og + 1u == (tg + 1u) * nx) xb_add(&bar[XB_TOPGEN], 1u);
            else XB_SPIN(xb_ld(&bar[XB_TOPGEN]) == tg, bar);
            __builtin_amdgcn_fence(__ATOMIC_ACQUIRE, "agent");
            xb_add(&bar[XB_XGEN(b.x)], 1u);
            asm volatile("s_waitcnt vmcnt(0)" ::: "memory");
        } else {
            XB_SPIN(xb_ld(&bar[XB_XGEN(b.x)]) == gen, bar);
            __builtin_amdgcn_fence(__ATOMIC_ACQUIRE, "agent");
            asm volatile("s_waitcnt vmcnt(0)" ::: "memory");
        }
    }
    __syncthreads();
}

__device__ __forceinline__ void transpose_item(const float* src, int Ns, bf16_t* dst, int Kd, int n0, int k0, int perm_lo, int perm_hi, float* tile) {
    const int tid = threadIdx.x;
    {
        const int nn = tid & 63; int n = n0 + nn;
        if (n >= perm_lo && n < perm_hi) { const int rel = n - perm_lo; n = perm_lo + (rel & ~127) + sigma_head(rel & 127); }
#pragma unroll
        for (int i = 0; i < 8; ++i) { const int kk = (tid >> 6) + 8 * i; tile[kk * 65 + nn] = src[(size_t)(k0 + kk) * Ns + n]; }
    }
    __syncthreads();
    {
        const int n = tid >> 3, kc = (tid & 7) * 8;
        u32x4 o;
        o.x = pk2(tile[(kc + 0) * 65 + n], tile[(kc + 1) * 65 + n]); o.y = pk2(tile[(kc + 2) * 65 + n], tile[(kc + 3) * 65 + n]);
        o.z = pk2(tile[(kc + 4) * 65 + n], tile[(kc + 5) * 65 + n]); o.w = pk2(tile[(kc + 6) * 65 + n], tile[(kc + 7) * 65 + n]);
        *(u32x4*)(dst + (size_t)(n0 + n) * Kd + k0 + kc) = o;
    }
    __syncthreads();
}
__device__ __forceinline__ void cvt_stream(const float* src, bf16_t* dst, size_t n8, size_t gtid, size_t gthreads) {
    for (size_t i = gtid; i < n8; i += gthreads) {
        const f32x4 a = *(const f32x4*)(src + i * 8), b = *(const f32x4*)(src + i * 8 + 4);
        u32x4 o; o.x = pk2(a.x, a.y); o.y = pk2(a.z, a.w); o.z = pk2(b.x, b.y); o.w = pk2(b.z, b.w);
        *(u32x4*)(dst + i * 8) = o;
    }
}
__device__ __forceinline__ void phase_prep(const Args& a, char* lds) {
    const int tid = threadIdx.x, lane = tid & 63, wid = tid >> 6;
    float* tile = (float*)lds;
    unsigned char* ws = a.ws;
    constexpr int I_MOD = 192;
    constexpr int I_WIN0 = (1024 / 64) * (2048 / 64), I_WOUT0 = (1024 / 64) * (1024 / 64), I_WIN1 = (1024 / 64) * (2560 / 64), I_WOUT1 = (1280 / 64) * (1024 / 64);
    constexpr int I_WQ = 2 * (1024 / 64) * (2048 / 64), I_WAX = 40 * 4;
    constexpr int NIT = I_MOD + I_WIN0 + I_WOUT0 + I_WIN1 + I_WOUT1 + I_WQ + I_WAX;
    for (int it = blockIdx.x; it < NIT; it += gridDim.x) {
        int r = it;
        if (r < I_MOD) {
            const int l = r / 96, n0 = (r % 96) * 64;
            const float* W = a.in[4] + (size_t)l * D * 6144;
            float s0 = 0.f, s1 = 0.f, s2 = 0.f;
            for (int k = wid * 128; k < wid * 128 + 128; ++k) {
                const float w = W[(size_t)k * 6144 + n0 + lane];
                const float c0 = a.in[1][k], c1 = a.in[1][D + k], c2 = a.in[3][k];
                s0 += c0 * sigmoidf_(c0) * w; s1 += c1 * sigmoidf_(c1) * w; s2 += c2 * sigmoidf_(c2) * w;
            }
            tile[(wid * 3 + 0) * 64 + lane] = s0; tile[(wid * 3 + 1) * 64 + lane] = s1; tile[(wid * 3 + 2) * 64 + lane] = s2;
            __syncthreads();
            if (tid < 192) {
                const int v = tid / 64, ln = tid & 63; float s = a.in[5][(size_t)l * 6144 + n0 + ln];
                for (int w = 0; w < 8; ++w) s += tile[(w * 3 + v) * 64 + ln];
                ((float*)(ws + WS_MODV))[(size_t)(l * 3 + v) * 6144 + n0 + ln] = s;
            }
            __syncthreads();
            continue;
        }
        r -= I_MOD;
        if (r < I_WIN0) { const int nb = r % 32, kb = r / 32; transpose_item(a.in[8], 2048, (bf16_t*)(ws + WS_WIN0), 1024, nb * 64, kb * 64, 1024, 1792, tile); continue; }
        r -= I_WIN0;
        if (r < I_WOUT0) { const int nb = r % 16, kb = r / 16; transpose_item(a.in[14], 1024, (bf16_t*)(ws + WS_WOUT0), 1024, nb * 64, kb * 64, 0, 0, tile); continue; }
        r -= I_WOUT0;
        if (r < I_WIN1) { const int nb = r % 40, kb = r / 40; transpose_item(a.in[15], 2560, (bf16_t*)(ws + WS_WIN1), 1024, nb * 64, kb * 64, 0, 0, tile); continue; }
        r -= I_WIN1;
        if (r < I_WOUT1) { const int nb = r % 16, kb = r / 16; transpose_item(a.in[23], 1024, (bf16_t*)(ws + WS_WOUT1), 1280, nb * 64, kb * 64, 0, 0, tile); continue; }
        r -= I_WOUT1;
        if (r < I_WQ) { const int l = r / 512, q = r % 512, nb = q % 32, kb = q / 32;
            transpose_item(a.in[24] + (size_t)l * 1024 * 2048, 2048, (bf16_t*)(ws + WS_WQ) + (size_t)l * 2048 * 1024, 1024, nb * 64, kb * 64, 0, 0, tile); continue; }
        r -= I_WQ;
        { const int m = r / 4, q = r % 4, nb = q % 2, kb = q / 2;
            const int which = m / 20, dh = m % 20;
            const float* src = a.in[which == 0 ? 18 : 20] + (size_t)dh * 128 * 128;
            bf16_t* dst = (bf16_t*)(ws + (which == 0 ? WS_WAT : WS_WXT)) + (size_t)dh * 128 * 128;
            transpose_item(src, 128, dst, 128, nb * 64, kb * 64, 0, 0, tile);
        }
    }
    const size_t gtid = (size_t)blockIdx.x * NTHR + tid, gthreads = (size_t)gridDim.x * NTHR;
    cvt_stream(a.in[25], (bf16_t*)(ws + WS_KEYS), (size_t)2 * 8 * 2 * 128 * 128 / 8, gtid, gthreads);
    cvt_stream(a.in[10], (bf16_t*)(ws + WS_GWS), (size_t)4 * 128 * 128 / 8, gtid, gthreads);
    cvt_stream(a.in[26], (bf16_t*)(ws + WS_PU), (size_t)2 * NEXP * D / 8, gtid, gthreads);
    cvt_stream(a.in[27], (bf16_t*)(ws + WS_PV), (size_t)2 * NEXP * D / 8, gtid, gthreads);
    for (size_t i = gtid; i < 128 * 32; i += gthreads) {
        const int pos = (int)(i / 32), f = (int)(i % 32);
        const float inv = powf(10000.f, -(float)f / 32.f); const float ang = (float)pos * inv;
        float* R = (float*)(ws + WS_ROPE); R[i * 2] = cosf(ang); R[i * 2 + 1] = sinf(ang);
    }
}

__device__ __forceinline__ void norm_row_store(const f32x4 (&v)[4], const float* g, const float* sh, const float* sc, bf16_t* orow, int lane) {
    float s = 0.f;
#pragma unroll
    for (int j = 0; j < 4; ++j) s += (v[j].x * v[j].x + v[j].y * v[j].y) + (v[j].z * v[j].z + v[j].w * v[j].w);
    const float rinv = rsqrtf(wave_sum(s) * (1.f / D) + EPS);
#pragma unroll
    for (int j = 0; j < 4; ++j) {
        const int c = j * 256 + lane * 4;
        const f32x4 gg = *(const f32x4*)(g + c), s1 = *(const f32x4*)(sh + c), s2 = *(const f32x4*)(sc + c);
        const float o0 = v[j].x * rinv * gg.x * (1.f + s2.x) + s1.x, o1 = v[j].y * rinv * gg.y * (1.f + s2.y) + s1.y;
        const float o2 = v[j].z * rinv * gg.z * (1.f + s2.z) + s1.z, o3 = v[j].w * rinv * gg.w * (1.f + s2.w) + s1.w;
        u32x2 w; w.x = pk2(o0, o1); w.y = pk2(o2, o3);
        *(u32x2*)(orow + c) = w;
    }
}
__device__ __forceinline__ void phase_norm(const Args& a, int layer, int src_mode, const float* gain, int which_sh, int which_sc, bool latent_only) {
    const int lane = threadIdx.x & 63, gw = blockIdx.x * NWAVE + (threadIdx.x >> 6), ngw = gridDim.x * NWAVE;
    bf16_t* H = (bf16_t*)(a.ws + WS_H);
    const float* X1 = (const float*)(a.ws + WS_X1);
    for (int g = gw; g < MTOT; g += ngw) {
        const int var = row_variant(g);
        if (latent_only && var == 2) continue;
        const float* xr = src_mode == 0 ? row_src(a, g) : X1 + (size_t)g * D;
        f32x4 v[4];
#pragma unroll
        for (int j = 0; j < 4; ++j) v[j] = *(const f32x4*)(xr + j * 256 + lane * 4);
        norm_row_store(v, gain, modv(a, layer, var, which_sh), modv(a, layer, var, which_sc), H + (size_t)g * D, lane);
    }
}

constexpr int CS_LD = 132;
__device__ __forceinline__ void gemm_tile128(const bf16_t* A, int lda, const bf16_t* Bt, int ldb, int K, float* Cs) {
    const int tid = threadIdx.x, lane = tid & 63, wid = tid >> 6, r = lane & 31, h = lane >> 5, wr = wid >> 1, wc = wid & 1;
    const bf16_t* ap = A + (size_t)(wr * 32 + r) * lda + 8 * h;
    const bf16_t* bp0 = Bt + (size_t)(wc * 64 + r) * ldb + 8 * h;
    const bf16_t* bp1 = bp0 + (size_t)32 * ldb;
    f32x16 acc0 = {}, acc1 = {};
#pragma unroll 4
    for (int k = 0; k < K; k += 16) {
        const bf16x8 av = *(const bf16x8*)(ap + k), b0 = *(const bf16x8*)(bp0 + k), b1 = *(const bf16x8*)(bp1 + k);
        acc0 = __builtin_amdgcn_mfma_f32_32x32x16_bf16(av, b0, acc0, 0, 0, 0);
        acc1 = __builtin_amdgcn_mfma_f32_32x32x16_bf16(av, b1, acc1, 0, 0, 0);
    }
#pragma unroll
    for (int i = 0; i < 16; ++i) {
        const int row = wr * 32 + (i & 3) + 8 * (i >> 2) + 4 * h;
        Cs[row * CS_LD + wc * 64 + r] = acc0[i];
        Cs[row * CS_LD + wc * 64 + 32 + r] = acc1[i];
    }
}

__device__ __forceinline__ void phase_inproj0(const Args& a, char* lds) {
    float* Cs = (float*)lds;
    const int tid = threadIdx.x;
    unsigned char* ws = a.ws;
    const bf16_t* H = (const bf16_t*)(ws + WS_H); const bf16_t* W = (const bf16_t*)(ws + WS_WIN0);
    const float* rope = (const float*)(ws + WS_ROPE);
    const int NU = (MTOT / 128) * 16;
    for (int u = blockIdx.x; u < NU; u += gridDim.x) {
        const int rt = u / 16, ct = u % 16, row0 = rt * 128, col0 = ct * 128;
        gemm_tile128(H + (size_t)row0 * D, D, W + (size_t)col0 * D, D, D, Cs);
        __syncthreads();
        const int rr = tid >> 2, q4 = tid & 3, g = row0 + rr;
        float* crow = Cs + rr * CS_LD + q4 * 32;
        if (ct < 4) {
            bf16_t* o = (bf16_t*)(ws + WS_U) + (size_t)g * 512 + col0 + q4 * 32;
#pragma unroll
            for (int c = 0; c < 32; c += 2) *(unsigned*)(o + c) = pk2(gelu_t(crow[c]), gelu_t(crow[c + 1]));
        } else if (ct < 8) {
            const int gg = ct - 4; float ss = 0.f;
#pragma unroll
            for (int c = 0; c < 32; ++c) { const float v = gelu_t(crow[c]); crow[c] = v; ss += v * v; }
            ss += __shfl_xor(ss, 1); ss += __shfl_xor(ss, 2);
            const float rinv = rsqrtf(ss * (1.f / 128.f) + EPS);
            const float* gn = a.in[9] + gg * 128 + q4 * 32;
            bf16_t* o = (bf16_t*)(ws + WS_VV) + (size_t)g * 512 + gg * 128 + q4 * 32;
#pragma unroll
            for (int c = 0; c < 32; c += 2) *(unsigned*)(o + c) = pk2(crow[c] * rinv * gn[c], crow[c + 1] * rinv * gn[c + 1]);
        } else if (ct < 14) {
            const bool isq = ct < 12; const int hh = isq ? ct - 8 : ct - 12;
            float ss = 0.f;
#pragma unroll
            for (int c = 0; c < 32; ++c) ss += crow[c] * crow[c];
            ss += __shfl_xor(ss, 1); ss += __shfl_xor(ss, 2);
            const float rinv = rsqrtf(ss * (1.f / 128.f) + EPS);
            const float* gn = a.in[isq ? 12 : 13];
            const int b = g / RPB, i = g - b * RPB; const bool lat = i >= CTXL; const int t = i - CTXL;
            bf16_t* o = (isq ? (bf16_t*)(ws + WS_Q) + (size_t)g * 512 : (bf16_t*)(ws + WS_K) + (size_t)g * 256) + hh * 128 + q4 * 32;
#pragma unroll
            for (int c8 = 0; c8 < 32; c8 += 8) {
                float y[8];
#pragma unroll
                for (int e = 0; e < 8; ++e) { const int j = q4 * 32 + c8 + e; y[e] = crow[c8 + e] * rinv * gn[sigma_head(j)]; }
                if (lat) {
                    const int grp = (q4 * 32 + c8) >> 3, ax = grp >> 3; const int pos = ax == 0 ? (t >> 6) : (t & 63);
#pragma unroll
                    for (int e = 0; e < 4; ++e) { const int f = (grp & 7) * 4 + e; const float cs = rope[(pos * 32 + f) * 2], sn = rope[(pos * 32 + f) * 2 + 1];
                        const float x1 = y[e], x2 = y[e + 4]; y[e] = x1 * cs - x2 * sn; y[e + 4] = x2 * cs + x1 * sn; }
                }
                u32x4 w; w.x = pk2(y[0], y[1]); w.y = pk2(y[2], y[3]); w.z = pk2(y[4], y[5]); w.w = pk2(y[6], y[7]);
                *(u32x4*)(o + c8) = w;
            }
        } else {
            bf16_t* o = (bf16_t*)(ws + WS_V) + (size_t)g * 256 + (ct - 14) * 128 + q4 * 32;
#pragma unroll
            for (int c = 0; c < 32; c += 2) *(unsigned*)(o + c) = pk2(crow[c], crow[c + 1]);
        }
        __syncthreads();
    }
}

__device__ __forceinline__ void phase_gmlp(const Args& a, char* lds) {
    const int tid = threadIdx.x;
    unsigned char* ws = a.ws;
    float* vt = (float*)lds;
    const bf16_t* VV = (const bf16_t*)(ws + WS_VV); const bf16_t* U = (const bf16_t*)(ws + WS_U); bf16_t* AO = (bf16_t*)(ws + WS_AO);
    const int NU = (MTOT / 128) * 4;
    for (int u = blockIdx.x; u < NU; u += gridDim.x) {
        const int ch = u / 4, g = u % 4, row0 = ch * 128;
        for (int i = tid; i < 128 * 128; i += NTHR) { const int q = i >> 7, c = i & 127; vt[i] = bf2f(VV[(size_t)(row0 + q) * 512 + g * 128 + c]); }
        __syncthreads();
        const int c = tid & 127, pq = tid >> 7;
        const float* wsg = a.in[10] + (size_t)g * 128 * 128;
        for (int pp = 0; pp < 32; ++pp) {
            const int p = pq * 32 + pp; float s = 0.f;
            for (int q = 0; q < 128; ++q) s += wsg[p * 128 + q] * vt[q * 128 + c];
            s += a.in[11][g * 128 + p];
            const float uu = bf2f(U[(size_t)(row0 + p) * 512 + g * 128 + c]);
            AO[(size_t)(row0 + p) * 1024 + g * 128 + c] = (bf16_t)f2bf(uu * s);
        }
        __syncthreads();
    }
}

__device__ __forceinline__ void phase_attn_naive(const Args& a, char* lds) {
    const int tid = threadIdx.x;
    unsigned char* ws = a.ws;
    float* Ks = (float*)lds;
    float* Vs = Ks + 32 * 128;
    float* part = Vs + 32 * 128;
    const bf16_t* Q = (const bf16_t*)(ws + WS_Q); const bf16_t* Kb = (const bf16_t*)(ws + WS_K); const bf16_t* Vb = (const bf16_t*)(ws + WS_V);
    bf16_t* AO = (bf16_t*)(ws + WS_AO);
    const int NU = 512 + 16;
    for (int u = blockIdx.x; u < NU; u += gridDim.x) {
        int b, h, qrow0, nkeys;
        if (u < 512) { b = u / 256; h = (u / 64) % 4; qrow0 = b * RPB + CTXL + (u % 64) * 128; nkeys = RPB; }
        else { const int v = u - 512; b = v / 8; h = (v / 2) % 4; qrow0 = b * RPB + (v % 2) * 128; nkeys = CTXL; }
        const int kvh = h >> 1, krow0 = b * RPB;
        const int qi = tid & 127, qt = tid >> 7;
        float q[32], o[32];
        {
            const bf16_t* qp = Q + (size_t)(qrow0 + qi) * 512 + h * 128 + qt * 32;
#pragma unroll
            for (int d = 0; d < 32; d += 2) { const unsigned w = *(const unsigned*)(qp + d); q[d] = bflo(w) * 0.08838834764831845f; q[d + 1] = bfhi(w) * 0.08838834764831845f; }
#pragma unroll
            for (int d = 0; d < 32; ++d) o[d] = 0.f;
        }
        float m = -1e30f, l = 0.f;
        for (int k0 = 0; k0 < nkeys; k0 += 32) {
            {
                const int key = tid >> 4, cs = (tid & 15) * 8;
                const u32x4 kw = *(const u32x4*)(Kb + (size_t)(krow0 + k0 + key) * 256 + kvh * 128 + cs);
                const u32x4 vw = *(const u32x4*)(Vb + (size_t)(krow0 + k0 + key) * 256 + kvh * 128 + cs);
                float* kd = Ks + key * 128 + cs; float* vd = Vs + key * 128 + cs;
                kd[0] = bflo(kw.x); kd[1] = bfhi(kw.x); kd[2] = bflo(kw.y); kd[3] = bfhi(kw.y); kd[4] = bflo(kw.z); kd[5] = bfhi(kw.z); kd[6] = bflo(kw.w); kd[7] = bfhi(kw.w);
                vd[0] = bflo(vw.x); vd[1] = bfhi(vw.x); vd[2] = bflo(vw.y); vd[3] = bfhi(vw.y); vd[4] = bflo(vw.z); vd[5] = bfhi(vw.z); vd[6] = bflo(vw.w); vd[7] = bfhi(vw.w);
            }
            __syncthreads();
#pragma unroll 2
            for (int j = 0; j < 32; ++j) {
                const float* kr = Ks + j * 128 + qt * 32; float acc = 0.f;
#pragma unroll
                for (int d = 0; d < 32; d += 4) { const f32x4 kv = *(const f32x4*)(kr + d); acc += q[d] * kv.x + q[d + 1] * kv.y + q[d + 2] * kv.z + q[d + 3] * kv.w; }
                part[(qt * 32 + j) * 128 + qi] = acc;
            }
            __syncthreads();
            float mx = m;
#pragma unroll 4
            for (int j = 0; j < 32; ++j) { const float sj = (part[(0 * 32 + j) * 128 + qi] + part[(1 * 32 + j) * 128 + qi]) + (part[(2 * 32 + j) * 128 + qi] + part[(3 * 32 + j) * 128 + qi]); mx = fmaxf(mx, sj); }
            const float alpha = __expf(m - mx); m = mx; float ps = 0.f;
#pragma unroll
            for (int d = 0; d < 32; ++d) o[d] *= alpha;
#pragma unroll 2
            for (int j = 0; j < 32; ++j) {
                const float sj = (part[(0 * 32 + j) * 128 + qi] + part[(1 * 32 + j) * 128 + qi]) + (part[(2 * 32 + j) * 128 + qi] + part[(3 * 32 + j) * 128 + qi]);
                const float pj = __expf(sj - mx); ps += pj;
                const float* vr = Vs + j * 128 + qt * 32;
#pragma unroll
                for (int d = 0; d < 32; d += 4) { const f32x4 vv = *(const f32x4*)(vr + d); o[d] += pj * vv.x; o[d + 1] += pj * vv.y; o[d + 2] += pj * vv.z; o[d + 3] += pj * vv.w; }
            }
            l = l * alpha + ps;
            __syncthreads();
        }
        const float rl = 1.f / l;
        bf16_t* op = AO + (size_t)(qrow0 + qi) * 1024 + 512 + h * 128 + qt * 32;
#pragma unroll
        for (int d = 0; d < 32; d += 2) *(unsigned*)(op + d) = pk2(o[d] * rl, o[d + 1] * rl);
    }
}

namespace fa {
typedef short s16x4 __attribute__((ext_vector_type(4)));
constexpr int QBLK = 32, KVBLK = 64, LDQ = 512, LDK = 256, LDO = 1024;
constexpr float SCALE = 0.088388347648318440f, THR = 8.f;
constexpr size_t SHM_V = KVBLK * 128 * 2, SHM_K = KVBLK * 128 * 2, SHM_ATTN = 2 * SHM_V + 2 * SHM_K + NWAVE * 64 * 4;
#define KSWZ(row, colB) ((row) * 256 + ((colB) ^ (((row) & 7) << 4)))
#define SBAR() __builtin_amdgcn_sched_barrier(0)
__device__ __forceinline__ int crow(int r, int hi) { return (r & 3) + 8 * (r >> 2) + 4 * hi; }
__device__ __forceinline__ unsigned cvtpk(float lo, float hi) { unsigned r; asm volatile("v_cvt_pk_bf16_f32 %0, %1, %2" : "=v"(r) : "v"(lo), "v"(hi)); return r; }
__device__ __forceinline__ void partialSM(f32x16& p0, f32x16& p1, float& m_reg, float& mn, float& alpha) {
  constexpr float C = SCALE * 1.4426950408889634f;
  float pmax = p0[0]; for (int r = 1; r < 16; ++r) pmax = fmaxf(pmax, p0[r]); for (int r = 0; r < 16; ++r) pmax = fmaxf(pmax, p1[r]);
  { auto rr = __builtin_amdgcn_permlane32_swap(__float_as_uint(pmax), __float_as_uint(pmax), false, false);
    pmax = fmaxf(__uint_as_float(rr[0]), __uint_as_float(rr[1])); }
  if (__builtin_expect(__all(pmax - m_reg <= THR / SCALE), 1)) { mn = m_reg; alpha = 1.f; }
  else { mn = fmaxf(m_reg, pmax); alpha = __builtin_amdgcn_exp2f((m_reg - mn) * C); m_reg = mn; }
  float mnC = -mn * C;
  for (int r = 0; r < 16; ++r) p0[r] = fmaf(p0[r], C, mnC); for (int r = 0; r < 16; ++r) p1[r] = fmaf(p1[r], C, mnC);
  for (int r = 0; r < 16; ++r) p0[r] = __builtin_amdgcn_exp2f(p0[r]);
}
__device__ __forceinline__ void finishSM(f32x16& p0, f32x16& p1, float alpha, float& l_reg, bf16x8& pa0, bf16x8& pa1, bf16x8& pa2, bf16x8& pa3) {
  for (int r = 0; r < 16; ++r) p1[r] = __builtin_amdgcn_exp2f(p1[r]);
  float ps = 0; for (int r = 0; r < 16; ++r) ps += p0[r]; for (int r = 0; r < 16; ++r) ps += p1[r];
  { auto rr = __builtin_amdgcn_permlane32_swap(__float_as_uint(ps), __float_as_uint(ps), false, false);
    ps = __uint_as_float(rr[0]) + __uint_as_float(rr[1]); }
  l_reg = l_reg * alpha + ps;
#define PK4(P, BASE, OUT) do { unsigned a0 = cvtpk(P[BASE + 0], P[BASE + 1]), a1 = cvtpk(P[BASE + 2], P[BASE + 3]);   \
    unsigned b0 = cvtpk(P[BASE + 4], P[BASE + 5]), b1 = cvtpk(P[BASE + 6], P[BASE + 7]);                              \
    auto r0 = __builtin_amdgcn_permlane32_swap(a0, b0, false, false); auto r1 = __builtin_amdgcn_permlane32_swap(a1, b1, false, false); \
    u32x4 w = {r0[0], r1[0], r0[1], r1[1]}; OUT = *reinterpret_cast<bf16x8*>(&w); } while (0)
  PK4(p0, 0, pa0); PK4(p0, 8, pa1); PK4(p1, 0, pa2); PK4(p1, 8, pa3);
#undef PK4
}
__device__ __forceinline__ void qkt(f32x16& p0, f32x16& p1, const bf16_t* Ks, const bf16x8* qr, int r32, int hi) {
  p0 = f32x16{}; p1 = f32x16{};
  for (int d0 = 0; d0 < 8; ++d0) { int cb = (d0 * 16 + hi * 8) * 2;
    bf16x8 b0 = *reinterpret_cast<const bf16x8*>((const char*)Ks + KSWZ(r32, cb));
    bf16x8 b1 = *reinterpret_cast<const bf16x8*>((const char*)Ks + KSWZ(32 + r32, cb));
    p0 = __builtin_amdgcn_mfma_f32_32x32x16_bf16(b0, qr[d0], p0, 0, 0, 0);
    p1 = __builtin_amdgcn_mfma_f32_32x32x16_bf16(b1, qr[d0], p1, 0, 0, 0); }
}
__device__ __forceinline__ int v_st(int k, int c) { const int kk = (k & ~0xC) | ((k & 4) << 1) | ((k & 8) >> 1); return ((kk >> 3) * 4 + (c >> 5)) * 512 + ((kk & 7) * 32 + (c & 31)) * 2; }
__device__ __forceinline__ int v_rd_base(int lane) { return ((lane & 3) << 3) | (((lane >> 2) & 3) << 6) | (((lane >> 4) & 1) << 5) | (((lane >> 5) & 1) << 8); }
constexpr int v_rd_off(int d0, int ks, int half) { return d0 * 512 + ks * 4096 + half * 2048; }
template <int OFF> __device__ __forceinline__ s16x4 tr_read(int vb) {
  s16x4 r; asm volatile("ds_read_b64_tr_b16 %0, %1 offset:%2" : "=&v"(r) : "v"(vb), "i"(OFF) : "memory"); return r;
}
template <int D0> __device__ __forceinline__ void pv_one(f32x16& od, int vb, bf16x8 pa0, bf16x8 pa1, bf16x8 pa2, bf16x8 pa3) {
  const s16x4 l0 = tr_read<v_rd_off(D0, 0, 0)>(vb), h0 = tr_read<v_rd_off(D0, 0, 1)>(vb), l1 = tr_read<v_rd_off(D0, 1, 0)>(vb), h1 = tr_read<v_rd_off(D0, 1, 1)>(vb);
  const s16x4 l2 = tr_read<v_rd_off(D0, 2, 0)>(vb), h2 = tr_read<v_rd_off(D0, 2, 1)>(vb), l3 = tr_read<v_rd_off(D0, 3, 0)>(vb), h3 = tr_read<v_rd_off(D0, 3, 1)>(vb);
  asm volatile("s_waitcnt lgkmcnt(0)" ::: "memory"); SBAR();
#define PK(L, H) (bf16x8){L[0], L[1], L[2], L[3], H[0], H[1], H[2], H[3]}
  od = __builtin_amdgcn_mfma_f32_32x32x16_bf16(pa0, PK(l0, h0), od, 0, 0, 0);
  od = __builtin_amdgcn_mfma_f32_32x32x16_bf16(pa1, PK(l1, h1), od, 0, 0, 0);
  od = __builtin_amdgcn_mfma_f32_32x32x16_bf16(pa2, PK(l2, h2), od, 0, 0, 0);
  od = __builtin_amdgcn_mfma_f32_32x32x16_bf16(pa3, PK(l3, h3), od, 0, 0, 0);
#undef PK
}
__device__ __forceinline__ void pv_d0(f32x16* o, int vb, bf16x8 pa0, bf16x8 pa1, bf16x8 pa2, bf16x8 pa3) {
  pv_one<0>(o[0], vb, pa0, pa1, pa2, pa3); pv_one<1>(o[1], vb, pa0, pa1, pa2, pa3); pv_one<2>(o[2], vb, pa0, pa1, pa2, pa3); pv_one<3>(o[3], vb, pa0, pa1, pa2, pa3);
}
__device__ __forceinline__ void attn_dense_body(const bf16_t* __restrict__ Qb, const bf16_t* __restrict__ Kh, const bf16_t* __restrict__ Vh,
                                                bf16_t* __restrict__ Ob, int seq, char* lds) {
  const int tid = threadIdx.x, wid = tid >> 6, lane = tid & 63, r32 = lane & 31, hi = lane >> 5;
  bf16_t* V_lds = (bf16_t*)lds; bf16_t* K_lds = (bf16_t*)(lds + 2 * SHM_V);
  float* ws = (float*)(lds + 2 * SHM_V + 2 * SHM_K) + wid * 64; float* li_l = ws; float* al_l = ws + 32;
  float m_reg = -1e30f, l_reg = 0; f32x16 o[4] = {}; bf16x8 qr[8];
  const bf16_t* Qw = Qb + (long)(wid * QBLK + r32) * LDQ + hi * 8;
#pragma unroll
  for (int d0 = 0; d0 < 8; ++d0) qr[d0] = *reinterpret_cast<const bf16x8*>(Qw + d0 * 16);
  const int sr = tid >> 4, sc = (tid & 15) * 8, vst0 = v_st(sr, sc), vst1 = v_st(32 + sr, sc);
  const int vb0 = (int)(uintptr_t)V_lds + v_rd_base(lane);
  struct { bf16x8 vs0, vs1, ks0, ks1; } sr_[2];
#define SLOAD(i, k0) do { sr_[i].vs0 = *reinterpret_cast<const bf16x8*>(&Vh[(long)((k0) + sr) * LDK + sc]); sr_[i].vs1 = *reinterpret_cast<const bf16x8*>(&Vh[(long)((k0) + 32 + sr) * LDK + sc]); \
    sr_[i].ks0 = *reinterpret_cast<const bf16x8*>(&Kh[(long)((k0) + sr) * LDK + sc]); sr_[i].ks1 = *reinterpret_cast<const bf16x8*>(&Kh[(long)((k0) + 32 + sr) * LDK + sc]); } while (0)
#define SWRITE(b, i) do { *(bf16x8*)((char*)V_lds + (b) * SHM_V + vst0) = sr_[i].vs0;          \
    *(bf16x8*)((char*)V_lds + (b) * SHM_V + vst1) = sr_[i].vs1; int kc = sc * 2;               \
    *(bf16x8*)((char*)K_lds + (b) * SHM_K + KSWZ(sr, kc)) = sr_[i].ks0;                       \
    *(bf16x8*)((char*)K_lds + (b) * SHM_K + KSWZ(32 + sr, kc)) = sr_[i].ks1; } while (0)
#define SWAIT() asm volatile("s_waitcnt vmcnt(4)" ::: "memory")
#define RESC(a) do { if (__any((a) < 1.f)) { if (hi == 0) al_l[r32] = (a); asm volatile("s_waitcnt lgkmcnt(0)" ::: "memory"); \
    for (int d = 0; d < 4; ++d) for (int r = 0; r < 16; ++r) o[d][r] *= al_l[crow(r, hi)]; } } while (0)
  f32x16 pA0, pA1, pB0, pB1; float mnA, mnB, alA, alB; bf16x8 pa0, pa1, pa2, pa3; const int NT = seq / KVBLK;
  constexpr int SE = 0, SO = 1;
  SLOAD(SE, 0); asm volatile("s_waitcnt vmcnt(0)" ::: "memory"); SWRITE(0, SE); __syncthreads();
  qkt(pA0, pA1, K_lds, qr, r32, hi); partialSM(pA0, pA1, m_reg, mnA, alA);
  SLOAD(SO, KVBLK); if (2 < NT) SLOAD(SE, 2 * KVBLK);
  SWAIT(); SWRITE(1, SO); __syncthreads();
  for (int j = 1; j + 1 < NT; j += 2) {
    SBAR(); qkt(pB0, pB1, (bf16_t*)((char*)K_lds + SHM_K), qr, r32, hi);
    finishSM(pA0, pA1, alA, l_reg, pa0, pa1, pa2, pa3); SBAR();
    SLOAD(SO, (j + 2) * KVBLK); SBAR();
    pv_d0(o, vb0, pa0, pa1, pa2, pa3); partialSM(pB0, pB1, m_reg, mnB, alB);
    __syncthreads(); SWAIT(); SWRITE(0, SE);
    RESC(alB); __syncthreads();
    SBAR(); qkt(pA0, pA1, K_lds, qr, r32, hi);
    finishSM(pB0, pB1, alB, l_reg, pa0, pa1, pa2, pa3); SBAR();
    if (j + 3 < NT) SLOAD(SE, (j + 3) * KVBLK); SBAR();
    pv_d0(o, vb0 + (int)SHM_V, pa0, pa1, pa2, pa3); partialSM(pA0, pA1, m_reg, mnA, alA);
    __syncthreads(); SWAIT(); SWRITE(1, SO);
    RESC(alA); __syncthreads();
  }
  SBAR(); qkt(pB0, pB1, (bf16_t*)((char*)K_lds + SHM_K), qr, r32, hi);
  finishSM(pA0, pA1, alA, l_reg, pa0, pa1, pa2, pa3); SBAR();
  pv_d0(o, vb0, pa0, pa1, pa2, pa3); partialSM(pB0, pB1, m_reg, mnB, alB);
  __syncthreads(); RESC(alB);
  finishSM(pB0, pB1, alB, l_reg, pa0, pa1, pa2, pa3); SBAR();
  pv_d0(o, vb0 + (int)SHM_V, pa0, pa1, pa2, pa3);
  if (hi == 0) li_l[r32] = l_reg; asm volatile("s_waitcnt lgkmcnt(0)" ::: "memory");
  float rli[16];
#pragma unroll
  for (int r = 0; r < 16; ++r) rli[r] = __builtin_amdgcn_rcpf(li_l[crow(r, hi)]);
  bf16_t* Ow = Ob + (long)(wid * QBLK) * LDO;
#pragma unroll
  for (int r = 0; r < 16; ++r) { int orow = crow(r, hi);
    for (int d0 = 0; d0 < 4; ++d0) Ow[(long)orow * LDO + d0 * 32 + r32] = (bf16_t)f2bf(o[d0][r] * rli[r]); }
  __syncthreads();
#undef SLOAD
#undef SWRITE
#undef SWAIT
#undef RESC
}
#undef KSWZ
#undef SBAR
}

__device__ __forceinline__ void phase_attn(const Args& a, char* lds) {
    unsigned char* ws = a.ws;
    const bf16_t* Q = (const bf16_t*)(ws + WS_Q); const bf16_t* Kb = (const bf16_t*)(ws + WS_K); const bf16_t* Vb = (const bf16_t*)(ws + WS_V);
    bf16_t* AO = (bf16_t*)(ws + WS_AO);
    const int NU = 256 + 8;
    for (int u = blockIdx.x; u < NU; u += gridDim.x) {
        int b, h, qrow0, nkeys;
        if (u < 256) { b = u / 128; h = (u / 32) % 4; qrow0 = b * RPB + CTXL + (u % 32) * 256; nkeys = RPB; }
        else { const int v = u - 256; b = v / 4; h = v % 4; qrow0 = b * RPB; nkeys = CTXL; }
        const int kvh = h >> 1; const size_t krow0 = (size_t)b * RPB;
        fa::attn_dense_body(Q + (size_t)qrow0 * 512 + h * 128, Kb + krow0 * 256 + kvh * 128, Vb + krow0 * 256 + kvh * 128, AO + (size_t)qrow0 * 1024 + 512 + h * 128, nkeys, lds);
    }
}

__device__ __forceinline__ void phase_outproj(const Args& a, char* lds, const bf16_t* A, int K, const bf16_t* Bt, int layer, int which_gate, int base_mode, bool latent_only) {
    float* Cs = (float*)lds;
    const int tid = threadIdx.x;
    float* X1 = (float*)(a.ws + WS_X1);
    const int NU = (MTOT / 128) * 8;
    for (int u = blockIdx.x; u < NU; u += gridDim.x) {
        const int rt = u / 8, ct = u % 8, row0 = rt * 128, col0 = ct * 128;
        if (latent_only && (rt % 66) < 2) continue;
        gemm_tile128(A + (size_t)row0 * K, K, Bt + (size_t)col0 * K, K, K, Cs);
        __syncthreads();
        const int rr = tid >> 2, q4 = tid & 3, g = row0 + rr;
        const float* crow = Cs + rr * CS_LD + q4 * 32;
        const float* gt = modv(a, layer, row_variant(g), which_gate) + col0 + q4 * 32;
        const float* base = (base_mode == 0 ? row_src(a, g) : X1 + (size_t)g * D) + col0 + q4 * 32;
        float* o = X1 + (size_t)g * D + col0 + q4 * 32;
#pragma unroll
        for (int c = 0; c < 32; c += 4) {
            const f32x4 bs = *(const f32x4*)(base + c), gv = *(const f32x4*)(gt + c);
            f32x4 r; r.x = bs.x + gv.x * crow[c]; r.y = bs.y + gv.y * crow[c + 1]; r.z = bs.z + gv.z * crow[c + 2]; r.w = bs.w + gv.w * crow[c + 3];
            *(f32x4*)(o + c) = r;
        }
        __syncthreads();
    }
}

__device__ __forceinline__ void phase_peerq(const Args& a, char* lds, int layer, bool latent_only) {
    float* Cs = (float*)lds;
    const int tid = threadIdx.x;
    const bf16_t* H = (const bf16_t*)(a.ws + WS_H); const bf16_t* W = (const bf16_t*)(a.ws + WS_WQ) + (size_t)layer * 2048 * 1024;
    bf16_t* QP = (bf16_t*)(a.ws + WS_QP);
    const int NU = (MTOT / 128) * 16;
    for (int u = blockIdx.x; u < NU; u += gridDim.x) {
        const int rt = u / 16, ct = u % 16, row0 = rt * 128, col0 = ct * 128;
        if (latent_only && (rt % 66) < 2) continue;
        gemm_tile128(H + (size_t)row0 * D, D, W + (size_t)col0 * D, D, D, Cs);
        __syncthreads();
        const int rr = tid >> 2, q4 = tid & 3, g = row0 + rr;
        const float* crow = Cs + rr * CS_LD + q4 * 32;
        bf16_t* o = QP + (size_t)g * 2048 + col0 + q4 * 32;
#pragma unroll
        for (int c = 0; c < 32; c += 2) *(unsigned*)(o + c) = pk2(crow[c], crow[c + 1]);
        __syncthreads();
    }
}

__device__ __forceinline__ void wave_argmax(float& v, int& i) {
#pragma unroll
    for (int o = 1; o < 64; o <<= 1) {
        const float ov = __shfl_xor(v, o); const int oi = __shfl_xor(i, o);
        if (ov > v || (ov == v && oi < i)) { v = ov; i = oi; }
    }
}
__device__ __forceinline__ void phase_peer_topk(const Args& a, int layer, bool latent_only) {
    const int lane = threadIdx.x & 63, gw = blockIdx.x * NWAVE + (threadIdx.x >> 6), ngw = gridDim.x * NWAVE;
    const bf16_t* QP = (const bf16_t*)(a.ws + WS_QP);
    const bf16_t* KEYS = (const bf16_t*)(a.ws + WS_KEYS) + (size_t)layer * 8 * 2 * 128 * 128;
    int* SELI = (int*)(a.ws + WS_SELI); float* SELG = (float*)(a.ws + WS_SELG);
    for (int it = gw; it < MTOT * 8; it += ngw) {
        const int g = it >> 3, h = it & 7;
        if (latent_only && row_variant(g) == 2) continue;
        float tv[2]; int ti[2];
#pragma unroll
        for (int s = 0; s < 2; ++s) {
            const bf16_t* qp = QP + (size_t)g * 2048 + h * 256 + s * 128;
            const bf16_t* k0p = KEYS + ((size_t)(h * 2 + s) * 128 + lane) * 128;
            const bf16_t* k1p = k0p + 64 * 128;
            float s0 = 0.f, s1 = 0.f;
#pragma unroll 4
            for (int d = 0; d < 128; d += 8) {
                const u32x4 qw = *(const u32x4*)(qp + d), ka = *(const u32x4*)(k0p + d), kb = *(const u32x4*)(k1p + d);
                s0 += bflo(qw.x) * bflo(ka.x) + bfhi(qw.x) * bfhi(ka.x) + bflo(qw.y) * bflo(ka.y) + bfhi(qw.y) * bfhi(ka.y)
                    + bflo(qw.z) * bflo(ka.z) + bfhi(qw.z) * bfhi(ka.z) + bflo(qw.w) * bflo(ka.w) + bfhi(qw.w) * bfhi(ka.w);
                s1 += bflo(qw.x) * bflo(kb.x) + bfhi(qw.x) * bfhi(kb.x) + bflo(qw.y) * bflo(kb.y) + bfhi(qw.y) * bfhi(kb.y)
                    + bflo(qw.z) * bflo(kb.z) + bfhi(qw.z) * bfhi(kb.z) + bflo(qw.w) * bflo(kb.w) + bfhi(qw.w) * bfhi(kb.w);
            }
            float myv = 0.f; int myi = 0;
            for (int r = 0; r < 16; ++r) {
                float bv; int bi;
                if (s0 >= s1) { bv = s0; bi = lane; } else { bv = s1; bi = lane + 64; }
                wave_argmax(bv, bi);
                if (bi == lane) s0 = -INFINITY; else if (bi == lane + 64) s1 = -INFINITY;
                if (lane == r) { myv = bv; myi = bi; }
            }
            tv[s] = myv; ti[s] = myi;
        }
        float cv[4]; int ci[4];
        {
            const float v0 = __shfl(tv[0], lane >> 2); const int i0 = __shfl(ti[0], lane >> 2);
#pragma unroll
            for (int m = 0; m < 4; ++m) { const int j = (lane & 3) * 4 + m; cv[m] = v0 + __shfl(tv[1], j); ci[m] = i0 * 128 + __shfl(ti[1], j); }
        }
        float topv = 0.f; int tope = 0;
        for (int r = 0; r < 16; ++r) {
            float bv = cv[0]; int bp = lane * 4;
#pragma unroll
            for (int m = 1; m < 4; ++m) if (cv[m] > bv) { bv = cv[m]; bp = lane * 4 + m; }
            wave_argmax(bv, bp);
            int be = 0;
#pragma unroll
            for (int m = 0; m < 4; ++m) if (bp == lane * 4 + m) { be = ci[m]; cv[m] = -INFINITY; }
            be = __shfl(be, bp >> 2);
            if (lane == r) { topv = bv; tope = be; }
        }
        const float mx = __shfl(topv, 0);
        float e = lane < 16 ? __expf(topv - mx) : 0.f;
        float sum = e;
#pragma unroll
        for (int o = 1; o < 16; o <<= 1) sum += __shfl_xor(sum, o);
        if (lane < 16) { SELI[(size_t)g * 128 + h * 16 + lane] = tope; SELG[(size_t)g * 128 + h * 16 + lane] = e / sum; }
    }
}

namespace tk {
__device__ __forceinline__ void ce(float& a, float& b) { const float mx = __builtin_fmaxf(a, b), mn = __builtin_fminf(a, b); a = mx; b = mn; }
__device__ __forceinline__ void sort16_desc(float (&v)[16]) {
#pragma unroll
    for (int ks = 1; ks <= 4; ++ks)
#pragma unroll
        for (int js = ks - 1; js >= 0; --js)
#pragma unroll
            for (int i = 0; i < 16; ++i) { const int k = 1 << ks, j = 1 << js, l = i ^ j; if (l > i) { if ((i & k) == 0) ce(v[i], v[l]); else ce(v[l], v[i]); } }
}
__device__ __forceinline__ void merge16_desc(float (&v)[16]) {
#pragma unroll
    for (int js = 3; js >= 0; --js)
#pragma unroll
        for (int i = 0; i < 16; ++i) { const int j = 1 << js, l = i ^ j; if (l > i) ce(v[i], v[l]); }
}
__device__ __forceinline__ void merge_prune(float (&x)[16], const float (&y)[16]) {
#pragma unroll
    for (int i = 0; i < 16; ++i) x[i] = __builtin_fmaxf(x[i], y[15 - i]);
    merge16_desc(x);
}
__host__ __device__ constexpr bool pair_ok(int i, int j) { return (i + 1) * (j + 1) <= 16; }
__host__ __device__ constexpr int pair_index(int i, int j) { int n = 0; for (int a = 0; a < 16; ++a) for (int b = 0; b < 16; ++b) { if (a == i && b == j) return n; if (pair_ok(a, b)) ++n; } return n; }
static_assert(pair_index(15, 15) == 49 + 0 || true, "");
}
__device__ __forceinline__ void phase_peer_topk2(const Args& a, int layer, bool latent_only) {
    const int lane = threadIdx.x & 63, r32 = lane & 31, hh = lane >> 5, gw = blockIdx.x * NWAVE + __builtin_amdgcn_readfirstlane(threadIdx.x >> 6), ngw = gridDim.x * NWAVE;
    const bf16_t* QP = (const bf16_t*)(a.ws + WS_QP);
    const bf16_t* KEYS = (const bf16_t*)(a.ws + WS_KEYS) + (size_t)layer * 8 * 2 * 128 * 128;
    int* SELI = (int*)(a.ws + WS_SELI); float* SELG = (float*)(a.ws + WS_SELG);
    const int NIT = (MTOT / 32) * 8;
    for (int it = gw; it < NIT; it += ngw) {
        const int tg = it >> 3, h = it & 7, g0 = tg * 32;
        if (latent_only && row_variant(g0) == 2) continue;
        float top[2][16];
#pragma unroll
        for (int s = 0; s < 2; ++s) {
            bf16x8 qf[8];
            unsigned qoff = (unsigned)(r32 * 2048 + 8 * hh), koff = (unsigned)(r32 * 128 + 8 * hh); asm volatile("" : "+v"(qoff), "+v"(koff));
            const bf16_t* qb = QP + (size_t)g0 * 2048 + h * 256 + s * 128;
#pragma unroll
            for (int k = 0; k < 8; ++k) qf[k] = *(const bf16x8*)(qb + qoff + k * 16);
            float grp[4][16];
#pragma unroll
            for (int kb = 0; kb < 4; ++kb) {
                const bf16_t* kbp = KEYS + (size_t)(h * 2 + s) * 128 * 128 + kb * 32 * 128;
                f32x16 acc = {};
#pragma unroll
                for (int k = 0; k < 8; ++k) { const bf16x8 kf = *(const bf16x8*)(kbp + koff + k * 16); acc = __builtin_amdgcn_mfma_f32_32x32x16_bf16(kf, qf[k], acc, 0, 0, 0); }
#pragma unroll
                for (int r = 0; r < 16; ++r) { const int key = kb * 32 + (r & 3) + 8 * (r >> 2) + 4 * hh; grp[kb][r] = __uint_as_float((__float_as_uint(acc[r]) & ~127u) | (unsigned)key); }
                tk::sort16_desc(grp[kb]); __builtin_amdgcn_sched_barrier(0);
            }
            tk::merge_prune(grp[0], grp[1]); __builtin_amdgcn_sched_barrier(0); tk::merge_prune(grp[2], grp[3]); __builtin_amdgcn_sched_barrier(0); tk::merge_prune(grp[0], grp[2]); __builtin_amdgcn_sched_barrier(0);
            float oth[16];
#pragma unroll
            for (int r = 0; r < 16; ++r) { const auto rr = __builtin_amdgcn_permlane32_swap(__float_as_uint(grp[0][r]), __float_as_uint(grp[0][r]), false, false); oth[r] = __uint_as_float(hh == 0 ? rr[1] : rr[0]); }
            tk::merge_prune(grp[0], oth);
#pragma unroll
            for (int r = 0; r < 16; ++r) top[s][r] = grp[0][r];
            __builtin_amdgcn_sched_barrier(0);
        }
        float cg[4][16];
#pragma unroll
        for (int q = 0; q < 4; ++q)
#pragma unroll
            for (int r = 0; r < 16; ++r) cg[q][r] = -INFINITY;
        cg[0][0] = __uint_as_float((__float_as_uint(top[0][0] + top[1][0]) & ~255u) | 0u);
        cg[0][1] = __uint_as_float((__float_as_uint(top[0][0] + top[1][1]) & ~255u) | 1u);
        cg[0][2] = __uint_as_float((__float_as_uint(top[0][0] + top[1][2]) & ~255u) | 2u);
        cg[0][3] = __uint_as_float((__float_as_uint(top[0][0] + top[1][3]) & ~255u) | 3u);
        cg[0][4] = __uint_as_float((__float_as_uint(top[0][0] + top[1][4]) & ~255u) | 4u);
        cg[0][5] = __uint_as_float((__float_as_uint(top[0][0] + top[1][5]) & ~255u) | 5u);
        cg[0][6] = __uint_as_float((__float_as_uint(top[0][0] + top[1][6]) & ~255u) | 6u);
        cg[0][7] = __uint_as_float((__float_as_uint(top[0][0] + top[1][7]) & ~255u) | 7u);
        cg[0][8] = __uint_as_float((__float_as_uint(top[0][0] + top[1][8]) & ~255u) | 8u);
        cg[0][9] = __uint_as_float((__float_as_uint(top[0][0] + top[1][9]) & ~255u) | 9u);
        cg[0][10] = __uint_as_float((__float_as_uint(top[0][0] + top[1][10]) & ~255u) | 10u);
        cg[0][11] = __uint_as_float((__float_as_uint(top[0][0] + top[1][11]) & ~255u) | 11u);
        cg[0][12] = __uint_as_float((__float_as_uint(top[0][0] + top[1][12]) & ~255u) | 12u);
        cg[0][13] = __uint_as_float((__float_as_uint(top[0][0] + top[1][13]) & ~255u) | 13u);
        cg[0][14] = __uint_as_float((__float_as_uint(top[0][0] + top[1][14]) & ~255u) | 14u);
        cg[0][15] = __uint_as_float((__float_as_uint(top[0][0] + top[1][15]) & ~255u) | 15u);
        cg[1][0] = __uint_as_float((__float_as_uint(top[0][1] + top[1][0]) & ~255u) | 16u);
        cg[1][1] = __uint_as_float((__float_as_uint(top[0][1] + top[1][1]) & ~255u) | 17u);
        cg[1][2] = __uint_as_float((__float_as_uint(top[0][1] + top[1][2]) & ~255u) | 18u);
        cg[1][3] = __uint_as_float((__float_as_uint(top[0][1] + top[1][3]) & ~255u) | 19u);
        cg[1][4] = __uint_as_float((__float_as_uint(top[0][1] + top[1][4]) & ~255u) | 20u);
        cg[1][5] = __uint_as_float((__float_as_uint(top[0][1] + top[1][5]) & ~255u) | 21u);
        cg[1][6] = __uint_as_float((__float_as_uint(top[0][1] + top[1][6]) & ~255u) | 22u);
        cg[1][7] = __uint_as_float((__float_as_uint(top[0][1] + top[1][7]) & ~255u) | 23u);
        cg[1][8] = __uint_as_float((__float_as_uint(top[0][2] + top[1][0]) & ~255u) | 32u);
        cg[1][9] = __uint_as_float((__float_as_uint(top[0][2] + top[1][1]) & ~255u) | 33u);
        cg[1][10] = __uint_as_float((__float_as_uint(top[0][2] + top[1][2]) & ~255u) | 34u);
        cg[1][11] = __uint_as_float((__float_as_uint(top[0][2] + top[1][3]) & ~255u) | 35u);
        cg[1][12] = __uint_as_float((__float_as_uint(top[0][2] + top[1][4]) & ~255u) | 36u);
        cg[1][13] = __uint_as_float((__float_as_uint(top[0][3] + top[1][0]) & ~255u) | 48u);
        cg[1][14] = __uint_as_float((__float_as_uint(top[0][3] + top[1][1]) & ~255u) | 49u);
        cg[1][15] = __uint_as_float((__float_as_uint(top[0][3] + top[1][2]) & ~255u) | 50u);
        cg[2][0] = __uint_as_float((__float_as_uint(top[0][3] + top[1][3]) & ~255u) | 51u);
        cg[2][1] = __uint_as_float((__float_as_uint(top[0][4] + top[1][0]) & ~255u) | 64u);
        cg[2][2] = __uint_as_float((__float_as_uint(top[0][4] + top[1][1]) & ~255u) | 65u);
        cg[2][3] = __uint_as_float((__float_as_uint(top[0][4] + top[1][2]) & ~255u) | 66u);
        cg[2][4] = __uint_as_float((__float_as_uint(top[0][5] + top[1][0]) & ~255u) | 80u);
        cg[2][5] = __uint_as_float((__float_as_uint(top[0][5] + top[1][1]) & ~255u) | 81u);
        cg[2][6] = __uint_as_float((__float_as_uint(top[0][6] + top[1][0]) & ~255u) | 96u);
        cg[2][7] = __uint_as_float((__float_as_uint(top[0][6] + top[1][1]) & ~255u) | 97u);
        cg[2][8] = __uint_as_float((__float_as_uint(top[0][7] + top[1][0]) & ~255u) | 112u);
        cg[2][9] = __uint_as_float((__float_as_uint(top[0][7] + top[1][1]) & ~255u) | 113u);
        cg[2][10] = __uint_as_float((__float_as_uint(top[0][8] + top[1][0]) & ~255u) | 128u);
        cg[2][11] = __uint_as_float((__float_as_uint(top[0][9] + top[1][0]) & ~255u) | 144u);
        cg[2][12] = __uint_as_float((__float_as_uint(top[0][10] + top[1][0]) & ~255u) | 160u);
        cg[2][13] = __uint_as_float((__float_as_uint(top[0][11] + top[1][0]) & ~255u) | 176u);
        cg[2][14] = __uint_as_float((__float_as_uint(top[0][12] + top[1][0]) & ~255u) | 192u);
        cg[2][15] = __uint_as_float((__float_as_uint(top[0][13] + top[1][0]) & ~255u) | 208u);
        cg[3][0] = __uint_as_float((__float_as_uint(top[0][14] + top[1][0]) & ~255u) | 224u);
        cg[3][1] = __uint_as_float((__float_as_uint(top[0][15] + top[1][0]) & ~255u) | 240u);
#pragma unroll
        for (int q = 0; q < 4; ++q) { tk::sort16_desc(cg[q]); __builtin_amdgcn_sched_barrier(0); }
        tk::merge_prune(cg[0], cg[1]); __builtin_amdgcn_sched_barrier(0); tk::merge_prune(cg[2], cg[3]); __builtin_amdgcn_sched_barrier(0); tk::merge_prune(cg[0], cg[2]); __builtin_amdgcn_sched_barrier(0);
        int eidx[16]; float ev[16]; float sum = 0.f;
#pragma unroll
        for (int r = 0; r < 16; ++r) {
            const unsigned bits = __float_as_uint(cg[0][r]); const int ci = (bits >> 4) & 15, cj = bits & 15;
            int ia = 0, ib = 0;
#pragma unroll
            for (int i = 0; i < 16; ++i) { ia = (ci == i) ? (int)(__float_as_uint(top[0][i]) & 127u) : ia; ib = (cj == i) ? (int)(__float_as_uint(top[1][i]) & 127u) : ib; }
            eidx[r] = ia * 128 + ib;
            ev[r] = __expf(cg[0][r] - cg[0][0]); sum += ev[r];
        }
        const float rs = 1.f / sum;
        int* oi = SELI + (size_t)(g0 + r32) * 128 + h * 16 + hh * 8; float* og = SELG + (size_t)(g0 + r32) * 128 + h * 16 + hh * 8;
        if (hh == 0) {
#pragma unroll
            for (int r = 0; r < 8; ++r) { oi[r] = eidx[r]; og[r] = ev[r] * rs; }
        } else {
#pragma unroll
            for (int r = 0; r < 8; ++r) { oi[r] = eidx[8 + r]; og[r] = ev[8 + r] * rs; }
        }
    }
}

__device__ __forceinline__ void phase_peer_gather(const Args& a, int layer, int mode) {
    const int lane = threadIdx.x & 63, gw = blockIdx.x * NWAVE + (threadIdx.x >> 6), ngw = gridDim.x * NWAVE;
    unsigned char* ws = a.ws;
    bf16_t* H = (bf16_t*)(ws + WS_H); float* X1 = (float*)(ws + WS_X1);
    const bf16_t* PU = (const bf16_t*)(ws + WS_PU) + (size_t)layer * NEXP * D; const bf16_t* PV = (const bf16_t*)(ws + WS_PV) + (size_t)layer * NEXP * D;
    const int* SELI = (const int*)(ws + WS_SELI); const float* SELG = (const float*)(ws + WS_SELG);
    for (int g = gw; g < MTOT; g += ngw) {
        const int var = row_variant(g);
        if (mode == 1 && var == 2) continue;
        float hp[16], acc[16];
        {
            const u32x4 w0 = *(const u32x4*)(H + (size_t)g * D + lane * 16), w1 = *(const u32x4*)(H + (size_t)g * D + lane * 16 + 8);
            hp[0] = bflo(w0.x); hp[1] = bfhi(w0.x); hp[2] = bflo(w0.y); hp[3] = bfhi(w0.y); hp[4] = bflo(w0.z); hp[5] = bfhi(w0.z); hp[6] = bflo(w0.w); hp[7] = bfhi(w0.w);
            hp[8] = bflo(w1.x); hp[9] = bfhi(w1.x); hp[10] = bflo(w1.y); hp[11] = bfhi(w1.y); hp[12] = bflo(w1.z); hp[13] = bfhi(w1.z); hp[14] = bflo(w1.w); hp[15] = bfhi(w1.w);
#pragma unroll
            for (int d = 0; d < 16; ++d) acc[d] = 0.f;
        }
        const int myi0 = SELI[(size_t)g * 128 + lane], myi1 = SELI[(size_t)g * 128 + 64 + lane];
        const float myg0 = SELG[(size_t)g * 128 + lane], myg1 = SELG[(size_t)g * 128 + 64 + lane];
        for (int e = 0; e < 128; ++e) {
            const int ei = e < 64 ? __shfl(myi0, e) : __shfl(myi1, e - 64);
            const float eg = e < 64 ? __shfl(myg0, e) : __shfl(myg1, e - 64);
            const bf16_t* up = PU + (size_t)ei * D + lane * 16; const bf16_t* vp = PV + (size_t)ei * D + lane * 16;
            const u32x4 u0 = *(const u32x4*)up, u1 = *(const u32x4*)(up + 8), v0 = *(const u32x4*)vp, v1 = *(const u32x4*)(vp + 8);
            float dt = hp[0] * bflo(u0.x) + hp[1] * bfhi(u0.x) + hp[2] * bflo(u0.y) + hp[3] * bfhi(u0.y) + hp[4] * bflo(u0.z) + hp[5] * bfhi(u0.z) + hp[6] * bflo(u0.w) + hp[7] * bfhi(u0.w)
                     + hp[8] * bflo(u1.x) + hp[9] * bfhi(u1.x) + hp[10] * bflo(u1.y) + hp[11] * bfhi(u1.y) + hp[12] * bflo(u1.z) + hp[13] * bfhi(u1.z) + hp[14] * bflo(u1.w) + hp[15] * bfhi(u1.w);
            dt = wave_sum(dt);
            const float act = gelu_t(dt) * eg;
            acc[0] += act * bflo(v0.x); acc[1] += act * bfhi(v0.x); acc[2] += act * bflo(v0.y); acc[3] += act * bfhi(v0.y);
            acc[4] += act * bflo(v0.z); acc[5] += act * bfhi(v0.z); acc[6] += act * bflo(v0.w); acc[7] += act * bfhi(v0.w);
            acc[8] += act * bflo(v1.x); acc[9] += act * bfhi(v1.x); acc[10] += act * bflo(v1.y); acc[11] += act * bfhi(v1.y);
            acc[12] += act * bflo(v1.z); acc[13] += act * bfhi(v1.z); acc[14] += act * bflo(v1.w); acc[15] += act * bfhi(v1.w);
        }
        float* xr = X1 + (size_t)g * D + lane * 16;
        const float* g2 = modv(a, layer, var, 5) + lane * 16;
        float xn[16]; float ss = 0.f;
#pragma unroll
        for (int d = 0; d < 16; d += 4) {
            const f32x4 xv = *(const f32x4*)(xr + d), gv = *(const f32x4*)(g2 + d);
            xn[d] = xv.x + gv.x * acc[d]; xn[d + 1] = xv.y + gv.y * acc[d + 1]; xn[d + 2] = xv.z + gv.z * acc[d + 2]; xn[d + 3] = xv.w + gv.w * acc[d + 3];
            ss += xn[d] * xn[d] + xn[d + 1] * xn[d + 1] + xn[d + 2] * xn[d + 2] + xn[d + 3] * xn[d + 3];
        }
        const float rinv = rsqrtf(wave_sum(ss) * (1.f / D) + EPS);
        if (mode == 0) {
#pragma unroll
            for (int d = 0; d < 16; d += 4) { f32x4 o; o.x = xn[d]; o.y = xn[d + 1]; o.z = xn[d + 2]; o.w = xn[d + 3]; *(f32x4*)(xr + d) = o; }
            const float* gn = a.in[6] + D + lane * 16; const float* sh = modv(a, 1, var, 0) + lane * 16; const float* sc = modv(a, 1, var, 1) + lane * 16;
            unsigned w[8];
#pragma unroll
            for (int d = 0; d < 16; d += 2) w[d >> 1] = pk2(xn[d] * rinv * gn[d] * (1.f + sc[d]) + sh[d], xn[d + 1] * rinv * gn[d + 1] * (1.f + sc[d + 1]) + sh[d + 1]);
            u32x4 o0, o1; o0.x = w[0]; o0.y = w[1]; o0.z = w[2]; o0.w = w[3]; o1.x = w[4]; o1.y = w[5]; o1.z = w[6]; o1.w = w[7];
            *(u32x4*)(H + (size_t)g * D + lane * 16) = o0; *(u32x4*)(H + (size_t)g * D + lane * 16 + 8) = o1;
        } else {
            const int b = g / RPB, t = g - b * RPB - CTXL;
            float* op = a.out + ((size_t)b * SEQ + t) * D + lane * 16; const float* gn = a.in[28] + lane * 16;
#pragma unroll
            for (int d = 0; d < 16; d += 4) { f32x4 o; o.x = xn[d] * rinv * gn[d]; o.y = xn[d + 1] * rinv * gn[d + 1]; o.z = xn[d + 2] * rinv * gn[d + 2]; o.w = xn[d + 3] * rinv * gn[d + 3]; *(f32x4*)(op + d) = o; }
        }
    }
}

typedef __bf16 bf16x2_t __attribute__((ext_vector_type(2)));
__device__ __forceinline__ float dot2bf(unsigned w, unsigned x, float acc) { return __builtin_amdgcn_fdot2_f32_bf16(__builtin_bit_cast(bf16x2_t, w), __builtin_bit_cast(bf16x2_t, x), acc, false); }
struct Row8 { u32x4 c[8]; };
__device__ __forceinline__ void load_row8(Row8& r, const bf16_t* p) {
#pragma unroll
    for (int c = 0; c < 8; ++c) r.c[c] = *(const u32x4*)(p + c * 128);
}
__device__ __forceinline__ float dot_row8(const Row8& r, const u32x4 (&hp)[8]) {
    float a0 = 0.f, a1 = 0.f, a2 = 0.f, a3 = 0.f;
#pragma unroll
    for (int c = 0; c < 8; ++c) { a0 = dot2bf(r.c[c].x, hp[c].x, a0); a1 = dot2bf(r.c[c].y, hp[c].y, a1); a2 = dot2bf(r.c[c].z, hp[c].z, a2); a3 = dot2bf(r.c[c].w, hp[c].w, a3); }
    float s = (a0 + a1) + (a2 + a3);
    s += __shfl_xor(s, 1); s += __shfl_xor(s, 2); s += __shfl_xor(s, 4); s += __shfl_xor(s, 8);
    return s;
}
__device__ __forceinline__ void fma_row(float (&acc)[16], const u32x4& v0, const u32x4& v1, float a) {
    acc[0] += a * bflo(v0.x); acc[1] += a * bfhi(v0.x); acc[2] += a * bflo(v0.y); acc[3] += a * bfhi(v0.y);
    acc[4] += a * bflo(v0.z); acc[5] += a * bfhi(v0.z); acc[6] += a * bflo(v0.w); acc[7] += a * bfhi(v0.w);
    acc[8] += a * bflo(v1.x); acc[9] += a * bfhi(v1.x); acc[10] += a * bflo(v1.y); acc[11] += a * bfhi(v1.y);
    acc[12] += a * bflo(v1.z); acc[13] += a * bfhi(v1.z); acc[14] += a * bflo(v1.w); acc[15] += a * bfhi(v1.w);
}
__device__ __forceinline__ void phase_peer_gather2(const Args& a, char* lds, int layer, int mode) {
    const int lane = threadIdx.x & 63, wid = threadIdx.x >> 6, gw = blockIdx.x * NWAVE + wid, ngw = gridDim.x * NWAVE;
    const int grp = lane >> 4, sub = lane & 15;
    unsigned char* ws = a.ws;
    bf16_t* H = (bf16_t*)(ws + WS_H); float* X1 = (float*)(ws + WS_X1);
    const bf16_t* PU = (const bf16_t*)(ws + WS_PU) + (size_t)layer * NEXP * D; const bf16_t* PV = (const bf16_t*)(ws + WS_PV) + (size_t)layer * NEXP * D;
    const int* SELI = (const int*)(ws + WS_SELI); const float* SELG = (const float*)(ws + WS_SELG);
    LAS int* lidx = (LAS int*)((LAS char*)lds + wid * 2048);
    LAS float* lgate = (LAS float*)(lidx + 128);
    LAS float* lact = lgate + 128;
    for (int g = gw; g < MTOT; g += ngw) {
        const int var = row_variant(g);
        if (mode == 1 && var == 2) continue;
        lidx[lane] = SELI[(size_t)g * 128 + lane]; lidx[64 + lane] = SELI[(size_t)g * 128 + 64 + lane];
        lgate[lane] = SELG[(size_t)g * 128 + lane]; lgate[64 + lane] = SELG[(size_t)g * 128 + 64 + lane];
        u32x4 hp[8];
#pragma unroll
        for (int c = 0; c < 8; ++c) hp[c] = *(const u32x4*)(H + (size_t)g * D + c * 128 + sub * 8);
        {
            Row8 ra, rb;
            load_row8(ra, PU + (size_t)lidx[grp] * D + sub * 8);
            for (int it = 0; it < 32; it += 2) {
                load_row8(rb, PU + (size_t)lidx[(it + 1) * 4 + grp] * D + sub * 8);
                { const float s = dot_row8(ra, hp); const int e = it * 4 + grp; if (sub == 0) lact[e] = gelu_t(s) * lgate[e]; }
                if (it + 2 < 32) load_row8(ra, PU + (size_t)lidx[(it + 2) * 4 + grp] * D + sub * 8);
                { const float s = dot_row8(rb, hp); const int e = (it + 1) * 4 + grp; if (sub == 0) lact[e] = gelu_t(s) * lgate[e]; }
            }
        }
        float acc[16];
#pragma unroll
        for (int d = 0; d < 16; ++d) acc[d] = 0.f;
        {
            u32x4 va[4][2], vb[4][2];
#pragma unroll
            for (int k = 0; k < 4; ++k) { const bf16_t* p = PV + (size_t)lidx[k] * D + lane * 8; va[k][0] = *(const u32x4*)p; va[k][1] = *(const u32x4*)(p + 512); }
            for (int e = 0; e < 128; e += 8) {
#pragma unroll
                for (int k = 0; k < 4; ++k) { const bf16_t* p = PV + (size_t)lidx[e + 4 + k] * D + lane * 8; vb[k][0] = *(const u32x4*)p; vb[k][1] = *(const u32x4*)(p + 512); }
#pragma unroll
                for (int k = 0; k < 4; ++k) fma_row(acc, va[k][0], va[k][1], lact[e + k]);
                if (e + 8 < 128) {
#pragma unroll
                    for (int k = 0; k < 4; ++k) { const bf16_t* p = PV + (size_t)lidx[e + 8 + k] * D + lane * 8; va[k][0] = *(const u32x4*)p; va[k][1] = *(const u32x4*)(p + 512); }
                }
#pragma unroll
                for (int k = 0; k < 4; ++k) fma_row(acc, vb[k][0], vb[k][1], lact[e + 4 + k]);
            }
        }
        float* xr = X1 + (size_t)g * D + lane * 8;
        const float* g2 = modv(a, layer, var, 5) + lane * 8;
        float xn[16]; float ss = 0.f;
#pragma unroll
        for (int hh = 0; hh < 2; ++hh)
#pragma unroll
            for (int d = 0; d < 8; d += 4) {
                const f32x4 xv = *(const f32x4*)(xr + hh * 512 + d), gv = *(const f32x4*)(g2 + hh * 512 + d);
                const int o = hh * 8 + d;
                xn[o] = xv.x + gv.x * acc[o]; xn[o + 1] = xv.y + gv.y * acc[o + 1]; xn[o + 2] = xv.z + gv.z * acc[o + 2]; xn[o + 3] = xv.w + gv.w * acc[o + 3];
                ss += xn[o] * xn[o] + xn[o + 1] * xn[o + 1] + xn[o + 2] * xn[o + 2] + xn[o + 3] * xn[o + 3];
            }
        const float rinv = rsqrtf(wave_sum(ss) * (1.f / D) + EPS);
        if (mode == 0) {
            const float* gn = a.in[6] + D + lane * 8; const float* sh = modv(a, 1, var, 0) + lane * 8; const float* sc = modv(a, 1, var, 1) + lane * 8;
#pragma unroll
            for (int hh = 0; hh < 2; ++hh) {
                const int o = hh * 8;
                f32x4 o0, o1; o0.x = xn[o]; o0.y = xn[o + 1]; o0.z = xn[o + 2]; o0.w = xn[o + 3]; o1.x = xn[o + 4]; o1.y = xn[o + 5]; o1.z = xn[o + 6]; o1.w = xn[o + 7];
                *(f32x4*)(xr + hh * 512) = o0; *(f32x4*)(xr + hh * 512 + 4) = o1;
                unsigned w[4];
#pragma unroll
                for (int d = 0; d < 8; d += 2) { const int cc = hh * 512 + d; w[d >> 1] = pk2(xn[o + d] * rinv * gn[cc] * (1.f + sc[cc]) + sh[cc], xn[o + d + 1] * rinv * gn[cc + 1] * (1.f + sc[cc + 1]) + sh[cc + 1]); }
                u32x4 ow; ow.x = w[0]; ow.y = w[1]; ow.z = w[2]; ow.w = w[3];
                *(u32x4*)(H + (size_t)g * D + hh * 512 + lane * 8) = ow;
            }
        } else {
            const int b = g / RPB, t = g - b * RPB - CTXL;
            float* op = a.out + ((size_t)b * SEQ + t) * D + lane * 8; const float* gn = a.in[28] + lane * 8;
#pragma unroll
            for (int hh = 0; hh < 2; ++hh)
#pragma unroll
                for (int d = 0; d < 8; d += 4) { const int o = hh * 8 + d, cc = hh * 512 + d;
                    f32x4 ov; ov.x = xn[o] * rinv * gn[cc]; ov.y = xn[o + 1] * rinv * gn[cc + 1]; ov.z = xn[o + 2] * rinv * gn[cc + 2]; ov.w = xn[o + 3] * rinv * gn[cc + 3]; *(f32x4*)(op + cc) = ov; }
        }
    }
}

__device__ __forceinline__ void phase_inproj1(const Args& a, char* lds) {
    float* Cs = (float*)lds;
    const int tid = threadIdx.x;
    const bf16_t* H = (const bf16_t*)(a.ws + WS_H); const bf16_t* W = (const bf16_t*)(a.ws + WS_WIN1);
    const int NU = (MTOT / 128) * 20;
    for (int u = blockIdx.x; u < NU; u += gridDim.x) {
        const int rt = u / 20, ct = u % 20, row0 = rt * 128, col0 = ct * 128;
        if (ct < 10 && (rt % 66) < 2) continue;
        gemm_tile128(H + (size_t)row0 * D, D, W + (size_t)col0 * D, D, D, Cs);
        __syncthreads();
        const int rr = tid >> 2, q4 = tid & 3, g = row0 + rr;
        const float* crow = Cs + rr * CS_LD + q4 * 32;
        if (ct < 10) {
            bf16_t* o = (bf16_t*)(a.ws + WS_GG) + (size_t)g * DRNN + col0 + q4 * 32;
#pragma unroll
            for (int c = 0; c < 32; c += 2) *(unsigned*)(o + c) = pk2(gelu_t(crow[c]), gelu_t(crow[c + 1]));
        } else {
            bf16_t* o = (bf16_t*)(a.ws + WS_XR) + (size_t)g * DRNN + (col0 - DRNN) + q4 * 32;
#pragma unroll
            for (int c = 0; c < 32; c += 2) *(unsigned*)(o + c) = pk2(crow[c], crow[c + 1]);
        }
        __syncthreads();
    }
}

__device__ __forceinline__ void phase_rglru(const Args& a, char* lds, int pass) {
    const int tid = threadIdx.x;
    unsigned char* ws = a.ws;
    float* xc = (float*)lds;
    float* seg = xc + 128 * 128;
    const bf16_t* XR = (const bf16_t*)(ws + WS_XR); const bf16_t* GG = (const bf16_t*)(ws + WS_GG); bf16_t* YG = (bf16_t*)(ws + WS_YG);
    float* CARRY = (float*)(ws + WS_CARRY);
    const int j = tid & 127, tq = tid >> 7;
    const int NU = (MTOT / 128) * 10;
    for (int u = blockIdx.x; u < NU; u += gridDim.x) {
        const int T = u / 10, hb = u % 10, b = T / 66, tl = T % 66, row0 = T * 128, ch = hb * 128 + j;
        if (pass == 1 && tl < 2) continue;
        const int seq_lo = tl < 2 ? b * RPB : b * RPB + CTXL, seq_hi = tl < 2 ? b * RPB + CTXL : (b + 1) * RPB;
        {
            const float w0 = a.in[16][0 * DRNN + ch], w1 = a.in[16][1 * DRNN + ch], w2 = a.in[16][2 * DRNN + ch], w3 = a.in[16][3 * DRNN + ch], cb = a.in[17][ch];
            for (int tt = 0; tt < 32; ++tt) {
                const int g = row0 + tq * 32 + tt;
                const float xm2 = (g - 2 >= seq_lo) ? bf2f(XR[(size_t)(g - 2) * DRNN + ch]) : 0.f;
                const float xm1 = (g - 1 >= seq_lo) ? bf2f(XR[(size_t)(g - 1) * DRNN + ch]) : 0.f;
                const float x0 = bf2f(XR[(size_t)g * DRNN + ch]);
                const float xp1 = (g + 1 < seq_hi) ? bf2f(XR[(size_t)(g + 1) * DRNN + ch]) : 0.f;
                xc[(tq * 32 + tt) * 128 + j] = w0 * xm2 + w1 * xm1 + w2 * x0 + w3 * xp1 + cb;
            }
        }
        __syncthreads();
        float acc[4][32];
#pragma unroll
        for (int m = 0; m < 4; ++m)
#pragma unroll
            for (int tt = 0; tt < 32; ++tt) acc[m][tt] = 0.f;
        {
            const float* wa0 = a.in[18] + ((size_t)(0 * 10 + hb) * 128) * 128 + j; const float* wx0 = a.in[20] + ((size_t)(0 * 10 + hb) * 128) * 128 + j;
            const float* wa1 = a.in[18] + ((size_t)(1 * 10 + hb) * 128) * 128 + j; const float* wx1 = a.in[20] + ((size_t)(1 * 10 + hb) * 128) * 128 + j;
            for (int i = 0; i < 128; ++i) {
                const float w0 = wa0[i * 128], w1 = wx0[i * 128], w2 = wa1[i * 128], w3 = wx1[i * 128];
#pragma unroll
                for (int tt = 0; tt < 32; ++tt) { const float x = xc[(tq * 32 + tt) * 128 + i]; acc[0][tt] += x * w0; acc[1][tt] += x * w1; acc[2][tt] += x * w2; acc[3][tt] += x * w3; }
            }
        }
#pragma unroll
        for (int d = 0; d < 2; ++d) {
            const float ba = a.in[19][d * DRNN + ch], bx = a.in[21][d * DRNN + ch], lam = a.in[22][d * DRNN + ch];
            const float sp = log1pf(__expf(-lam));
#pragma unroll
            for (int tt = 0; tt < 32; ++tt) {
                const float r = sigmoidf_(acc[2 * d][tt] + ba), ig = sigmoidf_(acc[2 * d + 1][tt] + bx);
                const float la = -8.f * r * sp; const float av = __expf(la);
                const float uv = sqrtf(fmaxf(-expm1f(2.f * la), 0.f)) * ig * xc[(tq * 32 + tt) * 128 + j];
                acc[2 * d][tt] = av; acc[2 * d + 1][tt] = uv;
            }
        }
        {
            float Af = 1.f, Hf = 0.f, Ab = 1.f, Hb = 0.f;
#pragma unroll
            for (int tt = 0; tt < 32; ++tt) { Hf = acc[0][tt] * Hf + acc[1][tt]; Af *= acc[0][tt]; }
#pragma unroll
            for (int tt = 31; tt >= 0; --tt) { Hb = acc[2][tt] * Hb + acc[3][tt]; Ab *= acc[2][tt]; }
            seg[((0 * 4 + tq) * 128 + j) * 2] = Af; seg[((0 * 4 + tq) * 128 + j) * 2 + 1] = Hf;
            seg[((1 * 4 + tq) * 128 + j) * 2] = Ab; seg[((1 * 4 + tq) * 128 + j) * 2 + 1] = Hb;
        }
        __syncthreads();
        if (pass == 0) {
            if (tq == 0) {
                float A = 1.f, Hh = 0.f;
                for (int s = 0; s < 4; ++s) { const float sa = seg[((0 * 4 + s) * 128 + j) * 2], sh = seg[((0 * 4 + s) * 128 + j) * 2 + 1]; Hh = sa * Hh + sh; A *= sa; }
                float* c0 = CARRY + (((size_t)(b * 2 + 0) * 66 + tl) * DRNN + ch) * 2; c0[0] = A; c0[1] = Hh;
                A = 1.f; Hh = 0.f;
                for (int s = 3; s >= 0; --s) { const float sa = seg[((1 * 4 + s) * 128 + j) * 2], sh = seg[((1 * 4 + s) * 128 + j) * 2 + 1]; Hh = sa * Hh + sh; A *= sa; }
                float* c1 = CARRY + (((size_t)(b * 2 + 1) * 66 + tl) * DRNN + ch) * 2; c1[0] = A; c1[1] = Hh;
            }
        } else {
            float hf = 0.f, hbk = 0.f;
            for (int t2 = 0; t2 < tl; ++t2) { const float* c = CARRY + (((size_t)(b * 2 + 0) * 66 + t2) * DRNN + ch) * 2; hf = c[0] * hf + c[1]; }
            { const float* c = CARRY + (((size_t)(b * 2 + 1) * 66 + 1) * DRNN + ch) * 2; hbk = c[0] * hbk + c[1]; }
            { const float* c = CARRY + (((size_t)(b * 2 + 1) * 66 + 0) * DRNN + ch) * 2; hbk = c[0] * hbk + c[1]; }
            for (int t2 = 65; t2 > tl; --t2) { const float* c = CARRY + (((size_t)(b * 2 + 1) * 66 + t2) * DRNN + ch) * 2; hbk = c[0] * hbk + c[1]; }
            for (int s = 0; s < tq; ++s) { const float sa = seg[((0 * 4 + s) * 128 + j) * 2], sh = seg[((0 * 4 + s) * 128 + j) * 2 + 1]; hf = sa * hf + sh; }
            for (int s = 3; s > tq; --s) { const float sa = seg[((1 * 4 + s) * 128 + j) * 2], sh = seg[((1 * 4 + s) * 128 + j) * 2 + 1]; hbk = sa * hbk + sh; }
#pragma unroll
            for (int tt = 0; tt < 32; ++tt) { hf = acc[0][tt] * hf + acc[1][tt]; acc[0][tt] = hf; }
#pragma unroll
            for (int tt = 31; tt >= 0; --tt) { hbk = acc[2][tt] * hbk + acc[3][tt]; acc[0][tt] += hbk; }
#pragma unroll
            for (int tt = 0; tt < 32; ++tt) {
                const int g = row0 + tq * 32 + tt;
                YG[(size_t)g * DRNN + ch] = (bf16_t)f2bf(acc[0][tt] * bf2f(GG[(size_t)g * DRNN + ch]));
            }
        }
        __syncthreads();
    }
}

constexpr int XC_LD = 136;
__device__ __forceinline__ float exp2_fast(float x) { return __builtin_amdgcn_exp2f(x); }
__device__ __forceinline__ float sigm_fast(float x) { return __builtin_amdgcn_rcpf(1.f + __builtin_amdgcn_exp2f(-1.4426950408889634f * x)); }
__device__ __forceinline__ void phase_rglru2(const Args& a, char* lds, int pass) {
    const int tid = threadIdx.x, lane = tid & 63, wid = __builtin_amdgcn_readfirstlane(tid >> 6), r32 = lane & 31, hh = lane >> 5;
    const int nb = wid & 3, dir = wid >> 2;
    unsigned char* ws = a.ws;
    LAS bf16_t* xcA = (LAS bf16_t*)((LAS char*)lds);
    LAS float* HS = (LAS float*)((LAS char*)lds + 36864);
    const bf16_t* XR = (const bf16_t*)(ws + WS_XR); const bf16_t* GG = (const bf16_t*)(ws + WS_GG); bf16_t* YG = (bf16_t*)(ws + WS_YG);
    float* CARRY = (float*)(ws + WS_CARRY);
    const int NU = (MTOT / 128) * 10;
    for (int u = blockIdx.x; u < NU; u += gridDim.x) {
        const int T = u / 10, hb = u % 10, b = T / 66, tl = T % 66, row0 = T * 128;
        if (pass == 1 && tl < 2) continue;
        const int seq_lo = tl < 2 ? b * RPB : b * RPB + CTXL, seq_hi = tl < 2 ? b * RPB + CTXL : (b + 1) * RPB;
        {
            const int j2 = tid & 63, ts = tid >> 6, c0 = hb * 128 + 2 * j2;
            const float w00 = a.in[16][0 * DRNN + c0], w01 = a.in[16][0 * DRNN + c0 + 1], w10 = a.in[16][1 * DRNN + c0], w11 = a.in[16][1 * DRNN + c0 + 1];
            const float w20 = a.in[16][2 * DRNN + c0], w21 = a.in[16][2 * DRNN + c0 + 1], w30 = a.in[16][3 * DRNN + c0], w31 = a.in[16][3 * DRNN + c0 + 1];
            const float cb0 = a.in[17][c0], cb1 = a.in[17][c0 + 1];
            unsigned xw[19];
#pragma unroll
            for (int i = 0; i < 19; ++i) { const int g = row0 + ts * 16 - 2 + i; xw[i] = (g >= seq_lo && g < seq_hi) ? *(const unsigned*)(XR + (size_t)g * DRNN + c0) : 0u; }
#pragma unroll
            for (int i = 0; i < 16; ++i) {
                const float y0 = w00 * bflo(xw[i]) + w10 * bflo(xw[i + 1]) + w20 * bflo(xw[i + 2]) + w30 * bflo(xw[i + 3]) + cb0;
                const float y1 = w01 * bfhi(xw[i]) + w11 * bfhi(xw[i + 1]) + w21 * bfhi(xw[i + 2]) + w31 * bfhi(xw[i + 3]) + cb1;
                *(LAS unsigned*)(xcA + (ts * 16 + i) * XC_LD + 2 * j2) = pk2(y0, y1);
            }
        }
        __syncthreads();
        const int ch = hb * 128 + nb * 32 + r32;
        f32x16 accA[4], accX[4];
        {
            unsigned woff = (unsigned)((nb * 32 + r32) * 128 + 8 * hh); asm volatile("" : "+v"(woff));
            const bf16_t* wa = (const bf16_t*)(ws + WS_WAT) + (size_t)(dir * 10 + hb) * 128 * 128;
            const bf16_t* wx = (const bf16_t*)(ws + WS_WXT) + (size_t)(dir * 10 + hb) * 128 * 128;
            bf16x8 bfa[8], bfx[8];
#pragma unroll
            for (int k = 0; k < 8; ++k) { bfa[k] = *(const bf16x8*)(wa + woff + k * 16); bfx[k] = *(const bf16x8*)(wx + woff + k * 16); }
#pragma unroll
            for (int mb = 0; mb < 4; ++mb) {
                accA[mb] = f32x16{}; accX[mb] = f32x16{};
#pragma unroll
                for (int k = 0; k < 8; ++k) {
                    const bf16x8 af = *(const LAS bf16x8*)(xcA + (mb * 32 + r32) * XC_LD + k * 16 + 8 * hh);
                    accA[mb] = __builtin_amdgcn_mfma_f32_32x32x16_bf16(af, bfa[k], accA[mb], 0, 0, 0);
                    accX[mb] = __builtin_amdgcn_mfma_f32_32x32x16_bf16(af, bfx[k], accX[mb], 0, 0, 0);
                }
            }
        }
        __builtin_amdgcn_sched_barrier(0);
        {
            const float ba = a.in[19][dir * DRNN + ch], bx = a.in[21][dir * DRNN + ch], lam = a.in[22][dir * DRNN + ch];
            const float sp8 = -8.f * log1pf(__expf(-lam));
#pragma unroll
            for (int mb = 0; mb < 4; ++mb)
#pragma unroll
                for (int r = 0; r < 16; ++r) {
                    const int t = mb * 32 + (r & 3) + 8 * (r >> 2) + 4 * hh;
                    const float xv = bf2f(xcA[t * XC_LD + nb * 32 + r32]);
                    const float rg = sigm_fast(accA[mb][r] + ba), ig = sigm_fast(accX[mb][r] + bx);
                    const float la = rg * sp8, av = exp2_fast(1.4426950408889634f * la), x2 = 2.f * la;
                    const float om1 = -x2 * (1.f + x2 * (0.5f + x2 * (0.16666667f + x2 * 0.041666668f))), om2 = __builtin_fmaf(-av, av, 1.f);
                    const float om = (x2 > -0.25f) ? om1 : om2;
                    accA[mb][r] = av; accX[mb][r] = __builtin_sqrtf(fmaxf(om, 0.f)) * ig * xv;
                    if ((r & 3) == 3) __builtin_amdgcn_sched_barrier(0);
                }
        }
        __builtin_amdgcn_sched_barrier(0);
        float h = 0.f;
        if (pass == 1) {
            const int pos = dir == 0 ? tl : 67 - tl;
            const float* cbase = CARRY + ((size_t)(b * 2 + dir) * 66) * DRNN * 2 + (size_t)ch * 2;
            float cA = 1.f, cH = 0.f;
#pragma unroll 3
            for (int i = 0; i < 33; ++i) {
                const int p = hh * 33 + i;
                const int tile = dir == 0 ? p : (p < 2 ? 1 - p : 67 - p);
                if (p < pos) { const float* c = cbase + (size_t)tile * DRNN * 2; const float ta = c[0], th = c[1]; cH = ta * cH + th; cA = ta * cA; }
            }
            const auto ra = __builtin_amdgcn_permlane32_swap(__float_as_uint(cA), __float_as_uint(cA), false, false);
            const auto rh = __builtin_amdgcn_permlane32_swap(__float_as_uint(cH), __float_as_uint(cH), false, false);
            const float lowH = hh == 0 ? cH : __uint_as_float(rh[0]);
            const float upA = hh == 0 ? __uint_as_float(ra[1]) : cA;
            const float upH = hh == 0 ? __uint_as_float(rh[1]) : cH;
            h = upA * lowH + upH;
        }
        float Atot = 1.f; float cin[16];
#define RG_COMPOSITE(q) const int mb = (q) >> 2, rg = ((q) & 3) * 4; \
            const float a0 = accA[mb][rg], a1 = accA[mb][rg + 1], a2 = accA[mb][rg + 2], a3 = accA[mb][rg + 3]; \
            const float u0 = accX[mb][rg], u1 = accX[mb][rg + 1], u2 = accX[mb][rg + 2], u3 = accX[mb][rg + 3]; \
            const float gA = (a0 * a1) * (a2 * a3); \
            const float gH = dir == 0 ? ((u0 * a1 + u1) * a2 + u2) * a3 + u3 : ((u3 * a2 + u2) * a1 + u1) * a0 + u0; \
            const auto ra = __builtin_amdgcn_permlane32_swap(__float_as_uint(gA), __float_as_uint(gA), false, false); \
            const auto rh = __builtin_amdgcn_permlane32_swap(__float_as_uint(gH), __float_as_uint(gH), false, false); \
            const float pA = __uint_as_float(hh == 0 ? ra[1] : ra[0]), pH = __uint_as_float(hh == 0 ? rh[1] : rh[0]); \
            const float EA = hh ? pA : gA, EH = hh ? pH : gH, OA = hh ? gA : pA, OH = hh ? gH : pH;
        if (dir == 0) {
#pragma unroll
            for (int q = 0; q < 16; ++q) { RG_COMPOSITE(q)
                const float hE = h; h = EA * h + EH; const float hO = h; h = OA * h + OH; Atot *= EA * OA; cin[q] = hh ? hO : hE; }
        } else {
#pragma unroll
            for (int q = 15; q >= 0; --q) { RG_COMPOSITE(q)
                const float hO = h; h = OA * h + OH; const float hE = h; h = EA * h + EH; Atot *= EA * OA; cin[q] = hh ? hO : hE; }
        }
#undef RG_COMPOSITE
        if (pass == 0) {
            if (hh == 0) { float* c = CARRY + (((size_t)(b * 2 + dir) * 66 + tl) * DRNN + ch) * 2; c[0] = Atot; c[1] = h; }
            __syncthreads();
            continue;
        }
#pragma unroll
        for (int q = 0; q < 16; ++q) {
            const int mb = q >> 2, rg = (q & 3) * 4; float hc = cin[q];
            if (dir == 0) {
#pragma unroll
                for (int e = 0; e < 4; ++e) { hc = accA[mb][rg + e] * hc + accX[mb][rg + e]; accA[mb][rg + e] = hc; }
            } else {
#pragma unroll
                for (int e = 3; e >= 0; --e) { hc = accA[mb][rg + e] * hc + accX[mb][rg + e]; accA[mb][rg + e] = hc; }
            }
        }
        if (dir == 0) {
#pragma unroll
            for (int mb = 0; mb < 4; ++mb)
#pragma unroll
                for (int r = 0; r < 16; ++r) { const int t = mb * 32 + (r & 3) + 8 * (r >> 2) + 4 * hh; HS[t * 128 + nb * 32 + r32] = accA[mb][r]; }
        }
        __syncthreads();
        if (dir == 1) {
#pragma unroll
            for (int mb = 0; mb < 4; ++mb)
#pragma unroll
                for (int r = 0; r < 16; ++r) { const int t = mb * 32 + (r & 3) + 8 * (r >> 2) + 4 * hh; HS[t * 128 + nb * 32 + r32] += accA[mb][r]; }
        }
        __syncthreads();
        {
            const int t = tid >> 2, cs = (tid & 3) * 32, g = row0 + t;
            const bf16_t* gp = GG + (size_t)g * DRNN + hb * 128 + cs; bf16_t* yp = YG + (size_t)g * DRNN + hb * 128 + cs;
#pragma unroll
            for (int c8 = 0; c8 < 32; c8 += 8) {
                const u32x4 gw = *(const u32x4*)(gp + c8);
                const f32x4 h0 = *(const LAS f32x4*)(HS + t * 128 + cs + c8), h1 = *(const LAS f32x4*)(HS + t * 128 + cs + c8 + 4);
                u32x4 o; o.x = pk2(h0.x * bflo(gw.x), h0.y * bfhi(gw.x)); o.y = pk2(h0.z * bflo(gw.y), h0.w * bfhi(gw.y));
                o.z = pk2(h1.x * bflo(gw.z), h1.y * bfhi(gw.z)); o.w = pk2(h1.z * bflo(gw.w), h1.w * bfhi(gw.w));
                *(u32x4*)(yp + c8) = o;
            }
        }
        __syncthreads();
    }
}

namespace pg8 {
constexpr int BM = 256, BK = 64, HALF = 128, HTB = HALF * BK * 2, STAGE_BYTES = 8 * HTB, NXCD = 8, WGM = 8;
__host__ __device__ __forceinline__ int lds_byte(int r, int c) { const int st = (r >> 4) * 2 + (c >> 5), rr = r & 15, cc = c & 31, ob = rr * 64 + cc * 2; return st * 1024 + (ob ^ (((ob >> 9) & 1) << 5)); }
__host__ __device__ __forceinline__ void stage_rc(int b, int& R, int& C) { const int st = b / 1024, sb = b % 1024, swz = sb ^ (((sb >> 9) & 1) << 5); R = (st >> 1) * 16 + swz / 64; C = (st & 1) * 32 + (swz % 64) / 2; }
__host__ __device__ __forceinline__ int perm32(int rho) { const int n = rho >> 4, i = rho & 15; return 8 * (i >> 2) + 4 * n + (i & 3); }
struct Unit { int pm, pn; };
struct Gemm { const bf16_t* A; const bf16_t* Bt; int M, N, K; };
struct StaticOrder {
    int nM, nN, nwg, G, c;
    __host__ __device__ void init(int M, int N, int G_, int c_) { nM = M / BM; nN = N / BM; nwg = nM * nN; G = G_; c = c_; }
    __host__ __device__ bool next(int i, Unit& u) const {
        const long L = (long)i * G + c; if (L >= nwg) return false;
        int wgid = (int)L; { const int q = nwg / NXCD, r = nwg % NXCD, xcd = wgid % NXCD, off = wgid / NXCD; wgid = (xcd < r ? xcd * (q + 1) : r * (q + 1) + (xcd - r) * q) + off; }
        const int nig = WGM * nN, gid = wgid / nig, fm = gid * WGM, gsz = (nM - fm) < WGM ? (nM - fm) : WGM;
        u.pm = fm + ((wgid % nig) % gsz); u.pn = (wgid % nig) / gsz; return true;
    }
    __device__ __forceinline__ void a_ready(const Unit&) const {}
    __device__ __forceinline__ void done(const Unit&) const {}
};
struct LatentOrder {
    StaticOrder S;
    __host__ __device__ void init(int N, int G_, int c_) { S.init(16384, N, G_, c_); }
    __host__ __device__ bool next(int i, Unit& u) const { if (!S.next(i, u)) return false; u.pm = u.pm + 1 + (u.pm >= 32 ? 1 : 0); return true; }
    __device__ __forceinline__ void a_ready(const Unit&) const {}
    __device__ __forceinline__ void done(const Unit&) const {}
};
__device__ __forceinline__ unsigned cvt_pk_bf16(float lo, float hi) { unsigned r; asm volatile("v_cvt_pk_bf16_f32 %0, %1, %2" : "=v"(r) : "v"(lo), "v"(hi)); return r; }
__device__ __forceinline__ u32x4 pack8(const f32x4& v0, const f32x4& v1) { u32x4 w; w.x = cvt_pk_bf16(v0[0], v0[1]); w.y = cvt_pk_bf16(v0[2], v0[3]); w.z = cvt_pk_bf16(v1[0], v1[1]); w.w = cvt_pk_bf16(v1[2], v1[3]); return w; }
__device__ __forceinline__ f32x4 gelu4(const f32x4& v) { f32x4 r; r.x = gelu_t(v.x); r.y = gelu_t(v.y); r.z = gelu_t(v.z); r.w = gelu_t(v.w); return r; }

struct EpiStore {
    static constexpr bool PERM = true, AFTER_DRAIN = false;
    bf16_t* O1; bf16_t* O2; int ld; int split_tile; int gelu_tiles;
    __device__ __forceinline__ void operator()(f32x4 (&acc)[2][2][4][2], const Unit& u, int wr, int wc, int fr, int fq) const {
        const bool second = u.pn >= split_tile; bf16_t* base = second ? O2 : O1; const int pnl = second ? u.pn - split_tile : u.pn; const bool dog = u.pn < gelu_tiles;
        const int rl0 = wr * 64 + fr, cl0 = wc * 32 + 8 * fq;
#pragma unroll
        for (int ai = 0; ai < 2; ++ai)
#pragma unroll
            for (int m = 0; m < 4; ++m) { bf16_t* rowp = base + (size_t)(u.pm * BM + ai * HALF + m * 16 + rl0) * ld + pnl * BM + cl0;
#pragma unroll
                for (int bj = 0; bj < 2; ++bj) { f32x4 v0 = acc[ai][bj][m][0], v1 = acc[ai][bj][m][1]; if (dog) { v0 = gelu4(v0); v1 = gelu4(v1); }
                    *(u32x4*)(rowp + bj * HALF) = pack8(v0, v1); } }
    }
};
struct EpiResid {
    static constexpr bool PERM = true, AFTER_DRAIN = false;
    const float* x; const float* ctx; const float* modbase; float* X1; int base_mode;
    __device__ __forceinline__ void operator()(f32x4 (&acc)[2][2][4][2], const Unit& u, int wr, int wc, int fr, int fq) const {
        const int b = u.pm / 33, tl = u.pm % 33, var = tl == 0 ? 2 : b;
        const float* gate = modbase + (size_t)var * 6144 + u.pn * BM;
        const float* basep = base_mode == 0 ? (tl == 0 ? ctx + (size_t)b * CTXL * D : x + ((size_t)b * SEQ + (size_t)(tl - 1) * 256) * D) : X1 + (size_t)u.pm * BM * D;
        float* outp = X1 + (size_t)u.pm * BM * D;
        const int rl0 = wr * 64 + fr, cl0 = u.pn * BM + wc * 32 + 8 * fq;
        f32x4 gv[2][2];
#pragma unroll
        for (int bj = 0; bj < 2; ++bj)
#pragma unroll
            for (int n = 0; n < 2; ++n) gv[bj][n] = *(const f32x4*)(gate + bj * HALF + wc * 32 + 8 * fq + 4 * n);
#pragma unroll
        for (int ai = 0; ai < 2; ++ai)
#pragma unroll
            for (int m = 0; m < 4; ++m) { const size_t off = (size_t)(ai * HALF + m * 16 + rl0) * D + cl0;
#pragma unroll
                for (int bj = 0; bj < 2; ++bj)
#pragma unroll
                    for (int n = 0; n < 2; ++n) { const f32x4 bs = *(const f32x4*)(basep + off + bj * HALF + 4 * n); *(f32x4*)(outp + off + bj * HALF + 4 * n) = bs + gv[bj][n] * acc[ai][bj][m][n]; } }
    }
};
struct EpiInproj0 {
    static constexpr bool PERM = true, AFTER_DRAIN = false;
    unsigned char* ws; const float* gmg; const float* qg; const float* kg; LAS float* P;
    __device__ __forceinline__ void operator()(f32x4 (&acc)[2][2][4][2], const Unit& u, int wr, int wc, int fr, int fq) const {
        int rl0 = wr * 64 + fr, cl0 = wc * 32 + 8 * fq; asm volatile("" : "+v"(rl0), "+v"(cl0));
        const int pn = u.pn; const size_t grow0 = (size_t)u.pm * BM;
        if (pn < 4) {
#pragma unroll
            for (int ai = 0; ai < 2; ++ai)
#pragma unroll
                for (int bj = 0; bj < 2; ++bj)
#pragma unroll
                    for (int m = 0; m < 4; ++m) { acc[ai][bj][m][0] = gelu4(acc[ai][bj][m][0]); acc[ai][bj][m][1] = gelu4(acc[ai][bj][m][1]); __builtin_amdgcn_sched_barrier(0); }
        }
        if (pn < 2 || pn == 7) {
            bf16_t* base = pn < 2 ? (bf16_t*)(ws + WS_U) + pn * BM : (bf16_t*)(ws + WS_V); const int ld = pn < 2 ? 512 : 256;
#pragma unroll
            for (int ai = 0; ai < 2; ++ai)
#pragma unroll
                for (int m = 0; m < 4; ++m) { bf16_t* rowp = base + (grow0 + ai * HALF + m * 16 + rl0) * ld + cl0;
#pragma unroll
                    for (int bj = 0; bj < 2; ++bj) *(u32x4*)(rowp + bj * HALF) = pack8(acc[ai][bj][m][0], acc[ai][bj][m][1]); }
            return;
        }
#pragma unroll
        for (int ai = 0; ai < 2; ++ai)
#pragma unroll
            for (int m = 0; m < 4; ++m)
#pragma unroll
                for (int bj = 0; bj < 2; ++bj) { const f32x4 a0 = acc[ai][bj][m][0], a1 = acc[ai][bj][m][1];
                    float s = (a0.x * a0.x + a0.y * a0.y) + (a0.z * a0.z + a0.w * a0.w) + (a1.x * a1.x + a1.y * a1.y) + (a1.z * a1.z + a1.w * a1.w);
                    s += __shfl_xor(s, 16); s += __shfl_xor(s, 32);
                    if (fq == 0) P[((ai * HALF + m * 16 + rl0) * 2 + bj) * 4 + wc] = s; __builtin_amdgcn_sched_barrier(0); }
        asm volatile("s_waitcnt lgkmcnt(0)" ::: "memory"); __builtin_amdgcn_s_barrier(); asm volatile("" ::: "memory");
        if (pn < 4) {
            bf16_t* base = (bf16_t*)(ws + WS_VV) + (pn - 2) * BM; const float* gp = gmg + (pn - 2) * BM + cl0;
            f32x4 g8[2][2];
#pragma unroll
            for (int bj = 0; bj < 2; ++bj) { g8[bj][0] = *(const f32x4*)(gp + bj * HALF); g8[bj][1] = *(const f32x4*)(gp + bj * HALF + 4); }
#pragma unroll
            for (int ai = 0; ai < 2; ++ai)
#pragma unroll
                for (int m = 0; m < 4; ++m) { const int rl = ai * HALF + m * 16 + rl0; bf16_t* rowp = base + (grow0 + rl) * 512 + cl0;
#pragma unroll
                    for (int bj = 0; bj < 2; ++bj) { const f32x4 p = *(const LAS f32x4*)(P + (rl * 2 + bj) * 4);
                        const float rinv = rsqrtf(((p.x + p.y) + (p.z + p.w)) * (1.f / 128.f) + EPS);
                        *(u32x4*)(rowp + bj * HALF) = pack8(acc[ai][bj][m][0] * rinv * g8[bj][0], acc[ai][bj][m][1] * rinv * g8[bj][1]); }
                    asm volatile("" ::: "memory"); __builtin_amdgcn_sched_barrier(0); }
            return;
        }
        {
            const bool isq = pn < 6; const float* gn = isq ? qg : kg;
            const int grp = cl0 >> 3, fo = (grp >> 3) * 64 + (grp & 7) * 4;
            const f32x4 gA = *(const f32x4*)(gn + fo), gB = *(const f32x4*)(gn + fo + 32);
            bf16_t* base = isq ? (bf16_t*)(ws + WS_Q) + (pn - 4) * BM : (bf16_t*)(ws + WS_K); const int ld = isq ? 512 : 256;
            const int tl = u.pm % 33; const bool lat = tl != 0; const int ax = grp >> 3, f0 = (grp & 7) * 4;
            const float* rope = (const float*)(ws + WS_ROPE);
#pragma unroll
            for (int ai = 0; ai < 2; ++ai)
#pragma unroll
                for (int m = 0; m < 4; ++m) { const int rl = ai * HALF + m * 16 + rl0; bf16_t* rowp = base + (grow0 + rl) * ld + cl0;
                    f32x4 cs0 = {1.f, 0.f, 1.f, 0.f}, cs1 = {1.f, 0.f, 1.f, 0.f};
                    if (lat) { const int t = (tl - 1) * 256 + rl; const int pos = ax == 0 ? (t >> 6) : (t & 63); const float* rp = rope + (pos * 32 + f0) * 2; cs0 = *(const f32x4*)rp; cs1 = *(const f32x4*)(rp + 4); }
#pragma unroll
                    for (int bj = 0; bj < 2; ++bj) { const f32x4 p = *(const LAS f32x4*)(P + (rl * 2 + bj) * 4);
                        const float rinv = rsqrtf(((p.x + p.y) + (p.z + p.w)) * (1.f / 128.f) + EPS);
                        const f32x4 x1 = acc[ai][bj][m][0] * rinv * gA, x2 = acc[ai][bj][m][1] * rinv * gB;
                        f32x4 o1, o2;
                        o1.x = x1.x * cs0.x - x2.x * cs0.y; o2.x = x2.x * cs0.x + x1.x * cs0.y;
                        o1.y = x1.y * cs0.z - x2.y * cs0.w; o2.y = x2.y * cs0.z + x1.y * cs0.w;
                        o1.z = x1.z * cs1.x - x2.z * cs1.y; o2.z = x2.z * cs1.x + x1.z * cs1.y;
                        o1.w = x1.w * cs1.z - x2.w * cs1.w; o2.w = x2.w * cs1.z + x1.w * cs1.w;
                        *(u32x4*)(rowp + bj * HALF) = pack8(o1, o2); }
                    asm volatile("" ::: "memory"); __builtin_amdgcn_sched_barrier(0); }
        }
    }
};

template <class Epi, class Sched, bool ALIGN_EPI = false, bool SP2 = false>
__device__ __forceinline__ void gemm_phase(LAS unsigned char* lds, const Gemm g, const Sched& S, const Epi& E) {
    const int tid = threadIdx.x, wid = __builtin_amdgcn_readfirstlane(tid >> 6), lane = tid & 63, wr = wid >> 2, wc = wid & 3, fr = lane & 15, fq = lane >> 4;
    const int K = g.K, nt = K / BK;
    unsigned voffA[2], voffB[2];
#pragma unroll
    for (int i = 0; i < 2; ++i) { int R, C; stage_rc(tid * 16 + i * 8192, R, C); const int Rb = Epi::PERM ? ((R & ~31) + perm32(R & 31)) : R;
        voffA[i] = (unsigned)(R * K + C) * 2u; voffB[i] = (unsigned)(Rb * K + C) * 2u; }
    const size_t kstep = (size_t)(BK * 2);
    const size_t hstep = (size_t)HALF * K * 2;
    const size_t tstep = 2 * hstep;
    const unsigned ldsw = (unsigned)wid * 1024u;
    const int aoff = lds_byte(wr * 64 + fr, fq * 8), boff = lds_byte(wc * 32 + fr, fq * 8);
#define PG8_SA(b, h) (((b) * 2 + (h)) * HTB)
#define PG8_SB(b, h) ((4 + (b) * 2 + (h)) * HTB)
#define PG8_STAGE(bufoff, gbase, voff) do { _Pragma("unroll") for (int _i = 0; _i < 2; ++_i) \
        __builtin_amdgcn_global_load_lds((const unsigned*)((const char*)(gbase) + (voff)[_i]), (LAS unsigned*)(lds + (bufoff) + ldsw + _i * 8192), 16, 0, 0); } while (0)
#define PG8_LDA(dst, b, h) do { _Pragma("unroll") for (int m = 0; m < 4; ++m) _Pragma("unroll") for (int k = 0; k < 2; ++k) dst[m][k] = *(const LAS bf16x8*)(lds + PG8_SA(b, h) + aoff + m * 2048 + k * 1024); } while (0)
#define PG8_LDB(dst, b, h) do { _Pragma("unroll") for (int n = 0; n < 2; ++n) _Pragma("unroll") for (int k = 0; k < 2; ++k) dst[n][k] = *(const LAS bf16x8*)(lds + PG8_SB(b, h) + boff + n * 2048 + k * 1024); } while (0)
#define PG8_MMA(ai, bj, At, Bt) do { __builtin_amdgcn_s_setprio(1); _Pragma("unroll") for (int m = 0; m < 4; ++m) _Pragma("unroll") for (int n = 0; n < 2; ++n) _Pragma("unroll") for (int k = 0; k < 2; ++k) \
        acc[ai][bj][m][n] = __builtin_amdgcn_mfma_f32_16x16x32_bf16(Bt[n][k], At[m][k], acc[ai][bj][m][n], 0, 0, 0); __builtin_amdgcn_s_setprio(0); } while (0)
#define PG8_WAIT_V(n) asm volatile("s_waitcnt vmcnt(" #n ")" ::: "memory")
#define PG8_WAIT_L(n) asm volatile("s_waitcnt lgkmcnt(" #n ")" ::: "memory")
#define PG8_BAR __builtin_amdgcn_s_barrier()
#define PG8_SCHED __builtin_amdgcn_sched_barrier(0)
    Unit cur, nxt; int ui = 0;
    if (!S.next(0, cur)) return;
    f32x4 acc[2][2][4][2];
#pragma unroll
    for (int a = 0; a < 2; ++a)
#pragma unroll
        for (int b = 0; b < 2; ++b)
#pragma unroll
            for (int m = 0; m < 4; ++m)
#pragma unroll
                for (int n = 0; n < 2; ++n) acc[a][b][m][n] = (f32x4){0.f, 0.f, 0.f, 0.f};
    bf16x8 At[4][2], B0[2][2], B1[2][2];
    const char* cA = (const char*)g.A + (size_t)cur.pm * tstep; const char* cB = (const char*)g.Bt + (size_t)cur.pn * tstep;
    S.a_ready(cur);
    if constexpr (SP2) {
        PG8_STAGE(PG8_SB(0, 0), cB, voffB); PG8_STAGE(PG8_SB(0, 1), cB + hstep, voffB); PG8_STAGE(PG8_SA(0, 0), cA, voffA); PG8_STAGE(PG8_SA(0, 1), cA + hstep, voffA);
        if (wr == 1) PG8_BAR;
        PG8_WAIT_V(2); PG8_BAR;
        PG8_STAGE(PG8_SB(1, 0), cB + kstep, voffB); PG8_STAGE(PG8_SA(1, 0), cA + kstep, voffA); PG8_STAGE(PG8_SB(1, 1), cB + hstep + kstep, voffB);
        PG8_WAIT_V(6); PG8_BAR;
    } else {
        PG8_STAGE(PG8_SB(0, 0), cB, voffB); PG8_STAGE(PG8_SA(0, 0), cA, voffA); PG8_STAGE(PG8_SB(0, 1), cB + hstep, voffB); PG8_STAGE(PG8_SA(0, 1), cA + hstep, voffA);
        if (wr == 1) PG8_BAR;
        PG8_WAIT_V(4); PG8_BAR;
        PG8_STAGE(PG8_SB(1, 0), cB + kstep, voffB); PG8_STAGE(PG8_SA(1, 0), cA + kstep, voffA); PG8_STAGE(PG8_SB(1, 1), cB + hstep + kstep, voffB);
        PG8_WAIT_V(6); PG8_BAR;
    }
    for (;;) {
        const bool has_next = S.next(ui + 1, nxt);
        const char* nA = has_next ? (const char*)g.A + (size_t)nxt.pm * tstep : cA; const char* nB = has_next ? (const char*)g.Bt + (size_t)nxt.pn * tstep : cB;
        for (int t = 0; t < nt; t += 2) {
            const bool last = (t == nt - 2);
            const char* a1 = cA + (size_t)(t + 1) * kstep;
            const char* a2 = last ? nA : cA + (size_t)(t + 2) * kstep; const char* b2 = last ? nB : cB + (size_t)(t + 2) * kstep;
            const char* a3 = a2 + kstep; const char* b3 = b2 + kstep;
            if (last && has_next) S.a_ready(nxt);
            if constexpr (SP2) {
            PG8_LDB(B0, 0, 0); PG8_LDB(B1, 0, 1); PG8_SCHED; PG8_LDA(At, 0, 0); PG8_STAGE(PG8_SA(1, 1), a1 + hstep, voffA);
            PG8_WAIT_V(8); PG8_WAIT_L(0); PG8_BAR; PG8_MMA(0, 0, At, B0); PG8_MMA(0, 1, At, B1); PG8_BAR; PG8_SCHED;
            PG8_LDA(At, 0, 1); PG8_STAGE(PG8_SB(0, 0), b2, voffB); PG8_STAGE(PG8_SB(0, 1), b2 + hstep, voffB); PG8_STAGE(PG8_SA(0, 0), a2, voffA);
            PG8_WAIT_V(8); PG8_WAIT_L(0); PG8_BAR; PG8_MMA(1, 0, At, B0); PG8_MMA(1, 1, At, B1); PG8_BAR; PG8_SCHED;
            PG8_LDB(B0, 1, 0); PG8_LDB(B1, 1, 1); PG8_SCHED; PG8_LDA(At, 1, 0); PG8_STAGE(PG8_SA(0, 1), a2 + hstep, voffA);
            PG8_WAIT_V(8); PG8_WAIT_L(0); PG8_BAR; PG8_MMA(0, 0, At, B0); PG8_MMA(0, 1, At, B1); PG8_BAR; PG8_SCHED;
            PG8_LDA(At, 1, 1); PG8_STAGE(PG8_SB(1, 0), b3, voffB); PG8_STAGE(PG8_SB(1, 1), b3 + hstep, voffB); PG8_STAGE(PG8_SA(1, 0), a3, voffA);
            PG8_WAIT_V(8); PG8_WAIT_L(0); PG8_BAR; PG8_MMA(1, 0, At, B0); PG8_MMA(1, 1, At, B1); PG8_BAR; PG8_SCHED;
            } else {
            PG8_LDB(B0, 0, 0); PG8_SCHED; PG8_LDA(At, 0, 0); PG8_STAGE(PG8_SA(1, 1), a1 + hstep, voffA);
            PG8_WAIT_L(8); PG8_BAR; PG8_WAIT_L(0); PG8_MMA(0, 0, At, B0); PG8_BAR; PG8_SCHED;
            PG8_LDB(B1, 0, 1); PG8_STAGE(PG8_SB(0, 0), b2, voffB);
            PG8_BAR; PG8_WAIT_L(0); PG8_MMA(0, 1, At, B1); PG8_BAR;
            PG8_LDA(At, 0, 1); PG8_STAGE(PG8_SA(0, 0), a2, voffA);
            PG8_BAR; PG8_WAIT_L(0); PG8_MMA(1, 0, At, B0); PG8_BAR; PG8_SCHED;
            PG8_STAGE(PG8_SB(0, 1), b2 + hstep, voffB);
            PG8_WAIT_V(6); PG8_BAR; PG8_MMA(1, 1, At, B1); PG8_BAR;
            PG8_LDB(B0, 1, 0); PG8_SCHED; PG8_LDA(At, 1, 0); PG8_STAGE(PG8_SA(0, 1), a2 + hstep, voffA);
            PG8_WAIT_L(8); PG8_BAR; PG8_WAIT_L(0); PG8_MMA(0, 0, At, B0); PG8_BAR; PG8_SCHED;
            PG8_LDB(B1, 1, 1); PG8_STAGE(PG8_SB(1, 0), b3, voffB);
            PG8_BAR; PG8_WAIT_L(0); PG8_MMA(0, 1, At, B1); PG8_BAR;
            PG8_LDA(At, 1, 1); PG8_STAGE(PG8_SA(1, 0), a3, voffA);
            PG8_BAR; PG8_WAIT_L(0); PG8_MMA(1, 0, At, B0); PG8_BAR; PG8_SCHED;
            PG8_STAGE(PG8_SB(1, 1), b3 + hstep, voffB);
            PG8_WAIT_V(6); PG8_BAR; PG8_MMA(1, 1, At, B1); PG8_BAR;
            }
        }
        if constexpr (ALIGN_EPI) { if (wr == 0) PG8_BAR; }
        if constexpr (!Epi::AFTER_DRAIN) { E(acc, cur, wr, wc, fr, fq); S.done(cur); }
        if (!has_next) break;
#pragma unroll
        for (int a = 0; a < 2; ++a)
#pragma unroll
            for (int b = 0; b < 2; ++b)
#pragma unroll
                for (int m = 0; m < 4; ++m)
#pragma unroll
                    for (int n = 0; n < 2; ++n) acc[a][b][m][n] = (f32x4){0.f, 0.f, 0.f, 0.f};
        cur = nxt; cA = nA; cB = nB; ++ui;
        if constexpr (ALIGN_EPI) { if (wr == 1) PG8_BAR; }
    }
    PG8_WAIT_V(0);
    if constexpr (!ALIGN_EPI) { if (wr == 0) PG8_BAR; }
    PG8_BAR;
#undef PG8_SA
#undef PG8_SB
#undef PG8_STAGE
#undef PG8_LDA
#undef PG8_LDB
#undef PG8_MMA
#undef PG8_WAIT_V
#undef PG8_WAIT_L
#undef PG8_BAR
#undef PG8_SCHED
}
}

__device__ __forceinline__ void fphase_inproj0(const Args& a, char* lds) {
    pg8::Gemm g{(const bf16_t*)(a.ws + WS_H), (const bf16_t*)(a.ws + WS_WIN0), MTOT, 2048, 1024};
    pg8::StaticOrder S; S.init(MTOT, 2048, (int)gridDim.x, (int)blockIdx.x);
    pg8::EpiInproj0 E{a.ws, a.in[9], a.in[12], a.in[13], (LAS float*)((LAS char*)lds + 131072)};
    pg8::gemm_phase<pg8::EpiInproj0, pg8::StaticOrder, true, true>((LAS unsigned char*)lds, g, S, E);
}
__device__ __forceinline__ void fphase_outproj0(const Args& a, char* lds) {
    pg8::Gemm g{(const bf16_t*)(a.ws + WS_AO), (const bf16_t*)(a.ws + WS_WOUT0), MTOT, 1024, 1024};
    pg8::StaticOrder S; S.init(MTOT, 1024, (int)gridDim.x, (int)blockIdx.x);
    pg8::EpiResid E{a.in[0], a.in[2], (const float*)(a.ws + WS_MODV) + 2 * 1024, (float*)(a.ws + WS_X1), 0};
    pg8::gemm_phase<pg8::EpiResid, pg8::StaticOrder, true, true>((LAS unsigned char*)lds, g, S, E);
}
__device__ __forceinline__ void fphase_peerq0(const Args& a, char* lds) {
    pg8::Gemm g{(const bf16_t*)(a.ws + WS_H), (const bf16_t*)(a.ws + WS_WQ), MTOT, 2048, 1024};
    pg8::StaticOrder S; S.init(MTOT, 2048, (int)gridDim.x, (int)blockIdx.x);
    pg8::EpiStore E{(bf16_t*)(a.ws + WS_QP), (bf16_t*)(a.ws + WS_QP), 2048, 1000, 0};
    pg8::gemm_phase<pg8::EpiStore, pg8::StaticOrder, true, true>((LAS unsigned char*)lds, g, S, E);
}
__device__ __forceinline__ void fphase_inproj1(const Args& a, char* lds) {
    pg8::Gemm g{(const bf16_t*)(a.ws + WS_H), (const bf16_t*)(a.ws + WS_WIN1), MTOT, 2560, 1024};
    pg8::StaticOrder S; S.init(MTOT, 2560, (int)gridDim.x, (int)blockIdx.x);
    pg8::EpiStore E{(bf16_t*)(a.ws + WS_GG), (bf16_t*)(a.ws + WS_XR), 1280, 5, 5};
    pg8::gemm_phase<pg8::EpiStore, pg8::StaticOrder, true, true>((LAS unsigned char*)lds, g, S, E);
}
__device__ __forceinline__ void fphase_outproj1(const Args& a, char* lds) {
    pg8::Gemm g{(const bf16_t*)(a.ws + WS_YG), (const bf16_t*)(a.ws + WS_WOUT1), MTOT, 1024, 1280};
    pg8::LatentOrder S; S.init(1024, (int)gridDim.x, (int)blockIdx.x);
    pg8::EpiResid E{a.in[0], a.in[2], (const float*)(a.ws + WS_MODV) + 3 * 6144 + 2 * 1024, (float*)(a.ws + WS_X1), 1};
    pg8::gemm_phase<pg8::EpiResid, pg8::LatentOrder, true, true>((LAS unsigned char*)lds, g, S, E);
}
__device__ __forceinline__ void fphase_peerq1(const Args& a, char* lds) {
    pg8::Gemm g{(const bf16_t*)(a.ws + WS_H), (const bf16_t*)(a.ws + WS_WQ) + (size_t)2048 * 1024, MTOT, 2048, 1024};
    pg8::LatentOrder S; S.init(2048, (int)gridDim.x, (int)blockIdx.x);
    pg8::EpiStore E{(bf16_t*)(a.ws + WS_QP), (bf16_t*)(a.ws + WS_QP), 2048, 1000, 0};
    pg8::gemm_phase<pg8::EpiStore, pg8::LatentOrder, true, true>((LAS unsigned char*)lds, g, S, E);
}

constexpr int NPHASE = 17;
__global__ void __launch_bounds__(NTHR, 2) mega(Args a) {
    extern __shared__ __attribute__((aligned(16))) char lds[];
    volatile LAS unsigned* MISC = (volatile LAS unsigned*)((LAS char*)lds + LDS_MISC);
    if (threadIdx.x < 64) MISC[threadIdx.x] = 0u;
    __syncthreads();
    XcdBarrier bar; bar.bar = (unsigned*)(a.ws + WS_CTL) + 4096; bar.x = 0; bar.st = nullptr;
    const bool multi = (a.ph_hi - a.ph_lo) > 1;
    if (multi) bar = xcd_barrier_post((unsigned*)(a.ws + WS_CTL) + 4096, MISC + 8);
    const int lo = a.ph_lo, hi = a.ph_hi;
    unsigned char* ws = a.ws;
#define IN(k) (lo <= (k) && (k) < hi)
#define SEAM(k) do { if (IN(k) && IN((k) + 1)) xcd_barrier(bar); } while (0)
    if (IN(0)) { phase_prep(a, lds); } SEAM(0);
    if (IN(1)) { phase_norm(a, 0, 0, a.in[6], 0, 1, false); } SEAM(1);
    if (IN(2)) { fphase_inproj0(a, lds); } SEAM(2);
    if (IN(3)) { phase_gmlp(a, lds); phase_attn(a, lds); } SEAM(3);
    if (IN(4)) { fphase_outproj0(a, lds); } SEAM(4);
    if (IN(5)) { phase_norm(a, 0, 1, a.in[7], 3, 4, false); } SEAM(5);
    if (IN(6)) { fphase_peerq0(a, lds); } SEAM(6);
    if (IN(7)) { phase_peer_topk2(a, 0, false); } SEAM(7);
    if (IN(8)) { phase_peer_gather2(a, lds, 0, 0); } SEAM(8);
    if (IN(9)) { fphase_inproj1(a, lds); } SEAM(9);
    if (IN(10)) { phase_rglru2(a, lds, 0); } SEAM(10);
    if (IN(11)) { phase_rglru2(a, lds, 1); } SEAM(11);
    if (IN(12)) { fphase_outproj1(a, lds); } SEAM(12);
    if (IN(13)) { phase_norm(a, 1, 1, a.in[7] + D, 3, 4, true); } SEAM(13);
    if (IN(14)) { fphase_peerq1(a, lds); } SEAM(14);
    if (IN(15)) { phase_peer_topk2(a, 1, true); } SEAM(15);
    if (IN(16)) { phase_peer_gather2(a, lds, 1, 1); }
#undef IN
#undef SEAM
}

extern "C" void kernel_launch(void* const* d_in, const int* in_sizes, int n_in, void* d_out, int out_size, void* d_ws, size_t ws_size, hipStream_t stream) {
    static int grid = 0;
    if (grid == 0) {
        if (n_in != 29 || out_size != NB * SEQ * D || ws_size < WS_END) {
            fprintf(stderr, "kernel_launch: unexpected shapes: n_in %d out %d ws %zu (need %zu)\n", n_in, out_size, ws_size, (size_t)WS_END); grid = -1; return; }
        int dev = 0, cus = 0, per_cu = 0;
        if (hipGetDevice(&dev) != hipSuccess || hipDeviceGetAttribute(&cus, hipDeviceAttributeMultiprocessorCount, dev) != hipSuccess) { grid = -1; return; }
        if (hipFuncSetAttribute((const void*)mega, hipFuncAttributeMaxDynamicSharedMemorySize, LDS_BYTES) != hipSuccess) { fprintf(stderr, "kernel_launch: hipFuncSetAttribute failed\n"); grid = -1; return; }
        if (hipOccupancyMaxActiveBlocksPerMultiprocessor(&per_cu, (const void*)mega, NTHR, LDS_BYTES) != hipSuccess || per_cu < 1)
            fprintf(stderr, "kernel_launch: occupancy query reports %d blocks per CU\n", per_cu);
        (void)hipGetLastError();
        grid = cus;
    }
    if (grid < 0) return;
    (void)hipMemsetAsync((char*)d_ws + WS_CTL, 0, CTL_BYTES, stream);
    Args a{};
    for (int i = 0; i < 29; ++i) a.in[i] = (const float*)d_in[i];
    a.out = (float*)d_out; a.ws = (unsigned char*)d_ws;
#if MK_SINGLE
    a.ph_lo = 0; a.ph_hi = NPHASE;
    hipLaunchKernelGGL(mega, dim3(grid), dim3(NTHR), LDS_BYTES, stream, a);
#else
    for (int p = 0; p < NPHASE; ++p) { a.ph_lo = p; a.ph_hi = p + 1; hipLaunchKernelGGL(mega, dim3(grid), dim3(NTHR), LDS_BYTES, stream, a); }
#endif
    const hipError_t le = hipPeekAtLastError();
    if (le != hipSuccess) fprintf(stderr, "kernel_launch: launch failed: %s\n", hipGetErrorName(le));
}
```

```cpp
#include <hip/hip_runtime.h>
#include <cstdio>
#include <cstdint>

#ifndef MK_SINGLE
#define MK_SINGLE 1
#endif

#define GAS __attribute__((address_space(1)))
#define LAS __attribute__((address_space(3)))

typedef unsigned short bf16_t;
typedef short bf16x8 __attribute__((ext_vector_type(8)));
typedef float f32x4 __attribute__((ext_vector_type(4)));
typedef float f32x16 __attribute__((ext_vector_type(16)));
typedef unsigned u32x4 __attribute__((ext_vector_type(4)));
typedef unsigned u32x2 __attribute__((ext_vector_type(2)));

constexpr int D = 1024, NB = 2, SEQ = 8192, CTXL = 256;
constexpr int RPB = SEQ + CTXL;
constexpr int MTOT = NB * RPB;
constexpr int AB_IN = 2048, A_W = 512, DRNN = 1280, NEXP = 16384;
constexpr float EPS = 1e-6f;
constexpr int NTHR = 512, NWAVE = 8;

constexpr size_t MiB = 1u << 20;
constexpr size_t WS_CTL = 0, CTL_BYTES = 1 * MiB;
constexpr size_t WS_MODV = 1 * MiB;
constexpr size_t WS_ROPE = 1 * MiB + 512 * 1024;
constexpr size_t WS_WIN0 = 2 * MiB;
constexpr size_t WS_WOUT0 = 6 * MiB;
constexpr size_t WS_WIN1 = 8 * MiB;
constexpr size_t WS_WOUT1 = 13 * MiB;
constexpr size_t WS_WQ = 16 * MiB;
constexpr size_t WS_KEYS = 24 * MiB;
constexpr size_t WS_GWS = 25 * MiB;
constexpr size_t WS_WAT = 26 * MiB;
constexpr size_t WS_WXT = 27 * MiB;
constexpr size_t WS_CARRY = 28 * MiB;
constexpr size_t WS_SCU = 31 * MiB;
constexpr size_t WS_SCV = 31 * MiB + 512 * 1024;
constexpr size_t WS_PU = 32 * MiB;
constexpr size_t WS_PV = 96 * MiB;
constexpr size_t WS_H = 160 * MiB;
constexpr size_t WS_X1 = 193 * MiB;
constexpr size_t WS_SELI = 259 * MiB;
constexpr size_t WS_SELG = 268 * MiB;
constexpr size_t WS_R = 277 * MiB;
constexpr size_t WS_U = WS_R;
constexpr size_t WS_VV = WS_R + 17 * MiB;
constexpr size_t WS_Q = WS_R + 34 * MiB;
constexpr size_t WS_K = WS_R + 51 * MiB;
constexpr size_t WS_V = WS_R + 60 * MiB;
constexpr size_t WS_AO = WS_R + 69 * MiB;
constexpr size_t WS_QP = WS_R;
constexpr size_t WS_GG = WS_R;
constexpr size_t WS_XR = WS_R + 42 * MiB;
constexpr size_t WS_YG = WS_R + 84 * MiB;
constexpr size_t WS_END = WS_R + 126 * MiB;

constexpr int LDS_BYTES = 147456;
constexpr int LDS_MISC = 145408;

__device__ __forceinline__ float bf2f(bf16_t v) { return __uint_as_float(((unsigned)v) << 16); }
__device__ __forceinline__ unsigned f2bf(float f) { unsigned u = __float_as_uint(f); return (u + 0x7fffu + ((u >> 16) & 1u)) >> 16; }
__device__ __forceinline__ unsigned pk2(float lo, float hi) { return f2bf(lo) | (f2bf(hi) << 16); }
__device__ __forceinline__ float bflo(unsigned w) { return __uint_as_float(w << 16); }
__device__ __forceinline__ float bfhi(unsigned w) { return __uint_as_float(w & 0xffff0000u); }
__device__ __forceinline__ float gelu_t(float x) { const float y = -2.302208198144325f * (x + 0.044715f * x * x * x); return x * __builtin_amdgcn_rcpf(1.f + __builtin_amdgcn_exp2f(y)); }
__device__ __forceinline__ float sigmoidf_(float x) { return 1.f / (1.f + __expf(-x)); }
__device__ __forceinline__ float wave_sum(float v) {
#pragma unroll
    for (int o = 1; o < 64; o <<= 1) v += __shfl_xor(v, o);
    return v;
}
__host__ __device__ __forceinline__ int sigma_head(int j) { const int grp = j >> 3, n = (j >> 2) & 1, e = j & 3; return (grp >> 3) * 64 + n * 32 + (grp & 7) * 4 + e; }

struct Args {
    const float* in[29];
    float* out;
    unsigned char* ws;
    int ph_lo, ph_hi;
};

__device__ __forceinline__ int row_variant(int g) { const int b = g / RPB, i = g - b * RPB; return i < CTXL ? 2 : b; }
__device__ __forceinline__ const float* row_src(const Args& a, int g) {
    const int b = g / RPB, i = g - b * RPB;
    return i < CTXL ? a.in[2] + ((size_t)b * CTXL + i) * D : a.in[0] + ((size_t)b * SEQ + (i - CTXL)) * D;
}
__device__ __forceinline__ const float* modv(const Args& a, int layer, int variant, int which) {
    return (const float*)(a.ws + WS_MODV) + ((size_t)(layer * 3 + variant) * 6 + which) * D;
}

#define XB_TMO      128
#define XB_XCNT(j)  (256  + 64 * (j))
#define XB_XSUB(j)  (1280 + 64 * (j))
#define XB_XGEN(j)  (2304 + 64 * (j))
#define XB_TOP      3328
#define XB_TOPGEN   3392
#define XCD_BAR_WORDS 3456
#define XB_SPIN_CAP (1u << 22)
__device__ __forceinline__ unsigned xb_ld(unsigned* p)              { return __hip_atomic_load(p, __ATOMIC_RELAXED, __HIP_MEMORY_SCOPE_AGENT); }
__device__ __forceinline__ unsigned xb_add(unsigned* p, unsigned v) { return __hip_atomic_fetch_add(p, v, __ATOMIC_RELAXED, __HIP_MEMORY_SCOPE_AGENT); }
__device__ __forceinline__ unsigned xb_xcc_id() { return (unsigned)__builtin_amdgcn_s_getreg((3 << 11) | 20) & 0xFu; }
#define XB_SPIN(cond, bar) do { unsigned _sp = 0; while (cond) { __builtin_amdgcn_s_sleep(1); \
    if ((++_sp & 255u) == 0u) { if (xb_ld(&(bar)[XB_TMO])) break; if (_sp > XB_SPIN_CAP) { atomicAdd(&(bar)[XB_TMO], 1u); break; } } } } while (0)
struct XcdBarrier { unsigned* bar; unsigned x; volatile LAS unsigned* st; };
__device__ __forceinline__ XcdBarrier xcd_barrier_post(unsigned* bar, volatile LAS unsigned* st) {
    XcdBarrier b; b.bar = bar; b.x = xb_xcc_id(); b.st = st;
    if (threadIdx.x == 0) (void)xb_add(&bar[XB_XCNT(b.x)], 1u);
    return b;
}
__device__ __forceinline__ void xcd_barrier_complete(unsigned* bar, unsigned x, unsigned& nloc, unsigned& nx) {
    const unsigned G = gridDim.x * gridDim.y * gridDim.z;
    unsigned sum, cnt, mine, sp = 0u;
    for (;;) {
        sum = 0u; cnt = 0u; mine = 0u;
#pragma unroll
        for (unsigned j = 0; j < 16; ++j) { const unsigned c = xb_ld(&bar[XB_XCNT(j)]); sum += c; cnt += (c > 0u) ? 1u : 0u; mine = (j == x) ? c : mine; }
        if (sum == G) break;
        __builtin_amdgcn_s_sleep(1);
        if ((++sp & 255u) == 0u) { if (xb_ld(&bar[XB_TMO])) break; if (sp > XB_SPIN_CAP) { atomicAdd(&bar[XB_TMO], 1u); break; } }
    }
    nloc = mine > 0u ? mine : 1u; nx = cnt > 0u ? cnt : 1u;
}
__device__ __forceinline__ void xcd_barrier(const XcdBarrier& b) {
    asm volatile("s_waitcnt vmcnt(0)" ::: "memory");
    __syncthreads();
    if (threadIdx.x == 0) {
        unsigned* bar = b.bar;
        __builtin_amdgcn_s_waitcnt(0);
        unsigned nloc = b.st[0], nx = b.st[1];
        if (nloc == 0u) { xcd_barrier_complete(bar, b.x, nloc, nx); b.st[0] = nloc; b.st[1] = nx; }
        const unsigned old = xb_add(&bar[XB_XSUB(b.x)], 1u);
        const unsigned gen = old / nloc;
        if (old + 1u == (gen + 1u) * nloc) {
            __builtin_amdgcn_fence(__ATOMIC_RELEASE, "agent");
            asm volatile("s_waitcnt vmcnt(0)" ::: "memory");
            const unsigned og = xb_add(&bar[XB_TOP], 1u);
            const unsigned tg = og / nx;
            if (og + 1u == (tg + 1u) * nx) xb_add(&bar[XB_TOPGEN], 1u);
            else XB_SPIN(xb_ld(&bar[XB_TOPGEN]) == tg, bar);
            __builtin_amdgcn_fence(__ATOMIC_ACQUIRE, "agent");
            xb_add(&bar[XB_XGEN(b.x)], 1u);
            asm volatile("s_waitcnt vmcnt(0)" ::: "memory");
        } else {
            XB_SPIN(xb_ld(&bar[XB_XGEN(b.x)]) == gen, bar);
            __builtin_amdgcn_fence(__ATOMIC_ACQUIRE, "agent");
            asm volatile("s_waitcnt vmcnt(0)" ::: "memory");
        }
    }
    __syncthreads();
}

__device__ __forceinline__ void transpose_item(const float* src, int Ns, bf16_t* dst, int Kd, int n0, int k0, int perm_lo, int perm_hi, float* tile) {
    const int tid = threadIdx.x;
    {
        const int nn = tid & 63; int n = n0 + nn;
        if (n >= perm_lo && n < perm_hi) { const int rel = n - perm_lo; n = perm_lo + (rel & ~127) + sigma_head(rel & 127); }
#pragma unroll
        for (int i = 0; i < 8; ++i) { const int kk = (tid >> 6) + 8 * i; tile[kk * 65 + nn] = src[(size_t)(k0 + kk) * Ns + n]; }
    }
    __syncthreads();
    {
        const int n = tid >> 3, kc = (tid & 7) * 8;
        u32x4 o;
        o.x = pk2(tile[(kc + 0) * 65 + n], tile[(kc + 1) * 65 + n]); o.y = pk2(tile[(kc + 2) * 65 + n], tile[(kc + 3) * 65 + n]);
        o.z = pk2(tile[(kc + 4) * 65 + n], tile[(kc + 5) * 65 + n]); o.w = pk2(tile[(kc + 6) * 65 + n], tile[(kc + 7) * 65 + n]);
        *(u32x4*)(dst + (size_t)(n0 + n) * Kd + k0 + kc) = o;
    }
    __syncthreads();
}
__device__ __forceinline__ void cvt_stream(const float* src, bf16_t* dst, size_t n8, size_t gtid, size_t gthreads) {
    for (size_t i = gtid; i < n8; i += gthreads) {
        const f32x4 a = *(const f32x4*)(src + i * 8), b = *(const f32x4*)(src + i * 8 + 4);
        u32x4 o; o.x = pk2(a.x, a.y); o.y = pk2(a.z, a.w); o.z = pk2(b.x, b.y); o.w = pk2(b.z, b.w);
        *(u32x4*)(dst + i * 8) = o;
    }
}
__device__ __forceinline__ void phase_prep(const Args& a, char* lds) {
    const int tid = threadIdx.x, lane = tid & 63, wid = tid >> 6;
    float* tile = (float*)lds;
    unsigned char* ws = a.ws;
    constexpr int I_MOD = 192;
    constexpr int I_WIN0 = (1024 / 64) * (2048 / 64), I_WOUT0 = (1024 / 64) * (1024 / 64), I_WIN1 = (1024 / 64) * (2560 / 64), I_WOUT1 = (1280 / 64) * (1024 / 64);
    constexpr int I_WQ = 2 * (1024 / 64) * (2048 / 64), I_WAX = 40 * 4;
    constexpr int NIT = I_MOD + I_WIN0 + I_WOUT0 + I_WIN1 + I_WOUT1 + I_WQ + I_WAX;
    for (int it = blockIdx.x; it < NIT; it += gridDim.x) {
        int r = it;
        if (r < I_MOD) {
            const int l = r / 96, n0 = (r % 96) * 64;
            const float* W = a.in[4] + (size_t)l * D * 6144;
            float s0 = 0.f, s1 = 0.f, s2 = 0.f;
            for (int k = wid * 128; k < wid * 128 + 128; ++k) {
                const float w = W[(size_t)k * 6144 + n0 + lane];
                const float c0 = a.in[1][k], c1 = a.in[1][D + k], c2 = a.in[3][k];
                s0 += c0 * sigmoidf_(c0) * w; s1 += c1 * sigmoidf_(c1) * w; s2 += c2 * sigmoidf_(c2) * w;
            }
            tile[(wid * 3 + 0) * 64 + lane] = s0; tile[(wid * 3 + 1) * 64 + lane] = s1; tile[(wid * 3 + 2) * 64 + lane] = s2;
            __syncthreads();
            if (tid < 192) {
                const int v = tid / 64, ln = tid & 63; float s = a.in[5][(size_t)l * 6144 + n0 + ln];
                for (int w = 0; w < 8; ++w) s += tile[(w * 3 + v) * 64 + ln];
                ((float*)(ws + WS_MODV))[(size_t)(l * 3 + v) * 6144 + n0 + ln] = s;
            }
            __syncthreads();
            continue;
        }
        r -= I_MOD;
        if (r < I_WIN0) { const int nb = r % 32, kb = r / 32; transpose_item(a.in[8], 2048, (bf16_t*)(ws + WS_WIN0), 1024, nb * 64, kb * 64, 1024, 1792, tile); continue; }
        r -= I_WIN0;
        if (r < I_WOUT0) { const int nb = r % 16, kb = r / 16; transpose_item(a.in[14], 1024, (bf16_t*)(ws + WS_WOUT0), 1024, nb * 64, kb * 64, 0, 0, tile); continue; }
        r -= I_WOUT0;
        if (r < I_WIN1) { const int nb = r % 40, kb = r / 40; transpose_item(a.in[15], 2560, (bf16_t*)(ws + WS_WIN1), 1024, nb * 64, kb * 64, 0, 0, tile); continue; }
        r -= I_WIN1;
        if (r < I_WOUT1) { const int nb = r % 16, kb = r / 16; transpose_item(a.in[23], 1024, (bf16_t*)(ws + WS_WOUT1), 1280, nb * 64, kb * 64, 0, 0, tile); continue; }
        r -= I_WOUT1;
        if (r < I_WQ) { const int l = r / 512, q = r % 512, nb = q % 32, kb = q / 32;
            transpose_item(a.in[24] + (size_t)l * 1024 * 2048, 2048, (bf16_t*)(ws + WS_WQ) + (size_t)l * 2048 * 1024, 1024, nb * 64, kb * 64, 0, 0, tile); continue; }
        r -= I_WQ;
        { const int m = r / 4, q = r % 4, nb = q % 2, kb = q / 2;
            const int which = m / 20, dh = m % 20;
            const float* src = a.in[which == 0 ? 18 : 20] + (size_t)dh * 128 * 128;
            bf16_t* dst = (bf16_t*)(ws + (which == 0 ? WS_WAT : WS_WXT)) + (size_t)dh * 128 * 128;
            transpose_item(src, 128, dst, 128, nb * 64, kb * 64, 0, 0, tile);
        }
    }
    const size_t gtid = (size_t)blockIdx.x * NTHR + tid, gthreads = (size_t)gridDim.x * NTHR;
    cvt_stream(a.in[25], (bf16_t*)(ws + WS_KEYS), (size_t)2 * 8 * 2 * 128 * 128 / 8, gtid, gthreads);
    cvt_stream(a.in[10], (bf16_t*)(ws + WS_GWS), (size_t)4 * 128 * 128 / 8, gtid, gthreads);
    {
        const int gw = blockIdx.x * NWAVE + wid, ngw = gridDim.x * NWAVE;
        for (int r = gw; r < 4 * NEXP; r += ngw) {
            const int tb = r / (2 * NEXP), rr = r - tb * 2 * NEXP;
            const float* src = a.in[tb == 0 ? 26 : 27] + (size_t)rr * D;
            f32x4 v[4]; float mx = 0.f;
#pragma unroll
            for (int j = 0; j < 4; ++j) { v[j] = *(const f32x4*)(src + j * 256 + lane * 4); mx = fmaxf(fmaxf(fmaxf(fabsf(v[j].x), fabsf(v[j].y)), fmaxf(fabsf(v[j].z), fabsf(v[j].w))), mx); }
#pragma unroll
            for (int o = 1; o < 64; o <<= 1) mx = fmaxf(mx, __shfl_xor(mx, o));
            mx = fmaxf(mx, 1e-30f);
            const float inv = 127.f / mx;
            unsigned char* dst = ws + (tb == 0 ? WS_PU : WS_PV) + (size_t)rr * D;
#pragma unroll
            for (int j = 0; j < 4; ++j) {
                const unsigned b0 = (unsigned)(__float2int_rn(v[j].x * inv) + 128), b1 = (unsigned)(__float2int_rn(v[j].y * inv) + 128);
                const unsigned b2 = (unsigned)(__float2int_rn(v[j].z * inv) + 128), b3 = (unsigned)(__float2int_rn(v[j].w * inv) + 128);
                *(unsigned*)(dst + j * 256 + lane * 4) = b0 | (b1 << 8) | (b2 << 16) | (b3 << 24);
            }
            if (lane == 0) ((float*)(ws + (tb == 0 ? WS_SCU : WS_SCV)))[rr] = mx * (1.f / 127.f);
        }
    }
    for (size_t i = gtid; i < 128 * 32; i += gthreads) {
        const int pos = (int)(i / 32), f = (int)(i % 32);
        const float inv = powf(10000.f, -(float)f / 32.f); const float ang = (float)pos * inv;
        float* R = (float*)(ws + WS_ROPE); R[i * 2] = cosf(ang); R[i * 2 + 1] = sinf(ang);
    }
}

__device__ __forceinline__ void norm_row_store(const f32x4 (&v)[4], const float* g, const float* sh, const float* sc, bf16_t* orow, int lane) {
    float s = 0.f;
#pragma unroll
    for (int j = 0; j < 4; ++j) s += (v[j].x * v[j].x + v[j].y * v[j].y) + (v[j].z * v[j].z + v[j].w * v[j].w);
    const float rinv = rsqrtf(wave_sum(s) * (1.f / D) + EPS);
#pragma unroll
    for (int j = 0; j < 4; ++j) {
        const int c = j * 256 + lane * 4;
        const f32x4 gg = *(const f32x4*)(g + c), s1 = *(const f32x4*)(sh + c), s2 = *(const f32x4*)(sc + c);
        const float o0 = v[j].x * rinv * gg.x * (1.f + s2.x) + s1.x, o1 = v[j].y * rinv * gg.y * (1.f + s2.y) + s1.y;
        const float o2 = v[j].z * rinv * gg.z * (1.f + s2.z) + s1.z, o3 = v[j].w * rinv * gg.w * (1.f + s2.w) + s1.w;
        u32x2 w; w.x = pk2(o0, o1); w.y = pk2(o2, o3);
        *(u32x2*)(orow + c) = w;
    }
}
__device__ __forceinline__ void phase_norm(const Args& a, int layer, int src_mode, const float* gain, int which_sh, int which_sc, bool latent_only) {
    const int lane = threadIdx.x & 63, gw = blockIdx.x * NWAVE + (threadIdx.x >> 6), ngw = gridDim.x * NWAVE;
    bf16_t* H = (bf16_t*)(a.ws + WS_H);
    const float* X1 = (const float*)(a.ws + WS_X1);
    for (int g = gw; g < MTOT; g += ngw) {
        const int var = row_variant(g);
        if (latent_only && var == 2) continue;
        const float* xr = src_mode == 0 ? row_src(a, g) : X1 + (size_t)g * D;
        f32x4 v[4];
#pragma unroll
        for (int j = 0; j < 4; ++j) v[j] = *(const f32x4*)(xr + j * 256 + lane * 4);
        norm_row_store(v, gain, modv(a, layer, var, which_sh), modv(a, layer, var, which_sc), H + (size_t)g * D, lane);
    }
}

constexpr int CS_LD = 132;
__device__ __forceinline__ void gemm_tile128(const bf16_t* A, int lda, const bf16_t* Bt, int ldb, int K, float* Cs) {
    const int tid = threadIdx.x, lane = tid & 63, wid = tid >> 6, r = lane & 31, h = lane >> 5, wr = wid >> 1, wc = wid & 1;
    const bf16_t* ap = A + (size_t)(wr * 32 + r) * lda + 8 * h;
    const bf16_t* bp0 = Bt + (size_t)(wc * 64 + r) * ldb + 8 * h;
    const bf16_t* bp1 = bp0 + (size_t)32 * ldb;
    f32x16 acc0 = {}, acc1 = {};
#pragma unroll 4
    for (int k = 0; k < K; k += 16) {
        const bf16x8 av = *(const bf16x8*)(ap + k), b0 = *(const bf16x8*)(bp0 + k), b1 = *(const bf16x8*)(bp1 + k);
        acc0 = __builtin_amdgcn_mfma_f32_32x32x16_bf16(av, b0, acc0, 0, 0, 0);
        acc1 = __builtin_amdgcn_mfma_f32_32x32x16_bf16(av, b1, acc1, 0, 0, 0);
    }
#pragma unroll
    for (int i = 0; i < 16; ++i) {
        const int row = wr * 32 + (i & 3) + 8 * (i >> 2) + 4 * h;
        Cs[row * CS_LD + wc * 64 + r] = acc0[i];
        Cs[row * CS_LD + wc * 64 + 32 + r] = acc1[i];
    }
}

__device__ __forceinline__ void phase_inproj0(const Args& a, char* lds) {
    float* Cs = (float*)lds;
    const int tid = threadIdx.x;
    unsigned char* ws = a.ws;
    const bf16_t* H = (const bf16_t*)(ws + WS_H); const bf16_t* W = (const bf16_t*)(ws + WS_WIN0);
    const float* rope = (const float*)(ws + WS_ROPE);
    const int NU = (MTOT / 128) * 16;
    for (int u = blockIdx.x; u < NU; u += gridDim.x) {
        const int rt = u / 16, ct = u % 16, row0 = rt * 128, col0 = ct * 128;
        gemm_tile128(H + (size_t)row0 * D, D, W + (size_t)col0 * D, D, D, Cs);
        __syncthreads();
        const int rr = tid >> 2, q4 = tid & 3, g = row0 + rr;
        float* crow = Cs + rr * CS_LD + q4 * 32;
        if (ct < 4) {
            bf16_t* o = (bf16_t*)(ws + WS_U) + (size_t)g * 512 + col0 + q4 * 32;
#pragma unroll
            for (int c = 0; c < 32; c += 2) *(unsigned*)(o + c) = pk2(gelu_t(crow[c]), gelu_t(crow[c + 1]));
        } else if (ct < 8) {
            const int gg = ct - 4; float ss = 0.f;
#pragma unroll
            for (int c = 0; c < 32; ++c) { const float v = gelu_t(crow[c]); crow[c] = v; ss += v * v; }
            ss += __shfl_xor(ss, 1); ss += __shfl_xor(ss, 2);
            const float rinv = rsqrtf(ss * (1.f / 128.f) + EPS);
            const float* gn = a.in[9] + gg * 128 + q4 * 32;
            bf16_t* o = (bf16_t*)(ws + WS_VV) + (size_t)g * 512 + gg * 128 + q4 * 32;
#pragma unroll
            for (int c = 0; c < 32; c += 2) *(unsigned*)(o + c) = pk2(crow[c] * rinv * gn[c], crow[c + 1] * rinv * gn[c + 1]);
        } else if (ct < 14) {
            const bool isq = ct < 12; const int hh = isq ? ct - 8 : ct - 12;
            float ss = 0.f;
#pragma unroll
            for (int c = 0; c < 32; ++c) ss += crow[c] * crow[c];
            ss += __shfl_xor(ss, 1); ss += __shfl_xor(ss, 2);
            const float rinv = rsqrtf(ss * (1.f / 128.f) + EPS);
            const float* gn = a.in[isq ? 12 : 13];
            const int b = g / RPB, i = g - b * RPB; const bool lat = i >= CTXL; const int t = i - CTXL;
            bf16_t* o = (isq ? (bf16_t*)(ws + WS_Q) + (size_t)g * 512 : (bf16_t*)(ws + WS_K) + (size_t)g * 256) + hh * 128 + q4 * 32;
#pragma unroll
            for (int c8 = 0; c8 < 32; c8 += 8) {
                float y[8];
#pragma unroll
                for (int e = 0; e < 8; ++e) { const int j = q4 * 32 + c8 + e; y[e] = crow[c8 + e] * rinv * gn[sigma_head(j)]; }
                if (lat) {
                    const int grp = (q4 * 32 + c8) >> 3, ax = grp >> 3; const int pos = ax == 0 ? (t >> 6) : (t & 63);
#pragma unroll
                    for (int e = 0; e < 4; ++e) { const int f = (grp & 7) * 4 + e; const float cs = rope[(pos * 32 + f) * 2], sn = rope[(pos * 32 + f) * 2 + 1];
                        const float x1 = y[e], x2 = y[e + 4]; y[e] = x1 * cs - x2 * sn; y[e + 4] = x2 * cs + x1 * sn; }
                }
                u32x4 w; w.x = pk2(y[0], y[1]); w.y = pk2(y[2], y[3]); w.z = pk2(y[4], y[5]); w.w = pk2(y[6], y[7]);
                *(u32x4*)(o + c8) = w;
            }
        } else {
            bf16_t* o = (bf16_t*)(ws + WS_V) + (size_t)g * 256 + (ct - 14) * 128 + q4 * 32;
#pragma unroll
            for (int c = 0; c < 32; c += 2) *(unsigned*)(o + c) = pk2(crow[c], crow[c + 1]);
        }
        __syncthreads();
    }
}

__device__ __forceinline__ void phase_gmlp(const Args& a, char* lds) {
    const int tid = threadIdx.x;
    unsigned char* ws = a.ws;
    float* vt = (float*)lds;
    const bf16_t* VV = (const bf16_t*)(ws + WS_VV); const bf16_t* U = (const bf16_t*)(ws + WS_U); bf16_t* AO = (bf16_t*)(ws + WS_AO);
    const int NU = (MTOT / 128) * 4;
    for (int u = blockIdx.x; u < NU; u += gridDim.x) {
        const int ch = u / 4, g = u % 4, row0 = ch * 128;
        for (int i = tid; i < 128 * 128; i += NTHR) { const int q = i >> 7, c = i & 127; vt[i] = bf2f(VV[(size_t)(row0 + q) * 512 + g * 128 + c]); }
        __syncthreads();
        const int c = tid & 127, pq = tid >> 7;
        const float* wsg = a.in[10] + (size_t)g * 128 * 128;
        for (int pp = 0; pp < 32; ++pp) {
            const int p = pq * 32 + pp; float s = 0.f;
            for (int q = 0; q < 128; ++q) s += wsg[p * 128 + q] * vt[q * 128 + c];
            s += a.in[11][g * 128 + p];
            const float uu = bf2f(U[(size_t)(row0 + p) * 512 + g * 128 + c]);
            AO[(size_t)(row0 + p) * 1024 + g * 128 + c] = (bf16_t)f2bf(uu * s);
        }
        __syncthreads();
    }
}

__device__ __forceinline__ void phase_attn_naive(const Args& a, char* lds) {
    const int tid = threadIdx.x;
    unsigned char* ws = a.ws;
    float* Ks = (float*)lds;
    float* Vs = Ks + 32 * 128;
    float* part = Vs + 32 * 128;
    const bf16_t* Q = (const bf16_t*)(ws + WS_Q); const bf16_t* Kb = (const bf16_t*)(ws + WS_K); const bf16_t* Vb = (const bf16_t*)(ws + WS_V);
    bf16_t* AO = (bf16_t*)(ws + WS_AO);
    const int NU = 512 + 16;
    for (int u = blockIdx.x; u < NU; u += gridDim.x) {
        int b, h, qrow0, nkeys;
        if (u < 512) { b = u / 256; h = (u / 64) % 4; qrow0 = b * RPB + CTXL + (u % 64) * 128; nkeys = RPB; }
        else { const int v = u - 512; b = v / 8; h = (v / 2) % 4; qrow0 = b * RPB + (v % 2) * 128; nkeys = CTXL; }
        const int kvh = h >> 1, krow0 = b * RPB;
        const int qi = tid & 127, qt = tid >> 7;
        float q[32], o[32];
        {
            const bf16_t* qp = Q + (size_t)(qrow0 + qi) * 512 + h * 128 + qt * 32;
#pragma unroll
            for (int d = 0; d < 32; d += 2) { const unsigned w = *(const unsigned*)(qp + d); q[d] = bflo(w) * 0.08838834764831845f; q[d + 1] = bfhi(w) * 0.08838834764831845f; }
#pragma unroll
            for (int d = 0; d < 32; ++d) o[d] = 0.f;
        }
        float m = -1e30f, l = 0.f;
        for (int k0 = 0; k0 < nkeys; k0 += 32) {
            {
                const int key = tid >> 4, cs = (tid & 15) * 8;
                const u32x4 kw = *(const u32x4*)(Kb + (size_t)(krow0 + k0 + key) * 256 + kvh * 128 + cs);
                const u32x4 vw = *(const u32x4*)(Vb + (size_t)(krow0 + k0 + key) * 256 + kvh * 128 + cs);
                float* kd = Ks + key * 128 + cs; float* vd = Vs + key * 128 + cs;
                kd[0] = bflo(kw.x); kd[1] = bfhi(kw.x); kd[2] = bflo(kw.y); kd[3] = bfhi(kw.y); kd[4] = bflo(kw.z); kd[5] = bfhi(kw.z); kd[6] = bflo(kw.w); kd[7] = bfhi(kw.w);
                vd[0] = bflo(vw.x); vd[1] = bfhi(vw.x); vd[2] = bflo(vw.y); vd[3] = bfhi(vw.y); vd[4] = bflo(vw.z); vd[5] = bfhi(vw.z); vd[6] = bflo(vw.w); vd[7] = bfhi(vw.w);
            }
            __syncthreads();
#pragma unroll 2
            for (int j = 0; j < 32; ++j) {
                const float* kr = Ks + j * 128 + qt * 32; float acc = 0.f;
#pragma unroll
                for (int d = 0; d < 32; d += 4) { const f32x4 kv = *(const f32x4*)(kr + d); acc += q[d] * kv.x + q[d + 1] * kv.y + q[d + 2] * kv.z + q[d + 3] * kv.w; }
                part[(qt * 32 + j) * 128 + qi] = acc;
            }
            __syncthreads();
            float mx = m;
#pragma unroll 4
            for (int j = 0; j < 32; ++j) { const float sj = (part[(0 * 32 + j) * 128 + qi] + part[(1 * 32 + j) * 128 + qi]) + (part[(2 * 32 + j) * 128 + qi] + part[(3 * 32 + j) * 128 + qi]); mx = fmaxf(mx, sj); }
            const float alpha = __expf(m - mx); m = mx; float ps = 0.f;
#pragma unroll
            for (int d = 0; d < 32; ++d) o[d] *= alpha;
#pragma unroll 2
            for (int j = 0; j < 32; ++j) {
                const float sj = (part[(0 * 32 + j) * 128 + qi] + part[(1 * 32 + j) * 128 + qi]) + (part[(2 * 32 + j) * 128 + qi] + part[(3 * 32 + j) * 128 + qi]);
                const float pj = __expf(sj - mx); ps += pj;
                const float* vr = Vs + j * 128 + qt * 32;
#pragma unroll
                for (int d = 0; d < 32; d += 4) { const f32x4 vv = *(const f32x4*)(vr + d); o[d] += pj * vv.x; o[d + 1] += pj * vv.y; o[d + 2] += pj * vv.z; o[d + 3] += pj * vv.w; }
            }
            l = l * alpha + ps;
            __syncthreads();
        }
        const float rl = 1.f / l;
        bf16_t* op = AO + (size_t)(qrow0 + qi) * 1024 + 512 + h * 128 + qt * 32;
#pragma unroll
        for (int d = 0; d < 32; d += 2) *(unsigned*)(op + d) = pk2(o[d] * rl, o[d + 1] * rl);
    }
}

namespace fa {
typedef short s16x4 __attribute__((ext_vector_type(4)));
constexpr int QBLK = 32, KVBLK = 64, LDQ = 512, LDK = 256, LDO = 1024;
constexpr float SCALE = 0.088388347648318440f, THR = 8.f;
constexpr size_t SHM_V = KVBLK * 128 * 2, SHM_K = KVBLK * 128 * 2, SHM_ATTN = 2 * SHM_V + 2 * SHM_K + NWAVE * 64 * 4;
#define KSWZ(row, colB) ((row) * 256 + ((colB) ^ (((row) & 7) << 4)))
#define SBAR() __builtin_amdgcn_sched_barrier(0)
__device__ __forceinline__ int crow(int r, int hi) { return (r & 3) + 8 * (r >> 2) + 4 * hi; }
__device__ __forceinline__ unsigned cvtpk(float lo, float hi) { unsigned r; asm volatile("v_cvt_pk_bf16_f32 %0, %1, %2" : "=v"(r) : "v"(lo), "v"(hi)); return r; }
__device__ __forceinline__ void partialSM(f32x16& p0, f32x16& p1, float& m_reg, float& mn, float& alpha) {
  constexpr float C = SCALE * 1.4426950408889634f;
  float pmax = p0[0]; for (int r = 1; r < 16; ++r) pmax = fmaxf(pmax, p0[r]); for (int r = 0; r < 16; ++r) pmax = fmaxf(pmax, p1[r]);
  { auto rr = __builtin_amdgcn_permlane32_swap(__float_as_uint(pmax), __float_as_uint(pmax), false, false);
    pmax = fmaxf(__uint_as_float(rr[0]), __uint_as_float(rr[1])); }
  if (__builtin_expect(__all(pmax - m_reg <= THR / SCALE), 1)) { mn = m_reg; alpha = 1.f; }
  else { mn = fmaxf(m_reg, pmax); alpha = __builtin_amdgcn_exp2f((m_reg - mn) * C); m_reg = mn; }
  float mnC = -mn * C;
  for (int r = 0; r < 16; ++r) p0[r] = fmaf(p0[r], C, mnC); for (int r = 0; r < 16; ++r) p1[r] = fmaf(p1[r], C, mnC);
  for (int r = 0; r < 16; ++r) p0[r] = __builtin_amdgcn_exp2f(p0[r]);
}
__device__ __forceinline__ void finishSM(f32x16& p0, f32x16& p1, float alpha, float& l_reg, bf16x8& pa0, bf16x8& pa1, bf16x8& pa2, bf16x8& pa3) {
  for (int r = 0; r < 16; ++r) p1[r] = __builtin_amdgcn_exp2f(p1[r]);
  float ps = 0; for (int r = 0; r < 16; ++r) ps += p0[r]; for (int r = 0; r < 16; ++r) ps += p1[r];
  { auto rr = __builtin_amdgcn_permlane32_swap(__float_as_uint(ps), __float_as_uint(ps), false, false);
    ps = __uint_as_float(rr[0]) + __uint_as_float(rr[1]); }
  l_reg = l_reg * alpha + ps;
#define PK4(P, BASE, OUT) do { unsigned a0 = cvtpk(P[BASE + 0], P[BASE + 1]), a1 = cvtpk(P[BASE + 2], P[BASE + 3]);   \
    unsigned b0 = cvtpk(P[BASE + 4], P[BASE + 5]), b1 = cvtpk(P[BASE + 6], P[BASE + 7]);                              \
    auto r0 = __builtin_amdgcn_permlane32_swap(a0, b0, false, false); auto r1 = __builtin_amdgcn_permlane32_swap(a1, b1, false, false); \
    u32x4 w = {r0[0], r1[0], r0[1], r1[1]}; OUT = *reinterpret_cast<bf16x8*>(&w); } while (0)
  PK4(p0, 0, pa0); PK4(p0, 8, pa1); PK4(p1, 0, pa2); PK4(p1, 8, pa3);
#undef PK4
}
__device__ __forceinline__ void qkt(f32x16& p0, f32x16& p1, const bf16_t* Ks, const bf16x8* qr, int r32, int hi) {
  p0 = f32x16{}; p1 = f32x16{};
  for (int d0 = 0; d0 < 8; ++d0) { int cb = (d0 * 16 + hi * 8) * 2;
    bf16x8 b0 = *reinterpret_cast<const bf16x8*>((const char*)Ks + KSWZ(r32, cb));
    bf16x8 b1 = *reinterpret_cast<const bf16x8*>((const char*)Ks + KSWZ(32 + r32, cb));
    p0 = __builtin_amdgcn_mfma_f32_32x32x16_bf16(b0, qr[d0], p0, 0, 0, 0);
    p1 = __builtin_amdgcn_mfma_f32_32x32x16_bf16(b1, qr[d0], p1, 0, 0, 0); }
}
__device__ __forceinline__ int v_st(int k, int c) { const int kk = (k & ~0xC) | ((k & 4) << 1) | ((k & 8) >> 1); return ((kk >> 3) * 4 + (c >> 5)) * 512 + ((kk & 7) * 32 + (c & 31)) * 2; }
__device__ __forceinline__ int v_rd_base(int lane) { return ((lane & 3) << 3) | (((lane >> 2) & 3) << 6) | (((lane >> 4) & 1) << 5) | (((lane >> 5) & 1) << 8); }
constexpr int v_rd_off(int d0, int ks, int half) { return d0 * 512 + ks * 4096 + half * 2048; }
template <int OFF> __device__ __forceinline__ s16x4 tr_read(int vb) {
  s16x4 r; asm volatile("ds_read_b64_tr_b16 %0, %1 offset:%2" : "=&v"(r) : "v"(vb), "i"(OFF) : "memory"); return r;
}
template <int D0> __device__ __forceinline__ void pv_one(f32x16& od, int vb, bf16x8 pa0, bf16x8 pa1, bf16x8 pa2, bf16x8 pa3) {
  const s16x4 l0 = tr_read<v_rd_off(D0, 0, 0)>(vb), h0 = tr_read<v_rd_off(D0, 0, 1)>(vb), l1 = tr_read<v_rd_off(D0, 1, 0)>(vb), h1 = tr_read<v_rd_off(D0, 1, 1)>(vb);
  const s16x4 l2 = tr_read<v_rd_off(D0, 2, 0)>(vb), h2 = tr_read<v_rd_off(D0, 2, 1)>(vb), l3 = tr_read<v_rd_off(D0, 3, 0)>(vb), h3 = tr_read<v_rd_off(D0, 3, 1)>(vb);
  asm volatile("s_waitcnt lgkmcnt(0)" ::: "memory"); SBAR();
#define PK(L, H) (bf16x8){L[0], L[1], L[2], L[3], H[0], H[1], H[2], H[3]}
  od = __builtin_amdgcn_mfma_f32_32x32x16_bf16(pa0, PK(l0, h0), od, 0, 0, 0);
  od = __builtin_amdgcn_mfma_f32_32x32x16_bf16(pa1, PK(l1, h1), od, 0, 0, 0);
  od = __builtin_amdgcn_mfma_f32_32x32x16_bf16(pa2, PK(l2, h2), od, 0, 0, 0);
  od = __builtin_amdgcn_mfma_f32_32x32x16_bf16(pa3, PK(l3, h3), od, 0, 0, 0);
#undef PK
}
__device__ __forceinline__ void pv_d0(f32x16* o, int vb, bf16x8 pa0, bf16x8 pa1, bf16x8 pa2, bf16x8 pa3) {
  pv_one<0>(o[0], vb, pa0, pa1, pa2, pa3); pv_one<1>(o[1], vb, pa0, pa1, pa2, pa3); pv_one<2>(o[2], vb, pa0, pa1, pa2, pa3); pv_one<3>(o[3], vb, pa0, pa1, pa2, pa3);
}
__device__ __forceinline__ void attn_dense_body(const bf16_t* __restrict__ Qb, const bf16_t* __restrict__ Kh, const bf16_t* __restrict__ Vh,
                                                bf16_t* __restrict__ Ob, int seq, char* lds) {
  const int tid = threadIdx.x, wid = tid >> 6, lane = tid & 63, r32 = lane & 31, hi = lane >> 5;
  bf16_t* V_lds = (bf16_t*)lds; bf16_t* K_lds = (bf16_t*)(lds + 2 * SHM_V);
  float* ws = (float*)(lds + 2 * SHM_V + 2 * SHM_K) + wid * 64; float* li_l = ws; float* al_l = ws + 32;
  float m_reg = -1e30f, l_reg = 0; f32x16 o[4] = {}; bf16x8 qr[8];
  const bf16_t* Qw = Qb + (long)(wid * QBLK + r32) * LDQ + hi * 8;
#pragma unroll
  for (int d0 = 0; d0 < 8; ++d0) qr[d0] = *reinterpret_cast<const bf16x8*>(Qw + d0 * 16);
  const int sr = tid >> 4, sc = (tid & 15) * 8, vst0 = v_st(sr, sc), vst1 = v_st(32 + sr, sc);
  const int vb0 = (int)(uintptr_t)V_lds + v_rd_base(lane);
  struct { bf16x8 vs0, vs1, ks0, ks1; } sr_[2];
#define SLOAD(i, k0) do { sr_[i].vs0 = *reinterpret_cast<const bf16x8*>(&Vh[(long)((k0) + sr) * LDK + sc]); sr_[i].vs1 = *reinterpret_cast<const bf16x8*>(&Vh[(long)((k0) + 32 + sr) * LDK + sc]); \
    sr_[i].ks0 = *reinterpret_cast<const bf16x8*>(&Kh[(long)((k0) + sr) * LDK + sc]); sr_[i].ks1 = *reinterpret_cast<const bf16x8*>(&Kh[(long)((k0) + 32 + sr) * LDK + sc]); } while (0)
#define SWRITE(b, i) do { *(bf16x8*)((char*)V_lds + (b) * SHM_V + vst0) = sr_[i].vs0;          \
    *(bf16x8*)((char*)V_lds + (b) * SHM_V + vst1) = sr_[i].vs1; int kc = sc * 2;               \
    *(bf16x8*)((char*)K_lds + (b) * SHM_K + KSWZ(sr, kc)) = sr_[i].ks0;                       \
    *(bf16x8*)((char*)K_lds + (b) * SHM_K + KSWZ(32 + sr, kc)) = sr_[i].ks1; } while (0)
#define SWAIT() asm volatile("s_waitcnt vmcnt(4)" ::: "memory")
#define RESC(a) do { if (__any((a) < 1.f)) { if (hi == 0) al_l[r32] = (a); asm volatile("s_waitcnt lgkmcnt(0)" ::: "memory"); \
    for (int d = 0; d < 4; ++d) for (int r = 0; r < 16; ++r) o[d][r] *= al_l[crow(r, hi)]; } } while (0)
  f32x16 pA0, pA1, pB0, pB1; float mnA, mnB, alA, alB; bf16x8 pa0, pa1, pa2, pa3; const int NT = seq / KVBLK;
  constexpr int SE = 0, SO = 1;
  SLOAD(SE, 0); asm volatile("s_waitcnt vmcnt(0)" ::: "memory"); SWRITE(0, SE); __syncthreads();
  qkt(pA0, pA1, K_lds, qr, r32, hi); partialSM(pA0, pA1, m_reg, mnA, alA);
  SLOAD(SO, KVBLK); if (2 < NT) SLOAD(SE, 2 * KVBLK);
  SWAIT(); SWRITE(1, SO); __syncthreads();
  for (int j = 1; j + 1 < NT; j += 2) {
    SBAR(); qkt(pB0, pB1, (bf16_t*)((char*)K_lds + SHM_K), qr, r32, hi);
    finishSM(pA0, pA1, alA, l_reg, pa0, pa1, pa2, pa3); SBAR();
    SLOAD(SO, (j + 2) * KVBLK); SBAR();
    pv_d0(o, vb0, pa0, pa1, pa2, pa3); partialSM(pB0, pB1, m_reg, mnB, alB);
    __syncthreads(); SWAIT(); SWRITE(0, SE);
    RESC(alB); __syncthreads();
    SBAR(); qkt(pA0, pA1, K_lds, qr, r32, hi);
    finishSM(pB0, pB1, alB, l_reg, pa0, pa1, pa2, pa3); SBAR();
    if (j + 3 < NT) SLOAD(SE, (j + 3) * KVBLK); SBAR();
    pv_d0(o, vb0 + (int)SHM_V, pa0, pa1, pa2, pa3); partialSM(pA0, pA1, m_reg, mnA, alA);
    __syncthreads(); SWAIT(); SWRITE(1, SO);
    RESC(alA); __syncthreads();
  }
  SBAR(); qkt(pB0, pB1, (bf16_t*)((char*)K_lds + SHM_K), qr, r32, hi);
  finishSM(pA0, pA1, alA, l_reg, pa0, pa1, pa2, pa3); SBAR();
  pv_d0(o, vb0, pa0, pa1, pa2, pa3); partialSM(pB0, pB1, m_reg, mnB, alB);
  __syncthreads(); RESC(alB);
  finishSM(pB0, pB1, alB, l_reg, pa0, pa1, pa2, pa3); SBAR();
  pv_d0(o, vb0 + (int)SHM_V, pa0, pa1, pa2, pa3);
  if (hi == 0) li_l[r32] = l_reg; asm volatile("s_waitcnt lgkmcnt(0)" ::: "memory");
  float rli[16];
#pragma unroll
  for (int r = 0; r < 16; ++r) rli[r] = __builtin_amdgcn_rcpf(li_l[crow(r, hi)]);
  bf16_t* Ow = Ob + (long)(wid * QBLK) * LDO;
#pragma unroll
  for (int r = 0; r < 16; ++r) { int orow = crow(r, hi);
    for (int d0 = 0; d0 < 4; ++d0) Ow[(long)orow * LDO + d0 * 32 + r32] = (bf16_t)f2bf(o[d0][r] * rli[r]); }
  __syncthreads();
#undef SLOAD
#undef SWRITE
#undef SWAIT
#undef RESC
}
#undef KSWZ
#undef SBAR
}

__device__ __forceinline__ void phase_attn(const Args& a, char* lds) {
    unsigned char* ws = a.ws;
    const bf16_t* Q = (const bf16_t*)(ws + WS_Q); const bf16_t* Kb = (const bf16_t*)(ws + WS_K); const bf16_t* Vb = (const bf16_t*)(ws + WS_V);
    bf16_t* AO = (bf16_t*)(ws + WS_AO);
    const int NU = 256 + 8;
    for (int u = blockIdx.x; u < NU; u += gridDim.x) {
        int b, h, qrow0, nkeys;
        if (u < 256) { b = u / 128; h = (u / 32) % 4; qrow0 = b * RPB + CTXL + (u % 32) * 256; nkeys = RPB; }
        else { const int v = u - 256; b = v / 4; h = v % 4; qrow0 = b * RPB; nkeys = CTXL; }
        const int kvh = h >> 1; const size_t krow0 = (size_t)b * RPB;
        fa::attn_dense_body(Q + (size_t)qrow0 * 512 + h * 128, Kb + krow0 * 256 + kvh * 128, Vb + krow0 * 256 + kvh * 128, AO + (size_t)qrow0 * 1024 + 512 + h * 128, nkeys, lds);
    }
}

__device__ __forceinline__ void phase_outproj(const Args& a, char* lds, const bf16_t* A, int K, const bf16_t* Bt, int layer, int which_gate, int base_mode, bool latent_only) {
    float* Cs = (float*)lds;
    const int tid = threadIdx.x;
    float* X1 = (float*)(a.ws + WS_X1);
    const int NU = (MTOT / 128) * 8;
    for (int u = blockIdx.x; u < NU; u += gridDim.x) {
        const int rt = u / 8, ct = u % 8, row0 = rt * 128, col0 = ct * 128;
        if (latent_only && (rt % 66) < 2) continue;
        gemm_tile128(A + (size_t)row0 * K, K, Bt + (size_t)col0 * K, K, K, Cs);
        __syncthreads();
        const int rr = tid >> 2, q4 = tid & 3, g = row0 + rr;
        const float* crow = Cs + rr * CS_LD + q4 * 32;
        const float* gt = modv(a, layer, row_variant(g), which_gate) + col0 + q4 * 32;
        const float* base = (base_mode == 0 ? row_src(a, g) : X1 + (size_t)g * D) + col0 + q4 * 32;
        float* o = X1 + (size_t)g * D + col0 + q4 * 32;
#pragma unroll
        for (int c = 0; c < 32; c += 4) {
            const f32x4 bs = *(const f32x4*)(base + c), gv = *(const f32x4*)(gt + c);
            f32x4 r; r.x = bs.x + gv.x * crow[c]; r.y = bs.y + gv.y * crow[c + 1]; r.z = bs.z + gv.z * crow[c + 2]; r.w = bs.w + gv.w * crow[c + 3];
            *(f32x4*)(o + c) = r;
        }
        __syncthreads();
    }
}

__device__ __forceinline__ void phase_peerq(const Args& a, char* lds, int layer, bool latent_only) {
    float* Cs = (float*)lds;
    const int tid = threadIdx.x;
    const bf16_t* H = (const bf16_t*)(a.ws + WS_H); const bf16_t* W = (const bf16_t*)(a.ws + WS_WQ) + (size_t)layer * 2048 * 1024;
    bf16_t* QP = (bf16_t*)(a.ws + WS_QP);
    const int NU = (MTOT / 128) * 16;
    for (int u = blockIdx.x; u < NU; u += gridDim.x) {
        const int rt = u / 16, ct = u % 16, row0 = rt * 128, col0 = ct * 128;
        if (latent_only && (rt % 66) < 2) continue;
        gemm_tile128(H + (size_t)row0 * D, D, W + (size_t)col0 * D, D, D, Cs);
        __syncthreads();
        const int rr = tid >> 2, q4 = tid & 3, g = row0 + rr;
        const float* crow = Cs + rr * CS_LD + q4 * 32;
        bf16_t* o = QP + (size_t)g * 2048 + col0 + q4 * 32;
#pragma unroll
        for (int c = 0; c < 32; c += 2) *(unsigned*)(o + c) = pk2(crow[c], crow[c + 1]);
        __syncthreads();
    }
}

__device__ __forceinline__ void wave_argmax(float& v, int& i) {
#pragma unroll
    for (int o = 1; o < 64; o <<= 1) {
        const float ov = __shfl_xor(v, o); const int oi = __shfl_xor(i, o);
        if (ov > v || (ov == v && oi < i)) { v = ov; i = oi; }
    }
}
__device__ __forceinline__ void phase_peer_topk(const Args& a, int layer, bool latent_only) {
    const int lane = threadIdx.x & 63, gw = blockIdx.x * NWAVE + (threadIdx.x >> 6), ngw = gridDim.x * NWAVE;
    const bf16_t* QP = (const bf16_t*)(a.ws + WS_QP);
    const bf16_t* KEYS = (const bf16_t*)(a.ws + WS_KEYS) + (size_t)layer * 8 * 2 * 128 * 128;
    int* SELI = (int*)(a.ws + WS_SELI); float* SELG = (float*)(a.ws + WS_SELG);
    for (int it = gw; it < MTOT * 8; it += ngw) {
        const int g = it >> 3, h = it & 7;
        if (latent_only && row_variant(g) == 2) continue;
        float tv[2]; int ti[2];
#pragma unroll
        for (int s = 0; s < 2; ++s) {
            const bf16_t* qp = QP + (size_t)g * 2048 + h * 256 + s * 128;
            const bf16_t* k0p = KEYS + ((size_t)(h * 2 + s) * 128 + lane) * 128;
            const bf16_t* k1p = k0p + 64 * 128;
            float s0 = 0.f, s1 = 0.f;
#pragma unroll 4
            for (int d = 0; d < 128; d += 8) {
                const u32x4 qw = *(const u32x4*)(qp + d), ka = *(const u32x4*)(k0p + d), kb = *(const u32x4*)(k1p + d);
                s0 += bflo(qw.x) * bflo(ka.x) + bfhi(qw.x) * bfhi(ka.x) + bflo(qw.y) * bflo(ka.y) + bfhi(qw.y) * bfhi(ka.y)
                    + bflo(qw.z) * bflo(ka.z) + bfhi(qw.z) * bfhi(ka.z) + bflo(qw.w) * bflo(ka.w) + bfhi(qw.w) * bfhi(ka.w);
                s1 += bflo(qw.x) * bflo(kb.x) + bfhi(qw.x) * bfhi(kb.x) + bflo(qw.y) * bflo(kb.y) + bfhi(qw.y) * bfhi(kb.y)
                    + bflo(qw.z) * bflo(kb.z) + bfhi(qw.z) * bfhi(kb.z) + bflo(qw.w) * bflo(kb.w) + bfhi(qw.w) * bfhi(kb.w);
            }
            float myv = 0.f; int myi = 0;
            for (int r = 0; r < 16; ++r) {
                float bv; int bi;
                if (s0 >= s1) { bv = s0; bi = lane; } else { bv = s1; bi = lane + 64; }
                wave_argmax(bv, bi);
                if (bi == lane) s0 = -INFINITY; else if (bi == lane + 64) s1 = -INFINITY;
                if (lane == r) { myv = bv; myi = bi; }
            }
            tv[s] = myv; ti[s] = myi;
        }
        float cv[4]; int ci[4];
        {
            const float v0 = __shfl(tv[0], lane >> 2); const int i0 = __shfl(ti[0], lane >> 2);
#pragma unroll
            for (int m = 0; m < 4; ++m) { const int j = (lane & 3) * 4 + m; cv[m] = v0 + __shfl(tv[1], j); ci[m] = i0 * 128 + __shfl(ti[1], j); }
        }
        float topv = 0.f; int tope = 0;
        for (int r = 0; r < 16; ++r) {
            float bv = cv[0]; int bp = lane * 4;
#pragma unroll
            for (int m = 1; m < 4; ++m) if (cv[m] > bv) { bv = cv[m]; bp = lane * 4 + m; }
            wave_argmax(bv, bp);
            int be = 0;
#pragma unroll
            for (int m = 0; m < 4; ++m) if (bp == lane * 4 + m) { be = ci[m]; cv[m] = -INFINITY; }
            be = __shfl(be, bp >> 2);
            if (lane == r) { topv = bv; tope = be; }
        }
        const float mx = __shfl(topv, 0);
        float e = lane < 16 ? __expf(topv - mx) : 0.f;
        float sum = e;
#pragma unroll
        for (int o = 1; o < 16; o <<= 1) sum += __shfl_xor(sum, o);
        if (lane < 16) { SELI[(size_t)g * 128 + h * 16 + lane] = tope; SELG[(size_t)g * 128 + h * 16 + lane] = e / sum; }
    }
}

namespace tk {
__device__ __forceinline__ void ce(float& a, float& b) { const float mx = __builtin_fmaxf(a, b), mn = __builtin_fminf(a, b); a = mx; b = mn; }
__device__ __forceinline__ void sort16_desc(float (&v)[16]) {
#pragma unroll
    for (int ks = 1; ks <= 4; ++ks)
#pragma unroll
        for (int js = ks - 1; js >= 0; --js)
#pragma unroll
            for (int i = 0; i < 16; ++i) { const int k = 1 << ks, j = 1 << js, l = i ^ j; if (l > i) { if ((i & k) == 0) ce(v[i], v[l]); else ce(v[l], v[i]); } }
}
__device__ __forceinline__ void merge16_desc(float (&v)[16]) {
#pragma unroll
    for (int js = 3; js >= 0; --js)
#pragma unroll
        for (int i = 0; i < 16; ++i) { const int j = 1 << js, l = i ^ j; if (l > i) ce(v[i], v[l]); }
}
__device__ __forceinline__ void merge_prune(float (&x)[16], const float (&y)[16]) {
#pragma unroll
    for (int i = 0; i < 16; ++i) x[i] = __builtin_fmaxf(x[i], y[15 - i]);
    merge16_desc(x);
}
__host__ __device__ constexpr bool pair_ok(int i, int j) { return (i + 1) * (j + 1) <= 16; }
__host__ __device__ constexpr int pair_index(int i, int j) { int n = 0; for (int a = 0; a < 16; ++a) for (int b = 0; b < 16; ++b) { if (a == i && b == j) return n; if (pair_ok(a, b)) ++n; } return n; }
static_assert(pair_index(15, 15) == 49 + 0 || true, "");
}
__device__ __forceinline__ void phase_peer_topk2(const Args& a, int layer, bool latent_only) {
    const int lane = threadIdx.x & 63, r32 = lane & 31, hh = lane >> 5, gw = blockIdx.x * NWAVE + __builtin_amdgcn_readfirstlane(threadIdx.x >> 6), ngw = gridDim.x * NWAVE;
    const bf16_t* QP = (const bf16_t*)(a.ws + WS_QP);
    const bf16_t* KEYS = (const bf16_t*)(a.ws + WS_KEYS) + (size_t)layer * 8 * 2 * 128 * 128;
    int* SELI = (int*)(a.ws + WS_SELI); float* SELG = (float*)(a.ws + WS_SELG);
    const int NIT = (MTOT / 32) * 8;
    for (int it = gw; it < NIT; it += ngw) {
        const int tg = it >> 3, h = it & 7, g0 = tg * 32;
        if (latent_only && row_variant(g0) == 2) continue;
        float top[2][16];
#pragma unroll
        for (int s = 0; s < 2; ++s) {
            bf16x8 qf[8];
            unsigned qoff = (unsigned)(r32 * 2048 + 8 * hh), koff = (unsigned)(r32 * 128 + 8 * hh); asm volatile("" : "+v"(qoff), "+v"(koff));
            const bf16_t* qb = QP + (size_t)g0 * 2048 + h * 256 + s * 128;
#pragma unroll
            for (int k = 0; k < 8; ++k) qf[k] = *(const bf16x8*)(qb + qoff + k * 16);
            float grp[4][16];
#pragma unroll
            for (int kb = 0; kb < 4; ++kb) {
                const bf16_t* kbp = KEYS + (size_t)(h * 2 + s) * 128 * 128 + kb * 32 * 128;
                f32x16 acc = {};
#pragma unroll
                for (int k = 0; k < 8; ++k) { const bf16x8 kf = *(const bf16x8*)(kbp + koff + k * 16); acc = __builtin_amdgcn_mfma_f32_32x32x16_bf16(kf, qf[k], acc, 0, 0, 0); }
#pragma unroll
                for (int r = 0; r < 16; ++r) { const int key = kb * 32 + (r & 3) + 8 * (r >> 2) + 4 * hh; grp[kb][r] = __uint_as_float((__float_as_uint(acc[r]) & ~127u) | (unsigned)key); }
                tk::sort16_desc(grp[kb]); __builtin_amdgcn_sched_barrier(0);
            }
            tk::merge_prune(grp[0], grp[1]); __builtin_amdgcn_sched_barrier(0); tk::merge_prune(grp[2], grp[3]); __builtin_amdgcn_sched_barrier(0); tk::merge_prune(grp[0], grp[2]); __builtin_amdgcn_sched_barrier(0);
            float oth[16];
#pragma unroll
            for (int r = 0; r < 16; ++r) { const auto rr = __builtin_amdgcn_permlane32_swap(__float_as_uint(grp[0][r]), __float_as_uint(grp[0][r]), false, false); oth[r] = __uint_as_float(hh == 0 ? rr[1] : rr[0]); }
            tk::merge_prune(grp[0], oth);
#pragma unroll
            for (int r = 0; r < 16; ++r) top[s][r] = grp[0][r];
            __builtin_amdgcn_sched_barrier(0);
        }
        float cg[4][16];
#pragma unroll
        for (int q = 0; q < 4; ++q)
#pragma unroll
            for (int r = 0; r < 16; ++r) cg[q][r] = -INFINITY;
        cg[0][0] = __uint_as_float((__float_as_uint(top[0][0] + top[1][0]) & ~255u) | 0u);
        cg[0][1] = __uint_as_float((__float_as_uint(top[0][0] + top[1][1]) & ~255u) | 1u);
        cg[0][2] = __uint_as_float((__float_as_uint(top[0][0] + top[1][2]) & ~255u) | 2u);
        cg[0][3] = __uint_as_float((__float_as_uint(top[0][0] + top[1][3]) & ~255u) | 3u);
        cg[0][4] = __uint_as_float((__float_as_uint(top[0][0] + top[1][4]) & ~255u) | 4u);
        cg[0][5] = __uint_as_float((__float_as_uint(top[0][0] + top[1][5]) & ~255u) | 5u);
        cg[0][6] = __uint_as_float((__float_as_uint(top[0][0] + top[1][6]) & ~255u) | 6u);
        cg[0][7] = __uint_as_float((__float_as_uint(top[0][0] + top[1][7]) & ~255u) | 7u);
        cg[0][8] = __uint_as_float((__float_as_uint(top[0][0] + top[1][8]) & ~255u) | 8u);
        cg[0][9] = __uint_as_float((__float_as_uint(top[0][0] + top[1][9]) & ~255u) | 9u);
        cg[0][10] = __uint_as_float((__float_as_uint(top[0][0] + top[1][10]) & ~255u) | 10u);
        cg[0][11] = __uint_as_float((__float_as_uint(top[0][0] + top[1][11]) & ~255u) | 11u);
        cg[0][12] = __uint_as_float((__float_as_uint(top[0][0] + top[1][12]) & ~255u) | 12u);
        cg[0][13] = __uint_as_float((__float_as_uint(top[0][0] + top[1][13]) & ~255u) | 13u);
        cg[0][14] = __uint_as_float((__float_as_uint(top[0][0] + top[1][14]) & ~255u) | 14u);
        cg[0][15] = __uint_as_float((__float_as_uint(top[0][0] + top[1][15]) & ~255u) | 15u);
        cg[1][0] = __uint_as_float((__float_as_uint(top[0][1] + top[1][0]) & ~255u) | 16u);
        cg[1][1] = __uint_as_float((__float_as_uint(top[0][1] + top[1][1]) & ~255u) | 17u);
        cg[1][2] = __uint_as_float((__float_as_uint(top[0][1] + top[1][2]) & ~255u) | 18u);
        cg[1][3] = __uint_as_float((__float_as_uint(top[0][1] + top[1][3]) & ~255u) | 19u);
        cg[1][4] = __uint_as_float((__float_as_uint(top[0][1] + top[1][4]) & ~255u) | 20u);
        cg[1][5] = __uint_as_float((__float_as_uint(top[0][1] + top[1][5]) & ~255u) | 21u);
        cg[1][6] = __uint_as_float((__float_as_uint(top[0][1] + top[1][6]) & ~255u) | 22u);
        cg[1][7] = __uint_as_float((__float_as_uint(top[0][1] + top[1][7]) & ~255u) | 23u);
        cg[1][8] = __uint_as_float((__float_as_uint(top[0][2] + top[1][0]) & ~255u) | 32u);
        cg[1][9] = __uint_as_float((__float_as_uint(top[0][2] + top[1][1]) & ~255u) | 33u);
        cg[1][10] = __uint_as_float((__float_as_uint(top[0][2] + top[1][2]) & ~255u) | 34u);
        cg[1][11] = __uint_as_float((__float_as_uint(top[0][2] + top[1][3]) & ~255u) | 35u);
        cg[1][12] = __uint_as_float((__float_as_uint(top[0][2] + top[1][4]) & ~255u) | 36u);
        cg[1][13] = __uint_as_float((__float_as_uint(top[0][3] + top[1][0]) & ~255u) | 48u);
        cg[1][14] = __uint_as_float((__float_as_uint(top[0][3] + top[1][1]) & ~255u) | 49u);
        cg[1][15] = __uint_as_float((__float_as_uint(top[0][3] + top[1][2]) & ~255u) | 50u);
        cg[2][0] = __uint_as_float((__float_as_uint(top[0][3] + top[1][3]) & ~255u) | 51u);
        cg[2][1] = __uint_as_float((__float_as_uint(top[0][4] + top[1][0]) & ~255u) | 64u);
        cg[2][2] = __uint_as_float((__float_as_uint(top[0][4] + top[1][1]) & ~255u) | 65u);
        cg[2][3] = __uint_as_float((__float_as_uint(top[0][4] + top[1][2]) & ~255u) | 66u);
        cg[2][4] = __uint_as_float((__float_as_uint(top[0][5] + top[1][0]) & ~255u) | 80u);
        cg[2][5] = __uint_as_float((__float_as_uint(top[0][5] + top[1][1]) & ~255u) | 81u);
        cg[2][6] = __uint_as_float((__float_as_uint(top[0][6] + top[1][0]) & ~255u) | 96u);
        cg[2][7] = __uint_as_float((__float_as_uint(top[0][6] + top[1][1]) & ~255u) | 97u);
        cg[2][8] = __uint_as_float((__float_as_uint(top[0][7] + top[1][0]) & ~255u) | 112u);
        cg[2][9] = __uint_as_float((__float_as_uint(top[0][7] + top[1][1]) & ~255u) | 113u);
        cg[2][10] = __uint_as_float((__float_as_uint(top[0][8] + top[1][0]) & ~255u) | 128u);
        cg[2][11] = __uint_as_float((__float_as_uint(top[0][9] + top[1][0]) & ~255u) | 144u);
        cg[2][12] = __uint_as_float((__float_as_uint(top[0][10] + top[1][0]) & ~255u) | 160u);
        cg[2][13] = __uint_as_float((__float_as_uint(top[0][11] + top[1][0]) & ~255u) | 176u);
        cg[2][14] = __uint_as_float((__float_as_uint(top[0][12] + top[1][0]) & ~255u) | 192u);
        cg[2][15] = __uint_as_float((__float_as_uint(top[0][13] + top[1][0]) & ~255u) | 208u);
        cg[3][0] = __uint_as_float((__float_as_uint(top[0][14] + top[1][0]) & ~255u) | 224u);
        cg[3][1] = __uint_as_float((__float_as_uint(top[0][15] + top[1][0]) & ~255u) | 240u);
#pragma unroll
        for (int q = 0; q < 4; ++q) { tk::sort16_desc(cg[q]); __builtin_amdgcn_sched_barrier(0); }
        tk::merge_prune(cg[0], cg[1]); __builtin_amdgcn_sched_barrier(0); tk::merge_prune(cg[2], cg[3]); __builtin_amdgcn_sched_barrier(0); tk::merge_prune(cg[0], cg[2]); __builtin_amdgcn_sched_barrier(0);
        int eidx[16]; float ev[16]; float sum = 0.f;
#pragma unroll
        for (int r = 0; r < 16; ++r) {
            const unsigned bits = __float_as_uint(cg[0][r]); const int ci = (bits >> 4) & 15, cj = bits & 15;
            int ia = 0, ib = 0;
#pragma unroll
            for (int i = 0; i < 16; ++i) { ia = (ci == i) ? (int)(__float_as_uint(top[0][i]) & 127u) : ia; ib = (cj == i) ? (int)(__float_as_uint(top[1][i]) & 127u) : ib; }
            eidx[r] = ia * 128 + ib;
            ev[r] = __expf(cg[0][r] - cg[0][0]); sum += ev[r];
        }
        const float rs = 1.f / sum;
        int* oi = SELI + (size_t)(g0 + r32) * 128 + h * 16 + hh * 8; float* og = SELG + (size_t)(g0 + r32) * 128 + h * 16 + hh * 8;
        if (hh == 0) {
#pragma unroll
            for (int r = 0; r < 8; ++r) { oi[r] = eidx[r]; og[r] = ev[r] * rs; }
        } else {
#pragma unroll
            for (int r = 0; r < 8; ++r) { oi[r] = eidx[8 + r]; og[r] = ev[8 + r] * rs; }
        }
    }
}

__device__ __forceinline__ void phase_peer_gather(const Args& a, int layer, int mode) {
    const int lane = threadIdx.x & 63, gw = blockIdx.x * NWAVE + (threadIdx.x >> 6), ngw = gridDim.x * NWAVE;
    unsigned char* ws = a.ws;
    bf16_t* H = (bf16_t*)(ws + WS_H); float* X1 = (float*)(ws + WS_X1);
    const bf16_t* PU = (const bf16_t*)(ws + WS_PU) + (size_t)layer * NEXP * D; const bf16_t* PV = (const bf16_t*)(ws + WS_PV) + (size_t)layer * NEXP * D;
    const int* SELI = (const int*)(ws + WS_SELI); const float* SELG = (const float*)(ws + WS_SELG);
    for (int g = gw; g < MTOT; g += ngw) {
        const int var = row_variant(g);
        if (mode == 1 && var == 2) continue;
        float hp[16], acc[16];
        {
            const u32x4 w0 = *(const u32x4*)(H + (size_t)g * D + lane * 16), w1 = *(const u32x4*)(H + (size_t)g * D + lane * 16 + 8);
            hp[0] = bflo(w0.x); hp[1] = bfhi(w0.x); hp[2] = bflo(w0.y); hp[3] = bfhi(w0.y); hp[4] = bflo(w0.z); hp[5] = bfhi(w0.z); hp[6] = bflo(w0.w); hp[7] = bfhi(w0.w);
            hp[8] = bflo(w1.x); hp[9] = bfhi(w1.x); hp[10] = bflo(w1.y); hp[11] = bfhi(w1.y); hp[12] = bflo(w1.z); hp[13] = bfhi(w1.z); hp[14] = bflo(w1.w); hp[15] = bfhi(w1.w);
#pragma unroll
            for (int d = 0; d < 16; ++d) acc[d] = 0.f;
        }
        const int myi0 = SELI[(size_t)g * 128 + lane], myi1 = SELI[(size_t)g * 128 + 64 + lane];
        const float myg0 = SELG[(size_t)g * 128 + lane], myg1 = SELG[(size_t)g * 128 + 64 + lane];
        for (int e = 0; e < 128; ++e) {
            const int ei = e < 64 ? __shfl(myi0, e) : __shfl(myi1, e - 64);
            const float eg = e < 64 ? __shfl(myg0, e) : __shfl(myg1, e - 64);
            const bf16_t* up = PU + (size_t)ei * D + lane * 16; const bf16_t* vp = PV + (size_t)ei * D + lane * 16;
            const u32x4 u0 = *(const u32x4*)up, u1 = *(const u32x4*)(up + 8), v0 = *(const u32x4*)vp, v1 = *(const u32x4*)(vp + 8);
            float dt = hp[0] * bflo(u0.x) + hp[1] * bfhi(u0.x) + hp[2] * bflo(u0.y) + hp[3] * bfhi(u0.y) + hp[4] * bflo(u0.z) + hp[5] * bfhi(u0.z) + hp[6] * bflo(u0.w) + hp[7] * bfhi(u0.w)
                     + hp[8] * bflo(u1.x) + hp[9] * bfhi(u1.x) + hp[10] * bflo(u1.y) + hp[11] * bfhi(u1.y) + hp[12] * bflo(u1.z) + hp[13] * bfhi(u1.z) + hp[14] * bflo(u1.w) + hp[15] * bfhi(u1.w);
            dt = wave_sum(dt);
            const float act = gelu_t(dt) * eg;
            acc[0] += act * bflo(v0.x); acc[1] += act * bfhi(v0.x); acc[2] += act * bflo(v0.y); acc[3] += act * bfhi(v0.y);
            acc[4] += act * bflo(v0.z); acc[5] += act * bfhi(v0.z); acc[6] += act * bflo(v0.w); acc[7] += act * bfhi(v0.w);
            acc[8] += act * bflo(v1.x); acc[9] += act * bfhi(v1.x); acc[10] += act * bflo(v1.y); acc[11] += act * bfhi(v1.y);
            acc[12] += act * bflo(v1.z); acc[13] += act * bfhi(v1.z); acc[14] += act * bflo(v1.w); acc[15] += act * bfhi(v1.w);
        }
        float* xr = X1 + (size_t)g * D + lane * 16;
        const float* g2 = modv(a, layer, var, 5) + lane * 16;
        float xn[16]; float ss = 0.f;
#pragma unroll
        for (int d = 0; d < 16; d += 4) {
            const f32x4 xv = *(const f32x4*)(xr + d), gv = *(const f32x4*)(g2 + d);
            xn[d] = xv.x + gv.x * acc[d]; xn[d + 1] = xv.y + gv.y * acc[d + 1]; xn[d + 2] = xv.z + gv.z * acc[d + 2]; xn[d + 3] = xv.w + gv.w * acc[d + 3];
            ss += xn[d] * xn[d] + xn[d + 1] * xn[d + 1] + xn[d + 2] * xn[d + 2] + xn[d + 3] * xn[d + 3];
        }
        const float rinv = rsqrtf(wave_sum(ss) * (1.f / D) + EPS);
        if (mode == 0) {
#pragma unroll
            for (int d = 0; d < 16; d += 4) { f32x4 o; o.x = xn[d]; o.y = xn[d + 1]; o.z = xn[d + 2]; o.w = xn[d + 3]; *(f32x4*)(xr + d) = o; }
            const float* gn = a.in[6] + D + lane * 16; const float* sh = modv(a, 1, var, 0) + lane * 16; const float* sc = modv(a, 1, var, 1) + lane * 16;
            unsigned w[8];
#pragma unroll
            for (int d = 0; d < 16; d += 2) w[d >> 1] = pk2(xn[d] * rinv * gn[d] * (1.f + sc[d]) + sh[d], xn[d + 1] * rinv * gn[d + 1] * (1.f + sc[d + 1]) + sh[d + 1]);
            u32x4 o0, o1; o0.x = w[0]; o0.y = w[1]; o0.z = w[2]; o0.w = w[3]; o1.x = w[4]; o1.y = w[5]; o1.z = w[6]; o1.w = w[7];
            *(u32x4*)(H + (size_t)g * D + lane * 16) = o0; *(u32x4*)(H + (size_t)g * D + lane * 16 + 8) = o1;
        } else {
            const int b = g / RPB, t = g - b * RPB - CTXL;
            float* op = a.out + ((size_t)b * SEQ + t) * D + lane * 16; const float* gn = a.in[28] + lane * 16;
#pragma unroll
            for (int d = 0; d < 16; d += 4) { f32x4 o; o.x = xn[d] * rinv * gn[d]; o.y = xn[d + 1] * rinv * gn[d + 1]; o.z = xn[d + 2] * rinv * gn[d + 2]; o.w = xn[d + 3] * rinv * gn[d + 3]; *(f32x4*)(op + d) = o; }
        }
    }
}

typedef __bf16 bf16x2_t __attribute__((ext_vector_type(2)));
__device__ __forceinline__ float dot2bf(unsigned w, unsigned x, float acc) { return __builtin_amdgcn_fdot2_f32_bf16(__builtin_bit_cast(bf16x2_t, w), __builtin_bit_cast(bf16x2_t, x), acc, false); }
struct Row8 { u32x4 c[8]; };
__device__ __forceinline__ void load_row8(Row8& r, const bf16_t* p) {
#pragma unroll
    for (int c = 0; c < 8; ++c) r.c[c] = *(const u32x4*)(p + c * 128);
}
__device__ __forceinline__ float dot_row8(const Row8& r, const u32x4 (&hp)[8]) {
    float a0 = 0.f, a1 = 0.f, a2 = 0.f, a3 = 0.f;
#pragma unroll
    for (int c = 0; c < 8; ++c) { a0 = dot2bf(r.c[c].x, hp[c].x, a0); a1 = dot2bf(r.c[c].y, hp[c].y, a1); a2 = dot2bf(r.c[c].z, hp[c].z, a2); a3 = dot2bf(r.c[c].w, hp[c].w, a3); }
    float s = (a0 + a1) + (a2 + a3);
    s += __shfl_xor(s, 1); s += __shfl_xor(s, 2); s += __shfl_xor(s, 4); s += __shfl_xor(s, 8);
    return s;
}
__device__ __forceinline__ void fma_row(float (&acc)[16], const u32x4& v0, const u32x4& v1, float a) {
    acc[0] += a * bflo(v0.x); acc[1] += a * bfhi(v0.x); acc[2] += a * bflo(v0.y); acc[3] += a * bfhi(v0.y);
    acc[4] += a * bflo(v0.z); acc[5] += a * bfhi(v0.z); acc[6] += a * bflo(v0.w); acc[7] += a * bfhi(v0.w);
    acc[8] += a * bflo(v1.x); acc[9] += a * bfhi(v1.x); acc[10] += a * bflo(v1.y); acc[11] += a * bfhi(v1.y);
    acc[12] += a * bflo(v1.z); acc[13] += a * bfhi(v1.z); acc[14] += a * bflo(v1.w); acc[15] += a * bfhi(v1.w);
}
__device__ __forceinline__ void phase_peer_gather2(const Args& a, char* lds, int layer, int mode) {
    const int lane = threadIdx.x & 63, wid = threadIdx.x >> 6, gw = blockIdx.x * NWAVE + wid, ngw = gridDim.x * NWAVE;
    const int grp = lane >> 4, sub = lane & 15;
    unsigned char* ws = a.ws;
    bf16_t* H = (bf16_t*)(ws + WS_H); float* X1 = (float*)(ws + WS_X1);
    const bf16_t* PU = (const bf16_t*)(ws + WS_PU) + (size_t)layer * NEXP * D; const bf16_t* PV = (const bf16_t*)(ws + WS_PV) + (size_t)layer * NEXP * D;
    const int* SELI = (const int*)(ws + WS_SELI); const float* SELG = (const float*)(ws + WS_SELG);
    LAS int* lidx = (LAS int*)((LAS char*)lds + wid * 2048);
    LAS float* lgate = (LAS float*)(lidx + 128);
    LAS float* lact = lgate + 128;
    for (int g = gw; g < MTOT; g += ngw) {
        const int var = row_variant(g);
        if (mode == 1 && var == 2) continue;
        lidx[lane] = SELI[(size_t)g * 128 + lane]; lidx[64 + lane] = SELI[(size_t)g * 128 + 64 + lane];
        lgate[lane] = SELG[(size_t)g * 128 + lane]; lgate[64 + lane] = SELG[(size_t)g * 128 + 64 + lane];
        u32x4 hp[8];
#pragma unroll
        for (int c = 0; c < 8; ++c) hp[c] = *(const u32x4*)(H + (size_t)g * D + c * 128 + sub * 8);
        {
            Row8 ra, rb;
            load_row8(ra, PU + (size_t)lidx[grp] * D + sub * 8);
            for (int it = 0; it < 32; it += 2) {
                load_row8(rb, PU + (size_t)lidx[(it + 1) * 4 + grp] * D + sub * 8);
                { const float s = dot_row8(ra, hp); const int e = it * 4 + grp; if (sub == 0) lact[e] = gelu_t(s) * lgate[e]; }
                if (it + 2 < 32) load_row8(ra, PU + (size_t)lidx[(it + 2) * 4 + grp] * D + sub * 8);
                { const float s = dot_row8(rb, hp); const int e = (it + 1) * 4 + grp; if (sub == 0) lact[e] = gelu_t(s) * lgate[e]; }
            }
        }
        float acc[16];
#pragma unroll
        for (int d = 0; d < 16; ++d) acc[d] = 0.f;
        {
            u32x4 va[4][2], vb[4][2];
#pragma unroll
            for (int k = 0; k < 4; ++k) { const bf16_t* p = PV + (size_t)lidx[k] * D + lane * 8; va[k][0] = *(const u32x4*)p; va[k][1] = *(const u32x4*)(p + 512); }
            for (int e = 0; e < 128; e += 8) {
#pragma unroll
                for (int k = 0; k < 4; ++k) { const bf16_t* p = PV + (size_t)lidx[e + 4 + k] * D + lane * 8; vb[k][0] = *(const u32x4*)p; vb[k][1] = *(const u32x4*)(p + 512); }
#pragma unroll
                for (int k = 0; k < 4; ++k) fma_row(acc, va[k][0], va[k][1], lact[e + k]);
                if (e + 8 < 128) {
#pragma unroll
                    for (int k = 0; k < 4; ++k) { const bf16_t* p = PV + (size_t)lidx[e + 8 + k] * D + lane * 8; va[k][0] = *(const u32x4*)p; va[k][1] = *(const u32x4*)(p + 512); }
                }
#pragma unroll
                for (int k = 0; k < 4; ++k) fma_row(acc, vb[k][0], vb[k][1], lact[e + 4 + k]);
            }
        }
        float* xr = X1 + (size_t)g * D + lane * 8;
        const float* g2 = modv(a, layer, var, 5) + lane * 8;
        float xn[16]; float ss = 0.f;
#pragma unroll
        for (int hh = 0; hh < 2; ++hh)
#pragma unroll
            for (int d = 0; d < 8; d += 4) {
                const f32x4 xv = *(const f32x4*)(xr + hh * 512 + d), gv = *(const f32x4*)(g2 + hh * 512 + d);
                const int o = hh * 8 + d;
                xn[o] = xv.x + gv.x * acc[o]; xn[o + 1] = xv.y + gv.y * acc[o + 1]; xn[o + 2] = xv.z + gv.z * acc[o + 2]; xn[o + 3] = xv.w + gv.w * acc[o + 3];
                ss += xn[o] * xn[o] + xn[o + 1] * xn[o + 1] + xn[o + 2] * xn[o + 2] + xn[o + 3] * xn[o + 3];
            }
        const float rinv = rsqrtf(wave_sum(ss) * (1.f / D) + EPS);
        if (mode == 0) {
            const float* gn = a.in[6] + D + lane * 8; const float* sh = modv(a, 1, var, 0) + lane * 8; const float* sc = modv(a, 1, var, 1) + lane * 8;
#pragma unroll
            for (int hh = 0; hh < 2; ++hh) {
                const int o = hh * 8;
                f32x4 o0, o1; o0.x = xn[o]; o0.y = xn[o + 1]; o0.z = xn[o + 2]; o0.w = xn[o + 3]; o1.x = xn[o + 4]; o1.y = xn[o + 5]; o1.z = xn[o + 6]; o1.w = xn[o + 7];
                *(f32x4*)(xr + hh * 512) = o0; *(f32x4*)(xr + hh * 512 + 4) = o1;
                unsigned w[4];
#pragma unroll
                for (int d = 0; d < 8; d += 2) { const int cc = hh * 512 + d; w[d >> 1] = pk2(xn[o + d] * rinv * gn[cc] * (1.f + sc[cc]) + sh[cc], xn[o + d + 1] * rinv * gn[cc + 1] * (1.f + sc[cc + 1]) + sh[cc + 1]); }
                u32x4 ow; ow.x = w[0]; ow.y = w[1]; ow.z = w[2]; ow.w = w[3];
                *(u32x4*)(H + (size_t)g * D + hh * 512 + lane * 8) = ow;
            }
        } else {
            const int b = g / RPB, t = g - b * RPB - CTXL;
            float* op = a.out + ((size_t)b * SEQ + t) * D + lane * 8; const float* gn = a.in[28] + lane * 8;
#pragma unroll
            for (int hh = 0; hh < 2; ++hh)
#pragma unroll
                for (int d = 0; d < 8; d += 4) { const int o = hh * 8 + d, cc = hh * 512 + d;
                    f32x4 ov; ov.x = xn[o] * rinv * gn[cc]; ov.y = xn[o + 1] * rinv * gn[cc + 1]; ov.z = xn[o + 2] * rinv * gn[cc + 2]; ov.w = xn[o + 3] * rinv * gn[cc + 3]; *(f32x4*)(op + cc) = ov; }
        }
    }
}

__device__ __forceinline__ float ub0(unsigned w) { return (float)(w & 0xffu); }
__device__ __forceinline__ float ub1(unsigned w) { return (float)((w >> 8) & 0xffu); }
__device__ __forceinline__ float ub2(unsigned w) { return (float)((w >> 16) & 0xffu); }
__device__ __forceinline__ float ub3(unsigned w) { return (float)(w >> 24); }
struct RowU { u32x4 c[4]; };
__device__ __forceinline__ void load_rowu(RowU& r, const unsigned char* p) {
#pragma unroll
    for (int c = 0; c < 4; ++c) r.c[c] = *(const u32x4*)(p + c * 256);
}
__device__ __forceinline__ float dot_rowu(const RowU& r, const float (&hp)[64]) {
    float a0 = 0.f, a1 = 0.f, a2 = 0.f, a3 = 0.f;
#pragma unroll
    for (int c = 0; c < 4; ++c) {
        const unsigned w0 = r.c[c].x, w1 = r.c[c].y, w2 = r.c[c].z, w3 = r.c[c].w; const int o = c * 16;
        a0 += hp[o + 0] * ub0(w0); a1 += hp[o + 1] * ub1(w0); a2 += hp[o + 2] * ub2(w0); a3 += hp[o + 3] * ub3(w0);
        a0 += hp[o + 4] * ub0(w1); a1 += hp[o + 5] * ub1(w1); a2 += hp[o + 6] * ub2(w1); a3 += hp[o + 7] * ub3(w1);
        a0 += hp[o + 8] * ub0(w2); a1 += hp[o + 9] * ub1(w2); a2 += hp[o + 10] * ub2(w2); a3 += hp[o + 11] * ub3(w2);
        a0 += hp[o + 12] * ub0(w3); a1 += hp[o + 13] * ub1(w3); a2 += hp[o + 14] * ub2(w3); a3 += hp[o + 15] * ub3(w3);
    }
    float s = (a0 + a1) + (a2 + a3);
    s += __shfl_xor(s, 1); s += __shfl_xor(s, 2); s += __shfl_xor(s, 4); s += __shfl_xor(s, 8);
    return s;
}
__device__ __forceinline__ void fma_rowv(float (&acc)[16], const u32x4& v, float a) {
    acc[0] += a * ub0(v.x); acc[1] += a * ub1(v.x); acc[2] += a * ub2(v.x); acc[3] += a * ub3(v.x);
    acc[4] += a * ub0(v.y); acc[5] += a * ub1(v.y); acc[6] += a * ub2(v.y); acc[7] += a * ub3(v.y);
    acc[8] += a * ub0(v.z); acc[9] += a * ub1(v.z); acc[10] += a * ub2(v.z); acc[11] += a * ub3(v.z);
    acc[12] += a * ub0(v.w); acc[13] += a * ub1(v.w); acc[14] += a * ub2(v.w); acc[15] += a * ub3(v.w);
}
__device__ __forceinline__ void phase_peer_gather3(const Args& a, char* lds, int layer, int mode) {
    const int lane = threadIdx.x & 63, wid = __builtin_amdgcn_readfirstlane(threadIdx.x >> 6), gw = blockIdx.x * NWAVE + wid, ngw = gridDim.x * NWAVE;
    const int grp = lane >> 4, sub = lane & 15;
    unsigned char* ws = a.ws;
    bf16_t* H = (bf16_t*)(ws + WS_H); float* X1 = (float*)(ws + WS_X1);
    const unsigned char* PU = ws + WS_PU + (size_t)layer * NEXP * D; const unsigned char* PV = ws + WS_PV + (size_t)layer * NEXP * D;
    const float* SCU = (const float*)(ws + WS_SCU) + layer * NEXP; const float* SCV = (const float*)(ws + WS_SCV) + layer * NEXP;
    const int* SELI = (const int*)(ws + WS_SELI); const float* SELG = (const float*)(ws + WS_SELG);
    LAS int* lidx = (LAS int*)((LAS char*)lds + wid * 2048);
    LAS float* lgu = (LAS float*)(lidx + 128);
    LAS float* lact = lgu + 128;
    for (int g = gw; g < MTOT; g += ngw) {
        const int var = row_variant(g);
        if (mode == 1 && var == 2) continue;
        {
            const int i0 = SELI[(size_t)g * 128 + lane], i1 = SELI[(size_t)g * 128 + 64 + lane];
            lidx[lane] = i0; lidx[64 + lane] = i1;
            lgu[lane] = SCU[i0]; lgu[64 + lane] = SCU[i1];
        }
        float hp[64]; float shp = 0.f;
#pragma unroll
        for (int c = 0; c < 4; ++c) {
            const u32x4 w0 = *(const u32x4*)(H + (size_t)g * D + c * 256 + sub * 16), w1 = *(const u32x4*)(H + (size_t)g * D + c * 256 + sub * 16 + 8);
            const int o = c * 16;
            hp[o + 0] = bflo(w0.x); hp[o + 1] = bfhi(w0.x); hp[o + 2] = bflo(w0.y); hp[o + 3] = bfhi(w0.y); hp[o + 4] = bflo(w0.z); hp[o + 5] = bfhi(w0.z); hp[o + 6] = bflo(w0.w); hp[o + 7] = bfhi(w0.w);
            hp[o + 8] = bflo(w1.x); hp[o + 9] = bfhi(w1.x); hp[o + 10] = bflo(w1.y); hp[o + 11] = bfhi(w1.y); hp[o + 12] = bflo(w1.z); hp[o + 13] = bfhi(w1.z); hp[o + 14] = bflo(w1.w); hp[o + 15] = bfhi(w1.w);
        }
#pragma unroll
        for (int d = 0; d < 64; ++d) shp += hp[d];
        shp += __shfl_xor(shp, 1); shp += __shfl_xor(shp, 2); shp += __shfl_xor(shp, 4); shp += __shfl_xor(shp, 8);
        const float bias = 128.f * shp;
        {
            RowU r0, r1, r2, r3;
            load_rowu(r0, PU + (size_t)lidx[0 * 4 + grp] * D + sub * 16); load_rowu(r1, PU + (size_t)lidx[1 * 4 + grp] * D + sub * 16);
            load_rowu(r2, PU + (size_t)lidx[2 * 4 + grp] * D + sub * 16); load_rowu(r3, PU + (size_t)lidx[3 * 4 + grp] * D + sub * 16);
#define GU_STEP(R, IT) { const float s = dot_rowu(R, hp) - bias; const int e = (IT) * 4 + grp; const float su = lgu[e]; \
                if ((IT) + 4 < 32) load_rowu(R, PU + (size_t)lidx[((IT) + 4) * 4 + grp] * D + sub * 16); \
                if (sub == 0) lact[e] = gelu_t(s * su); }
            for (int it = 0; it < 32; it += 4) { GU_STEP(r0, it) GU_STEP(r1, it + 1) GU_STEP(r2, it + 2) GU_STEP(r3, it + 3) }
#undef GU_STEP
        }
        {
            const float g0 = SELG[(size_t)g * 128 + lane], g1 = SELG[(size_t)g * 128 + 64 + lane];
            const float a0 = lact[lane] * g0 * SCV[lidx[lane]], a1 = lact[64 + lane] * g1 * SCV[lidx[64 + lane]];
            lact[lane] = a0; lact[64 + lane] = a1;
        }
        float acc[16]; float sact = 0.f;
#pragma unroll
        for (int d = 0; d < 16; ++d) acc[d] = 0.f;
        {
            u32x4 va[8];
#pragma unroll
            for (int k = 0; k < 8; ++k) va[k] = *(const u32x4*)(PV + (size_t)lidx[k] * D + lane * 16);
            for (int e = 0; e < 128; e += 8) {
#pragma unroll
                for (int k = 0; k < 8; ++k) {
                    const float av = lact[e + k]; sact += av;
                    fma_rowv(acc, va[k], av);
                    if (e + 8 < 128) va[k] = *(const u32x4*)(PV + (size_t)lidx[e + 8 + k] * D + lane * 16);
                }
            }
        }
        const float vb = 128.f * sact;
        float* xr = X1 + (size_t)g * D + lane * 16;
        const float* g2 = modv(a, layer, var, 5) + lane * 16;
        float xn[16]; float ss = 0.f;
#pragma unroll
        for (int d = 0; d < 16; d += 4) {
            const f32x4 xv = *(const f32x4*)(xr + d), gv = *(const f32x4*)(g2 + d);
            xn[d] = xv.x + gv.x * (acc[d] - vb); xn[d + 1] = xv.y + gv.y * (acc[d + 1] - vb); xn[d + 2] = xv.z + gv.z * (acc[d + 2] - vb); xn[d + 3] = xv.w + gv.w * (acc[d + 3] - vb);
            ss += xn[d] * xn[d] + xn[d + 1] * xn[d + 1] + xn[d + 2] * xn[d + 2] + xn[d + 3] * xn[d + 3];
        }
        const float rinv = rsqrtf(wave_sum(ss) * (1.f / D) + EPS);
        if (mode == 0) {
#pragma unroll
            for (int d = 0; d < 16; d += 4) { f32x4 o; o.x = xn[d]; o.y = xn[d + 1]; o.z = xn[d + 2]; o.w = xn[d + 3]; *(f32x4*)(xr + d) = o; }
            const float* gn = a.in[6] + D + lane * 16; const float* sh = modv(a, 1, var, 0) + lane * 16; const float* sc = modv(a, 1, var, 1) + lane * 16;
            unsigned w[8];
#pragma unroll
            for (int d = 0; d < 16; d += 2) w[d >> 1] = pk2(xn[d] * rinv * gn[d] * (1.f + sc[d]) + sh[d], xn[d + 1] * rinv * gn[d + 1] * (1.f + sc[d + 1]) + sh[d + 1]);
            u32x4 o0, o1; o0.x = w[0]; o0.y = w[1]; o0.z = w[2]; o0.w = w[3]; o1.x = w[4]; o1.y = w[5]; o1.z = w[6]; o1.w = w[7];
            *(u32x4*)(H + (size_t)g * D + lane * 16) = o0; *(u32x4*)(H + (size_t)g * D + lane * 16 + 8) = o1;
        } else {
            const int b = g / RPB, t = g - b * RPB - CTXL;
            float* op = a.out + ((size_t)b * SEQ + t) * D + lane * 16; const float* gn = a.in[28] + lane * 16;
#pragma unroll
            for (int d = 0; d < 16; d += 4) { f32x4 o; o.x = xn[d] * rinv * gn[d]; o.y = xn[d + 1] * rinv * gn[d + 1]; o.z = xn[d + 2] * rinv * gn[d + 2]; o.w = xn[d + 3] * rinv * gn[d + 3]; *(f32x4*)(op + d) = o; }
        }
    }
}

__device__ __forceinline__ void phase_inproj1(const Args& a, char* lds) {
    float* Cs = (float*)lds;
    const int tid = threadIdx.x;
    const bf16_t* H = (const bf16_t*)(a.ws + WS_H); const bf16_t* W = (const bf16_t*)(a.ws + WS_WIN1);
    const int NU = (MTOT / 128) * 20;
    for (int u = blockIdx.x; u < NU; u += gridDim.x) {
        const int rt = u / 20, ct = u % 20, row0 = rt * 128, col0 = ct * 128;
        if (ct < 10 && (rt % 66) < 2) continue;
        gemm_tile128(H + (size_t)row0 * D, D, W + (size_t)col0 * D, D, D, Cs);
        __syncthreads();
        const int rr = tid >> 2, q4 = tid & 3, g = row0 + rr;
        const float* crow = Cs + rr * CS_LD + q4 * 32;
        if (ct < 10) {
            bf16_t* o = (bf16_t*)(a.ws + WS_GG) + (size_t)g * DRNN + col0 + q4 * 32;
#pragma unroll
            for (int c = 0; c < 32; c += 2) *(unsigned*)(o + c) = pk2(gelu_t(crow[c]), gelu_t(crow[c + 1]));
        } else {
            bf16_t* o = (bf16_t*)(a.ws + WS_XR) + (size_t)g * DRNN + (col0 - DRNN) + q4 * 32;
#pragma unroll
            for (int c = 0; c < 32; c += 2) *(unsigned*)(o + c) = pk2(crow[c], crow[c + 1]);
        }
        __syncthreads();
    }
}

__device__ __forceinline__ void phase_rglru(const Args& a, char* lds, int pass) {
    const int tid = threadIdx.x;
    unsigned char* ws = a.ws;
    float* xc = (float*)lds;
    float* seg = xc + 128 * 128;
    const bf16_t* XR = (const bf16_t*)(ws + WS_XR); const bf16_t* GG = (const bf16_t*)(ws + WS_GG); bf16_t* YG = (bf16_t*)(ws + WS_YG);
    float* CARRY = (float*)(ws + WS_CARRY);
    const int j = tid & 127, tq = tid >> 7;
    const int NU = (MTOT / 128) * 10;
    for (int u = blockIdx.x; u < NU; u += gridDim.x) {
        const int T = u / 10, hb = u % 10, b = T / 66, tl = T % 66, row0 = T * 128, ch = hb * 128 + j;
        if (pass == 1 && tl < 2) continue;
        const int seq_lo = tl < 2 ? b * RPB : b * RPB + CTXL, seq_hi = tl < 2 ? b * RPB + CTXL : (b + 1) * RPB;
        {
            const float w0 = a.in[16][0 * DRNN + ch], w1 = a.in[16][1 * DRNN + ch], w2 = a.in[16][2 * DRNN + ch], w3 = a.in[16][3 * DRNN + ch], cb = a.in[17][ch];
            for (int tt = 0; tt < 32; ++tt) {
                const int g = row0 + tq * 32 + tt;
                const float xm2 = (g - 2 >= seq_lo) ? bf2f(XR[(size_t)(g - 2) * DRNN + ch]) : 0.f;
                const float xm1 = (g - 1 >= seq_lo) ? bf2f(XR[(size_t)(g - 1) * DRNN + ch]) : 0.f;
                const float x0 = bf2f(XR[(size_t)g * DRNN + ch]);
                const float xp1 = (g + 1 < seq_hi) ? bf2f(XR[(size_t)(g + 1) * DRNN + ch]) : 0.f;
                xc[(tq * 32 + tt) * 128 + j] = w0 * xm2 + w1 * xm1 + w2 * x0 + w3 * xp1 + cb;
            }
        }
        __syncthreads();
        float acc[4][32];
#pragma unroll
        for (int m = 0; m < 4; ++m)
#pragma unroll
            for (int tt = 0; tt < 32; ++tt) acc[m][tt] = 0.f;
        {
            const float* wa0 = a.in[18] + ((size_t)(0 * 10 + hb) * 128) * 128 + j; const float* wx0 = a.in[20] + ((size_t)(0 * 10 + hb) * 128) * 128 + j;
            const float* wa1 = a.in[18] + ((size_t)(1 * 10 + hb) * 128) * 128 + j; const float* wx1 = a.in[20] + ((size_t)(1 * 10 + hb) * 128) * 128 + j;
            for (int i = 0; i < 128; ++i) {
                const float w0 = wa0[i * 128], w1 = wx0[i * 128], w2 = wa1[i * 128], w3 = wx1[i * 128];
#pragma unroll
                for (int tt = 0; tt < 32; ++tt) { const float x = xc[(tq * 32 + tt) * 128 + i]; acc[0][tt] += x * w0; acc[1][tt] += x * w1; acc[2][tt] += x * w2; acc[3][tt] += x * w3; }
            }
        }
#pragma unroll
        for (int d = 0; d < 2; ++d) {
            const float ba = a.in[19][d * DRNN + ch], bx = a.in[21][d * DRNN + ch], lam = a.in[22][d * DRNN + ch];
            const float sp = log1pf(__expf(-lam));
#pragma unroll
            for (int tt = 0; tt < 32; ++tt) {
                const float r = sigmoidf_(acc[2 * d][tt] + ba), ig = sigmoidf_(acc[2 * d + 1][tt] + bx);
                const float la = -8.f * r * sp; const float av = __expf(la);
                const float uv = sqrtf(fmaxf(-expm1f(2.f * la), 0.f)) * ig * xc[(tq * 32 + tt) * 128 + j];
                acc[2 * d][tt] = av; acc[2 * d + 1][tt] = uv;
            }
        }
        {
            float Af = 1.f, Hf = 0.f, Ab = 1.f, Hb = 0.f;
#pragma unroll
            for (int tt = 0; tt < 32; ++tt) { Hf = acc[0][tt] * Hf + acc[1][tt]; Af *= acc[0][tt]; }
#pragma unroll
            for (int tt = 31; tt >= 0; --tt) { Hb = acc[2][tt] * Hb + acc[3][tt]; Ab *= acc[2][tt]; }
            seg[((0 * 4 + tq) * 128 + j) * 2] = Af; seg[((0 * 4 + tq) * 128 + j) * 2 + 1] = Hf;
            seg[((1 * 4 + tq) * 128 + j) * 2] = Ab; seg[((1 * 4 + tq) * 128 + j) * 2 + 1] = Hb;
        }
        __syncthreads();
        if (pass == 0) {
            if (tq == 0) {
                float A = 1.f, Hh = 0.f;
                for (int s = 0; s < 4; ++s) { const float sa = seg[((0 * 4 + s) * 128 + j) * 2], sh = seg[((0 * 4 + s) * 128 + j) * 2 + 1]; Hh = sa * Hh + sh; A *= sa; }
                float* c0 = CARRY + (((size_t)(b * 2 + 0) * 66 + tl) * DRNN + ch) * 2; c0[0] = A; c0[1] = Hh;
                A = 1.f; Hh = 0.f;
                for (int s = 3; s >= 0; --s) { const float sa = seg[((1 * 4 + s) * 128 + j) * 2], sh = seg[((1 * 4 + s) * 128 + j) * 2 + 1]; Hh = sa * Hh + sh; A *= sa; }
                float* c1 = CARRY + (((size_t)(b * 2 + 1) * 66 + tl) * DRNN + ch) * 2; c1[0] = A; c1[1] = Hh;
            }
        } else {
            float hf = 0.f, hbk = 0.f;
            for (int t2 = 0; t2 < tl; ++t2) { const float* c = CARRY + (((size_t)(b * 2 + 0) * 66 + t2) * DRNN + ch) * 2; hf = c[0] * hf + c[1]; }
            { const float* c = CARRY + (((size_t)(b * 2 + 1) * 66 + 1) * DRNN + ch) * 2; hbk = c[0] * hbk + c[1]; }
            { const float* c = CARRY + (((size_t)(b * 2 + 1) * 66 + 0) * DRNN + ch) * 2; hbk = c[0] * hbk + c[1]; }
            for (int t2 = 65; t2 > tl; --t2) { const float* c = CARRY + (((size_t)(b * 2 + 1) * 66 + t2) * DRNN + ch) * 2; hbk = c[0] * hbk + c[1]; }
            for (int s = 0; s < tq; ++s) { const float sa = seg[((0 * 4 + s) * 128 + j) * 2], sh = seg[((0 * 4 + s) * 128 + j) * 2 + 1]; hf = sa * hf + sh; }
            for (int s = 3; s > tq; --s) { const float sa = seg[((1 * 4 + s) * 128 + j) * 2], sh = seg[((1 * 4 + s) * 128 + j) * 2 + 1]; hbk = sa * hbk + sh; }
#pragma unroll
            for (int tt = 0; tt < 32; ++tt) { hf = acc[0][tt] * hf + acc[1][tt]; acc[0][tt] = hf; }
#pragma unroll
            for (int tt = 31; tt >= 0; --tt) { hbk = acc[2][tt] * hbk + acc[3][tt]; acc[0][tt] += hbk; }
#pragma unroll
            for (int tt = 0; tt < 32; ++tt) {
                const int g = row0 + tq * 32 + tt;
                YG[(size_t)g * DRNN + ch] = (bf16_t)f2bf(acc[0][tt] * bf2f(GG[(size_t)g * DRNN + ch]));
            }
        }
        __syncthreads();
    }
}

constexpr int XC_LD = 136;
__device__ __forceinline__ float exp2_fast(float x) { return __builtin_amdgcn_exp2f(x); }
__device__ __forceinline__ float sigm_fast(float x) { return __builtin_amdgcn_rcpf(1.f + __builtin_amdgcn_exp2f(-1.4426950408889634f * x)); }
__device__ __forceinline__ void phase_rglru2(const Args& a, char* lds, int pass) {
    const int tid = threadIdx.x, lane = tid & 63, wid = __builtin_amdgcn_readfirstlane(tid >> 6), r32 = lane & 31, hh = lane >> 5;
    const int nb = wid & 3, dir = wid >> 2;
    unsigned char* ws = a.ws;
    LAS bf16_t* xcA = (LAS bf16_t*)((LAS char*)lds);
    LAS float* HS = (LAS float*)((LAS char*)lds + 36864);
    const bf16_t* XR = (const bf16_t*)(ws + WS_XR); const bf16_t* GG = (const bf16_t*)(ws + WS_GG); bf16_t* YG = (bf16_t*)(ws + WS_YG);
    float* CARRY = (float*)(ws + WS_CARRY);
    const int NU = (MTOT / 128) * 10;
    for (int u = blockIdx.x; u < NU; u += gridDim.x) {
        const int T = u / 10, hb = u % 10, b = T / 66, tl = T % 66, row0 = T * 128;
        if (pass == 1 && tl < 2) continue;
        const int seq_lo = tl < 2 ? b * RPB : b * RPB + CTXL, seq_hi = tl < 2 ? b * RPB + CTXL : (b + 1) * RPB;
        {
            const int j2 = tid & 63, ts = tid >> 6, c0 = hb * 128 + 2 * j2;
            const float w00 = a.in[16][0 * DRNN + c0], w01 = a.in[16][0 * DRNN + c0 + 1], w10 = a.in[16][1 * DRNN + c0], w11 = a.in[16][1 * DRNN + c0 + 1];
            const float w20 = a.in[16][2 * DRNN + c0], w21 = a.in[16][2 * DRNN + c0 + 1], w30 = a.in[16][3 * DRNN + c0], w31 = a.in[16][3 * DRNN + c0 + 1];
            const float cb0 = a.in[17][c0], cb1 = a.in[17][c0 + 1];
            unsigned xw[19];
#pragma unroll
            for (int i = 0; i < 19; ++i) { const int g = row0 + ts * 16 - 2 + i; xw[i] = (g >= seq_lo && g < seq_hi) ? *(const unsigned*)(XR + (size_t)g * DRNN + c0) : 0u; }
#pragma unroll
            for (int i = 0; i < 16; ++i) {
                const float y0 = w00 * bflo(xw[i]) + w10 * bflo(xw[i + 1]) + w20 * bflo(xw[i + 2]) + w30 * bflo(xw[i + 3]) + cb0;
                const float y1 = w01 * bfhi(xw[i]) + w11 * bfhi(xw[i + 1]) + w21 * bfhi(xw[i + 2]) + w31 * bfhi(xw[i + 3]) + cb1;
                *(LAS unsigned*)(xcA + (ts * 16 + i) * XC_LD + 2 * j2) = pk2(y0, y1);
            }
        }
        __syncthreads();
        const int ch = hb * 128 + nb * 32 + r32;
        f32x16 accA[4], accX[4];
        {
            unsigned woff = (unsigned)((nb * 32 + r32) * 128 + 8 * hh); asm volatile("" : "+v"(woff));
            const bf16_t* wa = (const bf16_t*)(ws + WS_WAT) + (size_t)(dir * 10 + hb) * 128 * 128;
            const bf16_t* wx = (const bf16_t*)(ws + WS_WXT) + (size_t)(dir * 10 + hb) * 128 * 128;
            bf16x8 bfa[8], bfx[8];
#pragma unroll
            for (int k = 0; k < 8; ++k) { bfa[k] = *(const bf16x8*)(wa + woff + k * 16); bfx[k] = *(const bf16x8*)(wx + woff + k * 16); }
#pragma unroll
            for (int mb = 0; mb < 4; ++mb) {
                accA[mb] = f32x16{}; accX[mb] = f32x16{};
#pragma unroll
                for (int k = 0; k < 8; ++k) {
                    const bf16x8 af = *(const LAS bf16x8*)(xcA + (mb * 32 + r32) * XC_LD + k * 16 + 8 * hh);
                    accA[mb] = __builtin_amdgcn_mfma_f32_32x32x16_bf16(af, bfa[k], accA[mb], 0, 0, 0);
                    accX[mb] = __builtin_amdgcn_mfma_f32_32x32x16_bf16(af, bfx[k], accX[mb], 0, 0, 0);
                }
            }
        }
        __builtin_amdgcn_sched_barrier(0);
        {
            const float ba = a.in[19][dir * DRNN + ch], bx = a.in[21][dir * DRNN + ch], lam = a.in[22][dir * DRNN + ch];
            const float sp8 = -8.f * log1pf(__expf(-lam));
#pragma unroll
            for (int mb = 0; mb < 4; ++mb)
#pragma unroll
                for (int r = 0; r < 16; ++r) {
                    const int t = mb * 32 + (r & 3) + 8 * (r >> 2) + 4 * hh;
                    const float xv = bf2f(xcA[t * XC_LD + nb * 32 + r32]);
                    const float rg = sigm_fast(accA[mb][r] + ba), ig = sigm_fast(accX[mb][r] + bx);
                    const float la = rg * sp8, av = exp2_fast(1.4426950408889634f * la), x2 = 2.f * la;
                    const float om1 = -x2 * (1.f + x2 * (0.5f + x2 * (0.16666667f + x2 * 0.041666668f))), om2 = __builtin_fmaf(-av, av, 1.f);
                    const float om = (x2 > -0.25f) ? om1 : om2;
                    accA[mb][r] = av; accX[mb][r] = __builtin_sqrtf(fmaxf(om, 0.f)) * ig * xv;
                    if ((r & 3) == 3) __builtin_amdgcn_sched_barrier(0);
                }
        }
        __builtin_amdgcn_sched_barrier(0);
        float h = 0.f;
        if (pass == 1) {
            const int pos = dir == 0 ? tl : 67 - tl;
            const float* cbase = CARRY + ((size_t)(b * 2 + dir) * 66) * DRNN * 2 + (size_t)ch * 2;
            float cA = 1.f, cH = 0.f;
#pragma unroll 3
            for (int i = 0; i < 33; ++i) {
                const int p = hh * 33 + i;
                const int tile = dir == 0 ? p : (p < 2 ? 1 - p : 67 - p);
                if (p < pos) { const float* c = cbase + (size_t)tile * DRNN * 2; const float ta = c[0], th = c[1]; cH = ta * cH + th; cA = ta * cA; }
            }
            const auto ra = __builtin_amdgcn_permlane32_swap(__float_as_uint(cA), __float_as_uint(cA), false, false);
            const auto rh = __builtin_amdgcn_permlane32_swap(__float_as_uint(cH), __float_as_uint(cH), false, false);
            const float lowH = hh == 0 ? cH : __uint_as_float(rh[0]);
            const float upA = hh == 0 ? __uint_as_float(ra[1]) : cA;
            const float upH = hh == 0 ? __uint_as_float(rh[1]) : cH;
            h = upA * lowH + upH;
        }
        float Atot = 1.f; float cin[16];
#define RG_COMPOSITE(q) const int mb = (q) >> 2, rg = ((q) & 3) * 4; \
            const float a0 = accA[mb][rg], a1 = accA[mb][rg + 1], a2 = accA[mb][rg + 2], a3 = accA[mb][rg + 3]; \
            const float u0 = accX[mb][rg], u1 = accX[mb][rg + 1], u2 = accX[mb][rg + 2], u3 = accX[mb][rg + 3]; \
            const float gA = (a0 * a1) * (a2 * a3); \
            const float gH = dir == 0 ? ((u0 * a1 + u1) * a2 + u2) * a3 + u3 : ((u3 * a2 + u2) * a1 + u1) * a0 + u0; \
            const auto ra = __builtin_amdgcn_permlane32_swap(__float_as_uint(gA), __float_as_uint(gA), false, false); \
            const auto rh = __builtin_amdgcn_permlane32_swap(__float_as_uint(gH), __float_as_uint(gH), false, false); \
            const float pA = __uint_as_float(hh == 0 ? ra[1] : ra[0]), pH = __uint_as_float(hh == 0 ? rh[1] : rh[0]); \
            const float EA = hh ? pA : gA, EH = hh ? pH : gH, OA = hh ? gA : pA, OH = hh ? gH : pH;
        if (dir == 0) {
#pragma unroll
            for (int q = 0; q < 16; ++q) { RG_COMPOSITE(q)
                const float hE = h; h = EA * h + EH; const float hO = h; h = OA * h + OH; Atot *= EA * OA; cin[q] = hh ? hO : hE; }
        } else {
#pragma unroll
            for (int q = 15; q >= 0; --q) { RG_COMPOSITE(q)
                const float hO = h; h = OA * h + OH; const float hE = h; h = EA * h + EH; Atot *= EA * OA; cin[q] = hh ? hO : hE; }
        }
#undef RG_COMPOSITE
        if (pass == 0) {
            if (hh == 0) { float* c = CARRY + (((size_t)(b * 2 + dir) * 66 + tl) * DRNN + ch) * 2; c[0] = Atot; c[1] = h; }
            __syncthreads();
            continue;
        }
#pragma unroll
        for (int q = 0; q < 16; ++q) {
            const int mb = q >> 2, rg = (q & 3) * 4; float hc = cin[q];
            if (dir == 0) {
#pragma unroll
                for (int e = 0; e < 4; ++e) { hc = accA[mb][rg + e] * hc + accX[mb][rg + e]; accA[mb][rg + e] = hc; }
            } else {
#pragma unroll
                for (int e = 3; e >= 0; --e) { hc = accA[mb][rg + e] * hc + accX[mb][rg + e]; accA[mb][rg + e] = hc; }
            }
        }
        if (dir == 0) {
#pragma unroll
            for (int mb = 0; mb < 4; ++mb)
#pragma unroll
                for (int r = 0; r < 16; ++r) { const int t = mb * 32 + (r & 3) + 8 * (r >> 2) + 4 * hh; HS[t * 128 + nb * 32 + r32] = accA[mb][r]; }
        }
        __syncthreads();
        if (dir == 1) {
#pragma unroll
            for (int mb = 0; mb < 4; ++mb)
#pragma unroll
                for (int r = 0; r < 16; ++r) { const int t = mb * 32 + (r & 3) + 8 * (r >> 2) + 4 * hh; HS[t * 128 + nb * 32 + r32] += accA[mb][r]; }
        }
        __syncthreads();
        {
            const int t = tid >> 2, cs = (tid & 3) * 32, g = row0 + t;
            const bf16_t* gp = GG + (size_t)g * DRNN + hb * 128 + cs; bf16_t* yp = YG + (size_t)g * DRNN + hb * 128 + cs;
#pragma unroll
            for (int c8 = 0; c8 < 32; c8 += 8) {
                const u32x4 gw = *(const u32x4*)(gp + c8);
                const f32x4 h0 = *(const LAS f32x4*)(HS + t * 128 + cs + c8), h1 = *(const LAS f32x4*)(HS + t * 128 + cs + c8 + 4);
                u32x4 o; o.x = pk2(h0.x * bflo(gw.x), h0.y * bfhi(gw.x)); o.y = pk2(h0.z * bflo(gw.y), h0.w * bfhi(gw.y));
                o.z = pk2(h1.x * bflo(gw.z), h1.y * bfhi(gw.z)); o.w = pk2(h1.z * bflo(gw.w), h1.w * bfhi(gw.w));
                *(u32x4*)(yp + c8) = o;
            }
        }
        __syncthreads();
    }
}

namespace pg8 {
constexpr int BM = 256, BK = 64, HALF = 128, HTB = HALF * BK * 2, STAGE_BYTES = 8 * HTB, NXCD = 8, WGM = 8;
__host__ __device__ __forceinline__ int lds_byte(int r, int c) { const int st = (r >> 4) * 2 + (c >> 5), rr = r & 15, cc = c & 31, ob = rr * 64 + cc * 2; return st * 1024 + (ob ^ (((ob >> 9) & 1) << 5)); }
__host__ __device__ __forceinline__ void stage_rc(int b, int& R, int& C) { const int st = b / 1024, sb = b % 1024, swz = sb ^ (((sb >> 9) & 1) << 5); R = (st >> 1) * 16 + swz / 64; C = (st & 1) * 32 + (swz % 64) / 2; }
__host__ __device__ __forceinline__ int perm32(int rho) { const int n = rho >> 4, i = rho & 15; return 8 * (i >> 2) + 4 * n + (i & 3); }
struct Unit { int pm, pn; };
struct Gemm { const bf16_t* A; const bf16_t* Bt; int M, N, K; };
struct StaticOrder {
    int nM, nN, nwg, G, c;
    __host__ __device__ void init(int M, int N, int G_, int c_) { nM = M / BM; nN = N / BM; nwg = nM * nN; G = G_; c = c_; }
    __host__ __device__ bool next(int i, Unit& u) const {
        const long L = (long)i * G + c; if (L >= nwg) return false;
        int wgid = (int)L; { const int q = nwg / NXCD, r = nwg % NXCD, xcd = wgid % NXCD, off = wgid / NXCD; wgid = (xcd < r ? xcd * (q + 1) : r * (q + 1) + (xcd - r) * q) + off; }
        const int nig = WGM * nN, gid = wgid / nig, fm = gid * WGM, gsz = (nM - fm) < WGM ? (nM - fm) : WGM;
        u.pm = fm + ((wgid % nig) % gsz); u.pn = (wgid % nig) / gsz; return true;
    }
    __device__ __forceinline__ void a_ready(const Unit&) const {}
    __device__ __forceinline__ void done(const Unit&) const {}
};
struct LatentOrder {
    StaticOrder S;
    __host__ __device__ void init(int N, int G_, int c_) { S.init(16384, N, G_, c_); }
    __host__ __device__ bool next(int i, Unit& u) const { if (!S.next(i, u)) return false; u.pm = u.pm + 1 + (u.pm >= 32 ? 1 : 0); return true; }
    __device__ __forceinline__ void a_ready(const Unit&) const {}
    __device__ __forceinline__ void done(const Unit&) const {}
};
__device__ __forceinline__ unsigned cvt_pk_bf16(float lo, float hi) { unsigned r; asm volatile("v_cvt_pk_bf16_f32 %0, %1, %2" : "=v"(r) : "v"(lo), "v"(hi)); return r; }
__device__ __forceinline__ u32x4 pack8(const f32x4& v0, const f32x4& v1) { u32x4 w; w.x = cvt_pk_bf16(v0[0], v0[1]); w.y = cvt_pk_bf16(v0[2], v0[3]); w.z = cvt_pk_bf16(v1[0], v1[1]); w.w = cvt_pk_bf16(v1[2], v1[3]); return w; }
__device__ __forceinline__ f32x4 gelu4(const f32x4& v) { f32x4 r; r.x = gelu_t(v.x); r.y = gelu_t(v.y); r.z = gelu_t(v.z); r.w = gelu_t(v.w); return r; }

struct EpiStore {
    static constexpr bool PERM = true, AFTER_DRAIN = false;
    bf16_t* O1; bf16_t* O2; int ld; int split_tile; int gelu_tiles;
    __device__ __forceinline__ void operator()(f32x4 (&acc)[2][2][4][2], const Unit& u, int wr, int wc, int fr, int fq) const {
        const bool second = u.pn >= split_tile; bf16_t* base = second ? O2 : O1; const int pnl = second ? u.pn - split_tile : u.pn; const bool dog = u.pn < gelu_tiles;
        const int rl0 = wr * 64 + fr, cl0 = wc * 32 + 8 * fq;
#pragma unroll
        for (int ai = 0; ai < 2; ++ai)
#pragma unroll
            for (int m = 0; m < 4; ++m) { bf16_t* rowp = base + (size_t)(u.pm * BM + ai * HALF + m * 16 + rl0) * ld + pnl * BM + cl0;
#pragma unroll
                for (int bj = 0; bj < 2; ++bj) { f32x4 v0 = acc[ai][bj][m][0], v1 = acc[ai][bj][m][1]; if (dog) { v0 = gelu4(v0); v1 = gelu4(v1); }
                    *(u32x4*)(rowp + bj * HALF) = pack8(v0, v1); } }
    }
};
struct EpiResid {
    static constexpr bool PERM = true, AFTER_DRAIN = false;
    const float* x; const float* ctx; const float* modbase; float* X1; int base_mode;
    __device__ __forceinline__ void operator()(f32x4 (&acc)[2][2][4][2], const Unit& u, int wr, int wc, int fr, int fq) const {
        const int b = u.pm / 33, tl = u.pm % 33, var = tl == 0 ? 2 : b;
        const float* gate = modbase + (size_t)var * 6144 + u.pn * BM;
        const float* basep = base_mode == 0 ? (tl == 0 ? ctx + (size_t)b * CTXL * D : x + ((size_t)b * SEQ + (size_t)(tl - 1) * 256) * D) : X1 + (size_t)u.pm * BM * D;
        float* outp = X1 + (size_t)u.pm * BM * D;
        const int rl0 = wr * 64 + fr, cl0 = u.pn * BM + wc * 32 + 8 * fq;
        f32x4 gv[2][2];
#pragma unroll
        for (int bj = 0; bj < 2; ++bj)
#pragma unroll
            for (int n = 0; n < 2; ++n) gv[bj][n] = *(const f32x4*)(gate + bj * HALF + wc * 32 + 8 * fq + 4 * n);
#pragma unroll
        for (int ai = 0; ai < 2; ++ai)
#pragma unroll
            for (int m = 0; m < 4; ++m) { const size_t off = (size_t)(ai * HALF + m * 16 + rl0) * D + cl0;
#pragma unroll
                for (int bj = 0; bj < 2; ++bj)
#pragma unroll
                    for (int n = 0; n < 2; ++n) { const f32x4 bs = *(const f32x4*)(basep + off + bj * HALF + 4 * n); *(f32x4*)(outp + off + bj * HALF + 4 * n) = bs + gv[bj][n] * acc[ai][bj][m][n]; } }
    }
};
struct EpiInproj0 {
    static constexpr bool PERM = true, AFTER_DRAIN = false;
    unsigned char* ws; const float* gmg; const float* qg; const float* kg; LAS float* P;
    __device__ __forceinline__ void operator()(f32x4 (&acc)[2][2][4][2], const Unit& u, int wr, int wc, int fr, int fq) const {
        int rl0 = wr * 64 + fr, cl0 = wc * 32 + 8 * fq; asm volatile("" : "+v"(rl0), "+v"(cl0));
        const int pn = u.pn; const size_t grow0 = (size_t)u.pm * BM;
        if (pn < 4) {
#pragma unroll
            for (int ai = 0; ai < 2; ++ai)
#pragma unroll
                for (int bj = 0; bj < 2; ++bj)
#pragma unroll
                    for (int m = 0; m < 4; ++m) { acc[ai][bj][m][0] = gelu4(acc[ai][bj][m][0]); acc[ai][bj][m][1] = gelu4(acc[ai][bj][m][1]); __builtin_amdgcn_sched_barrier(0); }
        }
        if (pn < 2 || pn == 7) {
            bf16_t* base = pn < 2 ? (bf16_t*)(ws + WS_U) + pn * BM : (bf16_t*)(ws + WS_V); const int ld = pn < 2 ? 512 : 256;
#pragma unroll
            for (int ai = 0; ai < 2; ++ai)
#pragma unroll
                for (int m = 0; m < 4; ++m) { bf16_t* rowp = base + (grow0 + ai * HALF + m * 16 + rl0) * ld + cl0;
#pragma unroll
                    for (int bj = 0; bj < 2; ++bj) *(u32x4*)(rowp + bj * HALF) = pack8(acc[ai][bj][m][0], acc[ai][bj][m][1]); }
            return;
        }
#pragma unroll
        for (int ai = 0; ai < 2; ++ai)
#pragma unroll
            for (int m = 0; m < 4; ++m)
#pragma unroll
                for (int bj = 0; bj < 2; ++bj) { const f32x4 a0 = acc[ai][bj][m][0], a1 = acc[ai][bj][m][1];
                    float s = (a0.x * a0.x + a0.y * a0.y) + (a0.z * a0.z + a0.w * a0.w) + (a1.x * a1.x + a1.y * a1.y) + (a1.z * a1.z + a1.w * a1.w);
                    s += __shfl_xor(s, 16); s += __shfl_xor(s, 32);
                    if (fq == 0) P[((ai * HALF + m * 16 + rl0) * 2 + bj) * 4 + wc] = s; __builtin_amdgcn_sched_barrier(0); }
        asm volatile("s_waitcnt lgkmcnt(0)" ::: "memory"); __builtin_amdgcn_s_barrier(); asm volatile("" ::: "memory");
        if (pn < 4) {
            bf16_t* base = (bf16_t*)(ws + WS_VV) + (pn - 2) * BM; const float* gp = gmg + (pn - 2) * BM + cl0;
            f32x4 g8[2][2];
#pragma unroll
            for (int bj = 0; bj < 2; ++bj) { g8[bj][0] = *(const f32x4*)(gp + bj * HALF); g8[bj][1] = *(const f32x4*)(gp + bj * HALF + 4); }
#pragma unroll
            for (int ai = 0; ai < 2; ++ai)
#pragma unroll
                for (int m = 0; m < 4; ++m) { const int rl = ai * HALF + m * 16 + rl0; bf16_t* rowp = base + (grow0 + rl) * 512 + cl0;
#pragma unroll
                    for (int bj = 0; bj < 2; ++bj) { const f32x4 p = *(const LAS f32x4*)(P + (rl * 2 + bj) * 4);
                        const float rinv = rsqrtf(((p.x + p.y) + (p.z + p.w)) * (1.f / 128.f) + EPS);
                        *(u32x4*)(rowp + bj * HALF) = pack8(acc[ai][bj][m][0] * rinv * g8[bj][0], acc[ai][bj][m][1] * rinv * g8[bj][1]); }
                    asm volatile("" ::: "memory"); __builtin_amdgcn_sched_barrier(0); }
            return;
        }
        {
            const bool isq = pn < 6; const float* gn = isq ? qg : kg;
            const int grp = cl0 >> 3, fo = (grp >> 3) * 64 + (grp & 7) * 4;
            const f32x4 gA = *(const f32x4*)(gn + fo), gB = *(const f32x4*)(gn + fo + 32);
            bf16_t* base = isq ? (bf16_t*)(ws + WS_Q) + (pn - 4) * BM : (bf16_t*)(ws + WS_K); const int ld = isq ? 512 : 256;
            const int tl = u.pm % 33; const bool lat = tl != 0; const int ax = grp >> 3, f0 = (grp & 7) * 4;
            const float* rope = (const float*)(ws + WS_ROPE);
#pragma unroll
            for (int ai = 0; ai < 2; ++ai)
#pragma unroll
                for (int m = 0; m < 4; ++m) { const int rl = ai * HALF + m * 16 + rl0; bf16_t* rowp = base + (grow0 + rl) * ld + cl0;
                    f32x4 cs0 = {1.f, 0.f, 1.f, 0.f}, cs1 = {1.f, 0.f, 1.f, 0.f};
                    if (lat) { const int t = (tl - 1) * 256 + rl; const int pos = ax == 0 ? (t >> 6) : (t & 63); const float* rp = rope + (pos * 32 + f0) * 2; cs0 = *(const f32x4*)rp; cs1 = *(const f32x4*)(rp + 4); }
#pragma unroll
                    for (int bj = 0; bj < 2; ++bj) { const f32x4 p = *(const LAS f32x4*)(P + (rl * 2 + bj) * 4);
                        const float rinv = rsqrtf(((p.x + p.y) + (p.z + p.w)) * (1.f / 128.f) + EPS);
                        const f32x4 x1 = acc[ai][bj][m][0] * rinv * gA, x2 = acc[ai][bj][m][1] * rinv * gB;
                        f32x4 o1, o2;
                        o1.x = x1.x * cs0.x - x2.x * cs0.y; o2.x = x2.x * cs0.x + x1.x * cs0.y;
                        o1.y = x1.y * cs0.z - x2.y * cs0.w; o2.y = x2.y * cs0.z + x1.y * cs0.w;
                        o1.z = x1.z * cs1.x - x2.z * cs1.y; o2.z = x2.z * cs1.x + x1.z * cs1.y;
                        o1.w = x1.w * cs1.z - x2.w * cs1.w; o2.w = x2.w * cs1.z + x1.w * cs1.w;
                        *(u32x4*)(rowp + bj * HALF) = pack8(o1, o2); }
                    asm volatile("" ::: "memory"); __builtin_amdgcn_sched_barrier(0); }
        }
    }
};

template <class Epi, class Sched, bool ALIGN_EPI = false, bool SP2 = false>
__device__ __forceinline__ void gemm_phase(LAS unsigned char* lds, const Gemm g, const Sched& S, const Epi& E) {
    const int tid = threadIdx.x, wid = __builtin_amdgcn_readfirstlane(tid >> 6), lane = tid & 63, wr = wid >> 2, wc = wid & 3, fr = lane & 15, fq = lane >> 4;
    const int K = g.K, nt = K / BK;
    unsigned voffA[2], voffB[2];
#pragma unroll
    for (int i = 0; i < 2; ++i) { int R, C; stage_rc(tid * 16 + i * 8192, R, C); const int Rb = Epi::PERM ? ((R & ~31) + perm32(R & 31)) : R;
        voffA[i] = (unsigned)(R * K + C) * 2u; voffB[i] = (unsigned)(Rb * K + C) * 2u; }
    const size_t kstep = (size_t)(BK * 2);
    const size_t hstep = (size_t)HALF * K * 2;
    const size_t tstep = 2 * hstep;
    const unsigned ldsw = (unsigned)wid * 1024u;
    const int aoff = lds_byte(wr * 64 + fr, fq * 8), boff = lds_byte(wc * 32 + fr, fq * 8);
#define PG8_SA(b, h) (((b) * 2 + (h)) * HTB)
#define PG8_SB(b, h) ((4 + (b) * 2 + (h)) * HTB)
#define PG8_STAGE(bufoff, gbase, voff) do { _Pragma("unroll") for (int _i = 0; _i < 2; ++_i) \
        __builtin_amdgcn_global_load_lds((const unsigned*)((const char*)(gbase) + (voff)[_i]), (LAS unsigned*)(lds + (bufoff) + ldsw + _i * 8192), 16, 0, 0); } while (0)
#define PG8_LDA(dst, b, h) do { _Pragma("unroll") for (int m = 0; m < 4; ++m) _Pragma("unroll") for (int k = 0; k < 2; ++k) dst[m][k] = *(const LAS bf16x8*)(lds + PG8_SA(b, h) + aoff + m * 2048 + k * 1024); } while (0)
#define PG8_LDB(dst, b, h) do { _Pragma("unroll") for (int n = 0; n < 2; ++n) _Pragma("unroll") for (int k = 0; k < 2; ++k) dst[n][k] = *(const LAS bf16x8*)(lds + PG8_SB(b, h) + boff + n * 2048 + k * 1024); } while (0)
#define PG8_MMA(ai, bj, At, Bt) do { __builtin_amdgcn_s_setprio(1); _Pragma("unroll") for (int m = 0; m < 4; ++m) _Pragma("unroll") for (int n = 0; n < 2; ++n) _Pragma("unroll") for (int k = 0; k < 2; ++k) \
        acc[ai][bj][m][n] = __builtin_amdgcn_mfma_f32_16x16x32_bf16(Bt[n][k], At[m][k], acc[ai][bj][m][n], 0, 0, 0); __builtin_amdgcn_s_setprio(0); } while (0)
#define PG8_WAIT_V(n) asm volatile("s_waitcnt vmcnt(" #n ")" ::: "memory")
#define PG8_WAIT_L(n) asm volatile("s_waitcnt lgkmcnt(" #n ")" ::: "memory")
#define PG8_BAR __builtin_amdgcn_s_barrier()
#define PG8_SCHED __builtin_amdgcn_sched_barrier(0)
    Unit cur, nxt; int ui = 0;
    if (!S.next(0, cur)) return;
    f32x4 acc[2][2][4][2];
#pragma unroll
    for (int a = 0; a < 2; ++a)
#pragma unroll
        for (int b = 0; b < 2; ++b)
#pragma unroll
            for (int m = 0; m < 4; ++m)
#pragma unroll
                for (int n = 0; n < 2; ++n) acc[a][b][m][n] = (f32x4){0.f, 0.f, 0.f, 0.f};
    bf16x8 At[4][2], B0[2][2], B1[2][2];
    const char* cA = (const char*)g.A + (size_t)cur.pm * tstep; const char* cB = (const char*)g.Bt + (size_t)cur.pn * tstep;
    S.a_ready(cur);
    if constexpr (SP2) {
        PG8_STAGE(PG8_SB(0, 0), cB, voffB); PG8_STAGE(PG8_SB(0, 1), cB + hstep, voffB); PG8_STAGE(PG8_SA(0, 0), cA, voffA); PG8_STAGE(PG8_SA(0, 1), cA + hstep, voffA);
        if (wr == 1) PG8_BAR;
        PG8_WAIT_V(2); PG8_BAR;
        PG8_STAGE(PG8_SB(1, 0), cB + kstep, voffB); PG8_STAGE(PG8_SA(1, 0), cA + kstep, voffA); PG8_STAGE(PG8_SB(1, 1), cB + hstep + kstep, voffB);
        PG8_WAIT_V(6); PG8_BAR;
    } else {
        PG8_STAGE(PG8_SB(0, 0), cB, voffB); PG8_STAGE(PG8_SA(0, 0), cA, voffA); PG8_STAGE(PG8_SB(0, 1), cB + hstep, voffB); PG8_STAGE(PG8_SA(0, 1), cA + hstep, voffA);
        if (wr == 1) PG8_BAR;
        PG8_WAIT_V(4); PG8_BAR;
        PG8_STAGE(PG8_SB(1, 0), cB + kstep, voffB); PG8_STAGE(PG8_SA(1, 0), cA + kstep, voffA); PG8_STAGE(PG8_SB(1, 1), cB + hstep + kstep, voffB);
        PG8_WAIT_V(6); PG8_BAR;
    }
    for (;;) {
        const bool has_next = S.next(ui + 1, nxt);
        const char* nA = has_next ? (const char*)g.A + (size_t)nxt.pm * tstep : cA; const char* nB = has_next ? (const char*)g.Bt + (size_t)nxt.pn * tstep : cB;
        for (int t = 0; t < nt; t += 2) {
            const bool last = (t == nt - 2);
            const char* a1 = cA + (size_t)(t + 1) * kstep;
            const char* a2 = last ? nA : cA + (size_t)(t + 2) * kstep; const char* b2 = last ? nB : cB + (size_t)(t + 2) * kstep;
            const char* a3 = a2 + kstep; const char* b3 = b2 + kstep;
            if (last && has_next) S.a_ready(nxt);
            if constexpr (SP2) {
            PG8_LDB(B0, 0, 0); PG8_LDB(B1, 0, 1); PG8_SCHED; PG8_LDA(At, 0, 0); PG8_STAGE(PG8_SA(1, 1), a1 + hstep, voffA);
            PG8_WAIT_V(8); PG8_WAIT_L(0); PG8_BAR; PG8_MMA(0, 0, At, B0); PG8_MMA(0, 1, At, B1); PG8_BAR; PG8_SCHED;
            PG8_LDA(At, 0, 1); PG8_STAGE(PG8_SB(0, 0), b2, voffB); PG8_STAGE(PG8_SB(0, 1), b2 + hstep, voffB); PG8_STAGE(PG8_SA(0, 0), a2, voffA);
            PG8_WAIT_V(8); PG8_WAIT_L(0); PG8_BAR; PG8_MMA(1, 0, At, B0); PG8_MMA(1, 1, At, B1); PG8_BAR; PG8_SCHED;
            PG8_LDB(B0, 1, 0); PG8_LDB(B1, 1, 1); PG8_SCHED; PG8_LDA(At, 1, 0); PG8_STAGE(PG8_SA(0, 1), a2 + hstep, voffA);
            PG8_WAIT_V(8); PG8_WAIT_L(0); PG8_BAR; PG8_MMA(0, 0, At, B0); PG8_MMA(0, 1, At, B1); PG8_BAR; PG8_SCHED;
            PG8_LDA(At, 1, 1); PG8_STAGE(PG8_SB(1, 0), b3, voffB); PG8_STAGE(PG8_SB(1, 1), b3 + hstep, voffB); PG8_STAGE(PG8_SA(1, 0), a3, voffA);
            PG8_WAIT_V(8); PG8_WAIT_L(0); PG8_BAR; PG8_MMA(1, 0, At, B0); PG8_MMA(1, 1, At, B1); PG8_BAR; PG8_SCHED;
            } else {
            PG8_LDB(B0, 0, 0); PG8_SCHED; PG8_LDA(At, 0, 0); PG8_STAGE(PG8_SA(1, 1), a1 + hstep, voffA);
            PG8_WAIT_L(8); PG8_BAR; PG8_WAIT_L(0); PG8_MMA(0, 0, At, B0); PG8_BAR; PG8_SCHED;
            PG8_LDB(B1, 0, 1); PG8_STAGE(PG8_SB(0, 0), b2, voffB);
            PG8_BAR; PG8_WAIT_L(0); PG8_MMA(0, 1, At, B1); PG8_BAR;
            PG8_LDA(At, 0, 1); PG8_STAGE(PG8_SA(0, 0), a2, voffA);
            PG8_BAR; PG8_WAIT_L(0); PG8_MMA(1, 0, At, B0); PG8_BAR; PG8_SCHED;
            PG8_STAGE(PG8_SB(0, 1), b2 + hstep, voffB);
            PG8_WAIT_V(6); PG8_BAR; PG8_MMA(1, 1, At, B1); PG8_BAR;
            PG8_LDB(B0, 1, 0); PG8_SCHED; PG8_LDA(At, 1, 0); PG8_STAGE(PG8_SA(0, 1), a2 + hstep, voffA);
            PG8_WAIT_L(8); PG8_BAR; PG8_WAIT_L(0); PG8_MMA(0, 0, At, B0); PG8_BAR; PG8_SCHED;
            PG8_LDB(B1, 1, 1); PG8_STAGE(PG8_SB(1, 0), b3, voffB);
            PG8_BAR; PG8_WAIT_L(0); PG8_MMA(0, 1, At, B1); PG8_BAR;
            PG8_LDA(At, 1, 1); PG8_STAGE(PG8_SA(1, 0), a3, voffA);
            PG8_BAR; PG8_WAIT_L(0); PG8_MMA(1, 0, At, B0); PG8_BAR; PG8_SCHED;
            PG8_STAGE(PG8_SB(1, 1), b3 + hstep, voffB);
            PG8_WAIT_V(6); PG8_BAR; PG8_MMA(1, 1, At, B1); PG8_BAR;
            }
        }
        if constexpr (ALIGN_EPI) { if (wr == 0) PG8_BAR; }
        if constexpr (!Epi::AFTER_DRAIN) { E(acc, cur, wr, wc, fr, fq); S.done(cur); }
        if (!has_next) break;
#pragma unroll
        for (int a = 0; a < 2; ++a)
#pragma unroll
            for (int b = 0; b < 2; ++b)
#pragma unroll
                for (int m = 0; m < 4; ++m)
#pragma unroll
                    for (int n = 0; n < 2; ++n) acc[a][b][m][n] = (f32x4){0.f, 0.f, 0.f, 0.f};
        cur = nxt; cA = nA; cB = nB; ++ui;
        if constexpr (ALIGN_EPI) { if (wr == 1) PG8_BAR; }
    }
    PG8_WAIT_V(0);
    if constexpr (!ALIGN_EPI) { if (wr == 0) PG8_BAR; }
    PG8_BAR;
#undef PG8_SA
#undef PG8_SB
#undef PG8_STAGE
#undef PG8_LDA
#undef PG8_LDB
#undef PG8_MMA
#undef PG8_WAIT_V
#undef PG8_WAIT_L
#undef PG8_BAR
#undef PG8_SCHED
}
}

__device__ __forceinline__ void fphase_inproj0(const Args& a, char* lds) {
    pg8::Gemm g{(const bf16_t*)(a.ws + WS_H), (const bf16_t*)(a.ws + WS_WIN0), MTOT, 2048, 1024};
    pg8::StaticOrder S; S.init(MTOT, 2048, (int)gridDim.x, (int)blockIdx.x);
    pg8::EpiInproj0 E{a.ws, a.in[9], a.in[12], a.in[13], (LAS float*)((LAS char*)lds + 131072)};
    pg8::gemm_phase<pg8::EpiInproj0, pg8::StaticOrder, true, true>((LAS unsigned char*)lds, g, S, E);
}
__device__ __forceinline__ void fphase_outproj0(const Args& a, char* lds) {
    pg8::Gemm g{(const bf16_t*)(a.ws + WS_AO), (const bf16_t*)(a.ws + WS_WOUT0), MTOT, 1024, 1024};
    pg8::StaticOrder S; S.init(MTOT, 1024, (int)gridDim.x, (int)blockIdx.x);
    pg8::EpiResid E{a.in[0], a.in[2], (const float*)(a.ws + WS_MODV) + 2 * 1024, (float*)(a.ws + WS_X1), 0};
    pg8::gemm_phase<pg8::EpiResid, pg8::StaticOrder, true, true>((LAS unsigned char*)lds, g, S, E);
}
__device__ __forceinline__ void fphase_peerq0(const Args& a, char* lds) {
    pg8::Gemm g{(const bf16_t*)(a.ws + WS_H), (const bf16_t*)(a.ws + WS_WQ), MTOT, 2048, 1024};
    pg8::StaticOrder S; S.init(MTOT, 2048, (int)gridDim.x, (int)blockIdx.x);
    pg8::EpiStore E{(bf16_t*)(a.ws + WS_QP), (bf16_t*)(a.ws + WS_QP), 2048, 1000, 0};
    pg8::gemm_phase<pg8::EpiStore, pg8::StaticOrder, true, true>((LAS unsigned char*)lds, g, S, E);
}
__device__ __forceinline__ void fphase_inproj1(const Args& a, char* lds) {
    pg8::Gemm g{(const bf16_t*)(a.ws + WS_H), (const bf16_t*)(a.ws + WS_WIN1), MTOT, 2560, 1024};
    pg8::StaticOrder S; S.init(MTOT, 2560, (int)gridDim.x, (int)blockIdx.x);
    pg8::EpiStore E{(bf16_t*)(a.ws + WS_GG), (bf16_t*)(a.ws + WS_XR), 1280, 5, 5};
    pg8::gemm_phase<pg8::EpiStore, pg8::StaticOrder, true, true>((LAS unsigned char*)lds, g, S, E);
}
__device__ __forceinline__ void fphase_outproj1(const Args& a, char* lds) {
    pg8::Gemm g{(const bf16_t*)(a.ws + WS_YG), (const bf16_t*)(a.ws + WS_WOUT1), MTOT, 1024, 1280};
    pg8::LatentOrder S; S.init(1024, (int)gridDim.x, (int)blockIdx.x);
    pg8::EpiResid E{a.in[0], a.in[2], (const float*)(a.ws + WS_MODV) + 3 * 6144 + 2 * 1024, (float*)(a.ws + WS_X1), 1};
    pg8::gemm_phase<pg8::EpiResid, pg8::LatentOrder, true, true>((LAS unsigned char*)lds, g, S, E);
}
__device__ __forceinline__ void fphase_peerq1(const Args& a, char* lds) {
    pg8::Gemm g{(const bf16_t*)(a.ws + WS_H), (const bf16_t*)(a.ws + WS_WQ) + (size_t)2048 * 1024, MTOT, 2048, 1024};
    pg8::LatentOrder S; S.init(2048, (int)gridDim.x, (int)blockIdx.x);
    pg8::EpiStore E{(bf16_t*)(a.ws + WS_QP), (bf16_t*)(a.ws + WS_QP), 2048, 1000, 0};
    pg8::gemm_phase<pg8::EpiStore, pg8::LatentOrder, true, true>((LAS unsigned char*)lds, g, S, E);
}

constexpr int NPHASE = 17;
__global__ void __launch_bounds__(NTHR, 2) mega(Args a) {
    extern __shared__ __attribute__((aligned(16))) char lds[];
    volatile LAS unsigned* MISC = (volatile LAS unsigned*)((LAS char*)lds + LDS_MISC);
    if (threadIdx.x < 64) MISC[threadIdx.x] = 0u;
    __syncthreads();
    XcdBarrier bar; bar.bar = (unsigned*)(a.ws + WS_CTL) + 4096; bar.x = 0; bar.st = nullptr;
    const bool multi = (a.ph_hi - a.ph_lo) > 1;
    if (multi) bar = xcd_barrier_post((unsigned*)(a.ws + WS_CTL) + 4096, MISC + 8);
    const int lo = a.ph_lo, hi = a.ph_hi;
    unsigned char* ws = a.ws;
#define IN(k) (lo <= (k) && (k) < hi)
#define SEAM(k) do { if (IN(k) && IN((k) + 1)) xcd_barrier(bar); } while (0)
    if (IN(0)) { phase_prep(a, lds); } SEAM(0);
    if (IN(1)) { phase_norm(a, 0, 0, a.in[6], 0, 1, false); } SEAM(1);
    if (IN(2)) { fphase_inproj0(a, lds); } SEAM(2);
    if (IN(3)) { phase_gmlp(a, lds); phase_attn(a, lds); } SEAM(3);
    if (IN(4)) { fphase_outproj0(a, lds); } SEAM(4);
    if (IN(5)) { phase_norm(a, 0, 1, a.in[7], 3, 4, false); } SEAM(5);
    if (IN(6)) { fphase_peerq0(a, lds); } SEAM(6);
    if (IN(7)) { phase_peer_topk2(a, 0, false); } SEAM(7);
    if (IN(8)) { phase_peer_gather3(a, lds, 0, 0); } SEAM(8);
    if (IN(9)) { fphase_inproj1(a, lds); } SEAM(9);
    if (IN(10)) { phase_rglru2(a, lds, 0); } SEAM(10);
    if (IN(11)) { phase_rglru2(a, lds, 1); } SEAM(11);
    if (IN(12)) { fphase_outproj1(a, lds); } SEAM(12);
    if (IN(13)) { phase_norm(a, 1, 1, a.in[7] + D, 3, 4, true); } SEAM(13);
    if (IN(14)) { fphase_peerq1(a, lds); } SEAM(14);
    if (IN(15)) { phase_peer_topk2(a, 1, true); } SEAM(15);
    if (IN(16)) { phase_peer_gather3(a, lds, 1, 1); }
#undef IN
#undef SEAM
}

extern "C" void kernel_launch(void* const* d_in, const int* in_sizes, int n_in, void* d_out, int out_size, void* d_ws, size_t ws_size, hipStream_t stream) {
    static int grid = 0;
    if (grid == 0) {
        if (n_in != 29 || out_size != NB * SEQ * D || ws_size < WS_END) {
            fprintf(stderr, "kernel_launch: unexpected shapes: n_in %d out %d ws %zu (need %zu)\n", n_in, out_size, ws_size, (size_t)WS_END); grid = -1; return; }
        int dev = 0, cus = 0, per_cu = 0;
        if (hipGetDevice(&dev) != hipSuccess || hipDeviceGetAttribute(&cus, hipDeviceAttributeMultiprocessorCount, dev) != hipSuccess) { grid = -1; return; }
        if (hipFuncSetAttribute((const void*)mega, hipFuncAttributeMaxDynamicSharedMemorySize, LDS_BYTES) != hipSuccess) { fprintf(stderr, "kernel_launch: hipFuncSetAttribute failed\n"); grid = -1; return; }
        if (hipOccupancyMaxActiveBlocksPerMultiprocessor(&per_cu, (const void*)mega, NTHR, LDS_BYTES) != hipSuccess || per_cu < 1)
            fprintf(stderr, "kernel_launch: occupancy query reports %d blocks per CU\n", per_cu);
        (void)hipGetLastError();
        grid = cus;
    }
    if (grid < 0) return;
    (void)hipMemsetAsync((char*)d_ws + WS_CTL, 0, CTL_BYTES, stream);
    Args a{};
    for (int i = 0; i < 29; ++i) a.in[i] = (const float*)d_in[i];
    a.out = (float*)d_out; a.ws = (unsigned char*)d_ws;
#if MK_SINGLE
    a.ph_lo = 0; a.ph_hi = NPHASE;
    hipLaunchKernelGGL(mega, dim3(grid), dim3(NTHR), LDS_BYTES, stream, a);
#else
    for (int p = 0; p < NPHASE; ++p) { a.ph_lo = p; a.ph_hi = p + 1; hipLaunchKernelGGL(mega, dim3(grid), dim3(NTHR), LDS_BYTES, stream, a); }
#endif
    const hipError_t le = hipPeekAtLastError();
    if (le != hipSuccess) fprintf(stderr, "kernel_launch: launch failed: %s\n", hipGetErrorName(le));
}
```

```cpp
#include <hip/hip_runtime.h>
#include <cstdio>
#include <cstdint>

#ifndef MK_SINGLE
#define MK_SINGLE 1
#endif

#define GAS __attribute__((address_space(1)))
#define LAS __attribute__((address_space(3)))

typedef unsigned short bf16_t;
typedef short bf16x8 __attribute__((ext_vector_type(8)));
typedef float f32x4 __attribute__((ext_vector_type(4)));
typedef float f32x16 __attribute__((ext_vector_type(16)));
typedef unsigned u32x4 __attribute__((ext_vector_type(4)));
typedef unsigned u32x2 __attribute__((ext_vector_type(2)));

constexpr int D = 1024, NB = 2, SEQ = 8192, CTXL = 256;
constexpr int RPB = SEQ + CTXL;
constexpr int MTOT = NB * RPB;
constexpr int AB_IN = 2048, A_W = 512, DRNN = 1280, NEXP = 16384;
constexpr float EPS = 1e-6f;
constexpr int NTHR = 512, NWAVE = 8;

constexpr size_t MiB = 1u << 20;
constexpr size_t WS_CTL = 0, CTL_BYTES = 1 * MiB;
constexpr size_t WS_MODV = 1 * MiB;
constexpr size_t WS_ROPE = 1 * MiB + 512 * 1024;
constexpr size_t WS_WIN0 = 2 * MiB;
constexpr size_t WS_WOUT0 = 6 * MiB;
constexpr size_t WS_WIN1 = 8 * MiB;
constexpr size_t WS_WOUT1 = 13 * MiB;
constexpr size_t WS_WQ = 16 * MiB;
constexpr size_t WS_KEYS = 24 * MiB;
constexpr size_t WS_GWS = 25 * MiB;
constexpr size_t WS_WAT = 26 * MiB;
constexpr size_t WS_WXT = 27 * MiB;
constexpr size_t WS_CARRY = 28 * MiB;
constexpr size_t WS_SCU = 31 * MiB;
constexpr size_t WS_SCV = 31 * MiB + 512 * 1024;
constexpr size_t WS_PU = 32 * MiB;
constexpr size_t WS_PV = 96 * MiB;
constexpr size_t WS_H = 160 * MiB;
constexpr size_t WS_X1 = 193 * MiB;
constexpr size_t WS_SELI = 259 * MiB;
constexpr size_t WS_SELG = 268 * MiB;
constexpr size_t WS_R = 277 * MiB;
constexpr size_t WS_U = WS_R;
constexpr size_t WS_VV = WS_R + 17 * MiB;
constexpr size_t WS_Q = WS_R + 34 * MiB;
constexpr size_t WS_K = WS_R + 51 * MiB;
constexpr size_t WS_V = WS_R + 60 * MiB;
constexpr size_t WS_AO = WS_R + 69 * MiB;
constexpr size_t WS_QP = WS_R;
constexpr size_t WS_H8 = WS_R + 70 * MiB;
constexpr size_t WS_SH = WS_R + 88 * MiB;
constexpr size_t WS_ACT16 = WS_R + 89 * MiB;
constexpr size_t WS_SA = WS_R + 94 * MiB;
constexpr size_t WS_PART = WS_R;
constexpr size_t WS_GG = WS_R;
constexpr size_t WS_XR = WS_R + 42 * MiB;
constexpr size_t WS_YG = WS_R + 84 * MiB;
constexpr size_t WS_END = WS_R + 126 * MiB;

constexpr int LDS_BYTES = 147456;
constexpr int LDS_MISC = 145408;

__device__ __forceinline__ float bf2f(bf16_t v) { return __uint_as_float(((unsigned)v) << 16); }
__device__ __forceinline__ unsigned f2bf(float f) { unsigned u = __float_as_uint(f); return (u + 0x7fffu + ((u >> 16) & 1u)) >> 16; }
__device__ __forceinline__ unsigned pk2(float lo, float hi) { return f2bf(lo) | (f2bf(hi) << 16); }
__device__ __forceinline__ float bflo(unsigned w) { return __uint_as_float(w << 16); }
__device__ __forceinline__ float bfhi(unsigned w) { return __uint_as_float(w & 0xffff0000u); }
__device__ __forceinline__ float gelu_t(float x) { const float y = -2.302208198144325f * (x + 0.044715f * x * x * x); return x * __builtin_amdgcn_rcpf(1.f + __builtin_amdgcn_exp2f(y)); }
__device__ __forceinline__ float sigmoidf_(float x) { return 1.f / (1.f + __expf(-x)); }
__device__ __forceinline__ float wave_sum(float v) {
#pragma unroll
    for (int o = 1; o < 64; o <<= 1) v += __shfl_xor(v, o);
    return v;
}
__host__ __device__ __forceinline__ int sigma_head(int j) { const int grp = j >> 3, n = (j >> 2) & 1, e = j & 3; return (grp >> 3) * 64 + n * 32 + (grp & 7) * 4 + e; }

struct Args {
    const float* in[29];
    float* out;
    unsigned char* ws;
    int ph_lo, ph_hi;
};

__device__ __forceinline__ int row_variant(int g) { const int b = g / RPB, i = g - b * RPB; return i < CTXL ? 2 : b; }
__device__ __forceinline__ const float* row_src(const Args& a, int g) {
    const int b = g / RPB, i = g - b * RPB;
    return i < CTXL ? a.in[2] + ((size_t)b * CTXL + i) * D : a.in[0] + ((size_t)b * SEQ + (i - CTXL)) * D;
}
__device__ __forceinline__ const float* modv(const Args& a, int layer, int variant, int which) {
    return (const float*)(a.ws + WS_MODV) + ((size_t)(layer * 3 + variant) * 6 + which) * D;
}

#define XB_TMO      128
#define XB_XCNT(j)  (256  + 64 * (j))
#define XB_XSUB(j)  (1280 + 64 * (j))
#define XB_XGEN(j)  (2304 + 64 * (j))
#define XB_TOP      3328
#define XB_TOPGEN   3392
#define XCD_BAR_WORDS 3456
#define XB_SPIN_CAP (1u << 22)
__device__ __forceinline__ unsigned xb_ld(unsigned* p)              { return __hip_atomic_load(p, __ATOMIC_RELAXED, __HIP_MEMORY_SCOPE_AGENT); }
__device__ __forceinline__ unsigned xb_add(unsigned* p, unsigned v) { return __hip_atomic_fetch_add(p, v, __ATOMIC_RELAXED, __HIP_MEMORY_SCOPE_AGENT); }
__device__ __forceinline__ unsigned xb_xcc_id() { return (unsigned)__builtin_amdgcn_s_getreg((3 << 11) | 20) & 0xFu; }
#define XB_SPIN(cond, bar) do { unsigned _sp = 0; while (cond) { __builtin_amdgcn_s_sleep(1); \
    if ((++_sp & 255u) == 0u) { if (xb_ld(&(bar)[XB_TMO])) break; if (_sp > XB_SPIN_CAP) { atomicAdd(&(bar)[XB_TMO], 1u); break; } } } } while (0)
struct XcdBarrier { unsigned* bar; unsigned x; volatile LAS unsigned* st; };
__device__ __forceinline__ XcdBarrier xcd_barrier_post(unsigned* bar, volatile LAS unsigned* st) {
    XcdBarrier b; b.bar = bar; b.x = xb_xcc_id(); b.st = st;
    if (threadIdx.x == 0) (void)xb_add(&bar[XB_XCNT(b.x)], 1u);
    return b;
}
__device__ __forceinline__ void xcd_barrier_complete(unsigned* bar, unsigned x, unsigned& nloc, unsigned& nx) {
    const unsigned G = gridDim.x * gridDim.y * gridDim.z;
    unsigned sum, cnt, mine, sp = 0u;
    for (;;) {
        sum = 0u; cnt = 0u; mine = 0u;
#pragma unroll
        for (unsigned j = 0; j < 16; ++j) { const unsigned c = xb_ld(&bar[XB_XCNT(j)]); sum += c; cnt += (c > 0u) ? 1u : 0u; mine = (j == x) ? c : mine; }
        if (sum == G) break;
        __builtin_amdgcn_s_sleep(1);
        if ((++sp & 255u) == 0u) { if (xb_ld(&bar[XB_TMO])) break; if (sp > XB_SPIN_CAP) { atomicAdd(&bar[XB_TMO], 1u); break; } }
    }
    nloc = mine > 0u ? mine : 1u; nx = cnt > 0u ? cnt : 1u;
}
__device__ __forceinline__ void xcd_barrier(const XcdBarrier& b) {
    asm volatile("s_waitcnt vmcnt(0)" ::: "memory");
    __syncthreads();
    if (threadIdx.x == 0) {
        unsigned* bar = b.bar;
        __builtin_amdgcn_s_waitcnt(0);
        unsigned nloc = b.st[0], nx = b.st[1];
        if (nloc == 0u) { xcd_barrier_complete(bar, b.x, nloc, nx); b.st[0] = nloc; b.st[1] = nx; }
        const unsigned old = xb_add(&bar[XB_XSUB(b.x)], 1u);
        const unsigned gen = old / nloc;
        if (old + 1u == (gen + 1u) * nloc) {
            __builtin_amdgcn_fence(__ATOMIC_RELEASE, "agent");
            asm volatile("s_waitcnt vmcnt(0)" ::: "memory");
            const unsigned og = xb_add(&bar[XB_TOP], 1u);
            const unsigned tg = og / nx;
            if (og + 1u == (tg + 1u) * nx) xb_add(&bar[XB_TOPGEN], 1u);
            else XB_SPIN(xb_ld(&bar[XB_TOPGEN]) == tg, bar);
            __builtin_amdgcn_fence(__ATOMIC_ACQUIRE, "agent");
            xb_add(&bar[XB_XGEN(b.x)], 1u);
            asm volatile("s_waitcnt vmcnt(0)" ::: "memory");
        } else {
            XB_SPIN(xb_ld(&bar[XB_XGEN(b.x)]) == gen, bar);
            __builtin_amdgcn_fence(__ATOMIC_ACQUIRE, "agent");
            asm volatile("s_waitcnt vmcnt(0)" ::: "memory");
        }
    }
    __syncthreads();
}

__device__ __forceinline__ void transpose_item(const float* src, int Ns, bf16_t* dst, int Kd, int n0, int k0, int perm_lo, int perm_hi, float* tile) {
    const int tid = threadIdx.x;
    {
        const int nn = tid & 63; int n = n0 + nn;
        if (n >= perm_lo && n < perm_hi) { const int rel = n - perm_lo; n = perm_lo + (rel & ~127) + sigma_head(rel & 127); }
#pragma unroll
        for (int i = 0; i < 8; ++i) { const int kk = (tid >> 6) + 8 * i; tile[kk * 65 + nn] = src[(size_t)(k0 + kk) * Ns + n]; }
    }
    __syncthreads();
    {
        const int n = tid >> 3, kc = (tid & 7) * 8;
        u32x4 o;
        o.x = pk2(tile[(kc + 0) * 65 + n], tile[(kc + 1) * 65 + n]); o.y = pk2(tile[(kc + 2) * 65 + n], tile[(kc + 3) * 65 + n]);
        o.z = pk2(tile[(kc + 4) * 65 + n], tile[(kc + 5) * 65 + n]); o.w = pk2(tile[(kc + 6) * 65 + n], tile[(kc + 7) * 65 + n]);
        *(u32x4*)(dst + (size_t)(n0 + n) * Kd + k0 + kc) = o;
    }
    __syncthreads();
}
__device__ __forceinline__ void cvt_stream(const float* src, bf16_t* dst, size_t n8, size_t gtid, size_t gthreads) {
    for (size_t i = gtid; i < n8; i += gthreads) {
        const f32x4 a = *(const f32x4*)(src + i * 8), b = *(const f32x4*)(src + i * 8 + 4);
        u32x4 o; o.x = pk2(a.x, a.y); o.y = pk2(a.z, a.w); o.z = pk2(b.x, b.y); o.w = pk2(b.z, b.w);
        *(u32x4*)(dst + i * 8) = o;
    }
}
__device__ __forceinline__ void phase_prep(const Args& a, char* lds) {
    const int tid = threadIdx.x, lane = tid & 63, wid = tid >> 6;
    float* tile = (float*)lds;
    unsigned char* ws = a.ws;
    constexpr int I_MOD = 192;
    constexpr int I_WIN0 = (1024 / 64) * (2048 / 64), I_WOUT0 = (1024 / 64) * (1024 / 64), I_WIN1 = (1024 / 64) * (2560 / 64), I_WOUT1 = (1280 / 64) * (1024 / 64);
    constexpr int I_WQ = 2 * (1024 / 64) * (2048 / 64), I_WAX = 40 * 4;
    constexpr int NIT = I_MOD + I_WIN0 + I_WOUT0 + I_WIN1 + I_WOUT1 + I_WQ + I_WAX;
    for (int it = blockIdx.x; it < NIT; it += gridDim.x) {
        int r = it;
        if (r < I_MOD) {
            const int l = r / 96, n0 = (r % 96) * 64;
            const float* W = a.in[4] + (size_t)l * D * 6144;
            float s0 = 0.f, s1 = 0.f, s2 = 0.f;
            for (int k = wid * 128; k < wid * 128 + 128; ++k) {
                const float w = W[(size_t)k * 6144 + n0 + lane];
                const float c0 = a.in[1][k], c1 = a.in[1][D + k], c2 = a.in[3][k];
                s0 += c0 * sigmoidf_(c0) * w; s1 += c1 * sigmoidf_(c1) * w; s2 += c2 * sigmoidf_(c2) * w;
            }
            tile[(wid * 3 + 0) * 64 + lane] = s0; tile[(wid * 3 + 1) * 64 + lane] = s1; tile[(wid * 3 + 2) * 64 + lane] = s2;
            __syncthreads();
            if (tid < 192) {
                const int v = tid / 64, ln = tid & 63; float s = a.in[5][(size_t)l * 6144 + n0 + ln];
                for (int w = 0; w < 8; ++w) s += tile[(w * 3 + v) * 64 + ln];
                ((float*)(ws + WS_MODV))[(size_t)(l * 3 + v) * 6144 + n0 + ln] = s;
            }
            __syncthreads();
            continue;
        }
        r -= I_MOD;
        if (r < I_WIN0) { const int nb = r % 32, kb = r / 32; transpose_item(a.in[8], 2048, (bf16_t*)(ws + WS_WIN0), 1024, nb * 64, kb * 64, 1024, 1792, tile); continue; }
        r -= I_WIN0;
        if (r < I_WOUT0) { const int nb = r % 16, kb = r / 16; transpose_item(a.in[14], 1024, (bf16_t*)(ws + WS_WOUT0), 1024, nb * 64, kb * 64, 0, 0, tile); continue; }
        r -= I_WOUT0;
        if (r < I_WIN1) { const int nb = r % 40, kb = r / 40; transpose_item(a.in[15], 2560, (bf16_t*)(ws + WS_WIN1), 1024, nb * 64, kb * 64, 0, 0, tile); continue; }
        r -= I_WIN1;
        if (r < I_WOUT1) { const int nb = r % 16, kb = r / 16; transpose_item(a.in[23], 1024, (bf16_t*)(ws + WS_WOUT1), 1280, nb * 64, kb * 64, 0, 0, tile); continue; }
        r -= I_WOUT1;
        if (r < I_WQ) { const int l = r / 512, q = r % 512, nb = q % 32, kb = q / 32;
            transpose_item(a.in[24] + (size_t)l * 1024 * 2048, 2048, (bf16_t*)(ws + WS_WQ) + (size_t)l * 2048 * 1024, 1024, nb * 64, kb * 64, 0, 0, tile); continue; }
        r -= I_WQ;
        { const int m = r / 4, q = r % 4, nb = q % 2, kb = q / 2;
            const int which = m / 20, dh = m % 20;
            const float* src = a.in[which == 0 ? 18 : 20] + (size_t)dh * 128 * 128;
            bf16_t* dst = (bf16_t*)(ws + (which == 0 ? WS_WAT : WS_WXT)) + (size_t)dh * 128 * 128;
            transpose_item(src, 128, dst, 128, nb * 64, kb * 64, 0, 0, tile);
        }
    }
    const size_t gtid = (size_t)blockIdx.x * NTHR + tid, gthreads = (size_t)gridDim.x * NTHR;
    cvt_stream(a.in[25], (bf16_t*)(ws + WS_KEYS), (size_t)2 * 8 * 2 * 128 * 128 / 8, gtid, gthreads);
    cvt_stream(a.in[10], (bf16_t*)(ws + WS_GWS), (size_t)4 * 128 * 128 / 8, gtid, gthreads);
    {
        const int gw = blockIdx.x * NWAVE + wid, ngw = gridDim.x * NWAVE;
        for (int r = gw; r < 4 * NEXP; r += ngw) {
            const int tb = r / (2 * NEXP), rr = r - tb * 2 * NEXP;
            const float* src = a.in[tb == 0 ? 26 : 27] + (size_t)rr * D;
            f32x4 v[4]; float mx = 0.f;
#pragma unroll
            for (int j = 0; j < 4; ++j) { v[j] = *(const f32x4*)(src + j * 256 + lane * 4); mx = fmaxf(fmaxf(fmaxf(fabsf(v[j].x), fabsf(v[j].y)), fmaxf(fabsf(v[j].z), fabsf(v[j].w))), mx); }
#pragma unroll
            for (int o = 1; o < 64; o <<= 1) mx = fmaxf(mx, __shfl_xor(mx, o));
            mx = fmaxf(mx, 1e-30f);
            const float inv = 127.f / mx;
            const int lyr = rr / NEXP, ex = rr - lyr * NEXP;
            unsigned char* dst = ws + (tb == 0 ? WS_PU : WS_PV) + (size_t)lyr * NEXP * D + (size_t)ex * 128 + (lane & 31) * 4;
#pragma unroll
            for (int j = 0; j < 4; ++j) {
                const int bias = tb == 0 ? 0 : 128;
                const unsigned b0 = (unsigned)(__float2int_rn(v[j].x * inv) + bias) & 0xffu, b1 = (unsigned)(__float2int_rn(v[j].y * inv) + bias) & 0xffu;
                const unsigned b2 = (unsigned)(__float2int_rn(v[j].z * inv) + bias) & 0xffu, b3 = (unsigned)(__float2int_rn(v[j].w * inv) + bias) & 0xffu;
                *(unsigned*)(dst + (size_t)(2 * j + (lane >> 5)) * NEXP * 128) = b0 | (b1 << 8) | (b2 << 16) | (b3 << 24);
            }
            if (lane == 0) ((float*)(ws + (tb == 0 ? WS_SCU : WS_SCV)))[rr] = mx * (1.f / 127.f);
        }
    }
    for (size_t i = gtid; i < 128 * 32; i += gthreads) {
        const int pos = (int)(i / 32), f = (int)(i % 32);
        const float inv = powf(10000.f, -(float)f / 32.f); const float ang = (float)pos * inv;
        float* R = (float*)(ws + WS_ROPE); R[i * 2] = cosf(ang); R[i * 2 + 1] = sinf(ang);
    }
}

__device__ __forceinline__ void norm_row_store(const f32x4 (&v)[4], const float* g, const float* sh, const float* sc, bf16_t* orow, int lane, unsigned char* q8row = nullptr, float* q8scale = nullptr) {
    float s = 0.f;
#pragma unroll
    for (int j = 0; j < 4; ++j) s += (v[j].x * v[j].x + v[j].y * v[j].y) + (v[j].z * v[j].z + v[j].w * v[j].w);
    const float rinv = rsqrtf(wave_sum(s) * (1.f / D) + EPS);
    f32x4 o[4]; float mx = 0.f;
#pragma unroll
    for (int j = 0; j < 4; ++j) {
        const int c = j * 256 + lane * 4;
        const f32x4 gg = *(const f32x4*)(g + c), s1 = *(const f32x4*)(sh + c), s2 = *(const f32x4*)(sc + c);
        o[j].x = v[j].x * rinv * gg.x * (1.f + s2.x) + s1.x; o[j].y = v[j].y * rinv * gg.y * (1.f + s2.y) + s1.y;
        o[j].z = v[j].z * rinv * gg.z * (1.f + s2.z) + s1.z; o[j].w = v[j].w * rinv * gg.w * (1.f + s2.w) + s1.w;
        u32x2 w; w.x = pk2(o[j].x, o[j].y); w.y = pk2(o[j].z, o[j].w);
        *(u32x2*)(orow + c) = w;
        mx = fmaxf(fmaxf(fmaxf(fabsf(o[j].x), fabsf(o[j].y)), fmaxf(fabsf(o[j].z), fabsf(o[j].w))), mx);
    }
    if (q8row) {
#pragma unroll
        for (int of = 1; of < 64; of <<= 1) mx = fmaxf(mx, __shfl_xor(mx, of));
        mx = fmaxf(mx, 1e-30f); const float inv = 127.f / mx;
#pragma unroll
        for (int j = 0; j < 4; ++j) {
            const unsigned b0 = (unsigned)__float2int_rn(o[j].x * inv) & 0xffu, b1 = (unsigned)__float2int_rn(o[j].y * inv) & 0xffu;
            const unsigned b2 = (unsigned)__float2int_rn(o[j].z * inv) & 0xffu, b3 = (unsigned)__float2int_rn(o[j].w * inv) & 0xffu;
            *(unsigned*)(q8row + j * 256 + lane * 4) = b0 | (b1 << 8) | (b2 << 16) | (b3 << 24);
        }
        if (lane == 0) *q8scale = mx * (1.f / 127.f);
    }
}
__device__ __forceinline__ void phase_norm(const Args& a, int layer, int src_mode, const float* gain, int which_sh, int which_sc, bool latent_only, bool wq8 = false) {
    const int lane = threadIdx.x & 63, gw = blockIdx.x * NWAVE + (threadIdx.x >> 6), ngw = gridDim.x * NWAVE;
    bf16_t* H = (bf16_t*)(a.ws + WS_H);
    const float* X1 = (const float*)(a.ws + WS_X1);
    for (int g = gw; g < MTOT; g += ngw) {
        const int var = row_variant(g);
        if (latent_only && var == 2) continue;
        const float* xr = src_mode == 0 ? row_src(a, g) : X1 + (size_t)g * D;
        f32x4 v[4];
#pragma unroll
        for (int j = 0; j < 4; ++j) v[j] = *(const f32x4*)(xr + j * 256 + lane * 4);
        norm_row_store(v, gain, modv(a, layer, var, which_sh), modv(a, layer, var, which_sc), H + (size_t)g * D, lane, wq8 ? a.ws + WS_H8 + (size_t)g * D : nullptr, wq8 ? (float*)(a.ws + WS_SH) + g : nullptr);
    }
}

constexpr int CS_LD = 132;
__device__ __forceinline__ void gemm_tile128(const bf16_t* A, int lda, const bf16_t* Bt, int ldb, int K, float* Cs) {
    const int tid = threadIdx.x, lane = tid & 63, wid = tid >> 6, r = lane & 31, h = lane >> 5, wr = wid >> 1, wc = wid & 1;
    const bf16_t* ap = A + (size_t)(wr * 32 + r) * lda + 8 * h;
    const bf16_t* bp0 = Bt + (size_t)(wc * 64 + r) * ldb + 8 * h;
    const bf16_t* bp1 = bp0 + (size_t)32 * ldb;
    f32x16 acc0 = {}, acc1 = {};
#pragma unroll 4
    for (int k = 0; k < K; k += 16) {
        const bf16x8 av = *(const bf16x8*)(ap + k), b0 = *(const bf16x8*)(bp0 + k), b1 = *(const bf16x8*)(bp1 + k);
        acc0 = __builtin_amdgcn_mfma_f32_32x32x16_bf16(av, b0, acc0, 0, 0, 0);
        acc1 = __builtin_amdgcn_mfma_f32_32x32x16_bf16(av, b1, acc1, 0, 0, 0);
    }
#pragma unroll
    for (int i = 0; i < 16; ++i) {
        const int row = wr * 32 + (i & 3) + 8 * (i >> 2) + 4 * h;
        Cs[row * CS_LD + wc * 64 + r] = acc0[i];
        Cs[row * CS_LD + wc * 64 + 32 + r] = acc1[i];
    }
}

__device__ __forceinline__ void phase_inproj0(const Args& a, char* lds) {
    float* Cs = (float*)lds;
    const int tid = threadIdx.x;
    unsigned char* ws = a.ws;
    const bf16_t* H = (const bf16_t*)(ws + WS_H); const bf16_t* W = (const bf16_t*)(ws + WS_WIN0);
    const float* rope = (const float*)(ws + WS_ROPE);
    const int NU = (MTOT / 128) * 16;
    for (int u = blockIdx.x; u < NU; u += gridDim.x) {
        const int rt = u / 16, ct = u % 16, row0 = rt * 128, col0 = ct * 128;
        gemm_tile128(H + (size_t)row0 * D, D, W + (size_t)col0 * D, D, D, Cs);
        __syncthreads();
        const int rr = tid >> 2, q4 = tid & 3, g = row0 + rr;
        float* crow = Cs + rr * CS_LD + q4 * 32;
        if (ct < 4) {
            bf16_t* o = (bf16_t*)(ws + WS_U) + (size_t)g * 512 + col0 + q4 * 32;
#pragma unroll
            for (int c = 0; c < 32; c += 2) *(unsigned*)(o + c) = pk2(gelu_t(crow[c]), gelu_t(crow[c + 1]));
        } else if (ct < 8) {
            const int gg = ct - 4; float ss = 0.f;
#pragma unroll
            for (int c = 0; c < 32; ++c) { const float v = gelu_t(crow[c]); crow[c] = v; ss += v * v; }
            ss += __shfl_xor(ss, 1); ss += __shfl_xor(ss, 2);
            const float rinv = rsqrtf(ss * (1.f / 128.f) + EPS);
            const float* gn = a.in[9] + gg * 128 + q4 * 32;
            bf16_t* o = (bf16_t*)(ws + WS_VV) + (size_t)g * 512 + gg * 128 + q4 * 32;
#pragma unroll
            for (int c = 0; c < 32; c += 2) *(unsigned*)(o + c) = pk2(crow[c] * rinv * gn[c], crow[c + 1] * rinv * gn[c + 1]);
        } else if (ct < 14) {
            const bool isq = ct < 12; const int hh = isq ? ct - 8 : ct - 12;
            float ss = 0.f;
#pragma unroll
            for (int c = 0; c < 32; ++c) ss += crow[c] * crow[c];
            ss += __shfl_xor(ss, 1); ss += __shfl_xor(ss, 2);
            const float rinv = rsqrtf(ss * (1.f / 128.f) + EPS);
            const float* gn = a.in[isq ? 12 : 13];
            const int b = g / RPB, i = g - b * RPB; const bool lat = i >= CTXL; const int t = i - CTXL;
            bf16_t* o = (isq ? (bf16_t*)(ws + WS_Q) + (size_t)g * 512 : (bf16_t*)(ws + WS_K) + (size_t)g * 256) + hh * 128 + q4 * 32;
#pragma unroll
            for (int c8 = 0; c8 < 32; c8 += 8) {
                float y[8];
#pragma unroll
                for (int e = 0; e < 8; ++e) { const int j = q4 * 32 + c8 + e; y[e] = crow[c8 + e] * rinv * gn[sigma_head(j)]; }
                if (lat) {
                    const int grp = (q4 * 32 + c8) >> 3, ax = grp >> 3; const int pos = ax == 0 ? (t >> 6) : (t & 63);
#pragma unroll
                    for (int e = 0; e < 4; ++e) { const int f = (grp & 7) * 4 + e; const float cs = rope[(pos * 32 + f) * 2], sn = rope[(pos * 32 + f) * 2 + 1];
                        const float x1 = y[e], x2 = y[e + 4]; y[e] = x1 * cs - x2 * sn; y[e + 4] = x2 * cs + x1 * sn; }
                }
                u32x4 w; w.x = pk2(y[0], y[1]); w.y = pk2(y[2], y[3]); w.z = pk2(y[4], y[5]); w.w = pk2(y[6], y[7]);
                *(u32x4*)(o + c8) = w;
            }
        } else {
            bf16_t* o = (bf16_t*)(ws + WS_V) + (size_t)g * 256 + (ct - 14) * 128 + q4 * 32;
#pragma unroll
            for (int c = 0; c < 32; c += 2) *(unsigned*)(o + c) = pk2(crow[c], crow[c + 1]);
        }
        __syncthreads();
    }
}

__device__ __forceinline__ void phase_gmlp(const Args& a, char* lds) {
    const int tid = threadIdx.x;
    unsigned char* ws = a.ws;
    float* vt = (float*)lds;
    const bf16_t* VV = (const bf16_t*)(ws + WS_VV); const bf16_t* U = (const bf16_t*)(ws + WS_U); bf16_t* AO = (bf16_t*)(ws + WS_AO);
    const int NU = (MTOT / 128) * 4;
    for (int u = blockIdx.x; u < NU; u += gridDim.x) {
        const int ch = u / 4, g = u % 4, row0 = ch * 128;
        for (int i = tid; i < 128 * 128; i += NTHR) { const int q = i >> 7, c = i & 127; vt[i] = bf2f(VV[(size_t)(row0 + q) * 512 + g * 128 + c]); }
        __syncthreads();
        const int c = tid & 127, pq = tid >> 7;
        const float* wsg = a.in[10] + (size_t)g * 128 * 128;
        for (int pp = 0; pp < 32; ++pp) {
            const int p = pq * 32 + pp; float s = 0.f;
            for (int q = 0; q < 128; ++q) s += wsg[p * 128 + q] * vt[q * 128 + c];
            s += a.in[11][g * 128 + p];
            const float uu = bf2f(U[(size_t)(row0 + p) * 512 + g * 128 + c]);
            AO[(size_t)(row0 + p) * 1024 + g * 128 + c] = (bf16_t)f2bf(uu * s);
        }
        __syncthreads();
    }
}

__device__ __forceinline__ void phase_gmlp2(const Args& a, char* lds) {
    const int tid = threadIdx.x, lane = tid & 63, wid = __builtin_amdgcn_readfirstlane(tid >> 6), r32 = lane & 31, hh = lane >> 5;
    unsigned char* ws = a.ws;
    LAS bf16_t* vT = (LAS bf16_t*)((LAS char*)lds);
    const bf16_t* VV = (const bf16_t*)(ws + WS_VV); const bf16_t* U = (const bf16_t*)(ws + WS_U); bf16_t* AO = (bf16_t*)(ws + WS_AO);
    const bf16_t* GWS = (const bf16_t*)(ws + WS_GWS);
    const int NU = (MTOT / 128) * 4;
    for (int u = blockIdx.x; u < NU; u += gridDim.x) {
        const int ch = u >> 2, g = u & 3, row0 = ch * 128;
#pragma unroll
        for (int i = 0; i < 4; ++i) {
            const int q = (tid >> 4) + 32 * i, c0 = (tid & 15) * 8;
            const u32x4 w = *(const u32x4*)(VV + (size_t)(row0 + q) * 512 + g * 128 + c0);
            vT[(c0 + 0) * 136 + q] = (bf16_t)(w.x & 0xffffu); vT[(c0 + 1) * 136 + q] = (bf16_t)(w.x >> 16);
            vT[(c0 + 2) * 136 + q] = (bf16_t)(w.y & 0xffffu); vT[(c0 + 3) * 136 + q] = (bf16_t)(w.y >> 16);
            vT[(c0 + 4) * 136 + q] = (bf16_t)(w.z & 0xffffu); vT[(c0 + 5) * 136 + q] = (bf16_t)(w.z >> 16);
            vT[(c0 + 6) * 136 + q] = (bf16_t)(w.w & 0xffffu); vT[(c0 + 7) * 136 + q] = (bf16_t)(w.w >> 16);
        }
        __syncthreads();
        const int mb = wid >> 1, nb0 = (wid & 1) * 2;
        f32x16 acc0 = {}, acc1 = {};
        {
            unsigned aoff = (unsigned)((mb * 32 + r32) * 128 + 8 * hh); asm volatile("" : "+v"(aoff));
            const bf16_t* wsg = GWS + (size_t)g * 128 * 128;
#pragma unroll
            for (int ks = 0; ks < 8; ++ks) {
                const bf16x8 af = *(const bf16x8*)(wsg + aoff + ks * 16);
                const bf16x8 b0 = *(const LAS bf16x8*)(vT + (nb0 * 32 + r32) * 136 + ks * 16 + 8 * hh);
                const bf16x8 b1 = *(const LAS bf16x8*)(vT + ((nb0 + 1) * 32 + r32) * 136 + ks * 16 + 8 * hh);
                acc0 = __builtin_amdgcn_mfma_f32_32x32x16_bf16(af, b0, acc0, 0, 0, 0);
                acc1 = __builtin_amdgcn_mfma_f32_32x32x16_bf16(af, b1, acc1, 0, 0, 0);
            }
        }
#pragma unroll
        for (int r = 0; r < 16; ++r) {
            const int p = mb * 32 + (r & 3) + 8 * (r >> 2) + 4 * hh;
            const float bsv = a.in[11][g * 128 + p];
            const size_t ub = (size_t)(row0 + p) * 512 + g * 128, ob = (size_t)(row0 + p) * 1024 + g * 128;
            const int c0 = nb0 * 32 + r32, c1 = c0 + 32;
            AO[ob + c0] = (bf16_t)f2bf(bf2f(U[ub + c0]) * (acc0[r] + bsv));
            AO[ob + c1] = (bf16_t)f2bf(bf2f(U[ub + c1]) * (acc1[r] + bsv));
        }
        __syncthreads();
    }
}

__device__ __forceinline__ void phase_attn_naive(const Args& a, char* lds) {
    const int tid = threadIdx.x;
    unsigned char* ws = a.ws;
    float* Ks = (float*)lds;
    float* Vs = Ks + 32 * 128;
    float* part = Vs + 32 * 128;
    const bf16_t* Q = (const bf16_t*)(ws + WS_Q); const bf16_t* Kb = (const bf16_t*)(ws + WS_K); const bf16_t* Vb = (const bf16_t*)(ws + WS_V);
    bf16_t* AO = (bf16_t*)(ws + WS_AO);
    const int NU = 512 + 16;
    for (int u = blockIdx.x; u < NU; u += gridDim.x) {
        int b, h, qrow0, nkeys;
        if (u < 512) { b = u / 256; h = (u / 64) % 4; qrow0 = b * RPB + CTXL + (u % 64) * 128; nkeys = RPB; }
        else { const int v = u - 512; b = v / 8; h = (v / 2) % 4; qrow0 = b * RPB + (v % 2) * 128; nkeys = CTXL; }
        const int kvh = h >> 1, krow0 = b * RPB;
        const int qi = tid & 127, qt = tid >> 7;
        float q[32], o[32];
        {
            const bf16_t* qp = Q + (size_t)(qrow0 + qi) * 512 + h * 128 + qt * 32;
#pragma unroll
            for (int d = 0; d < 32; d += 2) { const unsigned w = *(const unsigned*)(qp + d); q[d] = bflo(w) * 0.08838834764831845f; q[d + 1] = bfhi(w) * 0.08838834764831845f; }
#pragma unroll
            for (int d = 0; d < 32; ++d) o[d] = 0.f;
        }
        float m = -1e30f, l = 0.f;
        for (int k0 = 0; k0 < nkeys; k0 += 32) {
            {
                const int key = tid >> 4, cs = (tid & 15) * 8;
                const u32x4 kw = *(const u32x4*)(Kb + (size_t)(krow0 + k0 + key) * 256 + kvh * 128 + cs);
                const u32x4 vw = *(const u32x4*)(Vb + (size_t)(krow0 + k0 + key) * 256 + kvh * 128 + cs);
                float* kd = Ks + key * 128 + cs; float* vd = Vs + key * 128 + cs;
                kd[0] = bflo(kw.x); kd[1] = bfhi(kw.x); kd[2] = bflo(kw.y); kd[3] = bfhi(kw.y); kd[4] = bflo(kw.z); kd[5] = bfhi(kw.z); kd[6] = bflo(kw.w); kd[7] = bfhi(kw.w);
                vd[0] = bflo(vw.x); vd[1] = bfhi(vw.x); vd[2] = bflo(vw.y); vd[3] = bfhi(vw.y); vd[4] = bflo(vw.z); vd[5] = bfhi(vw.z); vd[6] = bflo(vw.w); vd[7] = bfhi(vw.w);
            }
            __syncthreads();
#pragma unroll 2
            for (int j = 0; j < 32; ++j) {
                const float* kr = Ks + j * 128 + qt * 32; float acc = 0.f;
#pragma unroll
                for (int d = 0; d < 32; d += 4) { const f32x4 kv = *(const f32x4*)(kr + d); acc += q[d] * kv.x + q[d + 1] * kv.y + q[d + 2] * kv.z + q[d + 3] * kv.w; }
                part[(qt * 32 + j) * 128 + qi] = acc;
            }
            __syncthreads();
            float mx = m;
#pragma unroll 4
            for (int j = 0; j < 32; ++j) { const float sj = (part[(0 * 32 + j) * 128 + qi] + part[(1 * 32 + j) * 128 + qi]) + (part[(2 * 32 + j) * 128 + qi] + part[(3 * 32 + j) * 128 + qi]); mx = fmaxf(mx, sj); }
            const float alpha = __expf(m - mx); m = mx; float ps = 0.f;
#pragma unroll
            for (int d = 0; d < 32; ++d) o[d] *= alpha;
#pragma unroll 2
            for (int j = 0; j < 32; ++j) {
                const float sj = (part[(0 * 32 + j) * 128 + qi] + part[(1 * 32 + j) * 128 + qi]) + (part[(2 * 32 + j) * 128 + qi] + part[(3 * 32 + j) * 128 + qi]);
                const float pj = __expf(sj - mx); ps += pj;
                const float* vr = Vs + j * 128 + qt * 32;
#pragma unroll
                for (int d = 0; d < 32; d += 4) { const f32x4 vv = *(const f32x4*)(vr + d); o[d] += pj * vv.x; o[d + 1] += pj * vv.y; o[d + 2] += pj * vv.z; o[d + 3] += pj * vv.w; }
            }
            l = l * alpha + ps;
            __syncthreads();
        }
        const float rl = 1.f / l;
        bf16_t* op = AO + (size_t)(qrow0 + qi) * 1024 + 512 + h * 128 + qt * 32;
#pragma unroll
        for (int d = 0; d < 32; d += 2) *(unsigned*)(op + d) = pk2(o[d] * rl, o[d + 1] * rl);
    }
}

namespace fa {
typedef short s16x4 __attribute__((ext_vector_type(4)));
constexpr int QBLK = 32, KVBLK = 64, LDQ = 512, LDK = 256, LDO = 1024;
constexpr float SCALE = 0.088388347648318440f, THR = 8.f;
constexpr size_t SHM_V = KVBLK * 128 * 2, SHM_K = KVBLK * 128 * 2, SHM_ATTN = 2 * SHM_V + 2 * SHM_K + NWAVE * 64 * 4;
#define KSWZ(row, colB) ((row) * 256 + ((colB) ^ (((row) & 7) << 4)))
#define SBAR() __builtin_amdgcn_sched_barrier(0)
__device__ __forceinline__ int crow(int r, int hi) { return (r & 3) + 8 * (r >> 2) + 4 * hi; }
__device__ __forceinline__ unsigned cvtpk(float lo, float hi) { unsigned r; asm volatile("v_cvt_pk_bf16_f32 %0, %1, %2" : "=v"(r) : "v"(lo), "v"(hi)); return r; }
__device__ __forceinline__ void partialSM(f32x16& p0, f32x16& p1, float& m_reg, float& mn, float& alpha) {
  constexpr float C = SCALE * 1.4426950408889634f;
  float pmax = p0[0]; for (int r = 1; r < 16; ++r) pmax = fmaxf(pmax, p0[r]); for (int r = 0; r < 16; ++r) pmax = fmaxf(pmax, p1[r]);
  { auto rr = __builtin_amdgcn_permlane32_swap(__float_as_uint(pmax), __float_as_uint(pmax), false, false);
    pmax = fmaxf(__uint_as_float(rr[0]), __uint_as_float(rr[1])); }
  if (__builtin_expect(__all(pmax - m_reg <= THR / SCALE), 1)) { mn = m_reg; alpha = 1.f; }
  else { mn = fmaxf(m_reg, pmax); alpha = __builtin_amdgcn_exp2f((m_reg - mn) * C); m_reg = mn; }
  float mnC = -mn * C;
  for (int r = 0; r < 16; ++r) p0[r] = fmaf(p0[r], C, mnC); for (int r = 0; r < 16; ++r) p1[r] = fmaf(p1[r], C, mnC);
  for (int r = 0; r < 16; ++r) p0[r] = __builtin_amdgcn_exp2f(p0[r]);
}
__device__ __forceinline__ void finishSM(f32x16& p0, f32x16& p1, float alpha, float& l_reg, bf16x8& pa0, bf16x8& pa1, bf16x8& pa2, bf16x8& pa3) {
  for (int r = 0; r < 16; ++r) p1[r] = __builtin_amdgcn_exp2f(p1[r]);
  float ps = 0; for (int r = 0; r < 16; ++r) ps += p0[r]; for (int r = 0; r < 16; ++r) ps += p1[r];
  { auto rr = __builtin_amdgcn_permlane32_swap(__float_as_uint(ps), __float_as_uint(ps), false, false);
    ps = __uint_as_float(rr[0]) + __uint_as_float(rr[1]); }
  l_reg = l_reg * alpha + ps;
#define PK4(P, BASE, OUT) do { unsigned a0 = cvtpk(P[BASE + 0], P[BASE + 1]), a1 = cvtpk(P[BASE + 2], P[BASE + 3]);   \
    unsigned b0 = cvtpk(P[BASE + 4], P[BASE + 5]), b1 = cvtpk(P[BASE + 6], P[BASE + 7]);                              \
    auto r0 = __builtin_amdgcn_permlane32_swap(a0, b0, false, false); auto r1 = __builtin_amdgcn_permlane32_swap(a1, b1, false, false); \
    u32x4 w = {r0[0], r1[0], r0[1], r1[1]}; OUT = *reinterpret_cast<bf16x8*>(&w); } while (0)
  PK4(p0, 0, pa0); PK4(p0, 8, pa1); PK4(p1, 0, pa2); PK4(p1, 8, pa3);
#undef PK4
}
__device__ __forceinline__ void qkt(f32x16& p0, f32x16& p1, const bf16_t* Ks, const bf16x8* qr, int r32, int hi) {
  p0 = f32x16{}; p1 = f32x16{};
  for (int d0 = 0; d0 < 8; ++d0) { int cb = (d0 * 16 + hi * 8) * 2;
    bf16x8 b0 = *reinterpret_cast<const bf16x8*>((const char*)Ks + KSWZ(r32, cb));
    bf16x8 b1 = *reinterpret_cast<const bf16x8*>((const char*)Ks + KSWZ(32 + r32, cb));
    p0 = __builtin_amdgcn_mfma_f32_32x32x16_bf16(b0, qr[d0], p0, 0, 0, 0);
    p1 = __builtin_amdgcn_mfma_f32_32x32x16_bf16(b1, qr[d0], p1, 0, 0, 0); }
}
__device__ __forceinline__ int v_st(int k, int c) { const int kk = (k & ~0xC) | ((k & 4) << 1) | ((k & 8) >> 1); return ((kk >> 3) * 4 + (c >> 5)) * 512 + ((kk & 7) * 32 + (c & 31)) * 2; }
__device__ __forceinline__ int v_rd_base(int lane) { return ((lane & 3) << 3) | (((lane >> 2) & 3) << 6) | (((lane >> 4) & 1) << 5) | (((lane >> 5) & 1) << 8); }
constexpr int v_rd_off(int d0, int ks, int half) { return d0 * 512 + ks * 4096 + half * 2048; }
template <int OFF> __device__ __forceinline__ s16x4 tr_read(int vb) {
  s16x4 r; asm volatile("ds_read_b64_tr_b16 %0, %1 offset:%2" : "=&v"(r) : "v"(vb), "i"(OFF) : "memory"); return r;
}
template <int D0> __device__ __forceinline__ void pv_one(f32x16& od, int vb, bf16x8 pa0, bf16x8 pa1, bf16x8 pa2, bf16x8 pa3) {
  const s16x4 l0 = tr_read<v_rd_off(D0, 0, 0)>(vb), h0 = tr_read<v_rd_off(D0, 0, 1)>(vb), l1 = tr_read<v_rd_off(D0, 1, 0)>(vb), h1 = tr_read<v_rd_off(D0, 1, 1)>(vb);
  const s16x4 l2 = tr_read<v_rd_off(D0, 2, 0)>(vb), h2 = tr_read<v_rd_off(D0, 2, 1)>(vb), l3 = tr_read<v_rd_off(D0, 3, 0)>(vb), h3 = tr_read<v_rd_off(D0, 3, 1)>(vb);
  asm volatile("s_waitcnt lgkmcnt(0)" ::: "memory"); SBAR();
#define PK(L, H) (bf16x8){L[0], L[1], L[2], L[3], H[0], H[1], H[2], H[3]}
  od = __builtin_amdgcn_mfma_f32_32x32x16_bf16(pa0, PK(l0, h0), od, 0, 0, 0);
  od = __builtin_amdgcn_mfma_f32_32x32x16_bf16(pa1, PK(l1, h1), od, 0, 0, 0);
  od = __builtin_amdgcn_mfma_f32_32x32x16_bf16(pa2, PK(l2, h2), od, 0, 0, 0);
  od = __builtin_amdgcn_mfma_f32_32x32x16_bf16(pa3, PK(l3, h3), od, 0, 0, 0);
#undef PK
}
__device__ __forceinline__ void pv_d0(f32x16* o, int vb, bf16x8 pa0, bf16x8 pa1, bf16x8 pa2, bf16x8 pa3) {
  pv_one<0>(o[0], vb, pa0, pa1, pa2, pa3); pv_one<1>(o[1], vb, pa0, pa1, pa2, pa3); pv_one<2>(o[2], vb, pa0, pa1, pa2, pa3); pv_one<3>(o[3], vb, pa0, pa1, pa2, pa3);
}
__device__ __forceinline__ void attn_dense_body(const bf16_t* __restrict__ Qb, const bf16_t* __restrict__ Kh, const bf16_t* __restrict__ Vh,
                                                bf16_t* __restrict__ Ob, int seq, char* lds) {
  const int tid = threadIdx.x, wid = tid >> 6, lane = tid & 63, r32 = lane & 31, hi = lane >> 5;
  bf16_t* V_lds = (bf16_t*)lds; bf16_t* K_lds = (bf16_t*)(lds + 2 * SHM_V);
  float* ws = (float*)(lds + 2 * SHM_V + 2 * SHM_K) + wid * 64; float* li_l = ws; float* al_l = ws + 32;
  float m_reg = -1e30f, l_reg = 0; f32x16 o[4] = {}; bf16x8 qr[8];
  const bf16_t* Qw = Qb + (long)(wid * QBLK + r32) * LDQ + hi * 8;
#pragma unroll
  for (int d0 = 0; d0 < 8; ++d0) qr[d0] = *reinterpret_cast<const bf16x8*>(Qw + d0 * 16);
  const int sr = tid >> 4, sc = (tid & 15) * 8, vst0 = v_st(sr, sc), vst1 = v_st(32 + sr, sc);
  const int vb0 = (int)(uintptr_t)V_lds + v_rd_base(lane);
  struct { bf16x8 vs0, vs1, ks0, ks1; } sr_[2];
#define SLOAD(i, k0) do { sr_[i].vs0 = *reinterpret_cast<const bf16x8*>(&Vh[(long)((k0) + sr) * LDK + sc]); sr_[i].vs1 = *reinterpret_cast<const bf16x8*>(&Vh[(long)((k0) + 32 + sr) * LDK + sc]); \
    sr_[i].ks0 = *reinterpret_cast<const bf16x8*>(&Kh[(long)((k0) + sr) * LDK + sc]); sr_[i].ks1 = *reinterpret_cast<const bf16x8*>(&Kh[(long)((k0) + 32 + sr) * LDK + sc]); } while (0)
#define SWRITE(b, i) do { *(bf16x8*)((char*)V_lds + (b) * SHM_V + vst0) = sr_[i].vs0;          \
    *(bf16x8*)((char*)V_lds + (b) * SHM_V + vst1) = sr_[i].vs1; int kc = sc * 2;               \
    *(bf16x8*)((char*)K_lds + (b) * SHM_K + KSWZ(sr, kc)) = sr_[i].ks0;                       \
    *(bf16x8*)((char*)K_lds + (b) * SHM_K + KSWZ(32 + sr, kc)) = sr_[i].ks1; } while (0)
#define SWAIT() asm volatile("s_waitcnt vmcnt(4)" ::: "memory")
#define RESC(a) do { if (__any((a) < 1.f)) { if (hi == 0) al_l[r32] = (a); asm volatile("s_waitcnt lgkmcnt(0)" ::: "memory"); \
    for (int d = 0; d < 4; ++d) for (int r = 0; r < 16; ++r) o[d][r] *= al_l[crow(r, hi)]; } } while (0)
  f32x16 pA0, pA1, pB0, pB1; float mnA, mnB, alA, alB; bf16x8 pa0, pa1, pa2, pa3; const int NT = seq / KVBLK;
  constexpr int SE = 0, SO = 1;
  SLOAD(SE, 0); asm volatile("s_waitcnt vmcnt(0)" ::: "memory"); SWRITE(0, SE); __syncthreads();
  qkt(pA0, pA1, K_lds, qr, r32, hi); partialSM(pA0, pA1, m_reg, mnA, alA);
  SLOAD(SO, KVBLK); if (2 < NT) SLOAD(SE, 2 * KVBLK);
  SWAIT(); SWRITE(1, SO); __syncthreads();
  for (int j = 1; j + 1 < NT; j += 2) {
    SBAR(); qkt(pB0, pB1, (bf16_t*)((char*)K_lds + SHM_K), qr, r32, hi);
    finishSM(pA0, pA1, alA, l_reg, pa0, pa1, pa2, pa3); SBAR();
    SLOAD(SO, (j + 2) * KVBLK); SBAR();
    pv_d0(o, vb0, pa0, pa1, pa2, pa3); partialSM(pB0, pB1, m_reg, mnB, alB);
    __syncthreads(); SWAIT(); SWRITE(0, SE);
    RESC(alB); __syncthreads();
    SBAR(); qkt(pA0, pA1, K_lds, qr, r32, hi);
    finishSM(pB0, pB1, alB, l_reg, pa0, pa1, pa2, pa3); SBAR();
    if (j + 3 < NT) SLOAD(SE, (j + 3) * KVBLK); SBAR();
    pv_d0(o, vb0 + (int)SHM_V, pa0, pa1, pa2, pa3); partialSM(pA0, pA1, m_reg, mnA, alA);
    __syncthreads(); SWAIT(); SWRITE(1, SO);
    RESC(alA); __syncthreads();
  }
  SBAR(); qkt(pB0, pB1, (bf16_t*)((char*)K_lds + SHM_K), qr, r32, hi);
  finishSM(pA0, pA1, alA, l_reg, pa0, pa1, pa2, pa3); SBAR();
  pv_d0(o, vb0, pa0, pa1, pa2, pa3); partialSM(pB0, pB1, m_reg, mnB, alB);
  __syncthreads(); RESC(alB);
  finishSM(pB0, pB1, alB, l_reg, pa0, pa1, pa2, pa3); SBAR();
  pv_d0(o, vb0 + (int)SHM_V, pa0, pa1, pa2, pa3);
  if (hi == 0) li_l[r32] = l_reg; asm volatile("s_waitcnt lgkmcnt(0)" ::: "memory");
  float rli[16];
#pragma unroll
  for (int r = 0; r < 16; ++r) rli[r] = __builtin_amdgcn_rcpf(li_l[crow(r, hi)]);
  bf16_t* Ow = Ob + (long)(wid * QBLK) * LDO;
#pragma unroll
  for (int r = 0; r < 16; ++r) { int orow = crow(r, hi);
    for (int d0 = 0; d0 < 4; ++d0) Ow[(long)orow * LDO + d0 * 32 + r32] = (bf16_t)f2bf(o[d0][r] * rli[r]); }
  __syncthreads();
#undef SLOAD
#undef SWRITE
#undef SWAIT
#undef RESC
}
#undef KSWZ
#undef SBAR
}

__device__ __forceinline__ void phase_attn(const Args& a, char* lds) {
    unsigned char* ws = a.ws;
    const bf16_t* Q = (const bf16_t*)(ws + WS_Q); const bf16_t* Kb = (const bf16_t*)(ws + WS_K); const bf16_t* Vb = (const bf16_t*)(ws + WS_V);
    bf16_t* AO = (bf16_t*)(ws + WS_AO);
    const int NU = 256 + 8;
    for (int u = blockIdx.x; u < NU; u += gridDim.x) {
        int b, h, qrow0, nkeys;
        if (u < 256) { b = u / 128; h = (u / 32) % 4; qrow0 = b * RPB + CTXL + (u % 32) * 256; nkeys = RPB; }
        else { const int v = u - 256; b = v / 4; h = v % 4; qrow0 = b * RPB; nkeys = CTXL; }
        const int kvh = h >> 1; const size_t krow0 = (size_t)b * RPB;
        fa::attn_dense_body(Q + (size_t)qrow0 * 512 + h * 128, Kb + krow0 * 256 + kvh * 128, Vb + krow0 * 256 + kvh * 128, AO + (size_t)qrow0 * 1024 + 512 + h * 128, nkeys, lds);
    }
}

__device__ __forceinline__ void phase_outproj(const Args& a, char* lds, const bf16_t* A, int K, const bf16_t* Bt, int layer, int which_gate, int base_mode, bool latent_only) {
    float* Cs = (float*)lds;
    const int tid = threadIdx.x;
    float* X1 = (float*)(a.ws + WS_X1);
    const int NU = (MTOT / 128) * 8;
    for (int u = blockIdx.x; u < NU; u += gridDim.x) {
        const int rt = u / 8, ct = u % 8, row0 = rt * 128, col0 = ct * 128;
        if (latent_only && (rt % 66) < 2) continue;
        gemm_tile128(A + (size_t)row0 * K, K, Bt + (size_t)col0 * K, K, K, Cs);
        __syncthreads();
        const int rr = tid >> 2, q4 = tid & 3, g = row0 + rr;
        const float* crow = Cs + rr * CS_LD + q4 * 32;
        const float* gt = modv(a, layer, row_variant(g), which_gate) + col0 + q4 * 32;
        const float* base = (base_mode == 0 ? row_src(a, g) : X1 + (size_t)g * D) + col0 + q4 * 32;
        float* o = X1 + (size_t)g * D + col0 + q4 * 32;
#pragma unroll
        for (int c = 0; c < 32; c += 4) {
            const f32x4 bs = *(const f32x4*)(base + c), gv = *(const f32x4*)(gt + c);
            f32x4 r; r.x = bs.x + gv.x * crow[c]; r.y = bs.y + gv.y * crow[c + 1]; r.z = bs.z + gv.z * crow[c + 2]; r.w = bs.w + gv.w * crow[c + 3];
            *(f32x4*)(o + c) = r;
        }
        __syncthreads();
    }
}

__device__ __forceinline__ void phase_peerq(const Args& a, char* lds, int layer, bool latent_only) {
    float* Cs = (float*)lds;
    const int tid = threadIdx.x;
    const bf16_t* H = (const bf16_t*)(a.ws + WS_H); const bf16_t* W = (const bf16_t*)(a.ws + WS_WQ) + (size_t)layer * 2048 * 1024;
    bf16_t* QP = (bf16_t*)(a.ws + WS_QP);
    const int NU = (MTOT / 128) * 16;
    for (int u = blockIdx.x; u < NU; u += gridDim.x) {
        const int rt = u / 16, ct = u % 16, row0 = rt * 128, col0 = ct * 128;
        if (latent_only && (rt % 66) < 2) continue;
        gemm_tile128(H + (size_t)row0 * D, D, W + (size_t)col0 * D, D, D, Cs);
        __syncthreads();
        const int rr = tid >> 2, q4 = tid & 3, g = row0 + rr;
        const float* crow = Cs + rr * CS_LD + q4 * 32;
        bf16_t* o = QP + (size_t)g * 2048 + col0 + q4 * 32;
#pragma unroll
        for (int c = 0; c < 32; c += 2) *(unsigned*)(o + c) = pk2(crow[c], crow[c + 1]);
        __syncthreads();
    }
}

__device__ __forceinline__ void wave_argmax(float& v, int& i) {
#pragma unroll
    for (int o = 1; o < 64; o <<= 1) {
        const float ov = __shfl_xor(v, o); const int oi = __shfl_xor(i, o);
        if (ov > v || (ov == v && oi < i)) { v = ov; i = oi; }
    }
}
__device__ __forceinline__ void phase_peer_topk(const Args& a, int layer, bool latent_only) {
    const int lane = threadIdx.x & 63, gw = blockIdx.x * NWAVE + (threadIdx.x >> 6), ngw = gridDim.x * NWAVE;
    const bf16_t* QP = (const bf16_t*)(a.ws + WS_QP);
    const bf16_t* KEYS = (const bf16_t*)(a.ws + WS_KEYS) + (size_t)layer * 8 * 2 * 128 * 128;
    int* SELI = (int*)(a.ws + WS_SELI); float* SELG = (float*)(a.ws + WS_SELG);
    for (int it = gw; it < MTOT * 8; it += ngw) {
        const int g = it >> 3, h = it & 7;
        if (latent_only && row_variant(g) == 2) continue;
        float tv[2]; int ti[2];
#pragma unroll
        for (int s = 0; s < 2; ++s) {
            const bf16_t* qp = QP + (size_t)g * 2048 + h * 256 + s * 128;
            const bf16_t* k0p = KEYS + ((size_t)(h * 2 + s) * 128 + lane) * 128;
            const bf16_t* k1p = k0p + 64 * 128;
            float s0 = 0.f, s1 = 0.f;
#pragma unroll 4
            for (int d = 0; d < 128; d += 8) {
                const u32x4 qw = *(const u32x4*)(qp + d), ka = *(const u32x4*)(k0p + d), kb = *(const u32x4*)(k1p + d);
                s0 += bflo(qw.x) * bflo(ka.x) + bfhi(qw.x) * bfhi(ka.x) + bflo(qw.y) * bflo(ka.y) + bfhi(qw.y) * bfhi(ka.y)
                    + bflo(qw.z) * bflo(ka.z) + bfhi(qw.z) * bfhi(ka.z) + bflo(qw.w) * bflo(ka.w) + bfhi(qw.w) * bfhi(ka.w);
                s1 += bflo(qw.x) * bflo(kb.x) + bfhi(qw.x) * bfhi(kb.x) + bflo(qw.y) * bflo(kb.y) + bfhi(qw.y) * bfhi(kb.y)
                    + bflo(qw.z) * bflo(kb.z) + bfhi(qw.z) * bfhi(kb.z) + bflo(qw.w) * bflo(kb.w) + bfhi(qw.w) * bfhi(kb.w);
            }
            float myv = 0.f; int myi = 0;
            for (int r = 0; r < 16; ++r) {
                float bv; int bi;
                if (s0 >= s1) { bv = s0; bi = lane; } else { bv = s1; bi = lane + 64; }
                wave_argmax(bv, bi);
                if (bi == lane) s0 = -INFINITY; else if (bi == lane + 64) s1 = -INFINITY;
                if (lane == r) { myv = bv; myi = bi; }
            }
            tv[s] = myv; ti[s] = myi;
        }
        float cv[4]; int ci[4];
        {
            const float v0 = __shfl(tv[0], lane >> 2); const int i0 = __shfl(ti[0], lane >> 2);
#pragma unroll
            for (int m = 0; m < 4; ++m) { const int j = (lane & 3) * 4 + m; cv[m] = v0 + __shfl(tv[1], j); ci[m] = i0 * 128 + __shfl(ti[1], j); }
        }
        float topv = 0.f; int tope = 0;
        for (int r = 0; r < 16; ++r) {
            float bv = cv[0]; int bp = lane * 4;
#pragma unroll
            for (int m = 1; m < 4; ++m) if (cv[m] > bv) { bv = cv[m]; bp = lane * 4 + m; }
            wave_argmax(bv, bp);
            int be = 0;
#pragma unroll
            for (int m = 0; m < 4; ++m) if (bp == lane * 4 + m) { be = ci[m]; cv[m] = -INFINITY; }
            be = __shfl(be, bp >> 2);
            if (lane == r) { topv = bv; tope = be; }
        }
        const float mx = __shfl(topv, 0);
        float e = lane < 16 ? __expf(topv - mx) : 0.f;
        float sum = e;
#pragma unroll
        for (int o = 1; o < 16; o <<= 1) sum += __shfl_xor(sum, o);
        if (lane < 16) { SELI[(size_t)g * 128 + h * 16 + lane] = tope; SELG[(size_t)g * 128 + h * 16 + lane] = e / sum; }
    }
}

namespace tk {
__device__ __forceinline__ void ce(float& a, float& b) { const float mx = __builtin_fmaxf(a, b), mn = __builtin_fminf(a, b); a = mx; b = mn; }
__device__ __forceinline__ void sort16_desc(float (&v)[16]) {
#pragma unroll
    for (int ks = 1; ks <= 4; ++ks)
#pragma unroll
        for (int js = ks - 1; js >= 0; --js)
#pragma unroll
            for (int i = 0; i < 16; ++i) { const int k = 1 << ks, j = 1 << js, l = i ^ j; if (l > i) { if ((i & k) == 0) ce(v[i], v[l]); else ce(v[l], v[i]); } }
}
__device__ __forceinline__ void merge16_desc(float (&v)[16]) {
#pragma unroll
    for (int js = 3; js >= 0; --js)
#pragma unroll
        for (int i = 0; i < 16; ++i) { const int j = 1 << js, l = i ^ j; if (l > i) ce(v[i], v[l]); }
}
__device__ __forceinline__ void merge_prune(float (&x)[16], const float (&y)[16]) {
#pragma unroll
    for (int i = 0; i < 16; ++i) x[i] = __builtin_fmaxf(x[i], y[15 - i]);
    merge16_desc(x);
}
__host__ __device__ constexpr bool pair_ok(int i, int j) { return (i + 1) * (j + 1) <= 16; }
__host__ __device__ constexpr int pair_index(int i, int j) { int n = 0; for (int a = 0; a < 16; ++a) for (int b = 0; b < 16; ++b) { if (a == i && b == j) return n; if (pair_ok(a, b)) ++n; } return n; }
static_assert(pair_index(15, 15) == 49 + 0 || true, "");
}
__device__ __forceinline__ void phase_peer_topk2(const Args& a, int layer, bool latent_only) {
    const int lane = threadIdx.x & 63, r32 = lane & 31, hh = lane >> 5, gw = blockIdx.x * NWAVE + __builtin_amdgcn_readfirstlane(threadIdx.x >> 6), ngw = gridDim.x * NWAVE;
    const bf16_t* QP = (const bf16_t*)(a.ws + WS_QP);
    const bf16_t* KEYS = (const bf16_t*)(a.ws + WS_KEYS) + (size_t)layer * 8 * 2 * 128 * 128;
    int* SELI = (int*)(a.ws + WS_SELI); float* SELG = (float*)(a.ws + WS_SELG);
    const int NIT = (MTOT / 32) * 8;
    for (int it = gw; it < NIT; it += ngw) {
        const int tg = it >> 3, h = it & 7, g0 = tg * 32;
        if (latent_only && row_variant(g0) == 2) continue;
        float top[2][16];
#pragma unroll
        for (int s = 0; s < 2; ++s) {
            bf16x8 qf[8];
            unsigned qoff = (unsigned)(r32 * 2048 + 8 * hh), koff = (unsigned)(r32 * 128 + 8 * hh); asm volatile("" : "+v"(qoff), "+v"(koff));
            const bf16_t* qb = QP + (size_t)g0 * 2048 + h * 256 + s * 128;
#pragma unroll
            for (int k = 0; k < 8; ++k) qf[k] = *(const bf16x8*)(qb + qoff + k * 16);
            float grp[4][16];
#pragma unroll
            for (int kb = 0; kb < 4; ++kb) {
                const bf16_t* kbp = KEYS + (size_t)(h * 2 + s) * 128 * 128 + kb * 32 * 128;
                f32x16 acc = {};
#pragma unroll
                for (int k = 0; k < 8; ++k) { const bf16x8 kf = *(const bf16x8*)(kbp + koff + k * 16); acc = __builtin_amdgcn_mfma_f32_32x32x16_bf16(kf, qf[k], acc, 0, 0, 0); }
#pragma unroll
                for (int r = 0; r < 16; ++r) { const int key = kb * 32 + (r & 3) + 8 * (r >> 2) + 4 * hh; grp[kb][r] = __uint_as_float((__float_as_uint(acc[r]) & ~127u) | (unsigned)key); }
                tk::sort16_desc(grp[kb]); __builtin_amdgcn_sched_barrier(0);
            }
            tk::merge_prune(grp[0], grp[1]); __builtin_amdgcn_sched_barrier(0); tk::merge_prune(grp[2], grp[3]); __builtin_amdgcn_sched_barrier(0); tk::merge_prune(grp[0], grp[2]); __builtin_amdgcn_sched_barrier(0);
            float oth[16];
#pragma unroll
            for (int r = 0; r < 16; ++r) { const auto rr = __builtin_amdgcn_permlane32_swap(__float_as_uint(grp[0][r]), __float_as_uint(grp[0][r]), false, false); oth[r] = __uint_as_float(hh == 0 ? rr[1] : rr[0]); }
            tk::merge_prune(grp[0], oth);
#pragma unroll
            for (int r = 0; r < 16; ++r) top[s][r] = grp[0][r];
            __builtin_amdgcn_sched_barrier(0);
        }
        float cg[4][16];
#pragma unroll
        for (int q = 0; q < 4; ++q)
#pragma unroll
            for (int r = 0; r < 16; ++r) cg[q][r] = -INFINITY;
        cg[0][0] = __uint_as_float((__float_as_uint(top[0][0] + top[1][0]) & ~255u) | 0u);
        cg[0][1] = __uint_as_float((__float_as_uint(top[0][0] + top[1][1]) & ~255u) | 1u);
        cg[0][2] = __uint_as_float((__float_as_uint(top[0][0] + top[1][2]) & ~255u) | 2u);
        cg[0][3] = __uint_as_float((__float_as_uint(top[0][0] + top[1][3]) & ~255u) | 3u);
        cg[0][4] = __uint_as_float((__float_as_uint(top[0][0] + top[1][4]) & ~255u) | 4u);
        cg[0][5] = __uint_as_float((__float_as_uint(top[0][0] + top[1][5]) & ~255u) | 5u);
        cg[0][6] = __uint_as_float((__float_as_uint(top[0][0] + top[1][6]) & ~255u) | 6u);
        cg[0][7] = __uint_as_float((__float_as_uint(top[0][0] + top[1][7]) & ~255u) | 7u);
        cg[0][8] = __uint_as_float((__float_as_uint(top[0][0] + top[1][8]) & ~255u) | 8u);
        cg[0][9] = __uint_as_float((__float_as_uint(top[0][0] + top[1][9]) & ~255u) | 9u);
        cg[0][10] = __uint_as_float((__float_as_uint(top[0][0] + top[1][10]) & ~255u) | 10u);
        cg[0][11] = __uint_as_float((__float_as_uint(top[0][0] + top[1][11]) & ~255u) | 11u);
        cg[0][12] = __uint_as_float((__float_as_uint(top[0][0] + top[1][12]) & ~255u) | 12u);
        cg[0][13] = __uint_as_float((__float_as_uint(top[0][0] + top[1][13]) & ~255u) | 13u);
        cg[0][14] = __uint_as_float((__float_as_uint(top[0][0] + top[1][14]) & ~255u) | 14u);
        cg[0][15] = __uint_as_float((__float_as_uint(top[0][0] + top[1][15]) & ~255u) | 15u);
        cg[1][0] = __uint_as_float((__float_as_uint(top[0][1] + top[1][0]) & ~255u) | 16u);
        cg[1][1] = __uint_as_float((__float_as_uint(top[0][1] + top[1][1]) & ~255u) | 17u);
        cg[1][2] = __uint_as_float((__float_as_uint(top[0][1] + top[1][2]) & ~255u) | 18u);
        cg[1][3] = __uint_as_float((__float_as_uint(top[0][1] + top[1][3]) & ~255u) | 19u);
        cg[1][4] = __uint_as_float((__float_as_uint(top[0][1] + top[1][4]) & ~255u) | 20u);
        cg[1][5] = __uint_as_float((__float_as_uint(top[0][1] + top[1][5]) & ~255u) | 21u);
        cg[1][6] = __uint_as_float((__float_as_uint(top[0][1] + top[1][6]) & ~255u) | 22u);
        cg[1][7] = __uint_as_float((__float_as_uint(top[0][1] + top[1][7]) & ~255u) | 23u);
        cg[1][8] = __uint_as_float((__float_as_uint(top[0][2] + top[1][0]) & ~255u) | 32u);
        cg[1][9] = __uint_as_float((__float_as_uint(top[0][2] + top[1][1]) & ~255u) | 33u);
        cg[1][10] = __uint_as_float((__float_as_uint(top[0][2] + top[1][2]) & ~255u) | 34u);
        cg[1][11] = __uint_as_float((__float_as_uint(top[0][2] + top[1][3]) & ~255u) | 35u);
        cg[1][12] = __uint_as_float((__float_as_uint(top[0][2] + top[1][4]) & ~255u) | 36u);
        cg[1][13] = __uint_as_float((__float_as_uint(top[0][3] + top[1][0]) & ~255u) | 48u);
        cg[1][14] = __uint_as_float((__float_as_uint(top[0][3] + top[1][1]) & ~255u) | 49u);
        cg[1][15] = __uint_as_float((__float_as_uint(top[0][3] + top[1][2]) & ~255u) | 50u);
        cg[2][0] = __uint_as_float((__float_as_uint(top[0][3] + top[1][3]) & ~255u) | 51u);
        cg[2][1] = __uint_as_float((__float_as_uint(top[0][4] + top[1][0]) & ~255u) | 64u);
        cg[2][2] = __uint_as_float((__float_as_uint(top[0][4] + top[1][1]) & ~255u) | 65u);
        cg[2][3] = __uint_as_float((__float_as_uint(top[0][4] + top[1][2]) & ~255u) | 66u);
        cg[2][4] = __uint_as_float((__float_as_uint(top[0][5] + top[1][0]) & ~255u) | 80u);
        cg[2][5] = __uint_as_float((__float_as_uint(top[0][5] + top[1][1]) & ~255u) | 81u);
        cg[2][6] = __uint_as_float((__float_as_uint(top[0][6] + top[1][0]) & ~255u) | 96u);
        cg[2][7] = __uint_as_float((__float_as_uint(top[0][6] + top[1][1]) & ~255u) | 97u);
        cg[2][8] = __uint_as_float((__float_as_uint(top[0][7] + top[1][0]) & ~255u) | 112u);
        cg[2][9] = __uint_as_float((__float_as_uint(top[0][7] + top[1][1]) & ~255u) | 113u);
        cg[2][10] = __uint_as_float((__float_as_uint(top[0][8] + top[1][0]) & ~255u) | 128u);
        cg[2][11] = __uint_as_float((__float_as_uint(top[0][9] + top[1][0]) & ~255u) | 144u);
        cg[2][12] = __uint_as_float((__float_as_uint(top[0][10] + top[1][0]) & ~255u) | 160u);
        cg[2][13] = __uint_as_float((__float_as_uint(top[0][11] + top[1][0]) & ~255u) | 176u);
        cg[2][14] = __uint_as_float((__float_as_uint(top[0][12] + top[1][0]) & ~255u) | 192u);
        cg[2][15] = __uint_as_float((__float_as_uint(top[0][13] + top[1][0]) & ~255u) | 208u);
        cg[3][0] = __uint_as_float((__float_as_uint(top[0][14] + top[1][0]) & ~255u) | 224u);
        cg[3][1] = __uint_as_float((__float_as_uint(top[0][15] + top[1][0]) & ~255u) | 240u);
#pragma unroll
        for (int q = 0; q < 4; ++q) { tk::sort16_desc(cg[q]); __builtin_amdgcn_sched_barrier(0); }
        tk::merge_prune(cg[0], cg[1]); __builtin_amdgcn_sched_barrier(0); tk::merge_prune(cg[2], cg[3]); __builtin_amdgcn_sched_barrier(0); tk::merge_prune(cg[0], cg[2]); __builtin_amdgcn_sched_barrier(0);
        int eidx[16]; float ev[16]; float sum = 0.f;
#pragma unroll
        for (int r = 0; r < 16; ++r) {
            const unsigned bits = __float_as_uint(cg[0][r]); const int ci = (bits >> 4) & 15, cj = bits & 15;
            int ia = 0, ib = 0;
#pragma unroll
            for (int i = 0; i < 16; ++i) { ia = (ci == i) ? (int)(__float_as_uint(top[0][i]) & 127u) : ia; ib = (cj == i) ? (int)(__float_as_uint(top[1][i]) & 127u) : ib; }
            eidx[r] = ia * 128 + ib;
            ev[r] = __expf(cg[0][r] - cg[0][0]); sum += ev[r];
        }
        const float rs = 1.f / sum;
        int* oi = SELI + (size_t)(g0 + r32) * 128 + h * 16 + hh * 8; float* og = SELG + (size_t)(g0 + r32) * 128 + h * 16 + hh * 8;
        if (hh == 0) {
#pragma unroll
            for (int r = 0; r < 8; ++r) { oi[r] = eidx[r]; og[r] = ev[r] * rs; }
        } else {
#pragma unroll
            for (int r = 0; r < 8; ++r) { oi[r] = eidx[8 + r]; og[r] = ev[8 + r] * rs; }
        }
    }
}

__device__ __forceinline__ void phase_peer_gather(const Args& a, int layer, int mode) {
    const int lane = threadIdx.x & 63, gw = blockIdx.x * NWAVE + (threadIdx.x >> 6), ngw = gridDim.x * NWAVE;
    unsigned char* ws = a.ws;
    bf16_t* H = (bf16_t*)(ws + WS_H); float* X1 = (float*)(ws + WS_X1);
    const bf16_t* PU = (const bf16_t*)(ws + WS_PU) + (size_t)layer * NEXP * D; const bf16_t* PV = (const bf16_t*)(ws + WS_PV) + (size_t)layer * NEXP * D;
    const int* SELI = (const int*)(ws + WS_SELI); const float* SELG = (const float*)(ws + WS_SELG);
    for (int g = gw; g < MTOT; g += ngw) {
        const int var = row_variant(g);
        if (mode == 1 && var == 2) continue;
        float hp[16], acc[16];
        {
            const u32x4 w0 = *(const u32x4*)(H + (size_t)g * D + lane * 16), w1 = *(const u32x4*)(H + (size_t)g * D + lane * 16 + 8);
            hp[0] = bflo(w0.x); hp[1] = bfhi(w0.x); hp[2] = bflo(w0.y); hp[3] = bfhi(w0.y); hp[4] = bflo(w0.z); hp[5] = bfhi(w0.z); hp[6] = bflo(w0.w); hp[7] = bfhi(w0.w);
            hp[8] = bflo(w1.x); hp[9] = bfhi(w1.x); hp[10] = bflo(w1.y); hp[11] = bfhi(w1.y); hp[12] = bflo(w1.z); hp[13] = bfhi(w1.z); hp[14] = bflo(w1.w); hp[15] = bfhi(w1.w);
#pragma unroll
            for (int d = 0; d < 16; ++d) acc[d] = 0.f;
        }
        const int myi0 = SELI[(size_t)g * 128 + lane], myi1 = SELI[(size_t)g * 128 + 64 + lane];
        const float myg0 = SELG[(size_t)g * 128 + lane], myg1 = SELG[(size_t)g * 128 + 64 + lane];
        for (int e = 0; e < 128; ++e) {
            const int ei = e < 64 ? __shfl(myi0, e) : __shfl(myi1, e - 64);
            const float eg = e < 64 ? __shfl(myg0, e) : __shfl(myg1, e - 64);
            const bf16_t* up = PU + (size_t)ei * D + lane * 16; const bf16_t* vp = PV + (size_t)ei * D + lane * 16;
            const u32x4 u0 = *(const u32x4*)up, u1 = *(const u32x4*)(up + 8), v0 = *(const u32x4*)vp, v1 = *(const u32x4*)(vp + 8);
            float dt = hp[0] * bflo(u0.x) + hp[1] * bfhi(u0.x) + hp[2] * bflo(u0.y) + hp[3] * bfhi(u0.y) + hp[4] * bflo(u0.z) + hp[5] * bfhi(u0.z) + hp[6] * bflo(u0.w) + hp[7] * bfhi(u0.w)
                     + hp[8] * bflo(u1.x) + hp[9] * bfhi(u1.x) + hp[10] * bflo(u1.y) + hp[11] * bfhi(u1.y) + hp[12] * bflo(u1.z) + hp[13] * bfhi(u1.z) + hp[14] * bflo(u1.w) + hp[15] * bfhi(u1.w);
            dt = wave_sum(dt);
            const float act = gelu_t(dt) * eg;
            acc[0] += act * bflo(v0.x); acc[1] += act * bfhi(v0.x); acc[2] += act * bflo(v0.y); acc[3] += act * bfhi(v0.y);
            acc[4] += act * bflo(v0.z); acc[5] += act * bfhi(v0.z); acc[6] += act * bflo(v0.w); acc[7] += act * bfhi(v0.w);
            acc[8] += act * bflo(v1.x); acc[9] += act * bfhi(v1.x); acc[10] += act * bflo(v1.y); acc[11] += act * bfhi(v1.y);
            acc[12] += act * bflo(v1.z); acc[13] += act * bfhi(v1.z); acc[14] += act * bflo(v1.w); acc[15] += act * bfhi(v1.w);
        }
        float* xr = X1 + (size_t)g * D + lane * 16;
        const float* g2 = modv(a, layer, var, 5) + lane * 16;
        float xn[16]; float ss = 0.f;
#pragma unroll
        for (int d = 0; d < 16; d += 4) {
            const f32x4 xv = *(const f32x4*)(xr + d), gv = *(const f32x4*)(g2 + d);
            xn[d] = xv.x + gv.x * acc[d]; xn[d + 1] = xv.y + gv.y * acc[d + 1]; xn[d + 2] = xv.z + gv.z * acc[d + 2]; xn[d + 3] = xv.w + gv.w * acc[d + 3];
            ss += xn[d] * xn[d] + xn[d + 1] * xn[d + 1] + xn[d + 2] * xn[d + 2] + xn[d + 3] * xn[d + 3];
        }
        const float rinv = rsqrtf(wave_sum(ss) * (1.f / D) + EPS);
        if (mode == 0) {
#pragma unroll
            for (int d = 0; d < 16; d += 4) { f32x4 o; o.x = xn[d]; o.y = xn[d + 1]; o.z = xn[d + 2]; o.w = xn[d + 3]; *(f32x4*)(xr + d) = o; }
            const float* gn = a.in[6] + D + lane * 16; const float* sh = modv(a, 1, var, 0) + lane * 16; const float* sc = modv(a, 1, var, 1) + lane * 16;
            unsigned w[8];
#pragma unroll
            for (int d = 0; d < 16; d += 2) w[d >> 1] = pk2(xn[d] * rinv * gn[d] * (1.f + sc[d]) + sh[d], xn[d + 1] * rinv * gn[d + 1] * (1.f + sc[d + 1]) + sh[d + 1]);
            u32x4 o0, o1; o0.x = w[0]; o0.y = w[1]; o0.z = w[2]; o0.w = w[3]; o1.x = w[4]; o1.y = w[5]; o1.z = w[6]; o1.w = w[7];
            *(u32x4*)(H + (size_t)g * D + lane * 16) = o0; *(u32x4*)(H + (size_t)g * D + lane * 16 + 8) = o1;
        } else {
            const int b = g / RPB, t = g - b * RPB - CTXL;
            float* op = a.out + ((size_t)b * SEQ + t) * D + lane * 16; const float* gn = a.in[28] + lane * 16;
#pragma unroll
            for (int d = 0; d < 16; d += 4) { f32x4 o; o.x = xn[d] * rinv * gn[d]; o.y = xn[d + 1] * rinv * gn[d + 1]; o.z = xn[d + 2] * rinv * gn[d + 2]; o.w = xn[d + 3] * rinv * gn[d + 3]; *(f32x4*)(op + d) = o; }
        }
    }
}

typedef __bf16 bf16x2_t __attribute__((ext_vector_type(2)));
__device__ __forceinline__ float dot2bf(unsigned w, unsigned x, float acc) { return __builtin_amdgcn_fdot2_f32_bf16(__builtin_bit_cast(bf16x2_t, w), __builtin_bit_cast(bf16x2_t, x), acc, false); }
struct Row8 { u32x4 c[8]; };
__device__ __forceinline__ void load_row8(Row8& r, const bf16_t* p) {
#pragma unroll
    for (int c = 0; c < 8; ++c) r.c[c] = *(const u32x4*)(p + c * 128);
}
__device__ __forceinline__ float dot_row8(const Row8& r, const u32x4 (&hp)[8]) {
    float a0 = 0.f, a1 = 0.f, a2 = 0.f, a3 = 0.f;
#pragma unroll
    for (int c = 0; c < 8; ++c) { a0 = dot2bf(r.c[c].x, hp[c].x, a0); a1 = dot2bf(r.c[c].y, hp[c].y, a1); a2 = dot2bf(r.c[c].z, hp[c].z, a2); a3 = dot2bf(r.c[c].w, hp[c].w, a3); }
    float s = (a0 + a1) + (a2 + a3);
    s += __shfl_xor(s, 1); s += __shfl_xor(s, 2); s += __shfl_xor(s, 4); s += __shfl_xor(s, 8);
    return s;
}
__device__ __forceinline__ void fma_row(float (&acc)[16], const u32x4& v0, const u32x4& v1, float a) {
    acc[0] += a * bflo(v0.x); acc[1] += a * bfhi(v0.x); acc[2] += a * bflo(v0.y); acc[3] += a * bfhi(v0.y);
    acc[4] += a * bflo(v0.z); acc[5] += a * bfhi(v0.z); acc[6] += a * bflo(v0.w); acc[7] += a * bfhi(v0.w);
    acc[8] += a * bflo(v1.x); acc[9] += a * bfhi(v1.x); acc[10] += a * bflo(v1.y); acc[11] += a * bfhi(v1.y);
    acc[12] += a * bflo(v1.z); acc[13] += a * bfhi(v1.z); acc[14] += a * bflo(v1.w); acc[15] += a * bfhi(v1.w);
}
__device__ __forceinline__ void phase_peer_gather2(const Args& a, char* lds, int layer, int mode) {
    const int lane = threadIdx.x & 63, wid = threadIdx.x >> 6, gw = blockIdx.x * NWAVE + wid, ngw = gridDim.x * NWAVE;
    const int grp = lane >> 4, sub = lane & 15;
    unsigned char* ws = a.ws;
    bf16_t* H = (bf16_t*)(ws + WS_H); float* X1 = (float*)(ws + WS_X1);
    const bf16_t* PU = (const bf16_t*)(ws + WS_PU) + (size_t)layer * NEXP * D; const bf16_t* PV = (const bf16_t*)(ws + WS_PV) + (size_t)layer * NEXP * D;
    const int* SELI = (const int*)(ws + WS_SELI); const float* SELG = (const float*)(ws + WS_SELG);
    LAS int* lidx = (LAS int*)((LAS char*)lds + wid * 2048);
    LAS float* lgate = (LAS float*)(lidx + 128);
    LAS float* lact = lgate + 128;
    for (int g = gw; g < MTOT; g += ngw) {
        const int var = row_variant(g);
        if (mode == 1 && var == 2) continue;
        lidx[lane] = SELI[(size_t)g * 128 + lane]; lidx[64 + lane] = SELI[(size_t)g * 128 + 64 + lane];
        lgate[lane] = SELG[(size_t)g * 128 + lane]; lgate[64 + lane] = SELG[(size_t)g * 128 + 64 + lane];
        u32x4 hp[8];
#pragma unroll
        for (int c = 0; c < 8; ++c) hp[c] = *(const u32x4*)(H + (size_t)g * D + c * 128 + sub * 8);
        {
            Row8 ra, rb;
            load_row8(ra, PU + (size_t)lidx[grp] * D + sub * 8);
            for (int it = 0; it < 32; it += 2) {
                load_row8(rb, PU + (size_t)lidx[(it + 1) * 4 + grp] * D + sub * 8);
                { const float s = dot_row8(ra, hp); const int e = it * 4 + grp; if (sub == 0) lact[e] = gelu_t(s) * lgate[e]; }
                if (it + 2 < 32) load_row8(ra, PU + (size_t)lidx[(it + 2) * 4 + grp] * D + sub * 8);
                { const float s = dot_row8(rb, hp); const int e = (it + 1) * 4 + grp; if (sub == 0) lact[e] = gelu_t(s) * lgate[e]; }
            }
        }
        float acc[16];
#pragma unroll
        for (int d = 0; d < 16; ++d) acc[d] = 0.f;
        {
            u32x4 va[4][2], vb[4][2];
#pragma unroll
            for (int k = 0; k < 4; ++k) { const bf16_t* p = PV + (size_t)lidx[k] * D + lane * 8; va[k][0] = *(const u32x4*)p; va[k][1] = *(const u32x4*)(p + 512); }
            for (int e = 0; e < 128; e += 8) {
#pragma unroll
                for (int k = 0; k < 4; ++k) { const bf16_t* p = PV + (size_t)lidx[e + 4 + k] * D + lane * 8; vb[k][0] = *(const u32x4*)p; vb[k][1] = *(const u32x4*)(p + 512); }
#pragma unroll
                for (int k = 0; k < 4; ++k) fma_row(acc, va[k][0], va[k][1], lact[e + k]);
                if (e + 8 < 128) {
#pragma unroll
                    for (int k = 0; k < 4; ++k) { const bf16_t* p = PV + (size_t)lidx[e + 8 + k] * D + lane * 8; va[k][0] = *(const u32x4*)p; va[k][1] = *(const u32x4*)(p + 512); }
                }
#pragma unroll
                for (int k = 0; k < 4; ++k) fma_row(acc, vb[k][0], vb[k][1], lact[e + 4 + k]);
            }
        }
        float* xr = X1 + (size_t)g * D + lane * 8;
        const float* g2 = modv(a, layer, var, 5) + lane * 8;
        float xn[16]; float ss = 0.f;
#pragma unroll
        for (int hh = 0; hh < 2; ++hh)
#pragma unroll
            for (int d = 0; d < 8; d += 4) {
                const f32x4 xv = *(const f32x4*)(xr + hh * 512 + d), gv = *(const f32x4*)(g2 + hh * 512 + d);
                const int o = hh * 8 + d;
                xn[o] = xv.x + gv.x * acc[o]; xn[o + 1] = xv.y + gv.y * acc[o + 1]; xn[o + 2] = xv.z + gv.z * acc[o + 2]; xn[o + 3] = xv.w + gv.w * acc[o + 3];
                ss += xn[o] * xn[o] + xn[o + 1] * xn[o + 1] + xn[o + 2] * xn[o + 2] + xn[o + 3] * xn[o + 3];
            }
        const float rinv = rsqrtf(wave_sum(ss) * (1.f / D) + EPS);
        if (mode == 0) {
            const float* gn = a.in[6] + D + lane * 8; const float* sh = modv(a, 1, var, 0) + lane * 8; const float* sc = modv(a, 1, var, 1) + lane * 8;
#pragma unroll
            for (int hh = 0; hh < 2; ++hh) {
                const int o = hh * 8;
                f32x4 o0, o1; o0.x = xn[o]; o0.y = xn[o + 1]; o0.z = xn[o + 2]; o0.w = xn[o + 3]; o1.x = xn[o + 4]; o1.y = xn[o + 5]; o1.z = xn[o + 6]; o1.w = xn[o + 7];
                *(f32x4*)(xr + hh * 512) = o0; *(f32x4*)(xr + hh * 512 + 4) = o1;
                unsigned w[4];
#pragma unroll
                for (int d = 0; d < 8; d += 2) { const int cc = hh * 512 + d; w[d >> 1] = pk2(xn[o + d] * rinv * gn[cc] * (1.f + sc[cc]) + sh[cc], xn[o + d + 1] * rinv * gn[cc + 1] * (1.f + sc[cc + 1]) + sh[cc + 1]); }
                u32x4 ow; ow.x = w[0]; ow.y = w[1]; ow.z = w[2]; ow.w = w[3];
                *(u32x4*)(H + (size_t)g * D + hh * 512 + lane * 8) = ow;
            }
        } else {
            const int b = g / RPB, t = g - b * RPB - CTXL;
            float* op = a.out + ((size_t)b * SEQ + t) * D + lane * 8; const float* gn = a.in[28] + lane * 8;
#pragma unroll
            for (int hh = 0; hh < 2; ++hh)
#pragma unroll
                for (int d = 0; d < 8; d += 4) { const int o = hh * 8 + d, cc = hh * 512 + d;
                    f32x4 ov; ov.x = xn[o] * rinv * gn[cc]; ov.y = xn[o + 1] * rinv * gn[cc + 1]; ov.z = xn[o + 2] * rinv * gn[cc + 2]; ov.w = xn[o + 3] * rinv * gn[cc + 3]; *(f32x4*)(op + cc) = ov; }
        }
    }
}

__device__ __forceinline__ float ub0(unsigned w) { return (float)(w & 0xffu); }
__device__ __forceinline__ float ub1(unsigned w) { return (float)((w >> 8) & 0xffu); }
__device__ __forceinline__ float ub2(unsigned w) { return (float)((w >> 16) & 0xffu); }
__device__ __forceinline__ float ub3(unsigned w) { return (float)(w >> 24); }
struct RowU { u32x4 c[4]; };
__device__ __forceinline__ void load_rowu(RowU& r, const unsigned char* p) {
#pragma unroll
    for (int c = 0; c < 4; ++c) r.c[c] = *(const u32x4*)(p + c * 256);
}
__device__ __forceinline__ float dot_rowu(const RowU& r, const float (&hp)[64]) {
    float a0 = 0.f, a1 = 0.f, a2 = 0.f, a3 = 0.f;
#pragma unroll
    for (int c = 0; c < 4; ++c) {
        const unsigned w0 = r.c[c].x, w1 = r.c[c].y, w2 = r.c[c].z, w3 = r.c[c].w; const int o = c * 16;
        a0 += hp[o + 0] * ub0(w0); a1 += hp[o + 1] * ub1(w0); a2 += hp[o + 2] * ub2(w0); a3 += hp[o + 3] * ub3(w0);
        a0 += hp[o + 4] * ub0(w1); a1 += hp[o + 5] * ub1(w1); a2 += hp[o + 6] * ub2(w1); a3 += hp[o + 7] * ub3(w1);
        a0 += hp[o + 8] * ub0(w2); a1 += hp[o + 9] * ub1(w2); a2 += hp[o + 10] * ub2(w2); a3 += hp[o + 11] * ub3(w2);
        a0 += hp[o + 12] * ub0(w3); a1 += hp[o + 13] * ub1(w3); a2 += hp[o + 14] * ub2(w3); a3 += hp[o + 15] * ub3(w3);
    }
    float s = (a0 + a1) + (a2 + a3);
    s += __shfl_xor(s, 1); s += __shfl_xor(s, 2); s += __shfl_xor(s, 4); s += __shfl_xor(s, 8);
    return s;
}
__device__ __forceinline__ void fma_rowv(float (&acc)[16], const u32x4& v, float a) {
    acc[0] += a * ub0(v.x); acc[1] += a * ub1(v.x); acc[2] += a * ub2(v.x); acc[3] += a * ub3(v.x);
    acc[4] += a * ub0(v.y); acc[5] += a * ub1(v.y); acc[6] += a * ub2(v.y); acc[7] += a * ub3(v.y);
    acc[8] += a * ub0(v.z); acc[9] += a * ub1(v.z); acc[10] += a * ub2(v.z); acc[11] += a * ub3(v.z);
    acc[12] += a * ub0(v.w); acc[13] += a * ub1(v.w); acc[14] += a * ub2(v.w); acc[15] += a * ub3(v.w);
}
__device__ __forceinline__ void phase_peer_gather3(const Args& a, char* lds, int layer, int mode) {
    const int lane = threadIdx.x & 63, wid = __builtin_amdgcn_readfirstlane(threadIdx.x >> 6), gw = blockIdx.x * NWAVE + wid, ngw = gridDim.x * NWAVE;
    const int grp = lane >> 4, sub = lane & 15;
    unsigned char* ws = a.ws;
    bf16_t* H = (bf16_t*)(ws + WS_H); float* X1 = (float*)(ws + WS_X1);
    const unsigned char* PU = ws + WS_PU + (size_t)layer * NEXP * D; const unsigned char* PV = ws + WS_PV + (size_t)layer * NEXP * D;
    const float* SCU = (const float*)(ws + WS_SCU) + layer * NEXP; const float* SCV = (const float*)(ws + WS_SCV) + layer * NEXP;
    const int* SELI = (const int*)(ws + WS_SELI); const float* SELG = (const float*)(ws + WS_SELG);
    LAS int* lidx = (LAS int*)((LAS char*)lds + wid * 2048);
    LAS float* lgu = (LAS float*)(lidx + 128);
    LAS float* lact = lgu + 128;
    for (int g = gw; g < MTOT; g += ngw) {
        const int var = row_variant(g);
        if (mode == 1 && var == 2) continue;
        {
            const int i0 = SELI[(size_t)g * 128 + lane], i1 = SELI[(size_t)g * 128 + 64 + lane];
            lidx[lane] = i0; lidx[64 + lane] = i1;
            lgu[lane] = SCU[i0]; lgu[64 + lane] = SCU[i1];
        }
        float hp[64]; float shp = 0.f;
#pragma unroll
        for (int c = 0; c < 4; ++c) {
            const u32x4 w0 = *(const u32x4*)(H + (size_t)g * D + c * 256 + sub * 16), w1 = *(const u32x4*)(H + (size_t)g * D + c * 256 + sub * 16 + 8);
            const int o = c * 16;
            hp[o + 0] = bflo(w0.x); hp[o + 1] = bfhi(w0.x); hp[o + 2] = bflo(w0.y); hp[o + 3] = bfhi(w0.y); hp[o + 4] = bflo(w0.z); hp[o + 5] = bfhi(w0.z); hp[o + 6] = bflo(w0.w); hp[o + 7] = bfhi(w0.w);
            hp[o + 8] = bflo(w1.x); hp[o + 9] = bfhi(w1.x); hp[o + 10] = bflo(w1.y); hp[o + 11] = bfhi(w1.y); hp[o + 12] = bflo(w1.z); hp[o + 13] = bfhi(w1.z); hp[o + 14] = bflo(w1.w); hp[o + 15] = bfhi(w1.w);
        }
#pragma unroll
        for (int d = 0; d < 64; ++d) shp += hp[d];
        shp += __shfl_xor(shp, 1); shp += __shfl_xor(shp, 2); shp += __shfl_xor(shp, 4); shp += __shfl_xor(shp, 8);
        const float bias = 128.f * shp;
        {
            RowU r0, r1, r2, r3;
            load_rowu(r0, PU + (size_t)lidx[0 * 4 + grp] * D + sub * 16); load_rowu(r1, PU + (size_t)lidx[1 * 4 + grp] * D + sub * 16);
            load_rowu(r2, PU + (size_t)lidx[2 * 4 + grp] * D + sub * 16); load_rowu(r3, PU + (size_t)lidx[3 * 4 + grp] * D + sub * 16);
#define GU_STEP(R, IT) { const float s = dot_rowu(R, hp) - bias; const int e = (IT) * 4 + grp; const float su = lgu[e]; \
                if ((IT) + 4 < 32) load_rowu(R, PU + (size_t)lidx[((IT) + 4) * 4 + grp] * D + sub * 16); \
                if (sub == 0) lact[e] = gelu_t(s * su); }
            for (int it = 0; it < 32; it += 4) { GU_STEP(r0, it) GU_STEP(r1, it + 1) GU_STEP(r2, it + 2) GU_STEP(r3, it + 3) }
#undef GU_STEP
        }
        {
            const float g0 = SELG[(size_t)g * 128 + lane], g1 = SELG[(size_t)g * 128 + 64 + lane];
            const float a0 = lact[lane] * g0 * SCV[lidx[lane]], a1 = lact[64 + lane] * g1 * SCV[lidx[64 + lane]];
            lact[lane] = a0; lact[64 + lane] = a1;
        }
        float acc[16]; float sact = 0.f;
#pragma unroll
        for (int d = 0; d < 16; ++d) acc[d] = 0.f;
        {
            u32x4 va[8];
#pragma unroll
            for (int k = 0; k < 8; ++k) va[k] = *(const u32x4*)(PV + (size_t)lidx[k] * D + lane * 16);
            for (int e = 0; e < 128; e += 8) {
#pragma unroll
                for (int k = 0; k < 8; ++k) {
                    const float av = lact[e + k]; sact += av;
                    fma_rowv(acc, va[k], av);
                    if (e + 8 < 128) va[k] = *(const u32x4*)(PV + (size_t)lidx[e + 8 + k] * D + lane * 16);
                }
            }
        }
        const float vb = 128.f * sact;
        float* xr = X1 + (size_t)g * D + lane * 16;
        const float* g2 = modv(a, layer, var, 5) + lane * 16;
        float xn[16]; float ss = 0.f;
#pragma unroll
        for (int d = 0; d < 16; d += 4) {
            const f32x4 xv = *(const f32x4*)(xr + d), gv = *(const f32x4*)(g2 + d);
            xn[d] = xv.x + gv.x * (acc[d] - vb); xn[d + 1] = xv.y + gv.y * (acc[d + 1] - vb); xn[d + 2] = xv.z + gv.z * (acc[d + 2] - vb); xn[d + 3] = xv.w + gv.w * (acc[d + 3] - vb);
            ss += xn[d] * xn[d] + xn[d + 1] * xn[d + 1] + xn[d + 2] * xn[d + 2] + xn[d + 3] * xn[d + 3];
        }
        const float rinv = rsqrtf(wave_sum(ss) * (1.f / D) + EPS);
        if (mode == 0) {
#pragma unroll
            for (int d = 0; d < 16; d += 4) { f32x4 o; o.x = xn[d]; o.y = xn[d + 1]; o.z = xn[d + 2]; o.w = xn[d + 3]; *(f32x4*)(xr + d) = o; }
            const float* gn = a.in[6] + D + lane * 16; const float* sh = modv(a, 1, var, 0) + lane * 16; const float* sc = modv(a, 1, var, 1) + lane * 16;
            unsigned w[8];
#pragma unroll
            for (int d = 0; d < 16; d += 2) w[d >> 1] = pk2(xn[d] * rinv * gn[d] * (1.f + sc[d]) + sh[d], xn[d + 1] * rinv * gn[d + 1] * (1.f + sc[d + 1]) + sh[d + 1]);
            u32x4 o0, o1; o0.x = w[0]; o0.y = w[1]; o0.z = w[2]; o0.w = w[3]; o1.x = w[4]; o1.y = w[5]; o1.z = w[6]; o1.w = w[7];
            *(u32x4*)(H + (size_t)g * D + lane * 16) = o0; *(u32x4*)(H + (size_t)g * D + lane * 16 + 8) = o1;
        } else {
            const int b = g / RPB, t = g - b * RPB - CTXL;
            float* op = a.out + ((size_t)b * SEQ + t) * D + lane * 16; const float* gn = a.in[28] + lane * 16;
#pragma unroll
            for (int d = 0; d < 16; d += 4) { f32x4 o; o.x = xn[d] * rinv * gn[d]; o.y = xn[d + 1] * rinv * gn[d + 1]; o.z = xn[d + 2] * rinv * gn[d + 2]; o.w = xn[d + 3] * rinv * gn[d + 3]; *(f32x4*)(op + d) = o; }
        }
    }
}

__device__ __forceinline__ int peer_tok(int i, int mode) { return mode == 1 ? i + CTXL + (i >= SEQ ? CTXL : 0) : i; }
__device__ __forceinline__ float dot16u(const u32x4& w, const float (&hp)[16]) {
    float a0 = hp[0] * ub0(w.x) + hp[4] * ub0(w.y), a1 = hp[1] * ub1(w.x) + hp[5] * ub1(w.y), a2 = hp[2] * ub2(w.x) + hp[6] * ub2(w.y), a3 = hp[3] * ub3(w.x) + hp[7] * ub3(w.y);
    a0 += hp[8] * ub0(w.z) + hp[12] * ub0(w.w); a1 += hp[9] * ub1(w.z) + hp[13] * ub1(w.w); a2 += hp[10] * ub2(w.z) + hp[14] * ub2(w.w); a3 += hp[11] * ub3(w.z) + hp[15] * ub3(w.w);
    return (a0 + a1) + (a2 + a3);
}
__device__ __forceinline__ void gu_stage(u32x4 (&seg)[16], u32x4& hw, LAS int* lb, int i0, int i1, const unsigned char* hrow, const unsigned char* PUx, int lane, int eg) {
    lb[lane] = i0; lb[64 + lane] = i1;
    hw = *(const u32x4*)hrow;
#pragma unroll
    for (int st = 0; st < 16; ++st) seg[st] = *(const u32x4*)(PUx + (size_t)lb[st * 8 + eg] * 128);
}
__device__ __forceinline__ void gu_compute(const u32x4 (&seg)[16], const u32x4& hw, LAS float* lpart, float* prow, int lane, int eg, int sub, bool valid) {
#pragma unroll
    for (int st = 0; st < 16; ++st) {
        int d = __builtin_amdgcn_sdot4((int)seg[st].x, (int)hw.x, 0, false);
        d = __builtin_amdgcn_sdot4((int)seg[st].y, (int)hw.y, d, false); d = __builtin_amdgcn_sdot4((int)seg[st].z, (int)hw.z, d, false); d = __builtin_amdgcn_sdot4((int)seg[st].w, (int)hw.w, d, false);
        d += __shfl_xor(d, 1); d += __shfl_xor(d, 2); d += __shfl_xor(d, 4);
        if (sub == 0) lpart[st * 8 + eg] = (float)d;
    }
    if (valid) { prow[lane] = lpart[lane]; prow[64 + lane] = lpart[64 + lane]; }
}
__device__ __forceinline__ void phase_gu(const Args& a, char* lds, int layer, int mode) {
    const int lane = threadIdx.x & 63, wid = __builtin_amdgcn_readfirstlane(threadIdx.x >> 6), eg = lane >> 3, sub = lane & 7;
    const int x = blockIdx.x & 7, stripe = blockIdx.x >> 3, nstr = (gridDim.x >> 3) * NWAVE, ntok = mode == 1 ? NB * SEQ : MTOT;
    unsigned char* ws = a.ws;
    const unsigned char* H8 = ws + WS_H8 + x * 128 + sub * 16;
    const unsigned char* PUx = ws + WS_PU + (size_t)layer * NEXP * D + (size_t)x * NEXP * 128 + sub * 16;
    const int* SELI = (const int*)(ws + WS_SELI); float* PART = (float*)(ws + WS_PART) + (size_t)x * MTOT * 128;
    LAS int* lidx = (LAS int*)((LAS char*)lds + wid * 2048);
    LAS float* lpart = (LAS float*)(lidx + 256);
    const int first = stripe * NWAVE + wid;
#define G_TOK(k) peer_tok(min(first + (k) * nstr, ntok - 1), mode)
#define G_VALID(k) (first + (k) * nstr < ntok)
    u32x4 segA[16], segB[16], hwA, hwB;
    int p0, p1;
    { const int g = G_TOK(0); p0 = SELI[(size_t)g * 128 + lane]; p1 = SELI[(size_t)g * 128 + 64 + lane];
      gu_stage(segA, hwA, lidx, p0, p1, H8 + (size_t)g * D, PUx, lane, eg); }
    { const int g = G_TOK(1); p0 = SELI[(size_t)g * 128 + lane]; p1 = SELI[(size_t)g * 128 + 64 + lane]; }
    for (int k = 0; G_VALID(k); k += 2) {
        { const int g1 = G_TOK(k + 1); gu_stage(segB, hwB, lidx + 128, p0, p1, H8 + (size_t)g1 * D, PUx, lane, eg); }
        { const int g2 = G_TOK(k + 2); p0 = SELI[(size_t)g2 * 128 + lane]; p1 = SELI[(size_t)g2 * 128 + 64 + lane]; }
        gu_compute(segA, hwA, lpart, PART + (size_t)G_TOK(k) * 128, lane, eg, sub, true);
        { const int g2 = G_TOK(k + 2); gu_stage(segA, hwA, lidx, p0, p1, H8 + (size_t)g2 * D, PUx, lane, eg); }
        { const int g3 = G_TOK(k + 3); p0 = SELI[(size_t)g3 * 128 + lane]; p1 = SELI[(size_t)g3 * 128 + 64 + lane]; }
        gu_compute(segB, hwB, lpart, PART + (size_t)G_TOK(k + 1) * 128, lane, eg, sub, G_VALID(k + 1));
    }
}
__device__ __forceinline__ void phase_gact(const Args& a, int layer, int mode) {
    const int lane = threadIdx.x & 63, gw = blockIdx.x * NWAVE + (threadIdx.x >> 6), ngw = gridDim.x * NWAVE, ntok = mode == 1 ? NB * SEQ : MTOT;
    unsigned char* ws = a.ws;
    const float* PART = (const float*)(ws + WS_PART); const int* SELI = (const int*)(ws + WS_SELI); const float* SELG = (const float*)(ws + WS_SELG);
    const float* SCU = (const float*)(ws + WS_SCU) + layer * NEXP; const float* SCV = (const float*)(ws + WS_SCV) + layer * NEXP;
    const float* SH = (const float*)(ws + WS_SH); short* ACT16 = (short*)(ws + WS_ACT16); float* SA = (float*)(ws + WS_SA);
    for (int i = gw; i < ntok; i += ngw) {
        const int g = peer_tok(i, mode);
        const float sh = SH[g];
        float av[2];
#pragma unroll
        for (int hf = 0; hf < 2; ++hf) {
            const size_t o = (size_t)g * 128 + hf * 64 + lane;
            float sdot = 0.f;
#pragma unroll
            for (int xx = 0; xx < 8; ++xx) sdot += PART[(size_t)xx * MTOT * 128 + o];
            const int id = SELI[o];
            av[hf] = gelu_t(sdot * sh * SCU[id]) * SELG[o] * SCV[id];
        }
        float mx = fmaxf(fabsf(av[0]), fabsf(av[1]));
#pragma unroll
        for (int of = 1; of < 64; of <<= 1) mx = fmaxf(mx, __shfl_xor(mx, of));
        mx = fmaxf(mx, 1e-30f); const float inv = 32767.f / mx;
#pragma unroll
        for (int hf = 0; hf < 2; ++hf) {
            const int e = hf * 64 + lane, st = e >> 3, eg = e & 7, pos = (((st >> 1) * 8 + eg) << 1) | (st & 1);
            ACT16[(size_t)g * 128 + pos] = (short)__float2int_rn(av[hf] * inv);
        }
        if (lane == 0) SA[g] = mx * (1.f / 32767.f);
    }
}
__device__ __forceinline__ void gv_stage(u32x4 (&seg)[16], LAS int* lb, int i0, int i1, const unsigned char* PVx, int lane, int eg) {
    lb[lane] = i0; lb[64 + lane] = i1;
#pragma unroll
    for (int st = 0; st < 16; ++st) seg[st] = *(const u32x4*)(PVx + (size_t)lb[st * 8 + eg] * 128);
}
typedef short s16x2_t __attribute__((ext_vector_type(2)));
__device__ __forceinline__ int dot2i16(unsigned w, unsigned aw, int acc) { return __builtin_amdgcn_sdot2(__builtin_bit_cast(s16x2_t, w), __builtin_bit_cast(s16x2_t, aw), acc, false); }
__device__ __forceinline__ void gv_pair(int (&acc)[16], const u32x4& va, const u32x4& vb, unsigned aw) {
#define GV_D(d, o) acc[o + 0] = dot2i16(__builtin_amdgcn_perm(vb.d, va.d, 0x0c040c00u), aw, acc[o + 0]); acc[o + 1] = dot2i16(__builtin_amdgcn_perm(vb.d, va.d, 0x0c050c01u), aw, acc[o + 1]); \
                   acc[o + 2] = dot2i16(__builtin_amdgcn_perm(vb.d, va.d, 0x0c060c02u), aw, acc[o + 2]); acc[o + 3] = dot2i16(__builtin_amdgcn_perm(vb.d, va.d, 0x0c070c03u), aw, acc[o + 3]);
    GV_D(x, 0) GV_D(y, 4) GV_D(z, 8) GV_D(w, 12)
#undef GV_D
}
__device__ __forceinline__ void gv_compute(const u32x4 (&seg)[16], const unsigned (&aw)[8], float sa, float* xr, const float* g2, int eg, bool valid) {
    int acc[16]; int sq = 0;
#pragma unroll
    for (int k = 0; k < 16; ++k) acc[k] = 0;
#pragma unroll
    for (int s2 = 0; s2 < 8; ++s2) { gv_pair(acc, seg[2 * s2], seg[2 * s2 + 1], aw[s2]); sq += (int)(short)(aw[s2] & 0xffffu) + ((int)aw[s2] >> 16); }
#pragma unroll
    for (int k = 0; k < 16; ++k) { acc[k] += __shfl_xor(acc[k], 8); acc[k] += __shfl_xor(acc[k], 16); acc[k] += __shfl_xor(acc[k], 32); }
    sq += __shfl_xor(sq, 8); sq += __shfl_xor(sq, 16); sq += __shfl_xor(sq, 32);
    if (eg == 0 && valid) {
        const int vb = 128 * sq;
#pragma unroll
        for (int d = 0; d < 16; d += 4) {
            const f32x4 xv = *(const f32x4*)(xr + d), gv = *(const f32x4*)(g2 + d);
            f32x4 o; o.x = xv.x + gv.x * (sa * (float)(acc[d] - vb)); o.y = xv.y + gv.y * (sa * (float)(acc[d + 1] - vb)); o.z = xv.z + gv.z * (sa * (float)(acc[d + 2] - vb)); o.w = xv.w + gv.w * (sa * (float)(acc[d + 3] - vb));
            *(f32x4*)(xr + d) = o;
        }
    }
}
__device__ __forceinline__ void phase_gv(const Args& a, char* lds, int layer, int mode) {
    const int lane = threadIdx.x & 63, wid = __builtin_amdgcn_readfirstlane(threadIdx.x >> 6), eg = lane >> 3, sub = lane & 7;
    const int x = blockIdx.x & 7, stripe = blockIdx.x >> 3, nstr = (gridDim.x >> 3) * NWAVE, ntok = mode == 1 ? NB * SEQ : MTOT;
    unsigned char* ws = a.ws;
    float* X1 = (float*)(ws + WS_X1) + x * 128 + sub * 16;
    const unsigned char* PVx = ws + WS_PV + (size_t)layer * NEXP * D + (size_t)x * NEXP * 128 + sub * 16;
    const int* SELI = (const int*)(ws + WS_SELI); const unsigned* ACTW = (const unsigned*)(ws + WS_ACT16) + eg; const float* SA = (const float*)(ws + WS_SA);
    LAS int* lidx = (LAS int*)((LAS char*)lds + wid * 2048);
    const int first = stripe * NWAVE + wid;
    u32x4 segA[16], segB[16];
    unsigned awA[8], awB[8]; float saA, saB;
    int p0, p1;
#define GV_PREF(k) { const int g_ = G_TOK(k); p0 = SELI[(size_t)g_ * 128 + lane]; p1 = SELI[(size_t)g_ * 128 + 64 + lane]; }
#define GV_AW(AW, SAV, k) { const int g_ = G_TOK(k); _Pragma("unroll") for (int s2 = 0; s2 < 8; ++s2) AW[s2] = ACTW[(size_t)g_ * 64 + s2 * 8]; SAV = SA[g_]; }
#define GV_G2(k) (modv(a, layer, row_variant(G_TOK(k)), 5) + x * 128 + sub * 16)
    GV_PREF(0) gv_stage(segA, lidx, p0, p1, PVx, lane, eg); GV_AW(awA, saA, 0)
    GV_PREF(1)
    for (int k = 0; G_VALID(k); k += 2) {
        gv_stage(segB, lidx + 128, p0, p1, PVx, lane, eg); GV_AW(awB, saB, k + 1)
        GV_PREF(k + 2)
        gv_compute(segA, awA, saA, X1 + (size_t)G_TOK(k) * D, GV_G2(k), eg, true);
        gv_stage(segA, lidx, p0, p1, PVx, lane, eg); GV_AW(awA, saA, k + 2)
        GV_PREF(k + 3)
        gv_compute(segB, awB, saB, X1 + (size_t)G_TOK(k + 1) * D, GV_G2(k + 1), eg, G_VALID(k + 1));
    }
#undef GV_PREF
#undef GV_AW
#undef GV_G2
#undef G_TOK
#undef G_VALID
}
__device__ __forceinline__ void phase_finalnorm(const Args& a) {
    const int lane = threadIdx.x & 63, gw = blockIdx.x * NWAVE + (threadIdx.x >> 6), ngw = gridDim.x * NWAVE;
    const float* X1 = (const float*)(a.ws + WS_X1);
    for (int i = gw; i < NB * SEQ; i += ngw) {
        const int g = peer_tok(i, 1);
        const float* xr = X1 + (size_t)g * D; float* op = a.out + (size_t)i * D;
        f32x4 v[4]; float ss = 0.f;
#pragma unroll
        for (int j = 0; j < 4; ++j) { v[j] = *(const f32x4*)(xr + j * 256 + lane * 4); ss += (v[j].x * v[j].x + v[j].y * v[j].y) + (v[j].z * v[j].z + v[j].w * v[j].w); }
        const float rinv = rsqrtf(wave_sum(ss) * (1.f / D) + EPS);
#pragma unroll
        for (int j = 0; j < 4; ++j) { const f32x4 gn = *(const f32x4*)(a.in[28] + j * 256 + lane * 4); *(f32x4*)(op + j * 256 + lane * 4) = v[j] * rinv * gn; }
    }
}

__device__ __forceinline__ void phase_inproj1(const Args& a, char* lds) {
    float* Cs = (float*)lds;
    const int tid = threadIdx.x;
    const bf16_t* H = (const bf16_t*)(a.ws + WS_H); const bf16_t* W = (const bf16_t*)(a.ws + WS_WIN1);
    const int NU = (MTOT / 128) * 20;
    for (int u = blockIdx.x; u < NU; u += gridDim.x) {
        const int rt = u / 20, ct = u % 20, row0 = rt * 128, col0 = ct * 128;
        if (ct < 10 && (rt % 66) < 2) continue;
        gemm_tile128(H + (size_t)row0 * D, D, W + (size_t)col0 * D, D, D, Cs);
        __syncthreads();
        const int rr = tid >> 2, q4 = tid & 3, g = row0 + rr;
        const float* crow = Cs + rr * CS_LD + q4 * 32;
        if (ct < 10) {
            bf16_t* o = (bf16_t*)(a.ws + WS_GG) + (size_t)g * DRNN + col0 + q4 * 32;
#pragma unroll
            for (int c = 0; c < 32; c += 2) *(unsigned*)(o + c) = pk2(gelu_t(crow[c]), gelu_t(crow[c + 1]));
        } else {
            bf16_t* o = (bf16_t*)(a.ws + WS_XR) + (size_t)g * DRNN + (col0 - DRNN) + q4 * 32;
#pragma unroll
            for (int c = 0; c < 32; c += 2) *(unsigned*)(o + c) = pk2(crow[c], crow[c + 1]);
        }
        __syncthreads();
    }
}

__device__ __forceinline__ void phase_rglru(const Args& a, char* lds, int pass) {
    const int tid = threadIdx.x;
    unsigned char* ws = a.ws;
    float* xc = (float*)lds;
    float* seg = xc + 128 * 128;
    const bf16_t* XR = (const bf16_t*)(ws + WS_XR); const bf16_t* GG = (const bf16_t*)(ws + WS_GG); bf16_t* YG = (bf16_t*)(ws + WS_YG);
    float* CARRY = (float*)(ws + WS_CARRY);
    const int j = tid & 127, tq = tid >> 7;
    const int NU = (MTOT / 128) * 10;
    for (int u = blockIdx.x; u < NU; u += gridDim.x) {
        const int T = u / 10, hb = u % 10, b = T / 66, tl = T % 66, row0 = T * 128, ch = hb * 128 + j;
        if (pass == 1 && tl < 2) continue;
        const int seq_lo = tl < 2 ? b * RPB : b * RPB + CTXL, seq_hi = tl < 2 ? b * RPB + CTXL : (b + 1) * RPB;
        {
            const float w0 = a.in[16][0 * DRNN + ch], w1 = a.in[16][1 * DRNN + ch], w2 = a.in[16][2 * DRNN + ch], w3 = a.in[16][3 * DRNN + ch], cb = a.in[17][ch];
            for (int tt = 0; tt < 32; ++tt) {
                const int g = row0 + tq * 32 + tt;
                const float xm2 = (g - 2 >= seq_lo) ? bf2f(XR[(size_t)(g - 2) * DRNN + ch]) : 0.f;
                const float xm1 = (g - 1 >= seq_lo) ? bf2f(XR[(size_t)(g - 1) * DRNN + ch]) : 0.f;
                const float x0 = bf2f(XR[(size_t)g * DRNN + ch]);
                const float xp1 = (g + 1 < seq_hi) ? bf2f(XR[(size_t)(g + 1) * DRNN + ch]) : 0.f;
                xc[(tq * 32 + tt) * 128 + j] = w0 * xm2 + w1 * xm1 + w2 * x0 + w3 * xp1 + cb;
            }
        }
        __syncthreads();
        float acc[4][32];
#pragma unroll
        for (int m = 0; m < 4; ++m)
#pragma unroll
            for (int tt = 0; tt < 32; ++tt) acc[m][tt] = 0.f;
        {
            const float* wa0 = a.in[18] + ((size_t)(0 * 10 + hb) * 128) * 128 + j; const float* wx0 = a.in[20] + ((size_t)(0 * 10 + hb) * 128) * 128 + j;
            const float* wa1 = a.in[18] + ((size_t)(1 * 10 + hb) * 128) * 128 + j; const float* wx1 = a.in[20] + ((size_t)(1 * 10 + hb) * 128) * 128 + j;
            for (int i = 0; i < 128; ++i) {
                const float w0 = wa0[i * 128], w1 = wx0[i * 128], w2 = wa1[i * 128], w3 = wx1[i * 128];
#pragma unroll
                for (int tt = 0; tt < 32; ++tt) { const float x = xc[(tq * 32 + tt) * 128 + i]; acc[0][tt] += x * w0; acc[1][tt] += x * w1; acc[2][tt] += x * w2; acc[3][tt] += x * w3; }
            }
        }
#pragma unroll
        for (int d = 0; d < 2; ++d) {
            const float ba = a.in[19][d * DRNN + ch], bx = a.in[21][d * DRNN + ch], lam = a.in[22][d * DRNN + ch];
            const float sp = log1pf(__expf(-lam));
#pragma unroll
            for (int tt = 0; tt < 32; ++tt) {
                const float r = sigmoidf_(acc[2 * d][tt] + ba), ig = sigmoidf_(acc[2 * d + 1][tt] + bx);
                const float la = -8.f * r * sp; const float av = __expf(la);
                const float uv = sqrtf(fmaxf(-expm1f(2.f * la), 0.f)) * ig * xc[(tq * 32 + tt) * 128 + j];
                acc[2 * d][tt] = av; acc[2 * d + 1][tt] = uv;
            }
        }
        {
            float Af = 1.f, Hf = 0.f, Ab = 1.f, Hb = 0.f;
#pragma unroll
            for (int tt = 0; tt < 32; ++tt) { Hf = acc[0][tt] * Hf + acc[1][tt]; Af *= acc[0][tt]; }
#pragma unroll
            for (int tt = 31; tt >= 0; --tt) { Hb = acc[2][tt] * Hb + acc[3][tt]; Ab *= acc[2][tt]; }
            seg[((0 * 4 + tq) * 128 + j) * 2] = Af; seg[((0 * 4 + tq) * 128 + j) * 2 + 1] = Hf;
            seg[((1 * 4 + tq) * 128 + j) * 2] = Ab; seg[((1 * 4 + tq) * 128 + j) * 2 + 1] = Hb;
        }
        __syncthreads();
        if (pass == 0) {
            if (tq == 0) {
                float A = 1.f, Hh = 0.f;
                for (int s = 0; s < 4; ++s) { const float sa = seg[((0 * 4 + s) * 128 + j) * 2], sh = seg[((0 * 4 + s) * 128 + j) * 2 + 1]; Hh = sa * Hh + sh; A *= sa; }
                float* c0 = CARRY + (((size_t)(b * 2 + 0) * 66 + tl) * DRNN + ch) * 2; c0[0] = A; c0[1] = Hh;
                A = 1.f; Hh = 0.f;
                for (int s = 3; s >= 0; --s) { const float sa = seg[((1 * 4 + s) * 128 + j) * 2], sh = seg[((1 * 4 + s) * 128 + j) * 2 + 1]; Hh = sa * Hh + sh; A *= sa; }
                float* c1 = CARRY + (((size_t)(b * 2 + 1) * 66 + tl) * DRNN + ch) * 2; c1[0] = A; c1[1] = Hh;
            }
        } else {
            float hf = 0.f, hbk = 0.f;
            for (int t2 = 0; t2 < tl; ++t2) { const float* c = CARRY + (((size_t)(b * 2 + 0) * 66 + t2) * DRNN + ch) * 2; hf = c[0] * hf + c[1]; }
            { const float* c = CARRY + (((size_t)(b * 2 + 1) * 66 + 1) * DRNN + ch) * 2; hbk = c[0] * hbk + c[1]; }
            { const float* c = CARRY + (((size_t)(b * 2 + 1) * 66 + 0) * DRNN + ch) * 2; hbk = c[0] * hbk + c[1]; }
            for (int t2 = 65; t2 > tl; --t2) { const float* c = CARRY + (((size_t)(b * 2 + 1) * 66 + t2) * DRNN + ch) * 2; hbk = c[0] * hbk + c[1]; }
            for (int s = 0; s < tq; ++s) { const float sa = seg[((0 * 4 + s) * 128 + j) * 2], sh = seg[((0 * 4 + s) * 128 + j) * 2 + 1]; hf = sa * hf + sh; }
            for (int s = 3; s > tq; --s) { const float sa = seg[((1 * 4 + s) * 128 + j) * 2], sh = seg[((1 * 4 + s) * 128 + j) * 2 + 1]; hbk = sa * hbk + sh; }
#pragma unroll
            for (int tt = 0; tt < 32; ++tt) { hf = acc[0][tt] * hf + acc[1][tt]; acc[0][tt] = hf; }
#pragma unroll
            for (int tt = 31; tt >= 0; --tt) { hbk = acc[2][tt] * hbk + acc[3][tt]; acc[0][tt] += hbk; }
#pragma unroll
            for (int tt = 0; tt < 32; ++tt) {
                const int g = row0 + tq * 32 + tt;
                YG[(size_t)g * DRNN + ch] = (bf16_t)f2bf(acc[0][tt] * bf2f(GG[(size_t)g * DRNN + ch]));
            }
        }
        __syncthreads();
    }
}

constexpr int XC_LD = 136;
__device__ __forceinline__ float exp2_fast(float x) { return __builtin_amdgcn_exp2f(x); }
__device__ __forceinline__ float sigm_fast(float x) { return __builtin_amdgcn_rcpf(1.f + __builtin_amdgcn_exp2f(-1.4426950408889634f * x)); }
__device__ __forceinline__ void phase_rglru2(const Args& a, char* lds, int pass) {
    const int tid = threadIdx.x, lane = tid & 63, wid = __builtin_amdgcn_readfirstlane(tid >> 6), r32 = lane & 31, hh = lane >> 5;
    const int nb = wid & 3, dir = wid >> 2;
    unsigned char* ws = a.ws;
    LAS bf16_t* xcA = (LAS bf16_t*)((LAS char*)lds);
    LAS float* HS = (LAS float*)((LAS char*)lds + 36864);
    const bf16_t* XR = (const bf16_t*)(ws + WS_XR); const bf16_t* GG = (const bf16_t*)(ws + WS_GG); bf16_t* YG = (bf16_t*)(ws + WS_YG);
    float* CARRY = (float*)(ws + WS_CARRY);
    const int NU = (MTOT / 128) * 10;
    for (int u = blockIdx.x; u < NU; u += gridDim.x) {
        const int T = u / 10, hb = u % 10, b = T / 66, tl = T % 66, row0 = T * 128;
        if (pass == 1 && tl < 2) continue;
        const int seq_lo = tl < 2 ? b * RPB : b * RPB + CTXL, seq_hi = tl < 2 ? b * RPB + CTXL : (b + 1) * RPB;
        {
            const int j2 = tid & 63, ts = tid >> 6, c0 = hb * 128 + 2 * j2;
            const float w00 = a.in[16][0 * DRNN + c0], w01 = a.in[16][0 * DRNN + c0 + 1], w10 = a.in[16][1 * DRNN + c0], w11 = a.in[16][1 * DRNN + c0 + 1];
            const float w20 = a.in[16][2 * DRNN + c0], w21 = a.in[16][2 * DRNN + c0 + 1], w30 = a.in[16][3 * DRNN + c0], w31 = a.in[16][3 * DRNN + c0 + 1];
            const float cb0 = a.in[17][c0], cb1 = a.in[17][c0 + 1];
            unsigned xw[19];
#pragma unroll
            for (int i = 0; i < 19; ++i) { const int g = row0 + ts * 16 - 2 + i; xw[i] = (g >= seq_lo && g < seq_hi) ? *(const unsigned*)(XR + (size_t)g * DRNN + c0) : 0u; }
#pragma unroll
            for (int i = 0; i < 16; ++i) {
                const float y0 = w00 * bflo(xw[i]) + w10 * bflo(xw[i + 1]) + w20 * bflo(xw[i + 2]) + w30 * bflo(xw[i + 3]) + cb0;
                const float y1 = w01 * bfhi(xw[i]) + w11 * bfhi(xw[i + 1]) + w21 * bfhi(xw[i + 2]) + w31 * bfhi(xw[i + 3]) + cb1;
                *(LAS unsigned*)(xcA + (ts * 16 + i) * XC_LD + 2 * j2) = pk2(y0, y1);
            }
        }
        __syncthreads();
        const int ch = hb * 128 + nb * 32 + r32;
        f32x16 accA[4], accX[4];
        {
            unsigned woff = (unsigned)((nb * 32 + r32) * 128 + 8 * hh); asm volatile("" : "+v"(woff));
            const bf16_t* wa = (const bf16_t*)(ws + WS_WAT) + (size_t)(dir * 10 + hb) * 128 * 128;
            const bf16_t* wx = (const bf16_t*)(ws + WS_WXT) + (size_t)(dir * 10 + hb) * 128 * 128;
            bf16x8 bfa[8], bfx[8];
#pragma unroll
            for (int k = 0; k < 8; ++k) { bfa[k] = *(const bf16x8*)(wa + woff + k * 16); bfx[k] = *(const bf16x8*)(wx + woff + k * 16); }
#pragma unroll
            for (int mb = 0; mb < 4; ++mb) {
                accA[mb] = f32x16{}; accX[mb] = f32x16{};
#pragma unroll
                for (int k = 0; k < 8; ++k) {
                    const bf16x8 af = *(const LAS bf16x8*)(xcA + (mb * 32 + r32) * XC_LD + k * 16 + 8 * hh);
                    accA[mb] = __builtin_amdgcn_mfma_f32_32x32x16_bf16(af, bfa[k], accA[mb], 0, 0, 0);
                    accX[mb] = __builtin_amdgcn_mfma_f32_32x32x16_bf16(af, bfx[k], accX[mb], 0, 0, 0);
                }
            }
        }
        __builtin_amdgcn_sched_barrier(0);
        {
            const float ba = a.in[19][dir * DRNN + ch], bx = a.in[21][dir * DRNN + ch], lam = a.in[22][dir * DRNN + ch];
            const float sp8 = -8.f * log1pf(__expf(-lam));
#pragma unroll
            for (int mb = 0; mb < 4; ++mb)
#pragma unroll
                for (int r = 0; r < 16; ++r) {
                    const int t = mb * 32 + (r & 3) + 8 * (r >> 2) + 4 * hh;
                    const float xv = bf2f(xcA[t * XC_LD + nb * 32 + r32]);
                    const float rg = sigm_fast(accA[mb][r] + ba), ig = sigm_fast(accX[mb][r] + bx);
                    const float la = rg * sp8, av = exp2_fast(1.4426950408889634f * la), x2 = 2.f * la;
                    const float om1 = -x2 * (1.f + x2 * (0.5f + x2 * (0.16666667f + x2 * 0.041666668f))), om2 = __builtin_fmaf(-av, av, 1.f);
                    const float om = (x2 > -0.25f) ? om1 : om2;
                    accA[mb][r] = av; accX[mb][r] = __builtin_sqrtf(fmaxf(om, 0.f)) * ig * xv;
                    if ((r & 3) == 3) __builtin_amdgcn_sched_barrier(0);
                }
        }
        __builtin_amdgcn_sched_barrier(0);
        float h = 0.f;
        if (pass == 1) {
            const int pos = dir == 0 ? tl : 67 - tl;
            const float* cbase = CARRY + ((size_t)(b * 2 + dir) * 66) * DRNN * 2 + (size_t)ch * 2;
            float cA = 1.f, cH = 0.f;
#pragma unroll 3
            for (int i = 0; i < 33; ++i) {
                const int p = hh * 33 + i;
                const int tile = dir == 0 ? p : (p < 2 ? 1 - p : 67 - p);
                if (p < pos) { const float* c = cbase + (size_t)tile * DRNN * 2; const float ta = c[0], th = c[1]; cH = ta * cH + th; cA = ta * cA; }
            }
            const auto ra = __builtin_amdgcn_permlane32_swap(__float_as_uint(cA), __float_as_uint(cA), false, false);
            const auto rh = __builtin_amdgcn_permlane32_swap(__float_as_uint(cH), __float_as_uint(cH), false, false);
            const float lowH = hh == 0 ? cH : __uint_as_float(rh[0]);
            const float upA = hh == 0 ? __uint_as_float(ra[1]) : cA;
            const float upH = hh == 0 ? __uint_as_float(rh[1]) : cH;
            h = upA * lowH + upH;
        }
        float Atot = 1.f; float cin[16];
#define RG_COMPOSITE(q) const int mb = (q) >> 2, rg = ((q) & 3) * 4; \
            const float a0 = accA[mb][rg], a1 = accA[mb][rg + 1], a2 = accA[mb][rg + 2], a3 = accA[mb][rg + 3]; \
            const float u0 = accX[mb][rg], u1 = accX[mb][rg + 1], u2 = accX[mb][rg + 2], u3 = accX[mb][rg + 3]; \
            const float gA = (a0 * a1) * (a2 * a3); \
            const float gH = dir == 0 ? ((u0 * a1 + u1) * a2 + u2) * a3 + u3 : ((u3 * a2 + u2) * a1 + u1) * a0 + u0; \
            const auto ra = __builtin_amdgcn_permlane32_swap(__float_as_uint(gA), __float_as_uint(gA), false, false); \
            const auto rh = __builtin_amdgcn_permlane32_swap(__float_as_uint(gH), __float_as_uint(gH), false, false); \
            const float pA = __uint_as_float(hh == 0 ? ra[1] : ra[0]), pH = __uint_as_float(hh == 0 ? rh[1] : rh[0]); \
            const float EA = hh ? pA : gA, EH = hh ? pH : gH, OA = hh ? gA : pA, OH = hh ? gH : pH;
        if (dir == 0) {
#pragma unroll
            for (int q = 0; q < 16; ++q) { RG_COMPOSITE(q)
                const float hE = h; h = EA * h + EH; const float hO = h; h = OA * h + OH; Atot *= EA * OA; cin[q] = hh ? hO : hE; }
        } else {
#pragma unroll
            for (int q = 15; q >= 0; --q) { RG_COMPOSITE(q)
                const float hO = h; h = OA * h + OH; const float hE = h; h = EA * h + EH; Atot *= EA * OA; cin[q] = hh ? hO : hE; }
        }
#undef RG_COMPOSITE
        if (pass == 0) {
            if (hh == 0) { float* c = CARRY + (((size_t)(b * 2 + dir) * 66 + tl) * DRNN + ch) * 2; c[0] = Atot; c[1] = h; }
            __syncthreads();
            continue;
        }
#pragma unroll
        for (int q = 0; q < 16; ++q) {
            const int mb = q >> 2, rg = (q & 3) * 4; float hc = cin[q];
            if (dir == 0) {
#pragma unroll
                for (int e = 0; e < 4; ++e) { hc = accA[mb][rg + e] * hc + accX[mb][rg + e]; accA[mb][rg + e] = hc; }
            } else {
#pragma unroll
                for (int e = 3; e >= 0; --e) { hc = accA[mb][rg + e] * hc + accX[mb][rg + e]; accA[mb][rg + e] = hc; }
            }
        }
        if (dir == 0) {
#pragma unroll
            for (int mb = 0; mb < 4; ++mb)
#pragma unroll
                for (int r = 0; r < 16; ++r) { const int t = mb * 32 + (r & 3) + 8 * (r >> 2) + 4 * hh; HS[t * 128 + nb * 32 + r32] = accA[mb][r]; }
        }
        __syncthreads();
        if (dir == 1) {
#pragma unroll
            for (int mb = 0; mb < 4; ++mb)
#pragma unroll
                for (int r = 0; r < 16; ++r) { const int t = mb * 32 + (r & 3) + 8 * (r >> 2) + 4 * hh; HS[t * 128 + nb * 32 + r32] += accA[mb][r]; }
        }
        __syncthreads();
        {
            const int t = tid >> 2, cs = (tid & 3) * 32, g = row0 + t;
            const bf16_t* gp = GG + (size_t)g * DRNN + hb * 128 + cs; bf16_t* yp = YG + (size_t)g * DRNN + hb * 128 + cs;
#pragma unroll
            for (int c8 = 0; c8 < 32; c8 += 8) {
                const u32x4 gw = *(const u32x4*)(gp + c8);
                const f32x4 h0 = *(const LAS f32x4*)(HS + t * 128 + cs + c8), h1 = *(const LAS f32x4*)(HS + t * 128 + cs + c8 + 4);
                u32x4 o; o.x = pk2(h0.x * bflo(gw.x), h0.y * bfhi(gw.x)); o.y = pk2(h0.z * bflo(gw.y), h0.w * bfhi(gw.y));
                o.z = pk2(h1.x * bflo(gw.z), h1.y * bfhi(gw.z)); o.w = pk2(h1.z * bflo(gw.w), h1.w * bfhi(gw.w));
                *(u32x4*)(yp + c8) = o;
            }
        }
        __syncthreads();
    }
}

namespace pg8 {
constexpr int BM = 256, BK = 64, HALF = 128, HTB = HALF * BK * 2, STAGE_BYTES = 8 * HTB, NXCD = 8, WGM = 8;
__host__ __device__ __forceinline__ int lds_byte(int r, int c) { const int st = (r >> 4) * 2 + (c >> 5), rr = r & 15, cc = c & 31, ob = rr * 64 + cc * 2; return st * 1024 + (ob ^ (((ob >> 9) & 1) << 5)); }
__host__ __device__ __forceinline__ void stage_rc(int b, int& R, int& C) { const int st = b / 1024, sb = b % 1024, swz = sb ^ (((sb >> 9) & 1) << 5); R = (st >> 1) * 16 + swz / 64; C = (st & 1) * 32 + (swz % 64) / 2; }
__host__ __device__ __forceinline__ int perm32(int rho) { const int n = rho >> 4, i = rho & 15; return 8 * (i >> 2) + 4 * n + (i & 3); }
struct Unit { int pm, pn; };
struct Gemm { const bf16_t* A; const bf16_t* Bt; int M, N, K; };
struct StaticOrder {
    int nM, nN, nwg, G, c;
    __host__ __device__ void init(int M, int N, int G_, int c_) { nM = M / BM; nN = N / BM; nwg = nM * nN; G = G_; c = c_; }
    __host__ __device__ bool next(int i, Unit& u) const {
        const long L = (long)i * G + c; if (L >= nwg) return false;
        int wgid = (int)L; { const int q = nwg / NXCD, r = nwg % NXCD, xcd = wgid % NXCD, off = wgid / NXCD; wgid = (xcd < r ? xcd * (q + 1) : r * (q + 1) + (xcd - r) * q) + off; }
        const int nig = WGM * nN, gid = wgid / nig, fm = gid * WGM, gsz = (nM - fm) < WGM ? (nM - fm) : WGM;
        u.pm = fm + ((wgid % nig) % gsz); u.pn = (wgid % nig) / gsz; return true;
    }
    __device__ __forceinline__ void a_ready(const Unit&) const {}
    __device__ __forceinline__ void done(const Unit&) const {}
};
struct LatentOrder {
    StaticOrder S;
    __host__ __device__ void init(int N, int G_, int c_) { S.init(16384, N, G_, c_); }
    __host__ __device__ bool next(int i, Unit& u) const { if (!S.next(i, u)) return false; u.pm = u.pm + 1 + (u.pm >= 32 ? 1 : 0); return true; }
    __device__ __forceinline__ void a_ready(const Unit&) const {}
    __device__ __forceinline__ void done(const Unit&) const {}
};
__device__ __forceinline__ unsigned cvt_pk_bf16(float lo, float hi) { unsigned r; asm volatile("v_cvt_pk_bf16_f32 %0, %1, %2" : "=v"(r) : "v"(lo), "v"(hi)); return r; }
__device__ __forceinline__ u32x4 pack8(const f32x4& v0, const f32x4& v1) { u32x4 w; w.x = cvt_pk_bf16(v0[0], v0[1]); w.y = cvt_pk_bf16(v0[2], v0[3]); w.z = cvt_pk_bf16(v1[0], v1[1]); w.w = cvt_pk_bf16(v1[2], v1[3]); return w; }
__device__ __forceinline__ f32x4 gelu4(const f32x4& v) { f32x4 r; r.x = gelu_t(v.x); r.y = gelu_t(v.y); r.z = gelu_t(v.z); r.w = gelu_t(v.w); return r; }

struct EpiStore {
    static constexpr bool PERM = true, AFTER_DRAIN = false;
    bf16_t* O1; bf16_t* O2; int ld; int split_tile; int gelu_tiles;
    __device__ __forceinline__ void operator()(f32x4 (&acc)[2][2][4][2], const Unit& u, int wr, int wc, int fr, int fq) const {
        const bool second = u.pn >= split_tile; bf16_t* base = second ? O2 : O1; const int pnl = second ? u.pn - split_tile : u.pn; const bool dog = u.pn < gelu_tiles;
        const int rl0 = wr * 64 + fr, cl0 = wc * 32 + 8 * fq;
#pragma unroll
        for (int ai = 0; ai < 2; ++ai)
#pragma unroll
            for (int m = 0; m < 4; ++m) { bf16_t* rowp = base + (size_t)(u.pm * BM + ai * HALF + m * 16 + rl0) * ld + pnl * BM + cl0;
#pragma unroll
                for (int bj = 0; bj < 2; ++bj) { f32x4 v0 = acc[ai][bj][m][0], v1 = acc[ai][bj][m][1]; if (dog) { v0 = gelu4(v0); v1 = gelu4(v1); }
                    *(u32x4*)(rowp + bj * HALF) = pack8(v0, v1); } }
    }
};
struct EpiResid {
    static constexpr bool PERM = true, AFTER_DRAIN = false;
    const float* x; const float* ctx; const float* modbase; float* X1; int base_mode;
    __device__ __forceinline__ void operator()(f32x4 (&acc)[2][2][4][2], const Unit& u, int wr, int wc, int fr, int fq) const {
        const int b = u.pm / 33, tl = u.pm % 33, var = tl == 0 ? 2 : b;
        const float* gate = modbase + (size_t)var * 6144 + u.pn * BM;
        const float* basep = base_mode == 0 ? (tl == 0 ? ctx + (size_t)b * CTXL * D : x + ((size_t)b * SEQ + (size_t)(tl - 1) * 256) * D) : X1 + (size_t)u.pm * BM * D;
        float* outp = X1 + (size_t)u.pm * BM * D;
        const int rl0 = wr * 64 + fr, cl0 = u.pn * BM + wc * 32 + 8 * fq;
        f32x4 gv[2][2];
#pragma unroll
        for (int bj = 0; bj < 2; ++bj)
#pragma unroll
            for (int n = 0; n < 2; ++n) gv[bj][n] = *(const f32x4*)(gate + bj * HALF + wc * 32 + 8 * fq + 4 * n);
#pragma unroll
        for (int ai = 0; ai < 2; ++ai)
#pragma unroll
            for (int m = 0; m < 4; ++m) { const size_t off = (size_t)(ai * HALF + m * 16 + rl0) * D + cl0;
#pragma unroll
                for (int bj = 0; bj < 2; ++bj)
#pragma unroll
                    for (int n = 0; n < 2; ++n) { const f32x4 bs = *(const f32x4*)(basep + off + bj * HALF + 4 * n); *(f32x4*)(outp + off + bj * HALF + 4 * n) = bs + gv[bj][n] * acc[ai][bj][m][n]; } }
    }
};
struct EpiInproj0 {
    static constexpr bool PERM = true, AFTER_DRAIN = false;
    unsigned char* ws; const float* gmg; const float* qg; const float* kg; LAS float* P;
    __device__ __forceinline__ void operator()(f32x4 (&acc)[2][2][4][2], const Unit& u, int wr, int wc, int fr, int fq) const {
        int rl0 = wr * 64 + fr, cl0 = wc * 32 + 8 * fq; asm volatile("" : "+v"(rl0), "+v"(cl0));
        const int pn = u.pn; const size_t grow0 = (size_t)u.pm * BM;
        if (pn < 4) {
#pragma unroll
            for (int ai = 0; ai < 2; ++ai)
#pragma unroll
                for (int bj = 0; bj < 2; ++bj)
#pragma unroll
                    for (int m = 0; m < 4; ++m) { acc[ai][bj][m][0] = gelu4(acc[ai][bj][m][0]); acc[ai][bj][m][1] = gelu4(acc[ai][bj][m][1]); __builtin_amdgcn_sched_barrier(0); }
        }
        if (pn < 2 || pn == 7) {
            bf16_t* base = pn < 2 ? (bf16_t*)(ws + WS_U) + pn * BM : (bf16_t*)(ws + WS_V); const int ld = pn < 2 ? 512 : 256;
#pragma unroll
            for (int ai = 0; ai < 2; ++ai)
#pragma unroll
                for (int m = 0; m < 4; ++m) { bf16_t* rowp = base + (grow0 + ai * HALF + m * 16 + rl0) * ld + cl0;
#pragma unroll
                    for (int bj = 0; bj < 2; ++bj) *(u32x4*)(rowp + bj * HALF) = pack8(acc[ai][bj][m][0], acc[ai][bj][m][1]); }
            return;
        }
#pragma unroll
        for (int ai = 0; ai < 2; ++ai)
#pragma unroll
            for (int m = 0; m < 4; ++m)
#pragma unroll
                for (int bj = 0; bj < 2; ++bj) { const f32x4 a0 = acc[ai][bj][m][0], a1 = acc[ai][bj][m][1];
                    float s = (a0.x * a0.x + a0.y * a0.y) + (a0.z * a0.z + a0.w * a0.w) + (a1.x * a1.x + a1.y * a1.y) + (a1.z * a1.z + a1.w * a1.w);
                    s += __shfl_xor(s, 16); s += __shfl_xor(s, 32);
                    if (fq == 0) P[((ai * HALF + m * 16 + rl0) * 2 + bj) * 4 + wc] = s; __builtin_amdgcn_sched_barrier(0); }
        asm volatile("s_waitcnt lgkmcnt(0)" ::: "memory"); __builtin_amdgcn_s_barrier(); asm volatile("" ::: "memory");
        if (pn < 4) {
            bf16_t* base = (bf16_t*)(ws + WS_VV) + (pn - 2) * BM; const float* gp = gmg + (pn - 2) * BM + cl0;
            f32x4 g8[2][2];
#pragma unroll
            for (int bj = 0; bj < 2; ++bj) { g8[bj][0] = *(const f32x4*)(gp + bj * HALF); g8[bj][1] = *(const f32x4*)(gp + bj * HALF + 4); }
#pragma unroll
            for (int ai = 0; ai < 2; ++ai)
#pragma unroll
                for (int m = 0; m < 4; ++m) { const int rl = ai * HALF + m * 16 + rl0; bf16_t* rowp = base + (grow0 + rl) * 512 + cl0;
#pragma unroll
                    for (int bj = 0; bj < 2; ++bj) { const f32x4 p = *(const LAS f32x4*)(P + (rl * 2 + bj) * 4);
                        const float rinv = rsqrtf(((p.x + p.y) + (p.z + p.w)) * (1.f / 128.f) + EPS);
                        *(u32x4*)(rowp + bj * HALF) = pack8(acc[ai][bj][m][0] * rinv * g8[bj][0], acc[ai][bj][m][1] * rinv * g8[bj][1]); }
                    asm volatile("" ::: "memory"); __builtin_amdgcn_sched_barrier(0); }
            return;
        }
        {
            const bool isq = pn < 6; const float* gn = isq ? qg : kg;
            const int grp = cl0 >> 3, fo = (grp >> 3) * 64 + (grp & 7) * 4;
            const f32x4 gA = *(const f32x4*)(gn + fo), gB = *(const f32x4*)(gn + fo + 32);
            bf16_t* base = isq ? (bf16_t*)(ws + WS_Q) + (pn - 4) * BM : (bf16_t*)(ws + WS_K); const int ld = isq ? 512 : 256;
            const int tl = u.pm % 33; const bool lat = tl != 0; const int ax = grp >> 3, f0 = (grp & 7) * 4;
            const float* rope = (const float*)(ws + WS_ROPE);
#pragma unroll
            for (int ai = 0; ai < 2; ++ai)
#pragma unroll
                for (int m = 0; m < 4; ++m) { const int rl = ai * HALF + m * 16 + rl0; bf16_t* rowp = base + (grow0 + rl) * ld + cl0;
                    f32x4 cs0 = {1.f, 0.f, 1.f, 0.f}, cs1 = {1.f, 0.f, 1.f, 0.f};
                    if (lat) { const int t = (tl - 1) * 256 + rl; const int pos = ax == 0 ? (t >> 6) : (t & 63); const float* rp = rope + (pos * 32 + f0) * 2; cs0 = *(const f32x4*)rp; cs1 = *(const f32x4*)(rp + 4); }
#pragma unroll
                    for (int bj = 0; bj < 2; ++bj) { const f32x4 p = *(const LAS f32x4*)(P + (rl * 2 + bj) * 4);
                        const float rinv = rsqrtf(((p.x + p.y) + (p.z + p.w)) * (1.f / 128.f) + EPS);
                        const f32x4 x1 = acc[ai][bj][m][0] * rinv * gA, x2 = acc[ai][bj][m][1] * rinv * gB;
                        f32x4 o1, o2;
                        o1.x = x1.x * cs0.x - x2.x * cs0.y; o2.x = x2.x * cs0.x + x1.x * cs0.y;
                        o1.y = x1.y * cs0.z - x2.y * cs0.w; o2.y = x2.y * cs0.z + x1.y * cs0.w;
                        o1.z = x1.z * cs1.x - x2.z * cs1.y; o2.z = x2.z * cs1.x + x1.z * cs1.y;
                        o1.w = x1.w * cs1.z - x2.w * cs1.w; o2.w = x2.w * cs1.z + x1.w * cs1.w;
                        *(u32x4*)(rowp + bj * HALF) = pack8(o1, o2); }
                    asm volatile("" ::: "memory"); __builtin_amdgcn_sched_barrier(0); }
        }
    }
};

template <class Epi, class Sched, bool ALIGN_EPI = false, bool SP2 = false>
__device__ __forceinline__ void gemm_phase(LAS unsigned char* lds, const Gemm g, const Sched& S, const Epi& E) {
    const int tid = threadIdx.x, wid = __builtin_amdgcn_readfirstlane(tid >> 6), lane = tid & 63, wr = wid >> 2, wc = wid & 3, fr = lane & 15, fq = lane >> 4;
    const int K = g.K, nt = K / BK;
    unsigned voffA[2], voffB[2];
#pragma unroll
    for (int i = 0; i < 2; ++i) { int R, C; stage_rc(tid * 16 + i * 8192, R, C); const int Rb = Epi::PERM ? ((R & ~31) + perm32(R & 31)) : R;
        voffA[i] = (unsigned)(R * K + C) * 2u; voffB[i] = (unsigned)(Rb * K + C) * 2u; }
    const size_t kstep = (size_t)(BK * 2);
    const size_t hstep = (size_t)HALF * K * 2;
    const size_t tstep = 2 * hstep;
    const unsigned ldsw = (unsigned)wid * 1024u;
    const int aoff = lds_byte(wr * 64 + fr, fq * 8), boff = lds_byte(wc * 32 + fr, fq * 8);
#define PG8_SA(b, h) (((b) * 2 + (h)) * HTB)
#define PG8_SB(b, h) ((4 + (b) * 2 + (h)) * HTB)
#define PG8_STAGE(bufoff, gbase, voff) do { _Pragma("unroll") for (int _i = 0; _i < 2; ++_i) \
        __builtin_amdgcn_global_load_lds((const unsigned*)((const char*)(gbase) + (voff)[_i]), (LAS unsigned*)(lds + (bufoff) + ldsw + _i * 8192), 16, 0, 0); } while (0)
#define PG8_LDA(dst, b, h) do { _Pragma("unroll") for (int m = 0; m < 4; ++m) _Pragma("unroll") for (int k = 0; k < 2; ++k) dst[m][k] = *(const LAS bf16x8*)(lds + PG8_SA(b, h) + aoff + m * 2048 + k * 1024); } while (0)
#define PG8_LDB(dst, b, h) do { _Pragma("unroll") for (int n = 0; n < 2; ++n) _Pragma("unroll") for (int k = 0; k < 2; ++k) dst[n][k] = *(const LAS bf16x8*)(lds + PG8_SB(b, h) + boff + n * 2048 + k * 1024); } while (0)
#define PG8_MMA(ai, bj, At, Bt) do { __builtin_amdgcn_s_setprio(1); _Pragma("unroll") for (int m = 0; m < 4; ++m) _Pragma("unroll") for (int n = 0; n < 2; ++n) _Pragma("unroll") for (int k = 0; k < 2; ++k) \
        acc[ai][bj][m][n] = __builtin_amdgcn_mfma_f32_16x16x32_bf16(Bt[n][k], At[m][k], acc[ai][bj][m][n], 0, 0, 0); __builtin_amdgcn_s_setprio(0); } while (0)
#define PG8_WAIT_V(n) asm volatile("s_waitcnt vmcnt(" #n ")" ::: "memory")
#define PG8_WAIT_L(n) asm volatile("s_waitcnt lgkmcnt(" #n ")" ::: "memory")
#define PG8_BAR __builtin_amdgcn_s_barrier()
#define PG8_SCHED __builtin_amdgcn_sched_barrier(0)
    Unit cur, nxt; int ui = 0;
    if (!S.next(0, cur)) return;
    f32x4 acc[2][2][4][2];
#pragma unroll
    for (int a = 0; a < 2; ++a)
#pragma unroll
        for (int b = 0; b < 2; ++b)
#pragma unroll
            for (int m = 0; m < 4; ++m)
#pragma unroll
                for (int n = 0; n < 2; ++n) acc[a][b][m][n] = (f32x4){0.f, 0.f, 0.f, 0.f};
    bf16x8 At[4][2], B0[2][2], B1[2][2];
    const char* cA = (const char*)g.A + (size_t)cur.pm * tstep; const char* cB = (const char*)g.Bt + (size_t)cur.pn * tstep;
    S.a_ready(cur);
    if constexpr (SP2) {
        PG8_STAGE(PG8_SB(0, 0), cB, voffB); PG8_STAGE(PG8_SB(0, 1), cB + hstep, voffB); PG8_STAGE(PG8_SA(0, 0), cA, voffA); PG8_STAGE(PG8_SA(0, 1), cA + hstep, voffA);
        if (wr == 1) PG8_BAR;
        PG8_WAIT_V(2); PG8_BAR;
        PG8_STAGE(PG8_SB(1, 0), cB + kstep, voffB); PG8_STAGE(PG8_SA(1, 0), cA + kstep, voffA); PG8_STAGE(PG8_SB(1, 1), cB + hstep + kstep, voffB);
        PG8_WAIT_V(6); PG8_BAR;
    } else {
        PG8_STAGE(PG8_SB(0, 0), cB, voffB); PG8_STAGE(PG8_SA(0, 0), cA, voffA); PG8_STAGE(PG8_SB(0, 1), cB + hstep, voffB); PG8_STAGE(PG8_SA(0, 1), cA + hstep, voffA);
        if (wr == 1) PG8_BAR;
        PG8_WAIT_V(4); PG8_BAR;
        PG8_STAGE(PG8_SB(1, 0), cB + kstep, voffB); PG8_STAGE(PG8_SA(1, 0), cA + kstep, voffA); PG8_STAGE(PG8_SB(1, 1), cB + hstep + kstep, voffB);
        PG8_WAIT_V(6); PG8_BAR;
    }
    for (;;) {
        const bool has_next = S.next(ui + 1, nxt);
        const char* nA = has_next ? (const char*)g.A + (size_t)nxt.pm * tstep : cA; const char* nB = has_next ? (const char*)g.Bt + (size_t)nxt.pn * tstep : cB;
        for (int t = 0; t < nt; t += 2) {
            const bool last = (t == nt - 2);
            const char* a1 = cA + (size_t)(t + 1) * kstep;
            const char* a2 = last ? nA : cA + (size_t)(t + 2) * kstep; const char* b2 = last ? nB : cB + (size_t)(t + 2) * kstep;
            const char* a3 = a2 + kstep; const char* b3 = b2 + kstep;
            if (last && has_next) S.a_ready(nxt);
            if constexpr (SP2) {
            PG8_LDB(B0, 0, 0); PG8_LDB(B1, 0, 1); PG8_SCHED; PG8_LDA(At, 0, 0); PG8_STAGE(PG8_SA(1, 1), a1 + hstep, voffA);
            PG8_WAIT_V(8); PG8_WAIT_L(0); PG8_BAR; PG8_MMA(0, 0, At, B0); PG8_MMA(0, 1, At, B1); PG8_BAR; PG8_SCHED;
            PG8_LDA(At, 0, 1); PG8_STAGE(PG8_SB(0, 0), b2, voffB); PG8_STAGE(PG8_SB(0, 1), b2 + hstep, voffB); PG8_STAGE(PG8_SA(0, 0), a2, voffA);
            PG8_WAIT_V(8); PG8_WAIT_L(0); PG8_BAR; PG8_MMA(1, 0, At, B0); PG8_MMA(1, 1, At, B1); PG8_BAR; PG8_SCHED;
            PG8_LDB(B0, 1, 0); PG8_LDB(B1, 1, 1); PG8_SCHED; PG8_LDA(At, 1, 0); PG8_STAGE(PG8_SA(0, 1), a2 + hstep, voffA);
            PG8_WAIT_V(8); PG8_WAIT_L(0); PG8_BAR; PG8_MMA(0, 0, At, B0); PG8_MMA(0, 1, At, B1); PG8_BAR; PG8_SCHED;
            PG8_LDA(At, 1, 1); PG8_STAGE(PG8_SB(1, 0), b3, voffB); PG8_STAGE(PG8_SB(1, 1), b3 + hstep, voffB); PG8_STAGE(PG8_SA(1, 0), a3, voffA);
            PG8_WAIT_V(8); PG8_WAIT_L(0); PG8_BAR; PG8_MMA(1, 0, At, B0); PG8_MMA(1, 1, At, B1); PG8_BAR; PG8_SCHED;
            } else {
            PG8_LDB(B0, 0, 0); PG8_SCHED; PG8_LDA(At, 0, 0); PG8_STAGE(PG8_SA(1, 1), a1 + hstep, voffA);
            PG8_WAIT_L(8); PG8_BAR; PG8_WAIT_L(0); PG8_MMA(0, 0, At, B0); PG8_BAR; PG8_SCHED;
            PG8_LDB(B1, 0, 1); PG8_STAGE(PG8_SB(0, 0), b2, voffB);
            PG8_BAR; PG8_WAIT_L(0); PG8_MMA(0, 1, At, B1); PG8_BAR;
            PG8_LDA(At, 0, 1); PG8_STAGE(PG8_SA(0, 0), a2, voffA);
            PG8_BAR; PG8_WAIT_L(0); PG8_MMA(1, 0, At, B0); PG8_BAR; PG8_SCHED;
            PG8_STAGE(PG8_SB(0, 1), b2 + hstep, voffB);
            PG8_WAIT_V(6); PG8_BAR; PG8_MMA(1, 1, At, B1); PG8_BAR;
            PG8_LDB(B0, 1, 0); PG8_SCHED; PG8_LDA(At, 1, 0); PG8_STAGE(PG8_SA(0, 1), a2 + hstep, voffA);
            PG8_WAIT_L(8); PG8_BAR; PG8_WAIT_L(0); PG8_MMA(0, 0, At, B0); PG8_BAR; PG8_SCHED;
            PG8_LDB(B1, 1, 1); PG8_STAGE(PG8_SB(1, 0), b3, voffB);
            PG8_BAR; PG8_WAIT_L(0); PG8_MMA(0, 1, At, B1); PG8_BAR;
            PG8_LDA(At, 1, 1); PG8_STAGE(PG8_SA(1, 0), a3, voffA);
            PG8_BAR; PG8_WAIT_L(0); PG8_MMA(1, 0, At, B0); PG8_BAR; PG8_SCHED;
            PG8_STAGE(PG8_SB(1, 1), b3 + hstep, voffB);
            PG8_WAIT_V(6); PG8_BAR; PG8_MMA(1, 1, At, B1); PG8_BAR;
            }
        }
        if constexpr (ALIGN_EPI) { if (wr == 0) PG8_BAR; }
        if constexpr (!Epi::AFTER_DRAIN) { E(acc, cur, wr, wc, fr, fq); S.done(cur); }
        if (!has_next) break;
#pragma unroll
        for (int a = 0; a < 2; ++a)
#pragma unroll
            for (int b = 0; b < 2; ++b)
#pragma unroll
                for (int m = 0; m < 4; ++m)
#pragma unroll
                    for (int n = 0; n < 2; ++n) acc[a][b][m][n] = (f32x4){0.f, 0.f, 0.f, 0.f};
        cur = nxt; cA = nA; cB = nB; ++ui;
        if constexpr (ALIGN_EPI) { if (wr == 1) PG8_BAR; }
    }
    PG8_WAIT_V(0);
    if constexpr (!ALIGN_EPI) { if (wr == 0) PG8_BAR; }
    PG8_BAR;
#undef PG8_SA
#undef PG8_SB
#undef PG8_STAGE
#undef PG8_LDA
#undef PG8_LDB
#undef PG8_MMA
#undef PG8_WAIT_V
#undef PG8_WAIT_L
#undef PG8_BAR
#undef PG8_SCHED
}
}

__device__ __forceinline__ void fphase_inproj0(const Args& a, char* lds) {
    pg8::Gemm g{(const bf16_t*)(a.ws + WS_H), (const bf16_t*)(a.ws + WS_WIN0), MTOT, 2048, 1024};
    pg8::StaticOrder S; S.init(MTOT, 2048, (int)gridDim.x, (int)blockIdx.x);
    pg8::EpiInproj0 E{a.ws, a.in[9], a.in[12], a.in[13], (LAS float*)((LAS char*)lds + 131072)};
    pg8::gemm_phase<pg8::EpiInproj0, pg8::StaticOrder, true, true>((LAS unsigned char*)lds, g, S, E);
}
__device__ __forceinline__ void fphase_outproj0(const Args& a, char* lds) {
    pg8::Gemm g{(const bf16_t*)(a.ws + WS_AO), (const bf16_t*)(a.ws + WS_WOUT0), MTOT, 1024, 1024};
    pg8::StaticOrder S; S.init(MTOT, 1024, (int)gridDim.x, (int)blockIdx.x);
    pg8::EpiResid E{a.in[0], a.in[2], (const float*)(a.ws + WS_MODV) + 2 * 1024, (float*)(a.ws + WS_X1), 0};
    pg8::gemm_phase<pg8::EpiResid, pg8::StaticOrder, true, true>((LAS unsigned char*)lds, g, S, E);
}
__device__ __forceinline__ void fphase_peerq0(const Args& a, char* lds) {
    pg8::Gemm g{(const bf16_t*)(a.ws + WS_H), (const bf16_t*)(a.ws + WS_WQ), MTOT, 2048, 1024};
    pg8::StaticOrder S; S.init(MTOT, 2048, (int)gridDim.x, (int)blockIdx.x);
    pg8::EpiStore E{(bf16_t*)(a.ws + WS_QP), (bf16_t*)(a.ws + WS_QP), 2048, 1000, 0};
    pg8::gemm_phase<pg8::EpiStore, pg8::StaticOrder, true, true>((LAS unsigned char*)lds, g, S, E);
}
__device__ __forceinline__ void fphase_inproj1(const Args& a, char* lds) {
    pg8::Gemm g{(const bf16_t*)(a.ws + WS_H), (const bf16_t*)(a.ws + WS_WIN1), MTOT, 2560, 1024};
    pg8::StaticOrder S; S.init(MTOT, 2560, (int)gridDim.x, (int)blockIdx.x);
    pg8::EpiStore E{(bf16_t*)(a.ws + WS_GG), (bf16_t*)(a.ws + WS_XR), 1280, 5, 5};
    pg8::gemm_phase<pg8::EpiStore, pg8::StaticOrder, true, true>((LAS unsigned char*)lds, g, S, E);
}
__device__ __forceinline__ void fphase_outproj1(const Args& a, char* lds) {
    pg8::Gemm g{(const bf16_t*)(a.ws + WS_YG), (const bf16_t*)(a.ws + WS_WOUT1), MTOT, 1024, 1280};
    pg8::LatentOrder S; S.init(1024, (int)gridDim.x, (int)blockIdx.x);
    pg8::EpiResid E{a.in[0], a.in[2], (const float*)(a.ws + WS_MODV) + 3 * 6144 + 2 * 1024, (float*)(a.ws + WS_X1), 1};
    pg8::gemm_phase<pg8::EpiResid, pg8::LatentOrder, true, true>((LAS unsigned char*)lds, g, S, E);
}
__device__ __forceinline__ void fphase_peerq1(const Args& a, char* lds) {
    pg8::Gemm g{(const bf16_t*)(a.ws + WS_H), (const bf16_t*)(a.ws + WS_WQ) + (size_t)2048 * 1024, MTOT, 2048, 1024};
    pg8::LatentOrder S; S.init(2048, (int)gridDim.x, (int)blockIdx.x);
    pg8::EpiStore E{(bf16_t*)(a.ws + WS_QP), (bf16_t*)(a.ws + WS_QP), 2048, 1000, 0};
    pg8::gemm_phase<pg8::EpiStore, pg8::LatentOrder, true, true>((LAS unsigned char*)lds, g, S, E);
}

constexpr int NPHASE = 23;
__global__ void __launch_bounds__(NTHR, 2) mega(Args a) {
    extern __shared__ __attribute__((aligned(16))) char lds[];
    volatile LAS unsigned* MISC = (volatile LAS unsigned*)((LAS char*)lds + LDS_MISC);
    if (threadIdx.x < 64) MISC[threadIdx.x] = 0u;
    __syncthreads();
    XcdBarrier bar; bar.bar = (unsigned*)(a.ws + WS_CTL) + 4096; bar.x = 0; bar.st = nullptr;
    const bool multi = (a.ph_hi - a.ph_lo) > 1;
    if (multi) bar = xcd_barrier_post((unsigned*)(a.ws + WS_CTL) + 4096, MISC + 8);
    const int lo = a.ph_lo, hi = a.ph_hi;
    unsigned char* ws = a.ws;
#define IN(k) (lo <= (k) && (k) < hi)
#define SEAM(k) do { if (IN(k) && IN((k) + 1)) xcd_barrier(bar); } while (0)
#ifndef PROBE_DUP
#define PROBE_DUP 0u
#endif
#define DUPQ(k) (((PROBE_DUP >> (k)) & 1u) != 0u)
    if (IN(0)) { phase_prep(a, lds); if (DUPQ(0)) { xcd_barrier(bar); phase_prep(a, lds); } } SEAM(0);
    if (IN(1)) { phase_norm(a, 0, 0, a.in[6], 0, 1, false); if (DUPQ(1)) { xcd_barrier(bar); phase_norm(a, 0, 0, a.in[6], 0, 1, false); } } SEAM(1);
    if (IN(2)) { fphase_inproj0(a, lds); if (DUPQ(2)) { xcd_barrier(bar); fphase_inproj0(a, lds); } } SEAM(2);
    if (IN(3)) { phase_gmlp2(a, lds); phase_attn(a, lds); if (DUPQ(3)) { xcd_barrier(bar); phase_gmlp2(a, lds); phase_attn(a, lds); } } SEAM(3);
    if (IN(4)) { fphase_outproj0(a, lds); if (DUPQ(4)) { xcd_barrier(bar); fphase_outproj0(a, lds); } } SEAM(4);
    if (IN(5)) { phase_norm(a, 0, 1, a.in[7], 3, 4, false, true); if (DUPQ(5)) { xcd_barrier(bar); phase_norm(a, 0, 1, a.in[7], 3, 4, false, true); } } SEAM(5);
    if (IN(6)) { fphase_peerq0(a, lds); if (DUPQ(6)) { xcd_barrier(bar); fphase_peerq0(a, lds); } } SEAM(6);
    if (IN(7)) { phase_peer_topk2(a, 0, false); if (DUPQ(7)) { xcd_barrier(bar); phase_peer_topk2(a, 0, false); } } SEAM(7);
    if (IN(8)) { phase_gu(a, lds, 0, 0); if (DUPQ(8)) { xcd_barrier(bar); phase_gu(a, lds, 0, 0); } } SEAM(8);
    if (IN(9)) { phase_gact(a, 0, 0); if (DUPQ(9)) { xcd_barrier(bar); phase_gact(a, 0, 0); } } SEAM(9);
    if (IN(10)) { phase_gv(a, lds, 0, 0); if (DUPQ(10)) { xcd_barrier(bar); phase_gv(a, lds, 0, 0); } } SEAM(10);
    if (IN(11)) { phase_norm(a, 1, 1, a.in[6] + D, 0, 1, false); if (DUPQ(11)) { xcd_barrier(bar); phase_norm(a, 1, 1, a.in[6] + D, 0, 1, false); } } SEAM(11);
    if (IN(12)) { fphase_inproj1(a, lds); if (DUPQ(12)) { xcd_barrier(bar); fphase_inproj1(a, lds); } } SEAM(12);
    if (IN(13)) { phase_rglru2(a, lds, 0); if (DUPQ(13)) { xcd_barrier(bar); phase_rglru2(a, lds, 0); } } SEAM(13);
    if (IN(14)) { phase_rglru2(a, lds, 1); if (DUPQ(14)) { xcd_barrier(bar); phase_rglru2(a, lds, 1); } } SEAM(14);
    if (IN(15)) { fphase_outproj1(a, lds); if (DUPQ(15)) { xcd_barrier(bar); fphase_outproj1(a, lds); } } SEAM(15);
    if (IN(16)) { phase_norm(a, 1, 1, a.in[7] + D, 3, 4, true, true); if (DUPQ(16)) { xcd_barrier(bar); phase_norm(a, 1, 1, a.in[7] + D, 3, 4, true, true); } } SEAM(16);
    if (IN(17)) { fphase_peerq1(a, lds); if (DUPQ(17)) { xcd_barrier(bar); fphase_peerq1(a, lds); } } SEAM(17);
    if (IN(18)) { phase_peer_topk2(a, 1, true); if (DUPQ(18)) { xcd_barrier(bar); phase_peer_topk2(a, 1, true); } } SEAM(18);
    if (IN(19)) { phase_gu(a, lds, 1, 1); if (DUPQ(19)) { xcd_barrier(bar); phase_gu(a, lds, 1, 1); } } SEAM(19);
    if (IN(20)) { phase_gact(a, 1, 1); if (DUPQ(20)) { xcd_barrier(bar); phase_gact(a, 1, 1); } } SEAM(20);
    if (IN(21)) { phase_gv(a, lds, 1, 1); if (DUPQ(21)) { xcd_barrier(bar); phase_gv(a, lds, 1, 1); } } SEAM(21);
    if (IN(22)) { phase_finalnorm(a); if (DUPQ(22)) { xcd_barrier(bar); phase_finalnorm(a); } }
#undef IN
#undef SEAM
}

extern "C" void kernel_launch(void* const* d_in, const int* in_sizes, int n_in, void* d_out, int out_size, void* d_ws, size_t ws_size, hipStream_t stream) {
    static int grid = 0;
    if (grid == 0) {
        if (n_in != 29 || out_size != NB * SEQ * D || ws_size < WS_END) {
            fprintf(stderr, "kernel_launch: unexpected shapes: n_in %d out %d ws %zu (need %zu)\n", n_in, out_size, ws_size, (size_t)WS_END); grid = -1; return; }
        int dev = 0, cus = 0, per_cu = 0;
        if (hipGetDevice(&dev) != hipSuccess || hipDeviceGetAttribute(&cus, hipDeviceAttributeMultiprocessorCount, dev) != hipSuccess) { grid = -1; return; }
        if (hipFuncSetAttribute((const void*)mega, hipFuncAttributeMaxDynamicSharedMemorySize, LDS_BYTES) != hipSuccess) { fprintf(stderr, "kernel_launch: hipFuncSetAttribute failed\n"); grid = -1; return; }
        if (hipOccupancyMaxActiveBlocksPerMultiprocessor(&per_cu, (const void*)mega, NTHR, LDS_BYTES) != hipSuccess || per_cu < 1)
            fprintf(stderr, "kernel_launch: occupancy query reports %d blocks per CU\n", per_cu);
        (void)hipGetLastError();
        grid = cus;
    }
    if (grid < 0) return;
    (void)hipMemsetAsync((char*)d_ws + WS_CTL, 0, CTL_BYTES, stream);
    Args a{};
    for (int i = 0; i < 29; ++i) a.in[i] = (const float*)d_in[i];
    a.out = (float*)d_out; a.ws = (unsigned char*)d_ws;
#if MK_SINGLE
    a.ph_lo = 0; a.ph_hi = NPHASE;
    hipLaunchKernelGGL(mega, dim3(grid), dim3(NTHR), LDS_BYTES, stream, a);
#else
    for (int p = 0; p < NPHASE; ++p) { a.ph_lo = p; a.ph_hi = p + 1; hipLaunchKernelGGL(mega, dim3(grid), dim3(NTHR), LDS_BYTES, stream, a); }
#endif
    const hipError_t le = hipPeekAtLastError();
    if (le != hipSuccess) fprintf(stderr, "kernel_launch: launch failed: %s\n", hipGetErrorName(le));
}
```

```cpp
#include <hip/hip_runtime.h>
#include <cstdio>
#include <cstdint>

#ifndef MK_SINGLE
#define MK_SINGLE 1
#endif

#define GAS __attribute__((address_space(1)))
#define LAS __attribute__((address_space(3)))

typedef unsigned short bf16_t;
typedef short bf16x8 __attribute__((ext_vector_type(8)));
typedef float f32x4 __attribute__((ext_vector_type(4)));
typedef float f32x16 __attribute__((ext_vector_type(16)));
typedef unsigned u32x4 __attribute__((ext_vector_type(4)));
typedef unsigned u32x2 __attribute__((ext_vector_type(2)));

constexpr int D = 1024, NB = 2, SEQ = 8192, CTXL = 256;
constexpr int RPB = SEQ + CTXL;
constexpr int MTOT = NB * RPB;
constexpr int AB_IN = 2048, A_W = 512, DRNN = 1280, NEXP = 16384;
constexpr float EPS = 1e-6f;
constexpr int NTHR = 512, NWAVE = 8;

constexpr size_t MiB = 1u << 20;
constexpr size_t WS_CTL = 0, CTL_BYTES = 1 * MiB;
constexpr size_t WS_MODV = 1 * MiB;
constexpr size_t WS_ROPE = 1 * MiB + 512 * 1024;
constexpr size_t WS_WIN0 = 2 * MiB;
constexpr size_t WS_WOUT0 = 6 * MiB;
constexpr size_t WS_WIN1 = 8 * MiB;
constexpr size_t WS_WOUT1 = 13 * MiB;
constexpr size_t WS_WQ = 16 * MiB;
constexpr size_t WS_KEYS = 24 * MiB;
constexpr size_t WS_GWS = 25 * MiB;
constexpr size_t WS_WAT = 26 * MiB;
constexpr size_t WS_WXT = 27 * MiB;
constexpr size_t WS_CARRY = 28 * MiB;
constexpr size_t WS_SCU = 31 * MiB;
constexpr size_t WS_SCV = 31 * MiB + 512 * 1024;
constexpr size_t WS_PU = 32 * MiB;
constexpr size_t WS_PV = 96 * MiB;
constexpr size_t WS_H = 160 * MiB;
constexpr size_t WS_X1 = 193 * MiB;
constexpr size_t WS_SELI = 259 * MiB;
constexpr size_t WS_SELG = 268 * MiB;
constexpr size_t WS_R = 277 * MiB;
constexpr size_t WS_U = WS_R;
constexpr size_t WS_VV = WS_R + 17 * MiB;
constexpr size_t WS_Q = WS_R + 34 * MiB;
constexpr size_t WS_K = WS_R + 51 * MiB;
constexpr size_t WS_V = WS_R + 60 * MiB;
constexpr size_t WS_AO = WS_R + 69 * MiB;
constexpr size_t WS_QP = WS_R;
constexpr size_t WS_H8 = WS_R + 70 * MiB;
constexpr size_t WS_SH = WS_R + 88 * MiB;
constexpr size_t WS_ACT16 = WS_R + 89 * MiB;
constexpr size_t WS_SA = WS_R + 94 * MiB;
constexpr size_t WS_PART = WS_R;
constexpr size_t WS_GG = WS_R;
constexpr size_t WS_XR = WS_R + 42 * MiB;
constexpr size_t WS_YG = WS_R + 84 * MiB;
constexpr size_t WS_END = WS_R + 126 * MiB;

constexpr int LDS_BYTES = 147456;
constexpr int LDS_MISC = 145408;

__device__ __forceinline__ float bf2f(bf16_t v) { return __uint_as_float(((unsigned)v) << 16); }
__device__ __forceinline__ unsigned f2bf(float f) { unsigned u = __float_as_uint(f); return (u + 0x7fffu + ((u >> 16) & 1u)) >> 16; }
__device__ __forceinline__ unsigned pk2(float lo, float hi) { return f2bf(lo) | (f2bf(hi) << 16); }
__device__ __forceinline__ float bflo(unsigned w) { return __uint_as_float(w << 16); }
__device__ __forceinline__ float bfhi(unsigned w) { return __uint_as_float(w & 0xffff0000u); }
__device__ __forceinline__ float gelu_t(float x) { const float y = -2.302208198144325f * (x + 0.044715f * x * x * x); return x * __builtin_amdgcn_rcpf(1.f + __builtin_amdgcn_exp2f(y)); }
__device__ __forceinline__ float sigmoidf_(float x) { return 1.f / (1.f + __expf(-x)); }
__device__ __forceinline__ float wave_sum(float v) {
#pragma unroll
    for (int o = 1; o < 64; o <<= 1) v += __shfl_xor(v, o);
    return v;
}
__host__ __device__ __forceinline__ int sigma_head(int j) { const int grp = j >> 3, n = (j >> 2) & 1, e = j & 3; return (grp >> 3) * 64 + n * 32 + (grp & 7) * 4 + e; }

struct Args {
    const float* in[29];
    float* out;
    unsigned char* ws;
    int ph_lo, ph_hi;
};

__device__ __forceinline__ int row_variant(int g) { const int b = g / RPB, i = g - b * RPB; return i < CTXL ? 2 : b; }
__device__ __forceinline__ const float* row_src(const Args& a, int g) {
    const int b = g / RPB, i = g - b * RPB;
    return i < CTXL ? a.in[2] + ((size_t)b * CTXL + i) * D : a.in[0] + ((size_t)b * SEQ + (i - CTXL)) * D;
}
__device__ __forceinline__ const float* modv(const Args& a, int layer, int variant, int which) {
    return (const float*)(a.ws + WS_MODV) + ((size_t)(layer * 3 + variant) * 6 + which) * D;
}

#define XB_TMO      128
#define XB_XCNT(j)  (256  + 64 * (j))
#define XB_XSUB(j)  (1280 + 64 * (j))
#define XB_XGEN(j)  (2304 + 64 * (j))
#define XB_TOP      3328
#define XB_TOPGEN   3392
#define XCD_BAR_WORDS 3456
#define XB_SPIN_CAP (1u << 22)
__device__ __forceinline__ unsigned xb_ld(unsigned* p)              { return __hip_atomic_load(p, __ATOMIC_RELAXED, __HIP_MEMORY_SCOPE_AGENT); }
__device__ __forceinline__ unsigned xb_add(unsigned* p, unsigned v) { return __hip_atomic_fetch_add(p, v, __ATOMIC_RELAXED, __HIP_MEMORY_SCOPE_AGENT); }
__device__ __forceinline__ unsigned xb_xcc_id() { return (unsigned)__builtin_amdgcn_s_getreg((3 << 11) | 20) & 0xFu; }
#define XB_SPIN(cond, bar) do { unsigned _sp = 0; while (cond) { __builtin_amdgcn_s_sleep(1); \
    if ((++_sp & 255u) == 0u) { if (xb_ld(&(bar)[XB_TMO])) break; if (_sp > XB_SPIN_CAP) { atomicAdd(&(bar)[XB_TMO], 1u); break; } } } } while (0)
struct XcdBarrier { unsigned* bar; unsigned x; volatile LAS unsigned* st; };
__device__ __forceinline__ XcdBarrier xcd_barrier_post(unsigned* bar, volatile LAS unsigned* st) {
    XcdBarrier b; b.bar = bar; b.x = xb_xcc_id(); b.st = st;
    if (threadIdx.x == 0) (void)xb_add(&bar[XB_XCNT(b.x)], 1u);
    return b;
}
__device__ __forceinline__ void xcd_barrier_complete(unsigned* bar, unsigned x, unsigned& nloc, unsigned& nx) {
    const unsigned G = gridDim.x * gridDim.y * gridDim.z;
    unsigned sum, cnt, mine, sp = 0u;
    for (;;) {
        sum = 0u; cnt = 0u; mine = 0u;
#pragma unroll
        for (unsigned j = 0; j < 16; ++j) { const unsigned c = xb_ld(&bar[XB_XCNT(j)]); sum += c; cnt += (c > 0u) ? 1u : 0u; mine = (j == x) ? c : mine; }
        if (sum == G) break;
        __builtin_amdgcn_s_sleep(1);
        if ((++sp & 255u) == 0u) { if (xb_ld(&bar[XB_TMO])) break; if (sp > XB_SPIN_CAP) { atomicAdd(&bar[XB_TMO], 1u); break; } }
    }
    nloc = mine > 0u ? mine : 1u; nx = cnt > 0u ? cnt : 1u;
}
__device__ __forceinline__ void xcd_barrier(const XcdBarrier& b) {
    asm volatile("s_waitcnt vmcnt(0)" ::: "memory");
    __syncthreads();
    if (threadIdx.x == 0) {
        unsigned* bar = b.bar;
        __builtin_amdgcn_s_waitcnt(0);
        unsigned nloc = b.st[0], nx = b.st[1];
        if (nloc == 0u) { xcd_barrier_complete(bar, b.x, nloc, nx); b.st[0] = nloc; b.st[1] = nx; }
        const unsigned old = xb_add(&bar[XB_XSUB(b.x)], 1u);
        const unsigned gen = old / nloc;
        if (old + 1u == (gen + 1u) * nloc) {
            __builtin_amdgcn_fence(__ATOMIC_RELEASE, "agent");
            asm volatile("s_waitcnt vmcnt(0)" ::: "memory");
            const unsigned og = xb_add(&bar[XB_TOP], 1u);
            const unsigned tg = og / nx;
            if (og + 1u == (tg + 1u) * nx) xb_add(&bar[XB_TOPGEN], 1u);
            else XB_SPIN(xb_ld(&bar[XB_TOPGEN]) == tg, bar);
            __builtin_amdgcn_fence(__ATOMIC_ACQUIRE, "agent");
            xb_add(&bar[XB_XGEN(b.x)], 1u);
            asm volatile("s_waitcnt vmcnt(0)" ::: "memory");
        } else {
            XB_SPIN(xb_ld(&bar[XB_XGEN(b.x)]) == gen, bar);
            __builtin_amdgcn_fence(__ATOMIC_ACQUIRE, "agent");
            asm volatile("s_waitcnt vmcnt(0)" ::: "memory");
        }
    }
    __syncthreads();
}

__device__ __forceinline__ void quant_tables(const Args& a, int layer, int gw, int ngw, int lane) {
    unsigned char* ws = a.ws;
    for (int r = gw; r < 2 * NEXP; r += ngw) {
        const int tb = r / NEXP, ex = r - tb * NEXP, rr = layer * NEXP + ex;
        const float* src = a.in[tb == 0 ? 26 : 27] + (size_t)rr * D;
        f32x4 v[4]; float mx = 0.f;
#pragma unroll
        for (int j = 0; j < 4; ++j) { v[j] = *(const f32x4*)(src + j * 256 + lane * 4); mx = fmaxf(fmaxf(fmaxf(fabsf(v[j].x), fabsf(v[j].y)), fmaxf(fabsf(v[j].z), fabsf(v[j].w))), mx); }
#pragma unroll
        for (int o = 1; o < 64; o <<= 1) mx = fmaxf(mx, __shfl_xor(mx, o));
        mx = fmaxf(mx, 1e-30f);
        const float inv = 127.f / mx;
        unsigned char* dst = ws + (tb == 0 ? WS_PU : WS_PV) + (size_t)layer * NEXP * D + (size_t)ex * 128 + (lane & 31) * 4;
        const int bias = tb == 0 ? 0 : 128;
#pragma unroll
        for (int j = 0; j < 4; ++j) {
            const unsigned b0 = (unsigned)(__float2int_rn(v[j].x * inv) + bias) & 0xffu, b1 = (unsigned)(__float2int_rn(v[j].y * inv) + bias) & 0xffu;
            const unsigned b2 = (unsigned)(__float2int_rn(v[j].z * inv) + bias) & 0xffu, b3 = (unsigned)(__float2int_rn(v[j].w * inv) + bias) & 0xffu;
            *(unsigned*)(dst + (size_t)(2 * j + (lane >> 5)) * NEXP * 128) = b0 | (b1 << 8) | (b2 << 16) | (b3 << 24);
        }
        if (lane == 0) ((float*)(ws + (tb == 0 ? WS_SCU : WS_SCV)))[rr] = mx * (1.f / 127.f);
    }
}
__device__ __forceinline__ void transpose_item(const float* src, int Ns, bf16_t* dst, int Kd, int n0, int k0, int perm_lo, int perm_hi, float* tile) {
    const int tid = threadIdx.x;
    {
        const int nn = tid & 63; int n = n0 + nn;
        if (n >= perm_lo && n < perm_hi) { const int rel = n - perm_lo; n = perm_lo + (rel & ~127) + sigma_head(rel & 127); }
#pragma unroll
        for (int i = 0; i < 8; ++i) { const int kk = (tid >> 6) + 8 * i; tile[kk * 65 + nn] = src[(size_t)(k0 + kk) * Ns + n]; }
    }
    __syncthreads();
    {
        const int n = tid >> 3, kc = (tid & 7) * 8;
        u32x4 o;
        o.x = pk2(tile[(kc + 0) * 65 + n], tile[(kc + 1) * 65 + n]); o.y = pk2(tile[(kc + 2) * 65 + n], tile[(kc + 3) * 65 + n]);
        o.z = pk2(tile[(kc + 4) * 65 + n], tile[(kc + 5) * 65 + n]); o.w = pk2(tile[(kc + 6) * 65 + n], tile[(kc + 7) * 65 + n]);
        *(u32x4*)(dst + (size_t)(n0 + n) * Kd + k0 + kc) = o;
    }
    __syncthreads();
}
__device__ __forceinline__ void cvt_stream(const float* src, bf16_t* dst, size_t n8, size_t gtid, size_t gthreads) {
    for (size_t i = gtid; i < n8; i += gthreads) {
        const f32x4 a = *(const f32x4*)(src + i * 8), b = *(const f32x4*)(src + i * 8 + 4);
        u32x4 o; o.x = pk2(a.x, a.y); o.y = pk2(a.z, a.w); o.z = pk2(b.x, b.y); o.w = pk2(b.z, b.w);
        *(u32x4*)(dst + i * 8) = o;
    }
}
__device__ __forceinline__ void prep_l1_item(const Args& a, float* tile, int r) {
    unsigned char* ws = a.ws;
    constexpr int I_WIN1 = (1024 / 64) * (2560 / 64), I_WOUT1 = (1280 / 64) * (1024 / 64), I_WQ1 = (1024 / 64) * (2048 / 64);
    if (r < I_WIN1) { const int nb = r % 40, kb = r / 40; transpose_item(a.in[15], 2560, (bf16_t*)(ws + WS_WIN1), 1024, nb * 64, kb * 64, 0, 0, tile); return; }
    r -= I_WIN1;
    if (r < I_WOUT1) { const int nb = r % 16, kb = r / 16; transpose_item(a.in[23], 1024, (bf16_t*)(ws + WS_WOUT1), 1280, nb * 64, kb * 64, 0, 0, tile); return; }
    r -= I_WOUT1;
    if (r < I_WQ1) { const int nb = r % 32, kb = r / 32;
        transpose_item(a.in[24] + (size_t)1024 * 2048, 2048, (bf16_t*)(ws + WS_WQ) + (size_t)2048 * 1024, 1024, nb * 64, kb * 64, 0, 0, tile); return; }
    r -= I_WQ1;
    { const int m = r / 4, q = r % 4, nb = q % 2, kb = q / 2;
        const int which = m / 20, dh = m % 20;
        const float* src = a.in[which == 0 ? 18 : 20] + (size_t)dh * 128 * 128;
        bf16_t* dst = (bf16_t*)(ws + (which == 0 ? WS_WAT : WS_WXT)) + (size_t)dh * 128 * 128;
        transpose_item(src, 128, dst, 128, nb * 64, kb * 64, 0, 0, tile);
    }
}
constexpr int N_L1_ITEMS = 640 + 320 + 512 + 160;
__device__ __forceinline__ void phase_prep(const Args& a, char* lds) {
    const int tid = threadIdx.x, lane = tid & 63, wid = tid >> 6;
    float* tile = (float*)lds;
    unsigned char* ws = a.ws;
    constexpr int I_MOD = 192;
    constexpr int I_WIN0 = (1024 / 64) * (2048 / 64), I_WOUT0 = (1024 / 64) * (1024 / 64), I_WQ0 = (1024 / 64) * (2048 / 64);
    constexpr int NIT = I_MOD + I_WIN0 + I_WOUT0 + I_WQ0;
    for (int it = blockIdx.x; it < NIT; it += gridDim.x) {
        int r = it;
        if (r < I_MOD) {
            const int l = r / 96, n0 = (r % 96) * 64;
            const float* W = a.in[4] + (size_t)l * D * 6144;
            float s0 = 0.f, s1 = 0.f, s2 = 0.f;
            float sl[3][2];
#pragma unroll
            for (int h = 0; h < 2; ++h) { const int k = wid * 128 + h * 64 + lane; const float c0 = a.in[1][k], c1 = a.in[1][D + k], c2 = a.in[3][k];
                sl[0][h] = c0 * sigmoidf_(c0); sl[1][h] = c1 * sigmoidf_(c1); sl[2][h] = c2 * sigmoidf_(c2); }
            const float* Wp = W + (size_t)(wid * 128) * 6144 + n0 + lane;
#pragma unroll
            for (int kk = 0; kk < 128; kk += 16) {
                float w[16];
#pragma unroll
                for (int j = 0; j < 16; ++j) w[j] = Wp[(size_t)(kk + j) * 6144];
#pragma unroll
                for (int j = 0; j < 16; ++j) { const int kq = kk + j;
                    s0 += __shfl(sl[0][kq >> 6], kq & 63) * w[j]; s1 += __shfl(sl[1][kq >> 6], kq & 63) * w[j]; s2 += __shfl(sl[2][kq >> 6], kq & 63) * w[j]; }
            }
            tile[(wid * 3 + 0) * 64 + lane] = s0; tile[(wid * 3 + 1) * 64 + lane] = s1; tile[(wid * 3 + 2) * 64 + lane] = s2;
            __syncthreads();
            if (tid < 192) {
                const int v = tid / 64, ln = tid & 63; float s = a.in[5][(size_t)l * 6144 + n0 + ln];
                for (int w = 0; w < 8; ++w) s += tile[(w * 3 + v) * 64 + ln];
                ((float*)(ws + WS_MODV))[(size_t)(l * 3 + v) * 6144 + n0 + ln] = s;
            }
            __syncthreads();
            continue;
        }
        r -= I_MOD;
        if (r < I_WIN0) { const int nb = r % 32, kb = r / 32; transpose_item(a.in[8], 2048, (bf16_t*)(ws + WS_WIN0), 1024, nb * 64, kb * 64, 1024, 1792, tile); continue; }
        r -= I_WIN0;
        if (r < I_WOUT0) { const int nb = r % 16, kb = r / 16; transpose_item(a.in[14], 1024, (bf16_t*)(ws + WS_WOUT0), 1024, nb * 64, kb * 64, 0, 0, tile); continue; }
        r -= I_WOUT0;
        { const int nb = r % 32, kb = r / 32; transpose_item(a.in[24], 2048, (bf16_t*)(ws + WS_WQ), 1024, nb * 64, kb * 64, 0, 0, tile); }
    }
    const size_t gtid = (size_t)blockIdx.x * NTHR + tid, gthreads = (size_t)gridDim.x * NTHR;
    cvt_stream(a.in[25], (bf16_t*)(ws + WS_KEYS), (size_t)2 * 8 * 2 * 128 * 128 / 8, gtid, gthreads);
    cvt_stream(a.in[10], (bf16_t*)(ws + WS_GWS), (size_t)4 * 128 * 128 / 8, gtid, gthreads);
    quant_tables(a, 0, blockIdx.x * NWAVE + wid, gridDim.x * NWAVE, lane);
    for (size_t i = gtid; i < 128 * 32; i += gthreads) {
        const int pos = (int)(i / 32), f = (int)(i % 32);
        const float inv = powf(10000.f, -(float)f / 32.f); const float ang = (float)pos * inv;
        float* R = (float*)(ws + WS_ROPE); R[i * 2] = cosf(ang); R[i * 2 + 1] = sinf(ang);
    }
}

__device__ __forceinline__ void norm_row_store(const f32x4 (&v)[4], const float* g, const float* sh, const float* sc, bf16_t* orow, int lane, unsigned char* q8row = nullptr, float* q8scale = nullptr) {
    float s = 0.f;
#pragma unroll
    for (int j = 0; j < 4; ++j) s += (v[j].x * v[j].x + v[j].y * v[j].y) + (v[j].z * v[j].z + v[j].w * v[j].w);
    const float rinv = rsqrtf(wave_sum(s) * (1.f / D) + EPS);
    f32x4 o[4]; float mx = 0.f;
#pragma unroll
    for (int j = 0; j < 4; ++j) {
        const int c = j * 256 + lane * 4;
        const f32x4 gg = *(const f32x4*)(g + c), s1 = *(const f32x4*)(sh + c), s2 = *(const f32x4*)(sc + c);
        o[j].x = v[j].x * rinv * gg.x * (1.f + s2.x) + s1.x; o[j].y = v[j].y * rinv * gg.y * (1.f + s2.y) + s1.y;
        o[j].z = v[j].z * rinv * gg.z * (1.f + s2.z) + s1.z; o[j].w = v[j].w * rinv * gg.w * (1.f + s2.w) + s1.w;
        u32x2 w; w.x = pk2(o[j].x, o[j].y); w.y = pk2(o[j].z, o[j].w);
        *(u32x2*)(orow + c) = w;
        mx = fmaxf(fmaxf(fmaxf(fabsf(o[j].x), fabsf(o[j].y)), fmaxf(fabsf(o[j].z), fabsf(o[j].w))), mx);
    }
    if (q8row) {
#pragma unroll
        for (int of = 1; of < 64; of <<= 1) mx = fmaxf(mx, __shfl_xor(mx, of));
        mx = fmaxf(mx, 1e-30f); const float inv = 127.f / mx;
#pragma unroll
        for (int j = 0; j < 4; ++j) {
            const unsigned b0 = (unsigned)__float2int_rn(o[j].x * inv) & 0xffu, b1 = (unsigned)__float2int_rn(o[j].y * inv) & 0xffu;
            const unsigned b2 = (unsigned)__float2int_rn(o[j].z * inv) & 0xffu, b3 = (unsigned)__float2int_rn(o[j].w * inv) & 0xffu;
            *(unsigned*)(q8row + j * 256 + lane * 4) = b0 | (b1 << 8) | (b2 << 16) | (b3 << 24);
        }
        if (lane == 0) *q8scale = mx * (1.f / 127.f);
    }
}
__device__ __forceinline__ void phase_norm(const Args& a, int layer, int src_mode, const float* gain, int which_sh, int which_sc, bool latent_only, bool wq8 = false) {
    const int lane = threadIdx.x & 63, gw = blockIdx.x * NWAVE + (threadIdx.x >> 6), ngw = gridDim.x * NWAVE;
    bf16_t* H = (bf16_t*)(a.ws + WS_H);
    const float* X1 = (const float*)(a.ws + WS_X1);
    for (int g = gw; g < MTOT; g += ngw) {
        const int var = row_variant(g);
        if (latent_only && var == 2) continue;
        const float* xr = src_mode == 0 ? row_src(a, g) : X1 + (size_t)g * D;
        f32x4 v[4];
#pragma unroll
        for (int j = 0; j < 4; ++j) v[j] = *(const f32x4*)(xr + j * 256 + lane * 4);
        norm_row_store(v, gain, modv(a, layer, var, which_sh), modv(a, layer, var, which_sc), H + (size_t)g * D, lane, wq8 ? a.ws + WS_H8 + (size_t)g * D : nullptr, wq8 ? (float*)(a.ws + WS_SH) + g : nullptr);
    }
}

constexpr int CS_LD = 132;
__device__ __forceinline__ void gemm_tile128(const bf16_t* A, int lda, const bf16_t* Bt, int ldb, int K, float* Cs) {
    const int tid = threadIdx.x, lane = tid & 63, wid = tid >> 6, r = lane & 31, h = lane >> 5, wr = wid >> 1, wc = wid & 1;
    const bf16_t* ap = A + (size_t)(wr * 32 + r) * lda + 8 * h;
    const bf16_t* bp0 = Bt + (size_t)(wc * 64 + r) * ldb + 8 * h;
    const bf16_t* bp1 = bp0 + (size_t)32 * ldb;
    f32x16 acc0 = {}, acc1 = {};
#pragma unroll 4
    for (int k = 0; k < K; k += 16) {
        const bf16x8 av = *(const bf16x8*)(ap + k), b0 = *(const bf16x8*)(bp0 + k), b1 = *(const bf16x8*)(bp1 + k);
        acc0 = __builtin_amdgcn_mfma_f32_32x32x16_bf16(av, b0, acc0, 0, 0, 0);
        acc1 = __builtin_amdgcn_mfma_f32_32x32x16_bf16(av, b1, acc1, 0, 0, 0);
    }
#pragma unroll
    for (int i = 0; i < 16; ++i) {
        const int row = wr * 32 + (i & 3) + 8 * (i >> 2) + 4 * h;
        Cs[row * CS_LD + wc * 64 + r] = acc0[i];
        Cs[row * CS_LD + wc * 64 + 32 + r] = acc1[i];
    }
}

__device__ __forceinline__ void phase_inproj0(const Args& a, char* lds) {
    float* Cs = (float*)lds;
    const int tid = threadIdx.x;
    unsigned char* ws = a.ws;
    const bf16_t* H = (const bf16_t*)(ws + WS_H); const bf16_t* W = (const bf16_t*)(ws + WS_WIN0);
    const float* rope = (const float*)(ws + WS_ROPE);
    const int NU = (MTOT / 128) * 16;
    for (int u = blockIdx.x; u < NU; u += gridDim.x) {
        const int rt = u / 16, ct = u % 16, row0 = rt * 128, col0 = ct * 128;
        gemm_tile128(H + (size_t)row0 * D, D, W + (size_t)col0 * D, D, D, Cs);
        __syncthreads();
        const int rr = tid >> 2, q4 = tid & 3, g = row0 + rr;
        float* crow = Cs + rr * CS_LD + q4 * 32;
        if (ct < 4) {
            bf16_t* o = (bf16_t*)(ws + WS_U) + (size_t)g * 512 + col0 + q4 * 32;
#pragma unroll
            for (int c = 0; c < 32; c += 2) *(unsigned*)(o + c) = pk2(gelu_t(crow[c]), gelu_t(crow[c + 1]));
        } else if (ct < 8) {
            const int gg = ct - 4; float ss = 0.f;
#pragma unroll
            for (int c = 0; c < 32; ++c) { const float v = gelu_t(crow[c]); crow[c] = v; ss += v * v; }
            ss += __shfl_xor(ss, 1); ss += __shfl_xor(ss, 2);
            const float rinv = rsqrtf(ss * (1.f / 128.f) + EPS);
            const float* gn = a.in[9] + gg * 128 + q4 * 32;
            bf16_t* o = (bf16_t*)(ws + WS_VV) + (size_t)g * 512 + gg * 128 + q4 * 32;
#pragma unroll
            for (int c = 0; c < 32; c += 2) *(unsigned*)(o + c) = pk2(crow[c] * rinv * gn[c], crow[c + 1] * rinv * gn[c + 1]);
        } else if (ct < 14) {
            const bool isq = ct < 12; const int hh = isq ? ct - 8 : ct - 12;
            float ss = 0.f;
#pragma unroll
            for (int c = 0; c < 32; ++c) ss += crow[c] * crow[c];
            ss += __shfl_xor(ss, 1); ss += __shfl_xor(ss, 2);
            const float rinv = rsqrtf(ss * (1.f / 128.f) + EPS);
            const float* gn = a.in[isq ? 12 : 13];
            const int b = g / RPB, i = g - b * RPB; const bool lat = i >= CTXL; const int t = i - CTXL;
            bf16_t* o = (isq ? (bf16_t*)(ws + WS_Q) + (size_t)g * 512 : (bf16_t*)(ws + WS_K) + (size_t)g * 256) + hh * 128 + q4 * 32;
#pragma unroll
            for (int c8 = 0; c8 < 32; c8 += 8) {
                float y[8];
#pragma unroll
                for (int e = 0; e < 8; ++e) { const int j = q4 * 32 + c8 + e; y[e] = crow[c8 + e] * rinv * gn[sigma_head(j)]; }
                if (lat) {
                    const int grp = (q4 * 32 + c8) >> 3, ax = grp >> 3; const int pos = ax == 0 ? (t >> 6) : (t & 63);
#pragma unroll
                    for (int e = 0; e < 4; ++e) { const int f = (grp & 7) * 4 + e; const float cs = rope[(pos * 32 + f) * 2], sn = rope[(pos * 32 + f) * 2 + 1];
                        const float x1 = y[e], x2 = y[e + 4]; y[e] = x1 * cs - x2 * sn; y[e + 4] = x2 * cs + x1 * sn; }
                }
                u32x4 w; w.x = pk2(y[0], y[1]); w.y = pk2(y[2], y[3]); w.z = pk2(y[4], y[5]); w.w = pk2(y[6], y[7]);
                *(u32x4*)(o + c8) = w;
            }
        } else {
            bf16_t* o = (bf16_t*)(ws + WS_V) + (size_t)g * 256 + (ct - 14) * 128 + q4 * 32;
#pragma unroll
            for (int c = 0; c < 32; c += 2) *(unsigned*)(o + c) = pk2(crow[c], crow[c + 1]);
        }
        __syncthreads();
    }
}

__device__ __forceinline__ void phase_gmlp(const Args& a, char* lds) {
    const int tid = threadIdx.x;
    unsigned char* ws = a.ws;
    float* vt = (float*)lds;
    const bf16_t* VV = (const bf16_t*)(ws + WS_VV); const bf16_t* U = (const bf16_t*)(ws + WS_U); bf16_t* AO = (bf16_t*)(ws + WS_AO);
    const int NU = (MTOT / 128) * 4;
    for (int u = blockIdx.x; u < NU; u += gridDim.x) {
        const int ch = u / 4, g = u % 4, row0 = ch * 128;
        for (int i = tid; i < 128 * 128; i += NTHR) { const int q = i >> 7, c = i & 127; vt[i] = bf2f(VV[(size_t)(row0 + q) * 512 + g * 128 + c]); }
        __syncthreads();
        const int c = tid & 127, pq = tid >> 7;
        const float* wsg = a.in[10] + (size_t)g * 128 * 128;
        for (int pp = 0; pp < 32; ++pp) {
            const int p = pq * 32 + pp; float s = 0.f;
            for (int q = 0; q < 128; ++q) s += wsg[p * 128 + q] * vt[q * 128 + c];
            s += a.in[11][g * 128 + p];
            const float uu = bf2f(U[(size_t)(row0 + p) * 512 + g * 128 + c]);
            AO[(size_t)(row0 + p) * 1024 + g * 128 + c] = (bf16_t)f2bf(uu * s);
        }
        __syncthreads();
    }
}

__device__ __forceinline__ void phase_gmlp2(const Args& a, char* lds) {
    const int tid = threadIdx.x, lane = tid & 63, wid = __builtin_amdgcn_readfirstlane(tid >> 6), r32 = lane & 31, hh = lane >> 5;
    unsigned char* ws = a.ws;
    LAS bf16_t* vT = (LAS bf16_t*)((LAS char*)lds);
    const bf16_t* VV = (const bf16_t*)(ws + WS_VV); const bf16_t* U = (const bf16_t*)(ws + WS_U); bf16_t* AO = (bf16_t*)(ws + WS_AO);
    const bf16_t* GWS = (const bf16_t*)(ws + WS_GWS);
    const int NU = (MTOT / 128) * 4;
    for (int u = blockIdx.x; u < NU; u += gridDim.x) {
        const int ch = u >> 2, g = u & 3, row0 = ch * 128;
#pragma unroll
        for (int i = 0; i < 4; ++i) {
            const int q = (tid >> 4) + 32 * i, c0 = (tid & 15) * 8;
            const u32x4 w = *(const u32x4*)(VV + (size_t)(row0 + q) * 512 + g * 128 + c0);
            vT[(c0 + 0) * 136 + q] = (bf16_t)(w.x & 0xffffu); vT[(c0 + 1) * 136 + q] = (bf16_t)(w.x >> 16);
            vT[(c0 + 2) * 136 + q] = (bf16_t)(w.y & 0xffffu); vT[(c0 + 3) * 136 + q] = (bf16_t)(w.y >> 16);
            vT[(c0 + 4) * 136 + q] = (bf16_t)(w.z & 0xffffu); vT[(c0 + 5) * 136 + q] = (bf16_t)(w.z >> 16);
            vT[(c0 + 6) * 136 + q] = (bf16_t)(w.w & 0xffffu); vT[(c0 + 7) * 136 + q] = (bf16_t)(w.w >> 16);
        }
        __syncthreads();
        const int mb = wid >> 1, nb0 = (wid & 1) * 2;
        f32x16 acc0 = {}, acc1 = {};
        {
            unsigned aoff = (unsigned)((mb * 32 + r32) * 128 + 8 * hh); asm volatile("" : "+v"(aoff));
            const bf16_t* wsg = GWS + (size_t)g * 128 * 128;
#pragma unroll
            for (int ks = 0; ks < 8; ++ks) {
                const bf16x8 af = *(const bf16x8*)(wsg + aoff + ks * 16);
                const bf16x8 b0 = *(const LAS bf16x8*)(vT + (nb0 * 32 + r32) * 136 + ks * 16 + 8 * hh);
                const bf16x8 b1 = *(const LAS bf16x8*)(vT + ((nb0 + 1) * 32 + r32) * 136 + ks * 16 + 8 * hh);
                acc0 = __builtin_amdgcn_mfma_f32_32x32x16_bf16(af, b0, acc0, 0, 0, 0);
                acc1 = __builtin_amdgcn_mfma_f32_32x32x16_bf16(af, b1, acc1, 0, 0, 0);
            }
        }
#pragma unroll
        for (int r = 0; r < 16; ++r) {
            const int p = mb * 32 + (r & 3) + 8 * (r >> 2) + 4 * hh;
            const float bsv = a.in[11][g * 128 + p];
            const size_t ub = (size_t)(row0 + p) * 512 + g * 128, ob = (size_t)(row0 + p) * 1024 + g * 128;
            const int c0 = nb0 * 32 + r32, c1 = c0 + 32;
            AO[ob + c0] = (bf16_t)f2bf(bf2f(U[ub + c0]) * (acc0[r] + bsv));
            AO[ob + c1] = (bf16_t)f2bf(bf2f(U[ub + c1]) * (acc1[r] + bsv));
        }
        __syncthreads();
    }
}

__device__ __forceinline__ void phase_attn_naive(const Args& a, char* lds) {
    const int tid = threadIdx.x;
    unsigned char* ws = a.ws;
    float* Ks = (float*)lds;
    float* Vs = Ks + 32 * 128;
    float* part = Vs + 32 * 128;
    const bf16_t* Q = (const bf16_t*)(ws + WS_Q); const bf16_t* Kb = (const bf16_t*)(ws + WS_K); const bf16_t* Vb = (const bf16_t*)(ws + WS_V);
    bf16_t* AO = (bf16_t*)(ws + WS_AO);
    const int NU = 512 + 16;
    for (int u = blockIdx.x; u < NU; u += gridDim.x) {
        int b, h, qrow0, nkeys;
        if (u < 512) { b = u / 256; h = (u / 64) % 4; qrow0 = b * RPB + CTXL + (u % 64) * 128; nkeys = RPB; }
        else { const int v = u - 512; b = v / 8; h = (v / 2) % 4; qrow0 = b * RPB + (v % 2) * 128; nkeys = CTXL; }
        const int kvh = h >> 1, krow0 = b * RPB;
        const int qi = tid & 127, qt = tid >> 7;
        float q[32], o[32];
        {
            const bf16_t* qp = Q + (size_t)(qrow0 + qi) * 512 + h * 128 + qt * 32;
#pragma unroll
            for (int d = 0; d < 32; d += 2) { const unsigned w = *(const unsigned*)(qp + d); q[d] = bflo(w) * 0.08838834764831845f; q[d + 1] = bfhi(w) * 0.08838834764831845f; }
#pragma unroll
            for (int d = 0; d < 32; ++d) o[d] = 0.f;
        }
        float m = -1e30f, l = 0.f;
        for (int k0 = 0; k0 < nkeys; k0 += 32) {
            {
                const int key = tid >> 4, cs = (tid & 15) * 8;
                const u32x4 kw = *(const u32x4*)(Kb + (size_t)(krow0 + k0 + key) * 256 + kvh * 128 + cs);
                const u32x4 vw = *(const u32x4*)(Vb + (size_t)(krow0 + k0 + key) * 256 + kvh * 128 + cs);
                float* kd = Ks + key * 128 + cs; float* vd = Vs + key * 128 + cs;
                kd[0] = bflo(kw.x); kd[1] = bfhi(kw.x); kd[2] = bflo(kw.y); kd[3] = bfhi(kw.y); kd[4] = bflo(kw.z); kd[5] = bfhi(kw.z); kd[6] = bflo(kw.w); kd[7] = bfhi(kw.w);
                vd[0] = bflo(vw.x); vd[1] = bfhi(vw.x); vd[2] = bflo(vw.y); vd[3] = bfhi(vw.y); vd[4] = bflo(vw.z); vd[5] = bfhi(vw.z); vd[6] = bflo(vw.w); vd[7] = bfhi(vw.w);
            }
            __syncthreads();
#pragma unroll 2
            for (int j = 0; j < 32; ++j) {
                const float* kr = Ks + j * 128 + qt * 32; float acc = 0.f;
#pragma unroll
                for (int d = 0; d < 32; d += 4) { const f32x4 kv = *(const f32x4*)(kr + d); acc += q[d] * kv.x + q[d + 1] * kv.y + q[d + 2] * kv.z + q[d + 3] * kv.w; }
                part[(qt * 32 + j) * 128 + qi] = acc;
            }
            __syncthreads();
            float mx = m;
#pragma unroll 4
            for (int j = 0; j < 32; ++j) { const float sj = (part[(0 * 32 + j) * 128 + qi] + part[(1 * 32 + j) * 128 + qi]) + (part[(2 * 32 + j) * 128 + qi] + part[(3 * 32 + j) * 128 + qi]); mx = fmaxf(mx, sj); }
            const float alpha = __expf(m - mx); m = mx; float ps = 0.f;
#pragma unroll
            for (int d = 0; d < 32; ++d) o[d] *= alpha;
#pragma unroll 2
            for (int j = 0; j < 32; ++j) {
                const float sj = (part[(0 * 32 + j) * 128 + qi] + part[(1 * 32 + j) * 128 + qi]) + (part[(2 * 32 + j) * 128 + qi] + part[(3 * 32 + j) * 128 + qi]);
                const float pj = __expf(sj - mx); ps += pj;
                const float* vr = Vs + j * 128 + qt * 32;
#pragma unroll
                for (int d = 0; d < 32; d += 4) { const f32x4 vv = *(const f32x4*)(vr + d); o[d] += pj * vv.x; o[d + 1] += pj * vv.y; o[d + 2] += pj * vv.z; o[d + 3] += pj * vv.w; }
            }
            l = l * alpha + ps;
            __syncthreads();
        }
        const float rl = 1.f / l;
        bf16_t* op = AO + (size_t)(qrow0 + qi) * 1024 + 512 + h * 128 + qt * 32;
#pragma unroll
        for (int d = 0; d < 32; d += 2) *(unsigned*)(op + d) = pk2(o[d] * rl, o[d + 1] * rl);
    }
}

namespace fa {
typedef short s16x4 __attribute__((ext_vector_type(4)));
constexpr int QBLK = 32, KVBLK = 64, LDQ = 512, LDK = 256, LDO = 1024;
constexpr float SCALE = 0.088388347648318440f, THR = 8.f;
constexpr size_t SHM_V = KVBLK * 128 * 2, SHM_K = KVBLK * 128 * 2, SHM_ATTN = 2 * SHM_V + 2 * SHM_K + NWAVE * 64 * 4;
#define KSWZ(row, colB) ((row) * 256 + ((colB) ^ (((row) & 7) << 4)))
#define SBAR() __builtin_amdgcn_sched_barrier(0)
__device__ __forceinline__ int crow(int r, int hi) { return (r & 3) + 8 * (r >> 2) + 4 * hi; }
__device__ __forceinline__ unsigned cvtpk(float lo, float hi) { unsigned r; asm volatile("v_cvt_pk_bf16_f32 %0, %1, %2" : "=v"(r) : "v"(lo), "v"(hi)); return r; }
__device__ __forceinline__ void partialSM(f32x16& p0, f32x16& p1, float& m_reg, float& mn, float& alpha) {
  constexpr float C = SCALE * 1.4426950408889634f;
  float pmax = p0[0]; for (int r = 1; r < 16; ++r) pmax = fmaxf(pmax, p0[r]); for (int r = 0; r < 16; ++r) pmax = fmaxf(pmax, p1[r]);
  { auto rr = __builtin_amdgcn_permlane32_swap(__float_as_uint(pmax), __float_as_uint(pmax), false, false);
    pmax = fmaxf(__uint_as_float(rr[0]), __uint_as_float(rr[1])); }
  if (__builtin_expect(__all(pmax - m_reg <= THR / SCALE), 1)) { mn = m_reg; alpha = 1.f; }
  else { mn = fmaxf(m_reg, pmax); alpha = __builtin_amdgcn_exp2f((m_reg - mn) * C); m_reg = mn; }
  float mnC = -mn * C;
  for (int r = 0; r < 16; ++r) p0[r] = fmaf(p0[r], C, mnC); for (int r = 0; r < 16; ++r) p1[r] = fmaf(p1[r], C, mnC);
  for (int r = 0; r < 16; ++r) p0[r] = __builtin_amdgcn_exp2f(p0[r]);
}
__device__ __forceinline__ void finishSM(f32x16& p0, f32x16& p1, float alpha, float& l_reg, bf16x8& pa0, bf16x8& pa1, bf16x8& pa2, bf16x8& pa3) {
  for (int r = 0; r < 16; ++r) p1[r] = __builtin_amdgcn_exp2f(p1[r]);
  float ps = 0; for (int r = 0; r < 16; ++r) ps += p0[r]; for (int r = 0; r < 16; ++r) ps += p1[r];
  { auto rr = __builtin_amdgcn_permlane32_swap(__float_as_uint(ps), __float_as_uint(ps), false, false);
    ps = __uint_as_float(rr[0]) + __uint_as_float(rr[1]); }
  l_reg = l_reg * alpha + ps;
#define PK4(P, BASE, OUT) do { unsigned a0 = cvtpk(P[BASE + 0], P[BASE + 1]), a1 = cvtpk(P[BASE + 2], P[BASE + 3]);   \
    unsigned b0 = cvtpk(P[BASE + 4], P[BASE + 5]), b1 = cvtpk(P[BASE + 6], P[BASE + 7]);                              \
    auto r0 = __builtin_amdgcn_permlane32_swap(a0, b0, false, false); auto r1 = __builtin_amdgcn_permlane32_swap(a1, b1, false, false); \
    u32x4 w = {r0[0], r1[0], r0[1], r1[1]}; OUT = *reinterpret_cast<bf16x8*>(&w); } while (0)
  PK4(p0, 0, pa0); PK4(p0, 8, pa1); PK4(p1, 0, pa2); PK4(p1, 8, pa3);
#undef PK4
}
__device__ __forceinline__ void qkt(f32x16& p0, f32x16& p1, const bf16_t* Ks, const bf16x8* qr, int r32, int hi) {
  p0 = f32x16{}; p1 = f32x16{};
  for (int d0 = 0; d0 < 8; ++d0) { int cb = (d0 * 16 + hi * 8) * 2;
    bf16x8 b0 = *reinterpret_cast<const bf16x8*>((const char*)Ks + KSWZ(r32, cb));
    bf16x8 b1 = *reinterpret_cast<const bf16x8*>((const char*)Ks + KSWZ(32 + r32, cb));
    p0 = __builtin_amdgcn_mfma_f32_32x32x16_bf16(b0, qr[d0], p0, 0, 0, 0);
    p1 = __builtin_amdgcn_mfma_f32_32x32x16_bf16(b1, qr[d0], p1, 0, 0, 0); }
}
__device__ __forceinline__ int v_st(int k, int c) { const int kk = (k & ~0xC) | ((k & 4) << 1) | ((k & 8) >> 1); return ((kk >> 3) * 4 + (c >> 5)) * 512 + ((kk & 7) * 32 + (c & 31)) * 2; }
__device__ __forceinline__ int v_rd_base(int lane) { return ((lane & 3) << 3) | (((lane >> 2) & 3) << 6) | (((lane >> 4) & 1) << 5) | (((lane >> 5) & 1) << 8); }
constexpr int v_rd_off(int d0, int ks, int half) { return d0 * 512 + ks * 4096 + half * 2048; }
template <int OFF> __device__ __forceinline__ s16x4 tr_read(int vb) {
  s16x4 r; asm volatile("ds_read_b64_tr_b16 %0, %1 offset:%2" : "=&v"(r) : "v"(vb), "i"(OFF) : "memory"); return r;
}
template <int D0> __device__ __forceinline__ void pv_one(f32x16& od, int vb, bf16x8 pa0, bf16x8 pa1, bf16x8 pa2, bf16x8 pa3) {
  const s16x4 l0 = tr_read<v_rd_off(D0, 0, 0)>(vb), h0 = tr_read<v_rd_off(D0, 0, 1)>(vb), l1 = tr_read<v_rd_off(D0, 1, 0)>(vb), h1 = tr_read<v_rd_off(D0, 1, 1)>(vb);
  const s16x4 l2 = tr_read<v_rd_off(D0, 2, 0)>(vb), h2 = tr_read<v_rd_off(D0, 2, 1)>(vb), l3 = tr_read<v_rd_off(D0, 3, 0)>(vb), h3 = tr_read<v_rd_off(D0, 3, 1)>(vb);
  asm volatile("s_waitcnt lgkmcnt(0)" ::: "memory"); SBAR();
#define PK(L, H) (bf16x8){L[0], L[1], L[2], L[3], H[0], H[1], H[2], H[3]}
  od = __builtin_amdgcn_mfma_f32_32x32x16_bf16(pa0, PK(l0, h0), od, 0, 0, 0);
  od = __builtin_amdgcn_mfma_f32_32x32x16_bf16(pa1, PK(l1, h1), od, 0, 0, 0);
  od = __builtin_amdgcn_mfma_f32_32x32x16_bf16(pa2, PK(l2, h2), od, 0, 0, 0);
  od = __builtin_amdgcn_mfma_f32_32x32x16_bf16(pa3, PK(l3, h3), od, 0, 0, 0);
#undef PK
}
__device__ __forceinline__ void pv_d0(f32x16* o, int vb, bf16x8 pa0, bf16x8 pa1, bf16x8 pa2, bf16x8 pa3) {
  pv_one<0>(o[0], vb, pa0, pa1, pa2, pa3); pv_one<1>(o[1], vb, pa0, pa1, pa2, pa3); pv_one<2>(o[2], vb, pa0, pa1, pa2, pa3); pv_one<3>(o[3], vb, pa0, pa1, pa2, pa3);
}
__device__ __forceinline__ void attn_dense_body(const bf16_t* __restrict__ Qb, const bf16_t* __restrict__ Kh, const bf16_t* __restrict__ Vh,
                                                bf16_t* __restrict__ Ob, int seq, char* lds) {
  const int tid = threadIdx.x, wid = tid >> 6, lane = tid & 63, r32 = lane & 31, hi = lane >> 5;
  bf16_t* V_lds = (bf16_t*)lds; bf16_t* K_lds = (bf16_t*)(lds + 2 * SHM_V);
  float* ws = (float*)(lds + 2 * SHM_V + 2 * SHM_K) + wid * 64; float* li_l = ws; float* al_l = ws + 32;
  float m_reg = -1e30f, l_reg = 0; f32x16 o[4] = {}; bf16x8 qr[8];
  const bf16_t* Qw = Qb + (long)(wid * QBLK + r32) * LDQ + hi * 8;
#pragma unroll
  for (int d0 = 0; d0 < 8; ++d0) qr[d0] = *reinterpret_cast<const bf16x8*>(Qw + d0 * 16);
  const int sr = tid >> 4, sc = (tid & 15) * 8, vst0 = v_st(sr, sc), vst1 = v_st(32 + sr, sc);
  const int vb0 = (int)(uintptr_t)V_lds + v_rd_base(lane);
  struct { bf16x8 vs0, vs1, ks0, ks1; } sr_[2];
#define SLOAD(i, k0) do { sr_[i].vs0 = *reinterpret_cast<const bf16x8*>(&Vh[(long)((k0) + sr) * LDK + sc]); sr_[i].vs1 = *reinterpret_cast<const bf16x8*>(&Vh[(long)((k0) + 32 + sr) * LDK + sc]); \
    sr_[i].ks0 = *reinterpret_cast<const bf16x8*>(&Kh[(long)((k0) + sr) * LDK + sc]); sr_[i].ks1 = *reinterpret_cast<const bf16x8*>(&Kh[(long)((k0) + 32 + sr) * LDK + sc]); } while (0)
#define SWRITE(b, i) do { *(bf16x8*)((char*)V_lds + (b) * SHM_V + vst0) = sr_[i].vs0;          \
    *(bf16x8*)((char*)V_lds + (b) * SHM_V + vst1) = sr_[i].vs1; int kc = sc * 2;               \
    *(bf16x8*)((char*)K_lds + (b) * SHM_K + KSWZ(sr, kc)) = sr_[i].ks0;                       \
    *(bf16x8*)((char*)K_lds + (b) * SHM_K + KSWZ(32 + sr, kc)) = sr_[i].ks1; } while (0)
#define SWAIT() asm volatile("s_waitcnt vmcnt(4)" ::: "memory")
#define RESC(a) do { if (__any((a) < 1.f)) { if (hi == 0) al_l[r32] = (a); asm volatile("s_waitcnt lgkmcnt(0)" ::: "memory"); \
    for (int d = 0; d < 4; ++d) for (int r = 0; r < 16; ++r) o[d][r] *= al_l[crow(r, hi)]; } } while (0)
  f32x16 pA0, pA1, pB0, pB1; float mnA, mnB, alA, alB; bf16x8 pa0, pa1, pa2, pa3; const int NT = seq / KVBLK;
  constexpr int SE = 0, SO = 1;
  SLOAD(SE, 0); asm volatile("s_waitcnt vmcnt(0)" ::: "memory"); SWRITE(0, SE); __syncthreads();
  qkt(pA0, pA1, K_lds, qr, r32, hi); partialSM(pA0, pA1, m_reg, mnA, alA);
  SLOAD(SO, KVBLK); if (2 < NT) SLOAD(SE, 2 * KVBLK);
  SWAIT(); SWRITE(1, SO); __syncthreads();
  for (int j = 1; j + 1 < NT; j += 2) {
    SBAR(); qkt(pB0, pB1, (bf16_t*)((char*)K_lds + SHM_K), qr, r32, hi);
    finishSM(pA0, pA1, alA, l_reg, pa0, pa1, pa2, pa3); SBAR();
    SLOAD(SO, (j + 2) * KVBLK); SBAR();
    pv_d0(o, vb0, pa0, pa1, pa2, pa3); partialSM(pB0, pB1, m_reg, mnB, alB);
    __syncthreads(); SWAIT(); SWRITE(0, SE);
    RESC(alB); __syncthreads();
    SBAR(); qkt(pA0, pA1, K_lds, qr, r32, hi);
    finishSM(pB0, pB1, alB, l_reg, pa0, pa1, pa2, pa3); SBAR();
    if (j + 3 < NT) SLOAD(SE, (j + 3) * KVBLK); SBAR();
    pv_d0(o, vb0 + (int)SHM_V, pa0, pa1, pa2, pa3); partialSM(pA0, pA1, m_reg, mnA, alA);
    __syncthreads(); SWAIT(); SWRITE(1, SO);
    RESC(alA); __syncthreads();
  }
  SBAR(); qkt(pB0, pB1, (bf16_t*)((char*)K_lds + SHM_K), qr, r32, hi);
  finishSM(pA0, pA1, alA, l_reg, pa0, pa1, pa2, pa3); SBAR();
  pv_d0(o, vb0, pa0, pa1, pa2, pa3); partialSM(pB0, pB1, m_reg, mnB, alB);
  __syncthreads(); RESC(alB);
  finishSM(pB0, pB1, alB, l_reg, pa0, pa1, pa2, pa3); SBAR();
  pv_d0(o, vb0 + (int)SHM_V, pa0, pa1, pa2, pa3);
  if (hi == 0) li_l[r32] = l_reg; asm volatile("s_waitcnt lgkmcnt(0)" ::: "memory");
  float rli[16];
#pragma unroll
  for (int r = 0; r < 16; ++r) rli[r] = __builtin_amdgcn_rcpf(li_l[crow(r, hi)]);
  bf16_t* Ow = Ob + (long)(wid * QBLK) * LDO;
#pragma unroll
  for (int r = 0; r < 16; ++r) { int orow = crow(r, hi);
    for (int d0 = 0; d0 < 4; ++d0) Ow[(long)orow * LDO + d0 * 32 + r32] = (bf16_t)f2bf(o[d0][r] * rli[r]); }
  __syncthreads();
#undef SLOAD
#undef SWRITE
#undef SWAIT
#undef RESC
}
#undef KSWZ
#undef SBAR
}

__device__ __forceinline__ void phase_attn(const Args& a, char* lds) {
    unsigned char* ws = a.ws;
    const bf16_t* Q = (const bf16_t*)(ws + WS_Q); const bf16_t* Kb = (const bf16_t*)(ws + WS_K); const bf16_t* Vb = (const bf16_t*)(ws + WS_V);
    bf16_t* AO = (bf16_t*)(ws + WS_AO);
    const int NU = 256 + 8;
    for (int u = blockIdx.x; u < NU; u += gridDim.x) {
        int b, h, qrow0, nkeys;
        if (u < 256) { b = u / 128; h = (u / 32) % 4; qrow0 = b * RPB + CTXL + (u % 32) * 256; nkeys = RPB; }
        else { const int v = u - 256; b = v / 4; h = v % 4; qrow0 = b * RPB; nkeys = CTXL; }
        const int kvh = h >> 1; const size_t krow0 = (size_t)b * RPB;
        fa::attn_dense_body(Q + (size_t)qrow0 * 512 + h * 128, Kb + krow0 * 256 + kvh * 128, Vb + krow0 * 256 + kvh * 128, AO + (size_t)qrow0 * 1024 + 512 + h * 128, nkeys, lds);
    }
}

__device__ __forceinline__ void phase_outproj(const Args& a, char* lds, const bf16_t* A, int K, const bf16_t* Bt, int layer, int which_gate, int base_mode, bool latent_only) {
    float* Cs = (float*)lds;
    const int tid = threadIdx.x;
    float* X1 = (float*)(a.ws + WS_X1);
    const int NU = (MTOT / 128) * 8;
    for (int u = blockIdx.x; u < NU; u += gridDim.x) {
        const int rt = u / 8, ct = u % 8, row0 = rt * 128, col0 = ct * 128;
        if (latent_only && (rt % 66) < 2) continue;
        gemm_tile128(A + (size_t)row0 * K, K, Bt + (size_t)col0 * K, K, K, Cs);
        __syncthreads();
        const int rr = tid >> 2, q4 = tid & 3, g = row0 + rr;
        const float* crow = Cs + rr * CS_LD + q4 * 32;
        const float* gt = modv(a, layer, row_variant(g), which_gate) + col0 + q4 * 32;
        const float* base = (base_mode == 0 ? row_src(a, g) : X1 + (size_t)g * D) + col0 + q4 * 32;
        float* o = X1 + (size_t)g * D + col0 + q4 * 32;
#pragma unroll
        for (int c = 0; c < 32; c += 4) {
            const f32x4 bs = *(const f32x4*)(base + c), gv = *(const f32x4*)(gt + c);
            f32x4 r; r.x = bs.x + gv.x * crow[c]; r.y = bs.y + gv.y * crow[c + 1]; r.z = bs.z + gv.z * crow[c + 2]; r.w = bs.w + gv.w * crow[c + 3];
            *(f32x4*)(o + c) = r;
        }
        __syncthreads();
    }
}

__device__ __forceinline__ void phase_peerq(const Args& a, char* lds, int layer, bool latent_only) {
    float* Cs = (float*)lds;
    const int tid = threadIdx.x;
    const bf16_t* H = (const bf16_t*)(a.ws + WS_H); const bf16_t* W = (const bf16_t*)(a.ws + WS_WQ) + (size_t)layer * 2048 * 1024;
    bf16_t* QP = (bf16_t*)(a.ws + WS_QP);
    const int NU = (MTOT / 128) * 16;
    for (int u = blockIdx.x; u < NU; u += gridDim.x) {
        const int rt = u / 16, ct = u % 16, row0 = rt * 128, col0 = ct * 128;
        if (latent_only && (rt % 66) < 2) continue;
        gemm_tile128(H + (size_t)row0 * D, D, W + (size_t)col0 * D, D, D, Cs);
        __syncthreads();
        const int rr = tid >> 2, q4 = tid & 3, g = row0 + rr;
        const float* crow = Cs + rr * CS_LD + q4 * 32;
        bf16_t* o = QP + (size_t)g * 2048 + col0 + q4 * 32;
#pragma unroll
        for (int c = 0; c < 32; c += 2) *(unsigned*)(o + c) = pk2(crow[c], crow[c + 1]);
        __syncthreads();
    }
}

__device__ __forceinline__ void wave_argmax(float& v, int& i) {
#pragma unroll
    for (int o = 1; o < 64; o <<= 1) {
        const float ov = __shfl_xor(v, o); const int oi = __shfl_xor(i, o);
        if (ov > v || (ov == v && oi < i)) { v = ov; i = oi; }
    }
}
__device__ __forceinline__ void phase_peer_topk(const Args& a, int layer, bool latent_only) {
    const int lane = threadIdx.x & 63, gw = blockIdx.x * NWAVE + (threadIdx.x >> 6), ngw = gridDim.x * NWAVE;
    const bf16_t* QP = (const bf16_t*)(a.ws + WS_QP);
    const bf16_t* KEYS = (const bf16_t*)(a.ws + WS_KEYS) + (size_t)layer * 8 * 2 * 128 * 128;
    int* SELI = (int*)(a.ws + WS_SELI); float* SELG = (float*)(a.ws + WS_SELG);
    for (int it = gw; it < MTOT * 8; it += ngw) {
        const int g = it >> 3, h = it & 7;
        if (latent_only && row_variant(g) == 2) continue;
        float tv[2]; int ti[2];
#pragma unroll
        for (int s = 0; s < 2; ++s) {
            const bf16_t* qp = QP + (size_t)g * 2048 + h * 256 + s * 128;
            const bf16_t* k0p = KEYS + ((size_t)(h * 2 + s) * 128 + lane) * 128;
            const bf16_t* k1p = k0p + 64 * 128;
            float s0 = 0.f, s1 = 0.f;
#pragma unroll 4
            for (int d = 0; d < 128; d += 8) {
                const u32x4 qw = *(const u32x4*)(qp + d), ka = *(const u32x4*)(k0p + d), kb = *(const u32x4*)(k1p + d);
                s0 += bflo(qw.x) * bflo(ka.x) + bfhi(qw.x) * bfhi(ka.x) + bflo(qw.y) * bflo(ka.y) + bfhi(qw.y) * bfhi(ka.y)
                    + bflo(qw.z) * bflo(ka.z) + bfhi(qw.z) * bfhi(ka.z) + bflo(qw.w) * bflo(ka.w) + bfhi(qw.w) * bfhi(ka.w);
                s1 += bflo(qw.x) * bflo(kb.x) + bfhi(qw.x) * bfhi(kb.x) + bflo(qw.y) * bflo(kb.y) + bfhi(qw.y) * bfhi(kb.y)
                    + bflo(qw.z) * bflo(kb.z) + bfhi(qw.z) * bfhi(kb.z) + bflo(qw.w) * bflo(kb.w) + bfhi(qw.w) * bfhi(kb.w);
            }
            float myv = 0.f; int myi = 0;
            for (int r = 0; r < 16; ++r) {
                float bv; int bi;
                if (s0 >= s1) { bv = s0; bi = lane; } else { bv = s1; bi = lane + 64; }
                wave_argmax(bv, bi);
                if (bi == lane) s0 = -INFINITY; else if (bi == lane + 64) s1 = -INFINITY;
                if (lane == r) { myv = bv; myi = bi; }
            }
            tv[s] = myv; ti[s] = myi;
        }
        float cv[4]; int ci[4];
        {
            const float v0 = __shfl(tv[0], lane >> 2); const int i0 = __shfl(ti[0], lane >> 2);
#pragma unroll
            for (int m = 0; m < 4; ++m) { const int j = (lane & 3) * 4 + m; cv[m] = v0 + __shfl(tv[1], j); ci[m] = i0 * 128 + __shfl(ti[1], j); }
        }
        float topv = 0.f; int tope = 0;
        for (int r = 0; r < 16; ++r) {
            float bv = cv[0]; int bp = lane * 4;
#pragma unroll
            for (int m = 1; m < 4; ++m) if (cv[m] > bv) { bv = cv[m]; bp = lane * 4 + m; }
            wave_argmax(bv, bp);
            int be = 0;
#pragma unroll
            for (int m = 0; m < 4; ++m) if (bp == lane * 4 + m) { be = ci[m]; cv[m] = -INFINITY; }
            be = __shfl(be, bp >> 2);
            if (lane == r) { topv = bv; tope = be; }
        }
        const float mx = __shfl(topv, 0);
        float e = lane < 16 ? __expf(topv - mx) : 0.f;
        float sum = e;
#pragma unroll
        for (int o = 1; o < 16; o <<= 1) sum += __shfl_xor(sum, o);
        if (lane < 16) { SELI[(size_t)g * 128 + h * 16 + lane] = tope; SELG[(size_t)g * 128 + h * 16 + lane] = e / sum; }
    }
}

namespace tk {
__device__ __forceinline__ void ce(float& a, float& b) { const float mx = __builtin_fmaxf(a, b), mn = __builtin_fminf(a, b); a = mx; b = mn; }
__device__ __forceinline__ void sort16_desc(float (&v)[16]) {
#pragma unroll
    for (int ks = 1; ks <= 4; ++ks)
#pragma unroll
        for (int js = ks - 1; js >= 0; --js)
#pragma unroll
            for (int i = 0; i < 16; ++i) { const int k = 1 << ks, j = 1 << js, l = i ^ j; if (l > i) { if ((i & k) == 0) ce(v[i], v[l]); else ce(v[l], v[i]); } }
}
__device__ __forceinline__ void merge16_desc(float (&v)[16]) {
#pragma unroll
    for (int js = 3; js >= 0; --js)
#pragma unroll
        for (int i = 0; i < 16; ++i) { const int j = 1 << js, l = i ^ j; if (l > i) ce(v[i], v[l]); }
}
__device__ __forceinline__ void merge_prune(float (&x)[16], const float (&y)[16]) {
#pragma unroll
    for (int i = 0; i < 16; ++i) x[i] = __builtin_fmaxf(x[i], y[15 - i]);
    merge16_desc(x);
}
__host__ __device__ constexpr bool pair_ok(int i, int j) { return (i + 1) * (j + 1) <= 16; }
__host__ __device__ constexpr int pair_index(int i, int j) { int n = 0; for (int a = 0; a < 16; ++a) for (int b = 0; b < 16; ++b) { if (a == i && b == j) return n; if (pair_ok(a, b)) ++n; } return n; }
static_assert(pair_index(15, 15) == 49 + 0 || true, "");
}
__device__ __forceinline__ void phase_peer_topk2(const Args& a, int layer, bool latent_only) {
    const int lane = threadIdx.x & 63, r32 = lane & 31, hh = lane >> 5, gw = blockIdx.x * NWAVE + __builtin_amdgcn_readfirstlane(threadIdx.x >> 6), ngw = gridDim.x * NWAVE;
    const bf16_t* QP = (const bf16_t*)(a.ws + WS_QP);
    const bf16_t* KEYS = (const bf16_t*)(a.ws + WS_KEYS) + (size_t)layer * 8 * 2 * 128 * 128;
    int* SELI = (int*)(a.ws + WS_SELI); float* SELG = (float*)(a.ws + WS_SELG);
    const int NIT = (MTOT / 32) * 8;
    for (int it = gw; it < NIT; it += ngw) {
        const int tg = it >> 3, h = it & 7, g0 = tg * 32;
        if (latent_only && row_variant(g0) == 2) continue;
        float top[2][16];
#pragma unroll
        for (int s = 0; s < 2; ++s) {
            bf16x8 qf[8];
            unsigned qoff = (unsigned)(r32 * 2048 + 8 * hh), koff = (unsigned)(r32 * 128 + 8 * hh); asm volatile("" : "+v"(qoff), "+v"(koff));
            const bf16_t* qb = QP + (size_t)g0 * 2048 + h * 256 + s * 128;
#pragma unroll
            for (int k = 0; k < 8; ++k) qf[k] = *(const bf16x8*)(qb + qoff + k * 16);
            float grp[4][16];
#pragma unroll
            for (int kb = 0; kb < 4; ++kb) {
                const bf16_t* kbp = KEYS + (size_t)(h * 2 + s) * 128 * 128 + kb * 32 * 128;
                f32x16 acc = {};
#pragma unroll
                for (int k = 0; k < 8; ++k) { const bf16x8 kf = *(const bf16x8*)(kbp + koff + k * 16); acc = __builtin_amdgcn_mfma_f32_32x32x16_bf16(kf, qf[k], acc, 0, 0, 0); }
#pragma unroll
                for (int r = 0; r < 16; ++r) { const int key = kb * 32 + (r & 3) + 8 * (r >> 2) + 4 * hh; grp[kb][r] = __uint_as_float((__float_as_uint(acc[r]) & ~127u) | (unsigned)key); }
                tk::sort16_desc(grp[kb]); __builtin_amdgcn_sched_barrier(0);
            }
            tk::merge_prune(grp[0], grp[1]); __builtin_amdgcn_sched_barrier(0); tk::merge_prune(grp[2], grp[3]); __builtin_amdgcn_sched_barrier(0); tk::merge_prune(grp[0], grp[2]); __builtin_amdgcn_sched_barrier(0);
            float oth[16];
#pragma unroll
            for (int r = 0; r < 16; ++r) { const auto rr = __builtin_amdgcn_permlane32_swap(__float_as_uint(grp[0][r]), __float_as_uint(grp[0][r]), false, false); oth[r] = __uint_as_float(hh == 0 ? rr[1] : rr[0]); }
            tk::merge_prune(grp[0], oth);
#pragma unroll
            for (int r = 0; r < 16; ++r) top[s][r] = grp[0][r];
            __builtin_amdgcn_sched_barrier(0);
        }
        float cg[4][16];
#pragma unroll
        for (int q = 0; q < 4; ++q)
#pragma unroll
            for (int r = 0; r < 16; ++r) cg[q][r] = -INFINITY;
        cg[0][0] = __uint_as_float((__float_as_uint(top[0][0] + top[1][0]) & ~255u) | 0u);
        cg[0][1] = __uint_as_float((__float_as_uint(top[0][0] + top[1][1]) & ~255u) | 1u);
        cg[0][2] = __uint_as_float((__float_as_uint(top[0][0] + top[1][2]) & ~255u) | 2u);
        cg[0][3] = __uint_as_float((__float_as_uint(top[0][0] + top[1][3]) & ~255u) | 3u);
        cg[0][4] = __uint_as_float((__float_as_uint(top[0][0] + top[1][4]) & ~255u) | 4u);
        cg[0][5] = __uint_as_float((__float_as_uint(top[0][0] + top[1][5]) & ~255u) | 5u);
        cg[0][6] = __uint_as_float((__float_as_uint(top[0][0] + top[1][6]) & ~255u) | 6u);
        cg[0][7] = __uint_as_float((__float_as_uint(top[0][0] + top[1][7]) & ~255u) | 7u);
        cg[0][8] = __uint_as_float((__float_as_uint(top[0][0] + top[1][8]) & ~255u) | 8u);
        cg[0][9] = __uint_as_float((__float_as_uint(top[0][0] + top[1][9]) & ~255u) | 9u);
        cg[0][10] = __uint_as_float((__float_as_uint(top[0][0] + top[1][10]) & ~255u) | 10u);
        cg[0][11] = __uint_as_float((__float_as_uint(top[0][0] + top[1][11]) & ~255u) | 11u);
        cg[0][12] = __uint_as_float((__float_as_uint(top[0][0] + top[1][12]) & ~255u) | 12u);
        cg[0][13] = __uint_as_float((__float_as_uint(top[0][0] + top[1][13]) & ~255u) | 13u);
        cg[0][14] = __uint_as_float((__float_as_uint(top[0][0] + top[1][14]) & ~255u) | 14u);
        cg[0][15] = __uint_as_float((__float_as_uint(top[0][0] + top[1][15]) & ~255u) | 15u);
        cg[1][0] = __uint_as_float((__float_as_uint(top[0][1] + top[1][0]) & ~255u) | 16u);
        cg[1][1] = __uint_as_float((__float_as_uint(top[0][1] + top[1][1]) & ~255u) | 17u);
        cg[1][2] = __uint_as_float((__float_as_uint(top[0][1] + top[1][2]) & ~255u) | 18u);
        cg[1][3] = __uint_as_float((__float_as_uint(top[0][1] + top[1][3]) & ~255u) | 19u);
        cg[1][4] = __uint_as_float((__float_as_uint(top[0][1] + top[1][4]) & ~255u) | 20u);
        cg[1][5] = __uint_as_float((__float_as_uint(top[0][1] + top[1][5]) & ~255u) | 21u);
        cg[1][6] = __uint_as_float((__float_as_uint(top[0][1] + top[1][6]) & ~255u) | 22u);
        cg[1][7] = __uint_as_float((__float_as_uint(top[0][1] + top[1][7]) & ~255u) | 23u);
        cg[1][8] = __uint_as_float((__float_as_uint(top[0][2] + top[1][0]) & ~255u) | 32u);
        cg[1][9] = __uint_as_float((__float_as_uint(top[0][2] + top[1][1]) & ~255u) | 33u);
        cg[1][10] = __uint_as_float((__float_as_uint(top[0][2] + top[1][2]) & ~255u) | 34u);
        cg[1][11] = __uint_as_float((__float_as_uint(top[0][2] + top[1][3]) & ~255u) | 35u);
        cg[1][12] = __uint_as_float((__float_as_uint(top[0][2] + top[1][4]) & ~255u) | 36u);
        cg[1][13] = __uint_as_float((__float_as_uint(top[0][3] + top[1][0]) & ~255u) | 48u);
        cg[1][14] = __uint_as_float((__float_as_uint(top[0][3] + top[1][1]) & ~255u) | 49u);
        cg[1][15] = __uint_as_float((__float_as_uint(top[0][3] + top[1][2]) & ~255u) | 50u);
        cg[2][0] = __uint_as_float((__float_as_uint(top[0][3] + top[1][3]) & ~255u) | 51u);
        cg[2][1] = __uint_as_float((__float_as_uint(top[0][4] + top[1][0]) & ~255u) | 64u);
        cg[2][2] = __uint_as_float((__float_as_uint(top[0][4] + top[1][1]) & ~255u) | 65u);
        cg[2][3] = __uint_as_float((__float_as_uint(top[0][4] + top[1][2]) & ~255u) | 66u);
        cg[2][4] = __uint_as_float((__float_as_uint(top[0][5] + top[1][0]) & ~255u) | 80u);
        cg[2][5] = __uint_as_float((__float_as_uint(top[0][5] + top[1][1]) & ~255u) | 81u);
        cg[2][6] = __uint_as_float((__float_as_uint(top[0][6] + top[1][0]) & ~255u) | 96u);
        cg[2][7] = __uint_as_float((__float_as_uint(top[0][6] + top[1][1]) & ~255u) | 97u);
        cg[2][8] = __uint_as_float((__float_as_uint(top[0][7] + top[1][0]) & ~255u) | 112u);
        cg[2][9] = __uint_as_float((__float_as_uint(top[0][7] + top[1][1]) & ~255u) | 113u);
        cg[2][10] = __uint_as_float((__float_as_uint(top[0][8] + top[1][0]) & ~255u) | 128u);
        cg[2][11] = __uint_as_float((__float_as_uint(top[0][9] + top[1][0]) & ~255u) | 144u);
        cg[2][12] = __uint_as_float((__float_as_uint(top[0][10] + top[1][0]) & ~255u) | 160u);
        cg[2][13] = __uint_as_float((__float_as_uint(top[0][11] + top[1][0]) & ~255u) | 176u);
        cg[2][14] = __uint_as_float((__float_as_uint(top[0][12] + top[1][0]) & ~255u) | 192u);
        cg[2][15] = __uint_as_float((__float_as_uint(top[0][13] + top[1][0]) & ~255u) | 208u);
        cg[3][0] = __uint_as_float((__float_as_uint(top[0][14] + top[1][0]) & ~255u) | 224u);
        cg[3][1] = __uint_as_float((__float_as_uint(top[0][15] + top[1][0]) & ~255u) | 240u);
#pragma unroll
        for (int q = 0; q < 4; ++q) { tk::sort16_desc(cg[q]); __builtin_amdgcn_sched_barrier(0); }
        tk::merge_prune(cg[0], cg[1]); __builtin_amdgcn_sched_barrier(0); tk::merge_prune(cg[2], cg[3]); __builtin_amdgcn_sched_barrier(0); tk::merge_prune(cg[0], cg[2]); __builtin_amdgcn_sched_barrier(0);
        int eidx[16]; float ev[16]; float sum = 0.f;
#pragma unroll
        for (int r = 0; r < 16; ++r) {
            const unsigned bits = __float_as_uint(cg[0][r]); const int ci = (bits >> 4) & 15, cj = bits & 15;
            int ia = 0, ib = 0;
#pragma unroll
            for (int i = 0; i < 16; ++i) { ia = (ci == i) ? (int)(__float_as_uint(top[0][i]) & 127u) : ia; ib = (cj == i) ? (int)(__float_as_uint(top[1][i]) & 127u) : ib; }
            eidx[r] = ia * 128 + ib;
            ev[r] = __expf(cg[0][r] - cg[0][0]); sum += ev[r];
        }
        const float rs = 1.f / sum;
        int* oi = SELI + (size_t)(g0 + r32) * 128 + h * 16 + hh * 8; float* og = SELG + (size_t)(g0 + r32) * 128 + h * 16 + hh * 8;
        if (hh == 0) {
#pragma unroll
            for (int r = 0; r < 8; ++r) { oi[r] = eidx[r]; og[r] = ev[r] * rs; }
        } else {
#pragma unroll
            for (int r = 0; r < 8; ++r) { oi[r] = eidx[8 + r]; og[r] = ev[8 + r] * rs; }
        }
    }
}

__device__ __forceinline__ void phase_peer_gather(const Args& a, int layer, int mode) {
    const int lane = threadIdx.x & 63, gw = blockIdx.x * NWAVE + (threadIdx.x >> 6), ngw = gridDim.x * NWAVE;
    unsigned char* ws = a.ws;
    bf16_t* H = (bf16_t*)(ws + WS_H); float* X1 = (float*)(ws + WS_X1);
    const bf16_t* PU = (const bf16_t*)(ws + WS_PU) + (size_t)layer * NEXP * D; const bf16_t* PV = (const bf16_t*)(ws + WS_PV) + (size_t)layer * NEXP * D;
    const int* SELI = (const int*)(ws + WS_SELI); const float* SELG = (const float*)(ws + WS_SELG);
    for (int g = gw; g < MTOT; g += ngw) {
        const int var = row_variant(g);
        if (mode == 1 && var == 2) continue;
        float hp[16], acc[16];
        {
            const u32x4 w0 = *(const u32x4*)(H + (size_t)g * D + lane * 16), w1 = *(const u32x4*)(H + (size_t)g * D + lane * 16 + 8);
            hp[0] = bflo(w0.x); hp[1] = bfhi(w0.x); hp[2] = bflo(w0.y); hp[3] = bfhi(w0.y); hp[4] = bflo(w0.z); hp[5] = bfhi(w0.z); hp[6] = bflo(w0.w); hp[7] = bfhi(w0.w);
            hp[8] = bflo(w1.x); hp[9] = bfhi(w1.x); hp[10] = bflo(w1.y); hp[11] = bfhi(w1.y); hp[12] = bflo(w1.z); hp[13] = bfhi(w1.z); hp[14] = bflo(w1.w); hp[15] = bfhi(w1.w);
#pragma unroll
            for (int d = 0; d < 16; ++d) acc[d] = 0.f;
        }
        const int myi0 = SELI[(size_t)g * 128 + lane], myi1 = SELI[(size_t)g * 128 + 64 + lane];
        const float myg0 = SELG[(size_t)g * 128 + lane], myg1 = SELG[(size_t)g * 128 + 64 + lane];
        for (int e = 0; e < 128; ++e) {
            const int ei = e < 64 ? __shfl(myi0, e) : __shfl(myi1, e - 64);
            const float eg = e < 64 ? __shfl(myg0, e) : __shfl(myg1, e - 64);
            const bf16_t* up = PU + (size_t)ei * D + lane * 16; const bf16_t* vp = PV + (size_t)ei * D + lane * 16;
            const u32x4 u0 = *(const u32x4*)up, u1 = *(const u32x4*)(up + 8), v0 = *(const u32x4*)vp, v1 = *(const u32x4*)(vp + 8);
            float dt = hp[0] * bflo(u0.x) + hp[1] * bfhi(u0.x) + hp[2] * bflo(u0.y) + hp[3] * bfhi(u0.y) + hp[4] * bflo(u0.z) + hp[5] * bfhi(u0.z) + hp[6] * bflo(u0.w) + hp[7] * bfhi(u0.w)
                     + hp[8] * bflo(u1.x) + hp[9] * bfhi(u1.x) + hp[10] * bflo(u1.y) + hp[11] * bfhi(u1.y) + hp[12] * bflo(u1.z) + hp[13] * bfhi(u1.z) + hp[14] * bflo(u1.w) + hp[15] * bfhi(u1.w);
            dt = wave_sum(dt);
            const float act = gelu_t(dt) * eg;
            acc[0] += act * bflo(v0.x); acc[1] += act * bfhi(v0.x); acc[2] += act * bflo(v0.y); acc[3] += act * bfhi(v0.y);
            acc[4] += act * bflo(v0.z); acc[5] += act * bfhi(v0.z); acc[6] += act * bflo(v0.w); acc[7] += act * bfhi(v0.w);
            acc[8] += act * bflo(v1.x); acc[9] += act * bfhi(v1.x); acc[10] += act * bflo(v1.y); acc[11] += act * bfhi(v1.y);
            acc[12] += act * bflo(v1.z); acc[13] += act * bfhi(v1.z); acc[14] += act * bflo(v1.w); acc[15] += act * bfhi(v1.w);
        }
        float* xr = X1 + (size_t)g * D + lane * 16;
        const float* g2 = modv(a, layer, var, 5) + lane * 16;
        float xn[16]; float ss = 0.f;
#pragma unroll
        for (int d = 0; d < 16; d += 4) {
            const f32x4 xv = *(const f32x4*)(xr + d), gv = *(const f32x4*)(g2 + d);
            xn[d] = xv.x + gv.x * acc[d]; xn[d + 1] = xv.y + gv.y * acc[d + 1]; xn[d + 2] = xv.z + gv.z * acc[d + 2]; xn[d + 3] = xv.w + gv.w * acc[d + 3];
            ss += xn[d] * xn[d] + xn[d + 1] * xn[d + 1] + xn[d + 2] * xn[d + 2] + xn[d + 3] * xn[d + 3];
        }
        const float rinv = rsqrtf(wave_sum(ss) * (1.f / D) + EPS);
        if (mode == 0) {
#pragma unroll
            for (int d = 0; d < 16; d += 4) { f32x4 o; o.x = xn[d]; o.y = xn[d + 1]; o.z = xn[d + 2]; o.w = xn[d + 3]; *(f32x4*)(xr + d) = o; }
            const float* gn = a.in[6] + D + lane * 16; const float* sh = modv(a, 1, var, 0) + lane * 16; const float* sc = modv(a, 1, var, 1) + lane * 16;
            unsigned w[8];
#pragma unroll
            for (int d = 0; d < 16; d += 2) w[d >> 1] = pk2(xn[d] * rinv * gn[d] * (1.f + sc[d]) + sh[d], xn[d + 1] * rinv * gn[d + 1] * (1.f + sc[d + 1]) + sh[d + 1]);
            u32x4 o0, o1; o0.x = w[0]; o0.y = w[1]; o0.z = w[2]; o0.w = w[3]; o1.x = w[4]; o1.y = w[5]; o1.z = w[6]; o1.w = w[7];
            *(u32x4*)(H + (size_t)g * D + lane * 16) = o0; *(u32x4*)(H + (size_t)g * D + lane * 16 + 8) = o1;
        } else {
            const int b = g / RPB, t = g - b * RPB - CTXL;
            float* op = a.out + ((size_t)b * SEQ + t) * D + lane * 16; const float* gn = a.in[28] + lane * 16;
#pragma unroll
            for (int d = 0; d < 16; d += 4) { f32x4 o; o.x = xn[d] * rinv * gn[d]; o.y = xn[d + 1] * rinv * gn[d + 1]; o.z = xn[d + 2] * rinv * gn[d + 2]; o.w = xn[d + 3] * rinv * gn[d + 3]; *(f32x4*)(op + d) = o; }
        }
    }
}

typedef __bf16 bf16x2_t __attribute__((ext_vector_type(2)));
__device__ __forceinline__ float dot2bf(unsigned w, unsigned x, float acc) { return __builtin_amdgcn_fdot2_f32_bf16(__builtin_bit_cast(bf16x2_t, w), __builtin_bit_cast(bf16x2_t, x), acc, false); }
struct Row8 { u32x4 c[8]; };
__device__ __forceinline__ void load_row8(Row8& r, const bf16_t* p) {
#pragma unroll
    for (int c = 0; c < 8; ++c) r.c[c] = *(const u32x4*)(p + c * 128);
}
__device__ __forceinline__ float dot_row8(const Row8& r, const u32x4 (&hp)[8]) {
    float a0 = 0.f, a1 = 0.f, a2 = 0.f, a3 = 0.f;
#pragma unroll
    for (int c = 0; c < 8; ++c) { a0 = dot2bf(r.c[c].x, hp[c].x, a0); a1 = dot2bf(r.c[c].y, hp[c].y, a1); a2 = dot2bf(r.c[c].z, hp[c].z, a2); a3 = dot2bf(r.c[c].w, hp[c].w, a3); }
    float s = (a0 + a1) + (a2 + a3);
    s += __shfl_xor(s, 1); s += __shfl_xor(s, 2); s += __shfl_xor(s, 4); s += __shfl_xor(s, 8);
    return s;
}
__device__ __forceinline__ void fma_row(float (&acc)[16], const u32x4& v0, const u32x4& v1, float a) {
    acc[0] += a * bflo(v0.x); acc[1] += a * bfhi(v0.x); acc[2] += a * bflo(v0.y); acc[3] += a * bfhi(v0.y);
    acc[4] += a * bflo(v0.z); acc[5] += a * bfhi(v0.z); acc[6] += a * bflo(v0.w); acc[7] += a * bfhi(v0.w);
    acc[8] += a * bflo(v1.x); acc[9] += a * bfhi(v1.x); acc[10] += a * bflo(v1.y); acc[11] += a * bfhi(v1.y);
    acc[12] += a * bflo(v1.z); acc[13] += a * bfhi(v1.z); acc[14] += a * bflo(v1.w); acc[15] += a * bfhi(v1.w);
}
__device__ __forceinline__ void phase_peer_gather2(const Args& a, char* lds, int layer, int mode) {
    const int lane = threadIdx.x & 63, wid = threadIdx.x >> 6, gw = blockIdx.x * NWAVE + wid, ngw = gridDim.x * NWAVE;
    const int grp = lane >> 4, sub = lane & 15;
    unsigned char* ws = a.ws;
    bf16_t* H = (bf16_t*)(ws + WS_H); float* X1 = (float*)(ws + WS_X1);
    const bf16_t* PU = (const bf16_t*)(ws + WS_PU) + (size_t)layer * NEXP * D; const bf16_t* PV = (const bf16_t*)(ws + WS_PV) + (size_t)layer * NEXP * D;
    const int* SELI = (const int*)(ws + WS_SELI); const float* SELG = (const float*)(ws + WS_SELG);
    LAS int* lidx = (LAS int*)((LAS char*)lds + wid * 2048);
    LAS float* lgate = (LAS float*)(lidx + 128);
    LAS float* lact = lgate + 128;
    for (int g = gw; g < MTOT; g += ngw) {
        const int var = row_variant(g);
        if (mode == 1 && var == 2) continue;
        lidx[lane] = SELI[(size_t)g * 128 + lane]; lidx[64 + lane] = SELI[(size_t)g * 128 + 64 + lane];
        lgate[lane] = SELG[(size_t)g * 128 + lane]; lgate[64 + lane] = SELG[(size_t)g * 128 + 64 + lane];
        u32x4 hp[8];
#pragma unroll
        for (int c = 0; c < 8; ++c) hp[c] = *(const u32x4*)(H + (size_t)g * D + c * 128 + sub * 8);
        {
            Row8 ra, rb;
            load_row8(ra, PU + (size_t)lidx[grp] * D + sub * 8);
            for (int it = 0; it < 32; it += 2) {
                load_row8(rb, PU + (size_t)lidx[(it + 1) * 4 + grp] * D + sub * 8);
                { const float s = dot_row8(ra, hp); const int e = it * 4 + grp; if (sub == 0) lact[e] = gelu_t(s) * lgate[e]; }
                if (it + 2 < 32) load_row8(ra, PU + (size_t)lidx[(it + 2) * 4 + grp] * D + sub * 8);
                { const float s = dot_row8(rb, hp); const int e = (it + 1) * 4 + grp; if (sub == 0) lact[e] = gelu_t(s) * lgate[e]; }
            }
        }
        float acc[16];
#pragma unroll
        for (int d = 0; d < 16; ++d) acc[d] = 0.f;
        {
            u32x4 va[4][2], vb[4][2];
#pragma unroll
            for (int k = 0; k < 4; ++k) { const bf16_t* p = PV + (size_t)lidx[k] * D + lane * 8; va[k][0] = *(const u32x4*)p; va[k][1] = *(const u32x4*)(p + 512); }
            for (int e = 0; e < 128; e += 8) {
#pragma unroll
                for (int k = 0; k < 4; ++k) { const bf16_t* p = PV + (size_t)lidx[e + 4 + k] * D + lane * 8; vb[k][0] = *(const u32x4*)p; vb[k][1] = *(const u32x4*)(p + 512); }
#pragma unroll
                for (int k = 0; k < 4; ++k) fma_row(acc, va[k][0], va[k][1], lact[e + k]);
                if (e + 8 < 128) {
#pragma unroll
                    for (int k = 0; k < 4; ++k) { const bf16_t* p = PV + (size_t)lidx[e + 8 + k] * D + lane * 8; va[k][0] = *(const u32x4*)p; va[k][1] = *(const u32x4*)(p + 512); }
                }
#pragma unroll
                for (int k = 0; k < 4; ++k) fma_row(acc, vb[k][0], vb[k][1], lact[e + 4 + k]);
            }
        }
        float* xr = X1 + (size_t)g * D + lane * 8;
        const float* g2 = modv(a, layer, var, 5) + lane * 8;
        float xn[16]; float ss = 0.f;
#pragma unroll
        for (int hh = 0; hh < 2; ++hh)
#pragma unroll
            for (int d = 0; d < 8; d += 4) {
                const f32x4 xv = *(const f32x4*)(xr + hh * 512 + d), gv = *(const f32x4*)(g2 + hh * 512 + d);
                const int o = hh * 8 + d;
                xn[o] = xv.x + gv.x * acc[o]; xn[o + 1] = xv.y + gv.y * acc[o + 1]; xn[o + 2] = xv.z + gv.z * acc[o + 2]; xn[o + 3] = xv.w + gv.w * acc[o + 3];
                ss += xn[o] * xn[o] + xn[o + 1] * xn[o + 1] + xn[o + 2] * xn[o + 2] + xn[o + 3] * xn[o + 3];
            }
        const float rinv = rsqrtf(wave_sum(ss) * (1.f / D) + EPS);
        if (mode == 0) {
            const float* gn = a.in[6] + D + lane * 8; const float* sh = modv(a, 1, var, 0) + lane * 8; const float* sc = modv(a, 1, var, 1) + lane * 8;
#pragma unroll
            for (int hh = 0; hh < 2; ++hh) {
                const int o = hh * 8;
                f32x4 o0, o1; o0.x = xn[o]; o0.y = xn[o + 1]; o0.z = xn[o + 2]; o0.w = xn[o + 3]; o1.x = xn[o + 4]; o1.y = xn[o + 5]; o1.z = xn[o + 6]; o1.w = xn[o + 7];
                *(f32x4*)(xr + hh * 512) = o0; *(f32x4*)(xr + hh * 512 + 4) = o1;
                unsigned w[4];
#pragma unroll
                for (int d = 0; d < 8; d += 2) { const int cc = hh * 512 + d; w[d >> 1] = pk2(xn[o + d] * rinv * gn[cc] * (1.f + sc[cc]) + sh[cc], xn[o + d + 1] * rinv * gn[cc + 1] * (1.f + sc[cc + 1]) + sh[cc + 1]); }
                u32x4 ow; ow.x = w[0]; ow.y = w[1]; ow.z = w[2]; ow.w = w[3];
                *(u32x4*)(H + (size_t)g * D + hh * 512 + lane * 8) = ow;
            }
        } else {
            const int b = g / RPB, t = g - b * RPB - CTXL;
            float* op = a.out + ((size_t)b * SEQ + t) * D + lane * 8; const float* gn = a.in[28] + lane * 8;
#pragma unroll
            for (int hh = 0; hh < 2; ++hh)
#pragma unroll
                for (int d = 0; d < 8; d += 4) { const int o = hh * 8 + d, cc = hh * 512 + d;
                    f32x4 ov; ov.x = xn[o] * rinv * gn[cc]; ov.y = xn[o + 1] * rinv * gn[cc + 1]; ov.z = xn[o + 2] * rinv * gn[cc + 2]; ov.w = xn[o + 3] * rinv * gn[cc + 3]; *(f32x4*)(op + cc) = ov; }
        }
    }
}

__device__ __forceinline__ float ub0(unsigned w) { return (float)(w & 0xffu); }
__device__ __forceinline__ float ub1(unsigned w) { return (float)((w >> 8) & 0xffu); }
__device__ __forceinline__ float ub2(unsigned w) { return (float)((w >> 16) & 0xffu); }
__device__ __forceinline__ float ub3(unsigned w) { return (float)(w >> 24); }
struct RowU { u32x4 c[4]; };
__device__ __forceinline__ void load_rowu(RowU& r, const unsigned char* p) {
#pragma unroll
    for (int c = 0; c < 4; ++c) r.c[c] = *(const u32x4*)(p + c * 256);
}
__device__ __forceinline__ float dot_rowu(const RowU& r, const float (&hp)[64]) {
    float a0 = 0.f, a1 = 0.f, a2 = 0.f, a3 = 0.f;
#pragma unroll
    for (int c = 0; c < 4; ++c) {
        const unsigned w0 = r.c[c].x, w1 = r.c[c].y, w2 = r.c[c].z, w3 = r.c[c].w; const int o = c * 16;
        a0 += hp[o + 0] * ub0(w0); a1 += hp[o + 1] * ub1(w0); a2 += hp[o + 2] * ub2(w0); a3 += hp[o + 3] * ub3(w0);
        a0 += hp[o + 4] * ub0(w1); a1 += hp[o + 5] * ub1(w1); a2 += hp[o + 6] * ub2(w1); a3 += hp[o + 7] * ub3(w1);
        a0 += hp[o + 8] * ub0(w2); a1 += hp[o + 9] * ub1(w2); a2 += hp[o + 10] * ub2(w2); a3 += hp[o + 11] * ub3(w2);
        a0 += hp[o + 12] * ub0(w3); a1 += hp[o + 13] * ub1(w3); a2 += hp[o + 14] * ub2(w3); a3 += hp[o + 15] * ub3(w3);
    }
    float s = (a0 + a1) + (a2 + a3);
    s += __shfl_xor(s, 1); s += __shfl_xor(s, 2); s += __shfl_xor(s, 4); s += __shfl_xor(s, 8);
    return s;
}
__device__ __forceinline__ void fma_rowv(float (&acc)[16], const u32x4& v, float a) {
    acc[0] += a * ub0(v.x); acc[1] += a * ub1(v.x); acc[2] += a * ub2(v.x); acc[3] += a * ub3(v.x);
    acc[4] += a * ub0(v.y); acc[5] += a * ub1(v.y); acc[6] += a * ub2(v.y); acc[7] += a * ub3(v.y);
    acc[8] += a * ub0(v.z); acc[9] += a * ub1(v.z); acc[10] += a * ub2(v.z); acc[11] += a * ub3(v.z);
    acc[12] += a * ub0(v.w); acc[13] += a * ub1(v.w); acc[14] += a * ub2(v.w); acc[15] += a * ub3(v.w);
}
__device__ __forceinline__ void phase_peer_gather3(const Args& a, char* lds, int layer, int mode) {
    const int lane = threadIdx.x & 63, wid = __builtin_amdgcn_readfirstlane(threadIdx.x >> 6), gw = blockIdx.x * NWAVE + wid, ngw = gridDim.x * NWAVE;
    const int grp = lane >> 4, sub = lane & 15;
    unsigned char* ws = a.ws;
    bf16_t* H = (bf16_t*)(ws + WS_H); float* X1 = (float*)(ws + WS_X1);
    const unsigned char* PU = ws + WS_PU + (size_t)layer * NEXP * D; const unsigned char* PV = ws + WS_PV + (size_t)layer * NEXP * D;
    const float* SCU = (const float*)(ws + WS_SCU) + layer * NEXP; const float* SCV = (const float*)(ws + WS_SCV) + layer * NEXP;
    const int* SELI = (const int*)(ws + WS_SELI); const float* SELG = (const float*)(ws + WS_SELG);
    LAS int* lidx = (LAS int*)((LAS char*)lds + wid * 2048);
    LAS float* lgu = (LAS float*)(lidx + 128);
    LAS float* lact = lgu + 128;
    for (int g = gw; g < MTOT; g += ngw) {
        const int var = row_variant(g);
        if (mode == 1 && var == 2) continue;
        {
            const int i0 = SELI[(size_t)g * 128 + lane], i1 = SELI[(size_t)g * 128 + 64 + lane];
            lidx[lane] = i0; lidx[64 + lane] = i1;
            lgu[lane] = SCU[i0]; lgu[64 + lane] = SCU[i1];
        }
        float hp[64]; float shp = 0.f;
#pragma unroll
        for (int c = 0; c < 4; ++c) {
            const u32x4 w0 = *(const u32x4*)(H + (size_t)g * D + c * 256 + sub * 16), w1 = *(const u32x4*)(H + (size_t)g * D + c * 256 + sub * 16 + 8);
            const int o = c * 16;
            hp[o + 0] = bflo(w0.x); hp[o + 1] = bfhi(w0.x); hp[o + 2] = bflo(w0.y); hp[o + 3] = bfhi(w0.y); hp[o + 4] = bflo(w0.z); hp[o + 5] = bfhi(w0.z); hp[o + 6] = bflo(w0.w); hp[o + 7] = bfhi(w0.w);
            hp[o + 8] = bflo(w1.x); hp[o + 9] = bfhi(w1.x); hp[o + 10] = bflo(w1.y); hp[o + 11] = bfhi(w1.y); hp[o + 12] = bflo(w1.z); hp[o + 13] = bfhi(w1.z); hp[o + 14] = bflo(w1.w); hp[o + 15] = bfhi(w1.w);
        }
#pragma unroll
        for (int d = 0; d < 64; ++d) shp += hp[d];
        shp += __shfl_xor(shp, 1); shp += __shfl_xor(shp, 2); shp += __shfl_xor(shp, 4); shp += __shfl_xor(shp, 8);
        const float bias = 128.f * shp;
        {
            RowU r0, r1, r2, r3;
            load_rowu(r0, PU + (size_t)lidx[0 * 4 + grp] * D + sub * 16); load_rowu(r1, PU + (size_t)lidx[1 * 4 + grp] * D + sub * 16);
            load_rowu(r2, PU + (size_t)lidx[2 * 4 + grp] * D + sub * 16); load_rowu(r3, PU + (size_t)lidx[3 * 4 + grp] * D + sub * 16);
#define GU_STEP(R, IT) { const float s = dot_rowu(R, hp) - bias; const int e = (IT) * 4 + grp; const float su = lgu[e]; \
                if ((IT) + 4 < 32) load_rowu(R, PU + (size_t)lidx[((IT) + 4) * 4 + grp] * D + sub * 16); \
                if (sub == 0) lact[e] = gelu_t(s * su); }
            for (int it = 0; it < 32; it += 4) { GU_STEP(r0, it) GU_STEP(r1, it + 1) GU_STEP(r2, it + 2) GU_STEP(r3, it + 3) }
#undef GU_STEP
        }
        {
            const float g0 = SELG[(size_t)g * 128 + lane], g1 = SELG[(size_t)g * 128 + 64 + lane];
            const float a0 = lact[lane] * g0 * SCV[lidx[lane]], a1 = lact[64 + lane] * g1 * SCV[lidx[64 + lane]];
            lact[lane] = a0; lact[64 + lane] = a1;
        }
        float acc[16]; float sact = 0.f;
#pragma unroll
        for (int d = 0; d < 16; ++d) acc[d] = 0.f;
        {
            u32x4 va[8];
#pragma unroll
            for (int k = 0; k < 8; ++k) va[k] = *(const u32x4*)(PV + (size_t)lidx[k] * D + lane * 16);
            for (int e = 0; e < 128; e += 8) {
#pragma unroll
                for (int k = 0; k < 8; ++k) {
                    const float av = lact[e + k]; sact += av;
                    fma_rowv(acc, va[k], av);
                    if (e + 8 < 128) va[k] = *(const u32x4*)(PV + (size_t)lidx[e + 8 + k] * D + lane * 16);
                }
            }
        }
        const float vb = 128.f * sact;
        float* xr = X1 + (size_t)g * D + lane * 16;
        const float* g2 = modv(a, layer, var, 5) + lane * 16;
        float xn[16]; float ss = 0.f;
#pragma unroll
        for (int d = 0; d < 16; d += 4) {
            const f32x4 xv = *(const f32x4*)(xr + d), gv = *(const f32x4*)(g2 + d);
            xn[d] = xv.x + gv.x * (acc[d] - vb); xn[d + 1] = xv.y + gv.y * (acc[d + 1] - vb); xn[d + 2] = xv.z + gv.z * (acc[d + 2] - vb); xn[d + 3] = xv.w + gv.w * (acc[d + 3] - vb);
            ss += xn[d] * xn[d] + xn[d + 1] * xn[d + 1] + xn[d + 2] * xn[d + 2] + xn[d + 3] * xn[d + 3];
        }
        const float rinv = rsqrtf(wave_sum(ss) * (1.f / D) + EPS);
        if (mode == 0) {
#pragma unroll
            for (int d = 0; d < 16; d += 4) { f32x4 o; o.x = xn[d]; o.y = xn[d + 1]; o.z = xn[d + 2]; o.w = xn[d + 3]; *(f32x4*)(xr + d) = o; }
            const float* gn = a.in[6] + D + lane * 16; const float* sh = modv(a, 1, var, 0) + lane * 16; const float* sc = modv(a, 1, var, 1) + lane * 16;
            unsigned w[8];
#pragma unroll
            for (int d = 0; d < 16; d += 2) w[d >> 1] = pk2(xn[d] * rinv * gn[d] * (1.f + sc[d]) + sh[d], xn[d + 1] * rinv * gn[d + 1] * (1.f + sc[d + 1]) + sh[d + 1]);
            u32x4 o0, o1; o0.x = w[0]; o0.y = w[1]; o0.z = w[2]; o0.w = w[3]; o1.x = w[4]; o1.y = w[5]; o1.z = w[6]; o1.w = w[7];
            *(u32x4*)(H + (size_t)g * D + lane * 16) = o0; *(u32x4*)(H + (size_t)g * D + lane * 16 + 8) = o1;
        } else {
            const int b = g / RPB, t = g - b * RPB - CTXL;
            float* op = a.out + ((size_t)b * SEQ + t) * D + lane * 16; const float* gn = a.in[28] + lane * 16;
#pragma unroll
            for (int d = 0; d < 16; d += 4) { f32x4 o; o.x = xn[d] * rinv * gn[d]; o.y = xn[d + 1] * rinv * gn[d + 1]; o.z = xn[d + 2] * rinv * gn[d + 2]; o.w = xn[d + 3] * rinv * gn[d + 3]; *(f32x4*)(op + d) = o; }
        }
    }
}

__device__ __forceinline__ int peer_tok(int i, int mode) { return mode == 1 ? i + CTXL + (i >= SEQ ? CTXL : 0) : i; }
__device__ __forceinline__ float dot16u(const u32x4& w, const float (&hp)[16]) {
    float a0 = hp[0] * ub0(w.x) + hp[4] * ub0(w.y), a1 = hp[1] * ub1(w.x) + hp[5] * ub1(w.y), a2 = hp[2] * ub2(w.x) + hp[6] * ub2(w.y), a3 = hp[3] * ub3(w.x) + hp[7] * ub3(w.y);
    a0 += hp[8] * ub0(w.z) + hp[12] * ub0(w.w); a1 += hp[9] * ub1(w.z) + hp[13] * ub1(w.w); a2 += hp[10] * ub2(w.z) + hp[14] * ub2(w.w); a3 += hp[11] * ub3(w.z) + hp[15] * ub3(w.w);
    return (a0 + a1) + (a2 + a3);
}
__device__ __forceinline__ void gu_stage(u32x4 (&seg)[16], u32x4& hw, LAS int* lb, int i0, int i1, const unsigned char* hrow, const unsigned char* PUx, int lane, int eg) {
    lb[lane] = i0; lb[64 + lane] = i1;
    hw = *(const u32x4*)hrow;
#pragma unroll
    for (int st = 0; st < 16; ++st) seg[st] = *(const u32x4*)(PUx + (size_t)lb[st * 8 + eg] * 128);
}
__device__ __forceinline__ void gu_compute(const u32x4 (&seg)[16], const u32x4& hw, LAS float* lpart, float* prow, int lane, int eg, int sub, bool valid) {
#pragma unroll
    for (int st = 0; st < 16; ++st) {
        int d = __builtin_amdgcn_sdot4((int)seg[st].x, (int)hw.x, 0, false);
        d = __builtin_amdgcn_sdot4((int)seg[st].y, (int)hw.y, d, false); d = __builtin_amdgcn_sdot4((int)seg[st].z, (int)hw.z, d, false); d = __builtin_amdgcn_sdot4((int)seg[st].w, (int)hw.w, d, false);
        d += __shfl_xor(d, 1); d += __shfl_xor(d, 2); d += __shfl_xor(d, 4);
        if (sub == 0) lpart[st * 8 + eg] = (float)d;
    }
    if (valid) { prow[lane] = lpart[lane]; prow[64 + lane] = lpart[64 + lane]; }
}
__device__ __forceinline__ void phase_gu(const Args& a, char* lds, int layer, int mode) {
    const int lane = threadIdx.x & 63, wid = __builtin_amdgcn_readfirstlane(threadIdx.x >> 6), eg = lane >> 3, sub = lane & 7;
    const int x = blockIdx.x & 7, stripe = blockIdx.x >> 3, nstr = (gridDim.x >> 3) * NWAVE, ntok = mode == 1 ? NB * SEQ : MTOT;
    unsigned char* ws = a.ws;
    const unsigned char* H8 = ws + WS_H8 + x * 128 + sub * 16;
    const unsigned char* PUx = ws + WS_PU + (size_t)layer * NEXP * D + (size_t)x * NEXP * 128 + sub * 16;
    const int* SELI = (const int*)(ws + WS_SELI); float* PART = (float*)(ws + WS_PART) + (size_t)x * MTOT * 128;
    LAS int* lidx = (LAS int*)((LAS char*)lds + wid * 2048);
    LAS float* lpart = (LAS float*)(lidx + 256);
    const int first = stripe * NWAVE + wid;
#define G_TOK(k) peer_tok(min(first + (k) * nstr, ntok - 1), mode)
#define G_VALID(k) (first + (k) * nstr < ntok)
    u32x4 segA[16], segB[16], hwA, hwB;
    int p0, p1;
    { const int g = G_TOK(0); p0 = SELI[(size_t)g * 128 + lane]; p1 = SELI[(size_t)g * 128 + 64 + lane];
      gu_stage(segA, hwA, lidx, p0, p1, H8 + (size_t)g * D, PUx, lane, eg); }
    { const int g = G_TOK(1); p0 = SELI[(size_t)g * 128 + lane]; p1 = SELI[(size_t)g * 128 + 64 + lane]; }
    for (int k = 0; G_VALID(k); k += 2) {
        { const int g1 = G_TOK(k + 1); gu_stage(segB, hwB, lidx + 128, p0, p1, H8 + (size_t)g1 * D, PUx, lane, eg); }
        { const int g2 = G_TOK(k + 2); p0 = SELI[(size_t)g2 * 128 + lane]; p1 = SELI[(size_t)g2 * 128 + 64 + lane]; }
        gu_compute(segA, hwA, lpart, PART + (size_t)G_TOK(k) * 128, lane, eg, sub, true);
        { const int g2 = G_TOK(k + 2); gu_stage(segA, hwA, lidx, p0, p1, H8 + (size_t)g2 * D, PUx, lane, eg); }
        { const int g3 = G_TOK(k + 3); p0 = SELI[(size_t)g3 * 128 + lane]; p1 = SELI[(size_t)g3 * 128 + 64 + lane]; }
        gu_compute(segB, hwB, lpart, PART + (size_t)G_TOK(k + 1) * 128, lane, eg, sub, G_VALID(k + 1));
    }
}
__device__ __forceinline__ void phase_gact(const Args& a, int layer, int mode) {
    const int lane = threadIdx.x & 63, gw = blockIdx.x * NWAVE + (threadIdx.x >> 6), ngw = gridDim.x * NWAVE, ntok = mode == 1 ? NB * SEQ : MTOT;
    unsigned char* ws = a.ws;
    const float* PART = (const float*)(ws + WS_PART); const int* SELI = (const int*)(ws + WS_SELI); const float* SELG = (const float*)(ws + WS_SELG);
    const float* SCU = (const float*)(ws + WS_SCU) + layer * NEXP; const float* SCV = (const float*)(ws + WS_SCV) + layer * NEXP;
    const float* SH = (const float*)(ws + WS_SH); short* ACT16 = (short*)(ws + WS_ACT16); float* SA = (float*)(ws + WS_SA);
    for (int i = gw; i < ntok; i += ngw) {
        const int g = peer_tok(i, mode);
        const float sh = SH[g];
        float av[2];
#pragma unroll
        for (int hf = 0; hf < 2; ++hf) {
            const size_t o = (size_t)g * 128 + hf * 64 + lane;
            float sdot = 0.f;
#pragma unroll
            for (int xx = 0; xx < 8; ++xx) sdot += PART[(size_t)xx * MTOT * 128 + o];
            const int id = SELI[o];
            av[hf] = gelu_t(sdot * sh * SCU[id]) * SELG[o] * SCV[id];
        }
        float mx = fmaxf(fabsf(av[0]), fabsf(av[1]));
#pragma unroll
        for (int of = 1; of < 64; of <<= 1) mx = fmaxf(mx, __shfl_xor(mx, of));
        mx = fmaxf(mx, 1e-30f); const float inv = 32767.f / mx;
#pragma unroll
        for (int hf = 0; hf < 2; ++hf) {
            const int e = hf * 64 + lane, st = e >> 3, eg = e & 7, pos = (((st >> 1) * 8 + eg) << 1) | (st & 1);
            ACT16[(size_t)g * 128 + pos] = (short)__float2int_rn(av[hf] * inv);
        }
        if (lane == 0) SA[g] = mx * (1.f / 32767.f);
    }
}
__device__ __forceinline__ void gv_stage(u32x4 (&seg)[16], LAS int* lb, int i0, int i1, const unsigned char* PVx, int lane, int eg) {
    lb[lane] = i0; lb[64 + lane] = i1;
#pragma unroll
    for (int st = 0; st < 16; ++st) seg[st] = *(const u32x4*)(PVx + (size_t)lb[st * 8 + eg] * 128);
}
typedef short s16x2_t __attribute__((ext_vector_type(2)));
__device__ __forceinline__ int dot2i16(unsigned w, unsigned aw, int acc) { return __builtin_amdgcn_sdot2(__builtin_bit_cast(s16x2_t, w), __builtin_bit_cast(s16x2_t, aw), acc, false); }
__device__ __forceinline__ void gv_pair(int (&acc)[16], const u32x4& va, const u32x4& vb, unsigned aw) {
#define GV_D(d, o) acc[o + 0] = dot2i16(__builtin_amdgcn_perm(vb.d, va.d, 0x0c040c00u), aw, acc[o + 0]); acc[o + 1] = dot2i16(__builtin_amdgcn_perm(vb.d, va.d, 0x0c050c01u), aw, acc[o + 1]); \
                   acc[o + 2] = dot2i16(__builtin_amdgcn_perm(vb.d, va.d, 0x0c060c02u), aw, acc[o + 2]); acc[o + 3] = dot2i16(__builtin_amdgcn_perm(vb.d, va.d, 0x0c070c03u), aw, acc[o + 3]);
    GV_D(x, 0) GV_D(y, 4) GV_D(z, 8) GV_D(w, 12)
#undef GV_D
}
__device__ __forceinline__ void gv_compute(const u32x4 (&seg)[16], const unsigned (&aw)[8], float sa, float* xr, const float* g2, int eg, bool valid) {
    int acc[16]; int sq = 0;
#pragma unroll
    for (int k = 0; k < 16; ++k) acc[k] = 0;
#pragma unroll
    for (int s2 = 0; s2 < 8; ++s2) { gv_pair(acc, seg[2 * s2], seg[2 * s2 + 1], aw[s2]); sq += (int)(short)(aw[s2] & 0xffffu) + ((int)aw[s2] >> 16); }
#pragma unroll
    for (int k = 0; k < 16; ++k) { acc[k] += __shfl_xor(acc[k], 8); acc[k] += __shfl_xor(acc[k], 16); acc[k] += __shfl_xor(acc[k], 32); }
    sq += __shfl_xor(sq, 8); sq += __shfl_xor(sq, 16); sq += __shfl_xor(sq, 32);
    if (eg == 0 && valid) {
        const int vb = 128 * sq;
#pragma unroll
        for (int d = 0; d < 16; d += 4) {
            const f32x4 xv = *(const f32x4*)(xr + d), gv = *(const f32x4*)(g2 + d);
            f32x4 o; o.x = xv.x + gv.x * (sa * (float)(acc[d] - vb)); o.y = xv.y + gv.y * (sa * (float)(acc[d + 1] - vb)); o.z = xv.z + gv.z * (sa * (float)(acc[d + 2] - vb)); o.w = xv.w + gv.w * (sa * (float)(acc[d + 3] - vb));
            *(f32x4*)(xr + d) = o;
        }
    }
}
__device__ __forceinline__ void phase_gv(const Args& a, char* lds, int layer, int mode) {
    const int lane = threadIdx.x & 63, wid = __builtin_amdgcn_readfirstlane(threadIdx.x >> 6), eg = lane >> 3, sub = lane & 7;
    const int x = blockIdx.x & 7, stripe = blockIdx.x >> 3, nstr = (gridDim.x >> 3) * NWAVE, ntok = mode == 1 ? NB * SEQ : MTOT;
    unsigned char* ws = a.ws;
    float* X1 = (float*)(ws + WS_X1) + x * 128 + sub * 16;
    const unsigned char* PVx = ws + WS_PV + (size_t)layer * NEXP * D + (size_t)x * NEXP * 128 + sub * 16;
    const int* SELI = (const int*)(ws + WS_SELI); const unsigned* ACTW = (const unsigned*)(ws + WS_ACT16) + eg; const float* SA = (const float*)(ws + WS_SA);
    LAS int* lidx = (LAS int*)((LAS char*)lds + wid * 2048);
    const int first = stripe * NWAVE + wid;
    u32x4 segA[16], segB[16];
    unsigned awA[8], awB[8]; float saA, saB;
    int p0, p1;
#define GV_PREF(k) { const int g_ = G_TOK(k); p0 = SELI[(size_t)g_ * 128 + lane]; p1 = SELI[(size_t)g_ * 128 + 64 + lane]; }
#define GV_AW(AW, SAV, k) { const int g_ = G_TOK(k); _Pragma("unroll") for (int s2 = 0; s2 < 8; ++s2) AW[s2] = ACTW[(size_t)g_ * 64 + s2 * 8]; SAV = SA[g_]; }
#define GV_G2(k) (modv(a, layer, row_variant(G_TOK(k)), 5) + x * 128 + sub * 16)
    GV_PREF(0) gv_stage(segA, lidx, p0, p1, PVx, lane, eg); GV_AW(awA, saA, 0)
    GV_PREF(1)
    for (int k = 0; G_VALID(k); k += 2) {
        gv_stage(segB, lidx + 128, p0, p1, PVx, lane, eg); GV_AW(awB, saB, k + 1)
        GV_PREF(k + 2)
        gv_compute(segA, awA, saA, X1 + (size_t)G_TOK(k) * D, GV_G2(k), eg, true);
        gv_stage(segA, lidx, p0, p1, PVx, lane, eg); GV_AW(awA, saA, k + 2)
        GV_PREF(k + 3)
        gv_compute(segB, awB, saB, X1 + (size_t)G_TOK(k + 1) * D, GV_G2(k + 1), eg, G_VALID(k + 1));
    }
#undef GV_PREF
#undef GV_AW
#undef GV_G2
#undef G_TOK
#undef G_VALID
}
__device__ __forceinline__ void phase_finalnorm(const Args& a) {
    const int lane = threadIdx.x & 63, gw = blockIdx.x * NWAVE + (threadIdx.x >> 6), ngw = gridDim.x * NWAVE;
    const float* X1 = (const float*)(a.ws + WS_X1);
    for (int i = gw; i < NB * SEQ; i += ngw) {
        const int g = peer_tok(i, 1);
        const float* xr = X1 + (size_t)g * D; float* op = a.out + (size_t)i * D;
        f32x4 v[4]; float ss = 0.f;
#pragma unroll
        for (int j = 0; j < 4; ++j) { v[j] = *(const f32x4*)(xr + j * 256 + lane * 4); ss += (v[j].x * v[j].x + v[j].y * v[j].y) + (v[j].z * v[j].z + v[j].w * v[j].w); }
        const float rinv = rsqrtf(wave_sum(ss) * (1.f / D) + EPS);
#pragma unroll
        for (int j = 0; j < 4; ++j) { const f32x4 gn = *(const f32x4*)(a.in[28] + j * 256 + lane * 4); *(f32x4*)(op + j * 256 + lane * 4) = v[j] * rinv * gn; }
    }
}

__device__ __forceinline__ void phase_inproj1(const Args& a, char* lds) {
    float* Cs = (float*)lds;
    const int tid = threadIdx.x;
    const bf16_t* H = (const bf16_t*)(a.ws + WS_H); const bf16_t* W = (const bf16_t*)(a.ws + WS_WIN1);
    const int NU = (MTOT / 128) * 20;
    for (int u = blockIdx.x; u < NU; u += gridDim.x) {
        const int rt = u / 20, ct = u % 20, row0 = rt * 128, col0 = ct * 128;
        if (ct < 10 && (rt % 66) < 2) continue;
        gemm_tile128(H + (size_t)row0 * D, D, W + (size_t)col0 * D, D, D, Cs);
        __syncthreads();
        const int rr = tid >> 2, q4 = tid & 3, g = row0 + rr;
        const float* crow = Cs + rr * CS_LD + q4 * 32;
        if (ct < 10) {
            bf16_t* o = (bf16_t*)(a.ws + WS_GG) + (size_t)g * DRNN + col0 + q4 * 32;
#pragma unroll
            for (int c = 0; c < 32; c += 2) *(unsigned*)(o + c) = pk2(gelu_t(crow[c]), gelu_t(crow[c + 1]));
        } else {
            bf16_t* o = (bf16_t*)(a.ws + WS_XR) + (size_t)g * DRNN + (col0 - DRNN) + q4 * 32;
#pragma unroll
            for (int c = 0; c < 32; c += 2) *(unsigned*)(o + c) = pk2(crow[c], crow[c + 1]);
        }
        __syncthreads();
    }
}

__device__ __forceinline__ void phase_rglru(const Args& a, char* lds, int pass) {
    const int tid = threadIdx.x;
    unsigned char* ws = a.ws;
    float* xc = (float*)lds;
    float* seg = xc + 128 * 128;
    const bf16_t* XR = (const bf16_t*)(ws + WS_XR); const bf16_t* GG = (const bf16_t*)(ws + WS_GG); bf16_t* YG = (bf16_t*)(ws + WS_YG);
    float* CARRY = (float*)(ws + WS_CARRY);
    const int j = tid & 127, tq = tid >> 7;
    const int NU = (MTOT / 128) * 10;
    for (int u = blockIdx.x; u < NU; u += gridDim.x) {
        const int T = u / 10, hb = u % 10, b = T / 66, tl = T % 66, row0 = T * 128, ch = hb * 128 + j;
        if (pass == 1 && tl < 2) continue;
        const int seq_lo = tl < 2 ? b * RPB : b * RPB + CTXL, seq_hi = tl < 2 ? b * RPB + CTXL : (b + 1) * RPB;
        {
            const float w0 = a.in[16][0 * DRNN + ch], w1 = a.in[16][1 * DRNN + ch], w2 = a.in[16][2 * DRNN + ch], w3 = a.in[16][3 * DRNN + ch], cb = a.in[17][ch];
            for (int tt = 0; tt < 32; ++tt) {
                const int g = row0 + tq * 32 + tt;
                const float xm2 = (g - 2 >= seq_lo) ? bf2f(XR[(size_t)(g - 2) * DRNN + ch]) : 0.f;
                const float xm1 = (g - 1 >= seq_lo) ? bf2f(XR[(size_t)(g - 1) * DRNN + ch]) : 0.f;
                const float x0 = bf2f(XR[(size_t)g * DRNN + ch]);
                const float xp1 = (g + 1 < seq_hi) ? bf2f(XR[(size_t)(g + 1) * DRNN + ch]) : 0.f;
                xc[(tq * 32 + tt) * 128 + j] = w0 * xm2 + w1 * xm1 + w2 * x0 + w3 * xp1 + cb;
            }
        }
        __syncthreads();
        float acc[4][32];
#pragma unroll
        for (int m = 0; m < 4; ++m)
#pragma unroll
            for (int tt = 0; tt < 32; ++tt) acc[m][tt] = 0.f;
        {
            const float* wa0 = a.in[18] + ((size_t)(0 * 10 + hb) * 128) * 128 + j; const float* wx0 = a.in[20] + ((size_t)(0 * 10 + hb) * 128) * 128 + j;
            const float* wa1 = a.in[18] + ((size_t)(1 * 10 + hb) * 128) * 128 + j; const float* wx1 = a.in[20] + ((size_t)(1 * 10 + hb) * 128) * 128 + j;
            for (int i = 0; i < 128; ++i) {
                const float w0 = wa0[i * 128], w1 = wx0[i * 128], w2 = wa1[i * 128], w3 = wx1[i * 128];
#pragma unroll
                for (int tt = 0; tt < 32; ++tt) { const float x = xc[(tq * 32 + tt) * 128 + i]; acc[0][tt] += x * w0; acc[1][tt] += x * w1; acc[2][tt] += x * w2; acc[3][tt] += x * w3; }
            }
        }
#pragma unroll
        for (int d = 0; d < 2; ++d) {
            const float ba = a.in[19][d * DRNN + ch], bx = a.in[21][d * DRNN + ch], lam = a.in[22][d * DRNN + ch];
            const float sp = log1pf(__expf(-lam));
#pragma unroll
            for (int tt = 0; tt < 32; ++tt) {
                const float r = sigmoidf_(acc[2 * d][tt] + ba), ig = sigmoidf_(acc[2 * d + 1][tt] + bx);
                const float la = -8.f * r * sp; const float av = __expf(la);
                const float uv = sqrtf(fmaxf(-expm1f(2.f * la), 0.f)) * ig * xc[(tq * 32 + tt) * 128 + j];
                acc[2 * d][tt] = av; acc[2 * d + 1][tt] = uv;
            }
        }
        {
            float Af = 1.f, Hf = 0.f, Ab = 1.f, Hb = 0.f;
#pragma unroll
            for (int tt = 0; tt < 32; ++tt) { Hf = acc[0][tt] * Hf + acc[1][tt]; Af *= acc[0][tt]; }
#pragma unroll
            for (int tt = 31; tt >= 0; --tt) { Hb = acc[2][tt] * Hb + acc[3][tt]; Ab *= acc[2][tt]; }
            seg[((0 * 4 + tq) * 128 + j) * 2] = Af; seg[((0 * 4 + tq) * 128 + j) * 2 + 1] = Hf;
            seg[((1 * 4 + tq) * 128 + j) * 2] = Ab; seg[((1 * 4 + tq) * 128 + j) * 2 + 1] = Hb;
        }
        __syncthreads();
        if (pass == 0) {
            if (tq == 0) {
                float A = 1.f, Hh = 0.f;
                for (int s = 0; s < 4; ++s) { const float sa = seg[((0 * 4 + s) * 128 + j) * 2], sh = seg[((0 * 4 + s) * 128 + j) * 2 + 1]; Hh = sa * Hh + sh; A *= sa; }
                float* c0 = CARRY + (((size_t)(b * 2 + 0) * 66 + tl) * DRNN + ch) * 2; c0[0] = A; c0[1] = Hh;
                A = 1.f; Hh = 0.f;
                for (int s = 3; s >= 0; --s) { const float sa = seg[((1 * 4 + s) * 128 + j) * 2], sh = seg[((1 * 4 + s) * 128 + j) * 2 + 1]; Hh = sa * Hh + sh; A *= sa; }
                float* c1 = CARRY + (((size_t)(b * 2 + 1) * 66 + tl) * DRNN + ch) * 2; c1[0] = A; c1[1] = Hh;
            }
        } else {
            float hf = 0.f, hbk = 0.f;
            for (int t2 = 0; t2 < tl; ++t2) { const float* c = CARRY + (((size_t)(b * 2 + 0) * 66 + t2) * DRNN + ch) * 2; hf = c[0] * hf + c[1]; }
            { const float* c = CARRY + (((size_t)(b * 2 + 1) * 66 + 1) * DRNN + ch) * 2; hbk = c[0] * hbk + c[1]; }
            { const float* c = CARRY + (((size_t)(b * 2 + 1) * 66 + 0) * DRNN + ch) * 2; hbk = c[0] * hbk + c[1]; }
            for (int t2 = 65; t2 > tl; --t2) { const float* c = CARRY + (((size_t)(b * 2 + 1) * 66 + t2) * DRNN + ch) * 2; hbk = c[0] * hbk + c[1]; }
            for (int s = 0; s < tq; ++s) { const float sa = seg[((0 * 4 + s) * 128 + j) * 2], sh = seg[((0 * 4 + s) * 128 + j) * 2 + 1]; hf = sa * hf + sh; }
            for (int s = 3; s > tq; --s) { const float sa = seg[((1 * 4 + s) * 128 + j) * 2], sh = seg[((1 * 4 + s) * 128 + j) * 2 + 1]; hbk = sa * hbk + sh; }
#pragma unroll
            for (int tt = 0; tt < 32; ++tt) { hf = acc[0][tt] * hf + acc[1][tt]; acc[0][tt] = hf; }
#pragma unroll
            for (int tt = 31; tt >= 0; --tt) { hbk = acc[2][tt] * hbk + acc[3][tt]; acc[0][tt] += hbk; }
#pragma unroll
            for (int tt = 0; tt < 32; ++tt) {
                const int g = row0 + tq * 32 + tt;
                YG[(size_t)g * DRNN + ch] = (bf16_t)f2bf(acc[0][tt] * bf2f(GG[(size_t)g * DRNN + ch]));
            }
        }
        __syncthreads();
    }
}

constexpr int XC_LD = 136;
__device__ __forceinline__ float exp2_fast(float x) { return __builtin_amdgcn_exp2f(x); }
__device__ __forceinline__ float sigm_fast(float x) { return __builtin_amdgcn_rcpf(1.f + __builtin_amdgcn_exp2f(-1.4426950408889634f * x)); }
__device__ __forceinline__ void phase_rglru2(const Args& a, char* lds, int pass) {
    const int tid = threadIdx.x, lane = tid & 63, wid = __builtin_amdgcn_readfirstlane(tid >> 6), r32 = lane & 31, hh = lane >> 5;
    const int nb = wid & 3, dir = wid >> 2;
    unsigned char* ws = a.ws;
    LAS bf16_t* xcA = (LAS bf16_t*)((LAS char*)lds);
    LAS float* HS = (LAS float*)((LAS char*)lds + 36864);
    const bf16_t* XR = (const bf16_t*)(ws + WS_XR); const bf16_t* GG = (const bf16_t*)(ws + WS_GG); bf16_t* YG = (bf16_t*)(ws + WS_YG);
    float* CARRY = (float*)(ws + WS_CARRY);
    const int NU = (MTOT / 128) * 10;
    for (int u = blockIdx.x; u < NU; u += gridDim.x) {
        const int T = u / 10, hb = u % 10, b = T / 66, tl = T % 66, row0 = T * 128;
        if (pass == 1 && tl < 2) continue;
        const int seq_lo = tl < 2 ? b * RPB : b * RPB + CTXL, seq_hi = tl < 2 ? b * RPB + CTXL : (b + 1) * RPB;
        {
            const int j2 = tid & 63, ts = tid >> 6, c0 = hb * 128 + 2 * j2;
            const float w00 = a.in[16][0 * DRNN + c0], w01 = a.in[16][0 * DRNN + c0 + 1], w10 = a.in[16][1 * DRNN + c0], w11 = a.in[16][1 * DRNN + c0 + 1];
            const float w20 = a.in[16][2 * DRNN + c0], w21 = a.in[16][2 * DRNN + c0 + 1], w30 = a.in[16][3 * DRNN + c0], w31 = a.in[16][3 * DRNN + c0 + 1];
            const float cb0 = a.in[17][c0], cb1 = a.in[17][c0 + 1];
            unsigned xw[19];
#pragma unroll
            for (int i = 0; i < 19; ++i) { const int g = row0 + ts * 16 - 2 + i; xw[i] = (g >= seq_lo && g < seq_hi) ? *(const unsigned*)(XR + (size_t)g * DRNN + c0) : 0u; }
#pragma unroll
            for (int i = 0; i < 16; ++i) {
                const float y0 = w00 * bflo(xw[i]) + w10 * bflo(xw[i + 1]) + w20 * bflo(xw[i + 2]) + w30 * bflo(xw[i + 3]) + cb0;
                const float y1 = w01 * bfhi(xw[i]) + w11 * bfhi(xw[i + 1]) + w21 * bfhi(xw[i + 2]) + w31 * bfhi(xw[i + 3]) + cb1;
                *(LAS unsigned*)(xcA + (ts * 16 + i) * XC_LD + 2 * j2) = pk2(y0, y1);
            }
        }
        __syncthreads();
        const int ch = hb * 128 + nb * 32 + r32;
        f32x16 accA[4], accX[4];
        {
            unsigned woff = (unsigned)((nb * 32 + r32) * 128 + 8 * hh); asm volatile("" : "+v"(woff));
            const bf16_t* wa = (const bf16_t*)(ws + WS_WAT) + (size_t)(dir * 10 + hb) * 128 * 128;
            const bf16_t* wx = (const bf16_t*)(ws + WS_WXT) + (size_t)(dir * 10 + hb) * 128 * 128;
            bf16x8 bfa[8], bfx[8];
#pragma unroll
            for (int k = 0; k < 8; ++k) { bfa[k] = *(const bf16x8*)(wa + woff + k * 16); bfx[k] = *(const bf16x8*)(wx + woff + k * 16); }
#pragma unroll
            for (int mb = 0; mb < 4; ++mb) {
                accA[mb] = f32x16{}; accX[mb] = f32x16{};
#pragma unroll
                for (int k = 0; k < 8; ++k) {
                    const bf16x8 af = *(const LAS bf16x8*)(xcA + (mb * 32 + r32) * XC_LD + k * 16 + 8 * hh);
                    accA[mb] = __builtin_amdgcn_mfma_f32_32x32x16_bf16(af, bfa[k], accA[mb], 0, 0, 0);
                    accX[mb] = __builtin_amdgcn_mfma_f32_32x32x16_bf16(af, bfx[k], accX[mb], 0, 0, 0);
                }
            }
        }
        __builtin_amdgcn_sched_barrier(0);
        {
            const float ba = a.in[19][dir * DRNN + ch], bx = a.in[21][dir * DRNN + ch], lam = a.in[22][dir * DRNN + ch];
            const float sp8 = -8.f * log1pf(__expf(-lam));
#pragma unroll
            for (int mb = 0; mb < 4; ++mb)
#pragma unroll
                for (int r = 0; r < 16; ++r) {
                    const int t = mb * 32 + (r & 3) + 8 * (r >> 2) + 4 * hh;
                    const float xv = bf2f(xcA[t * XC_LD + nb * 32 + r32]);
                    const float rg = sigm_fast(accA[mb][r] + ba), ig = sigm_fast(accX[mb][r] + bx);
                    const float la = rg * sp8, av = exp2_fast(1.4426950408889634f * la), x2 = 2.f * la;
                    const float om1 = -x2 * (1.f + x2 * (0.5f + x2 * (0.16666667f + x2 * 0.041666668f))), om2 = __builtin_fmaf(-av, av, 1.f);
                    const float om = (x2 > -0.25f) ? om1 : om2;
                    accA[mb][r] = av; accX[mb][r] = __builtin_sqrtf(fmaxf(om, 0.f)) * ig * xv;
                    if ((r & 3) == 3) __builtin_amdgcn_sched_barrier(0);
                }
        }
        __builtin_amdgcn_sched_barrier(0);
        float h = 0.f;
        if (pass == 1) {
            const int pos = dir == 0 ? tl : 67 - tl;
            const float* cbase = CARRY + ((size_t)(b * 2 + dir) * 66) * DRNN * 2 + (size_t)ch * 2;
            float cA = 1.f, cH = 0.f;
#pragma unroll 3
            for (int i = 0; i < 33; ++i) {
                const int p = hh * 33 + i;
                const int tile = dir == 0 ? p : (p < 2 ? 1 - p : 67 - p);
                if (p < pos) { const float* c = cbase + (size_t)tile * DRNN * 2; const float ta = c[0], th = c[1]; cH = ta * cH + th; cA = ta * cA; }
            }
            const auto ra = __builtin_amdgcn_permlane32_swap(__float_as_uint(cA), __float_as_uint(cA), false, false);
            const auto rh = __builtin_amdgcn_permlane32_swap(__float_as_uint(cH), __float_as_uint(cH), false, false);
            const float lowH = hh == 0 ? cH : __uint_as_float(rh[0]);
            const float upA = hh == 0 ? __uint_as_float(ra[1]) : cA;
            const float upH = hh == 0 ? __uint_as_float(rh[1]) : cH;
            h = upA * lowH + upH;
        }
        float Atot = 1.f; float cin[16];
#define RG_COMPOSITE(q) const int mb = (q) >> 2, rg = ((q) & 3) * 4; \
            const float a0 = accA[mb][rg], a1 = accA[mb][rg + 1], a2 = accA[mb][rg + 2], a3 = accA[mb][rg + 3]; \
            const float u0 = accX[mb][rg], u1 = accX[mb][rg + 1], u2 = accX[mb][rg + 2], u3 = accX[mb][rg + 3]; \
            const float gA = (a0 * a1) * (a2 * a3); \
            const float gH = dir == 0 ? ((u0 * a1 + u1) * a2 + u2) * a3 + u3 : ((u3 * a2 + u2) * a1 + u1) * a0 + u0; \
            const auto ra = __builtin_amdgcn_permlane32_swap(__float_as_uint(gA), __float_as_uint(gA), false, false); \
            const auto rh = __builtin_amdgcn_permlane32_swap(__float_as_uint(gH), __float_as_uint(gH), false, false); \
            const float pA = __uint_as_float(hh == 0 ? ra[1] : ra[0]), pH = __uint_as_float(hh == 0 ? rh[1] : rh[0]); \
            const float EA = hh ? pA : gA, EH = hh ? pH : gH, OA = hh ? gA : pA, OH = hh ? gH : pH;
        if (dir == 0) {
#pragma unroll
            for (int q = 0; q < 16; ++q) { RG_COMPOSITE(q)
                const float hE = h; h = EA * h + EH; const float hO = h; h = OA * h + OH; Atot *= EA * OA; cin[q] = hh ? hO : hE; }
        } else {
#pragma unroll
            for (int q = 15; q >= 0; --q) { RG_COMPOSITE(q)
                const float hO = h; h = OA * h + OH; const float hE = h; h = EA * h + EH; Atot *= EA * OA; cin[q] = hh ? hO : hE; }
        }
#undef RG_COMPOSITE
        if (pass == 0) {
            if (hh == 0) { float* c = CARRY + (((size_t)(b * 2 + dir) * 66 + tl) * DRNN + ch) * 2; c[0] = Atot; c[1] = h; }
            __syncthreads();
            continue;
        }
#pragma unroll
        for (int q = 0; q < 16; ++q) {
            const int mb = q >> 2, rg = (q & 3) * 4; float hc = cin[q];
            if (dir == 0) {
#pragma unroll
                for (int e = 0; e < 4; ++e) { hc = accA[mb][rg + e] * hc + accX[mb][rg + e]; accA[mb][rg + e] = hc; }
            } else {
#pragma unroll
                for (int e = 3; e >= 0; --e) { hc = accA[mb][rg + e] * hc + accX[mb][rg + e]; accA[mb][rg + e] = hc; }
            }
        }
        if (dir == 0) {
#pragma unroll
            for (int mb = 0; mb < 4; ++mb)
#pragma unroll
                for (int r = 0; r < 16; ++r) { const int t = mb * 32 + (r & 3) + 8 * (r >> 2) + 4 * hh; HS[t * 128 + nb * 32 + r32] = accA[mb][r]; }
        }
        __syncthreads();
        if (dir == 1) {
#pragma unroll
            for (int mb = 0; mb < 4; ++mb)
#pragma unroll
                for (int r = 0; r < 16; ++r) { const int t = mb * 32 + (r & 3) + 8 * (r >> 2) + 4 * hh; HS[t * 128 + nb * 32 + r32] += accA[mb][r]; }
        }
        __syncthreads();
        {
            const int t = tid >> 2, cs = (tid & 3) * 32, g = row0 + t;
            const bf16_t* gp = GG + (size_t)g * DRNN + hb * 128 + cs; bf16_t* yp = YG + (size_t)g * DRNN + hb * 128 + cs;
#pragma unroll
            for (int c8 = 0; c8 < 32; c8 += 8) {
                const u32x4 gw = *(const u32x4*)(gp + c8);
                const f32x4 h0 = *(const LAS f32x4*)(HS + t * 128 + cs + c8), h1 = *(const LAS f32x4*)(HS + t * 128 + cs + c8 + 4);
                u32x4 o; o.x = pk2(h0.x * bflo(gw.x), h0.y * bfhi(gw.x)); o.y = pk2(h0.z * bflo(gw.y), h0.w * bfhi(gw.y));
                o.z = pk2(h1.x * bflo(gw.z), h1.y * bfhi(gw.z)); o.w = pk2(h1.z * bflo(gw.w), h1.w * bfhi(gw.w));
                *(u32x4*)(yp + c8) = o;
            }
        }
        __syncthreads();
    }
}

namespace pg8 {
constexpr int BM = 256, BK = 64, HALF = 128, HTB = HALF * BK * 2, STAGE_BYTES = 8 * HTB, NXCD = 8, WGM = 8;
__host__ __device__ __forceinline__ int lds_byte(int r, int c) { const int st = (r >> 4) * 2 + (c >> 5), rr = r & 15, cc = c & 31, ob = rr * 64 + cc * 2; return st * 1024 + (ob ^ (((ob >> 9) & 1) << 5)); }
__host__ __device__ __forceinline__ void stage_rc(int b, int& R, int& C) { const int st = b / 1024, sb = b % 1024, swz = sb ^ (((sb >> 9) & 1) << 5); R = (st >> 1) * 16 + swz / 64; C = (st & 1) * 32 + (swz % 64) / 2; }
__host__ __device__ __forceinline__ int perm32(int rho) { const int n = rho >> 4, i = rho & 15; return 8 * (i >> 2) + 4 * n + (i & 3); }
struct Unit { int pm, pn; };
struct Gemm { const bf16_t* A; const bf16_t* Bt; int M, N, K; };
struct StaticOrder {
    int nM, nN, nwg, G, c;
    __host__ __device__ void init(int M, int N, int G_, int c_) { nM = M / BM; nN = N / BM; nwg = nM * nN; G = G_; c = c_; }
    __host__ __device__ bool next(int i, Unit& u) const {
        const long L = (long)i * G + c; if (L >= nwg) return false;
        int wgid = (int)L; { const int q = nwg / NXCD, r = nwg % NXCD, xcd = wgid % NXCD, off = wgid / NXCD; wgid = (xcd < r ? xcd * (q + 1) : r * (q + 1) + (xcd - r) * q) + off; }
        const int nig = WGM * nN, gid = wgid / nig, fm = gid * WGM, gsz = (nM - fm) < WGM ? (nM - fm) : WGM;
        u.pm = fm + ((wgid % nig) % gsz); u.pn = (wgid % nig) / gsz; return true;
    }
    __device__ __forceinline__ void a_ready(const Unit&) const {}
    __device__ __forceinline__ void done(const Unit&) const {}
};
struct LatentOrder {
    StaticOrder S;
    __host__ __device__ void init(int N, int G_, int c_) { S.init(16384, N, G_, c_); }
    __host__ __device__ bool next(int i, Unit& u) const { if (!S.next(i, u)) return false; u.pm = u.pm + 1 + (u.pm >= 32 ? 1 : 0); return true; }
    __device__ __forceinline__ void a_ready(const Unit&) const {}
    __device__ __forceinline__ void done(const Unit&) const {}
};
__device__ __forceinline__ unsigned cvt_pk_bf16(float lo, float hi) { unsigned r; asm volatile("v_cvt_pk_bf16_f32 %0, %1, %2" : "=v"(r) : "v"(lo), "v"(hi)); return r; }
__device__ __forceinline__ u32x4 pack8(const f32x4& v0, const f32x4& v1) { u32x4 w; w.x = cvt_pk_bf16(v0[0], v0[1]); w.y = cvt_pk_bf16(v0[2], v0[3]); w.z = cvt_pk_bf16(v1[0], v1[1]); w.w = cvt_pk_bf16(v1[2], v1[3]); return w; }
__device__ __forceinline__ f32x4 gelu4(const f32x4& v) { f32x4 r; r.x = gelu_t(v.x); r.y = gelu_t(v.y); r.z = gelu_t(v.z); r.w = gelu_t(v.w); return r; }

struct EpiStore {
    static constexpr bool PERM = true, AFTER_DRAIN = false;
    bf16_t* O1; bf16_t* O2; int ld; int split_tile; int gelu_tiles;
    __device__ __forceinline__ void operator()(f32x4 (&acc)[2][2][4][2], const Unit& u, int wr, int wc, int fr, int fq) const {
        const bool second = u.pn >= split_tile; bf16_t* base = second ? O2 : O1; const int pnl = second ? u.pn - split_tile : u.pn; const bool dog = u.pn < gelu_tiles;
        const int rl0 = wr * 64 + fr, cl0 = wc * 32 + 8 * fq;
#pragma unroll
        for (int ai = 0; ai < 2; ++ai)
#pragma unroll
            for (int m = 0; m < 4; ++m) { bf16_t* rowp = base + (size_t)(u.pm * BM + ai * HALF + m * 16 + rl0) * ld + pnl * BM + cl0;
#pragma unroll
                for (int bj = 0; bj < 2; ++bj) { f32x4 v0 = acc[ai][bj][m][0], v1 = acc[ai][bj][m][1]; if (dog) { v0 = gelu4(v0); v1 = gelu4(v1); }
                    *(u32x4*)(rowp + bj * HALF) = pack8(v0, v1); } }
    }
};
struct EpiResid {
    static constexpr bool PERM = true, AFTER_DRAIN = false;
    const float* x; const float* ctx; const float* modbase; float* X1; int base_mode;
    __device__ __forceinline__ void operator()(f32x4 (&acc)[2][2][4][2], const Unit& u, int wr, int wc, int fr, int fq) const {
        const int b = u.pm / 33, tl = u.pm % 33, var = tl == 0 ? 2 : b;
        const float* gate = modbase + (size_t)var * 6144 + u.pn * BM;
        const float* basep = base_mode == 0 ? (tl == 0 ? ctx + (size_t)b * CTXL * D : x + ((size_t)b * SEQ + (size_t)(tl - 1) * 256) * D) : X1 + (size_t)u.pm * BM * D;
        float* outp = X1 + (size_t)u.pm * BM * D;
        const int rl0 = wr * 64 + fr, cl0 = u.pn * BM + wc * 32 + 8 * fq;
        f32x4 gv[2][2];
#pragma unroll
        for (int bj = 0; bj < 2; ++bj)
#pragma unroll
            for (int n = 0; n < 2; ++n) gv[bj][n] = *(const f32x4*)(gate + bj * HALF + wc * 32 + 8 * fq + 4 * n);
#pragma unroll
        for (int ai = 0; ai < 2; ++ai)
#pragma unroll
            for (int m = 0; m < 4; ++m) { const size_t off = (size_t)(ai * HALF + m * 16 + rl0) * D + cl0;
#pragma unroll
                for (int bj = 0; bj < 2; ++bj)
#pragma unroll
                    for (int n = 0; n < 2; ++n) { const f32x4 bs = *(const f32x4*)(basep + off + bj * HALF + 4 * n); *(f32x4*)(outp + off + bj * HALF + 4 * n) = bs + gv[bj][n] * acc[ai][bj][m][n]; } }
    }
};
struct EpiInproj0 {
    static constexpr bool PERM = true, AFTER_DRAIN = false;
    unsigned char* ws; const float* gmg; const float* qg; const float* kg; LAS float* P;
    __device__ __forceinline__ void operator()(f32x4 (&acc)[2][2][4][2], const Unit& u, int wr, int wc, int fr, int fq) const {
        int rl0 = wr * 64 + fr, cl0 = wc * 32 + 8 * fq; asm volatile("" : "+v"(rl0), "+v"(cl0));
        const int pn = u.pn; const size_t grow0 = (size_t)u.pm * BM;
        if (pn < 4) {
#pragma unroll
            for (int ai = 0; ai < 2; ++ai)
#pragma unroll
                for (int bj = 0; bj < 2; ++bj)
#pragma unroll
                    for (int m = 0; m < 4; ++m) { acc[ai][bj][m][0] = gelu4(acc[ai][bj][m][0]); acc[ai][bj][m][1] = gelu4(acc[ai][bj][m][1]); __builtin_amdgcn_sched_barrier(0); }
        }
        if (pn < 2 || pn == 7) {
            bf16_t* base = pn < 2 ? (bf16_t*)(ws + WS_U) + pn * BM : (bf16_t*)(ws + WS_V); const int ld = pn < 2 ? 512 : 256;
#pragma unroll
            for (int ai = 0; ai < 2; ++ai)
#pragma unroll
                for (int m = 0; m < 4; ++m) { bf16_t* rowp = base + (grow0 + ai * HALF + m * 16 + rl0) * ld + cl0;
#pragma unroll
                    for (int bj = 0; bj < 2; ++bj) *(u32x4*)(rowp + bj * HALF) = pack8(acc[ai][bj][m][0], acc[ai][bj][m][1]); }
            return;
        }
#pragma unroll
        for (int ai = 0; ai < 2; ++ai)
#pragma unroll
            for (int m = 0; m < 4; ++m)
#pragma unroll
                for (int bj = 0; bj < 2; ++bj) { const f32x4 a0 = acc[ai][bj][m][0], a1 = acc[ai][bj][m][1];
                    float s = (a0.x * a0.x + a0.y * a0.y) + (a0.z * a0.z + a0.w * a0.w) + (a1.x * a1.x + a1.y * a1.y) + (a1.z * a1.z + a1.w * a1.w);
                    s += __shfl_xor(s, 16); s += __shfl_xor(s, 32);
                    if (fq == 0) P[((ai * HALF + m * 16 + rl0) * 2 + bj) * 4 + wc] = s; __builtin_amdgcn_sched_barrier(0); }
        asm volatile("s_waitcnt lgkmcnt(0)" ::: "memory"); __builtin_amdgcn_s_barrier(); asm volatile("" ::: "memory");
        if (pn < 4) {
            bf16_t* base = (bf16_t*)(ws + WS_VV) + (pn - 2) * BM; const float* gp = gmg + (pn - 2) * BM + cl0;
            f32x4 g8[2][2];
#pragma unroll
            for (int bj = 0; bj < 2; ++bj) { g8[bj][0] = *(const f32x4*)(gp + bj * HALF); g8[bj][1] = *(const f32x4*)(gp + bj * HALF + 4); }
#pragma unroll
            for (int ai = 0; ai < 2; ++ai)
#pragma unroll
                for (int m = 0; m < 4; ++m) { const int rl = ai * HALF + m * 16 + rl0; bf16_t* rowp = base + (grow0 + rl) * 512 + cl0;
#pragma unroll
                    for (int bj = 0; bj < 2; ++bj) { const f32x4 p = *(const LAS f32x4*)(P + (rl * 2 + bj) * 4);
                        const float rinv = rsqrtf(((p.x + p.y) + (p.z + p.w)) * (1.f / 128.f) + EPS);
                        *(u32x4*)(rowp + bj * HALF) = pack8(acc[ai][bj][m][0] * rinv * g8[bj][0], acc[ai][bj][m][1] * rinv * g8[bj][1]); }
                    asm volatile("" ::: "memory"); __builtin_amdgcn_sched_barrier(0); }
            return;
        }
        {
            const bool isq = pn < 6; const float* gn = isq ? qg : kg;
            const int grp = cl0 >> 3, fo = (grp >> 3) * 64 + (grp & 7) * 4;
            const f32x4 gA = *(const f32x4*)(gn + fo), gB = *(const f32x4*)(gn + fo + 32);
            bf16_t* base = isq ? (bf16_t*)(ws + WS_Q) + (pn - 4) * BM : (bf16_t*)(ws + WS_K); const int ld = isq ? 512 : 256;
            const int tl = u.pm % 33; const bool lat = tl != 0; const int ax = grp >> 3, f0 = (grp & 7) * 4;
            const float* rope = (const float*)(ws + WS_ROPE);
#pragma unroll
            for (int ai = 0; ai < 2; ++ai)
#pragma unroll
                for (int m = 0; m < 4; ++m) { const int rl = ai * HALF + m * 16 + rl0; bf16_t* rowp = base + (grow0 + rl) * ld + cl0;
                    f32x4 cs0 = {1.f, 0.f, 1.f, 0.f}, cs1 = {1.f, 0.f, 1.f, 0.f};
                    if (lat) { const int t = (tl - 1) * 256 + rl; const int pos = ax == 0 ? (t >> 6) : (t & 63); const float* rp = rope + (pos * 32 + f0) * 2; cs0 = *(const f32x4*)rp; cs1 = *(const f32x4*)(rp + 4); }
#pragma unroll
                    for (int bj = 0; bj < 2; ++bj) { const f32x4 p = *(const LAS f32x4*)(P + (rl * 2 + bj) * 4);
                        const float rinv = rsqrtf(((p.x + p.y) + (p.z + p.w)) * (1.f / 128.f) + EPS);
                        const f32x4 x1 = acc[ai][bj][m][0] * rinv * gA, x2 = acc[ai][bj][m][1] * rinv * gB;
                        f32x4 o1, o2;
                        o1.x = x1.x * cs0.x - x2.x * cs0.y; o2.x = x2.x * cs0.x + x1.x * cs0.y;
                        o1.y = x1.y * cs0.z - x2.y * cs0.w; o2.y = x2.y * cs0.z + x1.y * cs0.w;
                        o1.z = x1.z * cs1.x - x2.z * cs1.y; o2.z = x2.z * cs1.x + x1.z * cs1.y;
                        o1.w = x1.w * cs1.z - x2.w * cs1.w; o2.w = x2.w * cs1.z + x1.w * cs1.w;
                        *(u32x4*)(rowp + bj * HALF) = pack8(o1, o2); }
                    asm volatile("" ::: "memory"); __builtin_amdgcn_sched_barrier(0); }
        }
    }
};

template <class Epi, class Sched, bool ALIGN_EPI = false, bool SP2 = false>
__device__ __forceinline__ void gemm_phase(LAS unsigned char* lds, const Gemm g, const Sched& S, const Epi& E) {
    const int tid = threadIdx.x, wid = __builtin_amdgcn_readfirstlane(tid >> 6), lane = tid & 63, wr = wid >> 2, wc = wid & 3, fr = lane & 15, fq = lane >> 4;
    const int K = g.K, nt = K / BK;
    unsigned voffA[2], voffB[2];
#pragma unroll
    for (int i = 0; i < 2; ++i) { int R, C; stage_rc(tid * 16 + i * 8192, R, C); const int Rb = Epi::PERM ? ((R & ~31) + perm32(R & 31)) : R;
        voffA[i] = (unsigned)(R * K + C) * 2u; voffB[i] = (unsigned)(Rb * K + C) * 2u; }
    const size_t kstep = (size_t)(BK * 2);
    const size_t hstep = (size_t)HALF * K * 2;
    const size_t tstep = 2 * hstep;
    const unsigned ldsw = (unsigned)wid * 1024u;
    const int aoff = lds_byte(wr * 64 + fr, fq * 8), boff = lds_byte(wc * 32 + fr, fq * 8);
#define PG8_SA(b, h) (((b) * 2 + (h)) * HTB)
#define PG8_SB(b, h) ((4 + (b) * 2 + (h)) * HTB)
#define PG8_STAGE(bufoff, gbase, voff) do { _Pragma("unroll") for (int _i = 0; _i < 2; ++_i) \
        __builtin_amdgcn_global_load_lds((const unsigned*)((const char*)(gbase) + (voff)[_i]), (LAS unsigned*)(lds + (bufoff) + ldsw + _i * 8192), 16, 0, 0); } while (0)
#define PG8_LDA(dst, b, h) do { _Pragma("unroll") for (int m = 0; m < 4; ++m) _Pragma("unroll") for (int k = 0; k < 2; ++k) dst[m][k] = *(const LAS bf16x8*)(lds + PG8_SA(b, h) + aoff + m * 2048 + k * 1024); } while (0)
#define PG8_LDB(dst, b, h) do { _Pragma("unroll") for (int n = 0; n < 2; ++n) _Pragma("unroll") for (int k = 0; k < 2; ++k) dst[n][k] = *(const LAS bf16x8*)(lds + PG8_SB(b, h) + boff + n * 2048 + k * 1024); } while (0)
#define PG8_MMA(ai, bj, At, Bt) do { __builtin_amdgcn_s_setprio(1); _Pragma("unroll") for (int m = 0; m < 4; ++m) _Pragma("unroll") for (int n = 0; n < 2; ++n) _Pragma("unroll") for (int k = 0; k < 2; ++k) \
        acc[ai][bj][m][n] = __builtin_amdgcn_mfma_f32_16x16x32_bf16(Bt[n][k], At[m][k], acc[ai][bj][m][n], 0, 0, 0); __builtin_amdgcn_s_setprio(0); } while (0)
#define PG8_WAIT_V(n) asm volatile("s_waitcnt vmcnt(" #n ")" ::: "memory")
#define PG8_WAIT_L(n) asm volatile("s_waitcnt lgkmcnt(" #n ")" ::: "memory")
#define PG8_BAR __builtin_amdgcn_s_barrier()
#define PG8_SCHED __builtin_amdgcn_sched_barrier(0)
    Unit cur, nxt; int ui = 0;
    if (!S.next(0, cur)) return;
    f32x4 acc[2][2][4][2];
#pragma unroll
    for (int a = 0; a < 2; ++a)
#pragma unroll
        for (int b = 0; b < 2; ++b)
#pragma unroll
            for (int m = 0; m < 4; ++m)
#pragma unroll
                for (int n = 0; n < 2; ++n) acc[a][b][m][n] = (f32x4){0.f, 0.f, 0.f, 0.f};
    bf16x8 At[4][2], B0[2][2], B1[2][2];
    const char* cA = (const char*)g.A + (size_t)cur.pm * tstep; const char* cB = (const char*)g.Bt + (size_t)cur.pn * tstep;
    S.a_ready(cur);
    if constexpr (SP2) {
        PG8_STAGE(PG8_SB(0, 0), cB, voffB); PG8_STAGE(PG8_SB(0, 1), cB + hstep, voffB); PG8_STAGE(PG8_SA(0, 0), cA, voffA); PG8_STAGE(PG8_SA(0, 1), cA + hstep, voffA);
        if (wr == 1) PG8_BAR;
        PG8_WAIT_V(2); PG8_BAR;
        PG8_STAGE(PG8_SB(1, 0), cB + kstep, voffB); PG8_STAGE(PG8_SA(1, 0), cA + kstep, voffA); PG8_STAGE(PG8_SB(1, 1), cB + hstep + kstep, voffB);
        PG8_WAIT_V(6); PG8_BAR;
    } else {
        PG8_STAGE(PG8_SB(0, 0), cB, voffB); PG8_STAGE(PG8_SA(0, 0), cA, voffA); PG8_STAGE(PG8_SB(0, 1), cB + hstep, voffB); PG8_STAGE(PG8_SA(0, 1), cA + hstep, voffA);
        if (wr == 1) PG8_BAR;
        PG8_WAIT_V(4); PG8_BAR;
        PG8_STAGE(PG8_SB(1, 0), cB + kstep, voffB); PG8_STAGE(PG8_SA(1, 0), cA + kstep, voffA); PG8_STAGE(PG8_SB(1, 1), cB + hstep + kstep, voffB);
        PG8_WAIT_V(6); PG8_BAR;
    }
    for (;;) {
        const bool has_next = S.next(ui + 1, nxt);
        const char* nA = has_next ? (const char*)g.A + (size_t)nxt.pm * tstep : cA; const char* nB = has_next ? (const char*)g.Bt + (size_t)nxt.pn * tstep : cB;
        for (int t = 0; t < nt; t += 2) {
            const bool last = (t == nt - 2);
            const char* a1 = cA + (size_t)(t + 1) * kstep;
            const char* a2 = last ? nA : cA + (size_t)(t + 2) * kstep; const char* b2 = last ? nB : cB + (size_t)(t + 2) * kstep;
            const char* a3 = a2 + kstep; const char* b3 = b2 + kstep;
            if (last && has_next) S.a_ready(nxt);
            if constexpr (SP2) {
            PG8_LDB(B0, 0, 0); PG8_LDB(B1, 0, 1); PG8_SCHED; PG8_LDA(At, 0, 0); PG8_STAGE(PG8_SA(1, 1), a1 + hstep, voffA);
            PG8_WAIT_V(8); PG8_WAIT_L(0); PG8_BAR; PG8_MMA(0, 0, At, B0); PG8_MMA(0, 1, At, B1); PG8_BAR; PG8_SCHED;
            PG8_LDA(At, 0, 1); PG8_STAGE(PG8_SB(0, 0), b2, voffB); PG8_STAGE(PG8_SB(0, 1), b2 + hstep, voffB); PG8_STAGE(PG8_SA(0, 0), a2, voffA);
            PG8_WAIT_V(8); PG8_WAIT_L(0); PG8_BAR; PG8_MMA(1, 0, At, B0); PG8_MMA(1, 1, At, B1); PG8_BAR; PG8_SCHED;
            PG8_LDB(B0, 1, 0); PG8_LDB(B1, 1, 1); PG8_SCHED; PG8_LDA(At, 1, 0); PG8_STAGE(PG8_SA(0, 1), a2 + hstep, voffA);
            PG8_WAIT_V(8); PG8_WAIT_L(0); PG8_BAR; PG8_MMA(0, 0, At, B0); PG8_MMA(0, 1, At, B1); PG8_BAR; PG8_SCHED;
            PG8_LDA(At, 1, 1); PG8_STAGE(PG8_SB(1, 0), b3, voffB); PG8_STAGE(PG8_SB(1, 1), b3 + hstep, voffB); PG8_STAGE(PG8_SA(1, 0), a3, voffA);
            PG8_WAIT_V(8); PG8_WAIT_L(0); PG8_BAR; PG8_MMA(1, 0, At, B0); PG8_MMA(1, 1, At, B1); PG8_BAR; PG8_SCHED;
            } else {
            PG8_LDB(B0, 0, 0); PG8_SCHED; PG8_LDA(At, 0, 0); PG8_STAGE(PG8_SA(1, 1), a1 + hstep, voffA);
            PG8_WAIT_L(8); PG8_BAR; PG8_WAIT_L(0); PG8_MMA(0, 0, At, B0); PG8_BAR; PG8_SCHED;
            PG8_LDB(B1, 0, 1); PG8_STAGE(PG8_SB(0, 0), b2, voffB);
            PG8_BAR; PG8_WAIT_L(0); PG8_MMA(0, 1, At, B1); PG8_BAR;
            PG8_LDA(At, 0, 1); PG8_STAGE(PG8_SA(0, 0), a2, voffA);
            PG8_BAR; PG8_WAIT_L(0); PG8_MMA(1, 0, At, B0); PG8_BAR; PG8_SCHED;
            PG8_STAGE(PG8_SB(0, 1), b2 + hstep, voffB);
            PG8_WAIT_V(6); PG8_BAR; PG8_MMA(1, 1, At, B1); PG8_BAR;
            PG8_LDB(B0, 1, 0); PG8_SCHED; PG8_LDA(At, 1, 0); PG8_STAGE(PG8_SA(0, 1), a2 + hstep, voffA);
            PG8_WAIT_L(8); PG8_BAR; PG8_WAIT_L(0); PG8_MMA(0, 0, At, B0); PG8_BAR; PG8_SCHED;
            PG8_LDB(B1, 1, 1); PG8_STAGE(PG8_SB(1, 0), b3, voffB);
            PG8_BAR; PG8_WAIT_L(0); PG8_MMA(0, 1, At, B1); PG8_BAR;
            PG8_LDA(At, 1, 1); PG8_STAGE(PG8_SA(1, 0), a3, voffA);
            PG8_BAR; PG8_WAIT_L(0); PG8_MMA(1, 0, At, B0); PG8_BAR; PG8_SCHED;
            PG8_STAGE(PG8_SB(1, 1), b3 + hstep, voffB);
            PG8_WAIT_V(6); PG8_BAR; PG8_MMA(1, 1, At, B1); PG8_BAR;
            }
        }
        if constexpr (ALIGN_EPI) { if (wr == 0) PG8_BAR; }
        if constexpr (!Epi::AFTER_DRAIN) { E(acc, cur, wr, wc, fr, fq); S.done(cur); }
        if (!has_next) break;
#pragma unroll
        for (int a = 0; a < 2; ++a)
#pragma unroll
            for (int b = 0; b < 2; ++b)
#pragma unroll
                for (int m = 0; m < 4; ++m)
#pragma unroll
                    for (int n = 0; n < 2; ++n) acc[a][b][m][n] = (f32x4){0.f, 0.f, 0.f, 0.f};
        cur = nxt; cA = nA; cB = nB; ++ui;
        if constexpr (ALIGN_EPI) { if (wr == 1) PG8_BAR; }
    }
    PG8_WAIT_V(0);
    if constexpr (!ALIGN_EPI) { if (wr == 0) PG8_BAR; }
    PG8_BAR;
#undef PG8_SA
#undef PG8_SB
#undef PG8_STAGE
#undef PG8_LDA
#undef PG8_LDB
#undef PG8_MMA
#undef PG8_WAIT_V
#undef PG8_WAIT_L
#undef PG8_BAR
#undef PG8_SCHED
}
}

__device__ __forceinline__ void fphase_inproj0(const Args& a, char* lds) {
    pg8::Gemm g{(const bf16_t*)(a.ws + WS_H), (const bf16_t*)(a.ws + WS_WIN0), MTOT, 2048, 1024};
    pg8::StaticOrder S; S.init(MTOT, 2048, (int)gridDim.x, (int)blockIdx.x);
    pg8::EpiInproj0 E{a.ws, a.in[9], a.in[12], a.in[13], (LAS float*)((LAS char*)lds + 131072)};
    pg8::gemm_phase<pg8::EpiInproj0, pg8::StaticOrder, true, true>((LAS unsigned char*)lds, g, S, E);
    const int G = (int)gridDim.x, nbusy = 528 - 2 * G;
    if (G == 256 && (int)blockIdx.x >= nbusy) quant_tables(a, 1, ((int)blockIdx.x - nbusy) * NWAVE + (int)(threadIdx.x >> 6), (G - nbusy) * NWAVE, (int)(threadIdx.x & 63));
    else if (G != 256) quant_tables(a, 1, (int)blockIdx.x * NWAVE + (int)(threadIdx.x >> 6), G * NWAVE, (int)(threadIdx.x & 63));
}
__device__ __forceinline__ void fphase_outproj0(const Args& a, char* lds) {
    pg8::Gemm g{(const bf16_t*)(a.ws + WS_AO), (const bf16_t*)(a.ws + WS_WOUT0), MTOT, 1024, 1024};
    pg8::StaticOrder S; S.init(MTOT, 1024, (int)gridDim.x, (int)blockIdx.x);
    pg8::EpiResid E{a.in[0], a.in[2], (const float*)(a.ws + WS_MODV) + 2 * 1024, (float*)(a.ws + WS_X1), 0};
    pg8::gemm_phase<pg8::EpiResid, pg8::StaticOrder, true, true>((LAS unsigned char*)lds, g, S, E);
    const int G = (int)gridDim.x, nbusy = (G == 256) ? 264 - G : 0;
    if ((int)blockIdx.x >= nbusy) for (int r = (int)blockIdx.x - nbusy; r < N_L1_ITEMS; r += G - nbusy) prep_l1_item(a, (float*)lds, r);
}
__device__ __forceinline__ void fphase_peerq0(const Args& a, char* lds) {
    pg8::Gemm g{(const bf16_t*)(a.ws + WS_H), (const bf16_t*)(a.ws + WS_WQ), MTOT, 2048, 1024};
    pg8::StaticOrder S; S.init(MTOT, 2048, (int)gridDim.x, (int)blockIdx.x);
    pg8::EpiStore E{(bf16_t*)(a.ws + WS_QP), (bf16_t*)(a.ws + WS_QP), 2048, 1000, 0};
    pg8::gemm_phase<pg8::EpiStore, pg8::StaticOrder, true, true>((LAS unsigned char*)lds, g, S, E);
}
__device__ __forceinline__ void fphase_inproj1(const Args& a, char* lds) {
    pg8::Gemm g{(const bf16_t*)(a.ws + WS_H), (const bf16_t*)(a.ws + WS_WIN1), MTOT, 2560, 1024};
    pg8::StaticOrder S; S.init(MTOT, 2560, (int)gridDim.x, (int)blockIdx.x);
    pg8::EpiStore E{(bf16_t*)(a.ws + WS_GG), (bf16_t*)(a.ws + WS_XR), 1280, 5, 5};
    pg8::gemm_phase<pg8::EpiStore, pg8::StaticOrder, true, true>((LAS unsigned char*)lds, g, S, E);
}
__device__ __forceinline__ void fphase_outproj1(const Args& a, char* lds) {
    pg8::Gemm g{(const bf16_t*)(a.ws + WS_YG), (const bf16_t*)(a.ws + WS_WOUT1), MTOT, 1024, 1280};
    pg8::LatentOrder S; S.init(1024, (int)gridDim.x, (int)blockIdx.x);
    pg8::EpiResid E{a.in[0], a.in[2], (const float*)(a.ws + WS_MODV) + 3 * 6144 + 2 * 1024, (float*)(a.ws + WS_X1), 1};
    pg8::gemm_phase<pg8::EpiResid, pg8::LatentOrder, true, true>((LAS unsigned char*)lds, g, S, E);
}
__device__ __forceinline__ void fphase_peerq1(const Args& a, char* lds) {
    pg8::Gemm g{(const bf16_t*)(a.ws + WS_H), (const bf16_t*)(a.ws + WS_WQ) + (size_t)2048 * 1024, MTOT, 2048, 1024};
    pg8::LatentOrder S; S.init(2048, (int)gridDim.x, (int)blockIdx.x);
    pg8::EpiStore E{(bf16_t*)(a.ws + WS_QP), (bf16_t*)(a.ws + WS_QP), 2048, 1000, 0};
    pg8::gemm_phase<pg8::EpiStore, pg8::LatentOrder, true, true>((LAS unsigned char*)lds, g, S, E);
}

constexpr int NPHASE = 23;
__global__ void __launch_bounds__(NTHR, 2) mega(Args a) {
    extern __shared__ __attribute__((aligned(16))) char lds[];
    volatile LAS unsigned* MISC = (volatile LAS unsigned*)((LAS char*)lds + LDS_MISC);
    if (threadIdx.x < 64) MISC[threadIdx.x] = 0u;
    __syncthreads();
    XcdBarrier bar; bar.bar = (unsigned*)(a.ws + WS_CTL) + 4096; bar.x = 0; bar.st = nullptr;
    const bool multi = (a.ph_hi - a.ph_lo) > 1;
    if (multi) bar = xcd_barrier_post((unsigned*)(a.ws + WS_CTL) + 4096, MISC + 8);
    const int lo = a.ph_lo, hi = a.ph_hi;
    unsigned char* ws = a.ws;
#define IN(k) (lo <= (k) && (k) < hi)
#define SEAM(k) do { if (IN(k) && IN((k) + 1)) xcd_barrier(bar); } while (0)
#ifndef PROBE_DUP
#define PROBE_DUP 0u
#endif
#define DUPQ(k) (((PROBE_DUP >> (k)) & 1u) != 0u)
    if (IN(0)) { phase_prep(a, lds); if (DUPQ(0)) { xcd_barrier(bar); phase_prep(a, lds); } } SEAM(0);
    if (IN(1)) { phase_norm(a, 0, 0, a.in[6], 0, 1, false); if (DUPQ(1)) { xcd_barrier(bar); phase_norm(a, 0, 0, a.in[6], 0, 1, false); } } SEAM(1);
    if (IN(2)) { fphase_inproj0(a, lds); if (DUPQ(2)) { xcd_barrier(bar); fphase_inproj0(a, lds); } } SEAM(2);
    if (IN(3)) { phase_gmlp2(a, lds); phase_attn(a, lds); if (DUPQ(3)) { xcd_barrier(bar); phase_gmlp2(a, lds); phase_attn(a, lds); } } SEAM(3);
    if (IN(4)) { fphase_outproj0(a, lds); if (DUPQ(4)) { xcd_barrier(bar); fphase_outproj0(a, lds); } } SEAM(4);
    if (IN(5)) { phase_norm(a, 0, 1, a.in[7], 3, 4, false, true); if (DUPQ(5)) { xcd_barrier(bar); phase_norm(a, 0, 1, a.in[7], 3, 4, false, true); } } SEAM(5);
    if (IN(6)) { fphase_peerq0(a, lds); if (DUPQ(6)) { xcd_barrier(bar); fphase_peerq0(a, lds); } } SEAM(6);
    if (IN(7)) { phase_peer_topk2(a, 0, false); if (DUPQ(7)) { xcd_barrier(bar); phase_peer_topk2(a, 0, false); } } SEAM(7);
    if (IN(8)) { phase_gu(a, lds, 0, 0); if (DUPQ(8)) { xcd_barrier(bar); phase_gu(a, lds, 0, 0); } } SEAM(8);
    if (IN(9)) { phase_gact(a, 0, 0); if (DUPQ(9)) { xcd_barrier(bar); phase_gact(a, 0, 0); } } SEAM(9);
    if (IN(10)) { phase_gv(a, lds, 0, 0); if (DUPQ(10)) { xcd_barrier(bar); phase_gv(a, lds, 0, 0); } } SEAM(10);
    if (IN(11)) { phase_norm(a, 1, 1, a.in[6] + D, 0, 1, false); if (DUPQ(11)) { xcd_barrier(bar); phase_norm(a, 1, 1, a.in[6] + D, 0, 1, false); } } SEAM(11);
    if (IN(12)) { fphase_inproj1(a, lds); if (DUPQ(12)) { xcd_barrier(bar); fphase_inproj1(a, lds); } } SEAM(12);
    if (IN(13)) { phase_rglru2(a, lds, 0); if (DUPQ(13)) { xcd_barrier(bar); phase_rglru2(a, lds, 0); } } SEAM(13);
    if (IN(14)) { phase_rglru2(a, lds, 1); if (DUPQ(14)) { xcd_barrier(bar); phase_rglru2(a, lds, 1); } } SEAM(14);
    if (IN(15)) { fphase_outproj1(a, lds); if (DUPQ(15)) { xcd_barrier(bar); fphase_outproj1(a, lds); } } SEAM(15);
    if (IN(16)) { phase_norm(a, 1, 1, a.in[7] + D, 3, 4, true, true); if (DUPQ(16)) { xcd_barrier(bar); phase_norm(a, 1, 1, a.in[7] + D, 3, 4, true, true); } } SEAM(16);
    if (IN(17)) { fphase_peerq1(a, lds); if (DUPQ(17)) { xcd_barrier(bar); fphase_peerq1(a, lds); } } SEAM(17);
    if (IN(18)) { phase_peer_topk2(a, 1, true); if (DUPQ(18)) { xcd_barrier(bar); phase_peer_topk2(a, 1, true); } } SEAM(18);
    if (IN(19)) { phase_gu(a, lds, 1, 1); if (DUPQ(19)) { xcd_barrier(bar); phase_gu(a, lds, 1, 1); } } SEAM(19);
    if (IN(20)) { phase_gact(a, 1, 1); if (DUPQ(20)) { xcd_barrier(bar); phase_gact(a, 1, 1); } } SEAM(20);
    if (IN(21)) { phase_gv(a, lds, 1, 1); if (DUPQ(21)) { xcd_barrier(bar); phase_gv(a, lds, 1, 1); } } SEAM(21);
    if (IN(22)) { phase_finalnorm(a); if (DUPQ(22)) { xcd_barrier(bar); phase_finalnorm(a); } }
#undef IN
#undef SEAM
}

extern "C" void kernel_launch(void* const* d_in, const int* in_sizes, int n_in, void* d_out, int out_size, void* d_ws, size_t ws_size, hipStream_t stream) {
    static int grid = 0;
    if (grid == 0) {
        if (n_in != 29 || out_size != NB * SEQ * D || ws_size < WS_END) {
            fprintf(stderr, "kernel_launch: unexpected shapes: n_in %d out %d ws %zu (need %zu)\n", n_in, out_size, ws_size, (size_t)WS_END); grid = -1; return; }
        int dev = 0, cus = 0, per_cu = 0;
        if (hipGetDevice(&dev) != hipSuccess || hipDeviceGetAttribute(&cus, hipDeviceAttributeMultiprocessorCount, dev) != hipSuccess) { grid = -1; return; }
        if (hipFuncSetAttribute((const void*)mega, hipFuncAttributeMaxDynamicSharedMemorySize, LDS_BYTES) != hipSuccess) { fprintf(stderr, "kernel_launch: hipFuncSetAttribute failed\n"); grid = -1; return; }
        if (hipOccupancyMaxActiveBlocksPerMultiprocessor(&per_cu, (const void*)mega, NTHR, LDS_BYTES) != hipSuccess || per_cu < 1)
            fprintf(stderr, "kernel_launch: occupancy query reports %d blocks per CU\n", per_cu);
        (void)hipGetLastError();
        grid = cus;
    }
    if (grid < 0) return;
    (void)hipMemsetAsync((char*)d_ws + WS_CTL, 0, CTL_BYTES, stream);
    Args a{};
    for (int i = 0; i < 29; ++i) a.in[i] = (const float*)d_in[i];
    a.out = (float*)d_out; a.ws = (unsigned char*)d_ws;
#if MK_SINGLE
    a.ph_lo = 0; a.ph_hi = NPHASE;
    hipLaunchKernelGGL(mega, dim3(grid), dim3(NTHR), LDS_BYTES, stream, a);
#else
    for (int p = 0; p < NPHASE; ++p) { a.ph_lo = p; a.ph_hi = p + 1; hipLaunchKernelGGL(mega, dim3(grid), dim3(NTHR), LDS_BYTES, stream, a); }
#endif
    const hipError_t le = hipPeekAtLastError();
    if (le != hipSuccess) fprintf(stderr, "kernel_launch: launch failed: %s\n", hipGetErrorName(le));
}
```

```cpp
#include <hip/hip_runtime.h>
#include <cstdio>
#include <cstdint>

#ifndef MK_SINGLE
#define MK_SINGLE 1
#endif

#define GAS __attribute__((address_space(1)))
#define LAS __attribute__((address_space(3)))

typedef unsigned short bf16_t;
typedef short bf16x8 __attribute__((ext_vector_type(8)));
typedef float f32x4 __attribute__((ext_vector_type(4)));
typedef float f32x16 __attribute__((ext_vector_type(16)));
typedef unsigned u32x4 __attribute__((ext_vector_type(4)));
typedef unsigned u32x2 __attribute__((ext_vector_type(2)));

constexpr int D = 1024, NB = 2, SEQ = 8192, CTXL = 256;
constexpr int RPB = SEQ + CTXL;
constexpr int MTOT = NB * RPB;
constexpr int AB_IN = 2048, A_W = 512, DRNN = 1280, NEXP = 16384;
constexpr float EPS = 1e-6f;
constexpr int NTHR = 512, NWAVE = 8;

constexpr size_t MiB = 1u << 20;
constexpr size_t WS_CTL = 0, CTL_BYTES = 1 * MiB;
constexpr size_t WS_MODV = 1 * MiB;
constexpr size_t WS_ROPE = 1 * MiB + 512 * 1024;
constexpr size_t WS_WIN0 = 2 * MiB;
constexpr size_t WS_WOUT0 = 6 * MiB;
constexpr size_t WS_WIN1 = 8 * MiB;
constexpr size_t WS_WOUT1 = 13 * MiB;
constexpr size_t WS_WQ = 16 * MiB;
constexpr size_t WS_KEYS = 24 * MiB;
constexpr size_t WS_GWS = 25 * MiB;
constexpr size_t WS_WAT = 26 * MiB;
constexpr size_t WS_WXT = 27 * MiB;
constexpr size_t WS_CARRY = 28 * MiB;
constexpr size_t WS_SCU = 31 * MiB;
constexpr size_t WS_SCV = 31 * MiB + 512 * 1024;
constexpr size_t WS_PU = 32 * MiB;
constexpr size_t WS_PV = 96 * MiB;
constexpr size_t WS_H = 160 * MiB;
constexpr size_t WS_X1 = 193 * MiB;
constexpr size_t WS_SELI = 259 * MiB;
constexpr size_t WS_SELG = 268 * MiB;
constexpr size_t WS_R = 277 * MiB;
constexpr size_t WS_U = WS_R;
constexpr size_t WS_VV = WS_R + 17 * MiB;
constexpr size_t WS_Q = WS_R + 34 * MiB;
constexpr size_t WS_K = WS_R + 51 * MiB;
constexpr size_t WS_V = WS_R + 60 * MiB;
constexpr size_t WS_AO = WS_R + 69 * MiB;
constexpr size_t WS_QP = WS_R;
constexpr size_t WS_H8 = WS_R + 70 * MiB;
constexpr size_t WS_SH = WS_R + 88 * MiB;
constexpr size_t WS_ACT16 = WS_R + 89 * MiB;
constexpr size_t WS_SA = WS_R + 94 * MiB;
constexpr size_t WS_PART = WS_R;
constexpr size_t WS_GG = WS_R;
constexpr size_t WS_XR = WS_R + 42 * MiB;
constexpr size_t WS_YG = WS_R + 84 * MiB;
constexpr size_t WS_END = WS_R + 126 * MiB;

constexpr int LDS_BYTES = 147456;
constexpr int LDS_MISC = 145408;

__device__ __forceinline__ float bf2f(bf16_t v) { return __uint_as_float(((unsigned)v) << 16); }
__device__ __forceinline__ unsigned f2bf(float f) { unsigned u = __float_as_uint(f); return (u + 0x7fffu + ((u >> 16) & 1u)) >> 16; }
__device__ __forceinline__ unsigned pk2(float lo, float hi) { return f2bf(lo) | (f2bf(hi) << 16); }
__device__ __forceinline__ float bflo(unsigned w) { return __uint_as_float(w << 16); }
__device__ __forceinline__ float bfhi(unsigned w) { return __uint_as_float(w & 0xffff0000u); }
__device__ __forceinline__ float gelu_t(float x) { const float y = -2.302208198144325f * (x + 0.044715f * x * x * x); return x * __builtin_amdgcn_rcpf(1.f + __builtin_amdgcn_exp2f(y)); }
__device__ __forceinline__ float sigmoidf_(float x) { return 1.f / (1.f + __expf(-x)); }
__device__ __forceinline__ float wave_sum(float v) {
#pragma unroll
    for (int o = 1; o < 64; o <<= 1) v += __shfl_xor(v, o);
    return v;
}
__host__ __device__ __forceinline__ int sigma_head(int j) { const int grp = j >> 3, n = (j >> 2) & 1, e = j & 3; return (grp >> 3) * 64 + n * 32 + (grp & 7) * 4 + e; }

struct Args {
    const float* in[29];
    float* out;
    unsigned char* ws;
    int ph_lo, ph_hi;
};

__device__ __forceinline__ int row_variant(int g) { const int b = g / RPB, i = g - b * RPB; return i < CTXL ? 2 : b; }
__device__ __forceinline__ const float* row_src(const Args& a, int g) {
    const int b = g / RPB, i = g - b * RPB;
    return i < CTXL ? a.in[2] + ((size_t)b * CTXL + i) * D : a.in[0] + ((size_t)b * SEQ + (i - CTXL)) * D;
}
__device__ __forceinline__ const float* modv(const Args& a, int layer, int variant, int which) {
    return (const float*)(a.ws + WS_MODV) + ((size_t)(layer * 3 + variant) * 6 + which) * D;
}

#define XB_TMO      128
#define XB_XCNT(j)  (256  + 64 * (j))
#define XB_XSUB(j)  (1280 + 64 * (j))
#define XB_XGEN(j)  (2304 + 64 * (j))
#define XB_TOP      3328
#define XB_TOPGEN   3392
#define XCD_BAR_WORDS 3456
#define XB_SPIN_CAP (1u << 22)
__device__ __forceinline__ unsigned xb_ld(unsigned* p)              { return __hip_atomic_load(p, __ATOMIC_RELAXED, __HIP_MEMORY_SCOPE_AGENT); }
__device__ __forceinline__ unsigned xb_add(unsigned* p, unsigned v) { return __hip_atomic_fetch_add(p, v, __ATOMIC_RELAXED, __HIP_MEMORY_SCOPE_AGENT); }
__device__ __forceinline__ unsigned xb_xcc_id() { return (unsigned)__builtin_amdgcn_s_getreg((3 << 11) | 20) & 0xFu; }
#define XB_SPIN(cond, bar) do { unsigned _sp = 0; while (cond) { __builtin_amdgcn_s_sleep(1); \
    if ((++_sp & 255u) == 0u) { if (xb_ld(&(bar)[XB_TMO])) break; if (_sp > XB_SPIN_CAP) { atomicAdd(&(bar)[XB_TMO], 1u); break; } } } } while (0)
struct XcdBarrier { unsigned* bar; unsigned x; volatile LAS unsigned* st; };
__device__ __forceinline__ XcdBarrier xcd_barrier_post(unsigned* bar, volatile LAS unsigned* st) {
    XcdBarrier b; b.bar = bar; b.x = xb_xcc_id(); b.st = st;
    if (threadIdx.x == 0) (void)xb_add(&bar[XB_XCNT(b.x)], 1u);
    return b;
}
__device__ __forceinline__ void xcd_barrier_complete(unsigned* bar, unsigned x, unsigned& nloc, unsigned& nx) {
    const unsigned G = gridDim.x * gridDim.y * gridDim.z;
    unsigned sum, cnt, mine, sp = 0u;
    for (;;) {
        sum = 0u; cnt = 0u; mine = 0u;
#pragma unroll
        for (unsigned j = 0; j < 16; ++j) { const unsigned c = xb_ld(&bar[XB_XCNT(j)]); sum += c; cnt += (c > 0u) ? 1u : 0u; mine = (j == x) ? c : mine; }
        if (sum == G) break;
        __builtin_amdgcn_s_sleep(1);
        if ((++sp & 255u) == 0u) { if (xb_ld(&bar[XB_TMO])) break; if (sp > XB_SPIN_CAP) { atomicAdd(&bar[XB_TMO], 1u); break; } }
    }
    nloc = mine > 0u ? mine : 1u; nx = cnt > 0u ? cnt : 1u;
}
__device__ __forceinline__ void xcd_barrier(const XcdBarrier& b) {
    asm volatile("s_waitcnt vmcnt(0)" ::: "memory");
    __syncthreads();
    if (threadIdx.x == 0) {
        unsigned* bar = b.bar;
        __builtin_amdgcn_s_waitcnt(0);
        unsigned nloc = b.st[0], nx = b.st[1];
        if (nloc == 0u) { xcd_barrier_complete(bar, b.x, nloc, nx); b.st[0] = nloc; b.st[1] = nx; }
        const unsigned old = xb_add(&bar[XB_XSUB(b.x)], 1u);
        const unsigned gen = old / nloc;
        if (old + 1u == (gen + 1u) * nloc) {
            __builtin_amdgcn_fence(__ATOMIC_RELEASE, "agent");
            asm volatile("s_waitcnt vmcnt(0)" ::: "memory");
            const unsigned og = xb_add(&bar[XB_TOP], 1u);
            const unsigned tg = og / nx;
            if (og + 1u == (tg + 1u) * nx) xb_add(&bar[XB_TOPGEN], 1u);
            else XB_SPIN(xb_ld(&bar[XB_TOPGEN]) == tg, bar);
            __builtin_amdgcn_fence(__ATOMIC_ACQUIRE, "agent");
            xb_add(&bar[XB_XGEN(b.x)], 1u);
            asm volatile("s_waitcnt vmcnt(0)" ::: "memory");
        } else {
            XB_SPIN(xb_ld(&bar[XB_XGEN(b.x)]) == gen, bar);
            __builtin_amdgcn_fence(__ATOMIC_ACQUIRE, "agent");
            asm volatile("s_waitcnt vmcnt(0)" ::: "memory");
        }
    }
    __syncthreads();
}

__device__ __forceinline__ void quant_tables(const Args& a, int layer, int gw, int ngw, int lane) {
    unsigned char* ws = a.ws;
    for (int r = gw; r < 2 * NEXP; r += ngw) {
        const int tb = r / NEXP, ex = r - tb * NEXP, rr = layer * NEXP + ex;
        const float* src = a.in[tb == 0 ? 26 : 27] + (size_t)rr * D;
        f32x4 v[4]; float mx = 0.f;
#pragma unroll
        for (int j = 0; j < 4; ++j) { v[j] = *(const f32x4*)(src + j * 256 + lane * 4); mx = fmaxf(fmaxf(fmaxf(fabsf(v[j].x), fabsf(v[j].y)), fmaxf(fabsf(v[j].z), fabsf(v[j].w))), mx); }
#pragma unroll
        for (int o = 1; o < 64; o <<= 1) mx = fmaxf(mx, __shfl_xor(mx, o));
        mx = fmaxf(mx, 1e-30f);
        const float inv = 127.f / mx;
        unsigned char* dst = ws + (tb == 0 ? WS_PU : WS_PV) + (size_t)layer * NEXP * D + (size_t)ex * 128 + (lane & 31) * 4;
        const int bias = tb == 0 ? 0 : 128;
#pragma unroll
        for (int j = 0; j < 4; ++j) {
            const unsigned b0 = (unsigned)(__float2int_rn(v[j].x * inv) + bias) & 0xffu, b1 = (unsigned)(__float2int_rn(v[j].y * inv) + bias) & 0xffu;
            const unsigned b2 = (unsigned)(__float2int_rn(v[j].z * inv) + bias) & 0xffu, b3 = (unsigned)(__float2int_rn(v[j].w * inv) + bias) & 0xffu;
            *(unsigned*)(dst + (size_t)(2 * j + (lane >> 5)) * NEXP * 128) = b0 | (b1 << 8) | (b2 << 16) | (b3 << 24);
        }
        if (lane == 0) ((float*)(ws + (tb == 0 ? WS_SCU : WS_SCV)))[rr] = mx * (1.f / 127.f);
    }
}
__device__ __forceinline__ void transpose_item(const float* src, int Ns, bf16_t* dst, int Kd, int n0, int k0, int perm_lo, int perm_hi, float* tile) {
    const int tid = threadIdx.x;
    {
        const int nn = tid & 63; int n = n0 + nn;
        if (n >= perm_lo && n < perm_hi) { const int rel = n - perm_lo; n = perm_lo + (rel & ~127) + sigma_head(rel & 127); }
#pragma unroll
        for (int i = 0; i < 8; ++i) { const int kk = (tid >> 6) + 8 * i; tile[kk * 65 + nn] = src[(size_t)(k0 + kk) * Ns + n]; }
    }
    __syncthreads();
    {
        const int n = tid >> 3, kc = (tid & 7) * 8;
        u32x4 o;
        o.x = pk2(tile[(kc + 0) * 65 + n], tile[(kc + 1) * 65 + n]); o.y = pk2(tile[(kc + 2) * 65 + n], tile[(kc + 3) * 65 + n]);
        o.z = pk2(tile[(kc + 4) * 65 + n], tile[(kc + 5) * 65 + n]); o.w = pk2(tile[(kc + 6) * 65 + n], tile[(kc + 7) * 65 + n]);
        *(u32x4*)(dst + (size_t)(n0 + n) * Kd + k0 + kc) = o;
    }
    __syncthreads();
}
__device__ __forceinline__ void cvt_stream(const float* src, bf16_t* dst, size_t n8, size_t gtid, size_t gthreads) {
    for (size_t i = gtid; i < n8; i += gthreads) {
        const f32x4 a = *(const f32x4*)(src + i * 8), b = *(const f32x4*)(src + i * 8 + 4);
        u32x4 o; o.x = pk2(a.x, a.y); o.y = pk2(a.z, a.w); o.z = pk2(b.x, b.y); o.w = pk2(b.z, b.w);
        *(u32x4*)(dst + i * 8) = o;
    }
}
__device__ __forceinline__ void prep_l1_item(const Args& a, float* tile, int r) {
    unsigned char* ws = a.ws;
    constexpr int I_WIN1 = (1024 / 64) * (2560 / 64), I_WOUT1 = (1280 / 64) * (1024 / 64), I_WQ1 = (1024 / 64) * (2048 / 64);
    if (r < I_WIN1) { const int nb = r % 40, kb = r / 40; transpose_item(a.in[15], 2560, (bf16_t*)(ws + WS_WIN1), 1024, nb * 64, kb * 64, 0, 0, tile); return; }
    r -= I_WIN1;
    if (r < I_WOUT1) { const int nb = r % 16, kb = r / 16; transpose_item(a.in[23], 1024, (bf16_t*)(ws + WS_WOUT1), 1280, nb * 64, kb * 64, 0, 0, tile); return; }
    r -= I_WOUT1;
    if (r < I_WQ1) { const int nb = r % 32, kb = r / 32;
        transpose_item(a.in[24] + (size_t)1024 * 2048, 2048, (bf16_t*)(ws + WS_WQ) + (size_t)2048 * 1024, 1024, nb * 64, kb * 64, 0, 0, tile); return; }
    r -= I_WQ1;
    { const int m = r / 4, q = r % 4, nb = q % 2, kb = q / 2;
        const int which = m / 20, dh = m % 20;
        const float* src = a.in[which == 0 ? 18 : 20] + (size_t)dh * 128 * 128;
        bf16_t* dst = (bf16_t*)(ws + (which == 0 ? WS_WAT : WS_WXT)) + (size_t)dh * 128 * 128;
        transpose_item(src, 128, dst, 128, nb * 64, kb * 64, 0, 0, tile);
    }
}
constexpr int N_L1_ITEMS = 640 + 320 + 512 + 160;
__device__ __forceinline__ void phase_prep(const Args& a, char* lds) {
    const int tid = threadIdx.x, lane = tid & 63, wid = tid >> 6;
    float* tile = (float*)lds;
    unsigned char* ws = a.ws;
    constexpr int I_MOD = 192;
    constexpr int I_WIN0 = (1024 / 64) * (2048 / 64), I_WOUT0 = (1024 / 64) * (1024 / 64), I_WQ0 = (1024 / 64) * (2048 / 64);
    constexpr int NIT = I_MOD + I_WIN0 + I_WOUT0 + I_WQ0;
    for (int it = blockIdx.x; it < NIT; it += gridDim.x) {
        int r = it;
        if (r < I_MOD) {
            const int l = r / 96, n0 = (r % 96) * 64;
            const float* W = a.in[4] + (size_t)l * D * 6144;
            float s0 = 0.f, s1 = 0.f, s2 = 0.f;
            float sl[3][2];
#pragma unroll
            for (int h = 0; h < 2; ++h) { const int k = wid * 128 + h * 64 + lane; const float c0 = a.in[1][k], c1 = a.in[1][D + k], c2 = a.in[3][k];
                sl[0][h] = c0 * sigmoidf_(c0); sl[1][h] = c1 * sigmoidf_(c1); sl[2][h] = c2 * sigmoidf_(c2); }
            const float* Wp = W + (size_t)(wid * 128) * 6144 + n0 + lane;
#pragma unroll
            for (int kk = 0; kk < 128; kk += 16) {
                float w[16];
#pragma unroll
                for (int j = 0; j < 16; ++j) w[j] = Wp[(size_t)(kk + j) * 6144];
#pragma unroll
                for (int j = 0; j < 16; ++j) { const int kq = kk + j;
                    s0 += __shfl(sl[0][kq >> 6], kq & 63) * w[j]; s1 += __shfl(sl[1][kq >> 6], kq & 63) * w[j]; s2 += __shfl(sl[2][kq >> 6], kq & 63) * w[j]; }
            }
            tile[(wid * 3 + 0) * 64 + lane] = s0; tile[(wid * 3 + 1) * 64 + lane] = s1; tile[(wid * 3 + 2) * 64 + lane] = s2;
            __syncthreads();
            if (tid < 192) {
                const int v = tid / 64, ln = tid & 63; float s = a.in[5][(size_t)l * 6144 + n0 + ln];
                for (int w = 0; w < 8; ++w) s += tile[(w * 3 + v) * 64 + ln];
                ((float*)(ws + WS_MODV))[(size_t)(l * 3 + v) * 6144 + n0 + ln] = s;
            }
            __syncthreads();
            continue;
        }
        r -= I_MOD;
        if (r < I_WIN0) { const int nb = r % 32, kb = r / 32; transpose_item(a.in[8], 2048, (bf16_t*)(ws + WS_WIN0), 1024, nb * 64, kb * 64, 1024, 1792, tile); continue; }
        r -= I_WIN0;
        if (r < I_WOUT0) { const int nb = r % 16, kb = r / 16; transpose_item(a.in[14], 1024, (bf16_t*)(ws + WS_WOUT0), 1024, nb * 64, kb * 64, 0, 0, tile); continue; }
        r -= I_WOUT0;
        { const int nb = r % 32, kb = r / 32; transpose_item(a.in[24], 2048, (bf16_t*)(ws + WS_WQ), 1024, nb * 64, kb * 64, 0, 0, tile); }
    }
    const size_t gtid = (size_t)blockIdx.x * NTHR + tid, gthreads = (size_t)gridDim.x * NTHR;
    cvt_stream(a.in[25], (bf16_t*)(ws + WS_KEYS), (size_t)2 * 8 * 2 * 128 * 128 / 8, gtid, gthreads);
    cvt_stream(a.in[10], (bf16_t*)(ws + WS_GWS), (size_t)4 * 128 * 128 / 8, gtid, gthreads);
    quant_tables(a, 0, blockIdx.x * NWAVE + wid, gridDim.x * NWAVE, lane);
    for (size_t i = gtid; i < 128 * 32; i += gthreads) {
        const int pos = (int)(i / 32), f = (int)(i % 32);
        const float inv = powf(10000.f, -(float)f / 32.f); const float ang = (float)pos * inv;
        float* R = (float*)(ws + WS_ROPE); R[i * 2] = cosf(ang); R[i * 2 + 1] = sinf(ang);
    }
}

__device__ __forceinline__ void norm_row_store(const f32x4 (&v)[4], const float* g, const float* sh, const float* sc, bf16_t* orow, int lane, unsigned char* q8row = nullptr, float* q8scale = nullptr) {
    float s = 0.f;
#pragma unroll
    for (int j = 0; j < 4; ++j) s += (v[j].x * v[j].x + v[j].y * v[j].y) + (v[j].z * v[j].z + v[j].w * v[j].w);
    const float rinv = rsqrtf(wave_sum(s) * (1.f / D) + EPS);
    f32x4 o[4]; float mx = 0.f;
#pragma unroll
    for (int j = 0; j < 4; ++j) {
        const int c = j * 256 + lane * 4;
        const f32x4 gg = *(const f32x4*)(g + c), s1 = *(const f32x4*)(sh + c), s2 = *(const f32x4*)(sc + c);
        o[j].x = v[j].x * rinv * gg.x * (1.f + s2.x) + s1.x; o[j].y = v[j].y * rinv * gg.y * (1.f + s2.y) + s1.y;
        o[j].z = v[j].z * rinv * gg.z * (1.f + s2.z) + s1.z; o[j].w = v[j].w * rinv * gg.w * (1.f + s2.w) + s1.w;
        u32x2 w; w.x = pk2(o[j].x, o[j].y); w.y = pk2(o[j].z, o[j].w);
        *(u32x2*)(orow + c) = w;
        mx = fmaxf(fmaxf(fmaxf(fabsf(o[j].x), fabsf(o[j].y)), fmaxf(fabsf(o[j].z), fabsf(o[j].w))), mx);
    }
    if (q8row) {
#pragma unroll
        for (int of = 1; of < 64; of <<= 1) mx = fmaxf(mx, __shfl_xor(mx, of));
        mx = fmaxf(mx, 1e-30f); const float inv = 127.f / mx;
#pragma unroll
        for (int j = 0; j < 4; ++j) {
            const unsigned b0 = (unsigned)__float2int_rn(o[j].x * inv) & 0xffu, b1 = (unsigned)__float2int_rn(o[j].y * inv) & 0xffu;
            const unsigned b2 = (unsigned)__float2int_rn(o[j].z * inv) & 0xffu, b3 = (unsigned)__float2int_rn(o[j].w * inv) & 0xffu;
            *(unsigned*)(q8row + j * 256 + lane * 4) = b0 | (b1 << 8) | (b2 << 16) | (b3 << 24);
        }
        if (lane == 0) *q8scale = mx * (1.f / 127.f);
    }
}
__device__ __forceinline__ void phase_norm(const Args& a, int layer, int src_mode, const float* gain, int which_sh, int which_sc, bool latent_only, bool wq8 = false) {
    const int lane = threadIdx.x & 63, gw = blockIdx.x * NWAVE + (threadIdx.x >> 6), ngw = gridDim.x * NWAVE;
    bf16_t* H = (bf16_t*)(a.ws + WS_H);
    const float* X1 = (const float*)(a.ws + WS_X1);
    for (int g = gw; g < MTOT; g += ngw) {
        const int var = row_variant(g);
        if (latent_only && var == 2) continue;
        const float* xr = src_mode == 0 ? row_src(a, g) : X1 + (size_t)g * D;
        f32x4 v[4];
#pragma unroll
        for (int j = 0; j < 4; ++j) v[j] = *(const f32x4*)(xr + j * 256 + lane * 4);
        norm_row_store(v, gain, modv(a, layer, var, which_sh), modv(a, layer, var, which_sc), H + (size_t)g * D, lane, wq8 ? a.ws + WS_H8 + (size_t)g * D : nullptr, wq8 ? (float*)(a.ws + WS_SH) + g : nullptr);
    }
}

constexpr int CS_LD = 132;
__device__ __forceinline__ void gemm_tile128(const bf16_t* A, int lda, const bf16_t* Bt, int ldb, int K, float* Cs) {
    const int tid = threadIdx.x, lane = tid & 63, wid = tid >> 6, r = lane & 31, h = lane >> 5, wr = wid >> 1, wc = wid & 1;
    const bf16_t* ap = A + (size_t)(wr * 32 + r) * lda + 8 * h;
    const bf16_t* bp0 = Bt + (size_t)(wc * 64 + r) * ldb + 8 * h;
    const bf16_t* bp1 = bp0 + (size_t)32 * ldb;
    f32x16 acc0 = {}, acc1 = {};
#pragma unroll 4
    for (int k = 0; k < K; k += 16) {
        const bf16x8 av = *(const bf16x8*)(ap + k), b0 = *(const bf16x8*)(bp0 + k), b1 = *(const bf16x8*)(bp1 + k);
        acc0 = __builtin_amdgcn_mfma_f32_32x32x16_bf16(av, b0, acc0, 0, 0, 0);
        acc1 = __builtin_amdgcn_mfma_f32_32x32x16_bf16(av, b1, acc1, 0, 0, 0);
    }
#pragma unroll
    for (int i = 0; i < 16; ++i) {
        const int row = wr * 32 + (i & 3) + 8 * (i >> 2) + 4 * h;
        Cs[row * CS_LD + wc * 64 + r] = acc0[i];
        Cs[row * CS_LD + wc * 64 + 32 + r] = acc1[i];
    }
}

__device__ __forceinline__ void phase_inproj0(const Args& a, char* lds) {
    float* Cs = (float*)lds;
    const int tid = threadIdx.x;
    unsigned char* ws = a.ws;
    const bf16_t* H = (const bf16_t*)(ws + WS_H); const bf16_t* W = (const bf16_t*)(ws + WS_WIN0);
    const float* rope = (const float*)(ws + WS_ROPE);
    const int NU = (MTOT / 128) * 16;
    for (int u = blockIdx.x; u < NU; u += gridDim.x) {
        const int rt = u / 16, ct = u % 16, row0 = rt * 128, col0 = ct * 128;
        gemm_tile128(H + (size_t)row0 * D, D, W + (size_t)col0 * D, D, D, Cs);
        __syncthreads();
        const int rr = tid >> 2, q4 = tid & 3, g = row0 + rr;
        float* crow = Cs + rr * CS_LD + q4 * 32;
        if (ct < 4) {
            bf16_t* o = (bf16_t*)(ws + WS_U) + (size_t)g * 512 + col0 + q4 * 32;
#pragma unroll
            for (int c = 0; c < 32; c += 2) *(unsigned*)(o + c) = pk2(gelu_t(crow[c]), gelu_t(crow[c + 1]));
        } else if (ct < 8) {
            const int gg = ct - 4; float ss = 0.f;
#pragma unroll
            for (int c = 0; c < 32; ++c) { const float v = gelu_t(crow[c]); crow[c] = v; ss += v * v; }
            ss += __shfl_xor(ss, 1); ss += __shfl_xor(ss, 2);
            const float rinv = rsqrtf(ss * (1.f / 128.f) + EPS);
            const float* gn = a.in[9] + gg * 128 + q4 * 32;
            bf16_t* o = (bf16_t*)(ws + WS_VV) + (size_t)g * 512 + gg * 128 + q4 * 32;
#pragma unroll
            for (int c = 0; c < 32; c += 2) *(unsigned*)(o + c) = pk2(crow[c] * rinv * gn[c], crow[c + 1] * rinv * gn[c + 1]);
        } else if (ct < 14) {
            const bool isq = ct < 12; const int hh = isq ? ct - 8 : ct - 12;
            float ss = 0.f;
#pragma unroll
            for (int c = 0; c < 32; ++c) ss += crow[c] * crow[c];
            ss += __shfl_xor(ss, 1); ss += __shfl_xor(ss, 2);
            const float rinv = rsqrtf(ss * (1.f / 128.f) + EPS);
            const float* gn = a.in[isq ? 12 : 13];
            const int b = g / RPB, i = g - b * RPB; const bool lat = i >= CTXL; const int t = i - CTXL;
            bf16_t* o = (isq ? (bf16_t*)(ws + WS_Q) + (size_t)g * 512 : (bf16_t*)(ws + WS_K) + (size_t)g * 256) + hh * 128 + q4 * 32;
#pragma unroll
            for (int c8 = 0; c8 < 32; c8 += 8) {
                float y[8];
#pragma unroll
                for (int e = 0; e < 8; ++e) { const int j = q4 * 32 + c8 + e; y[e] = crow[c8 + e] * rinv * gn[sigma_head(j)]; }
                if (lat) {
                    const int grp = (q4 * 32 + c8) >> 3, ax = grp >> 3; const int pos = ax == 0 ? (t >> 6) : (t & 63);
#pragma unroll
                    for (int e = 0; e < 4; ++e) { const int f = (grp & 7) * 4 + e; const float cs = rope[(pos * 32 + f) * 2], sn = rope[(pos * 32 + f) * 2 + 1];
                        const float x1 = y[e], x2 = y[e + 4]; y[e] = x1 * cs - x2 * sn; y[e + 4] = x2 * cs + x1 * sn; }
                }
                u32x4 w; w.x = pk2(y[0], y[1]); w.y = pk2(y[2], y[3]); w.z = pk2(y[4], y[5]); w.w = pk2(y[6], y[7]);
                *(u32x4*)(o + c8) = w;
            }
        } else {
            bf16_t* o = (bf16_t*)(ws + WS_V) + (size_t)g * 256 + (ct - 14) * 128 + q4 * 32;
#pragma unroll
            for (int c = 0; c < 32; c += 2) *(unsigned*)(o + c) = pk2(crow[c], crow[c + 1]);
        }
        __syncthreads();
    }
}

__device__ __forceinline__ void phase_gmlp(const Args& a, char* lds) {
    const int tid = threadIdx.x;
    unsigned char* ws = a.ws;
    float* vt = (float*)lds;
    const bf16_t* VV = (const bf16_t*)(ws + WS_VV); const bf16_t* U = (const bf16_t*)(ws + WS_U); bf16_t* AO = (bf16_t*)(ws + WS_AO);
    const int NU = (MTOT / 128) * 4;
    for (int u = blockIdx.x; u < NU; u += gridDim.x) {
        const int ch = u / 4, g = u % 4, row0 = ch * 128;
        for (int i = tid; i < 128 * 128; i += NTHR) { const int q = i >> 7, c = i & 127; vt[i] = bf2f(VV[(size_t)(row0 + q) * 512 + g * 128 + c]); }
        __syncthreads();
        const int c = tid & 127, pq = tid >> 7;
        const float* wsg = a.in[10] + (size_t)g * 128 * 128;
        for (int pp = 0; pp < 32; ++pp) {
            const int p = pq * 32 + pp; float s = 0.f;
            for (int q = 0; q < 128; ++q) s += wsg[p * 128 + q] * vt[q * 128 + c];
            s += a.in[11][g * 128 + p];
            const float uu = bf2f(U[(size_t)(row0 + p) * 512 + g * 128 + c]);
            AO[(size_t)(row0 + p) * 1024 + g * 128 + c] = (bf16_t)f2bf(uu * s);
        }
        __syncthreads();
    }
}

__device__ __forceinline__ void phase_gmlp2(const Args& a, char* lds) {
    const int tid = threadIdx.x, lane = tid & 63, wid = __builtin_amdgcn_readfirstlane(tid >> 6), r32 = lane & 31, hh = lane >> 5;
    unsigned char* ws = a.ws;
    LAS bf16_t* vT = (LAS bf16_t*)((LAS char*)lds);
    const bf16_t* VV = (const bf16_t*)(ws + WS_VV); const bf16_t* U = (const bf16_t*)(ws + WS_U); bf16_t* AO = (bf16_t*)(ws + WS_AO);
    const bf16_t* GWS = (const bf16_t*)(ws + WS_GWS);
    const int NU = (MTOT / 128) * 4;
    for (int u = blockIdx.x; u < NU; u += gridDim.x) {
        const int ch = u >> 2, g = u & 3, row0 = ch * 128;
#pragma unroll
        for (int i = 0; i < 4; ++i) {
            const int q = (tid >> 4) + 32 * i, c0 = (tid & 15) * 8;
            const u32x4 w = *(const u32x4*)(VV + (size_t)(row0 + q) * 512 + g * 128 + c0);
            vT[(c0 + 0) * 136 + q] = (bf16_t)(w.x & 0xffffu); vT[(c0 + 1) * 136 + q] = (bf16_t)(w.x >> 16);
            vT[(c0 + 2) * 136 + q] = (bf16_t)(w.y & 0xffffu); vT[(c0 + 3) * 136 + q] = (bf16_t)(w.y >> 16);
            vT[(c0 + 4) * 136 + q] = (bf16_t)(w.z & 0xffffu); vT[(c0 + 5) * 136 + q] = (bf16_t)(w.z >> 16);
            vT[(c0 + 6) * 136 + q] = (bf16_t)(w.w & 0xffffu); vT[(c0 + 7) * 136 + q] = (bf16_t)(w.w >> 16);
        }
        __syncthreads();
        const int mb = wid >> 1, nb0 = (wid & 1) * 2;
        f32x16 acc0 = {}, acc1 = {};
        {
            unsigned aoff = (unsigned)((mb * 32 + r32) * 128 + 8 * hh); asm volatile("" : "+v"(aoff));
            const bf16_t* wsg = GWS + (size_t)g * 128 * 128;
#pragma unroll
            for (int ks = 0; ks < 8; ++ks) {
                const bf16x8 af = *(const bf16x8*)(wsg + aoff + ks * 16);
                const bf16x8 b0 = *(const LAS bf16x8*)(vT + (nb0 * 32 + r32) * 136 + ks * 16 + 8 * hh);
                const bf16x8 b1 = *(const LAS bf16x8*)(vT + ((nb0 + 1) * 32 + r32) * 136 + ks * 16 + 8 * hh);
                acc0 = __builtin_amdgcn_mfma_f32_32x32x16_bf16(af, b0, acc0, 0, 0, 0);
                acc1 = __builtin_amdgcn_mfma_f32_32x32x16_bf16(af, b1, acc1, 0, 0, 0);
            }
        }
#pragma unroll
        for (int r = 0; r < 16; ++r) {
            const int p = mb * 32 + (r & 3) + 8 * (r >> 2) + 4 * hh;
            const float bsv = a.in[11][g * 128 + p];
            const size_t ub = (size_t)(row0 + p) * 512 + g * 128, ob = (size_t)(row0 + p) * 1024 + g * 128;
            const int c0 = nb0 * 32 + r32, c1 = c0 + 32;
            AO[ob + c0] = (bf16_t)f2bf(bf2f(U[ub + c0]) * (acc0[r] + bsv));
            AO[ob + c1] = (bf16_t)f2bf(bf2f(U[ub + c1]) * (acc1[r] + bsv));
        }
        __syncthreads();
    }
}

__device__ __forceinline__ void phase_attn_naive(const Args& a, char* lds) {
    const int tid = threadIdx.x;
    unsigned char* ws = a.ws;
    float* Ks = (float*)lds;
    float* Vs = Ks + 32 * 128;
    float* part = Vs + 32 * 128;
    const bf16_t* Q = (const bf16_t*)(ws + WS_Q); const bf16_t* Kb = (const bf16_t*)(ws + WS_K); const bf16_t* Vb = (const bf16_t*)(ws + WS_V);
    bf16_t* AO = (bf16_t*)(ws + WS_AO);
    const int NU = 512 + 16;
    for (int u = blockIdx.x; u < NU; u += gridDim.x) {
        int b, h, qrow0, nkeys;
        if (u < 512) { b = u / 256; h = (u / 64) % 4; qrow0 = b * RPB + CTXL + (u % 64) * 128; nkeys = RPB; }
        else { const int v = u - 512; b = v / 8; h = (v / 2) % 4; qrow0 = b * RPB + (v % 2) * 128; nkeys = CTXL; }
        const int kvh = h >> 1, krow0 = b * RPB;
        const int qi = tid & 127, qt = tid >> 7;
        float q[32], o[32];
        {
            const bf16_t* qp = Q + (size_t)(qrow0 + qi) * 512 + h * 128 + qt * 32;
#pragma unroll
            for (int d = 0; d < 32; d += 2) { const unsigned w = *(const unsigned*)(qp + d); q[d] = bflo(w) * 0.08838834764831845f; q[d + 1] = bfhi(w) * 0.08838834764831845f; }
#pragma unroll
            for (int d = 0; d < 32; ++d) o[d] = 0.f;
        }
        float m = -1e30f, l = 0.f;
        for (int k0 = 0; k0 < nkeys; k0 += 32) {
            {
                const int key = tid >> 4, cs = (tid & 15) * 8;
                const u32x4 kw = *(const u32x4*)(Kb + (size_t)(krow0 + k0 + key) * 256 + kvh * 128 + cs);
                const u32x4 vw = *(const u32x4*)(Vb + (size_t)(krow0 + k0 + key) * 256 + kvh * 128 + cs);
                float* kd = Ks + key * 128 + cs; float* vd = Vs + key * 128 + cs;
                kd[0] = bflo(kw.x); kd[1] = bfhi(kw.x); kd[2] = bflo(kw.y); kd[3] = bfhi(kw.y); kd[4] = bflo(kw.z); kd[5] = bfhi(kw.z); kd[6] = bflo(kw.w); kd[7] = bfhi(kw.w);
                vd[0] = bflo(vw.x); vd[1] = bfhi(vw.x); vd[2] = bflo(vw.y); vd[3] = bfhi(vw.y); vd[4] = bflo(vw.z); vd[5] = bfhi(vw.z); vd[6] = bflo(vw.w); vd[7] = bfhi(vw.w);
            }
            __syncthreads();
#pragma unroll 2
            for (int j = 0; j < 32; ++j) {
                const float* kr = Ks + j * 128 + qt * 32; float acc = 0.f;
#pragma unroll
                for (int d = 0; d < 32; d += 4) { const f32x4 kv = *(const f32x4*)(kr + d); acc += q[d] * kv.x + q[d + 1] * kv.y + q[d + 2] * kv.z + q[d + 3] * kv.w; }
                part[(qt * 32 + j) * 128 + qi] = acc;
            }
            __syncthreads();
            float mx = m;
#pragma unroll 4
            for (int j = 0; j < 32; ++j) { const float sj = (part[(0 * 32 + j) * 128 + qi] + part[(1 * 32 + j) * 128 + qi]) + (part[(2 * 32 + j) * 128 + qi] + part[(3 * 32 + j) * 128 + qi]); mx = fmaxf(mx, sj); }
            const float alpha = __expf(m - mx); m = mx; float ps = 0.f;
#pragma unroll
            for (int d = 0; d < 32; ++d) o[d] *= alpha;
#pragma unroll 2
            for (int j = 0; j < 32; ++j) {
                const float sj = (part[(0 * 32 + j) * 128 + qi] + part[(1 * 32 + j) * 128 + qi]) + (part[(2 * 32 + j) * 128 + qi] + part[(3 * 32 + j) * 128 + qi]);
                const float pj = __expf(sj - mx); ps += pj;
                const float* vr = Vs + j * 128 + qt * 32;
#pragma unroll
                for (int d = 0; d < 32; d += 4) { const f32x4 vv = *(const f32x4*)(vr + d); o[d] += pj * vv.x; o[d + 1] += pj * vv.y; o[d + 2] += pj * vv.z; o[d + 3] += pj * vv.w; }
            }
            l = l * alpha + ps;
            __syncthreads();
        }
        const float rl = 1.f / l;
        bf16_t* op = AO + (size_t)(qrow0 + qi) * 1024 + 512 + h * 128 + qt * 32;
#pragma unroll
        for (int d = 0; d < 32; d += 2) *(unsigned*)(op + d) = pk2(o[d] * rl, o[d + 1] * rl);
    }
}

namespace fa {
typedef short s16x4 __attribute__((ext_vector_type(4)));
constexpr int QBLK = 32, KVBLK = 64, LDQ = 512, LDK = 256, LDO = 1024;
constexpr float SCALE = 0.088388347648318440f, THR = 8.f;
constexpr size_t SHM_V = KVBLK * 128 * 2, SHM_K = KVBLK * 128 * 2, SHM_ATTN = 2 * SHM_V + 2 * SHM_K + NWAVE * 64 * 4;
#define KSWZ(row, colB) ((row) * 256 + ((colB) ^ (((row) & 7) << 4)))
#define SBAR() __builtin_amdgcn_sched_barrier(0)
__device__ __forceinline__ int crow(int r, int hi) { return (r & 3) + 8 * (r >> 2) + 4 * hi; }
__device__ __forceinline__ unsigned cvtpk(float lo, float hi) { unsigned r; asm volatile("v_cvt_pk_bf16_f32 %0, %1, %2" : "=v"(r) : "v"(lo), "v"(hi)); return r; }
__device__ __forceinline__ void partialSM(f32x16& p0, f32x16& p1, float& m_reg, float& mn, float& alpha) {
  constexpr float C = SCALE * 1.4426950408889634f;
  float pmax = p0[0]; for (int r = 1; r < 16; ++r) pmax = fmaxf(pmax, p0[r]); for (int r = 0; r < 16; ++r) pmax = fmaxf(pmax, p1[r]);
  { auto rr = __builtin_amdgcn_permlane32_swap(__float_as_uint(pmax), __float_as_uint(pmax), false, false);
    pmax = fmaxf(__uint_as_float(rr[0]), __uint_as_float(rr[1])); }
  if (__builtin_expect(__all(pmax - m_reg <= THR / SCALE), 1)) { mn = m_reg; alpha = 1.f; }
  else { mn = fmaxf(m_reg, pmax); alpha = __builtin_amdgcn_exp2f((m_reg - mn) * C); m_reg = mn; }
  float mnC = -mn * C;
  for (int r = 0; r < 16; ++r) p0[r] = fmaf(p0[r], C, mnC); for (int r = 0; r < 16; ++r) p1[r] = fmaf(p1[r], C, mnC);
  for (int r = 0; r < 16; ++r) p0[r] = __builtin_amdgcn_exp2f(p0[r]);
}
__device__ __forceinline__ void finishSM(f32x16& p0, f32x16& p1, float alpha, float& l_reg, bf16x8& pa0, bf16x8& pa1, bf16x8& pa2, bf16x8& pa3) {
  for (int r = 0; r < 16; ++r) p1[r] = __builtin_amdgcn_exp2f(p1[r]);
  float ps = 0; for (int r = 0; r < 16; ++r) ps += p0[r]; for (int r = 0; r < 16; ++r) ps += p1[r];
  { auto rr = __builtin_amdgcn_permlane32_swap(__float_as_uint(ps), __float_as_uint(ps), false, false);
    ps = __uint_as_float(rr[0]) + __uint_as_float(rr[1]); }
  l_reg = l_reg * alpha + ps;
#define PK4(P, BASE, OUT) do { unsigned a0 = cvtpk(P[BASE + 0], P[BASE + 1]), a1 = cvtpk(P[BASE + 2], P[BASE + 3]);   \
    unsigned b0 = cvtpk(P[BASE + 4], P[BASE + 5]), b1 = cvtpk(P[BASE + 6], P[BASE + 7]);                              \
    auto r0 = __builtin_amdgcn_permlane32_swap(a0, b0, false, false); auto r1 = __builtin_amdgcn_permlane32_swap(a1, b1, false, false); \
    u32x4 w = {r0[0], r1[0], r0[1], r1[1]}; OUT = *reinterpret_cast<bf16x8*>(&w); } while (0)
  PK4(p0, 0, pa0); PK4(p0, 8, pa1); PK4(p1, 0, pa2); PK4(p1, 8, pa3);
#undef PK4
}
__device__ __forceinline__ void qkt(f32x16& p0, f32x16& p1, const bf16_t* Ks, const bf16x8* qr, int r32, int hi) {
  p0 = f32x16{}; p1 = f32x16{};
  for (int d0 = 0; d0 < 8; ++d0) { int cb = (d0 * 16 + hi * 8) * 2;
    bf16x8 b0 = *reinterpret_cast<const bf16x8*>((const char*)Ks + KSWZ(r32, cb));
    bf16x8 b1 = *reinterpret_cast<const bf16x8*>((const char*)Ks + KSWZ(32 + r32, cb));
    p0 = __builtin_amdgcn_mfma_f32_32x32x16_bf16(b0, qr[d0], p0, 0, 0, 0);
    p1 = __builtin_amdgcn_mfma_f32_32x32x16_bf16(b1, qr[d0], p1, 0, 0, 0); }
}
__device__ __forceinline__ int v_st(int k, int c) { const int kk = (k & ~0xC) | ((k & 4) << 1) | ((k & 8) >> 1); return ((kk >> 3) * 4 + (c >> 5)) * 512 + ((kk & 7) * 32 + (c & 31)) * 2; }
__device__ __forceinline__ int v_rd_base(int lane) { return ((lane & 3) << 3) | (((lane >> 2) & 3) << 6) | (((lane >> 4) & 1) << 5) | (((lane >> 5) & 1) << 8); }
constexpr int v_rd_off(int d0, int ks, int half) { return d0 * 512 + ks * 4096 + half * 2048; }
template <int OFF> __device__ __forceinline__ s16x4 tr_read(int vb) {
  s16x4 r; asm volatile("ds_read_b64_tr_b16 %0, %1 offset:%2" : "=&v"(r) : "v"(vb), "i"(OFF) : "memory"); return r;
}
template <int D0> __device__ __forceinline__ void pv_one(f32x16& od, int vb, bf16x8 pa0, bf16x8 pa1, bf16x8 pa2, bf16x8 pa3) {
  const s16x4 l0 = tr_read<v_rd_off(D0, 0, 0)>(vb), h0 = tr_read<v_rd_off(D0, 0, 1)>(vb), l1 = tr_read<v_rd_off(D0, 1, 0)>(vb), h1 = tr_read<v_rd_off(D0, 1, 1)>(vb);
  const s16x4 l2 = tr_read<v_rd_off(D0, 2, 0)>(vb), h2 = tr_read<v_rd_off(D0, 2, 1)>(vb), l3 = tr_read<v_rd_off(D0, 3, 0)>(vb), h3 = tr_read<v_rd_off(D0, 3, 1)>(vb);
  asm volatile("s_waitcnt lgkmcnt(0)" ::: "memory"); SBAR();
#define PK(L, H) (bf16x8){L[0], L[1], L[2], L[3], H[0], H[1], H[2], H[3]}
  od = __builtin_amdgcn_mfma_f32_32x32x16_bf16(pa0, PK(l0, h0), od, 0, 0, 0);
  od = __builtin_amdgcn_mfma_f32_32x32x16_bf16(pa1, PK(l1, h1), od, 0, 0, 0);
  od = __builtin_amdgcn_mfma_f32_32x32x16_bf16(pa2, PK(l2, h2), od, 0, 0, 0);
  od = __builtin_amdgcn_mfma_f32_32x32x16_bf16(pa3, PK(l3, h3), od, 0, 0, 0);
#undef PK
}
__device__ __forceinline__ void pv_d0(f32x16* o, int vb, bf16x8 pa0, bf16x8 pa1, bf16x8 pa2, bf16x8 pa3) {
  pv_one<0>(o[0], vb, pa0, pa1, pa2, pa3); pv_one<1>(o[1], vb, pa0, pa1, pa2, pa3); pv_one<2>(o[2], vb, pa0, pa1, pa2, pa3); pv_one<3>(o[3], vb, pa0, pa1, pa2, pa3);
}
__device__ __forceinline__ void attn_dense_body(const bf16_t* __restrict__ Qb, const bf16_t* __restrict__ Kh, const bf16_t* __restrict__ Vh,
                                                bf16_t* __restrict__ Ob, int seq, char* lds) {
  const int tid = threadIdx.x, wid = tid >> 6, lane = tid & 63, r32 = lane & 31, hi = lane >> 5;
  bf16_t* V_lds = (bf16_t*)lds; bf16_t* K_lds = (bf16_t*)(lds + 2 * SHM_V);
  float* ws = (float*)(lds + 2 * SHM_V + 2 * SHM_K) + wid * 64; float* li_l = ws; float* al_l = ws + 32;
  float m_reg = -1e30f, l_reg = 0; f32x16 o[4] = {}; bf16x8 qr[8];
  const bf16_t* Qw = Qb + (long)(wid * QBLK + r32) * LDQ + hi * 8;
#pragma unroll
  for (int d0 = 0; d0 < 8; ++d0) qr[d0] = *reinterpret_cast<const bf16x8*>(Qw + d0 * 16);
  const int sr = tid >> 4, sc = (tid & 15) * 8, vst0 = v_st(sr, sc), vst1 = v_st(32 + sr, sc);
  const int vb0 = (int)(uintptr_t)V_lds + v_rd_base(lane);
  struct { bf16x8 vs0, vs1, ks0, ks1; } sr_[2];
#define SLOAD(i, k0) do { sr_[i].vs0 = *reinterpret_cast<const bf16x8*>(&Vh[(long)((k0) + sr) * LDK + sc]); sr_[i].vs1 = *reinterpret_cast<const bf16x8*>(&Vh[(long)((k0) + 32 + sr) * LDK + sc]); \
    sr_[i].ks0 = *reinterpret_cast<const bf16x8*>(&Kh[(long)((k0) + sr) * LDK + sc]); sr_[i].ks1 = *reinterpret_cast<const bf16x8*>(&Kh[(long)((k0) + 32 + sr) * LDK + sc]); } while (0)
#define SWRITE(b, i) do { *(bf16x8*)((char*)V_lds + (b) * SHM_V + vst0) = sr_[i].vs0;          \
    *(bf16x8*)((char*)V_lds + (b) * SHM_V + vst1) = sr_[i].vs1; int kc = sc * 2;               \
    *(bf16x8*)((char*)K_lds + (b) * SHM_K + KSWZ(sr, kc)) = sr_[i].ks0;                       \
    *(bf16x8*)((char*)K_lds + (b) * SHM_K + KSWZ(32 + sr, kc)) = sr_[i].ks1; } while (0)
#define SWAIT() asm volatile("s_waitcnt vmcnt(4)" ::: "memory")
#define RESC(a) do { if (__any((a) < 1.f)) { if (hi == 0) al_l[r32] = (a); asm volatile("s_waitcnt lgkmcnt(0)" ::: "memory"); \
    for (int d = 0; d < 4; ++d) for (int r = 0; r < 16; ++r) o[d][r] *= al_l[crow(r, hi)]; } } while (0)
  f32x16 pA0, pA1, pB0, pB1; float mnA, mnB, alA, alB; bf16x8 pa0, pa1, pa2, pa3; const int NT = seq / KVBLK;
  constexpr int SE = 0, SO = 1;
  SLOAD(SE, 0); asm volatile("s_waitcnt vmcnt(0)" ::: "memory"); SWRITE(0, SE); __syncthreads();
  qkt(pA0, pA1, K_lds, qr, r32, hi); partialSM(pA0, pA1, m_reg, mnA, alA);
  SLOAD(SO, KVBLK); if (2 < NT) SLOAD(SE, 2 * KVBLK);
  SWAIT(); SWRITE(1, SO); __syncthreads();
  for (int j = 1; j + 1 < NT; j += 2) {
    SBAR(); qkt(pB0, pB1, (bf16_t*)((char*)K_lds + SHM_K), qr, r32, hi);
    finishSM(pA0, pA1, alA, l_reg, pa0, pa1, pa2, pa3); SBAR();
    SLOAD(SO, (j + 2) * KVBLK); SBAR();
    pv_d0(o, vb0, pa0, pa1, pa2, pa3); partialSM(pB0, pB1, m_reg, mnB, alB);
    __syncthreads(); SWAIT(); SWRITE(0, SE);
    RESC(alB); __syncthreads();
    SBAR(); qkt(pA0, pA1, K_lds, qr, r32, hi);
    finishSM(pB0, pB1, alB, l_reg, pa0, pa1, pa2, pa3); SBAR();
    if (j + 3 < NT) SLOAD(SE, (j + 3) * KVBLK); SBAR();
    pv_d0(o, vb0 + (int)SHM_V, pa0, pa1, pa2, pa3); partialSM(pA0, pA1, m_reg, mnA, alA);
    __syncthreads(); SWAIT(); SWRITE(1, SO);
    RESC(alA); __syncthreads();
  }
  SBAR(); qkt(pB0, pB1, (bf16_t*)((char*)K_lds + SHM_K), qr, r32, hi);
  finishSM(pA0, pA1, alA, l_reg, pa0, pa1, pa2, pa3); SBAR();
  pv_d0(o, vb0, pa0, pa1, pa2, pa3); partialSM(pB0, pB1, m_reg, mnB, alB);
  __syncthreads(); RESC(alB);
  finishSM(pB0, pB1, alB, l_reg, pa0, pa1, pa2, pa3); SBAR();
  pv_d0(o, vb0 + (int)SHM_V, pa0, pa1, pa2, pa3);
  if (hi == 0) li_l[r32] = l_reg; asm volatile("s_waitcnt lgkmcnt(0)" ::: "memory");
  float rli[16];
#pragma unroll
  for (int r = 0; r < 16; ++r) rli[r] = __builtin_amdgcn_rcpf(li_l[crow(r, hi)]);
  bf16_t* Ow = Ob + (long)(wid * QBLK) * LDO;
#pragma unroll
  for (int r = 0; r < 16; ++r) { int orow = crow(r, hi);
    for (int d0 = 0; d0 < 4; ++d0) Ow[(long)orow * LDO + d0 * 32 + r32] = (bf16_t)f2bf(o[d0][r] * rli[r]); }
  __syncthreads();
#undef SLOAD
#undef SWRITE
#undef SWAIT
#undef RESC
}
#undef KSWZ
#undef SBAR
}

__device__ __forceinline__ void phase_attn(const Args& a, char* lds) {
    unsigned char* ws = a.ws;
    const bf16_t* Q = (const bf16_t*)(ws + WS_Q); const bf16_t* Kb = (const bf16_t*)(ws + WS_K); const bf16_t* Vb = (const bf16_t*)(ws + WS_V);
    bf16_t* AO = (bf16_t*)(ws + WS_AO);
    const int NU = 256 + 8;
    for (int u = blockIdx.x; u < NU; u += gridDim.x) {
        int b, h, qrow0, nkeys;
        if (u < 256) { b = u / 128; h = (u / 32) % 4; qrow0 = b * RPB + CTXL + (u % 32) * 256; nkeys = RPB; }
        else { const int v = u - 256; b = v / 4; h = v % 4; qrow0 = b * RPB; nkeys = CTXL; }
        const int kvh = h >> 1; const size_t krow0 = (size_t)b * RPB;
        fa::attn_dense_body(Q + (size_t)qrow0 * 512 + h * 128, Kb + krow0 * 256 + kvh * 128, Vb + krow0 * 256 + kvh * 128, AO + (size_t)qrow0 * 1024 + 512 + h * 128, nkeys, lds);
    }
}

__device__ __forceinline__ void phase_outproj(const Args& a, char* lds, const bf16_t* A, int K, const bf16_t* Bt, int layer, int which_gate, int base_mode, bool latent_only) {
    float* Cs = (float*)lds;
    const int tid = threadIdx.x;
    float* X1 = (float*)(a.ws + WS_X1);
    const int NU = (MTOT / 128) * 8;
    for (int u = blockIdx.x; u < NU; u += gridDim.x) {
        const int rt = u / 8, ct = u % 8, row0 = rt * 128, col0 = ct * 128;
        if (latent_only && (rt % 66) < 2) continue;
        gemm_tile128(A + (size_t)row0 * K, K, Bt + (size_t)col0 * K, K, K, Cs);
        __syncthreads();
        const int rr = tid >> 2, q4 = tid & 3, g = row0 + rr;
        const float* crow = Cs + rr * CS_LD + q4 * 32;
        const float* gt = modv(a, layer, row_variant(g), which_gate) + col0 + q4 * 32;
        const float* base = (base_mode == 0 ? row_src(a, g) : X1 + (size_t)g * D) + col0 + q4 * 32;
        float* o = X1 + (size_t)g * D + col0 + q4 * 32;
#pragma unroll
        for (int c = 0; c < 32; c += 4) {
            const f32x4 bs = *(const f32x4*)(base + c), gv = *(const f32x4*)(gt + c);
            f32x4 r; r.x = bs.x + gv.x * crow[c]; r.y = bs.y + gv.y * crow[c + 1]; r.z = bs.z + gv.z * crow[c + 2]; r.w = bs.w + gv.w * crow[c + 3];
            *(f32x4*)(o + c) = r;
        }
        __syncthreads();
    }
}

__device__ __forceinline__ void phase_peerq(const Args& a, char* lds, int layer, bool latent_only) {
    float* Cs = (float*)lds;
    const int tid = threadIdx.x;
    const bf16_t* H = (const bf16_t*)(a.ws + WS_H); const bf16_t* W = (const bf16_t*)(a.ws + WS_WQ) + (size_t)layer * 2048 * 1024;
    bf16_t* QP = (bf16_t*)(a.ws + WS_QP);
    const int NU = (MTOT / 128) * 16;
    for (int u = blockIdx.x; u < NU; u += gridDim.x) {
        const int rt = u / 16, ct = u % 16, row0 = rt * 128, col0 = ct * 128;
        if (latent_only && (rt % 66) < 2) continue;
        gemm_tile128(H + (size_t)row0 * D, D, W + (size_t)col0 * D, D, D, Cs);
        __syncthreads();
        const int rr = tid >> 2, q4 = tid & 3, g = row0 + rr;
        const float* crow = Cs + rr * CS_LD + q4 * 32;
        bf16_t* o = QP + (size_t)g * 2048 + col0 + q4 * 32;
#pragma unroll
        for (int c = 0; c < 32; c += 2) *(unsigned*)(o + c) = pk2(crow[c], crow[c + 1]);
        __syncthreads();
    }
}

__device__ __forceinline__ void wave_argmax(float& v, int& i) {
#pragma unroll
    for (int o = 1; o < 64; o <<= 1) {
        const float ov = __shfl_xor(v, o); const int oi = __shfl_xor(i, o);
        if (ov > v || (ov == v && oi < i)) { v = ov; i = oi; }
    }
}
__device__ __forceinline__ void phase_peer_topk(const Args& a, int layer, bool latent_only) {
    const int lane = threadIdx.x & 63, gw = blockIdx.x * NWAVE + (threadIdx.x >> 6), ngw = gridDim.x * NWAVE;
    const bf16_t* QP = (const bf16_t*)(a.ws + WS_QP);
    const bf16_t* KEYS = (const bf16_t*)(a.ws + WS_KEYS) + (size_t)layer * 8 * 2 * 128 * 128;
    int* SELI = (int*)(a.ws + WS_SELI); float* SELG = (float*)(a.ws + WS_SELG);
    for (int it = gw; it < MTOT * 8; it += ngw) {
        const int g = it >> 3, h = it & 7;
        if (latent_only && row_variant(g) == 2) continue;
        float tv[2]; int ti[2];
#pragma unroll
        for (int s = 0; s < 2; ++s) {
            const bf16_t* qp = QP + (size_t)g * 2048 + h * 256 + s * 128;
            const bf16_t* k0p = KEYS + ((size_t)(h * 2 + s) * 128 + lane) * 128;
            const bf16_t* k1p = k0p + 64 * 128;
            float s0 = 0.f, s1 = 0.f;
#pragma unroll 4
            for (int d = 0; d < 128; d += 8) {
                const u32x4 qw = *(const u32x4*)(qp + d), ka = *(const u32x4*)(k0p + d), kb = *(const u32x4*)(k1p + d);
                s0 += bflo(qw.x) * bflo(ka.x) + bfhi(qw.x) * bfhi(ka.x) + bflo(qw.y) * bflo(ka.y) + bfhi(qw.y) * bfhi(ka.y)
                    + bflo(qw.z) * bflo(ka.z) + bfhi(qw.z) * bfhi(ka.z) + bflo(qw.w) * bflo(ka.w) + bfhi(qw.w) * bfhi(ka.w);
                s1 += bflo(qw.x) * bflo(kb.x) + bfhi(qw.x) * bfhi(kb.x) + bflo(qw.y) * bflo(kb.y) + bfhi(qw.y) * bfhi(kb.y)
                    + bflo(qw.z) * bflo(kb.z) + bfhi(qw.z) * bfhi(kb.z) + bflo(qw.w) * bflo(kb.w) + bfhi(qw.w) * bfhi(kb.w);
            }
            float myv = 0.f; int myi = 0;
            for (int r = 0; r < 16; ++r) {
                float bv; int bi;
                if (s0 >= s1) { bv = s0; bi = lane; } else { bv = s1; bi = lane + 64; }
                wave_argmax(bv, bi);
                if (bi == lane) s0 = -INFINITY; else if (bi == lane + 64) s1 = -INFINITY;
                if (lane == r) { myv = bv; myi = bi; }
            }
            tv[s] = myv; ti[s] = myi;
        }
        float cv[4]; int ci[4];
        {
            const float v0 = __shfl(tv[0], lane >> 2); const int i0 = __shfl(ti[0], lane >> 2);
#pragma unroll
            for (int m = 0; m < 4; ++m) { const int j = (lane & 3) * 4 + m; cv[m] = v0 + __shfl(tv[1], j); ci[m] = i0 * 128 + __shfl(ti[1], j); }
        }
        float topv = 0.f; int tope = 0;
        for (int r = 0; r < 16; ++r) {
            float bv = cv[0]; int bp = lane * 4;
#pragma unroll
            for (int m = 1; m < 4; ++m) if (cv[m] > bv) { bv = cv[m]; bp = lane * 4 + m; }
            wave_argmax(bv, bp);
            int be = 0;
#pragma unroll
            for (int m = 0; m < 4; ++m) if (bp == lane * 4 + m) { be = ci[m]; cv[m] = -INFINITY; }
            be = __shfl(be, bp >> 2);
            if (lane == r) { topv = bv; tope = be; }
        }
        const float mx = __shfl(topv, 0);
        float e = lane < 16 ? __expf(topv - mx) : 0.f;
        float sum = e;
#pragma unroll
        for (int o = 1; o < 16; o <<= 1) sum += __shfl_xor(sum, o);
        if (lane < 16) { SELI[(size_t)g * 128 + h * 16 + lane] = tope; SELG[(size_t)g * 128 + h * 16 + lane] = e / sum; }
    }
}

namespace tk {
__device__ __forceinline__ void ce(float& a, float& b) { const float mx = __builtin_fmaxf(a, b), mn = __builtin_fminf(a, b); a = mx; b = mn; }
__device__ __forceinline__ void sort16_desc(float (&v)[16]) {
#pragma unroll
    for (int ks = 1; ks <= 4; ++ks)
#pragma unroll
        for (int js = ks - 1; js >= 0; --js)
#pragma unroll
            for (int i = 0; i < 16; ++i) { const int k = 1 << ks, j = 1 << js, l = i ^ j; if (l > i) { if ((i & k) == 0) ce(v[i], v[l]); else ce(v[l], v[i]); } }
}
__device__ __forceinline__ void merge16_desc(float (&v)[16]) {
#pragma unroll
    for (int js = 3; js >= 0; --js)
#pragma unroll
        for (int i = 0; i < 16; ++i) { const int j = 1 << js, l = i ^ j; if (l > i) ce(v[i], v[l]); }
}
__device__ __forceinline__ void merge_prune(float (&x)[16], const float (&y)[16]) {
#pragma unroll
    for (int i = 0; i < 16; ++i) x[i] = __builtin_fmaxf(x[i], y[15 - i]);
    merge16_desc(x);
}
__host__ __device__ constexpr bool pair_ok(int i, int j) { return (i + 1) * (j + 1) <= 16; }
__host__ __device__ constexpr int pair_index(int i, int j) { int n = 0; for (int a = 0; a < 16; ++a) for (int b = 0; b < 16; ++b) { if (a == i && b == j) return n; if (pair_ok(a, b)) ++n; } return n; }
static_assert(pair_index(15, 15) == 49 + 0 || true, "");
}
__device__ __forceinline__ void phase_peer_topk2(const Args& a, int layer, bool latent_only) {
    const int lane = threadIdx.x & 63, r32 = lane & 31, hh = lane >> 5, gw = blockIdx.x * NWAVE + __builtin_amdgcn_readfirstlane(threadIdx.x >> 6), ngw = gridDim.x * NWAVE;
    const bf16_t* QP = (const bf16_t*)(a.ws + WS_QP);
    const bf16_t* KEYS = (const bf16_t*)(a.ws + WS_KEYS) + (size_t)layer * 8 * 2 * 128 * 128;
    int* SELI = (int*)(a.ws + WS_SELI); float* SELG = (float*)(a.ws + WS_SELG);
    const int NIT = (MTOT / 32) * 8;
    for (int it = gw; it < NIT; it += ngw) {
        const int tg = it >> 3, h = it & 7, g0 = tg * 32;
        if (latent_only && row_variant(g0) == 2) continue;
        float top[2][16];
#pragma unroll
        for (int s = 0; s < 2; ++s) {
            bf16x8 qf[8];
            unsigned qoff = (unsigned)(r32 * 2048 + 8 * hh), koff = (unsigned)(r32 * 128 + 8 * hh); asm volatile("" : "+v"(qoff), "+v"(koff));
            const bf16_t* qb = QP + (size_t)g0 * 2048 + h * 256 + s * 128;
#pragma unroll
            for (int k = 0; k < 8; ++k) qf[k] = *(const bf16x8*)(qb + qoff + k * 16);
            float grp[4][16];
#pragma unroll
            for (int kb = 0; kb < 4; ++kb) {
                const bf16_t* kbp = KEYS + (size_t)(h * 2 + s) * 128 * 128 + kb * 32 * 128;
                f32x16 acc = {};
#pragma unroll
                for (int k = 0; k < 8; ++k) { const bf16x8 kf = *(const bf16x8*)(kbp + koff + k * 16); acc = __builtin_amdgcn_mfma_f32_32x32x16_bf16(kf, qf[k], acc, 0, 0, 0); }
#pragma unroll
                for (int r = 0; r < 16; ++r) { const int key = kb * 32 + (r & 3) + 8 * (r >> 2) + 4 * hh; grp[kb][r] = __uint_as_float((__float_as_uint(acc[r]) & ~127u) | (unsigned)key); }
                tk::sort16_desc(grp[kb]); __builtin_amdgcn_sched_barrier(0);
            }
            tk::merge_prune(grp[0], grp[1]); __builtin_amdgcn_sched_barrier(0); tk::merge_prune(grp[2], grp[3]); __builtin_amdgcn_sched_barrier(0); tk::merge_prune(grp[0], grp[2]); __builtin_amdgcn_sched_barrier(0);
            float oth[16];
#pragma unroll
            for (int r = 0; r < 16; ++r) { const auto rr = __builtin_amdgcn_permlane32_swap(__float_as_uint(grp[0][r]), __float_as_uint(grp[0][r]), false, false); oth[r] = __uint_as_float(hh == 0 ? rr[1] : rr[0]); }
            tk::merge_prune(grp[0], oth);
#pragma unroll
            for (int r = 0; r < 16; ++r) top[s][r] = grp[0][r];
            __builtin_amdgcn_sched_barrier(0);
        }
        float cg[4][16];
#pragma unroll
        for (int q = 0; q < 4; ++q)
#pragma unroll
            for (int r = 0; r < 16; ++r) cg[q][r] = -INFINITY;
        cg[0][0] = __uint_as_float((__float_as_uint(top[0][0] + top[1][0]) & ~255u) | 0u);
        cg[0][1] = __uint_as_float((__float_as_uint(top[0][0] + top[1][1]) & ~255u) | 1u);
        cg[0][2] = __uint_as_float((__float_as_uint(top[0][0] + top[1][2]) & ~255u) | 2u);
        cg[0][3] = __uint_as_float((__float_as_uint(top[0][0] + top[1][3]) & ~255u) | 3u);
        cg[0][4] = __uint_as_float((__float_as_uint(top[0][0] + top[1][4]) & ~255u) | 4u);
        cg[0][5] = __uint_as_float((__float_as_uint(top[0][0] + top[1][5]) & ~255u) | 5u);
        cg[0][6] = __uint_as_float((__float_as_uint(top[0][0] + top[1][6]) & ~255u) | 6u);
        cg[0][7] = __uint_as_float((__float_as_uint(top[0][0] + top[1][7]) & ~255u) | 7u);
        cg[0][8] = __uint_as_float((__float_as_uint(top[0][0] + top[1][8]) & ~255u) | 8u);
        cg[0][9] = __uint_as_float((__float_as_uint(top[0][0] + top[1][9]) & ~255u) | 9u);
        cg[0][10] = __uint_as_float((__float_as_uint(top[0][0] + top[1][10]) & ~255u) | 10u);
        cg[0][11] = __uint_as_float((__float_as_uint(top[0][0] + top[1][11]) & ~255u) | 11u);
        cg[0][12] = __uint_as_float((__float_as_uint(top[0][0] + top[1][12]) & ~255u) | 12u);
        cg[0][13] = __uint_as_float((__float_as_uint(top[0][0] + top[1][13]) & ~255u) | 13u);
        cg[0][14] = __uint_as_float((__float_as_uint(top[0][0] + top[1][14]) & ~255u) | 14u);
        cg[0][15] = __uint_as_float((__float_as_uint(top[0][0] + top[1][15]) & ~255u) | 15u);
        cg[1][0] = __uint_as_float((__float_as_uint(top[0][1] + top[1][0]) & ~255u) | 16u);
        cg[1][1] = __uint_as_float((__float_as_uint(top[0][1] + top[1][1]) & ~255u) | 17u);
        cg[1][2] = __uint_as_float((__float_as_uint(top[0][1] + top[1][2]) & ~255u) | 18u);
        cg[1][3] = __uint_as_float((__float_as_uint(top[0][1] + top[1][3]) & ~255u) | 19u);
        cg[1][4] = __uint_as_float((__float_as_uint(top[0][1] + top[1][4]) & ~255u) | 20u);
        cg[1][5] = __uint_as_float((__float_as_uint(top[0][1] + top[1][5]) & ~255u) | 21u);
        cg[1][6] = __uint_as_float((__float_as_uint(top[0][1] + top[1][6]) & ~255u) | 22u);
        cg[1][7] = __uint_as_float((__float_as_uint(top[0][1] + top[1][7]) & ~255u) | 23u);
        cg[1][8] = __uint_as_float((__float_as_uint(top[0][2] + top[1][0]) & ~255u) | 32u);
        cg[1][9] = __uint_as_float((__float_as_uint(top[0][2] + top[1][1]) & ~255u) | 33u);
        cg[1][10] = __uint_as_float((__float_as_uint(top[0][2] + top[1][2]) & ~255u) | 34u);
        cg[1][11] = __uint_as_float((__float_as_uint(top[0][2] + top[1][3]) & ~255u) | 35u);
        cg[1][12] = __uint_as_float((__float_as_uint(top[0][2] + top[1][4]) & ~255u) | 36u);
        cg[1][13] = __uint_as_float((__float_as_uint(top[0][3] + top[1][0]) & ~255u) | 48u);
        cg[1][14] = __uint_as_float((__float_as_uint(top[0][3] + top[1][1]) & ~255u) | 49u);
        cg[1][15] = __uint_as_float((__float_as_uint(top[0][3] + top[1][2]) & ~255u) | 50u);
        cg[2][0] = __uint_as_float((__float_as_uint(top[0][3] + top[1][3]) & ~255u) | 51u);
        cg[2][1] = __uint_as_float((__float_as_uint(top[0][4] + top[1][0]) & ~255u) | 64u);
        cg[2][2] = __uint_as_float((__float_as_uint(top[0][4] + top[1][1]) & ~255u) | 65u);
        cg[2][3] = __uint_as_float((__float_as_uint(top[0][4] + top[1][2]) & ~255u) | 66u);
        cg[2][4] = __uint_as_float((__float_as_uint(top[0][5] + top[1][0]) & ~255u) | 80u);
        cg[2][5] = __uint_as_float((__float_as_uint(top[0][5] + top[1][1]) & ~255u) | 81u);
        cg[2][6] = __uint_as_float((__float_as_uint(top[0][6] + top[1][0]) & ~255u) | 96u);
        cg[2][7] = __uint_as_float((__float_as_uint(top[0][6] + top[1][1]) & ~255u) | 97u);
        cg[2][8] = __uint_as_float((__float_as_uint(top[0][7] + top[1][0]) & ~255u) | 112u);
        cg[2][9] = __uint_as_float((__float_as_uint(top[0][7] + top[1][1]) & ~255u) | 113u);
        cg[2][10] = __uint_as_float((__float_as_uint(top[0][8] + top[1][0]) & ~255u) | 128u);
        cg[2][11] = __uint_as_float((__float_as_uint(top[0][9] + top[1][0]) & ~255u) | 144u);
        cg[2][12] = __uint_as_float((__float_as_uint(top[0][10] + top[1][0]) & ~255u) | 160u);
        cg[2][13] = __uint_as_float((__float_as_uint(top[0][11] + top[1][0]) & ~255u) | 176u);
        cg[2][14] = __uint_as_float((__float_as_uint(top[0][12] + top[1][0]) & ~255u) | 192u);
        cg[2][15] = __uint_as_float((__float_as_uint(top[0][13] + top[1][0]) & ~255u) | 208u);
        cg[3][0] = __uint_as_float((__float_as_uint(top[0][14] + top[1][0]) & ~255u) | 224u);
        cg[3][1] = __uint_as_float((__float_as_uint(top[0][15] + top[1][0]) & ~255u) | 240u);
#pragma unroll
        for (int q = 0; q < 4; ++q) { tk::sort16_desc(cg[q]); __builtin_amdgcn_sched_barrier(0); }
        tk::merge_prune(cg[0], cg[1]); __builtin_amdgcn_sched_barrier(0); tk::merge_prune(cg[2], cg[3]); __builtin_amdgcn_sched_barrier(0); tk::merge_prune(cg[0], cg[2]); __builtin_amdgcn_sched_barrier(0);
        int eidx[16]; float ev[16]; float sum = 0.f;
#pragma unroll
        for (int r = 0; r < 16; ++r) {
            const unsigned bits = __float_as_uint(cg[0][r]); const int ci = (bits >> 4) & 15, cj = bits & 15;
            int ia = 0, ib = 0;
#pragma unroll
            for (int i = 0; i < 16; ++i) { ia = (ci == i) ? (int)(__float_as_uint(top[0][i]) & 127u) : ia; ib = (cj == i) ? (int)(__float_as_uint(top[1][i]) & 127u) : ib; }
            eidx[r] = ia * 128 + ib;
            ev[r] = __expf(cg[0][r] - cg[0][0]); sum += ev[r];
        }
        const float rs = 1.f / sum;
        int* oi = SELI + (size_t)(g0 + r32) * 128 + h * 16 + hh * 8; float* og = SELG + (size_t)(g0 + r32) * 128 + h * 16 + hh * 8;
        if (hh == 0) {
#pragma unroll
            for (int r = 0; r < 8; ++r) { oi[r] = eidx[r]; og[r] = ev[r] * rs; }
        } else {
#pragma unroll
            for (int r = 0; r < 8; ++r) { oi[r] = eidx[8 + r]; og[r] = ev[8 + r] * rs; }
        }
    }
}

__device__ __forceinline__ void phase_peer_gather(const Args& a, int layer, int mode) {
    const int lane = threadIdx.x & 63, gw = blockIdx.x * NWAVE + (threadIdx.x >> 6), ngw = gridDim.x * NWAVE;
    unsigned char* ws = a.ws;
    bf16_t* H = (bf16_t*)(ws + WS_H); float* X1 = (float*)(ws + WS_X1);
    const bf16_t* PU = (const bf16_t*)(ws + WS_PU) + (size_t)layer * NEXP * D; const bf16_t* PV = (const bf16_t*)(ws + WS_PV) + (size_t)layer * NEXP * D;
    const int* SELI = (const int*)(ws + WS_SELI); const float* SELG = (const float*)(ws + WS_SELG);
    for (int g = gw; g < MTOT; g += ngw) {
        const int var = row_variant(g);
        if (mode == 1 && var == 2) continue;
        float hp[16], acc[16];
        {
            const u32x4 w0 = *(const u32x4*)(H + (size_t)g * D + lane * 16), w1 = *(const u32x4*)(H + (size_t)g * D + lane * 16 + 8);
            hp[0] = bflo(w0.x); hp[1] = bfhi(w0.x); hp[2] = bflo(w0.y); hp[3] = bfhi(w0.y); hp[4] = bflo(w0.z); hp[5] = bfhi(w0.z); hp[6] = bflo(w0.w); hp[7] = bfhi(w0.w);
            hp[8] = bflo(w1.x); hp[9] = bfhi(w1.x); hp[10] = bflo(w1.y); hp[11] = bfhi(w1.y); hp[12] = bflo(w1.z); hp[13] = bfhi(w1.z); hp[14] = bflo(w1.w); hp[15] = bfhi(w1.w);
#pragma unroll
            for (int d = 0; d < 16; ++d) acc[d] = 0.f;
        }
        const int myi0 = SELI[(size_t)g * 128 + lane], myi1 = SELI[(size_t)g * 128 + 64 + lane];
        const float myg0 = SELG[(size_t)g * 128 + lane], myg1 = SELG[(size_t)g * 128 + 64 + lane];
        for (int e = 0; e < 128; ++e) {
            const int ei = e < 64 ? __shfl(myi0, e) : __shfl(myi1, e - 64);
            const float eg = e < 64 ? __shfl(myg0, e) : __shfl(myg1, e - 64);
            const bf16_t* up = PU + (size_t)ei * D + lane * 16; const bf16_t* vp = PV + (size_t)ei * D + lane * 16;
            const u32x4 u0 = *(const u32x4*)up, u1 = *(const u32x4*)(up + 8), v0 = *(const u32x4*)vp, v1 = *(const u32x4*)(vp + 8);
            float dt = hp[0] * bflo(u0.x) + hp[1] * bfhi(u0.x) + hp[2] * bflo(u0.y) + hp[3] * bfhi(u0.y) + hp[4] * bflo(u0.z) + hp[5] * bfhi(u0.z) + hp[6] * bflo(u0.w) + hp[7] * bfhi(u0.w)
                     + hp[8] * bflo(u1.x) + hp[9] * bfhi(u1.x) + hp[10] * bflo(u1.y) + hp[11] * bfhi(u1.y) + hp[12] * bflo(u1.z) + hp[13] * bfhi(u1.z) + hp[14] * bflo(u1.w) + hp[15] * bfhi(u1.w);
            dt = wave_sum(dt);
            const float act = gelu_t(dt) * eg;
            acc[0] += act * bflo(v0.x); acc[1] += act * bfhi(v0.x); acc[2] += act * bflo(v0.y); acc[3] += act * bfhi(v0.y);
            acc[4] += act * bflo(v0.z); acc[5] += act * bfhi(v0.z); acc[6] += act * bflo(v0.w); acc[7] += act * bfhi(v0.w);
            acc[8] += act * bflo(v1.x); acc[9] += act * bfhi(v1.x); acc[10] += act * bflo(v1.y); acc[11] += act * bfhi(v1.y);
            acc[12] += act * bflo(v1.z); acc[13] += act * bfhi(v1.z); acc[14] += act * bflo(v1.w); acc[15] += act * bfhi(v1.w);
        }
        float* xr = X1 + (size_t)g * D + lane * 16;
        const float* g2 = modv(a, layer, var, 5) + lane * 16;
        float xn[16]; float ss = 0.f;
#pragma unroll
        for (int d = 0; d < 16; d += 4) {
            const f32x4 xv = *(const f32x4*)(xr + d), gv = *(const f32x4*)(g2 + d);
            xn[d] = xv.x + gv.x * acc[d]; xn[d + 1] = xv.y + gv.y * acc[d + 1]; xn[d + 2] = xv.z + gv.z * acc[d + 2]; xn[d + 3] = xv.w + gv.w * acc[d + 3];
            ss += xn[d] * xn[d] + xn[d + 1] * xn[d + 1] + xn[d + 2] * xn[d + 2] + xn[d + 3] * xn[d + 3];
        }
        const float rinv = rsqrtf(wave_sum(ss) * (1.f / D) + EPS);
        if (mode == 0) {
#pragma unroll
            for (int d = 0; d < 16; d += 4) { f32x4 o; o.x = xn[d]; o.y = xn[d + 1]; o.z = xn[d + 2]; o.w = xn[d + 3]; *(f32x4*)(xr + d) = o; }
            const float* gn = a.in[6] + D + lane * 16; const float* sh = modv(a, 1, var, 0) + lane * 16; const float* sc = modv(a, 1, var, 1) + lane * 16;
            unsigned w[8];
#pragma unroll
            for (int d = 0; d < 16; d += 2) w[d >> 1] = pk2(xn[d] * rinv * gn[d] * (1.f + sc[d]) + sh[d], xn[d + 1] * rinv * gn[d + 1] * (1.f + sc[d + 1]) + sh[d + 1]);
            u32x4 o0, o1; o0.x = w[0]; o0.y = w[1]; o0.z = w[2]; o0.w = w[3]; o1.x = w[4]; o1.y = w[5]; o1.z = w[6]; o1.w = w[7];
            *(u32x4*)(H + (size_t)g * D + lane * 16) = o0; *(u32x4*)(H + (size_t)g * D + lane * 16 + 8) = o1;
        } else {
            const int b = g / RPB, t = g - b * RPB - CTXL;
            float* op = a.out + ((size_t)b * SEQ + t) * D + lane * 16; const float* gn = a.in[28] + lane * 16;
#pragma unroll
            for (int d = 0; d < 16; d += 4) { f32x4 o; o.x = xn[d] * rinv * gn[d]; o.y = xn[d + 1] * rinv * gn[d + 1]; o.z = xn[d + 2] * rinv * gn[d + 2]; o.w = xn[d + 3] * rinv * gn[d + 3]; *(f32x4*)(op + d) = o; }
        }
    }
}

typedef __bf16 bf16x2_t __attribute__((ext_vector_type(2)));
__device__ __forceinline__ float dot2bf(unsigned w, unsigned x, float acc) { return __builtin_amdgcn_fdot2_f32_bf16(__builtin_bit_cast(bf16x2_t, w), __builtin_bit_cast(bf16x2_t, x), acc, false); }
struct Row8 { u32x4 c[8]; };
__device__ __forceinline__ void load_row8(Row8& r, const bf16_t* p) {
#pragma unroll
    for (int c = 0; c < 8; ++c) r.c[c] = *(const u32x4*)(p + c * 128);
}
__device__ __forceinline__ float dot_row8(const Row8& r, const u32x4 (&hp)[8]) {
    float a0 = 0.f, a1 = 0.f, a2 = 0.f, a3 = 0.f;
#pragma unroll
    for (int c = 0; c < 8; ++c) { a0 = dot2bf(r.c[c].x, hp[c].x, a0); a1 = dot2bf(r.c[c].y, hp[c].y, a1); a2 = dot2bf(r.c[c].z, hp[c].z, a2); a3 = dot2bf(r.c[c].w, hp[c].w, a3); }
    float s = (a0 + a1) + (a2 + a3);
    s += __shfl_xor(s, 1); s += __shfl_xor(s, 2); s += __shfl_xor(s, 4); s += __shfl_xor(s, 8);
    return s;
}
__device__ __forceinline__ void fma_row(float (&acc)[16], const u32x4& v0, const u32x4& v1, float a) {
    acc[0] += a * bflo(v0.x); acc[1] += a * bfhi(v0.x); acc[2] += a * bflo(v0.y); acc[3] += a * bfhi(v0.y);
    acc[4] += a * bflo(v0.z); acc[5] += a * bfhi(v0.z); acc[6] += a * bflo(v0.w); acc[7] += a * bfhi(v0.w);
    acc[8] += a * bflo(v1.x); acc[9] += a * bfhi(v1.x); acc[10] += a * bflo(v1.y); acc[11] += a * bfhi(v1.y);
    acc[12] += a * bflo(v1.z); acc[13] += a * bfhi(v1.z); acc[14] += a * bflo(v1.w); acc[15] += a * bfhi(v1.w);
}
__device__ __forceinline__ void phase_peer_gather2(const Args& a, char* lds, int layer, int mode) {
    const int lane = threadIdx.x & 63, wid = threadIdx.x >> 6, gw = blockIdx.x * NWAVE + wid, ngw = gridDim.x * NWAVE;
    const int grp = lane >> 4, sub = lane & 15;
    unsigned char* ws = a.ws;
    bf16_t* H = (bf16_t*)(ws + WS_H); float* X1 = (float*)(ws + WS_X1);
    const bf16_t* PU = (const bf16_t*)(ws + WS_PU) + (size_t)layer * NEXP * D; const bf16_t* PV = (const bf16_t*)(ws + WS_PV) + (size_t)layer * NEXP * D;
    const int* SELI = (const int*)(ws + WS_SELI); const float* SELG = (const float*)(ws + WS_SELG);
    LAS int* lidx = (LAS int*)((LAS char*)lds + wid * 2048);
    LAS float* lgate = (LAS float*)(lidx + 128);
    LAS float* lact = lgate + 128;
    for (int g = gw; g < MTOT; g += ngw) {
        const int var = row_variant(g);
        if (mode == 1 && var == 2) continue;
        lidx[lane] = SELI[(size_t)g * 128 + lane]; lidx[64 + lane] = SELI[(size_t)g * 128 + 64 + lane];
        lgate[lane] = SELG[(size_t)g * 128 + lane]; lgate[64 + lane] = SELG[(size_t)g * 128 + 64 + lane];
        u32x4 hp[8];
#pragma unroll
        for (int c = 0; c < 8; ++c) hp[c] = *(const u32x4*)(H + (size_t)g * D + c * 128 + sub * 8);
        {
            Row8 ra, rb;
            load_row8(ra, PU + (size_t)lidx[grp] * D + sub * 8);
            for (int it = 0; it < 32; it += 2) {
                load_row8(rb, PU + (size_t)lidx[(it + 1) * 4 + grp] * D + sub * 8);
                { const float s = dot_row8(ra, hp); const int e = it * 4 + grp; if (sub == 0) lact[e] = gelu_t(s) * lgate[e]; }
                if (it + 2 < 32) load_row8(ra, PU + (size_t)lidx[(it + 2) * 4 + grp] * D + sub * 8);
                { const float s = dot_row8(rb, hp); const int e = (it + 1) * 4 + grp; if (sub == 0) lact[e] = gelu_t(s) * lgate[e]; }
            }
        }
        float acc[16];
#pragma unroll
        for (int d = 0; d < 16; ++d) acc[d] = 0.f;
        {
            u32x4 va[4][2], vb[4][2];
#pragma unroll
            for (int k = 0; k < 4; ++k) { const bf16_t* p = PV + (size_t)lidx[k] * D + lane * 8; va[k][0] = *(const u32x4*)p; va[k][1] = *(const u32x4*)(p + 512); }
            for (int e = 0; e < 128; e += 8) {
#pragma unroll
                for (int k = 0; k < 4; ++k) { const bf16_t* p = PV + (size_t)lidx[e + 4 + k] * D + lane * 8; vb[k][0] = *(const u32x4*)p; vb[k][1] = *(const u32x4*)(p + 512); }
#pragma unroll
                for (int k = 0; k < 4; ++k) fma_row(acc, va[k][0], va[k][1], lact[e + k]);
                if (e + 8 < 128) {
#pragma unroll
                    for (int k = 0; k < 4; ++k) { const bf16_t* p = PV + (size_t)lidx[e + 8 + k] * D + lane * 8; va[k][0] = *(const u32x4*)p; va[k][1] = *(const u32x4*)(p + 512); }
                }
#pragma unroll
                for (int k = 0; k < 4; ++k) fma_row(acc, vb[k][0], vb[k][1], lact[e + 4 + k]);
            }
        }
        float* xr = X1 + (size_t)g * D + lane * 8;
        const float* g2 = modv(a, layer, var, 5) + lane * 8;
        float xn[16]; float ss = 0.f;
#pragma unroll
        for (int hh = 0; hh < 2; ++hh)
#pragma unroll
            for (int d = 0; d < 8; d += 4) {
                const f32x4 xv = *(const f32x4*)(xr + hh * 512 + d), gv = *(const f32x4*)(g2 + hh * 512 + d);
                const int o = hh * 8 + d;
                xn[o] = xv.x + gv.x * acc[o]; xn[o + 1] = xv.y + gv.y * acc[o + 1]; xn[o + 2] = xv.z + gv.z * acc[o + 2]; xn[o + 3] = xv.w + gv.w * acc[o + 3];
                ss += xn[o] * xn[o] + xn[o + 1] * xn[o + 1] + xn[o + 2] * xn[o + 2] + xn[o + 3] * xn[o + 3];
            }
        const float rinv = rsqrtf(wave_sum(ss) * (1.f / D) + EPS);
        if (mode == 0) {
            const float* gn = a.in[6] + D + lane * 8; const float* sh = modv(a, 1, var, 0) + lane * 8; const float* sc = modv(a, 1, var, 1) + lane * 8;
#pragma unroll
            for (int hh = 0; hh < 2; ++hh) {
                const int o = hh * 8;
                f32x4 o0, o1; o0.x = xn[o]; o0.y = xn[o + 1]; o0.z = xn[o + 2]; o0.w = xn[o + 3]; o1.x = xn[o + 4]; o1.y = xn[o + 5]; o1.z = xn[o + 6]; o1.w = xn[o + 7];
                *(f32x4*)(xr + hh * 512) = o0; *(f32x4*)(xr + hh * 512 + 4) = o1;
                unsigned w[4];
#pragma unroll
                for (int d = 0; d < 8; d += 2) { const int cc = hh * 512 + d; w[d >> 1] = pk2(xn[o + d] * rinv * gn[cc] * (1.f + sc[cc]) + sh[cc], xn[o + d + 1] * rinv * gn[cc + 1] * (1.f + sc[cc + 1]) + sh[cc + 1]); }
                u32x4 ow; ow.x = w[0]; ow.y = w[1]; ow.z = w[2]; ow.w = w[3];
                *(u32x4*)(H + (size_t)g * D + hh * 512 + lane * 8) = ow;
            }
        } else {
            const int b = g / RPB, t = g - b * RPB - CTXL;
            float* op = a.out + ((size_t)b * SEQ + t) * D + lane * 8; const float* gn = a.in[28] + lane * 8;
#pragma unroll
            for (int hh = 0; hh < 2; ++hh)
#pragma unroll
                for (int d = 0; d < 8; d += 4) { const int o = hh * 8 + d, cc = hh * 512 + d;
                    f32x4 ov; ov.x = xn[o] * rinv * gn[cc]; ov.y = xn[o + 1] * rinv * gn[cc + 1]; ov.z = xn[o + 2] * rinv * gn[cc + 2]; ov.w = xn[o + 3] * rinv * gn[cc + 3]; *(f32x4*)(op + cc) = ov; }
        }
    }
}

__device__ __forceinline__ float ub0(unsigned w) { return (float)(w & 0xffu); }
__device__ __forceinline__ float ub1(unsigned w) { return (float)((w >> 8) & 0xffu); }
__device__ __forceinline__ float ub2(unsigned w) { return (float)((w >> 16) & 0xffu); }
__device__ __forceinline__ float ub3(unsigned w) { return (float)(w >> 24); }
struct RowU { u32x4 c[4]; };
__device__ __forceinline__ void load_rowu(RowU& r, const unsigned char* p) {
#pragma unroll
    for (int c = 0; c < 4; ++c) r.c[c] = *(const u32x4*)(p + c * 256);
}
__device__ __forceinline__ float dot_rowu(const RowU& r, const float (&hp)[64]) {
    float a0 = 0.f, a1 = 0.f, a2 = 0.f, a3 = 0.f;
#pragma unroll
    for (int c = 0; c < 4; ++c) {
        const unsigned w0 = r.c[c].x, w1 = r.c[c].y, w2 = r.c[c].z, w3 = r.c[c].w; const int o = c * 16;
        a0 += hp[o + 0] * ub0(w0); a1 += hp[o + 1] * ub1(w0); a2 += hp[o + 2] * ub2(w0); a3 += hp[o + 3] * ub3(w0);
        a0 += hp[o + 4] * ub0(w1); a1 += hp[o + 5] * ub1(w1); a2 += hp[o + 6] * ub2(w1); a3 += hp[o + 7] * ub3(w1);
        a0 += hp[o + 8] * ub0(w2); a1 += hp[o + 9] * ub1(w2); a2 += hp[o + 10] * ub2(w2); a3 += hp[o + 11] * ub3(w2);
        a0 += hp[o + 12] * ub0(w3); a1 += hp[o + 13] * ub1(w3); a2 += hp[o + 14] * ub2(w3); a3 += hp[o + 15] * ub3(w3);
    }
    float s = (a0 + a1) + (a2 + a3);
    s += __shfl_xor(s, 1); s += __shfl_xor(s, 2); s += __shfl_xor(s, 4); s += __shfl_xor(s, 8);
    return s;
}
__device__ __forceinline__ void fma_rowv(float (&acc)[16], const u32x4& v, float a) {
    acc[0] += a * ub0(v.x); acc[1] += a * ub1(v.x); acc[2] += a * ub2(v.x); acc[3] += a * ub3(v.x);
    acc[4] += a * ub0(v.y); acc[5] += a * ub1(v.y); acc[6] += a * ub2(v.y); acc[7] += a * ub3(v.y);
    acc[8] += a * ub0(v.z); acc[9] += a * ub1(v.z); acc[10] += a * ub2(v.z); acc[11] += a * ub3(v.z);
    acc[12] += a * ub0(v.w); acc[13] += a * ub1(v.w); acc[14] += a * ub2(v.w); acc[15] += a * ub3(v.w);
}
__device__ __forceinline__ void phase_peer_gather3(const Args& a, char* lds, int layer, int mode) {
    const int lane = threadIdx.x & 63, wid = __builtin_amdgcn_readfirstlane(threadIdx.x >> 6), gw = blockIdx.x * NWAVE + wid, ngw = gridDim.x * NWAVE;
    const int grp = lane >> 4, sub = lane & 15;
    unsigned char* ws = a.ws;
    bf16_t* H = (bf16_t*)(ws + WS_H); float* X1 = (float*)(ws + WS_X1);
    const unsigned char* PU = ws + WS_PU + (size_t)layer * NEXP * D; const unsigned char* PV = ws + WS_PV + (size_t)layer * NEXP * D;
    const float* SCU = (const float*)(ws + WS_SCU) + layer * NEXP; const float* SCV = (const float*)(ws + WS_SCV) + layer * NEXP;
    const int* SELI = (const int*)(ws + WS_SELI); const float* SELG = (const float*)(ws + WS_SELG);
    LAS int* lidx = (LAS int*)((LAS char*)lds + wid * 2048);
    LAS float* lgu = (LAS float*)(lidx + 128);
    LAS float* lact = lgu + 128;
    for (int g = gw; g < MTOT; g += ngw) {
        const int var = row_variant(g);
        if (mode == 1 && var == 2) continue;
        {
            const int i0 = SELI[(size_t)g * 128 + lane], i1 = SELI[(size_t)g * 128 + 64 + lane];
            lidx[lane] = i0; lidx[64 + lane] = i1;
            lgu[lane] = SCU[i0]; lgu[64 + lane] = SCU[i1];
        }
        float hp[64]; float shp = 0.f;
#pragma unroll
        for (int c = 0; c < 4; ++c) {
            const u32x4 w0 = *(const u32x4*)(H + (size_t)g * D + c * 256 + sub * 16), w1 = *(const u32x4*)(H + (size_t)g * D + c * 256 + sub * 16 + 8);
            const int o = c * 16;
            hp[o + 0] = bflo(w0.x); hp[o + 1] = bfhi(w0.x); hp[o + 2] = bflo(w0.y); hp[o + 3] = bfhi(w0.y); hp[o + 4] = bflo(w0.z); hp[o + 5] = bfhi(w0.z); hp[o + 6] = bflo(w0.w); hp[o + 7] = bfhi(w0.w);
            hp[o + 8] = bflo(w1.x); hp[o + 9] = bfhi(w1.x); hp[o + 10] = bflo(w1.y); hp[o + 11] = bfhi(w1.y); hp[o + 12] = bflo(w1.z); hp[o + 13] = bfhi(w1.z); hp[o + 14] = bflo(w1.w); hp[o + 15] = bfhi(w1.w);
        }
#pragma unroll
        for (int d = 0; d < 64; ++d) shp += hp[d];
        shp += __shfl_xor(shp, 1); shp += __shfl_xor(shp, 2); shp += __shfl_xor(shp, 4); shp += __shfl_xor(shp, 8);
        const float bias = 128.f * shp;
        {
            RowU r0, r1, r2, r3;
            load_rowu(r0, PU + (size_t)lidx[0 * 4 + grp] * D + sub * 16); load_rowu(r1, PU + (size_t)lidx[1 * 4 + grp] * D + sub * 16);
            load_rowu(r2, PU + (size_t)lidx[2 * 4 + grp] * D + sub * 16); load_rowu(r3, PU + (size_t)lidx[3 * 4 + grp] * D + sub * 16);
#define GU_STEP(R, IT) { const float s = dot_rowu(R, hp) - bias; const int e = (IT) * 4 + grp; const float su = lgu[e]; \
                if ((IT) + 4 < 32) load_rowu(R, PU + (size_t)lidx[((IT) + 4) * 4 + grp] * D + sub * 16); \
                if (sub == 0) lact[e] = gelu_t(s * su); }
            for (int it = 0; it < 32; it += 4) { GU_STEP(r0, it) GU_STEP(r1, it + 1) GU_STEP(r2, it + 2) GU_STEP(r3, it + 3) }
#undef GU_STEP
        }
        {
            const float g0 = SELG[(size_t)g * 128 + lane], g1 = SELG[(size_t)g * 128 + 64 + lane];
            const float a0 = lact[lane] * g0 * SCV[lidx[lane]], a1 = lact[64 + lane] * g1 * SCV[lidx[64 + lane]];
            lact[lane] = a0; lact[64 + lane] = a1;
        }
        float acc[16]; float sact = 0.f;
#pragma unroll
        for (int d = 0; d < 16; ++d) acc[d] = 0.f;
        {
            u32x4 va[8];
#pragma unroll
            for (int k = 0; k < 8; ++k) va[k] = *(const u32x4*)(PV + (size_t)lidx[k] * D + lane * 16);
            for (int e = 0; e < 128; e += 8) {
#pragma unroll
                for (int k = 0; k < 8; ++k) {
                    const float av = lact[e + k]; sact += av;
                    fma_rowv(acc, va[k], av);
                    if (e + 8 < 128) va[k] = *(const u32x4*)(PV + (size_t)lidx[e + 8 + k] * D + lane * 16);
                }
            }
        }
        const float vb = 128.f * sact;
        float* xr = X1 + (size_t)g * D + lane * 16;
        const float* g2 = modv(a, layer, var, 5) + lane * 16;
        float xn[16]; float ss = 0.f;
#pragma unroll
        for (int d = 0; d < 16; d += 4) {
            const f32x4 xv = *(const f32x4*)(xr + d), gv = *(const f32x4*)(g2 + d);
            xn[d] = xv.x + gv.x * (acc[d] - vb); xn[d + 1] = xv.y + gv.y * (acc[d + 1] - vb); xn[d + 2] = xv.z + gv.z * (acc[d + 2] - vb); xn[d + 3] = xv.w + gv.w * (acc[d + 3] - vb);
            ss += xn[d] * xn[d] + xn[d + 1] * xn[d + 1] + xn[d + 2] * xn[d + 2] + xn[d + 3] * xn[d + 3];
        }
        const float rinv = rsqrtf(wave_sum(ss) * (1.f / D) + EPS);
        if (mode == 0) {
#pragma unroll
            for (int d = 0; d < 16; d += 4) { f32x4 o; o.x = xn[d]; o.y = xn[d + 1]; o.z = xn[d + 2]; o.w = xn[d + 3]; *(f32x4*)(xr + d) = o; }
            const float* gn = a.in[6] + D + lane * 16; const float* sh = modv(a, 1, var, 0) + lane * 16; const float* sc = modv(a, 1, var, 1) + lane * 16;
            unsigned w[8];
#pragma unroll
            for (int d = 0; d < 16; d += 2) w[d >> 1] = pk2(xn[d] * rinv * gn[d] * (1.f + sc[d]) + sh[d], xn[d + 1] * rinv * gn[d + 1] * (1.f + sc[d + 1]) + sh[d + 1]);
            u32x4 o0, o1; o0.x = w[0]; o0.y = w[1]; o0.z = w[2]; o0.w = w[3]; o1.x = w[4]; o1.y = w[5]; o1.z = w[6]; o1.w = w[7];
            *(u32x4*)(H + (size_t)g * D + lane * 16) = o0; *(u32x4*)(H + (size_t)g * D + lane * 16 + 8) = o1;
        } else {
            const int b = g / RPB, t = g - b * RPB - CTXL;
            float* op = a.out + ((size_t)b * SEQ + t) * D + lane * 16; const float* gn = a.in[28] + lane * 16;
#pragma unroll
            for (int d = 0; d < 16; d += 4) { f32x4 o; o.x = xn[d] * rinv * gn[d]; o.y = xn[d + 1] * rinv * gn[d + 1]; o.z = xn[d + 2] * rinv * gn[d + 2]; o.w = xn[d + 3] * rinv * gn[d + 3]; *(f32x4*)(op + d) = o; }
        }
    }
}

__device__ __forceinline__ int peer_tok(int i, int mode) { return mode == 1 ? i + CTXL + (i >= SEQ ? CTXL : 0) : i; }
__device__ __forceinline__ float dot16u(const u32x4& w, const float (&hp)[16]) {
    float a0 = hp[0] * ub0(w.x) + hp[4] * ub0(w.y), a1 = hp[1] * ub1(w.x) + hp[5] * ub1(w.y), a2 = hp[2] * ub2(w.x) + hp[6] * ub2(w.y), a3 = hp[3] * ub3(w.x) + hp[7] * ub3(w.y);
    a0 += hp[8] * ub0(w.z) + hp[12] * ub0(w.w); a1 += hp[9] * ub1(w.z) + hp[13] * ub1(w.w); a2 += hp[10] * ub2(w.z) + hp[14] * ub2(w.w); a3 += hp[11] * ub3(w.z) + hp[15] * ub3(w.w);
    return (a0 + a1) + (a2 + a3);
}
#define DPP_I(v, ctrl) __builtin_amdgcn_update_dpp(0, (v), (ctrl), 0xf, 0xf, true)
__device__ __forceinline__ int sum8_i(int v) {
    v += DPP_I(v, 0xB1);
    v += DPP_I(v, 0x4E);
    v += DPP_I(v, 0x141);
    return v;
}
__device__ __forceinline__ int sum_eg_i(int v) {
    v += DPP_I(v, 0x128);
    { const auto r = __builtin_amdgcn_permlane16_swap((unsigned)v, (unsigned)v, false, false); v = (int)(r[0] + r[1]); }
    { const auto r = __builtin_amdgcn_permlane32_swap((unsigned)v, (unsigned)v, false, false); v = (int)(r[0] + r[1]); }
    return v;
}
__device__ __forceinline__ void gu_stage(u32x4 (&seg)[16], u32x4& hw, LAS int* lb, int i0, int i1, const unsigned char* hrow, const unsigned char* PUx, int lane, int eg, unsigned loff) {
    lb[lane] = i0; lb[64 + lane] = i1;
    hw = *(const u32x4*)hrow;
#pragma unroll
    for (int st = 0; st < 16; ++st) seg[st] = *(const u32x4*)(PUx + ((unsigned)lb[st * 8 + eg] * 128u + loff));
}
__device__ __forceinline__ void gu_compute(const u32x4 (&seg)[16], const u32x4& hw, LAS float* lpart, float* prow, int lane, int eg, int sub, bool valid) {
#pragma unroll
    for (int st = 0; st < 16; ++st) {
        int d = __builtin_amdgcn_sdot4((int)seg[st].x, (int)hw.x, 0, false);
        d = __builtin_amdgcn_sdot4((int)seg[st].y, (int)hw.y, d, false); d = __builtin_amdgcn_sdot4((int)seg[st].z, (int)hw.z, d, false); d = __builtin_amdgcn_sdot4((int)seg[st].w, (int)hw.w, d, false);
        d = sum8_i(d);
        if (sub == 0) lpart[st * 8 + eg] = (float)d;
    }
    if (valid) { prow[lane] = lpart[lane]; prow[64 + lane] = lpart[64 + lane]; }
}
__device__ __forceinline__ void phase_gu(const Args& a, char* lds, int layer, int mode) {
    const int lane = threadIdx.x & 63, wid = __builtin_amdgcn_readfirstlane(threadIdx.x >> 6), eg = lane >> 3, sub = lane & 7;
    const int x = blockIdx.x & 7, stripe = blockIdx.x >> 3, nstr = (gridDim.x >> 3) * NWAVE, ntok = mode == 1 ? NB * SEQ : MTOT;
    unsigned char* ws = a.ws;
    const unsigned char* H8 = ws + WS_H8 + x * 128 + sub * 16;
    const unsigned char* PUx = ws + WS_PU + (size_t)layer * NEXP * D + (size_t)x * NEXP * 128; const unsigned loff = (unsigned)(sub * 16);
    const int* SELI = (const int*)(ws + WS_SELI); float* PART = (float*)(ws + WS_PART) + (size_t)x * MTOT * 128;
    LAS int* lidx = (LAS int*)((LAS char*)lds + wid * 2048);
    LAS float* lpart = (LAS float*)(lidx + 256);
    const int first = stripe * NWAVE + wid;
#define G_TOK(k) peer_tok(min(first + (k) * nstr, ntok - 1), mode)
#define G_VALID(k) (first + (k) * nstr < ntok)
    u32x4 segA[16], segB[16], hwA, hwB;
    int p0, p1;
    { const int g = G_TOK(0); p0 = SELI[(size_t)g * 128 + lane]; p1 = SELI[(size_t)g * 128 + 64 + lane];
      gu_stage(segA, hwA, lidx, p0, p1, H8 + (size_t)g * D, PUx, lane, eg, loff); }
    { const int g = G_TOK(1); p0 = SELI[(size_t)g * 128 + lane]; p1 = SELI[(size_t)g * 128 + 64 + lane]; }
    for (int k = 0; G_VALID(k); k += 2) {
        { const int g1 = G_TOK(k + 1); gu_stage(segB, hwB, lidx + 128, p0, p1, H8 + (size_t)g1 * D, PUx, lane, eg, loff); }
        { const int g2 = G_TOK(k + 2); p0 = SELI[(size_t)g2 * 128 + lane]; p1 = SELI[(size_t)g2 * 128 + 64 + lane]; }
        gu_compute(segA, hwA, lpart, PART + (size_t)G_TOK(k) * 128, lane, eg, sub, true);
        { const int g2 = G_TOK(k + 2); gu_stage(segA, hwA, lidx, p0, p1, H8 + (size_t)g2 * D, PUx, lane, eg, loff); }
        { const int g3 = G_TOK(k + 3); p0 = SELI[(size_t)g3 * 128 + lane]; p1 = SELI[(size_t)g3 * 128 + 64 + lane]; }
        gu_compute(segB, hwB, lpart, PART + (size_t)G_TOK(k + 1) * 128, lane, eg, sub, G_VALID(k + 1));
    }
}
__device__ __forceinline__ void phase_gact(const Args& a, int layer, int mode) {
    const int lane = threadIdx.x & 63, gw = blockIdx.x * NWAVE + (threadIdx.x >> 6), ngw = gridDim.x * NWAVE, ntok = mode == 1 ? NB * SEQ : MTOT;
    unsigned char* ws = a.ws;
    const float* PART = (const float*)(ws + WS_PART); const int* SELI = (const int*)(ws + WS_SELI); const float* SELG = (const float*)(ws + WS_SELG);
    const float* SCU = (const float*)(ws + WS_SCU) + layer * NEXP; const float* SCV = (const float*)(ws + WS_SCV) + layer * NEXP;
    const float* SH = (const float*)(ws + WS_SH); short* ACT16 = (short*)(ws + WS_ACT16); float* SA = (float*)(ws + WS_SA);
    for (int i = gw; i < ntok; i += ngw) {
        const int g = peer_tok(i, mode);
        const float sh = SH[g];
        float av[2];
#pragma unroll
        for (int hf = 0; hf < 2; ++hf) {
            const size_t o = (size_t)g * 128 + hf * 64 + lane;
            float sdot = 0.f;
#pragma unroll
            for (int xx = 0; xx < 8; ++xx) sdot += PART[(size_t)xx * MTOT * 128 + o];
            const int id = SELI[o];
            av[hf] = gelu_t(sdot * sh * SCU[id]) * SELG[o] * SCV[id];
        }
        float mx = fmaxf(fabsf(av[0]), fabsf(av[1]));
#pragma unroll
        for (int of = 1; of < 64; of <<= 1) mx = fmaxf(mx, __shfl_xor(mx, of));
        mx = fmaxf(mx, 1e-30f); const float inv = 32767.f / mx;
#pragma unroll
        for (int hf = 0; hf < 2; ++hf) {
            const int e = hf * 64 + lane, st = e >> 3, eg = e & 7, pos = (((st >> 1) * 8 + eg) << 1) | (st & 1);
            ACT16[(size_t)g * 128 + pos] = (short)__float2int_rn(av[hf] * inv);
        }
        if (lane == 0) SA[g] = mx * (1.f / 32767.f);
    }
}
__device__ __forceinline__ void gv_stage(u32x4 (&seg)[16], LAS int* lb, int i0, int i1, const unsigned char* PVx, int lane, int eg, unsigned loff) {
    lb[lane] = i0; lb[64 + lane] = i1;
#pragma unroll
    for (int st = 0; st < 16; ++st) seg[st] = *(const u32x4*)(PVx + ((unsigned)lb[st * 8 + eg] * 128u + loff));
}
typedef short s16x2_t __attribute__((ext_vector_type(2)));
__device__ __forceinline__ int dot2i16(unsigned w, unsigned aw, int acc) { return __builtin_amdgcn_sdot2(__builtin_bit_cast(s16x2_t, w), __builtin_bit_cast(s16x2_t, aw), acc, false); }
__device__ __forceinline__ void gv_pair(int (&acc)[16], const u32x4& va, const u32x4& vb, unsigned aw) {
#define GV_D(d, o) acc[o + 0] = dot2i16(__builtin_amdgcn_perm(vb.d, va.d, 0x0c040c00u), aw, acc[o + 0]); acc[o + 1] = dot2i16(__builtin_amdgcn_perm(vb.d, va.d, 0x0c050c01u), aw, acc[o + 1]); \
                   acc[o + 2] = dot2i16(__builtin_amdgcn_perm(vb.d, va.d, 0x0c060c02u), aw, acc[o + 2]); acc[o + 3] = dot2i16(__builtin_amdgcn_perm(vb.d, va.d, 0x0c070c03u), aw, acc[o + 3]);
    GV_D(x, 0) GV_D(y, 4) GV_D(z, 8) GV_D(w, 12)
#undef GV_D
}
__device__ __forceinline__ void gv_compute(const u32x4 (&seg)[16], const unsigned (&aw)[8], float sa, float* xr, const float* g2, int eg, bool valid) {
    int acc[16]; int sq = 0;
#pragma unroll
    for (int k = 0; k < 16; ++k) acc[k] = 0;
#pragma unroll
    for (int s2 = 0; s2 < 8; ++s2) { gv_pair(acc, seg[2 * s2], seg[2 * s2 + 1], aw[s2]); sq += (int)(short)(aw[s2] & 0xffffu) + ((int)aw[s2] >> 16); }
#pragma unroll
    for (int k = 0; k < 16; ++k) acc[k] = sum_eg_i(acc[k]);
    sq = sum_eg_i(sq);
    if (eg == 0 && valid) {
        const int vb = 128 * sq;
#pragma unroll
        for (int d = 0; d < 16; d += 4) {
            const f32x4 xv = *(const f32x4*)(xr + d), gv = *(const f32x4*)(g2 + d);
            f32x4 o; o.x = xv.x + gv.x * (sa * (float)(acc[d] - vb)); o.y = xv.y + gv.y * (sa * (float)(acc[d + 1] - vb)); o.z = xv.z + gv.z * (sa * (float)(acc[d + 2] - vb)); o.w = xv.w + gv.w * (sa * (float)(acc[d + 3] - vb));
            *(f32x4*)(xr + d) = o;
        }
    }
}
__device__ __forceinline__ void phase_gv(const Args& a, char* lds, int layer, int mode) {
    const int lane = threadIdx.x & 63, wid = __builtin_amdgcn_readfirstlane(threadIdx.x >> 6), eg = lane >> 3, sub = lane & 7;
    const int x = blockIdx.x & 7, stripe = blockIdx.x >> 3, nstr = (gridDim.x >> 3) * NWAVE, ntok = mode == 1 ? NB * SEQ : MTOT;
    unsigned char* ws = a.ws;
    float* X1 = (float*)(ws + WS_X1) + x * 128 + sub * 16;
    const unsigned char* PVx = ws + WS_PV + (size_t)layer * NEXP * D + (size_t)x * NEXP * 128; const unsigned loff = (unsigned)(sub * 16);
    const int* SELI = (const int*)(ws + WS_SELI); const unsigned* ACTW = (const unsigned*)(ws + WS_ACT16) + eg; const float* SA = (const float*)(ws + WS_SA);
    LAS int* lidx = (LAS int*)((LAS char*)lds + wid * 2048);
    const int first = stripe * NWAVE + wid;
    u32x4 segA[16], segB[16];
    unsigned awA[8], awB[8]; float saA, saB;
    int p0, p1;
#define GV_PREF(k) { const int g_ = G_TOK(k); p0 = SELI[(size_t)g_ * 128 + lane]; p1 = SELI[(size_t)g_ * 128 + 64 + lane]; }
#define GV_AW(AW, SAV, k) { const int g_ = G_TOK(k); _Pragma("unroll") for (int s2 = 0; s2 < 8; ++s2) AW[s2] = ACTW[(size_t)g_ * 64 + s2 * 8]; SAV = SA[g_]; }
#define GV_G2(k) (modv(a, layer, row_variant(G_TOK(k)), 5) + x * 128 + sub * 16)
    GV_PREF(0) gv_stage(segA, lidx, p0, p1, PVx, lane, eg, loff); GV_AW(awA, saA, 0)
    GV_PREF(1)
    for (int k = 0; G_VALID(k); k += 2) {
        gv_stage(segB, lidx + 128, p0, p1, PVx, lane, eg, loff); GV_AW(awB, saB, k + 1)
        GV_PREF(k + 2)
        gv_compute(segA, awA, saA, X1 + (size_t)G_TOK(k) * D, GV_G2(k), eg, true);
        gv_stage(segA, lidx, p0, p1, PVx, lane, eg, loff); GV_AW(awA, saA, k + 2)
        GV_PREF(k + 3)
        gv_compute(segB, awB, saB, X1 + (size_t)G_TOK(k + 1) * D, GV_G2(k + 1), eg, G_VALID(k + 1));
    }
#undef GV_PREF
#undef GV_AW
#undef GV_G2
#undef G_TOK
#undef G_VALID
}
__device__ __forceinline__ void phase_finalnorm(const Args& a) {
    const int lane = threadIdx.x & 63, gw = blockIdx.x * NWAVE + (threadIdx.x >> 6), ngw = gridDim.x * NWAVE;
    const float* X1 = (const float*)(a.ws + WS_X1);
    for (int i = gw; i < NB * SEQ; i += ngw) {
        const int g = peer_tok(i, 1);
        const float* xr = X1 + (size_t)g * D; float* op = a.out + (size_t)i * D;
        f32x4 v[4]; float ss = 0.f;
#pragma unroll
        for (int j = 0; j < 4; ++j) { v[j] = *(const f32x4*)(xr + j * 256 + lane * 4); ss += (v[j].x * v[j].x + v[j].y * v[j].y) + (v[j].z * v[j].z + v[j].w * v[j].w); }
        const float rinv = rsqrtf(wave_sum(ss) * (1.f / D) + EPS);
#pragma unroll
        for (int j = 0; j < 4; ++j) { const f32x4 gn = *(const f32x4*)(a.in[28] + j * 256 + lane * 4); *(f32x4*)(op + j * 256 + lane * 4) = v[j] * rinv * gn; }
    }
}

__device__ __forceinline__ void phase_inproj1(const Args& a, char* lds) {
    float* Cs = (float*)lds;
    const int tid = threadIdx.x;
    const bf16_t* H = (const bf16_t*)(a.ws + WS_H); const bf16_t* W = (const bf16_t*)(a.ws + WS_WIN1);
    const int NU = (MTOT / 128) * 20;
    for (int u = blockIdx.x; u < NU; u += gridDim.x) {
        const int rt = u / 20, ct = u % 20, row0 = rt * 128, col0 = ct * 128;
        if (ct < 10 && (rt % 66) < 2) continue;
        gemm_tile128(H + (size_t)row0 * D, D, W + (size_t)col0 * D, D, D, Cs);
        __syncthreads();
        const int rr = tid >> 2, q4 = tid & 3, g = row0 + rr;
        const float* crow = Cs + rr * CS_LD + q4 * 32;
        if (ct < 10) {
            bf16_t* o = (bf16_t*)(a.ws + WS_GG) + (size_t)g * DRNN + col0 + q4 * 32;
#pragma unroll
            for (int c = 0; c < 32; c += 2) *(unsigned*)(o + c) = pk2(gelu_t(crow[c]), gelu_t(crow[c + 1]));
        } else {
            bf16_t* o = (bf16_t*)(a.ws + WS_XR) + (size_t)g * DRNN + (col0 - DRNN) + q4 * 32;
#pragma unroll
            for (int c = 0; c < 32; c += 2) *(unsigned*)(o + c) = pk2(crow[c], crow[c + 1]);
        }
        __syncthreads();
    }
}

__device__ __forceinline__ void phase_rglru(const Args& a, char* lds, int pass) {
    const int tid = threadIdx.x;
    unsigned char* ws = a.ws;
    float* xc = (float*)lds;
    float* seg = xc + 128 * 128;
    const bf16_t* XR = (const bf16_t*)(ws + WS_XR); const bf16_t* GG = (const bf16_t*)(ws + WS_GG); bf16_t* YG = (bf16_t*)(ws + WS_YG);
    float* CARRY = (float*)(ws + WS_CARRY);
    const int j = tid & 127, tq = tid >> 7;
    const int NU = (MTOT / 128) * 10;
    for (int u = blockIdx.x; u < NU; u += gridDim.x) {
        const int T = u / 10, hb = u % 10, b = T / 66, tl = T % 66, row0 = T * 128, ch = hb * 128 + j;
        if (pass == 1 && tl < 2) continue;
        const int seq_lo = tl < 2 ? b * RPB : b * RPB + CTXL, seq_hi = tl < 2 ? b * RPB + CTXL : (b + 1) * RPB;
        {
            const float w0 = a.in[16][0 * DRNN + ch], w1 = a.in[16][1 * DRNN + ch], w2 = a.in[16][2 * DRNN + ch], w3 = a.in[16][3 * DRNN + ch], cb = a.in[17][ch];
            for (int tt = 0; tt < 32; ++tt) {
                const int g = row0 + tq * 32 + tt;
                const float xm2 = (g - 2 >= seq_lo) ? bf2f(XR[(size_t)(g - 2) * DRNN + ch]) : 0.f;
                const float xm1 = (g - 1 >= seq_lo) ? bf2f(XR[(size_t)(g - 1) * DRNN + ch]) : 0.f;
                const float x0 = bf2f(XR[(size_t)g * DRNN + ch]);
                const float xp1 = (g + 1 < seq_hi) ? bf2f(XR[(size_t)(g + 1) * DRNN + ch]) : 0.f;
                xc[(tq * 32 + tt) * 128 + j] = w0 * xm2 + w1 * xm1 + w2 * x0 + w3 * xp1 + cb;
            }
        }
        __syncthreads();
        float acc[4][32];
#pragma unroll
        for (int m = 0; m < 4; ++m)
#pragma unroll
            for (int tt = 0; tt < 32; ++tt) acc[m][tt] = 0.f;
        {
            const float* wa0 = a.in[18] + ((size_t)(0 * 10 + hb) * 128) * 128 + j; const float* wx0 = a.in[20] + ((size_t)(0 * 10 + hb) * 128) * 128 + j;
            const float* wa1 = a.in[18] + ((size_t)(1 * 10 + hb) * 128) * 128 + j; const float* wx1 = a.in[20] + ((size_t)(1 * 10 + hb) * 128) * 128 + j;
            for (int i = 0; i < 128; ++i) {
                const float w0 = wa0[i * 128], w1 = wx0[i * 128], w2 = wa1[i * 128], w3 = wx1[i * 128];
#pragma unroll
                for (int tt = 0; tt < 32; ++tt) { const float x = xc[(tq * 32 + tt) * 128 + i]; acc[0][tt] += x * w0; acc[1][tt] += x * w1; acc[2][tt] += x * w2; acc[3][tt] += x * w3; }
            }
        }
#pragma unroll
        for (int d = 0; d < 2; ++d) {
            const float ba = a.in[19][d * DRNN + ch], bx = a.in[21][d * DRNN + ch], lam = a.in[22][d * DRNN + ch];
            const float sp = log1pf(__expf(-lam));
#pragma unroll
            for (int tt = 0; tt < 32; ++tt) {
                const float r = sigmoidf_(acc[2 * d][tt] + ba), ig = sigmoidf_(acc[2 * d + 1][tt] + bx);
                const float la = -8.f * r * sp; const float av = __expf(la);
                const float uv = sqrtf(fmaxf(-expm1f(2.f * la), 0.f)) * ig * xc[(tq * 32 + tt) * 128 + j];
                acc[2 * d][tt] = av; acc[2 * d + 1][tt] = uv;
            }
        }
        {
            float Af = 1.f, Hf = 0.f, Ab = 1.f, Hb = 0.f;
#pragma unroll
            for (int tt = 0; tt < 32; ++tt) { Hf = acc[0][tt] * Hf + acc[1][tt]; Af *= acc[0][tt]; }
#pragma unroll
            for (int tt = 31; tt >= 0; --tt) { Hb = acc[2][tt] * Hb + acc[3][tt]; Ab *= acc[2][tt]; }
            seg[((0 * 4 + tq) * 128 + j) * 2] = Af; seg[((0 * 4 + tq) * 128 + j) * 2 + 1] = Hf;
            seg[((1 * 4 + tq) * 128 + j) * 2] = Ab; seg[((1 * 4 + tq) * 128 + j) * 2 + 1] = Hb;
        }
        __syncthreads();
        if (pass == 0) {
            if (tq == 0) {
                float A = 1.f, Hh = 0.f;
                for (int s = 0; s < 4; ++s) { const float sa = seg[((0 * 4 + s) * 128 + j) * 2], sh = seg[((0 * 4 + s) * 128 + j) * 2 + 1]; Hh = sa * Hh + sh; A *= sa; }
                float* c0 = CARRY + (((size_t)(b * 2 + 0) * 66 + tl) * DRNN + ch) * 2; c0[0] = A; c0[1] = Hh;
                A = 1.f; Hh = 0.f;
                for (int s = 3; s >= 0; --s) { const float sa = seg[((1 * 4 + s) * 128 + j) * 2], sh = seg[((1 * 4 + s) * 128 + j) * 2 + 1]; Hh = sa * Hh + sh; A *= sa; }
                float* c1 = CARRY + (((size_t)(b * 2 + 1) * 66 + tl) * DRNN + ch) * 2; c1[0] = A; c1[1] = Hh;
            }
        } else {
            float hf = 0.f, hbk = 0.f;
            for (int t2 = 0; t2 < tl; ++t2) { const float* c = CARRY + (((size_t)(b * 2 + 0) * 66 + t2) * DRNN + ch) * 2; hf = c[0] * hf + c[1]; }
            { const float* c = CARRY + (((size_t)(b * 2 + 1) * 66 + 1) * DRNN + ch) * 2; hbk = c[0] * hbk + c[1]; }
            { const float* c = CARRY + (((size_t)(b * 2 + 1) * 66 + 0) * DRNN + ch) * 2; hbk = c[0] * hbk + c[1]; }
            for (int t2 = 65; t2 > tl; --t2) { const float* c = CARRY + (((size_t)(b * 2 + 1) * 66 + t2) * DRNN + ch) * 2; hbk = c[0] * hbk + c[1]; }
            for (int s = 0; s < tq; ++s) { const float sa = seg[((0 * 4 + s) * 128 + j) * 2], sh = seg[((0 * 4 + s) * 128 + j) * 2 + 1]; hf = sa * hf + sh; }
            for (int s = 3; s > tq; --s) { const float sa = seg[((1 * 4 + s) * 128 + j) * 2], sh = seg[((1 * 4 + s) * 128 + j) * 2 + 1]; hbk = sa * hbk + sh; }
#pragma unroll
            for (int tt = 0; tt < 32; ++tt) { hf = acc[0][tt] * hf + acc[1][tt]; acc[0][tt] = hf; }
#pragma unroll
            for (int tt = 31; tt >= 0; --tt) { hbk = acc[2][tt] * hbk + acc[3][tt]; acc[0][tt] += hbk; }
#pragma unroll
            for (int tt = 0; tt < 32; ++tt) {
                const int g = row0 + tq * 32 + tt;
                YG[(size_t)g * DRNN + ch] = (bf16_t)f2bf(acc[0][tt] * bf2f(GG[(size_t)g * DRNN + ch]));
            }
        }
        __syncthreads();
    }
}

constexpr int XC_LD = 136;
__device__ __forceinline__ float exp2_fast(float x) { return __builtin_amdgcn_exp2f(x); }
__device__ __forceinline__ float sigm_fast(float x) { return __builtin_amdgcn_rcpf(1.f + __builtin_amdgcn_exp2f(-1.4426950408889634f * x)); }
__device__ __forceinline__ void phase_rglru2(const Args& a, char* lds, int pass) {
    const int tid_ = threadIdx.x, wid = __builtin_amdgcn_readfirstlane(tid_ >> 6);
    const int nb = wid & 3, dir = wid >> 2;
    unsigned char* ws = a.ws;
    LAS bf16_t* xcA = (LAS bf16_t*)((LAS char*)lds);
    LAS float* HS = (LAS float*)((LAS char*)lds + 36864);
    const bf16_t* XR = (const bf16_t*)(ws + WS_XR); const bf16_t* GG = (const bf16_t*)(ws + WS_GG); bf16_t* YG = (bf16_t*)(ws + WS_YG);
    float* CARRY = (float*)(ws + WS_CARRY);
    const int NU = (MTOT / 128) * 10;
    for (int u = blockIdx.x; u < NU; u += gridDim.x) {
        const int T = u / 10, hb = u % 10, b = T / 66, tl = T % 66, row0 = T * 128;
        if (pass == 1 && tl < 2) continue;
        int tid = tid_; asm volatile("" : "+v"(tid));
        const int lane = tid & 63, r32 = lane & 31, hh = lane >> 5;
        const int seq_lo = tl < 2 ? b * RPB : b * RPB + CTXL, seq_hi = tl < 2 ? b * RPB + CTXL : (b + 1) * RPB;
        float h0 = 0.f;
        if (pass == 1) {
            typedef float f32x2 __attribute__((ext_vector_type(2)));
            const int chl = hb * 128 + nb * 32 + r32;
            const int pos = dir == 0 ? tl : 67 - tl;
            const float* cbase = CARRY + ((size_t)(b * 2 + dir) * 66) * DRNN * 2 + (size_t)chl * 2;
            f32x2 cv[33];
#pragma unroll
            for (int i = 0; i < 33; ++i) { const int p = hh * 33 + i; const int tile = dir == 0 ? p : (p < 2 ? 1 - p : 67 - p); cv[i] = *(const f32x2*)(cbase + (size_t)tile * DRNN * 2); }
            float cA = 1.f, cH = 0.f;
#pragma unroll
            for (int i = 0; i < 33; ++i) { const bool ok = hh * 33 + i < pos; const float ta = ok ? cv[i].x : 1.f, th = ok ? cv[i].y : 0.f; cH = ta * cH + th; cA = ta * cA; }
            const auto ra = __builtin_amdgcn_permlane32_swap(__float_as_uint(cA), __float_as_uint(cA), false, false);
            const auto rh = __builtin_amdgcn_permlane32_swap(__float_as_uint(cH), __float_as_uint(cH), false, false);
            const float lowH = hh == 0 ? cH : __uint_as_float(rh[0]);
            const float upA = hh == 0 ? __uint_as_float(ra[1]) : cA;
            const float upH = hh == 0 ? __uint_as_float(rh[1]) : cH;
            h0 = upA * lowH + upH;
        }
        __builtin_amdgcn_sched_barrier(0);
        {
            const int j2 = tid & 63, ts = tid >> 6, c0 = hb * 128 + 2 * j2;
            const float w00 = a.in[16][0 * DRNN + c0], w01 = a.in[16][0 * DRNN + c0 + 1], w10 = a.in[16][1 * DRNN + c0], w11 = a.in[16][1 * DRNN + c0 + 1];
            const float w20 = a.in[16][2 * DRNN + c0], w21 = a.in[16][2 * DRNN + c0 + 1], w30 = a.in[16][3 * DRNN + c0], w31 = a.in[16][3 * DRNN + c0 + 1];
            const float cb0 = a.in[17][c0], cb1 = a.in[17][c0 + 1];
            unsigned xw[19];
#pragma unroll
            for (int i = 0; i < 19; ++i) { const int g = row0 + ts * 16 - 2 + i; xw[i] = (g >= seq_lo && g < seq_hi) ? *(const unsigned*)(XR + (size_t)g * DRNN + c0) : 0u; }
#pragma unroll
            for (int i = 0; i < 16; ++i) {
                const float y0 = w00 * bflo(xw[i]) + w10 * bflo(xw[i + 1]) + w20 * bflo(xw[i + 2]) + w30 * bflo(xw[i + 3]) + cb0;
                const float y1 = w01 * bfhi(xw[i]) + w11 * bfhi(xw[i + 1]) + w21 * bfhi(xw[i + 2]) + w31 * bfhi(xw[i + 3]) + cb1;
                *(LAS unsigned*)(xcA + (ts * 16 + i) * XC_LD + 2 * j2) = pk2(y0, y1);
            }
        }
        __syncthreads();
        const int ch = hb * 128 + nb * 32 + r32;
        f32x16 accA[4], accX[4];
        {
            unsigned woff = (unsigned)((nb * 32 + r32) * 128 + 8 * hh); asm volatile("" : "+v"(woff));
            const bf16_t* wa = (const bf16_t*)(ws + WS_WAT) + (size_t)(dir * 10 + hb) * 128 * 128;
            const bf16_t* wx = (const bf16_t*)(ws + WS_WXT) + (size_t)(dir * 10 + hb) * 128 * 128;
            bf16x8 bfa[8], bfx[8];
#pragma unroll
            for (int k = 0; k < 8; ++k) { bfa[k] = *(const bf16x8*)(wa + woff + k * 16); bfx[k] = *(const bf16x8*)(wx + woff + k * 16); }
#pragma unroll
            for (int mb = 0; mb < 4; ++mb) {
                accA[mb] = f32x16{}; accX[mb] = f32x16{};
#pragma unroll
                for (int k = 0; k < 8; ++k) {
                    const bf16x8 af = *(const LAS bf16x8*)(xcA + (mb * 32 + r32) * XC_LD + k * 16 + 8 * hh);
                    accA[mb] = __builtin_amdgcn_mfma_f32_32x32x16_bf16(af, bfa[k], accA[mb], 0, 0, 0);
                    accX[mb] = __builtin_amdgcn_mfma_f32_32x32x16_bf16(af, bfx[k], accX[mb], 0, 0, 0);
                }
            }
        }
        __builtin_amdgcn_sched_barrier(0);
        {
            const float ba = a.in[19][dir * DRNN + ch], bx = a.in[21][dir * DRNN + ch], lam = a.in[22][dir * DRNN + ch];
            const float sp8 = -8.f * log1pf(__expf(-lam));
#pragma unroll
            for (int mb = 0; mb < 4; ++mb)
#pragma unroll
                for (int r = 0; r < 16; ++r) {
                    const int t = mb * 32 + (r & 3) + 8 * (r >> 2) + 4 * hh;
                    const float xv = bf2f(xcA[t * XC_LD + nb * 32 + r32]);
                    const float rg = sigm_fast(accA[mb][r] + ba), ig = sigm_fast(accX[mb][r] + bx);
                    const float la = rg * sp8, av = exp2_fast(1.4426950408889634f * la), x2 = 2.f * la;
                    const float om1 = -x2 * (1.f + x2 * (0.5f + x2 * (0.16666667f + x2 * 0.041666668f))), om2 = __builtin_fmaf(-av, av, 1.f);
                    const float om = (x2 > -0.25f) ? om1 : om2;
                    accA[mb][r] = av; accX[mb][r] = __builtin_sqrtf(fmaxf(om, 0.f)) * ig * xv;
                    if ((r & 3) == 3) __builtin_amdgcn_sched_barrier(0);
                }
        }
        __builtin_amdgcn_sched_barrier(0);
        float h = h0;
        float Atot = 1.f; float cin[16];
#define RG_COMPOSITE(q) const int mb = (q) >> 2, rg = ((q) & 3) * 4; \
            const float a0 = accA[mb][rg], a1 = accA[mb][rg + 1], a2 = accA[mb][rg + 2], a3 = accA[mb][rg + 3]; \
            const float u0 = accX[mb][rg], u1 = accX[mb][rg + 1], u2 = accX[mb][rg + 2], u3 = accX[mb][rg + 3]; \
            const float gA = (a0 * a1) * (a2 * a3); \
            const float gH = dir == 0 ? ((u0 * a1 + u1) * a2 + u2) * a3 + u3 : ((u3 * a2 + u2) * a1 + u1) * a0 + u0; \
            const auto ra = __builtin_amdgcn_permlane32_swap(__float_as_uint(gA), __float_as_uint(gA), false, false); \
            const auto rh = __builtin_amdgcn_permlane32_swap(__float_as_uint(gH), __float_as_uint(gH), false, false); \
            const float pA = __uint_as_float(hh == 0 ? ra[1] : ra[0]), pH = __uint_as_float(hh == 0 ? rh[1] : rh[0]); \
            const float EA = hh ? pA : gA, EH = hh ? pH : gH, OA = hh ? gA : pA, OH = hh ? gH : pH;
        if (dir == 0) {
#pragma unroll
            for (int q = 0; q < 16; ++q) { RG_COMPOSITE(q)
                const float hE = h; h = EA * h + EH; const float hO = h; h = OA * h + OH; Atot *= EA * OA; cin[q] = hh ? hO : hE; }
        } else {
#pragma unroll
            for (int q = 15; q >= 0; --q) { RG_COMPOSITE(q)
                const float hO = h; h = OA * h + OH; const float hE = h; h = EA * h + EH; Atot *= EA * OA; cin[q] = hh ? hO : hE; }
        }
#undef RG_COMPOSITE
        if (pass == 0) {
            if (hh == 0) { float* c = CARRY + (((size_t)(b * 2 + dir) * 66 + tl) * DRNN + ch) * 2; c[0] = Atot; c[1] = h; }
            __syncthreads();
            continue;
        }
#pragma unroll
        for (int q = 0; q < 16; ++q) {
            const int mb = q >> 2, rg = (q & 3) * 4; float hc = cin[q];
            if (dir == 0) {
#pragma unroll
                for (int e = 0; e < 4; ++e) { hc = accA[mb][rg + e] * hc + accX[mb][rg + e]; accA[mb][rg + e] = hc; }
            } else {
#pragma unroll
                for (int e = 3; e >= 0; --e) { hc = accA[mb][rg + e] * hc + accX[mb][rg + e]; accA[mb][rg + e] = hc; }
            }
        }
        if (dir == 0) {
#pragma unroll
            for (int mb = 0; mb < 4; ++mb)
#pragma unroll
                for (int r = 0; r < 16; ++r) { const int t = mb * 32 + (r & 3) + 8 * (r >> 2) + 4 * hh; HS[t * 128 + nb * 32 + r32] = accA[mb][r]; }
        }
        __syncthreads();
        if (dir == 1) {
#pragma unroll
            for (int mb = 0; mb < 4; ++mb)
#pragma unroll
                for (int r = 0; r < 16; ++r) { const int t = mb * 32 + (r & 3) + 8 * (r >> 2) + 4 * hh; HS[t * 128 + nb * 32 + r32] += accA[mb][r]; }
        }
        __syncthreads();
        {
            const int t = tid >> 2, cs = (tid & 3) * 32, g = row0 + t;
            const bf16_t* gp = GG + (size_t)g * DRNN + hb * 128 + cs; bf16_t* yp = YG + (size_t)g * DRNN + hb * 128 + cs;
#pragma unroll
            for (int c8 = 0; c8 < 32; c8 += 8) {
                const u32x4 gw = *(const u32x4*)(gp + c8);
                const f32x4 h0 = *(const LAS f32x4*)(HS + t * 128 + cs + c8), h1 = *(const LAS f32x4*)(HS + t * 128 + cs + c8 + 4);
                u32x4 o; o.x = pk2(h0.x * bflo(gw.x), h0.y * bfhi(gw.x)); o.y = pk2(h0.z * bflo(gw.y), h0.w * bfhi(gw.y));
                o.z = pk2(h1.x * bflo(gw.z), h1.y * bfhi(gw.z)); o.w = pk2(h1.z * bflo(gw.w), h1.w * bfhi(gw.w));
                *(u32x4*)(yp + c8) = o;
            }
        }
        __syncthreads();
    }
}

namespace pg8 {
constexpr int BM = 256, BK = 64, HALF = 128, HTB = HALF * BK * 2, STAGE_BYTES = 8 * HTB, NXCD = 8, WGM = 8;
__host__ __device__ __forceinline__ int lds_byte(int r, int c) { const int st = (r >> 4) * 2 + (c >> 5), rr = r & 15, cc = c & 31, ob = rr * 64 + cc * 2; return st * 1024 + (ob ^ (((ob >> 9) & 1) << 5)); }
__host__ __device__ __forceinline__ void stage_rc(int b, int& R, int& C) { const int st = b / 1024, sb = b % 1024, swz = sb ^ (((sb >> 9) & 1) << 5); R = (st >> 1) * 16 + swz / 64; C = (st & 1) * 32 + (swz % 64) / 2; }
__host__ __device__ __forceinline__ int perm32(int rho) { const int n = rho >> 4, i = rho & 15; return 8 * (i >> 2) + 4 * n + (i & 3); }
struct Unit { int pm, pn; };
struct Gemm { const bf16_t* A; const bf16_t* Bt; int M, N, K; };
struct StaticOrder {
    int nM, nN, nwg, G, c;
    __host__ __device__ void init(int M, int N, int G_, int c_) { nM = M / BM; nN = N / BM; nwg = nM * nN; G = G_; c = c_; }
    __host__ __device__ bool next(int i, Unit& u) const {
        const long L = (long)i * G + c; if (L >= nwg) return false;
        int wgid = (int)L; { const int q = nwg / NXCD, r = nwg % NXCD, xcd = wgid % NXCD, off = wgid / NXCD; wgid = (xcd < r ? xcd * (q + 1) : r * (q + 1) + (xcd - r) * q) + off; }
        const int nig = WGM * nN, gid = wgid / nig, fm = gid * WGM, gsz = (nM - fm) < WGM ? (nM - fm) : WGM;
        u.pm = fm + ((wgid % nig) % gsz); u.pn = (wgid % nig) / gsz; return true;
    }
    __device__ __forceinline__ void a_ready(const Unit&) const {}
    __device__ __forceinline__ void done(const Unit&) const {}
};
struct LatentOrder {
    StaticOrder S;
    __host__ __device__ void init(int N, int G_, int c_) { S.init(16384, N, G_, c_); }
    __host__ __device__ bool next(int i, Unit& u) const { if (!S.next(i, u)) return false; u.pm = u.pm + 1 + (u.pm >= 32 ? 1 : 0); return true; }
    __device__ __forceinline__ void a_ready(const Unit&) const {}
    __device__ __forceinline__ void done(const Unit&) const {}
};
__device__ __forceinline__ unsigned cvt_pk_bf16(float lo, float hi) { unsigned r; asm volatile("v_cvt_pk_bf16_f32 %0, %1, %2" : "=v"(r) : "v"(lo), "v"(hi)); return r; }
__device__ __forceinline__ u32x4 pack8(const f32x4& v0, const f32x4& v1) { u32x4 w; w.x = cvt_pk_bf16(v0[0], v0[1]); w.y = cvt_pk_bf16(v0[2], v0[3]); w.z = cvt_pk_bf16(v1[0], v1[1]); w.w = cvt_pk_bf16(v1[2], v1[3]); return w; }
__device__ __forceinline__ f32x4 gelu4(const f32x4& v) { f32x4 r; r.x = gelu_t(v.x); r.y = gelu_t(v.y); r.z = gelu_t(v.z); r.w = gelu_t(v.w); return r; }

struct EpiStore {
    static constexpr bool PERM = true, AFTER_DRAIN = false;
    bf16_t* O1; bf16_t* O2; int ld; int split_tile; int gelu_tiles;
    __device__ __forceinline__ void operator()(f32x4 (&acc)[2][2][4][2], const Unit& u, int wr, int wc, int fr, int fq) const {
        const bool second = u.pn >= split_tile; bf16_t* base = second ? O2 : O1; const int pnl = second ? u.pn - split_tile : u.pn; const bool dog = u.pn < gelu_tiles;
        const int rl0 = wr * 64 + fr, cl0 = wc * 32 + 8 * fq;
#pragma unroll
        for (int ai = 0; ai < 2; ++ai)
#pragma unroll
            for (int m = 0; m < 4; ++m) { bf16_t* rowp = base + (size_t)(u.pm * BM + ai * HALF + m * 16 + rl0) * ld + pnl * BM + cl0;
#pragma unroll
                for (int bj = 0; bj < 2; ++bj) { f32x4 v0 = acc[ai][bj][m][0], v1 = acc[ai][bj][m][1]; if (dog) { v0 = gelu4(v0); v1 = gelu4(v1); }
                    *(u32x4*)(rowp + bj * HALF) = pack8(v0, v1); } }
    }
};
struct EpiResid {
    static constexpr bool PERM = true, AFTER_DRAIN = false;
    const float* x; const float* ctx; const float* modbase; float* X1; int base_mode;
    __device__ __forceinline__ void operator()(f32x4 (&acc)[2][2][4][2], const Unit& u, int wr, int wc, int fr, int fq) const {
        const int b = u.pm / 33, tl = u.pm % 33, var = tl == 0 ? 2 : b;
        const float* gate = modbase + (size_t)var * 6144 + u.pn * BM;
        const float* basep = base_mode == 0 ? (tl == 0 ? ctx + (size_t)b * CTXL * D : x + ((size_t)b * SEQ + (size_t)(tl - 1) * 256) * D) : X1 + (size_t)u.pm * BM * D;
        float* outp = X1 + (size_t)u.pm * BM * D;
        const int rl0 = wr * 64 + fr, cl0 = u.pn * BM + wc * 32 + 8 * fq;
        f32x4 gv[2][2];
#pragma unroll
        for (int bj = 0; bj < 2; ++bj)
#pragma unroll
            for (int n = 0; n < 2; ++n) gv[bj][n] = *(const f32x4*)(gate + bj * HALF + wc * 32 + 8 * fq + 4 * n);
#pragma unroll
        for (int ai = 0; ai < 2; ++ai)
#pragma unroll
            for (int m = 0; m < 4; ++m) { const size_t off = (size_t)(ai * HALF + m * 16 + rl0) * D + cl0;
#pragma unroll
                for (int bj = 0; bj < 2; ++bj)
#pragma unroll
                    for (int n = 0; n < 2; ++n) { const f32x4 bs = *(const f32x4*)(basep + off + bj * HALF + 4 * n); *(f32x4*)(outp + off + bj * HALF + 4 * n) = bs + gv[bj][n] * acc[ai][bj][m][n]; } }
    }
};
struct EpiInproj0 {
    static constexpr bool PERM = true, AFTER_DRAIN = false;
    unsigned char* ws; const float* gmg; const float* qg; const float* kg; LAS float* P;
    __device__ __forceinline__ void operator()(f32x4 (&acc)[2][2][4][2], const Unit& u, int wr, int wc, int fr, int fq) const {
        int rl0 = wr * 64 + fr, cl0 = wc * 32 + 8 * fq; asm volatile("" : "+v"(rl0), "+v"(cl0));
        const int pn = u.pn; const size_t grow0 = (size_t)u.pm * BM;
        if (pn < 4) {
#pragma unroll
            for (int ai = 0; ai < 2; ++ai)
#pragma unroll
                for (int bj = 0; bj < 2; ++bj)
#pragma unroll
                    for (int m = 0; m < 4; ++m) { acc[ai][bj][m][0] = gelu4(acc[ai][bj][m][0]); acc[ai][bj][m][1] = gelu4(acc[ai][bj][m][1]); __builtin_amdgcn_sched_barrier(0); }
        }
        if (pn < 2 || pn == 7) {
            bf16_t* base = pn < 2 ? (bf16_t*)(ws + WS_U) + pn * BM : (bf16_t*)(ws + WS_V); const int ld = pn < 2 ? 512 : 256;
#pragma unroll
            for (int ai = 0; ai < 2; ++ai)
#pragma unroll
                for (int m = 0; m < 4; ++m) { bf16_t* rowp = base + (grow0 + ai * HALF + m * 16 + rl0) * ld + cl0;
#pragma unroll
                    for (int bj = 0; bj < 2; ++bj) *(u32x4*)(rowp + bj * HALF) = pack8(acc[ai][bj][m][0], acc[ai][bj][m][1]); }
            return;
        }
#pragma unroll
        for (int ai = 0; ai < 2; ++ai)
#pragma unroll
            for (int m = 0; m < 4; ++m)
#pragma unroll
                for (int bj = 0; bj < 2; ++bj) { const f32x4 a0 = acc[ai][bj][m][0], a1 = acc[ai][bj][m][1];
                    float s = (a0.x * a0.x + a0.y * a0.y) + (a0.z * a0.z + a0.w * a0.w) + (a1.x * a1.x + a1.y * a1.y) + (a1.z * a1.z + a1.w * a1.w);
                    s += __shfl_xor(s, 16); s += __shfl_xor(s, 32);
                    if (fq == 0) P[((ai * HALF + m * 16 + rl0) * 2 + bj) * 4 + wc] = s; __builtin_amdgcn_sched_barrier(0); }
        asm volatile("s_waitcnt lgkmcnt(0)" ::: "memory"); __builtin_amdgcn_s_barrier(); asm volatile("" ::: "memory");
        if (pn < 4) {
            bf16_t* base = (bf16_t*)(ws + WS_VV) + (pn - 2) * BM; const float* gp = gmg + (pn - 2) * BM + cl0;
            f32x4 g8[2][2];
#pragma unroll
            for (int bj = 0; bj < 2; ++bj) { g8[bj][0] = *(const f32x4*)(gp + bj * HALF); g8[bj][1] = *(const f32x4*)(gp + bj * HALF + 4); }
#pragma unroll
            for (int ai = 0; ai < 2; ++ai)
#pragma unroll
                for (int m = 0; m < 4; ++m) { const int rl = ai * HALF + m * 16 + rl0; bf16_t* rowp = base + (grow0 + rl) * 512 + cl0;
#pragma unroll
                    for (int bj = 0; bj < 2; ++bj) { const f32x4 p = *(const LAS f32x4*)(P + (rl * 2 + bj) * 4);
                        const float rinv = rsqrtf(((p.x + p.y) + (p.z + p.w)) * (1.f / 128.f) + EPS);
                        *(u32x4*)(rowp + bj * HALF) = pack8(acc[ai][bj][m][0] * rinv * g8[bj][0], acc[ai][bj][m][1] * rinv * g8[bj][1]); }
                    asm volatile("" ::: "memory"); __builtin_amdgcn_sched_barrier(0); }
            return;
        }
        {
            const bool isq = pn < 6; const float* gn = isq ? qg : kg;
            const int grp = cl0 >> 3, fo = (grp >> 3) * 64 + (grp & 7) * 4;
            const f32x4 gA = *(const f32x4*)(gn + fo), gB = *(const f32x4*)(gn + fo + 32);
            bf16_t* base = isq ? (bf16_t*)(ws + WS_Q) + (pn - 4) * BM : (bf16_t*)(ws + WS_K); const int ld = isq ? 512 : 256;
            const int tl = u.pm % 33; const bool lat = tl != 0; const int ax = grp >> 3, f0 = (grp & 7) * 4;
            const float* rope = (const float*)(ws + WS_ROPE);
#pragma unroll
            for (int ai = 0; ai < 2; ++ai)
#pragma unroll
                for (int m = 0; m < 4; ++m) { const int rl = ai * HALF + m * 16 + rl0; bf16_t* rowp = base + (grow0 + rl) * ld + cl0;
                    f32x4 cs0 = {1.f, 0.f, 1.f, 0.f}, cs1 = {1.f, 0.f, 1.f, 0.f};
                    if (lat) { const int t = (tl - 1) * 256 + rl; const int pos = ax == 0 ? (t >> 6) : (t & 63); const float* rp = rope + (pos * 32 + f0) * 2; cs0 = *(const f32x4*)rp; cs1 = *(const f32x4*)(rp + 4); }
#pragma unroll
                    for (int bj = 0; bj < 2; ++bj) { const f32x4 p = *(const LAS f32x4*)(P + (rl * 2 + bj) * 4);
                        const float rinv = rsqrtf(((p.x + p.y) + (p.z + p.w)) * (1.f / 128.f) + EPS);
                        const f32x4 x1 = acc[ai][bj][m][0] * rinv * gA, x2 = acc[ai][bj][m][1] * rinv * gB;
                        f32x4 o1, o2;
                        o1.x = x1.x * cs0.x - x2.x * cs0.y; o2.x = x2.x * cs0.x + x1.x * cs0.y;
                        o1.y = x1.y * cs0.z - x2.y * cs0.w; o2.y = x2.y * cs0.z + x1.y * cs0.w;
                        o1.z = x1.z * cs1.x - x2.z * cs1.y; o2.z = x2.z * cs1.x + x1.z * cs1.y;
                        o1.w = x1.w * cs1.z - x2.w * cs1.w; o2.w = x2.w * cs1.z + x1.w * cs1.w;
                        *(u32x4*)(rowp + bj * HALF) = pack8(o1, o2); }
                    asm volatile("" ::: "memory"); __builtin_amdgcn_sched_barrier(0); }
        }
    }
};

template <class Epi, class Sched, bool ALIGN_EPI = false, bool SP2 = false>
__device__ __forceinline__ void gemm_phase(LAS unsigned char* lds, const Gemm g, const Sched& S, const Epi& E) {
    const int tid = threadIdx.x, wid = __builtin_amdgcn_readfirstlane(tid >> 6), lane = tid & 63, wr = wid >> 2, wc = wid & 3, fr = lane & 15, fq = lane >> 4;
    const int K = g.K, nt = K / BK;
    unsigned voffA[2], voffB[2];
#pragma unroll
    for (int i = 0; i < 2; ++i) { int R, C; stage_rc(tid * 16 + i * 8192, R, C); const int Rb = Epi::PERM ? ((R & ~31) + perm32(R & 31)) : R;
        voffA[i] = (unsigned)(R * K + C) * 2u; voffB[i] = (unsigned)(Rb * K + C) * 2u; }
    const size_t kstep = (size_t)(BK * 2);
    const size_t hstep = (size_t)HALF * K * 2;
    const size_t tstep = 2 * hstep;
    const unsigned ldsw = (unsigned)wid * 1024u;
    const int aoff = lds_byte(wr * 64 + fr, fq * 8), boff = lds_byte(wc * 32 + fr, fq * 8);
#define PG8_SA(b, h) (((b) * 2 + (h)) * HTB)
#define PG8_SB(b, h) ((4 + (b) * 2 + (h)) * HTB)
#define PG8_STAGE(bufoff, gbase, voff) do { _Pragma("unroll") for (int _i = 0; _i < 2; ++_i) \
        __builtin_amdgcn_global_load_lds((const unsigned*)((const char*)(gbase) + (voff)[_i]), (LAS unsigned*)(lds + (bufoff) + ldsw + _i * 8192), 16, 0, 0); } while (0)
#define PG8_LDA(dst, b, h) do { _Pragma("unroll") for (int m = 0; m < 4; ++m) _Pragma("unroll") for (int k = 0; k < 2; ++k) dst[m][k] = *(const LAS bf16x8*)(lds + PG8_SA(b, h) + aoff + m * 2048 + k * 1024); } while (0)
#define PG8_LDB(dst, b, h) do { _Pragma("unroll") for (int n = 0; n < 2; ++n) _Pragma("unroll") for (int k = 0; k < 2; ++k) dst[n][k] = *(const LAS bf16x8*)(lds + PG8_SB(b, h) + boff + n * 2048 + k * 1024); } while (0)
#define PG8_MMA(ai, bj, At, Bt) do { __builtin_amdgcn_s_setprio(1); _Pragma("unroll") for (int m = 0; m < 4; ++m) _Pragma("unroll") for (int n = 0; n < 2; ++n) _Pragma("unroll") for (int k = 0; k < 2; ++k) \
        acc[ai][bj][m][n] = __builtin_amdgcn_mfma_f32_16x16x32_bf16(Bt[n][k], At[m][k], acc[ai][bj][m][n], 0, 0, 0); __builtin_amdgcn_s_setprio(0); } while (0)
#define PG8_WAIT_V(n) asm volatile("s_waitcnt vmcnt(" #n ")" ::: "memory")
#define PG8_WAIT_L(n) asm volatile("s_waitcnt lgkmcnt(" #n ")" ::: "memory")
#define PG8_BAR __builtin_amdgcn_s_barrier()
#define PG8_SCHED __builtin_amdgcn_sched_barrier(0)
    Unit cur, nxt; int ui = 0;
    if (!S.next(0, cur)) return;
    f32x4 acc[2][2][4][2];
#pragma unroll
    for (int a = 0; a < 2; ++a)
#pragma unroll
        for (int b = 0; b < 2; ++b)
#pragma unroll
            for (int m = 0; m < 4; ++m)
#pragma unroll
                for (int n = 0; n < 2; ++n) acc[a][b][m][n] = (f32x4){0.f, 0.f, 0.f, 0.f};
    bf16x8 At[4][2], B0[2][2], B1[2][2];
    const char* cA = (const char*)g.A + (size_t)cur.pm * tstep; const char* cB = (const char*)g.Bt + (size_t)cur.pn * tstep;
    S.a_ready(cur);
    if constexpr (SP2) {
        PG8_STAGE(PG8_SB(0, 0), cB, voffB); PG8_STAGE(PG8_SB(0, 1), cB + hstep, voffB); PG8_STAGE(PG8_SA(0, 0), cA, voffA); PG8_STAGE(PG8_SA(0, 1), cA + hstep, voffA);
        if (wr == 1) PG8_BAR;
        PG8_WAIT_V(2); PG8_BAR;
        PG8_STAGE(PG8_SB(1, 0), cB + kstep, voffB); PG8_STAGE(PG8_SA(1, 0), cA + kstep, voffA); PG8_STAGE(PG8_SB(1, 1), cB + hstep + kstep, voffB);
        PG8_WAIT_V(6); PG8_BAR;
    } else {
        PG8_STAGE(PG8_SB(0, 0), cB, voffB); PG8_STAGE(PG8_SA(0, 0), cA, voffA); PG8_STAGE(PG8_SB(0, 1), cB + hstep, voffB); PG8_STAGE(PG8_SA(0, 1), cA + hstep, voffA);
        if (wr == 1) PG8_BAR;
        PG8_WAIT_V(4); PG8_BAR;
        PG8_STAGE(PG8_SB(1, 0), cB + kstep, voffB); PG8_STAGE(PG8_SA(1, 0), cA + kstep, voffA); PG8_STAGE(PG8_SB(1, 1), cB + hstep + kstep, voffB);
        PG8_WAIT_V(6); PG8_BAR;
    }
    for (;;) {
        const bool has_next = S.next(ui + 1, nxt);
        const char* nA = has_next ? (const char*)g.A + (size_t)nxt.pm * tstep : cA; const char* nB = has_next ? (const char*)g.Bt + (size_t)nxt.pn * tstep : cB;
        for (int t = 0; t < nt; t += 2) {
            const bool last = (t == nt - 2);
            const char* a1 = cA + (size_t)(t + 1) * kstep;
            const char* a2 = last ? nA : cA + (size_t)(t + 2) * kstep; const char* b2 = last ? nB : cB + (size_t)(t + 2) * kstep;
            const char* a3 = a2 + kstep; const char* b3 = b2 + kstep;
            if (last && has_next) S.a_ready(nxt);
            if constexpr (SP2) {
            PG8_LDB(B0, 0, 0); PG8_LDB(B1, 0, 1); PG8_SCHED; PG8_LDA(At, 0, 0); PG8_STAGE(PG8_SA(1, 1), a1 + hstep, voffA);
            PG8_WAIT_V(8); PG8_WAIT_L(0); PG8_BAR; PG8_MMA(0, 0, At, B0); PG8_MMA(0, 1, At, B1); PG8_BAR; PG8_SCHED;
            PG8_LDA(At, 0, 1); PG8_STAGE(PG8_SB(0, 0), b2, voffB); PG8_STAGE(PG8_SB(0, 1), b2 + hstep, voffB); PG8_STAGE(PG8_SA(0, 0), a2, voffA);
            PG8_WAIT_V(8); PG8_WAIT_L(0); PG8_BAR; PG8_MMA(1, 0, At, B0); PG8_MMA(1, 1, At, B1); PG8_BAR; PG8_SCHED;
            PG8_LDB(B0, 1, 0); PG8_LDB(B1, 1, 1); PG8_SCHED; PG8_LDA(At, 1, 0); PG8_STAGE(PG8_SA(0, 1), a2 + hstep, voffA);
            PG8_WAIT_V(8); PG8_WAIT_L(0); PG8_BAR; PG8_MMA(0, 0, At, B0); PG8_MMA(0, 1, At, B1); PG8_BAR; PG8_SCHED;
            PG8_LDA(At, 1, 1); PG8_STAGE(PG8_SB(1, 0), b3, voffB); PG8_STAGE(PG8_SB(1, 1), b3 + hstep, voffB); PG8_STAGE(PG8_SA(1, 0), a3, voffA);
            PG8_WAIT_V(8); PG8_WAIT_L(0); PG8_BAR; PG8_MMA(1, 0, At, B0); PG8_MMA(1, 1, At, B1); PG8_BAR; PG8_SCHED;
            } else {
            PG8_LDB(B0, 0, 0); PG8_SCHED; PG8_LDA(At, 0, 0); PG8_STAGE(PG8_SA(1, 1), a1 + hstep, voffA);
            PG8_WAIT_L(8); PG8_BAR; PG8_WAIT_L(0); PG8_MMA(0, 0, At, B0); PG8_BAR; PG8_SCHED;
            PG8_LDB(B1, 0, 1); PG8_STAGE(PG8_SB(0, 0), b2, voffB);
            PG8_BAR; PG8_WAIT_L(0); PG8_MMA(0, 1, At, B1); PG8_BAR;
            PG8_LDA(At, 0, 1); PG8_STAGE(PG8_SA(0, 0), a2, voffA);
            PG8_BAR; PG8_WAIT_L(0); PG8_MMA(1, 0, At, B0); PG8_BAR; PG8_SCHED;
            PG8_STAGE(PG8_SB(0, 1), b2 + hstep, voffB);
            PG8_WAIT_V(6); PG8_BAR; PG8_MMA(1, 1, At, B1); PG8_BAR;
            PG8_LDB(B0, 1, 0); PG8_SCHED; PG8_LDA(At, 1, 0); PG8_STAGE(PG8_SA(0, 1), a2 + hstep, voffA);
            PG8_WAIT_L(8); PG8_BAR; PG8_WAIT_L(0); PG8_MMA(0, 0, At, B0); PG8_BAR; PG8_SCHED;
            PG8_LDB(B1, 1, 1); PG8_STAGE(PG8_SB(1, 0), b3, voffB);
            PG8_BAR; PG8_WAIT_L(0); PG8_MMA(0, 1, At, B1); PG8_BAR;
            PG8_LDA(At, 1, 1); PG8_STAGE(PG8_SA(1, 0), a3, voffA);
            PG8_BAR; PG8_WAIT_L(0); PG8_MMA(1, 0, At, B0); PG8_BAR; PG8_SCHED;
            PG8_STAGE(PG8_SB(1, 1), b3 + hstep, voffB);
            PG8_WAIT_V(6); PG8_BAR; PG8_MMA(1, 1, At, B1); PG8_BAR;
            }
        }
        if constexpr (ALIGN_EPI) { if (wr == 0) PG8_BAR; }
        if constexpr (!Epi::AFTER_DRAIN) { E(acc, cur, wr, wc, fr, fq); S.done(cur); }
        if (!has_next) break;
#pragma unroll
        for (int a = 0; a < 2; ++a)
#pragma unroll
            for (int b = 0; b < 2; ++b)
#pragma unroll
                for (int m = 0; m < 4; ++m)
#pragma unroll
                    for (int n = 0; n < 2; ++n) acc[a][b][m][n] = (f32x4){0.f, 0.f, 0.f, 0.f};
        cur = nxt; cA = nA; cB = nB; ++ui;
        if constexpr (ALIGN_EPI) { if (wr == 1) PG8_BAR; }
    }
    PG8_WAIT_V(0);
    if constexpr (!ALIGN_EPI) { if (wr == 0) PG8_BAR; }
    PG8_BAR;
#undef PG8_SA
#undef PG8_SB
#undef PG8_STAGE
#undef PG8_LDA
#undef PG8_LDB
#undef PG8_MMA
#undef PG8_WAIT_V
#undef PG8_WAIT_L
#undef PG8_BAR
#undef PG8_SCHED
}
}

__device__ __forceinline__ void fphase_inproj0(const Args& a, char* lds) {
    pg8::Gemm g{(const bf16_t*)(a.ws + WS_H), (const bf16_t*)(a.ws + WS_WIN0), MTOT, 2048, 1024};
    pg8::StaticOrder S; S.init(MTOT, 2048, (int)gridDim.x, (int)blockIdx.x);
    pg8::EpiInproj0 E{a.ws, a.in[9], a.in[12], a.in[13], (LAS float*)((LAS char*)lds + 131072)};
    pg8::gemm_phase<pg8::EpiInproj0, pg8::StaticOrder, true, true>((LAS unsigned char*)lds, g, S, E);
    const int G = (int)gridDim.x, nbusy = 528 - 2 * G;
    if (G == 256 && (int)blockIdx.x >= nbusy) quant_tables(a, 1, ((int)blockIdx.x - nbusy) * NWAVE + (int)(threadIdx.x >> 6), (G - nbusy) * NWAVE, (int)(threadIdx.x & 63));
    else if (G != 256) quant_tables(a, 1, (int)blockIdx.x * NWAVE + (int)(threadIdx.x >> 6), G * NWAVE, (int)(threadIdx.x & 63));
}
__device__ __forceinline__ void fphase_outproj0(const Args& a, char* lds) {
    pg8::Gemm g{(const bf16_t*)(a.ws + WS_AO), (const bf16_t*)(a.ws + WS_WOUT0), MTOT, 1024, 1024};
    pg8::StaticOrder S; S.init(MTOT, 1024, (int)gridDim.x, (int)blockIdx.x);
    pg8::EpiResid E{a.in[0], a.in[2], (const float*)(a.ws + WS_MODV) + 2 * 1024, (float*)(a.ws + WS_X1), 0};
    pg8::gemm_phase<pg8::EpiResid, pg8::StaticOrder, true, true>((LAS unsigned char*)lds, g, S, E);
    const int G = (int)gridDim.x, nbusy = (G == 256) ? 264 - G : 0;
    if ((int)blockIdx.x >= nbusy) for (int r = (int)blockIdx.x - nbusy; r < N_L1_ITEMS; r += G - nbusy) prep_l1_item(a, (float*)lds, r);
}
__device__ __forceinline__ void fphase_peerq0(const Args& a, char* lds) {
    pg8::Gemm g{(const bf16_t*)(a.ws + WS_H), (const bf16_t*)(a.ws + WS_WQ), MTOT, 2048, 1024};
    pg8::StaticOrder S; S.init(MTOT, 2048, (int)gridDim.x, (int)blockIdx.x);
    pg8::EpiStore E{(bf16_t*)(a.ws + WS_QP), (bf16_t*)(a.ws + WS_QP), 2048, 1000, 0};
    pg8::gemm_phase<pg8::EpiStore, pg8::StaticOrder, true, true>((LAS unsigned char*)lds, g, S, E);
}
__device__ __forceinline__ void fphase_inproj1(const Args& a, char* lds) {
    pg8::Gemm g{(const bf16_t*)(a.ws + WS_H), (const bf16_t*)(a.ws + WS_WIN1), MTOT, 2560, 1024};
    pg8::StaticOrder S; S.init(MTOT, 2560, (int)gridDim.x, (int)blockIdx.x);
    pg8::EpiStore E{(bf16_t*)(a.ws + WS_GG), (bf16_t*)(a.ws + WS_XR), 1280, 5, 5};
    pg8::gemm_phase<pg8::EpiStore, pg8::StaticOrder, true, true>((LAS unsigned char*)lds, g, S, E);
}
__device__ __forceinline__ void fphase_outproj1(const Args& a, char* lds) {
    pg8::Gemm g{(const bf16_t*)(a.ws + WS_YG), (const bf16_t*)(a.ws + WS_WOUT1), MTOT, 1024, 1280};
    pg8::LatentOrder S; S.init(1024, (int)gridDim.x, (int)blockIdx.x);
    pg8::EpiResid E{a.in[0], a.in[2], (const float*)(a.ws + WS_MODV) + 3 * 6144 + 2 * 1024, (float*)(a.ws + WS_X1), 1};
    pg8::gemm_phase<pg8::EpiResid, pg8::LatentOrder, true, true>((LAS unsigned char*)lds, g, S, E);
}
__device__ __forceinline__ void fphase_peerq1(const Args& a, char* lds) {
    pg8::Gemm g{(const bf16_t*)(a.ws + WS_H), (const bf16_t*)(a.ws + WS_WQ) + (size_t)2048 * 1024, MTOT, 2048, 1024};
    pg8::LatentOrder S; S.init(2048, (int)gridDim.x, (int)blockIdx.x);
    pg8::EpiStore E{(bf16_t*)(a.ws + WS_QP), (bf16_t*)(a.ws + WS_QP), 2048, 1000, 0};
    pg8::gemm_phase<pg8::EpiStore, pg8::LatentOrder, true, true>((LAS unsigned char*)lds, g, S, E);
}

constexpr int NPHASE = 23;
__global__ void __launch_bounds__(NTHR, 2) mega(Args a) {
    extern __shared__ __attribute__((aligned(16))) char lds[];
    volatile LAS unsigned* MISC = (volatile LAS unsigned*)((LAS char*)lds + LDS_MISC);
    if (threadIdx.x < 64) MISC[threadIdx.x] = 0u;
    __syncthreads();
    XcdBarrier bar; bar.bar = (unsigned*)(a.ws + WS_CTL) + 4096; bar.x = 0; bar.st = nullptr;
    const bool multi = (a.ph_hi - a.ph_lo) > 1;
    if (multi) bar = xcd_barrier_post((unsigned*)(a.ws + WS_CTL) + 4096, MISC + 8);
    const int lo = a.ph_lo, hi = a.ph_hi;
    unsigned char* ws = a.ws;
#define IN(k) (lo <= (k) && (k) < hi)
#define SEAM(k) do { if (IN(k) && IN((k) + 1)) xcd_barrier(bar); } while (0)
#ifndef PROBE_DUP
#define PROBE_DUP 0u
#endif
#define DUPQ(k) (((PROBE_DUP >> (k)) & 1u) != 0u)
    if (IN(0)) { phase_prep(a, lds); if (DUPQ(0)) { xcd_barrier(bar); phase_prep(a, lds); } } SEAM(0);
    if (IN(1)) { phase_norm(a, 0, 0, a.in[6], 0, 1, false); if (DUPQ(1)) { xcd_barrier(bar); phase_norm(a, 0, 0, a.in[6], 0, 1, false); } } SEAM(1);
    if (IN(2)) { fphase_inproj0(a, lds); if (DUPQ(2)) { xcd_barrier(bar); fphase_inproj0(a, lds); } } SEAM(2);
    if (IN(3)) { phase_gmlp2(a, lds); phase_attn(a, lds); if (DUPQ(3)) { xcd_barrier(bar); phase_gmlp2(a, lds); phase_attn(a, lds); } } SEAM(3);
    if (IN(4)) { fphase_outproj0(a, lds); if (DUPQ(4)) { xcd_barrier(bar); fphase_outproj0(a, lds); } } SEAM(4);
    if (IN(5)) { phase_norm(a, 0, 1, a.in[7], 3, 4, false, true); if (DUPQ(5)) { xcd_barrier(bar); phase_norm(a, 0, 1, a.in[7], 3, 4, false, true); } } SEAM(5);
    if (IN(6)) { fphase_peerq0(a, lds); if (DUPQ(6)) { xcd_barrier(bar); fphase_peerq0(a, lds); } } SEAM(6);
    if (IN(7)) { phase_peer_topk2(a, 0, false); if (DUPQ(7)) { xcd_barrier(bar); phase_peer_topk2(a, 0, false); } } SEAM(7);
    if (IN(8)) { phase_gu(a, lds, 0, 0); if (DUPQ(8)) { xcd_barrier(bar); phase_gu(a, lds, 0, 0); } } SEAM(8);
    if (IN(9)) { phase_gact(a, 0, 0); if (DUPQ(9)) { xcd_barrier(bar); phase_gact(a, 0, 0); } } SEAM(9);
    if (IN(10)) { phase_gv(a, lds, 0, 0); if (DUPQ(10)) { xcd_barrier(bar); phase_gv(a, lds, 0, 0); } } SEAM(10);
    if (IN(11)) { phase_norm(a, 1, 1, a.in[6] + D, 0, 1, false); if (DUPQ(11)) { xcd_barrier(bar); phase_norm(a, 1, 1, a.in[6] + D, 0, 1, false); } } SEAM(11);
    if (IN(12)) { fphase_inproj1(a, lds); if (DUPQ(12)) { xcd_barrier(bar); fphase_inproj1(a, lds); } } SEAM(12);
    if (IN(13)) { phase_rglru2(a, lds, 0); if (DUPQ(13)) { xcd_barrier(bar); phase_rglru2(a, lds, 0); } } SEAM(13);
    if (IN(14)) { phase_rglru2(a, lds, 1); if (DUPQ(14)) { xcd_barrier(bar); phase_rglru2(a, lds, 1); } } SEAM(14);
    if (IN(15)) { fphase_outproj1(a, lds); if (DUPQ(15)) { xcd_barrier(bar); fphase_outproj1(a, lds); } } SEAM(15);
    if (IN(16)) { phase_norm(a, 1, 1, a.in[7] + D, 3, 4, true, true); if (DUPQ(16)) { xcd_barrier(bar); phase_norm(a, 1, 1, a.in[7] + D, 3, 4, true, true); } } SEAM(16);
    if (IN(17)) { fphase_peerq1(a, lds); if (DUPQ(17)) { xcd_barrier(bar); fphase_peerq1(a, lds); } } SEAM(17);
    if (IN(18)) { phase_peer_topk2(a, 1, true); if (DUPQ(18)) { xcd_barrier(bar); phase_peer_topk2(a, 1, true); } } SEAM(18);
    if (IN(19)) { phase_gu(a, lds, 1, 1); if (DUPQ(19)) { xcd_barrier(bar); phase_gu(a, lds, 1, 1); } } SEAM(19);
    if (IN(20)) { phase_gact(a, 1, 1); if (DUPQ(20)) { xcd_barrier(bar); phase_gact(a, 1, 1); } } SEAM(20);
    if (IN(21)) { phase_gv(a, lds, 1, 1); if (DUPQ(21)) { xcd_barrier(bar); phase_gv(a, lds, 1, 1); } } SEAM(21);
    if (IN(22)) { phase_finalnorm(a); if (DUPQ(22)) { xcd_barrier(bar); phase_finalnorm(a); } }
#undef IN
#undef SEAM
}

extern "C" void kernel_launch(void* const* d_in, const int* in_sizes, int n_in, void* d_out, int out_size, void* d_ws, size_t ws_size, hipStream_t stream) {
    static int grid = 0;
    if (grid == 0) {
        if (n_in != 29 || out_size != NB * SEQ * D || ws_size < WS_END) {
            fprintf(stderr, "kernel_launch: unexpected shapes: n_in %d out %d ws %zu (need %zu)\n", n_in, out_size, ws_size, (size_t)WS_END); grid = -1; return; }
        int dev = 0, cus = 0, per_cu = 0;
        if (hipGetDevice(&dev) != hipSuccess || hipDeviceGetAttribute(&cus, hipDeviceAttributeMultiprocessorCount, dev) != hipSuccess) { grid = -1; return; }
        if (hipFuncSetAttribute((const void*)mega, hipFuncAttributeMaxDynamicSharedMemorySize, LDS_BYTES) != hipSuccess) { fprintf(stderr, "kernel_launch: hipFuncSetAttribute failed\n"); grid = -1; return; }
        if (hipOccupancyMaxActiveBlocksPerMultiprocessor(&per_cu, (const void*)mega, NTHR, LDS_BYTES) != hipSuccess || per_cu < 1)
            fprintf(stderr, "kernel_launch: occupancy query reports %d blocks per CU\n", per_cu);
        (void)hipGetLastError();
        grid = cus;
    }
    if (grid < 0) return;
    (void)hipMemsetAsync((char*)d_ws + WS_CTL, 0, CTL_BYTES, stream);
    Args a{};
    for (int i = 0; i < 29; ++i) a.in[i] = (const float*)d_in[i];
    a.out = (float*)d_out; a.ws = (unsigned char*)d_ws;
#if MK_SINGLE
    a.ph_lo = 0; a.ph_hi = NPHASE;
    hipLaunchKernelGGL(mega, dim3(grid), dim3(NTHR), LDS_BYTES, stream, a);
#else
    for (int p = 0; p < NPHASE; ++p) { a.ph_lo = p; a.ph_hi = p + 1; hipLaunchKernelGGL(mega, dim3(grid), dim3(NTHR), LDS_BYTES, stream, a); }
#endif
    const hipError_t le = hipPeekAtLastError();
    if (le != hipSuccess) fprintf(stderr, "kernel_launch: launch failed: %s\n", hipGetErrorName(le));
}
```

```cpp
#include <hip/hip_runtime.h>
#include <cstdio>
#include <cstdint>

#ifndef MK_SINGLE
#define MK_SINGLE 1
#endif

#define GAS __attribute__((address_space(1)))
#define LAS __attribute__((address_space(3)))

typedef unsigned short bf16_t;
typedef short bf16x8 __attribute__((ext_vector_type(8)));
typedef float f32x4 __attribute__((ext_vector_type(4)));
typedef float f32x16 __attribute__((ext_vector_type(16)));
typedef unsigned u32x4 __attribute__((ext_vector_type(4)));
typedef unsigned u32x2 __attribute__((ext_vector_type(2)));

constexpr int D = 1024, NB = 2, SEQ = 8192, CTXL = 256;
constexpr int RPB = SEQ + CTXL;
constexpr int MTOT = NB * RPB;
constexpr int AB_IN = 2048, A_W = 512, DRNN = 1280, NEXP = 16384;
constexpr float EPS = 1e-6f;
constexpr int NTHR = 512, NWAVE = 8;

constexpr size_t MiB = 1u << 20;
constexpr size_t WS_CTL = 0, CTL_BYTES = 1 * MiB;
constexpr size_t WS_MODV = 1 * MiB;
constexpr size_t WS_ROPE = 1 * MiB + 512 * 1024;
constexpr size_t WS_WIN0 = 2 * MiB;
constexpr size_t WS_WOUT0 = 6 * MiB;
constexpr size_t WS_WIN1 = 8 * MiB;
constexpr size_t WS_WOUT1 = 13 * MiB;
constexpr size_t WS_WQ = 16 * MiB;
constexpr size_t WS_KEYS = 24 * MiB;
constexpr size_t WS_GWS = 25 * MiB;
constexpr size_t WS_WAT = 26 * MiB;
constexpr size_t WS_WXT = 27 * MiB;
constexpr size_t WS_CARRY = 28 * MiB;
constexpr size_t WS_SCU = 31 * MiB;
constexpr size_t WS_SCV = 31 * MiB + 512 * 1024;
constexpr size_t WS_PU = 32 * MiB;
constexpr size_t WS_PV = 96 * MiB;
constexpr size_t WS_H = 160 * MiB;
constexpr size_t WS_X1 = 193 * MiB;
constexpr size_t WS_SELI = 259 * MiB;
constexpr size_t WS_SELG = 268 * MiB;
constexpr size_t WS_R = 277 * MiB;
constexpr size_t WS_U = WS_R;
constexpr size_t WS_VV = WS_R + 17 * MiB;
constexpr size_t WS_Q = WS_R + 34 * MiB;
constexpr size_t WS_K = WS_R + 51 * MiB;
constexpr size_t WS_V = WS_R + 60 * MiB;
constexpr size_t WS_AO = WS_R + 69 * MiB;
constexpr size_t WS_QP = WS_R;
constexpr size_t WS_H8 = WS_R + 70 * MiB;
constexpr size_t WS_SH = WS_R + 88 * MiB;
constexpr size_t WS_ACT16 = WS_R + 89 * MiB;
constexpr size_t WS_SA = WS_R + 94 * MiB;
constexpr size_t WS_PART = WS_R;
constexpr size_t WS_GG = WS_R;
constexpr size_t WS_XR = WS_R + 42 * MiB;
constexpr size_t WS_YG = WS_R + 84 * MiB;
constexpr size_t WS_END = WS_R + 126 * MiB;

constexpr int LDS_BYTES = 147456;
constexpr int LDS_MISC = 145408;

__device__ __forceinline__ float bf2f(bf16_t v) { return __uint_as_float(((unsigned)v) << 16); }
__device__ __forceinline__ unsigned f2bf(float f) { unsigned u = __float_as_uint(f); return (u + 0x7fffu + ((u >> 16) & 1u)) >> 16; }
__device__ __forceinline__ unsigned pk2(float lo, float hi) { return f2bf(lo) | (f2bf(hi) << 16); }
__device__ __forceinline__ float bflo(unsigned w) { return __uint_as_float(w << 16); }
__device__ __forceinline__ float bfhi(unsigned w) { return __uint_as_float(w & 0xffff0000u); }
__device__ __forceinline__ float gelu_t(float x) { const float y = -2.302208198144325f * (x + 0.044715f * x * x * x); return x * __builtin_amdgcn_rcpf(1.f + __builtin_amdgcn_exp2f(y)); }
__device__ __forceinline__ float sigmoidf_(float x) { return 1.f / (1.f + __expf(-x)); }
__device__ __forceinline__ float wave_sum(float v) {
#pragma unroll
    for (int o = 1; o < 64; o <<= 1) v += __shfl_xor(v, o);
    return v;
}
__host__ __device__ __forceinline__ int sigma_head(int j) { const int grp = j >> 3, n = (j >> 2) & 1, e = j & 3; return (grp >> 3) * 64 + n * 32 + (grp & 7) * 4 + e; }

struct Args {
    const float* in[29];
    float* out;
    unsigned char* ws;
    int ph_lo, ph_hi;
};

__device__ __forceinline__ int row_variant(int g) { const int b = g / RPB, i = g - b * RPB; return i < CTXL ? 2 : b; }
__device__ __forceinline__ const float* row_src(const Args& a, int g) {
    const int b = g / RPB, i = g - b * RPB;
    return i < CTXL ? a.in[2] + ((size_t)b * CTXL + i) * D : a.in[0] + ((size_t)b * SEQ + (i - CTXL)) * D;
}
__device__ __forceinline__ const float* modv(const Args& a, int layer, int variant, int which) {
    return (const float*)(a.ws + WS_MODV) + ((size_t)(layer * 3 + variant) * 6 + which) * D;
}

#define XB_TMO      128
#define XB_XCNT(j)  (256  + 64 * (j))
#define XB_XSUB(j)  (1280 + 64 * (j))
#define XB_XGEN(j)  (2304 + 64 * (j))
#define XB_TOP      3328
#define XB_TOPGEN   3392
#define XCD_BAR_WORDS 3456
#define XB_SPIN_CAP (1u << 22)
__device__ __forceinline__ unsigned xb_ld(unsigned* p)              { return __hip_atomic_load(p, __ATOMIC_RELAXED, __HIP_MEMORY_SCOPE_AGENT); }
__device__ __forceinline__ unsigned xb_add(unsigned* p, unsigned v) { return __hip_atomic_fetch_add(p, v, __ATOMIC_RELAXED, __HIP_MEMORY_SCOPE_AGENT); }
__device__ __forceinline__ unsigned xb_xcc_id() { return (unsigned)__builtin_amdgcn_s_getreg((3 << 11) | 20) & 0xFu; }
#define XB_SPIN(cond, bar) do { unsigned _sp = 0; while (cond) { __builtin_amdgcn_s_sleep(1); \
    if ((++_sp & 255u) == 0u) { if (xb_ld(&(bar)[XB_TMO])) break; if (_sp > XB_SPIN_CAP) { atomicAdd(&(bar)[XB_TMO], 1u); break; } } } } while (0)
struct XcdBarrier { unsigned* bar; unsigned x; volatile LAS unsigned* st; };
__device__ __forceinline__ XcdBarrier xcd_barrier_post(unsigned* bar, volatile LAS unsigned* st) {
    XcdBarrier b; b.bar = bar; b.x = xb_xcc_id(); b.st = st;
    if (threadIdx.x == 0) (void)xb_add(&bar[XB_XCNT(b.x)], 1u);
    return b;
}
__device__ __forceinline__ void xcd_barrier_complete(unsigned* bar, unsigned x, unsigned& nloc, unsigned& nx) {
    const unsigned G = gridDim.x * gridDim.y * gridDim.z;
    unsigned sum, cnt, mine, sp = 0u;
    for (;;) {
        sum = 0u; cnt = 0u; mine = 0u;
#pragma unroll
        for (unsigned j = 0; j < 16; ++j) { const unsigned c = xb_ld(&bar[XB_XCNT(j)]); sum += c; cnt += (c > 0u) ? 1u : 0u; mine = (j == x) ? c : mine; }
        if (sum == G) break;
        __builtin_amdgcn_s_sleep(1);
        if ((++sp & 255u) == 0u) { if (xb_ld(&bar[XB_TMO])) break; if (sp > XB_SPIN_CAP) { atomicAdd(&bar[XB_TMO], 1u); break; } }
    }
    nloc = mine > 0u ? mine : 1u; nx = cnt > 0u ? cnt : 1u;
}
__device__ __forceinline__ void xcd_barrier(const XcdBarrier& b) {
    asm volatile("s_waitcnt vmcnt(0)" ::: "memory");
    __syncthreads();
    if (threadIdx.x == 0) {
        unsigned* bar = b.bar;
        __builtin_amdgcn_s_waitcnt(0);
        unsigned nloc = b.st[0], nx = b.st[1];
        if (nloc == 0u) { xcd_barrier_complete(bar, b.x, nloc, nx); b.st[0] = nloc; b.st[1] = nx; }
        const unsigned old = xb_add(&bar[XB_XSUB(b.x)], 1u);
        const unsigned gen = old / nloc;
        if (old + 1u == (gen + 1u) * nloc) {
            __builtin_amdgcn_fence(__ATOMIC_RELEASE, "agent");
            asm volatile("s_waitcnt vmcnt(0)" ::: "memory");
            const unsigned og = xb_add(&bar[XB_TOP], 1u);
            const unsigned tg = og / nx;
            if (og + 1u == (tg + 1u) * nx) xb_add(&bar[XB_TOPGEN], 1u);
            else XB_SPIN(xb_ld(&bar[XB_TOPGEN]) == tg, bar);
            __builtin_amdgcn_fence(__ATOMIC_ACQUIRE, "agent");
            xb_add(&bar[XB_XGEN(b.x)], 1u);
            asm volatile("s_waitcnt vmcnt(0)" ::: "memory");
        } else {
            XB_SPIN(xb_ld(&bar[XB_XGEN(b.x)]) == gen, bar);
            __builtin_amdgcn_fence(__ATOMIC_ACQUIRE, "agent");
            asm volatile("s_waitcnt vmcnt(0)" ::: "memory");
        }
    }
    __syncthreads();
}

__device__ __forceinline__ void quant_tables(const Args& a, int layer, int gw, int ngw, int lane) {
    unsigned char* ws = a.ws;
    for (int r0 = gw * 4; r0 < 2 * NEXP; r0 += ngw * 4) {
        f32x4 v[4][4]; float mx[4];
#pragma unroll
        for (int q = 0; q < 4; ++q) {
            const int r = r0 + q, tb = r / NEXP, ex = r - tb * NEXP;
            const float* src = a.in[tb == 0 ? 26 : 27] + ((size_t)layer * NEXP + ex) * D;
#pragma unroll
            for (int j = 0; j < 4; ++j) v[q][j] = *(const f32x4*)(src + j * 256 + lane * 4);
        }
#pragma unroll
        for (int q = 0; q < 4; ++q) { float m = 0.f;
#pragma unroll
            for (int j = 0; j < 4; ++j) m = fmaxf(fmaxf(fmaxf(fabsf(v[q][j].x), fabsf(v[q][j].y)), fmaxf(fabsf(v[q][j].z), fabsf(v[q][j].w))), m);
            mx[q] = m; }
#pragma unroll
        for (int o = 1; o < 64; o <<= 1) {
#pragma unroll
            for (int q = 0; q < 4; ++q) mx[q] = fmaxf(mx[q], __shfl_xor(mx[q], o)); }
#pragma unroll
        for (int q = 0; q < 4; ++q) {
            const int r = r0 + q, tb = r / NEXP, ex = r - tb * NEXP;
            const float m = fmaxf(mx[q], 1e-30f), inv = 127.f / m;
            unsigned char* dst = ws + (tb == 0 ? WS_PU : WS_PV) + (size_t)layer * NEXP * D + (size_t)ex * 128 + (lane & 31) * 4;
            const int bias = tb == 0 ? 0 : 128;
#pragma unroll
            for (int j = 0; j < 4; ++j) {
                const unsigned b0 = (unsigned)(__float2int_rn(v[q][j].x * inv) + bias) & 0xffu, b1 = (unsigned)(__float2int_rn(v[q][j].y * inv) + bias) & 0xffu;
                const unsigned b2 = (unsigned)(__float2int_rn(v[q][j].z * inv) + bias) & 0xffu, b3 = (unsigned)(__float2int_rn(v[q][j].w * inv) + bias) & 0xffu;
                *(unsigned*)(dst + (size_t)(2 * j + (lane >> 5)) * NEXP * 128) = b0 | (b1 << 8) | (b2 << 16) | (b3 << 24);
            }
            if (lane == 0) ((float*)(ws + (tb == 0 ? WS_SCU : WS_SCV)))[layer * NEXP + ex] = m * (1.f / 127.f);
        }
    }
}
__device__ __forceinline__ void transpose_item4(const float* src, int Ns, bf16_t* dst, int Kd, int n0, int k0, int dn1, int dk1, int dn2, int dk2, int dn3, int dk3, int perm_lo, int perm_hi, float* tile) {
    const int tid = threadIdx.x;
    const int dnv[4] = {0, dn1, dn2, dn3}, dkv[4] = {0, dk1, dk2, dk3};
    float v[4][8];
#pragma unroll
    for (int t = 0; t < 4; ++t) {
        const int nn = tid & 63; int n = n0 + dnv[t] + nn;
        if (n >= perm_lo && n < perm_hi) { const int rel = n - perm_lo; n = perm_lo + (rel & ~127) + sigma_head(rel & 127); }
#pragma unroll
        for (int i = 0; i < 8; ++i) { const int kk = (tid >> 6) + 8 * i; v[t][i] = src[(size_t)(k0 + dkv[t] + kk) * Ns + n]; }
    }
#pragma unroll
    for (int t = 0; t < 4; ++t)
#pragma unroll
        for (int i = 0; i < 8; ++i) { const int kk = (tid >> 6) + 8 * i; tile[t * 64 * 65 + kk * 65 + (tid & 63)] = v[t][i]; }
    __syncthreads();
#pragma unroll
    for (int t = 0; t < 4; ++t) {
        const int n = tid >> 3, kc = (tid & 7) * 8; const float* tl = tile + t * 64 * 65;
        u32x4 o;
        o.x = pk2(tl[(kc + 0) * 65 + n], tl[(kc + 1) * 65 + n]); o.y = pk2(tl[(kc + 2) * 65 + n], tl[(kc + 3) * 65 + n]);
        o.z = pk2(tl[(kc + 4) * 65 + n], tl[(kc + 5) * 65 + n]); o.w = pk2(tl[(kc + 6) * 65 + n], tl[(kc + 7) * 65 + n]);
        *(u32x4*)(dst + (size_t)(n0 + dnv[t] + n) * Kd + k0 + dkv[t] + kc) = o;
    }
    __syncthreads();
}
__device__ __forceinline__ void transpose_wide(const float* src, int Ns, bf16_t* dst, int Kd, int ng, int kb, int perm_lo, int perm_hi, float* tile) {
    transpose_item4(src, Ns, dst, Kd, ng * 256, kb * 64, 64, 0, 128, 0, 192, 0, perm_lo, perm_hi, tile);
}
__device__ __forceinline__ void cvt_stream(const float* src, bf16_t* dst, size_t n8, size_t gtid, size_t gthreads) {
    for (size_t i = gtid; i < n8; i += gthreads) {
        const f32x4 a = *(const f32x4*)(src + i * 8), b = *(const f32x4*)(src + i * 8 + 4);
        u32x4 o; o.x = pk2(a.x, a.y); o.y = pk2(a.z, a.w); o.z = pk2(b.x, b.y); o.w = pk2(b.z, b.w);
        *(u32x4*)(dst + i * 8) = o;
    }
}
__device__ __forceinline__ void prep_l1_item(const Args& a, float* tile, int r) {
    unsigned char* ws = a.ws;
    constexpr int I_WIN1 = 16 * 10, I_WOUT1 = 20 * 4, I_WQ1 = 16 * 8;
    if (r < I_WIN1) { transpose_wide(a.in[15], 2560, (bf16_t*)(ws + WS_WIN1), 1024, r % 10, r / 10, 0, 0, tile); return; }
    r -= I_WIN1;
    if (r < I_WOUT1) { transpose_wide(a.in[23], 1024, (bf16_t*)(ws + WS_WOUT1), 1280, r % 4, r / 4, 0, 0, tile); return; }
    r -= I_WOUT1;
    if (r < I_WQ1) { transpose_wide(a.in[24] + (size_t)1024 * 2048, 2048, (bf16_t*)(ws + WS_WQ) + (size_t)2048 * 1024, 1024, r % 8, r / 8, 0, 0, tile); return; }
    r -= I_WQ1;
    { const int which = r / 20, dh = r % 20;
        const float* src = a.in[which == 0 ? 18 : 20] + (size_t)dh * 128 * 128;
        bf16_t* dst = (bf16_t*)(ws + (which == 0 ? WS_WAT : WS_WXT)) + (size_t)dh * 128 * 128;
        transpose_item4(src, 128, dst, 128, 0, 0, 64, 0, 0, 64, 64, 64, 0, 0, tile);
    }
}
constexpr int N_L1_ITEMS = 160 + 80 + 128 + 40;
__device__ __forceinline__ void phase_prep(const Args& a, char* lds) {
    const int tid = threadIdx.x, lane = tid & 63, wid = tid >> 6;
    float* tile = (float*)lds;
    unsigned char* ws = a.ws;
    constexpr int I_MOD = 192;
    constexpr int I_WIN0 = 16 * 8, I_WOUT0 = 16 * 4, I_WQ0 = 16 * 8;
    constexpr int NIT = I_MOD + I_WIN0 + I_WOUT0 + I_WQ0;
    for (int it = blockIdx.x; it < NIT; it += gridDim.x) {
        int r = it;
        if (r < I_MOD) {
            const int l = r / 96, n0 = (r % 96) * 64;
            const float* W = a.in[4] + (size_t)l * D * 6144;
            float s0 = 0.f, s1 = 0.f, s2 = 0.f;
            float sl[3][2];
#pragma unroll
            for (int h = 0; h < 2; ++h) { const int k = wid * 128 + h * 64 + lane; const float c0 = a.in[1][k], c1 = a.in[1][D + k], c2 = a.in[3][k];
                sl[0][h] = c0 * sigmoidf_(c0); sl[1][h] = c1 * sigmoidf_(c1); sl[2][h] = c2 * sigmoidf_(c2); }
            const float* Wp = W + (size_t)(wid * 128) * 6144 + n0 + lane;
#pragma unroll
            for (int kk = 0; kk < 128; kk += 16) {
                float w[16];
#pragma unroll
                for (int j = 0; j < 16; ++j) w[j] = Wp[(size_t)(kk + j) * 6144];
#pragma unroll
                for (int j = 0; j < 16; ++j) { const int kq = kk + j;
                    s0 += __shfl(sl[0][kq >> 6], kq & 63) * w[j]; s1 += __shfl(sl[1][kq >> 6], kq & 63) * w[j]; s2 += __shfl(sl[2][kq >> 6], kq & 63) * w[j]; }
            }
            tile[(wid * 3 + 0) * 64 + lane] = s0; tile[(wid * 3 + 1) * 64 + lane] = s1; tile[(wid * 3 + 2) * 64 + lane] = s2;
            __syncthreads();
            if (tid < 192) {
                const int v = tid / 64, ln = tid & 63; float s = a.in[5][(size_t)l * 6144 + n0 + ln];
                for (int w = 0; w < 8; ++w) s += tile[(w * 3 + v) * 64 + ln];
                ((float*)(ws + WS_MODV))[(size_t)(l * 3 + v) * 6144 + n0 + ln] = s;
            }
            __syncthreads();
            continue;
        }
        r -= I_MOD;
        if (r < I_WIN0) { transpose_wide(a.in[8], 2048, (bf16_t*)(ws + WS_WIN0), 1024, r % 8, r / 8, 1024, 1792, tile); continue; }
        r -= I_WIN0;
        if (r < I_WOUT0) { transpose_wide(a.in[14], 1024, (bf16_t*)(ws + WS_WOUT0), 1024, r % 4, r / 4, 0, 0, tile); continue; }
        r -= I_WOUT0;
        transpose_wide(a.in[24], 2048, (bf16_t*)(ws + WS_WQ), 1024, r % 8, r / 8, 0, 0, tile);
    }
    const size_t gtid = (size_t)blockIdx.x * NTHR + tid, gthreads = (size_t)gridDim.x * NTHR;
    cvt_stream(a.in[25], (bf16_t*)(ws + WS_KEYS), (size_t)2 * 8 * 2 * 128 * 128 / 8, gtid, gthreads);
    cvt_stream(a.in[10], (bf16_t*)(ws + WS_GWS), (size_t)4 * 128 * 128 / 8, gtid, gthreads);
    quant_tables(a, 0, blockIdx.x * NWAVE + wid, gridDim.x * NWAVE, lane);
    for (size_t i = gtid; i < 128 * 32; i += gthreads) {
        const int pos = (int)(i / 32), f = (int)(i % 32);
        const float inv = powf(10000.f, -(float)f / 32.f); const float ang = (float)pos * inv;
        float* R = (float*)(ws + WS_ROPE); R[i * 2] = cosf(ang); R[i * 2 + 1] = sinf(ang);
    }
}

__device__ __forceinline__ void norm_row_store(const f32x4 (&v)[4], const float* g, const float* sh, const float* sc, bf16_t* orow, int lane, unsigned char* q8row = nullptr, float* q8scale = nullptr) {
    float s = 0.f;
#pragma unroll
    for (int j = 0; j < 4; ++j) s += (v[j].x * v[j].x + v[j].y * v[j].y) + (v[j].z * v[j].z + v[j].w * v[j].w);
    const float rinv = rsqrtf(wave_sum(s) * (1.f / D) + EPS);
    f32x4 o[4]; float mx = 0.f;
#pragma unroll
    for (int j = 0; j < 4; ++j) {
        const int c = j * 256 + lane * 4;
        const f32x4 gg = *(const f32x4*)(g + c), s1 = *(const f32x4*)(sh + c), s2 = *(const f32x4*)(sc + c);
        o[j].x = v[j].x * rinv * gg.x * (1.f + s2.x) + s1.x; o[j].y = v[j].y * rinv * gg.y * (1.f + s2.y) + s1.y;
        o[j].z = v[j].z * rinv * gg.z * (1.f + s2.z) + s1.z; o[j].w = v[j].w * rinv * gg.w * (1.f + s2.w) + s1.w;
        u32x2 w; w.x = pk2(o[j].x, o[j].y); w.y = pk2(o[j].z, o[j].w);
        *(u32x2*)(orow + c) = w;
        mx = fmaxf(fmaxf(fmaxf(fabsf(o[j].x), fabsf(o[j].y)), fmaxf(fabsf(o[j].z), fabsf(o[j].w))), mx);
    }
    if (q8row) {
#pragma unroll
        for (int of = 1; of < 64; of <<= 1) mx = fmaxf(mx, __shfl_xor(mx, of));
        mx = fmaxf(mx, 1e-30f); const float inv = 127.f / mx;
#pragma unroll
        for (int j = 0; j < 4; ++j) {
            const unsigned b0 = (unsigned)__float2int_rn(o[j].x * inv) & 0xffu, b1 = (unsigned)__float2int_rn(o[j].y * inv) & 0xffu;
            const unsigned b2 = (unsigned)__float2int_rn(o[j].z * inv) & 0xffu, b3 = (unsigned)__float2int_rn(o[j].w * inv) & 0xffu;
            *(unsigned*)(q8row + j * 256 + lane * 4) = b0 | (b1 << 8) | (b2 << 16) | (b3 << 24);
        }
        if (lane == 0) *q8scale = mx * (1.f / 127.f);
    }
}
__device__ __forceinline__ void phase_norm(const Args& a, int layer, int src_mode, const float* gain, int which_sh, int which_sc, bool latent_only, bool wq8 = false) {
    const int lane = threadIdx.x & 63, gw = blockIdx.x * NWAVE + (threadIdx.x >> 6), ngw = gridDim.x * NWAVE;
    bf16_t* H = (bf16_t*)(a.ws + WS_H);
    const float* X1 = (const float*)(a.ws + WS_X1);
    for (int g = gw; g < MTOT; g += ngw) {
        const int var = row_variant(g);
        if (latent_only && var == 2) continue;
        const float* xr = src_mode == 0 ? row_src(a, g) : X1 + (size_t)g * D;
        f32x4 v[4];
#pragma unroll
        for (int j = 0; j < 4; ++j) v[j] = *(const f32x4*)(xr + j * 256 + lane * 4);
        norm_row_store(v, gain, modv(a, layer, var, which_sh), modv(a, layer, var, which_sc), H + (size_t)g * D, lane, wq8 ? a.ws + WS_H8 + (size_t)g * D : nullptr, wq8 ? (float*)(a.ws + WS_SH) + g : nullptr);
    }
}

constexpr int CS_LD = 132;
__device__ __forceinline__ void gemm_tile128(const bf16_t* A, int lda, const bf16_t* Bt, int ldb, int K, float* Cs) {
    const int tid = threadIdx.x, lane = tid & 63, wid = tid >> 6, r = lane & 31, h = lane >> 5, wr = wid >> 1, wc = wid & 1;
    const bf16_t* ap = A + (size_t)(wr * 32 + r) * lda + 8 * h;
    const bf16_t* bp0 = Bt + (size_t)(wc * 64 + r) * ldb + 8 * h;
    const bf16_t* bp1 = bp0 + (size_t)32 * ldb;
    f32x16 acc0 = {}, acc1 = {};
#pragma unroll 4
    for (int k = 0; k < K; k += 16) {
        const bf16x8 av = *(const bf16x8*)(ap + k), b0 = *(const bf16x8*)(bp0 + k), b1 = *(const bf16x8*)(bp1 + k);
        acc0 = __builtin_amdgcn_mfma_f32_32x32x16_bf16(av, b0, acc0, 0, 0, 0);
        acc1 = __builtin_amdgcn_mfma_f32_32x32x16_bf16(av, b1, acc1, 0, 0, 0);
    }
#pragma unroll
    for (int i = 0; i < 16; ++i) {
        const int row = wr * 32 + (i & 3) + 8 * (i >> 2) + 4 * h;
        Cs[row * CS_LD + wc * 64 + r] = acc0[i];
        Cs[row * CS_LD + wc * 64 + 32 + r] = acc1[i];
    }
}

__device__ __forceinline__ void phase_inproj0(const Args& a, char* lds) {
    float* Cs = (float*)lds;
    const int tid = threadIdx.x;
    unsigned char* ws = a.ws;
    const bf16_t* H = (const bf16_t*)(ws + WS_H); const bf16_t* W = (const bf16_t*)(ws + WS_WIN0);
    const float* rope = (const float*)(ws + WS_ROPE);
    const int NU = (MTOT / 128) * 16;
    for (int u = blockIdx.x; u < NU; u += gridDim.x) {
        const int rt = u / 16, ct = u % 16, row0 = rt * 128, col0 = ct * 128;
        gemm_tile128(H + (size_t)row0 * D, D, W + (size_t)col0 * D, D, D, Cs);
        __syncthreads();
        const int rr = tid >> 2, q4 = tid & 3, g = row0 + rr;
        float* crow = Cs + rr * CS_LD + q4 * 32;
        if (ct < 4) {
            bf16_t* o = (bf16_t*)(ws + WS_U) + (size_t)g * 512 + col0 + q4 * 32;
#pragma unroll
            for (int c = 0; c < 32; c += 2) *(unsigned*)(o + c) = pk2(gelu_t(crow[c]), gelu_t(crow[c + 1]));
        } else if (ct < 8) {
            const int gg = ct - 4; float ss = 0.f;
#pragma unroll
            for (int c = 0; c < 32; ++c) { const float v = gelu_t(crow[c]); crow[c] = v; ss += v * v; }
            ss += __shfl_xor(ss, 1); ss += __shfl_xor(ss, 2);
            const float rinv = rsqrtf(ss * (1.f / 128.f) + EPS);
            const float* gn = a.in[9] + gg * 128 + q4 * 32;
            bf16_t* o = (bf16_t*)(ws + WS_VV) + (size_t)g * 512 + gg * 128 + q4 * 32;
#pragma unroll
            for (int c = 0; c < 32; c += 2) *(unsigned*)(o + c) = pk2(crow[c] * rinv * gn[c], crow[c + 1] * rinv * gn[c + 1]);
        } else if (ct < 14) {
            const bool isq = ct < 12; const int hh = isq ? ct - 8 : ct - 12;
            float ss = 0.f;
#pragma unroll
            for (int c = 0; c < 32; ++c) ss += crow[c] * crow[c];
            ss += __shfl_xor(ss, 1); ss += __shfl_xor(ss, 2);
            const float rinv = rsqrtf(ss * (1.f / 128.f) + EPS);
            const float* gn = a.in[isq ? 12 : 13];
            const int b = g / RPB, i = g - b * RPB; const bool lat = i >= CTXL; const int t = i - CTXL;
            bf16_t* o = (isq ? (bf16_t*)(ws + WS_Q) + (size_t)g * 512 : (bf16_t*)(ws + WS_K) + (size_t)g * 256) + hh * 128 + q4 * 32;
#pragma unroll
            for (int c8 = 0; c8 < 32; c8 += 8) {
                float y[8];
#pragma unroll
                for (int e = 0; e < 8; ++e) { const int j = q4 * 32 + c8 + e; y[e] = crow[c8 + e] * rinv * gn[sigma_head(j)]; }
                if (lat) {
                    const int grp = (q4 * 32 + c8) >> 3, ax = grp >> 3; const int pos = ax == 0 ? (t >> 6) : (t & 63);
#pragma unroll
                    for (int e = 0; e < 4; ++e) { const int f = (grp & 7) * 4 + e; const float cs = rope[(pos * 32 + f) * 2], sn = rope[(pos * 32 + f) * 2 + 1];
                        const float x1 = y[e], x2 = y[e + 4]; y[e] = x1 * cs - x2 * sn; y[e + 4] = x2 * cs + x1 * sn; }
                }
                u32x4 w; w.x = pk2(y[0], y[1]); w.y = pk2(y[2], y[3]); w.z = pk2(y[4], y[5]); w.w = pk2(y[6], y[7]);
                *(u32x4*)(o + c8) = w;
            }
        } else {
            bf16_t* o = (bf16_t*)(ws + WS_V) + (size_t)g * 256 + (ct - 14) * 128 + q4 * 32;
#pragma unroll
            for (int c = 0; c < 32; c += 2) *(unsigned*)(o + c) = pk2(crow[c], crow[c + 1]);
        }
        __syncthreads();
    }
}

__device__ __forceinline__ void phase_gmlp(const Args& a, char* lds) {
    const int tid = threadIdx.x;
    unsigned char* ws = a.ws;
    float* vt = (float*)lds;
    const bf16_t* VV = (const bf16_t*)(ws + WS_VV); const bf16_t* U = (const bf16_t*)(ws + WS_U); bf16_t* AO = (bf16_t*)(ws + WS_AO);
    const int NU = (MTOT / 128) * 4;
    for (int u = blockIdx.x; u < NU; u += gridDim.x) {
        const int ch = u / 4, g = u % 4, row0 = ch * 128;
        for (int i = tid; i < 128 * 128; i += NTHR) { const int q = i >> 7, c = i & 127; vt[i] = bf2f(VV[(size_t)(row0 + q) * 512 + g * 128 + c]); }
        __syncthreads();
        const int c = tid & 127, pq = tid >> 7;
        const float* wsg = a.in[10] + (size_t)g * 128 * 128;
        for (int pp = 0; pp < 32; ++pp) {
            const int p = pq * 32 + pp; float s = 0.f;
            for (int q = 0; q < 128; ++q) s += wsg[p * 128 + q] * vt[q * 128 + c];
            s += a.in[11][g * 128 + p];
            const float uu = bf2f(U[(size_t)(row0 + p) * 512 + g * 128 + c]);
            AO[(size_t)(row0 + p) * 1024 + g * 128 + c] = (bf16_t)f2bf(uu * s);
        }
        __syncthreads();
    }
}

__device__ __forceinline__ void phase_gmlp2(const Args& a, char* lds) {
    const int tid = threadIdx.x, lane = tid & 63, wid = __builtin_amdgcn_readfirstlane(tid >> 6), r32 = lane & 31, hh = lane >> 5;
    unsigned char* ws = a.ws;
    LAS bf16_t* vT = (LAS bf16_t*)((LAS char*)lds);
    const bf16_t* VV = (const bf16_t*)(ws + WS_VV); const bf16_t* U = (const bf16_t*)(ws + WS_U); bf16_t* AO = (bf16_t*)(ws + WS_AO);
    const bf16_t* GWS = (const bf16_t*)(ws + WS_GWS);
    const int NU = (MTOT / 128) * 4;
    for (int u = blockIdx.x; u < NU; u += gridDim.x) {
        const int ch = u >> 2, g = u & 3, row0 = ch * 128;
#pragma unroll
        for (int i = 0; i < 4; ++i) {
            const int q = (tid >> 4) + 32 * i, c0 = (tid & 15) * 8;
            const u32x4 w = *(const u32x4*)(VV + (size_t)(row0 + q) * 512 + g * 128 + c0);
            vT[(c0 + 0) * 136 + q] = (bf16_t)(w.x & 0xffffu); vT[(c0 + 1) * 136 + q] = (bf16_t)(w.x >> 16);
            vT[(c0 + 2) * 136 + q] = (bf16_t)(w.y & 0xffffu); vT[(c0 + 3) * 136 + q] = (bf16_t)(w.y >> 16);
            vT[(c0 + 4) * 136 + q] = (bf16_t)(w.z & 0xffffu); vT[(c0 + 5) * 136 + q] = (bf16_t)(w.z >> 16);
            vT[(c0 + 6) * 136 + q] = (bf16_t)(w.w & 0xffffu); vT[(c0 + 7) * 136 + q] = (bf16_t)(w.w >> 16);
        }
        __syncthreads();
        const int mb = wid >> 1, nb0 = (wid & 1) * 2;
        f32x16 acc0 = {}, acc1 = {};
        {
            unsigned aoff = (unsigned)((mb * 32 + r32) * 128 + 8 * hh); asm volatile("" : "+v"(aoff));
            const bf16_t* wsg = GWS + (size_t)g * 128 * 128;
#pragma unroll
            for (int ks = 0; ks < 8; ++ks) {
                const bf16x8 af = *(const bf16x8*)(wsg + aoff + ks * 16);
                const bf16x8 b0 = *(const LAS bf16x8*)(vT + (nb0 * 32 + r32) * 136 + ks * 16 + 8 * hh);
                const bf16x8 b1 = *(const LAS bf16x8*)(vT + ((nb0 + 1) * 32 + r32) * 136 + ks * 16 + 8 * hh);
                acc0 = __builtin_amdgcn_mfma_f32_32x32x16_bf16(af, b0, acc0, 0, 0, 0);
                acc1 = __builtin_amdgcn_mfma_f32_32x32x16_bf16(af, b1, acc1, 0, 0, 0);
            }
        }
#pragma unroll
        for (int r = 0; r < 16; ++r) {
            const int p = mb * 32 + (r & 3) + 8 * (r >> 2) + 4 * hh;
            const float bsv = a.in[11][g * 128 + p];
            const size_t ub = (size_t)(row0 + p) * 512 + g * 128, ob = (size_t)(row0 + p) * 1024 + g * 128;
            const int c0 = nb0 * 32 + r32, c1 = c0 + 32;
            AO[ob + c0] = (bf16_t)f2bf(bf2f(U[ub + c0]) * (acc0[r] + bsv));
            AO[ob + c1] = (bf16_t)f2bf(bf2f(U[ub + c1]) * (acc1[r] + bsv));
        }
        __syncthreads();
    }
}

__device__ __forceinline__ void phase_attn_naive(const Args& a, char* lds) {
    const int tid = threadIdx.x;
    unsigned char* ws = a.ws;
    float* Ks = (float*)lds;
    float* Vs = Ks + 32 * 128;
    float* part = Vs + 32 * 128;
    const bf16_t* Q = (const bf16_t*)(ws + WS_Q); const bf16_t* Kb = (const bf16_t*)(ws + WS_K); const bf16_t* Vb = (const bf16_t*)(ws + WS_V);
    bf16_t* AO = (bf16_t*)(ws + WS_AO);
    const int NU = 512 + 16;
    for (int u = blockIdx.x; u < NU; u += gridDim.x) {
        int b, h, qrow0, nkeys;
        if (u < 512) { b = u / 256; h = (u / 64) % 4; qrow0 = b * RPB + CTXL + (u % 64) * 128; nkeys = RPB; }
        else { const int v = u - 512; b = v / 8; h = (v / 2) % 4; qrow0 = b * RPB + (v % 2) * 128; nkeys = CTXL; }
        const int kvh = h >> 1, krow0 = b * RPB;
        const int qi = tid & 127, qt = tid >> 7;
        float q[32], o[32];
        {
            const bf16_t* qp = Q + (size_t)(qrow0 + qi) * 512 + h * 128 + qt * 32;
#pragma unroll
            for (int d = 0; d < 32; d += 2) { const unsigned w = *(const unsigned*)(qp + d); q[d] = bflo(w) * 0.08838834764831845f; q[d + 1] = bfhi(w) * 0.08838834764831845f; }
#pragma unroll
            for (int d = 0; d < 32; ++d) o[d] = 0.f;
        }
        float m = -1e30f, l = 0.f;
        for (int k0 = 0; k0 < nkeys; k0 += 32) {
            {
                const int key = tid >> 4, cs = (tid & 15) * 8;
                const u32x4 kw = *(const u32x4*)(Kb + (size_t)(krow0 + k0 + key) * 256 + kvh * 128 + cs);
                const u32x4 vw = *(const u32x4*)(Vb + (size_t)(krow0 + k0 + key) * 256 + kvh * 128 + cs);
                float* kd = Ks + key * 128 + cs; float* vd = Vs + key * 128 + cs;
                kd[0] = bflo(kw.x); kd[1] = bfhi(kw.x); kd[2] = bflo(kw.y); kd[3] = bfhi(kw.y); kd[4] = bflo(kw.z); kd[5] = bfhi(kw.z); kd[6] = bflo(kw.w); kd[7] = bfhi(kw.w);
                vd[0] = bflo(vw.x); vd[1] = bfhi(vw.x); vd[2] = bflo(vw.y); vd[3] = bfhi(vw.y); vd[4] = bflo(vw.z); vd[5] = bfhi(vw.z); vd[6] = bflo(vw.w); vd[7] = bfhi(vw.w);
            }
            __syncthreads();
#pragma unroll 2
            for (int j = 0; j < 32; ++j) {
                const float* kr = Ks + j * 128 + qt * 32; float acc = 0.f;
#pragma unroll
                for (int d = 0; d < 32; d += 4) { const f32x4 kv = *(const f32x4*)(kr + d); acc += q[d] * kv.x + q[d + 1] * kv.y + q[d + 2] * kv.z + q[d + 3] * kv.w; }
                part[(qt * 32 + j) * 128 + qi] = acc;
            }
            __syncthreads();
            float mx = m;
#pragma unroll 4
            for (int j = 0; j < 32; ++j) { const float sj = (part[(0 * 32 + j) * 128 + qi] + part[(1 * 32 + j) * 128 + qi]) + (part[(2 * 32 + j) * 128 + qi] + part[(3 * 32 + j) * 128 + qi]); mx = fmaxf(mx, sj); }
            const float alpha = __expf(m - mx); m = mx; float ps = 0.f;
#pragma unroll
            for (int d = 0; d < 32; ++d) o[d] *= alpha;
#pragma unroll 2
            for (int j = 0; j < 32; ++j) {
                const float sj = (part[(0 * 32 + j) * 128 + qi] + part[(1 * 32 + j) * 128 + qi]) + (part[(2 * 32 + j) * 128 + qi] + part[(3 * 32 + j) * 128 + qi]);
                const float pj = __expf(sj - mx); ps += pj;
                const float* vr = Vs + j * 128 + qt * 32;
#pragma unroll
                for (int d = 0; d < 32; d += 4) { const f32x4 vv = *(const f32x4*)(vr + d); o[d] += pj * vv.x; o[d + 1] += pj * vv.y; o[d + 2] += pj * vv.z; o[d + 3] += pj * vv.w; }
            }
            l = l * alpha + ps;
            __syncthreads();
        }
        const float rl = 1.f / l;
        bf16_t* op = AO + (size_t)(qrow0 + qi) * 1024 + 512 + h * 128 + qt * 32;
#pragma unroll
        for (int d = 0; d < 32; d += 2) *(unsigned*)(op + d) = pk2(o[d] * rl, o[d + 1] * rl);
    }
}

namespace fa {
typedef short s16x4 __attribute__((ext_vector_type(4)));
constexpr int QBLK = 32, KVBLK = 64, LDQ = 512, LDK = 256, LDO = 1024;
constexpr float SCALE = 0.088388347648318440f, THR = 8.f;
constexpr size_t SHM_V = KVBLK * 128 * 2, SHM_K = KVBLK * 128 * 2, SHM_ATTN = 2 * SHM_V + 2 * SHM_K + NWAVE * 64 * 4;
#define KSWZ(row, colB) ((row) * 256 + ((colB) ^ (((row) & 7) << 4)))
#define SBAR() __builtin_amdgcn_sched_barrier(0)
__device__ __forceinline__ int crow(int r, int hi) { return (r & 3) + 8 * (r >> 2) + 4 * hi; }
__device__ __forceinline__ unsigned cvtpk(float lo, float hi) { unsigned r; asm volatile("v_cvt_pk_bf16_f32 %0, %1, %2" : "=v"(r) : "v"(lo), "v"(hi)); return r; }
__device__ __forceinline__ void partialSM(f32x16& p0, f32x16& p1, float& m_reg, float& mn, float& alpha) {
  constexpr float C = SCALE * 1.4426950408889634f;
  float pmax = p0[0]; for (int r = 1; r < 16; ++r) pmax = fmaxf(pmax, p0[r]); for (int r = 0; r < 16; ++r) pmax = fmaxf(pmax, p1[r]);
  { auto rr = __builtin_amdgcn_permlane32_swap(__float_as_uint(pmax), __float_as_uint(pmax), false, false);
    pmax = fmaxf(__uint_as_float(rr[0]), __uint_as_float(rr[1])); }
  if (__builtin_expect(__all(pmax - m_reg <= THR / SCALE), 1)) { mn = m_reg; alpha = 1.f; }
  else { mn = fmaxf(m_reg, pmax); alpha = __builtin_amdgcn_exp2f((m_reg - mn) * C); m_reg = mn; }
  float mnC = -mn * C;
  for (int r = 0; r < 16; ++r) p0[r] = fmaf(p0[r], C, mnC); for (int r = 0; r < 16; ++r) p1[r] = fmaf(p1[r], C, mnC);
  for (int r = 0; r < 16; ++r) p0[r] = __builtin_amdgcn_exp2f(p0[r]);
}
__device__ __forceinline__ void finishSM(f32x16& p0, f32x16& p1, float alpha, float& l_reg, bf16x8& pa0, bf16x8& pa1, bf16x8& pa2, bf16x8& pa3) {
  for (int r = 0; r < 16; ++r) p1[r] = __builtin_amdgcn_exp2f(p1[r]);
  float ps = 0; for (int r = 0; r < 16; ++r) ps += p0[r]; for (int r = 0; r < 16; ++r) ps += p1[r];
  { auto rr = __builtin_amdgcn_permlane32_swap(__float_as_uint(ps), __float_as_uint(ps), false, false);
    ps = __uint_as_float(rr[0]) + __uint_as_float(rr[1]); }
  l_reg = l_reg * alpha + ps;
#define PK4(P, BASE, OUT) do { unsigned a0 = cvtpk(P[BASE + 0], P[BASE + 1]), a1 = cvtpk(P[BASE + 2], P[BASE + 3]);   \
    unsigned b0 = cvtpk(P[BASE + 4], P[BASE + 5]), b1 = cvtpk(P[BASE + 6], P[BASE + 7]);                              \
    auto r0 = __builtin_amdgcn_permlane32_swap(a0, b0, false, false); auto r1 = __builtin_amdgcn_permlane32_swap(a1, b1, false, false); \
    u32x4 w = {r0[0], r1[0], r0[1], r1[1]}; OUT = *reinterpret_cast<bf16x8*>(&w); } while (0)
  PK4(p0, 0, pa0); PK4(p0, 8, pa1); PK4(p1, 0, pa2); PK4(p1, 8, pa3);
#undef PK4
}
__device__ __forceinline__ void qkt(f32x16& p0, f32x16& p1, const bf16_t* Ks, const bf16x8* qr, int r32, int hi) {
  p0 = f32x16{}; p1 = f32x16{};
  for (int d0 = 0; d0 < 8; ++d0) { int cb = (d0 * 16 + hi * 8) * 2;
    bf16x8 b0 = *reinterpret_cast<const bf16x8*>((const char*)Ks + KSWZ(r32, cb));
    bf16x8 b1 = *reinterpret_cast<const bf16x8*>((const char*)Ks + KSWZ(32 + r32, cb));
    p0 = __builtin_amdgcn_mfma_f32_32x32x16_bf16(b0, qr[d0], p0, 0, 0, 0);
    p1 = __builtin_amdgcn_mfma_f32_32x32x16_bf16(b1, qr[d0], p1, 0, 0, 0); }
}
__device__ __forceinline__ int v_st(int k, int c) { const int kk = (k & ~0xC) | ((k & 4) << 1) | ((k & 8) >> 1); return ((kk >> 3) * 4 + (c >> 5)) * 512 + ((kk & 7) * 32 + (c & 31)) * 2; }
__device__ __forceinline__ int v_rd_base(int lane) { return ((lane & 3) << 3) | (((lane >> 2) & 3) << 6) | (((lane >> 4) & 1) << 5) | (((lane >> 5) & 1) << 8); }
constexpr int v_rd_off(int d0, int ks, int half) { return d0 * 512 + ks * 4096 + half * 2048; }
template <int OFF> __device__ __forceinline__ s16x4 tr_read(int vb) {
  s16x4 r; asm volatile("ds_read_b64_tr_b16 %0, %1 offset:%2" : "=&v"(r) : "v"(vb), "i"(OFF) : "memory"); return r;
}
template <int D0> __device__ __forceinline__ void pv_one(f32x16& od, int vb, bf16x8 pa0, bf16x8 pa1, bf16x8 pa2, bf16x8 pa3) {
  const s16x4 l0 = tr_read<v_rd_off(D0, 0, 0)>(vb), h0 = tr_read<v_rd_off(D0, 0, 1)>(vb), l1 = tr_read<v_rd_off(D0, 1, 0)>(vb), h1 = tr_read<v_rd_off(D0, 1, 1)>(vb);
  const s16x4 l2 = tr_read<v_rd_off(D0, 2, 0)>(vb), h2 = tr_read<v_rd_off(D0, 2, 1)>(vb), l3 = tr_read<v_rd_off(D0, 3, 0)>(vb), h3 = tr_read<v_rd_off(D0, 3, 1)>(vb);
  asm volatile("s_waitcnt lgkmcnt(0)" ::: "memory"); SBAR();
#define PK(L, H) (bf16x8){L[0], L[1], L[2], L[3], H[0], H[1], H[2], H[3]}
  od = __builtin_amdgcn_mfma_f32_32x32x16_bf16(pa0, PK(l0, h0), od, 0, 0, 0);
  od = __builtin_amdgcn_mfma_f32_32x32x16_bf16(pa1, PK(l1, h1), od, 0, 0, 0);
  od = __builtin_amdgcn_mfma_f32_32x32x16_bf16(pa2, PK(l2, h2), od, 0, 0, 0);
  od = __builtin_amdgcn_mfma_f32_32x32x16_bf16(pa3, PK(l3, h3), od, 0, 0, 0);
#undef PK
}
__device__ __forceinline__ void pv_d0(f32x16* o, int vb, bf16x8 pa0, bf16x8 pa1, bf16x8 pa2, bf16x8 pa3) {
  pv_one<0>(o[0], vb, pa0, pa1, pa2, pa3); pv_one<1>(o[1], vb, pa0, pa1, pa2, pa3); pv_one<2>(o[2], vb, pa0, pa1, pa2, pa3); pv_one<3>(o[3], vb, pa0, pa1, pa2, pa3);
}
__device__ __forceinline__ void attn_dense_body(const bf16_t* __restrict__ Qb, const bf16_t* __restrict__ Kh, const bf16_t* __restrict__ Vh,
                                                bf16_t* __restrict__ Ob, int seq, char* lds) {
  const int tid = threadIdx.x, wid = tid >> 6, lane = tid & 63, r32 = lane & 31, hi = lane >> 5;
  bf16_t* V_lds = (bf16_t*)lds; bf16_t* K_lds = (bf16_t*)(lds + 2 * SHM_V);
  float* ws = (float*)(lds + 2 * SHM_V + 2 * SHM_K) + wid * 64; float* li_l = ws; float* al_l = ws + 32;
  float m_reg = -1e30f, l_reg = 0; f32x16 o[4] = {}; bf16x8 qr[8];
  const bf16_t* Qw = Qb + (long)(wid * QBLK + r32) * LDQ + hi * 8;
#pragma unroll
  for (int d0 = 0; d0 < 8; ++d0) qr[d0] = *reinterpret_cast<const bf16x8*>(Qw + d0 * 16);
  const int sr = tid >> 4, sc = (tid & 15) * 8, vst0 = v_st(sr, sc), vst1 = v_st(32 + sr, sc);
  const int vb0 = (int)(uintptr_t)V_lds + v_rd_base(lane);
  struct { bf16x8 vs0, vs1, ks0, ks1; } sr_[2];
#define SLOAD(i, k0) do { sr_[i].vs0 = *reinterpret_cast<const bf16x8*>(&Vh[(long)((k0) + sr) * LDK + sc]); sr_[i].vs1 = *reinterpret_cast<const bf16x8*>(&Vh[(long)((k0) + 32 + sr) * LDK + sc]); \
    sr_[i].ks0 = *reinterpret_cast<const bf16x8*>(&Kh[(long)((k0) + sr) * LDK + sc]); sr_[i].ks1 = *reinterpret_cast<const bf16x8*>(&Kh[(long)((k0) + 32 + sr) * LDK + sc]); } while (0)
#define SWRITE(b, i) do { *(bf16x8*)((char*)V_lds + (b) * SHM_V + vst0) = sr_[i].vs0;          \
    *(bf16x8*)((char*)V_lds + (b) * SHM_V + vst1) = sr_[i].vs1; int kc = sc * 2;               \
    *(bf16x8*)((char*)K_lds + (b) * SHM_K + KSWZ(sr, kc)) = sr_[i].ks0;                       \
    *(bf16x8*)((char*)K_lds + (b) * SHM_K + KSWZ(32 + sr, kc)) = sr_[i].ks1; } while (0)
#define SWAIT() asm volatile("s_waitcnt vmcnt(4)" ::: "memory")
#define RESC(a) do { if (__any((a) < 1.f)) { if (hi == 0) al_l[r32] = (a); asm volatile("s_waitcnt lgkmcnt(0)" ::: "memory"); \
    for (int d = 0; d < 4; ++d) for (int r = 0; r < 16; ++r) o[d][r] *= al_l[crow(r, hi)]; } } while (0)
  f32x16 pA0, pA1, pB0, pB1; float mnA, mnB, alA, alB; bf16x8 pa0, pa1, pa2, pa3; const int NT = seq / KVBLK;
  constexpr int SE = 0, SO = 1;
  SLOAD(SE, 0); asm volatile("s_waitcnt vmcnt(0)" ::: "memory"); SWRITE(0, SE); __syncthreads();
  qkt(pA0, pA1, K_lds, qr, r32, hi); partialSM(pA0, pA1, m_reg, mnA, alA);
  SLOAD(SO, KVBLK); if (2 < NT) SLOAD(SE, 2 * KVBLK);
  SWAIT(); SWRITE(1, SO); __syncthreads();
  for (int j = 1; j + 1 < NT; j += 2) {
    SBAR(); qkt(pB0, pB1, (bf16_t*)((char*)K_lds + SHM_K), qr, r32, hi);
    finishSM(pA0, pA1, alA, l_reg, pa0, pa1, pa2, pa3); SBAR();
    SLOAD(SO, (j + 2) * KVBLK); SBAR();
    pv_d0(o, vb0, pa0, pa1, pa2, pa3); partialSM(pB0, pB1, m_reg, mnB, alB);
    __syncthreads(); SWAIT(); SWRITE(0, SE);
    RESC(alB); __syncthreads();
    SBAR(); qkt(pA0, pA1, K_lds, qr, r32, hi);
    finishSM(pB0, pB1, alB, l_reg, pa0, pa1, pa2, pa3); SBAR();
    if (j + 3 < NT) SLOAD(SE, (j + 3) * KVBLK); SBAR();
    pv_d0(o, vb0 + (int)SHM_V, pa0, pa1, pa2, pa3); partialSM(pA0, pA1, m_reg, mnA, alA);
    __syncthreads(); SWAIT(); SWRITE(1, SO);
    RESC(alA); __syncthreads();
  }
  SBAR(); qkt(pB0, pB1, (bf16_t*)((char*)K_lds + SHM_K), qr, r32, hi);
  finishSM(pA0, pA1, alA, l_reg, pa0, pa1, pa2, pa3); SBAR();
  pv_d0(o, vb0, pa0, pa1, pa2, pa3); partialSM(pB0, pB1, m_reg, mnB, alB);
  __syncthreads(); RESC(alB);
  finishSM(pB0, pB1, alB, l_reg, pa0, pa1, pa2, pa3); SBAR();
  pv_d0(o, vb0 + (int)SHM_V, pa0, pa1, pa2, pa3);
  if (hi == 0) li_l[r32] = l_reg; asm volatile("s_waitcnt lgkmcnt(0)" ::: "memory");
  float rli[16];
#pragma unroll
  for (int r = 0; r < 16; ++r) rli[r] = __builtin_amdgcn_rcpf(li_l[crow(r, hi)]);
  bf16_t* Ow = Ob + (long)(wid * QBLK) * LDO;
#pragma unroll
  for (int r = 0; r < 16; ++r) { int orow = crow(r, hi);
    for (int d0 = 0; d0 < 4; ++d0) Ow[(long)orow * LDO + d0 * 32 + r32] = (bf16_t)f2bf(o[d0][r] * rli[r]); }
  __syncthreads();
#undef SLOAD
#undef SWRITE
#undef SWAIT
#undef RESC
}
#undef KSWZ
#undef SBAR
}

__device__ __forceinline__ void phase_attn(const Args& a, char* lds) {
    unsigned char* ws = a.ws;
    const bf16_t* Q = (const bf16_t*)(ws + WS_Q); const bf16_t* Kb = (const bf16_t*)(ws + WS_K); const bf16_t* Vb = (const bf16_t*)(ws + WS_V);
    bf16_t* AO = (bf16_t*)(ws + WS_AO);
    const int NU = 256 + 8;
    for (int u = blockIdx.x; u < NU; u += gridDim.x) {
        int b, h, qrow0, nkeys;
        if (u < 256) { const int x = u & 7; b = x >> 2; h = x & 3; qrow0 = b * RPB + CTXL + (u >> 3) * 256; nkeys = RPB; }
        else { const int v = u - 256; b = v / 4; h = v % 4; qrow0 = b * RPB; nkeys = CTXL; }
        const int kvh = h >> 1; const size_t krow0 = (size_t)b * RPB;
        fa::attn_dense_body(Q + (size_t)qrow0 * 512 + h * 128, Kb + krow0 * 256 + kvh * 128, Vb + krow0 * 256 + kvh * 128, AO + (size_t)qrow0 * 1024 + 512 + h * 128, nkeys, lds);
    }
}

__device__ __forceinline__ void phase_outproj(const Args& a, char* lds, const bf16_t* A, int K, const bf16_t* Bt, int layer, int which_gate, int base_mode, bool latent_only) {
    float* Cs = (float*)lds;
    const int tid = threadIdx.x;
    float* X1 = (float*)(a.ws + WS_X1);
    const int NU = (MTOT / 128) * 8;
    for (int u = blockIdx.x; u < NU; u += gridDim.x) {
        const int rt = u / 8, ct = u % 8, row0 = rt * 128, col0 = ct * 128;
        if (latent_only && (rt % 66) < 2) continue;
        gemm_tile128(A + (size_t)row0 * K, K, Bt + (size_t)col0 * K, K, K, Cs);
        __syncthreads();
        const int rr = tid >> 2, q4 = tid & 3, g = row0 + rr;
        const float* crow = Cs + rr * CS_LD + q4 * 32;
        const float* gt = modv(a, layer, row_variant(g), which_gate) + col0 + q4 * 32;
        const float* base = (base_mode == 0 ? row_src(a, g) : X1 + (size_t)g * D) + col0 + q4 * 32;
        float* o = X1 + (size_t)g * D + col0 + q4 * 32;
#pragma unroll
        for (int c = 0; c < 32; c += 4) {
            const f32x4 bs = *(const f32x4*)(base + c), gv = *(const f32x4*)(gt + c);
            f32x4 r; r.x = bs.x + gv.x * crow[c]; r.y = bs.y + gv.y * crow[c + 1]; r.z = bs.z + gv.z * crow[c + 2]; r.w = bs.w + gv.w * crow[c + 3];
            *(f32x4*)(o + c) = r;
        }
        __syncthreads();
    }
}

__device__ __forceinline__ void phase_peerq(const Args& a, char* lds, int layer, bool latent_only) {
    float* Cs = (float*)lds;
    const int tid = threadIdx.x;
    const bf16_t* H = (const bf16_t*)(a.ws + WS_H); const bf16_t* W = (const bf16_t*)(a.ws + WS_WQ) + (size_t)layer * 2048 * 1024;
    bf16_t* QP = (bf16_t*)(a.ws + WS_QP);
    const int NU = (MTOT / 128) * 16;
    for (int u = blockIdx.x; u < NU; u += gridDim.x) {
        const int rt = u / 16, ct = u % 16, row0 = rt * 128, col0 = ct * 128;
        if (latent_only && (rt % 66) < 2) continue;
        gemm_tile128(H + (size_t)row0 * D, D, W + (size_t)col0 * D, D, D, Cs);
        __syncthreads();
        const int rr = tid >> 2, q4 = tid & 3, g = row0 + rr;
        const float* crow = Cs + rr * CS_LD + q4 * 32;
        bf16_t* o = QP + (size_t)g * 2048 + col0 + q4 * 32;
#pragma unroll
        for (int c = 0; c < 32; c += 2) *(unsigned*)(o + c) = pk2(crow[c], crow[c + 1]);
        __syncthreads();
    }
}

__device__ __forceinline__ void wave_argmax(float& v, int& i) {
#pragma unroll
    for (int o = 1; o < 64; o <<= 1) {
        const float ov = __shfl_xor(v, o); const int oi = __shfl_xor(i, o);
        if (ov > v || (ov == v && oi < i)) { v = ov; i = oi; }
    }
}
__device__ __forceinline__ void phase_peer_topk(const Args& a, int layer, bool latent_only) {
    const int lane = threadIdx.x & 63, gw = blockIdx.x * NWAVE + (threadIdx.x >> 6), ngw = gridDim.x * NWAVE;
    const bf16_t* QP = (const bf16_t*)(a.ws + WS_QP);
    const bf16_t* KEYS = (const bf16_t*)(a.ws + WS_KEYS) + (size_t)layer * 8 * 2 * 128 * 128;
    int* SELI = (int*)(a.ws + WS_SELI); float* SELG = (float*)(a.ws + WS_SELG);
    for (int it = gw; it < MTOT * 8; it += ngw) {
        const int g = it >> 3, h = it & 7;
        if (latent_only && row_variant(g) == 2) continue;
        float tv[2]; int ti[2];
#pragma unroll
        for (int s = 0; s < 2; ++s) {
            const bf16_t* qp = QP + (size_t)g * 2048 + h * 256 + s * 128;
            const bf16_t* k0p = KEYS + ((size_t)(h * 2 + s) * 128 + lane) * 128;
            const bf16_t* k1p = k0p + 64 * 128;
            float s0 = 0.f, s1 = 0.f;
#pragma unroll 4
            for (int d = 0; d < 128; d += 8) {
                const u32x4 qw = *(const u32x4*)(qp + d), ka = *(const u32x4*)(k0p + d), kb = *(const u32x4*)(k1p + d);
                s0 += bflo(qw.x) * bflo(ka.x) + bfhi(qw.x) * bfhi(ka.x) + bflo(qw.y) * bflo(ka.y) + bfhi(qw.y) * bfhi(ka.y)
                    + bflo(qw.z) * bflo(ka.z) + bfhi(qw.z) * bfhi(ka.z) + bflo(qw.w) * bflo(ka.w) + bfhi(qw.w) * bfhi(ka.w);
                s1 += bflo(qw.x) * bflo(kb.x) + bfhi(qw.x) * bfhi(kb.x) + bflo(qw.y) * bflo(kb.y) + bfhi(qw.y) * bfhi(kb.y)
                    + bflo(qw.z) * bflo(kb.z) + bfhi(qw.z) * bfhi(kb.z) + bflo(qw.w) * bflo(kb.w) + bfhi(qw.w) * bfhi(kb.w);
            }
            float myv = 0.f; int myi = 0;
            for (int r = 0; r < 16; ++r) {
                float bv; int bi;
                if (s0 >= s1) { bv = s0; bi = lane; } else { bv = s1; bi = lane + 64; }
                wave_argmax(bv, bi);
                if (bi == lane) s0 = -INFINITY; else if (bi == lane + 64) s1 = -INFINITY;
                if (lane == r) { myv = bv; myi = bi; }
            }
            tv[s] = myv; ti[s] = myi;
        }
        float cv[4]; int ci[4];
        {
            const float v0 = __shfl(tv[0], lane >> 2); const int i0 = __shfl(ti[0], lane >> 2);
#pragma unroll
            for (int m = 0; m < 4; ++m) { const int j = (lane & 3) * 4 + m; cv[m] = v0 + __shfl(tv[1], j); ci[m] = i0 * 128 + __shfl(ti[1], j); }
        }
        float topv = 0.f; int tope = 0;
        for (int r = 0; r < 16; ++r) {
            float bv = cv[0]; int bp = lane * 4;
#pragma unroll
            for (int m = 1; m < 4; ++m) if (cv[m] > bv) { bv = cv[m]; bp = lane * 4 + m; }
            wave_argmax(bv, bp);
            int be = 0;
#pragma unroll
            for (int m = 0; m < 4; ++m) if (bp == lane * 4 + m) { be = ci[m]; cv[m] = -INFINITY; }
            be = __shfl(be, bp >> 2);
            if (lane == r) { topv = bv; tope = be; }
        }
        const float mx = __shfl(topv, 0);
        float e = lane < 16 ? __expf(topv - mx) : 0.f;
        float sum = e;
#pragma unroll
        for (int o = 1; o < 16; o <<= 1) sum += __shfl_xor(sum, o);
        if (lane < 16) { SELI[(size_t)g * 128 + h * 16 + lane] = tope; SELG[(size_t)g * 128 + h * 16 + lane] = e / sum; }
    }
}

constexpr int TK_LD = 136;
__device__ __forceinline__ int peer_tok(int i, int mode);
namespace tk {
__device__ __forceinline__ void ce(float& a, float& b) { const float mx = __builtin_fmaxf(a, b), mn = __builtin_fminf(a, b); a = mx; b = mn; }
__device__ __forceinline__ void sort16_desc(float (&v)[16]) {
#pragma unroll
    for (int ks = 1; ks <= 4; ++ks)
#pragma unroll
        for (int js = ks - 1; js >= 0; --js)
#pragma unroll
            for (int i = 0; i < 16; ++i) { const int k = 1 << ks, j = 1 << js, l = i ^ j; if (l > i) { if ((i & k) == 0) ce(v[i], v[l]); else ce(v[l], v[i]); } }
}
__device__ __forceinline__ void merge16_desc(float (&v)[16]) {
#pragma unroll
    for (int js = 3; js >= 0; --js)
#pragma unroll
        for (int i = 0; i < 16; ++i) { const int j = 1 << js, l = i ^ j; if (l > i) ce(v[i], v[l]); }
}
__device__ __forceinline__ void merge_prune(float (&x)[16], const float (&y)[16]) {
#pragma unroll
    for (int i = 0; i < 16; ++i) x[i] = __builtin_fmaxf(x[i], y[15 - i]);
    merge16_desc(x);
}
__host__ __device__ constexpr bool pair_ok(int i, int j) { return (i + 1) * (j + 1) <= 16; }
__host__ __device__ constexpr int pair_index(int i, int j) { int n = 0; for (int a = 0; a < 16; ++a) for (int b = 0; b < 16; ++b) { if (a == i && b == j) return n; if (pair_ok(a, b)) ++n; } return n; }
static_assert(pair_index(15, 15) == 49 + 0 || true, "");
}
__device__ __forceinline__ void topk_item(const bf16_t* QP, const bf16_t* KEYS, int* SELI, float* SELG, int g0, int h, int r32, int hh) {
    float top[2][16];
#pragma unroll
    for (int s = 0; s < 2; ++s) {
        bf16x8 qf[8];
        unsigned qoff = (unsigned)(r32 * 2048 + 8 * hh), koff = (unsigned)(r32 * 128 + 8 * hh); asm volatile("" : "+v"(qoff), "+v"(koff));
        const bf16_t* qb = QP + (size_t)g0 * 2048 + h * 256 + s * 128;
#pragma unroll
        for (int k = 0; k < 8; ++k) qf[k] = *(const bf16x8*)(qb + qoff + k * 16);
        float grp[4][16];
#pragma unroll
        for (int kb = 0; kb < 4; ++kb) {
            const bf16_t* kbp = KEYS + (size_t)(h * 2 + s) * 128 * 128 + kb * 32 * 128;
            f32x16 acc = {};
#pragma unroll
            for (int k = 0; k < 8; ++k) { const bf16x8 kf = *(const bf16x8*)(kbp + koff + k * 16); acc = __builtin_amdgcn_mfma_f32_32x32x16_bf16(kf, qf[k], acc, 0, 0, 0); }
#pragma unroll
            for (int r = 0; r < 16; ++r) { const int key = kb * 32 + (r & 3) + 8 * (r >> 2) + 4 * hh; grp[kb][r] = __uint_as_float((__float_as_uint(acc[r]) & ~127u) | (unsigned)key); }
            tk::sort16_desc(grp[kb]); __builtin_amdgcn_sched_barrier(0);
        }
        tk::merge_prune(grp[0], grp[1]); __builtin_amdgcn_sched_barrier(0); tk::merge_prune(grp[2], grp[3]); __builtin_amdgcn_sched_barrier(0); tk::merge_prune(grp[0], grp[2]); __builtin_amdgcn_sched_barrier(0);
        float oth[16];
#pragma unroll
        for (int r = 0; r < 16; ++r) { const auto rr = __builtin_amdgcn_permlane32_swap(__float_as_uint(grp[0][r]), __float_as_uint(grp[0][r]), false, false); oth[r] = __uint_as_float(hh == 0 ? rr[1] : rr[0]); }
        tk::merge_prune(grp[0], oth);
#pragma unroll
        for (int r = 0; r < 16; ++r) top[s][r] = grp[0][r];
        __builtin_amdgcn_sched_barrier(0);
    }
    float cg[4][16];
#pragma unroll
    for (int q = 0; q < 4; ++q)
#pragma unroll
        for (int r = 0; r < 16; ++r) cg[q][r] = -INFINITY;
    cg[0][0] = __uint_as_float((__float_as_uint(top[0][0] + top[1][0]) & ~255u) | 0u);
    cg[0][1] = __uint_as_float((__float_as_uint(top[0][0] + top[1][1]) & ~255u) | 1u);
    cg[0][2] = __uint_as_float((__float_as_uint(top[0][0] + top[1][2]) & ~255u) | 2u);
    cg[0][3] = __uint_as_float((__float_as_uint(top[0][0] + top[1][3]) & ~255u) | 3u);
    cg[0][4] = __uint_as_float((__float_as_uint(top[0][0] + top[1][4]) & ~255u) | 4u);
    cg[0][5] = __uint_as_float((__float_as_uint(top[0][0] + top[1][5]) & ~255u) | 5u);
    cg[0][6] = __uint_as_float((__float_as_uint(top[0][0] + top[1][6]) & ~255u) | 6u);
    cg[0][7] = __uint_as_float((__float_as_uint(top[0][0] + top[1][7]) & ~255u) | 7u);
    cg[0][8] = __uint_as_float((__float_as_uint(top[0][0] + top[1][8]) & ~255u) | 8u);
    cg[0][9] = __uint_as_float((__float_as_uint(top[0][0] + top[1][9]) & ~255u) | 9u);
    cg[0][10] = __uint_as_float((__float_as_uint(top[0][0] + top[1][10]) & ~255u) | 10u);
    cg[0][11] = __uint_as_float((__float_as_uint(top[0][0] + top[1][11]) & ~255u) | 11u);
    cg[0][12] = __uint_as_float((__float_as_uint(top[0][0] + top[1][12]) & ~255u) | 12u);
    cg[0][13] = __uint_as_float((__float_as_uint(top[0][0] + top[1][13]) & ~255u) | 13u);
    cg[0][14] = __uint_as_float((__float_as_uint(top[0][0] + top[1][14]) & ~255u) | 14u);
    cg[0][15] = __uint_as_float((__float_as_uint(top[0][0] + top[1][15]) & ~255u) | 15u);
    cg[1][0] = __uint_as_float((__float_as_uint(top[0][1] + top[1][0]) & ~255u) | 16u);
    cg[1][1] = __uint_as_float((__float_as_uint(top[0][1] + top[1][1]) & ~255u) | 17u);
    cg[1][2] = __uint_as_float((__float_as_uint(top[0][1] + top[1][2]) & ~255u) | 18u);
    cg[1][3] = __uint_as_float((__float_as_uint(top[0][1] + top[1][3]) & ~255u) | 19u);
    cg[1][4] = __uint_as_float((__float_as_uint(top[0][1] + top[1][4]) & ~255u) | 20u);
    cg[1][5] = __uint_as_float((__float_as_uint(top[0][1] + top[1][5]) & ~255u) | 21u);
    cg[1][6] = __uint_as_float((__float_as_uint(top[0][1] + top[1][6]) & ~255u) | 22u);
    cg[1][7] = __uint_as_float((__float_as_uint(top[0][1] + top[1][7]) & ~255u) | 23u);
    cg[1][8] = __uint_as_float((__float_as_uint(top[0][2] + top[1][0]) & ~255u) | 32u);
    cg[1][9] = __uint_as_float((__float_as_uint(top[0][2] + top[1][1]) & ~255u) | 33u);
    cg[1][10] = __uint_as_float((__float_as_uint(top[0][2] + top[1][2]) & ~255u) | 34u);
    cg[1][11] = __uint_as_float((__float_as_uint(top[0][2] + top[1][3]) & ~255u) | 35u);
    cg[1][12] = __uint_as_float((__float_as_uint(top[0][2] + top[1][4]) & ~255u) | 36u);
    cg[1][13] = __uint_as_float((__float_as_uint(top[0][3] + top[1][0]) & ~255u) | 48u);
    cg[1][14] = __uint_as_float((__float_as_uint(top[0][3] + top[1][1]) & ~255u) | 49u);
    cg[1][15] = __uint_as_float((__float_as_uint(top[0][3] + top[1][2]) & ~255u) | 50u);
    cg[2][0] = __uint_as_float((__float_as_uint(top[0][3] + top[1][3]) & ~255u) | 51u);
    cg[2][1] = __uint_as_float((__float_as_uint(top[0][4] + top[1][0]) & ~255u) | 64u);
    cg[2][2] = __uint_as_float((__float_as_uint(top[0][4] + top[1][1]) & ~255u) | 65u);
    cg[2][3] = __uint_as_float((__float_as_uint(top[0][4] + top[1][2]) & ~255u) | 66u);
    cg[2][4] = __uint_as_float((__float_as_uint(top[0][5] + top[1][0]) & ~255u) | 80u);
    cg[2][5] = __uint_as_float((__float_as_uint(top[0][5] + top[1][1]) & ~255u) | 81u);
    cg[2][6] = __uint_as_float((__float_as_uint(top[0][6] + top[1][0]) & ~255u) | 96u);
    cg[2][7] = __uint_as_float((__float_as_uint(top[0][6] + top[1][1]) & ~255u) | 97u);
    cg[2][8] = __uint_as_float((__float_as_uint(top[0][7] + top[1][0]) & ~255u) | 112u);
    cg[2][9] = __uint_as_float((__float_as_uint(top[0][7] + top[1][1]) & ~255u) | 113u);
    cg[2][10] = __uint_as_float((__float_as_uint(top[0][8] + top[1][0]) & ~255u) | 128u);
    cg[2][11] = __uint_as_float((__float_as_uint(top[0][9] + top[1][0]) & ~255u) | 144u);
    cg[2][12] = __uint_as_float((__float_as_uint(top[0][10] + top[1][0]) & ~255u) | 160u);
    cg[2][13] = __uint_as_float((__float_as_uint(top[0][11] + top[1][0]) & ~255u) | 176u);
    cg[2][14] = __uint_as_float((__float_as_uint(top[0][12] + top[1][0]) & ~255u) | 192u);
    cg[2][15] = __uint_as_float((__float_as_uint(top[0][13] + top[1][0]) & ~255u) | 208u);
    cg[3][0] = __uint_as_float((__float_as_uint(top[0][14] + top[1][0]) & ~255u) | 224u);
    cg[3][1] = __uint_as_float((__float_as_uint(top[0][15] + top[1][0]) & ~255u) | 240u);
#pragma unroll
    for (int q = 0; q < 4; ++q) { tk::sort16_desc(cg[q]); __builtin_amdgcn_sched_barrier(0); }
    tk::merge_prune(cg[0], cg[1]); __builtin_amdgcn_sched_barrier(0); tk::merge_prune(cg[2], cg[3]); __builtin_amdgcn_sched_barrier(0); tk::merge_prune(cg[0], cg[2]); __builtin_amdgcn_sched_barrier(0);
    int eidx[16]; float ev[16]; float sum = 0.f;
#pragma unroll
    for (int r = 0; r < 16; ++r) {
        const unsigned bits = __float_as_uint(cg[0][r]); const int ci = (bits >> 4) & 15, cj = bits & 15;
        int ia = 0, ib = 0;
#pragma unroll
        for (int i = 0; i < 16; ++i) { ia = (ci == i) ? (int)(__float_as_uint(top[0][i]) & 127u) : ia; ib = (cj == i) ? (int)(__float_as_uint(top[1][i]) & 127u) : ib; }
        eidx[r] = ia * 128 + ib;
        ev[r] = __expf(cg[0][r] - cg[0][0]); sum += ev[r];
    }
    const float rs = 1.f / sum;
    int* oi = SELI + (size_t)(g0 + r32) * 128 + h * 16 + hh * 8; float* og = SELG + (size_t)(g0 + r32) * 128 + h * 16 + hh * 8;
    if (hh == 0) {
#pragma unroll
        for (int r = 0; r < 8; ++r) { oi[r] = eidx[r]; og[r] = ev[r] * rs; }
    } else {
#pragma unroll
        for (int r = 0; r < 8; ++r) { oi[r] = eidx[8 + r]; og[r] = ev[8 + r] * rs; }
    }
}
__device__ __forceinline__ void topk_item_lds(const bf16_t* QP, LAS const bf16_t* KL, int* SELI, float* SELG, int g0, int h, int r32, int hh) {
    float top[2][16];
#pragma unroll
    for (int s = 0; s < 2; ++s) {
        bf16x8 qf[8];
        unsigned qoff = (unsigned)(r32 * 2048 + 8 * hh), koff = (unsigned)(r32 * 128 + 8 * hh); asm volatile("" : "+v"(qoff), "+v"(koff));
        const bf16_t* qb = QP + (size_t)g0 * 2048 + h * 256 + s * 128;
#pragma unroll
        for (int k = 0; k < 8; ++k) qf[k] = *(const bf16x8*)(qb + qoff + k * 16);
        float grp[4][16];
#pragma unroll
        for (int kb = 0; kb < 4; ++kb) {
            LAS const bf16_t* kbp = KL + (s * 128 + kb * 32 + r32) * TK_LD + 8 * hh;
            f32x16 acc = {};
#pragma unroll
            for (int k = 0; k < 8; ++k) { const bf16x8 kf = *(LAS const bf16x8*)(kbp + k * 16); acc = __builtin_amdgcn_mfma_f32_32x32x16_bf16(kf, qf[k], acc, 0, 0, 0); }
#pragma unroll
            for (int r = 0; r < 16; ++r) { const int key = kb * 32 + (r & 3) + 8 * (r >> 2) + 4 * hh; grp[kb][r] = __uint_as_float((__float_as_uint(acc[r]) & ~127u) | (unsigned)key); }
            tk::sort16_desc(grp[kb]); __builtin_amdgcn_sched_barrier(0);
        }
        tk::merge_prune(grp[0], grp[1]); __builtin_amdgcn_sched_barrier(0); tk::merge_prune(grp[2], grp[3]); __builtin_amdgcn_sched_barrier(0); tk::merge_prune(grp[0], grp[2]); __builtin_amdgcn_sched_barrier(0);
        float oth[16];
#pragma unroll
        for (int r = 0; r < 16; ++r) { const auto rr = __builtin_amdgcn_permlane32_swap(__float_as_uint(grp[0][r]), __float_as_uint(grp[0][r]), false, false); oth[r] = __uint_as_float(hh == 0 ? rr[1] : rr[0]); }
        tk::merge_prune(grp[0], oth);
#pragma unroll
        for (int r = 0; r < 16; ++r) top[s][r] = grp[0][r];
        __builtin_amdgcn_sched_barrier(0);
    }
    float cg[4][16];
#pragma unroll
    for (int q = 0; q < 4; ++q)
#pragma unroll
        for (int r = 0; r < 16; ++r) cg[q][r] = -INFINITY;
    cg[0][0] = __uint_as_float((__float_as_uint(top[0][0] + top[1][0]) & ~255u) | 0u);
    cg[0][1] = __uint_as_float((__float_as_uint(top[0][0] + top[1][1]) & ~255u) | 1u);
    cg[0][2] = __uint_as_float((__float_as_uint(top[0][0] + top[1][2]) & ~255u) | 2u);
    cg[0][3] = __uint_as_float((__float_as_uint(top[0][0] + top[1][3]) & ~255u) | 3u);
    cg[0][4] = __uint_as_float((__float_as_uint(top[0][0] + top[1][4]) & ~255u) | 4u);
    cg[0][5] = __uint_as_float((__float_as_uint(top[0][0] + top[1][5]) & ~255u) | 5u);
    cg[0][6] = __uint_as_float((__float_as_uint(top[0][0] + top[1][6]) & ~255u) | 6u);
    cg[0][7] = __uint_as_float((__float_as_uint(top[0][0] + top[1][7]) & ~255u) | 7u);
    cg[0][8] = __uint_as_float((__float_as_uint(top[0][0] + top[1][8]) & ~255u) | 8u);
    cg[0][9] = __uint_as_float((__float_as_uint(top[0][0] + top[1][9]) & ~255u) | 9u);
    cg[0][10] = __uint_as_float((__float_as_uint(top[0][0] + top[1][10]) & ~255u) | 10u);
    cg[0][11] = __uint_as_float((__float_as_uint(top[0][0] + top[1][11]) & ~255u) | 11u);
    cg[0][12] = __uint_as_float((__float_as_uint(top[0][0] + top[1][12]) & ~255u) | 12u);
    cg[0][13] = __uint_as_float((__float_as_uint(top[0][0] + top[1][13]) & ~255u) | 13u);
    cg[0][14] = __uint_as_float((__float_as_uint(top[0][0] + top[1][14]) & ~255u) | 14u);
    cg[0][15] = __uint_as_float((__float_as_uint(top[0][0] + top[1][15]) & ~255u) | 15u);
    cg[1][0] = __uint_as_float((__float_as_uint(top[0][1] + top[1][0]) & ~255u) | 16u);
    cg[1][1] = __uint_as_float((__float_as_uint(top[0][1] + top[1][1]) & ~255u) | 17u);
    cg[1][2] = __uint_as_float((__float_as_uint(top[0][1] + top[1][2]) & ~255u) | 18u);
    cg[1][3] = __uint_as_float((__float_as_uint(top[0][1] + top[1][3]) & ~255u) | 19u);
    cg[1][4] = __uint_as_float((__float_as_uint(top[0][1] + top[1][4]) & ~255u) | 20u);
    cg[1][5] = __uint_as_float((__float_as_uint(top[0][1] + top[1][5]) & ~255u) | 21u);
    cg[1][6] = __uint_as_float((__float_as_uint(top[0][1] + top[1][6]) & ~255u) | 22u);
    cg[1][7] = __uint_as_float((__float_as_uint(top[0][1] + top[1][7]) & ~255u) | 23u);
    cg[1][8] = __uint_as_float((__float_as_uint(top[0][2] + top[1][0]) & ~255u) | 32u);
    cg[1][9] = __uint_as_float((__float_as_uint(top[0][2] + top[1][1]) & ~255u) | 33u);
    cg[1][10] = __uint_as_float((__float_as_uint(top[0][2] + top[1][2]) & ~255u) | 34u);
    cg[1][11] = __uint_as_float((__float_as_uint(top[0][2] + top[1][3]) & ~255u) | 35u);
    cg[1][12] = __uint_as_float((__float_as_uint(top[0][2] + top[1][4]) & ~255u) | 36u);
    cg[1][13] = __uint_as_float((__float_as_uint(top[0][3] + top[1][0]) & ~255u) | 48u);
    cg[1][14] = __uint_as_float((__float_as_uint(top[0][3] + top[1][1]) & ~255u) | 49u);
    cg[1][15] = __uint_as_float((__float_as_uint(top[0][3] + top[1][2]) & ~255u) | 50u);
    cg[2][0] = __uint_as_float((__float_as_uint(top[0][3] + top[1][3]) & ~255u) | 51u);
    cg[2][1] = __uint_as_float((__float_as_uint(top[0][4] + top[1][0]) & ~255u) | 64u);
    cg[2][2] = __uint_as_float((__float_as_uint(top[0][4] + top[1][1]) & ~255u) | 65u);
    cg[2][3] = __uint_as_float((__float_as_uint(top[0][4] + top[1][2]) & ~255u) | 66u);
    cg[2][4] = __uint_as_float((__float_as_uint(top[0][5] + top[1][0]) & ~255u) | 80u);
    cg[2][5] = __uint_as_float((__float_as_uint(top[0][5] + top[1][1]) & ~255u) | 81u);
    cg[2][6] = __uint_as_float((__float_as_uint(top[0][6] + top[1][0]) & ~255u) | 96u);
    cg[2][7] = __uint_as_float((__float_as_uint(top[0][6] + top[1][1]) & ~255u) | 97u);
    cg[2][8] = __uint_as_float((__float_as_uint(top[0][7] + top[1][0]) & ~255u) | 112u);
    cg[2][9] = __uint_as_float((__float_as_uint(top[0][7] + top[1][1]) & ~255u) | 113u);
    cg[2][10] = __uint_as_float((__float_as_uint(top[0][8] + top[1][0]) & ~255u) | 128u);
    cg[2][11] = __uint_as_float((__float_as_uint(top[0][9] + top[1][0]) & ~255u) | 144u);
    cg[2][12] = __uint_as_float((__float_as_uint(top[0][10] + top[1][0]) & ~255u) | 160u);
    cg[2][13] = __uint_as_float((__float_as_uint(top[0][11] + top[1][0]) & ~255u) | 176u);
    cg[2][14] = __uint_as_float((__float_as_uint(top[0][12] + top[1][0]) & ~255u) | 192u);
    cg[2][15] = __uint_as_float((__float_as_uint(top[0][13] + top[1][0]) & ~255u) | 208u);
    cg[3][0] = __uint_as_float((__float_as_uint(top[0][14] + top[1][0]) & ~255u) | 224u);
    cg[3][1] = __uint_as_float((__float_as_uint(top[0][15] + top[1][0]) & ~255u) | 240u);
#pragma unroll
    for (int q = 0; q < 4; ++q) { tk::sort16_desc(cg[q]); __builtin_amdgcn_sched_barrier(0); }
    tk::merge_prune(cg[0], cg[1]); __builtin_amdgcn_sched_barrier(0); tk::merge_prune(cg[2], cg[3]); __builtin_amdgcn_sched_barrier(0); tk::merge_prune(cg[0], cg[2]); __builtin_amdgcn_sched_barrier(0);
    int eidx[16]; float ev[16]; float sum = 0.f;
#pragma unroll
    for (int r = 0; r < 16; ++r) {
        const unsigned bits = __float_as_uint(cg[0][r]); const int ci = (bits >> 4) & 15, cj = bits & 15;
        int ia = 0, ib = 0;
#pragma unroll
        for (int i = 0; i < 16; ++i) { ia = (ci == i) ? (int)(__float_as_uint(top[0][i]) & 127u) : ia; ib = (cj == i) ? (int)(__float_as_uint(top[1][i]) & 127u) : ib; }
        eidx[r] = ia * 128 + ib;
        ev[r] = __expf(cg[0][r] - cg[0][0]); sum += ev[r];
    }
    const float rs = 1.f / sum;
    int* oi = SELI + (size_t)(g0 + r32) * 128 + h * 16 + hh * 8; float* og = SELG + (size_t)(g0 + r32) * 128 + h * 16 + hh * 8;
    if (hh == 0) {
#pragma unroll
        for (int r = 0; r < 8; ++r) { oi[r] = eidx[r]; og[r] = ev[r] * rs; }
    } else {
#pragma unroll
        for (int r = 0; r < 8; ++r) { oi[r] = eidx[8 + r]; og[r] = ev[8 + r] * rs; }
    }
}

__device__ __forceinline__ void phase_peer_topk3(const Args& a, char* lds, int layer, bool latent_only) {
    const int tid = threadIdx.x, lane = tid & 63, r32 = lane & 31, hh = lane >> 5, wid = __builtin_amdgcn_readfirstlane(tid >> 6);
    const int h = blockIdx.x & 7, stripe = blockIdx.x >> 3, nstr = (gridDim.x >> 3) * NWAVE;
    const bf16_t* QP = (const bf16_t*)(a.ws + WS_QP);
    const bf16_t* KEYS = (const bf16_t*)(a.ws + WS_KEYS) + (size_t)layer * 8 * 2 * 128 * 128 + (size_t)h * 2 * 128 * 128;
    int* SELI = (int*)(a.ws + WS_SELI); float* SELG = (float*)(a.ws + WS_SELG);
    LAS bf16_t* KL = (LAS bf16_t*)((LAS char*)lds);
    for (int i = tid; i < 2 * 128 * 16; i += NTHR) { const int row = i >> 4, c8 = (i & 15) * 8; *(LAS u32x4*)(KL + row * TK_LD + c8) = *(const u32x4*)(KEYS + (size_t)row * 128 + c8); }
    __syncthreads();
    const int ngrp = latent_only ? (NB * SEQ) / 32 : MTOT / 32;
    for (int i = stripe * NWAVE + wid; i < ngrp; i += nstr) {
        const int g0 = latent_only ? peer_tok(i * 32, 1) : i * 32;
        topk_item_lds(QP, KL, SELI, SELG, g0, h, r32, hh);
    }
}
__device__ __forceinline__ void phase_peer_topk2(const Args& a, int layer, bool latent_only) {
    const int lane = threadIdx.x & 63, r32 = lane & 31, hh = lane >> 5, gw = blockIdx.x * NWAVE + __builtin_amdgcn_readfirstlane(threadIdx.x >> 6), ngw = gridDim.x * NWAVE;
    const bf16_t* QP = (const bf16_t*)(a.ws + WS_QP);
    const bf16_t* KEYS = (const bf16_t*)(a.ws + WS_KEYS) + (size_t)layer * 8 * 2 * 128 * 128;
    int* SELI = (int*)(a.ws + WS_SELI); float* SELG = (float*)(a.ws + WS_SELG);
    const int NIT = (MTOT / 32) * 8;
    for (int it = gw; it < NIT; it += ngw) {
        const int tg = it >> 3, h = it & 7, g0 = tg * 32;
        if (latent_only && row_variant(g0) == 2) continue;
        topk_item(QP, KEYS, SELI, SELG, g0, h, r32, hh);
    }
}

__device__ __forceinline__ void phase_peer_gather(const Args& a, int layer, int mode) {
    const int lane = threadIdx.x & 63, gw = blockIdx.x * NWAVE + (threadIdx.x >> 6), ngw = gridDim.x * NWAVE;
    unsigned char* ws = a.ws;
    bf16_t* H = (bf16_t*)(ws + WS_H); float* X1 = (float*)(ws + WS_X1);
    const bf16_t* PU = (const bf16_t*)(ws + WS_PU) + (size_t)layer * NEXP * D; const bf16_t* PV = (const bf16_t*)(ws + WS_PV) + (size_t)layer * NEXP * D;
    const int* SELI = (const int*)(ws + WS_SELI); const float* SELG = (const float*)(ws + WS_SELG);
    for (int g = gw; g < MTOT; g += ngw) {
        const int var = row_variant(g);
        if (mode == 1 && var == 2) continue;
        float hp[16], acc[16];
        {
            const u32x4 w0 = *(const u32x4*)(H + (size_t)g * D + lane * 16), w1 = *(const u32x4*)(H + (size_t)g * D + lane * 16 + 8);
            hp[0] = bflo(w0.x); hp[1] = bfhi(w0.x); hp[2] = bflo(w0.y); hp[3] = bfhi(w0.y); hp[4] = bflo(w0.z); hp[5] = bfhi(w0.z); hp[6] = bflo(w0.w); hp[7] = bfhi(w0.w);
            hp[8] = bflo(w1.x); hp[9] = bfhi(w1.x); hp[10] = bflo(w1.y); hp[11] = bfhi(w1.y); hp[12] = bflo(w1.z); hp[13] = bfhi(w1.z); hp[14] = bflo(w1.w); hp[15] = bfhi(w1.w);
#pragma unroll
            for (int d = 0; d < 16; ++d) acc[d] = 0.f;
        }
        const int myi0 = SELI[(size_t)g * 128 + lane], myi1 = SELI[(size_t)g * 128 + 64 + lane];
        const float myg0 = SELG[(size_t)g * 128 + lane], myg1 = SELG[(size_t)g * 128 + 64 + lane];
        for (int e = 0; e < 128; ++e) {
            const int ei = e < 64 ? __shfl(myi0, e) : __shfl(myi1, e - 64);
            const float eg = e < 64 ? __shfl(myg0, e) : __shfl(myg1, e - 64);
            const bf16_t* up = PU + (size_t)ei * D + lane * 16; const bf16_t* vp = PV + (size_t)ei * D + lane * 16;
            const u32x4 u0 = *(const u32x4*)up, u1 = *(const u32x4*)(up + 8), v0 = *(const u32x4*)vp, v1 = *(const u32x4*)(vp + 8);
            float dt = hp[0] * bflo(u0.x) + hp[1] * bfhi(u0.x) + hp[2] * bflo(u0.y) + hp[3] * bfhi(u0.y) + hp[4] * bflo(u0.z) + hp[5] * bfhi(u0.z) + hp[6] * bflo(u0.w) + hp[7] * bfhi(u0.w)
                     + hp[8] * bflo(u1.x) + hp[9] * bfhi(u1.x) + hp[10] * bflo(u1.y) + hp[11] * bfhi(u1.y) + hp[12] * bflo(u1.z) + hp[13] * bfhi(u1.z) + hp[14] * bflo(u1.w) + hp[15] * bfhi(u1.w);
            dt = wave_sum(dt);
            const float act = gelu_t(dt) * eg;
            acc[0] += act * bflo(v0.x); acc[1] += act * bfhi(v0.x); acc[2] += act * bflo(v0.y); acc[3] += act * bfhi(v0.y);
            acc[4] += act * bflo(v0.z); acc[5] += act * bfhi(v0.z); acc[6] += act * bflo(v0.w); acc[7] += act * bfhi(v0.w);
            acc[8] += act * bflo(v1.x); acc[9] += act * bfhi(v1.x); acc[10] += act * bflo(v1.y); acc[11] += act * bfhi(v1.y);
            acc[12] += act * bflo(v1.z); acc[13] += act * bfhi(v1.z); acc[14] += act * bflo(v1.w); acc[15] += act * bfhi(v1.w);
        }
        float* xr = X1 + (size_t)g * D + lane * 16;
        const float* g2 = modv(a, layer, var, 5) + lane * 16;
        float xn[16]; float ss = 0.f;
#pragma unroll
        for (int d = 0; d < 16; d += 4) {
            const f32x4 xv = *(const f32x4*)(xr + d), gv = *(const f32x4*)(g2 + d);
            xn[d] = xv.x + gv.x * acc[d]; xn[d + 1] = xv.y + gv.y * acc[d + 1]; xn[d + 2] = xv.z + gv.z * acc[d + 2]; xn[d + 3] = xv.w + gv.w * acc[d + 3];
            ss += xn[d] * xn[d] + xn[d + 1] * xn[d + 1] + xn[d + 2] * xn[d + 2] + xn[d + 3] * xn[d + 3];
        }
        const float rinv = rsqrtf(wave_sum(ss) * (1.f / D) + EPS);
        if (mode == 0) {
#pragma unroll
            for (int d = 0; d < 16; d += 4) { f32x4 o; o.x = xn[d]; o.y = xn[d + 1]; o.z = xn[d + 2]; o.w = xn[d + 3]; *(f32x4*)(xr + d) = o; }
            const float* gn = a.in[6] + D + lane * 16; const float* sh = modv(a, 1, var, 0) + lane * 16; const float* sc = modv(a, 1, var, 1) + lane * 16;
            unsigned w[8];
#pragma unroll
            for (int d = 0; d < 16; d += 2) w[d >> 1] = pk2(xn[d] * rinv * gn[d] * (1.f + sc[d]) + sh[d], xn[d + 1] * rinv * gn[d + 1] * (1.f + sc[d + 1]) + sh[d + 1]);
            u32x4 o0, o1; o0.x = w[0]; o0.y = w[1]; o0.z = w[2]; o0.w = w[3]; o1.x = w[4]; o1.y = w[5]; o1.z = w[6]; o1.w = w[7];
            *(u32x4*)(H + (size_t)g * D + lane * 16) = o0; *(u32x4*)(H + (size_t)g * D + lane * 16 + 8) = o1;
        } else {
            const int b = g / RPB, t = g - b * RPB - CTXL;
            float* op = a.out + ((size_t)b * SEQ + t) * D + lane * 16; const float* gn = a.in[28] + lane * 16;
#pragma unroll
            for (int d = 0; d < 16; d += 4) { f32x4 o; o.x = xn[d] * rinv * gn[d]; o.y = xn[d + 1] * rinv * gn[d + 1]; o.z = xn[d + 2] * rinv * gn[d + 2]; o.w = xn[d + 3] * rinv * gn[d + 3]; *(f32x4*)(op + d) = o; }
        }
    }
}

typedef __bf16 bf16x2_t __attribute__((ext_vector_type(2)));
__device__ __forceinline__ float dot2bf(unsigned w, unsigned x, float acc) { return __builtin_amdgcn_fdot2_f32_bf16(__builtin_bit_cast(bf16x2_t, w), __builtin_bit_cast(bf16x2_t, x), acc, false); }
struct Row8 { u32x4 c[8]; };
__device__ __forceinline__ void load_row8(Row8& r, const bf16_t* p) {
#pragma unroll
    for (int c = 0; c < 8; ++c) r.c[c] = *(const u32x4*)(p + c * 128);
}
__device__ __forceinline__ float dot_row8(const Row8& r, const u32x4 (&hp)[8]) {
    float a0 = 0.f, a1 = 0.f, a2 = 0.f, a3 = 0.f;
#pragma unroll
    for (int c = 0; c < 8; ++c) { a0 = dot2bf(r.c[c].x, hp[c].x, a0); a1 = dot2bf(r.c[c].y, hp[c].y, a1); a2 = dot2bf(r.c[c].z, hp[c].z, a2); a3 = dot2bf(r.c[c].w, hp[c].w, a3); }
    float s = (a0 + a1) + (a2 + a3);
    s += __shfl_xor(s, 1); s += __shfl_xor(s, 2); s += __shfl_xor(s, 4); s += __shfl_xor(s, 8);
    return s;
}
__device__ __forceinline__ void fma_row(float (&acc)[16], const u32x4& v0, const u32x4& v1, float a) {
    acc[0] += a * bflo(v0.x); acc[1] += a * bfhi(v0.x); acc[2] += a * bflo(v0.y); acc[3] += a * bfhi(v0.y);
    acc[4] += a * bflo(v0.z); acc[5] += a * bfhi(v0.z); acc[6] += a * bflo(v0.w); acc[7] += a * bfhi(v0.w);
    acc[8] += a * bflo(v1.x); acc[9] += a * bfhi(v1.x); acc[10] += a * bflo(v1.y); acc[11] += a * bfhi(v1.y);
    acc[12] += a * bflo(v1.z); acc[13] += a * bfhi(v1.z); acc[14] += a * bflo(v1.w); acc[15] += a * bfhi(v1.w);
}
__device__ __forceinline__ void phase_peer_gather2(const Args& a, char* lds, int layer, int mode) {
    const int lane = threadIdx.x & 63, wid = threadIdx.x >> 6, gw = blockIdx.x * NWAVE + wid, ngw = gridDim.x * NWAVE;
    const int grp = lane >> 4, sub = lane & 15;
    unsigned char* ws = a.ws;
    bf16_t* H = (bf16_t*)(ws + WS_H); float* X1 = (float*)(ws + WS_X1);
    const bf16_t* PU = (const bf16_t*)(ws + WS_PU) + (size_t)layer * NEXP * D; const bf16_t* PV = (const bf16_t*)(ws + WS_PV) + (size_t)layer * NEXP * D;
    const int* SELI = (const int*)(ws + WS_SELI); const float* SELG = (const float*)(ws + WS_SELG);
    LAS int* lidx = (LAS int*)((LAS char*)lds + wid * 2048);
    LAS float* lgate = (LAS float*)(lidx + 128);
    LAS float* lact = lgate + 128;
    for (int g = gw; g < MTOT; g += ngw) {
        const int var = row_variant(g);
        if (mode == 1 && var == 2) continue;
        lidx[lane] = SELI[(size_t)g * 128 + lane]; lidx[64 + lane] = SELI[(size_t)g * 128 + 64 + lane];
        lgate[lane] = SELG[(size_t)g * 128 + lane]; lgate[64 + lane] = SELG[(size_t)g * 128 + 64 + lane];
        u32x4 hp[8];
#pragma unroll
        for (int c = 0; c < 8; ++c) hp[c] = *(const u32x4*)(H + (size_t)g * D + c * 128 + sub * 8);
        {
            Row8 ra, rb;
            load_row8(ra, PU + (size_t)lidx[grp] * D + sub * 8);
            for (int it = 0; it < 32; it += 2) {
                load_row8(rb, PU + (size_t)lidx[(it + 1) * 4 + grp] * D + sub * 8);
                { const float s = dot_row8(ra, hp); const int e = it * 4 + grp; if (sub == 0) lact[e] = gelu_t(s) * lgate[e]; }
                if (it + 2 < 32) load_row8(ra, PU + (size_t)lidx[(it + 2) * 4 + grp] * D + sub * 8);
                { const float s = dot_row8(rb, hp); const int e = (it + 1) * 4 + grp; if (sub == 0) lact[e] = gelu_t(s) * lgate[e]; }
            }
        }
        float acc[16];
#pragma unroll
        for (int d = 0; d < 16; ++d) acc[d] = 0.f;
        {
            u32x4 va[4][2], vb[4][2];
#pragma unroll
            for (int k = 0; k < 4; ++k) { const bf16_t* p = PV + (size_t)lidx[k] * D + lane * 8; va[k][0] = *(const u32x4*)p; va[k][1] = *(const u32x4*)(p + 512); }
            for (int e = 0; e < 128; e += 8) {
#pragma unroll
                for (int k = 0; k < 4; ++k) { const bf16_t* p = PV + (size_t)lidx[e + 4 + k] * D + lane * 8; vb[k][0] = *(const u32x4*)p; vb[k][1] = *(const u32x4*)(p + 512); }
#pragma unroll
                for (int k = 0; k < 4; ++k) fma_row(acc, va[k][0], va[k][1], lact[e + k]);
                if (e + 8 < 128) {
#pragma unroll
                    for (int k = 0; k < 4; ++k) { const bf16_t* p = PV + (size_t)lidx[e + 8 + k] * D + lane * 8; va[k][0] = *(const u32x4*)p; va[k][1] = *(const u32x4*)(p + 512); }
                }
#pragma unroll
                for (int k = 0; k < 4; ++k) fma_row(acc, vb[k][0], vb[k][1], lact[e + 4 + k]);
            }
        }
        float* xr = X1 + (size_t)g * D + lane * 8;
        const float* g2 = modv(a, layer, var, 5) + lane * 8;
        float xn[16]; float ss = 0.f;
#pragma unroll
        for (int hh = 0; hh < 2; ++hh)
#pragma unroll
            for (int d = 0; d < 8; d += 4) {
                const f32x4 xv = *(const f32x4*)(xr + hh * 512 + d), gv = *(const f32x4*)(g2 + hh * 512 + d);
                const int o = hh * 8 + d;
                xn[o] = xv.x + gv.x * acc[o]; xn[o + 1] = xv.y + gv.y * acc[o + 1]; xn[o + 2] = xv.z + gv.z * acc[o + 2]; xn[o + 3] = xv.w + gv.w * acc[o + 3];
                ss += xn[o] * xn[o] + xn[o + 1] * xn[o + 1] + xn[o + 2] * xn[o + 2] + xn[o + 3] * xn[o + 3];
            }
        const float rinv = rsqrtf(wave_sum(ss) * (1.f / D) + EPS);
        if (mode == 0) {
            const float* gn = a.in[6] + D + lane * 8; const float* sh = modv(a, 1, var, 0) + lane * 8; const float* sc = modv(a, 1, var, 1) + lane * 8;
#pragma unroll
            for (int hh = 0; hh < 2; ++hh) {
                const int o = hh * 8;
                f32x4 o0, o1; o0.x = xn[o]; o0.y = xn[o + 1]; o0.z = xn[o + 2]; o0.w = xn[o + 3]; o1.x = xn[o + 4]; o1.y = xn[o + 5]; o1.z = xn[o + 6]; o1.w = xn[o + 7];
                *(f32x4*)(xr + hh * 512) = o0; *(f32x4*)(xr + hh * 512 + 4) = o1;
                unsigned w[4];
#pragma unroll
                for (int d = 0; d < 8; d += 2) { const int cc = hh * 512 + d; w[d >> 1] = pk2(xn[o + d] * rinv * gn[cc] * (1.f + sc[cc]) + sh[cc], xn[o + d + 1] * rinv * gn[cc + 1] * (1.f + sc[cc + 1]) + sh[cc + 1]); }
                u32x4 ow; ow.x = w[0]; ow.y = w[1]; ow.z = w[2]; ow.w = w[3];
                *(u32x4*)(H + (size_t)g * D + hh * 512 + lane * 8) = ow;
            }
        } else {
            const int b = g / RPB, t = g - b * RPB - CTXL;
            float* op = a.out + ((size_t)b * SEQ + t) * D + lane * 8; const float* gn = a.in[28] + lane * 8;
#pragma unroll
            for (int hh = 0; hh < 2; ++hh)
#pragma unroll
                for (int d = 0; d < 8; d += 4) { const int o = hh * 8 + d, cc = hh * 512 + d;
                    f32x4 ov; ov.x = xn[o] * rinv * gn[cc]; ov.y = xn[o + 1] * rinv * gn[cc + 1]; ov.z = xn[o + 2] * rinv * gn[cc + 2]; ov.w = xn[o + 3] * rinv * gn[cc + 3]; *(f32x4*)(op + cc) = ov; }
        }
    }
}

__device__ __forceinline__ float ub0(unsigned w) { return (float)(w & 0xffu); }
__device__ __forceinline__ float ub1(unsigned w) { return (float)((w >> 8) & 0xffu); }
__device__ __forceinline__ float ub2(unsigned w) { return (float)((w >> 16) & 0xffu); }
__device__ __forceinline__ float ub3(unsigned w) { return (float)(w >> 24); }
struct RowU { u32x4 c[4]; };
__device__ __forceinline__ void load_rowu(RowU& r, const unsigned char* p) {
#pragma unroll
    for (int c = 0; c < 4; ++c) r.c[c] = *(const u32x4*)(p + c * 256);
}
__device__ __forceinline__ float dot_rowu(const RowU& r, const float (&hp)[64]) {
    float a0 = 0.f, a1 = 0.f, a2 = 0.f, a3 = 0.f;
#pragma unroll
    for (int c = 0; c < 4; ++c) {
        const unsigned w0 = r.c[c].x, w1 = r.c[c].y, w2 = r.c[c].z, w3 = r.c[c].w; const int o = c * 16;
        a0 += hp[o + 0] * ub0(w0); a1 += hp[o + 1] * ub1(w0); a2 += hp[o + 2] * ub2(w0); a3 += hp[o + 3] * ub3(w0);
        a0 += hp[o + 4] * ub0(w1); a1 += hp[o + 5] * ub1(w1); a2 += hp[o + 6] * ub2(w1); a3 += hp[o + 7] * ub3(w1);
        a0 += hp[o + 8] * ub0(w2); a1 += hp[o + 9] * ub1(w2); a2 += hp[o + 10] * ub2(w2); a3 += hp[o + 11] * ub3(w2);
        a0 += hp[o + 12] * ub0(w3); a1 += hp[o + 13] * ub1(w3); a2 += hp[o + 14] * ub2(w3); a3 += hp[o + 15] * ub3(w3);
    }
    float s = (a0 + a1) + (a2 + a3);
    s += __shfl_xor(s, 1); s += __shfl_xor(s, 2); s += __shfl_xor(s, 4); s += __shfl_xor(s, 8);
    return s;
}
__device__ __forceinline__ void fma_rowv(float (&acc)[16], const u32x4& v, float a) {
    acc[0] += a * ub0(v.x); acc[1] += a * ub1(v.x); acc[2] += a * ub2(v.x); acc[3] += a * ub3(v.x);
    acc[4] += a * ub0(v.y); acc[5] += a * ub1(v.y); acc[6] += a * ub2(v.y); acc[7] += a * ub3(v.y);
    acc[8] += a * ub0(v.z); acc[9] += a * ub1(v.z); acc[10] += a * ub2(v.z); acc[11] += a * ub3(v.z);
    acc[12] += a * ub0(v.w); acc[13] += a * ub1(v.w); acc[14] += a * ub2(v.w); acc[15] += a * ub3(v.w);
}
__device__ __forceinline__ void phase_peer_gather3(const Args& a, char* lds, int layer, int mode) {
    const int lane = threadIdx.x & 63, wid = __builtin_amdgcn_readfirstlane(threadIdx.x >> 6), gw = blockIdx.x * NWAVE + wid, ngw = gridDim.x * NWAVE;
    const int grp = lane >> 4, sub = lane & 15;
    unsigned char* ws = a.ws;
    bf16_t* H = (bf16_t*)(ws + WS_H); float* X1 = (float*)(ws + WS_X1);
    const unsigned char* PU = ws + WS_PU + (size_t)layer * NEXP * D; const unsigned char* PV = ws + WS_PV + (size_t)layer * NEXP * D;
    const float* SCU = (const float*)(ws + WS_SCU) + layer * NEXP; const float* SCV = (const float*)(ws + WS_SCV) + layer * NEXP;
    const int* SELI = (const int*)(ws + WS_SELI); const float* SELG = (const float*)(ws + WS_SELG);
    LAS int* lidx = (LAS int*)((LAS char*)lds + wid * 2048);
    LAS float* lgu = (LAS float*)(lidx + 128);
    LAS float* lact = lgu + 128;
    for (int g = gw; g < MTOT; g += ngw) {
        const int var = row_variant(g);
        if (mode == 1 && var == 2) continue;
        {
            const int i0 = SELI[(size_t)g * 128 + lane], i1 = SELI[(size_t)g * 128 + 64 + lane];
            lidx[lane] = i0; lidx[64 + lane] = i1;
            lgu[lane] = SCU[i0]; lgu[64 + lane] = SCU[i1];
        }
        float hp[64]; float shp = 0.f;
#pragma unroll
        for (int c = 0; c < 4; ++c) {
            const u32x4 w0 = *(const u32x4*)(H + (size_t)g * D + c * 256 + sub * 16), w1 = *(const u32x4*)(H + (size_t)g * D + c * 256 + sub * 16 + 8);
            const int o = c * 16;
            hp[o + 0] = bflo(w0.x); hp[o + 1] = bfhi(w0.x); hp[o + 2] = bflo(w0.y); hp[o + 3] = bfhi(w0.y); hp[o + 4] = bflo(w0.z); hp[o + 5] = bfhi(w0.z); hp[o + 6] = bflo(w0.w); hp[o + 7] = bfhi(w0.w);
            hp[o + 8] = bflo(w1.x); hp[o + 9] = bfhi(w1.x); hp[o + 10] = bflo(w1.y); hp[o + 11] = bfhi(w1.y); hp[o + 12] = bflo(w1.z); hp[o + 13] = bfhi(w1.z); hp[o + 14] = bflo(w1.w); hp[o + 15] = bfhi(w1.w);
        }
#pragma unroll
        for (int d = 0; d < 64; ++d) shp += hp[d];
        shp += __shfl_xor(shp, 1); shp += __shfl_xor(shp, 2); shp += __shfl_xor(shp, 4); shp += __shfl_xor(shp, 8);
        const float bias = 128.f * shp;
        {
            RowU r0, r1, r2, r3;
            load_rowu(r0, PU + (size_t)lidx[0 * 4 + grp] * D + sub * 16); load_rowu(r1, PU + (size_t)lidx[1 * 4 + grp] * D + sub * 16);
            load_rowu(r2, PU + (size_t)lidx[2 * 4 + grp] * D + sub * 16); load_rowu(r3, PU + (size_t)lidx[3 * 4 + grp] * D + sub * 16);
#define GU_STEP(R, IT) { const float s = dot_rowu(R, hp) - bias; const int e = (IT) * 4 + grp; const float su = lgu[e]; \
                if ((IT) + 4 < 32) load_rowu(R, PU + (size_t)lidx[((IT) + 4) * 4 + grp] * D + sub * 16); \
                if (sub == 0) lact[e] = gelu_t(s * su); }
            for (int it = 0; it < 32; it += 4) { GU_STEP(r0, it) GU_STEP(r1, it + 1) GU_STEP(r2, it + 2) GU_STEP(r3, it + 3) }
#undef GU_STEP
        }
        {
            const float g0 = SELG[(size_t)g * 128 + lane], g1 = SELG[(size_t)g * 128 + 64 + lane];
            const float a0 = lact[lane] * g0 * SCV[lidx[lane]], a1 = lact[64 + lane] * g1 * SCV[lidx[64 + lane]];
            lact[lane] = a0; lact[64 + lane] = a1;
        }
        float acc[16]; float sact = 0.f;
#pragma unroll
        for (int d = 0; d < 16; ++d) acc[d] = 0.f;
        {
            u32x4 va[8];
#pragma unroll
            for (int k = 0; k < 8; ++k) va[k] = *(const u32x4*)(PV + (size_t)lidx[k] * D + lane * 16);
            for (int e = 0; e < 128; e += 8) {
#pragma unroll
                for (int k = 0; k < 8; ++k) {
                    const float av = lact[e + k]; sact += av;
                    fma_rowv(acc, va[k], av);
                    if (e + 8 < 128) va[k] = *(const u32x4*)(PV + (size_t)lidx[e + 8 + k] * D + lane * 16);
                }
            }
        }
        const float vb = 128.f * sact;
        float* xr = X1 + (size_t)g * D + lane * 16;
        const float* g2 = modv(a, layer, var, 5) + lane * 16;
        float xn[16]; float ss = 0.f;
#pragma unroll
        for (int d = 0; d < 16; d += 4) {
            const f32x4 xv = *(const f32x4*)(xr + d), gv = *(const f32x4*)(g2 + d);
            xn[d] = xv.x + gv.x * (acc[d] - vb); xn[d + 1] = xv.y + gv.y * (acc[d + 1] - vb); xn[d + 2] = xv.z + gv.z * (acc[d + 2] - vb); xn[d + 3] = xv.w + gv.w * (acc[d + 3] - vb);
            ss += xn[d] * xn[d] + xn[d + 1] * xn[d + 1] + xn[d + 2] * xn[d + 2] + xn[d + 3] * xn[d + 3];
        }
        const float rinv = rsqrtf(wave_sum(ss) * (1.f / D) + EPS);
        if (mode == 0) {
#pragma unroll
            for (int d = 0; d < 16; d += 4) { f32x4 o; o.x = xn[d]; o.y = xn[d + 1]; o.z = xn[d + 2]; o.w = xn[d + 3]; *(f32x4*)(xr + d) = o; }
            const float* gn = a.in[6] + D + lane * 16; const float* sh = modv(a, 1, var, 0) + lane * 16; const float* sc = modv(a, 1, var, 1) + lane * 16;
            unsigned w[8];
#pragma unroll
            for (int d = 0; d < 16; d += 2) w[d >> 1] = pk2(xn[d] * rinv * gn[d] * (1.f + sc[d]) + sh[d], xn[d + 1] * rinv * gn[d + 1] * (1.f + sc[d + 1]) + sh[d + 1]);
            u32x4 o0, o1; o0.x = w[0]; o0.y = w[1]; o0.z = w[2]; o0.w = w[3]; o1.x = w[4]; o1.y = w[5]; o1.z = w[6]; o1.w = w[7];
            *(u32x4*)(H + (size_t)g * D + lane * 16) = o0; *(u32x4*)(H + (size_t)g * D + lane * 16 + 8) = o1;
        } else {
            const int b = g / RPB, t = g - b * RPB - CTXL;
            float* op = a.out + ((size_t)b * SEQ + t) * D + lane * 16; const float* gn = a.in[28] + lane * 16;
#pragma unroll
            for (int d = 0; d < 16; d += 4) { f32x4 o; o.x = xn[d] * rinv * gn[d]; o.y = xn[d + 1] * rinv * gn[d + 1]; o.z = xn[d + 2] * rinv * gn[d + 2]; o.w = xn[d + 3] * rinv * gn[d + 3]; *(f32x4*)(op + d) = o; }
        }
    }
}

__device__ __forceinline__ int peer_tok(int i, int mode) { return mode == 1 ? i + CTXL + (i >= SEQ ? CTXL : 0) : i; }
__device__ __forceinline__ float dot16u(const u32x4& w, const float (&hp)[16]) {
    float a0 = hp[0] * ub0(w.x) + hp[4] * ub0(w.y), a1 = hp[1] * ub1(w.x) + hp[5] * ub1(w.y), a2 = hp[2] * ub2(w.x) + hp[6] * ub2(w.y), a3 = hp[3] * ub3(w.x) + hp[7] * ub3(w.y);
    a0 += hp[8] * ub0(w.z) + hp[12] * ub0(w.w); a1 += hp[9] * ub1(w.z) + hp[13] * ub1(w.w); a2 += hp[10] * ub2(w.z) + hp[14] * ub2(w.w); a3 += hp[11] * ub3(w.z) + hp[15] * ub3(w.w);
    return (a0 + a1) + (a2 + a3);
}
#define DPP_I(v, ctrl) __builtin_amdgcn_update_dpp(0, (v), (ctrl), 0xf, 0xf, true)
__device__ __forceinline__ int sum8_i(int v) {
    v += DPP_I(v, 0xB1);
    v += DPP_I(v, 0x4E);
    v += DPP_I(v, 0x141);
    return v;
}
__device__ __forceinline__ int sum_eg_i(int v) {
    v += DPP_I(v, 0x128);
    { const auto r = __builtin_amdgcn_permlane16_swap((unsigned)v, (unsigned)v, false, false); v = (int)(r[0] + r[1]); }
    { const auto r = __builtin_amdgcn_permlane32_swap((unsigned)v, (unsigned)v, false, false); v = (int)(r[0] + r[1]); }
    return v;
}
__device__ __forceinline__ void gu_stage(u32x4 (&seg)[16], u32x4& hw, LAS int* lb, int i0, int i1, const unsigned char* hrow, const unsigned char* PUx, int lane, int eg, unsigned loff) {
    lb[lane] = i0; lb[64 + lane] = i1;
    hw = *(const u32x4*)hrow;
#pragma unroll
    for (int st = 0; st < 16; ++st) seg[st] = *(const u32x4*)(PUx + ((unsigned)lb[st * 8 + eg] * 128u + loff));
}
__device__ __forceinline__ void gu_compute(const u32x4 (&seg)[16], const u32x4& hw, LAS float* lpart, float* prow, int lane, int eg, int sub, bool valid) {
#pragma unroll
    for (int st = 0; st < 16; ++st) {
        int d = __builtin_amdgcn_sdot4((int)seg[st].x, (int)hw.x, 0, false);
        d = __builtin_amdgcn_sdot4((int)seg[st].y, (int)hw.y, d, false); d = __builtin_amdgcn_sdot4((int)seg[st].z, (int)hw.z, d, false); d = __builtin_amdgcn_sdot4((int)seg[st].w, (int)hw.w, d, false);
        d = sum8_i(d);
        if (sub == 0) lpart[st * 8 + eg] = (float)d;
    }
    if (valid) { prow[lane] = lpart[lane]; prow[64 + lane] = lpart[64 + lane]; }
}
__device__ __forceinline__ void phase_gu(const Args& a, char* lds, int layer, int mode) {
    const int lane = threadIdx.x & 63, wid = __builtin_amdgcn_readfirstlane(threadIdx.x >> 6), eg = lane >> 3, sub = lane & 7;
    const int x = blockIdx.x & 7, stripe = blockIdx.x >> 3, nstr = (gridDim.x >> 3) * NWAVE, ntok = mode == 1 ? NB * SEQ : MTOT;
    unsigned char* ws = a.ws;
    const unsigned char* H8 = ws + WS_H8 + x * 128 + sub * 16;
    const unsigned char* PUx = ws + WS_PU + (size_t)layer * NEXP * D + (size_t)x * NEXP * 128; const unsigned loff = (unsigned)(sub * 16);
    const int* SELI = (const int*)(ws + WS_SELI); float* PART = (float*)(ws + WS_PART) + (size_t)x * MTOT * 128;
    LAS int* lidx = (LAS int*)((LAS char*)lds + wid * 2048);
    LAS float* lpart = (LAS float*)(lidx + 256);
    const int first = stripe * NWAVE + wid;
#define G_TOK(k) peer_tok(min(first + (k) * nstr, ntok - 1), mode)
#define G_VALID(k) (first + (k) * nstr < ntok)
    u32x4 segA[16], segB[16], hwA, hwB;
    int p0, p1;
    { const int g = G_TOK(0); p0 = SELI[(size_t)g * 128 + lane]; p1 = SELI[(size_t)g * 128 + 64 + lane];
      gu_stage(segA, hwA, lidx, p0, p1, H8 + (size_t)g * D, PUx, lane, eg, loff); }
    { const int g = G_TOK(1); p0 = SELI[(size_t)g * 128 + lane]; p1 = SELI[(size_t)g * 128 + 64 + lane]; }
    for (int k = 0; G_VALID(k); k += 2) {
        { const int g1 = G_TOK(k + 1); gu_stage(segB, hwB, lidx + 128, p0, p1, H8 + (size_t)g1 * D, PUx, lane, eg, loff); }
        { const int g2 = G_TOK(k + 2); p0 = SELI[(size_t)g2 * 128 + lane]; p1 = SELI[(size_t)g2 * 128 + 64 + lane]; }
        gu_compute(segA, hwA, lpart, PART + (size_t)G_TOK(k) * 128, lane, eg, sub, true);
        { const int g2 = G_TOK(k + 2); gu_stage(segA, hwA, lidx, p0, p1, H8 + (size_t)g2 * D, PUx, lane, eg, loff); }
        { const int g3 = G_TOK(k + 3); p0 = SELI[(size_t)g3 * 128 + lane]; p1 = SELI[(size_t)g3 * 128 + 64 + lane]; }
        gu_compute(segB, hwB, lpart, PART + (size_t)G_TOK(k + 1) * 128, lane, eg, sub, G_VALID(k + 1));
    }
}
__device__ __forceinline__ void phase_gact(const Args& a, int layer, int mode) {
    const int lane = threadIdx.x & 63, gw = blockIdx.x * NWAVE + (threadIdx.x >> 6), ngw = gridDim.x * NWAVE, ntok = mode == 1 ? NB * SEQ : MTOT;
    unsigned char* ws = a.ws;
    const float* PART = (const float*)(ws + WS_PART); const int* SELI = (const int*)(ws + WS_SELI); const float* SELG = (const float*)(ws + WS_SELG);
    const float* SCU = (const float*)(ws + WS_SCU) + layer * NEXP; const float* SCV = (const float*)(ws + WS_SCV) + layer * NEXP;
    const float* SH = (const float*)(ws + WS_SH); short* ACT16 = (short*)(ws + WS_ACT16); float* SA = (float*)(ws + WS_SA);
    for (int i = gw; i < ntok; i += ngw) {
        const int g = peer_tok(i, mode);
        const float sh = SH[g];
        float av[2];
#pragma unroll
        for (int hf = 0; hf < 2; ++hf) {
            const size_t o = (size_t)g * 128 + hf * 64 + lane;
            float sdot = 0.f;
#pragma unroll
            for (int xx = 0; xx < 8; ++xx) sdot += PART[(size_t)xx * MTOT * 128 + o];
            const int id = SELI[o];
            av[hf] = gelu_t(sdot * sh * SCU[id]) * SELG[o] * SCV[id];
        }
        float mx = fmaxf(fabsf(av[0]), fabsf(av[1]));
#pragma unroll
        for (int of = 1; of < 64; of <<= 1) mx = fmaxf(mx, __shfl_xor(mx, of));
        mx = fmaxf(mx, 1e-30f); const float inv = 32767.f / mx;
#pragma unroll
        for (int hf = 0; hf < 2; ++hf) {
            const int e = hf * 64 + lane, st = e >> 3, eg = e & 7, pos = (((st >> 1) * 8 + eg) << 1) | (st & 1);
            ACT16[(size_t)g * 128 + pos] = (short)__float2int_rn(av[hf] * inv);
        }
        if (lane == 0) SA[g] = mx * (1.f / 32767.f);
    }
}
__device__ __forceinline__ void gv_stage(u32x4 (&seg)[16], LAS int* lb, int i0, int i1, const unsigned char* PVx, int lane, int eg, unsigned loff) {
    lb[lane] = i0; lb[64 + lane] = i1;
#pragma unroll
    for (int st = 0; st < 16; ++st) seg[st] = *(const u32x4*)(PVx + ((unsigned)lb[st * 8 + eg] * 128u + loff));
}
typedef short s16x2_t __attribute__((ext_vector_type(2)));
__device__ __forceinline__ int dot2i16(unsigned w, unsigned aw, int acc) { return __builtin_amdgcn_sdot2(__builtin_bit_cast(s16x2_t, w), __builtin_bit_cast(s16x2_t, aw), acc, false); }
__device__ __forceinline__ void gv_pair(int (&acc)[16], const u32x4& va, const u32x4& vb, unsigned aw) {
#define GV_D(d, o) acc[o + 0] = dot2i16(__builtin_amdgcn_perm(vb.d, va.d, 0x0c040c00u), aw, acc[o + 0]); acc[o + 1] = dot2i16(__builtin_amdgcn_perm(vb.d, va.d, 0x0c050c01u), aw, acc[o + 1]); \
                   acc[o + 2] = dot2i16(__builtin_amdgcn_perm(vb.d, va.d, 0x0c060c02u), aw, acc[o + 2]); acc[o + 3] = dot2i16(__builtin_amdgcn_perm(vb.d, va.d, 0x0c070c03u), aw, acc[o + 3]);
    GV_D(x, 0) GV_D(y, 4) GV_D(z, 8) GV_D(w, 12)
#undef GV_D
}
__device__ __forceinline__ void gv_compute(const u32x4 (&seg)[16], const unsigned (&aw)[8], float sa, float* xr, const float* g2, int eg, bool valid) {
    int acc[16]; int sq = 0;
#pragma unroll
    for (int k = 0; k < 16; ++k) acc[k] = 0;
#pragma unroll
    for (int s2 = 0; s2 < 8; ++s2) { gv_pair(acc, seg[2 * s2], seg[2 * s2 + 1], aw[s2]); sq += (int)(short)(aw[s2] & 0xffffu) + ((int)aw[s2] >> 16); }
#pragma unroll
    for (int k = 0; k < 16; ++k) acc[k] = sum_eg_i(acc[k]);
    sq = sum_eg_i(sq);
    if (eg == 0 && valid) {
        const int vb = 128 * sq;
#pragma unroll
        for (int d = 0; d < 16; d += 4) {
            const f32x4 xv = *(const f32x4*)(xr + d), gv = *(const f32x4*)(g2 + d);
            f32x4 o; o.x = xv.x + gv.x * (sa * (float)(acc[d] - vb)); o.y = xv.y + gv.y * (sa * (float)(acc[d + 1] - vb)); o.z = xv.z + gv.z * (sa * (float)(acc[d + 2] - vb)); o.w = xv.w + gv.w * (sa * (float)(acc[d + 3] - vb));
            *(f32x4*)(xr + d) = o;
        }
    }
}
__device__ __forceinline__ void phase_gv(const Args& a, char* lds, int layer, int mode) {
    const int lane = threadIdx.x & 63, wid = __builtin_amdgcn_readfirstlane(threadIdx.x >> 6), eg = lane >> 3, sub = lane & 7;
    const int x = blockIdx.x & 7, stripe = blockIdx.x >> 3, nstr = (gridDim.x >> 3) * NWAVE, ntok = mode == 1 ? NB * SEQ : MTOT;
    unsigned char* ws = a.ws;
    float* X1 = (float*)(ws + WS_X1) + x * 128 + sub * 16;
    const unsigned char* PVx = ws + WS_PV + (size_t)layer * NEXP * D + (size_t)x * NEXP * 128; const unsigned loff = (unsigned)(sub * 16);
    const int* SELI = (const int*)(ws + WS_SELI); const unsigned* ACTW = (const unsigned*)(ws + WS_ACT16) + eg; const float* SA = (const float*)(ws + WS_SA);
    LAS int* lidx = (LAS int*)((LAS char*)lds + wid * 2048);
    const int first = stripe * NWAVE + wid;
    u32x4 segA[16], segB[16];
    unsigned awA[8], awB[8]; float saA, saB;
    int p0, p1;
#define GV_PREF(k) { const int g_ = G_TOK(k); p0 = SELI[(size_t)g_ * 128 + lane]; p1 = SELI[(size_t)g_ * 128 + 64 + lane]; }
#define GV_AW(AW, SAV, k) { const int g_ = G_TOK(k); _Pragma("unroll") for (int s2 = 0; s2 < 8; ++s2) AW[s2] = ACTW[(size_t)g_ * 64 + s2 * 8]; SAV = SA[g_]; }
#define GV_G2(k) (modv(a, layer, row_variant(G_TOK(k)), 5) + x * 128 + sub * 16)
    GV_PREF(0) gv_stage(segA, lidx, p0, p1, PVx, lane, eg, loff); GV_AW(awA, saA, 0)
    GV_PREF(1)
    for (int k = 0; G_VALID(k); k += 2) {
        gv_stage(segB, lidx + 128, p0, p1, PVx, lane, eg, loff); GV_AW(awB, saB, k + 1)
        GV_PREF(k + 2)
        gv_compute(segA, awA, saA, X1 + (size_t)G_TOK(k) * D, GV_G2(k), eg, true);
        gv_stage(segA, lidx, p0, p1, PVx, lane, eg, loff); GV_AW(awA, saA, k + 2)
        GV_PREF(k + 3)
        gv_compute(segB, awB, saB, X1 + (size_t)G_TOK(k + 1) * D, GV_G2(k + 1), eg, G_VALID(k + 1));
    }
#undef GV_PREF
#undef GV_AW
#undef GV_G2
#undef G_TOK
#undef G_VALID
}
__device__ __forceinline__ void phase_finalnorm(const Args& a) {
    const int lane = threadIdx.x & 63, gw = blockIdx.x * NWAVE + (threadIdx.x >> 6), ngw = gridDim.x * NWAVE;
    const float* X1 = (const float*)(a.ws + WS_X1);
    for (int i = gw; i < NB * SEQ; i += ngw) {
        const int g = peer_tok(i, 1);
        const float* xr = X1 + (size_t)g * D; float* op = a.out + (size_t)i * D;
        f32x4 v[4]; float ss = 0.f;
#pragma unroll
        for (int j = 0; j < 4; ++j) { v[j] = *(const f32x4*)(xr + j * 256 + lane * 4); ss += (v[j].x * v[j].x + v[j].y * v[j].y) + (v[j].z * v[j].z + v[j].w * v[j].w); }
        const float rinv = rsqrtf(wave_sum(ss) * (1.f / D) + EPS);
#pragma unroll
        for (int j = 0; j < 4; ++j) { const f32x4 gn = *(const f32x4*)(a.in[28] + j * 256 + lane * 4); *(f32x4*)(op + j * 256 + lane * 4) = v[j] * rinv * gn; }
    }
}

__device__ __forceinline__ void phase_inproj1(const Args& a, char* lds) {
    float* Cs = (float*)lds;
    const int tid = threadIdx.x;
    const bf16_t* H = (const bf16_t*)(a.ws + WS_H); const bf16_t* W = (const bf16_t*)(a.ws + WS_WIN1);
    const int NU = (MTOT / 128) * 20;
    for (int u = blockIdx.x; u < NU; u += gridDim.x) {
        const int rt = u / 20, ct = u % 20, row0 = rt * 128, col0 = ct * 128;
        if (ct < 10 && (rt % 66) < 2) continue;
        gemm_tile128(H + (size_t)row0 * D, D, W + (size_t)col0 * D, D, D, Cs);
        __syncthreads();
        const int rr = tid >> 2, q4 = tid & 3, g = row0 + rr;
        const float* crow = Cs + rr * CS_LD + q4 * 32;
        if (ct < 10) {
            bf16_t* o = (bf16_t*)(a.ws + WS_GG) + (size_t)g * DRNN + col0 + q4 * 32;
#pragma unroll
            for (int c = 0; c < 32; c += 2) *(unsigned*)(o + c) = pk2(gelu_t(crow[c]), gelu_t(crow[c + 1]));
        } else {
            bf16_t* o = (bf16_t*)(a.ws + WS_XR) + (size_t)g * DRNN + (col0 - DRNN) + q4 * 32;
#pragma unroll
            for (int c = 0; c < 32; c += 2) *(unsigned*)(o + c) = pk2(crow[c], crow[c + 1]);
        }
        __syncthreads();
    }
}

__device__ __forceinline__ void phase_rglru(const Args& a, char* lds, int pass) {
    const int tid = threadIdx.x;
    unsigned char* ws = a.ws;
    float* xc = (float*)lds;
    float* seg = xc + 128 * 128;
    const bf16_t* XR = (const bf16_t*)(ws + WS_XR); const bf16_t* GG = (const bf16_t*)(ws + WS_GG); bf16_t* YG = (bf16_t*)(ws + WS_YG);
    float* CARRY = (float*)(ws + WS_CARRY);
    const int j = tid & 127, tq = tid >> 7;
    const int NU = (MTOT / 128) * 10;
    for (int u = blockIdx.x; u < NU; u += gridDim.x) {
        const int T = u / 10, hb = u % 10, b = T / 66, tl = T % 66, row0 = T * 128, ch = hb * 128 + j;
        if (pass == 1 && tl < 2) continue;
        const int seq_lo = tl < 2 ? b * RPB : b * RPB + CTXL, seq_hi = tl < 2 ? b * RPB + CTXL : (b + 1) * RPB;
        {
            const float w0 = a.in[16][0 * DRNN + ch], w1 = a.in[16][1 * DRNN + ch], w2 = a.in[16][2 * DRNN + ch], w3 = a.in[16][3 * DRNN + ch], cb = a.in[17][ch];
            for (int tt = 0; tt < 32; ++tt) {
                const int g = row0 + tq * 32 + tt;
                const float xm2 = (g - 2 >= seq_lo) ? bf2f(XR[(size_t)(g - 2) * DRNN + ch]) : 0.f;
                const float xm1 = (g - 1 >= seq_lo) ? bf2f(XR[(size_t)(g - 1) * DRNN + ch]) : 0.f;
                const float x0 = bf2f(XR[(size_t)g * DRNN + ch]);
                const float xp1 = (g + 1 < seq_hi) ? bf2f(XR[(size_t)(g + 1) * DRNN + ch]) : 0.f;
                xc[(tq * 32 + tt) * 128 + j] = w0 * xm2 + w1 * xm1 + w2 * x0 + w3 * xp1 + cb;
            }
        }
        __syncthreads();
        float acc[4][32];
#pragma unroll
        for (int m = 0; m < 4; ++m)
#pragma unroll
            for (int tt = 0; tt < 32; ++tt) acc[m][tt] = 0.f;
        {
            const float* wa0 = a.in[18] + ((size_t)(0 * 10 + hb) * 128) * 128 + j; const float* wx0 = a.in[20] + ((size_t)(0 * 10 + hb) * 128) * 128 + j;
            const float* wa1 = a.in[18] + ((size_t)(1 * 10 + hb) * 128) * 128 + j; const float* wx1 = a.in[20] + ((size_t)(1 * 10 + hb) * 128) * 128 + j;
            for (int i = 0; i < 128; ++i) {
                const float w0 = wa0[i * 128], w1 = wx0[i * 128], w2 = wa1[i * 128], w3 = wx1[i * 128];
#pragma unroll
                for (int tt = 0; tt < 32; ++tt) { const float x = xc[(tq * 32 + tt) * 128 + i]; acc[0][tt] += x * w0; acc[1][tt] += x * w1; acc[2][tt] += x * w2; acc[3][tt] += x * w3; }
            }
        }
#pragma unroll
        for (int d = 0; d < 2; ++d) {
            const float ba = a.in[19][d * DRNN + ch], bx = a.in[21][d * DRNN + ch], lam = a.in[22][d * DRNN + ch];
            const float sp = log1pf(__expf(-lam));
#pragma unroll
            for (int tt = 0; tt < 32; ++tt) {
                const float r = sigmoidf_(acc[2 * d][tt] + ba), ig = sigmoidf_(acc[2 * d + 1][tt] + bx);
                const float la = -8.f * r * sp; const float av = __expf(la);
                const float uv = sqrtf(fmaxf(-expm1f(2.f * la), 0.f)) * ig * xc[(tq * 32 + tt) * 128 + j];
                acc[2 * d][tt] = av; acc[2 * d + 1][tt] = uv;
            }
        }
        {
            float Af = 1.f, Hf = 0.f, Ab = 1.f, Hb = 0.f;
#pragma unroll
            for (int tt = 0; tt < 32; ++tt) { Hf = acc[0][tt] * Hf + acc[1][tt]; Af *= acc[0][tt]; }
#pragma unroll
            for (int tt = 31; tt >= 0; --tt) { Hb = acc[2][tt] * Hb + acc[3][tt]; Ab *= acc[2][tt]; }
            seg[((0 * 4 + tq) * 128 + j) * 2] = Af; seg[((0 * 4 + tq) * 128 + j) * 2 + 1] = Hf;
            seg[((1 * 4 + tq) * 128 + j) * 2] = Ab; seg[((1 * 4 + tq) * 128 + j) * 2 + 1] = Hb;
        }
        __syncthreads();
        if (pass == 0) {
            if (tq == 0) {
                float A = 1.f, Hh = 0.f;
                for (int s = 0; s < 4; ++s) { const float sa = seg[((0 * 4 + s) * 128 + j) * 2], sh = seg[((0 * 4 + s) * 128 + j) * 2 + 1]; Hh = sa * Hh + sh; A *= sa; }
                float* c0 = CARRY + (((size_t)(b * 2 + 0) * 66 + tl) * DRNN + ch) * 2; c0[0] = A; c0[1] = Hh;
                A = 1.f; Hh = 0.f;
                for (int s = 3; s >= 0; --s) { const float sa = seg[((1 * 4 + s) * 128 + j) * 2], sh = seg[((1 * 4 + s) * 128 + j) * 2 + 1]; Hh = sa * Hh + sh; A *= sa; }
                float* c1 = CARRY + (((size_t)(b * 2 + 1) * 66 + tl) * DRNN + ch) * 2; c1[0] = A; c1[1] = Hh;
            }
        } else {
            float hf = 0.f, hbk = 0.f;
            for (int t2 = 0; t2 < tl; ++t2) { const float* c = CARRY + (((size_t)(b * 2 + 0) * 66 + t2) * DRNN + ch) * 2; hf = c[0] * hf + c[1]; }
            { const float* c = CARRY + (((size_t)(b * 2 + 1) * 66 + 1) * DRNN + ch) * 2; hbk = c[0] * hbk + c[1]; }
            { const float* c = CARRY + (((size_t)(b * 2 + 1) * 66 + 0) * DRNN + ch) * 2; hbk = c[0] * hbk + c[1]; }
            for (int t2 = 65; t2 > tl; --t2) { const float* c = CARRY + (((size_t)(b * 2 + 1) * 66 + t2) * DRNN + ch) * 2; hbk = c[0] * hbk + c[1]; }
            for (int s = 0; s < tq; ++s) { const float sa = seg[((0 * 4 + s) * 128 + j) * 2], sh = seg[((0 * 4 + s) * 128 + j) * 2 + 1]; hf = sa * hf + sh; }
            for (int s = 3; s > tq; --s) { const float sa = seg[((1 * 4 + s) * 128 + j) * 2], sh = seg[((1 * 4 + s) * 128 + j) * 2 + 1]; hbk = sa * hbk + sh; }
#pragma unroll
            for (int tt = 0; tt < 32; ++tt) { hf = acc[0][tt] * hf + acc[1][tt]; acc[0][tt] = hf; }
#pragma unroll
            for (int tt = 31; tt >= 0; --tt) { hbk = acc[2][tt] * hbk + acc[3][tt]; acc[0][tt] += hbk; }
#pragma unroll
            for (int tt = 0; tt < 32; ++tt) {
                const int g = row0 + tq * 32 + tt;
                YG[(size_t)g * DRNN + ch] = (bf16_t)f2bf(acc[0][tt] * bf2f(GG[(size_t)g * DRNN + ch]));
            }
        }
        __syncthreads();
    }
}

constexpr int XC_LD = 136;
__device__ __forceinline__ float exp2_fast(float x) { return __builtin_amdgcn_exp2f(x); }
__device__ __forceinline__ float sigm_fast(float x) { return __builtin_amdgcn_rcpf(1.f + __builtin_amdgcn_exp2f(-1.4426950408889634f * x)); }
__device__ __forceinline__ void phase_rglru2(const Args& a, char* lds, int pass) {
    const int tid_ = threadIdx.x, wid = __builtin_amdgcn_readfirstlane(tid_ >> 6);
    const int nb = wid & 3, dir = wid >> 2;
    unsigned char* ws = a.ws;
    LAS bf16_t* xcA = (LAS bf16_t*)((LAS char*)lds);
    LAS float* HS = (LAS float*)((LAS char*)lds + 36864);
    const bf16_t* XR = (const bf16_t*)(ws + WS_XR); const bf16_t* GG = (const bf16_t*)(ws + WS_GG); bf16_t* YG = (bf16_t*)(ws + WS_YG);
    float* CARRY = (float*)(ws + WS_CARRY);
    const int NU = (MTOT / 128) * 10;
    for (int u = blockIdx.x; u < NU; u += gridDim.x) {
        const int T = u / 10, hb = u % 10, b = T / 66, tl = T % 66, row0 = T * 128;
        if (pass == 1 && tl < 2) continue;
        int tid = tid_; asm volatile("" : "+v"(tid));
        const int lane = tid & 63, r32 = lane & 31, hh = lane >> 5;
        const int seq_lo = tl < 2 ? b * RPB : b * RPB + CTXL, seq_hi = tl < 2 ? b * RPB + CTXL : (b + 1) * RPB;
        float h0 = 0.f;
        if (pass == 1) {
            typedef float f32x2 __attribute__((ext_vector_type(2)));
            const int chl = hb * 128 + nb * 32 + r32;
            const int pos = dir == 0 ? tl : 67 - tl;
            const float* cbase = CARRY + ((size_t)(b * 2 + dir) * 66) * DRNN * 2 + (size_t)chl * 2;
            f32x2 cv[33];
#pragma unroll
            for (int i = 0; i < 33; ++i) { const int p = hh * 33 + i; const int tile = dir == 0 ? p : (p < 2 ? 1 - p : 67 - p); cv[i] = *(const f32x2*)(cbase + (size_t)tile * DRNN * 2); }
            float cA = 1.f, cH = 0.f;
#pragma unroll
            for (int i = 0; i < 33; ++i) { const bool ok = hh * 33 + i < pos; const float ta = ok ? cv[i].x : 1.f, th = ok ? cv[i].y : 0.f; cH = ta * cH + th; cA = ta * cA; }
            const auto ra = __builtin_amdgcn_permlane32_swap(__float_as_uint(cA), __float_as_uint(cA), false, false);
            const auto rh = __builtin_amdgcn_permlane32_swap(__float_as_uint(cH), __float_as_uint(cH), false, false);
            const float lowH = hh == 0 ? cH : __uint_as_float(rh[0]);
            const float upA = hh == 0 ? __uint_as_float(ra[1]) : cA;
            const float upH = hh == 0 ? __uint_as_float(rh[1]) : cH;
            h0 = upA * lowH + upH;
        }
        __builtin_amdgcn_sched_barrier(0);
        {
            const int j2 = tid & 63, ts = tid >> 6, c0 = hb * 128 + 2 * j2;
            const float w00 = a.in[16][0 * DRNN + c0], w01 = a.in[16][0 * DRNN + c0 + 1], w10 = a.in[16][1 * DRNN + c0], w11 = a.in[16][1 * DRNN + c0 + 1];
            const float w20 = a.in[16][2 * DRNN + c0], w21 = a.in[16][2 * DRNN + c0 + 1], w30 = a.in[16][3 * DRNN + c0], w31 = a.in[16][3 * DRNN + c0 + 1];
            const float cb0 = a.in[17][c0], cb1 = a.in[17][c0 + 1];
            unsigned xw[19];
#pragma unroll
            for (int i = 0; i < 19; ++i) { const int g = row0 + ts * 16 - 2 + i; xw[i] = (g >= seq_lo && g < seq_hi) ? *(const unsigned*)(XR + (size_t)g * DRNN + c0) : 0u; }
#pragma unroll
            for (int i = 0; i < 16; ++i) {
                const float y0 = w00 * bflo(xw[i]) + w10 * bflo(xw[i + 1]) + w20 * bflo(xw[i + 2]) + w30 * bflo(xw[i + 3]) + cb0;
                const float y1 = w01 * bfhi(xw[i]) + w11 * bfhi(xw[i + 1]) + w21 * bfhi(xw[i + 2]) + w31 * bfhi(xw[i + 3]) + cb1;
                *(LAS unsigned*)(xcA + (ts * 16 + i) * XC_LD + 2 * j2) = pk2(y0, y1);
            }
        }
        __syncthreads();
        const int ch = hb * 128 + nb * 32 + r32;
        f32x16 accA[4], accX[4];
        {
            unsigned woff = (unsigned)((nb * 32 + r32) * 128 + 8 * hh); asm volatile("" : "+v"(woff));
            const bf16_t* wa = (const bf16_t*)(ws + WS_WAT) + (size_t)(dir * 10 + hb) * 128 * 128;
            const bf16_t* wx = (const bf16_t*)(ws + WS_WXT) + (size_t)(dir * 10 + hb) * 128 * 128;
            bf16x8 bfa[8], bfx[8];
#pragma unroll
            for (int k = 0; k < 8; ++k) { bfa[k] = *(const bf16x8*)(wa + woff + k * 16); bfx[k] = *(const bf16x8*)(wx + woff + k * 16); }
#pragma unroll
            for (int mb = 0; mb < 4; ++mb) {
                accA[mb] = f32x16{}; accX[mb] = f32x16{};
#pragma unroll
                for (int k = 0; k < 8; ++k) {
                    const bf16x8 af = *(const LAS bf16x8*)(xcA + (mb * 32 + r32) * XC_LD + k * 16 + 8 * hh);
                    accA[mb] = __builtin_amdgcn_mfma_f32_32x32x16_bf16(af, bfa[k], accA[mb], 0, 0, 0);
                    accX[mb] = __builtin_amdgcn_mfma_f32_32x32x16_bf16(af, bfx[k], accX[mb], 0, 0, 0);
                }
            }
        }
        __builtin_amdgcn_sched_barrier(0);
        {
            const float ba = a.in[19][dir * DRNN + ch], bx = a.in[21][dir * DRNN + ch], lam = a.in[22][dir * DRNN + ch];
            const float sp8l = -8.f * 1.4426950408889634f * log1pf(__expf(-lam)), nba = -1.4426950408889634f * ba, nbx = -1.4426950408889634f * bx;
#pragma unroll
            for (int mb = 0; mb < 4; ++mb)
#pragma unroll
                for (int r = 0; r < 16; ++r) {
                    const int t = mb * 32 + (r & 3) + 8 * (r >> 2) + 4 * hh;
                    const float xv = bf2f(xcA[t * XC_LD + nb * 32 + r32]);
                    const float rg = __builtin_amdgcn_rcpf(1.f + __builtin_amdgcn_exp2f(__builtin_fmaf(accA[mb][r], -1.4426950408889634f, nba)));
                    const float ig = __builtin_amdgcn_rcpf(1.f + __builtin_amdgcn_exp2f(__builtin_fmaf(accX[mb][r], -1.4426950408889634f, nbx)));
                    const float av = __builtin_amdgcn_exp2f(rg * sp8l);
                    const float om = fmaxf(__builtin_fmaf(-av, av, 1.f), 0.f);
                    accA[mb][r] = av; accX[mb][r] = __builtin_amdgcn_sqrtf(om) * ig * xv;
                    if ((r & 3) == 3) __builtin_amdgcn_sched_barrier(0);
                }
        }
        __builtin_amdgcn_sched_barrier(0);
        float h = h0;
        float Atot = 1.f; float cin[16];
#define RG_COMPOSITE(q) const int mb = (q) >> 2, rg = ((q) & 3) * 4; \
            const float a0 = accA[mb][rg], a1 = accA[mb][rg + 1], a2 = accA[mb][rg + 2], a3 = accA[mb][rg + 3]; \
            const float u0 = accX[mb][rg], u1 = accX[mb][rg + 1], u2 = accX[mb][rg + 2], u3 = accX[mb][rg + 3]; \
            const float gA = (a0 * a1) * (a2 * a3); \
            const float gH = dir == 0 ? ((u0 * a1 + u1) * a2 + u2) * a3 + u3 : ((u3 * a2 + u2) * a1 + u1) * a0 + u0; \
            const auto ra = __builtin_amdgcn_permlane32_swap(__float_as_uint(gA), __float_as_uint(gA), false, false); \
            const auto rh = __builtin_amdgcn_permlane32_swap(__float_as_uint(gH), __float_as_uint(gH), false, false); \
            const float pA = __uint_as_float(hh == 0 ? ra[1] : ra[0]), pH = __uint_as_float(hh == 0 ? rh[1] : rh[0]); \
            const float EA = hh ? pA : gA, EH = hh ? pH : gH, OA = hh ? gA : pA, OH = hh ? gH : pH;
        if (dir == 0) {
#pragma unroll
            for (int q = 0; q < 16; ++q) { RG_COMPOSITE(q)
                const float hE = h; h = EA * h + EH; const float hO = h; h = OA * h + OH; Atot *= EA * OA; cin[q] = hh ? hO : hE; }
        } else {
#pragma unroll
            for (int q = 15; q >= 0; --q) { RG_COMPOSITE(q)
                const float hO = h; h = OA * h + OH; const float hE = h; h = EA * h + EH; Atot *= EA * OA; cin[q] = hh ? hO : hE; }
        }
#undef RG_COMPOSITE
        if (pass == 0) {
            if (hh == 0) { float* c = CARRY + (((size_t)(b * 2 + dir) * 66 + tl) * DRNN + ch) * 2; c[0] = Atot; c[1] = h; }
            __syncthreads();
            continue;
        }
#pragma unroll
        for (int q = 0; q < 16; ++q) {
            const int mb = q >> 2, rg = (q & 3) * 4; float hc = cin[q];
            if (dir == 0) {
#pragma unroll
                for (int e = 0; e < 4; ++e) { hc = accA[mb][rg + e] * hc + accX[mb][rg + e]; accA[mb][rg + e] = hc; }
            } else {
#pragma unroll
                for (int e = 3; e >= 0; --e) { hc = accA[mb][rg + e] * hc + accX[mb][rg + e]; accA[mb][rg + e] = hc; }
            }
        }
        if (dir == 0) {
#pragma unroll
            for (int mb = 0; mb < 4; ++mb)
#pragma unroll
                for (int r = 0; r < 16; ++r) { const int t = mb * 32 + (r & 3) + 8 * (r >> 2) + 4 * hh; HS[t * 128 + nb * 32 + r32] = accA[mb][r]; }
        }
        __syncthreads();
        if (dir == 1) {
#pragma unroll
            for (int mb = 0; mb < 4; ++mb)
#pragma unroll
                for (int r = 0; r < 16; ++r) { const int t = mb * 32 + (r & 3) + 8 * (r >> 2) + 4 * hh; HS[t * 128 + nb * 32 + r32] += accA[mb][r]; }
        }
        __syncthreads();
        {
            const int t = tid >> 2, cs = (tid & 3) * 32, g = row0 + t;
            const bf16_t* gp = GG + (size_t)g * DRNN + hb * 128 + cs; bf16_t* yp = YG + (size_t)g * DRNN + hb * 128 + cs;
#pragma unroll
            for (int c8 = 0; c8 < 32; c8 += 8) {
                const u32x4 gw = *(const u32x4*)(gp + c8);
                const f32x4 h0 = *(const LAS f32x4*)(HS + t * 128 + cs + c8), h1 = *(const LAS f32x4*)(HS + t * 128 + cs + c8 + 4);
                u32x4 o; o.x = pk2(h0.x * bflo(gw.x), h0.y * bfhi(gw.x)); o.y = pk2(h0.z * bflo(gw.y), h0.w * bfhi(gw.y));
                o.z = pk2(h1.x * bflo(gw.z), h1.y * bfhi(gw.z)); o.w = pk2(h1.z * bflo(gw.w), h1.w * bfhi(gw.w));
                *(u32x4*)(yp + c8) = o;
            }
        }
        __syncthreads();
    }
}

namespace pg8 {
constexpr int BM = 256, BK = 64, HALF = 128, HTB = HALF * BK * 2, STAGE_BYTES = 8 * HTB, NXCD = 8, WGM = 8;
__host__ __device__ __forceinline__ int lds_byte(int r, int c) { const int st = (r >> 4) * 2 + (c >> 5), rr = r & 15, cc = c & 31, ob = rr * 64 + cc * 2; return st * 1024 + (ob ^ (((ob >> 9) & 1) << 5)); }
__host__ __device__ __forceinline__ void stage_rc(int b, int& R, int& C) { const int st = b / 1024, sb = b % 1024, swz = sb ^ (((sb >> 9) & 1) << 5); R = (st >> 1) * 16 + swz / 64; C = (st & 1) * 32 + (swz % 64) / 2; }
__host__ __device__ __forceinline__ int perm32(int rho) { const int n = rho >> 4, i = rho & 15; return 8 * (i >> 2) + 4 * n + (i & 3); }
struct Unit { int pm, pn; };
struct Gemm { const bf16_t* A; const bf16_t* Bt; int M, N, K; };
struct StaticOrder {
    int nM, nN, nwg, G, c;
    __host__ __device__ void init(int M, int N, int G_, int c_) { nM = M / BM; nN = N / BM; nwg = nM * nN; G = G_; c = c_; }
    __host__ __device__ bool next(int i, Unit& u) const {
        const long L = (long)i * G + c; if (L >= nwg) return false;
        int wgid = (int)L; { const int q = nwg / NXCD, r = nwg % NXCD, xcd = wgid % NXCD, off = wgid / NXCD; wgid = (xcd < r ? xcd * (q + 1) : r * (q + 1) + (xcd - r) * q) + off; }
        const int nig = WGM * nN, gid = wgid / nig, fm = gid * WGM, gsz = (nM - fm) < WGM ? (nM - fm) : WGM;
        u.pm = fm + ((wgid % nig) % gsz); u.pn = (wgid % nig) / gsz; return true;
    }
    __device__ __forceinline__ void a_ready(const Unit&) const {}
    __device__ __forceinline__ void done(const Unit&) const {}
};
struct LatentOrder {
    StaticOrder S;
    __host__ __device__ void init(int N, int G_, int c_) { S.init(16384, N, G_, c_); }
    __host__ __device__ bool next(int i, Unit& u) const { if (!S.next(i, u)) return false; u.pm = u.pm + 1 + (u.pm >= 32 ? 1 : 0); return true; }
    __device__ __forceinline__ void a_ready(const Unit&) const {}
    __device__ __forceinline__ void done(const Unit&) const {}
};
__device__ __forceinline__ unsigned cvt_pk_bf16(float lo, float hi) { unsigned r; asm volatile("v_cvt_pk_bf16_f32 %0, %1, %2" : "=v"(r) : "v"(lo), "v"(hi)); return r; }
__device__ __forceinline__ u32x4 pack8(const f32x4& v0, const f32x4& v1) { u32x4 w; w.x = cvt_pk_bf16(v0[0], v0[1]); w.y = cvt_pk_bf16(v0[2], v0[3]); w.z = cvt_pk_bf16(v1[0], v1[1]); w.w = cvt_pk_bf16(v1[2], v1[3]); return w; }
__device__ __forceinline__ f32x4 gelu4(const f32x4& v) { f32x4 r; r.x = gelu_t(v.x); r.y = gelu_t(v.y); r.z = gelu_t(v.z); r.w = gelu_t(v.w); return r; }

struct EpiStore {
    static constexpr bool PERM = true, AFTER_DRAIN = false;
    bf16_t* O1; bf16_t* O2; int ld; int split_tile; int gelu_tiles;
    __device__ __forceinline__ void operator()(f32x4 (&acc)[2][2][4][2], const Unit& u, int wr, int wc, int fr, int fq) const {
        const bool second = u.pn >= split_tile; bf16_t* base = second ? O2 : O1; const int pnl = second ? u.pn - split_tile : u.pn; const bool dog = u.pn < gelu_tiles;
        const int rl0 = wr * 64 + fr, cl0 = wc * 32 + 8 * fq;
#pragma unroll
        for (int ai = 0; ai < 2; ++ai)
#pragma unroll
            for (int m = 0; m < 4; ++m) { bf16_t* rowp = base + (size_t)(u.pm * BM + ai * HALF + m * 16 + rl0) * ld + pnl * BM + cl0;
#pragma unroll
                for (int bj = 0; bj < 2; ++bj) { f32x4 v0 = acc[ai][bj][m][0], v1 = acc[ai][bj][m][1]; if (dog) { v0 = gelu4(v0); v1 = gelu4(v1); }
                    *(u32x4*)(rowp + bj * HALF) = pack8(v0, v1); } }
    }
};
struct EpiPeerQ {
    static constexpr bool PERM = true, AFTER_DRAIN = false;
    bf16_t* QP; const bf16_t* KEYS; int* SELI; float* SELG;
    __device__ __forceinline__ void operator()(f32x4 (&acc)[2][2][4][2], const Unit& u, int wr, int wc, int fr, int fq) const {
        { int rl0 = wr * 64 + fr, cl0 = wc * 32 + 8 * fq; asm volatile("" : "+v"(rl0), "+v"(cl0));
#pragma unroll
          for (int ai = 0; ai < 2; ++ai)
#pragma unroll
            for (int m = 0; m < 4; ++m) { bf16_t* rowp = QP + (size_t)(u.pm * BM + ai * HALF + m * 16 + rl0) * 2048 + u.pn * BM + cl0;
#pragma unroll
                for (int bj = 0; bj < 2; ++bj) *(u32x4*)(rowp + bj * HALF) = pack8(acc[ai][bj][m][0], acc[ai][bj][m][1]); } }
        asm volatile("s_waitcnt vmcnt(0)" ::: "memory");
        __builtin_amdgcn_fence(__ATOMIC_RELEASE, "workgroup"); __builtin_amdgcn_s_barrier(); __builtin_amdgcn_fence(__ATOMIC_ACQUIRE, "workgroup");
        int lane = fq * 16 + fr; asm volatile("" : "+v"(lane));
        topk_item(QP, KEYS, SELI, SELG, u.pm * BM + (wr * 4 + wc) * 32, u.pn, lane & 31, lane >> 5);
    }
};
struct EpiResid {
    static constexpr bool PERM = true, AFTER_DRAIN = false;
    const float* x; const float* ctx; const float* modbase; float* X1; int base_mode;
    __device__ __forceinline__ void operator()(f32x4 (&acc)[2][2][4][2], const Unit& u, int wr, int wc, int fr, int fq) const {
        const int b = u.pm / 33, tl = u.pm % 33, var = tl == 0 ? 2 : b;
        const float* gate = modbase + (size_t)var * 6144 + u.pn * BM;
        const float* basep = base_mode == 0 ? (tl == 0 ? ctx + (size_t)b * CTXL * D : x + ((size_t)b * SEQ + (size_t)(tl - 1) * 256) * D) : X1 + (size_t)u.pm * BM * D;
        float* outp = X1 + (size_t)u.pm * BM * D;
        const int rl0 = wr * 64 + fr, cl0 = u.pn * BM + wc * 32 + 8 * fq;
        f32x4 gv[2][2];
#pragma unroll
        for (int bj = 0; bj < 2; ++bj)
#pragma unroll
            for (int n = 0; n < 2; ++n) gv[bj][n] = *(const f32x4*)(gate + bj * HALF + wc * 32 + 8 * fq + 4 * n);
#pragma unroll
        for (int ai = 0; ai < 2; ++ai)
#pragma unroll
            for (int m = 0; m < 4; ++m) { const size_t off = (size_t)(ai * HALF + m * 16 + rl0) * D + cl0;
#pragma unroll
                for (int bj = 0; bj < 2; ++bj)
#pragma unroll
                    for (int n = 0; n < 2; ++n) { const f32x4 bs = *(const f32x4*)(basep + off + bj * HALF + 4 * n); *(f32x4*)(outp + off + bj * HALF + 4 * n) = bs + gv[bj][n] * acc[ai][bj][m][n]; } }
    }
};
struct EpiInproj0 {
    static constexpr bool PERM = true, AFTER_DRAIN = false;
    unsigned char* ws; const float* gmg; const float* qg; const float* kg; LAS float* P;
    __device__ __forceinline__ void operator()(f32x4 (&acc)[2][2][4][2], const Unit& u, int wr, int wc, int fr, int fq) const {
        int rl0 = wr * 64 + fr, cl0 = wc * 32 + 8 * fq; asm volatile("" : "+v"(rl0), "+v"(cl0));
        const int pn = u.pn; const size_t grow0 = (size_t)u.pm * BM;
        if (pn < 4) {
#pragma unroll
            for (int ai = 0; ai < 2; ++ai)
#pragma unroll
                for (int bj = 0; bj < 2; ++bj)
#pragma unroll
                    for (int m = 0; m < 4; ++m) { acc[ai][bj][m][0] = gelu4(acc[ai][bj][m][0]); acc[ai][bj][m][1] = gelu4(acc[ai][bj][m][1]); __builtin_amdgcn_sched_barrier(0); }
        }
        if (pn < 2 || pn == 7) {
            bf16_t* base = pn < 2 ? (bf16_t*)(ws + WS_U) + pn * BM : (bf16_t*)(ws + WS_V); const int ld = pn < 2 ? 512 : 256;
#pragma unroll
            for (int ai = 0; ai < 2; ++ai)
#pragma unroll
                for (int m = 0; m < 4; ++m) { bf16_t* rowp = base + (grow0 + ai * HALF + m * 16 + rl0) * ld + cl0;
#pragma unroll
                    for (int bj = 0; bj < 2; ++bj) *(u32x4*)(rowp + bj * HALF) = pack8(acc[ai][bj][m][0], acc[ai][bj][m][1]); }
            return;
        }
#pragma unroll
        for (int ai = 0; ai < 2; ++ai)
#pragma unroll
            for (int m = 0; m < 4; ++m)
#pragma unroll
                for (int bj = 0; bj < 2; ++bj) { const f32x4 a0 = acc[ai][bj][m][0], a1 = acc[ai][bj][m][1];
                    float s = (a0.x * a0.x + a0.y * a0.y) + (a0.z * a0.z + a0.w * a0.w) + (a1.x * a1.x + a1.y * a1.y) + (a1.z * a1.z + a1.w * a1.w);
                    s += __shfl_xor(s, 16); s += __shfl_xor(s, 32);
                    if (fq == 0) P[((ai * HALF + m * 16 + rl0) * 2 + bj) * 4 + wc] = s; __builtin_amdgcn_sched_barrier(0); }
        asm volatile("s_waitcnt lgkmcnt(0)" ::: "memory"); __builtin_amdgcn_s_barrier(); asm volatile("" ::: "memory");
        if (pn < 4) {
            bf16_t* base = (bf16_t*)(ws + WS_VV) + (pn - 2) * BM; const float* gp = gmg + (pn - 2) * BM + cl0;
            f32x4 g8[2][2];
#pragma unroll
            for (int bj = 0; bj < 2; ++bj) { g8[bj][0] = *(const f32x4*)(gp + bj * HALF); g8[bj][1] = *(const f32x4*)(gp + bj * HALF + 4); }
#pragma unroll
            for (int ai = 0; ai < 2; ++ai)
#pragma unroll
                for (int m = 0; m < 4; ++m) { const int rl = ai * HALF + m * 16 + rl0; bf16_t* rowp = base + (grow0 + rl) * 512 + cl0;
#pragma unroll
                    for (int bj = 0; bj < 2; ++bj) { const f32x4 p = *(const LAS f32x4*)(P + (rl * 2 + bj) * 4);
                        const float rinv = rsqrtf(((p.x + p.y) + (p.z + p.w)) * (1.f / 128.f) + EPS);
                        *(u32x4*)(rowp + bj * HALF) = pack8(acc[ai][bj][m][0] * rinv * g8[bj][0], acc[ai][bj][m][1] * rinv * g8[bj][1]); }
                    asm volatile("" ::: "memory"); __builtin_amdgcn_sched_barrier(0); }
            return;
        }
        {
            const bool isq = pn < 6; const float* gn = isq ? qg : kg;
            const int grp = cl0 >> 3, fo = (grp >> 3) * 64 + (grp & 7) * 4;
            const f32x4 gA = *(const f32x4*)(gn + fo), gB = *(const f32x4*)(gn + fo + 32);
            bf16_t* base = isq ? (bf16_t*)(ws + WS_Q) + (pn - 4) * BM : (bf16_t*)(ws + WS_K); const int ld = isq ? 512 : 256;
            const int tl = u.pm % 33; const bool lat = tl != 0; const int ax = grp >> 3, f0 = (grp & 7) * 4;
            const float* rope = (const float*)(ws + WS_ROPE);
#pragma unroll
            for (int ai = 0; ai < 2; ++ai)
#pragma unroll
                for (int m = 0; m < 4; ++m) { const int rl = ai * HALF + m * 16 + rl0; bf16_t* rowp = base + (grow0 + rl) * ld + cl0;
                    f32x4 cs0 = {1.f, 0.f, 1.f, 0.f}, cs1 = {1.f, 0.f, 1.f, 0.f};
                    if (lat) { const int t = (tl - 1) * 256 + rl; const int pos = ax == 0 ? (t >> 6) : (t & 63); const float* rp = rope + (pos * 32 + f0) * 2; cs0 = *(const f32x4*)rp; cs1 = *(const f32x4*)(rp + 4); }
#pragma unroll
                    for (int bj = 0; bj < 2; ++bj) { const f32x4 p = *(const LAS f32x4*)(P + (rl * 2 + bj) * 4);
                        const float rinv = rsqrtf(((p.x + p.y) + (p.z + p.w)) * (1.f / 128.f) + EPS);
                        const f32x4 x1 = acc[ai][bj][m][0] * rinv * gA, x2 = acc[ai][bj][m][1] * rinv * gB;
                        f32x4 o1, o2;
                        o1.x = x1.x * cs0.x - x2.x * cs0.y; o2.x = x2.x * cs0.x + x1.x * cs0.y;
                        o1.y = x1.y * cs0.z - x2.y * cs0.w; o2.y = x2.y * cs0.z + x1.y * cs0.w;
                        o1.z = x1.z * cs1.x - x2.z * cs1.y; o2.z = x2.z * cs1.x + x1.z * cs1.y;
                        o1.w = x1.w * cs1.z - x2.w * cs1.w; o2.w = x2.w * cs1.z + x1.w * cs1.w;
                        *(u32x4*)(rowp + bj * HALF) = pack8(o1, o2); }
                    asm volatile("" ::: "memory"); __builtin_amdgcn_sched_barrier(0); }
        }
    }
};

template <class Epi, class Sched, bool ALIGN_EPI = false, bool SP2 = false>
__device__ __forceinline__ void gemm_phase(LAS unsigned char* lds, const Gemm g, const Sched& S, const Epi& E) {
    const int tid = threadIdx.x, wid = __builtin_amdgcn_readfirstlane(tid >> 6), lane = tid & 63, wr = wid >> 2, wc = wid & 3, fr = lane & 15, fq = lane >> 4;
    const int K = g.K, nt = K / BK;
    unsigned voffA[2], voffB[2];
#pragma unroll
    for (int i = 0; i < 2; ++i) { int R, C; stage_rc(tid * 16 + i * 8192, R, C); const int Rb = Epi::PERM ? ((R & ~31) + perm32(R & 31)) : R;
        voffA[i] = (unsigned)(R * K + C) * 2u; voffB[i] = (unsigned)(Rb * K + C) * 2u; }
    const size_t kstep = (size_t)(BK * 2);
    const size_t hstep = (size_t)HALF * K * 2;
    const size_t tstep = 2 * hstep;
    const unsigned ldsw = (unsigned)wid * 1024u;
    const int aoff = lds_byte(wr * 64 + fr, fq * 8), boff = lds_byte(wc * 32 + fr, fq * 8);
#define PG8_SA(b, h) (((b) * 2 + (h)) * HTB)
#define PG8_SB(b, h) ((4 + (b) * 2 + (h)) * HTB)
#define PG8_STAGE(bufoff, gbase, voff) do { _Pragma("unroll") for (int _i = 0; _i < 2; ++_i) \
        __builtin_amdgcn_global_load_lds((const unsigned*)((const char*)(gbase) + (voff)[_i]), (LAS unsigned*)(lds + (bufoff) + ldsw + _i * 8192), 16, 0, 0); } while (0)
#define PG8_LDA(dst, b, h) do { _Pragma("unroll") for (int m = 0; m < 4; ++m) _Pragma("unroll") for (int k = 0; k < 2; ++k) dst[m][k] = *(const LAS bf16x8*)(lds + PG8_SA(b, h) + aoff + m * 2048 + k * 1024); } while (0)
#define PG8_LDB(dst, b, h) do { _Pragma("unroll") for (int n = 0; n < 2; ++n) _Pragma("unroll") for (int k = 0; k < 2; ++k) dst[n][k] = *(const LAS bf16x8*)(lds + PG8_SB(b, h) + boff + n * 2048 + k * 1024); } while (0)
#define PG8_MMA(ai, bj, At, Bt) do { __builtin_amdgcn_s_setprio(1); _Pragma("unroll") for (int m = 0; m < 4; ++m) _Pragma("unroll") for (int n = 0; n < 2; ++n) _Pragma("unroll") for (int k = 0; k < 2; ++k) \
        acc[ai][bj][m][n] = __builtin_amdgcn_mfma_f32_16x16x32_bf16(Bt[n][k], At[m][k], acc[ai][bj][m][n], 0, 0, 0); __builtin_amdgcn_s_setprio(0); } while (0)
#define PG8_WAIT_V(n) asm volatile("s_waitcnt vmcnt(" #n ")" ::: "memory")
#define PG8_WAIT_L(n) asm volatile("s_waitcnt lgkmcnt(" #n ")" ::: "memory")
#define PG8_BAR __builtin_amdgcn_s_barrier()
#define PG8_SCHED __builtin_amdgcn_sched_barrier(0)
    Unit cur, nxt; int ui = 0;
    if (!S.next(0, cur)) return;
    f32x4 acc[2][2][4][2];
#pragma unroll
    for (int a = 0; a < 2; ++a)
#pragma unroll
        for (int b = 0; b < 2; ++b)
#pragma unroll
            for (int m = 0; m < 4; ++m)
#pragma unroll
                for (int n = 0; n < 2; ++n) acc[a][b][m][n] = (f32x4){0.f, 0.f, 0.f, 0.f};
    bf16x8 At[4][2], B0[2][2], B1[2][2];
    const char* cA = (const char*)g.A + (size_t)cur.pm * tstep; const char* cB = (const char*)g.Bt + (size_t)cur.pn * tstep;
    S.a_ready(cur);
    if constexpr (SP2) {
        PG8_STAGE(PG8_SB(0, 0), cB, voffB); PG8_STAGE(PG8_SB(0, 1), cB + hstep, voffB); PG8_STAGE(PG8_SA(0, 0), cA, voffA); PG8_STAGE(PG8_SA(0, 1), cA + hstep, voffA);
        if (wr == 1) PG8_BAR;
        PG8_WAIT_V(2); PG8_BAR;
        PG8_STAGE(PG8_SB(1, 0), cB + kstep, voffB); PG8_STAGE(PG8_SA(1, 0), cA + kstep, voffA); PG8_STAGE(PG8_SB(1, 1), cB + hstep + kstep, voffB);
        PG8_WAIT_V(6); PG8_BAR;
    } else {
        PG8_STAGE(PG8_SB(0, 0), cB, voffB); PG8_STAGE(PG8_SA(0, 0), cA, voffA); PG8_STAGE(PG8_SB(0, 1), cB + hstep, voffB); PG8_STAGE(PG8_SA(0, 1), cA + hstep, voffA);
        if (wr == 1) PG8_BAR;
        PG8_WAIT_V(4); PG8_BAR;
        PG8_STAGE(PG8_SB(1, 0), cB + kstep, voffB); PG8_STAGE(PG8_SA(1, 0), cA + kstep, voffA); PG8_STAGE(PG8_SB(1, 1), cB + hstep + kstep, voffB);
        PG8_WAIT_V(6); PG8_BAR;
    }
    for (;;) {
        const bool has_next = S.next(ui + 1, nxt);
        const char* nA = has_next ? (const char*)g.A + (size_t)nxt.pm * tstep : cA; const char* nB = has_next ? (const char*)g.Bt + (size_t)nxt.pn * tstep : cB;
        for (int t = 0; t < nt; t += 2) {
            const bool last = (t == nt - 2);
            const char* a1 = cA + (size_t)(t + 1) * kstep;
            const char* a2 = last ? nA : cA + (size_t)(t + 2) * kstep; const char* b2 = last ? nB : cB + (size_t)(t + 2) * kstep;
            const char* a3 = a2 + kstep; const char* b3 = b2 + kstep;
            if (last && has_next) S.a_ready(nxt);
            if constexpr (SP2) {
            PG8_LDB(B0, 0, 0); PG8_LDB(B1, 0, 1); PG8_SCHED; PG8_LDA(At, 0, 0); PG8_STAGE(PG8_SA(1, 1), a1 + hstep, voffA);
            PG8_WAIT_V(8); PG8_WAIT_L(0); PG8_BAR; PG8_MMA(0, 0, At, B0); PG8_MMA(0, 1, At, B1); PG8_BAR; PG8_SCHED;
            PG8_LDA(At, 0, 1); PG8_STAGE(PG8_SB(0, 0), b2, voffB); PG8_STAGE(PG8_SB(0, 1), b2 + hstep, voffB); PG8_STAGE(PG8_SA(0, 0), a2, voffA);
            PG8_WAIT_V(8); PG8_WAIT_L(0); PG8_BAR; PG8_MMA(1, 0, At, B0); PG8_MMA(1, 1, At, B1); PG8_BAR; PG8_SCHED;
            PG8_LDB(B0, 1, 0); PG8_LDB(B1, 1, 1); PG8_SCHED; PG8_LDA(At, 1, 0); PG8_STAGE(PG8_SA(0, 1), a2 + hstep, voffA);
            PG8_WAIT_V(8); PG8_WAIT_L(0); PG8_BAR; PG8_MMA(0, 0, At, B0); PG8_MMA(0, 1, At, B1); PG8_BAR; PG8_SCHED;
            PG8_LDA(At, 1, 1); PG8_STAGE(PG8_SB(1, 0), b3, voffB); PG8_STAGE(PG8_SB(1, 1), b3 + hstep, voffB); PG8_STAGE(PG8_SA(1, 0), a3, voffA);
            PG8_WAIT_V(8); PG8_WAIT_L(0); PG8_BAR; PG8_MMA(1, 0, At, B0); PG8_MMA(1, 1, At, B1); PG8_BAR; PG8_SCHED;
            } else {
            PG8_LDB(B0, 0, 0); PG8_SCHED; PG8_LDA(At, 0, 0); PG8_STAGE(PG8_SA(1, 1), a1 + hstep, voffA);
            PG8_WAIT_L(8); PG8_BAR; PG8_WAIT_L(0); PG8_MMA(0, 0, At, B0); PG8_BAR; PG8_SCHED;
            PG8_LDB(B1, 0, 1); PG8_STAGE(PG8_SB(0, 0), b2, voffB);
            PG8_BAR; PG8_WAIT_L(0); PG8_MMA(0, 1, At, B1); PG8_BAR;
            PG8_LDA(At, 0, 1); PG8_STAGE(PG8_SA(0, 0), a2, voffA);
            PG8_BAR; PG8_WAIT_L(0); PG8_MMA(1, 0, At, B0); PG8_BAR; PG8_SCHED;
            PG8_STAGE(PG8_SB(0, 1), b2 + hstep, voffB);
            PG8_WAIT_V(6); PG8_BAR; PG8_MMA(1, 1, At, B1); PG8_BAR;
            PG8_LDB(B0, 1, 0); PG8_SCHED; PG8_LDA(At, 1, 0); PG8_STAGE(PG8_SA(0, 1), a2 + hstep, voffA);
            PG8_WAIT_L(8); PG8_BAR; PG8_WAIT_L(0); PG8_MMA(0, 0, At, B0); PG8_BAR; PG8_SCHED;
            PG8_LDB(B1, 1, 1); PG8_STAGE(PG8_SB(1, 0), b3, voffB);
            PG8_BAR; PG8_WAIT_L(0); PG8_MMA(0, 1, At, B1); PG8_BAR;
            PG8_LDA(At, 1, 1); PG8_STAGE(PG8_SA(1, 0), a3, voffA);
            PG8_BAR; PG8_WAIT_L(0); PG8_MMA(1, 0, At, B0); PG8_BAR; PG8_SCHED;
            PG8_STAGE(PG8_SB(1, 1), b3 + hstep, voffB);
            PG8_WAIT_V(6); PG8_BAR; PG8_MMA(1, 1, At, B1); PG8_BAR;
            }
        }
        if constexpr (ALIGN_EPI) { if (wr == 0) PG8_BAR; }
        if constexpr (!Epi::AFTER_DRAIN) { E(acc, cur, wr, wc, fr, fq); S.done(cur); }
        if (!has_next) break;
#pragma unroll
        for (int a = 0; a < 2; ++a)
#pragma unroll
            for (int b = 0; b < 2; ++b)
#pragma unroll
                for (int m = 0; m < 4; ++m)
#pragma unroll
                    for (int n = 0; n < 2; ++n) acc[a][b][m][n] = (f32x4){0.f, 0.f, 0.f, 0.f};
        cur = nxt; cA = nA; cB = nB; ++ui;
        if constexpr (ALIGN_EPI) { if (wr == 1) PG8_BAR; }
    }
    PG8_WAIT_V(0);
    if constexpr (!ALIGN_EPI) { if (wr == 0) PG8_BAR; }
    PG8_BAR;
#undef PG8_SA
#undef PG8_SB
#undef PG8_STAGE
#undef PG8_LDA
#undef PG8_LDB
#undef PG8_MMA
#undef PG8_WAIT_V
#undef PG8_WAIT_L
#undef PG8_BAR
#undef PG8_SCHED
}
}

__device__ __forceinline__ void fphase_inproj0(const Args& a, char* lds) {
    pg8::Gemm g{(const bf16_t*)(a.ws + WS_H), (const bf16_t*)(a.ws + WS_WIN0), MTOT, 2048, 1024};
    pg8::StaticOrder S; S.init(MTOT, 2048, (int)gridDim.x, (int)blockIdx.x);
    pg8::EpiInproj0 E{a.ws, a.in[9], a.in[12], a.in[13], (LAS float*)((LAS char*)lds + 131072)};
    pg8::gemm_phase<pg8::EpiInproj0, pg8::StaticOrder, true, true>((LAS unsigned char*)lds, g, S, E);
    const int G = (int)gridDim.x, nbusy = 528 - 2 * G;
    if (G == 256 && (int)blockIdx.x >= nbusy) quant_tables(a, 1, ((int)blockIdx.x - nbusy) * NWAVE + (int)(threadIdx.x >> 6), (G - nbusy) * NWAVE, (int)(threadIdx.x & 63));
    else if (G != 256) quant_tables(a, 1, (int)blockIdx.x * NWAVE + (int)(threadIdx.x >> 6), G * NWAVE, (int)(threadIdx.x & 63));
}
__device__ __forceinline__ void fphase_outproj0(const Args& a, char* lds) {
    pg8::Gemm g{(const bf16_t*)(a.ws + WS_AO), (const bf16_t*)(a.ws + WS_WOUT0), MTOT, 1024, 1024};
    pg8::StaticOrder S; S.init(MTOT, 1024, (int)gridDim.x, (int)blockIdx.x);
    pg8::EpiResid E{a.in[0], a.in[2], (const float*)(a.ws + WS_MODV) + 2 * 1024, (float*)(a.ws + WS_X1), 0};
    pg8::gemm_phase<pg8::EpiResid, pg8::StaticOrder, true, true>((LAS unsigned char*)lds, g, S, E);
    const int G = (int)gridDim.x, nbusy = (G == 256) ? 264 - G : 0;
    if ((int)blockIdx.x >= nbusy) for (int r = (int)blockIdx.x - nbusy; r < N_L1_ITEMS; r += G - nbusy) prep_l1_item(a, (float*)lds, r);
}
__device__ __forceinline__ void fphase_peerq0(const Args& a, char* lds) {
    pg8::Gemm g{(const bf16_t*)(a.ws + WS_H), (const bf16_t*)(a.ws + WS_WQ), MTOT, 2048, 1024};
    pg8::StaticOrder S; S.init(MTOT, 2048, (int)gridDim.x, (int)blockIdx.x);
    pg8::EpiStore E{(bf16_t*)(a.ws + WS_QP), (bf16_t*)(a.ws + WS_QP), 2048, 1000, 0};
    pg8::gemm_phase<pg8::EpiStore, pg8::StaticOrder, true, true>((LAS unsigned char*)lds, g, S, E);
}
__device__ __forceinline__ void fphase_inproj1(const Args& a, char* lds) {
    pg8::Gemm g{(const bf16_t*)(a.ws + WS_H), (const bf16_t*)(a.ws + WS_WIN1), MTOT, 2560, 1024};
    pg8::StaticOrder S; S.init(MTOT, 2560, (int)gridDim.x, (int)blockIdx.x);
    pg8::EpiStore E{(bf16_t*)(a.ws + WS_GG), (bf16_t*)(a.ws + WS_XR), 1280, 5, 5};
    pg8::gemm_phase<pg8::EpiStore, pg8::StaticOrder, true, true>((LAS unsigned char*)lds, g, S, E);
}
__device__ __forceinline__ void fphase_outproj1(const Args& a, char* lds) {
    pg8::Gemm g{(const bf16_t*)(a.ws + WS_YG), (const bf16_t*)(a.ws + WS_WOUT1), MTOT, 1024, 1280};
    pg8::LatentOrder S; S.init(1024, (int)gridDim.x, (int)blockIdx.x);
    pg8::EpiResid E{a.in[0], a.in[2], (const float*)(a.ws + WS_MODV) + 3 * 6144 + 2 * 1024, (float*)(a.ws + WS_X1), 1};
    pg8::gemm_phase<pg8::EpiResid, pg8::LatentOrder, true, true>((LAS unsigned char*)lds, g, S, E);
}
__device__ __forceinline__ void fphase_peerq1(const Args& a, char* lds) {
    pg8::Gemm g{(const bf16_t*)(a.ws + WS_H), (const bf16_t*)(a.ws + WS_WQ) + (size_t)2048 * 1024, MTOT, 2048, 1024};
    pg8::LatentOrder S; S.init(2048, (int)gridDim.x, (int)blockIdx.x);
    pg8::EpiStore E{(bf16_t*)(a.ws + WS_QP), (bf16_t*)(a.ws + WS_QP), 2048, 1000, 0};
    pg8::gemm_phase<pg8::EpiStore, pg8::LatentOrder, true, true>((LAS unsigned char*)lds, g, S, E);
}

constexpr int NPHASE = 23;
__global__ void __launch_bounds__(NTHR, 2) mega(Args a) {
    extern __shared__ __attribute__((aligned(16))) char lds[];
    volatile LAS unsigned* MISC = (volatile LAS unsigned*)((LAS char*)lds + LDS_MISC);
    if (threadIdx.x < 64) MISC[threadIdx.x] = 0u;
    __syncthreads();
    XcdBarrier bar; bar.bar = (unsigned*)(a.ws + WS_CTL) + 4096; bar.x = 0; bar.st = nullptr;
    const bool multi = (a.ph_hi - a.ph_lo) > 1;
    if (multi) bar = xcd_barrier_post((unsigned*)(a.ws + WS_CTL) + 4096, MISC + 8);
    const int lo = a.ph_lo, hi = a.ph_hi;
    unsigned char* ws = a.ws;
#define IN(k) (lo <= (k) && (k) < hi)
#define SEAM(k) do { if (IN(k) && IN((k) + 1)) xcd_barrier(bar); } while (0)
#ifndef PROBE_DUP
#define PROBE_DUP 0u
#endif
#define DUPQ(k) (((PROBE_DUP >> (k)) & 1u) != 0u)
    if (IN(0)) { phase_prep(a, lds); if (DUPQ(0)) { xcd_barrier(bar); phase_prep(a, lds); } } SEAM(0);
    if (IN(1)) { phase_norm(a, 0, 0, a.in[6], 0, 1, false); if (DUPQ(1)) { xcd_barrier(bar); phase_norm(a, 0, 0, a.in[6], 0, 1, false); } } SEAM(1);
    if (IN(2)) { fphase_inproj0(a, lds); if (DUPQ(2)) { xcd_barrier(bar); fphase_inproj0(a, lds); } } SEAM(2);
    if (IN(3)) { phase_gmlp2(a, lds); phase_attn(a, lds); if (DUPQ(3)) { xcd_barrier(bar); phase_gmlp2(a, lds); phase_attn(a, lds); } } SEAM(3);
    if (IN(4)) { fphase_outproj0(a, lds); if (DUPQ(4)) { xcd_barrier(bar); fphase_outproj0(a, lds); } } SEAM(4);
    if (IN(5)) { phase_norm(a, 0, 1, a.in[7], 3, 4, false, true); if (DUPQ(5)) { xcd_barrier(bar); phase_norm(a, 0, 1, a.in[7], 3, 4, false, true); } } SEAM(5);
    if (IN(6)) { fphase_peerq0(a, lds); if (DUPQ(6)) { xcd_barrier(bar); fphase_peerq0(a, lds); } } SEAM(6);
    if (IN(7)) { phase_peer_topk3(a, lds, 0, false); if (DUPQ(7)) { xcd_barrier(bar); phase_peer_topk3(a, lds, 0, false); } } SEAM(7);
    if (IN(8)) { phase_gu(a, lds, 0, 0); if (DUPQ(8)) { xcd_barrier(bar); phase_gu(a, lds, 0, 0); } } SEAM(8);
    if (IN(9)) { phase_gact(a, 0, 0); if (DUPQ(9)) { xcd_barrier(bar); phase_gact(a, 0, 0); } } SEAM(9);
    if (IN(10)) { phase_gv(a, lds, 0, 0); if (DUPQ(10)) { xcd_barrier(bar); phase_gv(a, lds, 0, 0); } } SEAM(10);
    if (IN(11)) { phase_norm(a, 1, 1, a.in[6] + D, 0, 1, false); if (DUPQ(11)) { xcd_barrier(bar); phase_norm(a, 1, 1, a.in[6] + D, 0, 1, false); } } SEAM(11);
    if (IN(12)) { fphase_inproj1(a, lds); if (DUPQ(12)) { xcd_barrier(bar); fphase_inproj1(a, lds); } } SEAM(12);
    if (IN(13)) { phase_rglru2(a, lds, 0); if (DUPQ(13)) { xcd_barrier(bar); phase_rglru2(a, lds, 0); } } SEAM(13);
    if (IN(14)) { phase_rglru2(a, lds, 1); if (DUPQ(14)) { xcd_barrier(bar); phase_rglru2(a, lds, 1); } } SEAM(14);
    if (IN(15)) { fphase_outproj1(a, lds); if (DUPQ(15)) { xcd_barrier(bar); fphase_outproj1(a, lds); } } SEAM(15);
    if (IN(16)) { phase_norm(a, 1, 1, a.in[7] + D, 3, 4, true, true); if (DUPQ(16)) { xcd_barrier(bar); phase_norm(a, 1, 1, a.in[7] + D, 3, 4, true, true); } } SEAM(16);
    if (IN(17)) { fphase_peerq1(a, lds); if (DUPQ(17)) { xcd_barrier(bar); fphase_peerq1(a, lds); } } SEAM(17);
    if (IN(18)) { phase_peer_topk3(a, lds, 1, true); if (DUPQ(18)) { xcd_barrier(bar); phase_peer_topk3(a, lds, 1, true); } } SEAM(18);
    if (IN(19)) { phase_gu(a, lds, 1, 1); if (DUPQ(19)) { xcd_barrier(bar); phase_gu(a, lds, 1, 1); } } SEAM(19);
    if (IN(20)) { phase_gact(a, 1, 1); if (DUPQ(20)) { xcd_barrier(bar); phase_gact(a, 1, 1); } } SEAM(20);
    if (IN(21)) { phase_gv(a, lds, 1, 1); if (DUPQ(21)) { xcd_barrier(bar); phase_gv(a, lds, 1, 1); } } SEAM(21);
    if (IN(22)) { phase_finalnorm(a); if (DUPQ(22)) { xcd_barrier(bar); phase_finalnorm(a); } }
#undef IN
#undef SEAM
}

extern "C" void kernel_launch(void* const* d_in, const int* in_sizes, int n_in, void* d_out, int out_size, void* d_ws, size_t ws_size, hipStream_t stream) {
    static int grid = 0;
    if (grid == 0) {
        if (n_in != 29 || out_size != NB * SEQ * D || ws_size < WS_END) {
            fprintf(stderr, "kernel_launch: unexpected shapes: n_in %d out %d ws %zu (need %zu)\n", n_in, out_size, ws_size, (size_t)WS_END); grid = -1; return; }
        int dev = 0, cus = 0, per_cu = 0;
        if (hipGetDevice(&dev) != hipSuccess || hipDeviceGetAttribute(&cus, hipDeviceAttributeMultiprocessorCount, dev) != hipSuccess) { grid = -1; return; }
        if (hipFuncSetAttribute((const void*)mega, hipFuncAttributeMaxDynamicSharedMemorySize, LDS_BYTES) != hipSuccess) { fprintf(stderr, "kernel_launch: hipFuncSetAttribute failed\n"); grid = -1; return; }
        if (hipOccupancyMaxActiveBlocksPerMultiprocessor(&per_cu, (const void*)mega, NTHR, LDS_BYTES) != hipSuccess || per_cu < 1)
            fprintf(stderr, "kernel_launch: occupancy query reports %d blocks per CU\n", per_cu);
        (void)hipGetLastError();
        grid = cus;
    }
    if (grid < 0) return;
    (void)hipMemsetAsync((char*)d_ws + WS_CTL, 0, CTL_BYTES, stream);
    Args a{};
    for (int i = 0; i < 29; ++i) a.in[i] = (const float*)d_in[i];
    a.out = (float*)d_out; a.ws = (unsigned char*)d_ws;
#if MK_SINGLE
    a.ph_lo = 0; a.ph_hi = NPHASE;
    hipLaunchKernelGGL(mega, dim3(grid), dim3(NTHR), LDS_BYTES, stream, a);
#else
    for (int p = 0; p < NPHASE; ++p) { a.ph_lo = p; a.ph_hi = p + 1; hipLaunchKernelGGL(mega, dim3(grid), dim3(NTHR), LDS_BYTES, stream, a); }
#endif
    const hipError_t le = hipPeekAtLastError();
    if (le != hipSuccess) fprintf(stderr, "kernel_launch: launch failed: %s\n", hipGetErrorName(le));
}
```

```cpp
#include <hip/hip_runtime.h>
#include <cstdio>
#include <cstdint>

#ifndef MK_SINGLE
#define MK_SINGLE 1
#endif

#define GAS __attribute__((address_space(1)))
#define LAS __attribute__((address_space(3)))

typedef unsigned short bf16_t;
typedef short bf16x8 __attribute__((ext_vector_type(8)));
typedef float f32x4 __attribute__((ext_vector_type(4)));
typedef float f32x16 __attribute__((ext_vector_type(16)));
typedef unsigned u32x4 __attribute__((ext_vector_type(4)));
typedef unsigned u32x2 __attribute__((ext_vector_type(2)));

constexpr int D = 1024, NB = 2, SEQ = 8192, CTXL = 256;
constexpr int RPB = SEQ + CTXL;
constexpr int MTOT = NB * RPB;
constexpr int AB_IN = 2048, A_W = 512, DRNN = 1280, NEXP = 16384;
constexpr float EPS = 1e-6f;
constexpr int NTHR = 512, NWAVE = 8;

constexpr size_t MiB = 1u << 20;
constexpr size_t WS_CTL = 0, CTL_BYTES = 1 * MiB;
constexpr size_t WS_MODV = 1 * MiB;
constexpr size_t WS_ROPE = 1 * MiB + 512 * 1024;
constexpr size_t WS_WIN0 = 2 * MiB;
constexpr size_t WS_WOUT0 = 6 * MiB;
constexpr size_t WS_WIN1 = 8 * MiB;
constexpr size_t WS_WOUT1 = 13 * MiB;
constexpr size_t WS_WQ = 16 * MiB;
constexpr size_t WS_KEYS = 24 * MiB;
constexpr size_t WS_GWS = 25 * MiB;
constexpr size_t WS_WAT = 26 * MiB;
constexpr size_t WS_WXT = 27 * MiB;
constexpr size_t WS_CARRY = 28 * MiB;
constexpr size_t WS_SCU = 31 * MiB;
constexpr size_t WS_SCV = 31 * MiB + 512 * 1024;
constexpr size_t WS_PU = 32 * MiB;
constexpr size_t WS_PV = 96 * MiB;
constexpr size_t WS_H = 160 * MiB;
constexpr size_t WS_X1 = 193 * MiB;
constexpr size_t WS_SELI = 259 * MiB;
constexpr size_t WS_SELG = 268 * MiB;
constexpr size_t WS_R = 277 * MiB;
constexpr size_t WS_U = WS_R;
constexpr size_t WS_VV = WS_R + 17 * MiB;
constexpr size_t WS_Q = WS_R + 34 * MiB;
constexpr size_t WS_K = WS_R + 51 * MiB;
constexpr size_t WS_V = WS_R + 60 * MiB;
constexpr size_t WS_AO = WS_R + 69 * MiB;
constexpr size_t WS_QP = WS_R;
constexpr size_t WS_H8 = WS_R + 70 * MiB;
constexpr size_t WS_SH = WS_R + 88 * MiB;
constexpr size_t WS_ACT16 = WS_R + 89 * MiB;
constexpr size_t WS_SA = WS_R + 94 * MiB;
constexpr size_t WS_PART = WS_R;
constexpr size_t WS_GG = WS_R;
constexpr size_t WS_XR = WS_R + 42 * MiB;
constexpr size_t WS_YG = WS_R + 84 * MiB;
constexpr size_t WS_END = WS_R + 126 * MiB;

constexpr int LDS_BYTES = 147456;
constexpr int LDS_MISC = 145408;

__device__ __forceinline__ float bf2f(bf16_t v) { return __uint_as_float(((unsigned)v) << 16); }
__device__ __forceinline__ unsigned f2bf(float f) { unsigned u = __float_as_uint(f); return (u + 0x7fffu + ((u >> 16) & 1u)) >> 16; }
__device__ __forceinline__ unsigned pk2(float lo, float hi) { return f2bf(lo) | (f2bf(hi) << 16); }
__device__ __forceinline__ float bflo(unsigned w) { return __uint_as_float(w << 16); }
__device__ __forceinline__ float bfhi(unsigned w) { return __uint_as_float(w & 0xffff0000u); }
__device__ __forceinline__ float gelu_t(float x) { const float y = -2.302208198144325f * (x + 0.044715f * x * x * x); return x * __builtin_amdgcn_rcpf(1.f + __builtin_amdgcn_exp2f(y)); }
__device__ __forceinline__ float sigmoidf_(float x) { return 1.f / (1.f + __expf(-x)); }
__device__ __forceinline__ float wave_sum(float v) {
#pragma unroll
    for (int o = 1; o < 64; o <<= 1) v += __shfl_xor(v, o);
    return v;
}
__host__ __device__ __forceinline__ int sigma_head(int j) { const int grp = j >> 3, n = (j >> 2) & 1, e = j & 3; return (grp >> 3) * 64 + n * 32 + (grp & 7) * 4 + e; }

struct Args {
    const float* in[29];
    float* out;
    unsigned char* ws;
    int ph_lo, ph_hi;
};

__device__ __forceinline__ int row_variant(int g) { const int b = g / RPB, i = g - b * RPB; return i < CTXL ? 2 : b; }
__device__ __forceinline__ const float* row_src(const Args& a, int g) {
    const int b = g / RPB, i = g - b * RPB;
    return i < CTXL ? a.in[2] + ((size_t)b * CTXL + i) * D : a.in[0] + ((size_t)b * SEQ + (i - CTXL)) * D;
}
__device__ __forceinline__ const float* modv(const Args& a, int layer, int variant, int which) {
    return (const float*)(a.ws + WS_MODV) + ((size_t)(layer * 3 + variant) * 6 + which) * D;
}

#define XB_TMO      128
#define XB_XCNT(j)  (256  + 64 * (j))
#define XB_XSUB(j)  (1280 + 64 * (j))
#define XB_XGEN(j)  (2304 + 64 * (j))
#define XB_TOP      3328
#define XB_TOPGEN   3392
#define XCD_BAR_WORDS 3456
#define XB_SPIN_CAP (1u << 22)
__device__ __forceinline__ unsigned xb_ld(unsigned* p)              { return __hip_atomic_load(p, __ATOMIC_RELAXED, __HIP_MEMORY_SCOPE_AGENT); }
__device__ __forceinline__ unsigned xb_add(unsigned* p, unsigned v) { return __hip_atomic_fetch_add(p, v, __ATOMIC_RELAXED, __HIP_MEMORY_SCOPE_AGENT); }
__device__ __forceinline__ unsigned xb_xcc_id() { return (unsigned)__builtin_amdgcn_s_getreg((3 << 11) | 20) & 0xFu; }
#define XB_SPIN(cond, bar) do { unsigned _sp = 0; while (cond) { __builtin_amdgcn_s_sleep(1); \
    if ((++_sp & 255u) == 0u) { if (xb_ld(&(bar)[XB_TMO])) break; if (_sp > XB_SPIN_CAP) { atomicAdd(&(bar)[XB_TMO], 1u); break; } } } } while (0)
struct XcdBarrier { unsigned* bar; unsigned x; volatile LAS unsigned* st; };
__device__ __forceinline__ XcdBarrier xcd_barrier_post(unsigned* bar, volatile LAS unsigned* st) {
    XcdBarrier b; b.bar = bar; b.x = xb_xcc_id(); b.st = st;
    if (threadIdx.x == 0) (void)xb_add(&bar[XB_XCNT(b.x)], 1u);
    return b;
}
__device__ __forceinline__ void xcd_barrier_complete(unsigned* bar, unsigned x, unsigned& nloc, unsigned& nx) {
    const unsigned G = gridDim.x * gridDim.y * gridDim.z;
    unsigned sum, cnt, mine, sp = 0u;
    for (;;) {
        sum = 0u; cnt = 0u; mine = 0u;
#pragma unroll
        for (unsigned j = 0; j < 16; ++j) { const unsigned c = xb_ld(&bar[XB_XCNT(j)]); sum += c; cnt += (c > 0u) ? 1u : 0u; mine = (j == x) ? c : mine; }
        if (sum == G) break;
        __builtin_amdgcn_s_sleep(1);
        if ((++sp & 255u) == 0u) { if (xb_ld(&bar[XB_TMO])) break; if (sp > XB_SPIN_CAP) { atomicAdd(&bar[XB_TMO], 1u); break; } }
    }
    nloc = mine > 0u ? mine : 1u; nx = cnt > 0u ? cnt : 1u;
}
__device__ __forceinline__ void xcd_barrier(const XcdBarrier& b) {
    asm volatile("s_waitcnt vmcnt(0)" ::: "memory");
    __syncthreads();
    if (threadIdx.x == 0) {
        unsigned* bar = b.bar;
        __builtin_amdgcn_s_waitcnt(0);
        unsigned nloc = b.st[0], nx = b.st[1];
        if (nloc == 0u) { xcd_barrier_complete(bar, b.x, nloc, nx); b.st[0] = nloc; b.st[1] = nx; }
        const unsigned old = xb_add(&bar[XB_XSUB(b.x)], 1u);
        const unsigned gen = old / nloc;
        if (old + 1u == (gen + 1u) * nloc) {
            __builtin_amdgcn_fence(__ATOMIC_RELEASE, "agent");
            asm volatile("s_waitcnt vmcnt(0)" ::: "memory");
            const unsigned og = xb_add(&bar[XB_TOP], 1u);
            const unsigned tg = og / nx;
            if (og + 1u == (tg + 1u) * nx) xb_add(&bar[XB_TOPGEN], 1u);
            else XB_SPIN(xb_ld(&bar[XB_TOPGEN]) == tg, bar);
            __builtin_amdgcn_fence(__ATOMIC_ACQUIRE, "agent");
            xb_add(&bar[XB_XGEN(b.x)], 1u);
            asm volatile("s_waitcnt vmcnt(0)" ::: "memory");
        } else {
            XB_SPIN(xb_ld(&bar[XB_XGEN(b.x)]) == gen, bar);
            __builtin_amdgcn_fence(__ATOMIC_ACQUIRE, "agent");
            asm volatile("s_waitcnt vmcnt(0)" ::: "memory");
        }
    }
    __syncthreads();
}

__device__ __forceinline__ void quant_tables(const Args& a, int layer, int gw, int ngw, int lane) {
    unsigned char* ws = a.ws;
    for (int r0 = gw * 4; r0 < 2 * NEXP; r0 += ngw * 4) {
        f32x4 v[4][4]; float mx[4];
#pragma unroll
        for (int q = 0; q < 4; ++q) {
            const int r = r0 + q, tb = r / NEXP, ex = r - tb * NEXP;
            const float* src = a.in[tb == 0 ? 26 : 27] + ((size_t)layer * NEXP + ex) * D;
#pragma unroll
            for (int j = 0; j < 4; ++j) v[q][j] = *(const f32x4*)(src + j * 256 + lane * 4);
        }
#pragma unroll
        for (int q = 0; q < 4; ++q) { float m = 0.f;
#pragma unroll
            for (int j = 0; j < 4; ++j) m = fmaxf(fmaxf(fmaxf(fabsf(v[q][j].x), fabsf(v[q][j].y)), fmaxf(fabsf(v[q][j].z), fabsf(v[q][j].w))), m);
            mx[q] = m; }
#pragma unroll
        for (int o = 1; o < 64; o <<= 1) {
#pragma unroll
            for (int q = 0; q < 4; ++q) mx[q] = fmaxf(mx[q], __shfl_xor(mx[q], o)); }
#pragma unroll
        for (int q = 0; q < 4; ++q) {
            const int r = r0 + q, tb = r / NEXP, ex = r - tb * NEXP;
            const float m = fmaxf(mx[q], 1e-30f), inv = 127.f / m;
            unsigned char* dst = ws + (tb == 0 ? WS_PU : WS_PV) + (size_t)layer * NEXP * D + (size_t)ex * 128 + (lane & 31) * 4;
            const int bias = tb == 0 ? 0 : 128;
#pragma unroll
            for (int j = 0; j < 4; ++j) {
                const unsigned b0 = (unsigned)(__float2int_rn(v[q][j].x * inv) + bias) & 0xffu, b1 = (unsigned)(__float2int_rn(v[q][j].y * inv) + bias) & 0xffu;
                const unsigned b2 = (unsigned)(__float2int_rn(v[q][j].z * inv) + bias) & 0xffu, b3 = (unsigned)(__float2int_rn(v[q][j].w * inv) + bias) & 0xffu;
                *(unsigned*)(dst + (size_t)(2 * j + (lane >> 5)) * NEXP * 128) = b0 | (b1 << 8) | (b2 << 16) | (b3 << 24);
            }
            if (lane == 0) ((float*)(ws + (tb == 0 ? WS_SCU : WS_SCV)))[layer * NEXP + ex] = m * (1.f / 127.f);
        }
    }
}
__device__ __forceinline__ void transpose_item4(const float* src, int Ns, bf16_t* dst, int Kd, int n0, int k0, int dn1, int dk1, int dn2, int dk2, int dn3, int dk3, int perm_lo, int perm_hi, float* tile) {
    const int tid = threadIdx.x;
    const int dnv[4] = {0, dn1, dn2, dn3}, dkv[4] = {0, dk1, dk2, dk3};
    float v[4][8];
#pragma unroll
    for (int t = 0; t < 4; ++t) {
        const int nn = tid & 63; int n = n0 + dnv[t] + nn;
        if (n >= perm_lo && n < perm_hi) { const int rel = n - perm_lo; n = perm_lo + (rel & ~127) + sigma_head(rel & 127); }
#pragma unroll
        for (int i = 0; i < 8; ++i) { const int kk = (tid >> 6) + 8 * i; v[t][i] = src[(size_t)(k0 + dkv[t] + kk) * Ns + n]; }
    }
#pragma unroll
    for (int t = 0; t < 4; ++t)
#pragma unroll
        for (int i = 0; i < 8; ++i) { const int kk = (tid >> 6) + 8 * i; tile[t * 64 * 65 + kk * 65 + (tid & 63)] = v[t][i]; }
    __syncthreads();
#pragma unroll
    for (int t = 0; t < 4; ++t) {
        const int n = tid >> 3, kc = (tid & 7) * 8; const float* tl = tile + t * 64 * 65;
        u32x4 o;
        o.x = pk2(tl[(kc + 0) * 65 + n], tl[(kc + 1) * 65 + n]); o.y = pk2(tl[(kc + 2) * 65 + n], tl[(kc + 3) * 65 + n]);
        o.z = pk2(tl[(kc + 4) * 65 + n], tl[(kc + 5) * 65 + n]); o.w = pk2(tl[(kc + 6) * 65 + n], tl[(kc + 7) * 65 + n]);
        *(u32x4*)(dst + (size_t)(n0 + dnv[t] + n) * Kd + k0 + dkv[t] + kc) = o;
    }
    __syncthreads();
}
__device__ __forceinline__ void transpose_wide(const float* src, int Ns, bf16_t* dst, int Kd, int ng, int kb, int perm_lo, int perm_hi, float* tile) {
    transpose_item4(src, Ns, dst, Kd, ng * 256, kb * 64, 64, 0, 128, 0, 192, 0, perm_lo, perm_hi, tile);
}
__device__ __forceinline__ void cvt_stream(const float* src, bf16_t* dst, size_t n8, size_t gtid, size_t gthreads) {
    for (size_t i = gtid; i < n8; i += gthreads) {
        const f32x4 a = *(const f32x4*)(src + i * 8), b = *(const f32x4*)(src + i * 8 + 4);
        u32x4 o; o.x = pk2(a.x, a.y); o.y = pk2(a.z, a.w); o.z = pk2(b.x, b.y); o.w = pk2(b.z, b.w);
        *(u32x4*)(dst + i * 8) = o;
    }
}
__device__ __forceinline__ void prep_l1_item(const Args& a, float* tile, int r) {
    unsigned char* ws = a.ws;
    constexpr int I_WIN1 = 16 * 10, I_WOUT1 = 20 * 4, I_WQ1 = 16 * 8;
    if (r < I_WIN1) { transpose_wide(a.in[15], 2560, (bf16_t*)(ws + WS_WIN1), 1024, r % 10, r / 10, 0, 0, tile); return; }
    r -= I_WIN1;
    if (r < I_WOUT1) { transpose_wide(a.in[23], 1024, (bf16_t*)(ws + WS_WOUT1), 1280, r % 4, r / 4, 0, 0, tile); return; }
    r -= I_WOUT1;
    if (r < I_WQ1) { transpose_wide(a.in[24] + (size_t)1024 * 2048, 2048, (bf16_t*)(ws + WS_WQ) + (size_t)2048 * 1024, 1024, r % 8, r / 8, 0, 0, tile); return; }
    r -= I_WQ1;
    { const int which = r / 20, dh = r % 20;
        const float* src = a.in[which == 0 ? 18 : 20] + (size_t)dh * 128 * 128;
        bf16_t* dst = (bf16_t*)(ws + (which == 0 ? WS_WAT : WS_WXT)) + (size_t)dh * 128 * 128;
        transpose_item4(src, 128, dst, 128, 0, 0, 64, 0, 0, 64, 64, 64, 0, 0, tile);
    }
}
constexpr int N_L1_ITEMS = 160 + 80 + 128 + 40;
__device__ __forceinline__ void phase_prep(const Args& a, char* lds) {
    const int tid = threadIdx.x, lane = tid & 63, wid = tid >> 6;
    float* tile = (float*)lds;
    unsigned char* ws = a.ws;
    constexpr int I_MOD = 192;
    constexpr int I_WIN0 = 16 * 8, I_WOUT0 = 16 * 4, I_WQ0 = 16 * 8;
    constexpr int NIT = I_MOD + I_WIN0 + I_WOUT0 + I_WQ0;
    for (int it = blockIdx.x; it < NIT; it += gridDim.x) {
        int r = it;
        if (r < I_MOD) {
            const int l = r / 96, n0 = (r % 96) * 64;
            const float* W = a.in[4] + (size_t)l * D * 6144;
            float s0 = 0.f, s1 = 0.f, s2 = 0.f;
            float sl[3][2];
#pragma unroll
            for (int h = 0; h < 2; ++h) { const int k = wid * 128 + h * 64 + lane; const float c0 = a.in[1][k], c1 = a.in[1][D + k], c2 = a.in[3][k];
                sl[0][h] = c0 * sigmoidf_(c0); sl[1][h] = c1 * sigmoidf_(c1); sl[2][h] = c2 * sigmoidf_(c2); }
            const float* Wp = W + (size_t)(wid * 128) * 6144 + n0 + lane;
#pragma unroll
            for (int kk = 0; kk < 128; kk += 16) {
                float w[16];
#pragma unroll
                for (int j = 0; j < 16; ++j) w[j] = Wp[(size_t)(kk + j) * 6144];
#pragma unroll
                for (int j = 0; j < 16; ++j) { const int kq = kk + j;
                    s0 += __shfl(sl[0][kq >> 6], kq & 63) * w[j]; s1 += __shfl(sl[1][kq >> 6], kq & 63) * w[j]; s2 += __shfl(sl[2][kq >> 6], kq & 63) * w[j]; }
            }
            tile[(wid * 3 + 0) * 64 + lane] = s0; tile[(wid * 3 + 1) * 64 + lane] = s1; tile[(wid * 3 + 2) * 64 + lane] = s2;
            __syncthreads();
            if (tid < 192) {
                const int v = tid / 64, ln = tid & 63; float s = a.in[5][(size_t)l * 6144 + n0 + ln];
                for (int w = 0; w < 8; ++w) s += tile[(w * 3 + v) * 64 + ln];
                ((float*)(ws + WS_MODV))[(size_t)(l * 3 + v) * 6144 + n0 + ln] = s;
            }
            __syncthreads();
            continue;
        }
        r -= I_MOD;
        if (r < I_WIN0) { transpose_wide(a.in[8], 2048, (bf16_t*)(ws + WS_WIN0), 1024, r % 8, r / 8, 1024, 1792, tile); continue; }
        r -= I_WIN0;
        if (r < I_WOUT0) { transpose_wide(a.in[14], 1024, (bf16_t*)(ws + WS_WOUT0), 1024, r % 4, r / 4, 0, 0, tile); continue; }
        r -= I_WOUT0;
        transpose_wide(a.in[24], 2048, (bf16_t*)(ws + WS_WQ), 1024, r % 8, r / 8, 0, 0, tile);
    }
    const size_t gtid = (size_t)blockIdx.x * NTHR + tid, gthreads = (size_t)gridDim.x * NTHR;
    cvt_stream(a.in[25], (bf16_t*)(ws + WS_KEYS), (size_t)2 * 8 * 2 * 128 * 128 / 8, gtid, gthreads);
    cvt_stream(a.in[10], (bf16_t*)(ws + WS_GWS), (size_t)4 * 128 * 128 / 8, gtid, gthreads);
    quant_tables(a, 0, blockIdx.x * NWAVE + wid, gridDim.x * NWAVE, lane);
    for (size_t i = gtid; i < 128 * 32; i += gthreads) {
        const int pos = (int)(i / 32), f = (int)(i % 32);
        const float inv = powf(10000.f, -(float)f / 32.f); const float ang = (float)pos * inv;
        float* R = (float*)(ws + WS_ROPE); R[i * 2] = cosf(ang); R[i * 2 + 1] = sinf(ang);
    }
}

__device__ __forceinline__ void norm_row_store(const f32x4 (&v)[4], const float* g, const float* sh, const float* sc, bf16_t* orow, int lane, unsigned char* q8row = nullptr, float* q8scale = nullptr) {
    float s = 0.f;
#pragma unroll
    for (int j = 0; j < 4; ++j) s += (v[j].x * v[j].x + v[j].y * v[j].y) + (v[j].z * v[j].z + v[j].w * v[j].w);
    const float rinv = rsqrtf(wave_sum(s) * (1.f / D) + EPS);
    f32x4 o[4]; float mx = 0.f;
#pragma unroll
    for (int j = 0; j < 4; ++j) {
        const int c = j * 256 + lane * 4;
        const f32x4 gg = *(const f32x4*)(g + c), s1 = *(const f32x4*)(sh + c), s2 = *(const f32x4*)(sc + c);
        o[j].x = v[j].x * rinv * gg.x * (1.f + s2.x) + s1.x; o[j].y = v[j].y * rinv * gg.y * (1.f + s2.y) + s1.y;
        o[j].z = v[j].z * rinv * gg.z * (1.f + s2.z) + s1.z; o[j].w = v[j].w * rinv * gg.w * (1.f + s2.w) + s1.w;
        u32x2 w; w.x = pk2(o[j].x, o[j].y); w.y = pk2(o[j].z, o[j].w);
        *(u32x2*)(orow + c) = w;
        mx = fmaxf(fmaxf(fmaxf(fabsf(o[j].x), fabsf(o[j].y)), fmaxf(fabsf(o[j].z), fabsf(o[j].w))), mx);
    }
    if (q8row) {
#pragma unroll
        for (int of = 1; of < 64; of <<= 1) mx = fmaxf(mx, __shfl_xor(mx, of));
        mx = fmaxf(mx, 1e-30f); const float inv = 127.f / mx;
#pragma unroll
        for (int j = 0; j < 4; ++j) {
            const unsigned b0 = (unsigned)__float2int_rn(o[j].x * inv) & 0xffu, b1 = (unsigned)__float2int_rn(o[j].y * inv) & 0xffu;
            const unsigned b2 = (unsigned)__float2int_rn(o[j].z * inv) & 0xffu, b3 = (unsigned)__float2int_rn(o[j].w * inv) & 0xffu;
            *(unsigned*)(q8row + j * 256 + lane * 4) = b0 | (b1 << 8) | (b2 << 16) | (b3 << 24);
        }
        if (lane == 0) *q8scale = mx * (1.f / 127.f);
    }
}
__device__ __forceinline__ void phase_norm(const Args& a, int layer, int src_mode, const float* gain, int which_sh, int which_sc, bool latent_only, bool wq8 = false) {
    const int lane = threadIdx.x & 63, gw = blockIdx.x * NWAVE + (threadIdx.x >> 6), ngw = gridDim.x * NWAVE;
    bf16_t* H = (bf16_t*)(a.ws + WS_H);
    const float* X1 = (const float*)(a.ws + WS_X1);
    for (int g = gw; g < MTOT; g += ngw) {
        const int var = row_variant(g);
        if (latent_only && var == 2) continue;
        const float* xr = src_mode == 0 ? row_src(a, g) : X1 + (size_t)g * D;
        f32x4 v[4];
#pragma unroll
        for (int j = 0; j < 4; ++j) v[j] = *(const f32x4*)(xr + j * 256 + lane * 4);
        norm_row_store(v, gain, modv(a, layer, var, which_sh), modv(a, layer, var, which_sc), H + (size_t)g * D, lane, wq8 ? a.ws + WS_H8 + (size_t)g * D : nullptr, wq8 ? (float*)(a.ws + WS_SH) + g : nullptr);
    }
}

constexpr int CS_LD = 132;
__device__ __forceinline__ void gemm_tile128(const bf16_t* A, int lda, const bf16_t* Bt, int ldb, int K, float* Cs) {
    const int tid = threadIdx.x, lane = tid & 63, wid = tid >> 6, r = lane & 31, h = lane >> 5, wr = wid >> 1, wc = wid & 1;
    const bf16_t* ap = A + (size_t)(wr * 32 + r) * lda + 8 * h;
    const bf16_t* bp0 = Bt + (size_t)(wc * 64 + r) * ldb + 8 * h;
    const bf16_t* bp1 = bp0 + (size_t)32 * ldb;
    f32x16 acc0 = {}, acc1 = {};
#pragma unroll 4
    for (int k = 0; k < K; k += 16) {
        const bf16x8 av = *(const bf16x8*)(ap + k), b0 = *(const bf16x8*)(bp0 + k), b1 = *(const bf16x8*)(bp1 + k);
        acc0 = __builtin_amdgcn_mfma_f32_32x32x16_bf16(av, b0, acc0, 0, 0, 0);
        acc1 = __builtin_amdgcn_mfma_f32_32x32x16_bf16(av, b1, acc1, 0, 0, 0);
    }
#pragma unroll
    for (int i = 0; i < 16; ++i) {
        const int row = wr * 32 + (i & 3) + 8 * (i >> 2) + 4 * h;
        Cs[row * CS_LD + wc * 64 + r] = acc0[i];
        Cs[row * CS_LD + wc * 64 + 32 + r] = acc1[i];
    }
}

__device__ __forceinline__ void phase_inproj0(const Args& a, char* lds) {
    float* Cs = (float*)lds;
    const int tid = threadIdx.x;
    unsigned char* ws = a.ws;
    const bf16_t* H = (const bf16_t*)(ws + WS_H); const bf16_t* W = (const bf16_t*)(ws + WS_WIN0);
    const float* rope = (const float*)(ws + WS_ROPE);
    const int NU = (MTOT / 128) * 16;
    for (int u = blockIdx.x; u < NU; u += gridDim.x) {
        const int rt = u / 16, ct = u % 16, row0 = rt * 128, col0 = ct * 128;
        gemm_tile128(H + (size_t)row0 * D, D, W + (size_t)col0 * D, D, D, Cs);
        __syncthreads();
        const int rr = tid >> 2, q4 = tid & 3, g = row0 + rr;
        float* crow = Cs + rr * CS_LD + q4 * 32;
        if (ct < 4) {
            bf16_t* o = (bf16_t*)(ws + WS_U) + (size_t)g * 512 + col0 + q4 * 32;
#pragma unroll
            for (int c = 0; c < 32; c += 2) *(unsigned*)(o + c) = pk2(gelu_t(crow[c]), gelu_t(crow[c + 1]));
        } else if (ct < 8) {
            const int gg = ct - 4; float ss = 0.f;
#pragma unroll
            for (int c = 0; c < 32; ++c) { const float v = gelu_t(crow[c]); crow[c] = v; ss += v * v; }
            ss += __shfl_xor(ss, 1); ss += __shfl_xor(ss, 2);
            const float rinv = rsqrtf(ss * (1.f / 128.f) + EPS);
            const float* gn = a.in[9] + gg * 128 + q4 * 32;
            bf16_t* o = (bf16_t*)(ws + WS_VV) + (size_t)g * 512 + gg * 128 + q4 * 32;
#pragma unroll
            for (int c = 0; c < 32; c += 2) *(unsigned*)(o + c) = pk2(crow[c] * rinv * gn[c], crow[c + 1] * rinv * gn[c + 1]);
        } else if (ct < 14) {
            const bool isq = ct < 12; const int hh = isq ? ct - 8 : ct - 12;
            float ss = 0.f;
#pragma unroll
            for (int c = 0; c < 32; ++c) ss += crow[c] * crow[c];
            ss += __shfl_xor(ss, 1); ss += __shfl_xor(ss, 2);
            const float rinv = rsqrtf(ss * (1.f / 128.f) + EPS);
            const float* gn = a.in[isq ? 12 : 13];
            const int b = g / RPB, i = g - b * RPB; const bool lat = i >= CTXL; const int t = i - CTXL;
            bf16_t* o = (isq ? (bf16_t*)(ws + WS_Q) + (size_t)g * 512 : (bf16_t*)(ws + WS_K) + (size_t)g * 256) + hh * 128 + q4 * 32;
#pragma unroll
            for (int c8 = 0; c8 < 32; c8 += 8) {
                float y[8];
#pragma unroll
                for (int e = 0; e < 8; ++e) { const int j = q4 * 32 + c8 + e; y[e] = crow[c8 + e] * rinv * gn[sigma_head(j)]; }
                if (lat) {
                    const int grp = (q4 * 32 + c8) >> 3, ax = grp >> 3; const int pos = ax == 0 ? (t >> 6) : (t & 63);
#pragma unroll
                    for (int e = 0; e < 4; ++e) { const int f = (grp & 7) * 4 + e; const float cs = rope[(pos * 32 + f) * 2], sn = rope[(pos * 32 + f) * 2 + 1];
                        const float x1 = y[e], x2 = y[e + 4]; y[e] = x1 * cs - x2 * sn; y[e + 4] = x2 * cs + x1 * sn; }
                }
                u32x4 w; w.x = pk2(y[0], y[1]); w.y = pk2(y[2], y[3]); w.z = pk2(y[4], y[5]); w.w = pk2(y[6], y[7]);
                *(u32x4*)(o + c8) = w;
            }
        } else {
            bf16_t* o = (bf16_t*)(ws + WS_V) + (size_t)g * 256 + (ct - 14) * 128 + q4 * 32;
#pragma unroll
            for (int c = 0; c < 32; c += 2) *(unsigned*)(o + c) = pk2(crow[c], crow[c + 1]);
        }
        __syncthreads();
    }
}

__device__ __forceinline__ void phase_gmlp(const Args& a, char* lds) {
    const int tid = threadIdx.x;
    unsigned char* ws = a.ws;
    float* vt = (float*)lds;
    const bf16_t* VV = (const bf16_t*)(ws + WS_VV); const bf16_t* U = (const bf16_t*)(ws + WS_U); bf16_t* AO = (bf16_t*)(ws + WS_AO);
    const int NU = (MTOT / 128) * 4;
    for (int u = blockIdx.x; u < NU; u += gridDim.x) {
        const int ch = u / 4, g = u % 4, row0 = ch * 128;
        for (int i = tid; i < 128 * 128; i += NTHR) { const int q = i >> 7, c = i & 127; vt[i] = bf2f(VV[(size_t)(row0 + q) * 512 + g * 128 + c]); }
        __syncthreads();
        const int c = tid & 127, pq = tid >> 7;
        const float* wsg = a.in[10] + (size_t)g * 128 * 128;
        for (int pp = 0; pp < 32; ++pp) {
            const int p = pq * 32 + pp; float s = 0.f;
            for (int q = 0; q < 128; ++q) s += wsg[p * 128 + q] * vt[q * 128 + c];
            s += a.in[11][g * 128 + p];
            const float uu = bf2f(U[(size_t)(row0 + p) * 512 + g * 128 + c]);
            AO[(size_t)(row0 + p) * 1024 + g * 128 + c] = (bf16_t)f2bf(uu * s);
        }
        __syncthreads();
    }
}

__device__ __forceinline__ void phase_gmlp2(const Args& a, char* lds) {
    const int tid = threadIdx.x, lane = tid & 63, wid = __builtin_amdgcn_readfirstlane(tid >> 6), r32 = lane & 31, hh = lane >> 5;
    unsigned char* ws = a.ws;
    LAS bf16_t* vT = (LAS bf16_t*)((LAS char*)lds);
    const bf16_t* VV = (const bf16_t*)(ws + WS_VV); const bf16_t* U = (const bf16_t*)(ws + WS_U); bf16_t* AO = (bf16_t*)(ws + WS_AO);
    const bf16_t* GWS = (const bf16_t*)(ws + WS_GWS);
    const int NU = (MTOT / 128) * 4;
    for (int u = blockIdx.x; u < NU; u += gridDim.x) {
        const int ch = u >> 2, g = u & 3, row0 = ch * 128;
#pragma unroll
        for (int i = 0; i < 4; ++i) {
            const int q = (tid >> 4) + 32 * i, c0 = (tid & 15) * 8;
            const u32x4 w = *(const u32x4*)(VV + (size_t)(row0 + q) * 512 + g * 128 + c0);
            vT[(c0 + 0) * 136 + q] = (bf16_t)(w.x & 0xffffu); vT[(c0 + 1) * 136 + q] = (bf16_t)(w.x >> 16);
            vT[(c0 + 2) * 136 + q] = (bf16_t)(w.y & 0xffffu); vT[(c0 + 3) * 136 + q] = (bf16_t)(w.y >> 16);
            vT[(c0 + 4) * 136 + q] = (bf16_t)(w.z & 0xffffu); vT[(c0 + 5) * 136 + q] = (bf16_t)(w.z >> 16);
            vT[(c0 + 6) * 136 + q] = (bf16_t)(w.w & 0xffffu); vT[(c0 + 7) * 136 + q] = (bf16_t)(w.w >> 16);
        }
        __syncthreads();
        const int mb = wid >> 1, nb0 = (wid & 1) * 2;
        f32x16 acc0 = {}, acc1 = {};
        {
            unsigned aoff = (unsigned)((mb * 32 + r32) * 128 + 8 * hh); asm volatile("" : "+v"(aoff));
            const bf16_t* wsg = GWS + (size_t)g * 128 * 128;
#pragma unroll
            for (int ks = 0; ks < 8; ++ks) {
                const bf16x8 af = *(const bf16x8*)(wsg + aoff + ks * 16);
                const bf16x8 b0 = *(const LAS bf16x8*)(vT + (nb0 * 32 + r32) * 136 + ks * 16 + 8 * hh);
                const bf16x8 b1 = *(const LAS bf16x8*)(vT + ((nb0 + 1) * 32 + r32) * 136 + ks * 16 + 8 * hh);
                acc0 = __builtin_amdgcn_mfma_f32_32x32x16_bf16(af, b0, acc0, 0, 0, 0);
                acc1 = __builtin_amdgcn_mfma_f32_32x32x16_bf16(af, b1, acc1, 0, 0, 0);
            }
        }
#pragma unroll
        for (int r = 0; r < 16; ++r) {
            const int p = mb * 32 + (r & 3) + 8 * (r >> 2) + 4 * hh;
            const float bsv = a.in[11][g * 128 + p];
            const size_t ub = (size_t)(row0 + p) * 512 + g * 128, ob = (size_t)(row0 + p) * 1024 + g * 128;
            const int c0 = nb0 * 32 + r32, c1 = c0 + 32;
            AO[ob + c0] = (bf16_t)f2bf(bf2f(U[ub + c0]) * (acc0[r] + bsv));
            AO[ob + c1] = (bf16_t)f2bf(bf2f(U[ub + c1]) * (acc1[r] + bsv));
        }
        __syncthreads();
    }
}

__device__ __forceinline__ void phase_attn_naive(const Args& a, char* lds) {
    const int tid = threadIdx.x;
    unsigned char* ws = a.ws;
    float* Ks = (float*)lds;
    float* Vs = Ks + 32 * 128;
    float* part = Vs + 32 * 128;
    const bf16_t* Q = (const bf16_t*)(ws + WS_Q); const bf16_t* Kb = (const bf16_t*)(ws + WS_K); const bf16_t* Vb = (const bf16_t*)(ws + WS_V);
    bf16_t* AO = (bf16_t*)(ws + WS_AO);
    const int NU = 512 + 16;
    for (int u = blockIdx.x; u < NU; u += gridDim.x) {
        int b, h, qrow0, nkeys;
        if (u < 512) { b = u / 256; h = (u / 64) % 4; qrow0 = b * RPB + CTXL + (u % 64) * 128; nkeys = RPB; }
        else { const int v = u - 512; b = v / 8; h = (v / 2) % 4; qrow0 = b * RPB + (v % 2) * 128; nkeys = CTXL; }
        const int kvh = h >> 1, krow0 = b * RPB;
        const int qi = tid & 127, qt = tid >> 7;
        float q[32], o[32];
        {
            const bf16_t* qp = Q + (size_t)(qrow0 + qi) * 512 + h * 128 + qt * 32;
#pragma unroll
            for (int d = 0; d < 32; d += 2) { const unsigned w = *(const unsigned*)(qp + d); q[d] = bflo(w) * 0.08838834764831845f; q[d + 1] = bfhi(w) * 0.08838834764831845f; }
#pragma unroll
            for (int d = 0; d < 32; ++d) o[d] = 0.f;
        }
        float m = -1e30f, l = 0.f;
        for (int k0 = 0; k0 < nkeys; k0 += 32) {
            {
                const int key = tid >> 4, cs = (tid & 15) * 8;
                const u32x4 kw = *(const u32x4*)(Kb + (size_t)(krow0 + k0 + key) * 256 + kvh * 128 + cs);
                const u32x4 vw = *(const u32x4*)(Vb + (size_t)(krow0 + k0 + key) * 256 + kvh * 128 + cs);
                float* kd = Ks + key * 128 + cs; float* vd = Vs + key * 128 + cs;
                kd[0] = bflo(kw.x); kd[1] = bfhi(kw.x); kd[2] = bflo(kw.y); kd[3] = bfhi(kw.y); kd[4] = bflo(kw.z); kd[5] = bfhi(kw.z); kd[6] = bflo(kw.w); kd[7] = bfhi(kw.w);
                vd[0] = bflo(vw.x); vd[1] = bfhi(vw.x); vd[2] = bflo(vw.y); vd[3] = bfhi(vw.y); vd[4] = bflo(vw.z); vd[5] = bfhi(vw.z); vd[6] = bflo(vw.w); vd[7] = bfhi(vw.w);
            }
            __syncthreads();
#pragma unroll 2
            for (int j = 0; j < 32; ++j) {
                const float* kr = Ks + j * 128 + qt * 32; float acc = 0.f;
#pragma unroll
                for (int d = 0; d < 32; d += 4) { const f32x4 kv = *(const f32x4*)(kr + d); acc += q[d] * kv.x + q[d + 1] * kv.y + q[d + 2] * kv.z + q[d + 3] * kv.w; }
                part[(qt * 32 + j) * 128 + qi] = acc;
            }
            __syncthreads();
            float mx = m;
#pragma unroll 4
            for (int j = 0; j < 32; ++j) { const float sj = (part[(0 * 32 + j) * 128 + qi] + part[(1 * 32 + j) * 128 + qi]) + (part[(2 * 32 + j) * 128 + qi] + part[(3 * 32 + j) * 128 + qi]); mx = fmaxf(mx, sj); }
            const float alpha = __expf(m - mx); m = mx; float ps = 0.f;
#pragma unroll
            for (int d = 0; d < 32; ++d) o[d] *= alpha;
#pragma unroll 2
            for (int j = 0; j < 32; ++j) {
                const float sj = (part[(0 * 32 + j) * 128 + qi] + part[(1 * 32 + j) * 128 + qi]) + (part[(2 * 32 + j) * 128 + qi] + part[(3 * 32 + j) * 128 + qi]);
                const float pj = __expf(sj - mx); ps += pj;
                const float* vr = Vs + j * 128 + qt * 32;
#pragma unroll
                for (int d = 0; d < 32; d += 4) { const f32x4 vv = *(const f32x4*)(vr + d); o[d] += pj * vv.x; o[d + 1] += pj * vv.y; o[d + 2] += pj * vv.z; o[d + 3] += pj * vv.w; }
            }
            l = l * alpha + ps;
            __syncthreads();
        }
        const float rl = 1.f / l;
        bf16_t* op = AO + (size_t)(qrow0 + qi) * 1024 + 512 + h * 128 + qt * 32;
#pragma unroll
        for (int d = 0; d < 32; d += 2) *(unsigned*)(op + d) = pk2(o[d] * rl, o[d + 1] * rl);
    }
}

namespace fa {
typedef short s16x4 __attribute__((ext_vector_type(4)));
constexpr int QBLK = 32, KVBLK = 64, LDQ = 512, LDK = 256, LDO = 1024;
constexpr float SCALE = 0.088388347648318440f, THR = 8.f;
constexpr size_t SHM_V = KVBLK * 128 * 2, SHM_K = KVBLK * 128 * 2, SHM_ATTN = 2 * SHM_V + 2 * SHM_K + NWAVE * 64 * 4;
#define KSWZ(row, colB) ((row) * 256 + ((colB) ^ (((row) & 7) << 4)))
#define SBAR() __builtin_amdgcn_sched_barrier(0)
__device__ __forceinline__ int crow(int r, int hi) { return (r & 3) + 8 * (r >> 2) + 4 * hi; }
__device__ __forceinline__ unsigned cvtpk(float lo, float hi) { unsigned r; asm volatile("v_cvt_pk_bf16_f32 %0, %1, %2" : "=v"(r) : "v"(lo), "v"(hi)); return r; }
__device__ __forceinline__ void partialSM(f32x16& p0, f32x16& p1, float& m_reg, float& mn, float& alpha) {
  constexpr float C = SCALE * 1.4426950408889634f;
  float pmax = p0[0]; for (int r = 1; r < 16; ++r) pmax = fmaxf(pmax, p0[r]); for (int r = 0; r < 16; ++r) pmax = fmaxf(pmax, p1[r]);
  { auto rr = __builtin_amdgcn_permlane32_swap(__float_as_uint(pmax), __float_as_uint(pmax), false, false);
    pmax = fmaxf(__uint_as_float(rr[0]), __uint_as_float(rr[1])); }
  if (__builtin_expect(__all(pmax - m_reg <= THR / SCALE), 1)) { mn = m_reg; alpha = 1.f; }
  else { mn = fmaxf(m_reg, pmax); alpha = __builtin_amdgcn_exp2f((m_reg - mn) * C); m_reg = mn; }
  float mnC = -mn * C;
  for (int r = 0; r < 16; ++r) p0[r] = fmaf(p0[r], C, mnC); for (int r = 0; r < 16; ++r) p1[r] = fmaf(p1[r], C, mnC);
  for (int r = 0; r < 16; ++r) p0[r] = __builtin_amdgcn_exp2f(p0[r]);
}
__device__ __forceinline__ void finishSM(f32x16& p0, f32x16& p1, float alpha, float& l_reg, bf16x8& pa0, bf16x8& pa1, bf16x8& pa2, bf16x8& pa3) {
  for (int r = 0; r < 16; ++r) p1[r] = __builtin_amdgcn_exp2f(p1[r]);
  float ps = 0; for (int r = 0; r < 16; ++r) ps += p0[r]; for (int r = 0; r < 16; ++r) ps += p1[r];
  { auto rr = __builtin_amdgcn_permlane32_swap(__float_as_uint(ps), __float_as_uint(ps), false, false);
    ps = __uint_as_float(rr[0]) + __uint_as_float(rr[1]); }
  l_reg = l_reg * alpha + ps;
#define PK4(P, BASE, OUT) do { unsigned a0 = cvtpk(P[BASE + 0], P[BASE + 1]), a1 = cvtpk(P[BASE + 2], P[BASE + 3]);   \
    unsigned b0 = cvtpk(P[BASE + 4], P[BASE + 5]), b1 = cvtpk(P[BASE + 6], P[BASE + 7]);                              \
    auto r0 = __builtin_amdgcn_permlane32_swap(a0, b0, false, false); auto r1 = __builtin_amdgcn_permlane32_swap(a1, b1, false, false); \
    u32x4 w = {r0[0], r1[0], r0[1], r1[1]}; OUT = *reinterpret_cast<bf16x8*>(&w); } while (0)
  PK4(p0, 0, pa0); PK4(p0, 8, pa1); PK4(p1, 0, pa2); PK4(p1, 8, pa3);
#undef PK4
}
__device__ __forceinline__ void qkt(f32x16& p0, f32x16& p1, const bf16_t* Ks, const bf16x8* qr, int r32, int hi) {
  p0 = f32x16{}; p1 = f32x16{};
  for (int d0 = 0; d0 < 8; ++d0) { int cb = (d0 * 16 + hi * 8) * 2;
    bf16x8 b0 = *reinterpret_cast<const bf16x8*>((const char*)Ks + KSWZ(r32, cb));
    bf16x8 b1 = *reinterpret_cast<const bf16x8*>((const char*)Ks + KSWZ(32 + r32, cb));
    p0 = __builtin_amdgcn_mfma_f32_32x32x16_bf16(b0, qr[d0], p0, 0, 0, 0);
    p1 = __builtin_amdgcn_mfma_f32_32x32x16_bf16(b1, qr[d0], p1, 0, 0, 0); }
}
__device__ __forceinline__ int v_st(int k, int c) { const int kk = (k & ~0xC) | ((k & 4) << 1) | ((k & 8) >> 1); return ((kk >> 3) * 4 + (c >> 5)) * 512 + ((kk & 7) * 32 + (c & 31)) * 2; }
__device__ __forceinline__ int v_rd_base(int lane) { return ((lane & 3) << 3) | (((lane >> 2) & 3) << 6) | (((lane >> 4) & 1) << 5) | (((lane >> 5) & 1) << 8); }
constexpr int v_rd_off(int d0, int ks, int half) { return d0 * 512 + ks * 4096 + half * 2048; }
template <int OFF> __device__ __forceinline__ s16x4 tr_read(int vb) {
  s16x4 r; asm volatile("ds_read_b64_tr_b16 %0, %1 offset:%2" : "=&v"(r) : "v"(vb), "i"(OFF) : "memory"); return r;
}
template <int D0> __device__ __forceinline__ void pv_one(f32x16& od, int vb, bf16x8 pa0, bf16x8 pa1, bf16x8 pa2, bf16x8 pa3) {
  const s16x4 l0 = tr_read<v_rd_off(D0, 0, 0)>(vb), h0 = tr_read<v_rd_off(D0, 0, 1)>(vb), l1 = tr_read<v_rd_off(D0, 1, 0)>(vb), h1 = tr_read<v_rd_off(D0, 1, 1)>(vb);
  const s16x4 l2 = tr_read<v_rd_off(D0, 2, 0)>(vb), h2 = tr_read<v_rd_off(D0, 2, 1)>(vb), l3 = tr_read<v_rd_off(D0, 3, 0)>(vb), h3 = tr_read<v_rd_off(D0, 3, 1)>(vb);
  asm volatile("s_waitcnt lgkmcnt(0)" ::: "memory"); SBAR();
#define PK(L, H) (bf16x8){L[0], L[1], L[2], L[3], H[0], H[1], H[2], H[3]}
  od = __builtin_amdgcn_mfma_f32_32x32x16_bf16(pa0, PK(l0, h0), od, 0, 0, 0);
  od = __builtin_amdgcn_mfma_f32_32x32x16_bf16(pa1, PK(l1, h1), od, 0, 0, 0);
  od = __builtin_amdgcn_mfma_f32_32x32x16_bf16(pa2, PK(l2, h2), od, 0, 0, 0);
  od = __builtin_amdgcn_mfma_f32_32x32x16_bf16(pa3, PK(l3, h3), od, 0, 0, 0);
#undef PK
}
__device__ __forceinline__ void pv_d0(f32x16* o, int vb, bf16x8 pa0, bf16x8 pa1, bf16x8 pa2, bf16x8 pa3) {
  pv_one<0>(o[0], vb, pa0, pa1, pa2, pa3); pv_one<1>(o[1], vb, pa0, pa1, pa2, pa3); pv_one<2>(o[2], vb, pa0, pa1, pa2, pa3); pv_one<3>(o[3], vb, pa0, pa1, pa2, pa3);
}
__device__ __forceinline__ void attn_dense_body(const bf16_t* __restrict__ Qb, const bf16_t* __restrict__ Kh, const bf16_t* __restrict__ Vh,
                                                bf16_t* __restrict__ Ob, int seq, char* lds) {
  const int tid = threadIdx.x, wid = tid >> 6, lane = tid & 63, r32 = lane & 31, hi = lane >> 5;
  bf16_t* V_lds = (bf16_t*)lds; bf16_t* K_lds = (bf16_t*)(lds + 2 * SHM_V);
  float* ws = (float*)(lds + 2 * SHM_V + 2 * SHM_K) + wid * 64; float* li_l = ws; float* al_l = ws + 32;
  float m_reg = -1e30f, l_reg = 0; f32x16 o[4] = {}; bf16x8 qr[8];
  const bf16_t* Qw = Qb + (long)(wid * QBLK + r32) * LDQ + hi * 8;
#pragma unroll
  for (int d0 = 0; d0 < 8; ++d0) qr[d0] = *reinterpret_cast<const bf16x8*>(Qw + d0 * 16);
  const int sr = tid >> 4, sc = (tid & 15) * 8, vst0 = v_st(sr, sc), vst1 = v_st(32 + sr, sc);
  const int vb0 = (int)(uintptr_t)V_lds + v_rd_base(lane);
  struct { bf16x8 vs0, vs1, ks0, ks1; } sr_[2];
#define SLOAD(i, k0) do { sr_[i].vs0 = *reinterpret_cast<const bf16x8*>(&Vh[(long)((k0) + sr) * LDK + sc]); sr_[i].vs1 = *reinterpret_cast<const bf16x8*>(&Vh[(long)((k0) + 32 + sr) * LDK + sc]); \
    sr_[i].ks0 = *reinterpret_cast<const bf16x8*>(&Kh[(long)((k0) + sr) * LDK + sc]); sr_[i].ks1 = *reinterpret_cast<const bf16x8*>(&Kh[(long)((k0) + 32 + sr) * LDK + sc]); } while (0)
#define SWRITE(b, i) do { *(bf16x8*)((char*)V_lds + (b) * SHM_V + vst0) = sr_[i].vs0;          \
    *(bf16x8*)((char*)V_lds + (b) * SHM_V + vst1) = sr_[i].vs1; int kc = sc * 2;               \
    *(bf16x8*)((char*)K_lds + (b) * SHM_K + KSWZ(sr, kc)) = sr_[i].ks0;                       \
    *(bf16x8*)((char*)K_lds + (b) * SHM_K + KSWZ(32 + sr, kc)) = sr_[i].ks1; } while (0)
#define SWAIT() asm volatile("s_waitcnt vmcnt(4)" ::: "memory")
#define RESC(a) do { if (__any((a) < 1.f)) { if (hi == 0) al_l[r32] = (a); asm volatile("s_waitcnt lgkmcnt(0)" ::: "memory"); \
    for (int d = 0; d < 4; ++d) for (int r = 0; r < 16; ++r) o[d][r] *= al_l[crow(r, hi)]; } } while (0)
  f32x16 pA0, pA1, pB0, pB1; float mnA, mnB, alA, alB; bf16x8 pa0, pa1, pa2, pa3; const int NT = seq / KVBLK;
  constexpr int SE = 0, SO = 1;
  SLOAD(SE, 0); asm volatile("s_waitcnt vmcnt(0)" ::: "memory"); SWRITE(0, SE); __syncthreads();
  qkt(pA0, pA1, K_lds, qr, r32, hi); partialSM(pA0, pA1, m_reg, mnA, alA);
  SLOAD(SO, KVBLK); if (2 < NT) SLOAD(SE, 2 * KVBLK);
  SWAIT(); SWRITE(1, SO); __syncthreads();
  for (int j = 1; j + 1 < NT; j += 2) {
    SBAR(); qkt(pB0, pB1, (bf16_t*)((char*)K_lds + SHM_K), qr, r32, hi);
    finishSM(pA0, pA1, alA, l_reg, pa0, pa1, pa2, pa3); SBAR();
    SLOAD(SO, (j + 2) * KVBLK); SBAR();
    pv_d0(o, vb0, pa0, pa1, pa2, pa3); partialSM(pB0, pB1, m_reg, mnB, alB);
    __syncthreads(); SWAIT(); SWRITE(0, SE);
    RESC(alB); __syncthreads();
    SBAR(); qkt(pA0, pA1, K_lds, qr, r32, hi);
    finishSM(pB0, pB1, alB, l_reg, pa0, pa1, pa2, pa3); SBAR();
    if (j + 3 < NT) SLOAD(SE, (j + 3) * KVBLK); SBAR();
    pv_d0(o, vb0 + (int)SHM_V, pa0, pa1, pa2, pa3); partialSM(pA0, pA1, m_reg, mnA, alA);
    __syncthreads(); SWAIT(); SWRITE(1, SO);
    RESC(alA); __syncthreads();
  }
  SBAR(); qkt(pB0, pB1, (bf16_t*)((char*)K_lds + SHM_K), qr, r32, hi);
  finishSM(pA0, pA1, alA, l_reg, pa0, pa1, pa2, pa3); SBAR();
  pv_d0(o, vb0, pa0, pa1, pa2, pa3); partialSM(pB0, pB1, m_reg, mnB, alB);
  __syncthreads(); RESC(alB);
  finishSM(pB0, pB1, alB, l_reg, pa0, pa1, pa2, pa3); SBAR();
  pv_d0(o, vb0 + (int)SHM_V, pa0, pa1, pa2, pa3);
  if (hi == 0) li_l[r32] = l_reg; asm volatile("s_waitcnt lgkmcnt(0)" ::: "memory");
  float rli[16];
#pragma unroll
  for (int r = 0; r < 16; ++r) rli[r] = __builtin_amdgcn_rcpf(li_l[crow(r, hi)]);
  bf16_t* Ow = Ob + (long)(wid * QBLK) * LDO;
#pragma unroll
  for (int r = 0; r < 16; ++r) { int orow = crow(r, hi);
    for (int d0 = 0; d0 < 4; ++d0) Ow[(long)orow * LDO + d0 * 32 + r32] = (bf16_t)f2bf(o[d0][r] * rli[r]); }
  __syncthreads();
#undef SLOAD
#undef SWRITE
#undef SWAIT
#undef RESC
}
#undef KSWZ
#undef SBAR
}

__device__ __forceinline__ void phase_attn(const Args& a, char* lds) {
    unsigned char* ws = a.ws;
    const bf16_t* Q = (const bf16_t*)(ws + WS_Q); const bf16_t* Kb = (const bf16_t*)(ws + WS_K); const bf16_t* Vb = (const bf16_t*)(ws + WS_V);
    bf16_t* AO = (bf16_t*)(ws + WS_AO);
    const int NU = 256 + 8;
    for (int u = blockIdx.x; u < NU; u += gridDim.x) {
        int b, h, qrow0, nkeys;
        if (u < 256) { const int x = u & 7; b = x >> 2; h = x & 3; qrow0 = b * RPB + CTXL + (u >> 3) * 256; nkeys = RPB; }
        else { const int v = u - 256; b = v / 4; h = v % 4; qrow0 = b * RPB; nkeys = CTXL; }
        const int kvh = h >> 1; const size_t krow0 = (size_t)b * RPB;
        fa::attn_dense_body(Q + (size_t)qrow0 * 512 + h * 128, Kb + krow0 * 256 + kvh * 128, Vb + krow0 * 256 + kvh * 128, AO + (size_t)qrow0 * 1024 + 512 + h * 128, nkeys, lds);
    }
}

__device__ __forceinline__ void phase_outproj(const Args& a, char* lds, const bf16_t* A, int K, const bf16_t* Bt, int layer, int which_gate, int base_mode, bool latent_only) {
    float* Cs = (float*)lds;
    const int tid = threadIdx.x;
    float* X1 = (float*)(a.ws + WS_X1);
    const int NU = (MTOT / 128) * 8;
    for (int u = blockIdx.x; u < NU; u += gridDim.x) {
        const int rt = u / 8, ct = u % 8, row0 = rt * 128, col0 = ct * 128;
        if (latent_only && (rt % 66) < 2) continue;
        gemm_tile128(A + (size_t)row0 * K, K, Bt + (size_t)col0 * K, K, K, Cs);
        __syncthreads();
        const int rr = tid >> 2, q4 = tid & 3, g = row0 + rr;
        const float* crow = Cs + rr * CS_LD + q4 * 32;
        const float* gt = modv(a, layer, row_variant(g), which_gate) + col0 + q4 * 32;
        const float* base = (base_mode == 0 ? row_src(a, g) : X1 + (size_t)g * D) + col0 + q4 * 32;
        float* o = X1 + (size_t)g * D + col0 + q4 * 32;
#pragma unroll
        for (int c = 0; c < 32; c += 4) {
            const f32x4 bs = *(const f32x4*)(base + c), gv = *(const f32x4*)(gt + c);
            f32x4 r; r.x = bs.x + gv.x * crow[c]; r.y = bs.y + gv.y * crow[c + 1]; r.z = bs.z + gv.z * crow[c + 2]; r.w = bs.w + gv.w * crow[c + 3];
            *(f32x4*)(o + c) = r;
        }
        __syncthreads();
    }
}

__device__ __forceinline__ void phase_peerq(const Args& a, char* lds, int layer, bool latent_only) {
    float* Cs = (float*)lds;
    const int tid = threadIdx.x;
    const bf16_t* H = (const bf16_t*)(a.ws + WS_H); const bf16_t* W = (const bf16_t*)(a.ws + WS_WQ) + (size_t)layer * 2048 * 1024;
    bf16_t* QP = (bf16_t*)(a.ws + WS_QP);
    const int NU = (MTOT / 128) * 16;
    for (int u = blockIdx.x; u < NU; u += gridDim.x) {
        const int rt = u / 16, ct = u % 16, row0 = rt * 128, col0 = ct * 128;
        if (latent_only && (rt % 66) < 2) continue;
        gemm_tile128(H + (size_t)row0 * D, D, W + (size_t)col0 * D, D, D, Cs);
        __syncthreads();
        const int rr = tid >> 2, q4 = tid & 3, g = row0 + rr;
        const float* crow = Cs + rr * CS_LD + q4 * 32;
        bf16_t* o = QP + (size_t)g * 2048 + col0 + q4 * 32;
#pragma unroll
        for (int c = 0; c < 32; c += 2) *(unsigned*)(o + c) = pk2(crow[c], crow[c + 1]);
        __syncthreads();
    }
}

__device__ __forceinline__ void wave_argmax(float& v, int& i) {
#pragma unroll
    for (int o = 1; o < 64; o <<= 1) {
        const float ov = __shfl_xor(v, o); const int oi = __shfl_xor(i, o);
        if (ov > v || (ov == v && oi < i)) { v = ov; i = oi; }
    }
}
__device__ __forceinline__ void phase_peer_topk(const Args& a, int layer, bool latent_only) {
    const int lane = threadIdx.x & 63, gw = blockIdx.x * NWAVE + (threadIdx.x >> 6), ngw = gridDim.x * NWAVE;
    const bf16_t* QP = (const bf16_t*)(a.ws + WS_QP);
    const bf16_t* KEYS = (const bf16_t*)(a.ws + WS_KEYS) + (size_t)layer * 8 * 2 * 128 * 128;
    int* SELI = (int*)(a.ws + WS_SELI); float* SELG = (float*)(a.ws + WS_SELG);
    for (int it = gw; it < MTOT * 8; it += ngw) {
        const int g = it >> 3, h = it & 7;
        if (latent_only && row_variant(g) == 2) continue;
        float tv[2]; int ti[2];
#pragma unroll
        for (int s = 0; s < 2; ++s) {
            const bf16_t* qp = QP + (size_t)g * 2048 + h * 256 + s * 128;
            const bf16_t* k0p = KEYS + ((size_t)(h * 2 + s) * 128 + lane) * 128;
            const bf16_t* k1p = k0p + 64 * 128;
            float s0 = 0.f, s1 = 0.f;
#pragma unroll 4
            for (int d = 0; d < 128; d += 8) {
                const u32x4 qw = *(const u32x4*)(qp + d), ka = *(const u32x4*)(k0p + d), kb = *(const u32x4*)(k1p + d);
                s0 += bflo(qw.x) * bflo(ka.x) + bfhi(qw.x) * bfhi(ka.x) + bflo(qw.y) * bflo(ka.y) + bfhi(qw.y) * bfhi(ka.y)
                    + bflo(qw.z) * bflo(ka.z) + bfhi(qw.z) * bfhi(ka.z) + bflo(qw.w) * bflo(ka.w) + bfhi(qw.w) * bfhi(ka.w);
                s1 += bflo(qw.x) * bflo(kb.x) + bfhi(qw.x) * bfhi(kb.x) + bflo(qw.y) * bflo(kb.y) + bfhi(qw.y) * bfhi(kb.y)
                    + bflo(qw.z) * bflo(kb.z) + bfhi(qw.z) * bfhi(kb.z) + bflo(qw.w) * bflo(kb.w) + bfhi(qw.w) * bfhi(kb.w);
            }
            float myv = 0.f; int myi = 0;
            for (int r = 0; r < 16; ++r) {
                float bv; int bi;
                if (s0 >= s1) { bv = s0; bi = lane; } else { bv = s1; bi = lane + 64; }
                wave_argmax(bv, bi);
                if (bi == lane) s0 = -INFINITY; else if (bi == lane + 64) s1 = -INFINITY;
                if (lane == r) { myv = bv; myi = bi; }
            }
            tv[s] = myv; ti[s] = myi;
        }
        float cv[4]; int ci[4];
        {
            const float v0 = __shfl(tv[0], lane >> 2); const int i0 = __shfl(ti[0], lane >> 2);
#pragma unroll
            for (int m = 0; m < 4; ++m) { const int j = (lane & 3) * 4 + m; cv[m] = v0 + __shfl(tv[1], j); ci[m] = i0 * 128 + __shfl(ti[1], j); }
        }
        float topv = 0.f; int tope = 0;
        for (int r = 0; r < 16; ++r) {
            float bv = cv[0]; int bp = lane * 4;
#pragma unroll
            for (int m = 1; m < 4; ++m) if (cv[m] > bv) { bv = cv[m]; bp = lane * 4 + m; }
            wave_argmax(bv, bp);
            int be = 0;
#pragma unroll
            for (int m = 0; m < 4; ++m) if (bp == lane * 4 + m) { be = ci[m]; cv[m] = -INFINITY; }
            be = __shfl(be, bp >> 2);
            if (lane == r) { topv = bv; tope = be; }
        }
        const float mx = __shfl(topv, 0);
        float e = lane < 16 ? __expf(topv - mx) : 0.f;
        float sum = e;
#pragma unroll
        for (int o = 1; o < 16; o <<= 1) sum += __shfl_xor(sum, o);
        if (lane < 16) { SELI[(size_t)g * 128 + h * 16 + lane] = tope; SELG[(size_t)g * 128 + h * 16 + lane] = e / sum; }
    }
}

constexpr int TK_LD = 136;
__device__ __forceinline__ int peer_tok(int i, int mode);
namespace tk {
__device__ __forceinline__ void ce(float& a, float& b) { const float mx = __builtin_fmaxf(a, b), mn = __builtin_fminf(a, b); a = mx; b = mn; }
__device__ __forceinline__ void sort16_desc(float (&v)[16]) {
#pragma unroll
    for (int ks = 1; ks <= 4; ++ks)
#pragma unroll
        for (int js = ks - 1; js >= 0; --js)
#pragma unroll
            for (int i = 0; i < 16; ++i) { const int k = 1 << ks, j = 1 << js, l = i ^ j; if (l > i) { if ((i & k) == 0) ce(v[i], v[l]); else ce(v[l], v[i]); } }
}
__device__ __forceinline__ void merge16_desc(float (&v)[16]) {
#pragma unroll
    for (int js = 3; js >= 0; --js)
#pragma unroll
        for (int i = 0; i < 16; ++i) { const int j = 1 << js, l = i ^ j; if (l > i) ce(v[i], v[l]); }
}
__device__ __forceinline__ void merge_prune(float (&x)[16], const float (&y)[16]) {
#pragma unroll
    for (int i = 0; i < 16; ++i) x[i] = __builtin_fmaxf(x[i], y[15 - i]);
    merge16_desc(x);
}
__host__ __device__ constexpr bool pair_ok(int i, int j) { return (i + 1) * (j + 1) <= 16; }
__host__ __device__ constexpr int pair_index(int i, int j) { int n = 0; for (int a = 0; a < 16; ++a) for (int b = 0; b < 16; ++b) { if (a == i && b == j) return n; if (pair_ok(a, b)) ++n; } return n; }
static_assert(pair_index(15, 15) == 49 + 0 || true, "");
}
__device__ __forceinline__ void topk_stage2(const float (&top)[2][16], int* SELI, float* SELG, int g0, int h, int r32, int hh) {
    float X[16], Y[16];
    X[0] = __uint_as_float((__float_as_uint((hh ? top[0][3] : top[0][0]) + (hh ? top[1][3] : top[1][0])) & ~255u) | (hh ? 51u : 0u));
    Y[0] = __uint_as_float((__float_as_uint((hh ? top[0][14] : top[0][1]) + (hh ? top[1][0] : top[1][0])) & ~255u) | (hh ? 224u : 16u));
    X[1] = __uint_as_float((__float_as_uint((hh ? top[0][4] : top[0][0]) + (hh ? top[1][0] : top[1][1])) & ~255u) | (hh ? 64u : 1u));
    Y[1] = __uint_as_float((__float_as_uint((hh ? top[0][15] : top[0][1]) + (hh ? top[1][0] : top[1][1])) & ~255u) | (hh ? 240u : 17u));
    X[2] = __uint_as_float((__float_as_uint((hh ? top[0][4] : top[0][0]) + (hh ? top[1][1] : top[1][2])) & ~255u) | (hh ? 65u : 2u));
    Y[2] = (hh ? -INFINITY : __uint_as_float((__float_as_uint(top[0][1] + top[1][2]) & ~255u) | 18u));
    X[3] = __uint_as_float((__float_as_uint((hh ? top[0][4] : top[0][0]) + (hh ? top[1][2] : top[1][3])) & ~255u) | (hh ? 66u : 3u));
    Y[3] = (hh ? -INFINITY : __uint_as_float((__float_as_uint(top[0][1] + top[1][3]) & ~255u) | 19u));
    X[4] = __uint_as_float((__float_as_uint((hh ? top[0][5] : top[0][0]) + (hh ? top[1][0] : top[1][4])) & ~255u) | (hh ? 80u : 4u));
    Y[4] = (hh ? -INFINITY : __uint_as_float((__float_as_uint(top[0][1] + top[1][4]) & ~255u) | 20u));
    X[5] = __uint_as_float((__float_as_uint((hh ? top[0][5] : top[0][0]) + (hh ? top[1][1] : top[1][5])) & ~255u) | (hh ? 81u : 5u));
    Y[5] = (hh ? -INFINITY : __uint_as_float((__float_as_uint(top[0][1] + top[1][5]) & ~255u) | 21u));
    X[6] = __uint_as_float((__float_as_uint((hh ? top[0][6] : top[0][0]) + (hh ? top[1][0] : top[1][6])) & ~255u) | (hh ? 96u : 6u));
    Y[6] = (hh ? -INFINITY : __uint_as_float((__float_as_uint(top[0][1] + top[1][6]) & ~255u) | 22u));
    X[7] = __uint_as_float((__float_as_uint((hh ? top[0][6] : top[0][0]) + (hh ? top[1][1] : top[1][7])) & ~255u) | (hh ? 97u : 7u));
    Y[7] = (hh ? -INFINITY : __uint_as_float((__float_as_uint(top[0][1] + top[1][7]) & ~255u) | 23u));
    X[8] = __uint_as_float((__float_as_uint((hh ? top[0][7] : top[0][0]) + (hh ? top[1][0] : top[1][8])) & ~255u) | (hh ? 112u : 8u));
    Y[8] = (hh ? -INFINITY : __uint_as_float((__float_as_uint(top[0][2] + top[1][0]) & ~255u) | 32u));
    X[9] = __uint_as_float((__float_as_uint((hh ? top[0][7] : top[0][0]) + (hh ? top[1][1] : top[1][9])) & ~255u) | (hh ? 113u : 9u));
    Y[9] = (hh ? -INFINITY : __uint_as_float((__float_as_uint(top[0][2] + top[1][1]) & ~255u) | 33u));
    X[10] = __uint_as_float((__float_as_uint((hh ? top[0][8] : top[0][0]) + (hh ? top[1][0] : top[1][10])) & ~255u) | (hh ? 128u : 10u));
    Y[10] = (hh ? -INFINITY : __uint_as_float((__float_as_uint(top[0][2] + top[1][2]) & ~255u) | 34u));
    X[11] = __uint_as_float((__float_as_uint((hh ? top[0][9] : top[0][0]) + (hh ? top[1][0] : top[1][11])) & ~255u) | (hh ? 144u : 11u));
    Y[11] = (hh ? -INFINITY : __uint_as_float((__float_as_uint(top[0][2] + top[1][3]) & ~255u) | 35u));
    X[12] = __uint_as_float((__float_as_uint((hh ? top[0][10] : top[0][0]) + (hh ? top[1][0] : top[1][12])) & ~255u) | (hh ? 160u : 12u));
    Y[12] = (hh ? -INFINITY : __uint_as_float((__float_as_uint(top[0][2] + top[1][4]) & ~255u) | 36u));
    X[13] = __uint_as_float((__float_as_uint((hh ? top[0][11] : top[0][0]) + (hh ? top[1][0] : top[1][13])) & ~255u) | (hh ? 176u : 13u));
    Y[13] = (hh ? -INFINITY : __uint_as_float((__float_as_uint(top[0][3] + top[1][0]) & ~255u) | 48u));
    X[14] = __uint_as_float((__float_as_uint((hh ? top[0][12] : top[0][0]) + (hh ? top[1][0] : top[1][14])) & ~255u) | (hh ? 192u : 14u));
    Y[14] = (hh ? -INFINITY : __uint_as_float((__float_as_uint(top[0][3] + top[1][1]) & ~255u) | 49u));
    X[15] = __uint_as_float((__float_as_uint((hh ? top[0][13] : top[0][0]) + (hh ? top[1][0] : top[1][15])) & ~255u) | (hh ? 208u : 15u));
    Y[15] = (hh ? -INFINITY : __uint_as_float((__float_as_uint(top[0][3] + top[1][2]) & ~255u) | 50u));
    tk::sort16_desc(X); __builtin_amdgcn_sched_barrier(0); tk::sort16_desc(Y); __builtin_amdgcn_sched_barrier(0);
    tk::merge_prune(X, Y); __builtin_amdgcn_sched_barrier(0);
#pragma unroll
    for (int r = 0; r < 16; ++r) { const auto rr = __builtin_amdgcn_permlane32_swap(__float_as_uint(X[r]), __float_as_uint(X[r]), false, false); Y[r] = __uint_as_float(hh == 0 ? rr[1] : rr[0]); }
    tk::merge_prune(X, Y); __builtin_amdgcn_sched_barrier(0);
    const float vmax = X[0];
    int eidx[8]; float ev[8]; float sum = 0.f;
#pragma unroll
    for (int rr = 0; rr < 8; ++rr) {
        const float v = hh ? X[8 + rr] : X[rr];
        const unsigned bits = __float_as_uint(v); const int ci = (bits >> 4) & 15, cj = bits & 15;
        int ia = 0, ib = 0;
#pragma unroll
        for (int i = 0; i < 16; ++i) { ia = (ci == i) ? (int)(__float_as_uint(top[0][i]) & 127u) : ia; ib = (cj == i) ? (int)(__float_as_uint(top[1][i]) & 127u) : ib; }
        eidx[rr] = ia * 128 + ib;
        ev[rr] = __expf(v - vmax); sum += ev[rr];
    }
    { const auto rr = __builtin_amdgcn_permlane32_swap(__float_as_uint(sum), __float_as_uint(sum), false, false); sum = __uint_as_float(rr[0]) + __uint_as_float(rr[1]); }
    const float rs = __builtin_amdgcn_rcpf(sum);
    int* oi = SELI + (size_t)(g0 + r32) * 128 + h * 16 + hh * 8; float* og = SELG + (size_t)(g0 + r32) * 128 + h * 16 + hh * 8;
#pragma unroll
    for (int rr = 0; rr < 8; ++rr) { oi[rr] = eidx[rr]; og[rr] = ev[rr] * rs; }
}
__device__ __forceinline__ void topk_item(const bf16_t* QP, const bf16_t* KEYS, int* SELI, float* SELG, int g0, int h, int r32, int hh) {
    float top[2][16];
#pragma unroll
    for (int s = 0; s < 2; ++s) {
        bf16x8 qf[8];
        unsigned qoff = (unsigned)(r32 * 2048 + 8 * hh), koff = (unsigned)(r32 * 128 + 8 * hh); asm volatile("" : "+v"(qoff), "+v"(koff));
        const bf16_t* qb = QP + (size_t)g0 * 2048 + h * 256 + s * 128;
#pragma unroll
        for (int k = 0; k < 8; ++k) qf[k] = *(const bf16x8*)(qb + qoff + k * 16);
        float grp[4][16];
#pragma unroll
        for (int kb = 0; kb < 4; ++kb) {
            const bf16_t* kbp = KEYS + (size_t)(h * 2 + s) * 128 * 128 + kb * 32 * 128;
            f32x16 acc = {};
#pragma unroll
            for (int k = 0; k < 8; ++k) { const bf16x8 kf = *(const bf16x8*)(kbp + koff + k * 16); acc = __builtin_amdgcn_mfma_f32_32x32x16_bf16(kf, qf[k], acc, 0, 0, 0); }
#pragma unroll
            for (int r = 0; r < 16; ++r) { const int key = kb * 32 + (r & 3) + 8 * (r >> 2) + 4 * hh; grp[kb][r] = __uint_as_float((__float_as_uint(acc[r]) & ~127u) | (unsigned)key); }
            tk::sort16_desc(grp[kb]); __builtin_amdgcn_sched_barrier(0);
        }
        tk::merge_prune(grp[0], grp[1]); __builtin_amdgcn_sched_barrier(0); tk::merge_prune(grp[2], grp[3]); __builtin_amdgcn_sched_barrier(0); tk::merge_prune(grp[0], grp[2]); __builtin_amdgcn_sched_barrier(0);
        float oth[16];
#pragma unroll
        for (int r = 0; r < 16; ++r) { const auto rr = __builtin_amdgcn_permlane32_swap(__float_as_uint(grp[0][r]), __float_as_uint(grp[0][r]), false, false); oth[r] = __uint_as_float(hh == 0 ? rr[1] : rr[0]); }
        tk::merge_prune(grp[0], oth);
#pragma unroll
        for (int r = 0; r < 16; ++r) top[s][r] = grp[0][r];
        __builtin_amdgcn_sched_barrier(0);
    }
    topk_stage2(top, SELI, SELG, g0, h, r32, hh);
}
__device__ __forceinline__ void topk_item_lds(const bf16_t* QP, LAS const bf16_t* KL, int* SELI, float* SELG, int g0, int h, int r32, int hh) {
    float top[2][16];
#pragma unroll
    for (int s = 0; s < 2; ++s) {
        bf16x8 qf[8];
        unsigned qoff = (unsigned)(r32 * 2048 + 8 * hh), koff = (unsigned)(r32 * 128 + 8 * hh); asm volatile("" : "+v"(qoff), "+v"(koff));
        const bf16_t* qb = QP + (size_t)g0 * 2048 + h * 256 + s * 128;
#pragma unroll
        for (int k = 0; k < 8; ++k) qf[k] = *(const bf16x8*)(qb + qoff + k * 16);
        float grp[4][16];
#pragma unroll
        for (int kb = 0; kb < 4; ++kb) {
            LAS const bf16_t* kbp = KL + (s * 128 + kb * 32 + r32) * TK_LD + 8 * hh;
            f32x16 acc = {};
#pragma unroll
            for (int k = 0; k < 8; ++k) { const bf16x8 kf = *(LAS const bf16x8*)(kbp + k * 16); acc = __builtin_amdgcn_mfma_f32_32x32x16_bf16(kf, qf[k], acc, 0, 0, 0); }
#pragma unroll
            for (int r = 0; r < 16; ++r) { const int key = kb * 32 + (r & 3) + 8 * (r >> 2) + 4 * hh; grp[kb][r] = __uint_as_float((__float_as_uint(acc[r]) & ~127u) | (unsigned)key); }
            tk::sort16_desc(grp[kb]); __builtin_amdgcn_sched_barrier(0);
        }
        tk::merge_prune(grp[0], grp[1]); __builtin_amdgcn_sched_barrier(0); tk::merge_prune(grp[2], grp[3]); __builtin_amdgcn_sched_barrier(0); tk::merge_prune(grp[0], grp[2]); __builtin_amdgcn_sched_barrier(0);
        float oth[16];
#pragma unroll
        for (int r = 0; r < 16; ++r) { const auto rr = __builtin_amdgcn_permlane32_swap(__float_as_uint(grp[0][r]), __float_as_uint(grp[0][r]), false, false); oth[r] = __uint_as_float(hh == 0 ? rr[1] : rr[0]); }
        tk::merge_prune(grp[0], oth);
#pragma unroll
        for (int r = 0; r < 16; ++r) top[s][r] = grp[0][r];
        __builtin_amdgcn_sched_barrier(0);
    }
    topk_stage2(top, SELI, SELG, g0, h, r32, hh);
}

__device__ __forceinline__ void phase_peer_topk3(const Args& a, char* lds, int layer, bool latent_only) {
    const int tid = threadIdx.x, lane = tid & 63, r32 = lane & 31, hh = lane >> 5, wid = __builtin_amdgcn_readfirstlane(tid >> 6);
    const int h = blockIdx.x & 7, stripe = blockIdx.x >> 3, nstr = (gridDim.x >> 3) * NWAVE;
    const bf16_t* QP = (const bf16_t*)(a.ws + WS_QP);
    const bf16_t* KEYS = (const bf16_t*)(a.ws + WS_KEYS) + (size_t)layer * 8 * 2 * 128 * 128 + (size_t)h * 2 * 128 * 128;
    int* SELI = (int*)(a.ws + WS_SELI); float* SELG = (float*)(a.ws + WS_SELG);
    LAS bf16_t* KL = (LAS bf16_t*)((LAS char*)lds);
    for (int i = tid; i < 2 * 128 * 16; i += NTHR) { const int row = i >> 4, c8 = (i & 15) * 8; *(LAS u32x4*)(KL + row * TK_LD + c8) = *(const u32x4*)(KEYS + (size_t)row * 128 + c8); }
    __syncthreads();
    const int ngrp = latent_only ? (NB * SEQ) / 32 : MTOT / 32;
    for (int i = stripe * NWAVE + wid; i < ngrp; i += nstr) {
        const int g0 = latent_only ? peer_tok(i * 32, 1) : i * 32;
        topk_item_lds(QP, KL, SELI, SELG, g0, h, r32, hh);
    }
}
__device__ __forceinline__ void phase_peer_topk2(const Args& a, int layer, bool latent_only) {
    const int lane = threadIdx.x & 63, r32 = lane & 31, hh = lane >> 5, gw = blockIdx.x * NWAVE + __builtin_amdgcn_readfirstlane(threadIdx.x >> 6), ngw = gridDim.x * NWAVE;
    const bf16_t* QP = (const bf16_t*)(a.ws + WS_QP);
    const bf16_t* KEYS = (const bf16_t*)(a.ws + WS_KEYS) + (size_t)layer * 8 * 2 * 128 * 128;
    int* SELI = (int*)(a.ws + WS_SELI); float* SELG = (float*)(a.ws + WS_SELG);
    const int NIT = (MTOT / 32) * 8;
    for (int it = gw; it < NIT; it += ngw) {
        const int tg = it >> 3, h = it & 7, g0 = tg * 32;
        if (latent_only && row_variant(g0) == 2) continue;
        topk_item(QP, KEYS, SELI, SELG, g0, h, r32, hh);
    }
}

__device__ __forceinline__ void phase_peer_gather(const Args& a, int layer, int mode) {
    const int lane = threadIdx.x & 63, gw = blockIdx.x * NWAVE + (threadIdx.x >> 6), ngw = gridDim.x * NWAVE;
    unsigned char* ws = a.ws;
    bf16_t* H = (bf16_t*)(ws + WS_H); float* X1 = (float*)(ws + WS_X1);
    const bf16_t* PU = (const bf16_t*)(ws + WS_PU) + (size_t)layer * NEXP * D; const bf16_t* PV = (const bf16_t*)(ws + WS_PV) + (size_t)layer * NEXP * D;
    const int* SELI = (const int*)(ws + WS_SELI); const float* SELG = (const float*)(ws + WS_SELG);
    for (int g = gw; g < MTOT; g += ngw) {
        const int var = row_variant(g);
        if (mode == 1 && var == 2) continue;
        float hp[16], acc[16];
        {
            const u32x4 w0 = *(const u32x4*)(H + (size_t)g * D + lane * 16), w1 = *(const u32x4*)(H + (size_t)g * D + lane * 16 + 8);
            hp[0] = bflo(w0.x); hp[1] = bfhi(w0.x); hp[2] = bflo(w0.y); hp[3] = bfhi(w0.y); hp[4] = bflo(w0.z); hp[5] = bfhi(w0.z); hp[6] = bflo(w0.w); hp[7] = bfhi(w0.w);
            hp[8] = bflo(w1.x); hp[9] = bfhi(w1.x); hp[10] = bflo(w1.y); hp[11] = bfhi(w1.y); hp[12] = bflo(w1.z); hp[13] = bfhi(w1.z); hp[14] = bflo(w1.w); hp[15] = bfhi(w1.w);
#pragma unroll
            for (int d = 0; d < 16; ++d) acc[d] = 0.f;
        }
        const int myi0 = SELI[(size_t)g * 128 + lane], myi1 = SELI[(size_t)g * 128 + 64 + lane];
        const float myg0 = SELG[(size_t)g * 128 + lane], myg1 = SELG[(size_t)g * 128 + 64 + lane];
        for (int e = 0; e < 128; ++e) {
            const int ei = e < 64 ? __shfl(myi0, e) : __shfl(myi1, e - 64);
            const float eg = e < 64 ? __shfl(myg0, e) : __shfl(myg1, e - 64);
            const bf16_t* up = PU + (size_t)ei * D + lane * 16; const bf16_t* vp = PV + (size_t)ei * D + lane * 16;
            const u32x4 u0 = *(const u32x4*)up, u1 = *(const u32x4*)(up + 8), v0 = *(const u32x4*)vp, v1 = *(const u32x4*)(vp + 8);
            float dt = hp[0] * bflo(u0.x) + hp[1] * bfhi(u0.x) + hp[2] * bflo(u0.y) + hp[3] * bfhi(u0.y) + hp[4] * bflo(u0.z) + hp[5] * bfhi(u0.z) + hp[6] * bflo(u0.w) + hp[7] * bfhi(u0.w)
                     + hp[8] * bflo(u1.x) + hp[9] * bfhi(u1.x) + hp[10] * bflo(u1.y) + hp[11] * bfhi(u1.y) + hp[12] * bflo(u1.z) + hp[13] * bfhi(u1.z) + hp[14] * bflo(u1.w) + hp[15] * bfhi(u1.w);
            dt = wave_sum(dt);
            const float act = gelu_t(dt) * eg;
            acc[0] += act * bflo(v0.x); acc[1] += act * bfhi(v0.x); acc[2] += act * bflo(v0.y); acc[3] += act * bfhi(v0.y);
            acc[4] += act * bflo(v0.z); acc[5] += act * bfhi(v0.z); acc[6] += act * bflo(v0.w); acc[7] += act * bfhi(v0.w);
            acc[8] += act * bflo(v1.x); acc[9] += act * bfhi(v1.x); acc[10] += act * bflo(v1.y); acc[11] += act * bfhi(v1.y);
            acc[12] += act * bflo(v1.z); acc[13] += act * bfhi(v1.z); acc[14] += act * bflo(v1.w); acc[15] += act * bfhi(v1.w);
        }
        float* xr = X1 + (size_t)g * D + lane * 16;
        const float* g2 = modv(a, layer, var, 5) + lane * 16;
        float xn[16]; float ss = 0.f;
#pragma unroll
        for (int d = 0; d < 16; d += 4) {
            const f32x4 xv = *(const f32x4*)(xr + d), gv = *(const f32x4*)(g2 + d);
            xn[d] = xv.x + gv.x * acc[d]; xn[d + 1] = xv.y + gv.y * acc[d + 1]; xn[d + 2] = xv.z + gv.z * acc[d + 2]; xn[d + 3] = xv.w + gv.w * acc[d + 3];
            ss += xn[d] * xn[d] + xn[d + 1] * xn[d + 1] + xn[d + 2] * xn[d + 2] + xn[d + 3] * xn[d + 3];
        }
        const float rinv = rsqrtf(wave_sum(ss) * (1.f / D) + EPS);
        if (mode == 0) {
#pragma unroll
            for (int d = 0; d < 16; d += 4) { f32x4 o; o.x = xn[d]; o.y = xn[d + 1]; o.z = xn[d + 2]; o.w = xn[d + 3]; *(f32x4*)(xr + d) = o; }
            const float* gn = a.in[6] + D + lane * 16; const float* sh = modv(a, 1, var, 0) + lane * 16; const float* sc = modv(a, 1, var, 1) + lane * 16;
            unsigned w[8];
#pragma unroll
            for (int d = 0; d < 16; d += 2) w[d >> 1] = pk2(xn[d] * rinv * gn[d] * (1.f + sc[d]) + sh[d], xn[d + 1] * rinv * gn[d + 1] * (1.f + sc[d + 1]) + sh[d + 1]);
            u32x4 o0, o1; o0.x = w[0]; o0.y = w[1]; o0.z = w[2]; o0.w = w[3]; o1.x = w[4]; o1.y = w[5]; o1.z = w[6]; o1.w = w[7];
            *(u32x4*)(H + (size_t)g * D + lane * 16) = o0; *(u32x4*)(H + (size_t)g * D + lane * 16 + 8) = o1;
        } else {
            const int b = g / RPB, t = g - b * RPB - CTXL;
            float* op = a.out + ((size_t)b * SEQ + t) * D + lane * 16; const float* gn = a.in[28] + lane * 16;
#pragma unroll
            for (int d = 0; d < 16; d += 4) { f32x4 o; o.x = xn[d] * rinv * gn[d]; o.y = xn[d + 1] * rinv * gn[d + 1]; o.z = xn[d + 2] * rinv * gn[d + 2]; o.w = xn[d + 3] * rinv * gn[d + 3]; *(f32x4*)(op + d) = o; }
        }
    }
}

typedef __bf16 bf16x2_t __attribute__((ext_vector_type(2)));
__device__ __forceinline__ float dot2bf(unsigned w, unsigned x, float acc) { return __builtin_amdgcn_fdot2_f32_bf16(__builtin_bit_cast(bf16x2_t, w), __builtin_bit_cast(bf16x2_t, x), acc, false); }
struct Row8 { u32x4 c[8]; };
__device__ __forceinline__ void load_row8(Row8& r, const bf16_t* p) {
#pragma unroll
    for (int c = 0; c < 8; ++c) r.c[c] = *(const u32x4*)(p + c * 128);
}
__device__ __forceinline__ float dot_row8(const Row8& r, const u32x4 (&hp)[8]) {
    float a0 = 0.f, a1 = 0.f, a2 = 0.f, a3 = 0.f;
#pragma unroll
    for (int c = 0; c < 8; ++c) { a0 = dot2bf(r.c[c].x, hp[c].x, a0); a1 = dot2bf(r.c[c].y, hp[c].y, a1); a2 = dot2bf(r.c[c].z, hp[c].z, a2); a3 = dot2bf(r.c[c].w, hp[c].w, a3); }
    float s = (a0 + a1) + (a2 + a3);
    s += __shfl_xor(s, 1); s += __shfl_xor(s, 2); s += __shfl_xor(s, 4); s += __shfl_xor(s, 8);
    return s;
}
__device__ __forceinline__ void fma_row(float (&acc)[16], const u32x4& v0, const u32x4& v1, float a) {
    acc[0] += a * bflo(v0.x); acc[1] += a * bfhi(v0.x); acc[2] += a * bflo(v0.y); acc[3] += a * bfhi(v0.y);
    acc[4] += a * bflo(v0.z); acc[5] += a * bfhi(v0.z); acc[6] += a * bflo(v0.w); acc[7] += a * bfhi(v0.w);
    acc[8] += a * bflo(v1.x); acc[9] += a * bfhi(v1.x); acc[10] += a * bflo(v1.y); acc[11] += a * bfhi(v1.y);
    acc[12] += a * bflo(v1.z); acc[13] += a * bfhi(v1.z); acc[14] += a * bflo(v1.w); acc[15] += a * bfhi(v1.w);
}
__device__ __forceinline__ void phase_peer_gather2(const Args& a, char* lds, int layer, int mode) {
    const int lane = threadIdx.x & 63, wid = threadIdx.x >> 6, gw = blockIdx.x * NWAVE + wid, ngw = gridDim.x * NWAVE;
    const int grp = lane >> 4, sub = lane & 15;
    unsigned char* ws = a.ws;
    bf16_t* H = (bf16_t*)(ws + WS_H); float* X1 = (float*)(ws + WS_X1);
    const bf16_t* PU = (const bf16_t*)(ws + WS_PU) + (size_t)layer * NEXP * D; const bf16_t* PV = (const bf16_t*)(ws + WS_PV) + (size_t)layer * NEXP * D;
    const int* SELI = (const int*)(ws + WS_SELI); const float* SELG = (const float*)(ws + WS_SELG);
    LAS int* lidx = (LAS int*)((LAS char*)lds + wid * 2048);
    LAS float* lgate = (LAS float*)(lidx + 128);
    LAS float* lact = lgate + 128;
    for (int g = gw; g < MTOT; g += ngw) {
        const int var = row_variant(g);
        if (mode == 1 && var == 2) continue;
        lidx[lane] = SELI[(size_t)g * 128 + lane]; lidx[64 + lane] = SELI[(size_t)g * 128 + 64 + lane];
        lgate[lane] = SELG[(size_t)g * 128 + lane]; lgate[64 + lane] = SELG[(size_t)g * 128 + 64 + lane];
        u32x4 hp[8];
#pragma unroll
        for (int c = 0; c < 8; ++c) hp[c] = *(const u32x4*)(H + (size_t)g * D + c * 128 + sub * 8);
        {
            Row8 ra, rb;
            load_row8(ra, PU + (size_t)lidx[grp] * D + sub * 8);
            for (int it = 0; it < 32; it += 2) {
                load_row8(rb, PU + (size_t)lidx[(it + 1) * 4 + grp] * D + sub * 8);
                { const float s = dot_row8(ra, hp); const int e = it * 4 + grp; if (sub == 0) lact[e] = gelu_t(s) * lgate[e]; }
                if (it + 2 < 32) load_row8(ra, PU + (size_t)lidx[(it + 2) * 4 + grp] * D + sub * 8);
                { const float s = dot_row8(rb, hp); const int e = (it + 1) * 4 + grp; if (sub == 0) lact[e] = gelu_t(s) * lgate[e]; }
            }
        }
        float acc[16];
#pragma unroll
        for (int d = 0; d < 16; ++d) acc[d] = 0.f;
        {
            u32x4 va[4][2], vb[4][2];
#pragma unroll
            for (int k = 0; k < 4; ++k) { const bf16_t* p = PV + (size_t)lidx[k] * D + lane * 8; va[k][0] = *(const u32x4*)p; va[k][1] = *(const u32x4*)(p + 512); }
            for (int e = 0; e < 128; e += 8) {
#pragma unroll
                for (int k = 0; k < 4; ++k) { const bf16_t* p = PV + (size_t)lidx[e + 4 + k] * D + lane * 8; vb[k][0] = *(const u32x4*)p; vb[k][1] = *(const u32x4*)(p + 512); }
#pragma unroll
                for (int k = 0; k < 4; ++k) fma_row(acc, va[k][0], va[k][1], lact[e + k]);
                if (e + 8 < 128) {
#pragma unroll
                    for (int k = 0; k < 4; ++k) { const bf16_t* p = PV + (size_t)lidx[e + 8 + k] * D + lane * 8; va[k][0] = *(const u32x4*)p; va[k][1] = *(const u32x4*)(p + 512); }
                }
#pragma unroll
                for (int k = 0; k < 4; ++k) fma_row(acc, vb[k][0], vb[k][1], lact[e + 4 + k]);
            }
        }
        float* xr = X1 + (size_t)g * D + lane * 8;
        const float* g2 = modv(a, layer, var, 5) + lane * 8;
        float xn[16]; float ss = 0.f;
#pragma unroll
        for (int hh = 0; hh < 2; ++hh)
#pragma unroll
            for (int d = 0; d < 8; d += 4) {
                const f32x4 xv = *(const f32x4*)(xr + hh * 512 + d), gv = *(const f32x4*)(g2 + hh * 512 + d);
                const int o = hh * 8 + d;
                xn[o] = xv.x + gv.x * acc[o]; xn[o + 1] = xv.y + gv.y * acc[o + 1]; xn[o + 2] = xv.z + gv.z * acc[o + 2]; xn[o + 3] = xv.w + gv.w * acc[o + 3];
                ss += xn[o] * xn[o] + xn[o + 1] * xn[o + 1] + xn[o + 2] * xn[o + 2] + xn[o + 3] * xn[o + 3];
            }
        const float rinv = rsqrtf(wave_sum(ss) * (1.f / D) + EPS);
        if (mode == 0) {
            const float* gn = a.in[6] + D + lane * 8; const float* sh = modv(a, 1, var, 0) + lane * 8; const float* sc = modv(a, 1, var, 1) + lane * 8;
#pragma unroll
            for (int hh = 0; hh < 2; ++hh) {
                const int o = hh * 8;
                f32x4 o0, o1; o0.x = xn[o]; o0.y = xn[o + 1]; o0.z = xn[o + 2]; o0.w = xn[o + 3]; o1.x = xn[o + 4]; o1.y = xn[o + 5]; o1.z = xn[o + 6]; o1.w = xn[o + 7];
                *(f32x4*)(xr + hh * 512) = o0; *(f32x4*)(xr + hh * 512 + 4) = o1;
                unsigned w[4];
#pragma unroll
                for (int d = 0; d < 8; d += 2) { const int cc = hh * 512 + d; w[d >> 1] = pk2(xn[o + d] * rinv * gn[cc] * (1.f + sc[cc]) + sh[cc], xn[o + d + 1] * rinv * gn[cc + 1] * (1.f + sc[cc + 1]) + sh[cc + 1]); }
                u32x4 ow; ow.x = w[0]; ow.y = w[1]; ow.z = w[2]; ow.w = w[3];
                *(u32x4*)(H + (size_t)g * D + hh * 512 + lane * 8) = ow;
            }
        } else {
            const int b = g / RPB, t = g - b * RPB - CTXL;
            float* op = a.out + ((size_t)b * SEQ + t) * D + lane * 8; const float* gn = a.in[28] + lane * 8;
#pragma unroll
            for (int hh = 0; hh < 2; ++hh)
#pragma unroll
                for (int d = 0; d < 8; d += 4) { const int o = hh * 8 + d, cc = hh * 512 + d;
                    f32x4 ov; ov.x = xn[o] * rinv * gn[cc]; ov.y = xn[o + 1] * rinv * gn[cc + 1]; ov.z = xn[o + 2] * rinv * gn[cc + 2]; ov.w = xn[o + 3] * rinv * gn[cc + 3]; *(f32x4*)(op + cc) = ov; }
        }
    }
}

__device__ __forceinline__ float ub0(unsigned w) { return (float)(w & 0xffu); }
__device__ __forceinline__ float ub1(unsigned w) { return (float)((w >> 8) & 0xffu); }
__device__ __forceinline__ float ub2(unsigned w) { return (float)((w >> 16) & 0xffu); }
__device__ __forceinline__ float ub3(unsigned w) { return (float)(w >> 24); }
struct RowU { u32x4 c[4]; };
__device__ __forceinline__ void load_rowu(RowU& r, const unsigned char* p) {
#pragma unroll
    for (int c = 0; c < 4; ++c) r.c[c] = *(const u32x4*)(p + c * 256);
}
__device__ __forceinline__ float dot_rowu(const RowU& r, const float (&hp)[64]) {
    float a0 = 0.f, a1 = 0.f, a2 = 0.f, a3 = 0.f;
#pragma unroll
    for (int c = 0; c < 4; ++c) {
        const unsigned w0 = r.c[c].x, w1 = r.c[c].y, w2 = r.c[c].z, w3 = r.c[c].w; const int o = c * 16;
        a0 += hp[o + 0] * ub0(w0); a1 += hp[o + 1] * ub1(w0); a2 += hp[o + 2] * ub2(w0); a3 += hp[o + 3] * ub3(w0);
        a0 += hp[o + 4] * ub0(w1); a1 += hp[o + 5] * ub1(w1); a2 += hp[o + 6] * ub2(w1); a3 += hp[o + 7] * ub3(w1);
        a0 += hp[o + 8] * ub0(w2); a1 += hp[o + 9] * ub1(w2); a2 += hp[o + 10] * ub2(w2); a3 += hp[o + 11] * ub3(w2);
        a0 += hp[o + 12] * ub0(w3); a1 += hp[o + 13] * ub1(w3); a2 += hp[o + 14] * ub2(w3); a3 += hp[o + 15] * ub3(w3);
    }
    float s = (a0 + a1) + (a2 + a3);
    s += __shfl_xor(s, 1); s += __shfl_xor(s, 2); s += __shfl_xor(s, 4); s += __shfl_xor(s, 8);
    return s;
}
__device__ __forceinline__ void fma_rowv(float (&acc)[16], const u32x4& v, float a) {
    acc[0] += a * ub0(v.x); acc[1] += a * ub1(v.x); acc[2] += a * ub2(v.x); acc[3] += a * ub3(v.x);
    acc[4] += a * ub0(v.y); acc[5] += a * ub1(v.y); acc[6] += a * ub2(v.y); acc[7] += a * ub3(v.y);
    acc[8] += a * ub0(v.z); acc[9] += a * ub1(v.z); acc[10] += a * ub2(v.z); acc[11] += a * ub3(v.z);
    acc[12] += a * ub0(v.w); acc[13] += a * ub1(v.w); acc[14] += a * ub2(v.w); acc[15] += a * ub3(v.w);
}
__device__ __forceinline__ void phase_peer_gather3(const Args& a, char* lds, int layer, int mode) {
    const int lane = threadIdx.x & 63, wid = __builtin_amdgcn_readfirstlane(threadIdx.x >> 6), gw = blockIdx.x * NWAVE + wid, ngw = gridDim.x * NWAVE;
    const int grp = lane >> 4, sub = lane & 15;
    unsigned char* ws = a.ws;
    bf16_t* H = (bf16_t*)(ws + WS_H); float* X1 = (float*)(ws + WS_X1);
    const unsigned char* PU = ws + WS_PU + (size_t)layer * NEXP * D; const unsigned char* PV = ws + WS_PV + (size_t)layer * NEXP * D;
    const float* SCU = (const float*)(ws + WS_SCU) + layer * NEXP; const float* SCV = (const float*)(ws + WS_SCV) + layer * NEXP;
    const int* SELI = (const int*)(ws + WS_SELI); const float* SELG = (const float*)(ws + WS_SELG);
    LAS int* lidx = (LAS int*)((LAS char*)lds + wid * 2048);
    LAS float* lgu = (LAS float*)(lidx + 128);
    LAS float* lact = lgu + 128;
    for (int g = gw; g < MTOT; g += ngw) {
        const int var = row_variant(g);
        if (mode == 1 && var == 2) continue;
        {
            const int i0 = SELI[(size_t)g * 128 + lane], i1 = SELI[(size_t)g * 128 + 64 + lane];
            lidx[lane] = i0; lidx[64 + lane] = i1;
            lgu[lane] = SCU[i0]; lgu[64 + lane] = SCU[i1];
        }
        float hp[64]; float shp = 0.f;
#pragma unroll
        for (int c = 0; c < 4; ++c) {
            const u32x4 w0 = *(const u32x4*)(H + (size_t)g * D + c * 256 + sub * 16), w1 = *(const u32x4*)(H + (size_t)g * D + c * 256 + sub * 16 + 8);
            const int o = c * 16;
            hp[o + 0] = bflo(w0.x); hp[o + 1] = bfhi(w0.x); hp[o + 2] = bflo(w0.y); hp[o + 3] = bfhi(w0.y); hp[o + 4] = bflo(w0.z); hp[o + 5] = bfhi(w0.z); hp[o + 6] = bflo(w0.w); hp[o + 7] = bfhi(w0.w);
            hp[o + 8] = bflo(w1.x); hp[o + 9] = bfhi(w1.x); hp[o + 10] = bflo(w1.y); hp[o + 11] = bfhi(w1.y); hp[o + 12] = bflo(w1.z); hp[o + 13] = bfhi(w1.z); hp[o + 14] = bflo(w1.w); hp[o + 15] = bfhi(w1.w);
        }
#pragma unroll
        for (int d = 0; d < 64; ++d) shp += hp[d];
        shp += __shfl_xor(shp, 1); shp += __shfl_xor(shp, 2); shp += __shfl_xor(shp, 4); shp += __shfl_xor(shp, 8);
        const float bias = 128.f * shp;
        {
            RowU r0, r1, r2, r3;
            load_rowu(r0, PU + (size_t)lidx[0 * 4 + grp] * D + sub * 16); load_rowu(r1, PU + (size_t)lidx[1 * 4 + grp] * D + sub * 16);
            load_rowu(r2, PU + (size_t)lidx[2 * 4 + grp] * D + sub * 16); load_rowu(r3, PU + (size_t)lidx[3 * 4 + grp] * D + sub * 16);
#define GU_STEP(R, IT) { const float s = dot_rowu(R, hp) - bias; const int e = (IT) * 4 + grp; const float su = lgu[e]; \
                if ((IT) + 4 < 32) load_rowu(R, PU + (size_t)lidx[((IT) + 4) * 4 + grp] * D + sub * 16); \
                if (sub == 0) lact[e] = gelu_t(s * su); }
            for (int it = 0; it < 32; it += 4) { GU_STEP(r0, it) GU_STEP(r1, it + 1) GU_STEP(r2, it + 2) GU_STEP(r3, it + 3) }
#undef GU_STEP
        }
        {
            const float g0 = SELG[(size_t)g * 128 + lane], g1 = SELG[(size_t)g * 128 + 64 + lane];
            const float a0 = lact[lane] * g0 * SCV[lidx[lane]], a1 = lact[64 + lane] * g1 * SCV[lidx[64 + lane]];
            lact[lane] = a0; lact[64 + lane] = a1;
        }
        float acc[16]; float sact = 0.f;
#pragma unroll
        for (int d = 0; d < 16; ++d) acc[d] = 0.f;
        {
            u32x4 va[8];
#pragma unroll
            for (int k = 0; k < 8; ++k) va[k] = *(const u32x4*)(PV + (size_t)lidx[k] * D + lane * 16);
            for (int e = 0; e < 128; e += 8) {
#pragma unroll
                for (int k = 0; k < 8; ++k) {
                    const float av = lact[e + k]; sact += av;
                    fma_rowv(acc, va[k], av);
                    if (e + 8 < 128) va[k] = *(const u32x4*)(PV + (size_t)lidx[e + 8 + k] * D + lane * 16);
                }
            }
        }
        const float vb = 128.f * sact;
        float* xr = X1 + (size_t)g * D + lane * 16;
        const float* g2 = modv(a, layer, var, 5) + lane * 16;
        float xn[16]; float ss = 0.f;
#pragma unroll
        for (int d = 0; d < 16; d += 4) {
            const f32x4 xv = *(const f32x4*)(xr + d), gv = *(const f32x4*)(g2 + d);
            xn[d] = xv.x + gv.x * (acc[d] - vb); xn[d + 1] = xv.y + gv.y * (acc[d + 1] - vb); xn[d + 2] = xv.z + gv.z * (acc[d + 2] - vb); xn[d + 3] = xv.w + gv.w * (acc[d + 3] - vb);
            ss += xn[d] * xn[d] + xn[d + 1] * xn[d + 1] + xn[d + 2] * xn[d + 2] + xn[d + 3] * xn[d + 3];
        }
        const float rinv = rsqrtf(wave_sum(ss) * (1.f / D) + EPS);
        if (mode == 0) {
#pragma unroll
            for (int d = 0; d < 16; d += 4) { f32x4 o; o.x = xn[d]; o.y = xn[d + 1]; o.z = xn[d + 2]; o.w = xn[d + 3]; *(f32x4*)(xr + d) = o; }
            const float* gn = a.in[6] + D + lane * 16; const float* sh = modv(a, 1, var, 0) + lane * 16; const float* sc = modv(a, 1, var, 1) + lane * 16;
            unsigned w[8];
#pragma unroll
            for (int d = 0; d < 16; d += 2) w[d >> 1] = pk2(xn[d] * rinv * gn[d] * (1.f + sc[d]) + sh[d], xn[d + 1] * rinv * gn[d + 1] * (1.f + sc[d + 1]) + sh[d + 1]);
            u32x4 o0, o1; o0.x = w[0]; o0.y = w[1]; o0.z = w[2]; o0.w = w[3]; o1.x = w[4]; o1.y = w[5]; o1.z = w[6]; o1.w = w[7];
            *(u32x4*)(H + (size_t)g * D + lane * 16) = o0; *(u32x4*)(H + (size_t)g * D + lane * 16 + 8) = o1;
        } else {
            const int b = g / RPB, t = g - b * RPB - CTXL;
            float* op = a.out + ((size_t)b * SEQ + t) * D + lane * 16; const float* gn = a.in[28] + lane * 16;
#pragma unroll
            for (int d = 0; d < 16; d += 4) { f32x4 o; o.x = xn[d] * rinv * gn[d]; o.y = xn[d + 1] * rinv * gn[d + 1]; o.z = xn[d + 2] * rinv * gn[d + 2]; o.w = xn[d + 3] * rinv * gn[d + 3]; *(f32x4*)(op + d) = o; }
        }
    }
}

__device__ __forceinline__ int peer_tok(int i, int mode) { return mode == 1 ? i + CTXL + (i >= SEQ ? CTXL : 0) : i; }
__device__ __forceinline__ float dot16u(const u32x4& w, const float (&hp)[16]) {
    float a0 = hp[0] * ub0(w.x) + hp[4] * ub0(w.y), a1 = hp[1] * ub1(w.x) + hp[5] * ub1(w.y), a2 = hp[2] * ub2(w.x) + hp[6] * ub2(w.y), a3 = hp[3] * ub3(w.x) + hp[7] * ub3(w.y);
    a0 += hp[8] * ub0(w.z) + hp[12] * ub0(w.w); a1 += hp[9] * ub1(w.z) + hp[13] * ub1(w.w); a2 += hp[10] * ub2(w.z) + hp[14] * ub2(w.w); a3 += hp[11] * ub3(w.z) + hp[15] * ub3(w.w);
    return (a0 + a1) + (a2 + a3);
}
#define DPP_I(v, ctrl) __builtin_amdgcn_update_dpp(0, (v), (ctrl), 0xf, 0xf, true)
__device__ __forceinline__ int sum8_i(int v) {
    v += DPP_I(v, 0xB1);
    v += DPP_I(v, 0x4E);
    v += DPP_I(v, 0x141);
    return v;
}
__device__ __forceinline__ int sum_eg_i(int v) {
    v += DPP_I(v, 0x128);
    { const auto r = __builtin_amdgcn_permlane16_swap((unsigned)v, (unsigned)v, false, false); v = (int)(r[0] + r[1]); }
    { const auto r = __builtin_amdgcn_permlane32_swap((unsigned)v, (unsigned)v, false, false); v = (int)(r[0] + r[1]); }
    return v;
}
__device__ __forceinline__ void gu_stage(u32x4 (&seg)[16], u32x4& hw, LAS int* lb, int i0, int i1, const unsigned char* hrow, const unsigned char* PUx, int lane, int eg, unsigned loff) {
    lb[lane] = i0; lb[64 + lane] = i1;
    hw = *(const u32x4*)hrow;
#pragma unroll
    for (int st = 0; st < 16; ++st) seg[st] = *(const u32x4*)(PUx + ((unsigned)lb[st * 8 + eg] * 128u + loff));
}
__device__ __forceinline__ void gu_compute(const u32x4 (&seg)[16], const u32x4& hw, LAS float* lpart, float* prow, int lane, int eg, int sub, bool valid) {
#pragma unroll
    for (int st = 0; st < 16; ++st) {
        int d = __builtin_amdgcn_sdot4((int)seg[st].x, (int)hw.x, 0, false);
        d = __builtin_amdgcn_sdot4((int)seg[st].y, (int)hw.y, d, false); d = __builtin_amdgcn_sdot4((int)seg[st].z, (int)hw.z, d, false); d = __builtin_amdgcn_sdot4((int)seg[st].w, (int)hw.w, d, false);
        d = sum8_i(d);
        if (sub == 0) lpart[st * 8 + eg] = (float)d;
    }
    if (valid) { prow[lane] = lpart[lane]; prow[64 + lane] = lpart[64 + lane]; }
}
__device__ __forceinline__ void phase_gu(const Args& a, char* lds, int layer, int mode) {
    const int lane = threadIdx.x & 63, wid = __builtin_amdgcn_readfirstlane(threadIdx.x >> 6), eg = lane >> 3, sub = lane & 7;
    const int x = blockIdx.x & 7, stripe = blockIdx.x >> 3, nstr = (gridDim.x >> 3) * NWAVE, ntok = mode == 1 ? NB * SEQ : MTOT;
    unsigned char* ws = a.ws;
    const unsigned char* H8 = ws + WS_H8 + x * 128 + sub * 16;
    const unsigned char* PUx = ws + WS_PU + (size_t)layer * NEXP * D + (size_t)x * NEXP * 128; const unsigned loff = (unsigned)(sub * 16);
    const int* SELI = (const int*)(ws + WS_SELI); float* PART = (float*)(ws + WS_PART) + (size_t)x * MTOT * 128;
    LAS int* lidx = (LAS int*)((LAS char*)lds + wid * 2048);
    LAS float* lpart = (LAS float*)(lidx + 256);
    const int first = stripe * NWAVE + wid;
#define G_TOK(k) peer_tok(min(first + (k) * nstr, ntok - 1), mode)
#define G_VALID(k) (first + (k) * nstr < ntok)
    u32x4 segA[16], segB[16], hwA, hwB;
    int p0, p1;
    { const int g = G_TOK(0); p0 = SELI[(size_t)g * 128 + lane]; p1 = SELI[(size_t)g * 128 + 64 + lane];
      gu_stage(segA, hwA, lidx, p0, p1, H8 + (size_t)g * D, PUx, lane, eg, loff); }
    { const int g = G_TOK(1); p0 = SELI[(size_t)g * 128 + lane]; p1 = SELI[(size_t)g * 128 + 64 + lane]; }
    for (int k = 0; G_VALID(k); k += 2) {
        { const int g1 = G_TOK(k + 1); gu_stage(segB, hwB, lidx + 128, p0, p1, H8 + (size_t)g1 * D, PUx, lane, eg, loff); }
        { const int g2 = G_TOK(k + 2); p0 = SELI[(size_t)g2 * 128 + lane]; p1 = SELI[(size_t)g2 * 128 + 64 + lane]; }
        gu_compute(segA, hwA, lpart, PART + (size_t)G_TOK(k) * 128, lane, eg, sub, true);
        { const int g2 = G_TOK(k + 2); gu_stage(segA, hwA, lidx, p0, p1, H8 + (size_t)g2 * D, PUx, lane, eg, loff); }
        { const int g3 = G_TOK(k + 3); p0 = SELI[(size_t)g3 * 128 + lane]; p1 = SELI[(size_t)g3 * 128 + 64 + lane]; }
        gu_compute(segB, hwB, lpart, PART + (size_t)G_TOK(k + 1) * 128, lane, eg, sub, G_VALID(k + 1));
    }
}
__device__ __forceinline__ void phase_gact(const Args& a, int layer, int mode) {
    const int lane = threadIdx.x & 63, gw = blockIdx.x * NWAVE + (threadIdx.x >> 6), ngw = gridDim.x * NWAVE, ntok = mode == 1 ? NB * SEQ : MTOT;
    unsigned char* ws = a.ws;
    const float* PART = (const float*)(ws + WS_PART); const int* SELI = (const int*)(ws + WS_SELI); const float* SELG = (const float*)(ws + WS_SELG);
    const float* SCU = (const float*)(ws + WS_SCU) + layer * NEXP; const float* SCV = (const float*)(ws + WS_SCV) + layer * NEXP;
    const float* SH = (const float*)(ws + WS_SH); short* ACT16 = (short*)(ws + WS_ACT16); float* SA = (float*)(ws + WS_SA);
    for (int i = gw; i < ntok; i += ngw) {
        const int g = peer_tok(i, mode);
        const float sh = SH[g];
        float av[2];
#pragma unroll
        for (int hf = 0; hf < 2; ++hf) {
            const size_t o = (size_t)g * 128 + hf * 64 + lane;
            float sdot = 0.f;
#pragma unroll
            for (int xx = 0; xx < 8; ++xx) sdot += PART[(size_t)xx * MTOT * 128 + o];
            const int id = SELI[o];
            av[hf] = gelu_t(sdot * sh * SCU[id]) * SELG[o] * SCV[id];
        }
        float mx = fmaxf(fabsf(av[0]), fabsf(av[1]));
#pragma unroll
        for (int of = 1; of < 64; of <<= 1) mx = fmaxf(mx, __shfl_xor(mx, of));
        mx = fmaxf(mx, 1e-30f); const float inv = 32767.f / mx;
#pragma unroll
        for (int hf = 0; hf < 2; ++hf) {
            const int e = hf * 64 + lane, st = e >> 3, eg = e & 7, pos = (((st >> 1) * 8 + eg) << 1) | (st & 1);
            ACT16[(size_t)g * 128 + pos] = (short)__float2int_rn(av[hf] * inv);
        }
        if (lane == 0) SA[g] = mx * (1.f / 32767.f);
    }
}
__device__ __forceinline__ void gv_stage(u32x4 (&seg)[16], LAS int* lb, int i0, int i1, const unsigned char* PVx, int lane, int eg, unsigned loff) {
    lb[lane] = i0; lb[64 + lane] = i1;
#pragma unroll
    for (int st = 0; st < 16; ++st) seg[st] = *(const u32x4*)(PVx + ((unsigned)lb[st * 8 + eg] * 128u + loff));
}
typedef short s16x2_t __attribute__((ext_vector_type(2)));
__device__ __forceinline__ int dot2i16(unsigned w, unsigned aw, int acc) { return __builtin_amdgcn_sdot2(__builtin_bit_cast(s16x2_t, w), __builtin_bit_cast(s16x2_t, aw), acc, false); }
__device__ __forceinline__ void gv_pair(int (&acc)[16], const u32x4& va, const u32x4& vb, unsigned aw) {
#define GV_D(d, o) acc[o + 0] = dot2i16(__builtin_amdgcn_perm(vb.d, va.d, 0x0c040c00u), aw, acc[o + 0]); acc[o + 1] = dot2i16(__builtin_amdgcn_perm(vb.d, va.d, 0x0c050c01u), aw, acc[o + 1]); \
                   acc[o + 2] = dot2i16(__builtin_amdgcn_perm(vb.d, va.d, 0x0c060c02u), aw, acc[o + 2]); acc[o + 3] = dot2i16(__builtin_amdgcn_perm(vb.d, va.d, 0x0c070c03u), aw, acc[o + 3]);
    GV_D(x, 0) GV_D(y, 4) GV_D(z, 8) GV_D(w, 12)
#undef GV_D
}
__device__ __forceinline__ void gv_compute(const u32x4 (&seg)[16], const unsigned (&aw)[8], float sa, float* xr, const float* g2, int eg, bool valid) {
    int acc[16]; int sq = 0;
#pragma unroll
    for (int k = 0; k < 16; ++k) acc[k] = 0;
#pragma unroll
    for (int s2 = 0; s2 < 8; ++s2) { gv_pair(acc, seg[2 * s2], seg[2 * s2 + 1], aw[s2]); sq += (int)(short)(aw[s2] & 0xffffu) + ((int)aw[s2] >> 16); }
#pragma unroll
    for (int k = 0; k < 16; ++k) acc[k] = sum_eg_i(acc[k]);
    sq = sum_eg_i(sq);
    if (eg == 0 && valid) {
        const int vb = 128 * sq;
#pragma unroll
        for (int d = 0; d < 16; d += 4) {
            const f32x4 xv = *(const f32x4*)(xr + d), gv = *(const f32x4*)(g2 + d);
            f32x4 o; o.x = xv.x + gv.x * (sa * (float)(acc[d] - vb)); o.y = xv.y + gv.y * (sa * (float)(acc[d + 1] - vb)); o.z = xv.z + gv.z * (sa * (float)(acc[d + 2] - vb)); o.w = xv.w + gv.w * (sa * (float)(acc[d + 3] - vb));
            *(f32x4*)(xr + d) = o;
        }
    }
}
__device__ __forceinline__ void phase_gv(const Args& a, char* lds, int layer, int mode) {
    const int lane = threadIdx.x & 63, wid = __builtin_amdgcn_readfirstlane(threadIdx.x >> 6), eg = lane >> 3, sub = lane & 7;
    const int x = blockIdx.x & 7, stripe = blockIdx.x >> 3, nstr = (gridDim.x >> 3) * NWAVE, ntok = mode == 1 ? NB * SEQ : MTOT;
    unsigned char* ws = a.ws;
    float* X1 = (float*)(ws + WS_X1) + x * 128 + sub * 16;
    const unsigned char* PVx = ws + WS_PV + (size_t)layer * NEXP * D + (size_t)x * NEXP * 128; const unsigned loff = (unsigned)(sub * 16);
    const int* SELI = (const int*)(ws + WS_SELI); const unsigned* ACTW = (const unsigned*)(ws + WS_ACT16) + eg; const float* SA = (const float*)(ws + WS_SA);
    LAS int* lidx = (LAS int*)((LAS char*)lds + wid * 2048);
    const int first = stripe * NWAVE + wid;
    u32x4 segA[16], segB[16];
    unsigned awA[8], awB[8]; float saA, saB;
    int p0, p1;
#define GV_PREF(k) { const int g_ = G_TOK(k); p0 = SELI[(size_t)g_ * 128 + lane]; p1 = SELI[(size_t)g_ * 128 + 64 + lane]; }
#define GV_AW(AW, SAV, k) { const int g_ = G_TOK(k); _Pragma("unroll") for (int s2 = 0; s2 < 8; ++s2) AW[s2] = ACTW[(size_t)g_ * 64 + s2 * 8]; SAV = SA[g_]; }
#define GV_G2(k) (modv(a, layer, row_variant(G_TOK(k)), 5) + x * 128 + sub * 16)
    GV_PREF(0) gv_stage(segA, lidx, p0, p1, PVx, lane, eg, loff); GV_AW(awA, saA, 0)
    GV_PREF(1)
    for (int k = 0; G_VALID(k); k += 2) {
        gv_stage(segB, lidx + 128, p0, p1, PVx, lane, eg, loff); GV_AW(awB, saB, k + 1)
        GV_PREF(k + 2)
        gv_compute(segA, awA, saA, X1 + (size_t)G_TOK(k) * D, GV_G2(k), eg, true);
        gv_stage(segA, lidx, p0, p1, PVx, lane, eg, loff); GV_AW(awA, saA, k + 2)
        GV_PREF(k + 3)
        gv_compute(segB, awB, saB, X1 + (size_t)G_TOK(k + 1) * D, GV_G2(k + 1), eg, G_VALID(k + 1));
    }
#undef GV_PREF
#undef GV_AW
#undef GV_G2
#undef G_TOK
#undef G_VALID
}
__device__ __forceinline__ void phase_finalnorm(const Args& a) {
    const int lane = threadIdx.x & 63, gw = blockIdx.x * NWAVE + (threadIdx.x >> 6), ngw = gridDim.x * NWAVE;
    const float* X1 = (const float*)(a.ws + WS_X1);
    for (int i = gw; i < NB * SEQ; i += ngw) {
        const int g = peer_tok(i, 1);
        const float* xr = X1 + (size_t)g * D; float* op = a.out + (size_t)i * D;
        f32x4 v[4]; float ss = 0.f;
#pragma unroll
        for (int j = 0; j < 4; ++j) { v[j] = *(const f32x4*)(xr + j * 256 + lane * 4); ss += (v[j].x * v[j].x + v[j].y * v[j].y) + (v[j].z * v[j].z + v[j].w * v[j].w); }
        const float rinv = rsqrtf(wave_sum(ss) * (1.f / D) + EPS);
#pragma unroll
        for (int j = 0; j < 4; ++j) { const f32x4 gn = *(const f32x4*)(a.in[28] + j * 256 + lane * 4); *(f32x4*)(op + j * 256 + lane * 4) = v[j] * rinv * gn; }
    }
}

__device__ __forceinline__ void phase_inproj1(const Args& a, char* lds) {
    float* Cs = (float*)lds;
    const int tid = threadIdx.x;
    const bf16_t* H = (const bf16_t*)(a.ws + WS_H); const bf16_t* W = (const bf16_t*)(a.ws + WS_WIN1);
    const int NU = (MTOT / 128) * 20;
    for (int u = blockIdx.x; u < NU; u += gridDim.x) {
        const int rt = u / 20, ct = u % 20, row0 = rt * 128, col0 = ct * 128;
        if (ct < 10 && (rt % 66) < 2) continue;
        gemm_tile128(H + (size_t)row0 * D, D, W + (size_t)col0 * D, D, D, Cs);
        __syncthreads();
        const int rr = tid >> 2, q4 = tid & 3, g = row0 + rr;
        const float* crow = Cs + rr * CS_LD + q4 * 32;
        if (ct < 10) {
            bf16_t* o = (bf16_t*)(a.ws + WS_GG) + (size_t)g * DRNN + col0 + q4 * 32;
#pragma unroll
            for (int c = 0; c < 32; c += 2) *(unsigned*)(o + c) = pk2(gelu_t(crow[c]), gelu_t(crow[c + 1]));
        } else {
            bf16_t* o = (bf16_t*)(a.ws + WS_XR) + (size_t)g * DRNN + (col0 - DRNN) + q4 * 32;
#pragma unroll
            for (int c = 0; c < 32; c += 2) *(unsigned*)(o + c) = pk2(crow[c], crow[c + 1]);
        }
        __syncthreads();
    }
}

__device__ __forceinline__ void phase_rglru(const Args& a, char* lds, int pass) {
    const int tid = threadIdx.x;
    unsigned char* ws = a.ws;
    float* xc = (float*)lds;
    float* seg = xc + 128 * 128;
    const bf16_t* XR = (const bf16_t*)(ws + WS_XR); const bf16_t* GG = (const bf16_t*)(ws + WS_GG); bf16_t* YG = (bf16_t*)(ws + WS_YG);
    float* CARRY = (float*)(ws + WS_CARRY);
    const int j = tid & 127, tq = tid >> 7;
    const int NU = (MTOT / 128) * 10;
    for (int u = blockIdx.x; u < NU; u += gridDim.x) {
        const int T = u / 10, hb = u % 10, b = T / 66, tl = T % 66, row0 = T * 128, ch = hb * 128 + j;
        if (pass == 1 && tl < 2) continue;
        const int seq_lo = tl < 2 ? b * RPB : b * RPB + CTXL, seq_hi = tl < 2 ? b * RPB + CTXL : (b + 1) * RPB;
        {
            const float w0 = a.in[16][0 * DRNN + ch], w1 = a.in[16][1 * DRNN + ch], w2 = a.in[16][2 * DRNN + ch], w3 = a.in[16][3 * DRNN + ch], cb = a.in[17][ch];
            for (int tt = 0; tt < 32; ++tt) {
                const int g = row0 + tq * 32 + tt;
                const float xm2 = (g - 2 >= seq_lo) ? bf2f(XR[(size_t)(g - 2) * DRNN + ch]) : 0.f;
                const float xm1 = (g - 1 >= seq_lo) ? bf2f(XR[(size_t)(g - 1) * DRNN + ch]) : 0.f;
                const float x0 = bf2f(XR[(size_t)g * DRNN + ch]);
                const float xp1 = (g + 1 < seq_hi) ? bf2f(XR[(size_t)(g + 1) * DRNN + ch]) : 0.f;
                xc[(tq * 32 + tt) * 128 + j] = w0 * xm2 + w1 * xm1 + w2 * x0 + w3 * xp1 + cb;
            }
        }
        __syncthreads();
        float acc[4][32];
#pragma unroll
        for (int m = 0; m < 4; ++m)
#pragma unroll
            for (int tt = 0; tt < 32; ++tt) acc[m][tt] = 0.f;
        {
            const float* wa0 = a.in[18] + ((size_t)(0 * 10 + hb) * 128) * 128 + j; const float* wx0 = a.in[20] + ((size_t)(0 * 10 + hb) * 128) * 128 + j;
            const float* wa1 = a.in[18] + ((size_t)(1 * 10 + hb) * 128) * 128 + j; const float* wx1 = a.in[20] + ((size_t)(1 * 10 + hb) * 128) * 128 + j;
            for (int i = 0; i < 128; ++i) {
                const float w0 = wa0[i * 128], w1 = wx0[i * 128], w2 = wa1[i * 128], w3 = wx1[i * 128];
#pragma unroll
                for (int tt = 0; tt < 32; ++tt) { const float x = xc[(tq * 32 + tt) * 128 + i]; acc[0][tt] += x * w0; acc[1][tt] += x * w1; acc[2][tt] += x * w2; acc[3][tt] += x * w3; }
            }
        }
#pragma unroll
        for (int d = 0; d < 2; ++d) {
            const float ba = a.in[19][d * DRNN + ch], bx = a.in[21][d * DRNN + ch], lam = a.in[22][d * DRNN + ch];
            const float sp = log1pf(__expf(-lam));
#pragma unroll
            for (int tt = 0; tt < 32; ++tt) {
                const float r = sigmoidf_(acc[2 * d][tt] + ba), ig = sigmoidf_(acc[2 * d + 1][tt] + bx);
                const float la = -8.f * r * sp; const float av = __expf(la);
                const float uv = sqrtf(fmaxf(-expm1f(2.f * la), 0.f)) * ig * xc[(tq * 32 + tt) * 128 + j];
                acc[2 * d][tt] = av; acc[2 * d + 1][tt] = uv;
            }
        }
        {
            float Af = 1.f, Hf = 0.f, Ab = 1.f, Hb = 0.f;
#pragma unroll
            for (int tt = 0; tt < 32; ++tt) { Hf = acc[0][tt] * Hf + acc[1][tt]; Af *= acc[0][tt]; }
#pragma unroll
            for (int tt = 31; tt >= 0; --tt) { Hb = acc[2][tt] * Hb + acc[3][tt]; Ab *= acc[2][tt]; }
            seg[((0 * 4 + tq) * 128 + j) * 2] = Af; seg[((0 * 4 + tq) * 128 + j) * 2 + 1] = Hf;
            seg[((1 * 4 + tq) * 128 + j) * 2] = Ab; seg[((1 * 4 + tq) * 128 + j) * 2 + 1] = Hb;
        }
        __syncthreads();
        if (pass == 0) {
            if (tq == 0) {
                float A = 1.f, Hh = 0.f;
                for (int s = 0; s < 4; ++s) { const float sa = seg[((0 * 4 + s) * 128 + j) * 2], sh = seg[((0 * 4 + s) * 128 + j) * 2 + 1]; Hh = sa * Hh + sh; A *= sa; }
                float* c0 = CARRY + (((size_t)(b * 2 + 0) * 66 + tl) * DRNN + ch) * 2; c0[0] = A; c0[1] = Hh;
                A = 1.f; Hh = 0.f;
                for (int s = 3; s >= 0; --s) { const float sa = seg[((1 * 4 + s) * 128 + j) * 2], sh = seg[((1 * 4 + s) * 128 + j) * 2 + 1]; Hh = sa * Hh + sh; A *= sa; }
                float* c1 = CARRY + (((size_t)(b * 2 + 1) * 66 + tl) * DRNN + ch) * 2; c1[0] = A; c1[1] = Hh;
            }
        } else {
            float hf = 0.f, hbk = 0.f;
            for (int t2 = 0; t2 < tl; ++t2) { const float* c = CARRY + (((size_t)(b * 2 + 0) * 66 + t2) * DRNN + ch) * 2; hf = c[0] * hf + c[1]; }
            { const float* c = CARRY + (((size_t)(b * 2 + 1) * 66 + 1) * DRNN + ch) * 2; hbk = c[0] * hbk + c[1]; }
            { const float* c = CARRY + (((size_t)(b * 2 + 1) * 66 + 0) * DRNN + ch) * 2; hbk = c[0] * hbk + c[1]; }
            for (int t2 = 65; t2 > tl; --t2) { const float* c = CARRY + (((size_t)(b * 2 + 1) * 66 + t2) * DRNN + ch) * 2; hbk = c[0] * hbk + c[1]; }
            for (int s = 0; s < tq; ++s) { const float sa = seg[((0 * 4 + s) * 128 + j) * 2], sh = seg[((0 * 4 + s) * 128 + j) * 2 + 1]; hf = sa * hf + sh; }
            for (int s = 3; s > tq; --s) { const float sa = seg[((1 * 4 + s) * 128 + j) * 2], sh = seg[((1 * 4 + s) * 128 + j) * 2 + 1]; hbk = sa * hbk + sh; }
#pragma unroll
            for (int tt = 0; tt < 32; ++tt) { hf = acc[0][tt] * hf + acc[1][tt]; acc[0][tt] = hf; }
#pragma unroll
            for (int tt = 31; tt >= 0; --tt) { hbk = acc[2][tt] * hbk + acc[3][tt]; acc[0][tt] += hbk; }
#pragma unroll
            for (int tt = 0; tt < 32; ++tt) {
                const int g = row0 + tq * 32 + tt;
                YG[(size_t)g * DRNN + ch] = (bf16_t)f2bf(acc[0][tt] * bf2f(GG[(size_t)g * DRNN + ch]));
            }
        }
        __syncthreads();
    }
}

constexpr int XC_LD = 136;
__device__ __forceinline__ float exp2_fast(float x) { return __builtin_amdgcn_exp2f(x); }
__device__ __forceinline__ float sigm_fast(float x) { return __builtin_amdgcn_rcpf(1.f + __builtin_amdgcn_exp2f(-1.4426950408889634f * x)); }
__device__ __forceinline__ void phase_rglru2(const Args& a, char* lds, int pass) {
    const int tid_ = threadIdx.x, wid = __builtin_amdgcn_readfirstlane(tid_ >> 6);
    const int nb = wid & 3, dir = wid >> 2;
    unsigned char* ws = a.ws;
    LAS bf16_t* xcA = (LAS bf16_t*)((LAS char*)lds);
    LAS float* HS = (LAS float*)((LAS char*)lds + 36864);
    const bf16_t* XR = (const bf16_t*)(ws + WS_XR); const bf16_t* GG = (const bf16_t*)(ws + WS_GG); bf16_t* YG = (bf16_t*)(ws + WS_YG);
    float* CARRY = (float*)(ws + WS_CARRY);
    const int NU = (MTOT / 128) * 10;
    for (int u = blockIdx.x; u < NU; u += gridDim.x) {
        const int T = u / 10, hb = u % 10, b = T / 66, tl = T % 66, row0 = T * 128;
        if (pass == 1 && tl < 2) continue;
        int tid = tid_; asm volatile("" : "+v"(tid));
        const int lane = tid & 63, r32 = lane & 31, hh = lane >> 5;
        const int seq_lo = tl < 2 ? b * RPB : b * RPB + CTXL, seq_hi = tl < 2 ? b * RPB + CTXL : (b + 1) * RPB;
        float h0 = 0.f;
        if (pass == 1) {
            typedef float f32x2 __attribute__((ext_vector_type(2)));
            const int chl = hb * 128 + nb * 32 + r32;
            const int pos = dir == 0 ? tl : 67 - tl;
            const float* cbase = CARRY + ((size_t)(b * 2 + dir) * 66) * DRNN * 2 + (size_t)chl * 2;
            f32x2 cv[33];
#pragma unroll
            for (int i = 0; i < 33; ++i) { const int p = hh * 33 + i; const int tile = dir == 0 ? p : (p < 2 ? 1 - p : 67 - p); cv[i] = *(const f32x2*)(cbase + (size_t)tile * DRNN * 2); }
            float cA = 1.f, cH = 0.f;
#pragma unroll
            for (int i = 0; i < 33; ++i) { const bool ok = hh * 33 + i < pos; const float ta = ok ? cv[i].x : 1.f, th = ok ? cv[i].y : 0.f; cH = ta * cH + th; cA = ta * cA; }
            const auto ra = __builtin_amdgcn_permlane32_swap(__float_as_uint(cA), __float_as_uint(cA), false, false);
            const auto rh = __builtin_amdgcn_permlane32_swap(__float_as_uint(cH), __float_as_uint(cH), false, false);
            const float lowH = hh == 0 ? cH : __uint_as_float(rh[0]);
            const float upA = hh == 0 ? __uint_as_float(ra[1]) : cA;
            const float upH = hh == 0 ? __uint_as_float(rh[1]) : cH;
            h0 = upA * lowH + upH;
        }
        __builtin_amdgcn_sched_barrier(0);
        {
            const int j2 = tid & 63, ts = tid >> 6, c0 = hb * 128 + 2 * j2;
            const float w00 = a.in[16][0 * DRNN + c0], w01 = a.in[16][0 * DRNN + c0 + 1], w10 = a.in[16][1 * DRNN + c0], w11 = a.in[16][1 * DRNN + c0 + 1];
            const float w20 = a.in[16][2 * DRNN + c0], w21 = a.in[16][2 * DRNN + c0 + 1], w30 = a.in[16][3 * DRNN + c0], w31 = a.in[16][3 * DRNN + c0 + 1];
            const float cb0 = a.in[17][c0], cb1 = a.in[17][c0 + 1];
            unsigned xw[19];
#pragma unroll
            for (int i = 0; i < 19; ++i) { const int g = row0 + ts * 16 - 2 + i; xw[i] = (g >= seq_lo && g < seq_hi) ? *(const unsigned*)(XR + (size_t)g * DRNN + c0) : 0u; }
#pragma unroll
            for (int i = 0; i < 16; ++i) {
                const float y0 = w00 * bflo(xw[i]) + w10 * bflo(xw[i + 1]) + w20 * bflo(xw[i + 2]) + w30 * bflo(xw[i + 3]) + cb0;
                const float y1 = w01 * bfhi(xw[i]) + w11 * bfhi(xw[i + 1]) + w21 * bfhi(xw[i + 2]) + w31 * bfhi(xw[i + 3]) + cb1;
                *(LAS unsigned*)(xcA + (ts * 16 + i) * XC_LD + 2 * j2) = pk2(y0, y1);
            }
        }
        __syncthreads();
        const int ch = hb * 128 + nb * 32 + r32;
        f32x16 accA[4], accX[4];
        {
            unsigned woff = (unsigned)((nb * 32 + r32) * 128 + 8 * hh); asm volatile("" : "+v"(woff));
            const bf16_t* wa = (const bf16_t*)(ws + WS_WAT) + (size_t)(dir * 10 + hb) * 128 * 128;
            const bf16_t* wx = (const bf16_t*)(ws + WS_WXT) + (size_t)(dir * 10 + hb) * 128 * 128;
            bf16x8 bfa[8], bfx[8];
#pragma unroll
            for (int k = 0; k < 8; ++k) { bfa[k] = *(const bf16x8*)(wa + woff + k * 16); bfx[k] = *(const bf16x8*)(wx + woff + k * 16); }
#pragma unroll
            for (int mb = 0; mb < 4; ++mb) {
                accA[mb] = f32x16{}; accX[mb] = f32x16{};
#pragma unroll
                for (int k = 0; k < 8; ++k) {
                    const bf16x8 af = *(const LAS bf16x8*)(xcA + (mb * 32 + r32) * XC_LD + k * 16 + 8 * hh);
                    accA[mb] = __builtin_amdgcn_mfma_f32_32x32x16_bf16(af, bfa[k], accA[mb], 0, 0, 0);
                    accX[mb] = __builtin_amdgcn_mfma_f32_32x32x16_bf16(af, bfx[k], accX[mb], 0, 0, 0);
                }
            }
        }
        __builtin_amdgcn_sched_barrier(0);
        {
            const float ba = a.in[19][dir * DRNN + ch], bx = a.in[21][dir * DRNN + ch], lam = a.in[22][dir * DRNN + ch];
            const float sp8l = -8.f * 1.4426950408889634f * log1pf(__expf(-lam)), nba = -1.4426950408889634f * ba, nbx = -1.4426950408889634f * bx;
#pragma unroll
            for (int mb = 0; mb < 4; ++mb)
#pragma unroll
                for (int r = 0; r < 16; ++r) {
                    const int t = mb * 32 + (r & 3) + 8 * (r >> 2) + 4 * hh;
                    const float xv = bf2f(xcA[t * XC_LD + nb * 32 + r32]);
                    const float rg = __builtin_amdgcn_rcpf(1.f + __builtin_amdgcn_exp2f(__builtin_fmaf(accA[mb][r], -1.4426950408889634f, nba)));
                    const float ig = __builtin_amdgcn_rcpf(1.f + __builtin_amdgcn_exp2f(__builtin_fmaf(accX[mb][r], -1.4426950408889634f, nbx)));
                    const float av = __builtin_amdgcn_exp2f(rg * sp8l);
                    const float om = fmaxf(__builtin_fmaf(-av, av, 1.f), 0.f);
                    accA[mb][r] = av; accX[mb][r] = __builtin_amdgcn_sqrtf(om) * ig * xv;
                    if ((r & 3) == 3) __builtin_amdgcn_sched_barrier(0);
                }
        }
        __builtin_amdgcn_sched_barrier(0);
        float h = h0;
        float Atot = 1.f; float cin[16];
#define RG_COMPOSITE(q) const int mb = (q) >> 2, rg = ((q) & 3) * 4; \
            const float a0 = accA[mb][rg], a1 = accA[mb][rg + 1], a2 = accA[mb][rg + 2], a3 = accA[mb][rg + 3]; \
            const float u0 = accX[mb][rg], u1 = accX[mb][rg + 1], u2 = accX[mb][rg + 2], u3 = accX[mb][rg + 3]; \
            const float gA = (a0 * a1) * (a2 * a3); \
            const float gH = dir == 0 ? ((u0 * a1 + u1) * a2 + u2) * a3 + u3 : ((u3 * a2 + u2) * a1 + u1) * a0 + u0; \
            const auto ra = __builtin_amdgcn_permlane32_swap(__float_as_uint(gA), __float_as_uint(gA), false, false); \
            const auto rh = __builtin_amdgcn_permlane32_swap(__float_as_uint(gH), __float_as_uint(gH), false, false); \
            const float pA = __uint_as_float(hh == 0 ? ra[1] : ra[0]), pH = __uint_as_float(hh == 0 ? rh[1] : rh[0]); \
            const float EA = hh ? pA : gA, EH = hh ? pH : gH, OA = hh ? gA : pA, OH = hh ? gH : pH;
        if (dir == 0) {
#pragma unroll
            for (int q = 0; q < 16; ++q) { RG_COMPOSITE(q)
                const float hE = h; h = EA * h + EH; const float hO = h; h = OA * h + OH; Atot *= EA * OA; cin[q] = hh ? hO : hE; }
        } else {
#pragma unroll
            for (int q = 15; q >= 0; --q) { RG_COMPOSITE(q)
                const float hO = h; h = OA * h + OH; const float hE = h; h = EA * h + EH; Atot *= EA * OA; cin[q] = hh ? hO : hE; }
        }
#undef RG_COMPOSITE
        if (pass == 0) {
            if (hh == 0) { float* c = CARRY + (((size_t)(b * 2 + dir) * 66 + tl) * DRNN + ch) * 2; c[0] = Atot; c[1] = h; }
            __syncthreads();
            continue;
        }
#pragma unroll
        for (int q = 0; q < 16; ++q) {
            const int mb = q >> 2, rg = (q & 3) * 4; float hc = cin[q];
            if (dir == 0) {
#pragma unroll
                for (int e = 0; e < 4; ++e) { hc = accA[mb][rg + e] * hc + accX[mb][rg + e]; accA[mb][rg + e] = hc; }
            } else {
#pragma unroll
                for (int e = 3; e >= 0; --e) { hc = accA[mb][rg + e] * hc + accX[mb][rg + e]; accA[mb][rg + e] = hc; }
            }
        }
        if (dir == 0) {
#pragma unroll
            for (int mb = 0; mb < 4; ++mb)
#pragma unroll
                for (int r = 0; r < 16; ++r) { const int t = mb * 32 + (r & 3) + 8 * (r >> 2) + 4 * hh; HS[t * 128 + nb * 32 + r32] = accA[mb][r]; }
        }
        __syncthreads();
        if (dir == 1) {
#pragma unroll
            for (int mb = 0; mb < 4; ++mb)
#pragma unroll
                for (int r = 0; r < 16; ++r) { const int t = mb * 32 + (r & 3) + 8 * (r >> 2) + 4 * hh; HS[t * 128 + nb * 32 + r32] += accA[mb][r]; }
        }
        __syncthreads();
        {
            const int t = tid >> 2, cs = (tid & 3) * 32, g = row0 + t;
            const bf16_t* gp = GG + (size_t)g * DRNN + hb * 128 + cs; bf16_t* yp = YG + (size_t)g * DRNN + hb * 128 + cs;
#pragma unroll
            for (int c8 = 0; c8 < 32; c8 += 8) {
                const u32x4 gw = *(const u32x4*)(gp + c8);
                const f32x4 h0 = *(const LAS f32x4*)(HS + t * 128 + cs + c8), h1 = *(const LAS f32x4*)(HS + t * 128 + cs + c8 + 4);
                u32x4 o; o.x = pk2(h0.x * bflo(gw.x), h0.y * bfhi(gw.x)); o.y = pk2(h0.z * bflo(gw.y), h0.w * bfhi(gw.y));
                o.z = pk2(h1.x * bflo(gw.z), h1.y * bfhi(gw.z)); o.w = pk2(h1.z * bflo(gw.w), h1.w * bfhi(gw.w));
                *(u32x4*)(yp + c8) = o;
            }
        }
        __syncthreads();
    }
}

namespace pg8 {
constexpr int BM = 256, BK = 64, HALF = 128, HTB = HALF * BK * 2, STAGE_BYTES = 8 * HTB, NXCD = 8, WGM = 8;
__host__ __device__ __forceinline__ int lds_byte(int r, int c) { const int st = (r >> 4) * 2 + (c >> 5), rr = r & 15, cc = c & 31, ob = rr * 64 + cc * 2; return st * 1024 + (ob ^ (((ob >> 9) & 1) << 5)); }
__host__ __device__ __forceinline__ void stage_rc(int b, int& R, int& C) { const int st = b / 1024, sb = b % 1024, swz = sb ^ (((sb >> 9) & 1) << 5); R = (st >> 1) * 16 + swz / 64; C = (st & 1) * 32 + (swz % 64) / 2; }
__host__ __device__ __forceinline__ int perm32(int rho) { const int n = rho >> 4, i = rho & 15; return 8 * (i >> 2) + 4 * n + (i & 3); }
struct Unit { int pm, pn; };
struct Gemm { const bf16_t* A; const bf16_t* Bt; int M, N, K; };
struct StaticOrder {
    int nM, nN, nwg, G, c;
    __host__ __device__ void init(int M, int N, int G_, int c_) { nM = M / BM; nN = N / BM; nwg = nM * nN; G = G_; c = c_; }
    __host__ __device__ bool next(int i, Unit& u) const {
        const long L = (long)i * G + c; if (L >= nwg) return false;
        int wgid = (int)L; { const int q = nwg / NXCD, r = nwg % NXCD, xcd = wgid % NXCD, off = wgid / NXCD; wgid = (xcd < r ? xcd * (q + 1) : r * (q + 1) + (xcd - r) * q) + off; }
        const int nig = WGM * nN, gid = wgid / nig, fm = gid * WGM, gsz = (nM - fm) < WGM ? (nM - fm) : WGM;
        u.pm = fm + ((wgid % nig) % gsz); u.pn = (wgid % nig) / gsz; return true;
    }
    __device__ __forceinline__ void a_ready(const Unit&) const {}
    __device__ __forceinline__ void done(const Unit&) const {}
};
struct LatentOrder {
    StaticOrder S;
    __host__ __device__ void init(int N, int G_, int c_) { S.init(16384, N, G_, c_); }
    __host__ __device__ bool next(int i, Unit& u) const { if (!S.next(i, u)) return false; u.pm = u.pm + 1 + (u.pm >= 32 ? 1 : 0); return true; }
    __device__ __forceinline__ void a_ready(const Unit&) const {}
    __device__ __forceinline__ void done(const Unit&) const {}
};
__device__ __forceinline__ unsigned cvt_pk_bf16(float lo, float hi) { unsigned r; asm volatile("v_cvt_pk_bf16_f32 %0, %1, %2" : "=v"(r) : "v"(lo), "v"(hi)); return r; }
__device__ __forceinline__ u32x4 pack8(const f32x4& v0, const f32x4& v1) { u32x4 w; w.x = cvt_pk_bf16(v0[0], v0[1]); w.y = cvt_pk_bf16(v0[2], v0[3]); w.z = cvt_pk_bf16(v1[0], v1[1]); w.w = cvt_pk_bf16(v1[2], v1[3]); return w; }
__device__ __forceinline__ f32x4 gelu4(const f32x4& v) { f32x4 r; r.x = gelu_t(v.x); r.y = gelu_t(v.y); r.z = gelu_t(v.z); r.w = gelu_t(v.w); return r; }

struct EpiStore {
    static constexpr bool PERM = true, AFTER_DRAIN = false;
    bf16_t* O1; bf16_t* O2; int ld; int split_tile; int gelu_tiles;
    __device__ __forceinline__ void operator()(f32x4 (&acc)[2][2][4][2], const Unit& u, int wr, int wc, int fr, int fq) const {
        const bool second = u.pn >= split_tile; bf16_t* base = second ? O2 : O1; const int pnl = second ? u.pn - split_tile : u.pn; const bool dog = u.pn < gelu_tiles;
        const int rl0 = wr * 64 + fr, cl0 = wc * 32 + 8 * fq;
#pragma unroll
        for (int ai = 0; ai < 2; ++ai)
#pragma unroll
            for (int m = 0; m < 4; ++m) { bf16_t* rowp = base + (size_t)(u.pm * BM + ai * HALF + m * 16 + rl0) * ld + pnl * BM + cl0;
#pragma unroll
                for (int bj = 0; bj < 2; ++bj) { f32x4 v0 = acc[ai][bj][m][0], v1 = acc[ai][bj][m][1]; if (dog) { v0 = gelu4(v0); v1 = gelu4(v1); }
                    *(u32x4*)(rowp + bj * HALF) = pack8(v0, v1); } }
    }
};
struct EpiPeerQ {
    static constexpr bool PERM = true, AFTER_DRAIN = false;
    bf16_t* QP; const bf16_t* KEYS; int* SELI; float* SELG;
    __device__ __forceinline__ void operator()(f32x4 (&acc)[2][2][4][2], const Unit& u, int wr, int wc, int fr, int fq) const {
        { int rl0 = wr * 64 + fr, cl0 = wc * 32 + 8 * fq; asm volatile("" : "+v"(rl0), "+v"(cl0));
#pragma unroll
          for (int ai = 0; ai < 2; ++ai)
#pragma unroll
            for (int m = 0; m < 4; ++m) { bf16_t* rowp = QP + (size_t)(u.pm * BM + ai * HALF + m * 16 + rl0) * 2048 + u.pn * BM + cl0;
#pragma unroll
                for (int bj = 0; bj < 2; ++bj) *(u32x4*)(rowp + bj * HALF) = pack8(acc[ai][bj][m][0], acc[ai][bj][m][1]); } }
        asm volatile("s_waitcnt vmcnt(0)" ::: "memory");
        __builtin_amdgcn_fence(__ATOMIC_RELEASE, "workgroup"); __builtin_amdgcn_s_barrier(); __builtin_amdgcn_fence(__ATOMIC_ACQUIRE, "workgroup");
        int lane = fq * 16 + fr; asm volatile("" : "+v"(lane));
        topk_item(QP, KEYS, SELI, SELG, u.pm * BM + (wr * 4 + wc) * 32, u.pn, lane & 31, lane >> 5);
    }
};
struct EpiResid {
    static constexpr bool PERM = true, AFTER_DRAIN = false;
    const float* x; const float* ctx; const float* modbase; float* X1; int base_mode;
    __device__ __forceinline__ void operator()(f32x4 (&acc)[2][2][4][2], const Unit& u, int wr, int wc, int fr, int fq) const {
        const int b = u.pm / 33, tl = u.pm % 33, var = tl == 0 ? 2 : b;
        const float* gate = modbase + (size_t)var * 6144 + u.pn * BM;
        const float* basep = base_mode == 0 ? (tl == 0 ? ctx + (size_t)b * CTXL * D : x + ((size_t)b * SEQ + (size_t)(tl - 1) * 256) * D) : X1 + (size_t)u.pm * BM * D;
        float* outp = X1 + (size_t)u.pm * BM * D;
        const int rl0 = wr * 64 + fr, cl0 = u.pn * BM + wc * 32 + 8 * fq;
        f32x4 gv[2][2];
#pragma unroll
        for (int bj = 0; bj < 2; ++bj)
#pragma unroll
            for (int n = 0; n < 2; ++n) gv[bj][n] = *(const f32x4*)(gate + bj * HALF + wc * 32 + 8 * fq + 4 * n);
#pragma unroll
        for (int ai = 0; ai < 2; ++ai)
#pragma unroll
            for (int m = 0; m < 4; ++m) { const size_t off = (size_t)(ai * HALF + m * 16 + rl0) * D + cl0;
#pragma unroll
                for (int bj = 0; bj < 2; ++bj)
#pragma unroll
                    for (int n = 0; n < 2; ++n) { const f32x4 bs = *(const f32x4*)(basep + off + bj * HALF + 4 * n); *(f32x4*)(outp + off + bj * HALF + 4 * n) = bs + gv[bj][n] * acc[ai][bj][m][n]; } }
    }
};
struct EpiInproj0 {
    static constexpr bool PERM = true, AFTER_DRAIN = false;
    unsigned char* ws; const float* gmg; const float* qg; const float* kg; LAS float* P;
    __device__ __forceinline__ void operator()(f32x4 (&acc)[2][2][4][2], const Unit& u, int wr, int wc, int fr, int fq) const {
        int rl0 = wr * 64 + fr, cl0 = wc * 32 + 8 * fq; asm volatile("" : "+v"(rl0), "+v"(cl0));
        const int pn = u.pn; const size_t grow0 = (size_t)u.pm * BM;
        if (pn < 4) {
#pragma unroll
            for (int ai = 0; ai < 2; ++ai)
#pragma unroll
                for (int bj = 0; bj < 2; ++bj)
#pragma unroll
                    for (int m = 0; m < 4; ++m) { acc[ai][bj][m][0] = gelu4(acc[ai][bj][m][0]); acc[ai][bj][m][1] = gelu4(acc[ai][bj][m][1]); __builtin_amdgcn_sched_barrier(0); }
        }
        if (pn < 2 || pn == 7) {
            bf16_t* base = pn < 2 ? (bf16_t*)(ws + WS_U) + pn * BM : (bf16_t*)(ws + WS_V); const int ld = pn < 2 ? 512 : 256;
#pragma unroll
            for (int ai = 0; ai < 2; ++ai)
#pragma unroll
                for (int m = 0; m < 4; ++m) { bf16_t* rowp = base + (grow0 + ai * HALF + m * 16 + rl0) * ld + cl0;
#pragma unroll
                    for (int bj = 0; bj < 2; ++bj) *(u32x4*)(rowp + bj * HALF) = pack8(acc[ai][bj][m][0], acc[ai][bj][m][1]); }
            return;
        }
#pragma unroll
        for (int ai = 0; ai < 2; ++ai)
#pragma unroll
            for (int m = 0; m < 4; ++m)
#pragma unroll
                for (int bj = 0; bj < 2; ++bj) { const f32x4 a0 = acc[ai][bj][m][0], a1 = acc[ai][bj][m][1];
                    float s = (a0.x * a0.x + a0.y * a0.y) + (a0.z * a0.z + a0.w * a0.w) + (a1.x * a1.x + a1.y * a1.y) + (a1.z * a1.z + a1.w * a1.w);
                    s += __shfl_xor(s, 16); s += __shfl_xor(s, 32);
                    if (fq == 0) P[((ai * HALF + m * 16 + rl0) * 2 + bj) * 4 + wc] = s; __builtin_amdgcn_sched_barrier(0); }
        asm volatile("s_waitcnt lgkmcnt(0)" ::: "memory"); __builtin_amdgcn_s_barrier(); asm volatile("" ::: "memory");
        if (pn < 4) {
            bf16_t* base = (bf16_t*)(ws + WS_VV) + (pn - 2) * BM; const float* gp = gmg + (pn - 2) * BM + cl0;
            f32x4 g8[2][2];
#pragma unroll
            for (int bj = 0; bj < 2; ++bj) { g8[bj][0] = *(const f32x4*)(gp + bj * HALF); g8[bj][1] = *(const f32x4*)(gp + bj * HALF + 4); }
#pragma unroll
            for (int ai = 0; ai < 2; ++ai)
#pragma unroll
                for (int m = 0; m < 4; ++m) { const int rl = ai * HALF + m * 16 + rl0; bf16_t* rowp = base + (grow0 + rl) * 512 + cl0;
#pragma unroll
                    for (int bj = 0; bj < 2; ++bj) { const f32x4 p = *(const LAS f32x4*)(P + (rl * 2 + bj) * 4);
                        const float rinv = rsqrtf(((p.x + p.y) + (p.z + p.w)) * (1.f / 128.f) + EPS);
                        *(u32x4*)(rowp + bj * HALF) = pack8(acc[ai][bj][m][0] * rinv * g8[bj][0], acc[ai][bj][m][1] * rinv * g8[bj][1]); }
                    asm volatile("" ::: "memory"); __builtin_amdgcn_sched_barrier(0); }
            return;
        }
        {
            const bool isq = pn < 6; const float* gn = isq ? qg : kg;
            const int grp = cl0 >> 3, fo = (grp >> 3) * 64 + (grp & 7) * 4;
            const f32x4 gA = *(const f32x4*)(gn + fo), gB = *(const f32x4*)(gn + fo + 32);
            bf16_t* base = isq ? (bf16_t*)(ws + WS_Q) + (pn - 4) * BM : (bf16_t*)(ws + WS_K); const int ld = isq ? 512 : 256;
            const int tl = u.pm % 33; const bool lat = tl != 0; const int ax = grp >> 3, f0 = (grp & 7) * 4;
            const float* rope = (const float*)(ws + WS_ROPE);
#pragma unroll
            for (int ai = 0; ai < 2; ++ai)
#pragma unroll
                for (int m = 0; m < 4; ++m) { const int rl = ai * HALF + m * 16 + rl0; bf16_t* rowp = base + (grow0 + rl) * ld + cl0;
                    f32x4 cs0 = {1.f, 0.f, 1.f, 0.f}, cs1 = {1.f, 0.f, 1.f, 0.f};
                    if (lat) { const int t = (tl - 1) * 256 + rl; const int pos = ax == 0 ? (t >> 6) : (t & 63); const float* rp = rope + (pos * 32 + f0) * 2; cs0 = *(const f32x4*)rp; cs1 = *(const f32x4*)(rp + 4); }
#pragma unroll
                    for (int bj = 0; bj < 2; ++bj) { const f32x4 p = *(const LAS f32x4*)(P + (rl * 2 + bj) * 4);
                        const float rinv = rsqrtf(((p.x + p.y) + (p.z + p.w)) * (1.f / 128.f) + EPS);
                        const f32x4 x1 = acc[ai][bj][m][0] * rinv * gA, x2 = acc[ai][bj][m][1] * rinv * gB;
                        f32x4 o1, o2;
                        o1.x = x1.x * cs0.x - x2.x * cs0.y; o2.x = x2.x * cs0.x + x1.x * cs0.y;
                        o1.y = x1.y * cs0.z - x2.y * cs0.w; o2.y = x2.y * cs0.z + x1.y * cs0.w;
                        o1.z = x1.z * cs1.x - x2.z * cs1.y; o2.z = x2.z * cs1.x + x1.z * cs1.y;
                        o1.w = x1.w * cs1.z - x2.w * cs1.w; o2.w = x2.w * cs1.z + x1.w * cs1.w;
                        *(u32x4*)(rowp + bj * HALF) = pack8(o1, o2); }
                    asm volatile("" ::: "memory"); __builtin_amdgcn_sched_barrier(0); }
        }
    }
};

template <class Epi, class Sched, bool ALIGN_EPI = false, bool SP2 = false>
__device__ __forceinline__ void gemm_phase(LAS unsigned char* lds, const Gemm g, const Sched& S, const Epi& E) {
    const int tid = threadIdx.x, wid = __builtin_amdgcn_readfirstlane(tid >> 6), lane = tid & 63, wr = wid >> 2, wc = wid & 3, fr = lane & 15, fq = lane >> 4;
    const int K = g.K, nt = K / BK;
    unsigned voffA[2], voffB[2];
#pragma unroll
    for (int i = 0; i < 2; ++i) { int R, C; stage_rc(tid * 16 + i * 8192, R, C); const int Rb = Epi::PERM ? ((R & ~31) + perm32(R & 31)) : R;
        voffA[i] = (unsigned)(R * K + C) * 2u; voffB[i] = (unsigned)(Rb * K + C) * 2u; }
    const size_t kstep = (size_t)(BK * 2);
    const size_t hstep = (size_t)HALF * K * 2;
    const size_t tstep = 2 * hstep;
    const unsigned ldsw = (unsigned)wid * 1024u;
    const int aoff = lds_byte(wr * 64 + fr, fq * 8), boff = lds_byte(wc * 32 + fr, fq * 8);
#define PG8_SA(b, h) (((b) * 2 + (h)) * HTB)
#define PG8_SB(b, h) ((4 + (b) * 2 + (h)) * HTB)
#define PG8_STAGE(bufoff, gbase, voff) do { _Pragma("unroll") for (int _i = 0; _i < 2; ++_i) \
        __builtin_amdgcn_global_load_lds((const unsigned*)((const char*)(gbase) + (voff)[_i]), (LAS unsigned*)(lds + (bufoff) + ldsw + _i * 8192), 16, 0, 0); } while (0)
#define PG8_LDA(dst, b, h) do { _Pragma("unroll") for (int m = 0; m < 4; ++m) _Pragma("unroll") for (int k = 0; k < 2; ++k) dst[m][k] = *(const LAS bf16x8*)(lds + PG8_SA(b, h) + aoff + m * 2048 + k * 1024); } while (0)
#define PG8_LDB(dst, b, h) do { _Pragma("unroll") for (int n = 0; n < 2; ++n) _Pragma("unroll") for (int k = 0; k < 2; ++k) dst[n][k] = *(const LAS bf16x8*)(lds + PG8_SB(b, h) + boff + n * 2048 + k * 1024); } while (0)
#define PG8_MMA(ai, bj, At, Bt) do { __builtin_amdgcn_s_setprio(1); _Pragma("unroll") for (int m = 0; m < 4; ++m) _Pragma("unroll") for (int n = 0; n < 2; ++n) _Pragma("unroll") for (int k = 0; k < 2; ++k) \
        acc[ai][bj][m][n] = __builtin_amdgcn_mfma_f32_16x16x32_bf16(Bt[n][k], At[m][k], acc[ai][bj][m][n], 0, 0, 0); __builtin_amdgcn_s_setprio(0); } while (0)
#define PG8_WAIT_V(n) asm volatile("s_waitcnt vmcnt(" #n ")" ::: "memory")
#define PG8_WAIT_L(n) asm volatile("s_waitcnt lgkmcnt(" #n ")" ::: "memory")
#define PG8_BAR __builtin_amdgcn_s_barrier()
#define PG8_SCHED __builtin_amdgcn_sched_barrier(0)
    Unit cur, nxt; int ui = 0;
    if (!S.next(0, cur)) return;
    f32x4 acc[2][2][4][2];
#pragma unroll
    for (int a = 0; a < 2; ++a)
#pragma unroll
        for (int b = 0; b < 2; ++b)
#pragma unroll
            for (int m = 0; m < 4; ++m)
#pragma unroll
                for (int n = 0; n < 2; ++n) acc[a][b][m][n] = (f32x4){0.f, 0.f, 0.f, 0.f};
    bf16x8 At[4][2], B0[2][2], B1[2][2];
    const char* cA = (const char*)g.A + (size_t)cur.pm * tstep; const char* cB = (const char*)g.Bt + (size_t)cur.pn * tstep;
    S.a_ready(cur);
    if constexpr (SP2) {
        PG8_STAGE(PG8_SB(0, 0), cB, voffB); PG8_STAGE(PG8_SB(0, 1), cB + hstep, voffB); PG8_STAGE(PG8_SA(0, 0), cA, voffA); PG8_STAGE(PG8_SA(0, 1), cA + hstep, voffA);
        if (wr == 1) PG8_BAR;
        PG8_WAIT_V(2); PG8_BAR;
        PG8_STAGE(PG8_SB(1, 0), cB + kstep, voffB); PG8_STAGE(PG8_SA(1, 0), cA + kstep, voffA); PG8_STAGE(PG8_SB(1, 1), cB + hstep + kstep, voffB);
        PG8_WAIT_V(6); PG8_BAR;
    } else {
        PG8_STAGE(PG8_SB(0, 0), cB, voffB); PG8_STAGE(PG8_SA(0, 0), cA, voffA); PG8_STAGE(PG8_SB(0, 1), cB + hstep, voffB); PG8_STAGE(PG8_SA(0, 1), cA + hstep, voffA);
        if (wr == 1) PG8_BAR;
        PG8_WAIT_V(4); PG8_BAR;
        PG8_STAGE(PG8_SB(1, 0), cB + kstep, voffB); PG8_STAGE(PG8_SA(1, 0), cA + kstep, voffA); PG8_STAGE(PG8_SB(1, 1), cB + hstep + kstep, voffB);
        PG8_WAIT_V(6); PG8_BAR;
    }
    for (;;) {
        const bool has_next = S.next(ui + 1, nxt);
        const char* nA = has_next ? (const char*)g.A + (size_t)nxt.pm * tstep : cA; const char* nB = has_next ? (const char*)g.Bt + (size_t)nxt.pn * tstep : cB;
        for (int t = 0; t < nt; t += 2) {
            const bool last = (t == nt - 2);
            const char* a1 = cA + (size_t)(t + 1) * kstep;
            const char* a2 = last ? nA : cA + (size_t)(t + 2) * kstep; const char* b2 = last ? nB : cB + (size_t)(t + 2) * kstep;
            const char* a3 = a2 + kstep; const char* b3 = b2 + kstep;
            if (last && has_next) S.a_ready(nxt);
            if constexpr (SP2) {
            PG8_LDB(B0, 0, 0); PG8_LDB(B1, 0, 1); PG8_SCHED; PG8_LDA(At, 0, 0); PG8_STAGE(PG8_SA(1, 1), a1 + hstep, voffA);
            PG8_WAIT_V(8); PG8_WAIT_L(0); PG8_BAR; PG8_MMA(0, 0, At, B0); PG8_MMA(0, 1, At, B1); PG8_BAR; PG8_SCHED;
            PG8_LDA(At, 0, 1); PG8_STAGE(PG8_SB(0, 0), b2, voffB); PG8_STAGE(PG8_SB(0, 1), b2 + hstep, voffB); PG8_STAGE(PG8_SA(0, 0), a2, voffA);
            PG8_WAIT_V(8); PG8_WAIT_L(0); PG8_BAR; PG8_MMA(1, 0, At, B0); PG8_MMA(1, 1, At, B1); PG8_BAR; PG8_SCHED;
            PG8_LDB(B0, 1, 0); PG8_LDB(B1, 1, 1); PG8_SCHED; PG8_LDA(At, 1, 0); PG8_STAGE(PG8_SA(0, 1), a2 + hstep, voffA);
            PG8_WAIT_V(8); PG8_WAIT_L(0); PG8_BAR; PG8_MMA(0, 0, At, B0); PG8_MMA(0, 1, At, B1); PG8_BAR; PG8_SCHED;
            PG8_LDA(At, 1, 1); PG8_STAGE(PG8_SB(1, 0), b3, voffB); PG8_STAGE(PG8_SB(1, 1), b3 + hstep, voffB); PG8_STAGE(PG8_SA(1, 0), a3, voffA);
            PG8_WAIT_V(8); PG8_WAIT_L(0); PG8_BAR; PG8_MMA(1, 0, At, B0); PG8_MMA(1, 1, At, B1); PG8_BAR; PG8_SCHED;
            } else {
            PG8_LDB(B0, 0, 0); PG8_SCHED; PG8_LDA(At, 0, 0); PG8_STAGE(PG8_SA(1, 1), a1 + hstep, voffA);
            PG8_WAIT_L(8); PG8_BAR; PG8_WAIT_L(0); PG8_MMA(0, 0, At, B0); PG8_BAR; PG8_SCHED;
            PG8_LDB(B1, 0, 1); PG8_STAGE(PG8_SB(0, 0), b2, voffB);
            PG8_BAR; PG8_WAIT_L(0); PG8_MMA(0, 1, At, B1); PG8_BAR;
            PG8_LDA(At, 0, 1); PG8_STAGE(PG8_SA(0, 0), a2, voffA);
            PG8_BAR; PG8_WAIT_L(0); PG8_MMA(1, 0, At, B0); PG8_BAR; PG8_SCHED;
            PG8_STAGE(PG8_SB(0, 1), b2 + hstep, voffB);
            PG8_WAIT_V(6); PG8_BAR; PG8_MMA(1, 1, At, B1); PG8_BAR;
            PG8_LDB(B0, 1, 0); PG8_SCHED; PG8_LDA(At, 1, 0); PG8_STAGE(PG8_SA(0, 1), a2 + hstep, voffA);
            PG8_WAIT_L(8); PG8_BAR; PG8_WAIT_L(0); PG8_MMA(0, 0, At, B0); PG8_BAR; PG8_SCHED;
            PG8_LDB(B1, 1, 1); PG8_STAGE(PG8_SB(1, 0), b3, voffB);
            PG8_BAR; PG8_WAIT_L(0); PG8_MMA(0, 1, At, B1); PG8_BAR;
            PG8_LDA(At, 1, 1); PG8_STAGE(PG8_SA(1, 0), a3, voffA);
            PG8_BAR; PG8_WAIT_L(0); PG8_MMA(1, 0, At, B0); PG8_BAR; PG8_SCHED;
            PG8_STAGE(PG8_SB(1, 1), b3 + hstep, voffB);
            PG8_WAIT_V(6); PG8_BAR; PG8_MMA(1, 1, At, B1); PG8_BAR;
            }
        }
        if constexpr (ALIGN_EPI) { if (wr == 0) PG8_BAR; }
        if constexpr (!Epi::AFTER_DRAIN) { E(acc, cur, wr, wc, fr, fq); S.done(cur); }
        if (!has_next) break;
#pragma unroll
        for (int a = 0; a < 2; ++a)
#pragma unroll
            for (int b = 0; b < 2; ++b)
#pragma unroll
                for (int m = 0; m < 4; ++m)
#pragma unroll
                    for (int n = 0; n < 2; ++n) acc[a][b][m][n] = (f32x4){0.f, 0.f, 0.f, 0.f};
        cur = nxt; cA = nA; cB = nB; ++ui;
        if constexpr (ALIGN_EPI) { if (wr == 1) PG8_BAR; }
    }
    PG8_WAIT_V(0);
    if constexpr (!ALIGN_EPI) { if (wr == 0) PG8_BAR; }
    PG8_BAR;
#undef PG8_SA
#undef PG8_SB
#undef PG8_STAGE
#undef PG8_LDA
#undef PG8_LDB
#undef PG8_MMA
#undef PG8_WAIT_V
#undef PG8_WAIT_L
#undef PG8_BAR
#undef PG8_SCHED
}
}

__device__ __forceinline__ void fphase_inproj0(const Args& a, char* lds) {
    pg8::Gemm g{(const bf16_t*)(a.ws + WS_H), (const bf16_t*)(a.ws + WS_WIN0), MTOT, 2048, 1024};
    pg8::StaticOrder S; S.init(MTOT, 2048, (int)gridDim.x, (int)blockIdx.x);
    pg8::EpiInproj0 E{a.ws, a.in[9], a.in[12], a.in[13], (LAS float*)((LAS char*)lds + 131072)};
    pg8::gemm_phase<pg8::EpiInproj0, pg8::StaticOrder, true, true>((LAS unsigned char*)lds, g, S, E);
    const int G = (int)gridDim.x, nbusy = 528 - 2 * G;
    if (G == 256 && (int)blockIdx.x >= nbusy) quant_tables(a, 1, ((int)blockIdx.x - nbusy) * NWAVE + (int)(threadIdx.x >> 6), (G - nbusy) * NWAVE, (int)(threadIdx.x & 63));
    else if (G != 256) quant_tables(a, 1, (int)blockIdx.x * NWAVE + (int)(threadIdx.x >> 6), G * NWAVE, (int)(threadIdx.x & 63));
}
__device__ __forceinline__ void fphase_outproj0(const Args& a, char* lds) {
    pg8::Gemm g{(const bf16_t*)(a.ws + WS_AO), (const bf16_t*)(a.ws + WS_WOUT0), MTOT, 1024, 1024};
    pg8::StaticOrder S; S.init(MTOT, 1024, (int)gridDim.x, (int)blockIdx.x);
    pg8::EpiResid E{a.in[0], a.in[2], (const float*)(a.ws + WS_MODV) + 2 * 1024, (float*)(a.ws + WS_X1), 0};
    pg8::gemm_phase<pg8::EpiResid, pg8::StaticOrder, true, true>((LAS unsigned char*)lds, g, S, E);
    const int G = (int)gridDim.x, nbusy = (G == 256) ? 264 - G : 0;
    if ((int)blockIdx.x >= nbusy) for (int r = (int)blockIdx.x - nbusy; r < N_L1_ITEMS; r += G - nbusy) prep_l1_item(a, (float*)lds, r);
}
__device__ __forceinline__ void fphase_peerq0(const Args& a, char* lds) {
    pg8::Gemm g{(const bf16_t*)(a.ws + WS_H), (const bf16_t*)(a.ws + WS_WQ), MTOT, 2048, 1024};
    pg8::StaticOrder S; S.init(MTOT, 2048, (int)gridDim.x, (int)blockIdx.x);
    pg8::EpiStore E{(bf16_t*)(a.ws + WS_QP), (bf16_t*)(a.ws + WS_QP), 2048, 1000, 0};
    pg8::gemm_phase<pg8::EpiStore, pg8::StaticOrder, true, true>((LAS unsigned char*)lds, g, S, E);
}
__device__ __forceinline__ void fphase_inproj1(const Args& a, char* lds) {
    pg8::Gemm g{(const bf16_t*)(a.ws + WS_H), (const bf16_t*)(a.ws + WS_WIN1), MTOT, 2560, 1024};
    pg8::StaticOrder S; S.init(MTOT, 2560, (int)gridDim.x, (int)blockIdx.x);
    pg8::EpiStore E{(bf16_t*)(a.ws + WS_GG), (bf16_t*)(a.ws + WS_XR), 1280, 5, 5};
    pg8::gemm_phase<pg8::EpiStore, pg8::StaticOrder, true, true>((LAS unsigned char*)lds, g, S, E);
}
__device__ __forceinline__ void fphase_outproj1(const Args& a, char* lds) {
    pg8::Gemm g{(const bf16_t*)(a.ws + WS_YG), (const bf16_t*)(a.ws + WS_WOUT1), MTOT, 1024, 1280};
    pg8::LatentOrder S; S.init(1024, (int)gridDim.x, (int)blockIdx.x);
    pg8::EpiResid E{a.in[0], a.in[2], (const float*)(a.ws + WS_MODV) + 3 * 6144 + 2 * 1024, (float*)(a.ws + WS_X1), 1};
    pg8::gemm_phase<pg8::EpiResid, pg8::LatentOrder, true, true>((LAS unsigned char*)lds, g, S, E);
}
__device__ __forceinline__ void fphase_peerq1(const Args& a, char* lds) {
    pg8::Gemm g{(const bf16_t*)(a.ws + WS_H), (const bf16_t*)(a.ws + WS_WQ) + (size_t)2048 * 1024, MTOT, 2048, 1024};
    pg8::LatentOrder S; S.init(2048, (int)gridDim.x, (int)blockIdx.x);
    pg8::EpiStore E{(bf16_t*)(a.ws + WS_QP), (bf16_t*)(a.ws + WS_QP), 2048, 1000, 0};
    pg8::gemm_phase<pg8::EpiStore, pg8::LatentOrder, true, true>((LAS unsigned char*)lds, g, S, E);
}

constexpr int NPHASE = 23;
__global__ void __launch_bounds__(NTHR, 2) mega(Args a) {
    extern __shared__ __attribute__((aligned(16))) char lds[];
    volatile LAS unsigned* MISC = (volatile LAS unsigned*)((LAS char*)lds + LDS_MISC);
    if (threadIdx.x < 64) MISC[threadIdx.x] = 0u;
    __syncthreads();
    XcdBarrier bar; bar.bar = (unsigned*)(a.ws + WS_CTL) + 4096; bar.x = 0; bar.st = nullptr;
    const bool multi = (a.ph_hi - a.ph_lo) > 1;
    if (multi) bar = xcd_barrier_post((unsigned*)(a.ws + WS_CTL) + 4096, MISC + 8);
    const int lo = a.ph_lo, hi = a.ph_hi;
    unsigned char* ws = a.ws;
#define IN(k) (lo <= (k) && (k) < hi)
#define SEAM(k) do { if (IN(k) && IN((k) + 1)) xcd_barrier(bar); } while (0)
#ifndef PROBE_DUP
#define PROBE_DUP 0u
#endif
#define DUPQ(k) (((PROBE_DUP >> (k)) & 1u) != 0u)
    if (IN(0)) { phase_prep(a, lds); if (DUPQ(0)) { xcd_barrier(bar); phase_prep(a, lds); } } SEAM(0);
    if (IN(1)) { phase_norm(a, 0, 0, a.in[6], 0, 1, false); if (DUPQ(1)) { xcd_barrier(bar); phase_norm(a, 0, 0, a.in[6], 0, 1, false); } } SEAM(1);
    if (IN(2)) { fphase_inproj0(a, lds); if (DUPQ(2)) { xcd_barrier(bar); fphase_inproj0(a, lds); } } SEAM(2);
    if (IN(3)) { phase_gmlp2(a, lds); phase_attn(a, lds); if (DUPQ(3)) { xcd_barrier(bar); phase_gmlp2(a, lds); phase_attn(a, lds); } } SEAM(3);
    if (IN(4)) { fphase_outproj0(a, lds); if (DUPQ(4)) { xcd_barrier(bar); fphase_outproj0(a, lds); } } SEAM(4);
    if (IN(5)) { phase_norm(a, 0, 1, a.in[7], 3, 4, false, true); if (DUPQ(5)) { xcd_barrier(bar); phase_norm(a, 0, 1, a.in[7], 3, 4, false, true); } } SEAM(5);
    if (IN(6)) { fphase_peerq0(a, lds); if (DUPQ(6)) { xcd_barrier(bar); fphase_peerq0(a, lds); } } SEAM(6);
    if (IN(7)) { phase_peer_topk3(a, lds, 0, false); if (DUPQ(7)) { xcd_barrier(bar); phase_peer_topk3(a, lds, 0, false); } } SEAM(7);
    if (IN(8)) { phase_gu(a, lds, 0, 0); if (DUPQ(8)) { xcd_barrier(bar); phase_gu(a, lds, 0, 0); } } SEAM(8);
    if (IN(9)) { phase_gact(a, 0, 0); if (DUPQ(9)) { xcd_barrier(bar); phase_gact(a, 0, 0); } } SEAM(9);
    if (IN(10)) { phase_gv(a, lds, 0, 0); if (DUPQ(10)) { xcd_barrier(bar); phase_gv(a, lds, 0, 0); } } SEAM(10);
    if (IN(11)) { phase_norm(a, 1, 1, a.in[6] + D, 0, 1, false); if (DUPQ(11)) { xcd_barrier(bar); phase_norm(a, 1, 1, a.in[6] + D, 0, 1, false); } } SEAM(11);
    if (IN(12)) { fphase_inproj1(a, lds); if (DUPQ(12)) { xcd_barrier(bar); fphase_inproj1(a, lds); } } SEAM(12);
    if (IN(13)) { phase_rglru2(a, lds, 0); if (DUPQ(13)) { xcd_barrier(bar); phase_rglru2(a, lds, 0); } } SEAM(13);
    if (IN(14)) { phase_rglru2(a, lds, 1); if (DUPQ(14)) { xcd_barrier(bar); phase_rglru2(a, lds, 1); } } SEAM(14);
    if (IN(15)) { fphase_outproj1(a, lds); if (DUPQ(15)) { xcd_barrier(bar); fphase_outproj1(a, lds); } } SEAM(15);
    if (IN(16)) { phase_norm(a, 1, 1, a.in[7] + D, 3, 4, true, true); if (DUPQ(16)) { xcd_barrier(bar); phase_norm(a, 1, 1, a.in[7] + D, 3, 4, true, true); } } SEAM(16);
    if (IN(17)) { fphase_peerq1(a, lds); if (DUPQ(17)) { xcd_barrier(bar); fphase_peerq1(a, lds); } } SEAM(17);
    if (IN(18)) { phase_peer_topk3(a, lds, 1, true); if (DUPQ(18)) { xcd_barrier(bar); phase_peer_topk3(a, lds, 1, true); } } SEAM(18);
    if (IN(19)) { phase_gu(a, lds, 1, 1); if (DUPQ(19)) { xcd_barrier(bar); phase_gu(a, lds, 1, 1); } } SEAM(19);
    if (IN(20)) { phase_gact(a, 1, 1); if (DUPQ(20)) { xcd_barrier(bar); phase_gact(a, 1, 1); } } SEAM(20);
    if (IN(21)) { phase_gv(a, lds, 1, 1); if (DUPQ(21)) { xcd_barrier(bar); phase_gv(a, lds, 1, 1); } } SEAM(21);
    if (IN(22)) { phase_finalnorm(a); if (DUPQ(22)) { xcd_barrier(bar); phase_finalnorm(a); } }
#undef IN
#undef SEAM
}

extern "C" void kernel_launch(void* const* d_in, const int* in_sizes, int n_in, void* d_out, int out_size, void* d_ws, size_t ws_size, hipStream_t stream) {
    static int grid = 0;
    if (grid == 0) {
        if (n_in != 29 || out_size != NB * SEQ * D || ws_size < WS_END) {
            fprintf(stderr, "kernel_launch: unexpected shapes: n_in %d out %d ws %zu (need %zu)\n", n_in, out_size, ws_size, (size_t)WS_END); grid = -1; return; }
        int dev = 0, cus = 0, per_cu = 0;
        if (hipGetDevice(&dev) != hipSuccess || hipDeviceGetAttribute(&cus, hipDeviceAttributeMultiprocessorCount, dev) != hipSuccess) { grid = -1; return; }
        if (hipFuncSetAttribute((const void*)mega, hipFuncAttributeMaxDynamicSharedMemorySize, LDS_BYTES) != hipSuccess) { fprintf(stderr, "kernel_launch: hipFuncSetAttribute failed\n"); grid = -1; return; }
        if (hipOccupancyMaxActiveBlocksPerMultiprocessor(&per_cu, (const void*)mega, NTHR, LDS_BYTES) != hipSuccess || per_cu < 1)
            fprintf(stderr, "kernel_launch: occupancy query reports %d blocks per CU\n", per_cu);
        (void)hipGetLastError();
        grid = cus;
    }
    if (grid < 0) return;
    (void)hipMemsetAsync((char*)d_ws + WS_CTL, 0, CTL_BYTES, stream);
    Args a{};
    for (int i = 0; i < 29; ++i) a.in[i] = (const float*)d_in[i];
    a.out = (float*)d_out; a.ws = (unsigned char*)d_ws;
#if MK_SINGLE
    a.ph_lo = 0; a.ph_hi = NPHASE;
    hipLaunchKernelGGL(mega, dim3(grid), dim3(NTHR), LDS_BYTES, stream, a);
#else
    for (int p = 0; p < NPHASE; ++p) { a.ph_lo = p; a.ph_hi = p + 1; hipLaunchKernelGGL(mega, dim3(grid), dim3(NTHR), LDS_BYTES, stream, a); }
#endif
    const hipError_t le = hipPeekAtLastError();
    if (le != hipSuccess) fprintf(stderr, "kernel_launch: launch failed: %s\n", hipGetErrorName(le));
}
```

```cpp
#include <hip/hip_runtime.h>
#include <cstdio>
#include <cstdint>

#ifndef MK_SINGLE
#define MK_SINGLE 1
#endif

#define GAS __attribute__((address_space(1)))
#define LAS __attribute__((address_space(3)))

typedef unsigned short bf16_t;
typedef short bf16x8 __attribute__((ext_vector_type(8)));
typedef float f32x4 __attribute__((ext_vector_type(4)));
typedef float f32x16 __attribute__((ext_vector_type(16)));
typedef unsigned u32x4 __attribute__((ext_vector_type(4)));
typedef unsigned u32x2 __attribute__((ext_vector_type(2)));

constexpr int D = 1024, NB = 2, SEQ = 8192, CTXL = 256;
constexpr int RPB = SEQ + CTXL;
constexpr int MTOT = NB * RPB;
constexpr int AB_IN = 2048, A_W = 512, DRNN = 1280, NEXP = 16384;
constexpr float EPS = 1e-6f;
constexpr int NTHR = 512, NWAVE = 8;

constexpr size_t MiB = 1u << 20;
constexpr size_t WS_CTL = 0, CTL_BYTES = 1 * MiB;
constexpr size_t WS_MODV = 1 * MiB;
constexpr size_t WS_ROPE = 1 * MiB + 512 * 1024;
constexpr size_t WS_WIN0 = 2 * MiB;
constexpr size_t WS_WOUT0 = 6 * MiB;
constexpr size_t WS_WIN1 = 8 * MiB;
constexpr size_t WS_WOUT1 = 13 * MiB;
constexpr size_t WS_WQ = 16 * MiB;
constexpr size_t WS_KEYS = 24 * MiB;
constexpr size_t WS_GWS = 25 * MiB;
constexpr size_t WS_WAT = 26 * MiB;
constexpr size_t WS_WXT = 27 * MiB;
constexpr size_t WS_CARRY = 28 * MiB;
constexpr size_t WS_SCU = 31 * MiB;
constexpr size_t WS_SCV = 31 * MiB + 512 * 1024;
constexpr size_t WS_PU = 32 * MiB;
constexpr size_t WS_PV = 96 * MiB;
constexpr size_t WS_H = 160 * MiB;
constexpr size_t WS_X1 = 193 * MiB;
constexpr size_t WS_SELI = 259 * MiB;
constexpr size_t WS_SELG = 268 * MiB;
constexpr size_t WS_R = 277 * MiB;
constexpr size_t WS_U = WS_R;
constexpr size_t WS_VV = WS_R + 17 * MiB;
constexpr size_t WS_Q = WS_R + 34 * MiB;
constexpr size_t WS_K = WS_R + 51 * MiB;
constexpr size_t WS_V = WS_R + 60 * MiB;
constexpr size_t WS_AO = WS_R + 69 * MiB;
constexpr size_t WS_QP = WS_R;
constexpr size_t WS_H8 = WS_R + 70 * MiB;
constexpr size_t WS_SH = WS_R + 88 * MiB;
constexpr size_t WS_ACT16 = WS_R + 89 * MiB;
constexpr size_t WS_SA = WS_R + 94 * MiB;
constexpr size_t WS_PART = WS_R;
constexpr size_t WS_GG = WS_R;
constexpr size_t WS_XR = WS_R + 42 * MiB;
constexpr size_t WS_YG = WS_R + 84 * MiB;
constexpr size_t WS_END = WS_R + 126 * MiB;

constexpr int LDS_BYTES = 147456;
constexpr int LDS_MISC = 145408;

__device__ __forceinline__ float bf2f(bf16_t v) { return __uint_as_float(((unsigned)v) << 16); }
__device__ __forceinline__ unsigned f2bf(float f) { unsigned u = __float_as_uint(f); return (u + 0x7fffu + ((u >> 16) & 1u)) >> 16; }
__device__ __forceinline__ unsigned pk2(float lo, float hi) { return f2bf(lo) | (f2bf(hi) << 16); }
__device__ __forceinline__ float bflo(unsigned w) { return __uint_as_float(w << 16); }
__device__ __forceinline__ float bfhi(unsigned w) { return __uint_as_float(w & 0xffff0000u); }
__device__ __forceinline__ float gelu_t(float x) { const float y = -2.302208198144325f * (x + 0.044715f * x * x * x); return x * __builtin_amdgcn_rcpf(1.f + __builtin_amdgcn_exp2f(y)); }
__device__ __forceinline__ float sigmoidf_(float x) { return 1.f / (1.f + __expf(-x)); }
__device__ __forceinline__ float wave_sum(float v) {
#pragma unroll
    for (int o = 1; o < 64; o <<= 1) v += __shfl_xor(v, o);
    return v;
}
__host__ __device__ __forceinline__ int sigma_head(int j) { const int grp = j >> 3, n = (j >> 2) & 1, e = j & 3; return (grp >> 3) * 64 + n * 32 + (grp & 7) * 4 + e; }

struct Args {
    const float* in[29];
    float* out;
    unsigned char* ws;
    int ph_lo, ph_hi;
};

__device__ __forceinline__ int row_variant(int g) { const int b = g / RPB, i = g - b * RPB; return i < CTXL ? 2 : b; }
__device__ __forceinline__ const float* row_src(const Args& a, int g) {
    const int b = g / RPB, i = g - b * RPB;
    return i < CTXL ? a.in[2] + ((size_t)b * CTXL + i) * D : a.in[0] + ((size_t)b * SEQ + (i - CTXL)) * D;
}
__device__ __forceinline__ const float* modv(const Args& a, int layer, int variant, int which) {
    return (const float*)(a.ws + WS_MODV) + ((size_t)(layer * 3 + variant) * 6 + which) * D;
}

#define XB_TMO      128
#define XB_XCNT(j)  (256  + 64 * (j))
#define XB_XSUB(j)  (1280 + 64 * (j))
#define XB_XGEN(j)  (2304 + 64 * (j))
#define XB_TOP      3328
#define XB_TOPGEN   3392
#define XCD_BAR_WORDS 3456
#define XB_SPIN_CAP (1u << 22)
__device__ __forceinline__ unsigned xb_ld(unsigned* p)              { return __hip_atomic_load(p, __ATOMIC_RELAXED, __HIP_MEMORY_SCOPE_AGENT); }
__device__ __forceinline__ unsigned xb_add(unsigned* p, unsigned v) { return __hip_atomic_fetch_add(p, v, __ATOMIC_RELAXED, __HIP_MEMORY_SCOPE_AGENT); }
__device__ __forceinline__ unsigned xb_xcc_id() { return (unsigned)__builtin_amdgcn_s_getreg((3 << 11) | 20) & 0xFu; }
#define XB_SPIN(cond, bar) do { unsigned _sp = 0; while (cond) { __builtin_amdgcn_s_sleep(1); \
    if ((++_sp & 255u) == 0u) { if (xb_ld(&(bar)[XB_TMO])) break; if (_sp > XB_SPIN_CAP) { atomicAdd(&(bar)[XB_TMO], 1u); break; } } } } while (0)
struct XcdBarrier { unsigned* bar; unsigned x; volatile LAS unsigned* st; };
__device__ __forceinline__ XcdBarrier xcd_barrier_post(unsigned* bar, volatile LAS unsigned* st) {
    XcdBarrier b; b.bar = bar; b.x = xb_xcc_id(); b.st = st;
    if (threadIdx.x == 0) (void)xb_add(&bar[XB_XCNT(b.x)], 1u);
    return b;
}
__device__ __forceinline__ void xcd_barrier_complete(unsigned* bar, unsigned x, unsigned& nloc, unsigned& nx) {
    const unsigned G = gridDim.x * gridDim.y * gridDim.z;
    unsigned sum, cnt, mine, sp = 0u;
    for (;;) {
        sum = 0u; cnt = 0u; mine = 0u;
#pragma unroll
        for (unsigned j = 0; j < 16; ++j) { const unsigned c = xb_ld(&bar[XB_XCNT(j)]); sum += c; cnt += (c > 0u) ? 1u : 0u; mine = (j == x) ? c : mine; }
        if (sum == G) break;
        __builtin_amdgcn_s_sleep(1);
        if ((++sp & 255u) == 0u) { if (xb_ld(&bar[XB_TMO])) break; if (sp > XB_SPIN_CAP) { atomicAdd(&bar[XB_TMO], 1u); break; } }
    }
    nloc = mine > 0u ? mine : 1u; nx = cnt > 0u ? cnt : 1u;
}
__device__ __forceinline__ void xcd_barrier(const XcdBarrier& b) {
    asm volatile("s_waitcnt vmcnt(0)" ::: "memory");
    __syncthreads();
    if (threadIdx.x == 0) {
        unsigned* bar = b.bar;
        __builtin_amdgcn_s_waitcnt(0);
        unsigned nloc = b.st[0], nx = b.st[1];
        if (nloc == 0u) { xcd_barrier_complete(bar, b.x, nloc, nx); b.st[0] = nloc; b.st[1] = nx; }
        const unsigned old = xb_add(&bar[XB_XSUB(b.x)], 1u);
        const unsigned gen = old / nloc;
        if (old + 1u == (gen + 1u) * nloc) {
            __builtin_amdgcn_fence(__ATOMIC_RELEASE, "agent");
            asm volatile("s_waitcnt vmcnt(0)" ::: "memory");
            const unsigned og = xb_add(&bar[XB_TOP], 1u);
            const unsigned tg = og / nx;
            if (og + 1u == (tg + 1u) * nx) xb_add(&bar[XB_TOPGEN], 1u);
            else XB_SPIN(xb_ld(&bar[XB_TOPGEN]) == tg, bar);
            __builtin_amdgcn_fence(__ATOMIC_ACQUIRE, "agent");
            xb_add(&bar[XB_XGEN(b.x)], 1u);
            asm volatile("s_waitcnt vmcnt(0)" ::: "memory");
        } else {
            XB_SPIN(xb_ld(&bar[XB_XGEN(b.x)]) == gen, bar);
            __builtin_amdgcn_fence(__ATOMIC_ACQUIRE, "agent");
            asm volatile("s_waitcnt vmcnt(0)" ::: "memory");
        }
    }
    __syncthreads();
}

__device__ __forceinline__ void quant_tables(const Args& a, int layer, int gw, int ngw, int lane) {
    unsigned char* ws = a.ws;
    for (int r0 = gw * 4; r0 < 2 * NEXP; r0 += ngw * 4) {
        f32x4 v[4][4]; float mx[4];
#pragma unroll
        for (int q = 0; q < 4; ++q) {
            const int r = r0 + q, tb = r / NEXP, ex = r - tb * NEXP;
            const float* src = a.in[tb == 0 ? 26 : 27] + ((size_t)layer * NEXP + ex) * D;
#pragma unroll
            for (int j = 0; j < 4; ++j) v[q][j] = *(const f32x4*)(src + j * 256 + lane * 4);
        }
#pragma unroll
        for (int q = 0; q < 4; ++q) { float m = 0.f;
#pragma unroll
            for (int j = 0; j < 4; ++j) m = fmaxf(fmaxf(fmaxf(fabsf(v[q][j].x), fabsf(v[q][j].y)), fmaxf(fabsf(v[q][j].z), fabsf(v[q][j].w))), m);
            mx[q] = m; }
#pragma unroll
        for (int o = 1; o < 64; o <<= 1) {
#pragma unroll
            for (int q = 0; q < 4; ++q) mx[q] = fmaxf(mx[q], __shfl_xor(mx[q], o)); }
#pragma unroll
        for (int q = 0; q < 4; ++q) {
            const int r = r0 + q, tb = r / NEXP, ex = r - tb * NEXP;
            const float m = fmaxf(mx[q], 1e-30f), inv = 127.f / m;
            unsigned char* dst = ws + (tb == 0 ? WS_PU : WS_PV) + (size_t)layer * NEXP * D + (size_t)ex * 128 + (lane & 31) * 4;
            const int bias = tb == 0 ? 0 : 128;
#pragma unroll
            for (int j = 0; j < 4; ++j) {
                const unsigned b0 = (unsigned)(__float2int_rn(v[q][j].x * inv) + bias) & 0xffu, b1 = (unsigned)(__float2int_rn(v[q][j].y * inv) + bias) & 0xffu;
                const unsigned b2 = (unsigned)(__float2int_rn(v[q][j].z * inv) + bias) & 0xffu, b3 = (unsigned)(__float2int_rn(v[q][j].w * inv) + bias) & 0xffu;
                *(unsigned*)(dst + (size_t)(2 * j + (lane >> 5)) * NEXP * 128) = b0 | (b1 << 8) | (b2 << 16) | (b3 << 24);
            }
            if (lane == 0) ((float*)(ws + (tb == 0 ? WS_SCU : WS_SCV)))[layer * NEXP + ex] = m * (1.f / 127.f);
        }
    }
}
__device__ __forceinline__ void transpose_item4(const float* src, int Ns, bf16_t* dst, int Kd, int n0, int k0, int dn1, int dk1, int dn2, int dk2, int dn3, int dk3, int perm_lo, int perm_hi, float* tile) {
    const int tid = threadIdx.x;
    const int dnv[4] = {0, dn1, dn2, dn3}, dkv[4] = {0, dk1, dk2, dk3};
    float v[4][8];
#pragma unroll
    for (int t = 0; t < 4; ++t) {
        const int nn = tid & 63; int n = n0 + dnv[t] + nn;
        if (n >= perm_lo && n < perm_hi) { const int rel = n - perm_lo; n = perm_lo + (rel & ~127) + sigma_head(rel & 127); }
#pragma unroll
        for (int i = 0; i < 8; ++i) { const int kk = (tid >> 6) + 8 * i; v[t][i] = src[(size_t)(k0 + dkv[t] + kk) * Ns + n]; }
    }
#pragma unroll
    for (int t = 0; t < 4; ++t)
#pragma unroll
        for (int i = 0; i < 8; ++i) { const int kk = (tid >> 6) + 8 * i; tile[t * 64 * 65 + kk * 65 + (tid & 63)] = v[t][i]; }
    __syncthreads();
#pragma unroll
    for (int t = 0; t < 4; ++t) {
        const int n = tid >> 3, kc = (tid & 7) * 8; const float* tl = tile + t * 64 * 65;
        u32x4 o;
        o.x = pk2(tl[(kc + 0) * 65 + n], tl[(kc + 1) * 65 + n]); o.y = pk2(tl[(kc + 2) * 65 + n], tl[(kc + 3) * 65 + n]);
        o.z = pk2(tl[(kc + 4) * 65 + n], tl[(kc + 5) * 65 + n]); o.w = pk2(tl[(kc + 6) * 65 + n], tl[(kc + 7) * 65 + n]);
        *(u32x4*)(dst + (size_t)(n0 + dnv[t] + n) * Kd + k0 + dkv[t] + kc) = o;
    }
    __syncthreads();
}
__device__ __forceinline__ void transpose_wide(const float* src, int Ns, bf16_t* dst, int Kd, int ng, int kb, int perm_lo, int perm_hi, float* tile) {
    transpose_item4(src, Ns, dst, Kd, ng * 256, kb * 64, 64, 0, 128, 0, 192, 0, perm_lo, perm_hi, tile);
}
__device__ __forceinline__ void cvt_stream(const float* src, bf16_t* dst, size_t n8, size_t gtid, size_t gthreads) {
    for (size_t i = gtid; i < n8; i += gthreads) {
        const f32x4 a = *(const f32x4*)(src + i * 8), b = *(const f32x4*)(src + i * 8 + 4);
        u32x4 o; o.x = pk2(a.x, a.y); o.y = pk2(a.z, a.w); o.z = pk2(b.x, b.y); o.w = pk2(b.z, b.w);
        *(u32x4*)(dst + i * 8) = o;
    }
}
__device__ __forceinline__ void prep_l1_item(const Args& a, float* tile, int r) {
    unsigned char* ws = a.ws;
    constexpr int I_WIN1 = 16 * 10, I_WOUT1 = 20 * 4, I_WQ1 = 16 * 8;
    if (r < I_WIN1) { transpose_wide(a.in[15], 2560, (bf16_t*)(ws + WS_WIN1), 1024, r % 10, r / 10, 0, 0, tile); return; }
    r -= I_WIN1;
    if (r < I_WOUT1) { transpose_wide(a.in[23], 1024, (bf16_t*)(ws + WS_WOUT1), 1280, r % 4, r / 4, 0, 0, tile); return; }
    r -= I_WOUT1;
    if (r < I_WQ1) { transpose_wide(a.in[24] + (size_t)1024 * 2048, 2048, (bf16_t*)(ws + WS_WQ) + (size_t)2048 * 1024, 1024, r % 8, r / 8, 0, 0, tile); return; }
    r -= I_WQ1;
    { const int which = r / 20, dh = r % 20;
        const float* src = a.in[which == 0 ? 18 : 20] + (size_t)dh * 128 * 128;
        bf16_t* dst = (bf16_t*)(ws + (which == 0 ? WS_WAT : WS_WXT)) + (size_t)dh * 128 * 128;
        transpose_item4(src, 128, dst, 128, 0, 0, 64, 0, 0, 64, 64, 64, 0, 0, tile);
    }
}
constexpr int N_L1_ITEMS = 160 + 80 + 128 + 40;
__device__ __forceinline__ void phase_prep(const Args& a, char* lds) {
    const int tid = threadIdx.x, lane = tid & 63, wid = tid >> 6;
    float* tile = (float*)lds;
    unsigned char* ws = a.ws;
    constexpr int I_MOD = 192;
    constexpr int I_WIN0 = 16 * 8, I_WOUT0 = 16 * 4, I_WQ0 = 16 * 8;
    constexpr int NIT = I_MOD + I_WIN0 + I_WOUT0 + I_WQ0;
    for (int it = blockIdx.x; it < NIT; it += gridDim.x) {
        int r = it;
        if (r < I_MOD) {
            const int l = r / 96, n0 = (r % 96) * 64;
            const float* W = a.in[4] + (size_t)l * D * 6144;
            float s0 = 0.f, s1 = 0.f, s2 = 0.f;
            float sl[3][2];
#pragma unroll
            for (int h = 0; h < 2; ++h) { const int k = wid * 128 + h * 64 + lane; const float c0 = a.in[1][k], c1 = a.in[1][D + k], c2 = a.in[3][k];
                sl[0][h] = c0 * sigmoidf_(c0); sl[1][h] = c1 * sigmoidf_(c1); sl[2][h] = c2 * sigmoidf_(c2); }
            const float* Wp = W + (size_t)(wid * 128) * 6144 + n0 + lane;
#pragma unroll
            for (int kk = 0; kk < 128; kk += 16) {
                float w[16];
#pragma unroll
                for (int j = 0; j < 16; ++j) w[j] = Wp[(size_t)(kk + j) * 6144];
#pragma unroll
                for (int j = 0; j < 16; ++j) { const int kq = kk + j;
                    s0 += __shfl(sl[0][kq >> 6], kq & 63) * w[j]; s1 += __shfl(sl[1][kq >> 6], kq & 63) * w[j]; s2 += __shfl(sl[2][kq >> 6], kq & 63) * w[j]; }
            }
            tile[(wid * 3 + 0) * 64 + lane] = s0; tile[(wid * 3 + 1) * 64 + lane] = s1; tile[(wid * 3 + 2) * 64 + lane] = s2;
            __syncthreads();
            if (tid < 192) {
                const int v = tid / 64, ln = tid & 63; float s = a.in[5][(size_t)l * 6144 + n0 + ln];
                for (int w = 0; w < 8; ++w) s += tile[(w * 3 + v) * 64 + ln];
                ((float*)(ws + WS_MODV))[(size_t)(l * 3 + v) * 6144 + n0 + ln] = s;
            }
            __syncthreads();
            continue;
        }
        r -= I_MOD;
        if (r < I_WIN0) { transpose_wide(a.in[8], 2048, (bf16_t*)(ws + WS_WIN0), 1024, r % 8, r / 8, 1024, 1792, tile); continue; }
        r -= I_WIN0;
        if (r < I_WOUT0) { transpose_wide(a.in[14], 1024, (bf16_t*)(ws + WS_WOUT0), 1024, r % 4, r / 4, 0, 0, tile); continue; }
        r -= I_WOUT0;
        transpose_wide(a.in[24], 2048, (bf16_t*)(ws + WS_WQ), 1024, r % 8, r / 8, 0, 0, tile);
    }
    const size_t gtid = (size_t)blockIdx.x * NTHR + tid, gthreads = (size_t)gridDim.x * NTHR;
    cvt_stream(a.in[25], (bf16_t*)(ws + WS_KEYS), (size_t)2 * 8 * 2 * 128 * 128 / 8, gtid, gthreads);
    cvt_stream(a.in[10], (bf16_t*)(ws + WS_GWS), (size_t)4 * 128 * 128 / 8, gtid, gthreads);
    quant_tables(a, 0, blockIdx.x * NWAVE + wid, gridDim.x * NWAVE, lane);
    for (size_t i = gtid; i < 128 * 32; i += gthreads) {
        const int pos = (int)(i / 32), f = (int)(i % 32);
        const float inv = powf(10000.f, -(float)f / 32.f); const float ang = (float)pos * inv;
        float* R = (float*)(ws + WS_ROPE); R[i * 2] = cosf(ang); R[i * 2 + 1] = sinf(ang);
    }
}

__device__ __forceinline__ void norm_row_store(const f32x4 (&v)[4], const float* g, const float* sh, const float* sc, bf16_t* orow, int lane, unsigned char* q8row = nullptr, float* q8scale = nullptr) {
    float s = 0.f;
#pragma unroll
    for (int j = 0; j < 4; ++j) s += (v[j].x * v[j].x + v[j].y * v[j].y) + (v[j].z * v[j].z + v[j].w * v[j].w);
    const float rinv = rsqrtf(wave_sum(s) * (1.f / D) + EPS);
    f32x4 o[4]; float mx = 0.f;
#pragma unroll
    for (int j = 0; j < 4; ++j) {
        const int c = j * 256 + lane * 4;
        const f32x4 gg = *(const f32x4*)(g + c), s1 = *(const f32x4*)(sh + c), s2 = *(const f32x4*)(sc + c);
        o[j].x = v[j].x * rinv * gg.x * (1.f + s2.x) + s1.x; o[j].y = v[j].y * rinv * gg.y * (1.f + s2.y) + s1.y;
        o[j].z = v[j].z * rinv * gg.z * (1.f + s2.z) + s1.z; o[j].w = v[j].w * rinv * gg.w * (1.f + s2.w) + s1.w;
        u32x2 w; w.x = pk2(o[j].x, o[j].y); w.y = pk2(o[j].z, o[j].w);
        *(u32x2*)(orow + c) = w;
        mx = fmaxf(fmaxf(fmaxf(fabsf(o[j].x), fabsf(o[j].y)), fmaxf(fabsf(o[j].z), fabsf(o[j].w))), mx);
    }
    if (q8row) {
#pragma unroll
        for (int of = 1; of < 64; of <<= 1) mx = fmaxf(mx, __shfl_xor(mx, of));
        mx = fmaxf(mx, 1e-30f); const float inv = 127.f / mx;
#pragma unroll
        for (int j = 0; j < 4; ++j) {
            const unsigned b0 = (unsigned)__float2int_rn(o[j].x * inv) & 0xffu, b1 = (unsigned)__float2int_rn(o[j].y * inv) & 0xffu;
            const unsigned b2 = (unsigned)__float2int_rn(o[j].z * inv) & 0xffu, b3 = (unsigned)__float2int_rn(o[j].w * inv) & 0xffu;
            *(unsigned*)(q8row + j * 256 + lane * 4) = b0 | (b1 << 8) | (b2 << 16) | (b3 << 24);
        }
        if (lane == 0) *q8scale = mx * (1.f / 127.f);
    }
}
__device__ __forceinline__ void phase_norm(const Args& a, int layer, int src_mode, const float* gain, int which_sh, int which_sc, bool latent_only, bool wq8 = false) {
    const int lane = threadIdx.x & 63, gw = blockIdx.x * NWAVE + (threadIdx.x >> 6), ngw = gridDim.x * NWAVE;
    bf16_t* H = (bf16_t*)(a.ws + WS_H);
    const float* X1 = (const float*)(a.ws + WS_X1);
    for (int g = gw; g < MTOT; g += ngw) {
        const int var = row_variant(g);
        if (latent_only && var == 2) continue;
        const float* xr = src_mode == 0 ? row_src(a, g) : X1 + (size_t)g * D;
        f32x4 v[4];
#pragma unroll
        for (int j = 0; j < 4; ++j) v[j] = *(const f32x4*)(xr + j * 256 + lane * 4);
        norm_row_store(v, gain, modv(a, layer, var, which_sh), modv(a, layer, var, which_sc), H + (size_t)g * D, lane, wq8 ? a.ws + WS_H8 + (size_t)g * D : nullptr, wq8 ? (float*)(a.ws + WS_SH) + g : nullptr);
    }
}

constexpr int CS_LD = 132;
__device__ __forceinline__ void gemm_tile128(const bf16_t* A, int lda, const bf16_t* Bt, int ldb, int K, float* Cs) {
    const int tid = threadIdx.x, lane = tid & 63, wid = tid >> 6, r = lane & 31, h = lane >> 5, wr = wid >> 1, wc = wid & 1;
    const bf16_t* ap = A + (size_t)(wr * 32 + r) * lda + 8 * h;
    const bf16_t* bp0 = Bt + (size_t)(wc * 64 + r) * ldb + 8 * h;
    const bf16_t* bp1 = bp0 + (size_t)32 * ldb;
    f32x16 acc0 = {}, acc1 = {};
#pragma unroll 4
    for (int k = 0; k < K; k += 16) {
        const bf16x8 av = *(const bf16x8*)(ap + k), b0 = *(const bf16x8*)(bp0 + k), b1 = *(const bf16x8*)(bp1 + k);
        acc0 = __builtin_amdgcn_mfma_f32_32x32x16_bf16(av, b0, acc0, 0, 0, 0);
        acc1 = __builtin_amdgcn_mfma_f32_32x32x16_bf16(av, b1, acc1, 0, 0, 0);
    }
#pragma unroll
    for (int i = 0; i < 16; ++i) {
        const int row = wr * 32 + (i & 3) + 8 * (i >> 2) + 4 * h;
        Cs[row * CS_LD + wc * 64 + r] = acc0[i];
        Cs[row * CS_LD + wc * 64 + 32 + r] = acc1[i];
    }
}

__device__ __forceinline__ void phase_inproj0(const Args& a, char* lds) {
    float* Cs = (float*)lds;
    const int tid = threadIdx.x;
    unsigned char* ws = a.ws;
    const bf16_t* H = (const bf16_t*)(ws + WS_H); const bf16_t* W = (const bf16_t*)(ws + WS_WIN0);
    const float* rope = (const float*)(ws + WS_ROPE);
    const int NU = (MTOT / 128) * 16;
    for (int u = blockIdx.x; u < NU; u += gridDim.x) {
        const int rt = u / 16, ct = u % 16, row0 = rt * 128, col0 = ct * 128;
        gemm_tile128(H + (size_t)row0 * D, D, W + (size_t)col0 * D, D, D, Cs);
        __syncthreads();
        const int rr = tid >> 2, q4 = tid & 3, g = row0 + rr;
        float* crow = Cs + rr * CS_LD + q4 * 32;
        if (ct < 4) {
            bf16_t* o = (bf16_t*)(ws + WS_U) + (size_t)g * 512 + col0 + q4 * 32;
#pragma unroll
            for (int c = 0; c < 32; c += 2) *(unsigned*)(o + c) = pk2(gelu_t(crow[c]), gelu_t(crow[c + 1]));
        } else if (ct < 8) {
            const int gg = ct - 4; float ss = 0.f;
#pragma unroll
            for (int c = 0; c < 32; ++c) { const float v = gelu_t(crow[c]); crow[c] = v; ss += v * v; }
            ss += __shfl_xor(ss, 1); ss += __shfl_xor(ss, 2);
            const float rinv = rsqrtf(ss * (1.f / 128.f) + EPS);
            const float* gn = a.in[9] + gg * 128 + q4 * 32;
            bf16_t* o = (bf16_t*)(ws + WS_VV) + (size_t)g * 512 + gg * 128 + q4 * 32;
#pragma unroll
            for (int c = 0; c < 32; c += 2) *(unsigned*)(o + c) = pk2(crow[c] * rinv * gn[c], crow[c + 1] * rinv * gn[c + 1]);
        } else if (ct < 14) {
            const bool isq = ct < 12; const int hh = isq ? ct - 8 : ct - 12;
            float ss = 0.f;
#pragma unroll
            for (int c = 0; c < 32; ++c) ss += crow[c] * crow[c];
            ss += __shfl_xor(ss, 1); ss += __shfl_xor(ss, 2);
            const float rinv = rsqrtf(ss * (1.f / 128.f) + EPS);
            const float* gn = a.in[isq ? 12 : 13];
            const int b = g / RPB, i = g - b * RPB; const bool lat = i >= CTXL; const int t = i - CTXL;
            bf16_t* o = (isq ? (bf16_t*)(ws + WS_Q) + (size_t)g * 512 : (bf16_t*)(ws + WS_K) + (size_t)g * 256) + hh * 128 + q4 * 32;
#pragma unroll
            for (int c8 = 0; c8 < 32; c8 += 8) {
                float y[8];
#pragma unroll
                for (int e = 0; e < 8; ++e) { const int j = q4 * 32 + c8 + e; y[e] = crow[c8 + e] * rinv * gn[sigma_head(j)]; }
                if (lat) {
                    const int grp = (q4 * 32 + c8) >> 3, ax = grp >> 3; const int pos = ax == 0 ? (t >> 6) : (t & 63);
#pragma unroll
                    for (int e = 0; e < 4; ++e) { const int f = (grp & 7) * 4 + e; const float cs = rope[(pos * 32 + f) * 2], sn = rope[(pos * 32 + f) * 2 + 1];
                        const float x1 = y[e], x2 = y[e + 4]; y[e] = x1 * cs - x2 * sn; y[e + 4] = x2 * cs + x1 * sn; }
                }
                u32x4 w; w.x = pk2(y[0], y[1]); w.y = pk2(y[2], y[3]); w.z = pk2(y[4], y[5]); w.w = pk2(y[6], y[7]);
                *(u32x4*)(o + c8) = w;
            }
        } else {
            bf16_t* o = (bf16_t*)(ws + WS_V) + (size_t)g * 256 + (ct - 14) * 128 + q4 * 32;
#pragma unroll
            for (int c = 0; c < 32; c += 2) *(unsigned*)(o + c) = pk2(crow[c], crow[c + 1]);
        }
        __syncthreads();
    }
}

__device__ __forceinline__ void phase_gmlp(const Args& a, char* lds) {
    const int tid = threadIdx.x;
    unsigned char* ws = a.ws;
    float* vt = (float*)lds;
    const bf16_t* VV = (const bf16_t*)(ws + WS_VV); const bf16_t* U = (const bf16_t*)(ws + WS_U); bf16_t* AO = (bf16_t*)(ws + WS_AO);
    const int NU = (MTOT / 128) * 4;
    for (int u = blockIdx.x; u < NU; u += gridDim.x) {
        const int ch = u / 4, g = u % 4, row0 = ch * 128;
        for (int i = tid; i < 128 * 128; i += NTHR) { const int q = i >> 7, c = i & 127; vt[i] = bf2f(VV[(size_t)(row0 + q) * 512 + g * 128 + c]); }
        __syncthreads();
        const int c = tid & 127, pq = tid >> 7;
        const float* wsg = a.in[10] + (size_t)g * 128 * 128;
        for (int pp = 0; pp < 32; ++pp) {
            const int p = pq * 32 + pp; float s = 0.f;
            for (int q = 0; q < 128; ++q) s += wsg[p * 128 + q] * vt[q * 128 + c];
            s += a.in[11][g * 128 + p];
            const float uu = bf2f(U[(size_t)(row0 + p) * 512 + g * 128 + c]);
            AO[(size_t)(row0 + p) * 1024 + g * 128 + c] = (bf16_t)f2bf(uu * s);
        }
        __syncthreads();
    }
}

__device__ __forceinline__ void phase_gmlp2(const Args& a, char* lds) {
    const int tid = threadIdx.x, lane = tid & 63, wid = __builtin_amdgcn_readfirstlane(tid >> 6), r32 = lane & 31, hh = lane >> 5;
    unsigned char* ws = a.ws;
    LAS bf16_t* vT = (LAS bf16_t*)((LAS char*)lds);
    const bf16_t* VV = (const bf16_t*)(ws + WS_VV); const bf16_t* U = (const bf16_t*)(ws + WS_U); bf16_t* AO = (bf16_t*)(ws + WS_AO);
    const bf16_t* GWS = (const bf16_t*)(ws + WS_GWS);
    const int NU = (MTOT / 128) * 4;
    const int gskip = gridDim.x > 64 ? 8 : 0;
    if ((int)blockIdx.x < gskip) return;
    for (int u = blockIdx.x - gskip; u < NU; u += gridDim.x - gskip) {
        const int ch = u >> 2, g = u & 3, row0 = ch * 128;
#pragma unroll
        for (int i = 0; i < 4; ++i) {
            const int q = (tid >> 4) + 32 * i, c0 = (tid & 15) * 8;
            const u32x4 w = *(const u32x4*)(VV + (size_t)(row0 + q) * 512 + g * 128 + c0);
            vT[(c0 + 0) * 136 + q] = (bf16_t)(w.x & 0xffffu); vT[(c0 + 1) * 136 + q] = (bf16_t)(w.x >> 16);
            vT[(c0 + 2) * 136 + q] = (bf16_t)(w.y & 0xffffu); vT[(c0 + 3) * 136 + q] = (bf16_t)(w.y >> 16);
            vT[(c0 + 4) * 136 + q] = (bf16_t)(w.z & 0xffffu); vT[(c0 + 5) * 136 + q] = (bf16_t)(w.z >> 16);
            vT[(c0 + 6) * 136 + q] = (bf16_t)(w.w & 0xffffu); vT[(c0 + 7) * 136 + q] = (bf16_t)(w.w >> 16);
        }
        __syncthreads();
        const int mb = wid >> 1, nb0 = (wid & 1) * 2;
        f32x16 acc0 = {}, acc1 = {};
        {
            unsigned aoff = (unsigned)((mb * 32 + r32) * 128 + 8 * hh); asm volatile("" : "+v"(aoff));
            const bf16_t* wsg = GWS + (size_t)g * 128 * 128;
#pragma unroll
            for (int ks = 0; ks < 8; ++ks) {
                const bf16x8 af = *(const bf16x8*)(wsg + aoff + ks * 16);
                const bf16x8 b0 = *(const LAS bf16x8*)(vT + (nb0 * 32 + r32) * 136 + ks * 16 + 8 * hh);
                const bf16x8 b1 = *(const LAS bf16x8*)(vT + ((nb0 + 1) * 32 + r32) * 136 + ks * 16 + 8 * hh);
                acc0 = __builtin_amdgcn_mfma_f32_32x32x16_bf16(af, b0, acc0, 0, 0, 0);
                acc1 = __builtin_amdgcn_mfma_f32_32x32x16_bf16(af, b1, acc1, 0, 0, 0);
            }
        }
#pragma unroll
        for (int r = 0; r < 16; ++r) {
            const int p = mb * 32 + (r & 3) + 8 * (r >> 2) + 4 * hh;
            const float bsv = a.in[11][g * 128 + p];
            const size_t ub = (size_t)(row0 + p) * 512 + g * 128, ob = (size_t)(row0 + p) * 1024 + g * 128;
            const int c0 = nb0 * 32 + r32, c1 = c0 + 32;
            AO[ob + c0] = (bf16_t)f2bf(bf2f(U[ub + c0]) * (acc0[r] + bsv));
            AO[ob + c1] = (bf16_t)f2bf(bf2f(U[ub + c1]) * (acc1[r] + bsv));
        }
        __syncthreads();
    }
}

__device__ __forceinline__ void phase_attn_naive(const Args& a, char* lds) {
    const int tid = threadIdx.x;
    unsigned char* ws = a.ws;
    float* Ks = (float*)lds;
    float* Vs = Ks + 32 * 128;
    float* part = Vs + 32 * 128;
    const bf16_t* Q = (const bf16_t*)(ws + WS_Q); const bf16_t* Kb = (const bf16_t*)(ws + WS_K); const bf16_t* Vb = (const bf16_t*)(ws + WS_V);
    bf16_t* AO = (bf16_t*)(ws + WS_AO);
    const int NU = 512 + 16;
    for (int u = blockIdx.x; u < NU; u += gridDim.x) {
        int b, h, qrow0, nkeys;
        if (u < 512) { b = u / 256; h = (u / 64) % 4; qrow0 = b * RPB + CTXL + (u % 64) * 128; nkeys = RPB; }
        else { const int v = u - 512; b = v / 8; h = (v / 2) % 4; qrow0 = b * RPB + (v % 2) * 128; nkeys = CTXL; }
        const int kvh = h >> 1, krow0 = b * RPB;
        const int qi = tid & 127, qt = tid >> 7;
        float q[32], o[32];
        {
            const bf16_t* qp = Q + (size_t)(qrow0 + qi) * 512 + h * 128 + qt * 32;
#pragma unroll
            for (int d = 0; d < 32; d += 2) { const unsigned w = *(const unsigned*)(qp + d); q[d] = bflo(w) * 0.08838834764831845f; q[d + 1] = bfhi(w) * 0.08838834764831845f; }
#pragma unroll
            for (int d = 0; d < 32; ++d) o[d] = 0.f;
        }
        float m = -1e30f, l = 0.f;
        for (int k0 = 0; k0 < nkeys; k0 += 32) {
            {
                const int key = tid >> 4, cs = (tid & 15) * 8;
                const u32x4 kw = *(const u32x4*)(Kb + (size_t)(krow0 + k0 + key) * 256 + kvh * 128 + cs);
                const u32x4 vw = *(const u32x4*)(Vb + (size_t)(krow0 + k0 + key) * 256 + kvh * 128 + cs);
                float* kd = Ks + key * 128 + cs; float* vd = Vs + key * 128 + cs;
                kd[0] = bflo(kw.x); kd[1] = bfhi(kw.x); kd[2] = bflo(kw.y); kd[3] = bfhi(kw.y); kd[4] = bflo(kw.z); kd[5] = bfhi(kw.z); kd[6] = bflo(kw.w); kd[7] = bfhi(kw.w);
                vd[0] = bflo(vw.x); vd[1] = bfhi(vw.x); vd[2] = bflo(vw.y); vd[3] = bfhi(vw.y); vd[4] = bflo(vw.z); vd[5] = bfhi(vw.z); vd[6] = bflo(vw.w); vd[7] = bfhi(vw.w);
            }
            __syncthreads();
#pragma unroll 2
            for (int j = 0; j < 32; ++j) {
                const float* kr = Ks + j * 128 + qt * 32; float acc = 0.f;
#pragma unroll
                for (int d = 0; d < 32; d += 4) { const f32x4 kv = *(const f32x4*)(kr + d); acc += q[d] * kv.x + q[d + 1] * kv.y + q[d + 2] * kv.z + q[d + 3] * kv.w; }
                part[(qt * 32 + j) * 128 + qi] = acc;
            }
            __syncthreads();
            float mx = m;
#pragma unroll 4
            for (int j = 0; j < 32; ++j) { const float sj = (part[(0 * 32 + j) * 128 + qi] + part[(1 * 32 + j) * 128 + qi]) + (part[(2 * 32 + j) * 128 + qi] + part[(3 * 32 + j) * 128 + qi]); mx = fmaxf(mx, sj); }
            const float alpha = __expf(m - mx); m = mx; float ps = 0.f;
#pragma unroll
            for (int d = 0; d < 32; ++d) o[d] *= alpha;
#pragma unroll 2
            for (int j = 0; j < 32; ++j) {
                const float sj = (part[(0 * 32 + j) * 128 + qi] + part[(1 * 32 + j) * 128 + qi]) + (part[(2 * 32 + j) * 128 + qi] + part[(3 * 32 + j) * 128 + qi]);
                const float pj = __expf(sj - mx); ps += pj;
                const float* vr = Vs + j * 128 + qt * 32;
#pragma unroll
                for (int d = 0; d < 32; d += 4) { const f32x4 vv = *(const f32x4*)(vr + d); o[d] += pj * vv.x; o[d + 1] += pj * vv.y; o[d + 2] += pj * vv.z; o[d + 3] += pj * vv.w; }
            }
            l = l * alpha + ps;
            __syncthreads();
        }
        const float rl = 1.f / l;
        bf16_t* op = AO + (size_t)(qrow0 + qi) * 1024 + 512 + h * 128 + qt * 32;
#pragma unroll
        for (int d = 0; d < 32; d += 2) *(unsigned*)(op + d) = pk2(o[d] * rl, o[d + 1] * rl);
    }
}

namespace fa {
typedef short s16x4 __attribute__((ext_vector_type(4)));
constexpr int QBLK = 32, KVBLK = 64, LDQ = 512, LDK = 256, LDO = 1024;
constexpr float SCALE = 0.088388347648318440f, THR = 8.f;
constexpr size_t SHM_V = KVBLK * 128 * 2, SHM_K = KVBLK * 128 * 2, SHM_ATTN = 2 * SHM_V + 2 * SHM_K + NWAVE * 64 * 4;
#define KSWZ(row, colB) ((row) * 256 + ((colB) ^ (((row) & 7) << 4)))
#define SBAR() __builtin_amdgcn_sched_barrier(0)
__device__ __forceinline__ int crow(int r, int hi) { return (r & 3) + 8 * (r >> 2) + 4 * hi; }
__device__ __forceinline__ unsigned cvtpk(float lo, float hi) { unsigned r; asm volatile("v_cvt_pk_bf16_f32 %0, %1, %2" : "=v"(r) : "v"(lo), "v"(hi)); return r; }
__device__ __forceinline__ void partialSM(f32x16& p0, f32x16& p1, float& m_reg, float& mn, float& alpha) {
  constexpr float C = SCALE * 1.4426950408889634f;
  float pmax = p0[0]; for (int r = 1; r < 16; ++r) pmax = fmaxf(pmax, p0[r]); for (int r = 0; r < 16; ++r) pmax = fmaxf(pmax, p1[r]);
  { auto rr = __builtin_amdgcn_permlane32_swap(__float_as_uint(pmax), __float_as_uint(pmax), false, false);
    pmax = fmaxf(__uint_as_float(rr[0]), __uint_as_float(rr[1])); }
  if (__builtin_expect(__all(pmax - m_reg <= THR / SCALE), 1)) { mn = m_reg; alpha = 1.f; }
  else { mn = fmaxf(m_reg, pmax); alpha = __builtin_amdgcn_exp2f((m_reg - mn) * C); m_reg = mn; }
  float mnC = -mn * C;
  for (int r = 0; r < 16; ++r) p0[r] = fmaf(p0[r], C, mnC); for (int r = 0; r < 16; ++r) p1[r] = fmaf(p1[r], C, mnC);
  for (int r = 0; r < 16; ++r) p0[r] = __builtin_amdgcn_exp2f(p0[r]);
}
__device__ __forceinline__ void finishSM(f32x16& p0, f32x16& p1, float alpha, float& l_reg, bf16x8& pa0, bf16x8& pa1, bf16x8& pa2, bf16x8& pa3) {
  for (int r = 0; r < 16; ++r) p1[r] = __builtin_amdgcn_exp2f(p1[r]);
  float ps = 0; for (int r = 0; r < 16; ++r) ps += p0[r]; for (int r = 0; r < 16; ++r) ps += p1[r];
  { auto rr = __builtin_amdgcn_permlane32_swap(__float_as_uint(ps), __float_as_uint(ps), false, false);
    ps = __uint_as_float(rr[0]) + __uint_as_float(rr[1]); }
  l_reg = l_reg * alpha + ps;
#define PK4(P, BASE, OUT) do { unsigned a0 = cvtpk(P[BASE + 0], P[BASE + 1]), a1 = cvtpk(P[BASE + 2], P[BASE + 3]);   \
    unsigned b0 = cvtpk(P[BASE + 4], P[BASE + 5]), b1 = cvtpk(P[BASE + 6], P[BASE + 7]);                              \
    auto r0 = __builtin_amdgcn_permlane32_swap(a0, b0, false, false); auto r1 = __builtin_amdgcn_permlane32_swap(a1, b1, false, false); \
    u32x4 w = {r0[0], r1[0], r0[1], r1[1]}; OUT = *reinterpret_cast<bf16x8*>(&w); } while (0)
  PK4(p0, 0, pa0); PK4(p0, 8, pa1); PK4(p1, 0, pa2); PK4(p1, 8, pa3);
#undef PK4
}
__device__ __forceinline__ void qkt(f32x16& p0, f32x16& p1, const bf16_t* Ks, const bf16x8* qr, int r32, int hi) {
  p0 = f32x16{}; p1 = f32x16{};
  for (int d0 = 0; d0 < 8; ++d0) { int cb = (d0 * 16 + hi * 8) * 2;
    bf16x8 b0 = *reinterpret_cast<const bf16x8*>((const char*)Ks + KSWZ(r32, cb));
    bf16x8 b1 = *reinterpret_cast<const bf16x8*>((const char*)Ks + KSWZ(32 + r32, cb));
    p0 = __builtin_amdgcn_mfma_f32_32x32x16_bf16(b0, qr[d0], p0, 0, 0, 0);
    p1 = __builtin_amdgcn_mfma_f32_32x32x16_bf16(b1, qr[d0], p1, 0, 0, 0); }
}
__device__ __forceinline__ int v_st(int k, int c) { const int kk = (k & ~0xC) | ((k & 4) << 1) | ((k & 8) >> 1); return ((kk >> 3) * 4 + (c >> 5)) * 512 + ((kk & 7) * 32 + (c & 31)) * 2; }
__device__ __forceinline__ int v_rd_base(int lane) { return ((lane & 3) << 3) | (((lane >> 2) & 3) << 6) | (((lane >> 4) & 1) << 5) | (((lane >> 5) & 1) << 8); }
constexpr int v_rd_off(int d0, int ks, int half) { return d0 * 512 + ks * 4096 + half * 2048; }
template <int OFF> __device__ __forceinline__ s16x4 tr_read(int vb) {
  s16x4 r; asm volatile("ds_read_b64_tr_b16 %0, %1 offset:%2" : "=&v"(r) : "v"(vb), "i"(OFF) : "memory"); return r;
}
template <int D0> __device__ __forceinline__ void pv_one(f32x16& od, int vb, bf16x8 pa0, bf16x8 pa1, bf16x8 pa2, bf16x8 pa3) {
  const s16x4 l0 = tr_read<v_rd_off(D0, 0, 0)>(vb), h0 = tr_read<v_rd_off(D0, 0, 1)>(vb), l1 = tr_read<v_rd_off(D0, 1, 0)>(vb), h1 = tr_read<v_rd_off(D0, 1, 1)>(vb);
  const s16x4 l2 = tr_read<v_rd_off(D0, 2, 0)>(vb), h2 = tr_read<v_rd_off(D0, 2, 1)>(vb), l3 = tr_read<v_rd_off(D0, 3, 0)>(vb), h3 = tr_read<v_rd_off(D0, 3, 1)>(vb);
  asm volatile("s_waitcnt lgkmcnt(0)" ::: "memory"); SBAR();
#define PK(L, H) (bf16x8){L[0], L[1], L[2], L[3], H[0], H[1], H[2], H[3]}
  od = __builtin_amdgcn_mfma_f32_32x32x16_bf16(pa0, PK(l0, h0), od, 0, 0, 0);
  od = __builtin_amdgcn_mfma_f32_32x32x16_bf16(pa1, PK(l1, h1), od, 0, 0, 0);
  od = __builtin_amdgcn_mfma_f32_32x32x16_bf16(pa2, PK(l2, h2), od, 0, 0, 0);
  od = __builtin_amdgcn_mfma_f32_32x32x16_bf16(pa3, PK(l3, h3), od, 0, 0, 0);
#undef PK
}
__device__ __forceinline__ void pv_d0(f32x16* o, int vb, bf16x8 pa0, bf16x8 pa1, bf16x8 pa2, bf16x8 pa3) {
  pv_one<0>(o[0], vb, pa0, pa1, pa2, pa3); pv_one<1>(o[1], vb, pa0, pa1, pa2, pa3); pv_one<2>(o[2], vb, pa0, pa1, pa2, pa3); pv_one<3>(o[3], vb, pa0, pa1, pa2, pa3);
}
__device__ __forceinline__ void attn_dense_body(const bf16_t* __restrict__ Qb, const bf16_t* __restrict__ Kh, const bf16_t* __restrict__ Vh,
                                                bf16_t* __restrict__ Ob, int seq, char* lds) {
  const int tid = threadIdx.x, wid = tid >> 6, lane = tid & 63, r32 = lane & 31, hi = lane >> 5;
  bf16_t* V_lds = (bf16_t*)lds; bf16_t* K_lds = (bf16_t*)(lds + 2 * SHM_V);
  float* ws = (float*)(lds + 2 * SHM_V + 2 * SHM_K) + wid * 64; float* li_l = ws; float* al_l = ws + 32;
  float m_reg = -1e30f, l_reg = 0; f32x16 o[4] = {}; bf16x8 qr[8];
  const bf16_t* Qw = Qb + (long)(wid * QBLK + r32) * LDQ + hi * 8;
#pragma unroll
  for (int d0 = 0; d0 < 8; ++d0) qr[d0] = *reinterpret_cast<const bf16x8*>(Qw + d0 * 16);
  const int sr = tid >> 4, sc = (tid & 15) * 8, vst0 = v_st(sr, sc), vst1 = v_st(32 + sr, sc);
  const int vb0 = (int)(uintptr_t)V_lds + v_rd_base(lane);
  struct { bf16x8 vs0, vs1, ks0, ks1; } sr_[2];
#define SLOAD(i, k0) do { sr_[i].vs0 = *reinterpret_cast<const bf16x8*>(&Vh[(long)((k0) + sr) * LDK + sc]); sr_[i].vs1 = *reinterpret_cast<const bf16x8*>(&Vh[(long)((k0) + 32 + sr) * LDK + sc]); \
    sr_[i].ks0 = *reinterpret_cast<const bf16x8*>(&Kh[(long)((k0) + sr) * LDK + sc]); sr_[i].ks1 = *reinterpret_cast<const bf16x8*>(&Kh[(long)((k0) + 32 + sr) * LDK + sc]); } while (0)
#define SWRITE(b, i) do { *(bf16x8*)((char*)V_lds + (b) * SHM_V + vst0) = sr_[i].vs0;          \
    *(bf16x8*)((char*)V_lds + (b) * SHM_V + vst1) = sr_[i].vs1; int kc = sc * 2;               \
    *(bf16x8*)((char*)K_lds + (b) * SHM_K + KSWZ(sr, kc)) = sr_[i].ks0;                       \
    *(bf16x8*)((char*)K_lds + (b) * SHM_K + KSWZ(32 + sr, kc)) = sr_[i].ks1; } while (0)
#define SWAIT() asm volatile("s_waitcnt vmcnt(4)" ::: "memory")
#define RESC(a) do { if (__any((a) < 1.f)) { if (hi == 0) al_l[r32] = (a); asm volatile("s_waitcnt lgkmcnt(0)" ::: "memory"); \
    for (int d = 0; d < 4; ++d) for (int r = 0; r < 16; ++r) o[d][r] *= al_l[crow(r, hi)]; } } while (0)
  f32x16 pA0, pA1, pB0, pB1; float mnA, mnB, alA, alB; bf16x8 pa0, pa1, pa2, pa3; const int NT = seq / KVBLK;
  constexpr int SE = 0, SO = 1;
  SLOAD(SE, 0); asm volatile("s_waitcnt vmcnt(0)" ::: "memory"); SWRITE(0, SE); __syncthreads();
  qkt(pA0, pA1, K_lds, qr, r32, hi); partialSM(pA0, pA1, m_reg, mnA, alA);
  SLOAD(SO, KVBLK); if (2 < NT) SLOAD(SE, 2 * KVBLK);
  SWAIT(); SWRITE(1, SO); __syncthreads();
  for (int j = 1; j + 1 < NT; j += 2) {
    SBAR(); qkt(pB0, pB1, (bf16_t*)((char*)K_lds + SHM_K), qr, r32, hi);
    finishSM(pA0, pA1, alA, l_reg, pa0, pa1, pa2, pa3); SBAR();
    SLOAD(SO, (j + 2) * KVBLK); SBAR();
    pv_d0(o, vb0, pa0, pa1, pa2, pa3); partialSM(pB0, pB1, m_reg, mnB, alB);
    __syncthreads(); SWAIT(); SWRITE(0, SE);
    RESC(alB); __syncthreads();
    SBAR(); qkt(pA0, pA1, K_lds, qr, r32, hi);
    finishSM(pB0, pB1, alB, l_reg, pa0, pa1, pa2, pa3); SBAR();
    if (j + 3 < NT) SLOAD(SE, (j + 3) * KVBLK); SBAR();
    pv_d0(o, vb0 + (int)SHM_V, pa0, pa1, pa2, pa3); partialSM(pA0, pA1, m_reg, mnA, alA);
    __syncthreads(); SWAIT(); SWRITE(1, SO);
    RESC(alA); __syncthreads();
  }
  SBAR(); qkt(pB0, pB1, (bf16_t*)((char*)K_lds + SHM_K), qr, r32, hi);
  finishSM(pA0, pA1, alA, l_reg, pa0, pa1, pa2, pa3); SBAR();
  pv_d0(o, vb0, pa0, pa1, pa2, pa3); partialSM(pB0, pB1, m_reg, mnB, alB);
  __syncthreads(); RESC(alB);
  finishSM(pB0, pB1, alB, l_reg, pa0, pa1, pa2, pa3); SBAR();
  pv_d0(o, vb0 + (int)SHM_V, pa0, pa1, pa2, pa3);
  if (hi == 0) li_l[r32] = l_reg; asm volatile("s_waitcnt lgkmcnt(0)" ::: "memory");
  float rli[16];
#pragma unroll
  for (int r = 0; r < 16; ++r) rli[r] = __builtin_amdgcn_rcpf(li_l[crow(r, hi)]);
  bf16_t* Ow = Ob + (long)(wid * QBLK) * LDO;
#pragma unroll
  for (int r = 0; r < 16; ++r) { int orow = crow(r, hi);
    for (int d0 = 0; d0 < 4; ++d0) Ow[(long)orow * LDO + d0 * 32 + r32] = (bf16_t)f2bf(o[d0][r] * rli[r]); }
  __syncthreads();
#undef SLOAD
#undef SWRITE
#undef SWAIT
#undef RESC
}
#undef KSWZ
#undef SBAR
}

__device__ __forceinline__ void phase_attn(const Args& a, char* lds) {
    unsigned char* ws = a.ws;
    const bf16_t* Q = (const bf16_t*)(ws + WS_Q); const bf16_t* Kb = (const bf16_t*)(ws + WS_K); const bf16_t* Vb = (const bf16_t*)(ws + WS_V);
    bf16_t* AO = (bf16_t*)(ws + WS_AO);
    const int NU = 256 + 8;
    for (int u = blockIdx.x; u < NU; u += gridDim.x) {
        int b, h, qrow0, nkeys;
        if (u < 256) { const int x = u & 7; b = x >> 2; h = x & 3; qrow0 = b * RPB + CTXL + (u >> 3) * 256; nkeys = RPB; }
        else { const int v = u - 256; b = v / 4; h = v % 4; qrow0 = b * RPB; nkeys = CTXL; }
        const int kvh = h >> 1; const size_t krow0 = (size_t)b * RPB;
        fa::attn_dense_body(Q + (size_t)qrow0 * 512 + h * 128, Kb + krow0 * 256 + kvh * 128, Vb + krow0 * 256 + kvh * 128, AO + (size_t)qrow0 * 1024 + 512 + h * 128, nkeys, lds);
    }
}

__device__ __forceinline__ void phase_outproj(const Args& a, char* lds, const bf16_t* A, int K, const bf16_t* Bt, int layer, int which_gate, int base_mode, bool latent_only) {
    float* Cs = (float*)lds;
    const int tid = threadIdx.x;
    float* X1 = (float*)(a.ws + WS_X1);
    const int NU = (MTOT / 128) * 8;
    for (int u = blockIdx.x; u < NU; u += gridDim.x) {
        const int rt = u / 8, ct = u % 8, row0 = rt * 128, col0 = ct * 128;
        if (latent_only && (rt % 66) < 2) continue;
        gemm_tile128(A + (size_t)row0 * K, K, Bt + (size_t)col0 * K, K, K, Cs);
        __syncthreads();
        const int rr = tid >> 2, q4 = tid & 3, g = row0 + rr;
        const float* crow = Cs + rr * CS_LD + q4 * 32;
        const float* gt = modv(a, layer, row_variant(g), which_gate) + col0 + q4 * 32;
        const float* base = (base_mode == 0 ? row_src(a, g) : X1 + (size_t)g * D) + col0 + q4 * 32;
        float* o = X1 + (size_t)g * D + col0 + q4 * 32;
#pragma unroll
        for (int c = 0; c < 32; c += 4) {
            const f32x4 bs = *(const f32x4*)(base + c), gv = *(const f32x4*)(gt + c);
            f32x4 r; r.x = bs.x + gv.x * crow[c]; r.y = bs.y + gv.y * crow[c + 1]; r.z = bs.z + gv.z * crow[c + 2]; r.w = bs.w + gv.w * crow[c + 3];
            *(f32x4*)(o + c) = r;
        }
        __syncthreads();
    }
}

__device__ __forceinline__ void phase_peerq(const Args& a, char* lds, int layer, bool latent_only) {
    float* Cs = (float*)lds;
    const int tid = threadIdx.x;
    const bf16_t* H = (const bf16_t*)(a.ws + WS_H); const bf16_t* W = (const bf16_t*)(a.ws + WS_WQ) + (size_t)layer * 2048 * 1024;
    bf16_t* QP = (bf16_t*)(a.ws + WS_QP);
    const int NU = (MTOT / 128) * 16;
    for (int u = blockIdx.x; u < NU; u += gridDim.x) {
        const int rt = u / 16, ct = u % 16, row0 = rt * 128, col0 = ct * 128;
        if (latent_only && (rt % 66) < 2) continue;
        gemm_tile128(H + (size_t)row0 * D, D, W + (size_t)col0 * D, D, D, Cs);
        __syncthreads();
        const int rr = tid >> 2, q4 = tid & 3, g = row0 + rr;
        const float* crow = Cs + rr * CS_LD + q4 * 32;
        bf16_t* o = QP + (size_t)g * 2048 + col0 + q4 * 32;
#pragma unroll
        for (int c = 0; c < 32; c += 2) *(unsigned*)(o + c) = pk2(crow[c], crow[c + 1]);
        __syncthreads();
    }
}

__device__ __forceinline__ void wave_argmax(float& v, int& i) {
#pragma unroll
    for (int o = 1; o < 64; o <<= 1) {
        const float ov = __shfl_xor(v, o); const int oi = __shfl_xor(i, o);
        if (ov > v || (ov == v && oi < i)) { v = ov; i = oi; }
    }
}
__device__ __forceinline__ void phase_peer_topk(const Args& a, int layer, bool latent_only) {
    const int lane = threadIdx.x & 63, gw = blockIdx.x * NWAVE + (threadIdx.x >> 6), ngw = gridDim.x * NWAVE;
    const bf16_t* QP = (const bf16_t*)(a.ws + WS_QP);
    const bf16_t* KEYS = (const bf16_t*)(a.ws + WS_KEYS) + (size_t)layer * 8 * 2 * 128 * 128;
    int* SELI = (int*)(a.ws + WS_SELI); float* SELG = (float*)(a.ws + WS_SELG);
    for (int it = gw; it < MTOT * 8; it += ngw) {
        const int g = it >> 3, h = it & 7;
        if (latent_only && row_variant(g) == 2) continue;
        float tv[2]; int ti[2];
#pragma unroll
        for (int s = 0; s < 2; ++s) {
            const bf16_t* qp = QP + (size_t)g * 2048 + h * 256 + s * 128;
            const bf16_t* k0p = KEYS + ((size_t)(h * 2 + s) * 128 + lane) * 128;
            const bf16_t* k1p = k0p + 64 * 128;
            float s0 = 0.f, s1 = 0.f;
#pragma unroll 4
            for (int d = 0; d < 128; d += 8) {
                const u32x4 qw = *(const u32x4*)(qp + d), ka = *(const u32x4*)(k0p + d), kb = *(const u32x4*)(k1p + d);
                s0 += bflo(qw.x) * bflo(ka.x) + bfhi(qw.x) * bfhi(ka.x) + bflo(qw.y) * bflo(ka.y) + bfhi(qw.y) * bfhi(ka.y)
                    + bflo(qw.z) * bflo(ka.z) + bfhi(qw.z) * bfhi(ka.z) + bflo(qw.w) * bflo(ka.w) + bfhi(qw.w) * bfhi(ka.w);
                s1 += bflo(qw.x) * bflo(kb.x) + bfhi(qw.x) * bfhi(kb.x) + bflo(qw.y) * bflo(kb.y) + bfhi(qw.y) * bfhi(kb.y)
                    + bflo(qw.z) * bflo(kb.z) + bfhi(qw.z) * bfhi(kb.z) + bflo(qw.w) * bflo(kb.w) + bfhi(qw.w) * bfhi(kb.w);
            }
            float myv = 0.f; int myi = 0;
            for (int r = 0; r < 16; ++r) {
                float bv; int bi;
                if (s0 >= s1) { bv = s0; bi = lane; } else { bv = s1; bi = lane + 64; }
                wave_argmax(bv, bi);
                if (bi == lane) s0 = -INFINITY; else if (bi == lane + 64) s1 = -INFINITY;
                if (lane == r) { myv = bv; myi = bi; }
            }
            tv[s] = myv; ti[s] = myi;
        }
        float cv[4]; int ci[4];
        {
            const float v0 = __shfl(tv[0], lane >> 2); const int i0 = __shfl(ti[0], lane >> 2);
#pragma unroll
            for (int m = 0; m < 4; ++m) { const int j = (lane & 3) * 4 + m; cv[m] = v0 + __shfl(tv[1], j); ci[m] = i0 * 128 + __shfl(ti[1], j); }
        }
        float topv = 0.f; int tope = 0;
        for (int r = 0; r < 16; ++r) {
            float bv = cv[0]; int bp = lane * 4;
#pragma unroll
            for (int m = 1; m < 4; ++m) if (cv[m] > bv) { bv = cv[m]; bp = lane * 4 + m; }
            wave_argmax(bv, bp);
            int be = 0;
#pragma unroll
            for (int m = 0; m < 4; ++m) if (bp == lane * 4 + m) { be = ci[m]; cv[m] = -INFINITY; }
            be = __shfl(be, bp >> 2);
            if (lane == r) { topv = bv; tope = be; }
        }
        const float mx = __shfl(topv, 0);
        float e = lane < 16 ? __expf(topv - mx) : 0.f;
        float sum = e;
#pragma unroll
        for (int o = 1; o < 16; o <<= 1) sum += __shfl_xor(sum, o);
        if (lane < 16) { SELI[(size_t)g * 128 + h * 16 + lane] = tope; SELG[(size_t)g * 128 + h * 16 + lane] = e / sum; }
    }
}

constexpr int TK_LD = 136;
__device__ __forceinline__ int peer_tok(int i, int mode);
namespace tk {
__device__ __forceinline__ void ce(float& a, float& b) { const float mx = __builtin_fmaxf(a, b), mn = __builtin_fminf(a, b); a = mx; b = mn; }
__device__ __forceinline__ void sort16_desc(float (&v)[16]) {
#pragma unroll
    for (int ks = 1; ks <= 4; ++ks)
#pragma unroll
        for (int js = ks - 1; js >= 0; --js)
#pragma unroll
            for (int i = 0; i < 16; ++i) { const int k = 1 << ks, j = 1 << js, l = i ^ j; if (l > i) { if ((i & k) == 0) ce(v[i], v[l]); else ce(v[l], v[i]); } }
}
__device__ __forceinline__ void merge16_desc(float (&v)[16]) {
#pragma unroll
    for (int js = 3; js >= 0; --js)
#pragma unroll
        for (int i = 0; i < 16; ++i) { const int j = 1 << js, l = i ^ j; if (l > i) ce(v[i], v[l]); }
}
__device__ __forceinline__ void merge_prune(float (&x)[16], const float (&y)[16]) {
#pragma unroll
    for (int i = 0; i < 16; ++i) x[i] = __builtin_fmaxf(x[i], y[15 - i]);
    merge16_desc(x);
}
__host__ __device__ constexpr bool pair_ok(int i, int j) { return (i + 1) * (j + 1) <= 16; }
__host__ __device__ constexpr int pair_index(int i, int j) { int n = 0; for (int a = 0; a < 16; ++a) for (int b = 0; b < 16; ++b) { if (a == i && b == j) return n; if (pair_ok(a, b)) ++n; } return n; }
static_assert(pair_index(15, 15) == 49 + 0 || true, "");
}
__device__ __forceinline__ void topk_stage2(const float (&top)[2][16], int* SELI, float* SELG, int g0, int h, int r32, int hh) {
    float X[16], Y[16];
    X[0] = __uint_as_float((__float_as_uint((hh ? top[0][3] : top[0][0]) + (hh ? top[1][3] : top[1][0])) & ~255u) | (hh ? 51u : 0u));
    Y[0] = __uint_as_float((__float_as_uint((hh ? top[0][14] : top[0][1]) + (hh ? top[1][0] : top[1][0])) & ~255u) | (hh ? 224u : 16u));
    X[1] = __uint_as_float((__float_as_uint((hh ? top[0][4] : top[0][0]) + (hh ? top[1][0] : top[1][1])) & ~255u) | (hh ? 64u : 1u));
    Y[1] = __uint_as_float((__float_as_uint((hh ? top[0][15] : top[0][1]) + (hh ? top[1][0] : top[1][1])) & ~255u) | (hh ? 240u : 17u));
    X[2] = __uint_as_float((__float_as_uint((hh ? top[0][4] : top[0][0]) + (hh ? top[1][1] : top[1][2])) & ~255u) | (hh ? 65u : 2u));
    Y[2] = (hh ? -INFINITY : __uint_as_float((__float_as_uint(top[0][1] + top[1][2]) & ~255u) | 18u));
    X[3] = __uint_as_float((__float_as_uint((hh ? top[0][4] : top[0][0]) + (hh ? top[1][2] : top[1][3])) & ~255u) | (hh ? 66u : 3u));
    Y[3] = (hh ? -INFINITY : __uint_as_float((__float_as_uint(top[0][1] + top[1][3]) & ~255u) | 19u));
    X[4] = __uint_as_float((__float_as_uint((hh ? top[0][5] : top[0][0]) + (hh ? top[1][0] : top[1][4])) & ~255u) | (hh ? 80u : 4u));
    Y[4] = (hh ? -INFINITY : __uint_as_float((__float_as_uint(top[0][1] + top[1][4]) & ~255u) | 20u));
    X[5] = __uint_as_float((__float_as_uint((hh ? top[0][5] : top[0][0]) + (hh ? top[1][1] : top[1][5])) & ~255u) | (hh ? 81u : 5u));
    Y[5] = (hh ? -INFINITY : __uint_as_float((__float_as_uint(top[0][1] + top[1][5]) & ~255u) | 21u));
    X[6] = __uint_as_float((__float_as_uint((hh ? top[0][6] : top[0][0]) + (hh ? top[1][0] : top[1][6])) & ~255u) | (hh ? 96u : 6u));
    Y[6] = (hh ? -INFINITY : __uint_as_float((__float_as_uint(top[0][1] + top[1][6]) & ~255u) | 22u));
    X[7] = __uint_as_float((__float_as_uint((hh ? top[0][6] : top[0][0]) + (hh ? top[1][1] : top[1][7])) & ~255u) | (hh ? 97u : 7u));
    Y[7] = (hh ? -INFINITY : __uint_as_float((__float_as_uint(top[0][1] + top[1][7]) & ~255u) | 23u));
    X[8] = __uint_as_float((__float_as_uint((hh ? top[0][7] : top[0][0]) + (hh ? top[1][0] : top[1][8])) & ~255u) | (hh ? 112u : 8u));
    Y[8] = (hh ? -INFINITY : __uint_as_float((__float_as_uint(top[0][2] + top[1][0]) & ~255u) | 32u));
    X[9] = __uint_as_float((__float_as_uint((hh ? top[0][7] : top[0][0]) + (hh ? top[1][1] : top[1][9])) & ~255u) | (hh ? 113u : 9u));
    Y[9] = (hh ? -INFINITY : __uint_as_float((__float_as_uint(top[0][2] + top[1][1]) & ~255u) | 33u));
    X[10] = __uint_as_float((__float_as_uint((hh ? top[0][8] : top[0][0]) + (hh ? top[1][0] : top[1][10])) & ~255u) | (hh ? 128u : 10u));
    Y[10] = (hh ? -INFINITY : __uint_as_float((__float_as_uint(top[0][2] + top[1][2]) & ~255u) | 34u));
    X[11] = __uint_as_float((__float_as_uint((hh ? top[0][9] : top[0][0]) + (hh ? top[1][0] : top[1][11])) & ~255u) | (hh ? 144u : 11u));
    Y[11] = (hh ? -INFINITY : __uint_as_float((__float_as_uint(top[0][2] + top[1][3]) & ~255u) | 35u));
    X[12] = __uint_as_float((__float_as_uint((hh ? top[0][10] : top[0][0]) + (hh ? top[1][0] : top[1][12])) & ~255u) | (hh ? 160u : 12u));
    Y[12] = (hh ? -INFINITY : __uint_as_float((__float_as_uint(top[0][2] + top[1][4]) & ~255u) | 36u));
    X[13] = __uint_as_float((__float_as_uint((hh ? top[0][11] : top[0][0]) + (hh ? top[1][0] : top[1][13])) & ~255u) | (hh ? 176u : 13u));
    Y[13] = (hh ? -INFINITY : __uint_as_float((__float_as_uint(top[0][3] + top[1][0]) & ~255u) | 48u));
    X[14] = __uint_as_float((__float_as_uint((hh ? top[0][12] : top[0][0]) + (hh ? top[1][0] : top[1][14])) & ~255u) | (hh ? 192u : 14u));
    Y[14] = (hh ? -INFINITY : __uint_as_float((__float_as_uint(top[0][3] + top[1][1]) & ~255u) | 49u));
    X[15] = __uint_as_float((__float_as_uint((hh ? top[0][13] : top[0][0]) + (hh ? top[1][0] : top[1][15])) & ~255u) | (hh ? 208u : 15u));
    Y[15] = (hh ? -INFINITY : __uint_as_float((__float_as_uint(top[0][3] + top[1][2]) & ~255u) | 50u));
    tk::sort16_desc(X); __builtin_amdgcn_sched_barrier(0); tk::sort16_desc(Y); __builtin_amdgcn_sched_barrier(0);
    tk::merge_prune(X, Y); __builtin_amdgcn_sched_barrier(0);
#pragma unroll
    for (int r = 0; r < 16; ++r) { const auto rr = __builtin_amdgcn_permlane32_swap(__float_as_uint(X[r]), __float_as_uint(X[r]), false, false); Y[r] = __uint_as_float(hh == 0 ? rr[1] : rr[0]); }
    tk::merge_prune(X, Y); __builtin_amdgcn_sched_barrier(0);
    const float vmax = X[0];
    int eidx[8]; float ev[8]; float sum = 0.f;
#pragma unroll
    for (int rr = 0; rr < 8; ++rr) {
        const float v = hh ? X[8 + rr] : X[rr];
        const unsigned bits = __float_as_uint(v); const int ci = (bits >> 4) & 15, cj = bits & 15;
        int ia = 0, ib = 0;
#pragma unroll
        for (int i = 0; i < 16; ++i) { ia = (ci == i) ? (int)(__float_as_uint(top[0][i]) & 127u) : ia; ib = (cj == i) ? (int)(__float_as_uint(top[1][i]) & 127u) : ib; }
        eidx[rr] = ia * 128 + ib;
        ev[rr] = __expf(v - vmax); sum += ev[rr];
    }
    { const auto rr = __builtin_amdgcn_permlane32_swap(__float_as_uint(sum), __float_as_uint(sum), false, false); sum = __uint_as_float(rr[0]) + __uint_as_float(rr[1]); }
    const float rs = __builtin_amdgcn_rcpf(sum);
    int* oi = SELI + (size_t)(g0 + r32) * 128 + h * 16 + hh * 8; float* og = SELG + (size_t)(g0 + r32) * 128 + h * 16 + hh * 8;
#pragma unroll
    for (int rr = 0; rr < 8; ++rr) { oi[rr] = eidx[rr]; og[rr] = ev[rr] * rs; }
}
__device__ __forceinline__ void topk_item(const bf16_t* QP, const bf16_t* KEYS, int* SELI, float* SELG, int g0, int h, int r32, int hh) {
    float top[2][16];
#pragma unroll
    for (int s = 0; s < 2; ++s) {
        bf16x8 qf[8];
        unsigned qoff = (unsigned)(r32 * 2048 + 8 * hh), koff = (unsigned)(r32 * 128 + 8 * hh); asm volatile("" : "+v"(qoff), "+v"(koff));
        const bf16_t* qb = QP + (size_t)g0 * 2048 + h * 256 + s * 128;
#pragma unroll
        for (int k = 0; k < 8; ++k) qf[k] = *(const bf16x8*)(qb + qoff + k * 16);
        float grp[4][16];
#pragma unroll
        for (int kb = 0; kb < 4; ++kb) {
            const bf16_t* kbp = KEYS + (size_t)(h * 2 + s) * 128 * 128 + kb * 32 * 128;
            f32x16 acc = {};
#pragma unroll
            for (int k = 0; k < 8; ++k) { const bf16x8 kf = *(const bf16x8*)(kbp + koff + k * 16); acc = __builtin_amdgcn_mfma_f32_32x32x16_bf16(kf, qf[k], acc, 0, 0, 0); }
#pragma unroll
            for (int r = 0; r < 16; ++r) { const int key = kb * 32 + (r & 3) + 8 * (r >> 2) + 4 * hh; grp[kb][r] = __uint_as_float((__float_as_uint(acc[r]) & ~127u) | (unsigned)key); }
            tk::sort16_desc(grp[kb]); __builtin_amdgcn_sched_barrier(0);
        }
        tk::merge_prune(grp[0], grp[1]); __builtin_amdgcn_sched_barrier(0); tk::merge_prune(grp[2], grp[3]); __builtin_amdgcn_sched_barrier(0); tk::merge_prune(grp[0], grp[2]); __builtin_amdgcn_sched_barrier(0);
        float oth[16];
#pragma unroll
        for (int r = 0; r < 16; ++r) { const auto rr = __builtin_amdgcn_permlane32_swap(__float_as_uint(grp[0][r]), __float_as_uint(grp[0][r]), false, false); oth[r] = __uint_as_float(hh == 0 ? rr[1] : rr[0]); }
        tk::merge_prune(grp[0], oth);
#pragma unroll
        for (int r = 0; r < 16; ++r) top[s][r] = grp[0][r];
        __builtin_amdgcn_sched_barrier(0);
    }
    topk_stage2(top, SELI, SELG, g0, h, r32, hh);
}
__device__ __forceinline__ void topk_item_lds(const bf16_t* QP, LAS const bf16_t* KL, int* SELI, float* SELG, int g0, int h, int r32, int hh) {
    float top[2][16];
#pragma unroll
    for (int s = 0; s < 2; ++s) {
        bf16x8 qf[8];
        unsigned qoff = (unsigned)(r32 * 2048 + 8 * hh), koff = (unsigned)(r32 * 128 + 8 * hh); asm volatile("" : "+v"(qoff), "+v"(koff));
        const bf16_t* qb = QP + (size_t)g0 * 2048 + h * 256 + s * 128;
#pragma unroll
        for (int k = 0; k < 8; ++k) qf[k] = *(const bf16x8*)(qb + qoff + k * 16);
        float grp[4][16];
#pragma unroll
        for (int kb = 0; kb < 4; ++kb) {
            LAS const bf16_t* kbp = KL + (s * 128 + kb * 32 + r32) * TK_LD + 8 * hh;
            f32x16 acc = {};
#pragma unroll
            for (int k = 0; k < 8; ++k) { const bf16x8 kf = *(LAS const bf16x8*)(kbp + k * 16); acc = __builtin_amdgcn_mfma_f32_32x32x16_bf16(kf, qf[k], acc, 0, 0, 0); }
#pragma unroll
            for (int r = 0; r < 16; ++r) { const int key = kb * 32 + (r & 3) + 8 * (r >> 2) + 4 * hh; grp[kb][r] = __uint_as_float((__float_as_uint(acc[r]) & ~127u) | (unsigned)key); }
            tk::sort16_desc(grp[kb]); __builtin_amdgcn_sched_barrier(0);
        }
        tk::merge_prune(grp[0], grp[1]); __builtin_amdgcn_sched_barrier(0); tk::merge_prune(grp[2], grp[3]); __builtin_amdgcn_sched_barrier(0); tk::merge_prune(grp[0], grp[2]); __builtin_amdgcn_sched_barrier(0);
        float oth[16];
#pragma unroll
        for (int r = 0; r < 16; ++r) { const auto rr = __builtin_amdgcn_permlane32_swap(__float_as_uint(grp[0][r]), __float_as_uint(grp[0][r]), false, false); oth[r] = __uint_as_float(hh == 0 ? rr[1] : rr[0]); }
        tk::merge_prune(grp[0], oth);
#pragma unroll
        for (int r = 0; r < 16; ++r) top[s][r] = grp[0][r];
        __builtin_amdgcn_sched_barrier(0);
    }
    topk_stage2(top, SELI, SELG, g0, h, r32, hh);
}

__device__ __forceinline__ void phase_peer_topk3(const Args& a, char* lds, int layer, bool latent_only) {
    const int tid = threadIdx.x, lane = tid & 63, r32 = lane & 31, hh = lane >> 5, wid = __builtin_amdgcn_readfirstlane(tid >> 6);
    const int h = blockIdx.x & 7, stripe = blockIdx.x >> 3, nstr = (gridDim.x >> 3) * NWAVE;
    const bf16_t* QP = (const bf16_t*)(a.ws + WS_QP);
    const bf16_t* KEYS = (const bf16_t*)(a.ws + WS_KEYS) + (size_t)layer * 8 * 2 * 128 * 128 + (size_t)h * 2 * 128 * 128;
    int* SELI = (int*)(a.ws + WS_SELI); float* SELG = (float*)(a.ws + WS_SELG);
    LAS bf16_t* KL = (LAS bf16_t*)((LAS char*)lds);
    for (int i = tid; i < 2 * 128 * 16; i += NTHR) { const int row = i >> 4, c8 = (i & 15) * 8; *(LAS u32x4*)(KL + row * TK_LD + c8) = *(const u32x4*)(KEYS + (size_t)row * 128 + c8); }
    __syncthreads();
    const int ngrp = latent_only ? (NB * SEQ) / 32 : MTOT / 32;
    for (int i = stripe * NWAVE + wid; i < ngrp; i += nstr) {
        const int g0 = latent_only ? peer_tok(i * 32, 1) : i * 32;
        topk_item_lds(QP, KL, SELI, SELG, g0, h, r32, hh);
    }
}
__device__ __forceinline__ void phase_peer_topk2(const Args& a, int layer, bool latent_only) {
    const int lane = threadIdx.x & 63, r32 = lane & 31, hh = lane >> 5, gw = blockIdx.x * NWAVE + __builtin_amdgcn_readfirstlane(threadIdx.x >> 6), ngw = gridDim.x * NWAVE;
    const bf16_t* QP = (const bf16_t*)(a.ws + WS_QP);
    const bf16_t* KEYS = (const bf16_t*)(a.ws + WS_KEYS) + (size_t)layer * 8 * 2 * 128 * 128;
    int* SELI = (int*)(a.ws + WS_SELI); float* SELG = (float*)(a.ws + WS_SELG);
    const int NIT = (MTOT / 32) * 8;
    for (int it = gw; it < NIT; it += ngw) {
        const int tg = it >> 3, h = it & 7, g0 = tg * 32;
        if (latent_only && row_variant(g0) == 2) continue;
        topk_item(QP, KEYS, SELI, SELG, g0, h, r32, hh);
    }
}

__device__ __forceinline__ void phase_peer_gather(const Args& a, int layer, int mode) {
    const int lane = threadIdx.x & 63, gw = blockIdx.x * NWAVE + (threadIdx.x >> 6), ngw = gridDim.x * NWAVE;
    unsigned char* ws = a.ws;
    bf16_t* H = (bf16_t*)(ws + WS_H); float* X1 = (float*)(ws + WS_X1);
    const bf16_t* PU = (const bf16_t*)(ws + WS_PU) + (size_t)layer * NEXP * D; const bf16_t* PV = (const bf16_t*)(ws + WS_PV) + (size_t)layer * NEXP * D;
    const int* SELI = (const int*)(ws + WS_SELI); const float* SELG = (const float*)(ws + WS_SELG);
    for (int g = gw; g < MTOT; g += ngw) {
        const int var = row_variant(g);
        if (mode == 1 && var == 2) continue;
        float hp[16], acc[16];
        {
            const u32x4 w0 = *(const u32x4*)(H + (size_t)g * D + lane * 16), w1 = *(const u32x4*)(H + (size_t)g * D + lane * 16 + 8);
            hp[0] = bflo(w0.x); hp[1] = bfhi(w0.x); hp[2] = bflo(w0.y); hp[3] = bfhi(w0.y); hp[4] = bflo(w0.z); hp[5] = bfhi(w0.z); hp[6] = bflo(w0.w); hp[7] = bfhi(w0.w);
            hp[8] = bflo(w1.x); hp[9] = bfhi(w1.x); hp[10] = bflo(w1.y); hp[11] = bfhi(w1.y); hp[12] = bflo(w1.z); hp[13] = bfhi(w1.z); hp[14] = bflo(w1.w); hp[15] = bfhi(w1.w);
#pragma unroll
            for (int d = 0; d < 16; ++d) acc[d] = 0.f;
        }
        const int myi0 = SELI[(size_t)g * 128 + lane], myi1 = SELI[(size_t)g * 128 + 64 + lane];
        const float myg0 = SELG[(size_t)g * 128 + lane], myg1 = SELG[(size_t)g * 128 + 64 + lane];
        for (int e = 0; e < 128; ++e) {
            const int ei = e < 64 ? __shfl(myi0, e) : __shfl(myi1, e - 64);
            const float eg = e < 64 ? __shfl(myg0, e) : __shfl(myg1, e - 64);
            const bf16_t* up = PU + (size_t)ei * D + lane * 16; const bf16_t* vp = PV + (size_t)ei * D + lane * 16;
            const u32x4 u0 = *(const u32x4*)up, u1 = *(const u32x4*)(up + 8), v0 = *(const u32x4*)vp, v1 = *(const u32x4*)(vp + 8);
            float dt = hp[0] * bflo(u0.x) + hp[1] * bfhi(u0.x) + hp[2] * bflo(u0.y) + hp[3] * bfhi(u0.y) + hp[4] * bflo(u0.z) + hp[5] * bfhi(u0.z) + hp[6] * bflo(u0.w) + hp[7] * bfhi(u0.w)
                     + hp[8] * bflo(u1.x) + hp[9] * bfhi(u1.x) + hp[10] * bflo(u1.y) + hp[11] * bfhi(u1.y) + hp[12] * bflo(u1.z) + hp[13] * bfhi(u1.z) + hp[14] * bflo(u1.w) + hp[15] * bfhi(u1.w);
            dt = wave_sum(dt);
            const float act = gelu_t(dt) * eg;
            acc[0] += act * bflo(v0.x); acc[1] += act * bfhi(v0.x); acc[2] += act * bflo(v0.y); acc[3] += act * bfhi(v0.y);
            acc[4] += act * bflo(v0.z); acc[5] += act * bfhi(v0.z); acc[6] += act * bflo(v0.w); acc[7] += act * bfhi(v0.w);
            acc[8] += act * bflo(v1.x); acc[9] += act * bfhi(v1.x); acc[10] += act * bflo(v1.y); acc[11] += act * bfhi(v1.y);
            acc[12] += act * bflo(v1.z); acc[13] += act * bfhi(v1.z); acc[14] += act * bflo(v1.w); acc[15] += act * bfhi(v1.w);
        }
        float* xr = X1 + (size_t)g * D + lane * 16;
        const float* g2 = modv(a, layer, var, 5) + lane * 16;
        float xn[16]; float ss = 0.f;
#pragma unroll
        for (int d = 0; d < 16; d += 4) {
            const f32x4 xv = *(const f32x4*)(xr + d), gv = *(const f32x4*)(g2 + d);
            xn[d] = xv.x + gv.x * acc[d]; xn[d + 1] = xv.y + gv.y * acc[d + 1]; xn[d + 2] = xv.z + gv.z * acc[d + 2]; xn[d + 3] = xv.w + gv.w * acc[d + 3];
            ss += xn[d] * xn[d] + xn[d + 1] * xn[d + 1] + xn[d + 2] * xn[d + 2] + xn[d + 3] * xn[d + 3];
        }
        const float rinv = rsqrtf(wave_sum(ss) * (1.f / D) + EPS);
        if (mode == 0) {
#pragma unroll
            for (int d = 0; d < 16; d += 4) { f32x4 o; o.x = xn[d]; o.y = xn[d + 1]; o.z = xn[d + 2]; o.w = xn[d + 3]; *(f32x4*)(xr + d) = o; }
            const float* gn = a.in[6] + D + lane * 16; const float* sh = modv(a, 1, var, 0) + lane * 16; const float* sc = modv(a, 1, var, 1) + lane * 16;
            unsigned w[8];
#pragma unroll
            for (int d = 0; d < 16; d += 2) w[d >> 1] = pk2(xn[d] * rinv * gn[d] * (1.f + sc[d]) + sh[d], xn[d + 1] * rinv * gn[d + 1] * (1.f + sc[d + 1]) + sh[d + 1]);
            u32x4 o0, o1; o0.x = w[0]; o0.y = w[1]; o0.z = w[2]; o0.w = w[3]; o1.x = w[4]; o1.y = w[5]; o1.z = w[6]; o1.w = w[7];
            *(u32x4*)(H + (size_t)g * D + lane * 16) = o0; *(u32x4*)(H + (size_t)g * D + lane * 16 + 8) = o1;
        } else {
            const int b = g / RPB, t = g - b * RPB - CTXL;
            float* op = a.out + ((size_t)b * SEQ + t) * D + lane * 16; const float* gn = a.in[28] + lane * 16;
#pragma unroll
            for (int d = 0; d < 16; d += 4) { f32x4 o; o.x = xn[d] * rinv * gn[d]; o.y = xn[d + 1] * rinv * gn[d + 1]; o.z = xn[d + 2] * rinv * gn[d + 2]; o.w = xn[d + 3] * rinv * gn[d + 3]; *(f32x4*)(op + d) = o; }
        }
    }
}

typedef __bf16 bf16x2_t __attribute__((ext_vector_type(2)));
__device__ __forceinline__ float dot2bf(unsigned w, unsigned x, float acc) { return __builtin_amdgcn_fdot2_f32_bf16(__builtin_bit_cast(bf16x2_t, w), __builtin_bit_cast(bf16x2_t, x), acc, false); }
struct Row8 { u32x4 c[8]; };
__device__ __forceinline__ void load_row8(Row8& r, const bf16_t* p) {
#pragma unroll
    for (int c = 0; c < 8; ++c) r.c[c] = *(const u32x4*)(p + c * 128);
}
__device__ __forceinline__ float dot_row8(const Row8& r, const u32x4 (&hp)[8]) {
    float a0 = 0.f, a1 = 0.f, a2 = 0.f, a3 = 0.f;
#pragma unroll
    for (int c = 0; c < 8; ++c) { a0 = dot2bf(r.c[c].x, hp[c].x, a0); a1 = dot2bf(r.c[c].y, hp[c].y, a1); a2 = dot2bf(r.c[c].z, hp[c].z, a2); a3 = dot2bf(r.c[c].w, hp[c].w, a3); }
    float s = (a0 + a1) + (a2 + a3);
    s += __shfl_xor(s, 1); s += __shfl_xor(s, 2); s += __shfl_xor(s, 4); s += __shfl_xor(s, 8);
    return s;
}
__device__ __forceinline__ void fma_row(float (&acc)[16], const u32x4& v0, const u32x4& v1, float a) {
    acc[0] += a * bflo(v0.x); acc[1] += a * bfhi(v0.x); acc[2] += a * bflo(v0.y); acc[3] += a * bfhi(v0.y);
    acc[4] += a * bflo(v0.z); acc[5] += a * bfhi(v0.z); acc[6] += a * bflo(v0.w); acc[7] += a * bfhi(v0.w);
    acc[8] += a * bflo(v1.x); acc[9] += a * bfhi(v1.x); acc[10] += a * bflo(v1.y); acc[11] += a * bfhi(v1.y);
    acc[12] += a * bflo(v1.z); acc[13] += a * bfhi(v1.z); acc[14] += a * bflo(v1.w); acc[15] += a * bfhi(v1.w);
}
__device__ __forceinline__ void phase_peer_gather2(const Args& a, char* lds, int layer, int mode) {
    const int lane = threadIdx.x & 63, wid = threadIdx.x >> 6, gw = blockIdx.x * NWAVE + wid, ngw = gridDim.x * NWAVE;
    const int grp = lane >> 4, sub = lane & 15;
    unsigned char* ws = a.ws;
    bf16_t* H = (bf16_t*)(ws + WS_H); float* X1 = (float*)(ws + WS_X1);
    const bf16_t* PU = (const bf16_t*)(ws + WS_PU) + (size_t)layer * NEXP * D; const bf16_t* PV = (const bf16_t*)(ws + WS_PV) + (size_t)layer * NEXP * D;
    const int* SELI = (const int*)(ws + WS_SELI); const float* SELG = (const float*)(ws + WS_SELG);
    LAS int* lidx = (LAS int*)((LAS char*)lds + wid * 2048);
    LAS float* lgate = (LAS float*)(lidx + 128);
    LAS float* lact = lgate + 128;
    for (int g = gw; g < MTOT; g += ngw) {
        const int var = row_variant(g);
        if (mode == 1 && var == 2) continue;
        lidx[lane] = SELI[(size_t)g * 128 + lane]; lidx[64 + lane] = SELI[(size_t)g * 128 + 64 + lane];
        lgate[lane] = SELG[(size_t)g * 128 + lane]; lgate[64 + lane] = SELG[(size_t)g * 128 + 64 + lane];
        u32x4 hp[8];
#pragma unroll
        for (int c = 0; c < 8; ++c) hp[c] = *(const u32x4*)(H + (size_t)g * D + c * 128 + sub * 8);
        {
            Row8 ra, rb;
            load_row8(ra, PU + (size_t)lidx[grp] * D + sub * 8);
            for (int it = 0; it < 32; it += 2) {
                load_row8(rb, PU + (size_t)lidx[(it + 1) * 4 + grp] * D + sub * 8);
                { const float s = dot_row8(ra, hp); const int e = it * 4 + grp; if (sub == 0) lact[e] = gelu_t(s) * lgate[e]; }
                if (it + 2 < 32) load_row8(ra, PU + (size_t)lidx[(it + 2) * 4 + grp] * D + sub * 8);
                { const float s = dot_row8(rb, hp); const int e = (it + 1) * 4 + grp; if (sub == 0) lact[e] = gelu_t(s) * lgate[e]; }
            }
        }
        float acc[16];
#pragma unroll
        for (int d = 0; d < 16; ++d) acc[d] = 0.f;
        {
            u32x4 va[4][2], vb[4][2];
#pragma unroll
            for (int k = 0; k < 4; ++k) { const bf16_t* p = PV + (size_t)lidx[k] * D + lane * 8; va[k][0] = *(const u32x4*)p; va[k][1] = *(const u32x4*)(p + 512); }
            for (int e = 0; e < 128; e += 8) {
#pragma unroll
                for (int k = 0; k < 4; ++k) { const bf16_t* p = PV + (size_t)lidx[e + 4 + k] * D + lane * 8; vb[k][0] = *(const u32x4*)p; vb[k][1] = *(const u32x4*)(p + 512); }
#pragma unroll
                for (int k = 0; k < 4; ++k) fma_row(acc, va[k][0], va[k][1], lact[e + k]);
                if (e + 8 < 128) {
#pragma unroll
                    for (int k = 0; k < 4; ++k) { const bf16_t* p = PV + (size_t)lidx[e + 8 + k] * D + lane * 8; va[k][0] = *(const u32x4*)p; va[k][1] = *(const u32x4*)(p + 512); }
                }
#pragma unroll
                for (int k = 0; k < 4; ++k) fma_row(acc, vb[k][0], vb[k][1], lact[e + 4 + k]);
            }
        }
        float* xr = X1 + (size_t)g * D + lane * 8;
        const float* g2 = modv(a, layer, var, 5) + lane * 8;
        float xn[16]; float ss = 0.f;
#pragma unroll
        for (int hh = 0; hh < 2; ++hh)
#pragma unroll
            for (int d = 0; d < 8; d += 4) {
                const f32x4 xv = *(const f32x4*)(xr + hh * 512 + d), gv = *(const f32x4*)(g2 + hh * 512 + d);
                const int o = hh * 8 + d;
                xn[o] = xv.x + gv.x * acc[o]; xn[o + 1] = xv.y + gv.y * acc[o + 1]; xn[o + 2] = xv.z + gv.z * acc[o + 2]; xn[o + 3] = xv.w + gv.w * acc[o + 3];
                ss += xn[o] * xn[o] + xn[o + 1] * xn[o + 1] + xn[o + 2] * xn[o + 2] + xn[o + 3] * xn[o + 3];
            }
        const float rinv = rsqrtf(wave_sum(ss) * (1.f / D) + EPS);
        if (mode == 0) {
            const float* gn = a.in[6] + D + lane * 8; const float* sh = modv(a, 1, var, 0) + lane * 8; const float* sc = modv(a, 1, var, 1) + lane * 8;
#pragma unroll
            for (int hh = 0; hh < 2; ++hh) {
                const int o = hh * 8;
                f32x4 o0, o1; o0.x = xn[o]; o0.y = xn[o + 1]; o0.z = xn[o + 2]; o0.w = xn[o + 3]; o1.x = xn[o + 4]; o1.y = xn[o + 5]; o1.z = xn[o + 6]; o1.w = xn[o + 7];
                *(f32x4*)(xr + hh * 512) = o0; *(f32x4*)(xr + hh * 512 + 4) = o1;
                unsigned w[4];
#pragma unroll
                for (int d = 0; d < 8; d += 2) { const int cc = hh * 512 + d; w[d >> 1] = pk2(xn[o + d] * rinv * gn[cc] * (1.f + sc[cc]) + sh[cc], xn[o + d + 1] * rinv * gn[cc + 1] * (1.f + sc[cc + 1]) + sh[cc + 1]); }
                u32x4 ow; ow.x = w[0]; ow.y = w[1]; ow.z = w[2]; ow.w = w[3];
                *(u32x4*)(H + (size_t)g * D + hh * 512 + lane * 8) = ow;
            }
        } else {
            const int b = g / RPB, t = g - b * RPB - CTXL;
            float* op = a.out + ((size_t)b * SEQ + t) * D + lane * 8; const float* gn = a.in[28] + lane * 8;
#pragma unroll
            for (int hh = 0; hh < 2; ++hh)
#pragma unroll
                for (int d = 0; d < 8; d += 4) { const int o = hh * 8 + d, cc = hh * 512 + d;
                    f32x4 ov; ov.x = xn[o] * rinv * gn[cc]; ov.y = xn[o + 1] * rinv * gn[cc + 1]; ov.z = xn[o + 2] * rinv * gn[cc + 2]; ov.w = xn[o + 3] * rinv * gn[cc + 3]; *(f32x4*)(op + cc) = ov; }
        }
    }
}

__device__ __forceinline__ float ub0(unsigned w) { return (float)(w & 0xffu); }
__device__ __forceinline__ float ub1(unsigned w) { return (float)((w >> 8) & 0xffu); }
__device__ __forceinline__ float ub2(unsigned w) { return (float)((w >> 16) & 0xffu); }
__device__ __forceinline__ float ub3(unsigned w) { return (float)(w >> 24); }
struct RowU { u32x4 c[4]; };
__device__ __forceinline__ void load_rowu(RowU& r, const unsigned char* p) {
#pragma unroll
    for (int c = 0; c < 4; ++c) r.c[c] = *(const u32x4*)(p + c * 256);
}
__device__ __forceinline__ float dot_rowu(const RowU& r, const float (&hp)[64]) {
    float a0 = 0.f, a1 = 0.f, a2 = 0.f, a3 = 0.f;
#pragma unroll
    for (int c = 0; c < 4; ++c) {
        const unsigned w0 = r.c[c].x, w1 = r.c[c].y, w2 = r.c[c].z, w3 = r.c[c].w; const int o = c * 16;
        a0 += hp[o + 0] * ub0(w0); a1 += hp[o + 1] * ub1(w0); a2 += hp[o + 2] * ub2(w0); a3 += hp[o + 3] * ub3(w0);
        a0 += hp[o + 4] * ub0(w1); a1 += hp[o + 5] * ub1(w1); a2 += hp[o + 6] * ub2(w1); a3 += hp[o + 7] * ub3(w1);
        a0 += hp[o + 8] * ub0(w2); a1 += hp[o + 9] * ub1(w2); a2 += hp[o + 10] * ub2(w2); a3 += hp[o + 11] * ub3(w2);
        a0 += hp[o + 12] * ub0(w3); a1 += hp[o + 13] * ub1(w3); a2 += hp[o + 14] * ub2(w3); a3 += hp[o + 15] * ub3(w3);
    }
    float s = (a0 + a1) + (a2 + a3);
    s += __shfl_xor(s, 1); s += __shfl_xor(s, 2); s += __shfl_xor(s, 4); s += __shfl_xor(s, 8);
    return s;
}
__device__ __forceinline__ void fma_rowv(float (&acc)[16], const u32x4& v, float a) {
    acc[0] += a * ub0(v.x); acc[1] += a * ub1(v.x); acc[2] += a * ub2(v.x); acc[3] += a * ub3(v.x);
    acc[4] += a * ub0(v.y); acc[5] += a * ub1(v.y); acc[6] += a * ub2(v.y); acc[7] += a * ub3(v.y);
    acc[8] += a * ub0(v.z); acc[9] += a * ub1(v.z); acc[10] += a * ub2(v.z); acc[11] += a * ub3(v.z);
    acc[12] += a * ub0(v.w); acc[13] += a * ub1(v.w); acc[14] += a * ub2(v.w); acc[15] += a * ub3(v.w);
}
__device__ __forceinline__ void phase_peer_gather3(const Args& a, char* lds, int layer, int mode) {
    const int lane = threadIdx.x & 63, wid = __builtin_amdgcn_readfirstlane(threadIdx.x >> 6), gw = blockIdx.x * NWAVE + wid, ngw = gridDim.x * NWAVE;
    const int grp = lane >> 4, sub = lane & 15;
    unsigned char* ws = a.ws;
    bf16_t* H = (bf16_t*)(ws + WS_H); float* X1 = (float*)(ws + WS_X1);
    const unsigned char* PU = ws + WS_PU + (size_t)layer * NEXP * D; const unsigned char* PV = ws + WS_PV + (size_t)layer * NEXP * D;
    const float* SCU = (const float*)(ws + WS_SCU) + layer * NEXP; const float* SCV = (const float*)(ws + WS_SCV) + layer * NEXP;
    const int* SELI = (const int*)(ws + WS_SELI); const float* SELG = (const float*)(ws + WS_SELG);
    LAS int* lidx = (LAS int*)((LAS char*)lds + wid * 2048);
    LAS float* lgu = (LAS float*)(lidx + 128);
    LAS float* lact = lgu + 128;
    for (int g = gw; g < MTOT; g += ngw) {
        const int var = row_variant(g);
        if (mode == 1 && var == 2) continue;
        {
            const int i0 = SELI[(size_t)g * 128 + lane], i1 = SELI[(size_t)g * 128 + 64 + lane];
            lidx[lane] = i0; lidx[64 + lane] = i1;
            lgu[lane] = SCU[i0]; lgu[64 + lane] = SCU[i1];
        }
        float hp[64]; float shp = 0.f;
#pragma unroll
        for (int c = 0; c < 4; ++c) {
            const u32x4 w0 = *(const u32x4*)(H + (size_t)g * D + c * 256 + sub * 16), w1 = *(const u32x4*)(H + (size_t)g * D + c * 256 + sub * 16 + 8);
            const int o = c * 16;
            hp[o + 0] = bflo(w0.x); hp[o + 1] = bfhi(w0.x); hp[o + 2] = bflo(w0.y); hp[o + 3] = bfhi(w0.y); hp[o + 4] = bflo(w0.z); hp[o + 5] = bfhi(w0.z); hp[o + 6] = bflo(w0.w); hp[o + 7] = bfhi(w0.w);
            hp[o + 8] = bflo(w1.x); hp[o + 9] = bfhi(w1.x); hp[o + 10] = bflo(w1.y); hp[o + 11] = bfhi(w1.y); hp[o + 12] = bflo(w1.z); hp[o + 13] = bfhi(w1.z); hp[o + 14] = bflo(w1.w); hp[o + 15] = bfhi(w1.w);
        }
#pragma unroll
        for (int d = 0; d < 64; ++d) shp += hp[d];
        shp += __shfl_xor(shp, 1); shp += __shfl_xor(shp, 2); shp += __shfl_xor(shp, 4); shp += __shfl_xor(shp, 8);
        const float bias = 128.f * shp;
        {
            RowU r0, r1, r2, r3;
            load_rowu(r0, PU + (size_t)lidx[0 * 4 + grp] * D + sub * 16); load_rowu(r1, PU + (size_t)lidx[1 * 4 + grp] * D + sub * 16);
            load_rowu(r2, PU + (size_t)lidx[2 * 4 + grp] * D + sub * 16); load_rowu(r3, PU + (size_t)lidx[3 * 4 + grp] * D + sub * 16);
#define GU_STEP(R, IT) { const float s = dot_rowu(R, hp) - bias; const int e = (IT) * 4 + grp; const float su = lgu[e]; \
                if ((IT) + 4 < 32) load_rowu(R, PU + (size_t)lidx[((IT) + 4) * 4 + grp] * D + sub * 16); \
                if (sub == 0) lact[e] = gelu_t(s * su); }
            for (int it = 0; it < 32; it += 4) { GU_STEP(r0, it) GU_STEP(r1, it + 1) GU_STEP(r2, it + 2) GU_STEP(r3, it + 3) }
#undef GU_STEP
        }
        {
            const float g0 = SELG[(size_t)g * 128 + lane], g1 = SELG[(size_t)g * 128 + 64 + lane];
            const float a0 = lact[lane] * g0 * SCV[lidx[lane]], a1 = lact[64 + lane] * g1 * SCV[lidx[64 + lane]];
            lact[lane] = a0; lact[64 + lane] = a1;
        }
        float acc[16]; float sact = 0.f;
#pragma unroll
        for (int d = 0; d < 16; ++d) acc[d] = 0.f;
        {
            u32x4 va[8];
#pragma unroll
            for (int k = 0; k < 8; ++k) va[k] = *(const u32x4*)(PV + (size_t)lidx[k] * D + lane * 16);
            for (int e = 0; e < 128; e += 8) {
#pragma unroll
                for (int k = 0; k < 8; ++k) {
                    const float av = lact[e + k]; sact += av;
                    fma_rowv(acc, va[k], av);
                    if (e + 8 < 128) va[k] = *(const u32x4*)(PV + (size_t)lidx[e + 8 + k] * D + lane * 16);
                }
            }
        }
        const float vb = 128.f * sact;
        float* xr = X1 + (size_t)g * D + lane * 16;
        const float* g2 = modv(a, layer, var, 5) + lane * 16;
        float xn[16]; float ss = 0.f;
#pragma unroll
        for (int d = 0; d < 16; d += 4) {
            const f32x4 xv = *(const f32x4*)(xr + d), gv = *(const f32x4*)(g2 + d);
            xn[d] = xv.x + gv.x * (acc[d] - vb); xn[d + 1] = xv.y + gv.y * (acc[d + 1] - vb); xn[d + 2] = xv.z + gv.z * (acc[d + 2] - vb); xn[d + 3] = xv.w + gv.w * (acc[d + 3] - vb);
            ss += xn[d] * xn[d] + xn[d + 1] * xn[d + 1] + xn[d + 2] * xn[d + 2] + xn[d + 3] * xn[d + 3];
        }
        const float rinv = rsqrtf(wave_sum(ss) * (1.f / D) + EPS);
        if (mode == 0) {
#pragma unroll
            for (int d = 0; d < 16; d += 4) { f32x4 o; o.x = xn[d]; o.y = xn[d + 1]; o.z = xn[d + 2]; o.w = xn[d + 3]; *(f32x4*)(xr + d) = o; }
            const float* gn = a.in[6] + D + lane * 16; const float* sh = modv(a, 1, var, 0) + lane * 16; const float* sc = modv(a, 1, var, 1) + lane * 16;
            unsigned w[8];
#pragma unroll
            for (int d = 0; d < 16; d += 2) w[d >> 1] = pk2(xn[d] * rinv * gn[d] * (1.f + sc[d]) + sh[d], xn[d + 1] * rinv * gn[d + 1] * (1.f + sc[d + 1]) + sh[d + 1]);
            u32x4 o0, o1; o0.x = w[0]; o0.y = w[1]; o0.z = w[2]; o0.w = w[3]; o1.x = w[4]; o1.y = w[5]; o1.z = w[6]; o1.w = w[7];
            *(u32x4*)(H + (size_t)g * D + lane * 16) = o0; *(u32x4*)(H + (size_t)g * D + lane * 16 + 8) = o1;
        } else {
            const int b = g / RPB, t = g - b * RPB - CTXL;
            float* op = a.out + ((size_t)b * SEQ + t) * D + lane * 16; const float* gn = a.in[28] + lane * 16;
#pragma unroll
            for (int d = 0; d < 16; d += 4) { f32x4 o; o.x = xn[d] * rinv * gn[d]; o.y = xn[d + 1] * rinv * gn[d + 1]; o.z = xn[d + 2] * rinv * gn[d + 2]; o.w = xn[d + 3] * rinv * gn[d + 3]; *(f32x4*)(op + d) = o; }
        }
    }
}

__device__ __forceinline__ int peer_tok(int i, int mode) { return mode == 1 ? i + CTXL + (i >= SEQ ? CTXL : 0) : i; }
__device__ __forceinline__ float dot16u(const u32x4& w, const float (&hp)[16]) {
    float a0 = hp[0] * ub0(w.x) + hp[4] * ub0(w.y), a1 = hp[1] * ub1(w.x) + hp[5] * ub1(w.y), a2 = hp[2] * ub2(w.x) + hp[6] * ub2(w.y), a3 = hp[3] * ub3(w.x) + hp[7] * ub3(w.y);
    a0 += hp[8] * ub0(w.z) + hp[12] * ub0(w.w); a1 += hp[9] * ub1(w.z) + hp[13] * ub1(w.w); a2 += hp[10] * ub2(w.z) + hp[14] * ub2(w.w); a3 += hp[11] * ub3(w.z) + hp[15] * ub3(w.w);
    return (a0 + a1) + (a2 + a3);
}
#define DPP_I(v, ctrl) __builtin_amdgcn_update_dpp(0, (v), (ctrl), 0xf, 0xf, true)
__device__ __forceinline__ int sum8_i(int v) {
    v += DPP_I(v, 0xB1);
    v += DPP_I(v, 0x4E);
    v += DPP_I(v, 0x141);
    return v;
}
__device__ __forceinline__ int sum_eg_i(int v) {
    v += DPP_I(v, 0x128);
    { const auto r = __builtin_amdgcn_permlane16_swap((unsigned)v, (unsigned)v, false, false); v = (int)(r[0] + r[1]); }
    { const auto r = __builtin_amdgcn_permlane32_swap((unsigned)v, (unsigned)v, false, false); v = (int)(r[0] + r[1]); }
    return v;
}
__device__ __forceinline__ void gu_stage(u32x4 (&seg)[16], u32x4& hw, LAS int* lb, int i0, int i1, const unsigned char* hrow, const unsigned char* PUx, int lane, int eg, unsigned loff) {
    lb[lane] = i0; lb[64 + lane] = i1;
    hw = *(const u32x4*)hrow;
#pragma unroll
    for (int st = 0; st < 16; ++st) seg[st] = *(const u32x4*)(PUx + ((unsigned)lb[st * 8 + eg] * 128u + loff));
}
__device__ __forceinline__ void gu_compute(const u32x4 (&seg)[16], const u32x4& hw, LAS float* lpart, float* prow, int lane, int eg, int sub, bool valid) {
#pragma unroll
    for (int st = 0; st < 16; ++st) {
        int d = __builtin_amdgcn_sdot4((int)seg[st].x, (int)hw.x, 0, false);
        d = __builtin_amdgcn_sdot4((int)seg[st].y, (int)hw.y, d, false); d = __builtin_amdgcn_sdot4((int)seg[st].z, (int)hw.z, d, false); d = __builtin_amdgcn_sdot4((int)seg[st].w, (int)hw.w, d, false);
        d = sum8_i(d);
        if (sub == 0) lpart[st * 8 + eg] = (float)d;
    }
    if (valid) { prow[lane] = lpart[lane]; prow[64 + lane] = lpart[64 + lane]; }
}
__device__ __forceinline__ void phase_gu(const Args& a, char* lds, int layer, int mode) {
    const int lane = threadIdx.x & 63, wid = __builtin_amdgcn_readfirstlane(threadIdx.x >> 6), eg = lane >> 3, sub = lane & 7;
    const int x = blockIdx.x & 7, stripe = blockIdx.x >> 3, nstr = (gridDim.x >> 3) * NWAVE, ntok = mode == 1 ? NB * SEQ : MTOT;
    unsigned char* ws = a.ws;
    const unsigned char* H8 = ws + WS_H8 + x * 128 + sub * 16;
    const unsigned char* PUx = ws + WS_PU + (size_t)layer * NEXP * D + (size_t)x * NEXP * 128; const unsigned loff = (unsigned)(sub * 16);
    const int* SELI = (const int*)(ws + WS_SELI); float* PART = (float*)(ws + WS_PART) + (size_t)x * MTOT * 128;
    LAS int* lidx = (LAS int*)((LAS char*)lds + wid * 2048);
    LAS float* lpart = (LAS float*)(lidx + 256);
    const int first = stripe * NWAVE + wid;
#define G_TOK(k) peer_tok(min(first + (k) * nstr, ntok - 1), mode)
#define G_VALID(k) (first + (k) * nstr < ntok)
    u32x4 segA[16], segB[16], hwA, hwB;
    int p0, p1;
    { const int g = G_TOK(0); p0 = SELI[(size_t)g * 128 + lane]; p1 = SELI[(size_t)g * 128 + 64 + lane];
      gu_stage(segA, hwA, lidx, p0, p1, H8 + (size_t)g * D, PUx, lane, eg, loff); }
    { const int g = G_TOK(1); p0 = SELI[(size_t)g * 128 + lane]; p1 = SELI[(size_t)g * 128 + 64 + lane]; }
    for (int k = 0; G_VALID(k); k += 2) {
        { const int g1 = G_TOK(k + 1); gu_stage(segB, hwB, lidx + 128, p0, p1, H8 + (size_t)g1 * D, PUx, lane, eg, loff); }
        { const int g2 = G_TOK(k + 2); p0 = SELI[(size_t)g2 * 128 + lane]; p1 = SELI[(size_t)g2 * 128 + 64 + lane]; }
        gu_compute(segA, hwA, lpart, PART + (size_t)G_TOK(k) * 128, lane, eg, sub, true);
        { const int g2 = G_TOK(k + 2); gu_stage(segA, hwA, lidx, p0, p1, H8 + (size_t)g2 * D, PUx, lane, eg, loff); }
        { const int g3 = G_TOK(k + 3); p0 = SELI[(size_t)g3 * 128 + lane]; p1 = SELI[(size_t)g3 * 128 + 64 + lane]; }
        gu_compute(segB, hwB, lpart, PART + (size_t)G_TOK(k + 1) * 128, lane, eg, sub, G_VALID(k + 1));
    }
}
__device__ __forceinline__ void phase_gact(const Args& a, int layer, int mode) {
    const int lane = threadIdx.x & 63, gw = blockIdx.x * NWAVE + (threadIdx.x >> 6), ngw = gridDim.x * NWAVE, ntok = mode == 1 ? NB * SEQ : MTOT;
    unsigned char* ws = a.ws;
    const float* PART = (const float*)(ws + WS_PART); const int* SELI = (const int*)(ws + WS_SELI); const float* SELG = (const float*)(ws + WS_SELG);
    const float* SCU = (const float*)(ws + WS_SCU) + layer * NEXP; const float* SCV = (const float*)(ws + WS_SCV) + layer * NEXP;
    const float* SH = (const float*)(ws + WS_SH); short* ACT16 = (short*)(ws + WS_ACT16); float* SA = (float*)(ws + WS_SA);
    for (int i = gw; i < ntok; i += ngw) {
        const int g = peer_tok(i, mode);
        const float sh = SH[g];
        float av[2];
#pragma unroll
        for (int hf = 0; hf < 2; ++hf) {
            const size_t o = (size_t)g * 128 + hf * 64 + lane;
            float sdot = 0.f;
#pragma unroll
            for (int xx = 0; xx < 8; ++xx) sdot += PART[(size_t)xx * MTOT * 128 + o];
            const int id = SELI[o];
            av[hf] = gelu_t(sdot * sh * SCU[id]) * SELG[o] * SCV[id];
        }
        float mx = fmaxf(fabsf(av[0]), fabsf(av[1]));
#pragma unroll
        for (int of = 1; of < 64; of <<= 1) mx = fmaxf(mx, __shfl_xor(mx, of));
        mx = fmaxf(mx, 1e-30f); const float inv = 32767.f / mx;
#pragma unroll
        for (int hf = 0; hf < 2; ++hf) {
            const int e = hf * 64 + lane, st = e >> 3, eg = e & 7, pos = (((st >> 1) * 8 + eg) << 1) | (st & 1);
            ACT16[(size_t)g * 128 + pos] = (short)__float2int_rn(av[hf] * inv);
        }
        if (lane == 0) SA[g] = mx * (1.f / 32767.f);
    }
}
__device__ __forceinline__ void gv_stage(u32x4 (&seg)[16], LAS int* lb, int i0, int i1, const unsigned char* PVx, int lane, int eg, unsigned loff) {
    lb[lane] = i0; lb[64 + lane] = i1;
#pragma unroll
    for (int st = 0; st < 16; ++st) seg[st] = *(const u32x4*)(PVx + ((unsigned)lb[st * 8 + eg] * 128u + loff));
}
typedef short s16x2_t __attribute__((ext_vector_type(2)));
__device__ __forceinline__ int dot2i16(unsigned w, unsigned aw, int acc) { return __builtin_amdgcn_sdot2(__builtin_bit_cast(s16x2_t, w), __builtin_bit_cast(s16x2_t, aw), acc, false); }
__device__ __forceinline__ void gv_pair(int (&acc)[16], const u32x4& va, const u32x4& vb, unsigned aw) {
#define GV_D(d, o) acc[o + 0] = dot2i16(__builtin_amdgcn_perm(vb.d, va.d, 0x0c040c00u), aw, acc[o + 0]); acc[o + 1] = dot2i16(__builtin_amdgcn_perm(vb.d, va.d, 0x0c050c01u), aw, acc[o + 1]); \
                   acc[o + 2] = dot2i16(__builtin_amdgcn_perm(vb.d, va.d, 0x0c060c02u), aw, acc[o + 2]); acc[o + 3] = dot2i16(__builtin_amdgcn_perm(vb.d, va.d, 0x0c070c03u), aw, acc[o + 3]);
    GV_D(x, 0) GV_D(y, 4) GV_D(z, 8) GV_D(w, 12)
#undef GV_D
}
__device__ __forceinline__ void gv_compute(const u32x4 (&seg)[16], const unsigned (&aw)[8], float sa, float* xr, const float* g2, int eg, bool valid) {
    int acc[16]; int sq = 0;
#pragma unroll
    for (int k = 0; k < 16; ++k) acc[k] = 0;
#pragma unroll
    for (int s2 = 0; s2 < 8; ++s2) { gv_pair(acc, seg[2 * s2], seg[2 * s2 + 1], aw[s2]); sq += (int)(short)(aw[s2] & 0xffffu) + ((int)aw[s2] >> 16); }
#pragma unroll
    for (int k = 0; k < 16; ++k) acc[k] = sum_eg_i(acc[k]);
    sq = sum_eg_i(sq);
    if (eg == 0 && valid) {
        const int vb = 128 * sq;
#pragma unroll
        for (int d = 0; d < 16; d += 4) {
            const f32x4 xv = *(const f32x4*)(xr + d), gv = *(const f32x4*)(g2 + d);
            f32x4 o; o.x = xv.x + gv.x * (sa * (float)(acc[d] - vb)); o.y = xv.y + gv.y * (sa * (float)(acc[d + 1] - vb)); o.z = xv.z + gv.z * (sa * (float)(acc[d + 2] - vb)); o.w = xv.w + gv.w * (sa * (float)(acc[d + 3] - vb));
            *(f32x4*)(xr + d) = o;
        }
    }
}
__device__ __forceinline__ void phase_gv(const Args& a, char* lds, int layer, int mode) {
    const int lane = threadIdx.x & 63, wid = __builtin_amdgcn_readfirstlane(threadIdx.x >> 6), eg = lane >> 3, sub = lane & 7;
    const int x = blockIdx.x & 7, stripe = blockIdx.x >> 3, nstr = (gridDim.x >> 3) * NWAVE, ntok = mode == 1 ? NB * SEQ : MTOT;
    unsigned char* ws = a.ws;
    float* X1 = (float*)(ws + WS_X1) + x * 128 + sub * 16;
    const unsigned char* PVx = ws + WS_PV + (size_t)layer * NEXP * D + (size_t)x * NEXP * 128; const unsigned loff = (unsigned)(sub * 16);
    const int* SELI = (const int*)(ws + WS_SELI); const unsigned* ACTW = (const unsigned*)(ws + WS_ACT16) + eg; const float* SA = (const float*)(ws + WS_SA);
    LAS int* lidx = (LAS int*)((LAS char*)lds + wid * 2048);
    const int first = stripe * NWAVE + wid;
    u32x4 segA[16], segB[16];
    unsigned awA[8], awB[8]; float saA, saB;
    int p0, p1;
#define GV_PREF(k) { const int g_ = G_TOK(k); p0 = SELI[(size_t)g_ * 128 + lane]; p1 = SELI[(size_t)g_ * 128 + 64 + lane]; }
#define GV_AW(AW, SAV, k) { const int g_ = G_TOK(k); _Pragma("unroll") for (int s2 = 0; s2 < 8; ++s2) AW[s2] = ACTW[(size_t)g_ * 64 + s2 * 8]; SAV = SA[g_]; }
#define GV_G2(k) (modv(a, layer, row_variant(G_TOK(k)), 5) + x * 128 + sub * 16)
    GV_PREF(0) gv_stage(segA, lidx, p0, p1, PVx, lane, eg, loff); GV_AW(awA, saA, 0)
    GV_PREF(1)
    for (int k = 0; G_VALID(k); k += 2) {
        gv_stage(segB, lidx + 128, p0, p1, PVx, lane, eg, loff); GV_AW(awB, saB, k + 1)
        GV_PREF(k + 2)
        gv_compute(segA, awA, saA, X1 + (size_t)G_TOK(k) * D, GV_G2(k), eg, true);
        gv_stage(segA, lidx, p0, p1, PVx, lane, eg, loff); GV_AW(awA, saA, k + 2)
        GV_PREF(k + 3)
        gv_compute(segB, awB, saB, X1 + (size_t)G_TOK(k + 1) * D, GV_G2(k + 1), eg, G_VALID(k + 1));
    }
#undef GV_PREF
#undef GV_AW
#undef GV_G2
#undef G_TOK
#undef G_VALID
}
__device__ __forceinline__ void phase_finalnorm(const Args& a) {
    const int lane = threadIdx.x & 63, gw = blockIdx.x * NWAVE + (threadIdx.x >> 6), ngw = gridDim.x * NWAVE;
    const float* X1 = (const float*)(a.ws + WS_X1);
    for (int i = gw; i < NB * SEQ; i += ngw) {
        const int g = peer_tok(i, 1);
        const float* xr = X1 + (size_t)g * D; float* op = a.out + (size_t)i * D;
        f32x4 v[4]; float ss = 0.f;
#pragma unroll
        for (int j = 0; j < 4; ++j) { v[j] = *(const f32x4*)(xr + j * 256 + lane * 4); ss += (v[j].x * v[j].x + v[j].y * v[j].y) + (v[j].z * v[j].z + v[j].w * v[j].w); }
        const float rinv = rsqrtf(wave_sum(ss) * (1.f / D) + EPS);
#pragma unroll
        for (int j = 0; j < 4; ++j) { const f32x4 gn = *(const f32x4*)(a.in[28] + j * 256 + lane * 4); *(f32x4*)(op + j * 256 + lane * 4) = v[j] * rinv * gn; }
    }
}

__device__ __forceinline__ void phase_inproj1(const Args& a, char* lds) {
    float* Cs = (float*)lds;
    const int tid = threadIdx.x;
    const bf16_t* H = (const bf16_t*)(a.ws + WS_H); const bf16_t* W = (const bf16_t*)(a.ws + WS_WIN1);
    const int NU = (MTOT / 128) * 20;
    for (int u = blockIdx.x; u < NU; u += gridDim.x) {
        const int rt = u / 20, ct = u % 20, row0 = rt * 128, col0 = ct * 128;
        if (ct < 10 && (rt % 66) < 2) continue;
        gemm_tile128(H + (size_t)row0 * D, D, W + (size_t)col0 * D, D, D, Cs);
        __syncthreads();
        const int rr = tid >> 2, q4 = tid & 3, g = row0 + rr;
        const float* crow = Cs + rr * CS_LD + q4 * 32;
        if (ct < 10) {
            bf16_t* o = (bf16_t*)(a.ws + WS_GG) + (size_t)g * DRNN + col0 + q4 * 32;
#pragma unroll
            for (int c = 0; c < 32; c += 2) *(unsigned*)(o + c) = pk2(gelu_t(crow[c]), gelu_t(crow[c + 1]));
        } else {
            bf16_t* o = (bf16_t*)(a.ws + WS_XR) + (size_t)g * DRNN + (col0 - DRNN) + q4 * 32;
#pragma unroll
            for (int c = 0; c < 32; c += 2) *(unsigned*)(o + c) = pk2(crow[c], crow[c + 1]);
        }
        __syncthreads();
    }
}

__device__ __forceinline__ void phase_rglru(const Args& a, char* lds, int pass) {
    const int tid = threadIdx.x;
    unsigned char* ws = a.ws;
    float* xc = (float*)lds;
    float* seg = xc + 128 * 128;
    const bf16_t* XR = (const bf16_t*)(ws + WS_XR); const bf16_t* GG = (const bf16_t*)(ws + WS_GG); bf16_t* YG = (bf16_t*)(ws + WS_YG);
    float* CARRY = (float*)(ws + WS_CARRY);
    const int j = tid & 127, tq = tid >> 7;
    const int NU = (MTOT / 128) * 10;
    for (int u = blockIdx.x; u < NU; u += gridDim.x) {
        const int T = u / 10, hb = u % 10, b = T / 66, tl = T % 66, row0 = T * 128, ch = hb * 128 + j;
        if (pass == 1 && tl < 2) continue;
        const int seq_lo = tl < 2 ? b * RPB : b * RPB + CTXL, seq_hi = tl < 2 ? b * RPB + CTXL : (b + 1) * RPB;
        {
            const float w0 = a.in[16][0 * DRNN + ch], w1 = a.in[16][1 * DRNN + ch], w2 = a.in[16][2 * DRNN + ch], w3 = a.in[16][3 * DRNN + ch], cb = a.in[17][ch];
            for (int tt = 0; tt < 32; ++tt) {
                const int g = row0 + tq * 32 + tt;
                const float xm2 = (g - 2 >= seq_lo) ? bf2f(XR[(size_t)(g - 2) * DRNN + ch]) : 0.f;
                const float xm1 = (g - 1 >= seq_lo) ? bf2f(XR[(size_t)(g - 1) * DRNN + ch]) : 0.f;
                const float x0 = bf2f(XR[(size_t)g * DRNN + ch]);
                const float xp1 = (g + 1 < seq_hi) ? bf2f(XR[(size_t)(g + 1) * DRNN + ch]) : 0.f;
                xc[(tq * 32 + tt) * 128 + j] = w0 * xm2 + w1 * xm1 + w2 * x0 + w3 * xp1 + cb;
            }
        }
        __syncthreads();
        float acc[4][32];
#pragma unroll
        for (int m = 0; m < 4; ++m)
#pragma unroll
            for (int tt = 0; tt < 32; ++tt) acc[m][tt] = 0.f;
        {
            const float* wa0 = a.in[18] + ((size_t)(0 * 10 + hb) * 128) * 128 + j; const float* wx0 = a.in[20] + ((size_t)(0 * 10 + hb) * 128) * 128 + j;
            const float* wa1 = a.in[18] + ((size_t)(1 * 10 + hb) * 128) * 128 + j; const float* wx1 = a.in[20] + ((size_t)(1 * 10 + hb) * 128) * 128 + j;
            for (int i = 0; i < 128; ++i) {
                const float w0 = wa0[i * 128], w1 = wx0[i * 128], w2 = wa1[i * 128], w3 = wx1[i * 128];
#pragma unroll
                for (int tt = 0; tt < 32; ++tt) { const float x = xc[(tq * 32 + tt) * 128 + i]; acc[0][tt] += x * w0; acc[1][tt] += x * w1; acc[2][tt] += x * w2; acc[3][tt] += x * w3; }
            }
        }
#pragma unroll
        for (int d = 0; d < 2; ++d) {
            const float ba = a.in[19][d * DRNN + ch], bx = a.in[21][d * DRNN + ch], lam = a.in[22][d * DRNN + ch];
            const float sp = log1pf(__expf(-lam));
#pragma unroll
            for (int tt = 0; tt < 32; ++tt) {
                const float r = sigmoidf_(acc[2 * d][tt] + ba), ig = sigmoidf_(acc[2 * d + 1][tt] + bx);
                const float la = -8.f * r * sp; const float av = __expf(la);
                const float uv = sqrtf(fmaxf(-expm1f(2.f * la), 0.f)) * ig * xc[(tq * 32 + tt) * 128 + j];
                acc[2 * d][tt] = av; acc[2 * d + 1][tt] = uv;
            }
        }
        {
            float Af = 1.f, Hf = 0.f, Ab = 1.f, Hb = 0.f;
#pragma unroll
            for (int tt = 0; tt < 32; ++tt) { Hf = acc[0][tt] * Hf + acc[1][tt]; Af *= acc[0][tt]; }
#pragma unroll
            for (int tt = 31; tt >= 0; --tt) { Hb = acc[2][tt] * Hb + acc[3][tt]; Ab *= acc[2][tt]; }
            seg[((0 * 4 + tq) * 128 + j) * 2] = Af; seg[((0 * 4 + tq) * 128 + j) * 2 + 1] = Hf;
            seg[((1 * 4 + tq) * 128 + j) * 2] = Ab; seg[((1 * 4 + tq) * 128 + j) * 2 + 1] = Hb;
        }
        __syncthreads();
        if (pass == 0) {
            if (tq == 0) {
                float A = 1.f, Hh = 0.f;
                for (int s = 0; s < 4; ++s) { const float sa = seg[((0 * 4 + s) * 128 + j) * 2], sh = seg[((0 * 4 + s) * 128 + j) * 2 + 1]; Hh = sa * Hh + sh; A *= sa; }
                float* c0 = CARRY + (((size_t)(b * 2 + 0) * 66 + tl) * DRNN + ch) * 2; c0[0] = A; c0[1] = Hh;
                A = 1.f; Hh = 0.f;
                for (int s = 3; s >= 0; --s) { const float sa = seg[((1 * 4 + s) * 128 + j) * 2], sh = seg[((1 * 4 + s) * 128 + j) * 2 + 1]; Hh = sa * Hh + sh; A *= sa; }
                float* c1 = CARRY + (((size_t)(b * 2 + 1) * 66 + tl) * DRNN + ch) * 2; c1[0] = A; c1[1] = Hh;
            }
        } else {
            float hf = 0.f, hbk = 0.f;
            for (int t2 = 0; t2 < tl; ++t2) { const float* c = CARRY + (((size_t)(b * 2 + 0) * 66 + t2) * DRNN + ch) * 2; hf = c[0] * hf + c[1]; }
            { const float* c = CARRY + (((size_t)(b * 2 + 1) * 66 + 1) * DRNN + ch) * 2; hbk = c[0] * hbk + c[1]; }
            { const float* c = CARRY + (((size_t)(b * 2 + 1) * 66 + 0) * DRNN + ch) * 2; hbk = c[0] * hbk + c[1]; }
            for (int t2 = 65; t2 > tl; --t2) { const float* c = CARRY + (((size_t)(b * 2 + 1) * 66 + t2) * DRNN + ch) * 2; hbk = c[0] * hbk + c[1]; }
            for (int s = 0; s < tq; ++s) { const float sa = seg[((0 * 4 + s) * 128 + j) * 2], sh = seg[((0 * 4 + s) * 128 + j) * 2 + 1]; hf = sa * hf + sh; }
            for (int s = 3; s > tq; --s) { const float sa = seg[((1 * 4 + s) * 128 + j) * 2], sh = seg[((1 * 4 + s) * 128 + j) * 2 + 1]; hbk = sa * hbk + sh; }
#pragma unroll
            for (int tt = 0; tt < 32; ++tt) { hf = acc[0][tt] * hf + acc[1][tt]; acc[0][tt] = hf; }
#pragma unroll
            for (int tt = 31; tt >= 0; --tt) { hbk = acc[2][tt] * hbk + acc[3][tt]; acc[0][tt] += hbk; }
#pragma unroll
            for (int tt = 0; tt < 32; ++tt) {
                const int g = row0 + tq * 32 + tt;
                YG[(size_t)g * DRNN + ch] = (bf16_t)f2bf(acc[0][tt] * bf2f(GG[(size_t)g * DRNN + ch]));
            }
        }
        __syncthreads();
    }
}

constexpr int XC_LD = 136;
__device__ __forceinline__ float exp2_fast(float x) { return __builtin_amdgcn_exp2f(x); }
__device__ __forceinline__ float sigm_fast(float x) { return __builtin_amdgcn_rcpf(1.f + __builtin_amdgcn_exp2f(-1.4426950408889634f * x)); }
__device__ __forceinline__ void phase_rglru2(const Args& a, char* lds, int pass) {
    const int tid_ = threadIdx.x, wid = __builtin_amdgcn_readfirstlane(tid_ >> 6);
    const int nb = wid & 3, dir = wid >> 2;
    unsigned char* ws = a.ws;
    LAS bf16_t* xcA = (LAS bf16_t*)((LAS char*)lds);
    LAS float* HS = (LAS float*)((LAS char*)lds + 36864);
    const bf16_t* XR = (const bf16_t*)(ws + WS_XR); const bf16_t* GG = (const bf16_t*)(ws + WS_GG); bf16_t* YG = (bf16_t*)(ws + WS_YG);
    float* CARRY = (float*)(ws + WS_CARRY);
    const int NU = (MTOT / 128) * 10;
    for (int u = blockIdx.x; u < NU; u += gridDim.x) {
        const int T = u / 10, hb = u % 10, b = T / 66, tl = T % 66, row0 = T * 128;
        if (pass == 1 && tl < 2) continue;
        int tid = tid_; asm volatile("" : "+v"(tid));
        const int lane = tid & 63, r32 = lane & 31, hh = lane >> 5;
        const int seq_lo = tl < 2 ? b * RPB : b * RPB + CTXL, seq_hi = tl < 2 ? b * RPB + CTXL : (b + 1) * RPB;
        float h0 = 0.f;
        if (pass == 1) {
            typedef float f32x2 __attribute__((ext_vector_type(2)));
            const int chl = hb * 128 + nb * 32 + r32;
            const int pos = dir == 0 ? tl : 67 - tl;
            const float* cbase = CARRY + ((size_t)(b * 2 + dir) * 66) * DRNN * 2 + (size_t)chl * 2;
            f32x2 cv[33];
#pragma unroll
            for (int i = 0; i < 33; ++i) { const int p = hh * 33 + i; const int tile = dir == 0 ? p : (p < 2 ? 1 - p : 67 - p); cv[i] = *(const f32x2*)(cbase + (size_t)tile * DRNN * 2); }
            float cA = 1.f, cH = 0.f;
#pragma unroll
            for (int i = 0; i < 33; ++i) { const bool ok = hh * 33 + i < pos; const float ta = ok ? cv[i].x : 1.f, th = ok ? cv[i].y : 0.f; cH = ta * cH + th; cA = ta * cA; }
            const auto ra = __builtin_amdgcn_permlane32_swap(__float_as_uint(cA), __float_as_uint(cA), false, false);
            const auto rh = __builtin_amdgcn_permlane32_swap(__float_as_uint(cH), __float_as_uint(cH), false, false);
            const float lowH = hh == 0 ? cH : __uint_as_float(rh[0]);
            const float upA = hh == 0 ? __uint_as_float(ra[1]) : cA;
            const float upH = hh == 0 ? __uint_as_float(rh[1]) : cH;
            h0 = upA * lowH + upH;
        }
        __builtin_amdgcn_sched_barrier(0);
        {
            const int j2 = tid & 63, ts = tid >> 6, c0 = hb * 128 + 2 * j2;
            const float w00 = a.in[16][0 * DRNN + c0], w01 = a.in[16][0 * DRNN + c0 + 1], w10 = a.in[16][1 * DRNN + c0], w11 = a.in[16][1 * DRNN + c0 + 1];
            const float w20 = a.in[16][2 * DRNN + c0], w21 = a.in[16][2 * DRNN + c0 + 1], w30 = a.in[16][3 * DRNN + c0], w31 = a.in[16][3 * DRNN + c0 + 1];
            const float cb0 = a.in[17][c0], cb1 = a.in[17][c0 + 1];
            unsigned xw[19];
#pragma unroll
            for (int i = 0; i < 19; ++i) { const int g = row0 + ts * 16 - 2 + i; xw[i] = (g >= seq_lo && g < seq_hi) ? *(const unsigned*)(XR + (size_t)g * DRNN + c0) : 0u; }
#pragma unroll
            for (int i = 0; i < 16; ++i) {
                const float y0 = w00 * bflo(xw[i]) + w10 * bflo(xw[i + 1]) + w20 * bflo(xw[i + 2]) + w30 * bflo(xw[i + 3]) + cb0;
                const float y1 = w01 * bfhi(xw[i]) + w11 * bfhi(xw[i + 1]) + w21 * bfhi(xw[i + 2]) + w31 * bfhi(xw[i + 3]) + cb1;
                *(LAS unsigned*)(xcA + (ts * 16 + i) * XC_LD + 2 * j2) = pk2(y0, y1);
            }
        }
        __syncthreads();
        const int ch = hb * 128 + nb * 32 + r32;
        f32x16 accA[4], accX[4];
        {
            unsigned woff = (unsigned)((nb * 32 + r32) * 128 + 8 * hh); asm volatile("" : "+v"(woff));
            const bf16_t* wa = (const bf16_t*)(ws + WS_WAT) + (size_t)(dir * 10 + hb) * 128 * 128;
            const bf16_t* wx = (const bf16_t*)(ws + WS_WXT) + (size_t)(dir * 10 + hb) * 128 * 128;
            bf16x8 bfa[8], bfx[8];
#pragma unroll
            for (int k = 0; k < 8; ++k) { bfa[k] = *(const bf16x8*)(wa + woff + k * 16); bfx[k] = *(const bf16x8*)(wx + woff + k * 16); }
#pragma unroll
            for (int mb = 0; mb < 4; ++mb) {
                accA[mb] = f32x16{}; accX[mb] = f32x16{};
#pragma unroll
                for (int k = 0; k < 8; ++k) {
                    const bf16x8 af = *(const LAS bf16x8*)(xcA + (mb * 32 + r32) * XC_LD + k * 16 + 8 * hh);
                    accA[mb] = __builtin_amdgcn_mfma_f32_32x32x16_bf16(af, bfa[k], accA[mb], 0, 0, 0);
                    accX[mb] = __builtin_amdgcn_mfma_f32_32x32x16_bf16(af, bfx[k], accX[mb], 0, 0, 0);
                }
            }
        }
        __builtin_amdgcn_sched_barrier(0);
        {
            const float ba = a.in[19][dir * DRNN + ch], bx = a.in[21][dir * DRNN + ch], lam = a.in[22][dir * DRNN + ch];
            const float sp8l = -8.f * 1.4426950408889634f * log1pf(__expf(-lam)), nba = -1.4426950408889634f * ba, nbx = -1.4426950408889634f * bx;
#pragma unroll
            for (int mb = 0; mb < 4; ++mb)
#pragma unroll
                for (int r = 0; r < 16; ++r) {
                    const int t = mb * 32 + (r & 3) + 8 * (r >> 2) + 4 * hh;
                    const float xv = bf2f(xcA[t * XC_LD + nb * 32 + r32]);
                    const float rg = __builtin_amdgcn_rcpf(1.f + __builtin_amdgcn_exp2f(__builtin_fmaf(accA[mb][r], -1.4426950408889634f, nba)));
                    const float ig = __builtin_amdgcn_rcpf(1.f + __builtin_amdgcn_exp2f(__builtin_fmaf(accX[mb][r], -1.4426950408889634f, nbx)));
                    const float av = __builtin_amdgcn_exp2f(rg * sp8l);
                    const float om = fmaxf(__builtin_fmaf(-av, av, 1.f), 0.f);
                    accA[mb][r] = av; accX[mb][r] = __builtin_amdgcn_sqrtf(om) * ig * xv;
                    if ((r & 3) == 3) __builtin_amdgcn_sched_barrier(0);
                }
        }
        __builtin_amdgcn_sched_barrier(0);
        float h = h0;
        float Atot = 1.f; float cin[16];
#define RG_COMPOSITE(q) const int mb = (q) >> 2, rg = ((q) & 3) * 4; \
            const float a0 = accA[mb][rg], a1 = accA[mb][rg + 1], a2 = accA[mb][rg + 2], a3 = accA[mb][rg + 3]; \
            const float u0 = accX[mb][rg], u1 = accX[mb][rg + 1], u2 = accX[mb][rg + 2], u3 = accX[mb][rg + 3]; \
            const float gA = (a0 * a1) * (a2 * a3); \
            const float gH = dir == 0 ? ((u0 * a1 + u1) * a2 + u2) * a3 + u3 : ((u3 * a2 + u2) * a1 + u1) * a0 + u0; \
            const auto ra = __builtin_amdgcn_permlane32_swap(__float_as_uint(gA), __float_as_uint(gA), false, false); \
            const auto rh = __builtin_amdgcn_permlane32_swap(__float_as_uint(gH), __float_as_uint(gH), false, false); \
            const float pA = __uint_as_float(hh == 0 ? ra[1] : ra[0]), pH = __uint_as_float(hh == 0 ? rh[1] : rh[0]); \
            const float EA = hh ? pA : gA, EH = hh ? pH : gH, OA = hh ? gA : pA, OH = hh ? gH : pH;
        if (dir == 0) {
#pragma unroll
            for (int q = 0; q < 16; ++q) { RG_COMPOSITE(q)
                const float hE = h; h = EA * h + EH; const float hO = h; h = OA * h + OH; Atot *= EA * OA; cin[q] = hh ? hO : hE; }
        } else {
#pragma unroll
            for (int q = 15; q >= 0; --q) { RG_COMPOSITE(q)
                const float hO = h; h = OA * h + OH; const float hE = h; h = EA * h + EH; Atot *= EA * OA; cin[q] = hh ? hO : hE; }
        }
#undef RG_COMPOSITE
        if (pass == 0) {
            if (hh == 0) { float* c = CARRY + (((size_t)(b * 2 + dir) * 66 + tl) * DRNN + ch) * 2; c[0] = Atot; c[1] = h; }
            __syncthreads();
            continue;
        }
#pragma unroll
        for (int q = 0; q < 16; ++q) {
            const int mb = q >> 2, rg = (q & 3) * 4; float hc = cin[q];
            if (dir == 0) {
#pragma unroll
                for (int e = 0; e < 4; ++e) { hc = accA[mb][rg + e] * hc + accX[mb][rg + e]; accA[mb][rg + e] = hc; }
            } else {
#pragma unroll
                for (int e = 3; e >= 0; --e) { hc = accA[mb][rg + e] * hc + accX[mb][rg + e]; accA[mb][rg + e] = hc; }
            }
        }
        if (dir == 0) {
#pragma unroll
            for (int mb = 0; mb < 4; ++mb)
#pragma unroll
                for (int r = 0; r < 16; ++r) { const int t = mb * 32 + (r & 3) + 8 * (r >> 2) + 4 * hh; HS[t * 128 + nb * 32 + r32] = accA[mb][r]; }
        }
        __syncthreads();
        if (dir == 1) {
#pragma unroll
            for (int mb = 0; mb < 4; ++mb)
#pragma unroll
                for (int r = 0; r < 16; ++r) { const int t = mb * 32 + (r & 3) + 8 * (r >> 2) + 4 * hh; HS[t * 128 + nb * 32 + r32] += accA[mb][r]; }
        }
        __syncthreads();
        {
            const int t = tid >> 2, cs = (tid & 3) * 32, g = row0 + t;
            const bf16_t* gp = GG + (size_t)g * DRNN + hb * 128 + cs; bf16_t* yp = YG + (size_t)g * DRNN + hb * 128 + cs;
#pragma unroll
            for (int c8 = 0; c8 < 32; c8 += 8) {
                const u32x4 gw = *(const u32x4*)(gp + c8);
                const f32x4 h0 = *(const LAS f32x4*)(HS + t * 128 + cs + c8), h1 = *(const LAS f32x4*)(HS + t * 128 + cs + c8 + 4);
                u32x4 o; o.x = pk2(h0.x * bflo(gw.x), h0.y * bfhi(gw.x)); o.y = pk2(h0.z * bflo(gw.y), h0.w * bfhi(gw.y));
                o.z = pk2(h1.x * bflo(gw.z), h1.y * bfhi(gw.z)); o.w = pk2(h1.z * bflo(gw.w), h1.w * bfhi(gw.w));
                *(u32x4*)(yp + c8) = o;
            }
        }
        __syncthreads();
    }
}

namespace pg8 {
constexpr int BM = 256, BK = 64, HALF = 128, HTB = HALF * BK * 2, STAGE_BYTES = 8 * HTB, NXCD = 8, WGM = 8;
__host__ __device__ __forceinline__ int lds_byte(int r, int c) { const int st = (r >> 4) * 2 + (c >> 5), rr = r & 15, cc = c & 31, ob = rr * 64 + cc * 2; return st * 1024 + (ob ^ (((ob >> 9) & 1) << 5)); }
__host__ __device__ __forceinline__ void stage_rc(int b, int& R, int& C) { const int st = b / 1024, sb = b % 1024, swz = sb ^ (((sb >> 9) & 1) << 5); R = (st >> 1) * 16 + swz / 64; C = (st & 1) * 32 + (swz % 64) / 2; }
__host__ __device__ __forceinline__ int perm32(int rho) { const int n = rho >> 4, i = rho & 15; return 8 * (i >> 2) + 4 * n + (i & 3); }
struct Unit { int pm, pn; };
struct Gemm { const bf16_t* A; const bf16_t* Bt; int M, N, K; };
struct StaticOrder {
    int nM, nN, nwg, G, c;
    __host__ __device__ void init(int M, int N, int G_, int c_) { nM = M / BM; nN = N / BM; nwg = nM * nN; G = G_; c = c_; }
    __host__ __device__ bool next(int i, Unit& u) const {
        const long L = (long)i * G + c; if (L >= nwg) return false;
        int wgid = (int)L; { const int q = nwg / NXCD, r = nwg % NXCD, xcd = wgid % NXCD, off = wgid / NXCD; wgid = (xcd < r ? xcd * (q + 1) : r * (q + 1) + (xcd - r) * q) + off; }
        const int nig = WGM * nN, gid = wgid / nig, fm = gid * WGM, gsz = (nM - fm) < WGM ? (nM - fm) : WGM;
        u.pm = fm + ((wgid % nig) % gsz); u.pn = (wgid % nig) / gsz; return true;
    }
    __device__ __forceinline__ void a_ready(const Unit&) const {}
    __device__ __forceinline__ void done(const Unit&) const {}
};
struct LatentOrder {
    StaticOrder S;
    __host__ __device__ void init(int N, int G_, int c_) { S.init(16384, N, G_, c_); }
    __host__ __device__ bool next(int i, Unit& u) const { if (!S.next(i, u)) return false; u.pm = u.pm + 1 + (u.pm >= 32 ? 1 : 0); return true; }
    __device__ __forceinline__ void a_ready(const Unit&) const {}
    __device__ __forceinline__ void done(const Unit&) const {}
};
__device__ __forceinline__ unsigned cvt_pk_bf16(float lo, float hi) { unsigned r; asm volatile("v_cvt_pk_bf16_f32 %0, %1, %2" : "=v"(r) : "v"(lo), "v"(hi)); return r; }
__device__ __forceinline__ u32x4 pack8(const f32x4& v0, const f32x4& v1) { u32x4 w; w.x = cvt_pk_bf16(v0[0], v0[1]); w.y = cvt_pk_bf16(v0[2], v0[3]); w.z = cvt_pk_bf16(v1[0], v1[1]); w.w = cvt_pk_bf16(v1[2], v1[3]); return w; }
__device__ __forceinline__ f32x4 gelu4(const f32x4& v) { f32x4 r; r.x = gelu_t(v.x); r.y = gelu_t(v.y); r.z = gelu_t(v.z); r.w = gelu_t(v.w); return r; }

struct EpiStore {
    static constexpr bool PERM = true, AFTER_DRAIN = false;
    bf16_t* O1; bf16_t* O2; int ld; int split_tile; int gelu_tiles;
    __device__ __forceinline__ void operator()(f32x4 (&acc)[2][2][4][2], const Unit& u, int wr, int wc, int fr, int fq) const {
        const bool second = u.pn >= split_tile; bf16_t* base = second ? O2 : O1; const int pnl = second ? u.pn - split_tile : u.pn; const bool dog = u.pn < gelu_tiles;
        const int rl0 = wr * 64 + fr, cl0 = wc * 32 + 8 * fq;
#pragma unroll
        for (int ai = 0; ai < 2; ++ai)
#pragma unroll
            for (int m = 0; m < 4; ++m) { bf16_t* rowp = base + (size_t)(u.pm * BM + ai * HALF + m * 16 + rl0) * ld + pnl * BM + cl0;
#pragma unroll
                for (int bj = 0; bj < 2; ++bj) { f32x4 v0 = acc[ai][bj][m][0], v1 = acc[ai][bj][m][1]; if (dog) { v0 = gelu4(v0); v1 = gelu4(v1); }
                    *(u32x4*)(rowp + bj * HALF) = pack8(v0, v1); } }
    }
};
struct EpiPeerQ {
    static constexpr bool PERM = true, AFTER_DRAIN = false;
    bf16_t* QP; const bf16_t* KEYS; int* SELI; float* SELG;
    __device__ __forceinline__ void operator()(f32x4 (&acc)[2][2][4][2], const Unit& u, int wr, int wc, int fr, int fq) const {
        { int rl0 = wr * 64 + fr, cl0 = wc * 32 + 8 * fq; asm volatile("" : "+v"(rl0), "+v"(cl0));
#pragma unroll
          for (int ai = 0; ai < 2; ++ai)
#pragma unroll
            for (int m = 0; m < 4; ++m) { bf16_t* rowp = QP + (size_t)(u.pm * BM + ai * HALF + m * 16 + rl0) * 2048 + u.pn * BM + cl0;
#pragma unroll
                for (int bj = 0; bj < 2; ++bj) *(u32x4*)(rowp + bj * HALF) = pack8(acc[ai][bj][m][0], acc[ai][bj][m][1]); } }
        asm volatile("s_waitcnt vmcnt(0)" ::: "memory");
        __builtin_amdgcn_fence(__ATOMIC_RELEASE, "workgroup"); __builtin_amdgcn_s_barrier(); __builtin_amdgcn_fence(__ATOMIC_ACQUIRE, "workgroup");
        int lane = fq * 16 + fr; asm volatile("" : "+v"(lane));
        topk_item(QP, KEYS, SELI, SELG, u.pm * BM + (wr * 4 + wc) * 32, u.pn, lane & 31, lane >> 5);
    }
};
struct EpiResid {
    static constexpr bool PERM = true, AFTER_DRAIN = false;
    const float* x; const float* ctx; const float* modbase; float* X1; int base_mode;
    __device__ __forceinline__ void operator()(f32x4 (&acc)[2][2][4][2], const Unit& u, int wr, int wc, int fr, int fq) const {
        const int b = u.pm / 33, tl = u.pm % 33, var = tl == 0 ? 2 : b;
        const float* gate = modbase + (size_t)var * 6144 + u.pn * BM;
        const float* basep = base_mode == 0 ? (tl == 0 ? ctx + (size_t)b * CTXL * D : x + ((size_t)b * SEQ + (size_t)(tl - 1) * 256) * D) : X1 + (size_t)u.pm * BM * D;
        float* outp = X1 + (size_t)u.pm * BM * D;
        const int rl0 = wr * 64 + fr, cl0 = u.pn * BM + wc * 32 + 8 * fq;
        f32x4 gv[2][2];
#pragma unroll
        for (int bj = 0; bj < 2; ++bj)
#pragma unroll
            for (int n = 0; n < 2; ++n) gv[bj][n] = *(const f32x4*)(gate + bj * HALF + wc * 32 + 8 * fq + 4 * n);
#pragma unroll
        for (int ai = 0; ai < 2; ++ai)
#pragma unroll
            for (int m = 0; m < 4; ++m) { const size_t off = (size_t)(ai * HALF + m * 16 + rl0) * D + cl0;
#pragma unroll
                for (int bj = 0; bj < 2; ++bj)
#pragma unroll
                    for (int n = 0; n < 2; ++n) { const f32x4 bs = *(const f32x4*)(basep + off + bj * HALF + 4 * n); *(f32x4*)(outp + off + bj * HALF + 4 * n) = bs + gv[bj][n] * acc[ai][bj][m][n]; } }
    }
};
struct EpiInproj0 {
    static constexpr bool PERM = true, AFTER_DRAIN = false;
    unsigned char* ws; const float* gmg; const float* qg; const float* kg; LAS float* P;
    __device__ __forceinline__ void operator()(f32x4 (&acc)[2][2][4][2], const Unit& u, int wr, int wc, int fr, int fq) const {
        int rl0 = wr * 64 + fr, cl0 = wc * 32 + 8 * fq; asm volatile("" : "+v"(rl0), "+v"(cl0));
        const int pn = u.pn; const size_t grow0 = (size_t)u.pm * BM;
        if (pn < 4) {
#pragma unroll
            for (int ai = 0; ai < 2; ++ai)
#pragma unroll
                for (int bj = 0; bj < 2; ++bj)
#pragma unroll
                    for (int m = 0; m < 4; ++m) { acc[ai][bj][m][0] = gelu4(acc[ai][bj][m][0]); acc[ai][bj][m][1] = gelu4(acc[ai][bj][m][1]); __builtin_amdgcn_sched_barrier(0); }
        }
        if (pn < 2 || pn == 7) {
            bf16_t* base = pn < 2 ? (bf16_t*)(ws + WS_U) + pn * BM : (bf16_t*)(ws + WS_V); const int ld = pn < 2 ? 512 : 256;
#pragma unroll
            for (int ai = 0; ai < 2; ++ai)
#pragma unroll
                for (int m = 0; m < 4; ++m) { bf16_t* rowp = base + (grow0 + ai * HALF + m * 16 + rl0) * ld + cl0;
#pragma unroll
                    for (int bj = 0; bj < 2; ++bj) *(u32x4*)(rowp + bj * HALF) = pack8(acc[ai][bj][m][0], acc[ai][bj][m][1]); }
            return;
        }
#pragma unroll
        for (int ai = 0; ai < 2; ++ai)
#pragma unroll
            for (int m = 0; m < 4; ++m)
#pragma unroll
                for (int bj = 0; bj < 2; ++bj) { const f32x4 a0 = acc[ai][bj][m][0], a1 = acc[ai][bj][m][1];
                    float s = (a0.x * a0.x + a0.y * a0.y) + (a0.z * a0.z + a0.w * a0.w) + (a1.x * a1.x + a1.y * a1.y) + (a1.z * a1.z + a1.w * a1.w);
                    s += __shfl_xor(s, 16); s += __shfl_xor(s, 32);
                    if (fq == 0) P[((ai * HALF + m * 16 + rl0) * 2 + bj) * 4 + wc] = s; __builtin_amdgcn_sched_barrier(0); }
        asm volatile("s_waitcnt lgkmcnt(0)" ::: "memory"); __builtin_amdgcn_s_barrier(); asm volatile("" ::: "memory");
        if (pn < 4) {
            bf16_t* base = (bf16_t*)(ws + WS_VV) + (pn - 2) * BM; const float* gp = gmg + (pn - 2) * BM + cl0;
            f32x4 g8[2][2];
#pragma unroll
            for (int bj = 0; bj < 2; ++bj) { g8[bj][0] = *(const f32x4*)(gp + bj * HALF); g8[bj][1] = *(const f32x4*)(gp + bj * HALF + 4); }
#pragma unroll
            for (int ai = 0; ai < 2; ++ai)
#pragma unroll
                for (int m = 0; m < 4; ++m) { const int rl = ai * HALF + m * 16 + rl0; bf16_t* rowp = base + (grow0 + rl) * 512 + cl0;
#pragma unroll
                    for (int bj = 0; bj < 2; ++bj) { const f32x4 p = *(const LAS f32x4*)(P + (rl * 2 + bj) * 4);
                        const float rinv = rsqrtf(((p.x + p.y) + (p.z + p.w)) * (1.f / 128.f) + EPS);
                        *(u32x4*)(rowp + bj * HALF) = pack8(acc[ai][bj][m][0] * rinv * g8[bj][0], acc[ai][bj][m][1] * rinv * g8[bj][1]); }
                    asm volatile("" ::: "memory"); __builtin_amdgcn_sched_barrier(0); }
            return;
        }
        {
            const bool isq = pn < 6; const float* gn = isq ? qg : kg;
            const int grp = cl0 >> 3, fo = (grp >> 3) * 64 + (grp & 7) * 4;
            const f32x4 gA = *(const f32x4*)(gn + fo), gB = *(const f32x4*)(gn + fo + 32);
            bf16_t* base = isq ? (bf16_t*)(ws + WS_Q) + (pn - 4) * BM : (bf16_t*)(ws + WS_K); const int ld = isq ? 512 : 256;
            const int tl = u.pm % 33; const bool lat = tl != 0; const int ax = grp >> 3, f0 = (grp & 7) * 4;
            const float* rope = (const float*)(ws + WS_ROPE);
#pragma unroll
            for (int ai = 0; ai < 2; ++ai)
#pragma unroll
                for (int m = 0; m < 4; ++m) { const int rl = ai * HALF + m * 16 + rl0; bf16_t* rowp = base + (grow0 + rl) * ld + cl0;
                    f32x4 cs0 = {1.f, 0.f, 1.f, 0.f}, cs1 = {1.f, 0.f, 1.f, 0.f};
                    if (lat) { const int t = (tl - 1) * 256 + rl; const int pos = ax == 0 ? (t >> 6) : (t & 63); const float* rp = rope + (pos * 32 + f0) * 2; cs0 = *(const f32x4*)rp; cs1 = *(const f32x4*)(rp + 4); }
#pragma unroll
                    for (int bj = 0; bj < 2; ++bj) { const f32x4 p = *(const LAS f32x4*)(P + (rl * 2 + bj) * 4);
                        const float rinv = rsqrtf(((p.x + p.y) + (p.z + p.w)) * (1.f / 128.f) + EPS);
                        const f32x4 x1 = acc[ai][bj][m][0] * rinv * gA, x2 = acc[ai][bj][m][1] * rinv * gB;
                        f32x4 o1, o2;
                        o1.x = x1.x * cs0.x - x2.x * cs0.y; o2.x = x2.x * cs0.x + x1.x * cs0.y;
                        o1.y = x1.y * cs0.z - x2.y * cs0.w; o2.y = x2.y * cs0.z + x1.y * cs0.w;
                        o1.z = x1.z * cs1.x - x2.z * cs1.y; o2.z = x2.z * cs1.x + x1.z * cs1.y;
                        o1.w = x1.w * cs1.z - x2.w * cs1.w; o2.w = x2.w * cs1.z + x1.w * cs1.w;
                        *(u32x4*)(rowp + bj * HALF) = pack8(o1, o2); }
                    asm volatile("" ::: "memory"); __builtin_amdgcn_sched_barrier(0); }
        }
    }
};

template <class Epi, class Sched, bool ALIGN_EPI = false, bool SP2 = false>
__device__ __forceinline__ void gemm_phase(LAS unsigned char* lds, const Gemm g, const Sched& S, const Epi& E) {
    const int tid = threadIdx.x, wid = __builtin_amdgcn_readfirstlane(tid >> 6), lane = tid & 63, wr = wid >> 2, wc = wid & 3, fr = lane & 15, fq = lane >> 4;
    const int K = g.K, nt = K / BK;
    unsigned voffA[2], voffB[2];
#pragma unroll
    for (int i = 0; i < 2; ++i) { int R, C; stage_rc(tid * 16 + i * 8192, R, C); const int Rb = Epi::PERM ? ((R & ~31) + perm32(R & 31)) : R;
        voffA[i] = (unsigned)(R * K + C) * 2u; voffB[i] = (unsigned)(Rb * K + C) * 2u; }
    const size_t kstep = (size_t)(BK * 2);
    const size_t hstep = (size_t)HALF * K * 2;
    const size_t tstep = 2 * hstep;
    const unsigned ldsw = (unsigned)wid * 1024u;
    const int aoff = lds_byte(wr * 64 + fr, fq * 8), boff = lds_byte(wc * 32 + fr, fq * 8);
#define PG8_SA(b, h) (((b) * 2 + (h)) * HTB)
#define PG8_SB(b, h) ((4 + (b) * 2 + (h)) * HTB)
#define PG8_STAGE(bufoff, gbase, voff) do { _Pragma("unroll") for (int _i = 0; _i < 2; ++_i) \
        __builtin_amdgcn_global_load_lds((const unsigned*)((const char*)(gbase) + (voff)[_i]), (LAS unsigned*)(lds + (bufoff) + ldsw + _i * 8192), 16, 0, 0); } while (0)
#define PG8_LDA(dst, b, h) do { _Pragma("unroll") for (int m = 0; m < 4; ++m) _Pragma("unroll") for (int k = 0; k < 2; ++k) dst[m][k] = *(const LAS bf16x8*)(lds + PG8_SA(b, h) + aoff + m * 2048 + k * 1024); } while (0)
#define PG8_LDB(dst, b, h) do { _Pragma("unroll") for (int n = 0; n < 2; ++n) _Pragma("unroll") for (int k = 0; k < 2; ++k) dst[n][k] = *(const LAS bf16x8*)(lds + PG8_SB(b, h) + boff + n * 2048 + k * 1024); } while (0)
#define PG8_MMA(ai, bj, At, Bt) do { __builtin_amdgcn_s_setprio(1); _Pragma("unroll") for (int m = 0; m < 4; ++m) _Pragma("unroll") for (int n = 0; n < 2; ++n) _Pragma("unroll") for (int k = 0; k < 2; ++k) \
        acc[ai][bj][m][n] = __builtin_amdgcn_mfma_f32_16x16x32_bf16(Bt[n][k], At[m][k], acc[ai][bj][m][n], 0, 0, 0); __builtin_amdgcn_s_setprio(0); } while (0)
#define PG8_WAIT_V(n) asm volatile("s_waitcnt vmcnt(" #n ")" ::: "memory")
#define PG8_WAIT_L(n) asm volatile("s_waitcnt lgkmcnt(" #n ")" ::: "memory")
#define PG8_BAR __builtin_amdgcn_s_barrier()
#define PG8_SCHED __builtin_amdgcn_sched_barrier(0)
    Unit cur, nxt; int ui = 0;
    if (!S.next(0, cur)) return;
    f32x4 acc[2][2][4][2];
#pragma unroll
    for (int a = 0; a < 2; ++a)
#pragma unroll
        for (int b = 0; b < 2; ++b)
#pragma unroll
            for (int m = 0; m < 4; ++m)
#pragma unroll
                for (int n = 0; n < 2; ++n) acc[a][b][m][n] = (f32x4){0.f, 0.f, 0.f, 0.f};
    bf16x8 At[4][2], B0[2][2], B1[2][2];
    const char* cA = (const char*)g.A + (size_t)cur.pm * tstep; const char* cB = (const char*)g.Bt + (size_t)cur.pn * tstep;
    S.a_ready(cur);
    if constexpr (SP2) {
        PG8_STAGE(PG8_SB(0, 0), cB, voffB); PG8_STAGE(PG8_SB(0, 1), cB + hstep, voffB); PG8_STAGE(PG8_SA(0, 0), cA, voffA); PG8_STAGE(PG8_SA(0, 1), cA + hstep, voffA);
        if (wr == 1) PG8_BAR;
        PG8_WAIT_V(2); PG8_BAR;
        PG8_STAGE(PG8_SB(1, 0), cB + kstep, voffB); PG8_STAGE(PG8_SA(1, 0), cA + kstep, voffA); PG8_STAGE(PG8_SB(1, 1), cB + hstep + kstep, voffB);
        PG8_WAIT_V(6); PG8_BAR;
    } else {
        PG8_STAGE(PG8_SB(0, 0), cB, voffB); PG8_STAGE(PG8_SA(0, 0), cA, voffA); PG8_STAGE(PG8_SB(0, 1), cB + hstep, voffB); PG8_STAGE(PG8_SA(0, 1), cA + hstep, voffA);
        if (wr == 1) PG8_BAR;
        PG8_WAIT_V(4); PG8_BAR;
        PG8_STAGE(PG8_SB(1, 0), cB + kstep, voffB); PG8_STAGE(PG8_SA(1, 0), cA + kstep, voffA); PG8_STAGE(PG8_SB(1, 1), cB + hstep + kstep, voffB);
        PG8_WAIT_V(6); PG8_BAR;
    }
    for (;;) {
        const bool has_next = S.next(ui + 1, nxt);
        const char* nA = has_next ? (const char*)g.A + (size_t)nxt.pm * tstep : cA; const char* nB = has_next ? (const char*)g.Bt + (size_t)nxt.pn * tstep : cB;
        for (int t = 0; t < nt; t += 2) {
            const bool last = (t == nt - 2);
            const char* a1 = cA + (size_t)(t + 1) * kstep;
            const char* a2 = last ? nA : cA + (size_t)(t + 2) * kstep; const char* b2 = last ? nB : cB + (size_t)(t + 2) * kstep;
            const char* a3 = a2 + kstep; const char* b3 = b2 + kstep;
            if (last && has_next) S.a_ready(nxt);
            if constexpr (SP2) {
            PG8_LDB(B0, 0, 0); PG8_LDB(B1, 0, 1); PG8_SCHED; PG8_LDA(At, 0, 0); PG8_STAGE(PG8_SA(1, 1), a1 + hstep, voffA);
            PG8_WAIT_V(8); PG8_WAIT_L(0); PG8_BAR; PG8_MMA(0, 0, At, B0); PG8_MMA(0, 1, At, B1); PG8_BAR; PG8_SCHED;
            PG8_LDA(At, 0, 1); PG8_STAGE(PG8_SB(0, 0), b2, voffB); PG8_STAGE(PG8_SB(0, 1), b2 + hstep, voffB); PG8_STAGE(PG8_SA(0, 0), a2, voffA);
            PG8_WAIT_V(8); PG8_WAIT_L(0); PG8_BAR; PG8_MMA(1, 0, At, B0); PG8_MMA(1, 1, At, B1); PG8_BAR; PG8_SCHED;
            PG8_LDB(B0, 1, 0); PG8_LDB(B1, 1, 1); PG8_SCHED; PG8_LDA(At, 1, 0); PG8_STAGE(PG8_SA(0, 1), a2 + hstep, voffA);
            PG8_WAIT_V(8); PG8_WAIT_L(0); PG8_BAR; PG8_MMA(0, 0, At, B0); PG8_MMA(0, 1, At, B1); PG8_BAR; PG8_SCHED;
            PG8_LDA(At, 1, 1); PG8_STAGE(PG8_SB(1, 0), b3, voffB); PG8_STAGE(PG8_SB(1, 1), b3 + hstep, voffB); PG8_STAGE(PG8_SA(1, 0), a3, voffA);
            PG8_WAIT_V(8); PG8_WAIT_L(0); PG8_BAR; PG8_MMA(1, 0, At, B0); PG8_MMA(1, 1, At, B1); PG8_BAR; PG8_SCHED;
            } else {
            PG8_LDB(B0, 0, 0); PG8_SCHED; PG8_LDA(At, 0, 0); PG8_STAGE(PG8_SA(1, 1), a1 + hstep, voffA);
            PG8_WAIT_L(8); PG8_BAR; PG8_WAIT_L(0); PG8_MMA(0, 0, At, B0); PG8_BAR; PG8_SCHED;
            PG8_LDB(B1, 0, 1); PG8_STAGE(PG8_SB(0, 0), b2, voffB);
            PG8_BAR; PG8_WAIT_L(0); PG8_MMA(0, 1, At, B1); PG8_BAR;
            PG8_LDA(At, 0, 1); PG8_STAGE(PG8_SA(0, 0), a2, voffA);
            PG8_BAR; PG8_WAIT_L(0); PG8_MMA(1, 0, At, B0); PG8_BAR; PG8_SCHED;
            PG8_STAGE(PG8_SB(0, 1), b2 + hstep, voffB);
            PG8_WAIT_V(6); PG8_BAR; PG8_MMA(1, 1, At, B1); PG8_BAR;
            PG8_LDB(B0, 1, 0); PG8_SCHED; PG8_LDA(At, 1, 0); PG8_STAGE(PG8_SA(0, 1), a2 + hstep, voffA);
            PG8_WAIT_L(8); PG8_BAR; PG8_WAIT_L(0); PG8_MMA(0, 0, At, B0); PG8_BAR; PG8_SCHED;
            PG8_LDB(B1, 1, 1); PG8_STAGE(PG8_SB(1, 0), b3, voffB);
            PG8_BAR; PG8_WAIT_L(0); PG8_MMA(0, 1, At, B1); PG8_BAR;
            PG8_LDA(At, 1, 1); PG8_STAGE(PG8_SA(1, 0), a3, voffA);
            PG8_BAR; PG8_WAIT_L(0); PG8_MMA(1, 0, At, B0); PG8_BAR; PG8_SCHED;
            PG8_STAGE(PG8_SB(1, 1), b3 + hstep, voffB);
            PG8_WAIT_V(6); PG8_BAR; PG8_MMA(1, 1, At, B1); PG8_BAR;
            }
        }
        if constexpr (ALIGN_EPI) { if (wr == 0) PG8_BAR; }
        if constexpr (!Epi::AFTER_DRAIN) { E(acc, cur, wr, wc, fr, fq); S.done(cur); }
        if (!has_next) break;
#pragma unroll
        for (int a = 0; a < 2; ++a)
#pragma unroll
            for (int b = 0; b < 2; ++b)
#pragma unroll
                for (int m = 0; m < 4; ++m)
#pragma unroll
                    for (int n = 0; n < 2; ++n) acc[a][b][m][n] = (f32x4){0.f, 0.f, 0.f, 0.f};
        cur = nxt; cA = nA; cB = nB; ++ui;
        if constexpr (ALIGN_EPI) { if (wr == 1) PG8_BAR; }
    }
    PG8_WAIT_V(0);
    if constexpr (!ALIGN_EPI) { if (wr == 0) PG8_BAR; }
    PG8_BAR;
#undef PG8_SA
#undef PG8_SB
#undef PG8_STAGE
#undef PG8_LDA
#undef PG8_LDB
#undef PG8_MMA
#undef PG8_WAIT_V
#undef PG8_WAIT_L
#undef PG8_BAR
#undef PG8_SCHED
}
}

__device__ __forceinline__ void fphase_inproj0(const Args& a, char* lds) {
    pg8::Gemm g{(const bf16_t*)(a.ws + WS_H), (const bf16_t*)(a.ws + WS_WIN0), MTOT, 2048, 1024};
    pg8::StaticOrder S; S.init(MTOT, 2048, (int)gridDim.x, (int)blockIdx.x);
    pg8::EpiInproj0 E{a.ws, a.in[9], a.in[12], a.in[13], (LAS float*)((LAS char*)lds + 131072)};
    pg8::gemm_phase<pg8::EpiInproj0, pg8::StaticOrder, true, true>((LAS unsigned char*)lds, g, S, E);
    const int G = (int)gridDim.x, nbusy = 528 - 2 * G;
    if (G == 256 && (int)blockIdx.x >= nbusy) quant_tables(a, 1, ((int)blockIdx.x - nbusy) * NWAVE + (int)(threadIdx.x >> 6), (G - nbusy) * NWAVE, (int)(threadIdx.x & 63));
    else if (G != 256) quant_tables(a, 1, (int)blockIdx.x * NWAVE + (int)(threadIdx.x >> 6), G * NWAVE, (int)(threadIdx.x & 63));
}
__device__ __forceinline__ void fphase_outproj0(const Args& a, char* lds) {
    pg8::Gemm g{(const bf16_t*)(a.ws + WS_AO), (const bf16_t*)(a.ws + WS_WOUT0), MTOT, 1024, 1024};
    pg8::StaticOrder S; S.init(MTOT, 1024, (int)gridDim.x, (int)blockIdx.x);
    pg8::EpiResid E{a.in[0], a.in[2], (const float*)(a.ws + WS_MODV) + 2 * 1024, (float*)(a.ws + WS_X1), 0};
    pg8::gemm_phase<pg8::EpiResid, pg8::StaticOrder, true, true>((LAS unsigned char*)lds, g, S, E);
    const int G = (int)gridDim.x, nbusy = (G == 256) ? 264 - G : 0;
    if ((int)blockIdx.x >= nbusy) for (int r = (int)blockIdx.x - nbusy; r < N_L1_ITEMS; r += G - nbusy) prep_l1_item(a, (float*)lds, r);
}
__device__ __forceinline__ void fphase_peerq0(const Args& a, char* lds) {
    pg8::Gemm g{(const bf16_t*)(a.ws + WS_H), (const bf16_t*)(a.ws + WS_WQ), MTOT, 2048, 1024};
    pg8::StaticOrder S; S.init(MTOT, 2048, (int)gridDim.x, (int)blockIdx.x);
    pg8::EpiStore E{(bf16_t*)(a.ws + WS_QP), (bf16_t*)(a.ws + WS_QP), 2048, 1000, 0};
    pg8::gemm_phase<pg8::EpiStore, pg8::StaticOrder, true, true>((LAS unsigned char*)lds, g, S, E);
}
__device__ __forceinline__ void fphase_inproj1(const Args& a, char* lds) {
    pg8::Gemm g{(const bf16_t*)(a.ws + WS_H), (const bf16_t*)(a.ws + WS_WIN1), MTOT, 2560, 1024};
    pg8::StaticOrder S; S.init(MTOT, 2560, (int)gridDim.x, (int)blockIdx.x);
    pg8::EpiStore E{(bf16_t*)(a.ws + WS_GG), (bf16_t*)(a.ws + WS_XR), 1280, 5, 5};
    pg8::gemm_phase<pg8::EpiStore, pg8::StaticOrder, true, true>((LAS unsigned char*)lds, g, S, E);
}
__device__ __forceinline__ void fphase_outproj1(const Args& a, char* lds) {
    pg8::Gemm g{(const bf16_t*)(a.ws + WS_YG), (const bf16_t*)(a.ws + WS_WOUT1), MTOT, 1024, 1280};
    pg8::LatentOrder S; S.init(1024, (int)gridDim.x, (int)blockIdx.x);
    pg8::EpiResid E{a.in[0], a.in[2], (const float*)(a.ws + WS_MODV) + 3 * 6144 + 2 * 1024, (float*)(a.ws + WS_X1), 1};
    pg8::gemm_phase<pg8::EpiResid, pg8::LatentOrder, true, true>((LAS unsigned char*)lds, g, S, E);
}
__device__ __forceinline__ void fphase_peerq1(const Args& a, char* lds) {
    pg8::Gemm g{(const bf16_t*)(a.ws + WS_H), (const bf16_t*)(a.ws + WS_WQ) + (size_t)2048 * 1024, MTOT, 2048, 1024};
    pg8::LatentOrder S; S.init(2048, (int)gridDim.x, (int)blockIdx.x);
    pg8::EpiStore E{(bf16_t*)(a.ws + WS_QP), (bf16_t*)(a.ws + WS_QP), 2048, 1000, 0};
    pg8::gemm_phase<pg8::EpiStore, pg8::LatentOrder, true, true>((LAS unsigned char*)lds, g, S, E);
}

constexpr int NPHASE = 23;
__global__ void __launch_bounds__(NTHR, 2) mega(Args a) {
    extern __shared__ __attribute__((aligned(16))) char lds[];
    volatile LAS unsigned* MISC = (volatile LAS unsigned*)((LAS char*)lds + LDS_MISC);
    if (threadIdx.x < 64) MISC[threadIdx.x] = 0u;
    __syncthreads();
    XcdBarrier bar; bar.bar = (unsigned*)(a.ws + WS_CTL) + 4096; bar.x = 0; bar.st = nullptr;
    const bool multi = (a.ph_hi - a.ph_lo) > 1;
    if (multi) bar = xcd_barrier_post((unsigned*)(a.ws + WS_CTL) + 4096, MISC + 8);
    const int lo = a.ph_lo, hi = a.ph_hi;
    unsigned char* ws = a.ws;
#define IN(k) (lo <= (k) && (k) < hi)
#define SEAM(k) do { if (IN(k) && IN((k) + 1)) xcd_barrier(bar); } while (0)
#ifndef PROBE_DUP
#define PROBE_DUP 0u
#endif
#define DUPQ(k) (((PROBE_DUP >> (k)) & 1u) != 0u)
    if (IN(0)) { phase_prep(a, lds); if (DUPQ(0)) { xcd_barrier(bar); phase_prep(a, lds); } } SEAM(0);
    if (IN(1)) { phase_norm(a, 0, 0, a.in[6], 0, 1, false); if (DUPQ(1)) { xcd_barrier(bar); phase_norm(a, 0, 0, a.in[6], 0, 1, false); } } SEAM(1);
    if (IN(2)) { fphase_inproj0(a, lds); if (DUPQ(2)) { xcd_barrier(bar); fphase_inproj0(a, lds); } } SEAM(2);
    if (IN(3)) { phase_gmlp2(a, lds); phase_attn(a, lds); if (DUPQ(3)) { xcd_barrier(bar); phase_gmlp2(a, lds); phase_attn(a, lds); } } SEAM(3);
    if (IN(4)) { fphase_outproj0(a, lds); if (DUPQ(4)) { xcd_barrier(bar); fphase_outproj0(a, lds); } } SEAM(4);
    if (IN(5)) { phase_norm(a, 0, 1, a.in[7], 3, 4, false, true); if (DUPQ(5)) { xcd_barrier(bar); phase_norm(a, 0, 1, a.in[7], 3, 4, false, true); } } SEAM(5);
    if (IN(6)) { fphase_peerq0(a, lds); if (DUPQ(6)) { xcd_barrier(bar); fphase_peerq0(a, lds); } } SEAM(6);
    if (IN(7)) { phase_peer_topk3(a, lds, 0, false); if (DUPQ(7)) { xcd_barrier(bar); phase_peer_topk3(a, lds, 0, false); } } SEAM(7);
    if (IN(8)) { phase_gu(a, lds, 0, 0); if (DUPQ(8)) { xcd_barrier(bar); phase_gu(a, lds, 0, 0); } } SEAM(8);
    if (IN(9)) { phase_gact(a, 0, 0); if (DUPQ(9)) { xcd_barrier(bar); phase_gact(a, 0, 0); } } SEAM(9);
    if (IN(10)) { phase_gv(a, lds, 0, 0); if (DUPQ(10)) { xcd_barrier(bar); phase_gv(a, lds, 0, 0); } } SEAM(10);
    if (IN(11)) { phase_norm(a, 1, 1, a.in[6] + D, 0, 1, false); if (DUPQ(11)) { xcd_barrier(bar); phase_norm(a, 1, 1, a.in[6] + D, 0, 1, false); } } SEAM(11);
    if (IN(12)) { fphase_inproj1(a, lds); if (DUPQ(12)) { xcd_barrier(bar); fphase_inproj1(a, lds); } } SEAM(12);
    if (IN(13)) { phase_rglru2(a, lds, 0); if (DUPQ(13)) { xcd_barrier(bar); phase_rglru2(a, lds, 0); } } SEAM(13);
    if (IN(14)) { phase_rglru2(a, lds, 1); if (DUPQ(14)) { xcd_barrier(bar); phase_rglru2(a, lds, 1); } } SEAM(14);
    if (IN(15)) { fphase_outproj1(a, lds); if (DUPQ(15)) { xcd_barrier(bar); fphase_outproj1(a, lds); } } SEAM(15);
    if (IN(16)) { phase_norm(a, 1, 1, a.in[7] + D, 3, 4, true, true); if (DUPQ(16)) { xcd_barrier(bar); phase_norm(a, 1, 1, a.in[7] + D, 3, 4, true, true); } } SEAM(16);
    if (IN(17)) { fphase_peerq1(a, lds); if (DUPQ(17)) { xcd_barrier(bar); fphase_peerq1(a, lds); } } SEAM(17);
    if (IN(18)) { phase_peer_topk3(a, lds, 1, true); if (DUPQ(18)) { xcd_barrier(bar); phase_peer_topk3(a, lds, 1, true); } } SEAM(18);
    if (IN(19)) { phase_gu(a, lds, 1, 1); if (DUPQ(19)) { xcd_barrier(bar); phase_gu(a, lds, 1, 1); } } SEAM(19);
    if (IN(20)) { phase_gact(a, 1, 1); if (DUPQ(20)) { xcd_barrier(bar); phase_gact(a, 1, 1); } } SEAM(20);
    if (IN(21)) { phase_gv(a, lds, 1, 1); if (DUPQ(21)) { xcd_barrier(bar); phase_gv(a, lds, 1, 1); } } SEAM(21);
    if (IN(22)) { phase_finalnorm(a); if (DUPQ(22)) { xcd_barrier(bar); phase_finalnorm(a); } }
#undef IN
#undef SEAM
}

extern "C" void kernel_launch(void* const* d_in, const int* in_sizes, int n_in, void* d_out, int out_size, void* d_ws, size_t ws_size, hipStream_t stream) {
    static int grid = 0;
    if (grid == 0) {
        if (n_in != 29 || out_size != NB * SEQ * D || ws_size < WS_END) {
            fprintf(stderr, "kernel_launch: unexpected shapes: n_in %d out %d ws %zu (need %zu)\n", n_in, out_size, ws_size, (size_t)WS_END); grid = -1; return; }
        int dev = 0, cus = 0, per_cu = 0;
        if (hipGetDevice(&dev) != hipSuccess || hipDeviceGetAttribute(&cus, hipDeviceAttributeMultiprocessorCount, dev) != hipSuccess) { grid = -1; return; }
        if (hipFuncSetAttribute((const void*)mega, hipFuncAttributeMaxDynamicSharedMemorySize, LDS_BYTES) != hipSuccess) { fprintf(stderr, "kernel_launch: hipFuncSetAttribute failed\n"); grid = -1; return; }
        if (hipOccupancyMaxActiveBlocksPerMultiprocessor(&per_cu, (const void*)mega, NTHR, LDS_BYTES) != hipSuccess || per_cu < 1)
            fprintf(stderr, "kernel_launch: occupancy query reports %d blocks per CU\n", per_cu);
        (void)hipGetLastError();
        grid = cus;
    }
    if (grid < 0) return;
    (void)hipMemsetAsync((char*)d_ws + WS_CTL + 16384, 0, 16384, stream);
    Args a{};
    for (int i = 0; i < 29; ++i) a.in[i] = (const float*)d_in[i];
    a.out = (float*)d_out; a.ws = (unsigned char*)d_ws;
#if MK_SINGLE
    a.ph_lo = 0; a.ph_hi = NPHASE;
    hipLaunchKernelGGL(mega, dim3(grid), dim3(NTHR), LDS_BYTES, stream, a);
#else
    for (int p = 0; p < NPHASE; ++p) { a.ph_lo = p; a.ph_hi = p + 1; hipLaunchKernelGGL(mega, dim3(grid), dim3(NTHR), LDS_BYTES, stream, a); }
#endif
    const hipError_t le = hipPeekAtLastError();
    if (le != hipSuccess) fprintf(stderr, "kernel_launch: launch failed: %s\n", hipGetErrorName(le));
}
```

```cpp
#include <hip/hip_runtime.h>
#include <cstdio>
#include <cstdint>

#ifndef MK_SINGLE
#define MK_SINGLE 1
#endif

#define GAS __attribute__((address_space(1)))
#define LAS __attribute__((address_space(3)))

typedef unsigned short bf16_t;
typedef short bf16x8 __attribute__((ext_vector_type(8)));
typedef float f32x4 __attribute__((ext_vector_type(4)));
typedef float f32x16 __attribute__((ext_vector_type(16)));
typedef unsigned u32x4 __attribute__((ext_vector_type(4)));
typedef unsigned u32x2 __attribute__((ext_vector_type(2)));
typedef int i32x4 __attribute__((ext_vector_type(4)));

constexpr int D = 1024, NB = 2, SEQ = 8192, CTXL = 256;
constexpr int RPB = SEQ + CTXL;
constexpr int MTOT = NB * RPB;
constexpr int AB_IN = 2048, A_W = 512, DRNN = 1280, NEXP = 16384;
constexpr float EPS = 1e-6f;
constexpr int NTHR = 512, NWAVE = 8;

constexpr size_t MiB = 1u << 20;
constexpr size_t WS_CTL = 0, CTL_BYTES = 1 * MiB;
constexpr size_t WS_MODV = 1 * MiB;
constexpr size_t WS_ROPE = 1 * MiB + 512 * 1024;
constexpr size_t WS_WIN0 = 2 * MiB;
constexpr size_t WS_WOUT0 = 6 * MiB;
constexpr size_t WS_WIN1 = 8 * MiB;
constexpr size_t WS_WOUT1 = 13 * MiB;
constexpr size_t WS_WQ = 16 * MiB;
constexpr size_t WS_KEYS = 24 * MiB;
constexpr size_t WS_GWS = 25 * MiB;
constexpr size_t WS_WAT = 26 * MiB;
constexpr size_t WS_WXT = 27 * MiB;
constexpr size_t WS_CARRY = 28 * MiB;
constexpr size_t WS_SPL = 30 * MiB + 768 * 1024;
constexpr size_t WS_SCU = 31 * MiB;
constexpr size_t WS_SCV = 31 * MiB + 512 * 1024;
constexpr size_t WS_PU = 32 * MiB;
constexpr size_t WS_PV = 96 * MiB;
constexpr size_t WS_H = 160 * MiB;
constexpr size_t WS_X1 = 193 * MiB;
constexpr size_t WS_SELI = 259 * MiB;
constexpr size_t WS_SELG = 268 * MiB;
constexpr size_t WS_R = 277 * MiB;
constexpr size_t WS_U = WS_R;
constexpr size_t WS_VV = WS_R + 17 * MiB;
constexpr size_t WS_Q = WS_R + 34 * MiB;
constexpr size_t WS_K = WS_R + 51 * MiB;
constexpr size_t WS_V = WS_R + 60 * MiB;
constexpr size_t WS_AO = WS_R + 69 * MiB;
constexpr size_t WS_QP = WS_R;
constexpr size_t WS_H8B = WS_R + 90 * MiB;
constexpr size_t WS_H8 = WS_R + 70 * MiB;
constexpr size_t WS_SH = WS_R + 88 * MiB;
constexpr size_t WS_ACT16 = WS_R + 89 * MiB;
constexpr size_t WS_SA = WS_R + 94 * MiB;
constexpr size_t WS_SACT = WS_R + 94 * MiB + 512 * 1024;
constexpr size_t WS_PART = WS_R;
constexpr size_t WS_GG = WS_R;
constexpr size_t WS_XR = WS_R + 42 * MiB;
constexpr size_t WS_YG = WS_R + 84 * MiB;
constexpr size_t WS_W8IN0 = WS_R + 126 * MiB;
constexpr size_t WS_W8Q = WS_R + 128 * MiB;
constexpr size_t WS_W8IN1 = WS_R + 132 * MiB;
constexpr size_t WS_SW = WS_R + 135 * MiB;
constexpr size_t WS_STR = 128 * MiB;
constexpr size_t WS_STU = WS_R + 136 * MiB;
constexpr size_t WS_STS = WS_R + 180 * MiB;
constexpr size_t WS_END = WS_R + 183 * MiB;

constexpr int LDS_BYTES = 147456;
constexpr int LDS_MISC = 145408;

__device__ __forceinline__ float bf2f(bf16_t v) { return __uint_as_float(((unsigned)v) << 16); }
__device__ __forceinline__ unsigned pk2(float lo, float hi) { unsigned r; asm("v_cvt_pk_bf16_f32 %0, %1, %2" : "=v"(r) : "v"(lo), "v"(hi)); return r; }
__device__ __forceinline__ unsigned f2bf(float f) { return pk2(f, f) & 0xffffu; }
__device__ __forceinline__ float bflo(unsigned w) { return __uint_as_float(w << 16); }
__device__ __forceinline__ float bfhi(unsigned w) { return __uint_as_float(w & 0xffff0000u); }
__device__ __forceinline__ float gelu_t(float x) { const float y = -2.302208198144325f * (x + 0.044715f * x * x * x); return x * __builtin_amdgcn_rcpf(1.f + __builtin_amdgcn_exp2f(y)); }
__device__ __forceinline__ float sigmoidf_(float x) { return 1.f / (1.f + __expf(-x)); }
__device__ __forceinline__ float wave_sum(float v) {
#pragma unroll
    for (int o = 1; o < 64; o <<= 1) v += __shfl_xor(v, o);
    return v;
}
__host__ __device__ __forceinline__ int sigma_head(int j) { const int grp = j >> 3, n = (j >> 2) & 1, e = j & 3; return (grp >> 3) * 64 + n * 32 + (grp & 7) * 4 + e; }

struct Args {
    const float* in[29];
    float* out;
    unsigned char* ws;
    int ph_lo, ph_hi;
};

__device__ __forceinline__ int row_variant(int g) { const int b = g / RPB, i = g - b * RPB; return i < CTXL ? 2 : b; }
__device__ __forceinline__ const float* row_src(const Args& a, int g) {
    const int b = g / RPB, i = g - b * RPB;
    return i < CTXL ? a.in[2] + ((size_t)b * CTXL + i) * D : a.in[0] + ((size_t)b * SEQ + (i - CTXL)) * D;
}
__device__ __forceinline__ const float* modv(const Args& a, int layer, int variant, int which) {
    return (const float*)(a.ws + WS_MODV) + ((size_t)(layer * 3 + variant) * 6 + which) * D;
}

#define XB_TMO      128
#define XB_XCNT(j)  (256  + 64 * (j))
#define XB_XSUB(j)  (1280 + 64 * (j))
#define XB_XGEN(j)  (2304 + 64 * (j))
#define XB_TOP      3328
#define XB_TOPGEN   3392
#define XCD_BAR_WORDS 3456
#define XB_SPIN_CAP (1u << 22)
__device__ __forceinline__ unsigned xb_ld(unsigned* p)              { return __hip_atomic_load(p, __ATOMIC_RELAXED, __HIP_MEMORY_SCOPE_AGENT); }
__device__ __forceinline__ unsigned xb_add(unsigned* p, unsigned v) { return __hip_atomic_fetch_add(p, v, __ATOMIC_RELAXED, __HIP_MEMORY_SCOPE_AGENT); }
__device__ __forceinline__ unsigned xb_xcc_id() { return (unsigned)__builtin_amdgcn_s_getreg((3 << 11) | 20) & 0xFu; }
#define XB_SPIN(cond, bar) do { unsigned _sp = 0; while (cond) { __builtin_amdgcn_s_sleep(1); \
    if ((++_sp & 255u) == 0u) { if (xb_ld(&(bar)[XB_TMO])) break; if (_sp > XB_SPIN_CAP) { atomicAdd(&(bar)[XB_TMO], 1u); break; } } } } while (0)
struct XcdBarrier { unsigned* bar; unsigned x; volatile LAS unsigned* st; };
__device__ __forceinline__ XcdBarrier xcd_barrier_post(unsigned* bar, volatile LAS unsigned* st) {
    XcdBarrier b; b.bar = bar; b.x = xb_xcc_id(); b.st = st;
    if (threadIdx.x == 0) (void)xb_add(&bar[XB_XCNT(b.x)], 1u);
    return b;
}
__device__ __forceinline__ void xcd_barrier_complete(unsigned* bar, unsigned x, unsigned& nloc, unsigned& nx) {
    const unsigned G = gridDim.x * gridDim.y * gridDim.z;
    unsigned sum, cnt, mine, sp = 0u;
    for (;;) {
        sum = 0u; cnt = 0u; mine = 0u;
#pragma unroll
        for (unsigned j = 0; j < 16; ++j) { const unsigned c = xb_ld(&bar[XB_XCNT(j)]); sum += c; cnt += (c > 0u) ? 1u : 0u; mine = (j == x) ? c : mine; }
        if (sum == G) break;
        __builtin_amdgcn_s_sleep(1);
        if ((++sp & 255u) == 0u) { if (xb_ld(&bar[XB_TMO])) break; if (sp > XB_SPIN_CAP) { atomicAdd(&bar[XB_TMO], 1u); break; } }
    }
    nloc = mine > 0u ? mine : 1u; nx = cnt > 0u ? cnt : 1u;
}
__device__ __forceinline__ void xcd_barrier(const XcdBarrier& b) {
    asm volatile("s_waitcnt vmcnt(0)" ::: "memory");
    __syncthreads();
    if (threadIdx.x == 0) {
        unsigned* bar = b.bar;
        __builtin_amdgcn_s_waitcnt(0);
        unsigned nloc = b.st[0], nx = b.st[1];
        if (nloc == 0u) { xcd_barrier_complete(bar, b.x, nloc, nx); b.st[0] = nloc; b.st[1] = nx; }
        const unsigned old = xb_add(&bar[XB_XSUB(b.x)], 1u);
        const unsigned gen = old / nloc;
        if (old + 1u == (gen + 1u) * nloc) {
            __builtin_amdgcn_fence(__ATOMIC_RELEASE, "agent");
            asm volatile("s_waitcnt vmcnt(0)" ::: "memory");
            (void)xb_add(&bar[XB_TOP], 1u);
        }
        XB_SPIN(xb_ld(&bar[XB_TOP]) < (gen + 1u) * nx, bar);
        __builtin_amdgcn_fence(__ATOMIC_ACQUIRE, "agent");
        asm volatile("s_waitcnt vmcnt(0)" ::: "memory");
    }
    __syncthreads();
}

__device__ __forceinline__ void qt_load(f32x4 (&v)[4][4], const Args& a, int layer, int r0, int lane) {
#pragma unroll
    for (int q = 0; q < 4; ++q) {
        const int r = r0 + q, tb = r / NEXP, ex = r - tb * NEXP;
        const float* src = a.in[tb == 0 ? 26 : 27] + ((size_t)layer * NEXP + ex) * D;
#pragma unroll
        for (int j = 0; j < 4; ++j) v[q][j] = *(const f32x4*)(src + j * 256 + lane * 4);
    }
}
__device__ __forceinline__ void qt_store(const f32x4 (&v)[4][4], const Args& a, int layer, int r0, int lane) {
    unsigned char* ws = a.ws; float mx[4], ss[4];
#pragma unroll
    for (int q = 0; q < 4; ++q) { float m = 0.f, s2 = 0.f;
#pragma unroll
        for (int j = 0; j < 4; ++j) { m = fmaxf(fmaxf(fmaxf(fabsf(v[q][j].x), fabsf(v[q][j].y)), fmaxf(fabsf(v[q][j].z), fabsf(v[q][j].w))), m);
            s2 += (v[q][j].x * v[q][j].x + v[q][j].y * v[q][j].y) + (v[q][j].z * v[q][j].z + v[q][j].w * v[q][j].w); }
        mx[q] = m; ss[q] = s2; }
#pragma unroll
    for (int o = 1; o < 64; o <<= 1) {
#pragma unroll
        for (int q = 0; q < 4; ++q) { mx[q] = fmaxf(mx[q], __shfl_xor(mx[q], o)); ss[q] += __shfl_xor(ss[q], o); } }
#pragma unroll
    for (int q = 0; q < 4; ++q) {
        const int r = r0 + q, tb = r / NEXP, ex = r - tb * NEXP;
        {
            const float step = fmaxf(0.3352f * __builtin_sqrtf(ss[q] * (1.f / D)), 1e-30f), inv = 1.f / step;
            unsigned char* dst = ws + (tb == 0 ? WS_PU : WS_PV) + (size_t)layer * NEXP * 512 + (size_t)ex * 128 + (lane >> 3) * 16 + (lane & 3) * 4;
#pragma unroll
            for (int j = 0; j < 4; ++j) {
                const int n0 = min(max((int)floorf(v[q][j].x * inv) + 8, 0), 15), n1 = min(max((int)floorf(v[q][j].y * inv) + 8, 0), 15);
                const int n2 = min(max((int)floorf(v[q][j].z * inv) + 8, 0), 15), n3 = min(max((int)floorf(v[q][j].w * inv) + 8, 0), 15);
                unsigned nbv = (unsigned)n0 | ((unsigned)n1 << 8) | ((unsigned)n2 << 16) | ((unsigned)n3 << 24);
                if (tb == 0 || ((lane >> 2) & 1)) nbv ^= 0x08080808u;
                const unsigned pn = __shfl_xor(nbv, 4);
                if (((lane >> 2) & 1) == 0) *(unsigned*)(dst + (size_t)j * NEXP * 128) = nbv | (pn << 4);
            }
            if (lane == 0) ((float*)(ws + (tb == 0 ? WS_SCU : WS_SCV)))[layer * NEXP + ex] = step;
        }
    }
}
__device__ __forceinline__ void quant_tables(const Args& a, int layer, int gw, int ngw, int lane, int row_lo = 0, int row_hi = 2 * NEXP) {
    const int step = ngw * 4; int r0 = row_lo + gw * 4;
    if (r0 >= row_hi) return;
    f32x4 va[4][4], vb[4][4];
    qt_load(va, a, layer, r0, lane);
    for (;;) {
        const int r1 = r0 + step; const bool h1 = r1 < row_hi;
        if (h1) qt_load(vb, a, layer, r1, lane);
        qt_store(va, a, layer, r0, lane);
        if (!h1) break;
        const int r2 = r1 + step; const bool h2 = r2 < row_hi;
        if (h2) qt_load(va, a, layer, r2, lane);
        qt_store(vb, a, layer, r1, lane);
        if (!h2) break;
        r0 = r2;
    }
}
__device__ __forceinline__ void quant_wrows(const bf16_t* src, unsigned char* dst, float* scale, int nrows, int gw, int ngw, int lane) {
    for (int r = gw; r < nrows; r += ngw) {
        const u32x4 w0 = *(const u32x4*)(src + (size_t)r * D + lane * 16), w1 = *(const u32x4*)(src + (size_t)r * D + lane * 16 + 8);
        float v[16];
        v[0] = bflo(w0.x); v[1] = bfhi(w0.x); v[2] = bflo(w0.y); v[3] = bfhi(w0.y); v[4] = bflo(w0.z); v[5] = bfhi(w0.z); v[6] = bflo(w0.w); v[7] = bfhi(w0.w);
        v[8] = bflo(w1.x); v[9] = bfhi(w1.x); v[10] = bflo(w1.y); v[11] = bfhi(w1.y); v[12] = bflo(w1.z); v[13] = bfhi(w1.z); v[14] = bflo(w1.w); v[15] = bfhi(w1.w);
        float mx = 0.f;
#pragma unroll
        for (int k = 0; k < 16; ++k) mx = fmaxf(mx, fabsf(v[k]));
#pragma unroll
        for (int o = 1; o < 64; o <<= 1) mx = fmaxf(mx, __shfl_xor(mx, o));
        mx = fmaxf(mx, 1e-30f); const float inv = 127.f / mx;
        unsigned q[4];
#pragma unroll
        for (int d = 0; d < 4; ++d) q[d] = ((unsigned)__float2int_rn(v[4 * d] * inv) & 0xffu) | (((unsigned)__float2int_rn(v[4 * d + 1] * inv) & 0xffu) << 8) | (((unsigned)__float2int_rn(v[4 * d + 2] * inv) & 0xffu) << 16) | (((unsigned)__float2int_rn(v[4 * d + 3] * inv) & 0xffu) << 24);
        u32x4 o4; o4.x = q[0]; o4.y = q[1]; o4.z = q[2]; o4.w = q[3];
        *(u32x4*)(dst + (size_t)r * D + lane * 16) = o4;
        if (lane == 0) scale[r] = mx * (1.f / 127.f);
    }
}
__device__ __forceinline__ void transpose_item4(const float* src, int Ns, bf16_t* dst, int Kd, int n0, int k0, int dn1, int dk1, int dn2, int dk2, int dn3, int dk3, int perm_lo, int perm_hi, float* tile, float scl = 1.f) {
    const int tid = threadIdx.x;
    const int dnv[4] = {0, dn1, dn2, dn3}, dkv[4] = {0, dk1, dk2, dk3};
    float v[4][8];
#pragma unroll
    for (int t = 0; t < 4; ++t) {
        const int nn = tid & 63; int n = n0 + dnv[t] + nn;
        if (n >= perm_lo && n < perm_hi) { const int rel = n - perm_lo; n = perm_lo + (rel & ~127) + sigma_head(rel & 127); }
#pragma unroll
        for (int i = 0; i < 8; ++i) { const int kk = (tid >> 6) + 8 * i; v[t][i] = scl * src[(size_t)(k0 + dkv[t] + kk) * Ns + n]; }
    }
#pragma unroll
    for (int t = 0; t < 4; ++t)
#pragma unroll
        for (int i = 0; i < 8; ++i) { const int kk = (tid >> 6) + 8 * i; tile[t * 64 * 65 + kk * 65 + (tid & 63)] = v[t][i]; }
    __syncthreads();
#pragma unroll
    for (int t = 0; t < 4; ++t) {
        const int n = tid >> 3, kc = (tid & 7) * 8; const float* tl = tile + t * 64 * 65;
        u32x4 o;
        o.x = pk2(tl[(kc + 0) * 65 + n], tl[(kc + 1) * 65 + n]); o.y = pk2(tl[(kc + 2) * 65 + n], tl[(kc + 3) * 65 + n]);
        o.z = pk2(tl[(kc + 4) * 65 + n], tl[(kc + 5) * 65 + n]); o.w = pk2(tl[(kc + 6) * 65 + n], tl[(kc + 7) * 65 + n]);
        *(u32x4*)(dst + (size_t)(n0 + dnv[t] + n) * Kd + k0 + dkv[t] + kc) = o;
    }
    __syncthreads();
}
__device__ __forceinline__ void transpose_wide(const float* src, int Ns, bf16_t* dst, int Kd, int ng, int kb, int perm_lo, int perm_hi, float* tile) {
    transpose_item4(src, Ns, dst, Kd, ng * 256, kb * 64, 64, 0, 128, 0, 192, 0, perm_lo, perm_hi, tile);
}
__device__ __forceinline__ void cvt_stream(const float* src, bf16_t* dst, size_t n8, size_t gtid, size_t gthreads) {
    for (size_t i = gtid; i < n8; i += gthreads) {
        const f32x4 a = *(const f32x4*)(src + i * 8), b = *(const f32x4*)(src + i * 8 + 4);
        u32x4 o; o.x = pk2(a.x, a.y); o.y = pk2(a.z, a.w); o.z = pk2(b.x, b.y); o.w = pk2(b.z, b.w);
        *(u32x4*)(dst + i * 8) = o;
    }
}
__device__ __forceinline__ void prep_l1_item(const Args& a, float* tile, int r) {
    unsigned char* ws = a.ws;
    constexpr int I_WIN1 = 16 * 10, I_WOUT1 = 20 * 4, I_WQ1 = 16 * 8;
    if (r < I_WIN1) { transpose_wide(a.in[15], 2560, (bf16_t*)(ws + WS_WIN1), 1024, r % 10, r / 10, 0, 0, tile); return; }
    r -= I_WIN1;
    if (r < I_WOUT1) { transpose_wide(a.in[23], 1024, (bf16_t*)(ws + WS_WOUT1), 1280, r % 4, r / 4, 0, 0, tile); return; }
    r -= I_WOUT1;
    if (r < I_WQ1) { transpose_wide(a.in[24] + (size_t)1024 * 2048, 2048, (bf16_t*)(ws + WS_WQ) + (size_t)2048 * 1024, 1024, r % 8, r / 8, 0, 0, tile); return; }
    r -= I_WQ1;
    { const int which = r / 20, dh = r % 20;
        const float* src = a.in[which == 0 ? 18 : 20] + (size_t)dh * 128 * 128;
        bf16_t* dst = (bf16_t*)(ws + (which == 0 ? WS_WAT : WS_WXT)) + (size_t)dh * 128 * 128;
        transpose_item4(src, 128, dst, 128, 0, 0, 64, 0, 0, 64, 64, 64, 0, 0, tile, -1.4426950408889634f);
    }
}
constexpr int N_L1_ITEMS = 160 + 80 + 128 + 40;
__device__ __forceinline__ void phase_prep(const Args& a, char* lds) {
    const int tid = threadIdx.x, lane = tid & 63, wid = tid >> 6;
    float* tile = (float*)lds;
    unsigned char* ws = a.ws;
    constexpr int I_MOD = 192;
    constexpr int I_WIN0 = 16 * 8, I_WOUT0 = 16 * 4, I_WQ0 = 16 * 8;
    constexpr int NIT = I_MOD + I_WIN0 + I_WOUT0 + I_WQ0;
    for (int it = blockIdx.x; it < NIT; it += gridDim.x) {
        int r = it;
        if (r < I_MOD) {
            const int l = r / 96, n0 = (r % 96) * 64;
            const float* W = a.in[4] + (size_t)l * D * 6144;
            float s0 = 0.f, s1 = 0.f, s2 = 0.f;
            float sl[3][2];
#pragma unroll
            for (int h = 0; h < 2; ++h) { const int k = wid * 128 + h * 64 + lane; const float c0 = a.in[1][k], c1 = a.in[1][D + k], c2 = a.in[3][k];
                sl[0][h] = c0 * sigmoidf_(c0); sl[1][h] = c1 * sigmoidf_(c1); sl[2][h] = c2 * sigmoidf_(c2); }
            const float* Wp = W + (size_t)(wid * 128) * 6144 + n0 + lane;
#pragma unroll
            for (int kk = 0; kk < 128; kk += 16) {
                float w[16];
#pragma unroll
                for (int j = 0; j < 16; ++j) w[j] = Wp[(size_t)(kk + j) * 6144];
#pragma unroll
                for (int j = 0; j < 16; ++j) { const int kq = kk + j;
                    s0 += __shfl(sl[0][kq >> 6], kq & 63) * w[j]; s1 += __shfl(sl[1][kq >> 6], kq & 63) * w[j]; s2 += __shfl(sl[2][kq >> 6], kq & 63) * w[j]; }
            }
            tile[(wid * 3 + 0) * 64 + lane] = s0; tile[(wid * 3 + 1) * 64 + lane] = s1; tile[(wid * 3 + 2) * 64 + lane] = s2;
            __syncthreads();
            if (tid < 192) {
                const int v = tid / 64, ln = tid & 63; float s = a.in[5][(size_t)l * 6144 + n0 + ln];
                for (int w = 0; w < 8; ++w) s += tile[(w * 3 + v) * 64 + ln];
                ((float*)(ws + WS_MODV))[(size_t)(l * 3 + v) * 6144 + n0 + ln] = s;
            }
            __syncthreads();
            continue;
        }
        r -= I_MOD;
        if (r < I_WIN0) { transpose_wide(a.in[8], 2048, (bf16_t*)(ws + WS_WIN0), 1024, r % 8, r / 8, 1024, 1792, tile); continue; }
        r -= I_WIN0;
        if (r < I_WOUT0) { transpose_wide(a.in[14], 1024, (bf16_t*)(ws + WS_WOUT0), 1024, r % 4, r / 4, 0, 0, tile); continue; }
        r -= I_WOUT0;
        transpose_wide(a.in[24], 2048, (bf16_t*)(ws + WS_WQ), 1024, r % 8, r / 8, 0, 0, tile);
    }
    const size_t gtid = (size_t)blockIdx.x * NTHR + tid, gthreads = (size_t)gridDim.x * NTHR;
    cvt_stream(a.in[25], (bf16_t*)(ws + WS_KEYS), (size_t)2 * 8 * 2 * 128 * 128 / 8, gtid, gthreads);
    cvt_stream(a.in[10], (bf16_t*)(ws + WS_GWS), (size_t)4 * 128 * 128 / 8, gtid, gthreads);
    for (size_t i = gtid; i < 128 * 32; i += gthreads) {
        const int pos = (int)(i / 32), f = (int)(i % 32);
        const float inv = powf(10000.f, -(float)f / 32.f); const float ang = (float)pos * inv;
        float* R = (float*)(ws + WS_ROPE); R[i * 2] = cosf(ang); R[i * 2 + 1] = sinf(ang);
    }
}

__device__ __forceinline__ void norm_row_store(const f32x4 (&v)[4], const float* g, const float* sh, const float* sc, bf16_t* orow, int lane, unsigned char* q8row = nullptr, float* q8scale = nullptr) {
    float s = 0.f;
#pragma unroll
    for (int j = 0; j < 4; ++j) s += (v[j].x * v[j].x + v[j].y * v[j].y) + (v[j].z * v[j].z + v[j].w * v[j].w);
    const float rinv = rsqrtf(wave_sum(s) * (1.f / D) + EPS);
    f32x4 o[4]; float mx = 0.f;
#pragma unroll
    for (int j = 0; j < 4; ++j) {
        const int c = j * 256 + lane * 4;
        const f32x4 gg = *(const f32x4*)(g + c), s1 = *(const f32x4*)(sh + c), s2 = *(const f32x4*)(sc + c);
        o[j].x = v[j].x * rinv * gg.x * (1.f + s2.x) + s1.x; o[j].y = v[j].y * rinv * gg.y * (1.f + s2.y) + s1.y;
        o[j].z = v[j].z * rinv * gg.z * (1.f + s2.z) + s1.z; o[j].w = v[j].w * rinv * gg.w * (1.f + s2.w) + s1.w;
        if (!q8row) { u32x2 w; w.x = pk2(o[j].x, o[j].y); w.y = pk2(o[j].z, o[j].w); *(u32x2*)(orow + c) = w; }
        mx = fmaxf(fmaxf(fmaxf(fabsf(o[j].x), fabsf(o[j].y)), fmaxf(fabsf(o[j].z), fabsf(o[j].w))), mx);
    }
    if (q8row) {
#pragma unroll
        for (int of = 1; of < 64; of <<= 1) mx = fmaxf(mx, __shfl_xor(mx, of));
        mx = fmaxf(mx, 1e-30f); const float inv = 119.f / mx;
#pragma unroll
        for (int j = 0; j < 4; ++j) {
            const unsigned b0 = (unsigned)__float2int_rn(o[j].x * inv) & 0xffu, b1 = (unsigned)__float2int_rn(o[j].y * inv) & 0xffu;
            const unsigned b2 = (unsigned)__float2int_rn(o[j].z * inv) & 0xffu, b3 = (unsigned)__float2int_rn(o[j].w * inv) & 0xffu;
            *(unsigned*)(q8row + j * 256 + lane * 4) = b0 | (b1 << 8) | (b2 << 16) | (b3 << 24);
        }
        if (lane == 0) *q8scale = mx * (1.f / 119.f);
    }
}
__device__ __forceinline__ void phase_norm(const Args& a, int layer, int src_mode, const float* gain, int which_sh, int which_sc, bool latent_only, bool wq8 = false, size_t h8off = WS_H8) {
    const int lane = threadIdx.x & 63, gw = blockIdx.x * NWAVE + (threadIdx.x >> 6), ngw = gridDim.x * NWAVE;
    bf16_t* H = (bf16_t*)(a.ws + WS_H);
    const bf16_t* X1 = (const bf16_t*)(a.ws + WS_X1);
    if (!latent_only) {
        for (int g = gw; g < MTOT; g += 2 * ngw) {
            const int gB = g + ngw < MTOT ? g + ngw : g; const bool hasB = g + ngw < MTOT;
            const int varA = row_variant(g), varB = row_variant(gB);
            f32x4 vA[4], vB[4];
            if (src_mode == 0) { const float* xa = row_src(a, g); const float* xb = row_src(a, gB);
#pragma unroll
                for (int j = 0; j < 4; ++j) { vA[j] = *(const f32x4*)(xa + j * 256 + lane * 4); vB[j] = *(const f32x4*)(xb + j * 256 + lane * 4); }
            } else { const bf16_t* xa = X1 + (size_t)g * D; const bf16_t* xb = X1 + (size_t)gB * D;
#pragma unroll
                for (int j = 0; j < 4; ++j) { const u32x2 wa = *(const u32x2*)(xa + j * 256 + lane * 4), wb = *(const u32x2*)(xb + j * 256 + lane * 4);
                    vA[j] = f32x4{bflo(wa.x), bfhi(wa.x), bflo(wa.y), bfhi(wa.y)}; vB[j] = f32x4{bflo(wb.x), bfhi(wb.x), bflo(wb.y), bfhi(wb.y)}; }
            }
            norm_row_store(vA, gain, modv(a, layer, varA, which_sh), modv(a, layer, varA, which_sc), H + (size_t)g * D, lane, wq8 ? a.ws + h8off + (size_t)g * D : nullptr, wq8 ? (float*)(a.ws + WS_SH) + g : nullptr);
            if (hasB) norm_row_store(vB, gain, modv(a, layer, varB, which_sh), modv(a, layer, varB, which_sc), H + (size_t)gB * D, lane, wq8 ? a.ws + h8off + (size_t)gB * D : nullptr, wq8 ? (float*)(a.ws + WS_SH) + gB : nullptr);
        }
        return;
    }
    for (int g = gw; g < MTOT; g += ngw) {
        const int var = row_variant(g);
        if (latent_only && var == 2) continue;
        f32x4 v[4];
        if (src_mode == 0) { const float* xr = row_src(a, g);
#pragma unroll
            for (int j = 0; j < 4; ++j) v[j] = *(const f32x4*)(xr + j * 256 + lane * 4);
        } else { const bf16_t* xr = X1 + (size_t)g * D;
#pragma unroll
            for (int j = 0; j < 4; ++j) { const u32x2 w = *(const u32x2*)(xr + j * 256 + lane * 4); v[j] = f32x4{bflo(w.x), bfhi(w.x), bflo(w.y), bfhi(w.y)}; }
        }
        norm_row_store(v, gain, modv(a, layer, var, which_sh), modv(a, layer, var, which_sc), H + (size_t)g * D, lane, wq8 ? a.ws + h8off + (size_t)g * D : nullptr, wq8 ? (float*)(a.ws + WS_SH) + g : nullptr);
    }
}

__device__ __forceinline__ void phase_gmlp2(const Args& a, char* lds) {
    const int tid = threadIdx.x, lane = tid & 63, wid = __builtin_amdgcn_readfirstlane(tid >> 6), r32 = lane & 31, hh = lane >> 5;
    unsigned char* ws = a.ws;
    LAS bf16_t* vT = (LAS bf16_t*)((LAS char*)lds);
    const bf16_t* VV = (const bf16_t*)(ws + WS_VV); const bf16_t* U = (const bf16_t*)(ws + WS_U); bf16_t* AO = (bf16_t*)(ws + WS_AO);
    const bf16_t* GWS = (const bf16_t*)(ws + WS_GWS);
    const int NU = (MTOT / 128) * 4;
    const int gskip = gridDim.x > 64 ? 8 : 0;
    if ((int)blockIdx.x < gskip) return;
    for (int u = blockIdx.x - gskip; u < NU; u += gridDim.x - gskip) {
        const int ch = u >> 2, g = u & 3, row0 = ch * 128;
        const int mb = wid >> 1, nb0 = (wid & 1) * 2;
        u32x4 vw[4];
#pragma unroll
        for (int i = 0; i < 4; ++i) { const int q = (tid >> 4) + 32 * i, c0 = (tid & 15) * 8; vw[i] = *(const u32x4*)(VV + (size_t)(row0 + q) * 512 + g * 128 + c0); }
        bf16_t uv0[16], uv1[16]; float bsr[16];
#pragma unroll
        for (int r = 0; r < 16; ++r) {
            const int p = mb * 32 + (r & 3) + 8 * (r >> 2) + 4 * hh;
            const size_t ub = (size_t)(row0 + p) * 512 + g * 128;
            uv0[r] = U[ub + nb0 * 32 + r32]; uv1[r] = U[ub + nb0 * 32 + 32 + r32]; bsr[r] = a.in[11][g * 128 + p];
        }
#pragma unroll
        for (int i = 0; i < 4; ++i) {
            const int q = (tid >> 4) + 32 * i, c0 = (tid & 15) * 8;
            const u32x4 w = vw[i];
            vT[(c0 + 0) * 136 + q] = (bf16_t)(w.x & 0xffffu); vT[(c0 + 1) * 136 + q] = (bf16_t)(w.x >> 16);
            vT[(c0 + 2) * 136 + q] = (bf16_t)(w.y & 0xffffu); vT[(c0 + 3) * 136 + q] = (bf16_t)(w.y >> 16);
            vT[(c0 + 4) * 136 + q] = (bf16_t)(w.z & 0xffffu); vT[(c0 + 5) * 136 + q] = (bf16_t)(w.z >> 16);
            vT[(c0 + 6) * 136 + q] = (bf16_t)(w.w & 0xffffu); vT[(c0 + 7) * 136 + q] = (bf16_t)(w.w >> 16);
        }
        __syncthreads();
        f32x16 acc0 = {}, acc1 = {};
        {
            unsigned aoff = (unsigned)((mb * 32 + r32) * 128 + 8 * hh); asm volatile("" : "+v"(aoff));
            const bf16_t* wsg = GWS + (size_t)g * 128 * 128;
#pragma unroll
            for (int ks = 0; ks < 8; ++ks) {
                const bf16x8 af = *(const bf16x8*)(wsg + aoff + ks * 16);
                const bf16x8 b0 = *(const LAS bf16x8*)(vT + (nb0 * 32 + r32) * 136 + ks * 16 + 8 * hh);
                const bf16x8 b1 = *(const LAS bf16x8*)(vT + ((nb0 + 1) * 32 + r32) * 136 + ks * 16 + 8 * hh);
                acc0 = __builtin_amdgcn_mfma_f32_32x32x16_bf16(af, b0, acc0, 0, 0, 0);
                acc1 = __builtin_amdgcn_mfma_f32_32x32x16_bf16(af, b1, acc1, 0, 0, 0);
            }
        }
#pragma unroll
        for (int r = 0; r < 16; ++r) {
            const int p = mb * 32 + (r & 3) + 8 * (r >> 2) + 4 * hh;
            const float bsv = bsr[r];
            const size_t ob = (size_t)(row0 + p) * 1024 + g * 128;
            const int c0 = nb0 * 32 + r32, c1 = c0 + 32;
            AO[ob + c0] = (bf16_t)f2bf(bf2f(uv0[r]) * (acc0[r] + bsv));
            AO[ob + c1] = (bf16_t)f2bf(bf2f(uv1[r]) * (acc1[r] + bsv));
        }
        __syncthreads();
    }
}

namespace fa {
typedef short s16x4 __attribute__((ext_vector_type(4)));
constexpr int QBLK = 32, KVBLK = 64, LDQ = 512, LDK = 128, LDO = 1024;
constexpr float SCALE = 0.088388347648318440f, THR = 8.f;
constexpr size_t SHM_V = KVBLK * 128 * 2, SHM_K = KVBLK * 128 * 2, SHM_ATTN = 2 * SHM_V + 2 * SHM_K + NWAVE * 64 * 4;
#define KSWZ(row, colB) ((row) * 256 + ((colB) ^ (((row) & 7) << 4)))
#define SBAR() __builtin_amdgcn_sched_barrier(0)
__device__ __forceinline__ int crow(int r, int hi) { return (r & 3) + 8 * (r >> 2) + 4 * hi; }
__device__ __forceinline__ unsigned cvtpk(float lo, float hi) { unsigned r; asm volatile("v_cvt_pk_bf16_f32 %0, %1, %2" : "=v"(r) : "v"(lo), "v"(hi)); return r; }
__device__ __forceinline__ void partialSM(f32x16& p0, f32x16& p1, float& m_reg, float& mn, float& alpha) {
  constexpr float C = SCALE * 1.4426950408889634f;
  float pmax = p0[0]; for (int r = 1; r < 16; ++r) pmax = fmaxf(pmax, p0[r]); for (int r = 0; r < 16; ++r) pmax = fmaxf(pmax, p1[r]);
  { auto rr = __builtin_amdgcn_permlane32_swap(__float_as_uint(pmax), __float_as_uint(pmax), false, false);
    pmax = fmaxf(__uint_as_float(rr[0]), __uint_as_float(rr[1])); }
  if (__builtin_expect(__all(pmax - m_reg <= THR / SCALE), 1)) { mn = m_reg; alpha = 1.f; }
  else { mn = fmaxf(m_reg, pmax); alpha = __builtin_amdgcn_exp2f((m_reg - mn) * C); m_reg = mn; }
  float mnC = -mn * C;
  for (int r = 0; r < 16; ++r) p0[r] = fmaf(p0[r], C, mnC); for (int r = 0; r < 16; ++r) p1[r] = fmaf(p1[r], C, mnC);
  for (int r = 0; r < 16; ++r) p0[r] = __builtin_amdgcn_exp2f(p0[r]);
}
__device__ __forceinline__ void finishSM(f32x16& p0, f32x16& p1, float alpha, float& l_reg, bf16x8& pa0, bf16x8& pa1, bf16x8& pa2, bf16x8& pa3) {
  for (int r = 0; r < 16; ++r) p1[r] = __builtin_amdgcn_exp2f(p1[r]);
  float ps = 0; for (int r = 0; r < 16; ++r) ps += p0[r]; for (int r = 0; r < 16; ++r) ps += p1[r];
  { auto rr = __builtin_amdgcn_permlane32_swap(__float_as_uint(ps), __float_as_uint(ps), false, false);
    ps = __uint_as_float(rr[0]) + __uint_as_float(rr[1]); }
  l_reg = l_reg * alpha + ps;
#define PK4(P, BASE, OUT) do { unsigned a0 = cvtpk(P[BASE + 0], P[BASE + 1]), a1 = cvtpk(P[BASE + 2], P[BASE + 3]);   \
    unsigned b0 = cvtpk(P[BASE + 4], P[BASE + 5]), b1 = cvtpk(P[BASE + 6], P[BASE + 7]);                              \
    auto r0 = __builtin_amdgcn_permlane32_swap(a0, b0, false, false); auto r1 = __builtin_amdgcn_permlane32_swap(a1, b1, false, false); \
    u32x4 w = {r0[0], r1[0], r0[1], r1[1]}; OUT = *reinterpret_cast<bf16x8*>(&w); } while (0)
  PK4(p0, 0, pa0); PK4(p0, 8, pa1); PK4(p1, 0, pa2); PK4(p1, 8, pa3);
#undef PK4
}
__device__ __forceinline__ void qkt(f32x16& p0, f32x16& p1, const bf16_t* Ks, const bf16x8* qr, int r32, int hi) {
  p0 = f32x16{}; p1 = f32x16{};
  for (int d0 = 0; d0 < 8; ++d0) { int cb = (d0 * 16 + hi * 8) * 2;
    bf16x8 b0 = *reinterpret_cast<const bf16x8*>((const char*)Ks + KSWZ(r32, cb));
    bf16x8 b1 = *reinterpret_cast<const bf16x8*>((const char*)Ks + KSWZ(32 + r32, cb));
    p0 = __builtin_amdgcn_mfma_f32_32x32x16_bf16(b0, qr[d0], p0, 0, 0, 0);
    p1 = __builtin_amdgcn_mfma_f32_32x32x16_bf16(b1, qr[d0], p1, 0, 0, 0); }
}
__device__ __forceinline__ int v_st(int k, int c) { const int kk = (k & ~0xC) | ((k & 4) << 1) | ((k & 8) >> 1); return ((kk >> 3) * 4 + (c >> 5)) * 512 + ((kk & 7) * 32 + (c & 31)) * 2; }
__device__ __forceinline__ int v_rd_base(int lane) { return ((lane & 3) << 3) | (((lane >> 2) & 3) << 6) | (((lane >> 4) & 1) << 5) | (((lane >> 5) & 1) << 8); }
constexpr int v_rd_off(int d0, int ks, int half) { return d0 * 512 + ks * 4096 + half * 2048; }
template <int OFF> __device__ __forceinline__ s16x4 tr_read(int vb) {
  s16x4 r; asm volatile("ds_read_b64_tr_b16 %0, %1 offset:%2" : "=&v"(r) : "v"(vb), "i"(OFF) : "memory"); return r;
}
template <int D0> __device__ __forceinline__ void pv_one(f32x16& od, int vb, bf16x8 pa0, bf16x8 pa1, bf16x8 pa2, bf16x8 pa3) {
  const s16x4 l0 = tr_read<v_rd_off(D0, 0, 0)>(vb), h0 = tr_read<v_rd_off(D0, 0, 1)>(vb), l1 = tr_read<v_rd_off(D0, 1, 0)>(vb), h1 = tr_read<v_rd_off(D0, 1, 1)>(vb);
  const s16x4 l2 = tr_read<v_rd_off(D0, 2, 0)>(vb), h2 = tr_read<v_rd_off(D0, 2, 1)>(vb), l3 = tr_read<v_rd_off(D0, 3, 0)>(vb), h3 = tr_read<v_rd_off(D0, 3, 1)>(vb);
  asm volatile("s_waitcnt lgkmcnt(0)" ::: "memory"); SBAR();
#define PK(L, H) (bf16x8){L[0], L[1], L[2], L[3], H[0], H[1], H[2], H[3]}
  od = __builtin_amdgcn_mfma_f32_32x32x16_bf16(pa0, PK(l0, h0), od, 0, 0, 0);
  od = __builtin_amdgcn_mfma_f32_32x32x16_bf16(pa1, PK(l1, h1), od, 0, 0, 0);
  od = __builtin_amdgcn_mfma_f32_32x32x16_bf16(pa2, PK(l2, h2), od, 0, 0, 0);
  od = __builtin_amdgcn_mfma_f32_32x32x16_bf16(pa3, PK(l3, h3), od, 0, 0, 0);
#undef PK
}
__device__ __forceinline__ void pv_d0(f32x16* o, int vb, bf16x8 pa0, bf16x8 pa1, bf16x8 pa2, bf16x8 pa3) {
  pv_one<0>(o[0], vb, pa0, pa1, pa2, pa3); pv_one<1>(o[1], vb, pa0, pa1, pa2, pa3); pv_one<2>(o[2], vb, pa0, pa1, pa2, pa3); pv_one<3>(o[3], vb, pa0, pa1, pa2, pa3);
}
__device__ __forceinline__ void attn_dense_body(const bf16_t* __restrict__ Qb, const bf16_t* __restrict__ Kh, const bf16_t* __restrict__ Vh,
                                                bf16_t* __restrict__ Ob, int seq, char* lds) {
  const int tid = threadIdx.x, wid = tid >> 6, lane = tid & 63, r32 = lane & 31, hi = lane >> 5;
  bf16_t* V_lds = (bf16_t*)lds; bf16_t* K_lds = (bf16_t*)(lds + 2 * SHM_V);
  float* ws = (float*)(lds + 2 * SHM_V + 2 * SHM_K) + wid * 64; float* li_l = ws; float* al_l = ws + 32;
  float m_reg = -1e30f, l_reg = 0; f32x16 o[4] = {}; bf16x8 qr[8];
  const bf16_t* Qw = Qb + (long)(wid * QBLK + r32) * LDQ + hi * 8;
#pragma unroll
  for (int d0 = 0; d0 < 8; ++d0) qr[d0] = *reinterpret_cast<const bf16x8*>(Qw + d0 * 16);
  const int sr = tid >> 4, sc = (tid & 15) * 8, vst0 = v_st(sr, sc), vst1 = v_st(32 + sr, sc);
  const int vb0 = (int)(uintptr_t)V_lds + v_rd_base(lane);
  struct { bf16x8 vs0, vs1, ks0, ks1; } sr_[2];
#define SLOAD(i, k0) do { sr_[i].vs0 = *reinterpret_cast<const bf16x8*>(&Vh[(long)((k0) + sr) * LDK + sc]); sr_[i].vs1 = *reinterpret_cast<const bf16x8*>(&Vh[(long)((k0) + 32 + sr) * LDK + sc]); \
    sr_[i].ks0 = *reinterpret_cast<const bf16x8*>(&Kh[(long)((k0) + sr) * LDK + sc]); sr_[i].ks1 = *reinterpret_cast<const bf16x8*>(&Kh[(long)((k0) + 32 + sr) * LDK + sc]); } while (0)
#define SWRITE(b, i) do { *(bf16x8*)((char*)V_lds + (b) * SHM_V + vst0) = sr_[i].vs0;          \
    *(bf16x8*)((char*)V_lds + (b) * SHM_V + vst1) = sr_[i].vs1; int kc = sc * 2;               \
    *(bf16x8*)((char*)K_lds + (b) * SHM_K + KSWZ(sr, kc)) = sr_[i].ks0;                       \
    *(bf16x8*)((char*)K_lds + (b) * SHM_K + KSWZ(32 + sr, kc)) = sr_[i].ks1; } while (0)
#define SWAIT() asm volatile("s_waitcnt vmcnt(4)" ::: "memory")
#define RESC(a) do { if (__any((a) < 1.f)) { if (hi == 0) al_l[r32] = (a); asm volatile("s_waitcnt lgkmcnt(0)" ::: "memory"); \
    for (int d = 0; d < 4; ++d) for (int r = 0; r < 16; ++r) o[d][r] *= al_l[crow(r, hi)]; } } while (0)
  f32x16 pA0, pA1, pB0, pB1; float mnA, mnB, alA, alB; bf16x8 pa0, pa1, pa2, pa3; const int NT = seq / KVBLK;
  constexpr int SE = 0, SO = 1;
  SLOAD(SE, 0); asm volatile("s_waitcnt vmcnt(0)" ::: "memory"); SWRITE(0, SE); __syncthreads();
  qkt(pA0, pA1, K_lds, qr, r32, hi); partialSM(pA0, pA1, m_reg, mnA, alA);
  SLOAD(SO, KVBLK); if (2 < NT) SLOAD(SE, 2 * KVBLK);
  SWAIT(); SWRITE(1, SO); __syncthreads();
  for (int j = 1; j + 1 < NT; j += 2) {
    SBAR(); qkt(pB0, pB1, (bf16_t*)((char*)K_lds + SHM_K), qr, r32, hi);
    finishSM(pA0, pA1, alA, l_reg, pa0, pa1, pa2, pa3); SBAR();
    SLOAD(SO, (j + 2) * KVBLK); SBAR();
    pv_d0(o, vb0, pa0, pa1, pa2, pa3); partialSM(pB0, pB1, m_reg, mnB, alB);
    __syncthreads(); SWAIT(); SWRITE(0, SE);
    RESC(alB); __syncthreads();
    SBAR(); qkt(pA0, pA1, K_lds, qr, r32, hi);
    finishSM(pB0, pB1, alB, l_reg, pa0, pa1, pa2, pa3); SBAR();
    if (j + 3 < NT) SLOAD(SE, (j + 3) * KVBLK); SBAR();
    pv_d0(o, vb0 + (int)SHM_V, pa0, pa1, pa2, pa3); partialSM(pA0, pA1, m_reg, mnA, alA);
    __syncthreads(); SWAIT(); SWRITE(1, SO);
    RESC(alA); __syncthreads();
  }
  SBAR(); qkt(pB0, pB1, (bf16_t*)((char*)K_lds + SHM_K), qr, r32, hi);
  finishSM(pA0, pA1, alA, l_reg, pa0, pa1, pa2, pa3); SBAR();
  pv_d0(o, vb0, pa0, pa1, pa2, pa3); partialSM(pB0, pB1, m_reg, mnB, alB);
  __syncthreads(); RESC(alB);
  finishSM(pB0, pB1, alB, l_reg, pa0, pa1, pa2, pa3); SBAR();
  pv_d0(o, vb0 + (int)SHM_V, pa0, pa1, pa2, pa3);
  if (hi == 0) li_l[r32] = l_reg; asm volatile("s_waitcnt lgkmcnt(0)" ::: "memory");
  float rli[16];
#pragma unroll
  for (int r = 0; r < 16; ++r) rli[r] = __builtin_amdgcn_rcpf(li_l[crow(r, hi)]);
  bf16_t* Ow = Ob + (long)(wid * QBLK) * LDO;
#pragma unroll
  for (int r = 0; r < 16; ++r) { int orow = crow(r, hi);
    for (int d0 = 0; d0 < 4; ++d0) Ow[(long)orow * LDO + d0 * 32 + r32] = (bf16_t)f2bf(o[d0][r] * rli[r]); }
  __syncthreads();
#undef SLOAD
#undef SWRITE
#undef SWAIT
#undef RESC
}
#undef KSWZ
#undef SBAR
}

__device__ __forceinline__ void phase_attn(const Args& a, char* lds) {
    unsigned char* ws = a.ws;
    const bf16_t* Q = (const bf16_t*)(ws + WS_Q); const bf16_t* Kb = (const bf16_t*)(ws + WS_K); const bf16_t* Vb = (const bf16_t*)(ws + WS_V);
    bf16_t* AO = (bf16_t*)(ws + WS_AO);
    const int NU = 256 + 8;
    for (int u = blockIdx.x; u < NU; u += gridDim.x) {
        int b, h, qrow0, nkeys;
        if (u < 256) { const int x = u & 7; b = x >> 2; h = x & 3; qrow0 = b * RPB + CTXL + (u >> 3) * 256; nkeys = RPB; }
        else { const int v = u - 256; b = v / 4; h = v % 4; qrow0 = b * RPB; nkeys = CTXL; }
        const int kvh = h >> 1; const size_t krow0 = (size_t)(b * 2 + kvh) * RPB;
        fa::attn_dense_body(Q + (size_t)qrow0 * 512 + h * 128, Kb + krow0 * 128, Vb + krow0 * 128, AO + (size_t)qrow0 * 1024 + 512 + h * 128, nkeys, lds);
    }
}

constexpr int TK_LD = 136;
__device__ __forceinline__ int peer_tok(int i, int mode);
namespace tk {
__device__ __forceinline__ void ce(float& a, float& b) { const float mx = __builtin_fmaxf(a, b), mn = __builtin_fminf(a, b); a = mx; b = mn; }
__device__ __forceinline__ void sort16_desc(float (&v)[16]) {
#define TKC(i, j) ce(v[i], v[j]);
    TKC(0,13) TKC(1,12) TKC(2,15) TKC(3,14) TKC(4,8) TKC(5,6) TKC(7,11) TKC(9,10)
    TKC(0,5) TKC(1,7) TKC(2,9) TKC(3,4) TKC(6,13) TKC(8,14) TKC(10,15) TKC(11,12)
    TKC(0,1) TKC(2,3) TKC(4,5) TKC(6,8) TKC(7,9) TKC(10,11) TKC(12,13) TKC(14,15)
    TKC(0,2) TKC(1,3) TKC(4,10) TKC(5,11) TKC(6,7) TKC(8,9) TKC(12,14) TKC(13,15)
    TKC(1,2) TKC(3,12) TKC(4,6) TKC(5,7) TKC(8,10) TKC(9,11) TKC(13,14)
    TKC(1,4) TKC(2,6) TKC(5,8) TKC(7,10) TKC(9,13) TKC(11,14)
    TKC(2,4) TKC(3,6) TKC(9,12) TKC(11,13)
    TKC(3,5) TKC(6,8) TKC(7,9) TKC(10,12)
    TKC(3,4) TKC(5,6) TKC(7,8) TKC(9,10) TKC(11,12)
    TKC(6,7) TKC(8,9)
#undef TKC
}
__device__ __forceinline__ void merge16_desc(float (&v)[16]) {
#pragma unroll
    for (int js = 3; js >= 0; --js)
#pragma unroll
        for (int i = 0; i < 16; ++i) { const int j = 1 << js, l = i ^ j; if (l > i) ce(v[i], v[l]); }
}
__device__ __forceinline__ void merge_prune(float (&x)[16], const float (&y)[16]) {
#pragma unroll
    for (int i = 0; i < 16; ++i) x[i] = __builtin_fmaxf(x[i], y[15 - i]);
    merge16_desc(x);
}
__host__ __device__ constexpr bool pair_ok(int i, int j) { return (i + 1) * (j + 1) <= 16; }
__host__ __device__ constexpr int pair_index(int i, int j) { int n = 0; for (int a = 0; a < 16; ++a) for (int b = 0; b < 16; ++b) { if (a == i && b == j) return n; if (pair_ok(a, b)) ++n; } return n; }
static_assert(pair_index(15, 15) == 49 + 0 || true, "");
}
__device__ __forceinline__ void topk_stage2(const float (&top)[2][16], int* SELI, float* SELG, int g0, int h, int r32, int hh) {
    float X[16], Y[16];
    X[0] = __uint_as_float((__float_as_uint((hh ? top[0][3] : top[0][0]) + (hh ? top[1][3] : top[1][0])) & ~255u) | (hh ? 51u : 0u));
    Y[0] = __uint_as_float((__float_as_uint((hh ? top[0][14] : top[0][1]) + (hh ? top[1][0] : top[1][0])) & ~255u) | (hh ? 224u : 16u));
    X[1] = __uint_as_float((__float_as_uint((hh ? top[0][4] : top[0][0]) + (hh ? top[1][0] : top[1][1])) & ~255u) | (hh ? 64u : 1u));
    Y[1] = __uint_as_float((__float_as_uint((hh ? top[0][15] : top[0][1]) + (hh ? top[1][0] : top[1][1])) & ~255u) | (hh ? 240u : 17u));
    X[2] = __uint_as_float((__float_as_uint((hh ? top[0][4] : top[0][0]) + (hh ? top[1][1] : top[1][2])) & ~255u) | (hh ? 65u : 2u));
    Y[2] = (hh ? -INFINITY : __uint_as_float((__float_as_uint(top[0][1] + top[1][2]) & ~255u) | 18u));
    X[3] = __uint_as_float((__float_as_uint((hh ? top[0][4] : top[0][0]) + (hh ? top[1][2] : top[1][3])) & ~255u) | (hh ? 66u : 3u));
    Y[3] = (hh ? -INFINITY : __uint_as_float((__float_as_uint(top[0][1] + top[1][3]) & ~255u) | 19u));
    X[4] = __uint_as_float((__float_as_uint((hh ? top[0][5] : top[0][0]) + (hh ? top[1][0] : top[1][4])) & ~255u) | (hh ? 80u : 4u));
    Y[4] = (hh ? -INFINITY : __uint_as_float((__float_as_uint(top[0][1] + top[1][4]) & ~255u) | 20u));
    X[5] = __uint_as_float((__float_as_uint((hh ? top[0][5] : top[0][0]) + (hh ? top[1][1] : top[1][5])) & ~255u) | (hh ? 81u : 5u));
    Y[5] = (hh ? -INFINITY : __uint_as_float((__float_as_uint(top[0][1] + top[1][5]) & ~255u) | 21u));
    X[6] = __uint_as_float((__float_as_uint((hh ? top[0][6] : top[0][0]) + (hh ? top[1][0] : top[1][6])) & ~255u) | (hh ? 96u : 6u));
    Y[6] = (hh ? -INFINITY : __uint_as_float((__float_as_uint(top[0][1] + top[1][6]) & ~255u) | 22u));
    X[7] = __uint_as_float((__float_as_uint((hh ? top[0][6] : top[0][0]) + (hh ? top[1][1] : top[1][7])) & ~255u) | (hh ? 97u : 7u));
    Y[7] = (hh ? -INFINITY : __uint_as_float((__float_as_uint(top[0][1] + top[1][7]) & ~255u) | 23u));
    X[8] = __uint_as_float((__float_as_uint((hh ? top[0][7] : top[0][0]) + (hh ? top[1][0] : top[1][8])) & ~255u) | (hh ? 112u : 8u));
    Y[8] = (hh ? -INFINITY : __uint_as_float((__float_as_uint(top[0][2] + top[1][0]) & ~255u) | 32u));
    X[9] = __uint_as_float((__float_as_uint((hh ? top[0][7] : top[0][0]) + (hh ? top[1][1] : top[1][9])) & ~255u) | (hh ? 113u : 9u));
    Y[9] = (hh ? -INFINITY : __uint_as_float((__float_as_uint(top[0][2] + top[1][1]) & ~255u) | 33u));
    X[10] = __uint_as_float((__float_as_uint((hh ? top[0][8] : top[0][0]) + (hh ? top[1][0] : top[1][10])) & ~255u) | (hh ? 128u : 10u));
    Y[10] = (hh ? -INFINITY : __uint_as_float((__float_as_uint(top[0][2] + top[1][2]) & ~255u) | 34u));
    X[11] = __uint_as_float((__float_as_uint((hh ? top[0][9] : top[0][0]) + (hh ? top[1][0] : top[1][11])) & ~255u) | (hh ? 144u : 11u));
    Y[11] = (hh ? -INFINITY : __uint_as_float((__float_as_uint(top[0][2] + top[1][3]) & ~255u) | 35u));
    X[12] = __uint_as_float((__float_as_uint((hh ? top[0][10] : top[0][0]) + (hh ? top[1][0] : top[1][12])) & ~255u) | (hh ? 160u : 12u));
    Y[12] = (hh ? -INFINITY : __uint_as_float((__float_as_uint(top[0][2] + top[1][4]) & ~255u) | 36u));
    X[13] = __uint_as_float((__float_as_uint((hh ? top[0][11] : top[0][0]) + (hh ? top[1][0] : top[1][13])) & ~255u) | (hh ? 176u : 13u));
    Y[13] = (hh ? -INFINITY : __uint_as_float((__float_as_uint(top[0][3] + top[1][0]) & ~255u) | 48u));
    X[14] = __uint_as_float((__float_as_uint((hh ? top[0][12] : top[0][0]) + (hh ? top[1][0] : top[1][14])) & ~255u) | (hh ? 192u : 14u));
    Y[14] = (hh ? -INFINITY : __uint_as_float((__float_as_uint(top[0][3] + top[1][1]) & ~255u) | 49u));
    X[15] = __uint_as_float((__float_as_uint((hh ? top[0][13] : top[0][0]) + (hh ? top[1][0] : top[1][15])) & ~255u) | (hh ? 208u : 15u));
    Y[15] = (hh ? -INFINITY : __uint_as_float((__float_as_uint(top[0][3] + top[1][2]) & ~255u) | 50u));
    tk::sort16_desc(X); __builtin_amdgcn_sched_barrier(0); tk::sort16_desc(Y); __builtin_amdgcn_sched_barrier(0);
    tk::merge_prune(X, Y); __builtin_amdgcn_sched_barrier(0);
#pragma unroll
    for (int r = 0; r < 16; ++r) { const auto rr = __builtin_amdgcn_permlane32_swap(__float_as_uint(X[r]), __float_as_uint(X[r]), false, false); Y[r] = __uint_as_float(hh == 0 ? rr[1] : rr[0]); }
    tk::merge_prune(X, Y); __builtin_amdgcn_sched_barrier(0);
    const float vmax = X[0];
    int eidx[8]; float ev[8]; float sum = 0.f;
    unsigned pa[4], pb[4];
#pragma unroll
    for (int q = 0; q < 4; ++q) {
        pa[q] = (__float_as_uint(top[0][4 * q]) & 127u) | ((__float_as_uint(top[0][4 * q + 1]) & 127u) << 8) | ((__float_as_uint(top[0][4 * q + 2]) & 127u) << 16) | ((__float_as_uint(top[0][4 * q + 3]) & 127u) << 24);
        pb[q] = (__float_as_uint(top[1][4 * q]) & 127u) | ((__float_as_uint(top[1][4 * q + 1]) & 127u) << 8) | ((__float_as_uint(top[1][4 * q + 2]) & 127u) << 16) | ((__float_as_uint(top[1][4 * q + 3]) & 127u) << 24);
    }
#pragma unroll
    for (int rr = 0; rr < 8; ++rr) {
        const float v = hh ? X[8 + rr] : X[rr];
        const unsigned bits = __float_as_uint(v); const unsigned ci = (bits >> 4) & 15u, cj = bits & 15u;
        const unsigned sa_ = (ci & 7u) | 0x0c0c0c00u, sb_ = (cj & 7u) | 0x0c0c0c00u;
        const unsigned ia = (ci & 8u) ? __builtin_amdgcn_perm(pa[3], pa[2], sa_) : __builtin_amdgcn_perm(pa[1], pa[0], sa_);
        const unsigned ib = (cj & 8u) ? __builtin_amdgcn_perm(pb[3], pb[2], sb_) : __builtin_amdgcn_perm(pb[1], pb[0], sb_);
        eidx[rr] = (int)(ia * 128u + ib);
        ev[rr] = __expf(v - vmax); sum += ev[rr];
    }
    { const auto rr = __builtin_amdgcn_permlane32_swap(__float_as_uint(sum), __float_as_uint(sum), false, false); sum = __uint_as_float(rr[0]) + __uint_as_float(rr[1]); }
    const float rs = __builtin_amdgcn_rcpf(sum);
    int* oi = SELI + (size_t)(g0 + r32) * 128 + h * 16 + hh * 8; float* og = SELG + (size_t)(g0 + r32) * 128 + h * 16 + hh * 8;
#pragma unroll
    for (int rr = 0; rr < 8; ++rr) { oi[rr] = eidx[rr]; og[rr] = ev[rr] * rs; }
}
__device__ __forceinline__ void topk_item_lds(const bf16_t* QP, LAS const bf16_t* KL, int* SELI, float* SELG, int g0, int h, int r32, int hh) {
    float top[2][16];
#pragma unroll
    for (int s = 0; s < 2; ++s) {
        bf16x8 qf[8];
        unsigned qoff = (unsigned)(r32 * 2048 + 8 * hh), koff = (unsigned)(r32 * 128 + 8 * hh); asm volatile("" : "+v"(qoff), "+v"(koff));
        const bf16_t* qb = QP + (size_t)g0 * 2048 + h * 256 + s * 128;
#pragma unroll
        for (int k = 0; k < 8; ++k) qf[k] = *(const bf16x8*)(qb + qoff + k * 16);
        float grp[4][16];
#pragma unroll
        for (int kb = 0; kb < 4; ++kb) {
            LAS const bf16_t* kbp = KL + (s * 128 + kb * 32 + r32) * TK_LD + 8 * hh;
            f32x16 acc = {};
#pragma unroll
            for (int k = 0; k < 8; ++k) { const bf16x8 kf = *(LAS const bf16x8*)(kbp + k * 16); acc = __builtin_amdgcn_mfma_f32_32x32x16_bf16(kf, qf[k], acc, 0, 0, 0); }
#pragma unroll
            for (int r = 0; r < 16; ++r) { const int key = kb * 32 + (r & 3) + 8 * (r >> 2) + 4 * hh; grp[kb][r] = __uint_as_float((__float_as_uint(acc[r]) & ~127u) | (unsigned)key); }
            tk::sort16_desc(grp[kb]); __builtin_amdgcn_sched_barrier(0);
        }
        tk::merge_prune(grp[0], grp[1]); __builtin_amdgcn_sched_barrier(0); tk::merge_prune(grp[2], grp[3]); __builtin_amdgcn_sched_barrier(0); tk::merge_prune(grp[0], grp[2]); __builtin_amdgcn_sched_barrier(0);
        float oth[16];
#pragma unroll
        for (int r = 0; r < 16; ++r) { const auto rr = __builtin_amdgcn_permlane32_swap(__float_as_uint(grp[0][r]), __float_as_uint(grp[0][r]), false, false); oth[r] = __uint_as_float(hh == 0 ? rr[1] : rr[0]); }
        tk::merge_prune(grp[0], oth);
#pragma unroll
        for (int r = 0; r < 16; ++r) top[s][r] = grp[0][r];
        __builtin_amdgcn_sched_barrier(0);
    }
    topk_stage2(top, SELI, SELG, g0, h, r32, hh);
}

__device__ __forceinline__ void topk_load_keys(const Args& a, char* lds, int layer) {
    const int tid = threadIdx.x, h = blockIdx.x & 7;
    const bf16_t* KEYS = (const bf16_t*)(a.ws + WS_KEYS) + (size_t)layer * 8 * 2 * 128 * 128 + (size_t)h * 2 * 128 * 128;
    LAS bf16_t* KL = (LAS bf16_t*)((LAS char*)lds);
    for (int i = tid; i < 2 * 128 * 16; i += NTHR) { const int row = i >> 4, c8 = (i & 15) * 8; *(LAS u32x4*)(KL + row * TK_LD + c8) = *(const u32x4*)(KEYS + (size_t)row * 128 + c8); }
    __syncthreads();
}
__device__ __forceinline__ void phase_peer_topk3(const Args& a, char* lds, int layer, bool latent_only, bool keys_loaded = false) {
    const int tid = threadIdx.x, lane = tid & 63, r32 = lane & 31, hh = lane >> 5, wid = __builtin_amdgcn_readfirstlane(tid >> 6);
    const int h = blockIdx.x & 7, stripe = blockIdx.x >> 3, nstr = (gridDim.x >> 3) * NWAVE;
    const bf16_t* QP = (const bf16_t*)(a.ws + WS_QP);
    int* SELI = (int*)(a.ws + WS_SELI); float* SELG = (float*)(a.ws + WS_SELG);
    LAS bf16_t* KL = (LAS bf16_t*)((LAS char*)lds);
    if (!keys_loaded) topk_load_keys(a, lds, layer);
    const int ngrp = latent_only ? (NB * SEQ) / 32 : MTOT / 32;
    for (int i = stripe * NWAVE + wid; i < ngrp; i += nstr) {
        const int g0 = latent_only ? peer_tok(i * 32, 1) : i * 32;
        topk_item_lds(QP, KL, SELI, SELG, g0, h, r32, hh);
    }
    if (!latent_only) {
        const int G = (int)gridDim.x, nbusy = (G == 256) ? 16 : 0;
        __syncthreads();
        if ((int)blockIdx.x >= nbusy) for (int r = (int)blockIdx.x - nbusy; r < 200; r += G - nbusy) prep_l1_item(a, (float*)lds, r < 160 ? r : r + 208);
    }
}
__device__ __forceinline__ float ub0(unsigned w) { return (float)(w & 0xffu); }
__device__ __forceinline__ float ub1(unsigned w) { return (float)((w >> 8) & 0xffu); }
__device__ __forceinline__ float ub2(unsigned w) { return (float)((w >> 16) & 0xffu); }
__device__ __forceinline__ float ub3(unsigned w) { return (float)(w >> 24); }
__device__ __forceinline__ int peer_tok(int i, int mode) { return mode == 1 ? i + CTXL + (i >= SEQ ? CTXL : 0) : i; }
__device__ __forceinline__ float dot16u(const u32x4& w, const float (&hp)[16]) {
    float a0 = hp[0] * ub0(w.x) + hp[4] * ub0(w.y), a1 = hp[1] * ub1(w.x) + hp[5] * ub1(w.y), a2 = hp[2] * ub2(w.x) + hp[6] * ub2(w.y), a3 = hp[3] * ub3(w.x) + hp[7] * ub3(w.y);
    a0 += hp[8] * ub0(w.z) + hp[12] * ub0(w.w); a1 += hp[9] * ub1(w.z) + hp[13] * ub1(w.w); a2 += hp[10] * ub2(w.z) + hp[14] * ub2(w.w); a3 += hp[11] * ub3(w.z) + hp[15] * ub3(w.w);
    return (a0 + a1) + (a2 + a3);
}
#define DPP_I(v, ctrl) __builtin_amdgcn_update_dpp(0, (v), (ctrl), 0xf, 0xf, true)
__device__ __forceinline__ int sum8_i(int v) {
    v += DPP_I(v, 0xB1);
    v += DPP_I(v, 0x4E);
    v += DPP_I(v, 0x141);
    return v;
}
__device__ __forceinline__ int sum_eg_i(int v) {
    v += DPP_I(v, 0x128);
    { const auto r = __builtin_amdgcn_permlane16_swap((unsigned)v, (unsigned)v, false, false); v = (int)(r[0] + r[1]); }
    { const auto r = __builtin_amdgcn_permlane32_swap((unsigned)v, (unsigned)v, false, false); v = (int)(r[0] + r[1]); }
    return v;
}
__device__ __forceinline__ void gu_stage(u32x4 (&seg)[16], u32x4& hwa, u32x4& hwb, LAS int* lb, int i0, int i1, const unsigned char* hrow, const unsigned char* PUx, int lane, int eg, unsigned loff) {
    lb[lane] = i0; lb[64 + lane] = i1;
    hwa = *(const u32x4*)hrow; hwb = *(const u32x4*)(hrow + 16);
#pragma unroll
    for (int st = 0; st < 16; ++st) seg[st] = *(const u32x4*)(PUx + ((unsigned)lb[st * 8 + eg] * 128u + loff));
}
__device__ __forceinline__ unsigned gu_split(unsigned xa, unsigned xb, bool hi) {
    constexpr unsigned M = 0x0f0f0f0fu;
    const unsigned ya = (xa ^ 0x80808080u) + 0x08080808u, yb = (xb ^ 0x80808080u) + 0x08080808u;
    return (hi ? (((ya >> 4) & M) | (yb & ~M)) : ((ya & M) | ((yb & M) << 4))) ^ 0x88888888u;
}
__device__ __forceinline__ void gu_compute(const u32x4 (&seg)[16], const u32x4& hwa, const u32x4& hwb, LAS float* lpart, unsigned* prow, int lane, int eg, int sub, bool valid) {
    const int A0 = (int)gu_split(hwa.x, hwb.x, true), A1 = (int)gu_split(hwa.y, hwb.y, true), A2 = (int)gu_split(hwa.z, hwb.z, true), A3 = (int)gu_split(hwa.w, hwb.w, true);
    const int B0 = (int)gu_split(hwa.x, hwb.x, false), B1 = (int)gu_split(hwa.y, hwb.y, false), B2 = (int)gu_split(hwa.z, hwb.z, false), B3 = (int)gu_split(hwa.w, hwb.w, false);
    int hs = __builtin_amdgcn_sdot4((int)hwa.x, 0x01010101, 0, false);
    hs = __builtin_amdgcn_sdot4((int)hwa.y, 0x01010101, hs, false); hs = __builtin_amdgcn_sdot4((int)hwa.z, 0x01010101, hs, false); hs = __builtin_amdgcn_sdot4((int)hwa.w, 0x01010101, hs, false);
    hs = __builtin_amdgcn_sdot4((int)hwb.x, 0x01010101, hs, false); hs = __builtin_amdgcn_sdot4((int)hwb.y, 0x01010101, hs, false);
    hs = __builtin_amdgcn_sdot4((int)hwb.z, 0x01010101, hs, false); hs = __builtin_amdgcn_sdot4((int)hwb.w, 0x01010101, hs, false);
    const float bias = 0.5f * (float)sum8_i(hs);
#pragma unroll
    for (int st = 0; st < 16; ++st) {
        int da = __builtin_amdgcn_sdot8((int)seg[st].x, A0, 0, false); da = __builtin_amdgcn_sdot8((int)seg[st].y, A1, da, false);
        da = __builtin_amdgcn_sdot8((int)seg[st].z, A2, da, false); da = __builtin_amdgcn_sdot8((int)seg[st].w, A3, da, false);
        int db = __builtin_amdgcn_sdot8((int)seg[st].x, B0, 0, false); db = __builtin_amdgcn_sdot8((int)seg[st].y, B1, db, false);
        db = __builtin_amdgcn_sdot8((int)seg[st].z, B2, db, false); db = __builtin_amdgcn_sdot8((int)seg[st].w, B3, db, false);
        const int d = sum8_i(da * 16 + db);
        if (sub == 0) lpart[st * 8 + eg] = (float)d + bias;
    }
    if (valid) prow[lane] = pk2(lpart[2 * lane], lpart[2 * lane + 1]);
}
__device__ __forceinline__ void phase_gu(const Args& a, char* lds, int layer, int mode) {
    const int lane = threadIdx.x & 63, wid = __builtin_amdgcn_readfirstlane(threadIdx.x >> 6), eg = lane >> 3, sub = lane & 7;
    const int x = blockIdx.x & 7, s = x >> 1, stripe = (blockIdx.x >> 3) * 2 + (x & 1), nstr = (gridDim.x >> 3) * 2 * NWAVE, ntok = mode == 1 ? NB * SEQ : MTOT;
    unsigned char* ws = a.ws;
    const unsigned char* H8 = ws + WS_H8 + s * 256 + sub * 32;
    const unsigned char* PUx = ws + WS_PU + (size_t)layer * NEXP * 512 + (size_t)s * NEXP * 128; const unsigned loff = (unsigned)(sub * 16);
    const int* SELI = (const int*)(ws + WS_SELI); unsigned* PART = (unsigned*)(ws + WS_PART) + (size_t)s * MTOT * 64;
    LAS int* lidx = (LAS int*)((LAS char*)lds + wid * 2048);
    LAS float* lpart = (LAS float*)(lidx + 256);
    const int first = stripe * NWAVE + wid;
#define G_TOK(k) peer_tok(min(first + (k) * nstr, ntok - 1), mode)
#define G_VALID(k) (first + (k) * nstr < ntok)
    u32x4 segA[16], segB[16], haA, hbA, haB, hbB;
    int p0, p1;
    { const int g = G_TOK(0); p0 = SELI[(size_t)g * 128 + lane]; p1 = SELI[(size_t)g * 128 + 64 + lane];
      gu_stage(segA, haA, hbA, lidx, p0, p1, H8 + (size_t)g * D, PUx, lane, eg, loff); }
    { const int g = G_TOK(1); p0 = SELI[(size_t)g * 128 + lane]; p1 = SELI[(size_t)g * 128 + 64 + lane]; }
    for (int k = 0; G_VALID(k); k += 2) {
        { const int g1 = G_TOK(k + 1); gu_stage(segB, haB, hbB, lidx + 128, p0, p1, H8 + (size_t)g1 * D, PUx, lane, eg, loff); }
        { const int g2 = G_TOK(k + 2); p0 = SELI[(size_t)g2 * 128 + lane]; p1 = SELI[(size_t)g2 * 128 + 64 + lane]; }
        gu_compute(segA, haA, hbA, lpart, PART + (size_t)G_TOK(k) * 64, lane, eg, sub, true);
        { const int g2 = G_TOK(k + 2); gu_stage(segA, haA, hbA, lidx, p0, p1, H8 + (size_t)g2 * D, PUx, lane, eg, loff); }
        { const int g3 = G_TOK(k + 3); p0 = SELI[(size_t)g3 * 128 + lane]; p1 = SELI[(size_t)g3 * 128 + 64 + lane]; }
        gu_compute(segB, haB, hbB, lpart, PART + (size_t)G_TOK(k + 1) * 64, lane, eg, sub, G_VALID(k + 1));
    }
}
__device__ __forceinline__ void phase_gact(const Args& a, int layer, int mode) {
    const int lane = threadIdx.x & 63, gw = blockIdx.x * NWAVE + (threadIdx.x >> 6), ngw = gridDim.x * NWAVE, ntok = mode == 1 ? NB * SEQ : MTOT;
    unsigned char* ws = a.ws;
    const unsigned* PART = (const unsigned*)(ws + WS_PART); const int* SELI = (const int*)(ws + WS_SELI); const float* SELG = (const float*)(ws + WS_SELG);
    const float* SCU = (const float*)(ws + WS_SCU) + layer * NEXP; const float* SCV = (const float*)(ws + WS_SCV) + layer * NEXP;
    const float* SH = (const float*)(ws + WS_SH); unsigned short* ACT8 = (unsigned short*)(ws + WS_ACT16); float* SA = (float*)(ws + WS_SA);
    typedef float f32x2 __attribute__((ext_vector_type(2)));
    typedef int i32x2_ __attribute__((ext_vector_type(2)));
    constexpr int TT = 4;
    for (int i0 = gw * TT; i0 < ntok; i0 += ngw * TT) {
        unsigned pw[TT][4]; i32x2_ id[TT]; f32x2 gt[TT]; float sh[TT]; int g[TT];
#pragma unroll
        for (int t = 0; t < TT; ++t) {
            g[t] = peer_tok(min(i0 + t, ntok - 1), mode);
            const size_t o = (size_t)g[t] * 64 + lane;
#pragma unroll
            for (int xx = 0; xx < 4; ++xx) pw[t][xx] = PART[(size_t)xx * MTOT * 64 + o];
            id[t] = *(const i32x2_*)(SELI + o * 2); gt[t] = *(const f32x2*)(SELG + o * 2); sh[t] = SH[g[t]];
        }
        float su[TT][2], sv[TT][2];
#pragma unroll
        for (int t = 0; t < TT; ++t) { su[t][0] = SCU[id[t].x]; su[t][1] = SCU[id[t].y]; sv[t][0] = SCV[id[t].x]; sv[t][1] = SCV[id[t].y]; }
#pragma unroll
        for (int t = 0; t < TT; ++t) {
            float d0 = 0.f, d1 = 0.f;
#pragma unroll
            for (int xx = 0; xx < 4; ++xx) { d0 += bflo(pw[t][xx]); d1 += bfhi(pw[t][xx]); }
            const float a0 = gelu_t(d0 * sh[t] * su[t][0]) * gt[t].x * sv[t][0], a1 = gelu_t(d1 * sh[t] * su[t][1]) * gt[t].y * sv[t][1];
            float mx = fmaxf(fabsf(a0), fabsf(a1));
#pragma unroll
            for (int of = 1; of < 64; of <<= 1) mx = fmaxf(mx, __shfl_xor(mx, of));
            mx = fmaxf(mx, 1e-30f); const float inv = 127.f / mx;
            if (i0 + t < ntok) {
                ACT8[(size_t)g[t] * 64 + lane] = (unsigned short)((__float2int_rn(a0 * inv) & 0xff) | ((__float2int_rn(a1 * inv) & 0xff) << 8));
                const int q0 = __float2int_rn(a0 * inv), q1 = __float2int_rn(a1 * inv);
                int qs = q0 + q1;
#pragma unroll
                for (int of = 1; of < 64; of <<= 1) qs += __shfl_xor(qs, of);
                if (lane == 0) { SA[g[t]] = mx * (1.f / 127.f); ((int*)(ws + WS_SACT))[g[t]] = qs; }
            }
        }
    }
}
__device__ __forceinline__ void gv_stage(u32x4 (&seg)[16], LAS int* lb, int i0, int i1, const unsigned char* PVx, int lane, int eg, unsigned loff) {
    lb[lane] = i0; lb[64 + lane] = i1;
#pragma unroll
    for (int st = 0; st < 16; ++st) seg[st] = *(const u32x4*)(PVx + ((unsigned)lb[st * 8 + eg] * 128u + loff));
}
typedef int i32x2 __attribute__((ext_vector_type(2)));
__device__ __forceinline__ void gv_compute(const u32x4 (&seg)[16], LAS unsigned char* tile, const i32x4 (&aw)[2], float sa, int sact, bf16_t* xr, const float* g2, int lane, bool valid) {
    {
        const int eg = lane >> 3, sub = lane & 7;
        LAS unsigned char* w0 = tile + eg * 128 + ((sub ^ ((eg >> 1) & 3)) << 4);
        LAS unsigned char* w1 = tile + eg * 128 + ((sub ^ ((eg >> 1) & 3) ^ 4) << 4);
#pragma unroll
        for (int st = 0; st < 16; ++st) *(LAS u32x4*)(((st & 2) ? w1 : w0) + st * 1024) = seg[st];
    }
    const int kgrp = lane >> 4, q = (lane >> 1) & 7, p = lane & 1, rg = lane >> 4;
    const int swz = ((q >> 1) & 3) | ((kgrp & 1) << 2);
    LAS unsigned char* rb = tile + (kgrp * 16 + q) * 128 + 8 * p;
    int a0 = 0, a1 = 0, b0 = 0, b1 = 0;
    constexpr unsigned M = 0x0f0f0f0fu;
#pragma unroll
    for (int n4 = 0; n4 < 8; n4 += 4) {
        i32x4 aL[4], aH[4];
#pragma unroll
        for (int j = 0; j < 4; ++j) { aL[j] = i32x4{0, 0, 0, 0}; aH[j] = i32x4{0, 0, 0, 0}; }
#pragma unroll
        for (int kt = 0; kt < 2; ++kt) {
            i32x2 bl[4], bh[4];
#pragma unroll
            for (int j = 0; j < 4; ++j) {
                LAS unsigned char* pa = rb + (((n4 + j) ^ swz) << 4) + kt * 8192;
                bl[j] = __builtin_amdgcn_ds_read_tr8_b64_v2i32((LAS i32x2*)pa);
                bh[j] = __builtin_amdgcn_ds_read_tr8_b64_v2i32((LAS i32x2*)(pa + 1024));
            }
#pragma unroll
            for (int j = 0; j < 4; ++j) {
                const unsigned x0 = (unsigned)bl[j].x, x1 = (unsigned)bl[j].y, x2 = (unsigned)bh[j].x, x3 = (unsigned)bh[j].y;
                aL[j] = __builtin_amdgcn_mfma_i32_16x16x64_i8(aw[kt], i32x4{(int)(x0 & M), (int)(x1 & M), (int)(x2 & M), (int)(x3 & M)}, aL[j], 0, 0, 0);
                aH[j] = __builtin_amdgcn_mfma_i32_16x16x64_i8(aw[kt], i32x4{(int)x0, (int)x1, (int)x2, (int)x3}, aH[j], 0, 0, 0);
            }
        }
        const bool sel = (rg & 1) != 0, mine = (rg >> 1) == (n4 >> 2);
        const int ta0 = sel ? aL[2][0] : aL[0][0], ta1 = sel ? aL[3][0] : aL[1][0], tr0 = sel ? aH[2][0] : aH[0][0], tr1 = sel ? aH[3][0] : aH[1][0];
        a0 = mine ? ta0 : a0; a1 = mine ? ta1 : a1; b0 = mine ? ((tr0 - ta0) >> 4) : b0; b1 = mine ? ((tr1 - ta1) >> 4) : b1;
    }
    if (valid) {
        const float biasl = 7.5f * (float)sact, biash = 0.5f * (float)sact;
        xr[0] = (bf16_t)f2bf(bf2f(xr[0]) + g2[0] * (sa * ((float)a0 - biasl))); xr[16] = (bf16_t)f2bf(bf2f(xr[16]) + g2[16] * (sa * ((float)b0 + biash)));
        xr[32] = (bf16_t)f2bf(bf2f(xr[32]) + g2[32] * (sa * ((float)a1 - biasl))); xr[48] = (bf16_t)f2bf(bf2f(xr[48]) + g2[48] * (sa * ((float)b1 + biash)));
    }
}
__device__ __forceinline__ void phase_gv(const Args& a, char* lds, int layer, int mode) {
    const int lane = threadIdx.x & 63, wid = __builtin_amdgcn_readfirstlane(threadIdx.x >> 6), eg = lane >> 3, sub = lane & 7;
    const int x = blockIdx.x & 7, s = x >> 1, stripe = (blockIdx.x >> 3) * 2 + (x & 1), nstr = (gridDim.x >> 3) * 2 * NWAVE, ntok = mode == 1 ? NB * SEQ : MTOT;
    unsigned char* ws = a.ws;
    const int ocol = s * 256 + (lane >> 4) * 64 + (lane & 15);
    bf16_t* X1 = (bf16_t*)(ws + WS_X1) + ocol;
    const unsigned char* PVx = ws + WS_PV + (size_t)layer * NEXP * 512 + (size_t)s * NEXP * 128; const unsigned loff = (unsigned)(sub * 16);
    const int* SELI = (const int*)(ws + WS_SELI); const unsigned char* ACT8 = ws + WS_ACT16 + (lane >> 4) * 16; const float* SA = (const float*)(ws + WS_SA); const int* SACT = (const int*)(ws + WS_SACT);
    LAS int* lidx = (LAS int*)((LAS char*)lds + 131072 + wid * 1024);
    LAS unsigned char* tile = (LAS unsigned char*)((LAS char*)lds + wid * 16384);
    const int first = stripe * NWAVE + wid;
#define G_TOK(k) peer_tok(min(first + (k) * nstr, ntok - 1), mode)
#define G_VALID(k) (first + (k) * nstr < ntok)
    u32x4 segA[16], segB[16];
    i32x4 awA[2], awB[2]; float saA, saB; int scA, scB;
    int p0, p1;
#define GV_PREF(k) { const int g_ = G_TOK(k); p0 = SELI[(size_t)g_ * 128 + lane]; p1 = SELI[(size_t)g_ * 128 + 64 + lane]; }
#define GV_AW(AW, SAV, SCV_, k) { const int g_ = G_TOK(k); AW[0] = *(const i32x4*)(ACT8 + (size_t)g_ * 128); AW[1] = *(const i32x4*)(ACT8 + (size_t)g_ * 128 + 64); SAV = SA[g_]; SCV_ = SACT[g_]; }
#define GV_G2(k) (modv(a, layer, row_variant(G_TOK(k)), 5) + ocol)
    GV_PREF(0) gv_stage(segA, lidx, p0, p1, PVx, lane, eg, loff); GV_AW(awA, saA, scA, 0)
    GV_PREF(1)
    for (int k = 0; G_VALID(k); k += 2) {
        gv_stage(segB, lidx + 128, p0, p1, PVx, lane, eg, loff); GV_AW(awB, saB, scB, k + 1)
        GV_PREF(k + 2)
        gv_compute(segA, tile, awA, saA, scA, X1 + (size_t)G_TOK(k) * D, GV_G2(k), lane, true);
        gv_stage(segA, lidx, p0, p1, PVx, lane, eg, loff); GV_AW(awA, saA, scA, k + 2)
        GV_PREF(k + 3)
        gv_compute(segB, tile, awB, saB, scB, X1 + (size_t)G_TOK(k + 1) * D, GV_G2(k + 1), lane, G_VALID(k + 1));
    }
#undef GV_PREF
#undef GV_AW
#undef GV_G2
#undef G_TOK
#undef G_VALID
}
__device__ __forceinline__ void phase_finalnorm(const Args& a) {
    const int lane = threadIdx.x & 63, gw = blockIdx.x * NWAVE + (threadIdx.x >> 6), ngw = gridDim.x * NWAVE;
    const bf16_t* X1 = (const bf16_t*)(a.ws + WS_X1);
    for (int i = gw; i < NB * SEQ; i += ngw) {
        const int g = peer_tok(i, 1);
        const bf16_t* xr = X1 + (size_t)g * D; float* op = a.out + (size_t)i * D;
        f32x4 v[4]; float ss = 0.f;
#pragma unroll
        for (int j = 0; j < 4; ++j) { const u32x2 w = *(const u32x2*)(xr + j * 256 + lane * 4); v[j] = f32x4{bflo(w.x), bfhi(w.x), bflo(w.y), bfhi(w.y)}; ss += (v[j].x * v[j].x + v[j].y * v[j].y) + (v[j].z * v[j].z + v[j].w * v[j].w); }
        const float rinv = rsqrtf(wave_sum(ss) * (1.f / D) + EPS);
#pragma unroll
        for (int j = 0; j < 4; ++j) { const f32x4 gn = *(const f32x4*)(a.in[28] + j * 256 + lane * 4); *(f32x4*)(op + j * 256 + lane * 4) = v[j] * rinv * gn; }
    }
}

constexpr int XC_LD = 136;
__device__ __forceinline__ float exp2_fast(float x) { return __builtin_amdgcn_exp2f(x); }
__device__ __forceinline__ float sigm_fast(float x) { return __builtin_amdgcn_rcpf(1.f + __builtin_amdgcn_exp2f(-1.4426950408889634f * x)); }
__device__ __forceinline__ int rg_tau(int rho) { return 16 * ((rho >> 2) & 1) + (rho & 3) + 4 * (rho >> 3); }
__device__ __forceinline__ void phase_rglru2(const Args& a, char* lds, int pass) {
    const int tid_ = threadIdx.x, wid = __builtin_amdgcn_readfirstlane(tid_ >> 6);
    const int nb = wid & 3, dir = wid >> 2;
    unsigned char* ws = a.ws;
    LAS bf16_t* xcA = (LAS bf16_t*)((LAS char*)lds);
    const bf16_t* XR = (const bf16_t*)(ws + WS_XR);
    float* CARRY = (float*)(ws + WS_CARRY);
    typedef float f32x2 __attribute__((ext_vector_type(2)));
    const int NU = (MTOT / 128) * 10;
    for (int u = blockIdx.x; u < NU; u += gridDim.x) {
        const int T = u / 10, hb = u % 10, b = T / 66, tl = T % 66, row0 = T * 128;
        int tid = tid_; asm volatile("" : "+v"(tid));
        const int lane = tid & 63, r32 = lane & 31, hh = lane >> 5;
        const int seq_lo = tl < 2 ? b * RPB : b * RPB + CTXL, seq_hi = tl < 2 ? b * RPB + CTXL : (b + 1) * RPB;
        const int ch = hb * 128 + nb * 32 + r32;
        u32x4* stu = (u32x4*)(ws + WS_STU) + (size_t)(u * 8 + wid) * 4 * 64;
        u32x4* str = (u32x4*)(ws + WS_STR) + (size_t)(u * 8 + wid) * 4 * 64;
        f32x16 accA[4], accX[4];
        {
            const int j2 = tid & 63, ts = tid >> 6, c0 = hb * 128 + 2 * j2;
            unsigned xw[19];
#pragma unroll
            for (int i = 0; i < 19; ++i) { const int g = row0 + ts * 16 - 2 + i; const int gc = min(max(g, seq_lo), seq_hi - 1); xw[i] = *(const unsigned*)(XR + (size_t)gc * DRNN + c0); }
            const f32x2 cw0 = *(const f32x2*)(a.in[16] + 0 * DRNN + c0), cw1 = *(const f32x2*)(a.in[16] + 1 * DRNN + c0), cw2 = *(const f32x2*)(a.in[16] + 2 * DRNN + c0), cw3 = *(const f32x2*)(a.in[16] + 3 * DRNN + c0);
            const f32x2 cbv = *(const f32x2*)(a.in[17] + c0);
            bf16x8 bfa[8], bfx[8];
            {
                unsigned woff = (unsigned)((nb * 32 + r32) * 128 + 8 * hh); asm volatile("" : "+v"(woff));
                const bf16_t* wa = (const bf16_t*)(ws + WS_WAT) + (size_t)(dir * 10 + hb) * 128 * 128;
                const bf16_t* wx = (const bf16_t*)(ws + WS_WXT) + (size_t)(dir * 10 + hb) * 128 * 128;
#pragma unroll
                for (int k = 0; k < 8; ++k) { bfa[k] = *(const bf16x8*)(wa + woff + k * 16); bfx[k] = *(const bf16x8*)(wx + woff + k * 16); }
            }
            const float ba = a.in[19][dir * DRNN + ch], bx = a.in[21][dir * DRNN + ch], lam = a.in[22][dir * DRNN + ch];
            __builtin_amdgcn_sched_barrier(0);
            {
#pragma unroll
                for (int i = 0; i < 19; ++i) { const int g = row0 + ts * 16 - 2 + i; if (g < seq_lo || g >= seq_hi) xw[i] = 0u; }
                const int csw = (2 * j2) ^ ((ts & 1) << 6);
#pragma unroll
                for (int i = 0; i < 16; ++i) {
                    const float y0 = cw0.x * bflo(xw[i]) + cw1.x * bflo(xw[i + 1]) + cw2.x * bflo(xw[i + 2]) + cw3.x * bflo(xw[i + 3]) + cbv.x;
                    const float y1 = cw0.y * bfhi(xw[i]) + cw1.y * bfhi(xw[i + 1]) + cw2.y * bfhi(xw[i + 2]) + cw3.y * bfhi(xw[i + 3]) + cbv.y;
                    *(LAS unsigned*)(xcA + (ts * 16 + i) * XC_LD + csw) = pk2(y0, y1);
                }
            }
            __syncthreads();
            {
                const float nba = -1.4426950408889634f * ba, nbx = -1.4426950408889634f * bx;
                f32x16 cA, cX;
#pragma unroll
                for (int r = 0; r < 16; ++r) { cA[r] = nba; cX[r] = nbx; }
                const int arow = rg_tau(r32) * XC_LD, fl64 = ((r32 >> 2) & 1) << 6;
#pragma unroll
                for (int mb = 0; mb < 4; ++mb) {
#pragma unroll
                    for (int k = 0; k < 8; ++k) {
                        const bf16x8 af = *(const LAS bf16x8*)(xcA + mb * 32 * XC_LD + arow + (((k * 16) ^ fl64) + 8 * hh));
                        accA[mb] = __builtin_amdgcn_mfma_f32_32x32x16_bf16(af, bfa[k], k == 0 ? cA : accA[mb], 0, 0, 0);
                        accX[mb] = __builtin_amdgcn_mfma_f32_32x32x16_bf16(af, bfx[k], k == 0 ? cX : accX[mb], 0, 0, 0);
                    }
                }
            }
            __builtin_amdgcn_sched_barrier(0);
            {
                const float sp8l = -8.f * 1.4426950408889634f * log1pf(__expf(-lam));
                if (T == 2 && hh == 0) ((float*)(ws + WS_SPL))[dir * DRNN + ch] = sp8l;
                const int xcol = (nb * 32 + r32) ^ (hh << 6);
#pragma unroll
                for (int mb = 0; mb < 4; ++mb) {
                    u32x4 rq = {0u, 0u, 0u, 0u};
#pragma unroll
                    for (int r = 0; r < 16; ++r) {
                        const int t = mb * 32 + 16 * hh + r;
                        const float xv = bf2f(xcA[t * XC_LD + xcol]);
                        const float rg = __builtin_amdgcn_rcpf(1.f + __builtin_amdgcn_exp2f(accA[mb][r]));
                        const float ig = __builtin_amdgcn_rcpf(1.f + __builtin_amdgcn_exp2f(accX[mb][r]));
                        const float av = __builtin_amdgcn_exp2f(rg * sp8l);
                        const float om = fmaxf(__builtin_fmaf(-av, av, 1.f), 0.f);
                        accA[mb][r] = av; accX[mb][r] = __builtin_amdgcn_sqrtf(om) * ig * xv;
                        rq[r >> 2] = __builtin_amdgcn_cvt_pk_u8_f32(rg * 255.f, r & 3, rq[r >> 2]);
                        if ((r & 3) == 3) __builtin_amdgcn_sched_barrier(0);
                    }
                    if (tl >= 2) str[mb * 64 + lane] = rq;
                }
            }
            __builtin_amdgcn_sched_barrier(0);
        }
        float h = 0.f, Atot = 1.f;
#define RG_SEG(mb) float sA, sH; \
            if (dir == 0) { sH = accX[mb][0]; _Pragma("unroll") for (int r = 1; r < 16; ++r) sH = sH * accA[mb][r] + accX[mb][r]; } \
            else { sH = accX[mb][15]; _Pragma("unroll") for (int r = 14; r >= 0; --r) sH = sH * accA[mb][r] + accX[mb][r]; } \
            { const float p0 = accA[mb][0] * accA[mb][1], p1 = accA[mb][2] * accA[mb][3], p2 = accA[mb][4] * accA[mb][5], p3 = accA[mb][6] * accA[mb][7]; \
              const float p4 = accA[mb][8] * accA[mb][9], p5 = accA[mb][10] * accA[mb][11], p6 = accA[mb][12] * accA[mb][13], p7 = accA[mb][14] * accA[mb][15]; \
              sA = ((p0 * p1) * (p2 * p3)) * ((p4 * p5) * (p6 * p7)); } \
            const auto ra = __builtin_amdgcn_permlane32_swap(__float_as_uint(sA), __float_as_uint(sA), false, false); \
            const auto rh = __builtin_amdgcn_permlane32_swap(__float_as_uint(sH), __float_as_uint(sH), false, false); \
            const float EA = __uint_as_float(ra[0]), EH = __uint_as_float(rh[0]), OA = __uint_as_float(ra[1]), OH = __uint_as_float(rh[1]);
        if (dir == 0) {
#pragma unroll
            for (int mb = 0; mb < 4; ++mb) { RG_SEG(mb) h = EA * h + EH; h = OA * h + OH; Atot *= EA * OA; }
        } else {
#pragma unroll
            for (int mb = 3; mb >= 0; --mb) { RG_SEG(mb) h = OA * h + OH; h = EA * h + EH; Atot *= EA * OA; }
        }
#undef RG_SEG
        if (hh == 0) { const int pp = dir == 0 ? tl : (tl < 2 ? 1 - tl : 67 - tl);
            float* c = CARRY + (((size_t)(b * 2 + dir) * DRNN + ch) * 66 + pp) * 2; c[0] = Atot; c[1] = h; }
        if (tl >= 2) {
            float mxu = 0.f;
#pragma unroll
            for (int mb = 0; mb < 4; ++mb)
#pragma unroll
                for (int r = 0; r < 16; r += 2) mxu = fmaxf(fmaxf(fabsf(accX[mb][r]), fabsf(accX[mb][r + 1])), mxu);
            mxu = fmaxf(mxu, 1e-30f); const float uinv = 127.f / mxu;
#pragma unroll
            for (int mb = 0; mb < 4; ++mb) { u32x4 o = {0u, 0u, 0u, 0u};
#pragma unroll
                for (int r = 0; r < 16; ++r) o[r >> 2] = __builtin_amdgcn_cvt_pk_u8_f32(__builtin_rintf(accX[mb][r] * uinv) + 128.f, r & 3, o[r >> 2]);
                stu[mb * 64 + lane] = o; }
            ((float*)(ws + WS_STS))[(size_t)(u * 8 + wid) * 64 + lane] = mxu * (1.f / 127.f);
        }
        __syncthreads();
    }
    {
        const int G = (int)gridDim.x, nlast = NU - (NU / G) * G;
        if ((int)blockIdx.x >= nlast) quant_tables(a, 1, ((int)blockIdx.x - nlast) * NWAVE + wid, (G - nlast) * NWAVE, tid_ & 63, NEXP, 2 * NEXP);
    }
}

__device__ __forceinline__ void rg_out_load(u32x4 (&Lsr)[4], u32x4 (&Lsu)[4], float& Lusc, float& Llam, const Args& a, int u, int wid, int tid) {
    typedef float f32x2 __attribute__((ext_vector_type(2)));
    unsigned char* ws = a.ws;
    const int nb = wid & 3, dir = wid >> 2, lane = tid & 63, r32 = lane & 31, hh = lane >> 5;
    const int T = u / 10, hb = u % 10, b = T / 66, row0 = T * 128, ch = hb * 128 + nb * 32 + r32;
    const u32x4* stu = (const u32x4*)(ws + WS_STU) + (size_t)(u * 8 + wid) * 4 * 64;
    const u32x4* str = (const u32x4*)(ws + WS_STR) + (size_t)(u * 8 + wid) * 4 * 64;
#pragma unroll
    for (int c = 0; c < 4; ++c) Lsr[c] = str[c * 64 + lane];
#pragma unroll
    for (int c = 0; c < 4; ++c) Lsu[c] = stu[c * 64 + lane];
    Lusc = ((const float*)(ws + WS_STS))[(size_t)(u * 8 + wid) * 64 + lane];
    Llam = ((const float*)(ws + WS_SPL))[dir * DRNN + ch];
}
__device__ __forceinline__ void phase_rglru_out(const Args& a, char* lds) {
    const int tid_ = threadIdx.x, wid = __builtin_amdgcn_readfirstlane(tid_ >> 6);
    const int nb = wid & 3, dir = wid >> 2, G = (int)gridDim.x;
    LAS float* HS = (LAS float*)((LAS char*)lds + 36864);
    bf16_t* YG = (bf16_t*)(a.ws + WS_YG);
    const int NU = (MTOT / 128) * 10;
#define RG_SKIP(u_) ((((u_) / 10) % 66) < 2)
    int u = blockIdx.x;
    while (u < NU && RG_SKIP(u)) u += G;
    if (u >= NU) return;
    u32x4 Lsr[4], Lsu[4]; float Lusc, Llam;
    rg_out_load(Lsr, Lsu, Lusc, Llam, a, u, wid, tid_);
    for (;;) {
        int un = u + G;
        while (un < NU && RG_SKIP(un)) un += G;
        int tid = tid_; asm volatile("" : "+v"(tid));
        const int lane = tid & 63, r32 = lane & 31, hh = lane >> 5;
        const int T = u / 10, hb = u % 10, tl = T % 66, row0 = T * 128;
        f32x16 accA[4]; float h0; u32x4 ggw[4], csu[4];
#pragma unroll
        for (int c = 0; c < 4; ++c) csu[c] = Lsu[c];
        const float usc = Lusc, uof = -128.f * Lusc;
#define RG_UB(w, k) __builtin_fmaf((float)(((w) >> (8 * (k))) & 0xffu), usc, uof)
#define RG_UX(mb, r) RG_UB(csu[mb][(r) >> 2], (r) & 3)
        typedef float f32x2 __attribute__((ext_vector_type(2)));
        f32x2 cv[33];
        const float c255 = Llam * (1.f / 255.f);
#define RG_DECODE(mb) _Pragma("unroll") for (int r = 0; r < 16; ++r) { \
            const unsigned w = Lsr[mb][r >> 2]; \
            accA[mb][r] = __builtin_amdgcn_exp2f((float)((w >> (8 * (r & 3))) & 0xffu) * c255); }
        RG_DECODE(0) RG_DECODE(1)
        __builtin_amdgcn_sched_barrier(0);
        {
            const int b = T / 66, ch = hb * 128 + nb * 32 + r32;
            const float* cbase = (const float*)(a.ws + WS_CARRY) + (((size_t)(b * 2 + dir) * DRNN + ch) * 66 + hh * 33) * 2;
#pragma unroll
            for (int i = 0; i < 33; ++i) cv[i] = *(const f32x2*)(cbase + i * 2);

        }
        __builtin_amdgcn_sched_barrier(0);
        RG_DECODE(2) RG_DECODE(3)
#undef RG_DECODE
        __builtin_amdgcn_sched_barrier(0);
        {
            const int pos = dir == 0 ? tl : 67 - tl;
            float cA = 1.f, cH = 0.f;
#pragma unroll
            for (int i = 0; i < 33; ++i) { const bool ok = hh * 33 + i < pos; const float ta = ok ? cv[i].x : 1.f, th = ok ? cv[i].y : 0.f; cH = ta * cH + th; cA = ta * cA; }
            const auto ra = __builtin_amdgcn_permlane32_swap(__float_as_uint(cA), __float_as_uint(cA), false, false);
            const auto rh = __builtin_amdgcn_permlane32_swap(__float_as_uint(cH), __float_as_uint(cH), false, false);
            h0 = __uint_as_float(ra[1]) * __uint_as_float(rh[0]) + __uint_as_float(rh[1]);
        }
        __builtin_amdgcn_sched_barrier(0);
        float h = h0; float cin[4];
#define RG_SEG(mb) float sA, sH; \
            if (dir == 0) { sH = RG_UX(mb, 0); _Pragma("unroll") for (int r = 1; r < 16; ++r) sH = sH * accA[mb][r] + RG_UX(mb, r); } \
            else { sH = RG_UX(mb, 15); _Pragma("unroll") for (int r = 14; r >= 0; --r) sH = sH * accA[mb][r] + RG_UX(mb, r); } \
            { const float p0 = accA[mb][0] * accA[mb][1], p1 = accA[mb][2] * accA[mb][3], p2 = accA[mb][4] * accA[mb][5], p3 = accA[mb][6] * accA[mb][7]; \
              const float p4 = accA[mb][8] * accA[mb][9], p5 = accA[mb][10] * accA[mb][11], p6 = accA[mb][12] * accA[mb][13], p7 = accA[mb][14] * accA[mb][15]; \
              sA = ((p0 * p1) * (p2 * p3)) * ((p4 * p5) * (p6 * p7)); } \
            const auto ra = __builtin_amdgcn_permlane32_swap(__float_as_uint(sA), __float_as_uint(sA), false, false); \
            const auto rh = __builtin_amdgcn_permlane32_swap(__float_as_uint(sH), __float_as_uint(sH), false, false); \
            const float EA = __uint_as_float(ra[0]), EH = __uint_as_float(rh[0]), OA = __uint_as_float(ra[1]), OH = __uint_as_float(rh[1]);
#define RG_WORDS(mb, j) unsigned w0 = csu[mb][j]; asm volatile("" : "+v"(w0)); \
            const float uu[4] = {RG_UB(w0, 0), RG_UB(w0, 1), RG_UB(w0, 2), RG_UB(w0, 3)};
        if (dir == 0) {
#pragma unroll
            for (int mb = 0; mb < 4; ++mb) { RG_SEG(mb) const float hE = h; h = EA * h + EH; const float hO = h; h = OA * h + OH; cin[mb] = hh ? hO : hE; }
#pragma unroll
            for (int mb = 0; mb < 4; ++mb) { float hc = cin[mb];
#pragma unroll
                for (int j = 0; j < 4; ++j) { RG_WORDS(mb, j)
#pragma unroll
                    for (int e = 0; e < 4; ++e) { hc = accA[mb][4 * j + e] * hc + uu[e]; accA[mb][4 * j + e] = hc; } } }
        } else {
#pragma unroll
            for (int mb = 3; mb >= 0; --mb) { RG_SEG(mb) const float hO = h; h = OA * h + OH; const float hE = h; h = EA * h + EH; cin[mb] = hh ? hO : hE; }
#pragma unroll
            for (int mb = 0; mb < 4; ++mb) { float hc = cin[mb];
#pragma unroll
                for (int j = 3; j >= 0; --j) { RG_WORDS(mb, j)
#pragma unroll
                    for (int e = 3; e >= 0; --e) { hc = accA[mb][4 * j + e] * hc + uu[e]; accA[mb][4 * j + e] = hc; } } }
        }
#undef RG_SEG
#undef RG_WORDS
#undef RG_UX
#undef RG_UB
        __builtin_amdgcn_sched_barrier(0);
        {
            const int t = tid >> 2, cs = (tid & 3) * 32;
            const bf16_t* gp = (const bf16_t*)(a.ws + WS_GG) + (size_t)(row0 + t) * DRNN + hb * 128 + cs;
#pragma unroll
            for (int c8 = 0; c8 < 4; ++c8) ggw[c8] = *(const u32x4*)(gp + c8 * 8);
        }
        if (un < NU) rg_out_load(Lsr, Lsu, Lusc, Llam, a, un, wid, tid);
        __builtin_amdgcn_sched_barrier(0);
        if (dir == 0) {
#pragma unroll
            for (int mb = 0; mb < 4; ++mb)
#pragma unroll
                for (int r = 0; r < 16; ++r) { const int t = mb * 32 + 16 * hh + r; HS[t * 128 + nb * 32 + r32] = accA[mb][r]; }
        }
        __syncthreads();
        if (dir == 1) {
#pragma unroll
            for (int mb = 0; mb < 4; ++mb)
#pragma unroll
                for (int r = 0; r < 16; ++r) { const int t = mb * 32 + 16 * hh + r; HS[t * 128 + nb * 32 + r32] += accA[mb][r]; }
        }
        __syncthreads();
        {
            const int t = tid >> 2, cs = (tid & 3) * 32, g = row0 + t;
            bf16_t* yp = YG + (size_t)g * DRNN + hb * 128 + cs;
#pragma unroll
            for (int c8 = 0; c8 < 32; c8 += 8) {
                const u32x4 gw = ggw[c8 >> 3];
                const f32x4 h0v = *(const LAS f32x4*)(HS + t * 128 + cs + c8), h1v = *(const LAS f32x4*)(HS + t * 128 + cs + c8 + 4);
                u32x4 o; o.x = pk2(h0v.x * bflo(gw.x), h0v.y * bfhi(gw.x)); o.y = pk2(h0v.z * bflo(gw.y), h0v.w * bfhi(gw.y));
                o.z = pk2(h1v.x * bflo(gw.z), h1v.y * bfhi(gw.z)); o.w = pk2(h1v.z * bflo(gw.w), h1v.w * bfhi(gw.w));
                *(u32x4*)(yp + c8) = o;
            }
        }
        __syncthreads();
        if (un >= NU) break;
        u = un;
    }
#undef RG_SKIP
}

namespace pg8 {
constexpr int BM = 256, BK = 64, HALF = 128, HTB = HALF * BK * 2, STAGE_BYTES = 8 * HTB, NXCD = 8, WGM = 8;
__host__ __device__ __forceinline__ int lds_byte(int r, int c) { const int st = (r >> 4) * 2 + (c >> 5), rr = r & 15, cc = c & 31, ob = rr * 64 + cc * 2; return st * 1024 + (ob ^ (((ob >> 9) & 1) << 5)); }
__host__ __device__ __forceinline__ void stage_rc(int b, int& R, int& C) { const int st = b / 1024, sb = b % 1024, swz = sb ^ (((sb >> 9) & 1) << 5); R = (st >> 1) * 16 + swz / 64; C = (st & 1) * 32 + (swz % 64) / 2; }
__host__ __device__ __forceinline__ int perm32(int rho) { const int n = rho >> 4, i = rho & 15; return 8 * (i >> 2) + 4 * n + (i & 3); }
struct Unit { int pm, pn; };
struct Gemm { const bf16_t* A; const bf16_t* Bt; int M, N, K; const float* sa; const float* sw; };
struct StaticOrder {
    int nM, nN, nwg, G, c;
    __host__ __device__ void init(int M, int N, int G_, int c_) { nM = M / BM; nN = N / BM; nwg = nM * nN; G = G_; c = c_; }
    __host__ __device__ bool next(int i, Unit& u) const {
        const long L = (long)i * G + c; if (L >= nwg) return false;
        int wgid = (int)L; { const int q = nwg / NXCD, r = nwg % NXCD, xcd = wgid % NXCD, off = wgid / NXCD; wgid = (xcd < r ? xcd * (q + 1) : r * (q + 1) + (xcd - r) * q) + off; }
        const int nig = WGM * nN, gid = wgid / nig, fm = gid * WGM, gsz = (nM - fm) < WGM ? (nM - fm) : WGM;
        u.pm = fm + ((wgid % nig) % gsz); u.pn = (wgid % nig) / gsz; return true;
    }
    __device__ __forceinline__ void a_ready(const Unit&) const {}
    __device__ __forceinline__ void done(const Unit&) const {}
};
struct LatentOrder {
    StaticOrder S;
    __host__ __device__ void init(int N, int G_, int c_) { S.init(16384, N, G_, c_); }
    __host__ __device__ bool next(int i, Unit& u) const { if (!S.next(i, u)) return false; u.pm = u.pm + 1 + (u.pm >= 32 ? 1 : 0); return true; }
    __device__ __forceinline__ void a_ready(const Unit&) const {}
    __device__ __forceinline__ void done(const Unit&) const {}
};
__device__ __forceinline__ unsigned cvt_pk_bf16(float lo, float hi) { unsigned r; asm volatile("v_cvt_pk_bf16_f32 %0, %1, %2" : "=v"(r) : "v"(lo), "v"(hi)); return r; }
__device__ __forceinline__ u32x4 pack8(const f32x4& v0, const f32x4& v1) { u32x4 w; w.x = cvt_pk_bf16(v0[0], v0[1]); w.y = cvt_pk_bf16(v0[2], v0[3]); w.z = cvt_pk_bf16(v1[0], v1[1]); w.w = cvt_pk_bf16(v1[2], v1[3]); return w; }
__device__ __forceinline__ f32x4 gelu4(const f32x4& v) { f32x4 r; r.x = gelu_t(v.x); r.y = gelu_t(v.y); r.z = gelu_t(v.z); r.w = gelu_t(v.w); return r; }

struct EpiStore {
    static constexpr bool PERM = true, AFTER_DRAIN = false;
    bf16_t* O1; bf16_t* O2; int ld; int split_tile; int gelu_tiles;
    __device__ __forceinline__ void operator()(f32x4 (&acc)[2][2][4][2], const Unit& u, int wr, int wc, int fr, int fq) const {
        const bool second = u.pn >= split_tile; bf16_t* base = second ? O2 : O1; const int pnl = second ? u.pn - split_tile : u.pn; const bool dog = u.pn < gelu_tiles;
        const int rl0 = wr * 64 + fr, cl0 = wc * 32 + 8 * fq;
#pragma unroll
        for (int ai = 0; ai < 2; ++ai)
#pragma unroll
            for (int m = 0; m < 4; ++m) { bf16_t* rowp = base + (size_t)(u.pm * BM + ai * HALF + m * 16 + rl0) * ld + pnl * BM + cl0;
#pragma unroll
                for (int bj = 0; bj < 2; ++bj) { f32x4 v0 = acc[ai][bj][m][0], v1 = acc[ai][bj][m][1]; if (dog) { v0 = gelu4(v0); v1 = gelu4(v1); }
                    *(u32x4*)(rowp + bj * HALF) = pack8(v0, v1); } }
    }
};
struct EpiResid {
    static constexpr bool PERM = true, AFTER_DRAIN = false;
    const float* x; const float* ctx; const float* modbase; bf16_t* X1; int base_mode;
    __device__ __forceinline__ void operator()(f32x4 (&acc)[2][2][4][2], const Unit& u, int wr, int wc, int fr, int fq) const {
        const int b = u.pm / 33, tl = u.pm % 33, var = tl == 0 ? 2 : b;
        const float* gate = modbase + (size_t)var * 6144 + u.pn * BM;
        const float* basep = tl == 0 ? ctx + (size_t)b * CTXL * D : x + ((size_t)b * SEQ + (size_t)(tl - 1) * 256) * D;
        bf16_t* outp = X1 + (size_t)u.pm * BM * D;
        const int rl0 = wr * 64 + fr, cl0 = u.pn * BM + wc * 32 + 8 * fq;
        f32x4 gv[2][2];
#pragma unroll
        for (int bj = 0; bj < 2; ++bj)
#pragma unroll
            for (int n = 0; n < 2; ++n) gv[bj][n] = *(const f32x4*)(gate + bj * HALF + wc * 32 + 8 * fq + 4 * n);
#pragma unroll
        for (int ai = 0; ai < 2; ++ai)
#pragma unroll
            for (int m = 0; m < 4; ++m) { const size_t off = (size_t)(ai * HALF + m * 16 + rl0) * D + cl0;
#pragma unroll
                for (int bj = 0; bj < 2; ++bj)
                { f32x4 b0, b1;
                    if (base_mode == 0) { b0 = *(const f32x4*)(basep + off + bj * HALF); b1 = *(const f32x4*)(basep + off + bj * HALF + 4); }
                    else { const u32x4 w = *(const u32x4*)(outp + off + bj * HALF); b0 = f32x4{bflo(w.x), bfhi(w.x), bflo(w.y), bfhi(w.y)}; b1 = f32x4{bflo(w.z), bfhi(w.z), bflo(w.w), bfhi(w.w)}; }
                    const f32x4 o0 = b0 + gv[bj][0] * acc[ai][bj][m][0], o1 = b1 + gv[bj][1] * acc[ai][bj][m][1];
                    u32x4 o; o.x = pk2(o0.x, o0.y); o.y = pk2(o0.z, o0.w); o.z = pk2(o1.x, o1.y); o.w = pk2(o1.z, o1.w);
                    *(u32x4*)(outp + off + bj * HALF) = o; } }
    }
};
struct EpiInproj0 {
    static constexpr bool PERM = true, AFTER_DRAIN = false;
    unsigned char* ws; const float* gmg; const float* qg; const float* kg; LAS float* P;
    __device__ __forceinline__ void operator()(f32x4 (&acc)[2][2][4][2], const Unit& u, int wr, int wc, int fr, int fq) const {
        int rl0 = wr * 64 + fr, cl0 = wc * 32 + 8 * fq; asm volatile("" : "+v"(rl0), "+v"(cl0));
        const int pn = u.pn; const size_t grow0 = (size_t)u.pm * BM;
        if (pn < 4) {
#pragma unroll
            for (int ai = 0; ai < 2; ++ai)
#pragma unroll
                for (int bj = 0; bj < 2; ++bj)
#pragma unroll
                    for (int m = 0; m < 4; ++m) { acc[ai][bj][m][0] = gelu4(acc[ai][bj][m][0]); acc[ai][bj][m][1] = gelu4(acc[ai][bj][m][1]); __builtin_amdgcn_sched_barrier(0); }
        }
        if (pn < 2 || pn == 7) {
            const size_t kvrow0 = (size_t)((u.pm / 33) * 2) * RPB + (size_t)(u.pm % 33) * BM;
            bf16_t* base = pn < 2 ? (bf16_t*)(ws + WS_U) + pn * BM + grow0 * 512 : (bf16_t*)(ws + WS_V) + kvrow0 * 128; const int ld = pn < 2 ? 512 : 128;
            const size_t bjs = pn < 2 ? (size_t)HALF : (size_t)RPB * 128;
#pragma unroll
            for (int ai = 0; ai < 2; ++ai)
#pragma unroll
                for (int m = 0; m < 4; ++m) { bf16_t* rowp = base + (size_t)(ai * HALF + m * 16 + rl0) * ld + cl0;
#pragma unroll
                    for (int bj = 0; bj < 2; ++bj) *(u32x4*)(rowp + bj * bjs) = pack8(acc[ai][bj][m][0], acc[ai][bj][m][1]); }
            return;
        }
#pragma unroll
        for (int ai = 0; ai < 2; ++ai)
#pragma unroll
            for (int m = 0; m < 4; ++m)
#pragma unroll
                for (int bj = 0; bj < 2; ++bj) { const f32x4 a0 = acc[ai][bj][m][0], a1 = acc[ai][bj][m][1];
                    float s = (a0.x * a0.x + a0.y * a0.y) + (a0.z * a0.z + a0.w * a0.w) + (a1.x * a1.x + a1.y * a1.y) + (a1.z * a1.z + a1.w * a1.w);
                    s += __shfl_xor(s, 16); s += __shfl_xor(s, 32);
                    if (fq == 0) P[((ai * HALF + m * 16 + rl0) * 2 + bj) * 4 + wc] = s; __builtin_amdgcn_sched_barrier(0); }
        asm volatile("s_waitcnt lgkmcnt(0)" ::: "memory"); __builtin_amdgcn_s_barrier(); asm volatile("" ::: "memory");
        if (pn < 4) {
            bf16_t* base = (bf16_t*)(ws + WS_VV) + (pn - 2) * BM; const float* gp = gmg + (pn - 2) * BM + cl0;
            f32x4 g8[2][2];
#pragma unroll
            for (int bj = 0; bj < 2; ++bj) { g8[bj][0] = *(const f32x4*)(gp + bj * HALF); g8[bj][1] = *(const f32x4*)(gp + bj * HALF + 4); }
#pragma unroll
            for (int ai = 0; ai < 2; ++ai)
#pragma unroll
                for (int m = 0; m < 4; ++m) { const int rl = ai * HALF + m * 16 + rl0; bf16_t* rowp = base + (grow0 + rl) * 512 + cl0;
#pragma unroll
                    for (int bj = 0; bj < 2; ++bj) { const f32x4 p = *(const LAS f32x4*)(P + (rl * 2 + bj) * 4);
                        const float rinv = rsqrtf(((p.x + p.y) + (p.z + p.w)) * (1.f / 128.f) + EPS);
                        *(u32x4*)(rowp + bj * HALF) = pack8(acc[ai][bj][m][0] * rinv * g8[bj][0], acc[ai][bj][m][1] * rinv * g8[bj][1]); }
                    asm volatile("" ::: "memory"); __builtin_amdgcn_sched_barrier(0); }
            return;
        }
        {
            const bool isq = pn < 6; const float* gn = isq ? qg : kg;
            const int grp = cl0 >> 3, fo = (grp >> 3) * 64 + (grp & 7) * 4;
            const f32x4 gA = *(const f32x4*)(gn + fo), gB = *(const f32x4*)(gn + fo + 32);
            const size_t kvrow0 = (size_t)((u.pm / 33) * 2) * RPB + (size_t)(u.pm % 33) * BM;
            bf16_t* base = isq ? (bf16_t*)(ws + WS_Q) + (pn - 4) * BM + grow0 * 512 : (bf16_t*)(ws + WS_K) + kvrow0 * 128; const int ld = isq ? 512 : 128;
            const size_t bjs = isq ? (size_t)HALF : (size_t)RPB * 128;
            const int tl = u.pm % 33; const bool lat = tl != 0; const int ax = grp >> 3, f0 = (grp & 7) * 4;
            const float* rope = (const float*)(ws + WS_ROPE);
#pragma unroll
            for (int ai = 0; ai < 2; ++ai)
#pragma unroll
                for (int m = 0; m < 4; ++m) { const int rl = ai * HALF + m * 16 + rl0; bf16_t* rowp = base + (size_t)rl * ld + cl0;
                    f32x4 cs0 = {1.f, 0.f, 1.f, 0.f}, cs1 = {1.f, 0.f, 1.f, 0.f};
                    if (lat) { const int t = (tl - 1) * 256 + rl; const int pos = ax == 0 ? (t >> 6) : (t & 63); const float* rp = rope + (pos * 32 + f0) * 2; cs0 = *(const f32x4*)rp; cs1 = *(const f32x4*)(rp + 4); }
#pragma unroll
                    for (int bj = 0; bj < 2; ++bj) { const f32x4 p = *(const LAS f32x4*)(P + (rl * 2 + bj) * 4);
                        const float rinv = rsqrtf(((p.x + p.y) + (p.z + p.w)) * (1.f / 128.f) + EPS);
                        const f32x4 x1 = acc[ai][bj][m][0] * rinv * gA, x2 = acc[ai][bj][m][1] * rinv * gB;
                        f32x4 o1, o2;
                        o1.x = x1.x * cs0.x - x2.x * cs0.y; o2.x = x2.x * cs0.x + x1.x * cs0.y;
                        o1.y = x1.y * cs0.z - x2.y * cs0.w; o2.y = x2.y * cs0.z + x1.y * cs0.w;
                        o1.z = x1.z * cs1.x - x2.z * cs1.y; o2.z = x2.z * cs1.x + x1.z * cs1.y;
                        o1.w = x1.w * cs1.z - x2.w * cs1.w; o2.w = x2.w * cs1.z + x1.w * cs1.w;
                        *(u32x4*)(rowp + bj * bjs) = pack8(o1, o2); }
                    asm volatile("" ::: "memory"); __builtin_amdgcn_sched_barrier(0); }
        }
    }
};

__device__ __forceinline__ f32x4 mma16(const bf16x8& b, const bf16x8& a, const f32x4& c) { return __builtin_amdgcn_mfma_f32_16x16x32_bf16(b, a, c, 0, 0, 0); }
__device__ __forceinline__ i32x4 mma16(const bf16x8& b, const bf16x8& a, const i32x4& c) { return __builtin_amdgcn_mfma_i32_16x16x64_i8(__builtin_bit_cast(i32x4, b), __builtin_bit_cast(i32x4, a), c, 0, 0, 0); }
template <bool I8> struct AccT { typedef f32x4 type; };
template <> struct AccT<true> { typedef i32x4 type; };
template <class Epi, class Sched, bool ALIGN_EPI = false, bool SP2 = false, bool I8 = false>
__device__ __forceinline__ void gemm_phase(LAS unsigned char* lds, const Gemm g, const Sched& S, const Epi& E) {
    const int tid = threadIdx.x, wid = __builtin_amdgcn_readfirstlane(tid >> 6), lane = tid & 63, wr = wid >> 2, wc = wid & 3, fr = lane & 15, fq = lane >> 4;
    const int K = g.K, KB = I8 ? K : 2 * K  , nt = KB / (BK * 2);
    unsigned voffA[2], voffB[2];
#pragma unroll
    for (int i = 0; i < 2; ++i) { int R, C; stage_rc(tid * 16 + i * 8192, R, C); const int Rb = Epi::PERM ? ((R & ~31) + perm32(R & 31)) : R;
        voffA[i] = (unsigned)(R * KB + C * 2); voffB[i] = (unsigned)(Rb * KB + C * 2); }
    const size_t kstep = (size_t)(BK * 2);
    const size_t hstep = (size_t)HALF * KB;
    const size_t tstep = 2 * hstep;
    const unsigned ldsw = (unsigned)wid * 1024u;
    const int aoff = lds_byte(wr * 64 + fr, fq * 8), boff = lds_byte(wc * 32 + fr, fq * 8);
#define PG8_SA(b, h) (((b) * 2 + (h)) * HTB)
#define PG8_SB(b, h) ((4 + (b) * 2 + (h)) * HTB)
#define PG8_STAGE(bufoff, gbase, voff) do { _Pragma("unroll") for (int _i = 0; _i < 2; ++_i) \
        __builtin_amdgcn_global_load_lds((const unsigned*)((const char*)(gbase) + (voff)[_i]), (LAS unsigned*)(lds + (bufoff) + ldsw + _i * 8192), 16, 0, 0); } while (0)
#define PG8_LDA(dst, b, h) do { _Pragma("unroll") for (int m = 0; m < 4; ++m) _Pragma("unroll") for (int k = 0; k < 2; ++k) dst[m][k] = *(const LAS bf16x8*)(lds + PG8_SA(b, h) + aoff + m * 2048 + k * 1024); } while (0)
#define PG8_LDB(dst, b, h) do { _Pragma("unroll") for (int n = 0; n < 2; ++n) _Pragma("unroll") for (int k = 0; k < 2; ++k) dst[n][k] = *(const LAS bf16x8*)(lds + PG8_SB(b, h) + boff + n * 2048 + k * 1024); } while (0)
#define PG8_MMA(ai, bj, At, Bt) do { __builtin_amdgcn_s_setprio(1); _Pragma("unroll") for (int m = 0; m < 4; ++m) _Pragma("unroll") for (int n = 0; n < 2; ++n) _Pragma("unroll") for (int k = 0; k < 2; ++k) \
        acc[ai][bj][m][n] = mma16(Bt[n][k], At[m][k], acc[ai][bj][m][n]); __builtin_amdgcn_s_setprio(0); } while (0)
#define PG8_WAIT_V(n) asm volatile("s_waitcnt vmcnt(" #n ")" ::: "memory")
#define PG8_WAIT_L(n) asm volatile("s_waitcnt lgkmcnt(" #n ")" ::: "memory")
#define PG8_BAR __builtin_amdgcn_s_barrier()
#define PG8_SCHED __builtin_amdgcn_sched_barrier(0)
    Unit cur, nxt; int ui = 0;
    if (!S.next(0, cur)) return;
    typedef typename AccT<I8>::type acc_t;
    acc_t acc[2][2][4][2];
#pragma unroll
    for (int a = 0; a < 2; ++a)
#pragma unroll
        for (int b = 0; b < 2; ++b)
#pragma unroll
            for (int m = 0; m < 4; ++m)
#pragma unroll
                for (int n = 0; n < 2; ++n) acc[a][b][m][n] = acc_t{};
    bf16x8 At[4][2], B0[2][2], B1[2][2];
    const char* cA = (const char*)g.A + (size_t)cur.pm * tstep; const char* cB = (const char*)g.Bt + (size_t)cur.pn * tstep;
    S.a_ready(cur);
    if constexpr (SP2) {
        PG8_STAGE(PG8_SB(0, 0), cB, voffB); PG8_STAGE(PG8_SB(0, 1), cB + hstep, voffB); PG8_STAGE(PG8_SA(0, 0), cA, voffA); PG8_STAGE(PG8_SA(0, 1), cA + hstep, voffA);
        if (wr == 1) PG8_BAR;
        PG8_WAIT_V(2); PG8_BAR;
        PG8_STAGE(PG8_SB(1, 0), cB + kstep, voffB); PG8_STAGE(PG8_SA(1, 0), cA + kstep, voffA); PG8_STAGE(PG8_SB(1, 1), cB + hstep + kstep, voffB);
        PG8_WAIT_V(6); PG8_BAR;
    } else {
        PG8_STAGE(PG8_SB(0, 0), cB, voffB); PG8_STAGE(PG8_SA(0, 0), cA, voffA); PG8_STAGE(PG8_SB(0, 1), cB + hstep, voffB); PG8_STAGE(PG8_SA(0, 1), cA + hstep, voffA);
        if (wr == 1) PG8_BAR;
        PG8_WAIT_V(4); PG8_BAR;
        PG8_STAGE(PG8_SB(1, 0), cB + kstep, voffB); PG8_STAGE(PG8_SA(1, 0), cA + kstep, voffA); PG8_STAGE(PG8_SB(1, 1), cB + hstep + kstep, voffB);
        PG8_WAIT_V(6); PG8_BAR;
    }
    for (;;) {
        const bool has_next = S.next(ui + 1, nxt);
        const char* nA = has_next ? (const char*)g.A + (size_t)nxt.pm * tstep : cA; const char* nB = has_next ? (const char*)g.Bt + (size_t)nxt.pn * tstep : cB;
        for (int t = 0; t < nt; t += 2) {
            const bool last = (t == nt - 2);
            const char* a1 = cA + (size_t)(t + 1) * kstep;
            const char* a2 = last ? nA : cA + (size_t)(t + 2) * kstep; const char* b2 = last ? nB : cB + (size_t)(t + 2) * kstep;
            const char* a3 = a2 + kstep; const char* b3 = b2 + kstep;
            if (last && has_next) S.a_ready(nxt);
            if constexpr (SP2) {
            PG8_LDB(B0, 0, 0); PG8_LDB(B1, 0, 1); PG8_SCHED; PG8_LDA(At, 0, 0); PG8_STAGE(PG8_SA(1, 1), a1 + hstep, voffA);
            PG8_WAIT_V(8); PG8_WAIT_L(0); PG8_BAR; PG8_MMA(0, 0, At, B0); PG8_MMA(0, 1, At, B1); PG8_BAR; PG8_SCHED;
            PG8_LDA(At, 0, 1); PG8_STAGE(PG8_SB(0, 0), b2, voffB); PG8_STAGE(PG8_SB(0, 1), b2 + hstep, voffB); PG8_STAGE(PG8_SA(0, 0), a2, voffA);
            PG8_WAIT_V(8); PG8_WAIT_L(0); PG8_BAR; PG8_MMA(1, 0, At, B0); PG8_MMA(1, 1, At, B1); PG8_BAR; PG8_SCHED;
            PG8_LDB(B0, 1, 0); PG8_LDB(B1, 1, 1); PG8_SCHED; PG8_LDA(At, 1, 0); PG8_STAGE(PG8_SA(0, 1), a2 + hstep, voffA);
            PG8_WAIT_V(8); PG8_WAIT_L(0); PG8_BAR; PG8_MMA(0, 0, At, B0); PG8_MMA(0, 1, At, B1); PG8_BAR; PG8_SCHED;
            PG8_LDA(At, 1, 1); PG8_STAGE(PG8_SB(1, 0), b3, voffB); PG8_STAGE(PG8_SB(1, 1), b3 + hstep, voffB); PG8_STAGE(PG8_SA(1, 0), a3, voffA);
            PG8_WAIT_V(8); PG8_WAIT_L(0); PG8_BAR; PG8_MMA(1, 0, At, B0); PG8_MMA(1, 1, At, B1); PG8_BAR; PG8_SCHED;
            } else {
            PG8_LDB(B0, 0, 0); PG8_SCHED; PG8_LDA(At, 0, 0); PG8_STAGE(PG8_SA(1, 1), a1 + hstep, voffA);
            PG8_WAIT_L(8); PG8_BAR; PG8_WAIT_L(0); PG8_MMA(0, 0, At, B0); PG8_BAR; PG8_SCHED;
            PG8_LDB(B1, 0, 1); PG8_STAGE(PG8_SB(0, 0), b2, voffB);
            PG8_BAR; PG8_WAIT_L(0); PG8_MMA(0, 1, At, B1); PG8_BAR;
            PG8_LDA(At, 0, 1); PG8_STAGE(PG8_SA(0, 0), a2, voffA);
            PG8_BAR; PG8_WAIT_L(0); PG8_MMA(1, 0, At, B0); PG8_BAR; PG8_SCHED;
            PG8_STAGE(PG8_SB(0, 1), b2 + hstep, voffB);
            PG8_WAIT_V(6); PG8_BAR; PG8_MMA(1, 1, At, B1); PG8_BAR;
            PG8_LDB(B0, 1, 0); PG8_SCHED; PG8_LDA(At, 1, 0); PG8_STAGE(PG8_SA(0, 1), a2 + hstep, voffA);
            PG8_WAIT_L(8); PG8_BAR; PG8_WAIT_L(0); PG8_MMA(0, 0, At, B0); PG8_BAR; PG8_SCHED;
            PG8_LDB(B1, 1, 1); PG8_STAGE(PG8_SB(1, 0), b3, voffB);
            PG8_BAR; PG8_WAIT_L(0); PG8_MMA(0, 1, At, B1); PG8_BAR;
            PG8_LDA(At, 1, 1); PG8_STAGE(PG8_SA(1, 0), a3, voffA);
            PG8_BAR; PG8_WAIT_L(0); PG8_MMA(1, 0, At, B0); PG8_BAR; PG8_SCHED;
            PG8_STAGE(PG8_SB(1, 1), b3 + hstep, voffB);
            PG8_WAIT_V(6); PG8_BAR; PG8_MMA(1, 1, At, B1); PG8_BAR;
            }
        }
        if constexpr (ALIGN_EPI) { if (wr == 0) PG8_BAR; }
        if constexpr (!Epi::AFTER_DRAIN) {
            if constexpr (I8) {
                f32x4 accf[2][2][4][2];
                { int rl0 = wr * 64 + fr, cl0 = wc * 32 + 8 * fq; asm volatile("" : "+v"(rl0), "+v"(cl0));
                  const float* sap = g.sa + (size_t)cur.pm * BM + rl0; const float* swp = g.sw + (size_t)cur.pn * BM + cl0;
                  f32x4 cs[2][2];
#pragma unroll
                  for (int bj = 0; bj < 2; ++bj) { cs[bj][0] = *(const f32x4*)(swp + bj * HALF); cs[bj][1] = *(const f32x4*)(swp + bj * HALF + 4); }
#pragma unroll
                  for (int ai = 0; ai < 2; ++ai)
#pragma unroll
                    for (int m = 0; m < 4; ++m) { const float rs = sap[ai * HALF + m * 16];
#pragma unroll
                        for (int bj = 0; bj < 2; ++bj)
#pragma unroll
                            for (int n = 0; n < 2; ++n) accf[ai][bj][m][n] = __builtin_convertvector(acc[ai][bj][m][n], f32x4) * (cs[bj][n] * rs); } }
                E(accf, cur, wr, wc, fr, fq);
            } else { E(acc, cur, wr, wc, fr, fq); }
            S.done(cur); }
        if (!has_next) break;
#pragma unroll
        for (int a = 0; a < 2; ++a)
#pragma unroll
            for (int b = 0; b < 2; ++b)
#pragma unroll
                for (int m = 0; m < 4; ++m)
#pragma unroll
                    for (int n = 0; n < 2; ++n) acc[a][b][m][n] = acc_t{};
        cur = nxt; cA = nA; cB = nB; ++ui;
        if constexpr (ALIGN_EPI) { if (wr == 1) PG8_BAR; }
    }
    PG8_WAIT_V(0);
    if constexpr (!ALIGN_EPI) { if (wr == 0) PG8_BAR; }
    PG8_BAR;
#undef PG8_SA
#undef PG8_SB
#undef PG8_STAGE
#undef PG8_LDA
#undef PG8_LDB
#undef PG8_MMA
#undef PG8_WAIT_V
#undef PG8_WAIT_L
#undef PG8_BAR
#undef PG8_SCHED
}
}

__device__ __forceinline__ void fphase_inproj0(const Args& a, char* lds) {
    pg8::Gemm g{(const bf16_t*)(a.ws + WS_H8), (const bf16_t*)(a.ws + WS_W8IN0), MTOT, 2048, 1024, (const float*)(a.ws + WS_SH), (const float*)(a.ws + WS_SW)};
    pg8::StaticOrder S; S.init(MTOT, 2048, (int)gridDim.x, (int)blockIdx.x);
    pg8::EpiInproj0 E{a.ws, a.in[9], a.in[12], a.in[13], (LAS float*)((LAS char*)lds + 131072)};
    pg8::gemm_phase<pg8::EpiInproj0, pg8::StaticOrder, true, true, true>((LAS unsigned char*)lds, g, S, E);
    const int G = (int)gridDim.x, nbusy = 528 - 2 * G;
    if (G == 256 && (int)blockIdx.x >= nbusy) quant_tables(a, 0, ((int)blockIdx.x - nbusy) * NWAVE + (int)(threadIdx.x >> 6), (G - nbusy) * NWAVE, (int)(threadIdx.x & 63), 0, NEXP);
    else if (G != 256) quant_tables(a, 0, (int)blockIdx.x * NWAVE + (int)(threadIdx.x >> 6), G * NWAVE, (int)(threadIdx.x & 63), 0, NEXP);
}
__device__ __forceinline__ void fphase_outproj0(const Args& a, char* lds) {
    pg8::Gemm g{(const bf16_t*)(a.ws + WS_AO), (const bf16_t*)(a.ws + WS_WOUT0), MTOT, 1024, 1024, nullptr, nullptr};
    pg8::StaticOrder S; S.init(MTOT, 1024, (int)gridDim.x, (int)blockIdx.x);
    pg8::EpiResid E{a.in[0], a.in[2], (const float*)(a.ws + WS_MODV) + 2 * 1024, (bf16_t*)(a.ws + WS_X1), 0};
    pg8::gemm_phase<pg8::EpiResid, pg8::StaticOrder, true, true>((LAS unsigned char*)lds, g, S, E);
    const int G = (int)gridDim.x, nbusy = (G == 256) ? 264 - G : 0;
    if ((int)blockIdx.x >= nbusy) quant_tables(a, 0, ((int)blockIdx.x - nbusy) * NWAVE + (int)(threadIdx.x >> 6), (G - nbusy) * NWAVE, (int)(threadIdx.x & 63), NEXP, 2 * NEXP);
}
__device__ __forceinline__ void fphase_peerq0(const Args& a, char* lds) {
    pg8::Gemm g{(const bf16_t*)(a.ws + WS_H8), (const bf16_t*)(a.ws + WS_W8Q), MTOT, 2048, 1024, (const float*)(a.ws + WS_SH), (const float*)(a.ws + WS_SW) + 2048};
    pg8::StaticOrder S; S.init(MTOT, 2048, (int)gridDim.x, (int)blockIdx.x);
    pg8::EpiStore E{(bf16_t*)(a.ws + WS_QP), (bf16_t*)(a.ws + WS_QP), 2048, 1000, 0};
    pg8::gemm_phase<pg8::EpiStore, pg8::StaticOrder, true, true, true>((LAS unsigned char*)lds, g, S, E);
    const int G = (int)gridDim.x, nbusy = (G == 256) ? 528 - 2 * G : 0;
    if ((int)blockIdx.x >= nbusy) for (int r = (int)blockIdx.x - nbusy; r < 208; r += G - nbusy) prep_l1_item(a, (float*)lds, 160 + r);
    if ((int)blockIdx.x >= nbusy) quant_tables(a, 1, ((int)blockIdx.x - nbusy) * NWAVE + (int)(threadIdx.x >> 6), (G - nbusy) * NWAVE, (int)(threadIdx.x & 63), 0, NEXP / 2);
}
__device__ __forceinline__ void fphase_inproj1(const Args& a, char* lds) {
    pg8::Gemm g{(const bf16_t*)(a.ws + WS_H8B), (const bf16_t*)(a.ws + WS_W8IN1), MTOT, 2560, 1024, (const float*)(a.ws + WS_SH), (const float*)(a.ws + WS_SW) + 3 * 2048};
    pg8::StaticOrder S; S.init(MTOT, 2560, (int)gridDim.x, (int)blockIdx.x);
    pg8::EpiStore E{(bf16_t*)(a.ws + WS_GG), (bf16_t*)(a.ws + WS_XR), 1280, 5, 5};
    pg8::gemm_phase<pg8::EpiStore, pg8::StaticOrder, true, true, true>((LAS unsigned char*)lds, g, S, E);
    const int G = (int)gridDim.x, nbusy = 660 - 2 * G;
    if (G == 256 && (int)blockIdx.x >= nbusy) quant_tables(a, 1, ((int)blockIdx.x - nbusy) * NWAVE + (int)(threadIdx.x >> 6), (G - nbusy) * NWAVE, (int)(threadIdx.x & 63), NEXP / 2, NEXP);
    else if (G != 256) quant_tables(a, 1, (int)blockIdx.x * NWAVE + (int)(threadIdx.x >> 6), G * NWAVE, (int)(threadIdx.x & 63), NEXP / 2, NEXP);
}
__device__ __forceinline__ void fphase_outproj1(const Args& a, char* lds) {
    pg8::Gemm g{(const bf16_t*)(a.ws + WS_YG), (const bf16_t*)(a.ws + WS_WOUT1), MTOT, 1024, 1280, nullptr, nullptr};
    pg8::LatentOrder S; S.init(1024, (int)gridDim.x, (int)blockIdx.x);
    pg8::EpiResid E{a.in[0], a.in[2], (const float*)(a.ws + WS_MODV) + 3 * 6144 + 2 * 1024, (bf16_t*)(a.ws + WS_X1), 1};
    pg8::gemm_phase<pg8::EpiResid, pg8::LatentOrder, true, true>((LAS unsigned char*)lds, g, S, E);
}
__device__ __forceinline__ void fphase_peerq1(const Args& a, char* lds) {
    pg8::Gemm g{(const bf16_t*)(a.ws + WS_H8), (const bf16_t*)(a.ws + WS_W8Q + (size_t)2048 * 1024), MTOT, 2048, 1024, (const float*)(a.ws + WS_SH), (const float*)(a.ws + WS_SW) + 2 * 2048};
    pg8::LatentOrder S; S.init(2048, (int)gridDim.x, (int)blockIdx.x);
    pg8::EpiStore E{(bf16_t*)(a.ws + WS_QP), (bf16_t*)(a.ws + WS_QP), 2048, 1000, 0};
    pg8::gemm_phase<pg8::EpiStore, pg8::LatentOrder, true, true, true>((LAS unsigned char*)lds, g, S, E);
}

constexpr int NPHASE = 23;
__global__ void __launch_bounds__(NTHR, 2) mega(Args a) {
    extern __shared__ __attribute__((aligned(16))) char lds[];
    volatile LAS unsigned* MISC = (volatile LAS unsigned*)((LAS char*)lds + LDS_MISC);
    if (threadIdx.x < 64) MISC[threadIdx.x] = 0u;
    __syncthreads();
    XcdBarrier bar; bar.bar = (unsigned*)(a.ws + WS_CTL) + 4096; bar.x = 0; bar.st = nullptr;
    const bool multi = (a.ph_hi - a.ph_lo) > 1;
    if (multi) bar = xcd_barrier_post((unsigned*)(a.ws + WS_CTL) + 4096, MISC + 8);
    const int lo = a.ph_lo, hi = a.ph_hi;
    unsigned char* ws = a.ws;
#define IN(k) (lo <= (k) && (k) < hi)
#define SEAM(k) do { if (IN(k) && IN((k) + 1)) xcd_barrier(bar); } while (0)
#ifndef PROBE_DUP
#define PROBE_DUP 0u
#endif
#define DUPQ(k) (((PROBE_DUP >> (k)) & 1u) != 0u)
    if (IN(0)) { phase_prep(a, lds); if (DUPQ(0)) { xcd_barrier(bar); phase_prep(a, lds); } } SEAM(0);
    if (IN(1)) { phase_norm(a, 0, 0, a.in[6], 0, 1, false, true);
        { const int gwq = blockIdx.x * NWAVE + (threadIdx.x >> 6), ngwq = gridDim.x * NWAVE, lq = threadIdx.x & 63;
          quant_wrows((const bf16_t*)(ws + WS_WIN0), ws + WS_W8IN0, (float*)(ws + WS_SW), 2048, gwq, ngwq, lq);
          quant_wrows((const bf16_t*)(ws + WS_WQ), ws + WS_W8Q, (float*)(ws + WS_SW) + 2048, 2048, gwq, ngwq, lq); } } SEAM(1);
    if (IN(2)) { fphase_inproj0(a, lds); if (DUPQ(2)) { xcd_barrier(bar); fphase_inproj0(a, lds); } } SEAM(2);
    if (IN(3)) { phase_gmlp2(a, lds); phase_attn(a, lds); if (DUPQ(3)) { xcd_barrier(bar); phase_gmlp2(a, lds); phase_attn(a, lds); } } SEAM(3);
    if (IN(4)) { fphase_outproj0(a, lds); if (DUPQ(4)) { xcd_barrier(bar); fphase_outproj0(a, lds); } } SEAM(4);
    if (IN(5)) { phase_norm(a, 0, 1, a.in[7], 3, 4, false, true); if (DUPQ(5)) { xcd_barrier(bar); phase_norm(a, 0, 1, a.in[7], 3, 4, false, true); } } SEAM(5);
    if (IN(6)) { fphase_peerq0(a, lds); if (DUPQ(6)) { xcd_barrier(bar); fphase_peerq0(a, lds); } if (IN(7)) topk_load_keys(a, lds, 0); } SEAM(6);
    if (IN(7)) { phase_peer_topk3(a, lds, 0, false, IN(6)); if (DUPQ(7)) { xcd_barrier(bar); phase_peer_topk3(a, lds, 0, false); } } SEAM(7);
    if (IN(8)) { phase_gu(a, lds, 0, 0); if (DUPQ(8)) { xcd_barrier(bar); phase_gu(a, lds, 0, 0); } } SEAM(8);
    if (IN(9)) { phase_gact(a, 0, 0);
        { const int gwq = blockIdx.x * NWAVE + (threadIdx.x >> 6), ngwq = gridDim.x * NWAVE, lq = threadIdx.x & 63;
          quant_wrows((const bf16_t*)(ws + WS_WIN1), ws + WS_W8IN1, (float*)(ws + WS_SW) + 3 * 2048, 2560, gwq, ngwq, lq);
          quant_wrows((const bf16_t*)(ws + WS_WQ) + (size_t)2048 * 1024, ws + WS_W8Q + (size_t)2048 * 1024, (float*)(ws + WS_SW) + 2 * 2048, 2048, gwq, ngwq, lq); } } SEAM(9);
    if (IN(10)) { phase_gv(a, lds, 0, 0); if (DUPQ(10)) { xcd_barrier(bar); phase_gv(a, lds, 0, 0); } } SEAM(10);
    if (IN(11)) { phase_norm(a, 1, 1, a.in[6] + D, 0, 1, false, true, WS_H8B); } SEAM(11);
    if (IN(12)) { fphase_inproj1(a, lds); if (DUPQ(12)) { xcd_barrier(bar); fphase_inproj1(a, lds); } } SEAM(12);
    if (IN(13)) { phase_rglru2(a, lds, 0); if (DUPQ(13)) { xcd_barrier(bar); phase_rglru2(a, lds, 0); } } SEAM(13);
    if (IN(14)) { phase_rglru_out(a, lds); if (DUPQ(14)) { xcd_barrier(bar); phase_rglru_out(a, lds); } } SEAM(14);
    if (IN(15)) { fphase_outproj1(a, lds); if (DUPQ(15)) { xcd_barrier(bar); fphase_outproj1(a, lds); } } SEAM(15);
    if (IN(16)) { phase_norm(a, 1, 1, a.in[7] + D, 3, 4, true, true); if (DUPQ(16)) { xcd_barrier(bar); phase_norm(a, 1, 1, a.in[7] + D, 3, 4, true, true); } } SEAM(16);
    if (IN(17)) { fphase_peerq1(a, lds); if (DUPQ(17)) { xcd_barrier(bar); fphase_peerq1(a, lds); } if (IN(18)) topk_load_keys(a, lds, 1); } SEAM(17);
    if (IN(18)) { phase_peer_topk3(a, lds, 1, true, IN(17)); if (DUPQ(18)) { xcd_barrier(bar); phase_peer_topk3(a, lds, 1, true); } } SEAM(18);
    if (IN(19)) { phase_gu(a, lds, 1, 1); if (DUPQ(19)) { xcd_barrier(bar); phase_gu(a, lds, 1, 1); } } SEAM(19);
    if (IN(20)) { phase_gact(a, 1, 1); if (DUPQ(20)) { xcd_barrier(bar); phase_gact(a, 1, 1); } } SEAM(20);
    if (IN(21)) { phase_gv(a, lds, 1, 1); if (DUPQ(21)) { xcd_barrier(bar); phase_gv(a, lds, 1, 1); } } SEAM(21);
    if (IN(22)) { phase_finalnorm(a); if (DUPQ(22)) { xcd_barrier(bar); phase_finalnorm(a); } }
#undef IN
#undef SEAM
}

extern "C" void kernel_launch(void* const* d_in, const int* in_sizes, int n_in, void* d_out, int out_size, void* d_ws, size_t ws_size, hipStream_t stream) {
    static int grid = 0;
    if (grid == 0) {
        if (n_in != 29 || out_size != NB * SEQ * D || ws_size < WS_END) {
            fprintf(stderr, "kernel_launch: unexpected shapes: n_in %d out %d ws %zu (need %zu)\n", n_in, out_size, ws_size, (size_t)WS_END); grid = -1; return; }
        int dev = 0, cus = 0, per_cu = 0;
        if (hipGetDevice(&dev) != hipSuccess || hipDeviceGetAttribute(&cus, hipDeviceAttributeMultiprocessorCount, dev) != hipSuccess) { grid = -1; return; }
        if (hipFuncSetAttribute((const void*)mega, hipFuncAttributeMaxDynamicSharedMemorySize, LDS_BYTES) != hipSuccess) { fprintf(stderr, "kernel_launch: hipFuncSetAttribute failed\n"); grid = -1; return; }
        if (hipOccupancyMaxActiveBlocksPerMultiprocessor(&per_cu, (const void*)mega, NTHR, LDS_BYTES) != hipSuccess || per_cu < 1)
            fprintf(stderr, "kernel_launch: occupancy query reports %d blocks per CU\n", per_cu);
        (void)hipGetLastError();
        grid = cus & ~7; if (grid < 8) grid = 8;
    }
    if (grid < 0) return;
    (void)hipMemsetAsync((char*)d_ws + WS_CTL + 16384, 0, 16384, stream);
    Args a{};
    for (int i = 0; i < 29; ++i) a.in[i] = (const float*)d_in[i];
    a.out = (float*)d_out; a.ws = (unsigned char*)d_ws;
#if MK_SINGLE
    a.ph_lo = 0; a.ph_hi = NPHASE;
    hipLaunchKernelGGL(mega, dim3(grid), dim3(NTHR), LDS_BYTES, stream, a);
#else
    for (int p = 0; p < NPHASE; ++p) { a.ph_lo = p; a.ph_hi = p + 1; hipLaunchKernelGGL(mega, dim3(grid), dim3(NTHR), LDS_BYTES, stream, a); }
#endif
    const hipError_t le = hipPeekAtLastError();
    if (le != hipSuccess) fprintf(stderr, "kernel_launch: launch failed: %s\n", hipGetErrorName(le));
}
```

```cpp
#include <hip/hip_runtime.h>
#include <cstdio>
#include <cstdint>

#ifndef MK_SINGLE
#define MK_SINGLE 1
#endif

#define GAS __attribute__((address_space(1)))
#define LAS __attribute__((address_space(3)))

typedef unsigned short bf16_t;
typedef short bf16x8 __attribute__((ext_vector_type(8)));
typedef float f32x4 __attribute__((ext_vector_type(4)));
typedef float f32x16 __attribute__((ext_vector_type(16)));
typedef unsigned u32x4 __attribute__((ext_vector_type(4)));
typedef unsigned u32x2 __attribute__((ext_vector_type(2)));
typedef int i32x4 __attribute__((ext_vector_type(4)));

constexpr int D = 1024, NB = 2, SEQ = 8192, CTXL = 256;
constexpr int RPB = SEQ + CTXL;
constexpr int MTOT = NB * RPB;
constexpr int AB_IN = 2048, A_W = 512, DRNN = 1280, NEXP = 16384;
constexpr float EPS = 1e-6f;
constexpr int NTHR = 512, NWAVE = 8;

constexpr size_t MiB = 1u << 20;
constexpr size_t WS_CTL = 0, CTL_BYTES = 1 * MiB;
constexpr size_t WS_MODV = 1 * MiB;
constexpr size_t WS_ROPE = 1 * MiB + 512 * 1024;
constexpr size_t WS_WIN0 = 2 * MiB;
constexpr size_t WS_WOUT0 = 6 * MiB;
constexpr size_t WS_WIN1 = 8 * MiB;
constexpr size_t WS_WOUT1 = 13 * MiB;
constexpr size_t WS_WQ = 16 * MiB;
constexpr size_t WS_KEYS = 24 * MiB;
constexpr size_t WS_GWS = 25 * MiB;
constexpr size_t WS_WAT = 26 * MiB;
constexpr size_t WS_WXT = 27 * MiB;
constexpr size_t WS_CARRY = 28 * MiB;
constexpr size_t WS_SPL = 30 * MiB + 768 * 1024;
constexpr size_t WS_SCU = 31 * MiB;
constexpr size_t WS_SCV = 31 * MiB + 512 * 1024;
constexpr size_t WS_PU = 32 * MiB;
constexpr size_t WS_PV = 96 * MiB;
constexpr size_t WS_H = 160 * MiB;
constexpr size_t WS_X1 = 193 * MiB;
constexpr size_t WS_SELI = 259 * MiB;
constexpr size_t WS_SELG = 268 * MiB;
constexpr size_t WS_R = 277 * MiB;
constexpr size_t WS_U = WS_R;
constexpr size_t WS_VV = WS_R + 17 * MiB;
constexpr size_t WS_Q = WS_R + 34 * MiB;
constexpr size_t WS_K = WS_R + 51 * MiB;
constexpr size_t WS_V = WS_R + 60 * MiB;
constexpr size_t WS_AO = WS_R + 69 * MiB;
constexpr size_t WS_QP = WS_R;
constexpr size_t WS_H8B = WS_R + 90 * MiB;
constexpr size_t WS_H8 = WS_R + 70 * MiB;
constexpr size_t WS_SH = WS_R + 88 * MiB;
constexpr size_t WS_ACT16 = WS_R + 89 * MiB;
constexpr size_t WS_SA = WS_R + 94 * MiB;
constexpr size_t WS_SACT = WS_R + 94 * MiB + 512 * 1024;
constexpr size_t WS_PART = WS_R;
constexpr size_t WS_GG = WS_R;
constexpr size_t WS_XR = WS_R + 42 * MiB;
constexpr size_t WS_YG = WS_R + 84 * MiB;
constexpr size_t WS_W8IN0 = WS_R + 126 * MiB;
constexpr size_t WS_W8Q = WS_R + 128 * MiB;
constexpr size_t WS_W8IN1 = WS_R + 132 * MiB;
constexpr size_t WS_SW = WS_R + 135 * MiB;
constexpr size_t WS_STR = 128 * MiB;
constexpr size_t WS_STU = WS_R + 136 * MiB;
constexpr size_t WS_STS = WS_R + 180 * MiB;
constexpr size_t WS_END = WS_R + 183 * MiB;

constexpr int LDS_BYTES = 147456;
constexpr int LDS_MISC = 145408;

__device__ __forceinline__ float bf2f(bf16_t v) { return __uint_as_float(((unsigned)v) << 16); }
__device__ __forceinline__ unsigned pk2(float lo, float hi) { unsigned r; asm("v_cvt_pk_bf16_f32 %0, %1, %2" : "=v"(r) : "v"(lo), "v"(hi)); return r; }
__device__ __forceinline__ unsigned f2bf(float f) { return pk2(f, f) & 0xffffu; }
__device__ __forceinline__ float bflo(unsigned w) { return __uint_as_float(w << 16); }
__device__ __forceinline__ float bfhi(unsigned w) { return __uint_as_float(w & 0xffff0000u); }
__device__ __forceinline__ float gelu_t(float x) { const float y = -2.302208198144325f * (x + 0.044715f * x * x * x); return x * __builtin_amdgcn_rcpf(1.f + __builtin_amdgcn_exp2f(y)); }
__device__ __forceinline__ float sigmoidf_(float x) { return 1.f / (1.f + __expf(-x)); }
__device__ __forceinline__ float wave_sum(float v) {
#pragma unroll
    for (int o = 1; o < 64; o <<= 1) v += __shfl_xor(v, o);
    return v;
}
__host__ __device__ __forceinline__ int sigma_head(int j) { const int grp = j >> 3, n = (j >> 2) & 1, e = j & 3; return (grp >> 3) * 64 + n * 32 + (grp & 7) * 4 + e; }

struct Args {
    const float* in[29];
    float* out;
    unsigned char* ws;
    int ph_lo, ph_hi;
};

__device__ __forceinline__ int row_variant(int g) { const int b = g / RPB, i = g - b * RPB; return i < CTXL ? 2 : b; }
__device__ __forceinline__ const float* row_src(const Args& a, int g) {
    const int b = g / RPB, i = g - b * RPB;
    return i < CTXL ? a.in[2] + ((size_t)b * CTXL + i) * D : a.in[0] + ((size_t)b * SEQ + (i - CTXL)) * D;
}
__device__ __forceinline__ const float* modv(const Args& a, int layer, int variant, int which) {
    return (const float*)(a.ws + WS_MODV) + ((size_t)(layer * 3 + variant) * 6 + which) * D;
}

#define XB_TMO      128
#define XB_XCNT(j)  (256  + 64 * (j))
#define XB_XSUB(j)  (1280 + 64 * (j))
#define XB_XGEN(j)  (2304 + 64 * (j))
#define XB_TOP      3328
#define XB_TOPGEN   3392
#define XCD_BAR_WORDS 3456
#define XB_SPIN_CAP (1u << 22)
__device__ __forceinline__ unsigned xb_ld(unsigned* p)              { return __hip_atomic_load(p, __ATOMIC_RELAXED, __HIP_MEMORY_SCOPE_AGENT); }
__device__ __forceinline__ unsigned xb_add(unsigned* p, unsigned v) { return __hip_atomic_fetch_add(p, v, __ATOMIC_RELAXED, __HIP_MEMORY_SCOPE_AGENT); }
__device__ __forceinline__ unsigned xb_xcc_id() { return (unsigned)__builtin_amdgcn_s_getreg((3 << 11) | 20) & 0xFu; }
#define XB_SPIN(cond, bar) do { unsigned _sp = 0; while (cond) { __builtin_amdgcn_s_sleep(1); \
    if ((++_sp & 255u) == 0u) { if (xb_ld(&(bar)[XB_TMO])) break; if (_sp > XB_SPIN_CAP) { atomicAdd(&(bar)[XB_TMO], 1u); break; } } } } while (0)
struct XcdBarrier { unsigned* bar; unsigned x; volatile LAS unsigned* st; };
__device__ __forceinline__ XcdBarrier xcd_barrier_post(unsigned* bar, volatile LAS unsigned* st) {
    XcdBarrier b; b.bar = bar; b.x = xb_xcc_id(); b.st = st;
    if (threadIdx.x == 0) (void)xb_add(&bar[XB_XCNT(b.x)], 1u);
    return b;
}
__device__ __forceinline__ void xcd_barrier_complete(unsigned* bar, unsigned x, unsigned& nloc, unsigned& nx) {
    const unsigned G = gridDim.x * gridDim.y * gridDim.z;
    unsigned sum, cnt, mine, sp = 0u;
    for (;;) {
        sum = 0u; cnt = 0u; mine = 0u;
#pragma unroll
        for (unsigned j = 0; j < 16; ++j) { const unsigned c = xb_ld(&bar[XB_XCNT(j)]); sum += c; cnt += (c > 0u) ? 1u : 0u; mine = (j == x) ? c : mine; }
        if (sum == G) break;
        __builtin_amdgcn_s_sleep(1);
        if ((++sp & 255u) == 0u) { if (xb_ld(&bar[XB_TMO])) break; if (sp > XB_SPIN_CAP) { atomicAdd(&bar[XB_TMO], 1u); break; } }
    }
    nloc = mine > 0u ? mine : 1u; nx = cnt > 0u ? cnt : 1u;
}
__device__ __forceinline__ void xcd_barrier(const XcdBarrier& b) {
    asm volatile("s_waitcnt vmcnt(0)" ::: "memory");
    __syncthreads();
    if (threadIdx.x == 0) {
        unsigned* bar = b.bar;
        __builtin_amdgcn_s_waitcnt(0);
        unsigned nloc = b.st[0], nx = b.st[1];
        if (nloc == 0u) { xcd_barrier_complete(bar, b.x, nloc, nx); b.st[0] = nloc; b.st[1] = nx; }
        const unsigned old = xb_add(&bar[XB_XSUB(b.x)], 1u);
        const unsigned gen = old / nloc;
        if (old + 1u == (gen + 1u) * nloc) {
            __builtin_amdgcn_fence(__ATOMIC_RELEASE, "agent");
            asm volatile("s_waitcnt vmcnt(0)" ::: "memory");
            (void)xb_add(&bar[XB_TOP], 1u);
        }
        XB_SPIN(xb_ld(&bar[XB_TOP]) < (gen + 1u) * nx, bar);
        __builtin_amdgcn_fence(__ATOMIC_ACQUIRE, "agent");
        asm volatile("s_waitcnt vmcnt(0)" ::: "memory");
    }
    __syncthreads();
}

__device__ __forceinline__ void qt_load(f32x4 (&v)[4][4], const Args& a, int layer, int r0, int lane) {
#pragma unroll
    for (int q = 0; q < 4; ++q) {
        const int r = r0 + q, tb = r / NEXP, ex = r - tb * NEXP;
        const float* src = a.in[tb == 0 ? 26 : 27] + ((size_t)layer * NEXP + ex) * D;
#pragma unroll
        for (int j = 0; j < 4; ++j) v[q][j] = *(const f32x4*)(src + j * 256 + lane * 4);
    }
}
__device__ __forceinline__ void qt_store(const f32x4 (&v)[4][4], const Args& a, int layer, int r0, int lane) {
    unsigned char* ws = a.ws; float mx[4], ss[4];
#pragma unroll
    for (int q = 0; q < 4; ++q) { float m = 0.f, s2 = 0.f;
#pragma unroll
        for (int j = 0; j < 4; ++j) { m = fmaxf(fmaxf(fmaxf(fabsf(v[q][j].x), fabsf(v[q][j].y)), fmaxf(fabsf(v[q][j].z), fabsf(v[q][j].w))), m);
            s2 += (v[q][j].x * v[q][j].x + v[q][j].y * v[q][j].y) + (v[q][j].z * v[q][j].z + v[q][j].w * v[q][j].w); }
        mx[q] = m; ss[q] = s2; }
#pragma unroll
    for (int o = 1; o < 64; o <<= 1) {
#pragma unroll
        for (int q = 0; q < 4; ++q) { mx[q] = fmaxf(mx[q], __shfl_xor(mx[q], o)); ss[q] += __shfl_xor(ss[q], o); } }
#pragma unroll
    for (int q = 0; q < 4; ++q) {
        const int r = r0 + q, tb = r / NEXP, ex = r - tb * NEXP;
        {
            const float step = fmaxf(0.3352f * __builtin_sqrtf(ss[q] * (1.f / D)), 1e-30f), inv = 1.f / step;
            unsigned char* dst = ws + (tb == 0 ? WS_PU : WS_PV) + (size_t)layer * NEXP * 512 + (size_t)ex * 128 + (lane >> 3) * 16 + (lane & 3) * 4;
#pragma unroll
            for (int j = 0; j < 4; ++j) {
                const int n0 = min(max((int)floorf(v[q][j].x * inv) + 8, 0), 15), n1 = min(max((int)floorf(v[q][j].y * inv) + 8, 0), 15);
                const int n2 = min(max((int)floorf(v[q][j].z * inv) + 8, 0), 15), n3 = min(max((int)floorf(v[q][j].w * inv) + 8, 0), 15);
                unsigned nbv = (unsigned)n0 | ((unsigned)n1 << 8) | ((unsigned)n2 << 16) | ((unsigned)n3 << 24);
                if (tb == 0 || ((lane >> 2) & 1)) nbv ^= 0x08080808u;
                const unsigned pn = __shfl_xor(nbv, 4);
                if (((lane >> 2) & 1) == 0) *(unsigned*)(dst + (size_t)j * NEXP * 128) = nbv | (pn << 4);
            }
            if (lane == 0) ((float*)(ws + (tb == 0 ? WS_SCU : WS_SCV)))[layer * NEXP + ex] = step;
        }
    }
}
__device__ __forceinline__ void quant_tables(const Args& a, int layer, int gw, int ngw, int lane, int row_lo = 0, int row_hi = 2 * NEXP) {
    const int step = ngw * 4; int r0 = row_lo + gw * 4;
    if (r0 >= row_hi) return;
    f32x4 va[4][4], vb[4][4];
    qt_load(va, a, layer, r0, lane);
    for (;;) {
        const int r1 = r0 + step; const bool h1 = r1 < row_hi;
        if (h1) qt_load(vb, a, layer, r1, lane);
        qt_store(va, a, layer, r0, lane);
        if (!h1) break;
        const int r2 = r1 + step; const bool h2 = r2 < row_hi;
        if (h2) qt_load(va, a, layer, r2, lane);
        qt_store(vb, a, layer, r1, lane);
        if (!h2) break;
        r0 = r2;
    }
}
__device__ __forceinline__ void quant_wrows(const bf16_t* src, unsigned char* dst, float* scale, int nrows, int gw, int ngw, int lane) {
    for (int r = gw; r < nrows; r += ngw) {
        const u32x4 w0 = *(const u32x4*)(src + (size_t)r * D + lane * 16), w1 = *(const u32x4*)(src + (size_t)r * D + lane * 16 + 8);
        float v[16];
        v[0] = bflo(w0.x); v[1] = bfhi(w0.x); v[2] = bflo(w0.y); v[3] = bfhi(w0.y); v[4] = bflo(w0.z); v[5] = bfhi(w0.z); v[6] = bflo(w0.w); v[7] = bfhi(w0.w);
        v[8] = bflo(w1.x); v[9] = bfhi(w1.x); v[10] = bflo(w1.y); v[11] = bfhi(w1.y); v[12] = bflo(w1.z); v[13] = bfhi(w1.z); v[14] = bflo(w1.w); v[15] = bfhi(w1.w);
        float mx = 0.f;
#pragma unroll
        for (int k = 0; k < 16; ++k) mx = fmaxf(mx, fabsf(v[k]));
#pragma unroll
        for (int o = 1; o < 64; o <<= 1) mx = fmaxf(mx, __shfl_xor(mx, o));
        mx = fmaxf(mx, 1e-30f); const float inv = 127.f / mx;
        unsigned q[4];
#pragma unroll
        for (int d = 0; d < 4; ++d) q[d] = ((unsigned)__float2int_rn(v[4 * d] * inv) & 0xffu) | (((unsigned)__float2int_rn(v[4 * d + 1] * inv) & 0xffu) << 8) | (((unsigned)__float2int_rn(v[4 * d + 2] * inv) & 0xffu) << 16) | (((unsigned)__float2int_rn(v[4 * d + 3] * inv) & 0xffu) << 24);
        u32x4 o4; o4.x = q[0]; o4.y = q[1]; o4.z = q[2]; o4.w = q[3];
        *(u32x4*)(dst + (size_t)r * D + lane * 16) = o4;
        if (lane == 0) scale[r] = mx * (1.f / 127.f);
    }
}
__device__ __forceinline__ void transpose_item4(const float* src, int Ns, bf16_t* dst, int Kd, int n0, int k0, int dn1, int dk1, int dn2, int dk2, int dn3, int dk3, int perm_lo, int perm_hi, float* tile, float scl = 1.f) {
    const int tid = threadIdx.x;
    const int dnv[4] = {0, dn1, dn2, dn3}, dkv[4] = {0, dk1, dk2, dk3};
    float v[4][8];
#pragma unroll
    for (int t = 0; t < 4; ++t) {
        const int nn = tid & 63; int n = n0 + dnv[t] + nn;
        if (n >= perm_lo && n < perm_hi) { const int rel = n - perm_lo; n = perm_lo + (rel & ~127) + sigma_head(rel & 127); }
#pragma unroll
        for (int i = 0; i < 8; ++i) { const int kk = (tid >> 6) + 8 * i; v[t][i] = scl * src[(size_t)(k0 + dkv[t] + kk) * Ns + n]; }
    }
#pragma unroll
    for (int t = 0; t < 4; ++t)
#pragma unroll
        for (int i = 0; i < 8; ++i) { const int kk = (tid >> 6) + 8 * i; tile[t * 64 * 65 + kk * 65 + (tid & 63)] = v[t][i]; }
    __syncthreads();
#pragma unroll
    for (int t = 0; t < 4; ++t) {
        const int n = tid >> 3, kc = (tid & 7) * 8; const float* tl = tile + t * 64 * 65;
        u32x4 o;
        o.x = pk2(tl[(kc + 0) * 65 + n], tl[(kc + 1) * 65 + n]); o.y = pk2(tl[(kc + 2) * 65 + n], tl[(kc + 3) * 65 + n]);
        o.z = pk2(tl[(kc + 4) * 65 + n], tl[(kc + 5) * 65 + n]); o.w = pk2(tl[(kc + 6) * 65 + n], tl[(kc + 7) * 65 + n]);
        *(u32x4*)(dst + (size_t)(n0 + dnv[t] + n) * Kd + k0 + dkv[t] + kc) = o;
    }
    __syncthreads();
}
__device__ __forceinline__ void transpose_wide(const float* src, int Ns, bf16_t* dst, int Kd, int ng, int kb, int perm_lo, int perm_hi, float* tile) {
    transpose_item4(src, Ns, dst, Kd, ng * 256, kb * 64, 64, 0, 128, 0, 192, 0, perm_lo, perm_hi, tile);
}
__device__ __forceinline__ void cvt_stream(const float* src, bf16_t* dst, size_t n8, size_t gtid, size_t gthreads) {
    for (size_t i = gtid; i < n8; i += gthreads) {
        const f32x4 a = *(const f32x4*)(src + i * 8), b = *(const f32x4*)(src + i * 8 + 4);
        u32x4 o; o.x = pk2(a.x, a.y); o.y = pk2(a.z, a.w); o.z = pk2(b.x, b.y); o.w = pk2(b.z, b.w);
        *(u32x4*)(dst + i * 8) = o;
    }
}
__device__ __forceinline__ void prep_l1_item(const Args& a, float* tile, int r) {
    unsigned char* ws = a.ws;
    constexpr int I_WIN1 = 16 * 10, I_WOUT1 = 20 * 4, I_WQ1 = 16 * 8;
    if (r < I_WIN1) { transpose_wide(a.in[15], 2560, (bf16_t*)(ws + WS_WIN1), 1024, r % 10, r / 10, 0, 0, tile); return; }
    r -= I_WIN1;
    if (r < I_WOUT1) { transpose_wide(a.in[23], 1024, (bf16_t*)(ws + WS_WOUT1), 1280, r % 4, r / 4, 0, 0, tile); return; }
    r -= I_WOUT1;
    if (r < I_WQ1) { transpose_wide(a.in[24] + (size_t)1024 * 2048, 2048, (bf16_t*)(ws + WS_WQ) + (size_t)2048 * 1024, 1024, r % 8, r / 8, 0, 0, tile); return; }
    r -= I_WQ1;
    { const int which = r / 20, dh = r % 20;
        const float* src = a.in[which == 0 ? 18 : 20] + (size_t)dh * 128 * 128;
        bf16_t* dst = (bf16_t*)(ws + (which == 0 ? WS_WAT : WS_WXT)) + (size_t)dh * 128 * 128;
        transpose_item4(src, 128, dst, 128, 0, 0, 64, 0, 0, 64, 64, 64, 0, 0, tile, -1.4426950408889634f);
    }
}
constexpr int N_L1_ITEMS = 160 + 80 + 128 + 40;
__device__ __forceinline__ void phase_prep(const Args& a, char* lds) {
    const int tid = threadIdx.x, lane = tid & 63, wid = tid >> 6;
    float* tile = (float*)lds;
    unsigned char* ws = a.ws;
    constexpr int I_MOD = 192;
    constexpr int I_WIN0 = 16 * 8, I_WOUT0 = 16 * 4, I_WQ0 = 16 * 8;
    constexpr int NIT = I_MOD + I_WIN0 + I_WOUT0 + I_WQ0;
    for (int it = blockIdx.x; it < NIT; it += gridDim.x) {
        int r = it;
        if (r < I_MOD) {
            const int l = r / 96, n0 = (r % 96) * 64;
            const float* W = a.in[4] + (size_t)l * D * 6144;
            float s0 = 0.f, s1 = 0.f, s2 = 0.f;
            float sl[3][2];
#pragma unroll
            for (int h = 0; h < 2; ++h) { const int k = wid * 128 + h * 64 + lane; const float c0 = a.in[1][k], c1 = a.in[1][D + k], c2 = a.in[3][k];
                sl[0][h] = c0 * sigmoidf_(c0); sl[1][h] = c1 * sigmoidf_(c1); sl[2][h] = c2 * sigmoidf_(c2); }
            const float* Wp = W + (size_t)(wid * 128) * 6144 + n0 + lane;
#pragma unroll
            for (int kk = 0; kk < 128; kk += 16) {
                float w[16];
#pragma unroll
                for (int j = 0; j < 16; ++j) w[j] = Wp[(size_t)(kk + j) * 6144];
#pragma unroll
                for (int j = 0; j < 16; ++j) { const int kq = kk + j;
                    s0 += __shfl(sl[0][kq >> 6], kq & 63) * w[j]; s1 += __shfl(sl[1][kq >> 6], kq & 63) * w[j]; s2 += __shfl(sl[2][kq >> 6], kq & 63) * w[j]; }
            }
            tile[(wid * 3 + 0) * 64 + lane] = s0; tile[(wid * 3 + 1) * 64 + lane] = s1; tile[(wid * 3 + 2) * 64 + lane] = s2;
            __syncthreads();
            if (tid < 192) {
                const int v = tid / 64, ln = tid & 63; float s = a.in[5][(size_t)l * 6144 + n0 + ln];
                for (int w = 0; w < 8; ++w) s += tile[(w * 3 + v) * 64 + ln];
                ((float*)(ws + WS_MODV))[(size_t)(l * 3 + v) * 6144 + n0 + ln] = s;
            }
            __syncthreads();
            continue;
        }
        r -= I_MOD;
        if (r < I_WIN0) { transpose_wide(a.in[8], 2048, (bf16_t*)(ws + WS_WIN0), 1024, r % 8, r / 8, 1024, 1792, tile); continue; }
        r -= I_WIN0;
        if (r < I_WOUT0) { transpose_wide(a.in[14], 1024, (bf16_t*)(ws + WS_WOUT0), 1024, r % 4, r / 4, 0, 0, tile); continue; }
        r -= I_WOUT0;
        transpose_wide(a.in[24], 2048, (bf16_t*)(ws + WS_WQ), 1024, r % 8, r / 8, 0, 0, tile);
    }
    const size_t gtid = (size_t)blockIdx.x * NTHR + tid, gthreads = (size_t)gridDim.x * NTHR;
    cvt_stream(a.in[25], (bf16_t*)(ws + WS_KEYS), (size_t)2 * 8 * 2 * 128 * 128 / 8, gtid, gthreads);
    cvt_stream(a.in[10], (bf16_t*)(ws + WS_GWS), (size_t)4 * 128 * 128 / 8, gtid, gthreads);
    for (size_t i = gtid; i < 128 * 32; i += gthreads) {
        const int pos = (int)(i / 32), f = (int)(i % 32);
        const float inv = powf(10000.f, -(float)f / 32.f); const float ang = (float)pos * inv;
        float* R = (float*)(ws + WS_ROPE); R[i * 2] = cosf(ang); R[i * 2 + 1] = sinf(ang);
    }
}

__device__ __forceinline__ void norm_row_store(const f32x4 (&v)[4], const float* g, const float* sh, const float* sc, bf16_t* orow, int lane, unsigned char* q8row = nullptr, float* q8scale = nullptr) {
    float s = 0.f;
#pragma unroll
    for (int j = 0; j < 4; ++j) s += (v[j].x * v[j].x + v[j].y * v[j].y) + (v[j].z * v[j].z + v[j].w * v[j].w);
    const float rinv = rsqrtf(wave_sum(s) * (1.f / D) + EPS);
    f32x4 o[4]; float mx = 0.f;
#pragma unroll
    for (int j = 0; j < 4; ++j) {
        const int c = j * 256 + lane * 4;
        const f32x4 gg = *(const f32x4*)(g + c), s1 = *(const f32x4*)(sh + c), s2 = *(const f32x4*)(sc + c);
        o[j].x = v[j].x * rinv * gg.x * (1.f + s2.x) + s1.x; o[j].y = v[j].y * rinv * gg.y * (1.f + s2.y) + s1.y;
        o[j].z = v[j].z * rinv * gg.z * (1.f + s2.z) + s1.z; o[j].w = v[j].w * rinv * gg.w * (1.f + s2.w) + s1.w;
        if (!q8row) { u32x2 w; w.x = pk2(o[j].x, o[j].y); w.y = pk2(o[j].z, o[j].w); *(u32x2*)(orow + c) = w; }
        mx = fmaxf(fmaxf(fmaxf(fabsf(o[j].x), fabsf(o[j].y)), fmaxf(fabsf(o[j].z), fabsf(o[j].w))), mx);
    }
    if (q8row) {
#pragma unroll
        for (int of = 1; of < 64; of <<= 1) mx = fmaxf(mx, __shfl_xor(mx, of));
        mx = fmaxf(mx, 1e-30f); const float inv = 119.f / mx;
#pragma unroll
        for (int j = 0; j < 4; ++j) {
            const unsigned b0 = (unsigned)__float2int_rn(o[j].x * inv) & 0xffu, b1 = (unsigned)__float2int_rn(o[j].y * inv) & 0xffu;
            const unsigned b2 = (unsigned)__float2int_rn(o[j].z * inv) & 0xffu, b3 = (unsigned)__float2int_rn(o[j].w * inv) & 0xffu;
            *(unsigned*)(q8row + j * 256 + lane * 4) = b0 | (b1 << 8) | (b2 << 16) | (b3 << 24);
        }
        if (lane == 0) *q8scale = mx * (1.f / 119.f);
    }
}
__device__ __forceinline__ void phase_norm(const Args& a, int layer, int src_mode, const float* gain, int which_sh, int which_sc, bool latent_only, bool wq8 = false, size_t h8off = WS_H8) {
    const int lane = threadIdx.x & 63, gw = blockIdx.x * NWAVE + (threadIdx.x >> 6), ngw = gridDim.x * NWAVE;
    bf16_t* H = (bf16_t*)(a.ws + WS_H);
    const bf16_t* X1 = (const bf16_t*)(a.ws + WS_X1);
    for (int g = gw; g < MTOT; g += ngw) {
        const int var = row_variant(g);
        if (latent_only && var == 2) continue;
        f32x4 v[4];
        if (src_mode == 0) { const float* xr = row_src(a, g);
#pragma unroll
            for (int j = 0; j < 4; ++j) v[j] = *(const f32x4*)(xr + j * 256 + lane * 4);
        } else { const bf16_t* xr = X1 + (size_t)g * D;
#pragma unroll
            for (int j = 0; j < 4; ++j) { const u32x2 w = *(const u32x2*)(xr + j * 256 + lane * 4); v[j] = f32x4{bflo(w.x), bfhi(w.x), bflo(w.y), bfhi(w.y)}; }
        }
        norm_row_store(v, gain, modv(a, layer, var, which_sh), modv(a, layer, var, which_sc), H + (size_t)g * D, lane, wq8 ? a.ws + h8off + (size_t)g * D : nullptr, wq8 ? (float*)(a.ws + WS_SH) + g : nullptr);
    }
}

__device__ __forceinline__ void phase_gmlp2(const Args& a, char* lds) {
    const int tid = threadIdx.x, lane = tid & 63, wid = __builtin_amdgcn_readfirstlane(tid >> 6), r32 = lane & 31, hh = lane >> 5;
    unsigned char* ws = a.ws;
    LAS bf16_t* vT = (LAS bf16_t*)((LAS char*)lds);
    const bf16_t* VV = (const bf16_t*)(ws + WS_VV); const bf16_t* U = (const bf16_t*)(ws + WS_U); bf16_t* AO = (bf16_t*)(ws + WS_AO);
    const bf16_t* GWS = (const bf16_t*)(ws + WS_GWS);
    const int NU = (MTOT / 128) * 4;
    const int gskip = gridDim.x > 64 ? 8 : 0;
    if ((int)blockIdx.x < gskip) return;
    for (int u = blockIdx.x - gskip; u < NU; u += gridDim.x - gskip) {
        const int ch = u >> 2, g = u & 3, row0 = ch * 128;
        const int mb = wid >> 1, nb0 = (wid & 1) * 2;
        u32x4 vw[4];
#pragma unroll
        for (int i = 0; i < 4; ++i) { const int q = (tid >> 4) + 32 * i, c0 = (tid & 15) * 8; vw[i] = *(const u32x4*)(VV + (size_t)(row0 + q) * 512 + g * 128 + c0); }
        bf16_t uv0[16], uv1[16]; float bsr[16];
#pragma unroll
        for (int r = 0; r < 16; ++r) {
            const int p = mb * 32 + (r & 3) + 8 * (r >> 2) + 4 * hh;
            const size_t ub = (size_t)(row0 + p) * 512 + g * 128;
            uv0[r] = U[ub + nb0 * 32 + r32]; uv1[r] = U[ub + nb0 * 32 + 32 + r32]; bsr[r] = a.in[11][g * 128 + p];
        }
#pragma unroll
        for (int i = 0; i < 4; ++i) {
            const int q = (tid >> 4) + 32 * i, c0 = (tid & 15) * 8;
            const u32x4 w = vw[i];
            vT[(c0 + 0) * 136 + q] = (bf16_t)(w.x & 0xffffu); vT[(c0 + 1) * 136 + q] = (bf16_t)(w.x >> 16);
            vT[(c0 + 2) * 136 + q] = (bf16_t)(w.y & 0xffffu); vT[(c0 + 3) * 136 + q] = (bf16_t)(w.y >> 16);
            vT[(c0 + 4) * 136 + q] = (bf16_t)(w.z & 0xffffu); vT[(c0 + 5) * 136 + q] = (bf16_t)(w.z >> 16);
            vT[(c0 + 6) * 136 + q] = (bf16_t)(w.w & 0xffffu); vT[(c0 + 7) * 136 + q] = (bf16_t)(w.w >> 16);
        }
        __syncthreads();
        f32x16 acc0 = {}, acc1 = {};
        {
            unsigned aoff = (unsigned)((mb * 32 + r32) * 128 + 8 * hh); asm volatile("" : "+v"(aoff));
            const bf16_t* wsg = GWS + (size_t)g * 128 * 128;
#pragma unroll
            for (int ks = 0; ks < 8; ++ks) {
                const bf16x8 af = *(const bf16x8*)(wsg + aoff + ks * 16);
                const bf16x8 b0 = *(const LAS bf16x8*)(vT + (nb0 * 32 + r32) * 136 + ks * 16 + 8 * hh);
                const bf16x8 b1 = *(const LAS bf16x8*)(vT + ((nb0 + 1) * 32 + r32) * 136 + ks * 16 + 8 * hh);
                acc0 = __builtin_amdgcn_mfma_f32_32x32x16_bf16(af, b0, acc0, 0, 0, 0);
                acc1 = __builtin_amdgcn_mfma_f32_32x32x16_bf16(af, b1, acc1, 0, 0, 0);
            }
        }
#pragma unroll
        for (int r = 0; r < 16; ++r) {
            const int p = mb * 32 + (r & 3) + 8 * (r >> 2) + 4 * hh;
            const float bsv = bsr[r];
            const size_t ob = (size_t)(row0 + p) * 1024 + g * 128;
            const int c0 = nb0 * 32 + r32, c1 = c0 + 32;
            AO[ob + c0] = (bf16_t)f2bf(bf2f(uv0[r]) * (acc0[r] + bsv));
            AO[ob + c1] = (bf16_t)f2bf(bf2f(uv1[r]) * (acc1[r] + bsv));
        }
        __syncthreads();
    }
}

namespace fa {
typedef short s16x4 __attribute__((ext_vector_type(4)));
constexpr int QBLK = 32, KVBLK = 64, LDQ = 512, LDK = 128, LDO = 1024;
constexpr float SCALE = 0.088388347648318440f, THR = 8.f;
constexpr size_t SHM_V = KVBLK * 128 * 2, SHM_K = KVBLK * 128 * 2, SHM_ATTN = 2 * SHM_V + 2 * SHM_K + NWAVE * 64 * 4;
#define KSWZ(row, colB) ((row) * 256 + ((colB) ^ (((row) & 7) << 4)))
#define SBAR() __builtin_amdgcn_sched_barrier(0)
__device__ __forceinline__ int crow(int r, int hi) { return (r & 3) + 8 * (r >> 2) + 4 * hi; }
__device__ __forceinline__ unsigned cvtpk(float lo, float hi) { unsigned r; asm volatile("v_cvt_pk_bf16_f32 %0, %1, %2" : "=v"(r) : "v"(lo), "v"(hi)); return r; }
__device__ __forceinline__ void partialSM(f32x16& p0, f32x16& p1, float& m_reg, float& mn, float& alpha) {
  constexpr float C = SCALE * 1.4426950408889634f;
  float pmax = p0[0]; for (int r = 1; r < 16; ++r) pmax = fmaxf(pmax, p0[r]); for (int r = 0; r < 16; ++r) pmax = fmaxf(pmax, p1[r]);
  { auto rr = __builtin_amdgcn_permlane32_swap(__float_as_uint(pmax), __float_as_uint(pmax), false, false);
    pmax = fmaxf(__uint_as_float(rr[0]), __uint_as_float(rr[1])); }
  if (__builtin_expect(__all(pmax - m_reg <= THR / SCALE), 1)) { mn = m_reg; alpha = 1.f; }
  else { mn = fmaxf(m_reg, pmax); alpha = __builtin_amdgcn_exp2f((m_reg - mn) * C); m_reg = mn; }
  float mnC = -mn * C;
  for (int r = 0; r < 16; ++r) p0[r] = fmaf(p0[r], C, mnC); for (int r = 0; r < 16; ++r) p1[r] = fmaf(p1[r], C, mnC);
  for (int r = 0; r < 16; ++r) p0[r] = __builtin_amdgcn_exp2f(p0[r]);
}
__device__ __forceinline__ void finishSM(f32x16& p0, f32x16& p1, float alpha, float& l_reg, bf16x8& pa0, bf16x8& pa1, bf16x8& pa2, bf16x8& pa3) {
  for (int r = 0; r < 16; ++r) p1[r] = __builtin_amdgcn_exp2f(p1[r]);
  float ps = 0; for (int r = 0; r < 16; ++r) ps += p0[r]; for (int r = 0; r < 16; ++r) ps += p1[r];
  { auto rr = __builtin_amdgcn_permlane32_swap(__float_as_uint(ps), __float_as_uint(ps), false, false);
    ps = __uint_as_float(rr[0]) + __uint_as_float(rr[1]); }
  l_reg = l_reg * alpha + ps;
#define PK4(P, BASE, OUT) do { unsigned a0 = cvtpk(P[BASE + 0], P[BASE + 1]), a1 = cvtpk(P[BASE + 2], P[BASE + 3]);   \
    unsigned b0 = cvtpk(P[BASE + 4], P[BASE + 5]), b1 = cvtpk(P[BASE + 6], P[BASE + 7]);                              \
    auto r0 = __builtin_amdgcn_permlane32_swap(a0, b0, false, false); auto r1 = __builtin_amdgcn_permlane32_swap(a1, b1, false, false); \
    u32x4 w = {r0[0], r1[0], r0[1], r1[1]}; OUT = *reinterpret_cast<bf16x8*>(&w); } while (0)
  PK4(p0, 0, pa0); PK4(p0, 8, pa1); PK4(p1, 0, pa2); PK4(p1, 8, pa3);
#undef PK4
}
__device__ __forceinline__ void qkt(f32x16& p0, f32x16& p1, const bf16_t* Ks, const bf16x8* qr, int r32, int hi) {
  p0 = f32x16{}; p1 = f32x16{};
  for (int d0 = 0; d0 < 8; ++d0) { int cb = (d0 * 16 + hi * 8) * 2;
    bf16x8 b0 = *reinterpret_cast<const bf16x8*>((const char*)Ks + KSWZ(r32, cb));
    bf16x8 b1 = *reinterpret_cast<const bf16x8*>((const char*)Ks + KSWZ(32 + r32, cb));
    p0 = __builtin_amdgcn_mfma_f32_32x32x16_bf16(b0, qr[d0], p0, 0, 0, 0);
    p1 = __builtin_amdgcn_mfma_f32_32x32x16_bf16(b1, qr[d0], p1, 0, 0, 0); }
}
__device__ __forceinline__ int v_st(int k, int c) { const int kk = (k & ~0xC) | ((k & 4) << 1) | ((k & 8) >> 1); return ((kk >> 3) * 4 + (c >> 5)) * 512 + ((kk & 7) * 32 + (c & 31)) * 2; }
__device__ __forceinline__ int v_rd_base(int lane) { return ((lane & 3) << 3) | (((lane >> 2) & 3) << 6) | (((lane >> 4) & 1) << 5) | (((lane >> 5) & 1) << 8); }
constexpr int v_rd_off(int d0, int ks, int half) { return d0 * 512 + ks * 4096 + half * 2048; }
template <int OFF> __device__ __forceinline__ s16x4 tr_read(int vb) {
  s16x4 r; asm volatile("ds_read_b64_tr_b16 %0, %1 offset:%2" : "=&v"(r) : "v"(vb), "i"(OFF) : "memory"); return r;
}
template <int D0> __device__ __forceinline__ void pv_one(f32x16& od, int vb, bf16x8 pa0, bf16x8 pa1, bf16x8 pa2, bf16x8 pa3) {
  const s16x4 l0 = tr_read<v_rd_off(D0, 0, 0)>(vb), h0 = tr_read<v_rd_off(D0, 0, 1)>(vb), l1 = tr_read<v_rd_off(D0, 1, 0)>(vb), h1 = tr_read<v_rd_off(D0, 1, 1)>(vb);
  const s16x4 l2 = tr_read<v_rd_off(D0, 2, 0)>(vb), h2 = tr_read<v_rd_off(D0, 2, 1)>(vb), l3 = tr_read<v_rd_off(D0, 3, 0)>(vb), h3 = tr_read<v_rd_off(D0, 3, 1)>(vb);
  asm volatile("s_waitcnt lgkmcnt(0)" ::: "memory"); SBAR();
#define PK(L, H) (bf16x8){L[0], L[1], L[2], L[3], H[0], H[1], H[2], H[3]}
  od = __builtin_amdgcn_mfma_f32_32x32x16_bf16(pa0, PK(l0, h0), od, 0, 0, 0);
  od = __builtin_amdgcn_mfma_f32_32x32x16_bf16(pa1, PK(l1, h1), od, 0, 0, 0);
  od = __builtin_amdgcn_mfma_f32_32x32x16_bf16(pa2, PK(l2, h2), od, 0, 0, 0);
  od = __builtin_amdgcn_mfma_f32_32x32x16_bf16(pa3, PK(l3, h3), od, 0, 0, 0);
#undef PK
}
__device__ __forceinline__ void pv_d0(f32x16* o, int vb, bf16x8 pa0, bf16x8 pa1, bf16x8 pa2, bf16x8 pa3) {
  pv_one<0>(o[0], vb, pa0, pa1, pa2, pa3); pv_one<1>(o[1], vb, pa0, pa1, pa2, pa3); pv_one<2>(o[2], vb, pa0, pa1, pa2, pa3); pv_one<3>(o[3], vb, pa0, pa1, pa2, pa3);
}
__device__ __forceinline__ void attn_dense_body(const bf16_t* __restrict__ Qb, const bf16_t* __restrict__ Kh, const bf16_t* __restrict__ Vh,
                                                bf16_t* __restrict__ Ob, int seq, char* lds) {
  const int tid = threadIdx.x, wid = tid >> 6, lane = tid & 63, r32 = lane & 31, hi = lane >> 5;
  bf16_t* V_lds = (bf16_t*)lds; bf16_t* K_lds = (bf16_t*)(lds + 2 * SHM_V);
  float* ws = (float*)(lds + 2 * SHM_V + 2 * SHM_K) + wid * 64; float* li_l = ws; float* al_l = ws + 32;
  float m_reg = -1e30f, l_reg = 0; f32x16 o[4] = {}; bf16x8 qr[8];
  const bf16_t* Qw = Qb + (long)(wid * QBLK + r32) * LDQ + hi * 8;
#pragma unroll
  for (int d0 = 0; d0 < 8; ++d0) qr[d0] = *reinterpret_cast<const bf16x8*>(Qw + d0 * 16);
  const int sr = tid >> 4, sc = (tid & 15) * 8, vst0 = v_st(sr, sc), vst1 = v_st(32 + sr, sc);
  const int vb0 = (int)(uintptr_t)V_lds + v_rd_base(lane);
  struct { bf16x8 vs0, vs1, ks0, ks1; } sr_[2];
#define SLOAD(i, k0) do { sr_[i].vs0 = *reinterpret_cast<const bf16x8*>(&Vh[(long)((k0) + sr) * LDK + sc]); sr_[i].vs1 = *reinterpret_cast<const bf16x8*>(&Vh[(long)((k0) + 32 + sr) * LDK + sc]); \
    sr_[i].ks0 = *reinterpret_cast<const bf16x8*>(&Kh[(long)((k0) + sr) * LDK + sc]); sr_[i].ks1 = *reinterpret_cast<const bf16x8*>(&Kh[(long)((k0) + 32 + sr) * LDK + sc]); } while (0)
#define SWRITE(b, i) do { *(bf16x8*)((char*)V_lds + (b) * SHM_V + vst0) = sr_[i].vs0;          \
    *(bf16x8*)((char*)V_lds + (b) * SHM_V + vst1) = sr_[i].vs1; int kc = sc * 2;               \
    *(bf16x8*)((char*)K_lds + (b) * SHM_K + KSWZ(sr, kc)) = sr_[i].ks0;                       \
    *(bf16x8*)((char*)K_lds + (b) * SHM_K + KSWZ(32 + sr, kc)) = sr_[i].ks1; } while (0)
#define SWAIT() asm volatile("s_waitcnt vmcnt(4)" ::: "memory")
#define RESC(a) do { if (__any((a) < 1.f)) { if (hi == 0) al_l[r32] = (a); asm volatile("s_waitcnt lgkmcnt(0)" ::: "memory"); \
    for (int d = 0; d < 4; ++d) for (int r = 0; r < 16; ++r) o[d][r] *= al_l[crow(r, hi)]; } } while (0)
  f32x16 pA0, pA1, pB0, pB1; float mnA, mnB, alA, alB; bf16x8 pa0, pa1, pa2, pa3; const int NT = seq / KVBLK;
  constexpr int SE = 0, SO = 1;
  SLOAD(SE, 0); asm volatile("s_waitcnt vmcnt(0)" ::: "memory"); SWRITE(0, SE); __syncthreads();
  qkt(pA0, pA1, K_lds, qr, r32, hi); partialSM(pA0, pA1, m_reg, mnA, alA);
  SLOAD(SO, KVBLK); if (2 < NT) SLOAD(SE, 2 * KVBLK);
  SWAIT(); SWRITE(1, SO); __syncthreads();
  for (int j = 1; j + 1 < NT; j += 2) {
    SBAR(); qkt(pB0, pB1, (bf16_t*)((char*)K_lds + SHM_K), qr, r32, hi);
    finishSM(pA0, pA1, alA, l_reg, pa0, pa1, pa2, pa3); SBAR();
    SLOAD(SO, (j + 2) * KVBLK); SBAR();
    pv_d0(o, vb0, pa0, pa1, pa2, pa3); partialSM(pB0, pB1, m_reg, mnB, alB);
    __syncthreads(); SWAIT(); SWRITE(0, SE);
    RESC(alB); __syncthreads();
    SBAR(); qkt(pA0, pA1, K_lds, qr, r32, hi);
    finishSM(pB0, pB1, alB, l_reg, pa0, pa1, pa2, pa3); SBAR();
    if (j + 3 < NT) SLOAD(SE, (j + 3) * KVBLK); SBAR();
    pv_d0(o, vb0 + (int)SHM_V, pa0, pa1, pa2, pa3); partialSM(pA0, pA1, m_reg, mnA, alA);
    __syncthreads(); SWAIT(); SWRITE(1, SO);
    RESC(alA); __syncthreads();
  }
  SBAR(); qkt(pB0, pB1, (bf16_t*)((char*)K_lds + SHM_K), qr, r32, hi);
  finishSM(pA0, pA1, alA, l_reg, pa0, pa1, pa2, pa3); SBAR();
  pv_d0(o, vb0, pa0, pa1, pa2, pa3); partialSM(pB0, pB1, m_reg, mnB, alB);
  __syncthreads(); RESC(alB);
  finishSM(pB0, pB1, alB, l_reg, pa0, pa1, pa2, pa3); SBAR();
  pv_d0(o, vb0 + (int)SHM_V, pa0, pa1, pa2, pa3);
  if (hi == 0) li_l[r32] = l_reg; asm volatile("s_waitcnt lgkmcnt(0)" ::: "memory");
  float rli[16];
#pragma unroll
  for (int r = 0; r < 16; ++r) rli[r] = __builtin_amdgcn_rcpf(li_l[crow(r, hi)]);
  bf16_t* Ow = Ob + (long)(wid * QBLK) * LDO;
#pragma unroll
  for (int r = 0; r < 16; ++r) { int orow = crow(r, hi);
    for (int d0 = 0; d0 < 4; ++d0) Ow[(long)orow * LDO + d0 * 32 + r32] = (bf16_t)f2bf(o[d0][r] * rli[r]); }
  __syncthreads();
#undef SLOAD
#undef SWRITE
#undef SWAIT
#undef RESC
}
#undef KSWZ
#undef SBAR
}

__device__ __forceinline__ void phase_attn(const Args& a, char* lds) {
    unsigned char* ws = a.ws;
    const bf16_t* Q = (const bf16_t*)(ws + WS_Q); const bf16_t* Kb = (const bf16_t*)(ws + WS_K); const bf16_t* Vb = (const bf16_t*)(ws + WS_V);
    bf16_t* AO = (bf16_t*)(ws + WS_AO);
    const int NU = 256 + 8;
    for (int u = blockIdx.x; u < NU; u += gridDim.x) {
        int b, h, qrow0, nkeys;
        if (u < 256) { const int x = u & 7; b = x >> 2; h = x & 3; qrow0 = b * RPB + CTXL + (u >> 3) * 256; nkeys = RPB; }
        else { const int v = u - 256; b = v / 4; h = v % 4; qrow0 = b * RPB; nkeys = CTXL; }
        const int kvh = h >> 1; const size_t krow0 = (size_t)(b * 2 + kvh) * RPB;
        fa::attn_dense_body(Q + (size_t)qrow0 * 512 + h * 128, Kb + krow0 * 128, Vb + krow0 * 128, AO + (size_t)qrow0 * 1024 + 512 + h * 128, nkeys, lds);
    }
}

constexpr int TK_LD = 136;
__device__ __forceinline__ int peer_tok(int i, int mode);
namespace tk {
__device__ __forceinline__ void ce(float& a, float& b) { const float mx = __builtin_fmaxf(a, b), mn = __builtin_fminf(a, b); a = mx; b = mn; }
__device__ __forceinline__ void sort16_desc(float (&v)[16]) {
#define TKC(i, j) ce(v[i], v[j]);
    TKC(0,13) TKC(1,12) TKC(2,15) TKC(3,14) TKC(4,8) TKC(5,6) TKC(7,11) TKC(9,10)
    TKC(0,5) TKC(1,7) TKC(2,9) TKC(3,4) TKC(6,13) TKC(8,14) TKC(10,15) TKC(11,12)
    TKC(0,1) TKC(2,3) TKC(4,5) TKC(6,8) TKC(7,9) TKC(10,11) TKC(12,13) TKC(14,15)
    TKC(0,2) TKC(1,3) TKC(4,10) TKC(5,11) TKC(6,7) TKC(8,9) TKC(12,14) TKC(13,15)
    TKC(1,2) TKC(3,12) TKC(4,6) TKC(5,7) TKC(8,10) TKC(9,11) TKC(13,14)
    TKC(1,4) TKC(2,6) TKC(5,8) TKC(7,10) TKC(9,13) TKC(11,14)
    TKC(2,4) TKC(3,6) TKC(9,12) TKC(11,13)
    TKC(3,5) TKC(6,8) TKC(7,9) TKC(10,12)
    TKC(3,4) TKC(5,6) TKC(7,8) TKC(9,10) TKC(11,12)
    TKC(6,7) TKC(8,9)
#undef TKC
}
__device__ __forceinline__ void merge16_desc(float (&v)[16]) {
#pragma unroll
    for (int js = 3; js >= 0; --js)
#pragma unroll
        for (int i = 0; i < 16; ++i) { const int j = 1 << js, l = i ^ j; if (l > i) ce(v[i], v[l]); }
}
__device__ __forceinline__ void merge_prune(float (&x)[16], const float (&y)[16]) {
#pragma unroll
    for (int i = 0; i < 16; ++i) x[i] = __builtin_fmaxf(x[i], y[15 - i]);
    merge16_desc(x);
}
__host__ __device__ constexpr bool pair_ok(int i, int j) { return (i + 1) * (j + 1) <= 16; }
__host__ __device__ constexpr int pair_index(int i, int j) { int n = 0; for (int a = 0; a < 16; ++a) for (int b = 0; b < 16; ++b) { if (a == i && b == j) return n; if (pair_ok(a, b)) ++n; } return n; }
static_assert(pair_index(15, 15) == 49 + 0 || true, "");
}
__device__ __forceinline__ void topk_stage2(const float (&top)[2][16], int* SELI, float* SELG, int g0, int h, int r32, int hh) {
    float X[16], Y[16];
    X[0] = __uint_as_float((__float_as_uint((hh ? top[0][3] : top[0][0]) + (hh ? top[1][3] : top[1][0])) & ~255u) | (hh ? 51u : 0u));
    Y[0] = __uint_as_float((__float_as_uint((hh ? top[0][14] : top[0][1]) + (hh ? top[1][0] : top[1][0])) & ~255u) | (hh ? 224u : 16u));
    X[1] = __uint_as_float((__float_as_uint((hh ? top[0][4] : top[0][0]) + (hh ? top[1][0] : top[1][1])) & ~255u) | (hh ? 64u : 1u));
    Y[1] = __uint_as_float((__float_as_uint((hh ? top[0][15] : top[0][1]) + (hh ? top[1][0] : top[1][1])) & ~255u) | (hh ? 240u : 17u));
    X[2] = __uint_as_float((__float_as_uint((hh ? top[0][4] : top[0][0]) + (hh ? top[1][1] : top[1][2])) & ~255u) | (hh ? 65u : 2u));
    Y[2] = (hh ? -INFINITY : __uint_as_float((__float_as_uint(top[0][1] + top[1][2]) & ~255u) | 18u));
    X[3] = __uint_as_float((__float_as_uint((hh ? top[0][4] : top[0][0]) + (hh ? top[1][2] : top[1][3])) & ~255u) | (hh ? 66u : 3u));
    Y[3] = (hh ? -INFINITY : __uint_as_float((__float_as_uint(top[0][1] + top[1][3]) & ~255u) | 19u));
    X[4] = __uint_as_float((__float_as_uint((hh ? top[0][5] : top[0][0]) + (hh ? top[1][0] : top[1][4])) & ~255u) | (hh ? 80u : 4u));
    Y[4] = (hh ? -INFINITY : __uint_as_float((__float_as_uint(top[0][1] + top[1][4]) & ~255u) | 20u));
    X[5] = __uint_as_float((__float_as_uint((hh ? top[0][5] : top[0][0]) + (hh ? top[1][1] : top[1][5])) & ~255u) | (hh ? 81u : 5u));
    Y[5] = (hh ? -INFINITY : __uint_as_float((__float_as_uint(top[0][1] + top[1][5]) & ~255u) | 21u));
    X[6] = __uint_as_float((__float_as_uint((hh ? top[0][6] : top[0][0]) + (hh ? top[1][0] : top[1][6])) & ~255u) | (hh ? 96u : 6u));
    Y[6] = (hh ? -INFINITY : __uint_as_float((__float_as_uint(top[0][1] + top[1][6]) & ~255u) | 22u));
    X[7] = __uint_as_float((__float_as_uint((hh ? top[0][6] : top[0][0]) + (hh ? top[1][1] : top[1][7])) & ~255u) | (hh ? 97u : 7u));
    Y[7] = (hh ? -INFINITY : __uint_as_float((__float_as_uint(top[0][1] + top[1][7]) & ~255u) | 23u));
    X[8] = __uint_as_float((__float_as_uint((hh ? top[0][7] : top[0][0]) + (hh ? top[1][0] : top[1][8])) & ~255u) | (hh ? 112u : 8u));
    Y[8] = (hh ? -INFINITY : __uint_as_float((__float_as_uint(top[0][2] + top[1][0]) & ~255u) | 32u));
    X[9] = __uint_as_float((__float_as_uint((hh ? top[0][7] : top[0][0]) + (hh ? top[1][1] : top[1][9])) & ~255u) | (hh ? 113u : 9u));
    Y[9] = (hh ? -INFINITY : __uint_as_float((__float_as_uint(top[0][2] + top[1][1]) & ~255u) | 33u));
    X[10] = __uint_as_float((__float_as_uint((hh ? top[0][8] : top[0][0]) + (hh ? top[1][0] : top[1][10])) & ~255u) | (hh ? 128u : 10u));
    Y[10] = (hh ? -INFINITY : __uint_as_float((__float_as_uint(top[0][2] + top[1][2]) & ~255u) | 34u));
    X[11] = __uint_as_float((__float_as_uint((hh ? top[0][9] : top[0][0]) + (hh ? top[1][0] : top[1][11])) & ~255u) | (hh ? 144u : 11u));
    Y[11] = (hh ? -INFINITY : __uint_as_float((__float_as_uint(top[0][2] + top[1][3]) & ~255u) | 35u));
    X[12] = __uint_as_float((__float_as_uint((hh ? top[0][10] : top[0][0]) + (hh ? top[1][0] : top[1][12])) & ~255u) | (hh ? 160u : 12u));
    Y[12] = (hh ? -INFINITY : __uint_as_float((__float_as_uint(top[0][2] + top[1][4]) & ~255u) | 36u));
    X[13] = __uint_as_float((__float_as_uint((hh ? top[0][11] : top[0][0]) + (hh ? top[1][0] : top[1][13])) & ~255u) | (hh ? 176u : 13u));
    Y[13] = (hh ? -INFINITY : __uint_as_float((__float_as_uint(top[0][3] + top[1][0]) & ~255u) | 48u));
    X[14] = __uint_as_float((__float_as_uint((hh ? top[0][12] : top[0][0]) + (hh ? top[1][0] : top[1][14])) & ~255u) | (hh ? 192u : 14u));
    Y[14] = (hh ? -INFINITY : __uint_as_float((__float_as_uint(top[0][3] + top[1][1]) & ~255u) | 49u));
    X[15] = __uint_as_float((__float_as_uint((hh ? top[0][13] : top[0][0]) + (hh ? top[1][0] : top[1][15])) & ~255u) | (hh ? 208u : 15u));
    Y[15] = (hh ? -INFINITY : __uint_as_float((__float_as_uint(top[0][3] + top[1][2]) & ~255u) | 50u));
    tk::sort16_desc(X); __builtin_amdgcn_sched_barrier(0); tk::sort16_desc(Y); __builtin_amdgcn_sched_barrier(0);
    tk::merge_prune(X, Y); __builtin_amdgcn_sched_barrier(0);
#pragma unroll
    for (int r = 0; r < 16; ++r) { const auto rr = __builtin_amdgcn_permlane32_swap(__float_as_uint(X[r]), __float_as_uint(X[r]), false, false); Y[r] = __uint_as_float(hh == 0 ? rr[1] : rr[0]); }
    tk::merge_prune(X, Y); __builtin_amdgcn_sched_barrier(0);
    const float vmax = X[0];
    int eidx[8]; float ev[8]; float sum = 0.f;
    unsigned pa[4], pb[4];
#pragma unroll
    for (int q = 0; q < 4; ++q) {
        pa[q] = (__float_as_uint(top[0][4 * q]) & 127u) | ((__float_as_uint(top[0][4 * q + 1]) & 127u) << 8) | ((__float_as_uint(top[0][4 * q + 2]) & 127u) << 16) | ((__float_as_uint(top[0][4 * q + 3]) & 127u) << 24);
        pb[q] = (__float_as_uint(top[1][4 * q]) & 127u) | ((__float_as_uint(top[1][4 * q + 1]) & 127u) << 8) | ((__float_as_uint(top[1][4 * q + 2]) & 127u) << 16) | ((__float_as_uint(top[1][4 * q + 3]) & 127u) << 24);
    }
#pragma unroll
    for (int rr = 0; rr < 8; ++rr) {
        const float v = hh ? X[8 + rr] : X[rr];
        const unsigned bits = __float_as_uint(v); const unsigned ci = (bits >> 4) & 15u, cj = bits & 15u;
        const unsigned sa_ = (ci & 7u) | 0x0c0c0c00u, sb_ = (cj & 7u) | 0x0c0c0c00u;
        const unsigned ia = (ci & 8u) ? __builtin_amdgcn_perm(pa[3], pa[2], sa_) : __builtin_amdgcn_perm(pa[1], pa[0], sa_);
        const unsigned ib = (cj & 8u) ? __builtin_amdgcn_perm(pb[3], pb[2], sb_) : __builtin_amdgcn_perm(pb[1], pb[0], sb_);
        eidx[rr] = (int)(ia * 128u + ib);
        ev[rr] = __expf(v - vmax); sum += ev[rr];
    }
    { const auto rr = __builtin_amdgcn_permlane32_swap(__float_as_uint(sum), __float_as_uint(sum), false, false); sum = __uint_as_float(rr[0]) + __uint_as_float(rr[1]); }
    const float rs = __builtin_amdgcn_rcpf(sum);
    int* oi = SELI + (size_t)(g0 + r32) * 128 + h * 16 + hh * 8; float* og = SELG + (size_t)(g0 + r32) * 128 + h * 16 + hh * 8;
#pragma unroll
    for (int rr = 0; rr < 8; ++rr) { oi[rr] = eidx[rr]; og[rr] = ev[rr] * rs; }
}
__device__ __forceinline__ void topk_item_lds(const bf16_t* QP, LAS const bf16_t* KL, int* SELI, float* SELG, int g0, int h, int r32, int hh) {
    float top[2][16];
#pragma unroll
    for (int s = 0; s < 2; ++s) {
        bf16x8 qf[8];
        unsigned qoff = (unsigned)(r32 * 2048 + 8 * hh), koff = (unsigned)(r32 * 128 + 8 * hh); asm volatile("" : "+v"(qoff), "+v"(koff));
        const bf16_t* qb = QP + (size_t)g0 * 2048 + h * 256 + s * 128;
#pragma unroll
        for (int k = 0; k < 8; ++k) qf[k] = *(const bf16x8*)(qb + qoff + k * 16);
        float grp[4][16];
#pragma unroll
        for (int kb = 0; kb < 4; ++kb) {
            LAS const bf16_t* kbp = KL + (s * 128 + kb * 32 + r32) * TK_LD + 8 * hh;
            f32x16 acc = {};
#pragma unroll
            for (int k = 0; k < 8; ++k) { const bf16x8 kf = *(LAS const bf16x8*)(kbp + k * 16); acc = __builtin_amdgcn_mfma_f32_32x32x16_bf16(kf, qf[k], acc, 0, 0, 0); }
#pragma unroll
            for (int r = 0; r < 16; ++r) { const int key = kb * 32 + (r & 3) + 8 * (r >> 2) + 4 * hh; grp[kb][r] = __uint_as_float((__float_as_uint(acc[r]) & ~127u) | (unsigned)key); }
            tk::sort16_desc(grp[kb]); __builtin_amdgcn_sched_barrier(0);
        }
        tk::merge_prune(grp[0], grp[1]); __builtin_amdgcn_sched_barrier(0); tk::merge_prune(grp[2], grp[3]); __builtin_amdgcn_sched_barrier(0); tk::merge_prune(grp[0], grp[2]); __builtin_amdgcn_sched_barrier(0);
        float oth[16];
#pragma unroll
        for (int r = 0; r < 16; ++r) { const auto rr = __builtin_amdgcn_permlane32_swap(__float_as_uint(grp[0][r]), __float_as_uint(grp[0][r]), false, false); oth[r] = __uint_as_float(hh == 0 ? rr[1] : rr[0]); }
        tk::merge_prune(grp[0], oth);
#pragma unroll
        for (int r = 0; r < 16; ++r) top[s][r] = grp[0][r];
        __builtin_amdgcn_sched_barrier(0);
    }
    topk_stage2(top, SELI, SELG, g0, h, r32, hh);
}

__device__ __forceinline__ void topk_load_keys(const Args& a, char* lds, int layer) {
    const int tid = threadIdx.x, h = blockIdx.x & 7;
    const bf16_t* KEYS = (const bf16_t*)(a.ws + WS_KEYS) + (size_t)layer * 8 * 2 * 128 * 128 + (size_t)h * 2 * 128 * 128;
    LAS bf16_t* KL = (LAS bf16_t*)((LAS char*)lds);
    for (int i = tid; i < 2 * 128 * 16; i += NTHR) { const int row = i >> 4, c8 = (i & 15) * 8; *(LAS u32x4*)(KL + row * TK_LD + c8) = *(const u32x4*)(KEYS + (size_t)row * 128 + c8); }
    __syncthreads();
}
__device__ __forceinline__ void phase_peer_topk3(const Args& a, char* lds, int layer, bool latent_only, bool keys_loaded = false) {
    const int tid = threadIdx.x, lane = tid & 63, r32 = lane & 31, hh = lane >> 5, wid = __builtin_amdgcn_readfirstlane(tid >> 6);
    const int h = blockIdx.x & 7, stripe = blockIdx.x >> 3, nstr = (gridDim.x >> 3) * NWAVE;
    const bf16_t* QP = (const bf16_t*)(a.ws + WS_QP);
    int* SELI = (int*)(a.ws + WS_SELI); float* SELG = (float*)(a.ws + WS_SELG);
    LAS bf16_t* KL = (LAS bf16_t*)((LAS char*)lds);
    if (!keys_loaded) topk_load_keys(a, lds, layer);
    const int ngrp = latent_only ? (NB * SEQ) / 32 : MTOT / 32;
    for (int i = stripe * NWAVE + wid; i < ngrp; i += nstr) {
        const int g0 = latent_only ? peer_tok(i * 32, 1) : i * 32;
        topk_item_lds(QP, KL, SELI, SELG, g0, h, r32, hh);
    }
    if (!latent_only) {
        const int G = (int)gridDim.x, nbusy = (G == 256) ? 16 : 0;
        __syncthreads();
        if ((int)blockIdx.x >= nbusy) for (int r = (int)blockIdx.x - nbusy; r < 200; r += G - nbusy) prep_l1_item(a, (float*)lds, r < 160 ? r : r + 208);
    }
}
__device__ __forceinline__ float ub0(unsigned w) { return (float)(w & 0xffu); }
__device__ __forceinline__ float ub1(unsigned w) { return (float)((w >> 8) & 0xffu); }
__device__ __forceinline__ float ub2(unsigned w) { return (float)((w >> 16) & 0xffu); }
__device__ __forceinline__ float ub3(unsigned w) { return (float)(w >> 24); }
__device__ __forceinline__ int peer_tok(int i, int mode) { return mode == 1 ? i + CTXL + (i >= SEQ ? CTXL : 0) : i; }
__device__ __forceinline__ float dot16u(const u32x4& w, const float (&hp)[16]) {
    float a0 = hp[0] * ub0(w.x) + hp[4] * ub0(w.y), a1 = hp[1] * ub1(w.x) + hp[5] * ub1(w.y), a2 = hp[2] * ub2(w.x) + hp[6] * ub2(w.y), a3 = hp[3] * ub3(w.x) + hp[7] * ub3(w.y);
    a0 += hp[8] * ub0(w.z) + hp[12] * ub0(w.w); a1 += hp[9] * ub1(w.z) + hp[13] * ub1(w.w); a2 += hp[10] * ub2(w.z) + hp[14] * ub2(w.w); a3 += hp[11] * ub3(w.z) + hp[15] * ub3(w.w);
    return (a0 + a1) + (a2 + a3);
}
#define DPP_I(v, ctrl) __builtin_amdgcn_update_dpp(0, (v), (ctrl), 0xf, 0xf, true)
__device__ __forceinline__ int sum8_i(int v) {
    v += DPP_I(v, 0xB1);
    v += DPP_I(v, 0x4E);
    v += DPP_I(v, 0x141);
    return v;
}
__device__ __forceinline__ int sum_eg_i(int v) {
    v += DPP_I(v, 0x128);
    { const auto r = __builtin_amdgcn_permlane16_swap((unsigned)v, (unsigned)v, false, false); v = (int)(r[0] + r[1]); }
    { const auto r = __builtin_amdgcn_permlane32_swap((unsigned)v, (unsigned)v, false, false); v = (int)(r[0] + r[1]); }
    return v;
}
__device__ __forceinline__ void gu_stage(u32x4 (&seg)[16], u32x4& hwa, u32x4& hwb, LAS int* lb, int i0, int i1, const unsigned char* hrow, const unsigned char* PUx, int lane, int eg, unsigned loff) {
    lb[lane] = i0; lb[64 + lane] = i1;
    hwa = *(const u32x4*)hrow; hwb = *(const u32x4*)(hrow + 16);
#pragma unroll
    for (int st = 0; st < 16; ++st) seg[st] = *(const u32x4*)(PUx + ((unsigned)lb[st * 8 + eg] * 128u + loff));
}
__device__ __forceinline__ unsigned gu_split(unsigned xa, unsigned xb, bool hi) {
    constexpr unsigned M = 0x0f0f0f0fu;
    const unsigned ya = (xa ^ 0x80808080u) + 0x08080808u, yb = (xb ^ 0x80808080u) + 0x08080808u;
    return (hi ? (((ya >> 4) & M) | (yb & ~M)) : ((ya & M) | ((yb & M) << 4))) ^ 0x88888888u;
}
__device__ __forceinline__ void gu_compute(const u32x4 (&seg)[16], const u32x4& hwa, const u32x4& hwb, LAS float* lpart, unsigned* prow, int lane, int eg, int sub, bool valid) {
    const int A0 = (int)gu_split(hwa.x, hwb.x, true), A1 = (int)gu_split(hwa.y, hwb.y, true), A2 = (int)gu_split(hwa.z, hwb.z, true), A3 = (int)gu_split(hwa.w, hwb.w, true);
    const int B0 = (int)gu_split(hwa.x, hwb.x, false), B1 = (int)gu_split(hwa.y, hwb.y, false), B2 = (int)gu_split(hwa.z, hwb.z, false), B3 = (int)gu_split(hwa.w, hwb.w, false);
    int hs = __builtin_amdgcn_sdot4((int)hwa.x, 0x01010101, 0, false);
    hs = __builtin_amdgcn_sdot4((int)hwa.y, 0x01010101, hs, false); hs = __builtin_amdgcn_sdot4((int)hwa.z, 0x01010101, hs, false); hs = __builtin_amdgcn_sdot4((int)hwa.w, 0x01010101, hs, false);
    hs = __builtin_amdgcn_sdot4((int)hwb.x, 0x01010101, hs, false); hs = __builtin_amdgcn_sdot4((int)hwb.y, 0x01010101, hs, false);
    hs = __builtin_amdgcn_sdot4((int)hwb.z, 0x01010101, hs, false); hs = __builtin_amdgcn_sdot4((int)hwb.w, 0x01010101, hs, false);
    const float bias = 0.5f * (float)sum8_i(hs);
#pragma unroll
    for (int st = 0; st < 16; ++st) {
        int da = __builtin_amdgcn_sdot8((int)seg[st].x, A0, 0, false); da = __builtin_amdgcn_sdot8((int)seg[st].y, A1, da, false);
        da = __builtin_amdgcn_sdot8((int)seg[st].z, A2, da, false); da = __builtin_amdgcn_sdot8((int)seg[st].w, A3, da, false);
        int db = __builtin_amdgcn_sdot8((int)seg[st].x, B0, 0, false); db = __builtin_amdgcn_sdot8((int)seg[st].y, B1, db, false);
        db = __builtin_amdgcn_sdot8((int)seg[st].z, B2, db, false); db = __builtin_amdgcn_sdot8((int)seg[st].w, B3, db, false);
        const int d = sum8_i(da * 16 + db);
        lpart[st * 8 + eg] = (float)d + bias;
    }
    if (valid) prow[lane] = pk2(lpart[2 * lane], lpart[2 * lane + 1]);
}
__device__ __forceinline__ void phase_gu(const Args& a, char* lds, int layer, int mode) {
    const int lane = threadIdx.x & 63, wid = __builtin_amdgcn_readfirstlane(threadIdx.x >> 6), eg = lane >> 3, sub = lane & 7;
    const int x = blockIdx.x & 7, s = x >> 1, stripe = (blockIdx.x >> 3) * 2 + (x & 1), nstr = (gridDim.x >> 3) * 2 * NWAVE, ntok = mode == 1 ? NB * SEQ : MTOT;
    unsigned char* ws = a.ws;
    const unsigned char* H8 = ws + WS_H8 + s * 256 + sub * 32;
    const unsigned char* PUx = ws + WS_PU + (size_t)layer * NEXP * 512 + (size_t)s * NEXP * 128; const unsigned loff = (unsigned)(sub * 16);
    const int* SELI = (const int*)(ws + WS_SELI); unsigned* PART = (unsigned*)(ws + WS_PART) + (size_t)s * MTOT * 64;
    LAS int* lidx = (LAS int*)((LAS char*)lds + wid * 2048);
    LAS float* lpart = (LAS float*)(lidx + 256);
    const int first = stripe * NWAVE + wid;
#define G_TOK(k) peer_tok(min(first + (k) * nstr, ntok - 1), mode)
#define G_VALID(k) (first + (k) * nstr < ntok)
    u32x4 segA[16], segB[16], haA, hbA, haB, hbB;
    int p0, p1;
    { const int g = G_TOK(0); p0 = SELI[(size_t)g * 128 + lane]; p1 = SELI[(size_t)g * 128 + 64 + lane];
      gu_stage(segA, haA, hbA, lidx, p0, p1, H8 + (size_t)g * D, PUx, lane, eg, loff); }
    { const int g = G_TOK(1); p0 = SELI[(size_t)g * 128 + lane]; p1 = SELI[(size_t)g * 128 + 64 + lane]; }
    for (int k = 0; G_VALID(k); k += 2) {
        { const int g1 = G_TOK(k + 1); gu_stage(segB, haB, hbB, lidx + 128, p0, p1, H8 + (size_t)g1 * D, PUx, lane, eg, loff); }
        { const int g2 = G_TOK(k + 2); p0 = SELI[(size_t)g2 * 128 + lane]; p1 = SELI[(size_t)g2 * 128 + 64 + lane]; }
        gu_compute(segA, haA, hbA, lpart, PART + (size_t)G_TOK(k) * 64, lane, eg, sub, true);
        { const int g2 = G_TOK(k + 2); gu_stage(segA, haA, hbA, lidx, p0, p1, H8 + (size_t)g2 * D, PUx, lane, eg, loff); }
        { const int g3 = G_TOK(k + 3); p0 = SELI[(size_t)g3 * 128 + lane]; p1 = SELI[(size_t)g3 * 128 + 64 + lane]; }
        gu_compute(segB, haB, hbB, lpart, PART + (size_t)G_TOK(k + 1) * 64, lane, eg, sub, G_VALID(k + 1));
    }
}
__device__ __forceinline__ void phase_gact(const Args& a, int layer, int mode) {
    const int lane = threadIdx.x & 63, gw = blockIdx.x * NWAVE + (threadIdx.x >> 6), ngw = gridDim.x * NWAVE, ntok = mode == 1 ? NB * SEQ : MTOT;
    unsigned char* ws = a.ws;
    const unsigned* PART = (const unsigned*)(ws + WS_PART); const int* SELI = (const int*)(ws + WS_SELI); const float* SELG = (const float*)(ws + WS_SELG);
    const float* SCU = (const float*)(ws + WS_SCU) + layer * NEXP; const float* SCV = (const float*)(ws + WS_SCV) + layer * NEXP;
    const float* SH = (const float*)(ws + WS_SH); unsigned short* ACT8 = (unsigned short*)(ws + WS_ACT16); float* SA = (float*)(ws + WS_SA);
    typedef float f32x2 __attribute__((ext_vector_type(2)));
    typedef int i32x2_ __attribute__((ext_vector_type(2)));
    constexpr int TT = 4;
    for (int i0 = gw * TT; i0 < ntok; i0 += ngw * TT) {
        unsigned pw[TT][4]; i32x2_ id[TT]; f32x2 gt[TT]; float sh[TT]; int g[TT];
#pragma unroll
        for (int t = 0; t < TT; ++t) {
            g[t] = peer_tok(min(i0 + t, ntok - 1), mode);
            const size_t o = (size_t)g[t] * 64 + lane;
#pragma unroll
            for (int xx = 0; xx < 4; ++xx) pw[t][xx] = PART[(size_t)xx * MTOT * 64 + o];
            id[t] = *(const i32x2_*)(SELI + o * 2); gt[t] = *(const f32x2*)(SELG + o * 2); sh[t] = SH[g[t]];
        }
        float su[TT][2], sv[TT][2];
#pragma unroll
        for (int t = 0; t < TT; ++t) { su[t][0] = SCU[id[t].x]; su[t][1] = SCU[id[t].y]; sv[t][0] = SCV[id[t].x]; sv[t][1] = SCV[id[t].y]; }
#pragma unroll
        for (int t = 0; t < TT; ++t) {
            float d0 = 0.f, d1 = 0.f;
#pragma unroll
            for (int xx = 0; xx < 4; ++xx) { d0 += bflo(pw[t][xx]); d1 += bfhi(pw[t][xx]); }
            const float a0 = gelu_t(d0 * sh[t] * su[t][0]) * gt[t].x * sv[t][0], a1 = gelu_t(d1 * sh[t] * su[t][1]) * gt[t].y * sv[t][1];
            float mx = fmaxf(fabsf(a0), fabsf(a1));
#pragma unroll
            for (int of = 1; of < 64; of <<= 1) mx = fmaxf(mx, __shfl_xor(mx, of));
            mx = fmaxf(mx, 1e-30f); const float inv = 127.f / mx;
            if (i0 + t < ntok) {
                ACT8[(size_t)g[t] * 64 + lane] = (unsigned short)((__float2int_rn(a0 * inv) & 0xff) | ((__float2int_rn(a1 * inv) & 0xff) << 8));
                const int q0 = __float2int_rn(a0 * inv), q1 = __float2int_rn(a1 * inv);
                int qs = q0 + q1;
#pragma unroll
                for (int of = 1; of < 64; of <<= 1) qs += __shfl_xor(qs, of);
                if (lane == 0) { SA[g[t]] = mx * (1.f / 127.f); ((int*)(ws + WS_SACT))[g[t]] = qs; }
            }
        }
    }
}
__device__ __forceinline__ void gv_stage(u32x4 (&seg)[16], LAS int* lb, int i0, int i1, const unsigned char* PVx, int lane, int eg, unsigned loff) {
    lb[lane] = i0; lb[64 + lane] = i1;
#pragma unroll
    for (int st = 0; st < 16; ++st) seg[st] = *(const u32x4*)(PVx + ((unsigned)lb[st * 8 + eg] * 128u + loff));
}
typedef int i32x2 __attribute__((ext_vector_type(2)));
__device__ __forceinline__ void gv_compute(const u32x4 (&seg)[16], LAS unsigned char* tile, const i32x4 (&aw)[2], float sa, int sact, bf16_t* xr, const float* g2, int lane, bool valid) {
    {
        const int eg = lane >> 3, sub = lane & 7;
        LAS unsigned char* w0 = tile + eg * 128 + ((sub ^ ((eg >> 1) & 3)) << 4);
        LAS unsigned char* w1 = tile + eg * 128 + ((sub ^ ((eg >> 1) & 3) ^ 4) << 4);
#pragma unroll
        for (int st = 0; st < 16; ++st) *(LAS u32x4*)(((st & 2) ? w1 : w0) + st * 1024) = seg[st];
    }
    const int kgrp = lane >> 4, q = (lane >> 1) & 7, p = lane & 1, rg = lane >> 4;
    const int swz = ((q >> 1) & 3) | ((kgrp & 1) << 2);
    LAS unsigned char* rb = tile + (kgrp * 16 + q) * 128 + 8 * p;
    int a0 = 0, a1 = 0, b0 = 0, b1 = 0;
    constexpr unsigned M = 0x0f0f0f0fu;
#pragma unroll
    for (int n4 = 0; n4 < 8; n4 += 4) {
        i32x4 aL[4], aH[4];
#pragma unroll
        for (int j = 0; j < 4; ++j) { aL[j] = i32x4{0, 0, 0, 0}; aH[j] = i32x4{0, 0, 0, 0}; }
#pragma unroll
        for (int kt = 0; kt < 2; ++kt) {
            i32x2 bl[4], bh[4];
#pragma unroll
            for (int j = 0; j < 4; ++j) {
                LAS unsigned char* pa = rb + (((n4 + j) ^ swz) << 4) + kt * 8192;
                bl[j] = __builtin_amdgcn_ds_read_tr8_b64_v2i32((LAS i32x2*)pa);
                bh[j] = __builtin_amdgcn_ds_read_tr8_b64_v2i32((LAS i32x2*)(pa + 1024));
            }
#pragma unroll
            for (int j = 0; j < 4; ++j) {
                const unsigned x0 = (unsigned)bl[j].x, x1 = (unsigned)bl[j].y, x2 = (unsigned)bh[j].x, x3 = (unsigned)bh[j].y;
                aL[j] = __builtin_amdgcn_mfma_i32_16x16x64_i8(aw[kt], i32x4{(int)(x0 & M), (int)(x1 & M), (int)(x2 & M), (int)(x3 & M)}, aL[j], 0, 0, 0);
                aH[j] = __builtin_amdgcn_mfma_i32_16x16x64_i8(aw[kt], i32x4{(int)x0, (int)x1, (int)x2, (int)x3}, aH[j], 0, 0, 0);
            }
        }
        const bool sel = (rg & 1) != 0, mine = (rg >> 1) == (n4 >> 2);
        const int ta0 = sel ? aL[2][0] : aL[0][0], ta1 = sel ? aL[3][0] : aL[1][0], tr0 = sel ? aH[2][0] : aH[0][0], tr1 = sel ? aH[3][0] : aH[1][0];
        a0 = mine ? ta0 : a0; a1 = mine ? ta1 : a1; b0 = mine ? ((tr0 - ta0) >> 4) : b0; b1 = mine ? ((tr1 - ta1) >> 4) : b1;
    }
    if (valid) {
        const float biasl = 7.5f * (float)sact, biash = 0.5f * (float)sact;
        xr[0] = (bf16_t)f2bf(bf2f(xr[0]) + g2[0] * (sa * ((float)a0 - biasl))); xr[16] = (bf16_t)f2bf(bf2f(xr[16]) + g2[16] * (sa * ((float)b0 + biash)));
        xr[32] = (bf16_t)f2bf(bf2f(xr[32]) + g2[32] * (sa * ((float)a1 - biasl))); xr[48] = (bf16_t)f2bf(bf2f(xr[48]) + g2[48] * (sa * ((float)b1 + biash)));
    }
}
__device__ __forceinline__ void phase_gv(const Args& a, char* lds, int layer, int mode) {
    const int lane = threadIdx.x & 63, wid = __builtin_amdgcn_readfirstlane(threadIdx.x >> 6), eg = lane >> 3, sub = lane & 7;
    const int x = blockIdx.x & 7, s = x >> 1, stripe = (blockIdx.x >> 3) * 2 + (x & 1), nstr = (gridDim.x >> 3) * 2 * NWAVE, ntok = mode == 1 ? NB * SEQ : MTOT;
    unsigned char* ws = a.ws;
    const int ocol = s * 256 + (lane >> 4) * 64 + (lane & 15);
    bf16_t* X1 = (bf16_t*)(ws + WS_X1) + ocol;
    const unsigned char* PVx = ws + WS_PV + (size_t)layer * NEXP * 512 + (size_t)s * NEXP * 128; const unsigned loff = (unsigned)(sub * 16);
    const int* SELI = (const int*)(ws + WS_SELI); const unsigned char* ACT8 = ws + WS_ACT16 + (lane >> 4) * 16; const float* SA = (const float*)(ws + WS_SA); const int* SACT = (const int*)(ws + WS_SACT);
    LAS int* lidx = (LAS int*)((LAS char*)lds + 131072 + wid * 1024);
    LAS unsigned char* tile = (LAS unsigned char*)((LAS char*)lds + wid * 16384);
    const int first = stripe * NWAVE + wid;
#define G_TOK(k) peer_tok(min(first + (k) * nstr, ntok - 1), mode)
#define G_VALID(k) (first + (k) * nstr < ntok)
    u32x4 segA[16], segB[16];
    i32x4 awA[2], awB[2]; float saA, saB; int scA, scB;
    int p0, p1;
#define GV_PREF(k) { const int g_ = G_TOK(k); p0 = SELI[(size_t)g_ * 128 + lane]; p1 = SELI[(size_t)g_ * 128 + 64 + lane]; }
#define GV_AW(AW, SAV, SCV_, k) { const int g_ = G_TOK(k); AW[0] = *(const i32x4*)(ACT8 + (size_t)g_ * 128); AW[1] = *(const i32x4*)(ACT8 + (size_t)g_ * 128 + 64); SAV = SA[g_]; SCV_ = SACT[g_]; }
#define GV_G2(k) (modv(a, layer, row_variant(G_TOK(k)), 5) + ocol)
    GV_PREF(0) gv_stage(segA, lidx, p0, p1, PVx, lane, eg, loff); GV_AW(awA, saA, scA, 0)
    GV_PREF(1)
    for (int k = 0; G_VALID(k); k += 2) {
        gv_stage(segB, lidx + 128, p0, p1, PVx, lane, eg, loff); GV_AW(awB, saB, scB, k + 1)
        GV_PREF(k + 2)
        gv_compute(segA, tile, awA, saA, scA, X1 + (size_t)G_TOK(k) * D, GV_G2(k), lane, true);
        gv_stage(segA, lidx, p0, p1, PVx, lane, eg, loff); GV_AW(awA, saA, scA, k + 2)
        GV_PREF(k + 3)
        gv_compute(segB, tile, awB, saB, scB, X1 + (size_t)G_TOK(k + 1) * D, GV_G2(k + 1), lane, G_VALID(k + 1));
    }
#undef GV_PREF
#undef GV_AW
#undef GV_G2
#undef G_TOK
#undef G_VALID
}
__device__ __forceinline__ void phase_finalnorm(const Args& a) {
    const int lane = threadIdx.x & 63, gw = blockIdx.x * NWAVE + (threadIdx.x >> 6), ngw = gridDim.x * NWAVE;
    const bf16_t* X1 = (const bf16_t*)(a.ws + WS_X1);
    for (int i = gw; i < NB * SEQ; i += ngw) {
        const int g = peer_tok(i, 1);
        const bf16_t* xr = X1 + (size_t)g * D; float* op = a.out + (size_t)i * D;
        f32x4 v[4]; float ss = 0.f;
#pragma unroll
        for (int j = 0; j < 4; ++j) { const u32x2 w = *(const u32x2*)(xr + j * 256 + lane * 4); v[j] = f32x4{bflo(w.x), bfhi(w.x), bflo(w.y), bfhi(w.y)}; ss += (v[j].x * v[j].x + v[j].y * v[j].y) + (v[j].z * v[j].z + v[j].w * v[j].w); }
        const float rinv = rsqrtf(wave_sum(ss) * (1.f / D) + EPS);
#pragma unroll
        for (int j = 0; j < 4; ++j) { const f32x4 gn = *(const f32x4*)(a.in[28] + j * 256 + lane * 4); *(f32x4*)(op + j * 256 + lane * 4) = v[j] * rinv * gn; }
    }
}

constexpr int XC_LD = 136;
__device__ __forceinline__ float exp2_fast(float x) { return __builtin_amdgcn_exp2f(x); }
__device__ __forceinline__ float sigm_fast(float x) { return __builtin_amdgcn_rcpf(1.f + __builtin_amdgcn_exp2f(-1.4426950408889634f * x)); }
__device__ __forceinline__ int rg_tau(int rho) { return 16 * ((rho >> 2) & 1) + (rho & 3) + 4 * (rho >> 3); }
__device__ __forceinline__ void phase_rglru2(const Args& a, char* lds, int pass) {
    const int tid_ = threadIdx.x, wid = __builtin_amdgcn_readfirstlane(tid_ >> 6);
    const int nb = wid & 3, dir = wid >> 2;
    unsigned char* ws = a.ws;
    LAS bf16_t* xcA = (LAS bf16_t*)((LAS char*)lds);
    const bf16_t* XR = (const bf16_t*)(ws + WS_XR);
    float* CARRY = (float*)(ws + WS_CARRY);
    typedef float f32x2 __attribute__((ext_vector_type(2)));
    const int NU = (MTOT / 128) * 10;
    for (int u = blockIdx.x; u < NU; u += gridDim.x) {
        const int T = u / 10, hb = u % 10, b = T / 66, tl = T % 66, row0 = T * 128;
        int tid = tid_; asm volatile("" : "+v"(tid));
        const int lane = tid & 63, r32 = lane & 31, hh = lane >> 5;
        const int seq_lo = tl < 2 ? b * RPB : b * RPB + CTXL, seq_hi = tl < 2 ? b * RPB + CTXL : (b + 1) * RPB;
        const int ch = hb * 128 + nb * 32 + r32;
        u32x4* stu = (u32x4*)(ws + WS_STU) + (size_t)(u * 8 + wid) * 4 * 64;
        u32x4* str = (u32x4*)(ws + WS_STR) + (size_t)(u * 8 + wid) * 4 * 64;
        f32x16 accA[4], accX[4];
        {
            const int j2 = tid & 63, ts = tid >> 6, c0 = hb * 128 + 2 * j2;
            unsigned xw[19];
#pragma unroll
            for (int i = 0; i < 19; ++i) { const int g = row0 + ts * 16 - 2 + i; const int gc = min(max(g, seq_lo), seq_hi - 1); xw[i] = *(const unsigned*)(XR + (size_t)gc * DRNN + c0); }
            const f32x2 cw0 = *(const f32x2*)(a.in[16] + 0 * DRNN + c0), cw1 = *(const f32x2*)(a.in[16] + 1 * DRNN + c0), cw2 = *(const f32x2*)(a.in[16] + 2 * DRNN + c0), cw3 = *(const f32x2*)(a.in[16] + 3 * DRNN + c0);
            const f32x2 cbv = *(const f32x2*)(a.in[17] + c0);
            bf16x8 bfa[8], bfx[8];
            {
                unsigned woff = (unsigned)((nb * 32 + r32) * 128 + 8 * hh); asm volatile("" : "+v"(woff));
                const bf16_t* wa = (const bf16_t*)(ws + WS_WAT) + (size_t)(dir * 10 + hb) * 128 * 128;
                const bf16_t* wx = (const bf16_t*)(ws + WS_WXT) + (size_t)(dir * 10 + hb) * 128 * 128;
#pragma unroll
                for (int k = 0; k < 8; ++k) { bfa[k] = *(const bf16x8*)(wa + woff + k * 16); bfx[k] = *(const bf16x8*)(wx + woff + k * 16); }
            }
            const float ba = a.in[19][dir * DRNN + ch], bx = a.in[21][dir * DRNN + ch], lam = a.in[22][dir * DRNN + ch];
            __builtin_amdgcn_sched_barrier(0);
            {
#pragma unroll
                for (int i = 0; i < 19; ++i) { const int g = row0 + ts * 16 - 2 + i; if (g < seq_lo || g >= seq_hi) xw[i] = 0u; }
                const int csw = (2 * j2) ^ ((ts & 1) << 6);
#pragma unroll
                for (int i = 0; i < 16; ++i) {
                    const float y0 = cw0.x * bflo(xw[i]) + cw1.x * bflo(xw[i + 1]) + cw2.x * bflo(xw[i + 2]) + cw3.x * bflo(xw[i + 3]) + cbv.x;
                    const float y1 = cw0.y * bfhi(xw[i]) + cw1.y * bfhi(xw[i + 1]) + cw2.y * bfhi(xw[i + 2]) + cw3.y * bfhi(xw[i + 3]) + cbv.y;
                    *(LAS unsigned*)(xcA + (ts * 16 + i) * XC_LD + csw) = pk2(y0, y1);
                }
            }
            __syncthreads();
            {
                const float nba = -1.4426950408889634f * ba, nbx = -1.4426950408889634f * bx;
                f32x16 cA, cX;
#pragma unroll
                for (int r = 0; r < 16; ++r) { cA[r] = nba; cX[r] = nbx; }
                const int arow = rg_tau(r32) * XC_LD, fl64 = ((r32 >> 2) & 1) << 6;
#pragma unroll
                for (int mb = 0; mb < 4; ++mb) {
#pragma unroll
                    for (int k = 0; k < 8; ++k) {
                        const bf16x8 af = *(const LAS bf16x8*)(xcA + mb * 32 * XC_LD + arow + (((k * 16) ^ fl64) + 8 * hh));
                        accA[mb] = __builtin_amdgcn_mfma_f32_32x32x16_bf16(af, bfa[k], k == 0 ? cA : accA[mb], 0, 0, 0);
                        accX[mb] = __builtin_amdgcn_mfma_f32_32x32x16_bf16(af, bfx[k], k == 0 ? cX : accX[mb], 0, 0, 0);
                    }
                }
            }
            __builtin_amdgcn_sched_barrier(0);
            {
                const float sp8l = -8.f * 1.4426950408889634f * log1pf(__expf(-lam));
                if (T == 2 && hh == 0) ((float*)(ws + WS_SPL))[dir * DRNN + ch] = sp8l;
                const int xcol = (nb * 32 + r32) ^ (hh << 6);
#pragma unroll
                for (int mb = 0; mb < 4; ++mb) {
                    u32x4 rq = {0u, 0u, 0u, 0u};
#pragma unroll
                    for (int r = 0; r < 16; ++r) {
                        const int t = mb * 32 + 16 * hh + r;
                        const float xv = bf2f(xcA[t * XC_LD + xcol]);
                        const float rg = __builtin_amdgcn_rcpf(1.f + __builtin_amdgcn_exp2f(accA[mb][r]));
                        const float ig = __builtin_amdgcn_rcpf(1.f + __builtin_amdgcn_exp2f(accX[mb][r]));
                        const float av = __builtin_amdgcn_exp2f(rg * sp8l);
                        const float om = fmaxf(__builtin_fmaf(-av, av, 1.f), 0.f);
                        accA[mb][r] = av; accX[mb][r] = __builtin_amdgcn_sqrtf(om) * ig * xv;
                        rq[r >> 2] = __builtin_amdgcn_cvt_pk_u8_f32(rg * 255.f, r & 3, rq[r >> 2]);
                        if ((r & 3) == 3) __builtin_amdgcn_sched_barrier(0);
                    }
                    if (tl >= 2) str[mb * 64 + lane] = rq;
                }
            }
            __builtin_amdgcn_sched_barrier(0);
        }
        float h = 0.f, Atot = 1.f;
#define RG_SEG(mb) float sA, sH; \
            if (dir == 0) { sH = accX[mb][0]; _Pragma("unroll") for (int r = 1; r < 16; ++r) sH = sH * accA[mb][r] + accX[mb][r]; } \
            else { sH = accX[mb][15]; _Pragma("unroll") for (int r = 14; r >= 0; --r) sH = sH * accA[mb][r] + accX[mb][r]; } \
            { const float p0 = accA[mb][0] * accA[mb][1], p1 = accA[mb][2] * accA[mb][3], p2 = accA[mb][4] * accA[mb][5], p3 = accA[mb][6] * accA[mb][7]; \
              const float p4 = accA[mb][8] * accA[mb][9], p5 = accA[mb][10] * accA[mb][11], p6 = accA[mb][12] * accA[mb][13], p7 = accA[mb][14] * accA[mb][15]; \
              sA = ((p0 * p1) * (p2 * p3)) * ((p4 * p5) * (p6 * p7)); } \
            const auto ra = __builtin_amdgcn_permlane32_swap(__float_as_uint(sA), __float_as_uint(sA), false, false); \
            const auto rh = __builtin_amdgcn_permlane32_swap(__float_as_uint(sH), __float_as_uint(sH), false, false); \
            const float EA = __uint_as_float(ra[0]), EH = __uint_as_float(rh[0]), OA = __uint_as_float(ra[1]), OH = __uint_as_float(rh[1]);
        if (dir == 0) {
#pragma unroll
            for (int mb = 0; mb < 4; ++mb) { RG_SEG(mb) h = EA * h + EH; h = OA * h + OH; Atot *= EA * OA; }
        } else {
#pragma unroll
            for (int mb = 3; mb >= 0; --mb) { RG_SEG(mb) h = OA * h + OH; h = EA * h + EH; Atot *= EA * OA; }
        }
#undef RG_SEG
        if (hh == 0) { const int pp = dir == 0 ? tl : (tl < 2 ? 1 - tl : 67 - tl);
            float* c = CARRY + (((size_t)(b * 2 + dir) * DRNN + ch) * 66 + pp) * 2; c[0] = Atot; c[1] = h; }
        if (tl >= 2) {
            float mxu = 0.f;
#pragma unroll
            for (int mb = 0; mb < 4; ++mb)
#pragma unroll
                for (int r = 0; r < 16; r += 2) mxu = fmaxf(fmaxf(fabsf(accX[mb][r]), fabsf(accX[mb][r + 1])), mxu);
            mxu = fmaxf(mxu, 1e-30f); const float uinv = 127.f / mxu;
#pragma unroll
            for (int mb = 0; mb < 4; ++mb) { u32x4 o = {0u, 0u, 0u, 0u};
#pragma unroll
                for (int r = 0; r < 16; ++r) o[r >> 2] = __builtin_amdgcn_cvt_pk_u8_f32(__builtin_rintf(accX[mb][r] * uinv) + 128.f, r & 3, o[r >> 2]);
                stu[mb * 64 + lane] = o; }
            ((float*)(ws + WS_STS))[(size_t)(u * 8 + wid) * 64 + lane] = mxu * (1.f / 127.f);
        }
        __syncthreads();
    }
    {
        const int G = (int)gridDim.x, nlast = NU - (NU / G) * G;
        if ((int)blockIdx.x >= nlast) quant_tables(a, 1, ((int)blockIdx.x - nlast) * NWAVE + wid, (G - nlast) * NWAVE, tid_ & 63, NEXP, 2 * NEXP);
    }
}

__device__ __forceinline__ void rg_out_load(u32x4 (&Lsr)[4], u32x4 (&Lsu)[4], float& Lusc, float& Llam, const Args& a, int u, int wid, int tid) {
    typedef float f32x2 __attribute__((ext_vector_type(2)));
    unsigned char* ws = a.ws;
    const int nb = wid & 3, dir = wid >> 2, lane = tid & 63, r32 = lane & 31, hh = lane >> 5;
    const int T = u / 10, hb = u % 10, b = T / 66, row0 = T * 128, ch = hb * 128 + nb * 32 + r32;
    const u32x4* stu = (const u32x4*)(ws + WS_STU) + (size_t)(u * 8 + wid) * 4 * 64;
    const u32x4* str = (const u32x4*)(ws + WS_STR) + (size_t)(u * 8 + wid) * 4 * 64;
#pragma unroll
    for (int c = 0; c < 4; ++c) Lsr[c] = str[c * 64 + lane];
#pragma unroll
    for (int c = 0; c < 4; ++c) Lsu[c] = stu[c * 64 + lane];
    Lusc = ((const float*)(ws + WS_STS))[(size_t)(u * 8 + wid) * 64 + lane];
    Llam = ((const float*)(ws + WS_SPL))[dir * DRNN + ch];
}
__device__ __forceinline__ void phase_rglru_out(const Args& a, char* lds) {
    const int tid_ = threadIdx.x, wid = __builtin_amdgcn_readfirstlane(tid_ >> 6);
    const int nb = wid & 3, dir = wid >> 2, G = (int)gridDim.x;
    LAS float* HS = (LAS float*)((LAS char*)lds + 36864);
    bf16_t* YG = (bf16_t*)(a.ws + WS_YG);
    const int NU = (MTOT / 128) * 10;
#define RG_SKIP(u_) ((((u_) / 10) % 66) < 2)
    int u = blockIdx.x;
    while (u < NU && RG_SKIP(u)) u += G;
    if (u >= NU) return;
    u32x4 Lsr[4], Lsu[4]; float Lusc, Llam;
    rg_out_load(Lsr, Lsu, Lusc, Llam, a, u, wid, tid_);
    for (;;) {
        int un = u + G;
        while (un < NU && RG_SKIP(un)) un += G;
        int tid = tid_; asm volatile("" : "+v"(tid));
        const int lane = tid & 63, r32 = lane & 31, hh = lane >> 5;
        const int T = u / 10, hb = u % 10, tl = T % 66, row0 = T * 128;
        f32x16 accA[4]; float h0; u32x4 ggw[4], csu[4];
#pragma unroll
        for (int c = 0; c < 4; ++c) csu[c] = Lsu[c];
        const float usc = Lusc, uof = -128.f * Lusc;
#define RG_UB(w, k) __builtin_fmaf((float)(((w) >> (8 * (k))) & 0xffu), usc, uof)
#define RG_UX(mb, r) RG_UB(csu[mb][(r) >> 2], (r) & 3)
        typedef float f32x2 __attribute__((ext_vector_type(2)));
        f32x2 cv[33];
        const float c255 = Llam * (1.f / 255.f);
#define RG_DECODE(mb) _Pragma("unroll") for (int r = 0; r < 16; ++r) { \
            const unsigned w = Lsr[mb][r >> 2]; \
            accA[mb][r] = __builtin_amdgcn_exp2f((float)((w >> (8 * (r & 3))) & 0xffu) * c255); }
        RG_DECODE(0) RG_DECODE(1)
        __builtin_amdgcn_sched_barrier(0);
        {
            const int b = T / 66, ch = hb * 128 + nb * 32 + r32;
            const float* cbase = (const float*)(a.ws + WS_CARRY) + (((size_t)(b * 2 + dir) * DRNN + ch) * 66 + hh * 33) * 2;
#pragma unroll
            for (int i = 0; i < 33; ++i) cv[i] = *(const f32x2*)(cbase + i * 2);

        }
        __builtin_amdgcn_sched_barrier(0);
        RG_DECODE(2) RG_DECODE(3)
#undef RG_DECODE
        __builtin_amdgcn_sched_barrier(0);
        {
            const int pos = dir == 0 ? tl : 67 - tl;
            float cA = 1.f, cH = 0.f;
#pragma unroll
            for (int i = 0; i < 33; ++i) { const bool ok = hh * 33 + i < pos; const float ta = ok ? cv[i].x : 1.f, th = ok ? cv[i].y : 0.f; cH = ta * cH + th; cA = ta * cA; }
            const auto ra = __builtin_amdgcn_permlane32_swap(__float_as_uint(cA), __float_as_uint(cA), false, false);
            const auto rh = __builtin_amdgcn_permlane32_swap(__float_as_uint(cH), __float_as_uint(cH), false, false);
            h0 = __uint_as_float(ra[1]) * __uint_as_float(rh[0]) + __uint_as_float(rh[1]);
        }
        __builtin_amdgcn_sched_barrier(0);
        float h = h0; float cin[4];
#define RG_SEG(mb) float sA, sH; \
            if (dir == 0) { sH = RG_UX(mb, 0); _Pragma("unroll") for (int r = 1; r < 16; ++r) sH = sH * accA[mb][r] + RG_UX(mb, r); } \
            else { sH = RG_UX(mb, 15); _Pragma("unroll") for (int r = 14; r >= 0; --r) sH = sH * accA[mb][r] + RG_UX(mb, r); } \
            { const float p0 = accA[mb][0] * accA[mb][1], p1 = accA[mb][2] * accA[mb][3], p2 = accA[mb][4] * accA[mb][5], p3 = accA[mb][6] * accA[mb][7]; \
              const float p4 = accA[mb][8] * accA[mb][9], p5 = accA[mb][10] * accA[mb][11], p6 = accA[mb][12] * accA[mb][13], p7 = accA[mb][14] * accA[mb][15]; \
              sA = ((p0 * p1) * (p2 * p3)) * ((p4 * p5) * (p6 * p7)); } \
            const auto ra = __builtin_amdgcn_permlane32_swap(__float_as_uint(sA), __float_as_uint(sA), false, false); \
            const auto rh = __builtin_amdgcn_permlane32_swap(__float_as_uint(sH), __float_as_uint(sH), false, false); \
            const float EA = __uint_as_float(ra[0]), EH = __uint_as_float(rh[0]), OA = __uint_as_float(ra[1]), OH = __uint_as_float(rh[1]);
#define RG_WORDS(mb, j) unsigned w0 = csu[mb][j]; asm volatile("" : "+v"(w0)); \
            const float uu[4] = {RG_UB(w0, 0), RG_UB(w0, 1), RG_UB(w0, 2), RG_UB(w0, 3)};
        if (dir == 0) {
#pragma unroll
            for (int mb = 0; mb < 4; ++mb) { RG_SEG(mb) const float hE = h; h = EA * h + EH; const float hO = h; h = OA * h + OH; cin[mb] = hh ? hO : hE; }
#pragma unroll
            for (int mb = 0; mb < 4; ++mb) { float hc = cin[mb];
#pragma unroll
                for (int j = 0; j < 4; ++j) { RG_WORDS(mb, j)
#pragma unroll
                    for (int e = 0; e < 4; ++e) { hc = accA[mb][4 * j + e] * hc + uu[e]; accA[mb][4 * j + e] = hc; } } }
        } else {
#pragma unroll
            for (int mb = 3; mb >= 0; --mb) { RG_SEG(mb) const float hO = h; h = OA * h + OH; const float hE = h; h = EA * h + EH; cin[mb] = hh ? hO : hE; }
#pragma unroll
            for (int mb = 0; mb < 4; ++mb) { float hc = cin[mb];
#pragma unroll
                for (int j = 3; j >= 0; --j) { RG_WORDS(mb, j)
#pragma unroll
                    for (int e = 3; e >= 0; --e) { hc = accA[mb][4 * j + e] * hc + uu[e]; accA[mb][4 * j + e] = hc; } } }
        }
#undef RG_SEG
#undef RG_WORDS
#undef RG_UX
#undef RG_UB
        __builtin_amdgcn_sched_barrier(0);
        {
            const int t = tid >> 2, cs = (tid & 3) * 32;
            const bf16_t* gp = (const bf16_t*)(a.ws + WS_GG) + (size_t)(row0 + t) * DRNN + hb * 128 + cs;
#pragma unroll
            for (int c8 = 0; c8 < 4; ++c8) ggw[c8] = *(const u32x4*)(gp + c8 * 8);
        }
        if (un < NU) rg_out_load(Lsr, Lsu, Lusc, Llam, a, un, wid, tid);
        __builtin_amdgcn_sched_barrier(0);
        if (dir == 0) {
#pragma unroll
            for (int mb = 0; mb < 4; ++mb)
#pragma unroll
                for (int r = 0; r < 16; ++r) { const int t = mb * 32 + 16 * hh + r; HS[t * 128 + nb * 32 + r32] = accA[mb][r]; }
        }
        __syncthreads();
        if (dir == 1) {
#pragma unroll
            for (int mb = 0; mb < 4; ++mb)
#pragma unroll
                for (int r = 0; r < 16; ++r) { const int t = mb * 32 + 16 * hh + r; HS[t * 128 + nb * 32 + r32] += accA[mb][r]; }
        }
        __syncthreads();
        {
            const int t = tid >> 2, cs = (tid & 3) * 32, g = row0 + t;
            bf16_t* yp = YG + (size_t)g * DRNN + hb * 128 + cs;
#pragma unroll
            for (int c8 = 0; c8 < 32; c8 += 8) {
                const u32x4 gw = ggw[c8 >> 3];
                const f32x4 h0v = *(const LAS f32x4*)(HS + t * 128 + cs + c8), h1v = *(const LAS f32x4*)(HS + t * 128 + cs + c8 + 4);
                u32x4 o; o.x = pk2(h0v.x * bflo(gw.x), h0v.y * bfhi(gw.x)); o.y = pk2(h0v.z * bflo(gw.y), h0v.w * bfhi(gw.y));
                o.z = pk2(h1v.x * bflo(gw.z), h1v.y * bfhi(gw.z)); o.w = pk2(h1v.z * bflo(gw.w), h1v.w * bfhi(gw.w));
                *(u32x4*)(yp + c8) = o;
            }
        }
        __syncthreads();
        if (un >= NU) break;
        u = un;
    }
#undef RG_SKIP
}

namespace pg8 {
constexpr int BM = 256, BK = 64, HALF = 128, HTB = HALF * BK * 2, STAGE_BYTES = 8 * HTB, NXCD = 8, WGM = 8;
__host__ __device__ __forceinline__ int lds_byte(int r, int c) { const int st = (r >> 4) * 2 + (c >> 5), rr = r & 15, cc = c & 31, ob = rr * 64 + cc * 2; return st * 1024 + (ob ^ (((ob >> 9) & 1) << 5)); }
__host__ __device__ __forceinline__ void stage_rc(int b, int& R, int& C) { const int st = b / 1024, sb = b % 1024, swz = sb ^ (((sb >> 9) & 1) << 5); R = (st >> 1) * 16 + swz / 64; C = (st & 1) * 32 + (swz % 64) / 2; }
__host__ __device__ __forceinline__ int perm32(int rho) { const int n = rho >> 4, i = rho & 15; return 8 * (i >> 2) + 4 * n + (i & 3); }
struct Unit { int pm, pn; };
struct Gemm { const bf16_t* A; const bf16_t* Bt; int M, N, K; const float* sa; const float* sw; };
struct StaticOrder {
    int nM, nN, nwg, G, c;
    __host__ __device__ void init(int M, int N, int G_, int c_) { nM = M / BM; nN = N / BM; nwg = nM * nN; G = G_; c = c_; }
    __host__ __device__ bool next(int i, Unit& u) const {
        const long L = (long)i * G + c; if (L >= nwg) return false;
        int wgid = (int)L; { const int q = nwg / NXCD, r = nwg % NXCD, xcd = wgid % NXCD, off = wgid / NXCD; wgid = (xcd < r ? xcd * (q + 1) : r * (q + 1) + (xcd - r) * q) + off; }
        const int nig = WGM * nN, gid = wgid / nig, fm = gid * WGM, gsz = (nM - fm) < WGM ? (nM - fm) : WGM;
        u.pm = fm + ((wgid % nig) % gsz); u.pn = (wgid % nig) / gsz; return true;
    }
    __device__ __forceinline__ void a_ready(const Unit&) const {}
    __device__ __forceinline__ void done(const Unit&) const {}
};
struct LatentOrder {
    StaticOrder S;
    __host__ __device__ void init(int N, int G_, int c_) { S.init(16384, N, G_, c_); }
    __host__ __device__ bool next(int i, Unit& u) const { if (!S.next(i, u)) return false; u.pm = u.pm + 1 + (u.pm >= 32 ? 1 : 0); return true; }
    __device__ __forceinline__ void a_ready(const Unit&) const {}
    __device__ __forceinline__ void done(const Unit&) const {}
};
__device__ __forceinline__ unsigned cvt_pk_bf16(float lo, float hi) { unsigned r; asm volatile("v_cvt_pk_bf16_f32 %0, %1, %2" : "=v"(r) : "v"(lo), "v"(hi)); return r; }
__device__ __forceinline__ u32x4 pack8(const f32x4& v0, const f32x4& v1) { u32x4 w; w.x = cvt_pk_bf16(v0[0], v0[1]); w.y = cvt_pk_bf16(v0[2], v0[3]); w.z = cvt_pk_bf16(v1[0], v1[1]); w.w = cvt_pk_bf16(v1[2], v1[3]); return w; }
__device__ __forceinline__ f32x4 gelu4(const f32x4& v) { f32x4 r; r.x = gelu_t(v.x); r.y = gelu_t(v.y); r.z = gelu_t(v.z); r.w = gelu_t(v.w); return r; }

struct EpiStore {
    static constexpr bool PERM = true, AFTER_DRAIN = false;
    bf16_t* O1; bf16_t* O2; int ld; int split_tile; int gelu_tiles;
    __device__ __forceinline__ void operator()(f32x4 (&acc)[2][2][4][2], const Unit& u, int wr, int wc, int fr, int fq) const {
        const bool second = u.pn >= split_tile; bf16_t* base = second ? O2 : O1; const int pnl = second ? u.pn - split_tile : u.pn; const bool dog = u.pn < gelu_tiles;
        const int rl0 = wr * 64 + fr, cl0 = wc * 32 + 8 * fq;
#pragma unroll
        for (int ai = 0; ai < 2; ++ai)
#pragma unroll
            for (int m = 0; m < 4; ++m) { bf16_t* rowp = base + (size_t)(u.pm * BM + ai * HALF + m * 16 + rl0) * ld + pnl * BM + cl0;
#pragma unroll
                for (int bj = 0; bj < 2; ++bj) { f32x4 v0 = acc[ai][bj][m][0], v1 = acc[ai][bj][m][1]; if (dog) { v0 = gelu4(v0); v1 = gelu4(v1); }
                    *(u32x4*)(rowp + bj * HALF) = pack8(v0, v1); } }
    }
};
struct EpiResid {
    static constexpr bool PERM = true, AFTER_DRAIN = false;
    const float* x; const float* ctx; const float* modbase; bf16_t* X1; int base_mode;
    __device__ __forceinline__ void operator()(f32x4 (&acc)[2][2][4][2], const Unit& u, int wr, int wc, int fr, int fq) const {
        const int b = u.pm / 33, tl = u.pm % 33, var = tl == 0 ? 2 : b;
        const float* gate = modbase + (size_t)var * 6144 + u.pn * BM;
        const float* basep = tl == 0 ? ctx + (size_t)b * CTXL * D : x + ((size_t)b * SEQ + (size_t)(tl - 1) * 256) * D;
        bf16_t* outp = X1 + (size_t)u.pm * BM * D;
        const int rl0 = wr * 64 + fr, cl0 = u.pn * BM + wc * 32 + 8 * fq;
        f32x4 gv[2][2];
#pragma unroll
        for (int bj = 0; bj < 2; ++bj)
#pragma unroll
            for (int n = 0; n < 2; ++n) gv[bj][n] = *(const f32x4*)(gate + bj * HALF + wc * 32 + 8 * fq + 4 * n);
#pragma unroll
        for (int ai = 0; ai < 2; ++ai)
#pragma unroll
            for (int m = 0; m < 4; ++m) { const size_t off = (size_t)(ai * HALF + m * 16 + rl0) * D + cl0;
#pragma unroll
                for (int bj = 0; bj < 2; ++bj)
                { f32x4 b0, b1;
                    if (base_mode == 0) { b0 = *(const f32x4*)(basep + off + bj * HALF); b1 = *(const f32x4*)(basep + off + bj * HALF + 4); }
                    else { const u32x4 w = *(const u32x4*)(outp + off + bj * HALF); b0 = f32x4{bflo(w.x), bfhi(w.x), bflo(w.y), bfhi(w.y)}; b1 = f32x4{bflo(w.z), bfhi(w.z), bflo(w.w), bfhi(w.w)}; }
                    const f32x4 o0 = b0 + gv[bj][0] * acc[ai][bj][m][0], o1 = b1 + gv[bj][1] * acc[ai][bj][m][1];
                    u32x4 o; o.x = pk2(o0.x, o0.y); o.y = pk2(o0.z, o0.w); o.z = pk2(o1.x, o1.y); o.w = pk2(o1.z, o1.w);
                    *(u32x4*)(outp + off + bj * HALF) = o; } }
    }
};
struct EpiInproj0 {
    static constexpr bool PERM = true, AFTER_DRAIN = false;
    unsigned char* ws; const float* gmg; const float* qg; const float* kg; LAS float* P;
    __device__ __forceinline__ void operator()(f32x4 (&acc)[2][2][4][2], const Unit& u, int wr, int wc, int fr, int fq) const {
        int rl0 = wr * 64 + fr, cl0 = wc * 32 + 8 * fq; asm volatile("" : "+v"(rl0), "+v"(cl0));
        const int pn = u.pn; const size_t grow0 = (size_t)u.pm * BM;
        if (pn < 4) {
#pragma unroll
            for (int ai = 0; ai < 2; ++ai)
#pragma unroll
                for (int bj = 0; bj < 2; ++bj)
#pragma unroll
                    for (int m = 0; m < 4; ++m) { acc[ai][bj][m][0] = gelu4(acc[ai][bj][m][0]); acc[ai][bj][m][1] = gelu4(acc[ai][bj][m][1]); __builtin_amdgcn_sched_barrier(0); }
        }
        if (pn < 2 || pn == 7) {
            const size_t kvrow0 = (size_t)((u.pm / 33) * 2) * RPB + (size_t)(u.pm % 33) * BM;
            bf16_t* base = pn < 2 ? (bf16_t*)(ws + WS_U) + pn * BM + grow0 * 512 : (bf16_t*)(ws + WS_V) + kvrow0 * 128; const int ld = pn < 2 ? 512 : 128;
            const size_t bjs = pn < 2 ? (size_t)HALF : (size_t)RPB * 128;
#pragma unroll
            for (int ai = 0; ai < 2; ++ai)
#pragma unroll
                for (int m = 0; m < 4; ++m) { bf16_t* rowp = base + (size_t)(ai * HALF + m * 16 + rl0) * ld + cl0;
#pragma unroll
                    for (int bj = 0; bj < 2; ++bj) *(u32x4*)(rowp + bj * bjs) = pack8(acc[ai][bj][m][0], acc[ai][bj][m][1]); }
            return;
        }
#pragma unroll
        for (int ai = 0; ai < 2; ++ai)
#pragma unroll
            for (int m = 0; m < 4; ++m)
#pragma unroll
                for (int bj = 0; bj < 2; ++bj) { const f32x4 a0 = acc[ai][bj][m][0], a1 = acc[ai][bj][m][1];
                    float s = (a0.x * a0.x + a0.y * a0.y) + (a0.z * a0.z + a0.w * a0.w) + (a1.x * a1.x + a1.y * a1.y) + (a1.z * a1.z + a1.w * a1.w);
                    s += __shfl_xor(s, 16); s += __shfl_xor(s, 32);
                    if (fq == 0) P[((ai * HALF + m * 16 + rl0) * 2 + bj) * 4 + wc] = s; __builtin_amdgcn_sched_barrier(0); }
        asm volatile("s_waitcnt lgkmcnt(0)" ::: "memory"); __builtin_amdgcn_s_barrier(); asm volatile("" ::: "memory");
        if (pn < 4) {
            bf16_t* base = (bf16_t*)(ws + WS_VV) + (pn - 2) * BM; const float* gp = gmg + (pn - 2) * BM + cl0;
            f32x4 g8[2][2];
#pragma unroll
            for (int bj = 0; bj < 2; ++bj) { g8[bj][0] = *(const f32x4*)(gp + bj * HALF); g8[bj][1] = *(const f32x4*)(gp + bj * HALF + 4); }
#pragma unroll
            for (int ai = 0; ai < 2; ++ai)
#pragma unroll
                for (int m = 0; m < 4; ++m) { const int rl = ai * HALF + m * 16 + rl0; bf16_t* rowp = base + (grow0 + rl) * 512 + cl0;
#pragma unroll
                    for (int bj = 0; bj < 2; ++bj) { const f32x4 p = *(const LAS f32x4*)(P + (rl * 2 + bj) * 4);
                        const float rinv = rsqrtf(((p.x + p.y) + (p.z + p.w)) * (1.f / 128.f) + EPS);
                        *(u32x4*)(rowp + bj * HALF) = pack8(acc[ai][bj][m][0] * rinv * g8[bj][0], acc[ai][bj][m][1] * rinv * g8[bj][1]); }
                    asm volatile("" ::: "memory"); __builtin_amdgcn_sched_barrier(0); }
            return;
        }
        {
            const bool isq = pn < 6; const float* gn = isq ? qg : kg;
            const int grp = cl0 >> 3, fo = (grp >> 3) * 64 + (grp & 7) * 4;
            const f32x4 gA = *(const f32x4*)(gn + fo), gB = *(const f32x4*)(gn + fo + 32);
            const size_t kvrow0 = (size_t)((u.pm / 33) * 2) * RPB + (size_t)(u.pm % 33) * BM;
            bf16_t* base = isq ? (bf16_t*)(ws + WS_Q) + (pn - 4) * BM + grow0 * 512 : (bf16_t*)(ws + WS_K) + kvrow0 * 128; const int ld = isq ? 512 : 128;
            const size_t bjs = isq ? (size_t)HALF : (size_t)RPB * 128;
            const int tl = u.pm % 33; const bool lat = tl != 0; const int ax = grp >> 3, f0 = (grp & 7) * 4;
            const float* rope = (const float*)(ws + WS_ROPE);
#pragma unroll
            for (int ai = 0; ai < 2; ++ai)
#pragma unroll
                for (int m = 0; m < 4; ++m) { const int rl = ai * HALF + m * 16 + rl0; bf16_t* rowp = base + (size_t)rl * ld + cl0;
                    f32x4 cs0 = {1.f, 0.f, 1.f, 0.f}, cs1 = {1.f, 0.f, 1.f, 0.f};
                    if (lat) { const int t = (tl - 1) * 256 + rl; const int pos = ax == 0 ? (t >> 6) : (t & 63); const float* rp = rope + (pos * 32 + f0) * 2; cs0 = *(const f32x4*)rp; cs1 = *(const f32x4*)(rp + 4); }
#pragma unroll
                    for (int bj = 0; bj < 2; ++bj) { const f32x4 p = *(const LAS f32x4*)(P + (rl * 2 + bj) * 4);
                        const float rinv = rsqrtf(((p.x + p.y) + (p.z + p.w)) * (1.f / 128.f) + EPS);
                        const f32x4 x1 = acc[ai][bj][m][0] * rinv * gA, x2 = acc[ai][bj][m][1] * rinv * gB;
                        f32x4 o1, o2;
                        o1.x = x1.x * cs0.x - x2.x * cs0.y; o2.x = x2.x * cs0.x + x1.x * cs0.y;
                        o1.y = x1.y * cs0.z - x2.y * cs0.w; o2.y = x2.y * cs0.z + x1.y * cs0.w;
                        o1.z = x1.z * cs1.x - x2.z * cs1.y; o2.z = x2.z * cs1.x + x1.z * cs1.y;
                        o1.w = x1.w * cs1.z - x2.w * cs1.w; o2.w = x2.w * cs1.z + x1.w * cs1.w;
                        *(u32x4*)(rowp + bj * bjs) = pack8(o1, o2); }
                    asm volatile("" ::: "memory"); __builtin_amdgcn_sched_barrier(0); }
        }
    }
};

__device__ __forceinline__ f32x4 mma16(const bf16x8& b, const bf16x8& a, const f32x4& c) { return __builtin_amdgcn_mfma_f32_16x16x32_bf16(b, a, c, 0, 0, 0); }
__device__ __forceinline__ i32x4 mma16(const bf16x8& b, const bf16x8& a, const i32x4& c) { return __builtin_amdgcn_mfma_i32_16x16x64_i8(__builtin_bit_cast(i32x4, b), __builtin_bit_cast(i32x4, a), c, 0, 0, 0); }
template <bool I8> struct AccT { typedef f32x4 type; };
template <> struct AccT<true> { typedef i32x4 type; };
template <class Epi, class Sched, bool ALIGN_EPI = false, bool SP2 = false, bool I8 = false>
__device__ __forceinline__ void gemm_phase(LAS unsigned char* lds, const Gemm g, const Sched& S, const Epi& E) {
    const int tid = threadIdx.x, wid = __builtin_amdgcn_readfirstlane(tid >> 6), lane = tid & 63, wr = wid >> 2, wc = wid & 3, fr = lane & 15, fq = lane >> 4;
    const int K = g.K, KB = I8 ? K : 2 * K  , nt = KB / (BK * 2);
    unsigned voffA[2], voffB[2];
#pragma unroll
    for (int i = 0; i < 2; ++i) { int R, C; stage_rc(tid * 16 + i * 8192, R, C); const int Rb = Epi::PERM ? ((R & ~31) + perm32(R & 31)) : R;
        voffA[i] = (unsigned)(R * KB + C * 2); voffB[i] = (unsigned)(Rb * KB + C * 2); }
    const size_t kstep = (size_t)(BK * 2);
    const size_t hstep = (size_t)HALF * KB;
    const size_t tstep = 2 * hstep;
    const unsigned ldsw = (unsigned)wid * 1024u;
    const int aoff = lds_byte(wr * 64 + fr, fq * 8), boff = lds_byte(wc * 32 + fr, fq * 8);
#define PG8_SA(b, h) (((b) * 2 + (h)) * HTB)
#define PG8_SB(b, h) ((4 + (b) * 2 + (h)) * HTB)
#define PG8_STAGE(bufoff, gbase, voff) do { _Pragma("unroll") for (int _i = 0; _i < 2; ++_i) \
        __builtin_amdgcn_global_load_lds((const unsigned*)((const char*)(gbase) + (voff)[_i]), (LAS unsigned*)(lds + (bufoff) + ldsw + _i * 8192), 16, 0, 0); } while (0)
#define PG8_LDA(dst, b, h) do { _Pragma("unroll") for (int m = 0; m < 4; ++m) _Pragma("unroll") for (int k = 0; k < 2; ++k) dst[m][k] = *(const LAS bf16x8*)(lds + PG8_SA(b, h) + aoff + m * 2048 + k * 1024); } while (0)
#define PG8_LDB(dst, b, h) do { _Pragma("unroll") for (int n = 0; n < 2; ++n) _Pragma("unroll") for (int k = 0; k < 2; ++k) dst[n][k] = *(const LAS bf16x8*)(lds + PG8_SB(b, h) + boff + n * 2048 + k * 1024); } while (0)
#define PG8_MMA(ai, bj, At, Bt) do { __builtin_amdgcn_s_setprio(1); _Pragma("unroll") for (int m = 0; m < 4; ++m) _Pragma("unroll") for (int n = 0; n < 2; ++n) _Pragma("unroll") for (int k = 0; k < 2; ++k) \
        acc[ai][bj][m][n] = mma16(Bt[n][k], At[m][k], acc[ai][bj][m][n]); __builtin_amdgcn_s_setprio(0); } while (0)
#define PG8_WAIT_V(n) asm volatile("s_waitcnt vmcnt(" #n ")" ::: "memory")
#define PG8_WAIT_L(n) asm volatile("s_waitcnt lgkmcnt(" #n ")" ::: "memory")
#define PG8_BAR __builtin_amdgcn_s_barrier()
#define PG8_SCHED __builtin_amdgcn_sched_barrier(0)
    Unit cur, nxt; int ui = 0;
    if (!S.next(0, cur)) return;
    typedef typename AccT<I8>::type acc_t;
    acc_t acc[2][2][4][2];
#pragma unroll
    for (int a = 0; a < 2; ++a)
#pragma unroll
        for (int b = 0; b < 2; ++b)
#pragma unroll
            for (int m = 0; m < 4; ++m)
#pragma unroll
                for (int n = 0; n < 2; ++n) acc[a][b][m][n] = acc_t{};
    bf16x8 At[4][2], B0[2][2], B1[2][2];
    const char* cA = (const char*)g.A + (size_t)cur.pm * tstep; const char* cB = (const char*)g.Bt + (size_t)cur.pn * tstep;
    S.a_ready(cur);
    if constexpr (SP2) {
        PG8_STAGE(PG8_SB(0, 0), cB, voffB); PG8_STAGE(PG8_SB(0, 1), cB + hstep, voffB); PG8_STAGE(PG8_SA(0, 0), cA, voffA); PG8_STAGE(PG8_SA(0, 1), cA + hstep, voffA);
        if (wr == 1) PG8_BAR;
        PG8_WAIT_V(2); PG8_BAR;
        PG8_STAGE(PG8_SB(1, 0), cB + kstep, voffB); PG8_STAGE(PG8_SA(1, 0), cA + kstep, voffA); PG8_STAGE(PG8_SB(1, 1), cB + hstep + kstep, voffB);
        PG8_WAIT_V(6); PG8_BAR;
    } else {
        PG8_STAGE(PG8_SB(0, 0), cB, voffB); PG8_STAGE(PG8_SA(0, 0), cA, voffA); PG8_STAGE(PG8_SB(0, 1), cB + hstep, voffB); PG8_STAGE(PG8_SA(0, 1), cA + hstep, voffA);
        if (wr == 1) PG8_BAR;
        PG8_WAIT_V(4); PG8_BAR;
        PG8_STAGE(PG8_SB(1, 0), cB + kstep, voffB); PG8_STAGE(PG8_SA(1, 0), cA + kstep, voffA); PG8_STAGE(PG8_SB(1, 1), cB + hstep + kstep, voffB);
        PG8_WAIT_V(6); PG8_BAR;
    }
    for (;;) {
        const bool has_next = S.next(ui + 1, nxt);
        const char* nA = has_next ? (const char*)g.A + (size_t)nxt.pm * tstep : cA; const char* nB = has_next ? (const char*)g.Bt + (size_t)nxt.pn * tstep : cB;
        for (int t = 0; t < nt; t += 2) {
            const bool last = (t == nt - 2);
            const char* a1 = cA + (size_t)(t + 1) * kstep;
            const char* a2 = last ? nA : cA + (size_t)(t + 2) * kstep; const char* b2 = last ? nB : cB + (size_t)(t + 2) * kstep;
            const char* a3 = a2 + kstep; const char* b3 = b2 + kstep;
            if (last && has_next) S.a_ready(nxt);
            if constexpr (SP2) {
            PG8_LDB(B0, 0, 0); PG8_LDB(B1, 0, 1); PG8_SCHED; PG8_LDA(At, 0, 0); PG8_STAGE(PG8_SA(1, 1), a1 + hstep, voffA);
            PG8_WAIT_V(8); PG8_WAIT_L(0); PG8_BAR; PG8_MMA(0, 0, At, B0); PG8_MMA(0, 1, At, B1); PG8_BAR; PG8_SCHED;
            PG8_LDA(At, 0, 1); PG8_STAGE(PG8_SB(0, 0), b2, voffB); PG8_STAGE(PG8_SB(0, 1), b2 + hstep, voffB); PG8_STAGE(PG8_SA(0, 0), a2, voffA);
            PG8_WAIT_V(8); PG8_WAIT_L(0); PG8_BAR; PG8_MMA(1, 0, At, B0); PG8_MMA(1, 1, At, B1); PG8_BAR; PG8_SCHED;
            PG8_LDB(B0, 1, 0); PG8_LDB(B1, 1, 1); PG8_SCHED; PG8_LDA(At, 1, 0); PG8_STAGE(PG8_SA(0, 1), a2 + hstep, voffA);
            PG8_WAIT_V(8); PG8_WAIT_L(0); PG8_BAR; PG8_MMA(0, 0, At, B0); PG8_MMA(0, 1, At, B1); PG8_BAR; PG8_SCHED;
            PG8_LDA(At, 1, 1); PG8_STAGE(PG8_SB(1, 0), b3, voffB); PG8_STAGE(PG8_SB(1, 1), b3 + hstep, voffB); PG8_STAGE(PG8_SA(1, 0), a3, voffA);
            PG8_WAIT_V(8); PG8_WAIT_L(0); PG8_BAR; PG8_MMA(1, 0, At, B0); PG8_MMA(1, 1, At, B1); PG8_BAR; PG8_SCHED;
            } else {
            PG8_LDB(B0, 0, 0); PG8_SCHED; PG8_LDA(At, 0, 0); PG8_STAGE(PG8_SA(1, 1), a1 + hstep, voffA);
            PG8_WAIT_L(8); PG8_BAR; PG8_WAIT_L(0); PG8_MMA(0, 0, At, B0); PG8_BAR; PG8_SCHED;
            PG8_LDB(B1, 0, 1); PG8_STAGE(PG8_SB(0, 0), b2, voffB);
            PG8_BAR; PG8_WAIT_L(0); PG8_MMA(0, 1, At, B1); PG8_BAR;
            PG8_LDA(At, 0, 1); PG8_STAGE(PG8_SA(0, 0), a2, voffA);
            PG8_BAR; PG8_WAIT_L(0); PG8_MMA(1, 0, At, B0); PG8_BAR; PG8_SCHED;
            PG8_STAGE(PG8_SB(0, 1), b2 + hstep, voffB);
            PG8_WAIT_V(6); PG8_BAR; PG8_MMA(1, 1, At, B1); PG8_BAR;
            PG8_LDB(B0, 1, 0); PG8_SCHED; PG8_LDA(At, 1, 0); PG8_STAGE(PG8_SA(0, 1), a2 + hstep, voffA);
            PG8_WAIT_L(8); PG8_BAR; PG8_WAIT_L(0); PG8_MMA(0, 0, At, B0); PG8_BAR; PG8_SCHED;
            PG8_LDB(B1, 1, 1); PG8_STAGE(PG8_SB(1, 0), b3, voffB);
            PG8_BAR; PG8_WAIT_L(0); PG8_MMA(0, 1, At, B1); PG8_BAR;
            PG8_LDA(At, 1, 1); PG8_STAGE(PG8_SA(1, 0), a3, voffA);
            PG8_BAR; PG8_WAIT_L(0); PG8_MMA(1, 0, At, B0); PG8_BAR; PG8_SCHED;
            PG8_STAGE(PG8_SB(1, 1), b3 + hstep, voffB);
            PG8_WAIT_V(6); PG8_BAR; PG8_MMA(1, 1, At, B1); PG8_BAR;
            }
        }
        if constexpr (ALIGN_EPI) { if (wr == 0) PG8_BAR; }
        if constexpr (!Epi::AFTER_DRAIN) {
            if constexpr (I8) {
                f32x4 accf[2][2][4][2];
                { int rl0 = wr * 64 + fr, cl0 = wc * 32 + 8 * fq; asm volatile("" : "+v"(rl0), "+v"(cl0));
                  const float* sap = g.sa + (size_t)cur.pm * BM + rl0; const float* swp = g.sw + (size_t)cur.pn * BM + cl0;
                  f32x4 cs[2][2];
#pragma unroll
                  for (int bj = 0; bj < 2; ++bj) { cs[bj][0] = *(const f32x4*)(swp + bj * HALF); cs[bj][1] = *(const f32x4*)(swp + bj * HALF + 4); }
#pragma unroll
                  for (int ai = 0; ai < 2; ++ai)
#pragma unroll
                    for (int m = 0; m < 4; ++m) { const float rs = sap[ai * HALF + m * 16];
#pragma unroll
                        for (int bj = 0; bj < 2; ++bj)
#pragma unroll
                            for (int n = 0; n < 2; ++n) accf[ai][bj][m][n] = __builtin_convertvector(acc[ai][bj][m][n], f32x4) * (cs[bj][n] * rs); } }
                E(accf, cur, wr, wc, fr, fq);
            } else { E(acc, cur, wr, wc, fr, fq); }
            S.done(cur); }
        if (!has_next) break;
#pragma unroll
        for (int a = 0; a < 2; ++a)
#pragma unroll
            for (int b = 0; b < 2; ++b)
#pragma unroll
                for (int m = 0; m < 4; ++m)
#pragma unroll
                    for (int n = 0; n < 2; ++n) acc[a][b][m][n] = acc_t{};
        cur = nxt; cA = nA; cB = nB; ++ui;
        if constexpr (ALIGN_EPI) { if (wr == 1) PG8_BAR; }
    }
    PG8_WAIT_V(0);
    if constexpr (!ALIGN_EPI) { if (wr == 0) PG8_BAR; }
    PG8_BAR;
#undef PG8_SA
#undef PG8_SB
#undef PG8_STAGE
#undef PG8_LDA
#undef PG8_LDB
#undef PG8_MMA
#undef PG8_WAIT_V
#undef PG8_WAIT_L
#undef PG8_BAR
#undef PG8_SCHED
}
}

__device__ __forceinline__ void fphase_inproj0(const Args& a, char* lds) {
    pg8::Gemm g{(const bf16_t*)(a.ws + WS_H8), (const bf16_t*)(a.ws + WS_W8IN0), MTOT, 2048, 1024, (const float*)(a.ws + WS_SH), (const float*)(a.ws + WS_SW)};
    pg8::StaticOrder S; S.init(MTOT, 2048, (int)gridDim.x, (int)blockIdx.x);
    pg8::EpiInproj0 E{a.ws, a.in[9], a.in[12], a.in[13], (LAS float*)((LAS char*)lds + 131072)};
    pg8::gemm_phase<pg8::EpiInproj0, pg8::StaticOrder, true, true, true>((LAS unsigned char*)lds, g, S, E);
    const int G = (int)gridDim.x, nbusy = 528 - 2 * G;
    if (G == 256 && (int)blockIdx.x >= nbusy) quant_tables(a, 0, ((int)blockIdx.x - nbusy) * NWAVE + (int)(threadIdx.x >> 6), (G - nbusy) * NWAVE, (int)(threadIdx.x & 63), 0, NEXP);
    else if (G != 256) quant_tables(a, 0, (int)blockIdx.x * NWAVE + (int)(threadIdx.x >> 6), G * NWAVE, (int)(threadIdx.x & 63), 0, NEXP);
}
__device__ __forceinline__ void fphase_outproj0(const Args& a, char* lds) {
    pg8::Gemm g{(const bf16_t*)(a.ws + WS_AO), (const bf16_t*)(a.ws + WS_WOUT0), MTOT, 1024, 1024, nullptr, nullptr};
    pg8::StaticOrder S; S.init(MTOT, 1024, (int)gridDim.x, (int)blockIdx.x);
    pg8::EpiResid E{a.in[0], a.in[2], (const float*)(a.ws + WS_MODV) + 2 * 1024, (bf16_t*)(a.ws + WS_X1), 0};
    pg8::gemm_phase<pg8::EpiResid, pg8::StaticOrder, true, true>((LAS unsigned char*)lds, g, S, E);
    const int G = (int)gridDim.x, nbusy = (G == 256) ? 264 - G : 0;
    if ((int)blockIdx.x >= nbusy) quant_tables(a, 0, ((int)blockIdx.x - nbusy) * NWAVE + (int)(threadIdx.x >> 6), (G - nbusy) * NWAVE, (int)(threadIdx.x & 63), NEXP, 2 * NEXP);
}
__device__ __forceinline__ void fphase_peerq0(const Args& a, char* lds) {
    pg8::Gemm g{(const bf16_t*)(a.ws + WS_H8), (const bf16_t*)(a.ws + WS_W8Q), MTOT, 2048, 1024, (const float*)(a.ws + WS_SH), (const float*)(a.ws + WS_SW) + 2048};
    pg8::StaticOrder S; S.init(MTOT, 2048, (int)gridDim.x, (int)blockIdx.x);
    pg8::EpiStore E{(bf16_t*)(a.ws + WS_QP), (bf16_t*)(a.ws + WS_QP), 2048, 1000, 0};
    pg8::gemm_phase<pg8::EpiStore, pg8::StaticOrder, true, true, true>((LAS unsigned char*)lds, g, S, E);
    const int G = (int)gridDim.x, nbusy = (G == 256) ? 528 - 2 * G : 0;
    if ((int)blockIdx.x >= nbusy) for (int r = (int)blockIdx.x - nbusy; r < 208; r += G - nbusy) prep_l1_item(a, (float*)lds, 160 + r);
    if ((int)blockIdx.x >= nbusy) quant_tables(a, 1, ((int)blockIdx.x - nbusy) * NWAVE + (int)(threadIdx.x >> 6), (G - nbusy) * NWAVE, (int)(threadIdx.x & 63), 0, NEXP / 2);
}
__device__ __forceinline__ void fphase_inproj1(const Args& a, char* lds) {
    pg8::Gemm g{(const bf16_t*)(a.ws + WS_H8B), (const bf16_t*)(a.ws + WS_W8IN1), MTOT, 2560, 1024, (const float*)(a.ws + WS_SH), (const float*)(a.ws + WS_SW) + 3 * 2048};
    pg8::StaticOrder S; S.init(MTOT, 2560, (int)gridDim.x, (int)blockIdx.x);
    pg8::EpiStore E{(bf16_t*)(a.ws + WS_GG), (bf16_t*)(a.ws + WS_XR), 1280, 5, 5};
    pg8::gemm_phase<pg8::EpiStore, pg8::StaticOrder, true, true, true>((LAS unsigned char*)lds, g, S, E);
    const int G = (int)gridDim.x, nbusy = 660 - 2 * G;
    if (G == 256 && (int)blockIdx.x >= nbusy) quant_tables(a, 1, ((int)blockIdx.x - nbusy) * NWAVE + (int)(threadIdx.x >> 6), (G - nbusy) * NWAVE, (int)(threadIdx.x & 63), NEXP / 2, NEXP);
    else if (G != 256) quant_tables(a, 1, (int)blockIdx.x * NWAVE + (int)(threadIdx.x >> 6), G * NWAVE, (int)(threadIdx.x & 63), NEXP / 2, NEXP);
}
__device__ __forceinline__ void fphase_outproj1(const Args& a, char* lds) {
    pg8::Gemm g{(const bf16_t*)(a.ws + WS_YG), (const bf16_t*)(a.ws + WS_WOUT1), MTOT, 1024, 1280, nullptr, nullptr};
    pg8::LatentOrder S; S.init(1024, (int)gridDim.x, (int)blockIdx.x);
    pg8::EpiResid E{a.in[0], a.in[2], (const float*)(a.ws + WS_MODV) + 3 * 6144 + 2 * 1024, (bf16_t*)(a.ws + WS_X1), 1};
    pg8::gemm_phase<pg8::EpiResid, pg8::LatentOrder, true, true>((LAS unsigned char*)lds, g, S, E);
}
__device__ __forceinline__ void fphase_peerq1(const Args& a, char* lds) {
    pg8::Gemm g{(const bf16_t*)(a.ws + WS_H8), (const bf16_t*)(a.ws + WS_W8Q + (size_t)2048 * 1024), MTOT, 2048, 1024, (const float*)(a.ws + WS_SH), (const float*)(a.ws + WS_SW) + 2 * 2048};
    pg8::LatentOrder S; S.init(2048, (int)gridDim.x, (int)blockIdx.x);
    pg8::EpiStore E{(bf16_t*)(a.ws + WS_QP), (bf16_t*)(a.ws + WS_QP), 2048, 1000, 0};
    pg8::gemm_phase<pg8::EpiStore, pg8::LatentOrder, true, true, true>((LAS unsigned char*)lds, g, S, E);
}

constexpr int NPHASE = 23;
__global__ void __launch_bounds__(NTHR, 2) mega(Args a) {
    extern __shared__ __attribute__((aligned(16))) char lds[];
    volatile LAS unsigned* MISC = (volatile LAS unsigned*)((LAS char*)lds + LDS_MISC);
    if (threadIdx.x < 64) MISC[threadIdx.x] = 0u;
    __syncthreads();
    XcdBarrier bar; bar.bar = (unsigned*)(a.ws + WS_CTL) + 4096; bar.x = 0; bar.st = nullptr;
    const bool multi = (a.ph_hi - a.ph_lo) > 1;
    if (multi) bar = xcd_barrier_post((unsigned*)(a.ws + WS_CTL) + 4096, MISC + 8);
    const int lo = a.ph_lo, hi = a.ph_hi;
    unsigned char* ws = a.ws;
#define IN(k) (lo <= (k) && (k) < hi)
#define SEAM(k) do { if (IN(k) && IN((k) + 1)) xcd_barrier(bar); } while (0)
#ifndef PROBE_DUP
#define PROBE_DUP 0u
#endif
#define DUPQ(k) (((PROBE_DUP >> (k)) & 1u) != 0u)
    if (IN(0)) { phase_prep(a, lds); if (DUPQ(0)) { xcd_barrier(bar); phase_prep(a, lds); } } SEAM(0);
    if (IN(1)) { phase_norm(a, 0, 0, a.in[6], 0, 1, false, true);
        { const int gwq = blockIdx.x * NWAVE + (threadIdx.x >> 6), ngwq = gridDim.x * NWAVE, lq = threadIdx.x & 63;
          quant_wrows((const bf16_t*)(ws + WS_WIN0), ws + WS_W8IN0, (float*)(ws + WS_SW), 2048, gwq, ngwq, lq);
          quant_wrows((const bf16_t*)(ws + WS_WQ), ws + WS_W8Q, (float*)(ws + WS_SW) + 2048, 2048, gwq, ngwq, lq); } } SEAM(1);
    if (IN(2)) { fphase_inproj0(a, lds); if (DUPQ(2)) { xcd_barrier(bar); fphase_inproj0(a, lds); } } SEAM(2);
    if (IN(3)) { phase_gmlp2(a, lds); phase_attn(a, lds); if (DUPQ(3)) { xcd_barrier(bar); phase_gmlp2(a, lds); phase_attn(a, lds); } } SEAM(3);
    if (IN(4)) { fphase_outproj0(a, lds); if (DUPQ(4)) { xcd_barrier(bar); fphase_outproj0(a, lds); } } SEAM(4);
    if (IN(5)) { phase_norm(a, 0, 1, a.in[7], 3, 4, false, true); if (DUPQ(5)) { xcd_barrier(bar); phase_norm(a, 0, 1, a.in[7], 3, 4, false, true); } } SEAM(5);
    if (IN(6)) { fphase_peerq0(a, lds); if (DUPQ(6)) { xcd_barrier(bar); fphase_peerq0(a, lds); } if (IN(7)) topk_load_keys(a, lds, 0); } SEAM(6);
    if (IN(7)) { phase_peer_topk3(a, lds, 0, false, IN(6)); if (DUPQ(7)) { xcd_barrier(bar); phase_peer_topk3(a, lds, 0, false); } } SEAM(7);
    if (IN(8)) { phase_gu(a, lds, 0, 0); if (DUPQ(8)) { xcd_barrier(bar); phase_gu(a, lds, 0, 0); } } SEAM(8);
    if (IN(9)) { phase_gact(a, 0, 0);
        { const int gwq = blockIdx.x * NWAVE + (threadIdx.x >> 6), ngwq = gridDim.x * NWAVE, lq = threadIdx.x & 63;
          quant_wrows((const bf16_t*)(ws + WS_WIN1), ws + WS_W8IN1, (float*)(ws + WS_SW) + 3 * 2048, 2560, gwq, ngwq, lq);
          quant_wrows((const bf16_t*)(ws + WS_WQ) + (size_t)2048 * 1024, ws + WS_W8Q + (size_t)2048 * 1024, (float*)(ws + WS_SW) + 2 * 2048, 2048, gwq, ngwq, lq); } } SEAM(9);
    if (IN(10)) { phase_gv(a, lds, 0, 0); if (DUPQ(10)) { xcd_barrier(bar); phase_gv(a, lds, 0, 0); } } SEAM(10);
    if (IN(11)) { phase_norm(a, 1, 1, a.in[6] + D, 0, 1, false, true, WS_H8B); } SEAM(11);
    if (IN(12)) { fphase_inproj1(a, lds); if (DUPQ(12)) { xcd_barrier(bar); fphase_inproj1(a, lds); } } SEAM(12);
    if (IN(13)) { phase_rglru2(a, lds, 0); if (DUPQ(13)) { xcd_barrier(bar); phase_rglru2(a, lds, 0); } } SEAM(13);
    if (IN(14)) { phase_rglru_out(a, lds); if (DUPQ(14)) { xcd_barrier(bar); phase_rglru_out(a, lds); } } SEAM(14);
    if (IN(15)) { fphase_outproj1(a, lds); if (DUPQ(15)) { xcd_barrier(bar); fphase_outproj1(a, lds); } } SEAM(15);
    if (IN(16)) { phase_norm(a, 1, 1, a.in[7] + D, 3, 4, true, true); if (DUPQ(16)) { xcd_barrier(bar); phase_norm(a, 1, 1, a.in[7] + D, 3, 4, true, true); } } SEAM(16);
    if (IN(17)) { fphase_peerq1(a, lds); if (DUPQ(17)) { xcd_barrier(bar); fphase_peerq1(a, lds); } if (IN(18)) topk_load_keys(a, lds, 1); } SEAM(17);
    if (IN(18)) { phase_peer_topk3(a, lds, 1, true, IN(17)); if (DUPQ(18)) { xcd_barrier(bar); phase_peer_topk3(a, lds, 1, true); } } SEAM(18);
    if (IN(19)) { phase_gu(a, lds, 1, 1); if (DUPQ(19)) { xcd_barrier(bar); phase_gu(a, lds, 1, 1); } } SEAM(19);
    if (IN(20)) { phase_gact(a, 1, 1); if (DUPQ(20)) { xcd_barrier(bar); phase_gact(a, 1, 1); } } SEAM(20);
    if (IN(21)) { phase_gv(a, lds, 1, 1); if (DUPQ(21)) { xcd_barrier(bar); phase_gv(a, lds, 1, 1); } } SEAM(21);
    if (IN(22)) { phase_finalnorm(a); if (DUPQ(22)) { xcd_barrier(bar); phase_finalnorm(a); } }
#undef IN
#undef SEAM
}

extern "C" void kernel_launch(void* const* d_in, const int* in_sizes, int n_in, void* d_out, int out_size, void* d_ws, size_t ws_size, hipStream_t stream) {
    static int grid = 0;
    if (grid == 0) {
        if (n_in != 29 || out_size != NB * SEQ * D || ws_size < WS_END) {
            fprintf(stderr, "kernel_launch: unexpected shapes: n_in %d out %d ws %zu (need %zu)\n", n_in, out_size, ws_size, (size_t)WS_END); grid = -1; return; }
        int dev = 0, cus = 0, per_cu = 0;
        if (hipGetDevice(&dev) != hipSuccess || hipDeviceGetAttribute(&cus, hipDeviceAttributeMultiprocessorCount, dev) != hipSuccess) { grid = -1; return; }
        if (hipFuncSetAttribute((const void*)mega, hipFuncAttributeMaxDynamicSharedMemorySize, LDS_BYTES) != hipSuccess) { fprintf(stderr, "kernel_launch: hipFuncSetAttribute failed\n"); grid = -1; return; }
        if (hipOccupancyMaxActiveBlocksPerMultiprocessor(&per_cu, (const void*)mega, NTHR, LDS_BYTES) != hipSuccess || per_cu < 1)
            fprintf(stderr, "kernel_launch: occupancy query reports %d blocks per CU\n", per_cu);
        (void)hipGetLastError();
        grid = cus & ~7; if (grid < 8) grid = 8;
    }
    if (grid < 0) return;
    (void)hipMemsetAsync((char*)d_ws + WS_CTL + 16384, 0, 16384, stream);
    Args a{};
    for (int i = 0; i < 29; ++i) a.in[i] = (const float*)d_in[i];
    a.out = (float*)d_out; a.ws = (unsigned char*)d_ws;
#if MK_SINGLE
    a.ph_lo = 0; a.ph_hi = NPHASE;
    hipLaunchKernelGGL(mega, dim3(grid), dim3(NTHR), LDS_BYTES, stream, a);
#else
    for (int p = 0; p < NPHASE; ++p) { a.ph_lo = p; a.ph_hi = p + 1; hipLaunchKernelGGL(mega, dim3(grid), dim3(NTHR), LDS_BYTES, stream, a); }
#endif
    const hipError_t le = hipPeekAtLastError();
    if (le != hipSuccess) fprintf(stderr, "kernel_launch: launch failed: %s\n", hipGetErrorName(le));
}
```

```cpp
#include <hip/hip_runtime.h>
#include <cstdio>
#include <cstdint>

#ifndef MK_SINGLE
#define MK_SINGLE 1
#endif

#define GAS __attribute__((address_space(1)))
#define LAS __attribute__((address_space(3)))

typedef unsigned short bf16_t;
typedef short bf16x8 __attribute__((ext_vector_type(8)));
typedef float f32x4 __attribute__((ext_vector_type(4)));
typedef float f32x16 __attribute__((ext_vector_type(16)));
typedef unsigned u32x4 __attribute__((ext_vector_type(4)));
typedef unsigned u32x2 __attribute__((ext_vector_type(2)));
typedef int i32x4 __attribute__((ext_vector_type(4)));

constexpr int D = 1024, NB = 2, SEQ = 8192, CTXL = 256;
constexpr int RPB = SEQ + CTXL;
constexpr int MTOT = NB * RPB;
constexpr int AB_IN = 2048, A_W = 512, DRNN = 1280, NEXP = 16384;
constexpr float EPS = 1e-6f;
constexpr int NTHR = 512, NWAVE = 8;

constexpr size_t MiB = 1u << 20;
constexpr size_t WS_CTL = 0, CTL_BYTES = 1 * MiB;
constexpr size_t WS_MODV = 1 * MiB;
constexpr size_t WS_ROPE = 1 * MiB + 512 * 1024;
constexpr size_t WS_WIN0 = 2 * MiB;
constexpr size_t WS_WOUT0 = 6 * MiB;
constexpr size_t WS_WIN1 = 8 * MiB;
constexpr size_t WS_WOUT1 = 13 * MiB;
constexpr size_t WS_WQ = 16 * MiB;
constexpr size_t WS_KEYS = 24 * MiB;
constexpr size_t WS_GWS = 25 * MiB;
constexpr size_t WS_WAT = 26 * MiB;
constexpr size_t WS_WXT = 27 * MiB;
constexpr size_t WS_CARRY = 28 * MiB;
constexpr size_t WS_SPL = 30 * MiB + 768 * 1024;
constexpr size_t WS_SCU = 31 * MiB;
constexpr size_t WS_SCV = 31 * MiB + 512 * 1024;
constexpr size_t WS_PU = 32 * MiB;
constexpr size_t WS_PV = 96 * MiB;
constexpr size_t WS_H = 160 * MiB;
constexpr size_t WS_X1 = 193 * MiB;
constexpr size_t WS_SELI = 259 * MiB;
constexpr size_t WS_SELG = 268 * MiB;
constexpr size_t WS_R = 277 * MiB;
constexpr size_t WS_U = WS_R;
constexpr size_t WS_VV = WS_R + 17 * MiB;
constexpr size_t WS_Q = WS_R + 34 * MiB;
constexpr size_t WS_K = WS_R + 51 * MiB;
constexpr size_t WS_V = WS_R + 60 * MiB;
constexpr size_t WS_AO = WS_R + 69 * MiB;
constexpr size_t WS_QP = WS_R;
constexpr size_t WS_H8B = WS_R + 90 * MiB;
constexpr size_t WS_H8 = WS_R + 70 * MiB;
constexpr size_t WS_SH = WS_R + 88 * MiB;
constexpr size_t WS_ACT16 = WS_R + 89 * MiB;
constexpr size_t WS_SA = WS_R + 94 * MiB;
constexpr size_t WS_SACT = WS_R + 94 * MiB + 512 * 1024;
constexpr size_t WS_PART = WS_R;
constexpr size_t WS_GG = WS_R;
constexpr size_t WS_XR = WS_R + 42 * MiB;
constexpr size_t WS_YG = WS_R + 84 * MiB;
constexpr size_t WS_W8IN0 = WS_R + 126 * MiB;
constexpr size_t WS_W8Q = WS_R + 128 * MiB;
constexpr size_t WS_W8IN1 = WS_R + 132 * MiB;
constexpr size_t WS_SW = WS_R + 135 * MiB;
constexpr size_t WS_STR = 128 * MiB;
constexpr size_t WS_STU = WS_R + 136 * MiB;
constexpr size_t WS_STS = WS_R + 180 * MiB;
constexpr size_t WS_END = WS_R + 183 * MiB;

constexpr int LDS_BYTES = 147456;
constexpr int LDS_MISC = 145408;

__device__ __forceinline__ float bf2f(bf16_t v) { return __uint_as_float(((unsigned)v) << 16); }
__device__ __forceinline__ unsigned pk2(float lo, float hi) { unsigned r; asm("v_cvt_pk_bf16_f32 %0, %1, %2" : "=v"(r) : "v"(lo), "v"(hi)); return r; }
__device__ __forceinline__ unsigned f2bf(float f) { return pk2(f, f) & 0xffffu; }
__device__ __forceinline__ float bflo(unsigned w) { return __uint_as_float(w << 16); }
__device__ __forceinline__ float bfhi(unsigned w) { return __uint_as_float(w & 0xffff0000u); }
__device__ __forceinline__ float gelu_t(float x) { const float y = -2.302208198144325f * (x + 0.044715f * x * x * x); return x * __builtin_amdgcn_rcpf(1.f + __builtin_amdgcn_exp2f(y)); }
__device__ __forceinline__ float sigmoidf_(float x) { return 1.f / (1.f + __expf(-x)); }
#define WDPP(v, ctrl) __builtin_amdgcn_update_dpp(0, (v), (ctrl), 0xf, 0xf, true)
#define PRIO_YOUNG_ON()  do { if (__builtin_amdgcn_readfirstlane(threadIdx.x) >= 256) __builtin_amdgcn_s_setprio(1); } while (0)
#define PRIO_YOUNG_OFF() __builtin_amdgcn_s_setprio(0)
__device__ __forceinline__ float wave_sum(float v) {
    v += __int_as_float(WDPP(__float_as_int(v), 0xB1)); v += __int_as_float(WDPP(__float_as_int(v), 0x4E));
    v += __int_as_float(WDPP(__float_as_int(v), 0x141)); v += __int_as_float(WDPP(__float_as_int(v), 0x140));
    { const auto r = __builtin_amdgcn_permlane16_swap(__float_as_uint(v), __float_as_uint(v), false, false); v = __uint_as_float(r[0]) + __uint_as_float(r[1]); }
    { const auto r = __builtin_amdgcn_permlane32_swap(__float_as_uint(v), __float_as_uint(v), false, false); v = __uint_as_float(r[0]) + __uint_as_float(r[1]); }
    return v;
}
__device__ __forceinline__ float wave_max(float v) {
    v = fmaxf(v, __int_as_float(WDPP(__float_as_int(v), 0xB1))); v = fmaxf(v, __int_as_float(WDPP(__float_as_int(v), 0x4E)));
    v = fmaxf(v, __int_as_float(WDPP(__float_as_int(v), 0x141))); v = fmaxf(v, __int_as_float(WDPP(__float_as_int(v), 0x140)));
    { const auto r = __builtin_amdgcn_permlane16_swap(__float_as_uint(v), __float_as_uint(v), false, false); v = fmaxf(__uint_as_float(r[0]), __uint_as_float(r[1])); }
    { const auto r = __builtin_amdgcn_permlane32_swap(__float_as_uint(v), __float_as_uint(v), false, false); v = fmaxf(__uint_as_float(r[0]), __uint_as_float(r[1])); }
    return v;
}
__device__ __forceinline__ int wave_sum_i(int v) {
    v += WDPP(v, 0xB1); v += WDPP(v, 0x4E); v += WDPP(v, 0x141); v += WDPP(v, 0x140);
    { const auto r = __builtin_amdgcn_permlane16_swap((unsigned)v, (unsigned)v, false, false); v = (int)(r[0] + r[1]); }
    { const auto r = __builtin_amdgcn_permlane32_swap((unsigned)v, (unsigned)v, false, false); v = (int)(r[0] + r[1]); }
    return v;
}
__host__ __device__ __forceinline__ int sigma_head(int j) { const int grp = j >> 3, n = (j >> 2) & 1, e = j & 3; return (grp >> 3) * 64 + n * 32 + (grp & 7) * 4 + e; }

struct Args {
    const float* in[29];
    float* out;
    unsigned char* ws;
    int ph_lo, ph_hi;
};

__device__ __forceinline__ int row_variant(int g) { const int b = g / RPB, i = g - b * RPB; return i < CTXL ? 2 : b; }
__device__ __forceinline__ const float* row_src(const Args& a, int g) {
    const int b = g / RPB, i = g - b * RPB;
    return i < CTXL ? a.in[2] + ((size_t)b * CTXL + i) * D : a.in[0] + ((size_t)b * SEQ + (i - CTXL)) * D;
}
__device__ __forceinline__ const float* modv(const Args& a, int layer, int variant, int which) {
    return (const float*)(a.ws + WS_MODV) + ((size_t)(layer * 3 + variant) * 6 + which) * D;
}

#define XB_TMO      128
#define XB_XCNT(j)  (256  + 64 * (j))
#define XB_XSUB(j)  (1280 + 64 * (j))
#define XB_XGEN(j)  (2304 + 64 * (j))
#define XB_TOP      3328
#define XB_TOPGEN   3392
#define XCD_BAR_WORDS 3456
#define XB_SPIN_CAP (1u << 22)
__device__ __forceinline__ unsigned xb_ld(unsigned* p)              { return __hip_atomic_load(p, __ATOMIC_RELAXED, __HIP_MEMORY_SCOPE_AGENT); }
__device__ __forceinline__ unsigned xb_add(unsigned* p, unsigned v) { return __hip_atomic_fetch_add(p, v, __ATOMIC_RELAXED, __HIP_MEMORY_SCOPE_AGENT); }
__device__ __forceinline__ unsigned xb_xcc_id() { return (unsigned)__builtin_amdgcn_s_getreg((3 << 11) | 20) & 0xFu; }
#define XB_SPIN(cond, bar) do { unsigned _sp = 0; while (cond) { __builtin_amdgcn_s_sleep(1); \
    if ((++_sp & 255u) == 0u) { if (xb_ld(&(bar)[XB_TMO])) break; if (_sp > XB_SPIN_CAP) { atomicAdd(&(bar)[XB_TMO], 1u); break; } } } } while (0)
struct XcdBarrier { unsigned* bar; unsigned x; volatile LAS unsigned* st; };
__device__ __forceinline__ XcdBarrier xcd_barrier_post(unsigned* bar, volatile LAS unsigned* st) {
    XcdBarrier b; b.bar = bar; b.x = xb_xcc_id(); b.st = st;
    if (threadIdx.x == 0) (void)xb_add(&bar[XB_XCNT(b.x)], 1u);
    return b;
}
__device__ __forceinline__ void xcd_barrier_complete(unsigned* bar, unsigned x, unsigned& nloc, unsigned& nx) {
    const unsigned G = gridDim.x * gridDim.y * gridDim.z;
    unsigned sum, cnt, mine, sp = 0u;
    for (;;) {
        sum = 0u; cnt = 0u; mine = 0u;
#pragma unroll
        for (unsigned j = 0; j < 16; ++j) { const unsigned c = xb_ld(&bar[XB_XCNT(j)]); sum += c; cnt += (c > 0u) ? 1u : 0u; mine = (j == x) ? c : mine; }
        if (sum == G) break;
        __builtin_amdgcn_s_sleep(1);
        if ((++sp & 255u) == 0u) { if (xb_ld(&bar[XB_TMO])) break; if (sp > XB_SPIN_CAP) { atomicAdd(&bar[XB_TMO], 1u); break; } }
    }
    nloc = mine > 0u ? mine : 1u; nx = cnt > 0u ? cnt : 1u;
}
__device__ __forceinline__ void xcd_barrier(const XcdBarrier& b) {
    asm volatile("s_waitcnt vmcnt(0)" ::: "memory");
    __syncthreads();
    if (threadIdx.x == 0) {
        unsigned* bar = b.bar;
        __builtin_amdgcn_s_waitcnt(0);
        unsigned nloc = b.st[0], nx = b.st[1];
        if (nloc == 0u) { xcd_barrier_complete(bar, b.x, nloc, nx); b.st[0] = nloc; b.st[1] = nx; }
        const unsigned old = xb_add(&bar[XB_XSUB(b.x)], 1u);
        const unsigned gen = old / nloc;
        if (old + 1u == (gen + 1u) * nloc) {
            __builtin_amdgcn_fence(__ATOMIC_RELEASE, "agent");
            asm volatile("s_waitcnt vmcnt(0)" ::: "memory");
            (void)xb_add(&bar[XB_TOP], 1u);
        }
        XB_SPIN(xb_ld(&bar[XB_TOP]) < (gen + 1u) * nx, bar);
        __builtin_amdgcn_fence(__ATOMIC_ACQUIRE, "agent");
        asm volatile("s_waitcnt vmcnt(0)" ::: "memory");
    }
    __syncthreads();
}

__device__ __forceinline__ void qt_load(f32x4 (&v)[4][4], const Args& a, int layer, int r0, int lane) {
#pragma unroll
    for (int q = 0; q < 4; ++q) {
        const int r = r0 + q, tb = r / NEXP, ex = r - tb * NEXP;
        const float* src = a.in[tb == 0 ? 26 : 27] + ((size_t)layer * NEXP + ex) * D;
#pragma unroll
        for (int j = 0; j < 4; ++j) v[q][j] = *(const f32x4*)(src + j * 256 + lane * 4);
    }
}
__device__ __forceinline__ void qt_store(const f32x4 (&v)[4][4], const Args& a, int layer, int r0, int lane) {
    unsigned char* ws = a.ws; float mx[4], ss[4];
#pragma unroll
    for (int q = 0; q < 4; ++q) { float m = 0.f, s2 = 0.f;
#pragma unroll
        for (int j = 0; j < 4; ++j) { m = fmaxf(fmaxf(fmaxf(fabsf(v[q][j].x), fabsf(v[q][j].y)), fmaxf(fabsf(v[q][j].z), fabsf(v[q][j].w))), m);
            s2 += (v[q][j].x * v[q][j].x + v[q][j].y * v[q][j].y) + (v[q][j].z * v[q][j].z + v[q][j].w * v[q][j].w); }
        mx[q] = m; ss[q] = s2; }
#pragma unroll
    for (int q = 0; q < 4; ++q) ss[q] = wave_sum(ss[q]);
#pragma unroll
    for (int q = 0; q < 4; ++q) {
        const int r = r0 + q, tb = r / NEXP, ex = r - tb * NEXP;
        {
            const float step = fmaxf(0.3352f * __builtin_sqrtf(ss[q] * (1.f / D)), 1e-30f), inv = 1.f / step;
            unsigned char* dst = ws + (tb == 0 ? WS_PU : WS_PV) + (size_t)layer * NEXP * 512 + (size_t)ex * 128 + (lane >> 3) * 16 + (lane & 3) * 4;
            const bool hil = ((lane >> 2) & 1) != 0;
#pragma unroll
            for (int j = 0; j < 4; ++j) {
                const int n0 = min(max((int)floorf(v[q][j].x * inv) + 8, 0), 15), n1 = min(max((int)floorf(v[q][j].y * inv) + 8, 0), 15);
                const int n2 = min(max((int)floorf(v[q][j].z * inv) + 8, 0), 15), n3 = min(max((int)floorf(v[q][j].w * inv) + 8, 0), 15);
                unsigned nbv = (unsigned)n0 | ((unsigned)n1 << 8) | ((unsigned)n2 << 16) | ((unsigned)n3 << 24);
                if (tb == 0 || ((lane >> 2) & 1)) nbv ^= 0x08080808u;
                const unsigned pn = (unsigned)WDPP(WDPP((int)nbv, 0x1B), 0x141);
                *(unsigned*)(dst + (size_t)j * NEXP * 128) = hil ? (pn | (nbv << 4)) : (nbv | (pn << 4));
            }
            ((float*)(ws + (tb == 0 ? WS_SCU : WS_SCV)))[layer * NEXP + ex] = step;
        }
    }
}
__device__ __forceinline__ void quant_tables(const Args& a, int layer, int gw, int ngw, int lane, int row_lo = 0, int row_hi = 2 * NEXP) {
    const int step = ngw * 4; int r0 = row_lo + gw * 4;
    if (r0 >= row_hi) return;
    f32x4 va[4][4], vb[4][4];
    qt_load(va, a, layer, r0, lane);
    for (;;) {
        const int r1 = r0 + step; const bool h1 = r1 < row_hi;
        if (h1) qt_load(vb, a, layer, r1, lane);
        qt_store(va, a, layer, r0, lane);
        if (!h1) break;
        const int r2 = r1 + step; const bool h2 = r2 < row_hi;
        if (h2) qt_load(va, a, layer, r2, lane);
        qt_store(vb, a, layer, r1, lane);
        if (!h2) break;
        r0 = r2;
    }
}
__device__ __forceinline__ void quant_wrows(const bf16_t* src, unsigned char* dst, float* scale, int nrows, int gw, int ngw, int lane) {
    for (int r = gw; r < nrows; r += ngw) {
        const u32x4 w0 = *(const u32x4*)(src + (size_t)r * D + lane * 16), w1 = *(const u32x4*)(src + (size_t)r * D + lane * 16 + 8);
        float v[16];
        v[0] = bflo(w0.x); v[1] = bfhi(w0.x); v[2] = bflo(w0.y); v[3] = bfhi(w0.y); v[4] = bflo(w0.z); v[5] = bfhi(w0.z); v[6] = bflo(w0.w); v[7] = bfhi(w0.w);
        v[8] = bflo(w1.x); v[9] = bfhi(w1.x); v[10] = bflo(w1.y); v[11] = bfhi(w1.y); v[12] = bflo(w1.z); v[13] = bfhi(w1.z); v[14] = bflo(w1.w); v[15] = bfhi(w1.w);
        float mx = 0.f;
#pragma unroll
        for (int k = 0; k < 16; ++k) mx = fmaxf(mx, fabsf(v[k]));
        mx = wave_max(mx);
        mx = fmaxf(mx, 1e-30f); const float inv = 127.f / mx;
        unsigned q[4];
#pragma unroll
        for (int d = 0; d < 4; ++d) q[d] = ((unsigned)__float2int_rn(v[4 * d] * inv) & 0xffu) | (((unsigned)__float2int_rn(v[4 * d + 1] * inv) & 0xffu) << 8) | (((unsigned)__float2int_rn(v[4 * d + 2] * inv) & 0xffu) << 16) | (((unsigned)__float2int_rn(v[4 * d + 3] * inv) & 0xffu) << 24);
        u32x4 o4; o4.x = q[0]; o4.y = q[1]; o4.z = q[2]; o4.w = q[3];
        *(u32x4*)(dst + (size_t)r * D + lane * 16) = o4;
        scale[r] = mx * (1.f / 127.f);
    }
}
__device__ __forceinline__ void transpose_item4(const float* src, int Ns, bf16_t* dst, int Kd, int n0, int k0, int dn1, int dk1, int dn2, int dk2, int dn3, int dk3, int perm_lo, int perm_hi, float* tile, float scl = 1.f) {
    const int tid = threadIdx.x;
    const int dnv[4] = {0, dn1, dn2, dn3}, dkv[4] = {0, dk1, dk2, dk3};
    float v[4][8];
#pragma unroll
    for (int t = 0; t < 4; ++t) {
        const int nn = tid & 63; int n = n0 + dnv[t] + nn;
        if (n >= perm_lo && n < perm_hi) { const int rel = n - perm_lo; n = perm_lo + (rel & ~127) + sigma_head(rel & 127); }
#pragma unroll
        for (int i = 0; i < 8; ++i) { const int kk = (tid >> 6) + 8 * i; v[t][i] = scl * src[(size_t)(k0 + dkv[t] + kk) * Ns + n]; }
    }
#pragma unroll
    for (int t = 0; t < 4; ++t)
#pragma unroll
        for (int i = 0; i < 8; ++i) { const int kk = (tid >> 6) + 8 * i; tile[t * 64 * 65 + kk * 65 + (tid & 63)] = v[t][i]; }
    __syncthreads();
#pragma unroll
    for (int t = 0; t < 4; ++t) {
        const int n = tid >> 3, kc = (tid & 7) * 8; const float* tl = tile + t * 64 * 65;
        u32x4 o;
        o.x = pk2(tl[(kc + 0) * 65 + n], tl[(kc + 1) * 65 + n]); o.y = pk2(tl[(kc + 2) * 65 + n], tl[(kc + 3) * 65 + n]);
        o.z = pk2(tl[(kc + 4) * 65 + n], tl[(kc + 5) * 65 + n]); o.w = pk2(tl[(kc + 6) * 65 + n], tl[(kc + 7) * 65 + n]);
        *(u32x4*)(dst + (size_t)(n0 + dnv[t] + n) * Kd + k0 + dkv[t] + kc) = o;
    }
    __syncthreads();
}
__device__ __forceinline__ void transpose_wide(const float* src, int Ns, bf16_t* dst, int Kd, int ng, int kb, int perm_lo, int perm_hi, float* tile) {
    transpose_item4(src, Ns, dst, Kd, ng * 256, kb * 64, 64, 0, 128, 0, 192, 0, perm_lo, perm_hi, tile);
}
__device__ __forceinline__ void cvt_stream(const float* src, bf16_t* dst, size_t n8, size_t gtid, size_t gthreads) {
    for (size_t i = gtid; i < n8; i += gthreads) {
        const f32x4 a = *(const f32x4*)(src + i * 8), b = *(const f32x4*)(src + i * 8 + 4);
        u32x4 o; o.x = pk2(a.x, a.y); o.y = pk2(a.z, a.w); o.z = pk2(b.x, b.y); o.w = pk2(b.z, b.w);
        *(u32x4*)(dst + i * 8) = o;
    }
}
__device__ __forceinline__ void prep_l1_item(const Args& a, float* tile, int r) {
    unsigned char* ws = a.ws;
    constexpr int I_WIN1 = 16 * 10, I_WOUT1 = 20 * 4, I_WQ1 = 16 * 8;
    if (r < I_WIN1) { transpose_wide(a.in[15], 2560, (bf16_t*)(ws + WS_WIN1), 1024, r % 10, r / 10, 0, 0, tile); return; }
    r -= I_WIN1;
    if (r < I_WOUT1) { transpose_wide(a.in[23], 1024, (bf16_t*)(ws + WS_WOUT1), 1280, r % 4, r / 4, 0, 0, tile); return; }
    r -= I_WOUT1;
    if (r < I_WQ1) { transpose_wide(a.in[24] + (size_t)1024 * 2048, 2048, (bf16_t*)(ws + WS_WQ) + (size_t)2048 * 1024, 1024, r % 8, r / 8, 0, 0, tile); return; }
    r -= I_WQ1;
    { const int which = r / 20, dh = r % 20;
        const float* src = a.in[which == 0 ? 18 : 20] + (size_t)dh * 128 * 128;
        bf16_t* dst = (bf16_t*)(ws + (which == 0 ? WS_WAT : WS_WXT)) + (size_t)dh * 128 * 128;
        transpose_item4(src, 128, dst, 128, 0, 0, 64, 0, 0, 64, 64, 64, 0, 0, tile, -1.4426950408889634f);
    }
}
constexpr int N_L1_ITEMS = 160 + 80 + 128 + 40;
__device__ __forceinline__ void prep_l0_item(const Args& a, float* tile, int it) {
    const int tid = threadIdx.x, lane = tid & 63, wid = tid >> 6;
    unsigned char* ws = a.ws;
    constexpr int I_MOD = 192;
    constexpr int I_WIN0 = 16 * 8, I_WOUT0 = 16 * 4;
    {
        int r = it;
        if (r < I_MOD) {
            const int l = r / 96, n0 = (r % 96) * 64;
            const float* W = a.in[4] + (size_t)l * D * 6144;
            float s0 = 0.f, s1 = 0.f, s2 = 0.f;
            float sl[3][2];
#pragma unroll
            for (int h = 0; h < 2; ++h) { const int k = wid * 128 + h * 64 + lane; const float c0 = a.in[1][k], c1 = a.in[1][D + k], c2 = a.in[3][k];
                sl[0][h] = c0 * sigmoidf_(c0); sl[1][h] = c1 * sigmoidf_(c1); sl[2][h] = c2 * sigmoidf_(c2); }
            const float* Wp = W + (size_t)(wid * 128) * 6144 + n0 + lane;
#pragma unroll
            for (int kk = 0; kk < 128; kk += 16) {
                float w[16];
#pragma unroll
                for (int j = 0; j < 16; ++j) w[j] = Wp[(size_t)(kk + j) * 6144];
#pragma unroll
                for (int j = 0; j < 16; ++j) { const int kq = kk + j;
                    s0 += __int_as_float(__builtin_amdgcn_readlane(__float_as_int(sl[0][kq >> 6]), kq & 63)) * w[j]; s1 += __int_as_float(__builtin_amdgcn_readlane(__float_as_int(sl[1][kq >> 6]), kq & 63)) * w[j];
                    s2 += __int_as_float(__builtin_amdgcn_readlane(__float_as_int(sl[2][kq >> 6]), kq & 63)) * w[j]; }
            }
            tile[(wid * 3 + 0) * 64 + lane] = s0; tile[(wid * 3 + 1) * 64 + lane] = s1; tile[(wid * 3 + 2) * 64 + lane] = s2;
            __syncthreads();
            if (tid < 192) {
                const int v = tid / 64, ln = tid & 63; float s = a.in[5][(size_t)l * 6144 + n0 + ln];
                for (int w = 0; w < 8; ++w) s += tile[(w * 3 + v) * 64 + ln];
                ((float*)(ws + WS_MODV))[(size_t)(l * 3 + v) * 6144 + n0 + ln] = s;
            }
            __syncthreads();
            return;
        }
        r -= I_MOD;
        if (r < I_WIN0) { transpose_wide(a.in[8], 2048, (bf16_t*)(ws + WS_WIN0), 1024, r % 8, r / 8, 1024, 1792, tile); return; }
        r -= I_WIN0;
        if (r < I_WOUT0) { transpose_wide(a.in[14], 1024, (bf16_t*)(ws + WS_WOUT0), 1024, r % 4, r / 4, 0, 0, tile); return; }
        r -= I_WOUT0;
        transpose_wide(a.in[24], 2048, (bf16_t*)(ws + WS_WQ), 1024, r % 8, r / 8, 0, 0, tile);
    }
}
__device__ __forceinline__ void phase_prep(const Args& a, char* lds) {
    const int tid = threadIdx.x;
    float* tile = (float*)lds;
    unsigned char* ws = a.ws;
    if (gridDim.x == 256) { for (int j = blockIdx.x; j < 224; j += gridDim.x) prep_l0_item(a, tile, j < 96 ? j : j + 96); }
    else for (int it = blockIdx.x; it < 512; it += gridDim.x) prep_l0_item(a, tile, it);
    const size_t gtid = (size_t)blockIdx.x * NTHR + tid, gthreads = (size_t)gridDim.x * NTHR;
    cvt_stream(a.in[25], (bf16_t*)(ws + WS_KEYS), (size_t)2 * 8 * 2 * 128 * 128 / 8, gtid, gthreads);
    cvt_stream(a.in[10], (bf16_t*)(ws + WS_GWS), (size_t)4 * 128 * 128 / 8, gtid, gthreads);
    for (size_t i = gtid; i < 128 * 32; i += gthreads) {
        const int pos = (int)(i / 32), f = (int)(i % 32);
        const float inv = powf(10000.f, -(float)f / 32.f); const float ang = (float)pos * inv;
        float* R = (float*)(ws + WS_ROPE); R[i * 2] = cosf(ang); R[i * 2 + 1] = sinf(ang);
    }
}

__device__ __forceinline__ void norm_row_store(const f32x4 (&v)[4], const float* g, const float* sh, const float* sc, bf16_t* orow, int lane, unsigned char* q8row = nullptr, float* q8scale = nullptr) {
    float s = 0.f;
#pragma unroll
    for (int j = 0; j < 4; ++j) s += (v[j].x * v[j].x + v[j].y * v[j].y) + (v[j].z * v[j].z + v[j].w * v[j].w);
    const float rinv = rsqrtf(wave_sum(s) * (1.f / D) + EPS);
    f32x4 o[4]; float mx = 0.f;
#pragma unroll
    for (int j = 0; j < 4; ++j) {
        const int c = j * 256 + lane * 4;
        const f32x4 gg = *(const f32x4*)(g + c), s1 = *(const f32x4*)(sh + c), s2 = *(const f32x4*)(sc + c);
        o[j].x = v[j].x * rinv * gg.x * (1.f + s2.x) + s1.x; o[j].y = v[j].y * rinv * gg.y * (1.f + s2.y) + s1.y;
        o[j].z = v[j].z * rinv * gg.z * (1.f + s2.z) + s1.z; o[j].w = v[j].w * rinv * gg.w * (1.f + s2.w) + s1.w;
        if (!q8row) { u32x2 w; w.x = pk2(o[j].x, o[j].y); w.y = pk2(o[j].z, o[j].w); *(u32x2*)(orow + c) = w; }
        mx = fmaxf(fmaxf(fmaxf(fabsf(o[j].x), fabsf(o[j].y)), fmaxf(fabsf(o[j].z), fabsf(o[j].w))), mx);
    }
    if (q8row) {
        mx = wave_max(mx);
        mx = fmaxf(mx, 1e-30f); const float inv = 119.f / mx;
#pragma unroll
        for (int j = 0; j < 4; ++j) {
            const unsigned b0 = (unsigned)__float2int_rn(o[j].x * inv) & 0xffu, b1 = (unsigned)__float2int_rn(o[j].y * inv) & 0xffu;
            const unsigned b2 = (unsigned)__float2int_rn(o[j].z * inv) & 0xffu, b3 = (unsigned)__float2int_rn(o[j].w * inv) & 0xffu;
            *(unsigned*)(q8row + j * 256 + lane * 4) = b0 | (b1 << 8) | (b2 << 16) | (b3 << 24);
        }
        *q8scale = mx * (1.f / 119.f);
    }
}
__device__ __forceinline__ void phase_norm(const Args& a, int layer, int src_mode, const float* gain, int which_sh, int which_sc, bool latent_only, bool wq8 = false, size_t h8off = WS_H8) {
    const int lane = threadIdx.x & 63, gw = blockIdx.x * NWAVE + (threadIdx.x >> 6), ngw = gridDim.x * NWAVE;
    bf16_t* H = (bf16_t*)(a.ws + WS_H);
    const bf16_t* X1 = (const bf16_t*)(a.ws + WS_X1);
    for (int g = gw; g < MTOT; g += ngw) {
        const int var = row_variant(g);
        if (latent_only && var == 2) continue;
        f32x4 v[4];
        if (src_mode == 0) { const float* xr = row_src(a, g);
#pragma unroll
            for (int j = 0; j < 4; ++j) v[j] = *(const f32x4*)(xr + j * 256 + lane * 4);
        } else { const bf16_t* xr = X1 + (size_t)g * D;
#pragma unroll
            for (int j = 0; j < 4; ++j) { const u32x2 w = *(const u32x2*)(xr + j * 256 + lane * 4); v[j] = f32x4{bflo(w.x), bfhi(w.x), bflo(w.y), bfhi(w.y)}; }
        }
        norm_row_store(v, gain, modv(a, layer, var, which_sh), modv(a, layer, var, which_sc), H + (size_t)g * D, lane, wq8 ? a.ws + h8off + (size_t)g * D : nullptr, wq8 ? (float*)(a.ws + WS_SH) + g : nullptr);
    }
}

__device__ __forceinline__ void phase_gmlp2(const Args& a, char* lds) {
    const int tid = threadIdx.x, lane = tid & 63, wid = __builtin_amdgcn_readfirstlane(tid >> 6), r32 = lane & 31, hh = lane >> 5;
    unsigned char* ws = a.ws;
    LAS bf16_t* vT = (LAS bf16_t*)((LAS char*)lds);
    const bf16_t* VV = (const bf16_t*)(ws + WS_VV); const bf16_t* U = (const bf16_t*)(ws + WS_U); bf16_t* AO = (bf16_t*)(ws + WS_AO);
    const bf16_t* GWS = (const bf16_t*)(ws + WS_GWS);
    const int NU = (MTOT / 128) * 4;
    const int gskip = gridDim.x > 64 ? 8 : 0;
    if ((int)blockIdx.x < gskip) return;
    const int mb = wid >> 1, nb0 = (wid & 1) * 2, ustep = gridDim.x - gskip;
    u32x4 vw[4]; bf16_t uv0[16], uv1[16]; float bsr[16];
#define GM_LOAD(uu) { const int ch_ = (uu) >> 2, g_ = (uu) & 3, row0_ = ch_ * 128; \
        _Pragma("unroll") for (int i = 0; i < 4; ++i) { const int q = (tid >> 4) + 32 * i, c0 = (tid & 15) * 8; vw[i] = *(const u32x4*)(VV + (size_t)(row0_ + q) * 512 + g_ * 128 + c0); } \
        _Pragma("unroll") for (int r = 0; r < 16; ++r) { const int p = mb * 32 + (r & 3) + 8 * (r >> 2) + 4 * hh; const size_t ub = (size_t)(row0_ + p) * 512 + g_ * 128; \
            uv0[r] = U[ub + nb0 * 32 + r32]; uv1[r] = U[ub + nb0 * 32 + 32 + r32]; bsr[r] = a.in[11][g_ * 128 + p]; } }
    int u = blockIdx.x - gskip;
    if (u < NU) GM_LOAD(u)
    for (; u < NU; u += ustep) {
        const int ch = u >> 2, g = u & 3, row0 = ch * 128;
#pragma unroll
        for (int i = 0; i < 4; ++i) {
            const int q = (tid >> 4) + 32 * i, c0 = (tid & 15) * 8;
            const u32x4 w = vw[i];
            vT[(c0 + 0) * 136 + q] = (bf16_t)(w.x & 0xffffu); vT[(c0 + 1) * 136 + q] = (bf16_t)(w.x >> 16);
            vT[(c0 + 2) * 136 + q] = (bf16_t)(w.y & 0xffffu); vT[(c0 + 3) * 136 + q] = (bf16_t)(w.y >> 16);
            vT[(c0 + 4) * 136 + q] = (bf16_t)(w.z & 0xffffu); vT[(c0 + 5) * 136 + q] = (bf16_t)(w.z >> 16);
            vT[(c0 + 6) * 136 + q] = (bf16_t)(w.w & 0xffffu); vT[(c0 + 7) * 136 + q] = (bf16_t)(w.w >> 16);
        }
        bf16_t cu0[16], cu1[16]; float cbs[16];
#pragma unroll
        for (int r = 0; r < 16; ++r) { cu0[r] = uv0[r]; cu1[r] = uv1[r]; cbs[r] = bsr[r]; }
        __syncthreads();
        if (u + ustep < NU) GM_LOAD(u + ustep)
        f32x16 acc0 = {}, acc1 = {};
        {
            unsigned aoff = (unsigned)((mb * 32 + r32) * 128 + 8 * hh); asm volatile("" : "+v"(aoff));
            const bf16_t* wsg = GWS + (size_t)g * 128 * 128;
#pragma unroll
            for (int ks = 0; ks < 8; ++ks) {
                const bf16x8 af = *(const bf16x8*)(wsg + aoff + ks * 16);
                const bf16x8 b0 = *(const LAS bf16x8*)(vT + (nb0 * 32 + r32) * 136 + ks * 16 + 8 * hh);
                const bf16x8 b1 = *(const LAS bf16x8*)(vT + ((nb0 + 1) * 32 + r32) * 136 + ks * 16 + 8 * hh);
                acc0 = __builtin_amdgcn_mfma_f32_32x32x16_bf16(af, b0, acc0, 0, 0, 0);
                acc1 = __builtin_amdgcn_mfma_f32_32x32x16_bf16(af, b1, acc1, 0, 0, 0);
            }
        }
#pragma unroll
        for (int r = 0; r < 16; ++r) {
            const int p = mb * 32 + (r & 3) + 8 * (r >> 2) + 4 * hh;
            const float bsv = cbs[r];
            const size_t ob = (size_t)(row0 + p) * 1024 + g * 128;
            const int c0 = nb0 * 32 + r32, c1 = c0 + 32;
            AO[ob + c0] = (bf16_t)f2bf(bf2f(cu0[r]) * (acc0[r] + bsv));
            AO[ob + c1] = (bf16_t)f2bf(bf2f(cu1[r]) * (acc1[r] + bsv));
        }
        __syncthreads();
    }
#undef GM_LOAD
}

namespace fa {
typedef short s16x4 __attribute__((ext_vector_type(4)));
constexpr int QBLK = 32, KVBLK = 64, LDQ = 512, LDK = 128, LDO = 1024;
constexpr float SCALE = 0.088388347648318440f, THR = 8.f;
constexpr size_t SHM_V = KVBLK * 128 * 2, SHM_K = KVBLK * 128 * 2, SHM_ATTN = 2 * SHM_V + 2 * SHM_K + NWAVE * 64 * 4;
#define KSWZ(row, colB) ((row) * 256 + ((colB) ^ (((row) & 7) << 4)))
#define SBAR() __builtin_amdgcn_sched_barrier(0)
__device__ __forceinline__ int crow(int r, int hi) { return (r & 3) + 8 * (r >> 2) + 4 * hi; }
__device__ __forceinline__ unsigned cvtpk(float lo, float hi) { unsigned r; asm volatile("v_cvt_pk_bf16_f32 %0, %1, %2" : "=v"(r) : "v"(lo), "v"(hi)); return r; }
__device__ __forceinline__ void partialSM(f32x16& p0, f32x16& p1, float& m_reg, float& mn, float& alpha) {
  constexpr float C = SCALE * 1.4426950408889634f;
  float pmax = p0[0]; for (int r = 1; r < 16; ++r) pmax = fmaxf(pmax, p0[r]); for (int r = 0; r < 16; ++r) pmax = fmaxf(pmax, p1[r]);
  { auto rr = __builtin_amdgcn_permlane32_swap(__float_as_uint(pmax), __float_as_uint(pmax), false, false);
    pmax = fmaxf(__uint_as_float(rr[0]), __uint_as_float(rr[1])); }
  if (__builtin_expect(__all(pmax - m_reg <= THR / SCALE), 1)) { mn = m_reg; alpha = 1.f; }
  else { mn = fmaxf(m_reg, pmax); alpha = __builtin_amdgcn_exp2f((m_reg - mn) * C); m_reg = mn; }
  float mnC = -mn * C;
  for (int r = 0; r < 16; ++r) p0[r] = fmaf(p0[r], C, mnC); for (int r = 0; r < 16; ++r) p1[r] = fmaf(p1[r], C, mnC);
  for (int r = 0; r < 16; ++r) p0[r] = __builtin_amdgcn_exp2f(p0[r]);
}
__device__ __forceinline__ void finishSM(f32x16& p0, f32x16& p1, float alpha, float& l_reg, bf16x8& pa0, bf16x8& pa1, bf16x8& pa2, bf16x8& pa3) {
  for (int r = 0; r < 16; ++r) p1[r] = __builtin_amdgcn_exp2f(p1[r]);
  float ps = 0; for (int r = 0; r < 16; ++r) ps += p0[r]; for (int r = 0; r < 16; ++r) ps += p1[r];
  { auto rr = __builtin_amdgcn_permlane32_swap(__float_as_uint(ps), __float_as_uint(ps), false, false);
    ps = __uint_as_float(rr[0]) + __uint_as_float(rr[1]); }
  l_reg = l_reg * alpha + ps;
#define PK4(P, BASE, OUT) do { unsigned a0 = cvtpk(P[BASE + 0], P[BASE + 1]), a1 = cvtpk(P[BASE + 2], P[BASE + 3]);   \
    unsigned b0 = cvtpk(P[BASE + 4], P[BASE + 5]), b1 = cvtpk(P[BASE + 6], P[BASE + 7]);                              \
    auto r0 = __builtin_amdgcn_permlane32_swap(a0, b0, false, false); auto r1 = __builtin_amdgcn_permlane32_swap(a1, b1, false, false); \
    u32x4 w = {r0[0], r1[0], r0[1], r1[1]}; OUT = *reinterpret_cast<bf16x8*>(&w); } while (0)
  PK4(p0, 0, pa0); PK4(p0, 8, pa1); PK4(p1, 0, pa2); PK4(p1, 8, pa3);
#undef PK4
}
__device__ __forceinline__ void qkt(f32x16& p0, f32x16& p1, const bf16_t* Ks, const bf16x8* qr, int r32, int hi) {
  p0 = f32x16{}; p1 = f32x16{};
  for (int d0 = 0; d0 < 8; ++d0) { int cb = (d0 * 16 + hi * 8) * 2;
    bf16x8 b0 = *reinterpret_cast<const bf16x8*>((const char*)Ks + KSWZ(r32, cb));
    bf16x8 b1 = *reinterpret_cast<const bf16x8*>((const char*)Ks + KSWZ(32 + r32, cb));
    p0 = __builtin_amdgcn_mfma_f32_32x32x16_bf16(b0, qr[d0], p0, 0, 0, 0);
    p1 = __builtin_amdgcn_mfma_f32_32x32x16_bf16(b1, qr[d0], p1, 0, 0, 0); }
}
__device__ __forceinline__ int v_st(int k, int c) { const int kk = (k & ~0xC) | ((k & 4) << 1) | ((k & 8) >> 1); return ((kk >> 3) * 4 + (c >> 5)) * 512 + ((kk & 7) * 32 + (c & 31)) * 2; }
__device__ __forceinline__ int v_rd_base(int lane) { return ((lane & 3) << 3) | (((lane >> 2) & 3) << 6) | (((lane >> 4) & 1) << 5) | (((lane >> 5) & 1) << 8); }
constexpr int v_rd_off(int d0, int ks, int half) { return d0 * 512 + ks * 4096 + half * 2048; }
template <int OFF> __device__ __forceinline__ s16x4 tr_read(int vb) {
  s16x4 r; asm volatile("ds_read_b64_tr_b16 %0, %1 offset:%2" : "=&v"(r) : "v"(vb), "i"(OFF) : "memory"); return r;
}
template <int D0> __device__ __forceinline__ void pv_one(f32x16& od, int vb, bf16x8 pa0, bf16x8 pa1, bf16x8 pa2, bf16x8 pa3) {
  const s16x4 l0 = tr_read<v_rd_off(D0, 0, 0)>(vb), h0 = tr_read<v_rd_off(D0, 0, 1)>(vb), l1 = tr_read<v_rd_off(D0, 1, 0)>(vb), h1 = tr_read<v_rd_off(D0, 1, 1)>(vb);
  const s16x4 l2 = tr_read<v_rd_off(D0, 2, 0)>(vb), h2 = tr_read<v_rd_off(D0, 2, 1)>(vb), l3 = tr_read<v_rd_off(D0, 3, 0)>(vb), h3 = tr_read<v_rd_off(D0, 3, 1)>(vb);
  asm volatile("s_waitcnt lgkmcnt(0)" ::: "memory"); SBAR();
#define PK(L, H) (bf16x8){L[0], L[1], L[2], L[3], H[0], H[1], H[2], H[3]}
  od = __builtin_amdgcn_mfma_f32_32x32x16_bf16(pa0, PK(l0, h0), od, 0, 0, 0);
  od = __builtin_amdgcn_mfma_f32_32x32x16_bf16(pa1, PK(l1, h1), od, 0, 0, 0);
  od = __builtin_amdgcn_mfma_f32_32x32x16_bf16(pa2, PK(l2, h2), od, 0, 0, 0);
  od = __builtin_amdgcn_mfma_f32_32x32x16_bf16(pa3, PK(l3, h3), od, 0, 0, 0);
#undef PK
}
__device__ __forceinline__ void pv_d0(f32x16* o, int vb, bf16x8 pa0, bf16x8 pa1, bf16x8 pa2, bf16x8 pa3) {
  pv_one<0>(o[0], vb, pa0, pa1, pa2, pa3); pv_one<1>(o[1], vb, pa0, pa1, pa2, pa3); pv_one<2>(o[2], vb, pa0, pa1, pa2, pa3); pv_one<3>(o[3], vb, pa0, pa1, pa2, pa3);
}
__device__ __forceinline__ void attn_dense_body(const bf16_t* __restrict__ Qb, const bf16_t* __restrict__ Kh, const bf16_t* __restrict__ Vh,
                                                bf16_t* __restrict__ Ob, int seq, char* lds) {
  const int tid = threadIdx.x, wid = tid >> 6, lane = tid & 63, r32 = lane & 31, hi = lane >> 5;
  bf16_t* V_lds = (bf16_t*)lds; bf16_t* K_lds = (bf16_t*)(lds + 2 * SHM_V);
  float* ws = (float*)(lds + 2 * SHM_V + 2 * SHM_K) + wid * 64; float* li_l = ws; float* al_l = ws + 32;
  float m_reg = -1e30f, l_reg = 0; f32x16 o[4] = {}; bf16x8 qr[8];
  const bf16_t* Qw = Qb + (long)(wid * QBLK + r32) * LDQ + hi * 8;
#pragma unroll
  for (int d0 = 0; d0 < 8; ++d0) qr[d0] = *reinterpret_cast<const bf16x8*>(Qw + d0 * 16);
  const int sr = tid >> 4, sc = (tid & 15) * 8, vst0 = v_st(sr, sc), vst1 = v_st(32 + sr, sc);
  const int vb0 = (int)(uintptr_t)V_lds + v_rd_base(lane);
  struct { bf16x8 vs0, vs1, ks0, ks1; } sr_[2];
#define SLOAD(i, k0) do { sr_[i].vs0 = *reinterpret_cast<const bf16x8*>(&Vh[(long)((k0) + sr) * LDK + sc]); sr_[i].vs1 = *reinterpret_cast<const bf16x8*>(&Vh[(long)((k0) + 32 + sr) * LDK + sc]); \
    sr_[i].ks0 = *reinterpret_cast<const bf16x8*>(&Kh[(long)((k0) + sr) * LDK + sc]); sr_[i].ks1 = *reinterpret_cast<const bf16x8*>(&Kh[(long)((k0) + 32 + sr) * LDK + sc]); } while (0)
#define SWRITE(b, i) do { *(bf16x8*)((char*)V_lds + (b) * SHM_V + vst0) = sr_[i].vs0;          \
    *(bf16x8*)((char*)V_lds + (b) * SHM_V + vst1) = sr_[i].vs1; int kc = sc * 2;               \
    *(bf16x8*)((char*)K_lds + (b) * SHM_K + KSWZ(sr, kc)) = sr_[i].ks0;                       \
    *(bf16x8*)((char*)K_lds + (b) * SHM_K + KSWZ(32 + sr, kc)) = sr_[i].ks1; } while (0)
#define SWAIT() asm volatile("s_waitcnt vmcnt(4)" ::: "memory")
#define RESC(a) do { if (__builtin_expect(__any((a) < 1.f), 0)) { if (hi == 0) al_l[r32] = (a); asm volatile("s_waitcnt lgkmcnt(0)" ::: "memory"); \
    for (int d = 0; d < 4; ++d) for (int r = 0; r < 16; ++r) o[d][r] *= al_l[crow(r, hi)]; } } while (0)
  f32x16 pA0, pA1, pB0, pB1; float mnA, mnB, alA, alB; bf16x8 pa0, pa1, pa2, pa3; const int NT = seq / KVBLK;
  constexpr int SE = 0, SO = 1;
  SLOAD(SE, 0); asm volatile("s_waitcnt vmcnt(0)" ::: "memory"); SWRITE(0, SE); __syncthreads();
  qkt(pA0, pA1, K_lds, qr, r32, hi); partialSM(pA0, pA1, m_reg, mnA, alA);
  SLOAD(SO, KVBLK); if (2 < NT) SLOAD(SE, 2 * KVBLK);
  SWAIT(); SWRITE(1, SO); __syncthreads();
  asm volatile(".p2align 6");
  for (int j = 1; j + 1 < NT; j += 2) {
    SBAR(); qkt(pB0, pB1, (bf16_t*)((char*)K_lds + SHM_K), qr, r32, hi);
    finishSM(pA0, pA1, alA, l_reg, pa0, pa1, pa2, pa3); SBAR();
    SLOAD(SO, (j + 2) * KVBLK); SBAR();
    pv_d0(o, vb0, pa0, pa1, pa2, pa3); partialSM(pB0, pB1, m_reg, mnB, alB);
    __syncthreads(); SWAIT(); SWRITE(0, SE);
    RESC(alB); __syncthreads();
    SBAR(); qkt(pA0, pA1, K_lds, qr, r32, hi);
    finishSM(pB0, pB1, alB, l_reg, pa0, pa1, pa2, pa3); SBAR();
    if (j + 3 < NT) SLOAD(SE, (j + 3) * KVBLK); SBAR();
    pv_d0(o, vb0 + (int)SHM_V, pa0, pa1, pa2, pa3); partialSM(pA0, pA1, m_reg, mnA, alA);
    __syncthreads(); SWAIT(); SWRITE(1, SO);
    RESC(alA); __syncthreads();
  }
  SBAR(); qkt(pB0, pB1, (bf16_t*)((char*)K_lds + SHM_K), qr, r32, hi);
  finishSM(pA0, pA1, alA, l_reg, pa0, pa1, pa2, pa3); SBAR();
  pv_d0(o, vb0, pa0, pa1, pa2, pa3); partialSM(pB0, pB1, m_reg, mnB, alB);
  __syncthreads(); RESC(alB);
  finishSM(pB0, pB1, alB, l_reg, pa0, pa1, pa2, pa3); SBAR();
  pv_d0(o, vb0 + (int)SHM_V, pa0, pa1, pa2, pa3);
  if (hi == 0) li_l[r32] = l_reg; asm volatile("s_waitcnt lgkmcnt(0)" ::: "memory");
  float rli[16];
#pragma unroll
  for (int r = 0; r < 16; ++r) rli[r] = __builtin_amdgcn_rcpf(li_l[crow(r, hi)]);
  bf16_t* Ow = Ob + (long)(wid * QBLK) * LDO;
#pragma unroll
  for (int r = 0; r < 16; ++r) { int orow = crow(r, hi);
    for (int d0 = 0; d0 < 4; ++d0) Ow[(long)orow * LDO + d0 * 32 + r32] = (bf16_t)f2bf(o[d0][r] * rli[r]); }
  __syncthreads();
#undef SLOAD
#undef SWRITE
#undef SWAIT
#undef RESC
}
#undef KSWZ
#undef SBAR
}

__device__ __forceinline__ void phase_attn(const Args& a, char* lds) {
    unsigned char* ws = a.ws;
    const bf16_t* Q = (const bf16_t*)(ws + WS_Q); const bf16_t* Kb = (const bf16_t*)(ws + WS_K); const bf16_t* Vb = (const bf16_t*)(ws + WS_V);
    bf16_t* AO = (bf16_t*)(ws + WS_AO);
    const int NU = 256 + 8;
    PRIO_YOUNG_ON();
    for (int u = blockIdx.x; u < NU; u += gridDim.x) {
        int b, h, qrow0, nkeys;
        if (u < 256) { const int x = u & 7; b = x >> 2; h = x & 3; qrow0 = b * RPB + CTXL + (u >> 3) * 256; nkeys = RPB; }
        else { const int v = u - 256; b = v / 4; h = v % 4; qrow0 = b * RPB; nkeys = CTXL; }
        const int kvh = h >> 1; const size_t krow0 = (size_t)(b * 2 + kvh) * RPB;
        fa::attn_dense_body(Q + (size_t)qrow0 * 512 + h * 128, Kb + krow0 * 128, Vb + krow0 * 128, AO + (size_t)qrow0 * 1024 + 512 + h * 128, nkeys, lds);
    }
    PRIO_YOUNG_OFF();
}

constexpr int TK_LD = 136;
__device__ __forceinline__ int peer_tok(int i, int mode);
namespace tk {
__device__ __forceinline__ void ce(float& a, float& b) { const float mx = __builtin_fmaxf(a, b), mn = __builtin_fminf(a, b); a = mx; b = mn; }
__device__ __forceinline__ void sort16_desc(float (&v)[16]) {
#define TKC(i, j) ce(v[i], v[j]);
    TKC(0,13) TKC(1,12) TKC(2,15) TKC(3,14) TKC(4,8) TKC(5,6) TKC(7,11) TKC(9,10)
    TKC(0,5) TKC(1,7) TKC(2,9) TKC(3,4) TKC(6,13) TKC(8,14) TKC(10,15) TKC(11,12)
    TKC(0,1) TKC(2,3) TKC(4,5) TKC(6,8) TKC(7,9) TKC(10,11) TKC(12,13) TKC(14,15)
    TKC(0,2) TKC(1,3) TKC(4,10) TKC(5,11) TKC(6,7) TKC(8,9) TKC(12,14) TKC(13,15)
    TKC(1,2) TKC(3,12) TKC(4,6) TKC(5,7) TKC(8,10) TKC(9,11) TKC(13,14)
    TKC(1,4) TKC(2,6) TKC(5,8) TKC(7,10) TKC(9,13) TKC(11,14)
    TKC(2,4) TKC(3,6) TKC(9,12) TKC(11,13)
    TKC(3,5) TKC(6,8) TKC(7,9) TKC(10,12)
    TKC(3,4) TKC(5,6) TKC(7,8) TKC(9,10) TKC(11,12)
    TKC(6,7) TKC(8,9)
#undef TKC
}
__device__ __forceinline__ void merge16_desc(float (&v)[16]) {
#pragma unroll
    for (int js = 3; js >= 0; --js)
#pragma unroll
        for (int i = 0; i < 16; ++i) { const int j = 1 << js, l = i ^ j; if (l > i) ce(v[i], v[l]); }
}
__device__ __forceinline__ void merge_prune(float (&x)[16], const float (&y)[16]) {
#pragma unroll
    for (int i = 0; i < 16; ++i) x[i] = __builtin_fmaxf(x[i], y[15 - i]);
    merge16_desc(x);
}
__host__ __device__ constexpr bool pair_ok(int i, int j) { return (i + 1) * (j + 1) <= 16; }
__host__ __device__ constexpr int pair_index(int i, int j) { int n = 0; for (int a = 0; a < 16; ++a) for (int b = 0; b < 16; ++b) { if (a == i && b == j) return n; if (pair_ok(a, b)) ++n; } return n; }
static_assert(pair_index(15, 15) == 49 + 0 || true, "");
}
__device__ __forceinline__ void topk_stage2(const float (&top)[2][16], int* SELI, float* SELG, int g0, int h, int r32, int hh) {
    float X[16], Y[16];
    X[0] = __uint_as_float((__float_as_uint((hh ? top[0][3] : top[0][0]) + (hh ? top[1][3] : top[1][0])) & ~255u) | (hh ? 51u : 0u));
    Y[0] = __uint_as_float((__float_as_uint((hh ? top[0][14] : top[0][1]) + (hh ? top[1][0] : top[1][0])) & ~255u) | (hh ? 224u : 16u));
    X[1] = __uint_as_float((__float_as_uint((hh ? top[0][4] : top[0][0]) + (hh ? top[1][0] : top[1][1])) & ~255u) | (hh ? 64u : 1u));
    Y[1] = __uint_as_float((__float_as_uint((hh ? top[0][15] : top[0][1]) + (hh ? top[1][0] : top[1][1])) & ~255u) | (hh ? 240u : 17u));
    X[2] = __uint_as_float((__float_as_uint((hh ? top[0][4] : top[0][0]) + (hh ? top[1][1] : top[1][2])) & ~255u) | (hh ? 65u : 2u));
    Y[2] = (hh ? -INFINITY : __uint_as_float((__float_as_uint(top[0][1] + top[1][2]) & ~255u) | 18u));
    X[3] = __uint_as_float((__float_as_uint((hh ? top[0][4] : top[0][0]) + (hh ? top[1][2] : top[1][3])) & ~255u) | (hh ? 66u : 3u));
    Y[3] = (hh ? -INFINITY : __uint_as_float((__float_as_uint(top[0][1] + top[1][3]) & ~255u) | 19u));
    X[4] = __uint_as_float((__float_as_uint((hh ? top[0][5] : top[0][0]) + (hh ? top[1][0] : top[1][4])) & ~255u) | (hh ? 80u : 4u));
    Y[4] = (hh ? -INFINITY : __uint_as_float((__float_as_uint(top[0][1] + top[1][4]) & ~255u) | 20u));
    X[5] = __uint_as_float((__float_as_uint((hh ? top[0][5] : top[0][0]) + (hh ? top[1][1] : top[1][5])) & ~255u) | (hh ? 81u : 5u));
    Y[5] = (hh ? -INFINITY : __uint_as_float((__float_as_uint(top[0][1] + top[1][5]) & ~255u) | 21u));
    X[6] = __uint_as_float((__float_as_uint((hh ? top[0][6] : top[0][0]) + (hh ? top[1][0] : top[1][6])) & ~255u) | (hh ? 96u : 6u));
    Y[6] = (hh ? -INFINITY : __uint_as_float((__float_as_uint(top[0][1] + top[1][6]) & ~255u) | 22u));
    X[7] = __uint_as_float((__float_as_uint((hh ? top[0][6] : top[0][0]) + (hh ? top[1][1] : top[1][7])) & ~255u) | (hh ? 97u : 7u));
    Y[7] = (hh ? -INFINITY : __uint_as_float((__float_as_uint(top[0][1] + top[1][7]) & ~255u) | 23u));
    X[8] = __uint_as_float((__float_as_uint((hh ? top[0][7] : top[0][0]) + (hh ? top[1][0] : top[1][8])) & ~255u) | (hh ? 112u : 8u));
    Y[8] = (hh ? -INFINITY : __uint_as_float((__float_as_uint(top[0][2] + top[1][0]) & ~255u) | 32u));
    X[9] = __uint_as_float((__float_as_uint((hh ? top[0][7] : top[0][0]) + (hh ? top[1][1] : top[1][9])) & ~255u) | (hh ? 113u : 9u));
    Y[9] = (hh ? -INFINITY : __uint_as_float((__float_as_uint(top[0][2] + top[1][1]) & ~255u) | 33u));
    X[10] = __uint_as_float((__float_as_uint((hh ? top[0][8] : top[0][0]) + (hh ? top[1][0] : top[1][10])) & ~255u) | (hh ? 128u : 10u));
    Y[10] = (hh ? -INFINITY : __uint_as_float((__float_as_uint(top[0][2] + top[1][2]) & ~255u) | 34u));
    X[11] = __uint_as_float((__float_as_uint((hh ? top[0][9] : top[0][0]) + (hh ? top[1][0] : top[1][11])) & ~255u) | (hh ? 144u : 11u));
    Y[11] = (hh ? -INFINITY : __uint_as_float((__float_as_uint(top[0][2] + top[1][3]) & ~255u) | 35u));
    X[12] = __uint_as_float((__float_as_uint((hh ? top[0][10] : top[0][0]) + (hh ? top[1][0] : top[1][12])) & ~255u) | (hh ? 160u : 12u));
    Y[12] = (hh ? -INFINITY : __uint_as_float((__float_as_uint(top[0][2] + top[1][4]) & ~255u) | 36u));
    X[13] = __uint_as_float((__float_as_uint((hh ? top[0][11] : top[0][0]) + (hh ? top[1][0] : top[1][13])) & ~255u) | (hh ? 176u : 13u));
    Y[13] = (hh ? -INFINITY : __uint_as_float((__float_as_uint(top[0][3] + top[1][0]) & ~255u) | 48u));
    X[14] = __uint_as_float((__float_as_uint((hh ? top[0][12] : top[0][0]) + (hh ? top[1][0] : top[1][14])) & ~255u) | (hh ? 192u : 14u));
    Y[14] = (hh ? -INFINITY : __uint_as_float((__float_as_uint(top[0][3] + top[1][1]) & ~255u) | 49u));
    X[15] = __uint_as_float((__float_as_uint((hh ? top[0][13] : top[0][0]) + (hh ? top[1][0] : top[1][15])) & ~255u) | (hh ? 208u : 15u));
    Y[15] = (hh ? -INFINITY : __uint_as_float((__float_as_uint(top[0][3] + top[1][2]) & ~255u) | 50u));
    tk::sort16_desc(X); __builtin_amdgcn_sched_barrier(0); tk::sort16_desc(Y); __builtin_amdgcn_sched_barrier(0);
    tk::merge_prune(X, Y); __builtin_amdgcn_sched_barrier(0);
#pragma unroll
    for (int r = 0; r < 16; ++r) { const auto rr = __builtin_amdgcn_permlane32_swap(__float_as_uint(X[r]), __float_as_uint(X[r]), false, false); X[r] = __uint_as_float(rr[0]); Y[r] = __uint_as_float(rr[1]); }
    tk::merge_prune(X, Y); __builtin_amdgcn_sched_barrier(0);
    const float vmax = X[0];
    int eidx[8]; float ev[8]; float sum = 0.f;
    unsigned pa[4], pb[4];
#pragma unroll
    for (int q = 0; q < 4; ++q) {
        pa[q] = (__float_as_uint(top[0][4 * q]) & 127u) | ((__float_as_uint(top[0][4 * q + 1]) & 127u) << 8) | ((__float_as_uint(top[0][4 * q + 2]) & 127u) << 16) | ((__float_as_uint(top[0][4 * q + 3]) & 127u) << 24);
        pb[q] = (__float_as_uint(top[1][4 * q]) & 127u) | ((__float_as_uint(top[1][4 * q + 1]) & 127u) << 8) | ((__float_as_uint(top[1][4 * q + 2]) & 127u) << 16) | ((__float_as_uint(top[1][4 * q + 3]) & 127u) << 24);
    }
#pragma unroll
    for (int rr = 0; rr < 8; ++rr) {
        const float v = hh ? X[8 + rr] : X[rr];
        const unsigned bits = __float_as_uint(v); const unsigned ci = (bits >> 4) & 15u, cj = bits & 15u;
        const unsigned sa_ = (ci & 7u) | 0x0c0c0c00u, sb_ = (cj & 7u) | 0x0c0c0c00u;
        const unsigned ia = (ci & 8u) ? __builtin_amdgcn_perm(pa[3], pa[2], sa_) : __builtin_amdgcn_perm(pa[1], pa[0], sa_);
        const unsigned ib = (cj & 8u) ? __builtin_amdgcn_perm(pb[3], pb[2], sb_) : __builtin_amdgcn_perm(pb[1], pb[0], sb_);
        eidx[rr] = (int)(ia * 128u + ib);
        ev[rr] = __expf(v - vmax); sum += ev[rr];
    }
    { const auto rr = __builtin_amdgcn_permlane32_swap(__float_as_uint(sum), __float_as_uint(sum), false, false); sum = __uint_as_float(rr[0]) + __uint_as_float(rr[1]); }
    const float rs = __builtin_amdgcn_rcpf(sum);
    int* oi = SELI + (size_t)(g0 + r32) * 128 + h * 16 + hh * 8; float* og = SELG + (size_t)(g0 + r32) * 128 + h * 16 + hh * 8;
#pragma unroll
    for (int rr = 0; rr < 8; ++rr) { oi[rr] = eidx[rr]; og[rr] = ev[rr] * rs; }
}
__device__ __forceinline__ void topk_item_lds(const bf16_t* QP, LAS const bf16_t* KL, int* SELI, float* SELG, int g0, int h, int r32, int hh) {
    float top[2][16];
#pragma unroll
    for (int s = 0; s < 2; ++s) {
        bf16x8 qf[8];
        unsigned qoff = (unsigned)(r32 * 2048 + 8 * hh), koff = (unsigned)(r32 * 128 + 8 * hh); asm volatile("" : "+v"(qoff), "+v"(koff));
        const bf16_t* qb = QP + (size_t)g0 * 2048 + h * 256 + s * 128;
#pragma unroll
        for (int k = 0; k < 8; ++k) qf[k] = *(const bf16x8*)(qb + qoff + k * 16);
        float grp[4][16];
#pragma unroll
        for (int kb = 0; kb < 4; ++kb) {
            LAS const bf16_t* kbp = KL + (s * 128 + kb * 32 + r32) * TK_LD + 8 * hh;
            f32x16 acc = {};
#pragma unroll
            for (int k = 0; k < 8; ++k) { const bf16x8 kf = *(LAS const bf16x8*)(kbp + k * 16); acc = __builtin_amdgcn_mfma_f32_32x32x16_bf16(kf, qf[k], acc, 0, 0, 0); }
#pragma unroll
            for (int r = 0; r < 16; ++r) { const int key = kb * 32 + (r & 3) + 8 * (r >> 2) + 4 * hh; grp[kb][r] = __uint_as_float((__float_as_uint(acc[r]) & ~127u) | (unsigned)key); }
            tk::sort16_desc(grp[kb]); __builtin_amdgcn_sched_barrier(0);
        }
        tk::merge_prune(grp[0], grp[1]); __builtin_amdgcn_sched_barrier(0); tk::merge_prune(grp[2], grp[3]); __builtin_amdgcn_sched_barrier(0); tk::merge_prune(grp[0], grp[2]); __builtin_amdgcn_sched_barrier(0);
        float oth[16];
#pragma unroll
        for (int r = 0; r < 16; ++r) { const auto rr = __builtin_amdgcn_permlane32_swap(__float_as_uint(grp[0][r]), __float_as_uint(grp[0][r]), false, false); grp[0][r] = __uint_as_float(rr[0]); oth[r] = __uint_as_float(rr[1]); }
        tk::merge_prune(grp[0], oth);
#pragma unroll
        for (int r = 0; r < 16; ++r) top[s][r] = grp[0][r];
        __builtin_amdgcn_sched_barrier(0);
    }
    topk_stage2(top, SELI, SELG, g0, h, r32, hh);
}

__device__ __forceinline__ void topk_load_keys(const Args& a, char* lds, int layer) {
    const int tid = threadIdx.x, h = blockIdx.x & 7;
    const bf16_t* KEYS = (const bf16_t*)(a.ws + WS_KEYS) + (size_t)layer * 8 * 2 * 128 * 128 + (size_t)h * 2 * 128 * 128;
    LAS bf16_t* KL = (LAS bf16_t*)((LAS char*)lds);
    for (int i = tid; i < 2 * 128 * 16; i += NTHR) { const int row = i >> 4, c8 = (i & 15) * 8; *(LAS u32x4*)(KL + row * TK_LD + c8) = *(const u32x4*)(KEYS + (size_t)row * 128 + c8); }
    __syncthreads();
}
__device__ __forceinline__ void phase_peer_topk3(const Args& a, char* lds, int layer, bool latent_only, bool keys_loaded = false) {
    const int tid = threadIdx.x, lane = tid & 63, r32 = lane & 31, hh = lane >> 5, wid = __builtin_amdgcn_readfirstlane(tid >> 6);
    const int h = blockIdx.x & 7, stripe = blockIdx.x >> 3, nstr = (gridDim.x >> 3) * NWAVE;
    const bf16_t* QP = (const bf16_t*)(a.ws + WS_QP);
    int* SELI = (int*)(a.ws + WS_SELI); float* SELG = (float*)(a.ws + WS_SELG);
    LAS bf16_t* KL = (LAS bf16_t*)((LAS char*)lds);
    if (!keys_loaded) topk_load_keys(a, lds, layer);
    const int ngrp = latent_only ? (NB * SEQ) / 32 : MTOT / 32;
    asm volatile(".p2align 6");
    const bool spread = !latent_only && gridDim.x == 256 && ngrp == 528;
    const int nmain = spread ? 512 : ngrp;
    for (int i = stripe * NWAVE + wid; i < nmain; i += nstr) {
        const int g0 = latent_only ? peer_tok(i * 32, 1) : i * 32;
        topk_item_lds(QP, KL, SELI, SELG, g0, h, r32, hh);
    }
    if (spread && !(stripe & 1) && wid == 0) topk_item_lds(QP, KL, SELI, SELG, (512 + (stripe >> 1)) * 32, h, r32, hh);
    if (!latent_only) {
        const int G = (int)gridDim.x;
        __syncthreads();
        if (spread) {
            if (stripe & 1) quant_wrows((const bf16_t*)(a.ws + WS_WQ) + (size_t)2048 * 1024, a.ws + WS_W8Q + (size_t)2048 * 1024, (float*)(a.ws + WS_SW) + 2 * 2048, 2048, ((stripe >> 1) * 8 + h) * NWAVE + wid, 128 * NWAVE, lane);
        }
        else for (int r = (int)blockIdx.x; r < 200; r += G) prep_l1_item(a, (float*)lds, r < 160 ? r : r + 208);
    }
}
__device__ __forceinline__ float ub0(unsigned w) { return (float)(w & 0xffu); }
__device__ __forceinline__ float ub1(unsigned w) { return (float)((w >> 8) & 0xffu); }
__device__ __forceinline__ float ub2(unsigned w) { return (float)((w >> 16) & 0xffu); }
__device__ __forceinline__ float ub3(unsigned w) { return (float)(w >> 24); }
__device__ __forceinline__ int peer_tok(int i, int mode) { return mode == 1 ? i + CTXL + (i >= SEQ ? CTXL : 0) : i; }
__device__ __forceinline__ float dot16u(const u32x4& w, const float (&hp)[16]) {
    float a0 = hp[0] * ub0(w.x) + hp[4] * ub0(w.y), a1 = hp[1] * ub1(w.x) + hp[5] * ub1(w.y), a2 = hp[2] * ub2(w.x) + hp[6] * ub2(w.y), a3 = hp[3] * ub3(w.x) + hp[7] * ub3(w.y);
    a0 += hp[8] * ub0(w.z) + hp[12] * ub0(w.w); a1 += hp[9] * ub1(w.z) + hp[13] * ub1(w.w); a2 += hp[10] * ub2(w.z) + hp[14] * ub2(w.w); a3 += hp[11] * ub3(w.z) + hp[15] * ub3(w.w);
    return (a0 + a1) + (a2 + a3);
}
#define DPP_I(v, ctrl) __builtin_amdgcn_update_dpp(0, (v), (ctrl), 0xf, 0xf, true)
__device__ __forceinline__ int sum8_i(int v) {
    v += DPP_I(v, 0xB1);
    v += DPP_I(v, 0x4E);
    v += DPP_I(v, 0x141);
    return v;
}
__device__ __forceinline__ int sum_eg_i(int v) {
    v += DPP_I(v, 0x128);
    { const auto r = __builtin_amdgcn_permlane16_swap((unsigned)v, (unsigned)v, false, false); v = (int)(r[0] + r[1]); }
    { const auto r = __builtin_amdgcn_permlane32_swap((unsigned)v, (unsigned)v, false, false); v = (int)(r[0] + r[1]); }
    return v;
}
__device__ __forceinline__ void gu_stage(u32x4 (&seg)[16], u32x4& hwa, u32x4& hwb, LAS int* lb, int i0, int i1, const unsigned char* hrow, const unsigned char* PUx, int lane, int eg, unsigned loff) {
    lb[lane] = i0; lb[64 + lane] = i1;
    hwa = *(const u32x4*)hrow; hwb = *(const u32x4*)(hrow + 16);
#pragma unroll
    for (int st = 0; st < 16; ++st) seg[st] = *(const u32x4*)(PUx + ((unsigned)lb[st * 8 + eg] * 128u + loff));
}
__device__ __forceinline__ unsigned gu_split(unsigned xa, unsigned xb, bool hi) {
    constexpr unsigned M = 0x0f0f0f0fu;
    const unsigned ya = (xa ^ 0x80808080u) + 0x08080808u, yb = (xb ^ 0x80808080u) + 0x08080808u;
    return (hi ? (((ya >> 4) & M) | (yb & ~M)) : ((ya & M) | ((yb & M) << 4))) ^ 0x88888888u;
}
__device__ __forceinline__ void gu_compute(const u32x4 (&seg)[16], const u32x4& hwa, const u32x4& hwb, LAS float* lpart, unsigned* prow, int lane, int eg, int sub, bool valid) {
    const int A0 = (int)gu_split(hwa.x, hwb.x, true), A1 = (int)gu_split(hwa.y, hwb.y, true), A2 = (int)gu_split(hwa.z, hwb.z, true), A3 = (int)gu_split(hwa.w, hwb.w, true);
    const int B0 = (int)gu_split(hwa.x, hwb.x, false), B1 = (int)gu_split(hwa.y, hwb.y, false), B2 = (int)gu_split(hwa.z, hwb.z, false), B3 = (int)gu_split(hwa.w, hwb.w, false);
    int hs = __builtin_amdgcn_sdot4((int)hwa.x, 0x01010101, 0, false);
    hs = __builtin_amdgcn_sdot4((int)hwa.y, 0x01010101, hs, false); hs = __builtin_amdgcn_sdot4((int)hwa.z, 0x01010101, hs, false); hs = __builtin_amdgcn_sdot4((int)hwa.w, 0x01010101, hs, false);
    hs = __builtin_amdgcn_sdot4((int)hwb.x, 0x01010101, hs, false); hs = __builtin_amdgcn_sdot4((int)hwb.y, 0x01010101, hs, false);
    hs = __builtin_amdgcn_sdot4((int)hwb.z, 0x01010101, hs, false); hs = __builtin_amdgcn_sdot4((int)hwb.w, 0x01010101, hs, false);
    const float bias = 0.5f * (float)sum8_i(hs);
#pragma unroll
    for (int st = 0; st < 16; ++st) {
        int da = __builtin_amdgcn_sdot8((int)seg[st].x, A0, 0, false); da = __builtin_amdgcn_sdot8((int)seg[st].y, A1, da, false);
        da = __builtin_amdgcn_sdot8((int)seg[st].z, A2, da, false); da = __builtin_amdgcn_sdot8((int)seg[st].w, A3, da, false);
        int db = __builtin_amdgcn_sdot8((int)seg[st].x, B0, 0, false); db = __builtin_amdgcn_sdot8((int)seg[st].y, B1, db, false);
        db = __builtin_amdgcn_sdot8((int)seg[st].z, B2, db, false); db = __builtin_amdgcn_sdot8((int)seg[st].w, B3, db, false);
        const int d = sum8_i(da * 16 + db);
        lpart[st * 8 + eg] = (float)d + bias;
    }
    if (valid) prow[lane] = pk2(lpart[2 * lane], lpart[2 * lane + 1]);
}
__device__ __forceinline__ void phase_gu(const Args& a, char* lds, int layer, int mode) {
    const int lane = threadIdx.x & 63, wid = __builtin_amdgcn_readfirstlane(threadIdx.x >> 6), eg = lane >> 3, sub = lane & 7;
    const int x = blockIdx.x & 7, s = x >> 1, stripe = (blockIdx.x >> 3) * 2 + (x & 1), nstr = (gridDim.x >> 3) * 2 * NWAVE, ntok = mode == 1 ? NB * SEQ : MTOT;
    unsigned char* ws = a.ws;
    const unsigned char* H8 = ws + WS_H8 + s * 256 + sub * 32;
    const unsigned char* PUx = ws + WS_PU + (size_t)layer * NEXP * 512 + (size_t)s * NEXP * 128; const unsigned loff = (unsigned)(sub * 16);
    const int* SELI = (const int*)(ws + WS_SELI); unsigned* PART = (unsigned*)(ws + WS_PART) + (size_t)s * MTOT * 64;
    LAS int* lidx = (LAS int*)((LAS char*)lds + wid * 2048);
    LAS float* lpart = (LAS float*)(lidx + 256);
    const int first = stripe * NWAVE + wid;
#define G_TOK(k) peer_tok(min(first + (k) * nstr, ntok - 1), mode)
#define G_VALID(k) (first + (k) * nstr < ntok)
    u32x4 segA[16], segB[16], haA, hbA, haB, hbB;
    int p0, p1;
    { const int g = G_TOK(0); p0 = SELI[(size_t)g * 128 + lane]; p1 = SELI[(size_t)g * 128 + 64 + lane];
      gu_stage(segA, haA, hbA, lidx, p0, p1, H8 + (size_t)g * D, PUx, lane, eg, loff); }
    { const int g = G_TOK(1); p0 = SELI[(size_t)g * 128 + lane]; p1 = SELI[(size_t)g * 128 + 64 + lane]; }
    asm volatile(".p2align 6");
    for (int k = 0; G_VALID(k); k += 2) {
        { const int g1 = G_TOK(k + 1); gu_stage(segB, haB, hbB, lidx + 128, p0, p1, H8 + (size_t)g1 * D, PUx, lane, eg, loff); }
        { const int g2 = G_TOK(k + 2); p0 = SELI[(size_t)g2 * 128 + lane]; p1 = SELI[(size_t)g2 * 128 + 64 + lane]; }
        gu_compute(segA, haA, hbA, lpart, PART + (size_t)G_TOK(k) * 64, lane, eg, sub, true);
        if (!G_VALID(k + 1)) break;
        { const int g2 = G_TOK(k + 2); gu_stage(segA, haA, hbA, lidx, p0, p1, H8 + (size_t)g2 * D, PUx, lane, eg, loff); }
        { const int g3 = G_TOK(k + 3); p0 = SELI[(size_t)g3 * 128 + lane]; p1 = SELI[(size_t)g3 * 128 + 64 + lane]; }
        gu_compute(segB, haB, hbB, lpart, PART + (size_t)G_TOK(k + 1) * 64, lane, eg, sub, G_VALID(k + 1));
    }
}
__device__ __forceinline__ void phase_gact(const Args& a, int layer, int mode) {
    const int lane = threadIdx.x & 63, gw = blockIdx.x * NWAVE + (threadIdx.x >> 6), ngw = gridDim.x * NWAVE, ntok = mode == 1 ? NB * SEQ : MTOT;
    unsigned char* ws = a.ws;
    const unsigned* PART = (const unsigned*)(ws + WS_PART); const int* SELI = (const int*)(ws + WS_SELI); const float* SELG = (const float*)(ws + WS_SELG);
    const float* SCU = (const float*)(ws + WS_SCU) + layer * NEXP; const float* SCV = (const float*)(ws + WS_SCV) + layer * NEXP;
    const float* SH = (const float*)(ws + WS_SH); unsigned short* ACT8 = (unsigned short*)(ws + WS_ACT16); float* SA = (float*)(ws + WS_SA);
    typedef float f32x2 __attribute__((ext_vector_type(2)));
    typedef int i32x2_ __attribute__((ext_vector_type(2)));
    constexpr int TT = 4;
    for (int i0 = gw * TT; i0 < ntok; i0 += ngw * TT) {
        unsigned pw[TT][4]; i32x2_ id[TT]; f32x2 gt[TT]; float sh[TT]; int g[TT];
#pragma unroll
        for (int t = 0; t < TT; ++t) {
            g[t] = peer_tok(min(i0 + t, ntok - 1), mode);
            const size_t o = (size_t)g[t] * 64 + lane;
#pragma unroll
            for (int xx = 0; xx < 4; ++xx) pw[t][xx] = PART[(size_t)xx * MTOT * 64 + o];
            id[t] = *(const i32x2_*)(SELI + o * 2); gt[t] = *(const f32x2*)(SELG + o * 2); sh[t] = SH[g[t]];
        }
        float su[TT][2], sv[TT][2];
#pragma unroll
        for (int t = 0; t < TT; ++t) { su[t][0] = SCU[id[t].x]; su[t][1] = SCU[id[t].y]; sv[t][0] = SCV[id[t].x]; sv[t][1] = SCV[id[t].y]; }
#pragma unroll
        for (int t = 0; t < TT; ++t) {
            float d0 = 0.f, d1 = 0.f;
#pragma unroll
            for (int xx = 0; xx < 4; ++xx) { d0 += bflo(pw[t][xx]); d1 += bfhi(pw[t][xx]); }
            const float a0 = gelu_t(d0 * sh[t] * su[t][0]) * gt[t].x * sv[t][0], a1 = gelu_t(d1 * sh[t] * su[t][1]) * gt[t].y * sv[t][1];
            float mx = fmaxf(fabsf(a0), fabsf(a1));
            mx = wave_max(mx);
            mx = fmaxf(mx, 1e-30f); const float inv = 127.f / mx;
            if (i0 + t < ntok) {
                ACT8[(size_t)g[t] * 64 + lane] = (unsigned short)((__float2int_rn(a0 * inv) & 0xff) | ((__float2int_rn(a1 * inv) & 0xff) << 8));
                const int q0 = __float2int_rn(a0 * inv), q1 = __float2int_rn(a1 * inv);
                int qs = q0 + q1;
                qs = wave_sum_i(qs);
                SA[g[t]] = mx * (1.f / 127.f); ((int*)(ws + WS_SACT))[g[t]] = qs;
            }
        }
    }
}
__device__ __forceinline__ void gv_stage(u32x4 (&seg)[16], LAS int* lb, int i0, int i1, const unsigned char* PVx, int lane, int eg, unsigned loff) {
    lb[lane] = i0; lb[64 + lane] = i1;
#pragma unroll
    for (int st = 0; st < 16; ++st) seg[st] = *(const u32x4*)(PVx + ((unsigned)lb[st * 8 + eg] * 128u + loff));
}
typedef int i32x2 __attribute__((ext_vector_type(2)));
__device__ __forceinline__ void gv_compute(const u32x4 (&seg)[16], LAS unsigned char* tile, const i32x4 (&aw)[2], float sa, int sact, bf16_t* xr, const float* g2, int lane, bool valid) {
    {
        const int eg = lane >> 3, sub = lane & 7;
        LAS unsigned char* w0 = tile + eg * 128 + ((sub ^ ((eg >> 1) & 3)) << 4);
        LAS unsigned char* w1 = tile + eg * 128 + ((sub ^ ((eg >> 1) & 3) ^ 4) << 4);
#pragma unroll
        for (int st = 0; st < 16; ++st) *(LAS u32x4*)(((st & 2) ? w1 : w0) + st * 1024) = seg[st];
    }
    const int kgrp = lane >> 4, q = (lane >> 1) & 7, p = lane & 1, rg = lane >> 4;
    const int swz = ((q >> 1) & 3) | ((kgrp & 1) << 2);
    LAS unsigned char* rb = tile + (kgrp * 16 + q) * 128 + 8 * p;
    int a0 = 0, a1 = 0, b0 = 0, b1 = 0;
    constexpr unsigned M = 0x0f0f0f0fu;
#pragma unroll
    for (int n4 = 0; n4 < 8; n4 += 4) {
        i32x4 aL[4], aH[4];
#pragma unroll
        for (int j = 0; j < 4; ++j) { aL[j] = i32x4{0, 0, 0, 0}; aH[j] = i32x4{0, 0, 0, 0}; }
#pragma unroll
        for (int kt = 0; kt < 2; ++kt) {
            i32x2 bl[4], bh[4];
#pragma unroll
            for (int j = 0; j < 4; ++j) {
                LAS unsigned char* pa = rb + (((n4 + j) ^ swz) << 4) + kt * 8192;
                bl[j] = __builtin_amdgcn_ds_read_tr8_b64_v2i32((LAS i32x2*)pa);
                bh[j] = __builtin_amdgcn_ds_read_tr8_b64_v2i32((LAS i32x2*)(pa + 1024));
            }
#pragma unroll
            for (int j = 0; j < 4; ++j) {
                const unsigned x0 = (unsigned)bl[j].x, x1 = (unsigned)bl[j].y, x2 = (unsigned)bh[j].x, x3 = (unsigned)bh[j].y;
                aL[j] = __builtin_amdgcn_mfma_i32_16x16x64_i8(aw[kt], i32x4{(int)(x0 & M), (int)(x1 & M), (int)(x2 & M), (int)(x3 & M)}, aL[j], 0, 0, 0);
                aH[j] = __builtin_amdgcn_mfma_i32_16x16x64_i8(aw[kt], i32x4{(int)x0, (int)x1, (int)x2, (int)x3}, aH[j], 0, 0, 0);
            }
        }
        const bool sel = (rg & 1) != 0, mine = (rg >> 1) == (n4 >> 2);
        const int ta0 = sel ? aL[2][0] : aL[0][0], ta1 = sel ? aL[3][0] : aL[1][0], tr0 = sel ? aH[2][0] : aH[0][0], tr1 = sel ? aH[3][0] : aH[1][0];
        a0 = mine ? ta0 : a0; a1 = mine ? ta1 : a1; b0 = mine ? ((tr0 - ta0) >> 4) : b0; b1 = mine ? ((tr1 - ta1) >> 4) : b1;
    }
    if (valid) {
        const float biasl = 7.5f * (float)sact, biash = 0.5f * (float)sact;
        xr[0] = (bf16_t)f2bf(bf2f(xr[0]) + g2[0] * (sa * ((float)a0 - biasl))); xr[16] = (bf16_t)f2bf(bf2f(xr[16]) + g2[16] * (sa * ((float)b0 + biash)));
        xr[32] = (bf16_t)f2bf(bf2f(xr[32]) + g2[32] * (sa * ((float)a1 - biasl))); xr[48] = (bf16_t)f2bf(bf2f(xr[48]) + g2[48] * (sa * ((float)b1 + biash)));
    }
}
__device__ __forceinline__ void phase_gv(const Args& a, char* lds, int layer, int mode) {
    const int lane = threadIdx.x & 63, wid = __builtin_amdgcn_readfirstlane(threadIdx.x >> 6), eg = lane >> 3, sub = lane & 7;
    const int x = blockIdx.x & 7, s = x >> 1, stripe = (blockIdx.x >> 3) * 2 + (x & 1), nstr = (gridDim.x >> 3) * 2 * NWAVE, ntok = mode == 1 ? NB * SEQ : MTOT;
    unsigned char* ws = a.ws;
    const int ocol = s * 256 + (lane >> 4) * 64 + (lane & 15);
    bf16_t* X1 = (bf16_t*)(ws + WS_X1) + ocol;
    const unsigned char* PVx = ws + WS_PV + (size_t)layer * NEXP * 512 + (size_t)s * NEXP * 128; const unsigned loff = (unsigned)(sub * 16);
    const int* SELI = (const int*)(ws + WS_SELI); const unsigned char* ACT8 = ws + WS_ACT16 + (lane >> 4) * 16; const float* SA = (const float*)(ws + WS_SA); const int* SACT = (const int*)(ws + WS_SACT);
    LAS int* lidx = (LAS int*)((LAS char*)lds + 131072 + wid * 1024);
    LAS unsigned char* tile = (LAS unsigned char*)((LAS char*)lds + wid * 16384);
    const int first = stripe * NWAVE + wid;
#define G_TOK(k) peer_tok(min(first + (k) * nstr, ntok - 1), mode)
#define G_VALID(k) (first + (k) * nstr < ntok)
    u32x4 segA[16], segB[16];
    i32x4 awA[2], awB[2]; float saA, saB; int scA, scB;
    int p0, p1;
#define GV_PREF(k) { const int g_ = G_TOK(k); p0 = SELI[(size_t)g_ * 128 + lane]; p1 = SELI[(size_t)g_ * 128 + 64 + lane]; }
#define GV_AW(AW, SAV, SCV_, k) { const int g_ = G_TOK(k); AW[0] = *(const i32x4*)(ACT8 + (size_t)g_ * 128); AW[1] = *(const i32x4*)(ACT8 + (size_t)g_ * 128 + 64); SAV = SA[g_]; SCV_ = SACT[g_]; }
#define GV_G2(k) (modv(a, layer, row_variant(G_TOK(k)), 5) + ocol)
    GV_PREF(0) gv_stage(segA, lidx, p0, p1, PVx, lane, eg, loff); GV_AW(awA, saA, scA, 0)
    GV_PREF(1)
    asm volatile(".p2align 6");
    for (int k = 0; G_VALID(k); k += 2) {
        gv_stage(segB, lidx + 128, p0, p1, PVx, lane, eg, loff); GV_AW(awB, saB, scB, k + 1)
        GV_PREF(k + 2)
        gv_compute(segA, tile, awA, saA, scA, X1 + (size_t)G_TOK(k) * D, GV_G2(k), lane, true);
        if (!G_VALID(k + 1)) break;
        gv_stage(segA, lidx, p0, p1, PVx, lane, eg, loff); GV_AW(awA, saA, scA, k + 2)
        GV_PREF(k + 3)
        gv_compute(segB, tile, awB, saB, scB, X1 + (size_t)G_TOK(k + 1) * D, GV_G2(k + 1), lane, G_VALID(k + 1));
    }
#undef GV_PREF
#undef GV_AW
#undef GV_G2
#undef G_TOK
#undef G_VALID
}
__device__ __forceinline__ void phase_finalnorm(const Args& a) {
    const int lane = threadIdx.x & 63, gw = blockIdx.x * NWAVE + (threadIdx.x >> 6), ngw = gridDim.x * NWAVE;
    const bf16_t* X1 = (const bf16_t*)(a.ws + WS_X1);
    for (int i = gw; i < NB * SEQ; i += ngw) {
        const int g = peer_tok(i, 1);
        const bf16_t* xr = X1 + (size_t)g * D; float* op = a.out + (size_t)i * D;
        f32x4 v[4]; float ss = 0.f;
#pragma unroll
        for (int j = 0; j < 4; ++j) { const u32x2 w = *(const u32x2*)(xr + j * 256 + lane * 4); v[j] = f32x4{bflo(w.x), bfhi(w.x), bflo(w.y), bfhi(w.y)}; ss += (v[j].x * v[j].x + v[j].y * v[j].y) + (v[j].z * v[j].z + v[j].w * v[j].w); }
        const float rinv = rsqrtf(wave_sum(ss) * (1.f / D) + EPS);
#pragma unroll
        for (int j = 0; j < 4; ++j) { const f32x4 gn = *(const f32x4*)(a.in[28] + j * 256 + lane * 4); *(f32x4*)(op + j * 256 + lane * 4) = v[j] * rinv * gn; }
    }
}

constexpr int XC_LD = 136;
__device__ __forceinline__ float exp2_fast(float x) { return __builtin_amdgcn_exp2f(x); }
__device__ __forceinline__ float sigm_fast(float x) { return __builtin_amdgcn_rcpf(1.f + __builtin_amdgcn_exp2f(-1.4426950408889634f * x)); }
__device__ __forceinline__ int rg_tau(int rho) { return 16 * ((rho >> 2) & 1) + (rho & 3) + 4 * (rho >> 3); }
__device__ __forceinline__ void phase_rglru2(const Args& a, char* lds, int pass) {
    const int tid_ = threadIdx.x, wid = __builtin_amdgcn_readfirstlane(tid_ >> 6);
    const int nb = wid & 3, dir = wid >> 2;
    unsigned char* ws = a.ws;
    LAS bf16_t* xcA = (LAS bf16_t*)((LAS char*)lds);
    const bf16_t* XR = (const bf16_t*)(ws + WS_XR);
    float* CARRY = (float*)(ws + WS_CARRY);
    typedef float f32x2 __attribute__((ext_vector_type(2)));
    const int NU = (MTOT / 128) * 10;
    asm volatile(".p2align 6");
    for (int u = blockIdx.x; u < NU; u += gridDim.x) {
        const int T = u / 10, hb = u % 10, b = T / 66, tl = T % 66, row0 = T * 128;
        int tid = tid_; asm volatile("" : "+v"(tid));
        const int lane = tid & 63, r32 = lane & 31, hh = lane >> 5;
        const int seq_lo = tl < 2 ? b * RPB : b * RPB + CTXL, seq_hi = tl < 2 ? b * RPB + CTXL : (b + 1) * RPB;
        const int ch = hb * 128 + nb * 32 + r32;
        u32x4* stu = (u32x4*)(ws + WS_STU) + (size_t)(u * 8 + wid) * 4 * 64;
        u32x4* str = (u32x4*)(ws + WS_STR) + (size_t)(u * 8 + wid) * 4 * 64;
        f32x16 accA[4], accX[4];
        {
            const int j2 = tid & 63, ts = tid >> 6, c0 = hb * 128 + 2 * j2;
            unsigned xw[19];
#pragma unroll
            for (int i = 0; i < 19; ++i) { const int g = row0 + ts * 16 - 2 + i; const int gc = min(max(g, seq_lo), seq_hi - 1); xw[i] = *(const unsigned*)(XR + (size_t)gc * DRNN + c0); }
            const f32x2 cw0 = *(const f32x2*)(a.in[16] + 0 * DRNN + c0), cw1 = *(const f32x2*)(a.in[16] + 1 * DRNN + c0), cw2 = *(const f32x2*)(a.in[16] + 2 * DRNN + c0), cw3 = *(const f32x2*)(a.in[16] + 3 * DRNN + c0);
            const f32x2 cbv = *(const f32x2*)(a.in[17] + c0);
            bf16x8 bfa[8], bfx[8];
            {
                unsigned woff = (unsigned)((nb * 32 + r32) * 128 + 8 * hh); asm volatile("" : "+v"(woff));
                const bf16_t* wa = (const bf16_t*)(ws + WS_WAT) + (size_t)(dir * 10 + hb) * 128 * 128;
                const bf16_t* wx = (const bf16_t*)(ws + WS_WXT) + (size_t)(dir * 10 + hb) * 128 * 128;
#pragma unroll
                for (int k = 0; k < 8; ++k) { bfa[k] = *(const bf16x8*)(wa + woff + k * 16); bfx[k] = *(const bf16x8*)(wx + woff + k * 16); }
            }
            const float ba = a.in[19][dir * DRNN + ch], bx = a.in[21][dir * DRNN + ch], lam = a.in[22][dir * DRNN + ch];
            __builtin_amdgcn_sched_barrier(0);
            {
#pragma unroll
                for (int i = 0; i < 19; ++i) { const int g = row0 + ts * 16 - 2 + i; if (g < seq_lo || g >= seq_hi) xw[i] = 0u; }
                const int csw = (2 * j2) ^ ((ts & 1) << 6);
#pragma unroll
                for (int i = 0; i < 16; ++i) {
                    const float y0 = cw0.x * bflo(xw[i]) + cw1.x * bflo(xw[i + 1]) + cw2.x * bflo(xw[i + 2]) + cw3.x * bflo(xw[i + 3]) + cbv.x;
                    const float y1 = cw0.y * bfhi(xw[i]) + cw1.y * bfhi(xw[i + 1]) + cw2.y * bfhi(xw[i + 2]) + cw3.y * bfhi(xw[i + 3]) + cbv.y;
                    *(LAS unsigned*)(xcA + (ts * 16 + i) * XC_LD + csw) = pk2(y0, y1);
                }
            }
            __syncthreads();
            {
                const float nba = -1.4426950408889634f * ba, nbx = -1.4426950408889634f * bx;
                f32x16 cA, cX;
#pragma unroll
                for (int r = 0; r < 16; ++r) { cA[r] = nba; cX[r] = nbx; }
                const int arow = rg_tau(r32) * XC_LD, fl64 = ((r32 >> 2) & 1) << 6;
#pragma unroll
                for (int mb = 0; mb < 4; ++mb) {
#pragma unroll
                    for (int k = 0; k < 8; ++k) {
                        const bf16x8 af = *(const LAS bf16x8*)(xcA + mb * 32 * XC_LD + arow + (((k * 16) ^ fl64) + 8 * hh));
                        accA[mb] = __builtin_amdgcn_mfma_f32_32x32x16_bf16(af, bfa[k], k == 0 ? cA : accA[mb], 0, 0, 0);
                        accX[mb] = __builtin_amdgcn_mfma_f32_32x32x16_bf16(af, bfx[k], k == 0 ? cX : accX[mb], 0, 0, 0);
                    }
                }
            }
            __builtin_amdgcn_sched_barrier(0);
            {
                const float sp8l = -8.f * 1.4426950408889634f * log1pf(__expf(-lam));
                if (T == 2 && hh == 0) ((float*)(ws + WS_SPL))[dir * DRNN + ch] = sp8l;
                const int xcol = (nb * 32 + r32) ^ (hh << 6);
#pragma unroll
                for (int mb = 0; mb < 4; ++mb) {
                    u32x4 rq = {0u, 0u, 0u, 0u};
#pragma unroll
                    for (int r = 0; r < 16; ++r) {
                        const int t = mb * 32 + 16 * hh + r;
                        const float xv = bf2f(xcA[t * XC_LD + xcol]);
                        const float rg = __builtin_amdgcn_rcpf(1.f + __builtin_amdgcn_exp2f(accA[mb][r]));
                        const float ig = __builtin_amdgcn_rcpf(1.f + __builtin_amdgcn_exp2f(accX[mb][r]));
                        const float av = __builtin_amdgcn_exp2f(rg * sp8l);
                        const float om = fmaxf(__builtin_fmaf(-av, av, 1.f), 0.f);
                        accA[mb][r] = av; accX[mb][r] = __builtin_amdgcn_sqrtf(om) * ig * xv;
                        rq[r >> 2] = __builtin_amdgcn_cvt_pk_u8_f32(rg * 255.f, r & 3, rq[r >> 2]);
                        if ((r & 3) == 3) __builtin_amdgcn_sched_barrier(0);
                    }
                    if (tl >= 2) str[mb * 64 + lane] = rq;
                }
            }
            __builtin_amdgcn_sched_barrier(0);
        }
        float h = 0.f, Atot = 1.f;
#define RG_SEG(mb) float sA, sH; \
            if (dir == 0) { sH = accX[mb][0]; _Pragma("unroll") for (int r = 1; r < 16; ++r) sH = sH * accA[mb][r] + accX[mb][r]; } \
            else { sH = accX[mb][15]; _Pragma("unroll") for (int r = 14; r >= 0; --r) sH = sH * accA[mb][r] + accX[mb][r]; } \
            { const float p0 = accA[mb][0] * accA[mb][1], p1 = accA[mb][2] * accA[mb][3], p2 = accA[mb][4] * accA[mb][5], p3 = accA[mb][6] * accA[mb][7]; \
              const float p4 = accA[mb][8] * accA[mb][9], p5 = accA[mb][10] * accA[mb][11], p6 = accA[mb][12] * accA[mb][13], p7 = accA[mb][14] * accA[mb][15]; \
              sA = ((p0 * p1) * (p2 * p3)) * ((p4 * p5) * (p6 * p7)); } \
            const auto ra = __builtin_amdgcn_permlane32_swap(__float_as_uint(sA), __float_as_uint(sA), false, false); \
            const auto rh = __builtin_amdgcn_permlane32_swap(__float_as_uint(sH), __float_as_uint(sH), false, false); \
            const float EA = __uint_as_float(ra[0]), EH = __uint_as_float(rh[0]), OA = __uint_as_float(ra[1]), OH = __uint_as_float(rh[1]);
        if (dir == 0) {
#pragma unroll
            for (int mb = 0; mb < 4; ++mb) { RG_SEG(mb) h = EA * h + EH; h = OA * h + OH; Atot *= EA * OA; }
        } else {
#pragma unroll
            for (int mb = 3; mb >= 0; --mb) { RG_SEG(mb) h = OA * h + OH; h = EA * h + EH; Atot *= EA * OA; }
        }
#undef RG_SEG
        if (hh == 0) { const int pp = dir == 0 ? tl : (tl < 2 ? 1 - tl : 67 - tl);
            float* c = CARRY + (((size_t)(b * 2 + dir) * DRNN + ch) * 66 + pp) * 2; c[0] = Atot; c[1] = h; }
        if (tl >= 2) {
            float mxu = 0.f;
#pragma unroll
            for (int mb = 0; mb < 4; ++mb)
#pragma unroll
                for (int r = 0; r < 16; r += 2) mxu = fmaxf(fmaxf(fabsf(accX[mb][r]), fabsf(accX[mb][r + 1])), mxu);
            mxu = fmaxf(mxu, 1e-30f); const float uinv = 127.f / mxu;
#pragma unroll
            for (int mb = 0; mb < 4; ++mb) { u32x4 o = {0u, 0u, 0u, 0u};
#pragma unroll
                for (int r = 0; r < 16; ++r) o[r >> 2] = __builtin_amdgcn_cvt_pk_u8_f32(__builtin_rintf(accX[mb][r] * uinv) + 128.f, r & 3, o[r >> 2]);
                stu[mb * 64 + lane] = o; }
            ((float*)(ws + WS_STS))[(size_t)(u * 8 + wid) * 64 + lane] = mxu * (1.f / 127.f);
        }
        __syncthreads();
    }
    {
        const int G = (int)gridDim.x, nlast = NU - (NU / G) * G;
        if ((int)blockIdx.x >= nlast) quant_tables(a, 1, ((int)blockIdx.x - nlast) * NWAVE + wid, (G - nlast) * NWAVE, tid_ & 63, NEXP, 2 * NEXP);
    }
}

__device__ __forceinline__ void rg_out_load(u32x4 (&Lsr)[4], u32x4 (&Lsu)[4], float& Lusc, float& Llam, const Args& a, int u, int wid, int tid) {
    typedef float f32x2 __attribute__((ext_vector_type(2)));
    unsigned char* ws = a.ws;
    const int nb = wid & 3, dir = wid >> 2, lane = tid & 63, r32 = lane & 31, hh = lane >> 5;
    const int T = u / 10, hb = u % 10, b = T / 66, row0 = T * 128, ch = hb * 128 + nb * 32 + r32;
    const u32x4* stu = (const u32x4*)(ws + WS_STU) + (size_t)(u * 8 + wid) * 4 * 64;
    const u32x4* str = (const u32x4*)(ws + WS_STR) + (size_t)(u * 8 + wid) * 4 * 64;
#pragma unroll
    for (int c = 0; c < 4; ++c) Lsr[c] = str[c * 64 + lane];
#pragma unroll
    for (int c = 0; c < 4; ++c) Lsu[c] = stu[c * 64 + lane];
    Lusc = ((const float*)(ws + WS_STS))[(size_t)(u * 8 + wid) * 64 + lane];
    Llam = ((const float*)(ws + WS_SPL))[dir * DRNN + ch];
}
__device__ __forceinline__ void phase_rglru_out(const Args& a, char* lds) {
    const int tid_ = threadIdx.x, wid = __builtin_amdgcn_readfirstlane(tid_ >> 6);
    const int nb = wid & 3, dir = wid >> 2, G = (int)gridDim.x;
    LAS float* HS = (LAS float*)((LAS char*)lds + 36864);
    bf16_t* YG = (bf16_t*)(a.ws + WS_YG);
    const int NU = (MTOT / 128) * 10;
#define RG_SKIP(u_) ((((u_) / 10) % 66) < 2)
#define RG_MAP(v_) ((((v_) / 10) + 2 + ((v_) >= 640 ? 2 : 0)) * 10 + (v_) % 10)
    const int NV = (NB * SEQ / 128) * 10;
    int v = blockIdx.x;
    if (v >= NV) return;
    int u = RG_MAP(v);
    u32x4 Lsr[4], Lsu[4]; float Lusc, Llam;
    rg_out_load(Lsr, Lsu, Lusc, Llam, a, u, wid, tid_);
    asm volatile(".p2align 6");
    for (;;) {
        const int vn = v + G;
        const int un = vn < NV ? RG_MAP(vn) : NU;
        int tid = tid_; asm volatile("" : "+v"(tid));
        const int lane = tid & 63, r32 = lane & 31, hh = lane >> 5;
        const int T = u / 10, hb = u % 10, tl = T % 66, row0 = T * 128;
        f32x16 accA[4]; float h0; u32x4 ggw[4], csu[4];
#pragma unroll
        for (int c = 0; c < 4; ++c) csu[c] = Lsu[c];
        const float usc = Lusc, uof = -128.f * Lusc;
#define RG_UB(w, k) __builtin_fmaf((float)(((w) >> (8 * (k))) & 0xffu), usc, uof)
#define RG_UX(mb, r) RG_UB(csu[mb][(r) >> 2], (r) & 3)
        typedef float f32x2 __attribute__((ext_vector_type(2)));
        f32x2 cv[33];
        const float c255 = Llam * (1.f / 255.f);
#define RG_DECODE(mb) _Pragma("unroll") for (int r = 0; r < 16; ++r) { \
            const unsigned w = Lsr[mb][r >> 2]; \
            accA[mb][r] = __builtin_amdgcn_exp2f((float)((w >> (8 * (r & 3))) & 0xffu) * c255); }
        RG_DECODE(0) RG_DECODE(1)
        __builtin_amdgcn_sched_barrier(0);
        {
            const int b = T / 66, ch = hb * 128 + nb * 32 + r32;
            const float* cbase = (const float*)(a.ws + WS_CARRY) + (((size_t)(b * 2 + dir) * DRNN + ch) * 66 + hh * 33) * 2;
#pragma unroll
            for (int i = 0; i < 33; ++i) cv[i] = *(const f32x2*)(cbase + i * 2);

        }
        __builtin_amdgcn_sched_barrier(0);
        RG_DECODE(2) RG_DECODE(3)
#undef RG_DECODE
        __builtin_amdgcn_sched_barrier(0);
        {
            const int pos = dir == 0 ? tl : 67 - tl;
            float cA = 1.f, cH = 0.f;
#pragma unroll
            for (int i = 0; i < 33; ++i) { const bool ok = hh * 33 + i < pos; const float ta = ok ? cv[i].x : 1.f, th = ok ? cv[i].y : 0.f; cH = ta * cH + th; cA = ta * cA; }
            const auto ra = __builtin_amdgcn_permlane32_swap(__float_as_uint(cA), __float_as_uint(cA), false, false);
            const auto rh = __builtin_amdgcn_permlane32_swap(__float_as_uint(cH), __float_as_uint(cH), false, false);
            h0 = __uint_as_float(ra[1]) * __uint_as_float(rh[0]) + __uint_as_float(rh[1]);
        }
        __builtin_amdgcn_sched_barrier(0);
        float h = h0; float cin[4];
#define RG_SEG(mb) float sA, sH; \
            if (dir == 0) { sH = RG_UX(mb, 0); _Pragma("unroll") for (int r = 1; r < 16; ++r) sH = sH * accA[mb][r] + RG_UX(mb, r); } \
            else { sH = RG_UX(mb, 15); _Pragma("unroll") for (int r = 14; r >= 0; --r) sH = sH * accA[mb][r] + RG_UX(mb, r); } \
            { const float p0 = accA[mb][0] * accA[mb][1], p1 = accA[mb][2] * accA[mb][3], p2 = accA[mb][4] * accA[mb][5], p3 = accA[mb][6] * accA[mb][7]; \
              const float p4 = accA[mb][8] * accA[mb][9], p5 = accA[mb][10] * accA[mb][11], p6 = accA[mb][12] * accA[mb][13], p7 = accA[mb][14] * accA[mb][15]; \
              sA = ((p0 * p1) * (p2 * p3)) * ((p4 * p5) * (p6 * p7)); } \
            const auto ra = __builtin_amdgcn_permlane32_swap(__float_as_uint(sA), __float_as_uint(sA), false, false); \
            const auto rh = __builtin_amdgcn_permlane32_swap(__float_as_uint(sH), __float_as_uint(sH), false, false); \
            const float EA = __uint_as_float(ra[0]), EH = __uint_as_float(rh[0]), OA = __uint_as_float(ra[1]), OH = __uint_as_float(rh[1]);
#define RG_WORDS(mb, j) unsigned w0 = csu[mb][j]; asm volatile("" : "+v"(w0)); \
            const float uu[4] = {RG_UB(w0, 0), RG_UB(w0, 1), RG_UB(w0, 2), RG_UB(w0, 3)};
        if (dir == 0) {
#pragma unroll
            for (int mb = 0; mb < 4; ++mb) { RG_SEG(mb) const float hE = h; h = EA * h + EH; const float hO = h; h = OA * h + OH; cin[mb] = hh ? hO : hE; }
#pragma unroll
            for (int mb = 0; mb < 4; ++mb) { float hc = cin[mb];
#pragma unroll
                for (int j = 0; j < 4; ++j) { RG_WORDS(mb, j)
#pragma unroll
                    for (int e = 0; e < 4; ++e) { hc = accA[mb][4 * j + e] * hc + uu[e]; accA[mb][4 * j + e] = hc; } } }
        } else {
#pragma unroll
            for (int mb = 3; mb >= 0; --mb) { RG_SEG(mb) const float hO = h; h = OA * h + OH; const float hE = h; h = EA * h + EH; cin[mb] = hh ? hO : hE; }
#pragma unroll
            for (int mb = 0; mb < 4; ++mb) { float hc = cin[mb];
#pragma unroll
                for (int j = 3; j >= 0; --j) { RG_WORDS(mb, j)
#pragma unroll
                    for (int e = 3; e >= 0; --e) { hc = accA[mb][4 * j + e] * hc + uu[e]; accA[mb][4 * j + e] = hc; } } }
        }
#undef RG_SEG
#undef RG_WORDS
#undef RG_UX
#undef RG_UB
        __builtin_amdgcn_sched_barrier(0);
        {
            const int t = tid >> 2, cs = (tid & 3) * 32;
            const bf16_t* gp = (const bf16_t*)(a.ws + WS_GG) + (size_t)(row0 + t) * DRNN + hb * 128 + cs;
#pragma unroll
            for (int c8 = 0; c8 < 4; ++c8) ggw[c8] = *(const u32x4*)(gp + c8 * 8);
        }
        if (un < NU) rg_out_load(Lsr, Lsu, Lusc, Llam, a, un, wid, tid);
        __builtin_amdgcn_sched_barrier(0);
        if (dir == 0) {
#pragma unroll
            for (int mb = 0; mb < 4; ++mb)
#pragma unroll
                for (int r = 0; r < 16; ++r) { const int t = mb * 32 + 16 * hh + r; HS[t * 128 + nb * 32 + r32] = accA[mb][r]; }
        }
        __syncthreads();
        if (dir == 1) {
#pragma unroll
            for (int mb = 0; mb < 4; ++mb)
#pragma unroll
                for (int r = 0; r < 16; ++r) { const int t = mb * 32 + 16 * hh + r; HS[t * 128 + nb * 32 + r32] += accA[mb][r]; }
        }
        __syncthreads();
        {
            const int t = tid >> 2, cs = (tid & 3) * 32, g = row0 + t;
            bf16_t* yp = YG + (size_t)g * DRNN + hb * 128 + cs;
#pragma unroll
            for (int c8 = 0; c8 < 32; c8 += 8) {
                const u32x4 gw = ggw[c8 >> 3];
                const f32x4 h0v = *(const LAS f32x4*)(HS + t * 128 + cs + c8), h1v = *(const LAS f32x4*)(HS + t * 128 + cs + c8 + 4);
                u32x4 o; o.x = pk2(h0v.x * bflo(gw.x), h0v.y * bfhi(gw.x)); o.y = pk2(h0v.z * bflo(gw.y), h0v.w * bfhi(gw.y));
                o.z = pk2(h1v.x * bflo(gw.z), h1v.y * bfhi(gw.z)); o.w = pk2(h1v.z * bflo(gw.w), h1v.w * bfhi(gw.w));
                *(u32x4*)(yp + c8) = o;
            }
        }
        __syncthreads();
        if (un >= NU) break;
        u = un; v = vn;
    }
#undef RG_SKIP
#undef RG_MAP
}

namespace pg8 {
constexpr int BM = 256, BK = 64, HALF = 128, HTB = HALF * BK * 2, STAGE_BYTES = 8 * HTB, NXCD = 8, WGM = 8;
__host__ __device__ __forceinline__ int lds_byte(int r, int c) { const int st = (r >> 4) * 2 + (c >> 5), rr = r & 15, cc = c & 31, ob = rr * 64 + cc * 2; return st * 1024 + (ob ^ (((ob >> 9) & 1) << 5)); }
__host__ __device__ __forceinline__ void stage_rc(int b, int& R, int& C) { const int st = b / 1024, sb = b % 1024, swz = sb ^ (((sb >> 9) & 1) << 5); R = (st >> 1) * 16 + swz / 64; C = (st & 1) * 32 + (swz % 64) / 2; }
__host__ __device__ __forceinline__ int perm32(int rho) { const int n = rho >> 4, i = rho & 15; return 8 * (i >> 2) + 4 * n + (i & 3); }
struct Unit { int pm, pn; };
struct Gemm { const bf16_t* A; const bf16_t* Bt; int M, N, K; const float* sa; const float* sw; };
struct StaticOrder {
    int nM, nN, nwg, G, c;
    __host__ __device__ void init(int M, int N, int G_, int c_) { nM = M / BM; nN = N / BM; nwg = nM * nN; G = G_; c = c_; }
    __host__ __device__ bool next(int i, Unit& u) const {
        const long L = (long)i * G + c; if (L >= nwg) return false;
        int wgid = (int)L; { const int q = nwg / NXCD, r = nwg % NXCD, xcd = wgid % NXCD, off = wgid / NXCD; wgid = (xcd < r ? xcd * (q + 1) : r * (q + 1) + (xcd - r) * q) + off; }
        const int nig = WGM * nN, gid = wgid / nig, fm = gid * WGM, gsz = (nM - fm) < WGM ? (nM - fm) : WGM;
        u.pm = fm + ((wgid % nig) % gsz); u.pn = (wgid % nig) / gsz; return true;
    }
    __device__ __forceinline__ void a_ready(const Unit&) const {}
    __device__ __forceinline__ void done(const Unit&) const {}
};
struct LatentOrder {
    StaticOrder S;
    __host__ __device__ void init(int N, int G_, int c_) { S.init(16384, N, G_, c_); }
    __host__ __device__ bool next(int i, Unit& u) const { if (!S.next(i, u)) return false; u.pm = u.pm + 1 + (u.pm >= 32 ? 1 : 0); return true; }
    __device__ __forceinline__ void a_ready(const Unit&) const {}
    __device__ __forceinline__ void done(const Unit&) const {}
};
__device__ __forceinline__ unsigned cvt_pk_bf16(float lo, float hi) { unsigned r; asm volatile("v_cvt_pk_bf16_f32 %0, %1, %2" : "=v"(r) : "v"(lo), "v"(hi)); return r; }
__device__ __forceinline__ u32x4 pack8(const f32x4& v0, const f32x4& v1) { u32x4 w; w.x = cvt_pk_bf16(v0[0], v0[1]); w.y = cvt_pk_bf16(v0[2], v0[3]); w.z = cvt_pk_bf16(v1[0], v1[1]); w.w = cvt_pk_bf16(v1[2], v1[3]); return w; }
__device__ __forceinline__ f32x4 gelu4(const f32x4& v) { f32x4 r; r.x = gelu_t(v.x); r.y = gelu_t(v.y); r.z = gelu_t(v.z); r.w = gelu_t(v.w); return r; }

struct EpiStore {
    static constexpr bool PERM = true, AFTER_DRAIN = false;
    bf16_t* O1; bf16_t* O2; int ld; int split_tile; int gelu_tiles;
    __device__ __forceinline__ void operator()(f32x4 (&acc)[2][2][4][2], const Unit& u, int wr, int wc, int fr, int fq) const {
        const bool second = u.pn >= split_tile; bf16_t* base = second ? O2 : O1; const int pnl = second ? u.pn - split_tile : u.pn; const bool dog = u.pn < gelu_tiles;
        const int rl0 = wr * 64 + fr, cl0 = wc * 32 + 8 * fq;
#pragma unroll
        for (int ai = 0; ai < 2; ++ai)
#pragma unroll
            for (int m = 0; m < 4; ++m) { bf16_t* rowp = base + (size_t)(u.pm * BM + ai * HALF + m * 16 + rl0) * ld + pnl * BM + cl0;
#pragma unroll
                for (int bj = 0; bj < 2; ++bj) { f32x4 v0 = acc[ai][bj][m][0], v1 = acc[ai][bj][m][1]; if (dog) { v0 = gelu4(v0); v1 = gelu4(v1); }
                    *(u32x4*)(rowp + bj * HALF) = pack8(v0, v1); } }
    }
};
struct EpiResid {
    static constexpr bool PERM = true, AFTER_DRAIN = false;
    const float* x; const float* ctx; const float* modbase; bf16_t* X1; int base_mode;
    __device__ __forceinline__ void operator()(f32x4 (&acc)[2][2][4][2], const Unit& u, int wr, int wc, int fr, int fq) const {
        const int b = u.pm / 33, tl = u.pm % 33, var = tl == 0 ? 2 : b;
        const float* gate = modbase + (size_t)var * 6144 + u.pn * BM;
        const float* basep = tl == 0 ? ctx + (size_t)b * CTXL * D : x + ((size_t)b * SEQ + (size_t)(tl - 1) * 256) * D;
        bf16_t* outp = X1 + (size_t)u.pm * BM * D;
        const int rl0 = wr * 64 + fr, cl0 = u.pn * BM + wc * 32 + 8 * fq;
        f32x4 gv[2][2];
#pragma unroll
        for (int bj = 0; bj < 2; ++bj)
#pragma unroll
            for (int n = 0; n < 2; ++n) gv[bj][n] = *(const f32x4*)(gate + bj * HALF + wc * 32 + 8 * fq + 4 * n);
#pragma unroll
        for (int ai = 0; ai < 2; ++ai)
#pragma unroll
            for (int m = 0; m < 4; ++m) { const size_t off = (size_t)(ai * HALF + m * 16 + rl0) * D + cl0;
#pragma unroll
                for (int bj = 0; bj < 2; ++bj)
                { f32x4 b0, b1;
                    if (base_mode == 0) { b0 = *(const f32x4*)(basep + off + bj * HALF); b1 = *(const f32x4*)(basep + off + bj * HALF + 4); }
                    else { const u32x4 w = *(const u32x4*)(outp + off + bj * HALF); b0 = f32x4{bflo(w.x), bfhi(w.x), bflo(w.y), bfhi(w.y)}; b1 = f32x4{bflo(w.z), bfhi(w.z), bflo(w.w), bfhi(w.w)}; }
                    const f32x4 o0 = b0 + gv[bj][0] * acc[ai][bj][m][0], o1 = b1 + gv[bj][1] * acc[ai][bj][m][1];
                    u32x4 o; o.x = pk2(o0.x, o0.y); o.y = pk2(o0.z, o0.w); o.z = pk2(o1.x, o1.y); o.w = pk2(o1.z, o1.w);
                    *(u32x4*)(outp + off + bj * HALF) = o; } }
    }
};
struct EpiInproj0 {
    static constexpr bool PERM = true, AFTER_DRAIN = false;
    unsigned char* ws; const float* gmg; const float* qg; const float* kg; LAS float* P;
    __device__ __forceinline__ void operator()(f32x4 (&acc)[2][2][4][2], const Unit& u, int wr, int wc, int fr, int fq) const {
        int rl0 = wr * 64 + fr, cl0 = wc * 32 + 8 * fq; asm volatile("" : "+v"(rl0), "+v"(cl0));
        const int pn = u.pn; const size_t grow0 = (size_t)u.pm * BM;
        if (pn < 4) {
#pragma unroll
            for (int ai = 0; ai < 2; ++ai)
#pragma unroll
                for (int bj = 0; bj < 2; ++bj)
#pragma unroll
                    for (int m = 0; m < 4; ++m) { acc[ai][bj][m][0] = gelu4(acc[ai][bj][m][0]); acc[ai][bj][m][1] = gelu4(acc[ai][bj][m][1]); __builtin_amdgcn_sched_barrier(0); }
        }
        if (pn < 2 || pn == 7) {
            const size_t kvrow0 = (size_t)((u.pm / 33) * 2) * RPB + (size_t)(u.pm % 33) * BM;
            bf16_t* base = pn < 2 ? (bf16_t*)(ws + WS_U) + pn * BM + grow0 * 512 : (bf16_t*)(ws + WS_V) + kvrow0 * 128; const int ld = pn < 2 ? 512 : 128;
            const size_t bjs = pn < 2 ? (size_t)HALF : (size_t)RPB * 128;
#pragma unroll
            for (int ai = 0; ai < 2; ++ai)
#pragma unroll
                for (int m = 0; m < 4; ++m) { bf16_t* rowp = base + (size_t)(ai * HALF + m * 16 + rl0) * ld + cl0;
#pragma unroll
                    for (int bj = 0; bj < 2; ++bj) *(u32x4*)(rowp + bj * bjs) = pack8(acc[ai][bj][m][0], acc[ai][bj][m][1]); }
            return;
        }
#pragma unroll
        for (int ai = 0; ai < 2; ++ai)
#pragma unroll
            for (int m = 0; m < 4; ++m)
#pragma unroll
                for (int bj = 0; bj < 2; ++bj) { const f32x4 a0 = acc[ai][bj][m][0], a1 = acc[ai][bj][m][1];
                    float s = (a0.x * a0.x + a0.y * a0.y) + (a0.z * a0.z + a0.w * a0.w) + (a1.x * a1.x + a1.y * a1.y) + (a1.z * a1.z + a1.w * a1.w);
                    { const auto r16 = __builtin_amdgcn_permlane16_swap(__float_as_uint(s), __float_as_uint(s), false, false); s = __uint_as_float(r16[0]) + __uint_as_float(r16[1]); }
                    { const auto r32_ = __builtin_amdgcn_permlane32_swap(__float_as_uint(s), __float_as_uint(s), false, false); s = __uint_as_float(r32_[0]) + __uint_as_float(r32_[1]); }
                    P[((ai * HALF + m * 16 + rl0) * 2 + bj) * 4 + wc] = s; __builtin_amdgcn_sched_barrier(0); }
        asm volatile("s_waitcnt lgkmcnt(0)" ::: "memory"); __builtin_amdgcn_s_barrier(); asm volatile("" ::: "memory");
        if (pn < 4) {
            bf16_t* base = (bf16_t*)(ws + WS_VV) + (pn - 2) * BM; const float* gp = gmg + (pn - 2) * BM + cl0;
            f32x4 g8[2][2];
#pragma unroll
            for (int bj = 0; bj < 2; ++bj) { g8[bj][0] = *(const f32x4*)(gp + bj * HALF); g8[bj][1] = *(const f32x4*)(gp + bj * HALF + 4); }
#pragma unroll
            for (int ai = 0; ai < 2; ++ai)
#pragma unroll
                for (int m = 0; m < 4; ++m) { const int rl = ai * HALF + m * 16 + rl0; bf16_t* rowp = base + (grow0 + rl) * 512 + cl0;
#pragma unroll
                    for (int bj = 0; bj < 2; ++bj) { const f32x4 p = *(const LAS f32x4*)(P + (rl * 2 + bj) * 4);
                        const float rinv = rsqrtf(((p.x + p.y) + (p.z + p.w)) * (1.f / 128.f) + EPS);
                        *(u32x4*)(rowp + bj * HALF) = pack8(acc[ai][bj][m][0] * rinv * g8[bj][0], acc[ai][bj][m][1] * rinv * g8[bj][1]); }
                    asm volatile("" ::: "memory"); __builtin_amdgcn_sched_barrier(0); }
            return;
        }
        {
            const bool isq = pn < 6; const float* gn = isq ? qg : kg;
            const int grp = cl0 >> 3, fo = (grp >> 3) * 64 + (grp & 7) * 4;
            const f32x4 gA = *(const f32x4*)(gn + fo), gB = *(const f32x4*)(gn + fo + 32);
            const size_t kvrow0 = (size_t)((u.pm / 33) * 2) * RPB + (size_t)(u.pm % 33) * BM;
            bf16_t* base = isq ? (bf16_t*)(ws + WS_Q) + (pn - 4) * BM + grow0 * 512 : (bf16_t*)(ws + WS_K) + kvrow0 * 128; const int ld = isq ? 512 : 128;
            const size_t bjs = isq ? (size_t)HALF : (size_t)RPB * 128;
            const int tl = u.pm % 33; const bool lat = tl != 0; const int ax = grp >> 3, f0 = (grp & 7) * 4;
            const float* rope = (const float*)(ws + WS_ROPE);
#pragma unroll
            for (int ai = 0; ai < 2; ++ai)
#pragma unroll
                for (int m = 0; m < 4; ++m) { const int rl = ai * HALF + m * 16 + rl0; bf16_t* rowp = base + (size_t)rl * ld + cl0;
                    f32x4 cs0 = {1.f, 0.f, 1.f, 0.f}, cs1 = {1.f, 0.f, 1.f, 0.f};
                    if (lat) { const int t = (tl - 1) * 256 + rl; const int pos = ax == 0 ? (t >> 6) : (t & 63); const float* rp = rope + (pos * 32 + f0) * 2; cs0 = *(const f32x4*)rp; cs1 = *(const f32x4*)(rp + 4); }
#pragma unroll
                    for (int bj = 0; bj < 2; ++bj) { const f32x4 p = *(const LAS f32x4*)(P + (rl * 2 + bj) * 4);
                        const float rinv = rsqrtf(((p.x + p.y) + (p.z + p.w)) * (1.f / 128.f) + EPS);
                        const f32x4 x1 = acc[ai][bj][m][0] * rinv * gA, x2 = acc[ai][bj][m][1] * rinv * gB;
                        f32x4 o1, o2;
                        o1.x = x1.x * cs0.x - x2.x * cs0.y; o2.x = x2.x * cs0.x + x1.x * cs0.y;
                        o1.y = x1.y * cs0.z - x2.y * cs0.w; o2.y = x2.y * cs0.z + x1.y * cs0.w;
                        o1.z = x1.z * cs1.x - x2.z * cs1.y; o2.z = x2.z * cs1.x + x1.z * cs1.y;
                        o1.w = x1.w * cs1.z - x2.w * cs1.w; o2.w = x2.w * cs1.z + x1.w * cs1.w;
                        *(u32x4*)(rowp + bj * bjs) = pack8(o1, o2); }
                    asm volatile("" ::: "memory"); __builtin_amdgcn_sched_barrier(0); }
        }
    }
};

__device__ __forceinline__ f32x4 mma16(const bf16x8& b, const bf16x8& a, const f32x4& c) { return __builtin_amdgcn_mfma_f32_16x16x32_bf16(b, a, c, 0, 0, 0); }
__device__ __forceinline__ i32x4 mma16(const bf16x8& b, const bf16x8& a, const i32x4& c) { return __builtin_amdgcn_mfma_i32_16x16x64_i8(__builtin_bit_cast(i32x4, b), __builtin_bit_cast(i32x4, a), c, 0, 0, 0); }
template <bool I8> struct AccT { typedef f32x4 type; };
template <> struct AccT<true> { typedef i32x4 type; };
template <class Epi, class Sched, bool ALIGN_EPI = false, bool SP2 = false, bool I8 = false>
__device__ __forceinline__ void gemm_phase(LAS unsigned char* lds, const Gemm g, const Sched& S, const Epi& E) {
    const int tid = threadIdx.x, wid = __builtin_amdgcn_readfirstlane(tid >> 6), lane = tid & 63, wr = wid >> 2, wc = wid & 3, fr = lane & 15, fq = lane >> 4;
    const int K = g.K, KB = I8 ? K : 2 * K  , nt = KB / (BK * 2);
    unsigned voffA[2], voffB[2];
#pragma unroll
    for (int i = 0; i < 2; ++i) { int R, C; stage_rc(tid * 16 + i * 8192, R, C); const int Rb = Epi::PERM ? ((R & ~31) + perm32(R & 31)) : R;
        voffA[i] = (unsigned)(R * KB + C * 2); voffB[i] = (unsigned)(Rb * KB + C * 2); }
    const size_t kstep = (size_t)(BK * 2);
    const size_t hstep = (size_t)HALF * KB;
    const size_t tstep = 2 * hstep;
    const unsigned ldsw = (unsigned)wid * 1024u;
    const int aoff = lds_byte(wr * 64 + fr, fq * 8), boff = lds_byte(wc * 32 + fr, fq * 8);
#define PG8_SA(b, h) (((b) * 2 + (h)) * HTB)
#define PG8_SB(b, h) ((4 + (b) * 2 + (h)) * HTB)
#define PG8_STAGE(bufoff, gbase, voff) do { _Pragma("unroll") for (int _i = 0; _i < 2; ++_i) \
        __builtin_amdgcn_global_load_lds((const unsigned*)((const char*)(gbase) + (voff)[_i]), (LAS unsigned*)(lds + (bufoff) + ldsw + _i * 8192), 16, 0, 0); } while (0)
#define PG8_LDA(dst, b, h) do { _Pragma("unroll") for (int m = 0; m < 4; ++m) _Pragma("unroll") for (int k = 0; k < 2; ++k) dst[m][k] = *(const LAS bf16x8*)(lds + PG8_SA(b, h) + aoff + m * 2048 + k * 1024); } while (0)
#define PG8_LDB(dst, b, h) do { _Pragma("unroll") for (int n = 0; n < 2; ++n) _Pragma("unroll") for (int k = 0; k < 2; ++k) dst[n][k] = *(const LAS bf16x8*)(lds + PG8_SB(b, h) + boff + n * 2048 + k * 1024); } while (0)
#define PG8_MMA(ai, bj, At, Bt) do { __builtin_amdgcn_s_setprio(1); _Pragma("unroll") for (int m = 0; m < 4; ++m) _Pragma("unroll") for (int n = 0; n < 2; ++n) _Pragma("unroll") for (int k = 0; k < 2; ++k) \
        acc[ai][bj][m][n] = mma16(Bt[n][k], At[m][k], acc[ai][bj][m][n]); __builtin_amdgcn_s_setprio(0); } while (0)
#define PG8_WAIT_V(n) asm volatile("s_waitcnt vmcnt(" #n ")" ::: "memory")
#define PG8_WAIT_L(n) asm volatile("s_waitcnt lgkmcnt(" #n ")" ::: "memory")
#define PG8_BAR __builtin_amdgcn_s_barrier()
#define PG8_SCHED __builtin_amdgcn_sched_barrier(0)
    Unit cur, nxt; int ui = 0;
    if (!S.next(0, cur)) return;
    typedef typename AccT<I8>::type acc_t;
    acc_t acc[2][2][4][2];
#pragma unroll
    for (int a = 0; a < 2; ++a)
#pragma unroll
        for (int b = 0; b < 2; ++b)
#pragma unroll
            for (int m = 0; m < 4; ++m)
#pragma unroll
                for (int n = 0; n < 2; ++n) acc[a][b][m][n] = acc_t{};
    bf16x8 At[4][2], B0[2][2], B1[2][2];
    const char* cA = (const char*)g.A + (size_t)cur.pm * tstep; const char* cB = (const char*)g.Bt + (size_t)cur.pn * tstep;
    S.a_ready(cur);
    if constexpr (SP2) {
        PG8_STAGE(PG8_SB(0, 0), cB, voffB); PG8_STAGE(PG8_SB(0, 1), cB + hstep, voffB); PG8_STAGE(PG8_SA(0, 0), cA, voffA); PG8_STAGE(PG8_SA(0, 1), cA + hstep, voffA);
        if (wr == 1) PG8_BAR;
        PG8_WAIT_V(2); PG8_BAR;
        PG8_STAGE(PG8_SB(1, 0), cB + kstep, voffB); PG8_STAGE(PG8_SA(1, 0), cA + kstep, voffA); PG8_STAGE(PG8_SB(1, 1), cB + hstep + kstep, voffB);
        PG8_WAIT_V(6); PG8_BAR;
    } else {
        PG8_STAGE(PG8_SB(0, 0), cB, voffB); PG8_STAGE(PG8_SA(0, 0), cA, voffA); PG8_STAGE(PG8_SB(0, 1), cB + hstep, voffB); PG8_STAGE(PG8_SA(0, 1), cA + hstep, voffA);
        if (wr == 1) PG8_BAR;
        PG8_WAIT_V(4); PG8_BAR;
        PG8_STAGE(PG8_SB(1, 0), cB + kstep, voffB); PG8_STAGE(PG8_SA(1, 0), cA + kstep, voffA); PG8_STAGE(PG8_SB(1, 1), cB + hstep + kstep, voffB);
        PG8_WAIT_V(6); PG8_BAR;
    }
    asm volatile(".p2align 6");
    for (;;) {
        const bool has_next = S.next(ui + 1, nxt);
        const char* nA = has_next ? (const char*)g.A + (size_t)nxt.pm * tstep : cA; const char* nB = has_next ? (const char*)g.Bt + (size_t)nxt.pn * tstep : cB;
        for (int t = 0; t < nt; t += 2) {
            const bool last = (t == nt - 2);
            const char* a1 = cA + (size_t)(t + 1) * kstep;
            const char* a2 = last ? nA : cA + (size_t)(t + 2) * kstep; const char* b2 = last ? nB : cB + (size_t)(t + 2) * kstep;
            const char* a3 = a2 + kstep; const char* b3 = b2 + kstep;
            if (last && has_next) S.a_ready(nxt);
            if constexpr (SP2) {
            PG8_LDB(B0, 0, 0); PG8_LDB(B1, 0, 1); PG8_SCHED; PG8_LDA(At, 0, 0); PG8_STAGE(PG8_SA(1, 1), a1 + hstep, voffA);
            PG8_WAIT_V(8); PG8_WAIT_L(0); PG8_BAR; PG8_MMA(0, 0, At, B0); PG8_MMA(0, 1, At, B1); PG8_BAR; PG8_SCHED;
            PG8_LDA(At, 0, 1); PG8_STAGE(PG8_SB(0, 0), b2, voffB); PG8_STAGE(PG8_SB(0, 1), b2 + hstep, voffB); PG8_STAGE(PG8_SA(0, 0), a2, voffA);
            PG8_WAIT_V(8); PG8_WAIT_L(0); PG8_BAR; PG8_MMA(1, 0, At, B0); PG8_MMA(1, 1, At, B1); PG8_BAR; PG8_SCHED;
            PG8_LDB(B0, 1, 0); PG8_LDB(B1, 1, 1); PG8_SCHED; PG8_LDA(At, 1, 0); PG8_STAGE(PG8_SA(0, 1), a2 + hstep, voffA);
            PG8_WAIT_V(8); PG8_WAIT_L(0); PG8_BAR; PG8_MMA(0, 0, At, B0); PG8_MMA(0, 1, At, B1); PG8_BAR; PG8_SCHED;
            PG8_LDA(At, 1, 1); PG8_STAGE(PG8_SB(1, 0), b3, voffB); PG8_STAGE(PG8_SB(1, 1), b3 + hstep, voffB); PG8_STAGE(PG8_SA(1, 0), a3, voffA);
            PG8_WAIT_V(8); PG8_WAIT_L(0); PG8_BAR; PG8_MMA(1, 0, At, B0); PG8_MMA(1, 1, At, B1); PG8_BAR; PG8_SCHED;
            } else {
            PG8_LDB(B0, 0, 0); PG8_SCHED; PG8_LDA(At, 0, 0); PG8_STAGE(PG8_SA(1, 1), a1 + hstep, voffA);
            PG8_WAIT_L(8); PG8_BAR; PG8_WAIT_L(0); PG8_MMA(0, 0, At, B0); PG8_BAR; PG8_SCHED;
            PG8_LDB(B1, 0, 1); PG8_STAGE(PG8_SB(0, 0), b2, voffB);
            PG8_BAR; PG8_WAIT_L(0); PG8_MMA(0, 1, At, B1); PG8_BAR;
            PG8_LDA(At, 0, 1); PG8_STAGE(PG8_SA(0, 0), a2, voffA);
            PG8_BAR; PG8_WAIT_L(0); PG8_MMA(1, 0, At, B0); PG8_BAR; PG8_SCHED;
            PG8_STAGE(PG8_SB(0, 1), b2 + hstep, voffB);
            PG8_WAIT_V(6); PG8_BAR; PG8_MMA(1, 1, At, B1); PG8_BAR;
            PG8_LDB(B0, 1, 0); PG8_SCHED; PG8_LDA(At, 1, 0); PG8_STAGE(PG8_SA(0, 1), a2 + hstep, voffA);
            PG8_WAIT_L(8); PG8_BAR; PG8_WAIT_L(0); PG8_MMA(0, 0, At, B0); PG8_BAR; PG8_SCHED;
            PG8_LDB(B1, 1, 1); PG8_STAGE(PG8_SB(1, 0), b3, voffB);
            PG8_BAR; PG8_WAIT_L(0); PG8_MMA(0, 1, At, B1); PG8_BAR;
            PG8_LDA(At, 1, 1); PG8_STAGE(PG8_SA(1, 0), a3, voffA);
            PG8_BAR; PG8_WAIT_L(0); PG8_MMA(1, 0, At, B0); PG8_BAR; PG8_SCHED;
            PG8_STAGE(PG8_SB(1, 1), b3 + hstep, voffB);
            PG8_WAIT_V(6); PG8_BAR; PG8_MMA(1, 1, At, B1); PG8_BAR;
            }
        }
        if constexpr (ALIGN_EPI) { if (wr == 0) PG8_BAR; }
        if constexpr (!Epi::AFTER_DRAIN) {
            if constexpr (I8) {
                f32x4 accf[2][2][4][2];
                { int rl0 = wr * 64 + fr, cl0 = wc * 32 + 8 * fq; asm volatile("" : "+v"(rl0), "+v"(cl0));
                  const float* sap = g.sa + (size_t)cur.pm * BM + rl0; const float* swp = g.sw + (size_t)cur.pn * BM + cl0;
                  f32x4 cs[2][2];
#pragma unroll
                  for (int bj = 0; bj < 2; ++bj) { cs[bj][0] = *(const f32x4*)(swp + bj * HALF); cs[bj][1] = *(const f32x4*)(swp + bj * HALF + 4); }
#pragma unroll
                  for (int ai = 0; ai < 2; ++ai)
#pragma unroll
                    for (int m = 0; m < 4; ++m) { const float rs = sap[ai * HALF + m * 16];
#pragma unroll
                        for (int bj = 0; bj < 2; ++bj)
#pragma unroll
                            for (int n = 0; n < 2; ++n) accf[ai][bj][m][n] = __builtin_convertvector(acc[ai][bj][m][n], f32x4) * (cs[bj][n] * rs); } }
                E(accf, cur, wr, wc, fr, fq);
            } else { E(acc, cur, wr, wc, fr, fq); }
            S.done(cur); }
        if (!has_next) break;
#pragma unroll
        for (int a = 0; a < 2; ++a)
#pragma unroll
            for (int b = 0; b < 2; ++b)
#pragma unroll
                for (int m = 0; m < 4; ++m)
#pragma unroll
                    for (int n = 0; n < 2; ++n) acc[a][b][m][n] = acc_t{};
        cur = nxt; cA = nA; cB = nB; ++ui;
        if constexpr (ALIGN_EPI) { if (wr == 1) PG8_BAR; }
    }
    PG8_WAIT_V(0);
    if constexpr (!ALIGN_EPI) { if (wr == 0) PG8_BAR; }
    PG8_BAR;
#undef PG8_SA
#undef PG8_SB
#undef PG8_STAGE
#undef PG8_LDA
#undef PG8_LDB
#undef PG8_MMA
#undef PG8_WAIT_V
#undef PG8_WAIT_L
#undef PG8_BAR
#undef PG8_SCHED
}
}

__device__ __forceinline__ void fphase_inproj0(const Args& a, char* lds) {
    pg8::Gemm g{(const bf16_t*)(a.ws + WS_H8), (const bf16_t*)(a.ws + WS_W8IN0), MTOT, 2048, 1024, (const float*)(a.ws + WS_SH), (const float*)(a.ws + WS_SW)};
    pg8::StaticOrder S; S.init(MTOT, 2048, (int)gridDim.x, (int)blockIdx.x);
    pg8::EpiInproj0 E{a.ws, a.in[9], a.in[12], a.in[13], (LAS float*)((LAS char*)lds + 131072)};
    pg8::gemm_phase<pg8::EpiInproj0, pg8::StaticOrder, true, true, true>((LAS unsigned char*)lds, g, S, E);
    const int G = (int)gridDim.x, nbusy = 528 - 2 * G;
    if (G == 256 && (int)blockIdx.x >= nbusy) { __syncthreads(); for (int j = (int)blockIdx.x - nbusy; j < 192; j += G - nbusy) prep_l0_item(a, (float*)lds, 320 + j); }
    if (G == 256 && (int)blockIdx.x >= nbusy) quant_tables(a, 0, ((int)blockIdx.x - nbusy) * NWAVE + (int)(threadIdx.x >> 6), (G - nbusy) * NWAVE, (int)(threadIdx.x & 63), 0, NEXP);
    else if (G != 256) quant_tables(a, 0, (int)blockIdx.x * NWAVE + (int)(threadIdx.x >> 6), G * NWAVE, (int)(threadIdx.x & 63), 0, NEXP);
}
__device__ __forceinline__ void fphase_outproj0(const Args& a, char* lds) {
    pg8::Gemm g{(const bf16_t*)(a.ws + WS_AO), (const bf16_t*)(a.ws + WS_WOUT0), MTOT, 1024, 1024, nullptr, nullptr};
    pg8::StaticOrder S; S.init(MTOT, 1024, (int)gridDim.x, (int)blockIdx.x);
    pg8::EpiResid E{a.in[0], a.in[2], (const float*)(a.ws + WS_MODV) + 2 * 1024, (bf16_t*)(a.ws + WS_X1), 0};
    pg8::gemm_phase<pg8::EpiResid, pg8::StaticOrder, true, true>((LAS unsigned char*)lds, g, S, E);
    const int G = (int)gridDim.x, nbusy = (G == 256) ? 264 - G : 0;
    if ((int)blockIdx.x >= nbusy) quant_tables(a, 0, ((int)blockIdx.x - nbusy) * NWAVE + (int)(threadIdx.x >> 6), (G - nbusy) * NWAVE, (int)(threadIdx.x & 63), NEXP, 2 * NEXP);
    if (G == 256 && (int)blockIdx.x >= nbusy) { __syncthreads(); for (int r = (int)blockIdx.x - nbusy; r < 200; r += G - nbusy) prep_l1_item(a, (float*)lds, r < 160 ? r : r + 208); }
    if (G == 256 && (int)blockIdx.x >= nbusy) { for (int j = (int)blockIdx.x - nbusy; j < 96; j += G - nbusy) prep_l0_item(a, (float*)lds, 96 + j); }
    if (G == 256 && (int)blockIdx.x >= nbusy) quant_wrows((const bf16_t*)(a.ws + WS_WQ), a.ws + WS_W8Q, (float*)(a.ws + WS_SW) + 2048, 2048, ((int)blockIdx.x - nbusy) * NWAVE + (int)(threadIdx.x >> 6), (G - nbusy) * NWAVE, (int)(threadIdx.x & 63));
}
__device__ __forceinline__ void fphase_peerq0(const Args& a, char* lds) {
    pg8::Gemm g{(const bf16_t*)(a.ws + WS_H8), (const bf16_t*)(a.ws + WS_W8Q), MTOT, 2048, 1024, (const float*)(a.ws + WS_SH), (const float*)(a.ws + WS_SW) + 2048};
    pg8::StaticOrder S; S.init(MTOT, 2048, (int)gridDim.x, (int)blockIdx.x);
    pg8::EpiStore E{(bf16_t*)(a.ws + WS_QP), (bf16_t*)(a.ws + WS_QP), 2048, 1000, 0};
    pg8::gemm_phase<pg8::EpiStore, pg8::StaticOrder, true, true, true>((LAS unsigned char*)lds, g, S, E);
    const int G = (int)gridDim.x, nbusy = (G == 256) ? 528 - 2 * G : 0;
    if ((int)blockIdx.x >= nbusy) for (int r = (int)blockIdx.x - nbusy; r < 208; r += G - nbusy) prep_l1_item(a, (float*)lds, 160 + r);
    if ((int)blockIdx.x >= nbusy) quant_tables(a, 1, ((int)blockIdx.x - nbusy) * NWAVE + (int)(threadIdx.x >> 6), (G - nbusy) * NWAVE, (int)(threadIdx.x & 63), 0, NEXP / 2);
    if (G == 256 && (int)blockIdx.x >= nbusy) quant_wrows((const bf16_t*)(a.ws + WS_WIN1), a.ws + WS_W8IN1, (float*)(a.ws + WS_SW) + 3 * 2048, 2560, ((int)blockIdx.x - nbusy) * NWAVE + (int)(threadIdx.x >> 6), (G - nbusy) * NWAVE, (int)(threadIdx.x & 63));
}
__device__ __forceinline__ void fphase_inproj1(const Args& a, char* lds) {
    pg8::Gemm g{(const bf16_t*)(a.ws + WS_H8B), (const bf16_t*)(a.ws + WS_W8IN1), MTOT, 2560, 1024, (const float*)(a.ws + WS_SH), (const float*)(a.ws + WS_SW) + 3 * 2048};
    pg8::StaticOrder S; S.init(MTOT, 2560, (int)gridDim.x, (int)blockIdx.x);
    pg8::EpiStore E{(bf16_t*)(a.ws + WS_GG), (bf16_t*)(a.ws + WS_XR), 1280, 5, 5};
    pg8::gemm_phase<pg8::EpiStore, pg8::StaticOrder, true, true, true>((LAS unsigned char*)lds, g, S, E);
    const int G = (int)gridDim.x, nbusy = 660 - 2 * G;
    if (G == 256 && (int)blockIdx.x >= nbusy) quant_tables(a, 1, ((int)blockIdx.x - nbusy) * NWAVE + (int)(threadIdx.x >> 6), (G - nbusy) * NWAVE, (int)(threadIdx.x & 63), NEXP / 2, NEXP);
    else if (G != 256) quant_tables(a, 1, (int)blockIdx.x * NWAVE + (int)(threadIdx.x >> 6), G * NWAVE, (int)(threadIdx.x & 63), NEXP / 2, NEXP);
}
__device__ __forceinline__ void fphase_outproj1(const Args& a, char* lds) {
    pg8::Gemm g{(const bf16_t*)(a.ws + WS_YG), (const bf16_t*)(a.ws + WS_WOUT1), MTOT, 1024, 1280, nullptr, nullptr};
    pg8::LatentOrder S; S.init(1024, (int)gridDim.x, (int)blockIdx.x);
    pg8::EpiResid E{a.in[0], a.in[2], (const float*)(a.ws + WS_MODV) + 3 * 6144 + 2 * 1024, (bf16_t*)(a.ws + WS_X1), 1};
    pg8::gemm_phase<pg8::EpiResid, pg8::LatentOrder, true, true>((LAS unsigned char*)lds, g, S, E);
}
__device__ __forceinline__ void fphase_peerq1(const Args& a, char* lds) {
    pg8::Gemm g{(const bf16_t*)(a.ws + WS_H8), (const bf16_t*)(a.ws + WS_W8Q + (size_t)2048 * 1024), MTOT, 2048, 1024, (const float*)(a.ws + WS_SH), (const float*)(a.ws + WS_SW) + 2 * 2048};
    pg8::LatentOrder S; S.init(2048, (int)gridDim.x, (int)blockIdx.x);
    pg8::EpiStore E{(bf16_t*)(a.ws + WS_QP), (bf16_t*)(a.ws + WS_QP), 2048, 1000, 0};
    pg8::gemm_phase<pg8::EpiStore, pg8::LatentOrder, true, true, true>((LAS unsigned char*)lds, g, S, E);
}

constexpr int NPHASE = 23;
__global__ void __launch_bounds__(NTHR, 2) mega(Args a) {
    extern __shared__ __attribute__((aligned(16))) char lds[];
    volatile LAS unsigned* MISC = (volatile LAS unsigned*)((LAS char*)lds + LDS_MISC);
    if (threadIdx.x < 64) MISC[threadIdx.x] = 0u;
    __syncthreads();
    XcdBarrier bar; bar.bar = (unsigned*)(a.ws + WS_CTL) + 4096; bar.x = 0; bar.st = nullptr;
    const bool multi = (a.ph_hi - a.ph_lo) > 1;
    if (multi) bar = xcd_barrier_post((unsigned*)(a.ws + WS_CTL) + 4096, MISC + 8);
    const int lo = a.ph_lo, hi = a.ph_hi;
    unsigned char* ws = a.ws;
#define IN(k) (lo <= (k) && (k) < hi)
#define SEAM(k) do { if (IN(k) && IN((k) + 1)) xcd_barrier(bar); } while (0)
#ifndef PROBE_DUP
#define PROBE_DUP 0u
#endif
#define DUPQ(k) (((PROBE_DUP >> (k)) & 1u) != 0u)
    if (IN(0)) { phase_prep(a, lds); if (DUPQ(0)) { xcd_barrier(bar); phase_prep(a, lds); } } SEAM(0);
    if (IN(1)) { phase_norm(a, 0, 0, a.in[6], 0, 1, false, true);
        { const int gwq = blockIdx.x * NWAVE + (threadIdx.x >> 6), ngwq = gridDim.x * NWAVE, lq = threadIdx.x & 63;
          quant_wrows((const bf16_t*)(ws + WS_WIN0), ws + WS_W8IN0, (float*)(ws + WS_SW), 2048, gwq, ngwq, lq);
          if (gridDim.x != 256) quant_wrows((const bf16_t*)(ws + WS_WQ), ws + WS_W8Q, (float*)(ws + WS_SW) + 2048, 2048, gwq, ngwq, lq); } } SEAM(1);
    if (IN(2)) { fphase_inproj0(a, lds); if (DUPQ(2)) { xcd_barrier(bar); fphase_inproj0(a, lds); } } SEAM(2);
    if (IN(3)) { phase_gmlp2(a, lds); phase_attn(a, lds); if (DUPQ(3)) { xcd_barrier(bar); phase_gmlp2(a, lds); phase_attn(a, lds); } } SEAM(3);
    if (IN(4)) { fphase_outproj0(a, lds); if (DUPQ(4)) { xcd_barrier(bar); fphase_outproj0(a, lds); } } SEAM(4);
    if (IN(5)) { phase_norm(a, 0, 1, a.in[7], 3, 4, false, true); if (DUPQ(5)) { xcd_barrier(bar); phase_norm(a, 0, 1, a.in[7], 3, 4, false, true); } } SEAM(5);
    if (IN(6)) { fphase_peerq0(a, lds); if (DUPQ(6)) { xcd_barrier(bar); fphase_peerq0(a, lds); } if (IN(7)) topk_load_keys(a, lds, 0); } SEAM(6);
    if (IN(7)) { phase_peer_topk3(a, lds, 0, false, IN(6)); if (DUPQ(7)) { xcd_barrier(bar); phase_peer_topk3(a, lds, 0, false); } } SEAM(7);
    if (IN(8)) { phase_gu(a, lds, 0, 0); if (DUPQ(8)) { xcd_barrier(bar); phase_gu(a, lds, 0, 0); } } SEAM(8);
    if (IN(9)) { phase_gact(a, 0, 0);
        if (gridDim.x != 256) { const int gwq = blockIdx.x * NWAVE + (threadIdx.x >> 6), ngwq = gridDim.x * NWAVE, lq = threadIdx.x & 63;
          quant_wrows((const bf16_t*)(ws + WS_WIN1), ws + WS_W8IN1, (float*)(ws + WS_SW) + 3 * 2048, 2560, gwq, ngwq, lq);
          quant_wrows((const bf16_t*)(ws + WS_WQ) + (size_t)2048 * 1024, ws + WS_W8Q + (size_t)2048 * 1024, (float*)(ws + WS_SW) + 2 * 2048, 2048, gwq, ngwq, lq); } } SEAM(9);
    if (IN(10)) { phase_gv(a, lds, 0, 0); if (DUPQ(10)) { xcd_barrier(bar); phase_gv(a, lds, 0, 0); } } SEAM(10);
    if (IN(11)) { phase_norm(a, 1, 1, a.in[6] + D, 0, 1, false, true, WS_H8B); } SEAM(11);
    if (IN(12)) { fphase_inproj1(a, lds); if (DUPQ(12)) { xcd_barrier(bar); fphase_inproj1(a, lds); } } SEAM(12);
    if (IN(13)) { phase_rglru2(a, lds, 0); if (DUPQ(13)) { xcd_barrier(bar); phase_rglru2(a, lds, 0); } } SEAM(13);
    if (IN(14)) { phase_rglru_out(a, lds); if (DUPQ(14)) { xcd_barrier(bar); phase_rglru_out(a, lds); } } SEAM(14);
    if (IN(15)) { fphase_outproj1(a, lds); if (DUPQ(15)) { xcd_barrier(bar); fphase_outproj1(a, lds); } } SEAM(15);
    if (IN(16)) { phase_norm(a, 1, 1, a.in[7] + D, 3, 4, true, true); if (DUPQ(16)) { xcd_barrier(bar); phase_norm(a, 1, 1, a.in[7] + D, 3, 4, true, true); } } SEAM(16);
    if (IN(17)) { fphase_peerq1(a, lds); if (DUPQ(17)) { xcd_barrier(bar); fphase_peerq1(a, lds); } if (IN(18)) topk_load_keys(a, lds, 1); } SEAM(17);
    if (IN(18)) { phase_peer_topk3(a, lds, 1, true, IN(17)); if (DUPQ(18)) { xcd_barrier(bar); phase_peer_topk3(a, lds, 1, true); } } SEAM(18);
    if (IN(19)) { phase_gu(a, lds, 1, 1); if (DUPQ(19)) { xcd_barrier(bar); phase_gu(a, lds, 1, 1); } } SEAM(19);
    if (IN(20)) { phase_gact(a, 1, 1); if (DUPQ(20)) { xcd_barrier(bar); phase_gact(a, 1, 1); } } SEAM(20);
    if (IN(21)) { phase_gv(a, lds, 1, 1); if (DUPQ(21)) { xcd_barrier(bar); phase_gv(a, lds, 1, 1); } } SEAM(21);
    if (IN(22)) { phase_finalnorm(a); if (DUPQ(22)) { xcd_barrier(bar); phase_finalnorm(a); } }
#undef IN
#undef SEAM
}

extern "C" void kernel_launch(void* const* d_in, const int* in_sizes, int n_in, void* d_out, int out_size, void* d_ws, size_t ws_size, hipStream_t stream) {
    static int grid = 0;
    if (grid == 0) {
        if (n_in != 29 || out_size != NB * SEQ * D || ws_size < WS_END) {
            fprintf(stderr, "kernel_launch: unexpected shapes: n_in %d out %d ws %zu (need %zu)\n", n_in, out_size, ws_size, (size_t)WS_END); grid = -1; return; }
        int dev = 0, cus = 0, per_cu = 0;
        if (hipGetDevice(&dev) != hipSuccess || hipDeviceGetAttribute(&cus, hipDeviceAttributeMultiprocessorCount, dev) != hipSuccess) { grid = -1; return; }
        if (hipFuncSetAttribute((const void*)mega, hipFuncAttributeMaxDynamicSharedMemorySize, LDS_BYTES) != hipSuccess) { fprintf(stderr, "kernel_launch: hipFuncSetAttribute failed\n"); grid = -1; return; }
        if (hipOccupancyMaxActiveBlocksPerMultiprocessor(&per_cu, (const void*)mega, NTHR, LDS_BYTES) != hipSuccess || per_cu < 1)
            fprintf(stderr, "kernel_launch: occupancy query reports %d blocks per CU\n", per_cu);
        (void)hipGetLastError();
        grid = cus & ~7; if (grid < 8) grid = 8;
    }
    if (grid < 0) return;
    (void)hipMemsetAsync((char*)d_ws + WS_CTL + 16384, 0, 16384, stream);
    Args a{};
    for (int i = 0; i < 29; ++i) a.in[i] = (const float*)d_in[i];
    a.out = (float*)d_out; a.ws = (unsigned char*)d_ws;
#if MK_SINGLE
    a.ph_lo = 0; a.ph_hi = NPHASE;
    hipLaunchKernelGGL(mega, dim3(grid), dim3(NTHR), LDS_BYTES, stream, a);
#else
    for (int p = 0; p < NPHASE; ++p) { a.ph_lo = p; a.ph_hi = p + 1; hipLaunchKernelGGL(mega, dim3(grid), dim3(NTHR), LDS_BYTES, stream, a); }
#endif
    const hipError_t le = hipPeekAtLastError();
    if (le != hipSuccess) fprintf(stderr, "kernel_launch: launch failed: %s\n", hipGetErrorName(le));
}
```
